# Optimizing an MI355X kernel written in HIP

```python
import jax, jax.numpy as jnp
from jax import lax
import numpy as np

D_MODEL = 1024
BATCH = 8
SEQ = 4096
DEPTH = 2

GRID_W = 64
CTX_LEN = 256
MIX_W = D_MODEL
RG_W = MIX_W // 2
RG_BLOCKS = 8
RG_BLOCK_W = RG_W // RG_BLOCKS
RG_C = 8.0
CONV_W = 4
CONV_LEFT = 2
RET_W = MIX_W - RG_W
RET_HEADS = 4
RET_HEAD_DIM = RET_W // RET_HEADS
RET_CHUNK = 128
ROPE_BASE = 10000.0
IN_W = 2 * RG_W + 4 * RET_W
D_FF = 2816
N_EXPERTS = 8
TOP_K = 2
D_EXPERT = 3584
MOE_BLOCK = 512
N_DENSE = (DEPTH + 1) // 2
N_MOE = DEPTH // 2
EPS = 1e-6

kernel_name = 'hybrid_rglru_retention_moe_dit'


def rms_norm(x, g):
    xf = x.astype(jnp.float32)
    y = xf * lax.rsqrt(jnp.mean(xf * xf, axis=-1, keepdims=True) + EPS)
    return (y * g.astype(jnp.float32)).astype(x.dtype)


def modulate(h, shift, scale):
    return h * (1 + scale) + shift


def short_conv(u, w, b):
    n = u.shape[1]
    up = jnp.pad(u, ((0, 0), (CONV_LEFT, CONV_W - 1 - CONV_LEFT), (0, 0)))
    return sum(up[:, k:k + n] * w[k] for k in range(CONV_W)) + b


def _lin_combine(e1, e2):
    a1, b1 = e1
    a2, b2 = e2
    return a1 * a2, a2 * b1 + b2


def rglru(u, w_a, b_a, w_x, b_x, lam, h0, reverse):
    f32 = jnp.float32
    bsz, n, _ = u.shape
    ub = u.reshape(bsz, n, RG_BLOCKS, RG_BLOCK_W)
    r = jax.nn.sigmoid(jnp.einsum('bnkc,kcd->bnkd', ub, w_a.astype(f32)).reshape(bsz, n, RG_W) + b_a.astype(f32))
    i = jax.nn.sigmoid(jnp.einsum('bnkc,kcd->bnkd', ub, w_x.astype(f32)).reshape(bsz, n, RG_W) + b_x.astype(f32))
    log_a = -RG_C * r * jax.nn.softplus(-lam.astype(f32))
    a = jnp.exp(log_a)
    bt = jnp.sqrt(-jnp.expm1(2.0 * log_a)) * (i * u)
    a_cum, h = lax.associative_scan(_lin_combine, (a, bt), axis=1, reverse=reverse)
    h = h + a_cum * h0[:, None, :]
    return h, (h[:, 0] if reverse else h[:, -1])


def retention_dir(q, k, v, log_g, s0, strict):
    bsz, nh, n, d = q.shape
    L = RET_CHUNK
    nc = n // L
    q = q.reshape(bsz, nh, nc, L, d)
    k = k.reshape(bsz, nh, nc, L, d)
    v = v.reshape(bsz, nh, nc, L, d)
    j = jnp.arange(L, dtype=jnp.float32)
    diff = j[:, None] - j[None, :]
    mask = (diff > 0) if strict else (diff >= 0)
    dec = jnp.where(mask, jnp.exp(jnp.maximum(diff, 0.0) * log_g[:, None, None]), 0.0)
    scores = jnp.einsum('bhcid,bhcjd->bhcij', q, k) * dec[None, :, None]
    inner = jnp.einsum('bhcij,bhcjd->bhcid', scores, v)
    k_dec = k * jnp.exp((L - 1 - j)[None, :] * log_g[:, None])[None, :, None, :, None]
    kv = jnp.einsum('bhcjd,bhcje->cbhde', k_dec, v)
    chunk_decay = jnp.exp(L * log_g)[None, :, None, None]

    def step(s, kv_c):
        return chunk_decay * s + kv_c, s

    s_final, s_prev = lax.scan(step, s0, kv)
    q_dec = q * jnp.exp((j + 1)[None, :] * log_g[:, None])[None, :, None, :, None]
    cross = jnp.einsum('bhcid,cbhde->bhcie', q_dec, s_prev)
    return (inner + cross).reshape(bsz, nh, n, d), s_final


def retention_bidir(q, k, v, log_g_f, log_g_b, s0_f, s0_b):
    o_f, s_f = retention_dir(q, k, v, log_g_f, s0_f, False)
    flip = lambda t: jnp.flip(t, axis=2)
    o_b, s_b = retention_dir(flip(q), flip(k), flip(v), log_g_b, s0_b, True)
    return o_f + flip(o_b), s_f, s_b


def apply_rope(t, cos, sin):
    half = t.shape[-1] // 2
    t1, t2 = t[..., :half], t[..., half:]
    return jnp.concatenate([t1 * cos - t2 * sin, t1 * sin + t2 * cos], axis=-1)


def grid_rope(rows):
    row = jnp.repeat(jnp.arange(rows, dtype=jnp.float32), GRID_W)
    col = jnp.tile(jnp.arange(GRID_W, dtype=jnp.float32), rows)
    n_freq = RET_HEAD_DIM // 4
    inv = ROPE_BASE ** (-jnp.arange(n_freq, dtype=jnp.float32) / n_freq)
    ang = jnp.concatenate([row[:, None] * inv, col[:, None] * inv], axis=-1)
    return jnp.cos(ang), jnp.sin(ang)


def token_mixer(p, rope, states, conv_w, conv_b, rg_wa, rg_ba, rg_wx, rg_bx, rg_lam, ret_decay):
    f32 = jnp.float32
    bsz, n, _ = p.shape
    p = p.astype(f32)
    u, y_gate, q, k, v, g = jnp.split(
        p, [RG_W, 2 * RG_W, 2 * RG_W + RET_W, 2 * RG_W + 2 * RET_W, 2 * RG_W + 3 * RET_W], axis=-1)
    h_f0, h_b0, s_f0, s_b0 = states
    u = short_conv(u, conv_w.astype(f32), conv_b.astype(f32))
    h_f, hf_last = rglru(u, rg_wa[0], rg_ba[0], rg_wx[0], rg_bx[0], rg_lam[0], h_f0, False)
    h_b, hb_last = rglru(u, rg_wa[1], rg_ba[1], rg_wx[1], rg_bx[1], rg_lam[1], h_b0, True)
    rg_out = jax.nn.gelu(y_gate) * (h_f + h_b)
    heads = lambda t: t.reshape(bsz, n, RET_HEADS, RET_HEAD_DIM).transpose(0, 2, 1, 3)
    q, k, v = heads(q), heads(k) * RET_HEAD_DIM ** -0.5, heads(v)
    if rope is not None:
        cos, sin = rope
        q, k = apply_rope(q, cos, sin), apply_rope(k, cos, sin)
    log_g = jax.nn.log_sigmoid(ret_decay.astype(f32))
    o, s_f, s_b = retention_bidir(q, k, v, log_g[0], log_g[1], s_f0, s_b0)
    mu = jnp.mean(o, axis=-1, keepdims=True)
    var = jnp.mean(jnp.square(o - mu), axis=-1, keepdims=True)
    o = ((o - mu) * lax.rsqrt(var + EPS)).transpose(0, 2, 1, 3).reshape(bsz, n, RET_W)
    ret_out = jax.nn.silu(g) * o
    y = jnp.concatenate([rg_out, ret_out], axis=-1)
    return y, (hf_last, hb_last, s_f, s_b)


def swiglu(h, w1, w3, w2):
    return (jax.nn.silu(h @ w1) * (h @ w3)) @ w2


def moe_swiglu(h, w_router, b_router, w1, w3, w2):
    bsz, n, d = h.shape
    t = h.reshape(-1, d)
    n_tok = t.shape[0]
    n_asg = n_tok * TOP_K
    logits = (t @ w_router).astype(jnp.float32) + b_router.astype(jnp.float32)
    top_v, top_i = lax.top_k(logits, TOP_K)
    top_w = jax.nn.softmax(top_v, axis=-1)
    flat_e = top_i.reshape(-1)
    flat_w = top_w.reshape(-1)
    flat_tok = jnp.arange(n_asg, dtype=jnp.int32) // TOP_K
    order = jnp.argsort(flat_e)
    sorted_e = flat_e[order]
    counts = jnp.zeros((N_EXPERTS,), jnp.int32).at[flat_e].add(1)
    padded = (counts + MOE_BLOCK - 1) // MOE_BLOCK * MOE_BLOCK
    pad_end = jnp.cumsum(padded)
    pad_start = pad_end - padded
    start = jnp.cumsum(counts) - counts
    rank = jnp.arange(n_asg, dtype=jnp.int32) - start[sorted_e]
    dest = pad_start[sorted_e] + rank
    n_rows = (-(-n_asg // MOE_BLOCK)) * MOE_BLOCK + N_EXPERTS * MOE_BLOCK
    n_blocks = n_rows // MOE_BLOCK
    buf_tok = jnp.zeros((n_rows,), jnp.int32).at[dest].set(flat_tok[order])
    buf_w = jnp.zeros((n_rows,), jnp.float32).at[dest].set(flat_w[order])
    block_e = jnp.minimum(
        jnp.searchsorted(pad_end, jnp.arange(n_blocks, dtype=jnp.int32) * MOE_BLOCK, side='right'),
        N_EXPERTS - 1)

    def block_ffn(args):
        tok, e = args
        return swiglu(t[tok], w1[e], w3[e], w2[e])

    y = lax.map(block_ffn, (buf_tok.reshape(n_blocks, MOE_BLOCK), block_e))
    out = jnp.zeros((n_tok, d), jnp.float32).at[buf_tok].add(
        buf_w[:, None] * y.reshape(n_rows, d).astype(jnp.float32))
    return out.reshape(bsz, n, d).astype(h.dtype)


def channel_mixer(l, h, ffn_w1, ffn_w3, ffn_w2, moe_router, moe_router_b, moe_w1, moe_w3, moe_w2):
    i = l // 2
    if l % 2 == 0:
        return swiglu(h, ffn_w1[i], ffn_w3[i], ffn_w2[i])
    return moe_swiglu(h, moe_router[i], moe_router_b[i], moe_w1[i], moe_w3[i], moe_w2[i])


def setup_inputs(seed: int = 0) -> dict:
    key = jax.random.key(seed)
    ks = jax.random.split(key, 32)
    f32 = jnp.float32
    nrm = lambda k, shape, s: jax.random.normal(k, shape, f32) * s
    D = D_MODEL
    u = jax.random.uniform(ks[14], (DEPTH, 2, RG_W), f32, 0.9, 0.999)
    a = u ** (1.0 / RG_C)
    rg_lam = jnp.log(a) - jnp.log1p(-a)
    gamma = 1.0 - 2.0 ** (-5.0 - jnp.arange(RET_HEADS, dtype=f32))
    ret_decay = (jnp.log(gamma) - jnp.log1p(-gamma))[None, None, :] + nrm(ks[15], (DEPTH, 2, RET_HEADS), 0.1)
    return {
        'x': nrm(ks[0], (BATCH, SEQ, D), 1.0),
        'c': nrm(ks[1], (BATCH, D), 1.0),
        'ctx': nrm(ks[2], (BATCH, CTX_LEN, D), 1.0),
        'c_ctx': nrm(ks[3], (D,), 1.0),
        'w_mod': nrm(ks[4], (DEPTH, D, 6 * D), D ** -0.5),
        'b_mod': nrm(ks[5], (DEPTH, 6 * D), 0.02),
        'g_mix': 1.0 + nrm(ks[6], (DEPTH, D), 0.02),
        'g_ffn': 1.0 + nrm(ks[7], (DEPTH, D), 0.02),
        'g_final': 1.0 + nrm(ks[8], (D,), 0.02),
        'w_in': nrm(ks[9], (DEPTH, D, IN_W), D ** -0.5),
        'w_out': nrm(ks[10], (DEPTH, MIX_W, D), MIX_W ** -0.5),
        'conv_w': nrm(ks[11], (DEPTH, CONV_W, RG_W), CONV_W ** -0.5),
        'conv_b': nrm(ks[12], (DEPTH, RG_W), 0.02),
        'rg_wa': nrm(ks[13], (DEPTH, 2, RG_BLOCKS, RG_BLOCK_W, RG_BLOCK_W), RG_BLOCK_W ** -0.5),
        'rg_ba': nrm(ks[16], (DEPTH, 2, RG_W), 0.02),
        'rg_wx': nrm(ks[17], (DEPTH, 2, RG_BLOCKS, RG_BLOCK_W, RG_BLOCK_W), RG_BLOCK_W ** -0.5),
        'rg_bx': nrm(ks[18], (DEPTH, 2, RG_W), 0.02),
        'rg_lam': rg_lam,
        'ret_decay': ret_decay,
        'ffn_w1': nrm(ks[19], (N_DENSE, D, D_FF), D ** -0.5),
        'ffn_w3': nrm(ks[20], (N_DENSE, D, D_FF), D ** -0.5),
        'ffn_w2': nrm(ks[21], (N_DENSE, D_FF, D), D_FF ** -0.5),
        'moe_router': nrm(ks[22], (N_MOE, D, N_EXPERTS), D ** -0.5),
        'moe_router_b': nrm(ks[23], (N_MOE, N_EXPERTS), 0.01),
        'moe_w1': nrm(ks[24], (N_MOE, N_EXPERTS, D, D_EXPERT), D ** -0.5),
        'moe_w3': nrm(ks[25], (N_MOE, N_EXPERTS, D, D_EXPERT), D ** -0.5),
        'moe_w2': nrm(ks[26], (N_MOE, N_EXPERTS, D_EXPERT, D), D_EXPERT ** -0.5),
    }


def reference(x, c, ctx, c_ctx, w_mod, b_mod, g_mix, g_ffn, g_final, w_in, w_out, conv_w, conv_b,
              rg_wa, rg_ba, rg_wx, rg_bx, rg_lam, ret_decay, ffn_w1, ffn_w3, ffn_w2,
              moe_router, moe_router_b, moe_w1, moe_w3, moe_w2):
    f32 = jnp.float32
    bsz, n_lat, _ = x.shape
    rows = n_lat // GRID_W
    rope = grid_rope(rows)
    sc_lat = jax.nn.silu(c)
    sc_ctx = jax.nn.silu(c_ctx)
    ffn_args = (ffn_w1, ffn_w3, ffn_w2, moe_router, moe_router_b, moe_w1, moe_w3, moe_w2)
    for l in range(DEPTH):
        last = l == DEPTH - 1
        mod_lat = jnp.split((sc_lat @ w_mod[l] + b_mod[l])[:, None, :], 6, axis=-1)
        mod_ctx = jnp.split((sc_ctx @ w_mod[l] + b_mod[l])[None, None, :], 6, axis=-1)
        mix_p = (conv_w[l], conv_b[l], rg_wa[l], rg_ba[l], rg_wx[l], rg_bx[l], rg_lam[l], ret_decay[l])
        zero_states = (jnp.zeros((bsz, RG_W), f32), jnp.zeros((bsz, RG_W), f32),
                       jnp.zeros((bsz, RET_HEADS, RET_HEAD_DIM, RET_HEAD_DIM), f32),
                       jnp.zeros((bsz, RET_HEADS, RET_HEAD_DIM, RET_HEAD_DIM), f32))
        pc = modulate(rms_norm(ctx, g_mix[l]), mod_ctx[0], mod_ctx[1]) @ w_in[l]
        y_ctx, ctx_states = token_mixer(pc, None, zero_states, *mix_p)
        px = modulate(rms_norm(x, g_mix[l]), mod_lat[0], mod_lat[1]) @ w_in[l]
        y_lat, _ = token_mixer(px, rope, ctx_states, *mix_p)
        x = x + mod_lat[2] * (y_lat.astype(x.dtype) @ w_out[l])
        hx = modulate(rms_norm(x, g_ffn[l]), mod_lat[3], mod_lat[4])
        x = x + mod_lat[5] * channel_mixer(l, hx, *ffn_args)
        if not last:
            ctx = ctx + mod_ctx[2] * (y_ctx.astype(ctx.dtype) @ w_out[l])
            hc = modulate(rms_norm(ctx, g_ffn[l]), mod_ctx[3], mod_ctx[4])
            ctx = ctx + mod_ctx[5] * channel_mixer(l, hc, *ffn_args)
    return rms_norm(x, g_final)
```

```cpp
#include <hip/hip_runtime.h>
#include <cstdio>
#include <cstdint>
#include <cstring>

#ifndef MK_ONE_LAUNCH
#define MK_ONE_LAUNCH 1
#endif

#define GAS __attribute__((address_space(1)))
#define LAS __attribute__((address_space(3)))
typedef unsigned short bf16_t;
typedef short bf16x8 __attribute__((ext_vector_type(8)));
typedef float f32x4 __attribute__((ext_vector_type(4)));
typedef float f32x2 __attribute__((ext_vector_type(2)));
typedef unsigned u32x4 __attribute__((ext_vector_type(4)));
typedef unsigned u32x2 __attribute__((ext_vector_type(2)));
typedef LAS unsigned char* ldsp_t;

constexpr int D = 1024, NB = 8, SEQ = 4096, NLAT = NB * SEQ, CTXL = 256, NCTX = NB * CTXL, MROWS = NLAT + NCTX;
constexpr int INW = 3072, NH = 4, HD = 128, CHK = 128;
constexpr int DFF = 2816, NE = 8, DEXP = 3584;
constexpr int SPB = 34;
constexpr int NITEM = NB * SPB;
constexpr float EPS = 1e-6f;
constexpr int NWAVES = 8, NTHREADS = 512;

constexpr size_t MiB = 1u << 20;
constexpr size_t WS_CTL = 0, CTL_ZERO_BYTES = 64 * 1024;
constexpr size_t WS_MODLAT = 1 * MiB;
constexpr size_t WS_MODCTX = 1 * MiB + 2 * 8 * 6144 * 4;
constexpr size_t WS_ROPE = 2 * MiB;
constexpr size_t WS_RGW = 4 * MiB;
constexpr size_t WS_TOT = 5 * MiB;
constexpr size_t WS_CARRY = 8 * MiB;
constexpr size_t WS_MOE = 10 * MiB;
constexpr size_t MOE_CNT = WS_MOE, MOE_META = WS_MOE + 16384, MOE_TOKE = WS_MOE + 65536, MOE_TOKW = WS_MOE + 262144,
                 MOE_PTOK = WS_MOE + 524288, MOE_PW = WS_MOE + 1048576;
constexpr size_t WS_CTXX = 12 * MiB;
constexpr size_t WS_WIN = 20 * MiB;
constexpr size_t WS_WOUT = 32 * MiB;
constexpr size_t WS_WUP = 36 * MiB;
constexpr size_t WS_WDN = 47 * MiB;
constexpr size_t WS_HX = 54 * MiB;
constexpr size_t WS_PA = 122 * MiB;
constexpr size_t WS_KV = 360 * MiB;
constexpr size_t WS_Y = 496 * MiB;
constexpr size_t WS_MOEUP = 360 * MiB;
constexpr size_t WS_MOEDN = 472 * MiB;
constexpr size_t WS_SLABA = WS_KV;
constexpr size_t WS_SLABM = 528 * MiB;
constexpr int MAXSLAB_A = 256, MAXSLAB_M = 216;
constexpr size_t WS_END = 582 * MiB;
static_assert(WS_MOEDN + (size_t)NE * D * DEXP * 2 <= WS_END, "ws map");
static_assert(WS_PA + (size_t)MROWS * DEXP * 2 <= WS_KV, "ws map");

constexpr int LDS_SCRATCH = 147456;
constexpr int LDS_MISC = LDS_SCRATCH;
constexpr int LDS_DEC = LDS_MISC + 256;
constexpr int LDS_BYTES = LDS_SCRATCH + 8192;

__device__ __forceinline__ float bf2f(unsigned v) { return __uint_as_float(v << 16); }
typedef __bf16 bf16x2_t __attribute__((ext_vector_type(2)));
__device__ __forceinline__ unsigned pk2(float lo, float hi) { const f32x2 v = {lo, hi}; return __builtin_bit_cast(unsigned, __builtin_convertvector(v, bf16x2_t)); }
__device__ __forceinline__ unsigned f2bf(float f) { return pk2(f, f) & 0xffffu; }
template <int M> __device__ __forceinline__ float swz_xor(float v) { return __int_as_float(__builtin_amdgcn_ds_swizzle(__float_as_int(v), (M << 10) | 0x1f)); }
__device__ __forceinline__ float wave_sum(float v) {
    v += swz_xor<1>(v); v += swz_xor<2>(v); v += swz_xor<4>(v); v += swz_xor<8>(v); v += swz_xor<16>(v);
    const auto r = __builtin_amdgcn_permlane32_swap(__float_as_uint(v), __float_as_uint(v), false, false);
    return __uint_as_float(r[0]) + __uint_as_float(r[1]);
}
__device__ __forceinline__ float lane_bcast(float v, int src_lane) { return __int_as_float(__builtin_amdgcn_ds_bpermute(src_lane << 2, __float_as_int(v))); }
__device__ __forceinline__ float sigmoidf_(float x) { return __builtin_amdgcn_rcpf(1.0f + __expf(-x)); }
__device__ __forceinline__ float siluf_(float x) { return x * __builtin_amdgcn_rcpf(1.0f + __expf(-x)); }
__device__ __forceinline__ float gelu_tanh(float x) { const float z = 0.7978845608028654f * (x + 0.044715f * x * x * x); return x * (1.0f - __builtin_amdgcn_rcpf(1.0f + __expf(2.0f * z))); }
#define LDS_WAIT() asm volatile("s_waitcnt lgkmcnt(0)" ::: "memory")
#define WG_BAR_LDS() do { asm volatile("s_waitcnt lgkmcnt(0)" ::: "memory"); __builtin_amdgcn_s_barrier(); asm volatile("" ::: "memory"); } while (0)
__device__ __forceinline__ f32x4 zero4() { float z; asm volatile("v_mov_b32 %0, 0" : "=v"(z)); return (f32x4){z, z, z, z}; }

template <typename T> __device__ __forceinline__ T ldg(const void* base, unsigned off) { return *(const GAS T*)((const GAS char*)base + off); }
template <typename T> __device__ __forceinline__ void stg(void* base, unsigned off, T v) { *(GAS T*)((GAS char*)base + off) = v; }
#define XB_TMO      128
#define XB_XCNT(j)  (256  + 64 * (j))
#define XB_XSUB(j)  (1280 + 64 * (j))
#define XB_XGEN(j)  (2304 + 64 * (j))
#define XB_TOP      3328
#define XB_TOPGEN   3392
#define XCD_BAR_WORDS 3456
#define XB_SPIN_CAP (1u << 18)
__device__ __forceinline__ unsigned xb_ld(unsigned* p)              { return __hip_atomic_load(p, __ATOMIC_RELAXED, __HIP_MEMORY_SCOPE_AGENT); }
__device__ __forceinline__ unsigned xb_add(unsigned* p, unsigned v) { return __hip_atomic_fetch_add(p, v, __ATOMIC_RELAXED, __HIP_MEMORY_SCOPE_AGENT); }
__device__ __forceinline__ unsigned xb_xcc_id() { return (unsigned)__builtin_amdgcn_s_getreg((3 << 11) | 20) & 0xFu; }
#define XB_SPIN(cond, bar) do { unsigned _sp = 0; while (cond) { __builtin_amdgcn_s_sleep(1); \
    if ((++_sp & 255u) == 0u) { if (xb_ld(&(bar)[XB_TMO])) break; if (_sp > XB_SPIN_CAP) { atomicAdd(&(bar)[XB_TMO], 1u); break; } } } } while (0)
struct XcdBarrier { unsigned* bar; unsigned x; volatile LAS unsigned* st; };
__device__ __forceinline__ XcdBarrier xcd_barrier_post(unsigned* bar, volatile LAS unsigned* st) {
    XcdBarrier b; b.bar = bar; b.x = xb_xcc_id(); b.st = st;
    if (threadIdx.x == 0) (void)xb_add(&bar[XB_XCNT(b.x)], 1u);
    return b;
}
__device__ __forceinline__ void xcd_barrier_complete(unsigned* bar, unsigned x, unsigned& nloc, unsigned& nx) {
    const unsigned G = gridDim.x * gridDim.y * gridDim.z;
    unsigned sum, cnt, mine, sp = 0u;
    for (;;) {
        sum = 0u; cnt = 0u; mine = 0u;
#pragma unroll
        for (unsigned j = 0; j < 16; ++j) { const unsigned c = xb_ld(&bar[XB_XCNT(j)]); sum += c; cnt += (c > 0u) ? 1u : 0u; mine = (j == x) ? c : mine; }
        if (sum == G) break;
        __builtin_amdgcn_s_sleep(1);
        if ((++sp & 255u) == 0u) { if (xb_ld(&bar[XB_TMO])) break; if (sp > XB_SPIN_CAP) { atomicAdd(&bar[XB_TMO], 1u); break; } }
    }
    nloc = mine > 0u ? mine : 1u; nx = cnt > 0u ? cnt : 1u;
}
__device__ __forceinline__ void xcd_barrier(const XcdBarrier& b) {
    asm volatile("s_waitcnt vmcnt(0)" ::: "memory");
    __syncthreads();
    if (threadIdx.x == 0) {
        unsigned* bar = b.bar;
        __builtin_amdgcn_s_waitcnt(0);
        unsigned nloc = b.st[0], nx = b.st[1];
        if (nloc == 0u) { xcd_barrier_complete(bar, b.x, nloc, nx); b.st[0] = nloc; b.st[1] = nx; }
        const unsigned old = xb_add(&bar[XB_XSUB(b.x)], 1u);
        const unsigned gen = old / nloc;
        if (old + 1u == (gen + 1u) * nloc) {
            __builtin_amdgcn_fence(__ATOMIC_RELEASE, "agent");
            asm volatile("s_waitcnt vmcnt(0)" ::: "memory");
            const unsigned og = xb_add(&bar[XB_TOP], 1u);
            const unsigned tg = og / nx;
            if (og + 1u == (tg + 1u) * nx) xb_add(&bar[XB_TOPGEN], 1u);
            else XB_SPIN(xb_ld(&bar[XB_TOPGEN]) == tg, bar);
            __builtin_amdgcn_fence(__ATOMIC_ACQUIRE, "agent");
            xb_add(&bar[XB_XGEN(b.x)], 1u);
            asm volatile("s_waitcnt vmcnt(0)" ::: "memory");
        } else {
            XB_SPIN(xb_ld(&bar[XB_XGEN(b.x)]) == gen, bar);
            __builtin_amdgcn_fence(__ATOMIC_ACQUIRE, "agent");
            asm volatile("s_waitcnt vmcnt(0)" ::: "memory");
        }
    }
    __syncthreads();
}

namespace pg8 {
constexpr int BM = 256, BK = 64, HALF = 128, HTB = HALF * BK * 2, STAGE_BYTES = 8 * HTB, NXCD = 8, WGM = 8;
__host__ __device__ __forceinline__ int lds_byte(int r, int c) { const int st = (r >> 4) * 2 + (c >> 5), rr = r & 15, cc = c & 31, ob = rr * 64 + cc * 2; return st * 1024 + (ob ^ (((ob >> 9) & 1) << 5)); }
__host__ __device__ __forceinline__ void stage_rc(int b, int& R, int& C) { const int st = b / 1024, sb = b % 1024, swz = sb ^ (((sb >> 9) & 1) << 5); R = (st >> 1) * 16 + swz / 64; C = (st & 1) * 32 + (swz % 64) / 2; }
__host__ __device__ __forceinline__ int perm32(int rho) { const int n = rho >> 4, i = rho & 15; return 8 * (i >> 2) + 4 * n + (i & 3); }

struct Unit { int pm, pn, e, kt0, nt, slab; };
struct Gemm { const bf16_t* A; const bf16_t* Bt; int N, K; size_t estride; float* slabs; };

__device__ __forceinline__ int split_factor(int U, int G, int ntiles, int maxslabs) {
    const int R = U % G; if (R == 0) return 1;
    int S = G / R; if (S > 8) S = 8; if (S > ntiles / 2) S = ntiles / 2; if (R * S > maxslabs) S = maxslabs / R;
    return S < 2 ? 1 : S;
}
struct Order {
    int nM, nN, G, c, ntiles, mainu, S, total; const int* segs; const int* rowmap;
    __device__ __forceinline__ void init(int nM_, int nN_, int G_, int c_, const int* segs_, const int* rowmap_, int ntiles_, bool split, int maxslabs) {
        nM = nM_; nN = nN_; G = G_; c = c_; segs = segs_; rowmap = rowmap_; ntiles = ntiles_;
        const int U = nM * nN; S = split ? split_factor(U, G, ntiles, maxslabs) : 1; const int R = (S > 1) ? U % G : 0; mainu = U - R; total = mainu + R * S; }
    __device__ __forceinline__ bool next(int i, Unit& u) const {
        const long L = (long)i * G + c; if (L >= total) return false;
        int wgid; u.kt0 = 0; u.nt = ntiles; u.slab = -1;
        if (L < mainu) { wgid = (int)L; const int q = mainu / NXCD, r = mainu % NXCD, xcd = wgid % NXCD, off = wgid / NXCD; wgid = (xcd < r ? xcd * (q + 1) : r * (q + 1) + (xcd - r) * q) + off; }
        else { const int sub = (int)L - mainu, lu = sub / S, sl = sub - lu * S, pairs = ntiles / 2, p0 = (sl * pairs) / S, p1 = ((sl + 1) * pairs) / S;
            wgid = mainu + lu; u.kt0 = 2 * p0; u.nt = 2 * (p1 - p0); u.slab = sub; }
        const int nig = WGM * nN, gid = wgid / nig, fm = gid * WGM, gsz = (nM - fm) < WGM ? (nM - fm) : WGM;
        u.pm = fm + ((wgid % nig) % gsz); u.pn = (wgid % nig) / gsz; u.e = 0;
        if (segs) { int e = 0;
#pragma unroll
            for (int j = 1; j < 8; ++j) e += (u.pm >= segs[j]) ? 1 : 0;
            u.e = e; }
        return true;
    }
    __device__ __forceinline__ int arow(const Unit& u, int r) const {
        if (rowmap) { const int t = rowmap[u.pm * BM + r]; return t < 0 ? 0 : t; }
        return u.pm * BM + r;
    }
};

__device__ __forceinline__ unsigned cvt_pk_bf16(float lo, float hi) { return pk2(lo, hi); }

struct EpiBf16 {
    static constexpr bool PERM = true, SPLIT = false;
    bf16_t* O; int ldc;
    __device__ __forceinline__ void operator()(const f32x4 (&acc)[2][2][4][2], const Unit& u, int wr, int wc, int fr, int fq) const {
        asm volatile("" : "+v"(fr), "+v"(fq));
        const int row0 = u.pm * BM + wr * 64 + fr, col0 = u.pn * BM + wc * 32 + 8 * fq;
#pragma unroll
        for (int ai = 0; ai < 2; ++ai)
#pragma unroll
            for (int m = 0; m < 4; ++m) { bf16_t* rowp = O + (size_t)(row0 + ai * HALF + m * 16) * ldc + col0;
#pragma unroll
                for (int bj = 0; bj < 2; ++bj) { const f32x4 v0 = acc[ai][bj][m][0], v1 = acc[ai][bj][m][1];
                    u32x4 w; w.x = cvt_pk_bf16(v0[0], v0[1]); w.y = cvt_pk_bf16(v0[2], v0[3]); w.z = cvt_pk_bf16(v1[0], v1[1]); w.w = cvt_pk_bf16(v1[2], v1[3]);
                    *(u32x4*)(rowp + bj * HALF) = w; } }
    }
};
struct EpiSwiGLU {
    static constexpr bool PERM = true, SPLIT = false;
    bf16_t* O; int ldc;
    __device__ __forceinline__ void operator()(const f32x4 (&acc)[2][2][4][2], const Unit& u, int wr, int wc, int fr, int fq) const {
        asm volatile("" : "+v"(fr), "+v"(fq));
        const int row0 = u.pm * BM + wr * 64 + fr, col0 = u.pn * HALF + wc * 32 + 8 * fq;
#pragma unroll
        for (int ai = 0; ai < 2; ++ai)
#pragma unroll
            for (int m = 0; m < 4; ++m) { bf16_t* rowp = O + (size_t)(row0 + ai * HALF + m * 16) * ldc + col0;
                float o[8];
#pragma unroll
                for (int n = 0; n < 2; ++n)
#pragma unroll
                    for (int j = 0; j < 4; ++j) { const float a = acc[ai][0][m][n][j], b = acc[ai][1][m][n][j]; o[n * 4 + j] = (a * __builtin_amdgcn_rcpf(1.0f + __expf(-a))) * b; }
                u32x4 w; w.x = cvt_pk_bf16(o[0], o[1]); w.y = cvt_pk_bf16(o[2], o[3]); w.z = cvt_pk_bf16(o[4], o[5]); w.w = cvt_pk_bf16(o[6], o[7]);
                *(u32x4*)rowp = w; }
    }
};
struct EpiResid {
    static constexpr bool PERM = false, SPLIT = true;
    const float* src_lat; float* dst_lat; const float* src_ctx; float* dst_ctx; const float* gate_lat; const float* gate_ctx;
    __device__ __forceinline__ void operator()(const f32x4 (&acc)[2][2][4][2], const Unit& u, int wr, int wc, int fr, int fq) const {
        asm volatile("" : "+v"(fr), "+v"(fq));
        const int prow = u.pm * BM; const bool lat = prow < NLAT;
        const float* src = lat ? src_lat + (size_t)prow * D : src_ctx + (size_t)(prow - NLAT) * D;
        float* dst = lat ? dst_lat + (size_t)prow * D : dst_ctx + (size_t)(prow - NLAT) * D;
        const float* gate = lat ? gate_lat + (size_t)(prow / SEQ) * 6144 : gate_ctx;
        const int r0 = wr * 64 + fr, col0 = u.pn * BM + wc * 32 + 4 * fq;
        f32x4 gv[2][2];
#pragma unroll
        for (int bj = 0; bj < 2; ++bj)
#pragma unroll
            for (int n = 0; n < 2; ++n) gv[bj][n] = *(const f32x4*)(gate + col0 + bj * HALF + n * 16);
#pragma unroll
        for (int ai = 0; ai < 2; ++ai)
#pragma unroll
            for (int m = 0; m < 4; ++m) { const size_t off = (size_t)(r0 + ai * HALF + m * 16) * D + col0;
#pragma unroll
                for (int bj = 0; bj < 2; ++bj)
#pragma unroll
                    for (int n = 0; n < 2; ++n) { const f32x4 s = *(const f32x4*)(src + off + bj * HALF + n * 16); *(f32x4*)(dst + off + bj * HALF + n * 16) = s + gv[bj][n] * acc[ai][bj][m][n]; }
                asm volatile("" ::: "memory"); }
    }
};
struct EpiMoeDown {
    static constexpr bool PERM = false, SPLIT = true;
    float* x; const int* ptok; const float* pw; const float* gate_lat;
    __device__ __forceinline__ void operator()(const f32x4 (&acc)[2][2][4][2], const Unit& u, int wr, int wc, int fr, int fq) const {
        asm volatile("" : "+v"(fr), "+v"(fq));
        const int r0 = u.pm * BM + wr * 64 + fr, col0 = u.pn * BM + wc * 32 + 4 * fq;
#pragma unroll
        for (int ai = 0; ai < 2; ++ai)
#pragma unroll
            for (int m = 0; m < 4; ++m) { const int r = r0 + ai * HALF + m * 16; const int tok = ptok[r]; const float w = pw[r];
                if (tok >= 0) { float* xr = x + (size_t)tok * D + col0; const float* gate = gate_lat + (size_t)(tok / SEQ) * 6144 + col0;
#pragma unroll
                    for (int bj = 0; bj < 2; ++bj)
#pragma unroll
                        for (int n = 0; n < 2; ++n) { const f32x4 g = *(const f32x4*)(gate + bj * HALF + n * 16); const f32x4 s = *(const f32x4*)(xr + bj * HALF + n * 16);
                            *(f32x4*)(xr + bj * HALF + n * 16) = s + (g * w) * acc[ai][bj][m][n]; } }
                asm volatile("" ::: "memory"); }
    }
};

template <class Epi>
__device__ __forceinline__ void gemm_phase(ldsp_t lds, const Gemm g, const Order& S, const Epi& E, const int tid) {
    const int wid = __builtin_amdgcn_readfirstlane(tid >> 6), lane = tid & 63, wr = wid >> 2, wc = wid & 3, fr = lane & 15, fq = lane >> 4;
    const int K = g.K;
    unsigned voffB[2];
#pragma unroll
    for (int i = 0; i < 2; ++i) { int R, C; stage_rc(tid * 16 + i * 8192, R, C); const int Rb = Epi::PERM ? ((R & ~31) + perm32(R & 31)) : R;
        voffB[i] = (unsigned)(Rb * K + C) * 2u; }
    const size_t kstep = (size_t)(BK * 2);
    const size_t hstep = (size_t)HALF * K * 2;
    const size_t tstep = 2 * hstep;
    const unsigned ldsw = (unsigned)wid * 1024u;
    const int aoff = lds_byte(wr * 64 + fr, fq * 8), boff = lds_byte(wc * 32 + fr, fq * 8);
#define PG8_SA(b, h) (((b) * 2 + (h)) * HTB)
#define PG8_SB(b, h) ((4 + (b) * 2 + (h)) * HTB)
#define PG8_STAGE_B(bufoff, gbase) do { _Pragma("unroll") for (int _i = 0; _i < 2; ++_i) \
        __builtin_amdgcn_global_load_lds((const unsigned*)((const char*)(gbase) + voffB[_i]), (LAS unsigned*)(lds + (bufoff) + ldsw + _i * 8192), 16, 0, 0); } while (0)
#define PG8_STAGE_A(bufoff, gbase, o0, o1) do { \
        __builtin_amdgcn_global_load_lds((const unsigned*)((const char*)(gbase) + (o0)), (LAS unsigned*)(lds + (bufoff) + ldsw), 16, 0, 0); \
        __builtin_amdgcn_global_load_lds((const unsigned*)((const char*)(gbase) + (o1)), (LAS unsigned*)(lds + (bufoff) + ldsw + 8192), 16, 0, 0); } while (0)
#define PG8_LDA(dst, b, h) do { _Pragma("unroll") for (int m = 0; m < 4; ++m) _Pragma("unroll") for (int k = 0; k < 2; ++k) dst[m][k] = *(const LAS bf16x8*)(lds + PG8_SA(b, h) + aoff + m * 2048 + k * 1024); } while (0)
#define PG8_LDB(dst, b, h) do { _Pragma("unroll") for (int n = 0; n < 2; ++n) _Pragma("unroll") for (int k = 0; k < 2; ++k) dst[n][k] = *(const LAS bf16x8*)(lds + PG8_SB(b, h) + boff + n * 2048 + k * 1024); } while (0)
#define PG8_MMA(ai, bj, At, Bt) do { __builtin_amdgcn_s_setprio(1); _Pragma("unroll") for (int m = 0; m < 4; ++m) _Pragma("unroll") for (int n = 0; n < 2; ++n) _Pragma("unroll") for (int k = 0; k < 2; ++k) \
        acc[ai][bj][m][n] = __builtin_amdgcn_mfma_f32_16x16x32_bf16(Bt[n][k], At[m][k], acc[ai][bj][m][n], 0, 0, 0); __builtin_amdgcn_s_setprio(0); } while (0)
#define PG8_WAIT_V(n) asm volatile("s_waitcnt vmcnt(" #n ")" ::: "memory")
#define PG8_WAIT_L(n) asm volatile("s_waitcnt lgkmcnt(" #n ")" ::: "memory")
#define PG8_BAR __builtin_amdgcn_s_barrier()
#define PG8_SCHED __builtin_amdgcn_sched_barrier(0)
#define PG8_AOFFS(u, o00, o01, o10, o11) do { int R0_, C0_, R1_, C1_; stage_rc(tid * 16, R0_, C0_); stage_rc(tid * 16 + 8192, R1_, C1_); \
        o00 = (unsigned)(S.arow(u, R0_) * K + C0_ + (u).kt0 * BK) * 2u; o01 = (unsigned)(S.arow(u, R1_) * K + C1_ + (u).kt0 * BK) * 2u; \
        o10 = (unsigned)(S.arow(u, HALF + R0_) * K + C0_ + (u).kt0 * BK) * 2u; o11 = (unsigned)(S.arow(u, HALF + R1_) * K + C1_ + (u).kt0 * BK) * 2u; } while (0)
    Unit cur, nxt; int ui = 0;
    if (!S.next(0, cur)) return;
    f32x4 acc[2][2][4][2];
    { float z_; asm volatile("v_mov_b32 %0, 0" : "=v"(z_));
#pragma unroll
    for (int a = 0; a < 2; ++a)
#pragma unroll
        for (int b = 0; b < 2; ++b)
#pragma unroll
            for (int m = 0; m < 4; ++m)
#pragma unroll
                for (int n = 0; n < 2; ++n) acc[a][b][m][n] = (f32x4){z_, z_, z_, z_}; }
    bf16x8 At[4][2], B0[2][2], B1[2][2];
    const char* const Abase = (const char*)g.A;
    const char* cB = (const char*)g.Bt + (size_t)cur.e * g.estride + (size_t)cur.pn * tstep + (size_t)cur.kt0 * kstep;
    unsigned c00, c01, c10, c11;
    PG8_AOFFS(cur, c00, c01, c10, c11);
    PG8_STAGE_B(PG8_SB(0, 0), cB); PG8_STAGE_B(PG8_SB(0, 1), cB + hstep); PG8_STAGE_A(PG8_SA(0, 0), Abase, c00, c01); PG8_STAGE_A(PG8_SA(0, 1), Abase, c10, c11);
    if (wr == 1) PG8_BAR;
    PG8_WAIT_V(2); PG8_BAR;
    PG8_STAGE_B(PG8_SB(1, 0), cB + kstep); PG8_STAGE_A(PG8_SA(1, 0), Abase + kstep, c00, c01); PG8_STAGE_B(PG8_SB(1, 1), cB + hstep + kstep);
    PG8_WAIT_V(6); PG8_BAR;
    for (;;) {
        const bool has_next = S.next(ui + 1, nxt);
        const char* nB = has_next ? (const char*)g.Bt + (size_t)nxt.e * g.estride + (size_t)nxt.pn * tstep + (size_t)nxt.kt0 * kstep : cB;
        const int nt = cur.nt;
        for (int t = 0; t < nt; t += 2) {
            const bool last = (t == nt - 2);
            const char* a1 = Abase + (size_t)(t + 1) * kstep;
            const char* a2 = last ? Abase : Abase + (size_t)(t + 2) * kstep; const char* b2 = last ? nB : cB + (size_t)(t + 2) * kstep;
            const char* a3 = a2 + kstep; const char* b3 = b2 + kstep;
            PG8_LDB(B0, 0, 0); PG8_LDB(B1, 0, 1); PG8_SCHED; PG8_LDA(At, 0, 0); PG8_STAGE_A(PG8_SA(1, 1), a1, c10, c11);
            PG8_WAIT_V(8); PG8_WAIT_L(0); PG8_BAR; PG8_MMA(0, 0, At, B0); PG8_MMA(0, 1, At, B1); PG8_BAR; PG8_SCHED;
            if (last && has_next) { PG8_AOFFS(nxt, c00, c01, c10, c11); }
            PG8_LDA(At, 0, 1); PG8_STAGE_B(PG8_SB(0, 0), b2); PG8_STAGE_B(PG8_SB(0, 1), b2 + hstep); PG8_STAGE_A(PG8_SA(0, 0), a2, c00, c01);
            PG8_WAIT_V(8); PG8_WAIT_L(0); PG8_BAR; PG8_MMA(1, 0, At, B0); PG8_MMA(1, 1, At, B1); PG8_BAR; PG8_SCHED;
            PG8_LDB(B0, 1, 0); PG8_LDB(B1, 1, 1); PG8_SCHED; PG8_LDA(At, 1, 0); PG8_STAGE_A(PG8_SA(0, 1), a2, c10, c11);
            PG8_WAIT_V(8); PG8_WAIT_L(0); PG8_BAR; PG8_MMA(0, 0, At, B0); PG8_MMA(0, 1, At, B1); PG8_BAR; PG8_SCHED;
            PG8_LDA(At, 1, 1); PG8_STAGE_B(PG8_SB(1, 0), b3); PG8_STAGE_B(PG8_SB(1, 1), b3 + hstep); PG8_STAGE_A(PG8_SA(1, 0), a3, c00, c01);
            PG8_WAIT_V(8); PG8_WAIT_L(0); PG8_BAR; PG8_MMA(1, 0, At, B0); PG8_MMA(1, 1, At, B1); PG8_BAR; PG8_SCHED;
        }
        if (wr == 0) PG8_BAR;
        if (Epi::SPLIT && cur.slab >= 0) {
            int fr_ = fr, fq_ = fq; asm volatile("" : "+v"(fr_), "+v"(fq_));
            float* sp = g.slabs + (size_t)cur.slab * 65536 + (size_t)(wr * 64 + fr_) * 256 + wc * 32 + 4 * fq_;
#pragma unroll
            for (int ai = 0; ai < 2; ++ai)
#pragma unroll
                for (int m = 0; m < 4; ++m)
#pragma unroll
                    for (int bj = 0; bj < 2; ++bj)
#pragma unroll
                        for (int n = 0; n < 2; ++n) *(f32x4*)(sp + (ai * HALF + m * 16) * 256 + bj * HALF + n * 16) = acc[ai][bj][m][n];
        } else E(acc, cur, wr, wc, fr, fq);
        if (!has_next) break;
        { float z_; asm volatile("v_mov_b32 %0, 0" : "=v"(z_));
#pragma unroll
        for (int a = 0; a < 2; ++a)
#pragma unroll
            for (int b = 0; b < 2; ++b)
#pragma unroll
                for (int m = 0; m < 4; ++m)
#pragma unroll
                    for (int n = 0; n < 2; ++n) acc[a][b][m][n] = (f32x4){z_, z_, z_, z_}; }
        cur = nxt; cB = nB; ++ui;
        if (wr == 1) PG8_BAR;
    }
    PG8_WAIT_V(0);
    PG8_BAR;
#undef PG8_SA
#undef PG8_SB
#undef PG8_STAGE_A
#undef PG8_STAGE_B
#undef PG8_LDA
#undef PG8_LDB
#undef PG8_MMA
#undef PG8_WAIT_V
#undef PG8_WAIT_L
#undef PG8_BAR
#undef PG8_SCHED
#undef PG8_AOFFS
}
}

struct Args { const float* in[27]; float* out; unsigned char* ws; int ph_lo, ph_hi; };
struct Frame {
    ldsp_t lds; int tid, lane, wave, wave0, G, bid;
    const Args* pa; float* out; unsigned char* ws;
    const Args* pa0; float* out0; unsigned char* ws0;
};
enum { I_X = 0, I_C, I_CTX, I_CCTX, I_WMOD, I_BMOD, I_GMIX, I_GFFN, I_GFINAL, I_WIN, I_WOUT, I_CONVW, I_CONVB, I_RGWA, I_RGBA, I_RGWX, I_RGBX, I_RGLAM, I_RETDEC,
       I_FW1, I_FW3, I_FW2, I_MROUTER, I_MROUTERB, I_MW1, I_MW3, I_MW2 };

constexpr int TRS = 64 * 65 * 4;
__device__ __forceinline__ void transpose_item(const float* W, int ldw, int k0, int n0, bf16_t* WT, int ldt, int drow0, float scale, LAS float* scr, int lane) {
    float v[16];
#pragma unroll 4
    for (int i0 = 0; i0 < 64; i0 += 16) {
#pragma unroll
        for (int i = 0; i < 16; ++i) v[i] = W[(size_t)(k0 + i0 + i) * ldw + n0 + lane];
#pragma unroll
        for (int i = 0; i < 16; ++i) scr[(i0 + i) * 65 + lane] = v[i]; }
    LDS_WAIT(); asm volatile("" ::: "memory");
    const int c = lane & 7;
#pragma unroll
    for (int j = 0; j < 8; ++j) { const int n = (lane >> 3) + 8 * j; const LAS float* s = scr + (8 * c) * 65 + n;
        u32x4 o; o.x = pk2(s[0 * 65] * scale, s[1 * 65] * scale); o.y = pk2(s[2 * 65] * scale, s[3 * 65] * scale); o.z = pk2(s[4 * 65] * scale, s[5 * 65] * scale); o.w = pk2(s[6 * 65] * scale, s[7 * 65] * scale);
        *(u32x4*)(WT + (size_t)(drow0 + n) * ldt + k0 + 8 * c) = o; }
    LDS_WAIT(); asm volatile("" ::: "memory");
}
__device__ __forceinline__ void conv_up_item(const float* w1, const float* w3, int F, bf16_t* WT, int r, LAS float* scr, int lane) {
    const int per = 16 * (F / 64); const int which = r / per; r -= which * per;
    const int nblk = F / 64, kb = r / nblk, nb = r % nblk, n0 = nb * 64;
    transpose_item(which ? w3 : w1, F, kb * 64, n0, WT, D, (n0 / 128) * 256 + (n0 % 128) + which * 128, 1.0f, scr, lane);
}
__device__ __forceinline__ void phase_convert_small(Frame& F) {
    LAS float* scr = (LAS float*)(F.lds + F.wave * TRS);
    const int gw = F.bid * NWAVES + F.wave, NGW = F.G * NWAVES;
    constexpr int I_IN = 16 * (INW / 64), I_OUT = 16 * (D / 64), I_UP = 2 * 16 * (DFF / 64), I_DN = (DFF / 64) * (D / 64);
    constexpr int NITEMS = 2 * I_IN + 2 * I_OUT + I_UP + I_DN;
    for (int it = gw; it < NITEMS; it += NGW) {
        int r = it;
        if (r < 2 * I_IN) { const int l = r / I_IN; r -= l * I_IN; const int nblk = INW / 64, kb = r / nblk, nb = r % nblk, n0 = nb * 64;
            const float sc = (n0 >= 1536 && n0 < 2048) ? 0.08838834764831845f : 1.0f;
            transpose_item(F.pa->in[I_WIN] + (size_t)l * D * INW, INW, kb * 64, n0, (bf16_t*)(F.ws + WS_WIN) + (size_t)l * INW * D, D, n0, sc, scr, F.lane); continue; }
        r -= 2 * I_IN;
        if (r < 2 * I_OUT) { const int l = r / I_OUT; r -= l * I_OUT; const int nblk = D / 64, kb = r / nblk, nb = r % nblk;
            transpose_item(F.pa->in[I_WOUT] + (size_t)l * D * D, D, kb * 64, nb * 64, (bf16_t*)(F.ws + WS_WOUT) + (size_t)l * D * D, D, nb * 64, 1.0f, scr, F.lane); continue; }
        r -= 2 * I_OUT;
        if (r < I_UP) { conv_up_item(F.pa->in[I_FW1], F.pa->in[I_FW3], DFF, (bf16_t*)(F.ws + WS_WUP), r, scr, F.lane); continue; }
        r -= I_UP;
        { const int nblk = D / 64, kb = r / nblk, nb = r % nblk; transpose_item(F.pa->in[I_FW2], D, kb * 64, nb * 64, (bf16_t*)(F.ws + WS_WDN), DFF, nb * 64, 1.0f, scr, F.lane); }
    }
    { const int gt = F.bid * NTHREADS + F.tid, NGT = F.G * NTHREADS; bf16_t* o = (bf16_t*)(F.ws + WS_RGW);
      for (int i = gt; i < 2 * 2 * 2 * 8 * 64 * 64; i += NGT) { const int c = i & 63, dp = (i >> 6) & 63, blk = (i >> 12) & 7, gate = (i >> 15) & 1, dir = (i >> 16) & 1, l = i >> 17;
          const float* src = gate ? F.pa->in[I_RGWX] : F.pa->in[I_RGWA]; o[i] = (bf16_t)f2bf(src[((((size_t)l * 2 + dir) * 8 + blk) * 64 + c) * 64 + dp]); } }
    { const int gt = F.bid * NTHREADS + F.tid, NGT = F.G * NTHREADS; float* ct = (float*)(F.ws + WS_ROPE); float* st = ct + 4096 * 64;
      for (int i = gt; i < 4096 * 64; i += NGT) { const int pos = i >> 6, fi = i & 63; const float p = (float)((fi < 32) ? (pos >> 6) : (pos & 63));
          const float inv = powf(10000.0f, -(float)(fi & 31) / 32.0f); const float ang = p * inv;
          const double a = (double)ang; const double kq = __builtin_rint(a * 0.63661977236758134308); const double rr = a - kq * 1.57079632679489661923; const int q = ((int)kq) & 3;
          const double r2 = rr * rr;
          const double sn = rr * (1.0 + r2 * (-1.0 / 6 + r2 * (1.0 / 120 + r2 * (-1.0 / 5040 + r2 * (1.0 / 362880 + r2 * (-1.0 / 39916800))))));
          const double cs = 1.0 + r2 * (-0.5 + r2 * (1.0 / 24 + r2 * (-1.0 / 720 + r2 * (1.0 / 40320 + r2 * (-1.0 / 3628800 + r2 * (1.0 / 479001600))))));
          const double c_ = (q == 0) ? cs : (q == 1) ? -sn : (q == 2) ? -cs : sn; const double s_ = (q == 0) ? sn : (q == 1) ? cs : (q == 2) ? -sn : -cs;
          ct[i] = (float)c_; st[i] = (float)s_; } }
}
__device__ __forceinline__ void phase_convert_moe(Frame& F) {
    LAS float* scr = (LAS float*)(F.lds + F.wave * TRS);
    const int gw = F.bid * NWAVES + F.wave, NGW = F.G * NWAVES;
    constexpr int I_UP = 2 * 16 * (DEXP / 64), I_DN = (DEXP / 64) * (D / 64), PER_E = I_UP + I_DN;
    for (int it = gw; it < NE * PER_E; it += NGW) {
        const int e = it / PER_E; int r = it - e * PER_E;
        if (r < I_UP) { conv_up_item(F.pa->in[I_MW1] + (size_t)e * D * DEXP, F.pa->in[I_MW3] + (size_t)e * D * DEXP, DEXP, (bf16_t*)(F.ws + WS_MOEUP) + (size_t)e * 2 * DEXP * D, r, scr, F.lane); continue; }
        r -= I_UP;
        { const int nblk = D / 64, kb = r / nblk, nb = r % nblk; transpose_item(F.pa->in[I_MW2] + (size_t)e * DEXP * D, D, kb * 64, nb * 64, (bf16_t*)(F.ws + WS_MOEDN) + (size_t)e * D * DEXP, DEXP, nb * 64, 1.0f, scr, F.lane); }
    }
}
__device__ __forceinline__ void phase_mod(Frame& F) {
    LAS float* sc = (LAS float*)F.lds;
    LAS float* red = (LAS float*)(F.lds + 9 * 1024 * 4);
    for (int i = F.tid; i < 9 * 1024; i += NTHREADS) { const int r = i >> 10, k = i & 1023; const float v = (r < 8) ? F.pa->in[I_C][r * 1024 + k] : F.pa->in[I_CCTX][k]; sc[i] = v / (1.0f + __expf(-v)); }
    __syncthreads();
    for (int strip = F.bid; strip < 2 * 6144 / 64; strip += F.G) {
        const int l = strip / 96, j = (strip % 96) * 64 + F.lane;
        const float* w = F.pa->in[I_WMOD] + (size_t)l * 1024 * 6144 + j;
        float a[9];
#pragma unroll
        for (int r = 0; r < 9; ++r) a[r] = 0.f;
        const int k0 = F.wave * 128;
#pragma unroll 4
        for (int k = k0; k < k0 + 128; ++k) { const float wv = w[(size_t)k * 6144];
#pragma unroll
            for (int r = 0; r < 9; ++r) a[r] += sc[r * 1024 + k] * wv; }
#pragma unroll
        for (int r = 0; r < 9; ++r) red[(F.wave * 9 + r) * 64 + F.lane] = a[r];
        __syncthreads();
        for (int i = F.tid; i < 9 * 64; i += NTHREADS) { const int r = i >> 6, jj = i & 63; float s = 0.f;
#pragma unroll
            for (int w8 = 0; w8 < 8; ++w8) s += red[(w8 * 9 + r) * 64 + jj];
            const int col = (strip % 96) * 64 + jj; s += F.pa->in[I_BMOD][l * 6144 + col];
            if (r < 8) ((float*)(F.ws + WS_MODLAT))[((size_t)l * 8 + r) * 6144 + col] = s; else ((float*)(F.ws + WS_MODCTX))[(size_t)l * 6144 + col] = s; }
        __syncthreads();
    }
}

__device__ __forceinline__ void norm_row(const float* xrow, const float* g, const float* shift, const float* scale, bf16_t* orow, int lane, f32x4 (&y)[4]) {
    const f32x4* xr = (const f32x4*)xrow + lane; f32x4 v[4]; float ss = 0.f;
#pragma unroll
    for (int j = 0; j < 4; ++j) { v[j] = xr[64 * j]; ss += (v[j].x * v[j].x + v[j].y * v[j].y) + (v[j].z * v[j].z + v[j].w * v[j].w); }
    const float rstd = 1.0f / sqrtf(wave_sum(ss) * (1.0f / D) + EPS);
    u32x2* o8 = (u32x2*)orow + lane;
#pragma unroll
    for (int j = 0; j < 4; ++j) { const f32x4 gg = ((const f32x4*)g)[lane + 64 * j], sh = ((const f32x4*)shift)[lane + 64 * j], sl = ((const f32x4*)scale)[lane + 64 * j];
        y[j] = (v[j] * rstd) * gg * (sl + 1.0f) + sh;
        u32x2 w; w.x = pk2(y[j].x, y[j].y); w.y = pk2(y[j].z, y[j].w); o8[64 * j] = w; }
}
struct SlabRed { const float* slab; int S; const float* gate; const float* xold; float* xnew; };
__device__ __forceinline__ void norm_row_v(f32x4 (&v)[4], const float* g, const float* shift, const float* scale, bf16_t* orow, int lane) {
    float ss = 0.f;
#pragma unroll
    for (int j = 0; j < 4; ++j) ss += (v[j].x * v[j].x + v[j].y * v[j].y) + (v[j].z * v[j].z + v[j].w * v[j].w);
    const float rstd = 1.0f / sqrtf(wave_sum(ss) * (1.0f / D) + EPS);
    u32x2* o8 = (u32x2*)orow + lane;
#pragma unroll
    for (int j = 0; j < 4; ++j) { const f32x4 gg = ((const f32x4*)g)[lane + 64 * j], sh = ((const f32x4*)shift)[lane + 64 * j], sl = ((const f32x4*)scale)[lane + 64 * j];
        const f32x4 y = (v[j] * rstd) * gg * (sl + 1.0f) + sh;
        u32x2 w; w.x = pk2(y.x, y.y); w.y = pk2(y.z, y.w); o8[64 * j] = w; }
}
__device__ __forceinline__ void phase_norm(Frame& F, int l, int sel, const float* xlat, const float* xctx, int nrows, const SlabRed sr) {
    const int gw = F.bid * NWAVES + F.wave, NGW = F.G * NWAVES;
    const float* g = (sel ? F.pa->in[I_GFFN] : F.pa->in[I_GMIX]) + l * D; const int so = sel ? 3072 : 0;
    bf16_t* HX = (bf16_t*)(F.ws + WS_HX);
    for (int row = gw; row < nrows; row += NGW) {
        const bool lat = row < NLAT;
        const float* mod = lat ? (const float*)(F.ws + WS_MODLAT) + ((size_t)l * 8 + row / SEQ) * 6144 : (const float*)(F.ws + WS_MODCTX) + (size_t)l * 6144;
        f32x4 v[4];
        if (lat || sr.slab == nullptr) { const f32x4* xr = (const f32x4*)(lat ? xlat + (size_t)row * D : xctx + (size_t)(row - NLAT) * D) + F.lane;
#pragma unroll
            for (int j = 0; j < 4; ++j) v[j] = xr[64 * j]; }
        else { const int rc = row - NLAT, pmr = rc >> 8, r = rc & 255;
#pragma unroll
            for (int j = 0; j < 4; ++j) { f32x4 a = zero4(); const float* sp = sr.slab + (size_t)((pmr + 8 * j) * sr.S) * 65536 + (size_t)r * 256 + 4 * F.lane;
                for (int q = 0; q < sr.S; ++q) a += *(const f32x4*)(sp + (size_t)q * 65536);
                v[j] = ((const f32x4*)(sr.xold + (size_t)rc * D))[F.lane + 64 * j] + ((const f32x4*)sr.gate)[F.lane + 64 * j] * a;
                ((f32x4*)(sr.xnew + (size_t)rc * D))[F.lane + 64 * j] = v[j]; } }
        norm_row_v(v, g, mod + so, mod + so + 1024, HX + (size_t)row * D, F.lane);
    }
}
__device__ __forceinline__ void moe_reduce(Frame& F, int k) {
    const int* meta = (const int*)(F.ws + MOE_META) + 9 * k; const int npan = meta[8], gsz = npan - 128;
    if (gsz <= 0) return;
    const int S = pg8::split_factor(npan * 4, F.G, DEXP / 64, MAXSLAB_M); if (S < 2) return;
    const int gw = F.bid * NWAVES + F.wave, NGW = F.G * NWAVES;
    const int* ptok = (const int*)(F.ws + MOE_PTOK) + k * MROWS; const float* pw = (const float*)(F.ws + MOE_PW) + k * MROWS;
    const float* slab = (const float*)(F.ws + WS_SLABM); const float* gate_lat = (const float*)(F.ws + WS_MODLAT) + (size_t)8 * 6144 + 5120;
    for (int rr = NLAT + gw; rr < npan * 256; rr += NGW) { const int tok = ptok[rr]; if (tok < 0) continue; const float w = pw[rr];
        const int pmr = (rr - NLAT) >> 8, r = rr & 255; f32x4* xr = (f32x4*)(F.out + (size_t)tok * D); const f32x4* gt = (const f32x4*)(gate_lat + (size_t)(tok / SEQ) * 6144);
#pragma unroll
        for (int j = 0; j < 4; ++j) { f32x4 a = zero4(); const float* sp = slab + (size_t)((pmr + gsz * j) * S) * 65536 + (size_t)r * 256 + 4 * F.lane;
            for (int q = 0; q < S; ++q) a += *(const f32x4*)(sp + (size_t)q * 65536);
            xr[F.lane + 64 * j] = xr[F.lane + 64 * j] + (gt[F.lane + 64 * j] * w) * a; } }
}
__device__ __forceinline__ void phase_norm_router(Frame& F, const float* xlat) {
    constexpr int l = 1;
    LAS float* wr = (LAS float*)F.lds;
    LAS int* le = (LAS int*)(F.lds + 32768);
    for (int i = F.tid; i < 1024 * 8 / 4; i += NTHREADS) ((LAS f32x4*)wr)[i] = ((const f32x4*)F.pa->in[I_MROUTER])[i];
    __syncthreads();
    const float* g = F.pa->in[I_GFFN] + l * D; bf16_t* HX = (bf16_t*)(F.ws + WS_HX);
    int* toke = (int*)(F.ws + MOE_TOKE); float* tokw = (float*)(F.ws + MOE_TOKW);
    for (int wg = F.bid; wg < NLAT / 128; wg += F.G) {
        for (int i = 0; i < 16; ++i) { const int tl = F.wave * 16 + i, row = wg * 128 + tl;
            const float* mod = (const float*)(F.ws + WS_MODLAT) + ((size_t)l * 8 + row / SEQ) * 6144;
            f32x4 y[4]; norm_row(xlat + (size_t)row * D, g, mod + 3072, mod + 4096, HX + (size_t)row * D, F.lane, y);
            float lg[8];
#pragma unroll
            for (int e = 0; e < 8; ++e) lg[e] = 0.f;
#pragma unroll
            for (int j = 0; j < 4; ++j)
#pragma unroll
                for (int q = 0; q < 4; ++q) { const int k = 4 * F.lane + 256 * j + q; const f32x4 w0 = *(const LAS f32x4*)(wr + k * 8), w1 = *(const LAS f32x4*)(wr + k * 8 + 4); const float yv = y[j][q];
                    lg[0] += yv * w0.x; lg[1] += yv * w0.y; lg[2] += yv * w0.z; lg[3] += yv * w0.w; lg[4] += yv * w1.x; lg[5] += yv * w1.y; lg[6] += yv * w1.z; lg[7] += yv * w1.w; }
#pragma unroll
            for (int e = 0; e < 8; ++e) lg[e] = wave_sum(lg[e]) + F.pa->in[I_MROUTERB][e];
            int e0 = 0; float v0 = lg[0];
#pragma unroll
            for (int e = 1; e < 8; ++e) if (lg[e] > v0) { v0 = lg[e]; e0 = e; }
            int e1 = -1; float v1 = -3.0e38f;
#pragma unroll
            for (int e = 0; e < 8; ++e) if (e != e0 && lg[e] > v1) { v1 = lg[e]; e1 = e; }
            const float w0 = 1.0f / (1.0f + __expf(v1 - v0));
            if (F.lane == 0) { toke[row] = e0 | (e1 << 8); tokw[2 * row] = w0; tokw[2 * row + 1] = 1.0f - w0; le[tl] = e0 | (e1 << 8); }
        }
        __syncthreads();
        if (F.tid < 16) { const int k = F.tid >> 3, e = F.tid & 7; int c = 0; for (int t = 0; t < 128; ++t) c += (((le[t] >> (8 * k)) & 0xff) == e) ? 1 : 0; ((int*)(F.ws + MOE_CNT))[wg * 16 + F.tid] = c; }
        __syncthreads();
    }
}
__device__ __forceinline__ void phase_moe_sort(Frame& F) {
    LAS int* tot = (LAS int*)F.lds;
    LAS int* pre = tot + 16;
    LAS int* seg = tot + 32;
    LAS int* le = tot + 64;
    const int* cnt = (const int*)(F.ws + MOE_CNT); const int* toke = (const int*)(F.ws + MOE_TOKE); const float* tokw = (const float*)(F.ws + MOE_TOKW);
    int* ptok = (int*)(F.ws + MOE_PTOK); float* pw = (float*)(F.ws + MOE_PW); int* meta = (int*)(F.ws + MOE_META);
    for (int wg = F.bid; wg < NLAT / 128; wg += F.G) {
        if (F.tid < 16) { int t = 0, p = 0; for (int w = 0; w < 256; ++w) { const int c = cnt[w * 16 + F.tid]; t += c; p += (w < wg) ? c : 0; } tot[F.tid] = t; pre[F.tid] = p; }
        if (F.tid >= 64 && F.tid < 192) le[F.tid - 64] = toke[wg * 128 + F.tid - 64];
        __syncthreads();
        if (F.tid < 2) { int s = 0; for (int e = 0; e < 8; ++e) { seg[F.tid * 9 + e] = s; s += (tot[F.tid * 8 + e] + 255) & ~255; } seg[F.tid * 9 + 8] = s; }
        __syncthreads();
        if (F.tid < 256) { const int k = F.tid >> 7, t = F.tid & 127; const int e = (le[t] >> (8 * k)) & 0xff; int rank = 0; for (int u = 0; u < t; ++u) rank += (((le[u] >> (8 * k)) & 0xff) == e) ? 1 : 0;
            const int pos = seg[k * 9 + e] + pre[k * 8 + e] + rank; const int tok = wg * 128 + t; ptok[k * MROWS + pos] = tok; pw[k * MROWS + pos] = tokw[2 * tok + k]; }
        if (wg < 16) { const int k = wg >> 3, e = wg & 7; const int a = seg[k * 9 + e] + tot[k * 8 + e], b = seg[k * 9 + e + 1]; for (int p = a + F.tid; p < b; p += NTHREADS) { ptok[k * MROWS + p] = -1; pw[k * MROWS + p] = 0.f; } }
        if (wg == 0 && F.tid < 18) meta[F.tid] = seg[F.tid] >> 8;
        __syncthreads();
    }
}
__device__ __forceinline__ void phase_final(Frame& F) {
    const int gw = F.bid * NWAVES + F.wave, NGW = F.G * NWAVES; const float* g = F.pa->in[I_GFINAL];
    for (int row = gw; row < NLAT; row += NGW) {
        f32x4* xr = (f32x4*)(F.out + (size_t)row * D) + F.lane; f32x4 v[4]; float ss = 0.f;
#pragma unroll
        for (int j = 0; j < 4; ++j) { v[j] = xr[64 * j]; ss += (v[j].x * v[j].x + v[j].y * v[j].y) + (v[j].z * v[j].z + v[j].w * v[j].w); }
        const float rstd = 1.0f / sqrtf(wave_sum(ss) * (1.0f / D) + EPS);
#pragma unroll
        for (int j = 0; j < 4; ++j) xr[64 * j] = (v[j] * rstd) * ((const f32x4*)g)[F.lane + 64 * j];
    }
}

__device__ __forceinline__ bool fresh(Frame& F) {
    int l_ = (int)__builtin_amdgcn_mbcnt_hi(~0u, __builtin_amdgcn_mbcnt_lo(~0u, 0u)); asm volatile("" : "+v"(l_));
    int w_ = F.wave0; asm volatile("" : "+s"(w_));
    F.lane = l_; F.wave = w_; F.tid = w_ * 64 + l_;
    int b_ = blockIdx.x; asm volatile("" : "+s"(b_)); F.bid = b_;
    GAS unsigned char* w2_ = (GAS unsigned char*)F.ws0; asm volatile("" : "+s"(w2_)); F.ws = (unsigned char*)w2_;
    F.out = F.out0; F.pa = F.pa0;
    return true;
}
struct Item { int b, s, row0, seqbase, t0, seqlen; bool is_ctx; };
__device__ __forceinline__ Item item_info(int item) {
    Item it; it.b = item / SPB; it.s = item % SPB;
    if (it.s < 2) { it.is_ctx = true; it.seqbase = NLAT + it.b * CTXL; it.t0 = it.s * CHK; it.seqlen = CTXL; }
    else { it.is_ctx = false; it.seqbase = it.b * SEQ; it.t0 = (it.s - 2) * CHK; it.seqlen = SEQ; }
    it.row0 = it.seqbase + it.t0; return it;
}
constexpr int UCP = 144;
constexpr int TP = 272;
constexpr int TILEB = 128 * TP;
constexpr int VP = 288;
constexpr int TILEV = 128 * VP;

__device__ __forceinline__ unsigned tr_lane_addr(ldsp_t tile, int lane) { return (unsigned)(__SIZE_TYPE__)tile + (unsigned)((4 * (lane >> 4) + ((lane & 15) >> 2)) * VP + 8 * (lane & 3)); }
__device__ __forceinline__ bf16x8 mk_frag(u32x2 lo, u32x2 hi) { const u32x4 v = {lo.x, lo.y, hi.x, hi.y}; return __builtin_bit_cast(bf16x8, v); }
template <int OFF> __device__ __forceinline__ bf16x8 tr1(unsigned addr) {
    u32x2 a0, a1;
    asm volatile("ds_read_b64_tr_b16 %0, %2 offset:%3\n\tds_read_b64_tr_b16 %1, %2 offset:%4\n\ts_waitcnt lgkmcnt(0)" : "=&v"(a0), "=&v"(a1) : "v"(addr), "i"(OFF), "i"(OFF + 16 * VP) : "memory");
    return mk_frag(a0, a1);
}
template <int OFF> __device__ __forceinline__ void tr4(unsigned addr, bf16x8& f0, bf16x8& f1, bf16x8& f2, bf16x8& f3) {
    u32x2 a0, a1, b0, b1, c0, c1, d0, d1;
    asm volatile("ds_read_b64_tr_b16 %0, %8 offset:%9\n\tds_read_b64_tr_b16 %1, %8 offset:%10\n\tds_read_b64_tr_b16 %2, %8 offset:%11\n\tds_read_b64_tr_b16 %3, %8 offset:%12\n\t"
                 "ds_read_b64_tr_b16 %4, %8 offset:%13\n\tds_read_b64_tr_b16 %5, %8 offset:%14\n\tds_read_b64_tr_b16 %6, %8 offset:%15\n\tds_read_b64_tr_b16 %7, %8 offset:%16\n\ts_waitcnt lgkmcnt(0)"
                 : "=&v"(a0), "=&v"(a1), "=&v"(b0), "=&v"(b1), "=&v"(c0), "=&v"(c1), "=&v"(d0), "=&v"(d1)
                 : "v"(addr), "i"(OFF), "i"(OFF + 16 * VP), "i"(OFF + 32), "i"(OFF + 32 + 16 * VP), "i"(OFF + 64), "i"(OFF + 64 + 16 * VP), "i"(OFF + 96), "i"(OFF + 96 + 16 * VP) : "memory");
    f0 = mk_frag(a0, a1); f1 = mk_frag(b0, b1); f2 = mk_frag(c0, c1); f3 = mk_frag(d0, d1);
}

__device__ __forceinline__ void build_decay(Frame& F, int l) {
    LAS float* dec = (LAS float*)(F.lds + LDS_DEC);
    for (int i = F.tid; i < 2 * 4 * 132; i += NTHREADS) { const int n = i % 132, dh = i / 132; const float x = F.pa->in[I_RETDEC][l * 8 + dh]; const float lg = -log1pf(expf(-x)); dec[i] = expf((float)n * lg); }
}

struct RgStep { bf16x8 bwa[2], bwx[2]; float lam, ba, bx, carry; };
template <bool FINAL>
__device__ __forceinline__ void rg_load_step(RgStep& R, Frame& F, const bf16_t* wgt, int l, int dir, int item, int blk, int n, int lane) {
    const int fr = lane & 15, fq = lane >> 4;
    const bf16_t* wa = wgt + ((size_t)(0 * 8 + blk) * 64 + 16 * n + fr) * 64 + 8 * fq;
    const bf16_t* wx = wgt + ((size_t)(1 * 8 + blk) * 64 + 16 * n + fr) * 64 + 8 * fq;
    R.bwa[0] = *(const bf16x8*)wa; R.bwa[1] = *(const bf16x8*)(wa + 32); R.bwx[0] = *(const bf16x8*)wx; R.bwx[1] = *(const bf16x8*)(wx + 32);
    const int ch = blk * 64 + 16 * n + fr, pi = (l * 2 + dir) * 512 + ch;
    R.lam = F.pa->in[I_RGLAM][pi]; R.ba = F.pa->in[I_RGBA][pi]; R.bx = F.pa->in[I_RGBX][pi];
    R.carry = FINAL ? ((const float*)(F.ws + WS_CARRY))[((size_t)item * 2 + dir) * 512 + ch] : 0.f;
}
template <bool FINAL, int DIR>
__device__ __forceinline__ void rg_dir(ldsp_t ucw, const bf16x8 (&af)[8][2], const RgStep& R, int n, int lane, f32x4 (&hsum)[8], float& Atot, float& Htot) {
    const int fr = lane & 15, fq = lane >> 4;
    constexpr float L2E_ = 1.4426950408889634f;
    const float ba2 = -L2E_ * R.ba, bx2 = -L2E_ * R.bx, cl2 = -8.0f * L2E_ * log1pf(expf(-R.lam)), carry = R.carry;
    const bf16x8 bwa[2] = {R.bwa[0], R.bwa[1]}, bwx[2] = {R.bwx[0], R.bwx[1]};
    f32x4 ar[8], ai[8];
#pragma unroll
    for (int m = 0; m < 8; ++m) { ar[m] = zero4(); ai[m] = zero4(); }
#pragma unroll
    for (int m = 0; m < 8; ++m)
#pragma unroll
        for (int ks = 0; ks < 2; ++ks) { ar[m] = __builtin_amdgcn_mfma_f32_16x16x32_bf16(af[m][ks], bwa[ks], ar[m], 0, 0, 0); ai[m] = __builtin_amdgcn_mfma_f32_16x16x32_bf16(af[m][ks], bwx[ks], ai[m], 0, 0, 0); }
    const unsigned uo = (unsigned)(32 * fq * UCP + (16 * n + fr) * 2);
#pragma unroll
    for (int m = 0; m < 8; ++m)
#pragma unroll
        for (int jj = 0; jj < 4; ++jj) {
            const float r = __builtin_amdgcn_rcpf(1.0f + __builtin_amdgcn_exp2f(__builtin_fmaf(ar[m][jj], -1.4426950408889634f, ba2)));
            const float ig = __builtin_amdgcn_rcpf(1.0f + __builtin_amdgcn_exp2f(__builtin_fmaf(ai[m][jj], -1.4426950408889634f, bx2)));
            const float a = __builtin_amdgcn_exp2f(cl2 * r);
            const float u = bf2f(*(const LAS bf16_t*)(ucw + uo + (4 * m + jj) * UCP));
            ar[m][jj] = a; ai[m][jj] = __builtin_amdgcn_sqrtf(__builtin_fmaf(-a, a, 1.0f)) * ig * u; }
    float gA = 1.f, gH = 0.f;
#pragma unroll
    for (int mm = 0; mm < 8; ++mm) { const int m = DIR ? 7 - mm : mm;
#pragma unroll
        for (int j4 = 0; j4 < 4; ++j4) { const int jj = DIR ? 3 - j4 : j4; gH = __builtin_fmaf(ar[m][jj], gH, ai[m][jj]); gA *= ar[m][jj]; } }
    const float A0 = lane_bcast(gA, fr), H0 = lane_bcast(gH, fr), A1 = lane_bcast(gA, fr + 16), H1 = lane_bcast(gH, fr + 16), A2 = lane_bcast(gA, fr + 32), H2 = lane_bcast(gH, fr + 32), A3 = lane_bcast(gA, fr + 48), H3 = lane_bcast(gH, fr + 48);
    if (FINAL) { float h = carry;
        if (!DIR) { if (fq > 0) h = A0 * h + H0; if (fq > 1) h = A1 * h + H1; if (fq > 2) h = A2 * h + H2; }
        else { if (fq < 3) h = A3 * h + H3; if (fq < 2) h = A2 * h + H2; if (fq < 1) h = A1 * h + H1; }
#pragma unroll
        for (int mm = 0; mm < 8; ++mm) { const int m = DIR ? 7 - mm : mm;
#pragma unroll
            for (int j4 = 0; j4 < 4; ++j4) { const int jj = DIR ? 3 - j4 : j4; h = __builtin_fmaf(ar[m][jj], h, ai[m][jj]); hsum[m][jj] += h; } } }
    if (!DIR) Htot = A3 * (A2 * (A1 * H0 + H1) + H2) + H3; else Htot = A0 * (A1 * (A2 * H3 + H2) + H1) + H0;
    Atot = (A0 * A1) * (A2 * A3);
}
template <bool FINAL>
__device__ __forceinline__ void rg_part(Frame& F, int l, int item, const Item& it, const int blk, const int n0, const int n1) {
    const bf16_t* P = (const bf16_t*)(F.ws + WS_PA);
    int lane = F.lane;
    ldsp_t ucw = F.lds + F.wave * (128 * UCP);
    { const int grp = lane & 7, ch0 = blk * 64 + grp * 8; float cw[4][8], cb[8];
#pragma unroll
      for (int k = 0; k < 4; ++k)
#pragma unroll
          for (int i = 0; i < 8; ++i) cw[k][i] = F.pa->in[I_CONVW][((size_t)l * 4 + k) * 512 + ch0 + i];
#pragma unroll
      for (int i = 0; i < 8; ++i) cb[i] = F.pa->in[I_CONVB][l * 512 + ch0 + i];
      const bf16_t* Pu = P + (size_t)it.seqbase * INW + ch0;
#pragma unroll 8
      for (int q = 0; q < 16; ++q) { const int token = (lane >> 3) + 8 * q; float o[8];
#pragma unroll
          for (int i = 0; i < 8; ++i) o[i] = cb[i];
#pragma unroll
          for (int k = 0; k < 4; ++k) { const int tt = it.t0 + token + k - 2; const int tc = tt < 0 ? 0 : (tt >= it.seqlen ? it.seqlen - 1 : tt);
              u32x4 v = ldg<u32x4>(Pu, (unsigned)tc * (unsigned)(INW * 2)); if (tt != tc) v = (u32x4){0u, 0u, 0u, 0u};
              o[0] += cw[k][0] * bf2f(v.x & 0xffffu); o[1] += cw[k][1] * __uint_as_float(v.x & 0xffff0000u); o[2] += cw[k][2] * bf2f(v.y & 0xffffu); o[3] += cw[k][3] * __uint_as_float(v.y & 0xffff0000u);
              o[4] += cw[k][4] * bf2f(v.z & 0xffffu); o[5] += cw[k][5] * __uint_as_float(v.z & 0xffff0000u); o[6] += cw[k][6] * bf2f(v.w & 0xffffu); o[7] += cw[k][7] * __uint_as_float(v.w & 0xffff0000u); }
          u32x4 w; w.x = pk2(o[0], o[1]); w.y = pk2(o[2], o[3]); w.z = pk2(o[4], o[5]); w.w = pk2(o[6], o[7]);
          *(LAS u32x4*)(ucw + token * UCP + grp * 16) = w; }
      LDS_WAIT(); asm volatile("" ::: "memory"); }
    asm volatile("" : "+v"(lane));
    bf16x8 af[8][2];
    { const int fr = lane & 15, fq = lane >> 4;
#pragma unroll
      for (int m = 0; m < 8; ++m)
#pragma unroll
          for (int ks = 0; ks < 2; ++ks) af[m][ks] = *(const LAS bf16x8*)(ucw + (32 * (fr >> 2) + 4 * m + (fr & 3)) * UCP + (8 * fq + 32 * ks) * 2); }
    const bf16_t* wg0 = (const bf16_t*)(F.ws + WS_RGW) + (size_t)(l * 2 + 0) * 2 * 8 * 4096;
    const bf16_t* wg1 = (const bf16_t*)(F.ws + WS_RGW) + (size_t)(l * 2 + 1) * 2 * 8 * 4096;
    float* TOT = (float*)(F.ws + WS_TOT);
    RgStep R0, R1;
    rg_load_step<FINAL>(R0, F, wg0, l, 0, item, blk, n0, lane);
#pragma unroll 1
    for (int n = n0; n < n1; ++n) { asm volatile("" : "+v"(lane));
        const int fr = lane & 15, fq = lane >> 4; const int ch = blk * 64 + 16 * n + fr;
        f32x4 hsum[8];
#pragma unroll
        for (int m = 0; m < 8; ++m) hsum[m] = zero4();
        rg_load_step<FINAL>(R1, F, wg1, l, 1, item, blk, n, lane);
        { float At, Ht;
          rg_dir<FINAL, 0>(ucw, af, R0, n, lane, hsum, At, Ht);
          if (!FINAL && fq == 0) { *(f32x2*)(TOT + (((size_t)item * 2 + 0) * 512 + ch) * 2) = (f32x2){At, Ht}; } }
        __builtin_amdgcn_sched_barrier(0);
        if (n + 1 < n1) rg_load_step<FINAL>(R0, F, wg0, l, 0, item, blk, n + 1, lane);
        { float At, Ht;
          rg_dir<FINAL, 1>(ucw, af, R1, n, lane, hsum, At, Ht);
          if (!FINAL && fq == 0) { *(f32x2*)(TOT + (((size_t)item * 2 + 1) * 512 + ch) * 2) = (f32x2){At, Ht}; } }
        if (FINAL) {
            const unsigned uo = (unsigned)(32 * fq * UCP + (16 * n + fr) * 2);
#pragma unroll
            for (int m = 0; m < 8; ++m)
#pragma unroll
                for (int jj = 0; jj < 4; ++jj) *(LAS bf16_t*)(ucw + uo + (4 * m + jj) * UCP) = (bf16_t)f2bf(hsum[m][jj]); }
    }
    if (FINAL) {
        LDS_WAIT(); asm volatile("" : "+v"(lane) :: "memory");
        const int ng = 2 * (n1 - n0);
        const int grp = 2 * n0 + ((ng == 8) ? (lane & 7) : (lane & 1)); const int tk0 = (ng == 8) ? (lane >> 3) : (lane >> 1), tstep = (ng == 8) ? 8 : 32, nq = (ng == 8) ? 16 : 4;
        const bf16_t* Pg = P + (size_t)it.row0 * INW + 512 + blk * 64 + grp * 8; bf16_t* Yo = (bf16_t*)(F.ws + WS_Y) + (size_t)it.row0 * D + blk * 64 + grp * 8;
#pragma unroll 8
        for (int q = 0; q < nq; ++q) { const int token = tk0 + tstep * q;
            const u32x4 hv = *(const LAS u32x4*)(ucw + token * UCP + grp * 16); const u32x4 gv = ldg<u32x4>(Pg, (unsigned)token * (unsigned)(INW * 2));
            u32x4 w;
            w.x = pk2(gelu_tanh(bf2f(gv.x & 0xffffu)) * bf2f(hv.x & 0xffffu), gelu_tanh(__uint_as_float(gv.x & 0xffff0000u)) * __uint_as_float(hv.x & 0xffff0000u));
            w.y = pk2(gelu_tanh(bf2f(gv.y & 0xffffu)) * bf2f(hv.y & 0xffffu), gelu_tanh(__uint_as_float(gv.y & 0xffff0000u)) * __uint_as_float(hv.y & 0xffff0000u));
            w.z = pk2(gelu_tanh(bf2f(gv.z & 0xffffu)) * bf2f(hv.z & 0xffffu), gelu_tanh(__uint_as_float(gv.z & 0xffff0000u)) * __uint_as_float(hv.z & 0xffff0000u));
            w.w = pk2(gelu_tanh(bf2f(gv.w & 0xffffu)) * bf2f(hv.w & 0xffffu), gelu_tanh(__uint_as_float(gv.w & 0xffff0000u)) * __uint_as_float(hv.w & 0xffff0000u));
            stg<u32x4>(Yo, (unsigned)token * (unsigned)(D * 2), w); }
        LDS_WAIT();
    }
}

__device__ __forceinline__ void stage_rows(Frame& F, ldsp_t dst, const Item& it, int col0, bool rope) {
    const bf16_t* P = (const bf16_t*)(F.ws + WS_PA); const float* ct = (const float*)(F.ws + WS_ROPE); const float* st = ct + 4096 * 64;
    for (int task = F.tid; task < 1024; task += NTHREADS) { const int token = task >> 3, d0 = (task & 7) * 8;
        const bf16_t* src = P + (size_t)(it.row0 + token) * INW + col0;
        const u32x4 lo = *(const u32x4*)(src + d0), hi = *(const u32x4*)(src + d0 + 64);
        u32x4 olo = lo, ohi = hi;
        if (rope) { const int pos = it.t0 + token; const f32x4 c0 = *(const f32x4*)(ct + pos * 64 + d0), c1 = *(const f32x4*)(ct + pos * 64 + d0 + 4), s0 = *(const f32x4*)(st + pos * 64 + d0), s1 = *(const f32x4*)(st + pos * 64 + d0 + 4);
            const float a[8] = {bf2f(lo.x & 0xffffu), __uint_as_float(lo.x & 0xffff0000u), bf2f(lo.y & 0xffffu), __uint_as_float(lo.y & 0xffff0000u), bf2f(lo.z & 0xffffu), __uint_as_float(lo.z & 0xffff0000u), bf2f(lo.w & 0xffffu), __uint_as_float(lo.w & 0xffff0000u)};
            const float b[8] = {bf2f(hi.x & 0xffffu), __uint_as_float(hi.x & 0xffff0000u), bf2f(hi.y & 0xffffu), __uint_as_float(hi.y & 0xffff0000u), bf2f(hi.z & 0xffffu), __uint_as_float(hi.z & 0xffff0000u), bf2f(hi.w & 0xffffu), __uint_as_float(hi.w & 0xffff0000u)};
            const float c[8] = {c0.x, c0.y, c0.z, c0.w, c1.x, c1.y, c1.z, c1.w}, s[8] = {s0.x, s0.y, s0.z, s0.w, s1.x, s1.y, s1.z, s1.w};
            float ra[8], rb[8];
#pragma unroll
            for (int i = 0; i < 8; ++i) { ra[i] = a[i] * c[i] - b[i] * s[i]; rb[i] = a[i] * s[i] + b[i] * c[i]; }
            olo.x = pk2(ra[0], ra[1]); olo.y = pk2(ra[2], ra[3]); olo.z = pk2(ra[4], ra[5]); olo.w = pk2(ra[6], ra[7]);
            ohi.x = pk2(rb[0], rb[1]); ohi.y = pk2(rb[2], rb[3]); ohi.z = pk2(rb[4], rb[5]); ohi.w = pk2(rb[6], rb[7]); }
        *(LAS u32x4*)(dst + token * TP + d0 * 2) = olo; *(LAS u32x4*)(dst + token * TP + (d0 + 64) * 2) = ohi; }
}
__device__ __forceinline__ void stage_cols(Frame& F, ldsp_t dst, const Item& it, int col0) {
    const bf16_t* P = (const bf16_t*)(F.ws + WS_PA);
    for (int task = F.tid; task < 2048; task += NTHREADS) { const int token = task >> 4, d0 = (task & 15) * 8;
        const u32x4 v = *(const u32x4*)(P + (size_t)(it.row0 + token) * INW + col0 + d0);
        const unsigned w[4] = {v.x, v.y, v.z, v.w};
#pragma unroll
        for (int i = 0; i < 4; ++i) { *(LAS bf16_t*)(dst + (d0 + 2 * i) * TP + token * 2) = (bf16_t)(w[i] & 0xffffu); *(LAS bf16_t*)(dst + (d0 + 2 * i + 1) * TP + token * 2) = (bf16_t)(w[i] >> 16); } }
}
__device__ __forceinline__ void rope8(u32x4& lo, u32x4& hi, const float* ct, const float* st, int pos, int d0) {
    const f32x4 c0 = *(const f32x4*)(ct + pos * 64 + d0), c1 = *(const f32x4*)(ct + pos * 64 + d0 + 4), s0 = *(const f32x4*)(st + pos * 64 + d0), s1 = *(const f32x4*)(st + pos * 64 + d0 + 4);
    const float a[8] = {bf2f(lo.x & 0xffffu), __uint_as_float(lo.x & 0xffff0000u), bf2f(lo.y & 0xffffu), __uint_as_float(lo.y & 0xffff0000u), bf2f(lo.z & 0xffffu), __uint_as_float(lo.z & 0xffff0000u), bf2f(lo.w & 0xffffu), __uint_as_float(lo.w & 0xffff0000u)};
    const float b[8] = {bf2f(hi.x & 0xffffu), __uint_as_float(hi.x & 0xffff0000u), bf2f(hi.y & 0xffffu), __uint_as_float(hi.y & 0xffff0000u), bf2f(hi.z & 0xffffu), __uint_as_float(hi.z & 0xffff0000u), bf2f(hi.w & 0xffffu), __uint_as_float(hi.w & 0xffff0000u)};
    const float c[8] = {c0.x, c0.y, c0.z, c0.w, c1.x, c1.y, c1.z, c1.w}, sn[8] = {s0.x, s0.y, s0.z, s0.w, s1.x, s1.y, s1.z, s1.w};
    float ra[8], rb[8];
#pragma unroll
    for (int i = 0; i < 8; ++i) { ra[i] = a[i] * c[i] - b[i] * sn[i]; rb[i] = a[i] * sn[i] + b[i] * c[i]; }
    lo = (u32x4){pk2(ra[0], ra[1]), pk2(ra[2], ra[3]), pk2(ra[4], ra[5]), pk2(ra[6], ra[7])};
    hi = (u32x4){pk2(rb[0], rb[1]), pk2(rb[2], rb[3]), pk2(rb[4], rb[5]), pk2(rb[6], rb[7])};
}
struct KvRegs { u32x4 klo[2], khi[2], v[4]; };
__device__ __forceinline__ void kv_issue(Frame& F, KvRegs& R, const Item& it, int h) {
    const bf16_t* P = (const bf16_t*)(F.ws + WS_PA);
    const bf16_t* Pk = P + (size_t)it.row0 * INW + 1536 + h * HD; const bf16_t* Pv = P + (size_t)it.row0 * INW + 2048 + h * HD;
#pragma unroll
    for (int t2 = 0; t2 < 2; ++t2) { const int task = F.tid + t2 * NTHREADS, token = task >> 3, d0 = (task & 7) * 8;
        R.klo[t2] = ldg<u32x4>(Pk, (unsigned)(token * INW + d0) * 2u); R.khi[t2] = ldg<u32x4>(Pk, (unsigned)(token * INW + d0 + 64) * 2u); }
#pragma unroll
    for (int t4 = 0; t4 < 4; ++t4) { const int task = F.tid + t4 * NTHREADS, token = task >> 4, d0 = (task & 15) * 8; R.v[t4] = ldg<u32x4>(Pv, (unsigned)(token * INW + d0) * 2u); }
}
template <int KS> __device__ __forceinline__ void kv_step(unsigned aK, unsigned aVf, unsigned aVb, f32x4 (&accf)[8], f32x4 (&accb)[8]) {
    const bf16x8 af = tr1<KS * 32 * VP>(aVf), ab = tr1<KS * 32 * VP>(aVb);
    bf16x8 b[8];
    tr4<KS * 32 * VP>(aK, b[0], b[1], b[2], b[3]); tr4<KS * 32 * VP + 128>(aK, b[4], b[5], b[6], b[7]);
#pragma unroll
    for (int n = 0; n < 8; ++n) { accf[n] = __builtin_amdgcn_mfma_f32_16x16x32_bf16(af, b[n], accf[n], 0, 0, 0); accb[n] = __builtin_amdgcn_mfma_f32_16x16x32_bf16(ab, b[n], accb[n], 0, 0, 0); }
}
__device__ __forceinline__ void stage_state_t(Frame& F, ldsp_t dst, const bf16_t* St) {
#pragma unroll
    for (int t4 = 0; t4 < 4; ++t4) { const int task = F.tid + t4 * NTHREADS, e = task >> 4, c8 = task & 15;
        *(LAS u32x4*)(dst + e * TP + c8 * 16) = ldg<u32x4>(St, (unsigned)(e * 128 + c8 * 8) * 2u); }
}
__device__ __forceinline__ void mm16x128(ldsp_t At, int ra0, ldsp_t Bt, int lane, f32x4 (&acc)[8]) {
    const int fr = lane & 15, fq = lane >> 4;
#pragma unroll
    for (int ks = 0; ks < 4; ++ks) { const bf16x8 a = *(const LAS bf16x8*)(At + (ra0 + fr) * TP + (32 * ks + 8 * fq) * 2);
#pragma unroll
        for (int n = 0; n < 8; ++n) { const bf16x8 b = *(const LAS bf16x8*)(Bt + (16 * n + fr) * TP + (32 * ks + 8 * fq) * 2); acc[n] = __builtin_amdgcn_mfma_f32_16x16x32_bf16(a, b, acc[n], 0, 0, 0); } }
}

__device__ __forceinline__ void kv_head(Frame& F, KvRegs& R, KvRegs& Rn, bool pre, int item, const Item& it, int h) {
    bf16_t* KV = (bf16_t*)(F.ws + WS_KV);
    const float* ct = (const float*)(F.ws + WS_ROPE); const float* st = ct + 4096 * 64;
    const LAS float* dec = (const LAS float*)(F.lds + LDS_DEC); const bool rope = !it.is_ctx;
    ldsp_t tK = F.lds, tVf = F.lds + TILEV, tVb = F.lds + 2 * TILEV;
#pragma unroll
    for (int t2 = 0; t2 < 2; ++t2) { const int task = F.tid + t2 * NTHREADS, token = task >> 3, d0 = (task & 7) * 8;
        if (rope) rope8(R.klo[t2], R.khi[t2], ct, st, it.t0 + token, d0);
        *(LAS u32x4*)(tK + token * VP + d0 * 2) = R.klo[t2]; *(LAS u32x4*)(tK + token * VP + (d0 + 64) * 2) = R.khi[t2]; }
#pragma unroll
    for (int t4 = 0; t4 < 4; ++t4) { const int task = F.tid + t4 * NTHREADS, token = task >> 4, d0 = (task & 15) * 8; const u32x4 v = R.v[t4];
        const float df = dec[(0 * 4 + h) * 132 + 127 - token], db = dec[(1 * 4 + h) * 132 + token];
        const float x[8] = {bf2f(v.x & 0xffffu), __uint_as_float(v.x & 0xffff0000u), bf2f(v.y & 0xffffu), __uint_as_float(v.y & 0xffff0000u), bf2f(v.z & 0xffffu), __uint_as_float(v.z & 0xffff0000u), bf2f(v.w & 0xffffu), __uint_as_float(v.w & 0xffff0000u)};
        u32x4 wf, wb; wf.x = pk2(x[0] * df, x[1] * df); wf.y = pk2(x[2] * df, x[3] * df); wf.z = pk2(x[4] * df, x[5] * df); wf.w = pk2(x[6] * df, x[7] * df);
        wb.x = pk2(x[0] * db, x[1] * db); wb.y = pk2(x[2] * db, x[3] * db); wb.z = pk2(x[4] * db, x[5] * db); wb.w = pk2(x[6] * db, x[7] * db);
        *(LAS u32x4*)(tVf + token * VP + d0 * 2) = wf; *(LAS u32x4*)(tVb + token * VP + d0 * 2) = wb; }
    WG_BAR_LDS();
    if (pre) kv_issue(F, Rn, it, h + 1);
    f32x4 af[8], ab[8];
#pragma unroll
    for (int n = 0; n < 8; ++n) { af[n] = zero4(); ab[n] = zero4(); }
    { const unsigned aK = tr_lane_addr(tK, F.lane), aVf = tr_lane_addr(tVf, F.lane) + 32u * (unsigned)F.wave, aVb = tr_lane_addr(tVb, F.lane) + 32u * (unsigned)F.wave;
      kv_step<0>(aK, aVf, aVb, af, ab); kv_step<1>(aK, aVf, aVb, af, ab); kv_step<2>(aK, aVf, aVb, af, ab); kv_step<3>(aK, aVf, aVb, af, ab); }
    const int fr = F.lane & 15, fq = F.lane >> 4;
    bf16_t* of = KV + (((size_t)item * 4 + h) * 2 + 0) * 16384 + (size_t)(16 * F.wave) * 128;
    unsigned so = (unsigned)((4 * fq) * 128 + fr) * 2u; asm volatile("" : "+v"(so));
#pragma unroll
    for (int n = 0; n < 8; ++n)
#pragma unroll
        for (int jj = 0; jj < 4; ++jj) { stg<bf16_t>(of, so + (unsigned)((jj * 128 + 16 * n) * 2), (bf16_t)f2bf(af[n][jj])); stg<bf16_t>(of, so + (unsigned)((16384 + jj * 128 + 16 * n) * 2), (bf16_t)f2bf(ab[n][jj])); }
    WG_BAR_LDS();
}
__device__ __forceinline__ int latent_item(int c) { return (c >> 5) * SPB + 2 + (c & 31); }
__device__ __forceinline__ int ctx_item(int ci) { return (ci >> 1) * SPB + (ci & 1); }
__device__ __forceinline__ void phase_m1(Frame& F, int l) {
    build_decay(F, l); __syncthreads();
    for (int c = F.bid; c < 256; c += F.G) {
        fresh(F);
        { const int item = latent_item(c); const Item it = item_info(item);
          rg_part<false>(F, l, item, it, F.wave, 0, 4);
          __syncthreads();
          KvRegs A, B;
          fresh(F); kv_issue(F, A, it, 0);
          kv_head(F, A, B, true, item, it, 0);
          fresh(F); kv_head(F, B, A, true, item, it, 1);
          fresh(F); kv_head(F, A, B, true, item, it, 2);
          fresh(F); kv_head(F, B, A, false, item, it, 3); }
        fresh(F);
        if (F.wave < 2) { const int u = c + 256 * F.wave; const int item = ctx_item(u >> 5); const Item it = item_info(item); rg_part<false>(F, l, item, it, (u >> 2) & 7, u & 3, (u & 3) + 1); }
        __syncthreads();
        if (c < 64) { const int item = ctx_item(c >> 2); const Item it = item_info(item); KvRegs A, B; fresh(F); kv_issue(F, A, it, c & 3); kv_head(F, A, B, false, item, it, c & 3); }
    }
}
__device__ __forceinline__ int seq_order(int dir, int step) { return dir ? (step == 0 ? 1 : (step == 1 ? 0 : 35 - step)) : step; }
__device__ __forceinline__ void phase_m2(Frame& F, int l) {
    bf16_t* KV = (bf16_t*)(F.ws + WS_KV);
    const int gt = F.bid * NTHREADS + F.tid, NGT = F.G * NTHREADS;
    for (int c = gt; c < NB * NH * 2 * 128 * 16; c += NGT) {
        const int dc = c & 15, e = (c >> 4) & 127, dir = (c >> 11) & 1, h = (c >> 12) & 3, b = c >> 14;
        const float x = F.pa->in[I_RETDEC][l * 8 + dir * 4 + h]; const float decay = expf(128.0f * (-log1pf(expf(-x))));
        float S[8];
#pragma unroll
        for (int i = 0; i < 8; ++i) S[i] = 0.f;
        const unsigned lo = (unsigned)((((h * 2 + dir) * 128 + e) * 128 + dc * 8) * 2);
        for (int g0 = 0; g0 < SPB; g0 += 17) {
            u32x4 v[17];
#pragma unroll
            for (int i = 0; i < 17; ++i) { const int item = b * SPB + seq_order(dir, g0 + i); v[i] = ldg<u32x4>(KV + (size_t)item * 4 * 2 * 16384, lo); }
#pragma unroll
            for (int i = 0; i < 17; ++i) { const int item = b * SPB + seq_order(dir, g0 + i);
                u32x4 w; w.x = pk2(S[0], S[1]); w.y = pk2(S[2], S[3]); w.z = pk2(S[4], S[5]); w.w = pk2(S[6], S[7]);
                stg<u32x4>(KV + (size_t)item * 4 * 2 * 16384, lo, w);
                S[0] = S[0] * decay + bf2f(v[i].x & 0xffffu); S[1] = S[1] * decay + __uint_as_float(v[i].x & 0xffff0000u); S[2] = S[2] * decay + bf2f(v[i].y & 0xffffu); S[3] = S[3] * decay + __uint_as_float(v[i].y & 0xffff0000u);
                S[4] = S[4] * decay + bf2f(v[i].z & 0xffffu); S[5] = S[5] * decay + __uint_as_float(v[i].z & 0xffff0000u); S[6] = S[6] * decay + bf2f(v[i].w & 0xffffu); S[7] = S[7] * decay + __uint_as_float(v[i].w & 0xffff0000u); }
        }
    }
    const float* TOT = (const float*)(F.ws + WS_TOT); float* CARRY = (float*)(F.ws + WS_CARRY);
    for (int c = gt; c < NB * 2 * 512; c += NGT) { const int ch = c & 511, dir = (c >> 9) & 1, b = c >> 10; float cr = 0.f;
        for (int step = 0; step < SPB; ++step) { const int item = b * SPB + seq_order(dir, step); const f32x2 ah = *(const f32x2*)(TOT + (((size_t)item * 2 + dir) * 512 + ch) * 2);
            CARRY[((size_t)item * 2 + dir) * 512 + ch] = cr; cr = ah.x * cr + ah.y; } }
}
struct RetRegs { u32x4 v[4], sf[4], sb[4], klo[2], khi[2], g[4]; };
__device__ __forceinline__ void ret_issue(Frame& F, RetRegs& R, int item, const Item& it, int h) {
    const bf16_t* KV = (const bf16_t*)(F.ws + WS_KV); const bf16_t* P = (const bf16_t*)(F.ws + WS_PA);
    const bf16_t* Pk = P + (size_t)it.row0 * INW + 1536 + h * HD; const bf16_t* Pv = P + (size_t)it.row0 * INW + 2048 + h * HD;
    const bf16_t* Sf = KV + (((size_t)item * 4 + h) * 2 + 0) * 16384; const bf16_t* Sb = Sf + 16384;
    const int lane = F.lane, i0 = 16 * F.wave;
#pragma unroll
    for (int t2 = 0; t2 < 2; ++t2) { const int task = F.tid + t2 * NTHREADS, token = task >> 3, d0 = (task & 7) * 8;
        R.klo[t2] = ldg<u32x4>(Pk, (unsigned)(token * INW + d0) * 2u); R.khi[t2] = ldg<u32x4>(Pk, (unsigned)(token * INW + d0 + 64) * 2u); }
#pragma unroll
    for (int t4 = 0; t4 < 4; ++t4) { const int task = F.tid + t4 * NTHREADS, r = task >> 4, c8 = task & 15;
        R.v[t4] = ldg<u32x4>(Pv, (unsigned)(r * INW + c8 * 8) * 2u); R.sf[t4] = ldg<u32x4>(Sf, (unsigned)(r * 128 + c8 * 8) * 2u); R.sb[t4] = ldg<u32x4>(Sb, (unsigned)(r * 128 + c8 * 8) * 2u); }
    { const bf16_t* Pg = P + (size_t)(it.row0 + i0) * INW + 2560 + h * HD;
#pragma unroll
      for (int k = 0; k < 4; ++k) R.g[k] = ldg<u32x4>(Pg, (unsigned)((lane >> 2) * INW + 32 * (lane & 3) + 8 * k) * 2u); }
}
__device__ __forceinline__ void ret_head(Frame& F, RetRegs& R, RetRegs& Rn, bool pre, int item, const Item& it, int h) {
    bf16_t* Y = (bf16_t*)(F.ws + WS_Y);
    const float* ct = (const float*)(F.ws + WS_ROPE); const float* st = ct + 4096 * 64;
    const LAS float* dec = (const LAS float*)(F.lds + LDS_DEC);
    ldsp_t tK = F.lds, tV = F.lds + TILEB, tSf = tV + TILEV, tSb = tSf + TILEB;
    const bool rope = !it.is_ctx;
    const int lane = F.lane, fr = lane & 15, fq = lane >> 4, i0 = 16 * F.wave;
    u32x4 q4[4];
    { const bf16_t* Pq = (const bf16_t*)(F.ws + WS_PA) + (size_t)(it.row0 + i0) * INW + 1024 + h * HD;
#pragma unroll
      for (int ks = 0; ks < 4; ++ks) q4[ks] = ldg<u32x4>(Pq, (unsigned)(fr * INW + 32 * ks + 8 * fq) * 2u); }
#pragma unroll
    for (int t2 = 0; t2 < 2; ++t2) { const int task = F.tid + t2 * NTHREADS, token = task >> 3, d0 = (task & 7) * 8;
        if (rope) rope8(R.klo[t2], R.khi[t2], ct, st, it.t0 + token, d0);
        *(LAS u32x4*)(tK + token * TP + d0 * 2) = R.klo[t2]; *(LAS u32x4*)(tK + token * TP + (d0 + 64) * 2) = R.khi[t2]; }
#pragma unroll
    for (int t4 = 0; t4 < 4; ++t4) { const int task = F.tid + t4 * NTHREADS, r = task >> 4, c8 = task & 15;
        *(LAS u32x4*)(tV + r * VP + c8 * 16) = R.v[t4]; *(LAS u32x4*)(tSf + r * TP + c8 * 16) = R.sf[t4]; *(LAS u32x4*)(tSb + r * TP + c8 * 16) = R.sb[t4]; }
    bf16x8 qf[4];
    { if (rope) { rope8(q4[0], q4[2], ct, st, it.t0 + i0 + fr, 8 * fq); rope8(q4[1], q4[3], ct, st, it.t0 + i0 + fr, 32 + 8 * fq); }
#pragma unroll
      for (int ks = 0; ks < 4; ++ks) qf[ks] = __builtin_bit_cast(bf16x8, q4[ks]); }
    u32x4 gk[4];
#pragma unroll
    for (int k = 0; k < 4; ++k) gk[k] = R.g[k];
    WG_BAR_LDS();
    if (pre) ret_issue(F, Rn, item, it, h + 1);
    bf16x8 pa[4];
    { f32x4 C[8];
#pragma unroll
      for (int jt = 0; jt < 8; ++jt) { C[jt] = zero4();
#pragma unroll
          for (int ks = 0; ks < 4; ++ks) { const bf16x8 a = *(const LAS bf16x8*)(tK + (16 * jt + fr) * TP + (32 * ks + 8 * fq) * 2); C[jt] = __builtin_amdgcn_mfma_f32_16x16x32_bf16(a, qf[ks], C[jt], 0, 0, 0); } }
      const int i = i0 + fr;
#pragma unroll
      for (int jt = 0; jt < 8; ++jt)
#pragma unroll
          for (int jj = 0; jj < 4; ++jj) { const int j = 16 * jt + 4 * fq + jj; const float dcy = (i >= j) ? dec[(0 * 4 + h) * 132 + (i - j)] : dec[(1 * 4 + h) * 132 + (j - i)]; C[jt][jj] *= dcy; }
#pragma unroll
      for (int u = 0; u < 4; ++u) { const u32x4 w = {pg8::cvt_pk_bf16(C[2 * u][0], C[2 * u][1]), pg8::cvt_pk_bf16(C[2 * u][2], C[2 * u][3]), pg8::cvt_pk_bf16(C[2 * u + 1][0], C[2 * u + 1][1]), pg8::cvt_pk_bf16(C[2 * u + 1][2], C[2 * u + 1][3])};
          pa[u] = __builtin_bit_cast(bf16x8, w); } }
    WG_BAR_LDS();
    { ldsp_t gt = tK + (i0 + (lane >> 2)) * TP + (lane & 3) * 64;
#pragma unroll
      for (int k = 0; k < 4; ++k) *(LAS u32x4*)(gt + 16 * k) = gk[k]; }
    f32x4 o[8];
#pragma unroll
    for (int n = 0; n < 8; ++n) o[n] = zero4();
    { const unsigned aV = tr_lane_addr(tV, lane); bf16x8 b[8];
#define RET_PV(U) do { tr4<(U) * 32 * VP>(aV, b[0], b[1], b[2], b[3]); tr4<(U) * 32 * VP + 128>(aV, b[4], b[5], b[6], b[7]); \
        _Pragma("unroll") for (int n = 0; n < 8; ++n) o[n] = __builtin_amdgcn_mfma_f32_16x16x32_bf16(pa[U], b[n], o[n], 0, 0, 0); } while (0)
      RET_PV(0); RET_PV(1); RET_PV(2); RET_PV(3);
#undef RET_PV
    }
    { f32x4 cf[8];
#pragma unroll
      for (int n = 0; n < 8; ++n) { cf[n] = zero4();
#pragma unroll
          for (int ks = 0; ks < 4; ++ks) { const bf16x8 b = *(const LAS bf16x8*)(tSf + (16 * n + fr) * TP + (32 * ks + 8 * fq) * 2); cf[n] = __builtin_amdgcn_mfma_f32_16x16x32_bf16(qf[ks], b, cf[n], 0, 0, 0); } }
#pragma unroll
      for (int jj = 0; jj < 4; ++jj) { const float sf = dec[(0 * 4 + h) * 132 + (i0 + 4 * fq + jj + 1)];
#pragma unroll
          for (int n = 0; n < 8; ++n) o[n][jj] += sf * cf[n][jj]; } }
    { f32x4 cb[8];
#pragma unroll
      for (int n = 0; n < 8; ++n) { cb[n] = zero4();
#pragma unroll
          for (int ks = 0; ks < 4; ++ks) { const bf16x8 b = *(const LAS bf16x8*)(tSb + (16 * n + fr) * TP + (32 * ks + 8 * fq) * 2); cb[n] = __builtin_amdgcn_mfma_f32_16x16x32_bf16(qf[ks], b, cb[n], 0, 0, 0); } }
#pragma unroll
      for (int jj = 0; jj < 4; ++jj) { const float sb = dec[(1 * 4 + h) * 132 + (128 - (i0 + 4 * fq + jj))];
#pragma unroll
          for (int n = 0; n < 8; ++n) o[n][jj] += sb * cb[n][jj]; } }
    { ldsp_t gc = tK + (i0 + 4 * fq) * TP + fr * 2;
#pragma unroll
      for (int jj = 0; jj < 4; ++jj) { float s1 = 0.f;
#pragma unroll
          for (int n = 0; n < 8; ++n) s1 += o[n][jj];
          s1 += swz_xor<1>(s1); s1 += swz_xor<2>(s1); s1 += swz_xor<4>(s1); s1 += swz_xor<8>(s1);
          const float mu = s1 * (1.0f / 128.0f); float q = 0.f;
#pragma unroll
          for (int n = 0; n < 8; ++n) { const float dd = o[n][jj] - mu; q += dd * dd; }
          q += swz_xor<1>(q); q += swz_xor<2>(q); q += swz_xor<4>(q); q += swz_xor<8>(q);
          const float rstd = 1.0f / sqrtf(q * (1.0f / 128.0f) + EPS);
#pragma unroll
          for (int n = 0; n < 8; ++n) { LAS bf16_t* p = (LAS bf16_t*)(gc + jj * TP + 32 * n); const float gv = bf2f(*p); *p = (bf16_t)f2bf(siluf_(gv) * (o[n][jj] - mu) * rstd); } } }
    LDS_WAIT(); asm volatile("" ::: "memory");
    { ldsp_t gt = tK + (i0 + (lane >> 2)) * TP + (lane & 3) * 64; bf16_t* Yo = Y + (size_t)(it.row0 + i0) * D + 512 + h * HD;
#pragma unroll
      for (int k = 0; k < 4; ++k) stg<u32x4>(Yo, (unsigned)((lane >> 2) * D + 32 * (lane & 3) + 8 * k) * 2u, *(const LAS u32x4*)(gt + 16 * k)); }
    WG_BAR_LDS();
}
__device__ __forceinline__ void phase_m3(Frame& F, int l) {
    build_decay(F, l); __syncthreads();
    for (int c = F.bid; c < 256; c += F.G) {
        fresh(F);
        { const int item = latent_item(c); const Item it = item_info(item);
#ifndef PROBE_M3
#define PROBE_M3 0
#endif
          for (int r_ = 0; r_ < ((PROBE_M3 & 1) ? 2 : 1); ++r_) { fresh(F); rg_part<true>(F, l, item, it, F.wave, 0, 4); }
          __syncthreads();
          for (int r_ = 0; r_ < ((PROBE_M3 & 2) ? 2 : 1); ++r_) {
          RetRegs R, Rn;
          fresh(F); ret_issue(F, R, item, it, 0);
          ret_head(F, R, Rn, true, item, it, 0);
          fresh(F); ret_head(F, Rn, R, true, item, it, 1);
          fresh(F); ret_head(F, R, Rn, true, item, it, 2);
          fresh(F); ret_head(F, Rn, R, false, item, it, 3); } }
        if (l == 0) {
            fresh(F);
            if (F.wave < 2) { const int u = c + 256 * F.wave; const int item = ctx_item(u >> 5); const Item it = item_info(item); rg_part<true>(F, l, item, it, (u >> 2) & 7, u & 3, (u & 3) + 1); }
            __syncthreads();
            if (c < 64) { const int item = ctx_item(c >> 2); const Item it = item_info(item); RetRegs R, Rn; fresh(F); ret_issue(F, R, item, it, c & 3); ret_head(F, R, Rn, false, item, it, c & 3); }
        }
    }
}

constexpr int N_PHASES = 24;
__global__ void __launch_bounds__(NTHREADS, 2) fwd_kernel(Args args) {
    extern __shared__ __attribute__((aligned(16))) unsigned char lds_raw[];
    Frame F; F.lds = (ldsp_t)lds_raw; F.wave0 = __builtin_amdgcn_readfirstlane((int)threadIdx.x >> 6); F.G = gridDim.x; F.pa0 = &args; F.out0 = args.out; F.ws0 = args.ws; fresh(F);
    volatile LAS unsigned* MISC = (volatile LAS unsigned*)(F.lds + LDS_MISC);
    if (F.tid < 64) MISC[F.tid] = 0u;
    __syncthreads();
    const int lo = args.ph_lo, hi = args.ph_hi;
    XcdBarrier bar; bar.bar = (unsigned*)(F.ws + WS_CTL); bar.x = 0; bar.st = nullptr;
    if (hi - lo > 1) bar = xcd_barrier_post((unsigned*)(F.ws + WS_CTL), MISC);
#ifndef DIAG_MASK
#define DIAG_MASK 0xffffffffu
#endif
#ifndef REPEAT_MASK
#define REPEAT_MASK 0u
#endif
#define REPS(kind) ((((REPEAT_MASK) >> (kind)) & 1u) ? 2 : 1)
#define INK(k, kind) (((DIAG_MASK >> (kind)) & 1u) && lo <= (k) && (k) < hi && fresh(F))
#define IN(k) (lo <= (k) && (k) < hi)
#define SEAM(k) do { if (IN(k) && IN((k) + 1)) xcd_barrier(bar); } while (0)
    float* ctxx = (float*)(F.ws + WS_CTXX);
    const float* modlat = (const float*)(F.ws + WS_MODLAT); const float* modctx = (const float*)(F.ws + WS_MODCTX);

    if (INK(0, 0)) { for (int r_ = 0; r_ < REPS(0); ++r_) { phase_convert_small(F); __syncthreads(); phase_mod(F); __syncthreads(); } } SEAM(0);
    if (INK(1, 1)) { for (int r_ = 0; r_ < REPS(1); ++r_) phase_norm(F, 0, 0, F.pa->in[I_X], F.pa->in[I_CTX], MROWS, SlabRed{nullptr, 0, nullptr, nullptr, nullptr}); } SEAM(1);
#pragma unroll 1
    for (int l = 0; l < 2; ++l) {
        const int pb = (l == 0) ? 2 : 11;
        if (INK(pb + 0, 2)) { pg8::Gemm g{(const bf16_t*)(F.ws + WS_HX), (const bf16_t*)(F.ws + WS_WIN) + (size_t)l * INW * D, INW, D, 0, nullptr}; pg8::Order S; S.init(MROWS / 256, INW / 256, F.G, F.bid, nullptr, nullptr, D / 64, false, 0);
            pg8::EpiBf16 E{(bf16_t*)(F.ws + WS_PA), INW}; for (int r_ = 0; r_ < REPS(2); ++r_) pg8::gemm_phase<pg8::EpiBf16>(F.lds, g, S, E, F.tid); }
        SEAM(pb + 0);
        if (INK(pb + 1, 3)) { for (int r_ = 0; r_ < REPS(3); ++r_) phase_m1(F, l); }
        SEAM(pb + 1);
        if (INK(pb + 2, 4)) { for (int r_ = 0; r_ < REPS(4); ++r_) { if (r_) phase_m1(F, l); phase_m2(F, l); } }
        SEAM(pb + 2);
        if (INK(pb + 3, 5)) { for (int r_ = 0; r_ < REPS(5); ++r_) phase_m3(F, l); }
        SEAM(pb + 3);
        if (INK(pb + 4, 6)) { pg8::Gemm g{(const bf16_t*)(F.ws + WS_Y), (const bf16_t*)(F.ws + WS_WOUT) + (size_t)l * D * D, D, D, 0, (float*)(F.ws + WS_SLABA)}; pg8::Order S; S.init((l == 0 ? MROWS : NLAT) / 256, D / 256, F.G, F.bid, nullptr, nullptr, D / 64, true, MAXSLAB_A);
            pg8::EpiResid E{l == 0 ? F.pa->in[I_X] : (const float*)F.out, F.out, F.pa->in[I_CTX], ctxx, modlat + (size_t)l * 8 * 6144 + 2048, modctx + (size_t)l * 6144 + 2048};
            pg8::gemm_phase<pg8::EpiResid>(F.lds, g, S, E, F.tid); }
        SEAM(pb + 4);
        if (l == 0) {
            if (INK(7, 1)) { for (int r_ = 0; r_ < REPS(1); ++r_) phase_norm(F, 0, 1, F.out, ctxx, MROWS, SlabRed{(const float*)(F.ws + WS_SLABA), pg8::split_factor((MROWS / 256) * 4, F.G, D / 64, MAXSLAB_A), modctx + 2048, F.pa->in[I_CTX], ctxx}); } SEAM(7);
            if (INK(8, 7)) { pg8::Gemm g{(const bf16_t*)(F.ws + WS_HX), (const bf16_t*)(F.ws + WS_WUP), 2 * DFF, D, 0, nullptr}; pg8::Order S; S.init(MROWS / 256, 2 * DFF / 256, F.G, F.bid, nullptr, nullptr, D / 64, false, 0);
                pg8::EpiSwiGLU E{(bf16_t*)(F.ws + WS_PA), DFF}; for (int r_ = 0; r_ < REPS(7); ++r_) pg8::gemm_phase<pg8::EpiSwiGLU>(F.lds, g, S, E, F.tid); }
            SEAM(8);
            if (INK(9, 8)) { pg8::Gemm g{(const bf16_t*)(F.ws + WS_PA), (const bf16_t*)(F.ws + WS_WDN), D, DFF, 0, (float*)(F.ws + WS_SLABA)}; pg8::Order S; S.init(MROWS / 256, D / 256, F.G, F.bid, nullptr, nullptr, DFF / 64, true, MAXSLAB_A);
                pg8::EpiResid E{(const float*)F.out, F.out, (const float*)ctxx, ctxx, modlat + 5120, modctx + 5120}; pg8::gemm_phase<pg8::EpiResid>(F.lds, g, S, E, F.tid); }
            SEAM(9);
            if (INK(10, 1)) { for (int r_ = 0; r_ < REPS(1); ++r_) phase_norm(F, 1, 0, F.out, ctxx, MROWS, SlabRed{(const float*)(F.ws + WS_SLABA), pg8::split_factor((MROWS / 256) * 4, F.G, DFF / 64, MAXSLAB_A), modctx + 5120, ctxx, ctxx}); } SEAM(10);
        }
    }
    if (INK(16, 9)) { for (int r_ = 0; r_ < REPS(9); ++r_) { phase_norm_router(F, F.out); __syncthreads(); phase_convert_moe(F); __syncthreads(); } } SEAM(16);
    if (INK(17, 10)) { phase_moe_sort(F); } SEAM(17);
#pragma unroll 1
    for (int k = 0; k < 2; ++k) {
        const int* meta = (const int*)(F.ws + MOE_META) + 9 * k;
        if (INK(18 + 2 * k, 11)) { if (k == 1) { moe_reduce(F, 0); __syncthreads(); } pg8::Gemm g{(const bf16_t*)(F.ws + WS_HX), (const bf16_t*)(F.ws + WS_MOEUP), 2 * DEXP, D, (size_t)2 * DEXP * D * 2, nullptr}; pg8::Order S; S.init(meta[8], 2 * DEXP / 256, F.G, F.bid, meta, (const int*)(F.ws + MOE_PTOK) + k * MROWS, D / 64, false, 0);
            pg8::EpiSwiGLU E{(bf16_t*)(F.ws + WS_PA), DEXP}; for (int r_ = 0; r_ < REPS(11); ++r_) pg8::gemm_phase<pg8::EpiSwiGLU>(F.lds, g, S, E, F.tid); }
        SEAM(18 + 2 * k);
        if (INK(19 + 2 * k, 12)) { pg8::Gemm g{(const bf16_t*)(F.ws + WS_PA), (const bf16_t*)(F.ws + WS_MOEDN), D, DEXP, (size_t)D * DEXP * 2, (float*)(F.ws + WS_SLABM)}; pg8::Order S; S.init(meta[8], D / 256, F.G, F.bid, meta, nullptr, DEXP / 64, true, MAXSLAB_M);
            pg8::EpiMoeDown E{F.out, (const int*)(F.ws + MOE_PTOK) + k * MROWS, (const float*)(F.ws + MOE_PW) + k * MROWS, modlat + (size_t)8 * 6144 + 5120}; pg8::gemm_phase<pg8::EpiMoeDown>(F.lds, g, S, E, F.tid); }
        SEAM(19 + 2 * k);
    }
    if (INK(22, 13)) moe_reduce(F, 1);
    SEAM(22);
    if (INK(23, 13)) phase_final(F);
#undef IN
#undef INK
#undef SEAM
}

extern "C" void kernel_launch(void* const* d_in, const int* in_sizes, int n_in, void* d_out, int out_size, void* d_ws, size_t ws_size, hipStream_t stream) {
    static int grid = 0;
    if (grid == 0) {
        if (n_in != 27 || in_sizes[0] != NLAT * D || out_size != NLAT * D || ws_size < WS_END) { fprintf(stderr, "kernel_launch: unexpected problem (n_in %d, in0 %d, out %d, ws %zu, need %zu); nothing launched\n", n_in, n_in > 0 ? in_sizes[0] : -1, out_size, ws_size, (size_t)WS_END); grid = -1; return; }
        int dev = 0, cus = 0, per_cu = 0;
        if (hipGetDevice(&dev) != hipSuccess || hipDeviceGetAttribute(&cus, hipDeviceAttributeMultiprocessorCount, dev) != hipSuccess) { grid = -1; return; }
        if (hipFuncSetAttribute((const void*)fwd_kernel, hipFuncAttributeMaxDynamicSharedMemorySize, LDS_BYTES) != hipSuccess) { fprintf(stderr, "kernel_launch: hipFuncSetAttribute failed\n"); grid = -1; return; }
        if (hipOccupancyMaxActiveBlocksPerMultiprocessor(&per_cu, (const void*)fwd_kernel, NTHREADS, LDS_BYTES) != hipSuccess || per_cu < 1) { fprintf(stderr, "kernel_launch: occupancy query says %d\n", per_cu); }
        (void)hipGetLastError();
        grid = cus;
    }
    if (grid < 0) return;
    (void)hipMemsetAsync((char*)d_ws + WS_CTL, 0, CTL_ZERO_BYTES, stream);
    Args a; memset(&a, 0, sizeof(a));
    for (int i = 0; i < 27; ++i) a.in[i] = (const float*)d_in[i];
    a.out = (float*)d_out; a.ws = (unsigned char*)d_ws;
#if MK_ONE_LAUNCH
    a.ph_lo = 0; a.ph_hi = N_PHASES;
    hipLaunchKernelGGL(fwd_kernel, dim3(grid), dim3(NTHREADS), LDS_BYTES, stream, a);
#else
    for (int p = 0; p < N_PHASES; ++p) { a.ph_lo = p; a.ph_hi = p + 1; hipLaunchKernelGGL(fwd_kernel, dim3(grid), dim3(NTHREADS), LDS_BYTES, stream, a); }
#endif
}
```

```cpp
#include <hip/hip_runtime.h>
#include <cstdio>
#include <cstdint>
#include <cstring>

#ifndef MK_ONE_LAUNCH
#define MK_ONE_LAUNCH 1
#endif

#define GAS __attribute__((address_space(1)))
#define LAS __attribute__((address_space(3)))
typedef unsigned short bf16_t;
typedef short bf16x8 __attribute__((ext_vector_type(8)));
typedef float f32x4 __attribute__((ext_vector_type(4)));
typedef float f32x2 __attribute__((ext_vector_type(2)));
typedef unsigned u32x4 __attribute__((ext_vector_type(4)));
typedef unsigned u32x2 __attribute__((ext_vector_type(2)));
typedef LAS unsigned char* ldsp_t;

constexpr int D = 1024, NB = 8, SEQ = 4096, NLAT = NB * SEQ, CTXL = 256, NCTX = NB * CTXL, MROWS = NLAT + NCTX;
constexpr int INW = 3072, NH = 4, HD = 128, CHK = 128;
constexpr int DFF = 2816, NE = 8, DEXP = 3584;
constexpr int SPB = 34;
constexpr int NITEM = NB * SPB;
constexpr float EPS = 1e-6f;
constexpr int NWAVES = 8, NTHREADS = 512;

constexpr size_t MiB = 1u << 20;
constexpr size_t WS_CTL = 0, CTL_ZERO_BYTES = 64 * 1024;
constexpr size_t WS_MODLAT = 1 * MiB;
constexpr size_t WS_MODCTX = 1 * MiB + 2 * 8 * 6144 * 4;
constexpr size_t WS_ROPE = 2 * MiB;
constexpr size_t WS_RGW = 4 * MiB;
constexpr size_t WS_TOT = 5 * MiB;
constexpr size_t WS_CARRY = 8 * MiB;
constexpr size_t WS_MOE = 10 * MiB;
constexpr size_t MOE_CNT = WS_MOE, MOE_META = WS_MOE + 16384, MOE_TOKE = WS_MOE + 65536, MOE_TOKW = WS_MOE + 262144,
                 MOE_PTOK = WS_MOE + 524288, MOE_PW = WS_MOE + 1048576, MOE_PPOS = WS_MOE + 1572864;
constexpr size_t WS_CTXX = 12 * MiB;
constexpr size_t WS_WIN = 20 * MiB;
constexpr size_t WS_WOUT = 32 * MiB;
constexpr size_t WS_WUP = 36 * MiB;
constexpr size_t WS_WDN = 47 * MiB;
constexpr size_t WS_HX = 54 * MiB;
constexpr size_t WS_PA = 122 * MiB;
constexpr size_t WS_KV = 360 * MiB;
constexpr size_t WS_Y = 496 * MiB;
constexpr size_t WS_MOEUP = 360 * MiB;
constexpr size_t WS_MOEDN = 472 * MiB;
constexpr size_t WS_SLABA = WS_KV;
constexpr size_t WS_SLABM = 528 * MiB;
constexpr int MAXSLAB_A = 256, MAXSLAB_M = 216;
constexpr size_t XB_OFF = (size_t)NLAT * D * 2;
constexpr size_t WS_XCOPY = WS_PA;
constexpr size_t WS_END = 582 * MiB;
static_assert(WS_MOEDN + (size_t)NE * D * DEXP * 2 <= WS_END, "ws map");
static_assert(WS_PA + (size_t)MROWS * DEXP * 2 <= WS_KV, "ws map");

constexpr int LDS_SCRATCH = 147456;
constexpr int LDS_MISC = LDS_SCRATCH;
constexpr int LDS_DEC = LDS_MISC + 256;
constexpr int LDS_BYTES = LDS_SCRATCH + 8192;

__device__ __forceinline__ float bf2f(unsigned v) { return __uint_as_float(v << 16); }
typedef __bf16 bf16x2_t __attribute__((ext_vector_type(2)));
__device__ __forceinline__ unsigned pk2(float lo, float hi) { const f32x2 v = {lo, hi}; return __builtin_bit_cast(unsigned, __builtin_convertvector(v, bf16x2_t)); }
__device__ __forceinline__ unsigned f2bf(float f) { return pk2(f, f) & 0xffffu; }
__device__ __forceinline__ void unpack8(const u32x4 v, f32x4& a, f32x4& b) {
    a = (f32x4){bf2f(v.x & 0xffffu), __uint_as_float(v.x & 0xffff0000u), bf2f(v.y & 0xffffu), __uint_as_float(v.y & 0xffff0000u)};
    b = (f32x4){bf2f(v.z & 0xffffu), __uint_as_float(v.z & 0xffff0000u), bf2f(v.w & 0xffffu), __uint_as_float(v.w & 0xffff0000u)}; }
__device__ __forceinline__ u32x4 pack8(const f32x4 a, const f32x4 b) { return (u32x4){pk2(a.x, a.y), pk2(a.z, a.w), pk2(b.x, b.y), pk2(b.z, b.w)}; }
template <int M> __device__ __forceinline__ float swz_xor(float v) { return __int_as_float(__builtin_amdgcn_ds_swizzle(__float_as_int(v), (M << 10) | 0x1f)); }
__device__ __forceinline__ float wave_sum(float v) {
    v += swz_xor<1>(v); v += swz_xor<2>(v); v += swz_xor<4>(v); v += swz_xor<8>(v); v += swz_xor<16>(v);
    const auto r = __builtin_amdgcn_permlane32_swap(__float_as_uint(v), __float_as_uint(v), false, false);
    return __uint_as_float(r[0]) + __uint_as_float(r[1]);
}
__device__ __forceinline__ float lane_bcast(float v, int src_lane) { return __int_as_float(__builtin_amdgcn_ds_bpermute(src_lane << 2, __float_as_int(v))); }
__device__ __forceinline__ float sigmoidf_(float x) { return __builtin_amdgcn_rcpf(1.0f + __expf(-x)); }
__device__ __forceinline__ float siluf_(float x) { return x * __builtin_amdgcn_rcpf(1.0f + __expf(-x)); }
__device__ __forceinline__ float gelu_tanh(float x) { const float z = 0.7978845608028654f * (x + 0.044715f * x * x * x); return x * (1.0f - __builtin_amdgcn_rcpf(1.0f + __expf(2.0f * z))); }
#define LDS_WAIT() asm volatile("s_waitcnt lgkmcnt(0)" ::: "memory")
#define WG_BAR_LDS() do { asm volatile("s_waitcnt lgkmcnt(0)" ::: "memory"); __builtin_amdgcn_s_barrier(); asm volatile("" ::: "memory"); } while (0)
__device__ __forceinline__ f32x4 zero4() { float z; asm volatile("v_mov_b32 %0, 0" : "=v"(z)); return (f32x4){z, z, z, z}; }

template <typename T> __device__ __forceinline__ T ldg(const void* base, unsigned off) { return *(const GAS T*)((const GAS char*)base + off); }
template <typename T> __device__ __forceinline__ void stg(void* base, unsigned off, T v) { *(GAS T*)((GAS char*)base + off) = v; }
#define XB_TMO      128
#define XB_XCNT(j)  (256  + 64 * (j))
#define XB_XSUB(j)  (1280 + 64 * (j))
#define XB_XGEN(j)  (2304 + 64 * (j))
#define XB_TOP      3328
#define XB_TOPGEN   3392
#define XCD_BAR_WORDS 3456
#define XB_SPIN_CAP (1u << 18)
__device__ __forceinline__ unsigned xb_ld(unsigned* p)              { return __hip_atomic_load(p, __ATOMIC_RELAXED, __HIP_MEMORY_SCOPE_AGENT); }
__device__ __forceinline__ unsigned xb_add(unsigned* p, unsigned v) { return __hip_atomic_fetch_add(p, v, __ATOMIC_RELAXED, __HIP_MEMORY_SCOPE_AGENT); }
__device__ __forceinline__ unsigned xb_xcc_id() { return (unsigned)__builtin_amdgcn_s_getreg((3 << 11) | 20) & 0xFu; }
#define XB_SPIN(cond, bar) do { unsigned _sp = 0; while (cond) { __builtin_amdgcn_s_sleep(1); \
    if ((++_sp & 255u) == 0u) { if (xb_ld(&(bar)[XB_TMO])) break; if (_sp > XB_SPIN_CAP) { atomicAdd(&(bar)[XB_TMO], 1u); break; } } } } while (0)
struct XcdBarrier { unsigned* bar; unsigned x; volatile LAS unsigned* st; };
__device__ __forceinline__ XcdBarrier xcd_barrier_post(unsigned* bar, volatile LAS unsigned* st) {
    XcdBarrier b; b.bar = bar; b.x = xb_xcc_id(); b.st = st;
    if (threadIdx.x == 0) (void)xb_add(&bar[XB_XCNT(b.x)], 1u);
    return b;
}
__device__ __forceinline__ void xcd_barrier_complete(unsigned* bar, unsigned x, unsigned& nloc, unsigned& nx) {
    const unsigned G = gridDim.x * gridDim.y * gridDim.z;
    unsigned sum, cnt, mine, sp = 0u;
    for (;;) {
        sum = 0u; cnt = 0u; mine = 0u;
#pragma unroll
        for (unsigned j = 0; j < 16; ++j) { const unsigned c = xb_ld(&bar[XB_XCNT(j)]); sum += c; cnt += (c > 0u) ? 1u : 0u; mine = (j == x) ? c : mine; }
        if (sum == G) break;
        __builtin_amdgcn_s_sleep(1);
        if ((++sp & 255u) == 0u) { if (xb_ld(&bar[XB_TMO])) break; if (sp > XB_SPIN_CAP) { atomicAdd(&bar[XB_TMO], 1u); break; } }
    }
    nloc = mine > 0u ? mine : 1u; nx = cnt > 0u ? cnt : 1u;
}
__device__ __forceinline__ void xcd_barrier(const XcdBarrier& b) {
    asm volatile("s_waitcnt vmcnt(0)" ::: "memory");
    __syncthreads();
    if (threadIdx.x == 0) {
        unsigned* bar = b.bar;
        __builtin_amdgcn_s_waitcnt(0);
        unsigned nloc = b.st[0], nx = b.st[1];
        if (nloc == 0u) { xcd_barrier_complete(bar, b.x, nloc, nx); b.st[0] = nloc; b.st[1] = nx; }
        const unsigned old = xb_add(&bar[XB_XSUB(b.x)], 1u);
        const unsigned gen = old / nloc;
        if (old + 1u == (gen + 1u) * nloc) {
            __builtin_amdgcn_fence(__ATOMIC_RELEASE, "agent");
            asm volatile("s_waitcnt vmcnt(0)" ::: "memory");
            const unsigned og = xb_add(&bar[XB_TOP], 1u);
            const unsigned tg = og / nx;
            if (og + 1u == (tg + 1u) * nx) xb_add(&bar[XB_TOPGEN], 1u);
            else XB_SPIN(xb_ld(&bar[XB_TOPGEN]) == tg, bar);
            __builtin_amdgcn_fence(__ATOMIC_ACQUIRE, "agent");
            xb_add(&bar[XB_XGEN(b.x)], 1u);
            asm volatile("s_waitcnt vmcnt(0)" ::: "memory");
        } else {
            XB_SPIN(xb_ld(&bar[XB_XGEN(b.x)]) == gen, bar);
            __builtin_amdgcn_fence(__ATOMIC_ACQUIRE, "agent");
            asm volatile("s_waitcnt vmcnt(0)" ::: "memory");
        }
    }
    __syncthreads();
}

namespace pg8 {
constexpr int BM = 256, BK = 64, HALF = 128, HTB = HALF * BK * 2, STAGE_BYTES = 8 * HTB, NXCD = 8, WGM = 8;
__host__ __device__ __forceinline__ int lds_byte(int r, int c) { const int st = (r >> 4) * 2 + (c >> 5), rr = r & 15, cc = c & 31, ob = rr * 64 + cc * 2; return st * 1024 + (ob ^ (((ob >> 9) & 1) << 5)); }
__host__ __device__ __forceinline__ void stage_rc(int b, int& R, int& C) { const int st = b / 1024, sb = b % 1024, swz = sb ^ (((sb >> 9) & 1) << 5); R = (st >> 1) * 16 + swz / 64; C = (st & 1) * 32 + (swz % 64) / 2; }
__host__ __device__ __forceinline__ int perm32(int rho) { const int n = rho >> 4, i = rho & 15; return 8 * (i >> 2) + 4 * n + (i & 3); }

struct Unit { int pm, pn, e, kt0, nt, slab; };
struct Gemm { const bf16_t* A; const bf16_t* Bt; int N, K; size_t estride; float* slabs; };

__device__ __forceinline__ int split_factor(int U, int G, int ntiles, int maxslabs) {
    const int R = U % G; if (R == 0) return 1;
    int S = G / R; if (S > 8) S = 8; if (S > ntiles / 2) S = ntiles / 2; if (R * S > maxslabs) S = maxslabs / R;
    return S < 2 ? 1 : S;
}
struct Order {
    int nM, nN, G, c, ntiles, mainu, S, total; const int* segs; const int* rowmap;
    __device__ __forceinline__ void init(int nM_, int nN_, int G_, int c_, const int* segs_, const int* rowmap_, int ntiles_, bool split, int maxslabs) {
        nM = nM_; nN = nN_; G = G_; c = c_; segs = segs_; rowmap = rowmap_; ntiles = ntiles_;
        const int U = nM * nN; S = split ? split_factor(U, G, ntiles, maxslabs) : 1; const int R = (S > 1) ? U % G : 0; mainu = U - R; total = mainu + R * S; }
    __device__ __forceinline__ bool next(int i, Unit& u) const {
        const long L = (long)i * G + c; if (L >= total) return false;
        int wgid; u.kt0 = 0; u.nt = ntiles; u.slab = -1;
        if (L < mainu) { wgid = (int)L; const int q = mainu / NXCD, r = mainu % NXCD, xcd = wgid % NXCD, off = wgid / NXCD; wgid = (xcd < r ? xcd * (q + 1) : r * (q + 1) + (xcd - r) * q) + off; }
        else { const int sub = (int)L - mainu, lu = sub / S, sl = sub - lu * S, pairs = ntiles / 2, p0 = (sl * pairs) / S, p1 = ((sl + 1) * pairs) / S;
            wgid = mainu + lu; u.kt0 = 2 * p0; u.nt = 2 * (p1 - p0); u.slab = sub; }
        const int nig = WGM * nN, gid = wgid / nig, fm = gid * WGM, gsz = (nM - fm) < WGM ? (nM - fm) : WGM;
        u.pm = fm + ((wgid % nig) % gsz); u.pn = (wgid % nig) / gsz; u.e = 0;
        if (segs) { int e = 0;
#pragma unroll
            for (int j = 1; j < 8; ++j) e += (u.pm >= segs[j]) ? 1 : 0;
            u.e = e; }
        return true;
    }
    __device__ __forceinline__ int arow(const Unit& u, int r) const {
        if (rowmap) { const int t = rowmap[u.pm * BM + r]; return t < 0 ? 0 : t; }
        return u.pm * BM + r;
    }
};

__device__ __forceinline__ unsigned cvt_pk_bf16(float lo, float hi) { return pk2(lo, hi); }

struct EpiBf16 {
    static constexpr bool PERM = true, SPLIT = false;
    bf16_t* O; int ldc;
    __device__ __forceinline__ void operator()(const f32x4 (&acc)[2][2][4][2], const Unit& u, int wr, int wc, int fr, int fq) const {
        asm volatile("" : "+v"(fr), "+v"(fq));
        const int row0 = u.pm * BM + wr * 64 + fr, col0 = u.pn * BM + wc * 32 + 8 * fq;
#pragma unroll
        for (int ai = 0; ai < 2; ++ai)
#pragma unroll
            for (int m = 0; m < 4; ++m) { bf16_t* rowp = O + (size_t)(row0 + ai * HALF + m * 16) * ldc + col0;
#pragma unroll
                for (int bj = 0; bj < 2; ++bj) { const f32x4 v0 = acc[ai][bj][m][0], v1 = acc[ai][bj][m][1];
                    u32x4 w; w.x = cvt_pk_bf16(v0[0], v0[1]); w.y = cvt_pk_bf16(v0[2], v0[3]); w.z = cvt_pk_bf16(v1[0], v1[1]); w.w = cvt_pk_bf16(v1[2], v1[3]);
                    *(u32x4*)(rowp + bj * HALF) = w; } }
    }
};
struct EpiSwiGLU {
    static constexpr bool PERM = true, SPLIT = false;
    bf16_t* O; int ldc;
    __device__ __forceinline__ void operator()(const f32x4 (&acc)[2][2][4][2], const Unit& u, int wr, int wc, int fr, int fq) const {
        asm volatile("" : "+v"(fr), "+v"(fq));
        const int row0 = u.pm * BM + wr * 64 + fr, col0 = u.pn * HALF + wc * 32 + 8 * fq;
#pragma unroll
        for (int ai = 0; ai < 2; ++ai)
#pragma unroll
            for (int m = 0; m < 4; ++m) { bf16_t* rowp = O + (size_t)(row0 + ai * HALF + m * 16) * ldc + col0;
                float o[8];
#pragma unroll
                for (int n = 0; n < 2; ++n)
#pragma unroll
                    for (int j = 0; j < 4; ++j) { const float a = acc[ai][0][m][n][j], b = acc[ai][1][m][n][j]; o[n * 4 + j] = (a * __builtin_amdgcn_rcpf(1.0f + __expf(-a))) * b; }
                u32x4 w; w.x = cvt_pk_bf16(o[0], o[1]); w.y = cvt_pk_bf16(o[2], o[3]); w.z = cvt_pk_bf16(o[4], o[5]); w.w = cvt_pk_bf16(o[6], o[7]);
                *(u32x4*)rowp = w; }
    }
};
struct EpiResid {
    static constexpr bool PERM = true, SPLIT = true;
    const float* src_f32; bf16_t* xb; const float* src_ctx; float* dst_ctx; const float* gate_lat; const float* gate_ctx;
    __device__ __forceinline__ void operator()(const f32x4 (&acc)[2][2][4][2], const Unit& u, int wr, int wc, int fr, int fq) const {
        asm volatile("" : "+v"(fr), "+v"(fq));
        const int prow = u.pm * BM; const bool lat = prow < NLAT;
        const float* gate = lat ? gate_lat + (size_t)(prow / SEQ) * 6144 : gate_ctx;
        const int r0 = wr * 64 + fr, col0 = u.pn * BM + wc * 32 + 8 * fq;
        f32x4 gv[2][2];
#pragma unroll
        for (int bj = 0; bj < 2; ++bj)
#pragma unroll
            for (int n = 0; n < 2; ++n) gv[bj][n] = *(const f32x4*)(gate + col0 + bj * HALF + 4 * n);
        if (lat) {
#pragma unroll
            for (int ai = 0; ai < 2; ++ai)
#pragma unroll
                for (int m = 0; m < 4; ++m) { const size_t off = (size_t)(prow + r0 + ai * HALF + m * 16) * D + col0;
#pragma unroll
                    for (int bj = 0; bj < 2; ++bj) { f32x4 s0, s1;
                        if (src_f32) { s0 = *(const f32x4*)(src_f32 + off + bj * HALF); s1 = *(const f32x4*)(src_f32 + off + bj * HALF + 4); }
                        else unpack8(*(const u32x4*)(xb + off + bj * HALF), s0, s1);
                        *(u32x4*)(xb + off + bj * HALF) = pack8(s0 + gv[bj][0] * acc[ai][bj][m][0], s1 + gv[bj][1] * acc[ai][bj][m][1]); }
                    asm volatile("" ::: "memory"); }
        } else {
            const float* src = src_ctx + (size_t)(prow - NLAT) * D; float* dst = dst_ctx + (size_t)(prow - NLAT) * D;
#pragma unroll
            for (int ai = 0; ai < 2; ++ai)
#pragma unroll
                for (int m = 0; m < 4; ++m) { const size_t off = (size_t)(r0 + ai * HALF + m * 16) * D + col0;
#pragma unroll
                    for (int bj = 0; bj < 2; ++bj)
#pragma unroll
                        for (int n = 0; n < 2; ++n) { const f32x4 sv = *(const f32x4*)(src + off + bj * HALF + 4 * n); *(f32x4*)(dst + off + bj * HALF + 4 * n) = sv + gv[bj][n] * acc[ai][bj][m][n]; }
                    asm volatile("" ::: "memory"); }
        }
    }
};
struct EpiMoeDown {
    static constexpr bool PERM = true, SPLIT = true;
    bf16_t* xb; const int* ptok; const float* pw; const float* gate_lat;
    __device__ __forceinline__ void operator()(const f32x4 (&acc)[2][2][4][2], const Unit& u, int wr, int wc, int fr, int fq) const {
        asm volatile("" : "+v"(fr), "+v"(fq));
        const int r0 = u.pm * BM + wr * 64 + fr, col0 = u.pn * BM + wc * 32 + 8 * fq;
#pragma unroll
        for (int ai = 0; ai < 2; ++ai)
#pragma unroll
            for (int m = 0; m < 4; ++m) { const int r = r0 + ai * HALF + m * 16; const int tok = ptok[r]; const float w = pw[r];
                if (tok >= 0) { bf16_t* xr = xb + (size_t)tok * D + col0; const float* gate = gate_lat + (size_t)(tok / SEQ) * 6144 + col0;
#pragma unroll
                    for (int bj = 0; bj < 2; ++bj) { const f32x4 g0 = *(const f32x4*)(gate + bj * HALF), g1 = *(const f32x4*)(gate + bj * HALF + 4); f32x4 s0, s1; unpack8(*(const u32x4*)(xr + bj * HALF), s0, s1);
                        *(u32x4*)(xr + bj * HALF) = pack8(s0 + (g0 * w) * acc[ai][bj][m][0], s1 + (g1 * w) * acc[ai][bj][m][1]); } }
                asm volatile("" ::: "memory"); }
    }
};

template <class Epi>
__device__ __forceinline__ void gemm_phase(ldsp_t lds, const Gemm g, const Order& S, const Epi& E, const int tid) {
    const int wid = __builtin_amdgcn_readfirstlane(tid >> 6), lane = tid & 63, wr = wid >> 2, wc = wid & 3, fr = lane & 15, fq = lane >> 4;
    const int K = g.K;
    unsigned voffB[2];
#pragma unroll
    for (int i = 0; i < 2; ++i) { int R, C; stage_rc(tid * 16 + i * 8192, R, C); const int Rb = Epi::PERM ? ((R & ~31) + perm32(R & 31)) : R;
        voffB[i] = (unsigned)(Rb * K + C) * 2u; }
    const size_t kstep = (size_t)(BK * 2);
    const size_t hstep = (size_t)HALF * K * 2;
    const size_t tstep = 2 * hstep;
    const unsigned ldsw = (unsigned)wid * 1024u;
    const int aoff = lds_byte(wr * 64 + fr, fq * 8), boff = lds_byte(wc * 32 + fr, fq * 8);
#define PG8_SA(b, h) (((b) * 2 + (h)) * HTB)
#define PG8_SB(b, h) ((4 + (b) * 2 + (h)) * HTB)
#define PG8_STAGE_B(bufoff, gbase) do { _Pragma("unroll") for (int _i = 0; _i < 2; ++_i) \
        __builtin_amdgcn_global_load_lds((const unsigned*)((const char*)(gbase) + voffB[_i]), (LAS unsigned*)(lds + (bufoff) + ldsw + _i * 8192), 16, 0, 0); } while (0)
#define PG8_STAGE_A(bufoff, gbase, o0, o1) do { \
        __builtin_amdgcn_global_load_lds((const unsigned*)((const char*)(gbase) + (o0)), (LAS unsigned*)(lds + (bufoff) + ldsw), 16, 0, 0); \
        __builtin_amdgcn_global_load_lds((const unsigned*)((const char*)(gbase) + (o1)), (LAS unsigned*)(lds + (bufoff) + ldsw + 8192), 16, 0, 0); } while (0)
#define PG8_LDA(dst, b, h) do { _Pragma("unroll") for (int m = 0; m < 4; ++m) _Pragma("unroll") for (int k = 0; k < 2; ++k) dst[m][k] = *(const LAS bf16x8*)(lds + PG8_SA(b, h) + aoff + m * 2048 + k * 1024); } while (0)
#define PG8_LDB(dst, b, h) do { _Pragma("unroll") for (int n = 0; n < 2; ++n) _Pragma("unroll") for (int k = 0; k < 2; ++k) dst[n][k] = *(const LAS bf16x8*)(lds + PG8_SB(b, h) + boff + n * 2048 + k * 1024); } while (0)
#define PG8_MMA(ai, bj, At, Bt) do { __builtin_amdgcn_s_setprio(1); _Pragma("unroll") for (int m = 0; m < 4; ++m) _Pragma("unroll") for (int n = 0; n < 2; ++n) _Pragma("unroll") for (int k = 0; k < 2; ++k) \
        acc[ai][bj][m][n] = __builtin_amdgcn_mfma_f32_16x16x32_bf16(Bt[n][k], At[m][k], acc[ai][bj][m][n], 0, 0, 0); __builtin_amdgcn_s_setprio(0); } while (0)
#define PG8_WAIT_V(n) asm volatile("s_waitcnt vmcnt(" #n ")" ::: "memory")
#define PG8_WAIT_L(n) asm volatile("s_waitcnt lgkmcnt(" #n ")" ::: "memory")
#define PG8_BAR __builtin_amdgcn_s_barrier()
#define PG8_SCHED __builtin_amdgcn_sched_barrier(0)
#define PG8_AOFFS(u, o00, o01, o10, o11) do { int R0_, C0_, R1_, C1_; stage_rc(tid * 16, R0_, C0_); stage_rc(tid * 16 + 8192, R1_, C1_); \
        o00 = (unsigned)(S.arow(u, R0_) * K + C0_ + (u).kt0 * BK) * 2u; o01 = (unsigned)(S.arow(u, R1_) * K + C1_ + (u).kt0 * BK) * 2u; \
        o10 = (unsigned)(S.arow(u, HALF + R0_) * K + C0_ + (u).kt0 * BK) * 2u; o11 = (unsigned)(S.arow(u, HALF + R1_) * K + C1_ + (u).kt0 * BK) * 2u; } while (0)
    Unit cur, nxt; int ui = 0;
    if (!S.next(0, cur)) return;
    f32x4 acc[2][2][4][2];
    { float z_; asm volatile("v_mov_b32 %0, 0" : "=v"(z_));
#pragma unroll
    for (int a = 0; a < 2; ++a)
#pragma unroll
        for (int b = 0; b < 2; ++b)
#pragma unroll
            for (int m = 0; m < 4; ++m)
#pragma unroll
                for (int n = 0; n < 2; ++n) acc[a][b][m][n] = (f32x4){z_, z_, z_, z_}; }
    bf16x8 At[4][2], B0[2][2], B1[2][2];
    const char* const Abase = (const char*)g.A;
    const char* cB = (const char*)g.Bt + (size_t)cur.e * g.estride + (size_t)cur.pn * tstep + (size_t)cur.kt0 * kstep;
    unsigned c00, c01, c10, c11;
    PG8_AOFFS(cur, c00, c01, c10, c11);
    PG8_STAGE_B(PG8_SB(0, 0), cB); PG8_STAGE_B(PG8_SB(0, 1), cB + hstep); PG8_STAGE_A(PG8_SA(0, 0), Abase, c00, c01); PG8_STAGE_A(PG8_SA(0, 1), Abase, c10, c11);
    if (wr == 1) PG8_BAR;
    PG8_WAIT_V(2); PG8_BAR;
    PG8_STAGE_B(PG8_SB(1, 0), cB + kstep); PG8_STAGE_A(PG8_SA(1, 0), Abase + kstep, c00, c01); PG8_STAGE_B(PG8_SB(1, 1), cB + hstep + kstep);
    PG8_WAIT_V(6); PG8_BAR;
    for (;;) {
        const bool has_next = S.next(ui + 1, nxt);
        const char* nB = has_next ? (const char*)g.Bt + (size_t)nxt.e * g.estride + (size_t)nxt.pn * tstep + (size_t)nxt.kt0 * kstep : cB;
        const int nt = cur.nt;
        for (int t = 0; t < nt; t += 2) {
            const bool last = (t == nt - 2);
            const char* a1 = Abase + (size_t)(t + 1) * kstep;
            const char* a2 = last ? Abase : Abase + (size_t)(t + 2) * kstep; const char* b2 = last ? nB : cB + (size_t)(t + 2) * kstep;
            const char* a3 = a2 + kstep; const char* b3 = b2 + kstep;
            PG8_LDB(B0, 0, 0); PG8_LDB(B1, 0, 1); PG8_SCHED; PG8_LDA(At, 0, 0); PG8_STAGE_A(PG8_SA(1, 1), a1, c10, c11);
            PG8_WAIT_V(8); PG8_WAIT_L(0); PG8_BAR; PG8_MMA(0, 0, At, B0); PG8_MMA(0, 1, At, B1); PG8_BAR; PG8_SCHED;
            if (last && has_next) { PG8_AOFFS(nxt, c00, c01, c10, c11); }
            PG8_LDA(At, 0, 1); PG8_STAGE_B(PG8_SB(0, 0), b2); PG8_STAGE_B(PG8_SB(0, 1), b2 + hstep); PG8_STAGE_A(PG8_SA(0, 0), a2, c00, c01);
            PG8_WAIT_V(8); PG8_WAIT_L(0); PG8_BAR; PG8_MMA(1, 0, At, B0); PG8_MMA(1, 1, At, B1); PG8_BAR; PG8_SCHED;
            PG8_LDB(B0, 1, 0); PG8_LDB(B1, 1, 1); PG8_SCHED; PG8_LDA(At, 1, 0); PG8_STAGE_A(PG8_SA(0, 1), a2, c10, c11);
            PG8_WAIT_V(8); PG8_WAIT_L(0); PG8_BAR; PG8_MMA(0, 0, At, B0); PG8_MMA(0, 1, At, B1); PG8_BAR; PG8_SCHED;
            PG8_LDA(At, 1, 1); PG8_STAGE_B(PG8_SB(1, 0), b3); PG8_STAGE_B(PG8_SB(1, 1), b3 + hstep); PG8_STAGE_A(PG8_SA(1, 0), a3, c00, c01);
            PG8_WAIT_V(8); PG8_WAIT_L(0); PG8_BAR; PG8_MMA(1, 0, At, B0); PG8_MMA(1, 1, At, B1); PG8_BAR; PG8_SCHED;
        }
        if (wr == 0) PG8_BAR;
        if (Epi::SPLIT && cur.slab >= 0) {
            int fr_ = fr, fq_ = fq; asm volatile("" : "+v"(fr_), "+v"(fq_));
            float* sp = g.slabs + (size_t)cur.slab * 65536 + (size_t)(wr * 64 + fr_) * 256 + wc * 32 + (Epi::PERM ? 8 : 4) * fq_;
#pragma unroll
            for (int ai = 0; ai < 2; ++ai)
#pragma unroll
                for (int m = 0; m < 4; ++m)
#pragma unroll
                    for (int bj = 0; bj < 2; ++bj)
#pragma unroll
                        for (int n = 0; n < 2; ++n) *(f32x4*)(sp + (ai * HALF + m * 16) * 256 + bj * HALF + n * (Epi::PERM ? 4 : 16)) = acc[ai][bj][m][n];
        } else E(acc, cur, wr, wc, fr, fq);
        if (!has_next) break;
        { float z_; asm volatile("v_mov_b32 %0, 0" : "=v"(z_));
#pragma unroll
        for (int a = 0; a < 2; ++a)
#pragma unroll
            for (int b = 0; b < 2; ++b)
#pragma unroll
                for (int m = 0; m < 4; ++m)
#pragma unroll
                    for (int n = 0; n < 2; ++n) acc[a][b][m][n] = (f32x4){z_, z_, z_, z_}; }
        cur = nxt; cB = nB; ++ui;
        if (wr == 1) PG8_BAR;
    }
    PG8_WAIT_V(0);
    PG8_BAR;
#undef PG8_SA
#undef PG8_SB
#undef PG8_STAGE_A
#undef PG8_STAGE_B
#undef PG8_LDA
#undef PG8_LDB
#undef PG8_MMA
#undef PG8_WAIT_V
#undef PG8_WAIT_L
#undef PG8_BAR
#undef PG8_SCHED
#undef PG8_AOFFS
}
}

struct Args { const float* in[27]; float* out; unsigned char* ws; int ph_lo, ph_hi; };
struct Frame {
    ldsp_t lds; int tid, lane, wave, wave0, G, bid;
    const Args* pa; float* out; unsigned char* ws;
    const Args* pa0; float* out0; unsigned char* ws0;
};
enum { I_X = 0, I_C, I_CTX, I_CCTX, I_WMOD, I_BMOD, I_GMIX, I_GFFN, I_GFINAL, I_WIN, I_WOUT, I_CONVW, I_CONVB, I_RGWA, I_RGBA, I_RGWX, I_RGBX, I_RGLAM, I_RETDEC,
       I_FW1, I_FW3, I_FW2, I_MROUTER, I_MROUTERB, I_MW1, I_MW3, I_MW2 };

constexpr int TRS = 64 * 65 * 4;
__device__ __forceinline__ void transpose_item(const float* W, int ldw, int k0, int n0, bf16_t* WT, int ldt, int drow0, float scale, LAS float* scr, int lane) {
    float v[16];
#pragma unroll 4
    for (int i0 = 0; i0 < 64; i0 += 16) {
#pragma unroll
        for (int i = 0; i < 16; ++i) v[i] = W[(size_t)(k0 + i0 + i) * ldw + n0 + lane];
#pragma unroll
        for (int i = 0; i < 16; ++i) scr[(i0 + i) * 65 + lane] = v[i]; }
    LDS_WAIT(); asm volatile("" ::: "memory");
    const int c = lane & 7;
#pragma unroll
    for (int j = 0; j < 8; ++j) { const int n = (lane >> 3) + 8 * j; const LAS float* s = scr + (8 * c) * 65 + n;
        u32x4 o; o.x = pk2(s[0 * 65] * scale, s[1 * 65] * scale); o.y = pk2(s[2 * 65] * scale, s[3 * 65] * scale); o.z = pk2(s[4 * 65] * scale, s[5 * 65] * scale); o.w = pk2(s[6 * 65] * scale, s[7 * 65] * scale);
        *(u32x4*)(WT + (size_t)(drow0 + n) * ldt + k0 + 8 * c) = o; }
    LDS_WAIT(); asm volatile("" ::: "memory");
}
__device__ __forceinline__ void conv_up_item(const float* w1, const float* w3, int F, bf16_t* WT, int r, LAS float* scr, int lane) {
    const int per = 16 * (F / 64); const int which = r / per; r -= which * per;
    const int nblk = F / 64, kb = r / nblk, nb = r % nblk, n0 = nb * 64;
    transpose_item(which ? w3 : w1, F, kb * 64, n0, WT, D, (n0 / 128) * 256 + (n0 % 128) + which * 128, 1.0f, scr, lane);
}
__device__ __forceinline__ void phase_convert_small(Frame& F) {
    LAS float* scr = (LAS float*)(F.lds + F.wave * TRS);
    const int gw = F.bid * NWAVES + F.wave, NGW = F.G * NWAVES;
    constexpr int I_IN = 16 * (INW / 64), I_OUT = 16 * (D / 64), I_UP = 2 * 16 * (DFF / 64), I_DN = (DFF / 64) * (D / 64);
    constexpr int NITEMS = 2 * I_IN + 2 * I_OUT + I_UP + I_DN;
    for (int it = gw; it < NITEMS; it += NGW) {
        int r = it;
        if (r < 2 * I_IN) { const int l = r / I_IN; r -= l * I_IN; const int nblk = INW / 64, kb = r / nblk, nb = r % nblk, n0 = nb * 64;
            const float sc = (n0 >= 1536 && n0 < 2048) ? 0.08838834764831845f : 1.0f;
            transpose_item(F.pa->in[I_WIN] + (size_t)l * D * INW, INW, kb * 64, n0, (bf16_t*)(F.ws + WS_WIN) + (size_t)l * INW * D, D, n0, sc, scr, F.lane); continue; }
        r -= 2 * I_IN;
        if (r < 2 * I_OUT) { const int l = r / I_OUT; r -= l * I_OUT; const int nblk = D / 64, kb = r / nblk, nb = r % nblk;
            transpose_item(F.pa->in[I_WOUT] + (size_t)l * D * D, D, kb * 64, nb * 64, (bf16_t*)(F.ws + WS_WOUT) + (size_t)l * D * D, D, nb * 64, 1.0f, scr, F.lane); continue; }
        r -= 2 * I_OUT;
        if (r < I_UP) { conv_up_item(F.pa->in[I_FW1], F.pa->in[I_FW3], DFF, (bf16_t*)(F.ws + WS_WUP), r, scr, F.lane); continue; }
        r -= I_UP;
        { const int nblk = D / 64, kb = r / nblk, nb = r % nblk; transpose_item(F.pa->in[I_FW2], D, kb * 64, nb * 64, (bf16_t*)(F.ws + WS_WDN), DFF, nb * 64, 1.0f, scr, F.lane); }
    }
    { const int gt = F.bid * NTHREADS + F.tid, NGT = F.G * NTHREADS; bf16_t* o = (bf16_t*)(F.ws + WS_RGW);
      for (int i = gt; i < 2 * 2 * 2 * 8 * 64 * 64; i += NGT) { const int c = i & 63, dp = (i >> 6) & 63, blk = (i >> 12) & 7, gate = (i >> 15) & 1, dir = (i >> 16) & 1, l = i >> 17;
          const float* src = gate ? F.pa->in[I_RGWX] : F.pa->in[I_RGWA]; o[i] = (bf16_t)f2bf(src[((((size_t)l * 2 + dir) * 8 + blk) * 64 + c) * 64 + dp]); } }
    { const int gt = F.bid * NTHREADS + F.tid, NGT = F.G * NTHREADS; float* ct = (float*)(F.ws + WS_ROPE); float* st = ct + 4096 * 64;
      for (int i = gt; i < 4096 * 64; i += NGT) { const int pos = i >> 6, fi = i & 63; const float p = (float)((fi < 32) ? (pos >> 6) : (pos & 63));
          const float inv = powf(10000.0f, -(float)(fi & 31) / 32.0f); const float ang = p * inv;
          const double a = (double)ang; const double kq = __builtin_rint(a * 0.63661977236758134308); const double rr = a - kq * 1.57079632679489661923; const int q = ((int)kq) & 3;
          const double r2 = rr * rr;
          const double sn = rr * (1.0 + r2 * (-1.0 / 6 + r2 * (1.0 / 120 + r2 * (-1.0 / 5040 + r2 * (1.0 / 362880 + r2 * (-1.0 / 39916800))))));
          const double cs = 1.0 + r2 * (-0.5 + r2 * (1.0 / 24 + r2 * (-1.0 / 720 + r2 * (1.0 / 40320 + r2 * (-1.0 / 3628800 + r2 * (1.0 / 479001600))))));
          const double c_ = (q == 0) ? cs : (q == 1) ? -sn : (q == 2) ? -cs : sn; const double s_ = (q == 0) ? sn : (q == 1) ? cs : (q == 2) ? -sn : -cs;
          ct[i] = (float)c_; st[i] = (float)s_; } }
}
__device__ __forceinline__ void phase_convert_moe(Frame& F) {
    LAS float* scr = (LAS float*)(F.lds + F.wave * TRS);
    const int gw = F.bid * NWAVES + F.wave, NGW = F.G * NWAVES;
    constexpr int I_UP = 2 * 16 * (DEXP / 64), I_DN = (DEXP / 64) * (D / 64), PER_E = I_UP + I_DN;
    for (int it = gw; it < NE * PER_E; it += NGW) {
        const int e = it / PER_E; int r = it - e * PER_E;
        if (r < I_UP) { conv_up_item(F.pa->in[I_MW1] + (size_t)e * D * DEXP, F.pa->in[I_MW3] + (size_t)e * D * DEXP, DEXP, (bf16_t*)(F.ws + WS_MOEUP) + (size_t)e * 2 * DEXP * D, r, scr, F.lane); continue; }
        r -= I_UP;
        { const int nblk = D / 64, kb = r / nblk, nb = r % nblk; transpose_item(F.pa->in[I_MW2] + (size_t)e * DEXP * D, D, kb * 64, nb * 64, (bf16_t*)(F.ws + WS_MOEDN) + (size_t)e * D * DEXP, DEXP, nb * 64, 1.0f, scr, F.lane); }
    }
}
__device__ __forceinline__ void phase_mod(Frame& F) {
    LAS float* sc = (LAS float*)F.lds;
    LAS float* red = (LAS float*)(F.lds + 9 * 1024 * 4);
    for (int i = F.tid; i < 9 * 1024; i += NTHREADS) { const int r = i >> 10, k = i & 1023; const float v = (r < 8) ? F.pa->in[I_C][r * 1024 + k] : F.pa->in[I_CCTX][k]; sc[i] = v / (1.0f + __expf(-v)); }
    __syncthreads();
    for (int strip = F.bid; strip < 2 * 6144 / 64; strip += F.G) {
        const int l = strip / 96, j = (strip % 96) * 64 + F.lane;
        const float* w = F.pa->in[I_WMOD] + (size_t)l * 1024 * 6144 + j;
        float a[9];
#pragma unroll
        for (int r = 0; r < 9; ++r) a[r] = 0.f;
        const int k0 = F.wave * 128;
#pragma unroll 4
        for (int k = k0; k < k0 + 128; ++k) { const float wv = w[(size_t)k * 6144];
#pragma unroll
            for (int r = 0; r < 9; ++r) a[r] += sc[r * 1024 + k] * wv; }
#pragma unroll
        for (int r = 0; r < 9; ++r) red[(F.wave * 9 + r) * 64 + F.lane] = a[r];
        __syncthreads();
        for (int i = F.tid; i < 9 * 64; i += NTHREADS) { const int r = i >> 6, jj = i & 63; float s = 0.f;
#pragma unroll
            for (int w8 = 0; w8 < 8; ++w8) s += red[(w8 * 9 + r) * 64 + jj];
            const int col = (strip % 96) * 64 + jj; s += F.pa->in[I_BMOD][l * 6144 + col];
            if (r < 8) ((float*)(F.ws + WS_MODLAT))[((size_t)l * 8 + r) * 6144 + col] = s; else ((float*)(F.ws + WS_MODCTX))[(size_t)l * 6144 + col] = s; }
        __syncthreads();
    }
}

__device__ __forceinline__ void norm_row(const bf16_t* xrow, const float* g, const float* shift, const float* scale, bf16_t* orow, int lane, f32x4 (&y)[4]) {
    const u32x2* xr = (const u32x2*)xrow + lane; f32x4 v[4]; float ss = 0.f;
#pragma unroll
    for (int j = 0; j < 4; ++j) { const u32x2 w = xr[64 * j]; v[j] = (f32x4){bf2f(w.x & 0xffffu), __uint_as_float(w.x & 0xffff0000u), bf2f(w.y & 0xffffu), __uint_as_float(w.y & 0xffff0000u)};
        ss += (v[j].x * v[j].x + v[j].y * v[j].y) + (v[j].z * v[j].z + v[j].w * v[j].w); }
    const float rstd = 1.0f / sqrtf(wave_sum(ss) * (1.0f / D) + EPS);
    u32x2* o8 = (u32x2*)orow + lane;
#pragma unroll
    for (int j = 0; j < 4; ++j) { const f32x4 gg = ((const f32x4*)g)[lane + 64 * j], sh = ((const f32x4*)shift)[lane + 64 * j], sl = ((const f32x4*)scale)[lane + 64 * j];
        y[j] = (v[j] * rstd) * gg * (sl + 1.0f) + sh;
        u32x2 w; w.x = pk2(y[j].x, y[j].y); w.y = pk2(y[j].z, y[j].w); o8[64 * j] = w; }
}
struct SlabRed { const float* slab; int S; const float* gate; const float* xold; float* xnew; };
__device__ __forceinline__ void norm_row_v(f32x4 (&v)[4], const float* g, const float* shift, const float* scale, bf16_t* orow, int lane) {
    float ss = 0.f;
#pragma unroll
    for (int j = 0; j < 4; ++j) ss += (v[j].x * v[j].x + v[j].y * v[j].y) + (v[j].z * v[j].z + v[j].w * v[j].w);
    const float rstd = 1.0f / sqrtf(wave_sum(ss) * (1.0f / D) + EPS);
    u32x2* o8 = (u32x2*)orow + lane;
#pragma unroll
    for (int j = 0; j < 4; ++j) { const f32x4 gg = ((const f32x4*)g)[lane + 64 * j], sh = ((const f32x4*)shift)[lane + 64 * j], sl = ((const f32x4*)scale)[lane + 64 * j];
        const f32x4 y = (v[j] * rstd) * gg * (sl + 1.0f) + sh;
        u32x2 w; w.x = pk2(y.x, y.y); w.y = pk2(y.z, y.w); o8[64 * j] = w; }
}
__device__ __forceinline__ void phase_norm(Frame& F, int l, int sel, const float* xlat, const bf16_t* xb, const float* xctx, int nrows, const SlabRed sr) {
    const int gw = F.bid * NWAVES + F.wave, NGW = F.G * NWAVES;
    const float* g = (sel ? F.pa->in[I_GFFN] : F.pa->in[I_GMIX]) + l * D; const int so = sel ? 3072 : 0;
    bf16_t* HX = (bf16_t*)(F.ws + WS_HX);
    for (int row = gw; row < nrows; row += NGW) {
        const bool lat = row < NLAT;
        const float* mod = lat ? (const float*)(F.ws + WS_MODLAT) + ((size_t)l * 8 + row / SEQ) * 6144 : (const float*)(F.ws + WS_MODCTX) + (size_t)l * 6144;
        f32x4 v[4];
        if (lat && xb) { const u32x2* xr = (const u32x2*)(xb + (size_t)row * D) + F.lane;
#pragma unroll
            for (int j = 0; j < 4; ++j) { const u32x2 w = xr[64 * j]; v[j] = (f32x4){bf2f(w.x & 0xffffu), __uint_as_float(w.x & 0xffff0000u), bf2f(w.y & 0xffffu), __uint_as_float(w.y & 0xffff0000u)}; } }
        else if (lat || sr.slab == nullptr) { const f32x4* xr = (const f32x4*)(lat ? xlat + (size_t)row * D : xctx + (size_t)(row - NLAT) * D) + F.lane;
#pragma unroll
            for (int j = 0; j < 4; ++j) v[j] = xr[64 * j]; }
        else { const int rc = row - NLAT, pmr = rc >> 8, r = rc & 255;
#pragma unroll
            for (int j = 0; j < 4; ++j) { f32x4 a = zero4(); const float* sp = sr.slab + (size_t)((pmr + 8 * j) * sr.S) * 65536 + (size_t)r * 256 + 4 * F.lane;
                for (int q = 0; q < sr.S; ++q) a += *(const f32x4*)(sp + (size_t)q * 65536);
                v[j] = ((const f32x4*)(sr.xold + (size_t)rc * D))[F.lane + 64 * j] + ((const f32x4*)sr.gate)[F.lane + 64 * j] * a;
                ((f32x4*)(sr.xnew + (size_t)rc * D))[F.lane + 64 * j] = v[j]; } }
        norm_row_v(v, g, mod + so, mod + so + 1024, HX + (size_t)row * D, F.lane);
    }
}
__device__ __forceinline__ void moe_reduce(Frame& F, int k) {
    const int* meta = (const int*)(F.ws + MOE_META) + 9 * k; const int npan = meta[8], gsz = npan - 128;
    if (gsz <= 0) return;
    const int S = pg8::split_factor(npan * 4, F.G, DEXP / 64, MAXSLAB_M); if (S < 2) return;
    const int gw = F.bid * NWAVES + F.wave, NGW = F.G * NWAVES;
    const int* ptok = (const int*)(F.ws + MOE_PTOK) + k * MROWS; const float* pw = (const float*)(F.ws + MOE_PW) + k * MROWS;
    const float* slab = (const float*)(F.ws + WS_SLABM); const float* gate_lat = (const float*)(F.ws + WS_MODLAT) + (size_t)8 * 6144 + 5120;
    for (int rr = NLAT + gw; rr < npan * 256; rr += NGW) { const int tok = ptok[rr]; if (tok < 0) continue; const float w = pw[rr];
        const int pmr = (rr - NLAT) >> 8, r = rr & 255; u32x2* xr = (u32x2*)((bf16_t*)((char*)F.out + XB_OFF) + (size_t)tok * D); const f32x4* gt = (const f32x4*)(gate_lat + (size_t)(tok / SEQ) * 6144);
#pragma unroll
        for (int j = 0; j < 4; ++j) { f32x4 a = zero4(); const float* sp = slab + (size_t)((pmr + gsz * j) * S) * 65536 + (size_t)r * 256 + 4 * F.lane;
            for (int q = 0; q < S; ++q) a += *(const f32x4*)(sp + (size_t)q * 65536);
            const u32x2 xo = xr[F.lane + 64 * j]; const f32x4 xv = {bf2f(xo.x & 0xffffu), __uint_as_float(xo.x & 0xffff0000u), bf2f(xo.y & 0xffffu), __uint_as_float(xo.y & 0xffff0000u)};
            const f32x4 y = xv + (gt[F.lane + 64 * j] * w) * a; xr[F.lane + 64 * j] = (u32x2){pk2(y.x, y.y), pk2(y.z, y.w)}; } }
}
__device__ __forceinline__ void phase_norm_router(Frame& F, const bf16_t* xb) {
    constexpr int l = 1;
    LAS float* wr = (LAS float*)F.lds;
    LAS int* le = (LAS int*)(F.lds + 32768);
    for (int i = F.tid; i < 1024 * 8 / 4; i += NTHREADS) ((LAS f32x4*)wr)[i] = ((const f32x4*)F.pa->in[I_MROUTER])[i];
    __syncthreads();
    const float* g = F.pa->in[I_GFFN] + l * D; bf16_t* HX = (bf16_t*)(F.ws + WS_HX);
    int* toke = (int*)(F.ws + MOE_TOKE); float* tokw = (float*)(F.ws + MOE_TOKW);
    for (int wg = F.bid; wg < NLAT / 128; wg += F.G) {
        for (int i = 0; i < 16; ++i) { const int tl = F.wave * 16 + i, row = wg * 128 + tl;
            const float* mod = (const float*)(F.ws + WS_MODLAT) + ((size_t)l * 8 + row / SEQ) * 6144;
            f32x4 y[4]; norm_row(xb + (size_t)row * D, g, mod + 3072, mod + 4096, HX + (size_t)row * D, F.lane, y);
            float lg[8];
#pragma unroll
            for (int e = 0; e < 8; ++e) lg[e] = 0.f;
#pragma unroll
            for (int j = 0; j < 4; ++j)
#pragma unroll
                for (int q = 0; q < 4; ++q) { const int k = 4 * F.lane + 256 * j + q; const f32x4 w0 = *(const LAS f32x4*)(wr + k * 8), w1 = *(const LAS f32x4*)(wr + k * 8 + 4); const float yv = y[j][q];
                    lg[0] += yv * w0.x; lg[1] += yv * w0.y; lg[2] += yv * w0.z; lg[3] += yv * w0.w; lg[4] += yv * w1.x; lg[5] += yv * w1.y; lg[6] += yv * w1.z; lg[7] += yv * w1.w; }
#pragma unroll
            for (int e = 0; e < 8; ++e) lg[e] = wave_sum(lg[e]) + F.pa->in[I_MROUTERB][e];
            int e0 = 0; float v0 = lg[0];
#pragma unroll
            for (int e = 1; e < 8; ++e) if (lg[e] > v0) { v0 = lg[e]; e0 = e; }
            int e1 = -1; float v1 = -3.0e38f;
#pragma unroll
            for (int e = 0; e < 8; ++e) if (e != e0 && lg[e] > v1) { v1 = lg[e]; e1 = e; }
            const float w0 = 1.0f / (1.0f + __expf(v1 - v0));
            if (F.lane == 0) { toke[row] = e0 | (e1 << 8); tokw[2 * row] = w0; tokw[2 * row + 1] = 1.0f - w0; le[tl] = e0 | (e1 << 8); }
        }
        __syncthreads();
        if (F.tid < 16) { const int k = F.tid >> 3, e = F.tid & 7; int c = 0; for (int t = 0; t < 128; ++t) c += (((le[t] >> (8 * k)) & 0xff) == e) ? 1 : 0; ((int*)(F.ws + MOE_CNT))[wg * 16 + F.tid] = c; }
        __syncthreads();
    }
}
__device__ __forceinline__ void phase_moe_sort(Frame& F) {
    LAS int* tot = (LAS int*)F.lds;
    LAS int* pre = tot + 16;
    LAS int* seg = tot + 32;
    LAS int* le = tot + 64;
    const int* cnt = (const int*)(F.ws + MOE_CNT); const int* toke = (const int*)(F.ws + MOE_TOKE); const float* tokw = (const float*)(F.ws + MOE_TOKW);
    int* ptok = (int*)(F.ws + MOE_PTOK); float* pw = (float*)(F.ws + MOE_PW); int* meta = (int*)(F.ws + MOE_META);
    for (int wg = F.bid; wg < NLAT / 128; wg += F.G) {
        if (F.tid < 16) { int t = 0, p = 0; for (int w = 0; w < 256; ++w) { const int c = cnt[w * 16 + F.tid]; t += c; p += (w < wg) ? c : 0; } tot[F.tid] = t; pre[F.tid] = p; }
        if (F.tid >= 64 && F.tid < 192) le[F.tid - 64] = toke[wg * 128 + F.tid - 64];
        __syncthreads();
        if (F.tid < 2) { int s = 0; for (int e = 0; e < 8; ++e) { seg[F.tid * 9 + e] = s; s += (tot[F.tid * 8 + e] + 255) & ~255; } seg[F.tid * 9 + 8] = s; }
        __syncthreads();
        if (F.tid < 256) { const int k = F.tid >> 7, t = F.tid & 127; const int e = (le[t] >> (8 * k)) & 0xff; int rank = 0; for (int u = 0; u < t; ++u) rank += (((le[u] >> (8 * k)) & 0xff) == e) ? 1 : 0;
            const int pos = seg[k * 9 + e] + pre[k * 8 + e] + rank; const int tok = wg * 128 + t; ptok[k * MROWS + pos] = tok; pw[k * MROWS + pos] = tokw[2 * tok + k]; ((int*)(F.ws + MOE_PPOS))[k * NLAT + tok] = pos; }
        if (wg < 16) { const int k = wg >> 3, e = wg & 7; const int a = seg[k * 9 + e] + tot[k * 8 + e], b = seg[k * 9 + e + 1]; for (int p = a + F.tid; p < b; p += NTHREADS) { ptok[k * MROWS + p] = -1; pw[k * MROWS + p] = 0.f; } }
        if (wg == 0 && F.tid < 18) meta[F.tid] = seg[F.tid] >> 8;
        __syncthreads();
    }
}
__device__ __forceinline__ void phase_final_a(Frame& F) {
    const int gw = F.bid * NWAVES + F.wave, NGW = F.G * NWAVES; const float* g = F.pa->in[I_GFINAL];
    const bf16_t* xb = (const bf16_t*)((const char*)F.out + XB_OFF); bf16_t* xc = (bf16_t*)(F.ws + WS_XCOPY);
    const int* meta = (const int*)(F.ws + MOE_META) + 9; const int npan = meta[8], gsz = npan - 128;
    const int S = (gsz > 0) ? pg8::split_factor(npan * 4, F.G, DEXP / 64, MAXSLAB_M) : 1;
    const int* ppos = (const int*)(F.ws + MOE_PPOS) + NLAT; const float* pw = (const float*)(F.ws + MOE_PW) + MROWS;
    const float* slab = (const float*)(F.ws + WS_SLABM); const float* gate_lat = (const float*)(F.ws + WS_MODLAT) + (size_t)8 * 6144 + 5120;
    for (int row = gw; row < NLAT; row += NGW) {
        const u32x2* xr = (const u32x2*)(xb + (size_t)row * D) + F.lane; f32x4 v[4];
#pragma unroll
        for (int j = 0; j < 4; ++j) { const u32x2 w = xr[64 * j]; v[j] = (f32x4){bf2f(w.x & 0xffffu), __uint_as_float(w.x & 0xffff0000u), bf2f(w.y & 0xffffu), __uint_as_float(w.y & 0xffff0000u)}; }
        const int rr = ppos[row];
        if (S >= 2 && rr >= NLAT) { const float w = pw[rr]; const int pmr = (rr - NLAT) >> 8, r = rr & 255; const f32x4* gt = (const f32x4*)(gate_lat + (size_t)(row / SEQ) * 6144);
#pragma unroll
            for (int j = 0; j < 4; ++j) { f32x4 a = zero4(); const float* sp = slab + (size_t)((pmr + gsz * j) * S) * 65536 + (size_t)r * 256 + 4 * F.lane;
                for (int q = 0; q < S; ++q) a += *(const f32x4*)(sp + (size_t)q * 65536);
                v[j] += (gt[F.lane + 64 * j] * w) * a; } }
        if (row < NLAT / 2) { float ss = 0.f;
#pragma unroll
            for (int j = 0; j < 4; ++j) ss += (v[j].x * v[j].x + v[j].y * v[j].y) + (v[j].z * v[j].z + v[j].w * v[j].w);
            const float rstd = 1.0f / sqrtf(wave_sum(ss) * (1.0f / D) + EPS); f32x4* o = (f32x4*)(F.out + (size_t)row * D) + F.lane;
#pragma unroll
            for (int j = 0; j < 4; ++j) o[64 * j] = (v[j] * rstd) * ((const f32x4*)g)[F.lane + 64 * j]; }
        else { u32x2* o = (u32x2*)(xc + (size_t)(row - NLAT / 2) * D) + F.lane;
#pragma unroll
            for (int j = 0; j < 4; ++j) o[64 * j] = (u32x2){pk2(v[j].x, v[j].y), pk2(v[j].z, v[j].w)}; }
    }
}
__device__ __forceinline__ void phase_final_b(Frame& F) {
    const int gw = F.bid * NWAVES + F.wave, NGW = F.G * NWAVES; const float* g = F.pa->in[I_GFINAL]; const bf16_t* xc = (const bf16_t*)(F.ws + WS_XCOPY);
    for (int row = NLAT / 2 + gw; row < NLAT; row += NGW) {
        const u32x2* xr = (const u32x2*)(xc + (size_t)(row - NLAT / 2) * D) + F.lane; f32x4 v[4]; float ss = 0.f;
#pragma unroll
        for (int j = 0; j < 4; ++j) { const u32x2 w = xr[64 * j]; v[j] = (f32x4){bf2f(w.x & 0xffffu), __uint_as_float(w.x & 0xffff0000u), bf2f(w.y & 0xffffu), __uint_as_float(w.y & 0xffff0000u)};
            ss += (v[j].x * v[j].x + v[j].y * v[j].y) + (v[j].z * v[j].z + v[j].w * v[j].w); }
        const float rstd = 1.0f / sqrtf(wave_sum(ss) * (1.0f / D) + EPS); f32x4* o = (f32x4*)(F.out + (size_t)row * D) + F.lane;
#pragma unroll
        for (int j = 0; j < 4; ++j) o[64 * j] = (v[j] * rstd) * ((const f32x4*)g)[F.lane + 64 * j];
    }
}

__device__ __forceinline__ bool fresh(Frame& F) {
    int l_ = (int)__builtin_amdgcn_mbcnt_hi(~0u, __builtin_amdgcn_mbcnt_lo(~0u, 0u)); asm volatile("" : "+v"(l_));
    int w_ = F.wave0; asm volatile("" : "+s"(w_));
    F.lane = l_; F.wave = w_; F.tid = w_ * 64 + l_;
    int b_ = blockIdx.x; asm volatile("" : "+s"(b_)); F.bid = b_;
    GAS unsigned char* w2_ = (GAS unsigned char*)F.ws0; asm volatile("" : "+s"(w2_)); F.ws = (unsigned char*)w2_;
    F.out = F.out0; F.pa = F.pa0;
    return true;
}
struct Item { int b, s, row0, seqbase, t0, seqlen; bool is_ctx; };
__device__ __forceinline__ Item item_info(int item) {
    Item it; it.b = item / SPB; it.s = item % SPB;
    if (it.s < 2) { it.is_ctx = true; it.seqbase = NLAT + it.b * CTXL; it.t0 = it.s * CHK; it.seqlen = CTXL; }
    else { it.is_ctx = false; it.seqbase = it.b * SEQ; it.t0 = (it.s - 2) * CHK; it.seqlen = SEQ; }
    it.row0 = it.seqbase + it.t0; return it;
}
constexpr int UCP = 144;
constexpr int TP = 272;
constexpr int TILEB = 128 * TP;
constexpr int VP = 288;
constexpr int TILEV = 128 * VP;

__device__ __forceinline__ unsigned tr_lane_addr(ldsp_t tile, int lane) { return (unsigned)(__SIZE_TYPE__)tile + (unsigned)((4 * (lane >> 4) + ((lane & 15) >> 2)) * VP + 8 * (lane & 3)); }
__device__ __forceinline__ bf16x8 mk_frag(u32x2 lo, u32x2 hi) { const u32x4 v = {lo.x, lo.y, hi.x, hi.y}; return __builtin_bit_cast(bf16x8, v); }
template <int OFF> __device__ __forceinline__ bf16x8 tr1(unsigned addr) {
    u32x2 a0, a1;
    asm volatile("ds_read_b64_tr_b16 %0, %2 offset:%3\n\tds_read_b64_tr_b16 %1, %2 offset:%4\n\ts_waitcnt lgkmcnt(0)" : "=&v"(a0), "=&v"(a1) : "v"(addr), "i"(OFF), "i"(OFF + 16 * VP) : "memory");
    return mk_frag(a0, a1);
}
template <int OFF> __device__ __forceinline__ void tr4(unsigned addr, bf16x8& f0, bf16x8& f1, bf16x8& f2, bf16x8& f3) {
    u32x2 a0, a1, b0, b1, c0, c1, d0, d1;
    asm volatile("ds_read_b64_tr_b16 %0, %8 offset:%9\n\tds_read_b64_tr_b16 %1, %8 offset:%10\n\tds_read_b64_tr_b16 %2, %8 offset:%11\n\tds_read_b64_tr_b16 %3, %8 offset:%12\n\t"
                 "ds_read_b64_tr_b16 %4, %8 offset:%13\n\tds_read_b64_tr_b16 %5, %8 offset:%14\n\tds_read_b64_tr_b16 %6, %8 offset:%15\n\tds_read_b64_tr_b16 %7, %8 offset:%16\n\ts_waitcnt lgkmcnt(0)"
                 : "=&v"(a0), "=&v"(a1), "=&v"(b0), "=&v"(b1), "=&v"(c0), "=&v"(c1), "=&v"(d0), "=&v"(d1)
                 : "v"(addr), "i"(OFF), "i"(OFF + 16 * VP), "i"(OFF + 32), "i"(OFF + 32 + 16 * VP), "i"(OFF + 64), "i"(OFF + 64 + 16 * VP), "i"(OFF + 96), "i"(OFF + 96 + 16 * VP) : "memory");
    f0 = mk_frag(a0, a1); f1 = mk_frag(b0, b1); f2 = mk_frag(c0, c1); f3 = mk_frag(d0, d1);
}

__device__ __forceinline__ void build_decay(Frame& F, int l) {
    LAS float* dec = (LAS float*)(F.lds + LDS_DEC);
    for (int i = F.tid; i < 2 * 4 * 132; i += NTHREADS) { const int n = i % 132, dh = i / 132; const float x = F.pa->in[I_RETDEC][l * 8 + dh]; const float lg = -log1pf(expf(-x)); dec[i] = expf((float)n * lg); }
}

struct RgStep { bf16x8 bwa[2], bwx[2]; float lam, ba, bx, carry; };
template <bool FINAL>
__device__ __forceinline__ void rg_load_step(RgStep& R, Frame& F, const bf16_t* wgt, int l, int dir, int item, int blk, int n, int lane) {
    const int fr = lane & 15, fq = lane >> 4;
    const bf16_t* wa = wgt + ((size_t)(0 * 8 + blk) * 64 + 16 * n + fr) * 64 + 8 * fq;
    const bf16_t* wx = wgt + ((size_t)(1 * 8 + blk) * 64 + 16 * n + fr) * 64 + 8 * fq;
    R.bwa[0] = *(const bf16x8*)wa; R.bwa[1] = *(const bf16x8*)(wa + 32); R.bwx[0] = *(const bf16x8*)wx; R.bwx[1] = *(const bf16x8*)(wx + 32);
    const int ch = blk * 64 + 16 * n + fr, pi = (l * 2 + dir) * 512 + ch;
    R.lam = F.pa->in[I_RGLAM][pi]; R.ba = F.pa->in[I_RGBA][pi]; R.bx = F.pa->in[I_RGBX][pi];
    R.carry = FINAL ? ((const float*)(F.ws + WS_CARRY))[((size_t)item * 2 + dir) * 512 + ch] : 0.f;
}
template <bool FINAL, int DIR>
__device__ __forceinline__ void rg_dir(ldsp_t ucw, const bf16x8 (&af)[8][2], const RgStep& R, int n, int lane, f32x4 (&hsum)[8], float& Atot, float& Htot) {
    const int fr = lane & 15, fq = lane >> 4;
    constexpr float L2E_ = 1.4426950408889634f;
    const float ba2 = -L2E_ * R.ba, bx2 = -L2E_ * R.bx, cl2 = -8.0f * L2E_ * log1pf(expf(-R.lam)), carry = R.carry;
    const bf16x8 bwa[2] = {R.bwa[0], R.bwa[1]}, bwx[2] = {R.bwx[0], R.bwx[1]};
    f32x4 ar[8], ai[8];
#pragma unroll
    for (int m = 0; m < 8; ++m) { ar[m] = zero4(); ai[m] = zero4(); }
#pragma unroll
    for (int m = 0; m < 8; ++m)
#pragma unroll
        for (int ks = 0; ks < 2; ++ks) { ar[m] = __builtin_amdgcn_mfma_f32_16x16x32_bf16(af[m][ks], bwa[ks], ar[m], 0, 0, 0); ai[m] = __builtin_amdgcn_mfma_f32_16x16x32_bf16(af[m][ks], bwx[ks], ai[m], 0, 0, 0); }
    const unsigned uo = (unsigned)(32 * fq * UCP + (16 * n + fr) * 2);
#pragma unroll
    for (int m = 0; m < 8; ++m)
#pragma unroll
        for (int jj = 0; jj < 4; ++jj) {
            const float r = __builtin_amdgcn_rcpf(1.0f + __builtin_amdgcn_exp2f(__builtin_fmaf(ar[m][jj], -1.4426950408889634f, ba2)));
            const float ig = __builtin_amdgcn_rcpf(1.0f + __builtin_amdgcn_exp2f(__builtin_fmaf(ai[m][jj], -1.4426950408889634f, bx2)));
            const float a = __builtin_amdgcn_exp2f(cl2 * r);
            const float u = bf2f(*(const LAS bf16_t*)(ucw + uo + (4 * m + jj) * UCP));
            ar[m][jj] = a; ai[m][jj] = __builtin_amdgcn_sqrtf(__builtin_fmaf(-a, a, 1.0f)) * ig * u; }
    float gA = 1.f, gH = 0.f;
#pragma unroll
    for (int mm = 0; mm < 8; ++mm) { const int m = DIR ? 7 - mm : mm;
#pragma unroll
        for (int j4 = 0; j4 < 4; ++j4) { const int jj = DIR ? 3 - j4 : j4; gH = __builtin_fmaf(ar[m][jj], gH, ai[m][jj]); gA *= ar[m][jj]; } }
    const float A0 = lane_bcast(gA, fr), H0 = lane_bcast(gH, fr), A1 = lane_bcast(gA, fr + 16), H1 = lane_bcast(gH, fr + 16), A2 = lane_bcast(gA, fr + 32), H2 = lane_bcast(gH, fr + 32), A3 = lane_bcast(gA, fr + 48), H3 = lane_bcast(gH, fr + 48);
    if (FINAL) { float h = carry;
        if (!DIR) { if (fq > 0) h = A0 * h + H0; if (fq > 1) h = A1 * h + H1; if (fq > 2) h = A2 * h + H2; }
        else { if (fq < 3) h = A3 * h + H3; if (fq < 2) h = A2 * h + H2; if (fq < 1) h = A1 * h + H1; }
#pragma unroll
        for (int mm = 0; mm < 8; ++mm) { const int m = DIR ? 7 - mm : mm;
#pragma unroll
            for (int j4 = 0; j4 < 4; ++j4) { const int jj = DIR ? 3 - j4 : j4; h = __builtin_fmaf(ar[m][jj], h, ai[m][jj]); hsum[m][jj] += h; } } }
    if (!DIR) Htot = A3 * (A2 * (A1 * H0 + H1) + H2) + H3; else Htot = A0 * (A1 * (A2 * H3 + H2) + H1) + H0;
    Atot = (A0 * A1) * (A2 * A3);
}
template <bool FINAL>
__device__ __forceinline__ void rg_part(Frame& F, int l, int item, const Item& it, const int blk, const int n0, const int n1) {
    const bf16_t* P = (const bf16_t*)(F.ws + WS_PA);
    int lane = F.lane;
    ldsp_t ucw = F.lds + F.wave * (128 * UCP);
    { const int grp = lane & 7, ch0 = blk * 64 + grp * 8; float cw[4][8], cb[8];
#pragma unroll
      for (int k = 0; k < 4; ++k)
#pragma unroll
          for (int i = 0; i < 8; ++i) cw[k][i] = F.pa->in[I_CONVW][((size_t)l * 4 + k) * 512 + ch0 + i];
#pragma unroll
      for (int i = 0; i < 8; ++i) cb[i] = F.pa->in[I_CONVB][l * 512 + ch0 + i];
      const bf16_t* Pu = P + (size_t)it.seqbase * INW + ch0;
#pragma unroll 8
      for (int q = 0; q < 16; ++q) { const int token = (lane >> 3) + 8 * q; float o[8];
#pragma unroll
          for (int i = 0; i < 8; ++i) o[i] = cb[i];
#pragma unroll
          for (int k = 0; k < 4; ++k) { const int tt = it.t0 + token + k - 2; const int tc = tt < 0 ? 0 : (tt >= it.seqlen ? it.seqlen - 1 : tt);
              u32x4 v = ldg<u32x4>(Pu, (unsigned)tc * (unsigned)(INW * 2)); if (tt != tc) v = (u32x4){0u, 0u, 0u, 0u};
              o[0] += cw[k][0] * bf2f(v.x & 0xffffu); o[1] += cw[k][1] * __uint_as_float(v.x & 0xffff0000u); o[2] += cw[k][2] * bf2f(v.y & 0xffffu); o[3] += cw[k][3] * __uint_as_float(v.y & 0xffff0000u);
              o[4] += cw[k][4] * bf2f(v.z & 0xffffu); o[5] += cw[k][5] * __uint_as_float(v.z & 0xffff0000u); o[6] += cw[k][6] * bf2f(v.w & 0xffffu); o[7] += cw[k][7] * __uint_as_float(v.w & 0xffff0000u); }
          u32x4 w; w.x = pk2(o[0], o[1]); w.y = pk2(o[2], o[3]); w.z = pk2(o[4], o[5]); w.w = pk2(o[6], o[7]);
          *(LAS u32x4*)(ucw + token * UCP + grp * 16) = w; }
      LDS_WAIT(); asm volatile("" ::: "memory"); }
    asm volatile("" : "+v"(lane));
    bf16x8 af[8][2];
    { const int fr = lane & 15, fq = lane >> 4;
#pragma unroll
      for (int m = 0; m < 8; ++m)
#pragma unroll
          for (int ks = 0; ks < 2; ++ks) af[m][ks] = *(const LAS bf16x8*)(ucw + (32 * (fr >> 2) + 4 * m + (fr & 3)) * UCP + (8 * fq + 32 * ks) * 2); }
    const bf16_t* wg0 = (const bf16_t*)(F.ws + WS_RGW) + (size_t)(l * 2 + 0) * 2 * 8 * 4096;
    const bf16_t* wg1 = (const bf16_t*)(F.ws + WS_RGW) + (size_t)(l * 2 + 1) * 2 * 8 * 4096;
    float* TOT = (float*)(F.ws + WS_TOT);
    RgStep R0, R1;
    rg_load_step<FINAL>(R0, F, wg0, l, 0, item, blk, n0, lane);
#pragma unroll 1
    for (int n = n0; n < n1; ++n) { asm volatile("" : "+v"(lane));
        const int fr = lane & 15, fq = lane >> 4; const int ch = blk * 64 + 16 * n + fr;
        f32x4 hsum[8];
#pragma unroll
        for (int m = 0; m < 8; ++m) hsum[m] = zero4();
        rg_load_step<FINAL>(R1, F, wg1, l, 1, item, blk, n, lane);
        { float At, Ht;
          rg_dir<FINAL, 0>(ucw, af, R0, n, lane, hsum, At, Ht);
          if (!FINAL && fq == 0) { *(f32x2*)(TOT + (((size_t)item * 2 + 0) * 512 + ch) * 2) = (f32x2){At, Ht}; } }
        __builtin_amdgcn_sched_barrier(0);
        if (n + 1 < n1) rg_load_step<FINAL>(R0, F, wg0, l, 0, item, blk, n + 1, lane);
        { float At, Ht;
          rg_dir<FINAL, 1>(ucw, af, R1, n, lane, hsum, At, Ht);
          if (!FINAL && fq == 0) { *(f32x2*)(TOT + (((size_t)item * 2 + 1) * 512 + ch) * 2) = (f32x2){At, Ht}; } }
        if (FINAL) {
            const unsigned uo = (unsigned)(32 * fq * UCP + (16 * n + fr) * 2);
#pragma unroll
            for (int m = 0; m < 8; ++m)
#pragma unroll
                for (int jj = 0; jj < 4; ++jj) *(LAS bf16_t*)(ucw + uo + (4 * m + jj) * UCP) = (bf16_t)f2bf(hsum[m][jj]); }
    }
    if (FINAL) {
        LDS_WAIT(); asm volatile("" : "+v"(lane) :: "memory");
        const int ng = 2 * (n1 - n0);
        const int grp = 2 * n0 + ((ng == 8) ? (lane & 7) : (lane & 1)); const int tk0 = (ng == 8) ? (lane >> 3) : (lane >> 1), tstep = (ng == 8) ? 8 : 32, nq = (ng == 8) ? 16 : 4;
        const bf16_t* Pg = P + (size_t)it.row0 * INW + 512 + blk * 64 + grp * 8; bf16_t* Yo = (bf16_t*)(F.ws + WS_Y) + (size_t)it.row0 * D + blk * 64 + grp * 8;
#pragma unroll 8
        for (int q = 0; q < nq; ++q) { const int token = tk0 + tstep * q;
            const u32x4 hv = *(const LAS u32x4*)(ucw + token * UCP + grp * 16); const u32x4 gv = ldg<u32x4>(Pg, (unsigned)token * (unsigned)(INW * 2));
            u32x4 w;
            w.x = pk2(gelu_tanh(bf2f(gv.x & 0xffffu)) * bf2f(hv.x & 0xffffu), gelu_tanh(__uint_as_float(gv.x & 0xffff0000u)) * __uint_as_float(hv.x & 0xffff0000u));
            w.y = pk2(gelu_tanh(bf2f(gv.y & 0xffffu)) * bf2f(hv.y & 0xffffu), gelu_tanh(__uint_as_float(gv.y & 0xffff0000u)) * __uint_as_float(hv.y & 0xffff0000u));
            w.z = pk2(gelu_tanh(bf2f(gv.z & 0xffffu)) * bf2f(hv.z & 0xffffu), gelu_tanh(__uint_as_float(gv.z & 0xffff0000u)) * __uint_as_float(hv.z & 0xffff0000u));
            w.w = pk2(gelu_tanh(bf2f(gv.w & 0xffffu)) * bf2f(hv.w & 0xffffu), gelu_tanh(__uint_as_float(gv.w & 0xffff0000u)) * __uint_as_float(hv.w & 0xffff0000u));
            stg<u32x4>(Yo, (unsigned)token * (unsigned)(D * 2), w); }
        LDS_WAIT();
    }
}

__device__ __forceinline__ void stage_rows(Frame& F, ldsp_t dst, const Item& it, int col0, bool rope) {
    const bf16_t* P = (const bf16_t*)(F.ws + WS_PA); const float* ct = (const float*)(F.ws + WS_ROPE); const float* st = ct + 4096 * 64;
    for (int task = F.tid; task < 1024; task += NTHREADS) { const int token = task >> 3, d0 = (task & 7) * 8;
        const bf16_t* src = P + (size_t)(it.row0 + token) * INW + col0;
        const u32x4 lo = *(const u32x4*)(src + d0), hi = *(const u32x4*)(src + d0 + 64);
        u32x4 olo = lo, ohi = hi;
        if (rope) { const int pos = it.t0 + token; const f32x4 c0 = *(const f32x4*)(ct + pos * 64 + d0), c1 = *(const f32x4*)(ct + pos * 64 + d0 + 4), s0 = *(const f32x4*)(st + pos * 64 + d0), s1 = *(const f32x4*)(st + pos * 64 + d0 + 4);
            const float a[8] = {bf2f(lo.x & 0xffffu), __uint_as_float(lo.x & 0xffff0000u), bf2f(lo.y & 0xffffu), __uint_as_float(lo.y & 0xffff0000u), bf2f(lo.z & 0xffffu), __uint_as_float(lo.z & 0xffff0000u), bf2f(lo.w & 0xffffu), __uint_as_float(lo.w & 0xffff0000u)};
            const float b[8] = {bf2f(hi.x & 0xffffu), __uint_as_float(hi.x & 0xffff0000u), bf2f(hi.y & 0xffffu), __uint_as_float(hi.y & 0xffff0000u), bf2f(hi.z & 0xffffu), __uint_as_float(hi.z & 0xffff0000u), bf2f(hi.w & 0xffffu), __uint_as_float(hi.w & 0xffff0000u)};
            const float c[8] = {c0.x, c0.y, c0.z, c0.w, c1.x, c1.y, c1.z, c1.w}, s[8] = {s0.x, s0.y, s0.z, s0.w, s1.x, s1.y, s1.z, s1.w};
            float ra[8], rb[8];
#pragma unroll
            for (int i = 0; i < 8; ++i) { ra[i] = a[i] * c[i] - b[i] * s[i]; rb[i] = a[i] * s[i] + b[i] * c[i]; }
            olo.x = pk2(ra[0], ra[1]); olo.y = pk2(ra[2], ra[3]); olo.z = pk2(ra[4], ra[5]); olo.w = pk2(ra[6], ra[7]);
            ohi.x = pk2(rb[0], rb[1]); ohi.y = pk2(rb[2], rb[3]); ohi.z = pk2(rb[4], rb[5]); ohi.w = pk2(rb[6], rb[7]); }
        *(LAS u32x4*)(dst + token * TP + d0 * 2) = olo; *(LAS u32x4*)(dst + token * TP + (d0 + 64) * 2) = ohi; }
}
__device__ __forceinline__ void stage_cols(Frame& F, ldsp_t dst, const Item& it, int col0) {
    const bf16_t* P = (const bf16_t*)(F.ws + WS_PA);
    for (int task = F.tid; task < 2048; task += NTHREADS) { const int token = task >> 4, d0 = (task & 15) * 8;
        const u32x4 v = *(const u32x4*)(P + (size_t)(it.row0 + token) * INW + col0 + d0);
        const unsigned w[4] = {v.x, v.y, v.z, v.w};
#pragma unroll
        for (int i = 0; i < 4; ++i) { *(LAS bf16_t*)(dst + (d0 + 2 * i) * TP + token * 2) = (bf16_t)(w[i] & 0xffffu); *(LAS bf16_t*)(dst + (d0 + 2 * i + 1) * TP + token * 2) = (bf16_t)(w[i] >> 16); } }
}
__device__ __forceinline__ void rope8(u32x4& lo, u32x4& hi, const float* ct, const float* st, int pos, int d0) {
    const f32x4 c0 = *(const f32x4*)(ct + pos * 64 + d0), c1 = *(const f32x4*)(ct + pos * 64 + d0 + 4), s0 = *(const f32x4*)(st + pos * 64 + d0), s1 = *(const f32x4*)(st + pos * 64 + d0 + 4);
    const float a[8] = {bf2f(lo.x & 0xffffu), __uint_as_float(lo.x & 0xffff0000u), bf2f(lo.y & 0xffffu), __uint_as_float(lo.y & 0xffff0000u), bf2f(lo.z & 0xffffu), __uint_as_float(lo.z & 0xffff0000u), bf2f(lo.w & 0xffffu), __uint_as_float(lo.w & 0xffff0000u)};
    const float b[8] = {bf2f(hi.x & 0xffffu), __uint_as_float(hi.x & 0xffff0000u), bf2f(hi.y & 0xffffu), __uint_as_float(hi.y & 0xffff0000u), bf2f(hi.z & 0xffffu), __uint_as_float(hi.z & 0xffff0000u), bf2f(hi.w & 0xffffu), __uint_as_float(hi.w & 0xffff0000u)};
    const float c[8] = {c0.x, c0.y, c0.z, c0.w, c1.x, c1.y, c1.z, c1.w}, sn[8] = {s0.x, s0.y, s0.z, s0.w, s1.x, s1.y, s1.z, s1.w};
    float ra[8], rb[8];
#pragma unroll
    for (int i = 0; i < 8; ++i) { ra[i] = a[i] * c[i] - b[i] * sn[i]; rb[i] = a[i] * sn[i] + b[i] * c[i]; }
    lo = (u32x4){pk2(ra[0], ra[1]), pk2(ra[2], ra[3]), pk2(ra[4], ra[5]), pk2(ra[6], ra[7])};
    hi = (u32x4){pk2(rb[0], rb[1]), pk2(rb[2], rb[3]), pk2(rb[4], rb[5]), pk2(rb[6], rb[7])};
}
struct KvRegs { u32x4 klo[2], khi[2], v[4]; };
__device__ __forceinline__ void kv_issue(Frame& F, KvRegs& R, const Item& it, int h) {
    const bf16_t* P = (const bf16_t*)(F.ws + WS_PA);
    const bf16_t* Pk = P + (size_t)it.row0 * INW + 1536 + h * HD; const bf16_t* Pv = P + (size_t)it.row0 * INW + 2048 + h * HD;
#pragma unroll
    for (int t2 = 0; t2 < 2; ++t2) { const int task = F.tid + t2 * NTHREADS, token = task >> 3, d0 = (task & 7) * 8;
        R.klo[t2] = ldg<u32x4>(Pk, (unsigned)(token * INW + d0) * 2u); R.khi[t2] = ldg<u32x4>(Pk, (unsigned)(token * INW + d0 + 64) * 2u); }
#pragma unroll
    for (int t4 = 0; t4 < 4; ++t4) { const int task = F.tid + t4 * NTHREADS, token = task >> 4, d0 = (task & 15) * 8; R.v[t4] = ldg<u32x4>(Pv, (unsigned)(token * INW + d0) * 2u); }
}
template <int KS> __device__ __forceinline__ void kv_step(unsigned aK, unsigned aVf, unsigned aVb, f32x4 (&accf)[8], f32x4 (&accb)[8]) {
    const bf16x8 af = tr1<KS * 32 * VP>(aVf), ab = tr1<KS * 32 * VP>(aVb);
    bf16x8 b[8];
    tr4<KS * 32 * VP>(aK, b[0], b[1], b[2], b[3]); tr4<KS * 32 * VP + 128>(aK, b[4], b[5], b[6], b[7]);
#pragma unroll
    for (int n = 0; n < 8; ++n) { accf[n] = __builtin_amdgcn_mfma_f32_16x16x32_bf16(af, b[n], accf[n], 0, 0, 0); accb[n] = __builtin_amdgcn_mfma_f32_16x16x32_bf16(ab, b[n], accb[n], 0, 0, 0); }
}
__device__ __forceinline__ void stage_state_t(Frame& F, ldsp_t dst, const bf16_t* St) {
#pragma unroll
    for (int t4 = 0; t4 < 4; ++t4) { const int task = F.tid + t4 * NTHREADS, e = task >> 4, c8 = task & 15;
        *(LAS u32x4*)(dst + e * TP + c8 * 16) = ldg<u32x4>(St, (unsigned)(e * 128 + c8 * 8) * 2u); }
}
__device__ __forceinline__ void mm16x128(ldsp_t At, int ra0, ldsp_t Bt, int lane, f32x4 (&acc)[8]) {
    const int fr = lane & 15, fq = lane >> 4;
#pragma unroll
    for (int ks = 0; ks < 4; ++ks) { const bf16x8 a = *(const LAS bf16x8*)(At + (ra0 + fr) * TP + (32 * ks + 8 * fq) * 2);
#pragma unroll
        for (int n = 0; n < 8; ++n) { const bf16x8 b = *(const LAS bf16x8*)(Bt + (16 * n + fr) * TP + (32 * ks + 8 * fq) * 2); acc[n] = __builtin_amdgcn_mfma_f32_16x16x32_bf16(a, b, acc[n], 0, 0, 0); } }
}

__device__ __forceinline__ void kv_head(Frame& F, KvRegs& R, KvRegs& Rn, bool pre, int item, const Item& it, int h) {
    bf16_t* KV = (bf16_t*)(F.ws + WS_KV);
    const float* ct = (const float*)(F.ws + WS_ROPE); const float* st = ct + 4096 * 64;
    const LAS float* dec = (const LAS float*)(F.lds + LDS_DEC); const bool rope = !it.is_ctx;
    ldsp_t tK = F.lds, tVf = F.lds + TILEV, tVb = F.lds + 2 * TILEV;
#pragma unroll
    for (int t2 = 0; t2 < 2; ++t2) { const int task = F.tid + t2 * NTHREADS, token = task >> 3, d0 = (task & 7) * 8;
        if (rope) rope8(R.klo[t2], R.khi[t2], ct, st, it.t0 + token, d0);
        *(LAS u32x4*)(tK + token * VP + d0 * 2) = R.klo[t2]; *(LAS u32x4*)(tK + token * VP + (d0 + 64) * 2) = R.khi[t2]; }
#pragma unroll
    for (int t4 = 0; t4 < 4; ++t4) { const int task = F.tid + t4 * NTHREADS, token = task >> 4, d0 = (task & 15) * 8; const u32x4 v = R.v[t4];
        const float df = dec[(0 * 4 + h) * 132 + 127 - token], db = dec[(1 * 4 + h) * 132 + token];
        const float x[8] = {bf2f(v.x & 0xffffu), __uint_as_float(v.x & 0xffff0000u), bf2f(v.y & 0xffffu), __uint_as_float(v.y & 0xffff0000u), bf2f(v.z & 0xffffu), __uint_as_float(v.z & 0xffff0000u), bf2f(v.w & 0xffffu), __uint_as_float(v.w & 0xffff0000u)};
        u32x4 wf, wb; wf.x = pk2(x[0] * df, x[1] * df); wf.y = pk2(x[2] * df, x[3] * df); wf.z = pk2(x[4] * df, x[5] * df); wf.w = pk2(x[6] * df, x[7] * df);
        wb.x = pk2(x[0] * db, x[1] * db); wb.y = pk2(x[2] * db, x[3] * db); wb.z = pk2(x[4] * db, x[5] * db); wb.w = pk2(x[6] * db, x[7] * db);
        *(LAS u32x4*)(tVf + token * VP + d0 * 2) = wf; *(LAS u32x4*)(tVb + token * VP + d0 * 2) = wb; }
    WG_BAR_LDS();
    if (pre) kv_issue(F, Rn, it, h + 1);
    f32x4 af[8], ab[8];
#pragma unroll
    for (int n = 0; n < 8; ++n) { af[n] = zero4(); ab[n] = zero4(); }
    { const unsigned aK = tr_lane_addr(tK, F.lane), aVf = tr_lane_addr(tVf, F.lane) + 32u * (unsigned)F.wave, aVb = tr_lane_addr(tVb, F.lane) + 32u * (unsigned)F.wave;
      kv_step<0>(aK, aVf, aVb, af, ab); kv_step<1>(aK, aVf, aVb, af, ab); kv_step<2>(aK, aVf, aVb, af, ab); kv_step<3>(aK, aVf, aVb, af, ab); }
    const int fr = F.lane & 15, fq = F.lane >> 4;
    bf16_t* of = KV + (((size_t)item * 4 + h) * 2 + 0) * 16384 + (size_t)(16 * F.wave) * 128;
    unsigned so = (unsigned)((4 * fq) * 128 + fr) * 2u; asm volatile("" : "+v"(so));
#pragma unroll
    for (int n = 0; n < 8; ++n)
#pragma unroll
        for (int jj = 0; jj < 4; ++jj) { stg<bf16_t>(of, so + (unsigned)((jj * 128 + 16 * n) * 2), (bf16_t)f2bf(af[n][jj])); stg<bf16_t>(of, so + (unsigned)((16384 + jj * 128 + 16 * n) * 2), (bf16_t)f2bf(ab[n][jj])); }
    WG_BAR_LDS();
}
__device__ __forceinline__ int latent_item(int c) { return (c >> 5) * SPB + 2 + (c & 31); }
__device__ __forceinline__ int ctx_item(int ci) { return (ci >> 1) * SPB + (ci & 1); }
__device__ __forceinline__ void phase_m1(Frame& F, int l) {
    build_decay(F, l); __syncthreads();
    for (int c = F.bid; c < 256; c += F.G) {
        fresh(F);
        { const int item = latent_item(c); const Item it = item_info(item);
          rg_part<false>(F, l, item, it, F.wave, 0, 4);
          __syncthreads();
          KvRegs A, B;
          fresh(F); kv_issue(F, A, it, 0);
          kv_head(F, A, B, true, item, it, 0);
          fresh(F); kv_head(F, B, A, true, item, it, 1);
          fresh(F); kv_head(F, A, B, true, item, it, 2);
          fresh(F); kv_head(F, B, A, false, item, it, 3); }
        fresh(F);
        if (F.wave < 2) { const int u = c + 256 * F.wave; const int item = ctx_item(u >> 5); const Item it = item_info(item); rg_part<false>(F, l, item, it, (u >> 2) & 7, u & 3, (u & 3) + 1); }
        __syncthreads();
        if (c < 64) { const int item = ctx_item(c >> 2); const Item it = item_info(item); KvRegs A, B; fresh(F); kv_issue(F, A, it, c & 3); kv_head(F, A, B, false, item, it, c & 3); }
    }
}
__device__ __forceinline__ int seq_order(int dir, int step) { return dir ? (step == 0 ? 1 : (step == 1 ? 0 : 35 - step)) : step; }
__device__ __forceinline__ void phase_m2(Frame& F, int l) {
    bf16_t* KV = (bf16_t*)(F.ws + WS_KV);
    const int gt = F.bid * NTHREADS + F.tid, NGT = F.G * NTHREADS;
    for (int c = gt; c < NB * NH * 2 * 128 * 16; c += NGT) {
        const int dc = c & 15, e = (c >> 4) & 127, dir = (c >> 11) & 1, h = (c >> 12) & 3, b = c >> 14;
        const float x = F.pa->in[I_RETDEC][l * 8 + dir * 4 + h]; const float decay = expf(128.0f * (-log1pf(expf(-x))));
        float S[8];
#pragma unroll
        for (int i = 0; i < 8; ++i) S[i] = 0.f;
        const unsigned lo = (unsigned)((((h * 2 + dir) * 128 + e) * 128 + dc * 8) * 2);
        for (int g0 = 0; g0 < SPB; g0 += 17) {
            u32x4 v[17];
#pragma unroll
            for (int i = 0; i < 17; ++i) { const int item = b * SPB + seq_order(dir, g0 + i); v[i] = ldg<u32x4>(KV + (size_t)item * 4 * 2 * 16384, lo); }
#pragma unroll
            for (int i = 0; i < 17; ++i) { const int item = b * SPB + seq_order(dir, g0 + i);
                u32x4 w; w.x = pk2(S[0], S[1]); w.y = pk2(S[2], S[3]); w.z = pk2(S[4], S[5]); w.w = pk2(S[6], S[7]);
                stg<u32x4>(KV + (size_t)item * 4 * 2 * 16384, lo, w);
                S[0] = S[0] * decay + bf2f(v[i].x & 0xffffu); S[1] = S[1] * decay + __uint_as_float(v[i].x & 0xffff0000u); S[2] = S[2] * decay + bf2f(v[i].y & 0xffffu); S[3] = S[3] * decay + __uint_as_float(v[i].y & 0xffff0000u);
                S[4] = S[4] * decay + bf2f(v[i].z & 0xffffu); S[5] = S[5] * decay + __uint_as_float(v[i].z & 0xffff0000u); S[6] = S[6] * decay + bf2f(v[i].w & 0xffffu); S[7] = S[7] * decay + __uint_as_float(v[i].w & 0xffff0000u); }
        }
    }
    const float* TOT = (const float*)(F.ws + WS_TOT); float* CARRY = (float*)(F.ws + WS_CARRY);
    for (int c = gt; c < NB * 2 * 512; c += NGT) { const int ch = c & 511, dir = (c >> 9) & 1, b = c >> 10; float cr = 0.f;
        for (int step = 0; step < SPB; ++step) { const int item = b * SPB + seq_order(dir, step); const f32x2 ah = *(const f32x2*)(TOT + (((size_t)item * 2 + dir) * 512 + ch) * 2);
            CARRY[((size_t)item * 2 + dir) * 512 + ch] = cr; cr = ah.x * cr + ah.y; } }
}
struct RetRegs { u32x4 v[4], sf[4], sb[4], klo[2], khi[2], g[4]; };
__device__ __forceinline__ void ret_issue(Frame& F, RetRegs& R, int item, const Item& it, int h) {
    const bf16_t* KV = (const bf16_t*)(F.ws + WS_KV); const bf16_t* P = (const bf16_t*)(F.ws + WS_PA);
    const bf16_t* Pk = P + (size_t)it.row0 * INW + 1536 + h * HD; const bf16_t* Pv = P + (size_t)it.row0 * INW + 2048 + h * HD;
    const bf16_t* Sf = KV + (((size_t)item * 4 + h) * 2 + 0) * 16384; const bf16_t* Sb = Sf + 16384;
    const int lane = F.lane, i0 = 16 * F.wave;
#pragma unroll
    for (int t2 = 0; t2 < 2; ++t2) { const int task = F.tid + t2 * NTHREADS, token = task >> 3, d0 = (task & 7) * 8;
        R.klo[t2] = ldg<u32x4>(Pk, (unsigned)(token * INW + d0) * 2u); R.khi[t2] = ldg<u32x4>(Pk, (unsigned)(token * INW + d0 + 64) * 2u); }
#pragma unroll
    for (int t4 = 0; t4 < 4; ++t4) { const int task = F.tid + t4 * NTHREADS, r = task >> 4, c8 = task & 15;
        R.v[t4] = ldg<u32x4>(Pv, (unsigned)(r * INW + c8 * 8) * 2u); R.sf[t4] = ldg<u32x4>(Sf, (unsigned)(r * 128 + c8 * 8) * 2u); R.sb[t4] = ldg<u32x4>(Sb, (unsigned)(r * 128 + c8 * 8) * 2u); }
    { const bf16_t* Pg = P + (size_t)(it.row0 + i0) * INW + 2560 + h * HD;
#pragma unroll
      for (int k = 0; k < 4; ++k) R.g[k] = ldg<u32x4>(Pg, (unsigned)((lane >> 2) * INW + 32 * (lane & 3) + 8 * k) * 2u); }
}
__device__ __forceinline__ void ret_head(Frame& F, RetRegs& R, RetRegs& Rn, bool pre, int item, const Item& it, int h) {
    bf16_t* Y = (bf16_t*)(F.ws + WS_Y);
    const float* ct = (const float*)(F.ws + WS_ROPE); const float* st = ct + 4096 * 64;
    const LAS float* dec = (const LAS float*)(F.lds + LDS_DEC);
    ldsp_t tK = F.lds, tV = F.lds + TILEB, tSf = tV + TILEV, tSb = tSf + TILEB;
    const bool rope = !it.is_ctx;
    const int lane = F.lane, fr = lane & 15, fq = lane >> 4, i0 = 16 * F.wave;
    u32x4 q4[4];
    { const bf16_t* Pq = (const bf16_t*)(F.ws + WS_PA) + (size_t)(it.row0 + i0) * INW + 1024 + h * HD;
#pragma unroll
      for (int ks = 0; ks < 4; ++ks) q4[ks] = ldg<u32x4>(Pq, (unsigned)(fr * INW + 32 * ks + 8 * fq) * 2u); }
#pragma unroll
    for (int t2 = 0; t2 < 2; ++t2) { const int task = F.tid + t2 * NTHREADS, token = task >> 3, d0 = (task & 7) * 8;
        if (rope) rope8(R.klo[t2], R.khi[t2], ct, st, it.t0 + token, d0);
        *(LAS u32x4*)(tK + token * TP + d0 * 2) = R.klo[t2]; *(LAS u32x4*)(tK + token * TP + (d0 + 64) * 2) = R.khi[t2]; }
#pragma unroll
    for (int t4 = 0; t4 < 4; ++t4) { const int task = F.tid + t4 * NTHREADS, r = task >> 4, c8 = task & 15;
        *(LAS u32x4*)(tV + r * VP + c8 * 16) = R.v[t4]; *(LAS u32x4*)(tSf + r * TP + c8 * 16) = R.sf[t4]; *(LAS u32x4*)(tSb + r * TP + c8 * 16) = R.sb[t4]; }
    bf16x8 qf[4];
    { if (rope) { rope8(q4[0], q4[2], ct, st, it.t0 + i0 + fr, 8 * fq); rope8(q4[1], q4[3], ct, st, it.t0 + i0 + fr, 32 + 8 * fq); }
#pragma unroll
      for (int ks = 0; ks < 4; ++ks) qf[ks] = __builtin_bit_cast(bf16x8, q4[ks]); }
    u32x4 gk[4];
#pragma unroll
    for (int k = 0; k < 4; ++k) gk[k] = R.g[k];
    WG_BAR_LDS();
    if (pre) ret_issue(F, Rn, item, it, h + 1);
    bf16x8 pa[4];
    { f32x4 C[8];
#pragma unroll
      for (int jt = 0; jt < 8; ++jt) { C[jt] = zero4();
#pragma unroll
          for (int ks = 0; ks < 4; ++ks) { const bf16x8 a = *(const LAS bf16x8*)(tK + (16 * jt + fr) * TP + (32 * ks + 8 * fq) * 2); C[jt] = __builtin_amdgcn_mfma_f32_16x16x32_bf16(a, qf[ks], C[jt], 0, 0, 0); } }
      const int i = i0 + fr;
#pragma unroll
      for (int jt = 0; jt < 8; ++jt)
#pragma unroll
          for (int jj = 0; jj < 4; ++jj) { const int j = 16 * jt + 4 * fq + jj; const float dcy = (i >= j) ? dec[(0 * 4 + h) * 132 + (i - j)] : dec[(1 * 4 + h) * 132 + (j - i)]; C[jt][jj] *= dcy; }
#pragma unroll
      for (int u = 0; u < 4; ++u) { const u32x4 w = {pg8::cvt_pk_bf16(C[2 * u][0], C[2 * u][1]), pg8::cvt_pk_bf16(C[2 * u][2], C[2 * u][3]), pg8::cvt_pk_bf16(C[2 * u + 1][0], C[2 * u + 1][1]), pg8::cvt_pk_bf16(C[2 * u + 1][2], C[2 * u + 1][3])};
          pa[u] = __builtin_bit_cast(bf16x8, w); } }
    WG_BAR_LDS();
    { ldsp_t gt = tK + (i0 + (lane >> 2)) * TP + (lane & 3) * 64;
#pragma unroll
      for (int k = 0; k < 4; ++k) *(LAS u32x4*)(gt + 16 * k) = gk[k]; }
    f32x4 o[8];
#pragma unroll
    for (int n = 0; n < 8; ++n) o[n] = zero4();
    { const unsigned aV = tr_lane_addr(tV, lane); bf16x8 b[8];
#define RET_PV(U) do { tr4<(U) * 32 * VP>(aV, b[0], b[1], b[2], b[3]); tr4<(U) * 32 * VP + 128>(aV, b[4], b[5], b[6], b[7]); \
        _Pragma("unroll") for (int n = 0; n < 8; ++n) o[n] = __builtin_amdgcn_mfma_f32_16x16x32_bf16(pa[U], b[n], o[n], 0, 0, 0); } while (0)
      RET_PV(0); RET_PV(1); RET_PV(2); RET_PV(3);
#undef RET_PV
    }
    { f32x4 cf[8];
#pragma unroll
      for (int n = 0; n < 8; ++n) { cf[n] = zero4();
#pragma unroll
          for (int ks = 0; ks < 4; ++ks) { const bf16x8 b = *(const LAS bf16x8*)(tSf + (16 * n + fr) * TP + (32 * ks + 8 * fq) * 2); cf[n] = __builtin_amdgcn_mfma_f32_16x16x32_bf16(qf[ks], b, cf[n], 0, 0, 0); } }
#pragma unroll
      for (int jj = 0; jj < 4; ++jj) { const float sf = dec[(0 * 4 + h) * 132 + (i0 + 4 * fq + jj + 1)];
#pragma unroll
          for (int n = 0; n < 8; ++n) o[n][jj] += sf * cf[n][jj]; } }
    { f32x4 cb[8];
#pragma unroll
      for (int n = 0; n < 8; ++n) { cb[n] = zero4();
#pragma unroll
          for (int ks = 0; ks < 4; ++ks) { const bf16x8 b = *(const LAS bf16x8*)(tSb + (16 * n + fr) * TP + (32 * ks + 8 * fq) * 2); cb[n] = __builtin_amdgcn_mfma_f32_16x16x32_bf16(qf[ks], b, cb[n], 0, 0, 0); } }
#pragma unroll
      for (int jj = 0; jj < 4; ++jj) { const float sb = dec[(1 * 4 + h) * 132 + (128 - (i0 + 4 * fq + jj))];
#pragma unroll
          for (int n = 0; n < 8; ++n) o[n][jj] += sb * cb[n][jj]; } }
    { ldsp_t gc = tK + (i0 + 4 * fq) * TP + fr * 2;
#pragma unroll
      for (int jj = 0; jj < 4; ++jj) { float s1 = 0.f;
#pragma unroll
          for (int n = 0; n < 8; ++n) s1 += o[n][jj];
          s1 += swz_xor<1>(s1); s1 += swz_xor<2>(s1); s1 += swz_xor<4>(s1); s1 += swz_xor<8>(s1);
          const float mu = s1 * (1.0f / 128.0f); float q = 0.f;
#pragma unroll
          for (int n = 0; n < 8; ++n) { const float dd = o[n][jj] - mu; q += dd * dd; }
          q += swz_xor<1>(q); q += swz_xor<2>(q); q += swz_xor<4>(q); q += swz_xor<8>(q);
          const float rstd = 1.0f / sqrtf(q * (1.0f / 128.0f) + EPS);
#pragma unroll
          for (int n = 0; n < 8; ++n) { LAS bf16_t* p = (LAS bf16_t*)(gc + jj * TP + 32 * n); const float gv = bf2f(*p); *p = (bf16_t)f2bf(siluf_(gv) * (o[n][jj] - mu) * rstd); } } }
    LDS_WAIT(); asm volatile("" ::: "memory");
    { ldsp_t gt = tK + (i0 + (lane >> 2)) * TP + (lane & 3) * 64; bf16_t* Yo = Y + (size_t)(it.row0 + i0) * D + 512 + h * HD;
#pragma unroll
      for (int k = 0; k < 4; ++k) stg<u32x4>(Yo, (unsigned)((lane >> 2) * D + 32 * (lane & 3) + 8 * k) * 2u, *(const LAS u32x4*)(gt + 16 * k)); }
    WG_BAR_LDS();
}
__device__ __forceinline__ void phase_m3(Frame& F, int l) {
    build_decay(F, l); __syncthreads();
    for (int c = F.bid; c < 256; c += F.G) {
        fresh(F);
        { const int item = latent_item(c); const Item it = item_info(item);
#ifndef PROBE_M3
#define PROBE_M3 0
#endif
          for (int r_ = 0; r_ < ((PROBE_M3 & 1) ? 2 : 1); ++r_) { fresh(F); rg_part<true>(F, l, item, it, F.wave, 0, 4); }
          __syncthreads();
          for (int r_ = 0; r_ < ((PROBE_M3 & 2) ? 2 : 1); ++r_) {
          RetRegs R, Rn;
          fresh(F); ret_issue(F, R, item, it, 0);
          ret_head(F, R, Rn, true, item, it, 0);
          fresh(F); ret_head(F, Rn, R, true, item, it, 1);
          fresh(F); ret_head(F, R, Rn, true, item, it, 2);
          fresh(F); ret_head(F, Rn, R, false, item, it, 3); } }
        if (l == 0) {
            fresh(F);
            if (F.wave < 2) { const int u = c + 256 * F.wave; const int item = ctx_item(u >> 5); const Item it = item_info(item); rg_part<true>(F, l, item, it, (u >> 2) & 7, u & 3, (u & 3) + 1); }
            __syncthreads();
            if (c < 64) { const int item = ctx_item(c >> 2); const Item it = item_info(item); RetRegs R, Rn; fresh(F); ret_issue(F, R, item, it, c & 3); ret_head(F, R, Rn, false, item, it, c & 3); }
        }
    }
}

constexpr int N_PHASES = 24;
__global__ void __launch_bounds__(NTHREADS, 2) fwd_kernel(Args args) {
    extern __shared__ __attribute__((aligned(16))) unsigned char lds_raw[];
    Frame F; F.lds = (ldsp_t)lds_raw; F.wave0 = __builtin_amdgcn_readfirstlane((int)threadIdx.x >> 6); F.G = gridDim.x; F.pa0 = &args; F.out0 = args.out; F.ws0 = args.ws; fresh(F);
    volatile LAS unsigned* MISC = (volatile LAS unsigned*)(F.lds + LDS_MISC);
    if (F.tid < 64) MISC[F.tid] = 0u;
    __syncthreads();
    const int lo = args.ph_lo, hi = args.ph_hi;
    XcdBarrier bar; bar.bar = (unsigned*)(F.ws + WS_CTL); bar.x = 0; bar.st = nullptr;
    if (hi - lo > 1) bar = xcd_barrier_post((unsigned*)(F.ws + WS_CTL), MISC);
#ifndef DIAG_MASK
#define DIAG_MASK 0xffffffffu
#endif
#ifndef REPEAT_MASK
#define REPEAT_MASK 0u
#endif
#define REPS(kind) ((((REPEAT_MASK) >> (kind)) & 1u) ? 2 : 1)
#define INK(k, kind) (((DIAG_MASK >> (kind)) & 1u) && lo <= (k) && (k) < hi && fresh(F))
#define IN(k) (lo <= (k) && (k) < hi)
#define SEAM(k) do { if (IN(k) && IN((k) + 1)) xcd_barrier(bar); } while (0)
    float* ctxx = (float*)(F.ws + WS_CTXX); bf16_t* xb = (bf16_t*)((char*)F.out + XB_OFF);
    const float* modlat = (const float*)(F.ws + WS_MODLAT); const float* modctx = (const float*)(F.ws + WS_MODCTX);

    if (INK(0, 0)) { for (int r_ = 0; r_ < REPS(0); ++r_) { phase_convert_small(F); __syncthreads(); phase_mod(F); __syncthreads(); } } SEAM(0);
    if (INK(1, 1)) { for (int r_ = 0; r_ < REPS(1); ++r_) phase_norm(F, 0, 0, F.pa->in[I_X], nullptr, F.pa->in[I_CTX], MROWS, SlabRed{nullptr, 0, nullptr, nullptr, nullptr}); } SEAM(1);
#pragma unroll 1
    for (int l = 0; l < 2; ++l) {
        const int pb = (l == 0) ? 2 : 11;
        if (INK(pb + 0, 2)) { pg8::Gemm g{(const bf16_t*)(F.ws + WS_HX), (const bf16_t*)(F.ws + WS_WIN) + (size_t)l * INW * D, INW, D, 0, nullptr}; pg8::Order S; S.init(MROWS / 256, INW / 256, F.G, F.bid, nullptr, nullptr, D / 64, false, 0);
            pg8::EpiBf16 E{(bf16_t*)(F.ws + WS_PA), INW}; for (int r_ = 0; r_ < REPS(2); ++r_) pg8::gemm_phase<pg8::EpiBf16>(F.lds, g, S, E, F.tid); }
        SEAM(pb + 0);
        if (INK(pb + 1, 3)) { for (int r_ = 0; r_ < REPS(3); ++r_) phase_m1(F, l); }
        SEAM(pb + 1);
        if (INK(pb + 2, 4)) { for (int r_ = 0; r_ < REPS(4); ++r_) { if (r_) phase_m1(F, l); phase_m2(F, l); } }
        SEAM(pb + 2);
        if (INK(pb + 3, 5)) { for (int r_ = 0; r_ < REPS(5); ++r_) phase_m3(F, l); }
        SEAM(pb + 3);
        if (INK(pb + 4, 6)) { pg8::Gemm g{(const bf16_t*)(F.ws + WS_Y), (const bf16_t*)(F.ws + WS_WOUT) + (size_t)l * D * D, D, D, 0, (float*)(F.ws + WS_SLABA)}; pg8::Order S; S.init((l == 0 ? MROWS : NLAT) / 256, D / 256, F.G, F.bid, nullptr, nullptr, D / 64, true, MAXSLAB_A);
            pg8::EpiResid E{l == 0 ? F.pa->in[I_X] : nullptr, xb, F.pa->in[I_CTX], ctxx, modlat + (size_t)l * 8 * 6144 + 2048, modctx + (size_t)l * 6144 + 2048};
            pg8::gemm_phase<pg8::EpiResid>(F.lds, g, S, E, F.tid); }
        SEAM(pb + 4);
        if (l == 0) {
            if (INK(7, 1)) { for (int r_ = 0; r_ < REPS(1); ++r_) phase_norm(F, 0, 1, nullptr, xb, ctxx, MROWS, SlabRed{(const float*)(F.ws + WS_SLABA), pg8::split_factor((MROWS / 256) * 4, F.G, D / 64, MAXSLAB_A), modctx + 2048, F.pa->in[I_CTX], ctxx}); } SEAM(7);
            if (INK(8, 7)) { pg8::Gemm g{(const bf16_t*)(F.ws + WS_HX), (const bf16_t*)(F.ws + WS_WUP), 2 * DFF, D, 0, nullptr}; pg8::Order S; S.init(MROWS / 256, 2 * DFF / 256, F.G, F.bid, nullptr, nullptr, D / 64, false, 0);
                pg8::EpiSwiGLU E{(bf16_t*)(F.ws + WS_PA), DFF}; for (int r_ = 0; r_ < REPS(7); ++r_) pg8::gemm_phase<pg8::EpiSwiGLU>(F.lds, g, S, E, F.tid); }
            SEAM(8);
            if (INK(9, 8)) { pg8::Gemm g{(const bf16_t*)(F.ws + WS_PA), (const bf16_t*)(F.ws + WS_WDN), D, DFF, 0, (float*)(F.ws + WS_SLABA)}; pg8::Order S; S.init(MROWS / 256, D / 256, F.G, F.bid, nullptr, nullptr, DFF / 64, true, MAXSLAB_A);
                pg8::EpiResid E{nullptr, xb, (const float*)ctxx, ctxx, modlat + 5120, modctx + 5120}; pg8::gemm_phase<pg8::EpiResid>(F.lds, g, S, E, F.tid); }
            SEAM(9);
            if (INK(10, 1)) { for (int r_ = 0; r_ < REPS(1); ++r_) phase_norm(F, 1, 0, nullptr, xb, ctxx, MROWS, SlabRed{(const float*)(F.ws + WS_SLABA), pg8::split_factor((MROWS / 256) * 4, F.G, DFF / 64, MAXSLAB_A), modctx + 5120, ctxx, ctxx}); } SEAM(10);
        }
    }
    if (INK(16, 9)) { for (int r_ = 0; r_ < REPS(9); ++r_) { phase_norm_router(F, xb); __syncthreads(); phase_convert_moe(F); __syncthreads(); } } SEAM(16);
    if (INK(17, 10)) { phase_moe_sort(F); } SEAM(17);
#pragma unroll 1
    for (int k = 0; k < 2; ++k) {
        const int* meta = (const int*)(F.ws + MOE_META) + 9 * k;
        if (INK(18 + 2 * k, 11)) { if (k == 1) { moe_reduce(F, 0); __syncthreads(); } pg8::Gemm g{(const bf16_t*)(F.ws + WS_HX), (const bf16_t*)(F.ws + WS_MOEUP), 2 * DEXP, D, (size_t)2 * DEXP * D * 2, nullptr}; pg8::Order S; S.init(meta[8], 2 * DEXP / 256, F.G, F.bid, meta, (const int*)(F.ws + MOE_PTOK) + k * MROWS, D / 64, false, 0);
            pg8::EpiSwiGLU E{(bf16_t*)(F.ws + WS_PA), DEXP}; for (int r_ = 0; r_ < REPS(11); ++r_) pg8::gemm_phase<pg8::EpiSwiGLU>(F.lds, g, S, E, F.tid); }
        SEAM(18 + 2 * k);
        if (INK(19 + 2 * k, 12)) { pg8::Gemm g{(const bf16_t*)(F.ws + WS_PA), (const bf16_t*)(F.ws + WS_MOEDN), D, DEXP, (size_t)D * DEXP * 2, (float*)(F.ws + WS_SLABM)}; pg8::Order S; S.init(meta[8], D / 256, F.G, F.bid, meta, nullptr, DEXP / 64, true, MAXSLAB_M);
            pg8::EpiMoeDown E{xb, (const int*)(F.ws + MOE_PTOK) + k * MROWS, (const float*)(F.ws + MOE_PW) + k * MROWS, modlat + (size_t)8 * 6144 + 5120}; pg8::gemm_phase<pg8::EpiMoeDown>(F.lds, g, S, E, F.tid); }
        SEAM(19 + 2 * k);
    }
    if (INK(22, 13)) phase_final_a(F);
    SEAM(22);
    if (INK(23, 13)) phase_final_b(F);
#undef IN
#undef INK
#undef SEAM
}

extern "C" void kernel_launch(void* const* d_in, const int* in_sizes, int n_in, void* d_out, int out_size, void* d_ws, size_t ws_size, hipStream_t stream) {
    static int grid = 0;
    if (grid == 0) {
        if (n_in != 27 || in_sizes[0] != NLAT * D || out_size != NLAT * D || ws_size < WS_END) { fprintf(stderr, "kernel_launch: unexpected problem (n_in %d, in0 %d, out %d, ws %zu, need %zu); nothing launched\n", n_in, n_in > 0 ? in_sizes[0] : -1, out_size, ws_size, (size_t)WS_END); grid = -1; return; }
        int dev = 0, cus = 0, per_cu = 0;
        if (hipGetDevice(&dev) != hipSuccess || hipDeviceGetAttribute(&cus, hipDeviceAttributeMultiprocessorCount, dev) != hipSuccess) { grid = -1; return; }
        if (hipFuncSetAttribute((const void*)fwd_kernel, hipFuncAttributeMaxDynamicSharedMemorySize, LDS_BYTES) != hipSuccess) { fprintf(stderr, "kernel_launch: hipFuncSetAttribute failed\n"); grid = -1; return; }
        if (hipOccupancyMaxActiveBlocksPerMultiprocessor(&per_cu, (const void*)fwd_kernel, NTHREADS, LDS_BYTES) != hipSuccess || per_cu < 1) { fprintf(stderr, "kernel_launch: occupancy query says %d\n", per_cu); }
        (void)hipGetLastError();
        grid = cus;
    }
    if (grid < 0) return;
    (void)hipMemsetAsync((char*)d_ws + WS_CTL, 0, CTL_ZERO_BYTES, stream);
    Args a; memset(&a, 0, sizeof(a));
    for (int i = 0; i < 27; ++i) a.in[i] = (const float*)d_in[i];
    a.out = (float*)d_out; a.ws = (unsigned char*)d_ws;
#if MK_ONE_LAUNCH
    a.ph_lo = 0; a.ph_hi = N_PHASES;
    hipLaunchKernelGGL(fwd_kernel, dim3(grid), dim3(NTHREADS), LDS_BYTES, stream, a);
#else
    for (int p = 0; p < N_PHASES; ++p) { a.ph_lo = p; a.ph_hi = p + 1; hipLaunchKernelGGL(fwd_kernel, dim3(grid), dim3(NTHREADS), LDS_BYTES, stream, a); }
#endif
}
```

```cpp
#include <hip/hip_runtime.h>
#include <cstdio>
#include <cstdint>
#include <cstring>

#ifndef MK_ONE_LAUNCH
#define MK_ONE_LAUNCH 1
#endif

#define GAS __attribute__((address_space(1)))
#define LAS __attribute__((address_space(3)))
typedef unsigned short bf16_t;
typedef short bf16x8 __attribute__((ext_vector_type(8)));
typedef float f32x4 __attribute__((ext_vector_type(4)));
typedef float f32x2 __attribute__((ext_vector_type(2)));
typedef unsigned u32x4 __attribute__((ext_vector_type(4)));
typedef unsigned u32x2 __attribute__((ext_vector_type(2)));
typedef LAS unsigned char* ldsp_t;

constexpr int D = 1024, NB = 8, SEQ = 4096, NLAT = NB * SEQ, CTXL = 256, NCTX = NB * CTXL, MROWS = NLAT + NCTX;
constexpr int INW = 3072, NH = 4, HD = 128, CHK = 128;
constexpr int DFF = 2816, NE = 8, DEXP = 3584;
constexpr int SPB = 34;
constexpr int NITEM = NB * SPB;
constexpr float EPS = 1e-6f;
constexpr int NWAVES = 8, NTHREADS = 512;

constexpr size_t MiB = 1u << 20;
constexpr size_t WS_CTL = 0, CTL_ZERO_BYTES = 64 * 1024;
constexpr size_t WS_MODLAT = 1 * MiB;
constexpr size_t WS_MODCTX = 1 * MiB + 2 * 8 * 6144 * 4;
constexpr size_t WS_ROPE = 2 * MiB;
constexpr size_t WS_RGW = 4 * MiB;
constexpr size_t WS_TOT = 5 * MiB;
constexpr size_t WS_CARRY = 8 * MiB;
constexpr size_t WS_MOE = 10 * MiB;
constexpr size_t MOE_CNT = WS_MOE, MOE_META = WS_MOE + 16384, MOE_TOKE = WS_MOE + 65536, MOE_TOKW = WS_MOE + 262144,
                 MOE_PTOK = WS_MOE + 524288, MOE_PW = WS_MOE + 1048576, MOE_PPOS = WS_MOE + 1572864;
constexpr size_t WS_CTXX = 12 * MiB;
constexpr size_t WS_WIN = 20 * MiB;
constexpr size_t WS_WOUT = 32 * MiB;
constexpr size_t WS_WUP = 36 * MiB;
constexpr size_t WS_WDN = 47 * MiB;
constexpr size_t WS_HX = 54 * MiB;
constexpr size_t WS_PA = 122 * MiB;
constexpr size_t WS_KV = 360 * MiB;
constexpr size_t WS_Y = 496 * MiB;
constexpr size_t WS_MOEUP = 360 * MiB;
constexpr size_t WS_MOEDN = 472 * MiB;
constexpr size_t WS_SLABA = WS_KV;
constexpr size_t WS_SLABM = 528 * MiB;
constexpr int MAXSLAB_A = 256, MAXSLAB_M = 216;
constexpr size_t XB_OFF = (size_t)NLAT * D * 2;
constexpr size_t WS_XCOPY = WS_PA;
constexpr size_t WS_END = 582 * MiB;
static_assert(WS_MOEDN + (size_t)NE * D * DEXP * 2 <= WS_END, "ws map");
static_assert(WS_PA + (size_t)MROWS * DEXP * 2 <= WS_KV, "ws map");

constexpr int LDS_SCRATCH = 147456;
constexpr int LDS_MISC = LDS_SCRATCH;
constexpr int LDS_DEC = LDS_MISC + 256;
constexpr int LDS_BYTES = LDS_SCRATCH + 8192;

__device__ __forceinline__ float bf2f(unsigned v) { return __uint_as_float(v << 16); }
typedef __bf16 bf16x2_t __attribute__((ext_vector_type(2)));
__device__ __forceinline__ unsigned pk2(float lo, float hi) { const f32x2 v = {lo, hi}; return __builtin_bit_cast(unsigned, __builtin_convertvector(v, bf16x2_t)); }
__device__ __forceinline__ unsigned f2bf(float f) { return pk2(f, f) & 0xffffu; }
__device__ __forceinline__ void unpack8(const u32x4 v, f32x4& a, f32x4& b) {
    a = (f32x4){bf2f(v.x & 0xffffu), __uint_as_float(v.x & 0xffff0000u), bf2f(v.y & 0xffffu), __uint_as_float(v.y & 0xffff0000u)};
    b = (f32x4){bf2f(v.z & 0xffffu), __uint_as_float(v.z & 0xffff0000u), bf2f(v.w & 0xffffu), __uint_as_float(v.w & 0xffff0000u)}; }
__device__ __forceinline__ u32x4 pack8(const f32x4 a, const f32x4 b) { return (u32x4){pk2(a.x, a.y), pk2(a.z, a.w), pk2(b.x, b.y), pk2(b.z, b.w)}; }
template <int M> __device__ __forceinline__ float swz_xor(float v) { return __int_as_float(__builtin_amdgcn_ds_swizzle(__float_as_int(v), (M << 10) | 0x1f)); }
__device__ __forceinline__ float wave_sum(float v) {
    v += swz_xor<1>(v); v += swz_xor<2>(v); v += swz_xor<4>(v); v += swz_xor<8>(v); v += swz_xor<16>(v);
    const auto r = __builtin_amdgcn_permlane32_swap(__float_as_uint(v), __float_as_uint(v), false, false);
    return __uint_as_float(r[0]) + __uint_as_float(r[1]);
}
__device__ __forceinline__ float lane_bcast(float v, int src_lane) { return __int_as_float(__builtin_amdgcn_ds_bpermute(src_lane << 2, __float_as_int(v))); }
__device__ __forceinline__ float sigmoidf_(float x) { return __builtin_amdgcn_rcpf(1.0f + __expf(-x)); }
__device__ __forceinline__ float siluf_(float x) { return x * __builtin_amdgcn_rcpf(1.0f + __expf(-x)); }
__device__ __forceinline__ float gelu_tanh(float x) { const float z = 0.7978845608028654f * (x + 0.044715f * x * x * x); return x * (1.0f - __builtin_amdgcn_rcpf(1.0f + __expf(2.0f * z))); }
#define LDS_WAIT() asm volatile("s_waitcnt lgkmcnt(0)" ::: "memory")
#define WG_BAR_LDS() do { asm volatile("s_waitcnt lgkmcnt(0)" ::: "memory"); __builtin_amdgcn_s_barrier(); asm volatile("" ::: "memory"); } while (0)
__device__ __forceinline__ f32x4 zero4() { float z; asm volatile("v_mov_b32 %0, 0" : "=v"(z)); return (f32x4){z, z, z, z}; }

template <typename T> __device__ __forceinline__ T ldg(const void* base, unsigned off) { return *(const GAS T*)((const GAS char*)base + off); }
template <typename T> __device__ __forceinline__ void stg(void* base, unsigned off, T v) { *(GAS T*)((GAS char*)base + off) = v; }
#define XB_TMO      128
#define XB_XCNT(j)  (256  + 64 * (j))
#define XB_XSUB(j)  (1280 + 64 * (j))
#define XB_XGEN(j)  (2304 + 64 * (j))
#define XB_TOP      3328
#define XB_TOPGEN   3392
#define XCD_BAR_WORDS 3456
#define XB_SPIN_CAP (1u << 18)
__device__ __forceinline__ unsigned xb_ld(unsigned* p)              { return __hip_atomic_load(p, __ATOMIC_RELAXED, __HIP_MEMORY_SCOPE_AGENT); }
__device__ __forceinline__ unsigned xb_add(unsigned* p, unsigned v) { return __hip_atomic_fetch_add(p, v, __ATOMIC_RELAXED, __HIP_MEMORY_SCOPE_AGENT); }
__device__ __forceinline__ unsigned xb_xcc_id() { return (unsigned)__builtin_amdgcn_s_getreg((3 << 11) | 20) & 0xFu; }
#define XB_SPIN(cond, bar) do { unsigned _sp = 0; while (cond) { __builtin_amdgcn_s_sleep(1); \
    if ((++_sp & 255u) == 0u) { if (xb_ld(&(bar)[XB_TMO])) break; if (_sp > XB_SPIN_CAP) { atomicAdd(&(bar)[XB_TMO], 1u); break; } } } } while (0)
struct XcdBarrier { unsigned* bar; unsigned x; volatile LAS unsigned* st; };
__device__ __forceinline__ XcdBarrier xcd_barrier_post(unsigned* bar, volatile LAS unsigned* st) {
    XcdBarrier b; b.bar = bar; b.x = xb_xcc_id(); b.st = st;
    if (threadIdx.x == 0) (void)xb_add(&bar[XB_XCNT(b.x)], 1u);
    return b;
}
__device__ __forceinline__ void xcd_barrier_complete(unsigned* bar, unsigned x, unsigned& nloc, unsigned& nx) {
    const unsigned G = gridDim.x * gridDim.y * gridDim.z;
    unsigned sum, cnt, mine, sp = 0u;
    for (;;) {
        sum = 0u; cnt = 0u; mine = 0u;
#pragma unroll
        for (unsigned j = 0; j < 16; ++j) { const unsigned c = xb_ld(&bar[XB_XCNT(j)]); sum += c; cnt += (c > 0u) ? 1u : 0u; mine = (j == x) ? c : mine; }
        if (sum == G) break;
        __builtin_amdgcn_s_sleep(1);
        if ((++sp & 255u) == 0u) { if (xb_ld(&bar[XB_TMO])) break; if (sp > XB_SPIN_CAP) { atomicAdd(&bar[XB_TMO], 1u); break; } }
    }
    nloc = mine > 0u ? mine : 1u; nx = cnt > 0u ? cnt : 1u;
}
__device__ __forceinline__ void xcd_barrier(const XcdBarrier& b) {
    asm volatile("s_waitcnt vmcnt(0)" ::: "memory");
    __syncthreads();
    if (threadIdx.x == 0) {
        unsigned* bar = b.bar;
        __builtin_amdgcn_s_waitcnt(0);
        unsigned nloc = b.st[0], nx = b.st[1];
        if (nloc == 0u) { xcd_barrier_complete(bar, b.x, nloc, nx); b.st[0] = nloc; b.st[1] = nx; }
        const unsigned old = xb_add(&bar[XB_XSUB(b.x)], 1u);
        const unsigned gen = old / nloc;
        if (old + 1u == (gen + 1u) * nloc) {
            __builtin_amdgcn_fence(__ATOMIC_RELEASE, "agent");
            asm volatile("s_waitcnt vmcnt(0)" ::: "memory");
            const unsigned og = xb_add(&bar[XB_TOP], 1u);
            const unsigned tg = og / nx;
            if (og + 1u == (tg + 1u) * nx) xb_add(&bar[XB_TOPGEN], 1u);
            else XB_SPIN(xb_ld(&bar[XB_TOPGEN]) == tg, bar);
            __builtin_amdgcn_fence(__ATOMIC_ACQUIRE, "agent");
            xb_add(&bar[XB_XGEN(b.x)], 1u);
            asm volatile("s_waitcnt vmcnt(0)" ::: "memory");
        } else {
            XB_SPIN(xb_ld(&bar[XB_XGEN(b.x)]) == gen, bar);
            __builtin_amdgcn_fence(__ATOMIC_ACQUIRE, "agent");
            asm volatile("s_waitcnt vmcnt(0)" ::: "memory");
        }
    }
    __syncthreads();
}

namespace pg8 {
constexpr int BM = 256, BK = 64, HALF = 128, HTB = HALF * BK * 2, STAGE_BYTES = 8 * HTB, NXCD = 8, WGM = 8;
__host__ __device__ __forceinline__ int lds_byte(int r, int c) { const int st = (r >> 4) * 2 + (c >> 5), rr = r & 15, cc = c & 31, ob = rr * 64 + cc * 2; return st * 1024 + (ob ^ (((ob >> 9) & 1) << 5)); }
__host__ __device__ __forceinline__ void stage_rc(int b, int& R, int& C) { const int st = b / 1024, sb = b % 1024, swz = sb ^ (((sb >> 9) & 1) << 5); R = (st >> 1) * 16 + swz / 64; C = (st & 1) * 32 + (swz % 64) / 2; }
__host__ __device__ __forceinline__ int perm32(int rho) { const int n = rho >> 4, i = rho & 15; return 8 * (i >> 2) + 4 * n + (i & 3); }

struct Unit { int pm, pn, e, kt0, nt, slab; };
struct Gemm { const bf16_t* A; const bf16_t* Bt; int N, K; size_t estride; float* slabs; };

__device__ __forceinline__ int split_factor(int U, int G, int ntiles, int maxslabs) {
    const int R = U % G; if (R == 0) return 1;
    int S = G / R; if (S > 8) S = 8; if (S > ntiles / 2) S = ntiles / 2; if (R * S > maxslabs) S = maxslabs / R;
    return S < 2 ? 1 : S;
}
struct Order {
    int nM, nN, G, c, ntiles, mainu, S, total; const int* segs; const int* rowmap;
    __device__ __forceinline__ void init(int nM_, int nN_, int G_, int c_, const int* segs_, const int* rowmap_, int ntiles_, bool split, int maxslabs) {
        nM = nM_; nN = nN_; G = G_; c = c_; segs = segs_; rowmap = rowmap_; ntiles = ntiles_;
        const int U = nM * nN; S = split ? split_factor(U, G, ntiles, maxslabs) : 1; const int R = (S > 1) ? U % G : 0; mainu = U - R; total = mainu + R * S; }
    __device__ __forceinline__ bool next(int i, Unit& u) const {
        const long L = (long)i * G + c; if (L >= total) return false;
        int wgid; u.kt0 = 0; u.nt = ntiles; u.slab = -1;
        if (L < mainu) { wgid = (int)L; const int q = mainu / NXCD, r = mainu % NXCD, xcd = wgid % NXCD, off = wgid / NXCD; wgid = (xcd < r ? xcd * (q + 1) : r * (q + 1) + (xcd - r) * q) + off; }
        else { const int sub = (int)L - mainu, lu = sub / S, sl = sub - lu * S, pairs = ntiles / 2, p0 = (sl * pairs) / S, p1 = ((sl + 1) * pairs) / S;
            wgid = mainu + lu; u.kt0 = 2 * p0; u.nt = 2 * (p1 - p0); u.slab = sub; }
        const int nig = WGM * nN, gid = wgid / nig, fm = gid * WGM, gsz = (nM - fm) < WGM ? (nM - fm) : WGM;
        u.pm = fm + ((wgid % nig) % gsz); u.pn = (wgid % nig) / gsz; u.e = 0;
        if (segs) { int e = 0;
#pragma unroll
            for (int j = 1; j < 8; ++j) e += (u.pm >= segs[j]) ? 1 : 0;
            u.e = e; }
        return true;
    }
    __device__ __forceinline__ int arow(const Unit& u, int r) const {
        if (rowmap) { const int t = rowmap[u.pm * BM + r]; return t < 0 ? 0 : t; }
        return u.pm * BM + r;
    }
};

__device__ __forceinline__ unsigned cvt_pk_bf16(float lo, float hi) { return pk2(lo, hi); }

struct EpiBf16 {
    static constexpr bool PERM = true, SPLIT = false;
    bf16_t* O; int ldc;
    __device__ __forceinline__ void operator()(const f32x4 (&acc)[2][2][4][2], const Unit& u, int wr, int wc, int fr, int fq) const {
        asm volatile("" : "+v"(fr), "+v"(fq));
        const int row0 = u.pm * BM + wr * 64 + fr, col0 = u.pn * BM + wc * 32 + 8 * fq;
#pragma unroll
        for (int ai = 0; ai < 2; ++ai)
#pragma unroll
            for (int m = 0; m < 4; ++m) { bf16_t* rowp = O + (size_t)(row0 + ai * HALF + m * 16) * ldc + col0;
#pragma unroll
                for (int bj = 0; bj < 2; ++bj) { const f32x4 v0 = acc[ai][bj][m][0], v1 = acc[ai][bj][m][1];
                    u32x4 w; w.x = cvt_pk_bf16(v0[0], v0[1]); w.y = cvt_pk_bf16(v0[2], v0[3]); w.z = cvt_pk_bf16(v1[0], v1[1]); w.w = cvt_pk_bf16(v1[2], v1[3]);
                    *(u32x4*)(rowp + bj * HALF) = w; } }
    }
};
struct EpiSwiGLU {
    static constexpr bool PERM = true, SPLIT = false;
    bf16_t* O; int ldc;
    __device__ __forceinline__ void operator()(const f32x4 (&acc)[2][2][4][2], const Unit& u, int wr, int wc, int fr, int fq) const {
        asm volatile("" : "+v"(fr), "+v"(fq));
        const int row0 = u.pm * BM + wr * 64 + fr, col0 = u.pn * HALF + wc * 32 + 8 * fq;
#pragma unroll
        for (int ai = 0; ai < 2; ++ai)
#pragma unroll
            for (int m = 0; m < 4; ++m) { bf16_t* rowp = O + (size_t)(row0 + ai * HALF + m * 16) * ldc + col0;
                float o[8];
#pragma unroll
                for (int n = 0; n < 2; ++n)
#pragma unroll
                    for (int j = 0; j < 4; ++j) { const float a = acc[ai][0][m][n][j], b = acc[ai][1][m][n][j]; o[n * 4 + j] = (a * __builtin_amdgcn_rcpf(1.0f + __expf(-a))) * b; }
                u32x4 w; w.x = cvt_pk_bf16(o[0], o[1]); w.y = cvt_pk_bf16(o[2], o[3]); w.z = cvt_pk_bf16(o[4], o[5]); w.w = cvt_pk_bf16(o[6], o[7]);
                *(u32x4*)rowp = w; }
    }
};
struct EpiResid {
    static constexpr bool PERM = true, SPLIT = true;
    const float* src_f32; bf16_t* xb; const float* src_ctx; float* dst_ctx; const float* gate_lat; const float* gate_ctx;
    __device__ __forceinline__ void operator()(const f32x4 (&acc)[2][2][4][2], const Unit& u, int wr, int wc, int fr, int fq) const {
        asm volatile("" : "+v"(fr), "+v"(fq));
        const int prow = u.pm * BM; const bool lat = prow < NLAT;
        const float* gate = lat ? gate_lat + (size_t)(prow / SEQ) * 6144 : gate_ctx;
        const int r0 = wr * 64 + fr, col0 = u.pn * BM + wc * 32 + 8 * fq;
        f32x4 gv[2][2];
#pragma unroll
        for (int bj = 0; bj < 2; ++bj)
#pragma unroll
            for (int n = 0; n < 2; ++n) gv[bj][n] = *(const f32x4*)(gate + col0 + bj * HALF + 4 * n);
        if (lat) {
#pragma unroll
            for (int ai = 0; ai < 2; ++ai)
#pragma unroll
                for (int m = 0; m < 4; ++m) { const size_t off = (size_t)(prow + r0 + ai * HALF + m * 16) * D + col0;
#pragma unroll
                    for (int bj = 0; bj < 2; ++bj) { f32x4 s0, s1;
                        if (src_f32) { s0 = *(const f32x4*)(src_f32 + off + bj * HALF); s1 = *(const f32x4*)(src_f32 + off + bj * HALF + 4); }
                        else unpack8(*(const u32x4*)(xb + off + bj * HALF), s0, s1);
                        *(u32x4*)(xb + off + bj * HALF) = pack8(s0 + gv[bj][0] * acc[ai][bj][m][0], s1 + gv[bj][1] * acc[ai][bj][m][1]); }
                    asm volatile("" ::: "memory"); }
        } else {
            const float* src = src_ctx + (size_t)(prow - NLAT) * D; float* dst = dst_ctx + (size_t)(prow - NLAT) * D;
#pragma unroll
            for (int ai = 0; ai < 2; ++ai)
#pragma unroll
                for (int m = 0; m < 4; ++m) { const size_t off = (size_t)(r0 + ai * HALF + m * 16) * D + col0;
#pragma unroll
                    for (int bj = 0; bj < 2; ++bj)
#pragma unroll
                        for (int n = 0; n < 2; ++n) { const f32x4 sv = *(const f32x4*)(src + off + bj * HALF + 4 * n); *(f32x4*)(dst + off + bj * HALF + 4 * n) = sv + gv[bj][n] * acc[ai][bj][m][n]; }
                    asm volatile("" ::: "memory"); }
        }
    }
};
struct EpiMoeDown {
    static constexpr bool PERM = true, SPLIT = true;
    bf16_t* xb; const int* ptok; const float* pw; const float* gate_lat;
    __device__ __forceinline__ void operator()(const f32x4 (&acc)[2][2][4][2], const Unit& u, int wr, int wc, int fr, int fq) const {
        asm volatile("" : "+v"(fr), "+v"(fq));
        const int r0 = u.pm * BM + wr * 64 + fr, col0 = u.pn * BM + wc * 32 + 8 * fq;
#pragma unroll
        for (int ai = 0; ai < 2; ++ai)
#pragma unroll
            for (int m = 0; m < 4; ++m) { const int r = r0 + ai * HALF + m * 16; const int tok = ptok[r]; const float w = pw[r];
                if (tok >= 0) { bf16_t* xr = xb + (size_t)tok * D + col0; const float* gate = gate_lat + (size_t)(tok / SEQ) * 6144 + col0;
#pragma unroll
                    for (int bj = 0; bj < 2; ++bj) { const f32x4 g0 = *(const f32x4*)(gate + bj * HALF), g1 = *(const f32x4*)(gate + bj * HALF + 4); f32x4 s0, s1; unpack8(*(const u32x4*)(xr + bj * HALF), s0, s1);
                        *(u32x4*)(xr + bj * HALF) = pack8(s0 + (g0 * w) * acc[ai][bj][m][0], s1 + (g1 * w) * acc[ai][bj][m][1]); } }
                asm volatile("" ::: "memory"); }
    }
};

template <class Epi>
__device__ __forceinline__ void gemm_phase(ldsp_t lds, const Gemm g, const Order& S, const Epi& E, const int tid) {
    const int wid = __builtin_amdgcn_readfirstlane(tid >> 6), lane = tid & 63, wr = wid >> 2, wc = wid & 3, fr = lane & 15, fq = lane >> 4;
    const int K = g.K;
    unsigned voffB[2];
#pragma unroll
    for (int i = 0; i < 2; ++i) { int R, C; stage_rc(tid * 16 + i * 8192, R, C); const int Rb = Epi::PERM ? ((R & ~31) + perm32(R & 31)) : R;
        voffB[i] = (unsigned)(Rb * K + C) * 2u; }
    const size_t kstep = (size_t)(BK * 2);
    const size_t hstep = (size_t)HALF * K * 2;
    const size_t tstep = 2 * hstep;
    const unsigned ldsw = (unsigned)wid * 1024u;
    const int aoff = lds_byte(wr * 64 + fr, fq * 8), boff = lds_byte(wc * 32 + fr, fq * 8);
#define PG8_SA(b, h) (((b) * 2 + (h)) * HTB)
#define PG8_SB(b, h) ((4 + (b) * 2 + (h)) * HTB)
#define PG8_STAGE_B(bufoff, gbase) do { _Pragma("unroll") for (int _i = 0; _i < 2; ++_i) \
        __builtin_amdgcn_global_load_lds((const unsigned*)((const char*)(gbase) + voffB[_i]), (LAS unsigned*)(lds + (bufoff) + ldsw + _i * 8192), 16, 0, 0); } while (0)
#define PG8_STAGE_A(bufoff, gbase, o0, o1) do { \
        __builtin_amdgcn_global_load_lds((const unsigned*)((const char*)(gbase) + (o0)), (LAS unsigned*)(lds + (bufoff) + ldsw), 16, 0, 0); \
        __builtin_amdgcn_global_load_lds((const unsigned*)((const char*)(gbase) + (o1)), (LAS unsigned*)(lds + (bufoff) + ldsw + 8192), 16, 0, 0); } while (0)
#define PG8_LDA(dst, b, h) do { _Pragma("unroll") for (int m = 0; m < 4; ++m) _Pragma("unroll") for (int k = 0; k < 2; ++k) dst[m][k] = *(const LAS bf16x8*)(lds + PG8_SA(b, h) + aoff + m * 2048 + k * 1024); } while (0)
#define PG8_LDB(dst, b, h) do { _Pragma("unroll") for (int n = 0; n < 2; ++n) _Pragma("unroll") for (int k = 0; k < 2; ++k) dst[n][k] = *(const LAS bf16x8*)(lds + PG8_SB(b, h) + boff + n * 2048 + k * 1024); } while (0)
#define PG8_MMA(ai, bj, At, Bt) do { __builtin_amdgcn_s_setprio(1); _Pragma("unroll") for (int m = 0; m < 4; ++m) _Pragma("unroll") for (int n = 0; n < 2; ++n) _Pragma("unroll") for (int k = 0; k < 2; ++k) \
        acc[ai][bj][m][n] = __builtin_amdgcn_mfma_f32_16x16x32_bf16(Bt[n][k], At[m][k], acc[ai][bj][m][n], 0, 0, 0); __builtin_amdgcn_s_setprio(0); } while (0)
#define PG8_WAIT_V(n) asm volatile("s_waitcnt vmcnt(" #n ")" ::: "memory")
#define PG8_WAIT_L(n) asm volatile("s_waitcnt lgkmcnt(" #n ")" ::: "memory")
#define PG8_BAR __builtin_amdgcn_s_barrier()
#define PG8_SCHED __builtin_amdgcn_sched_barrier(0)
#define PG8_AOFFS(u, o00, o01, o10, o11) do { int R0_, C0_, R1_, C1_; stage_rc(tid * 16, R0_, C0_); stage_rc(tid * 16 + 8192, R1_, C1_); \
        o00 = (unsigned)(S.arow(u, R0_) * K + C0_ + (u).kt0 * BK) * 2u; o01 = (unsigned)(S.arow(u, R1_) * K + C1_ + (u).kt0 * BK) * 2u; \
        o10 = (unsigned)(S.arow(u, HALF + R0_) * K + C0_ + (u).kt0 * BK) * 2u; o11 = (unsigned)(S.arow(u, HALF + R1_) * K + C1_ + (u).kt0 * BK) * 2u; } while (0)
    Unit cur, nxt; int ui = 0;
    if (!S.next(0, cur)) return;
    f32x4 acc[2][2][4][2];
    { float z_; asm volatile("v_mov_b32 %0, 0" : "=v"(z_));
#pragma unroll
    for (int a = 0; a < 2; ++a)
#pragma unroll
        for (int b = 0; b < 2; ++b)
#pragma unroll
            for (int m = 0; m < 4; ++m)
#pragma unroll
                for (int n = 0; n < 2; ++n) acc[a][b][m][n] = (f32x4){z_, z_, z_, z_}; }
    bf16x8 At[4][2], B0[2][2], B1[2][2];
    const char* const Abase = (const char*)g.A;
    const char* cB = (const char*)g.Bt + (size_t)cur.e * g.estride + (size_t)cur.pn * tstep + (size_t)cur.kt0 * kstep;
    unsigned c00, c01, c10, c11;
    PG8_AOFFS(cur, c00, c01, c10, c11);
    PG8_STAGE_B(PG8_SB(0, 0), cB); PG8_STAGE_B(PG8_SB(0, 1), cB + hstep); PG8_STAGE_A(PG8_SA(0, 0), Abase, c00, c01); PG8_STAGE_A(PG8_SA(0, 1), Abase, c10, c11);
    if (wr == 1) PG8_BAR;
    PG8_WAIT_V(2); PG8_BAR;
    PG8_STAGE_B(PG8_SB(1, 0), cB + kstep); PG8_STAGE_A(PG8_SA(1, 0), Abase + kstep, c00, c01); PG8_STAGE_B(PG8_SB(1, 1), cB + hstep + kstep);
    PG8_WAIT_V(6); PG8_BAR;
    for (;;) {
        const bool has_next = S.next(ui + 1, nxt);
        const char* nB = has_next ? (const char*)g.Bt + (size_t)nxt.e * g.estride + (size_t)nxt.pn * tstep + (size_t)nxt.kt0 * kstep : cB;
        const int nt = cur.nt;
        int rn0 = 0, rn1 = 0, rn2 = 0, rn3 = 0;
        if (S.rowmap && has_next) { int R0_, C0_, R1_, C1_; stage_rc(tid * 16, R0_, C0_); stage_rc(tid * 16 + 8192, R1_, C1_);
            rn0 = S.arow(nxt, R0_); rn1 = S.arow(nxt, R1_); rn2 = S.arow(nxt, HALF + R0_); rn3 = S.arow(nxt, HALF + R1_); }
        for (int t = 0; t < nt; t += 2) {
            const bool last = (t == nt - 2);
            const char* a1 = Abase + (size_t)(t + 1) * kstep;
            const char* a2 = last ? Abase : Abase + (size_t)(t + 2) * kstep; const char* b2 = last ? nB : cB + (size_t)(t + 2) * kstep;
            const char* a3 = a2 + kstep; const char* b3 = b2 + kstep;
            PG8_LDB(B0, 0, 0); PG8_LDB(B1, 0, 1); PG8_SCHED; PG8_LDA(At, 0, 0); PG8_STAGE_A(PG8_SA(1, 1), a1, c10, c11);
            PG8_WAIT_V(8); PG8_WAIT_L(0); PG8_BAR; PG8_MMA(0, 0, At, B0); PG8_MMA(0, 1, At, B1); PG8_BAR; PG8_SCHED;
            if (last && has_next) {
                if (S.rowmap) { int R0_, C0_, R1_, C1_; stage_rc(tid * 16, R0_, C0_); stage_rc(tid * 16 + 8192, R1_, C1_);
                    c00 = (unsigned)(rn0 * K + C0_ + nxt.kt0 * BK) * 2u; c01 = (unsigned)(rn1 * K + C1_ + nxt.kt0 * BK) * 2u; c10 = (unsigned)(rn2 * K + C0_ + nxt.kt0 * BK) * 2u; c11 = (unsigned)(rn3 * K + C1_ + nxt.kt0 * BK) * 2u; }
                else { PG8_AOFFS(nxt, c00, c01, c10, c11); } }
            PG8_LDA(At, 0, 1); PG8_STAGE_B(PG8_SB(0, 0), b2); PG8_STAGE_B(PG8_SB(0, 1), b2 + hstep); PG8_STAGE_A(PG8_SA(0, 0), a2, c00, c01);
            PG8_WAIT_V(8); PG8_WAIT_L(0); PG8_BAR; PG8_MMA(1, 0, At, B0); PG8_MMA(1, 1, At, B1); PG8_BAR; PG8_SCHED;
            PG8_LDB(B0, 1, 0); PG8_LDB(B1, 1, 1); PG8_SCHED; PG8_LDA(At, 1, 0); PG8_STAGE_A(PG8_SA(0, 1), a2, c10, c11);
            PG8_WAIT_V(8); PG8_WAIT_L(0); PG8_BAR; PG8_MMA(0, 0, At, B0); PG8_MMA(0, 1, At, B1); PG8_BAR; PG8_SCHED;
            PG8_LDA(At, 1, 1); PG8_STAGE_B(PG8_SB(1, 0), b3); PG8_STAGE_B(PG8_SB(1, 1), b3 + hstep); PG8_STAGE_A(PG8_SA(1, 0), a3, c00, c01);
            PG8_WAIT_V(8); PG8_WAIT_L(0); PG8_BAR; PG8_MMA(1, 0, At, B0); PG8_MMA(1, 1, At, B1); PG8_BAR; PG8_SCHED;
        }
        if (wr == 0) PG8_BAR;
        if (Epi::SPLIT && cur.slab >= 0) {
            int fr_ = fr, fq_ = fq; asm volatile("" : "+v"(fr_), "+v"(fq_));
            float* sp = g.slabs + (size_t)cur.slab * 65536 + (size_t)(wr * 64 + fr_) * 256 + wc * 32 + (Epi::PERM ? 8 : 4) * fq_;
#pragma unroll
            for (int ai = 0; ai < 2; ++ai)
#pragma unroll
                for (int m = 0; m < 4; ++m)
#pragma unroll
                    for (int bj = 0; bj < 2; ++bj)
#pragma unroll
                        for (int n = 0; n < 2; ++n) *(f32x4*)(sp + (ai * HALF + m * 16) * 256 + bj * HALF + n * (Epi::PERM ? 4 : 16)) = acc[ai][bj][m][n];
        } else E(acc, cur, wr, wc, fr, fq);
        if (!has_next) break;
        { float z_; asm volatile("v_mov_b32 %0, 0" : "=v"(z_));
#pragma unroll
        for (int a = 0; a < 2; ++a)
#pragma unroll
            for (int b = 0; b < 2; ++b)
#pragma unroll
                for (int m = 0; m < 4; ++m)
#pragma unroll
                    for (int n = 0; n < 2; ++n) acc[a][b][m][n] = (f32x4){z_, z_, z_, z_}; }
        cur = nxt; cB = nB; ++ui;
        if (wr == 1) PG8_BAR;
    }
    PG8_WAIT_V(0);
    PG8_BAR;
#undef PG8_SA
#undef PG8_SB
#undef PG8_STAGE_A
#undef PG8_STAGE_B
#undef PG8_LDA
#undef PG8_LDB
#undef PG8_MMA
#undef PG8_WAIT_V
#undef PG8_WAIT_L
#undef PG8_BAR
#undef PG8_SCHED
#undef PG8_AOFFS
}
}

struct Args { const float* in[27]; float* out; unsigned char* ws; int ph_lo, ph_hi; };
struct Frame {
    ldsp_t lds; int tid, lane, wave, wave0, G, bid;
    const Args* pa; float* out; unsigned char* ws;
    const Args* pa0; float* out0; unsigned char* ws0;
};
enum { I_X = 0, I_C, I_CTX, I_CCTX, I_WMOD, I_BMOD, I_GMIX, I_GFFN, I_GFINAL, I_WIN, I_WOUT, I_CONVW, I_CONVB, I_RGWA, I_RGBA, I_RGWX, I_RGBX, I_RGLAM, I_RETDEC,
       I_FW1, I_FW3, I_FW2, I_MROUTER, I_MROUTERB, I_MW1, I_MW3, I_MW2 };

constexpr int TRS = 64 * 65 * 4;
struct TrItem { const float* W; bf16_t* WT; int ldw, k0, n0, ldt, drow0; float scale; };
__device__ __forceinline__ void tr_load(const TrItem& t, f32x4 (&v)[16], int lane) {
    const int r4 = lane >> 4, c4 = (lane & 15) * 4;
#pragma unroll
    for (int i = 0; i < 16; ++i) v[i] = *(const f32x4*)(t.W + (size_t)(t.k0 + 4 * i + r4) * t.ldw + t.n0 + c4);
}
__device__ __forceinline__ void tr_store(const TrItem& t, const f32x4 (&v)[16], LAS float* scr, int lane) {
    { const int r4 = lane >> 4, c4 = (lane & 15) * 4;
#pragma unroll
      for (int i = 0; i < 16; ++i) { LAS float* d = scr + (4 * i + r4) * 65 + c4; d[0] = v[i].x; d[1] = v[i].y; d[2] = v[i].z; d[3] = v[i].w; } }
    LDS_WAIT(); asm volatile("" ::: "memory");
    const int c = lane & 7; const float scale = t.scale;
#pragma unroll
    for (int j = 0; j < 8; ++j) { const int n = (lane >> 3) + 8 * j; const LAS float* sp = scr + (8 * c) * 65 + n;
        u32x4 o; o.x = pk2(sp[0 * 65] * scale, sp[1 * 65] * scale); o.y = pk2(sp[2 * 65] * scale, sp[3 * 65] * scale); o.z = pk2(sp[4 * 65] * scale, sp[5 * 65] * scale); o.w = pk2(sp[6 * 65] * scale, sp[7 * 65] * scale);
        *(u32x4*)(t.WT + (size_t)(t.drow0 + n) * t.ldt + t.k0 + 8 * c) = o; }
    LDS_WAIT(); asm volatile("" ::: "memory");
}
__device__ __forceinline__ TrItem up_item(const float* w1, const float* w3, int F, bf16_t* WT, int r) {
    const int per = 16 * (F / 64); const int which = r / per; r -= which * per;
    const int nblk = F / 64, kb = r / nblk, nb = r % nblk, n0 = nb * 64;
    return TrItem{which ? w3 : w1, WT, F, kb * 64, n0, D, (n0 / 128) * 256 + (n0 % 128) + which * 128, 1.0f};
}
__device__ __forceinline__ TrItem small_item(Frame& F, int r) {
    constexpr int I_IN = 16 * (INW / 64), I_OUT = 16 * (D / 64), I_UP = 2 * 16 * (DFF / 64);
    if (r < 2 * I_IN) { const int l = r / I_IN; r -= l * I_IN; const int nblk = INW / 64, kb = r / nblk, nb = r % nblk, n0 = nb * 64;
        const float sc = (n0 >= 1536 && n0 < 2048) ? 0.08838834764831845f : 1.0f;
        return TrItem{F.pa->in[I_WIN] + (size_t)l * D * INW, (bf16_t*)(F.ws + WS_WIN) + (size_t)l * INW * D, INW, kb * 64, n0, D, n0, sc}; }
    r -= 2 * I_IN;
    if (r < 2 * I_OUT) { const int l = r / I_OUT; r -= l * I_OUT; const int nblk = D / 64, kb = r / nblk, nb = r % nblk;
        return TrItem{F.pa->in[I_WOUT] + (size_t)l * D * D, (bf16_t*)(F.ws + WS_WOUT) + (size_t)l * D * D, D, kb * 64, nb * 64, D, nb * 64, 1.0f}; }
    r -= 2 * I_OUT;
    if (r < I_UP) return up_item(F.pa->in[I_FW1], F.pa->in[I_FW3], DFF, (bf16_t*)(F.ws + WS_WUP), r);
    r -= I_UP;
    { const int nblk = D / 64, kb = r / nblk, nb = r % nblk; return TrItem{F.pa->in[I_FW2], (bf16_t*)(F.ws + WS_WDN), D, kb * 64, nb * 64, DFF, nb * 64, 1.0f}; }
}
__device__ __forceinline__ TrItem moe_item(Frame& F, int it) {
    constexpr int I_UP = 2 * 16 * (DEXP / 64), I_DN = (DEXP / 64) * (D / 64), PER_E = I_UP + I_DN;
    const int e = it / PER_E; int r = it - e * PER_E;
    if (r < I_UP) return up_item(F.pa->in[I_MW1] + (size_t)e * D * DEXP, F.pa->in[I_MW3] + (size_t)e * D * DEXP, DEXP, (bf16_t*)(F.ws + WS_MOEUP) + (size_t)e * 2 * DEXP * D, r);
    r -= I_UP;
    { const int nblk = D / 64, kb = r / nblk, nb = r % nblk; return TrItem{F.pa->in[I_MW2] + (size_t)e * DEXP * D, (bf16_t*)(F.ws + WS_MOEDN) + (size_t)e * D * DEXP, D, kb * 64, nb * 64, DEXP, nb * 64, 1.0f}; }
}
__device__ __forceinline__ void phase_convert_small(Frame& F) {
    LAS float* scr = (LAS float*)(F.lds + F.wave * TRS);
    const int gw = F.bid * NWAVES + F.wave, NGW = F.G * NWAVES;
    constexpr int NITEMS = 2 * 16 * (INW / 64) + 2 * 16 * (D / 64) + 2 * 16 * (DFF / 64) + (DFF / 64) * (D / 64);
    if (gw < NITEMS) { TrItem cur = small_item(F, gw); f32x4 va[16], vb[16]; tr_load(cur, va, F.lane);
        for (int it = gw; it < NITEMS; it += 2 * NGW) {
            const bool h1 = it + NGW < NITEMS; TrItem n1 = cur; if (h1) { n1 = small_item(F, it + NGW); tr_load(n1, vb, F.lane); }
            tr_store(cur, va, scr, F.lane);
            if (!h1) break;
            const bool h2 = it + 2 * NGW < NITEMS; if (h2) { cur = small_item(F, it + 2 * NGW); tr_load(cur, va, F.lane); }
            tr_store(n1, vb, scr, F.lane);
            if (!h2) break; } }
    { const int gt = F.bid * NTHREADS + F.tid, NGT = F.G * NTHREADS; bf16_t* o = (bf16_t*)(F.ws + WS_RGW);
      for (int i = gt; i < 2 * 2 * 2 * 8 * 64 * 64; i += NGT) { const int c = i & 63, dp = (i >> 6) & 63, blk = (i >> 12) & 7, gate = (i >> 15) & 1, dir = (i >> 16) & 1, l = i >> 17;
          const float* src = gate ? F.pa->in[I_RGWX] : F.pa->in[I_RGWA]; o[i] = (bf16_t)f2bf(src[((((size_t)l * 2 + dir) * 8 + blk) * 64 + c) * 64 + dp]); } }
    { const int gt = F.bid * NTHREADS + F.tid, NGT = F.G * NTHREADS; float* ct = (float*)(F.ws + WS_ROPE); float* st = ct + 4096 * 64;
      for (int i = gt; i < 4096 * 64; i += NGT) { const int pos = i >> 6, fi = i & 63; const float p = (float)((fi < 32) ? (pos >> 6) : (pos & 63));
          const float inv = powf(10000.0f, -(float)(fi & 31) / 32.0f); const float ang = p * inv;
          const double a = (double)ang; const double kq = __builtin_rint(a * 0.63661977236758134308); const double rr = a - kq * 1.57079632679489661923; const int q = ((int)kq) & 3;
          const double r2 = rr * rr;
          const double sn = rr * (1.0 + r2 * (-1.0 / 6 + r2 * (1.0 / 120 + r2 * (-1.0 / 5040 + r2 * (1.0 / 362880 + r2 * (-1.0 / 39916800))))));
          const double cs = 1.0 + r2 * (-0.5 + r2 * (1.0 / 24 + r2 * (-1.0 / 720 + r2 * (1.0 / 40320 + r2 * (-1.0 / 3628800 + r2 * (1.0 / 479001600))))));
          const double c_ = (q == 0) ? cs : (q == 1) ? -sn : (q == 2) ? -cs : sn; const double s_ = (q == 0) ? sn : (q == 1) ? cs : (q == 2) ? -sn : -cs;
          ct[i] = (float)c_; st[i] = (float)s_; } }
}
__device__ __forceinline__ void phase_convert_moe(Frame& F) {
    LAS float* scr = (LAS float*)(F.lds + F.wave * TRS);
    const int gw = F.bid * NWAVES + F.wave, NGW = F.G * NWAVES;
    constexpr int NITEMS = NE * (2 * 16 * (DEXP / 64) + (DEXP / 64) * (D / 64));
    if (gw < NITEMS) { TrItem cur = moe_item(F, gw); f32x4 va[16], vb[16]; tr_load(cur, va, F.lane);
        for (int it = gw; it < NITEMS; it += 2 * NGW) {
            const bool h1 = it + NGW < NITEMS; TrItem n1 = cur; if (h1) { n1 = moe_item(F, it + NGW); tr_load(n1, vb, F.lane); }
            tr_store(cur, va, scr, F.lane);
            if (!h1) break;
            const bool h2 = it + 2 * NGW < NITEMS; if (h2) { cur = moe_item(F, it + 2 * NGW); tr_load(cur, va, F.lane); }
            tr_store(n1, vb, scr, F.lane);
            if (!h2) break; } }
}
__device__ __forceinline__ void phase_mod(Frame& F) {
    LAS float* sc = (LAS float*)F.lds;
    LAS float* red = (LAS float*)(F.lds + 9 * 1024 * 4);
    for (int i = F.tid; i < 9 * 1024; i += NTHREADS) { const int r = i >> 10, k = i & 1023; const float v = (r < 8) ? F.pa->in[I_C][r * 1024 + k] : F.pa->in[I_CCTX][k]; sc[i] = v / (1.0f + __expf(-v)); }
    __syncthreads();
    for (int strip = F.bid; strip < 2 * 6144 / 64; strip += F.G) {
        const int l = strip / 96, j = (strip % 96) * 64 + F.lane;
        const float* w = F.pa->in[I_WMOD] + (size_t)l * 1024 * 6144 + j;
        float a[9];
#pragma unroll
        for (int r = 0; r < 9; ++r) a[r] = 0.f;
        const int k0 = F.wave * 128;
#pragma unroll 4
        for (int k = k0; k < k0 + 128; ++k) { const float wv = w[(size_t)k * 6144];
#pragma unroll
            for (int r = 0; r < 9; ++r) a[r] += sc[r * 1024 + k] * wv; }
#pragma unroll
        for (int r = 0; r < 9; ++r) red[(F.wave * 9 + r) * 64 + F.lane] = a[r];
        __syncthreads();
        for (int i = F.tid; i < 9 * 64; i += NTHREADS) { const int r = i >> 6, jj = i & 63; float s = 0.f;
#pragma unroll
            for (int w8 = 0; w8 < 8; ++w8) s += red[(w8 * 9 + r) * 64 + jj];
            const int col = (strip % 96) * 64 + jj; s += F.pa->in[I_BMOD][l * 6144 + col];
            if (r < 8) ((float*)(F.ws + WS_MODLAT))[((size_t)l * 8 + r) * 6144 + col] = s; else ((float*)(F.ws + WS_MODCTX))[(size_t)l * 6144 + col] = s; }
        __syncthreads();
    }
}

__device__ __forceinline__ void norm_row(const u32x2 (&xw)[4], const f32x4 (&Am)[4], const f32x4 (&Sh)[4], bf16_t* orow, int lane, f32x4 (&y)[4]) {
    f32x4 v[4]; float ss = 0.f;
#pragma unroll
    for (int j = 0; j < 4; ++j) { const u32x2 w = xw[j]; v[j] = (f32x4){bf2f(w.x & 0xffffu), __uint_as_float(w.x & 0xffff0000u), bf2f(w.y & 0xffffu), __uint_as_float(w.y & 0xffff0000u)};
        ss += (v[j].x * v[j].x + v[j].y * v[j].y) + (v[j].z * v[j].z + v[j].w * v[j].w); }
    const float rstd = 1.0f / sqrtf(wave_sum(ss) * (1.0f / D) + EPS);
    u32x2* o8 = (u32x2*)orow + lane;
#pragma unroll
    for (int j = 0; j < 4; ++j) { y[j] = (v[j] * rstd) * Am[j] + Sh[j]; o8[64 * j] = (u32x2){pk2(y[j].x, y[j].y), pk2(y[j].z, y[j].w)}; }
}
struct SlabRed { const float* slab; int S; const float* gate; const float* xold; float* xnew; };
__device__ __forceinline__ void norm_row_v(f32x4 (&v)[4], const float* g, const float* shift, const float* scale, bf16_t* orow, int lane) {
    float ss = 0.f;
#pragma unroll
    for (int j = 0; j < 4; ++j) ss += (v[j].x * v[j].x + v[j].y * v[j].y) + (v[j].z * v[j].z + v[j].w * v[j].w);
    const float rstd = 1.0f / sqrtf(wave_sum(ss) * (1.0f / D) + EPS);
    u32x2* o8 = (u32x2*)orow + lane;
#pragma unroll
    for (int j = 0; j < 4; ++j) { const f32x4 gg = ((const f32x4*)g)[lane + 64 * j], sh = ((const f32x4*)shift)[lane + 64 * j], sl = ((const f32x4*)scale)[lane + 64 * j];
        const f32x4 y = (v[j] * rstd) * gg * (sl + 1.0f) + sh;
        u32x2 w; w.x = pk2(y.x, y.y); w.y = pk2(y.z, y.w); o8[64 * j] = w; }
}
__device__ __forceinline__ void phase_norm(Frame& F, int l, int sel, const float* xlat, const bf16_t* xb, const float* xctx, int nrows, const SlabRed sr) {
    const int gw = F.bid * NWAVES + F.wave, NGW = F.G * NWAVES;
    const float* g = (sel ? F.pa->in[I_GFFN] : F.pa->in[I_GMIX]) + l * D; const int so = sel ? 3072 : 0;
    bf16_t* HX = (bf16_t*)(F.ws + WS_HX);
    const int nlat = nrows < NLAT ? nrows : NLAT; const int per = (nlat + NGW - 1) / NGW, r_lo = gw * per, r_hi = (r_lo + per < nlat) ? r_lo + per : nlat;
    int curb = -1; f32x4 Am[4], Sh[4];
    for (int row0 = r_lo; row0 < r_hi; row0 += 4) {
        f32x4 v[4][4];
#pragma unroll
        for (int u = 0; u < 4; ++u) { const int row = (row0 + u < r_hi) ? row0 + u : row0;
            if (xb) { const u32x2* xr = (const u32x2*)(xb + (size_t)row * D) + F.lane;
#pragma unroll
                for (int j = 0; j < 4; ++j) { const u32x2 w = xr[64 * j]; v[u][j] = (f32x4){bf2f(w.x & 0xffffu), __uint_as_float(w.x & 0xffff0000u), bf2f(w.y & 0xffffu), __uint_as_float(w.y & 0xffff0000u)}; } }
            else { const f32x4* xr = (const f32x4*)(xlat + (size_t)row * D) + F.lane;
#pragma unroll
                for (int j = 0; j < 4; ++j) v[u][j] = xr[64 * j]; } }
#pragma unroll
        for (int u = 0; u < 4; ++u) { const int row = row0 + u; if (row >= r_hi) continue;
            const int b = row / SEQ;
            if (b != curb) { curb = b; const float* mod = (const float*)(F.ws + WS_MODLAT) + ((size_t)l * 8 + b) * 6144 + so;
#pragma unroll
                for (int j = 0; j < 4; ++j) { Am[j] = ((const f32x4*)g)[F.lane + 64 * j] * (((const f32x4*)(mod + 1024))[F.lane + 64 * j] + 1.0f); Sh[j] = ((const f32x4*)mod)[F.lane + 64 * j]; } }
            float ss = 0.f;
#pragma unroll
            for (int j = 0; j < 4; ++j) ss += (v[u][j].x * v[u][j].x + v[u][j].y * v[u][j].y) + (v[u][j].z * v[u][j].z + v[u][j].w * v[u][j].w);
            const float rstd = 1.0f / sqrtf(wave_sum(ss) * (1.0f / D) + EPS);
            u32x2* o8 = (u32x2*)(HX + (size_t)row * D) + F.lane;
#pragma unroll
            for (int j = 0; j < 4; ++j) { const f32x4 y = (v[u][j] * rstd) * Am[j] + Sh[j]; o8[64 * j] = (u32x2){pk2(y.x, y.y), pk2(y.z, y.w)}; } }
    }
    for (int row = NLAT + gw; row < nrows; row += NGW) {
        const float* mod = (const float*)(F.ws + WS_MODCTX) + (size_t)l * 6144;
        f32x4 v[4];
        if (sr.slab == nullptr) { const f32x4* xr = (const f32x4*)(xctx + (size_t)(row - NLAT) * D) + F.lane;
#pragma unroll
            for (int j = 0; j < 4; ++j) v[j] = xr[64 * j]; }
        else { const int rc = row - NLAT, pmr = rc >> 8, r = rc & 255;
#pragma unroll
            for (int j = 0; j < 4; ++j) { f32x4 a = zero4(); const float* sp = sr.slab + (size_t)((pmr + 8 * j) * sr.S) * 65536 + (size_t)r * 256 + 4 * F.lane;
                f32x4 t8[8];
#pragma unroll
                for (int q = 0; q < 8; ++q) t8[q] = (q < sr.S) ? *(const f32x4*)(sp + (size_t)q * 65536) : zero4();
#pragma unroll
                for (int q = 0; q < 8; ++q) a += t8[q];
                v[j] = ((const f32x4*)(sr.xold + (size_t)rc * D))[F.lane + 64 * j] + ((const f32x4*)sr.gate)[F.lane + 64 * j] * a;
                ((f32x4*)(sr.xnew + (size_t)rc * D))[F.lane + 64 * j] = v[j]; } }
        norm_row_v(v, g, mod + so, mod + so + 1024, HX + (size_t)row * D, F.lane);
    }
}
__device__ __forceinline__ void moe_reduce(Frame& F, int k) {
    const int* meta = (const int*)(F.ws + MOE_META) + 9 * k; const int npan = meta[8], gsz = npan - 128;
    if (gsz <= 0) return;
    const int S = pg8::split_factor(npan * 4, F.G, DEXP / 64, MAXSLAB_M); if (S < 2) return;
    const int gw = F.bid * NWAVES + F.wave, NGW = F.G * NWAVES;
    const int* ptok = (const int*)(F.ws + MOE_PTOK) + k * MROWS; const float* pw = (const float*)(F.ws + MOE_PW) + k * MROWS;
    const float* slab = (const float*)(F.ws + WS_SLABM); const float* gate_lat = (const float*)(F.ws + WS_MODLAT) + (size_t)8 * 6144 + 5120;
    for (int rr = NLAT + gw; rr < npan * 256; rr += NGW) { const int tok = ptok[rr]; if (tok < 0) continue; const float w = pw[rr];
        const int pmr = (rr - NLAT) >> 8, r = rr & 255; u32x2* xr = (u32x2*)((bf16_t*)((char*)F.out + XB_OFF) + (size_t)tok * D); const f32x4* gt = (const f32x4*)(gate_lat + (size_t)(tok / SEQ) * 6144);
#pragma unroll
        for (int j = 0; j < 4; ++j) { f32x4 a = zero4(); const float* sp = slab + (size_t)((pmr + gsz * j) * S) * 65536 + (size_t)r * 256 + 4 * F.lane;
            for (int q = 0; q < S; ++q) a += *(const f32x4*)(sp + (size_t)q * 65536);
            const u32x2 xo = xr[F.lane + 64 * j]; const f32x4 xv = {bf2f(xo.x & 0xffffu), __uint_as_float(xo.x & 0xffff0000u), bf2f(xo.y & 0xffffu), __uint_as_float(xo.y & 0xffff0000u)};
            const f32x4 y = xv + (gt[F.lane + 64 * j] * w) * a; xr[F.lane + 64 * j] = (u32x2){pk2(y.x, y.y), pk2(y.z, y.w)}; } }
}
__device__ __forceinline__ void phase_norm_router(Frame& F, const bf16_t* xb) {
    constexpr int l = 1;
    LAS float* wr = (LAS float*)F.lds;
    LAS int* le = (LAS int*)(F.lds + 32768);
    for (int i = F.tid; i < 1024 * 8 / 4; i += NTHREADS) ((LAS f32x4*)wr)[i] = ((const f32x4*)F.pa->in[I_MROUTER])[i];
    __syncthreads();
    const float* g = F.pa->in[I_GFFN] + l * D; bf16_t* HX = (bf16_t*)(F.ws + WS_HX);
    int* toke = (int*)(F.ws + MOE_TOKE); float* tokw = (float*)(F.ws + MOE_TOKW);
    for (int wg = F.bid; wg < NLAT / 128; wg += F.G) {
        u32x2 nx[4]; f32x4 Am[4], Sh[4];
        { const float* mod = (const float*)(F.ws + WS_MODLAT) + ((size_t)l * 8 + (wg * 128) / SEQ) * 6144 + 3072;
#pragma unroll
          for (int j = 0; j < 4; ++j) { Am[j] = ((const f32x4*)g)[F.lane + 64 * j] * (((const f32x4*)(mod + 1024))[F.lane + 64 * j] + 1.0f); Sh[j] = ((const f32x4*)mod)[F.lane + 64 * j]; } }
        { const u32x2* xr = (const u32x2*)(xb + (size_t)(wg * 128 + F.wave * 16) * D) + F.lane;
#pragma unroll
          for (int j = 0; j < 4; ++j) nx[j] = xr[64 * j]; }
        for (int i = 0; i < 16; ++i) { const int tl = F.wave * 16 + i, row = wg * 128 + tl;
            u32x2 cx[4];
#pragma unroll
            for (int j = 0; j < 4; ++j) cx[j] = nx[j];
            { const int rn = (i < 15) ? row + 1 : row; const u32x2* xr = (const u32x2*)(xb + (size_t)rn * D) + F.lane;
#pragma unroll
              for (int j = 0; j < 4; ++j) nx[j] = xr[64 * j]; }
            f32x4 y[4]; norm_row(cx, Am, Sh, HX + (size_t)row * D, F.lane, y);
            float lg[8];
#pragma unroll
            for (int e = 0; e < 8; ++e) lg[e] = 0.f;
#pragma unroll
            for (int j = 0; j < 4; ++j)
#pragma unroll
                for (int q = 0; q < 4; ++q) { const int k = 4 * F.lane + 256 * j + q; const f32x4 w0 = *(const LAS f32x4*)(wr + k * 8), w1 = *(const LAS f32x4*)(wr + k * 8 + 4); const float yv = y[j][q];
                    lg[0] += yv * w0.x; lg[1] += yv * w0.y; lg[2] += yv * w0.z; lg[3] += yv * w0.w; lg[4] += yv * w1.x; lg[5] += yv * w1.y; lg[6] += yv * w1.z; lg[7] += yv * w1.w; }
#pragma unroll
            for (int e = 0; e < 8; ++e) lg[e] = wave_sum(lg[e]) + F.pa->in[I_MROUTERB][e];
            int e0 = 0; float v0 = lg[0];
#pragma unroll
            for (int e = 1; e < 8; ++e) if (lg[e] > v0) { v0 = lg[e]; e0 = e; }
            int e1 = -1; float v1 = -3.0e38f;
#pragma unroll
            for (int e = 0; e < 8; ++e) if (e != e0 && lg[e] > v1) { v1 = lg[e]; e1 = e; }
            const float w0 = 1.0f / (1.0f + __expf(v1 - v0));
            if (F.lane == 0) { toke[row] = e0 | (e1 << 8); tokw[2 * row] = w0; tokw[2 * row + 1] = 1.0f - w0; le[tl] = e0 | (e1 << 8); }
        }
        __syncthreads();
        if (F.tid < 16) { const int k = F.tid >> 3, e = F.tid & 7; int c = 0; for (int t = 0; t < 128; ++t) c += (((le[t] >> (8 * k)) & 0xff) == e) ? 1 : 0; ((int*)(F.ws + MOE_CNT))[wg * 16 + F.tid] = c; }
        __syncthreads();
    }
}
__device__ __forceinline__ void phase_moe_sort(Frame& F) {
    LAS int* tot = (LAS int*)F.lds;
    LAS int* pre = tot + 16;
    LAS int* seg = tot + 32;
    LAS int* le = tot + 64;
    const int* cnt = (const int*)(F.ws + MOE_CNT); const int* toke = (const int*)(F.ws + MOE_TOKE); const float* tokw = (const float*)(F.ws + MOE_TOKW);
    int* ptok = (int*)(F.ws + MOE_PTOK); float* pw = (float*)(F.ws + MOE_PW); int* meta = (int*)(F.ws + MOE_META);
    for (int wg = F.bid; wg < NLAT / 128; wg += F.G) {
        if (F.tid < 16) { int t = 0, p = 0; for (int w = 0; w < 256; ++w) { const int c = cnt[w * 16 + F.tid]; t += c; p += (w < wg) ? c : 0; } tot[F.tid] = t; pre[F.tid] = p; }
        if (F.tid >= 64 && F.tid < 192) le[F.tid - 64] = toke[wg * 128 + F.tid - 64];
        __syncthreads();
        if (F.tid < 2) { int s = 0; for (int e = 0; e < 8; ++e) { seg[F.tid * 9 + e] = s; s += (tot[F.tid * 8 + e] + 255) & ~255; } seg[F.tid * 9 + 8] = s; }
        __syncthreads();
        if (F.tid < 256) { const int k = F.tid >> 7, t = F.tid & 127; const int e = (le[t] >> (8 * k)) & 0xff; int rank = 0; for (int u = 0; u < t; ++u) rank += (((le[u] >> (8 * k)) & 0xff) == e) ? 1 : 0;
            const int pos = seg[k * 9 + e] + pre[k * 8 + e] + rank; const int tok = wg * 128 + t; ptok[k * MROWS + pos] = tok; pw[k * MROWS + pos] = tokw[2 * tok + k]; ((int*)(F.ws + MOE_PPOS))[k * NLAT + tok] = pos; }
        if (wg < 16) { const int k = wg >> 3, e = wg & 7; const int a = seg[k * 9 + e] + tot[k * 8 + e], b = seg[k * 9 + e + 1]; for (int p = a + F.tid; p < b; p += NTHREADS) { ptok[k * MROWS + p] = -1; pw[k * MROWS + p] = 0.f; } }
        if (wg == 0 && F.tid < 18) meta[F.tid] = seg[F.tid] >> 8;
        __syncthreads();
    }
}
__device__ __forceinline__ void phase_final_a(Frame& F) {
    const int gw = F.bid * NWAVES + F.wave, NGW = F.G * NWAVES; const float* g = F.pa->in[I_GFINAL];
    const bf16_t* xb = (const bf16_t*)((const char*)F.out + XB_OFF); bf16_t* xc = (bf16_t*)(F.ws + WS_XCOPY);
    const int* meta = (const int*)(F.ws + MOE_META) + 9; const int npan = meta[8], gsz = npan - 128;
    const int S = (gsz > 0) ? pg8::split_factor(npan * 4, F.G, DEXP / 64, MAXSLAB_M) : 1;
    const int* ppos = (const int*)(F.ws + MOE_PPOS) + NLAT; const float* pw = (const float*)(F.ws + MOE_PW) + MROWS;
    const float* slab = (const float*)(F.ws + WS_SLABM); const float* gate_lat = (const float*)(F.ws + WS_MODLAT) + (size_t)8 * 6144 + 5120;
    for (int row0 = gw; row0 < NLAT; row0 += 4 * NGW) {
        u32x2 w[4][4]; int rr[4];
#pragma unroll
        for (int u = 0; u < 4; ++u) { const int row = (row0 + u * NGW < NLAT) ? row0 + u * NGW : row0; const u32x2* xr = (const u32x2*)(xb + (size_t)row * D) + F.lane; rr[u] = ppos[row];
#pragma unroll
            for (int j = 0; j < 4; ++j) w[u][j] = xr[64 * j]; }
#pragma unroll
        for (int u = 0; u < 4; ++u) { const int row = row0 + u * NGW; if (row >= NLAT) continue;
            f32x4 v[4];
#pragma unroll
            for (int j = 0; j < 4; ++j) v[j] = (f32x4){bf2f(w[u][j].x & 0xffffu), __uint_as_float(w[u][j].x & 0xffff0000u), bf2f(w[u][j].y & 0xffffu), __uint_as_float(w[u][j].y & 0xffff0000u)};
            if (S >= 2 && rr[u] >= NLAT) { const float wt = pw[rr[u]]; const int pmr = (rr[u] - NLAT) >> 8, r = rr[u] & 255; const f32x4* gt = (const f32x4*)(gate_lat + (size_t)(row / SEQ) * 6144);
#pragma unroll
                for (int j = 0; j < 4; ++j) { f32x4 a = zero4(); const float* sp = slab + (size_t)((pmr + gsz * j) * S) * 65536 + (size_t)r * 256 + 4 * F.lane;
                    for (int q = 0; q < S; ++q) a += *(const f32x4*)(sp + (size_t)q * 65536);
                    v[j] += (gt[F.lane + 64 * j] * wt) * a; } }
            if (row < NLAT / 2) { float ss = 0.f;
#pragma unroll
                for (int j = 0; j < 4; ++j) ss += (v[j].x * v[j].x + v[j].y * v[j].y) + (v[j].z * v[j].z + v[j].w * v[j].w);
                const float rstd = 1.0f / sqrtf(wave_sum(ss) * (1.0f / D) + EPS); f32x4* o = (f32x4*)(F.out + (size_t)row * D) + F.lane;
#pragma unroll
                for (int j = 0; j < 4; ++j) o[64 * j] = (v[j] * rstd) * ((const f32x4*)g)[F.lane + 64 * j]; }
            else { u32x2* o = (u32x2*)(xc + (size_t)(row - NLAT / 2) * D) + F.lane;
#pragma unroll
                for (int j = 0; j < 4; ++j) o[64 * j] = (u32x2){pk2(v[j].x, v[j].y), pk2(v[j].z, v[j].w)}; } }
    }
}
__device__ __forceinline__ void phase_final_b(Frame& F) {
    const int gw = F.bid * NWAVES + F.wave, NGW = F.G * NWAVES; const float* g = F.pa->in[I_GFINAL]; const bf16_t* xc = (const bf16_t*)(F.ws + WS_XCOPY);
    for (int row0 = NLAT / 2 + gw; row0 < NLAT; row0 += 4 * NGW) {
        u32x2 w[4][4];
#pragma unroll
        for (int u = 0; u < 4; ++u) { const int row = (row0 + u * NGW < NLAT) ? row0 + u * NGW : row0; const u32x2* xr = (const u32x2*)(xc + (size_t)(row - NLAT / 2) * D) + F.lane;
#pragma unroll
            for (int j = 0; j < 4; ++j) w[u][j] = xr[64 * j]; }
#pragma unroll
        for (int u = 0; u < 4; ++u) { const int row = row0 + u * NGW; if (row >= NLAT) continue;
            f32x4 v[4]; float ss = 0.f;
#pragma unroll
            for (int j = 0; j < 4; ++j) { v[j] = (f32x4){bf2f(w[u][j].x & 0xffffu), __uint_as_float(w[u][j].x & 0xffff0000u), bf2f(w[u][j].y & 0xffffu), __uint_as_float(w[u][j].y & 0xffff0000u)};
                ss += (v[j].x * v[j].x + v[j].y * v[j].y) + (v[j].z * v[j].z + v[j].w * v[j].w); }
            const float rstd = 1.0f / sqrtf(wave_sum(ss) * (1.0f / D) + EPS); f32x4* o = (f32x4*)(F.out + (size_t)row * D) + F.lane;
#pragma unroll
            for (int j = 0; j < 4; ++j) o[64 * j] = (v[j] * rstd) * ((const f32x4*)g)[F.lane + 64 * j]; }
    }
}

__device__ __forceinline__ bool fresh(Frame& F) {
    int l_ = (int)__builtin_amdgcn_mbcnt_hi(~0u, __builtin_amdgcn_mbcnt_lo(~0u, 0u)); asm volatile("" : "+v"(l_));
    int w_ = F.wave0; asm volatile("" : "+s"(w_));
    F.lane = l_; F.wave = w_; F.tid = w_ * 64 + l_;
    int b_ = blockIdx.x; asm volatile("" : "+s"(b_)); F.bid = b_;
    GAS unsigned char* w2_ = (GAS unsigned char*)F.ws0; asm volatile("" : "+s"(w2_)); F.ws = (unsigned char*)w2_;
    F.out = F.out0; F.pa = F.pa0;
    return true;
}
struct Item { int b, s, row0, seqbase, t0, seqlen; bool is_ctx; };
__device__ __forceinline__ Item item_info(int item) {
    Item it; it.b = item / SPB; it.s = item % SPB;
    if (it.s < 2) { it.is_ctx = true; it.seqbase = NLAT + it.b * CTXL; it.t0 = it.s * CHK; it.seqlen = CTXL; }
    else { it.is_ctx = false; it.seqbase = it.b * SEQ; it.t0 = (it.s - 2) * CHK; it.seqlen = SEQ; }
    it.row0 = it.seqbase + it.t0; return it;
}
constexpr int UCP = 144;
constexpr int TP = 272;
constexpr int TILEB = 128 * TP;
constexpr int VP = 288;
constexpr int TILEV = 128 * VP;

__device__ __forceinline__ unsigned tr_lane_addr(ldsp_t tile, int lane) { return (unsigned)(__SIZE_TYPE__)tile + (unsigned)((4 * (lane >> 4) + ((lane & 15) >> 2)) * VP + 8 * (lane & 3)); }
__device__ __forceinline__ bf16x8 mk_frag(u32x2 lo, u32x2 hi) { const u32x4 v = {lo.x, lo.y, hi.x, hi.y}; return __builtin_bit_cast(bf16x8, v); }
template <int OFF> __device__ __forceinline__ bf16x8 tr1(unsigned addr) {
    u32x2 a0, a1;
    asm volatile("ds_read_b64_tr_b16 %0, %2 offset:%3\n\tds_read_b64_tr_b16 %1, %2 offset:%4\n\ts_waitcnt lgkmcnt(0)" : "=&v"(a0), "=&v"(a1) : "v"(addr), "i"(OFF), "i"(OFF + 16 * VP) : "memory");
    return mk_frag(a0, a1);
}
template <int OFF> __device__ __forceinline__ void tr4(unsigned addr, bf16x8& f0, bf16x8& f1, bf16x8& f2, bf16x8& f3) {
    u32x2 a0, a1, b0, b1, c0, c1, d0, d1;
    asm volatile("ds_read_b64_tr_b16 %0, %8 offset:%9\n\tds_read_b64_tr_b16 %1, %8 offset:%10\n\tds_read_b64_tr_b16 %2, %8 offset:%11\n\tds_read_b64_tr_b16 %3, %8 offset:%12\n\t"
                 "ds_read_b64_tr_b16 %4, %8 offset:%13\n\tds_read_b64_tr_b16 %5, %8 offset:%14\n\tds_read_b64_tr_b16 %6, %8 offset:%15\n\tds_read_b64_tr_b16 %7, %8 offset:%16\n\ts_waitcnt lgkmcnt(0)"
                 : "=&v"(a0), "=&v"(a1), "=&v"(b0), "=&v"(b1), "=&v"(c0), "=&v"(c1), "=&v"(d0), "=&v"(d1)
                 : "v"(addr), "i"(OFF), "i"(OFF + 16 * VP), "i"(OFF + 32), "i"(OFF + 32 + 16 * VP), "i"(OFF + 64), "i"(OFF + 64 + 16 * VP), "i"(OFF + 96), "i"(OFF + 96 + 16 * VP) : "memory");
    f0 = mk_frag(a0, a1); f1 = mk_frag(b0, b1); f2 = mk_frag(c0, c1); f3 = mk_frag(d0, d1);
}

__device__ __forceinline__ void build_decay(Frame& F, int l) {
    LAS float* dec = (LAS float*)(F.lds + LDS_DEC);
    for (int i = F.tid; i < 2 * 4 * 132; i += NTHREADS) { const int n = i % 132, dh = i / 132; const float x = F.pa->in[I_RETDEC][l * 8 + dh]; const float lg = -log1pf(expf(-x)); dec[i] = expf((float)n * lg); }
}

struct RgStep { bf16x8 bwa[2], bwx[2]; float lam, ba, bx, carry; };
template <bool FINAL>
__device__ __forceinline__ void rg_load_step(RgStep& R, Frame& F, const bf16_t* wgt, int l, int dir, int item, int blk, int n, int lane) {
    const int fr = lane & 15, fq = lane >> 4;
    const bf16_t* wa = wgt + ((size_t)(0 * 8 + blk) * 64 + 16 * n + fr) * 64 + 8 * fq;
    const bf16_t* wx = wgt + ((size_t)(1 * 8 + blk) * 64 + 16 * n + fr) * 64 + 8 * fq;
    R.bwa[0] = *(const bf16x8*)wa; R.bwa[1] = *(const bf16x8*)(wa + 32); R.bwx[0] = *(const bf16x8*)wx; R.bwx[1] = *(const bf16x8*)(wx + 32);
    const int ch = blk * 64 + 16 * n + fr, pi = (l * 2 + dir) * 512 + ch;
    R.lam = F.pa->in[I_RGLAM][pi]; R.ba = F.pa->in[I_RGBA][pi]; R.bx = F.pa->in[I_RGBX][pi];
    R.carry = FINAL ? ((const float*)(F.ws + WS_CARRY))[((size_t)item * 2 + dir) * 512 + ch] : 0.f;
}
template <bool FINAL, int DIR>
__device__ __forceinline__ void rg_dir(ldsp_t ucw, const bf16x8 (&af)[8][2], const RgStep& R, int n, int lane, f32x4 (&hsum)[8], float& Atot, float& Htot) {
    const int fr = lane & 15, fq = lane >> 4;
    constexpr float L2E_ = 1.4426950408889634f;
    const float ba2 = -L2E_ * R.ba, bx2 = -L2E_ * R.bx, cl2 = -8.0f * L2E_ * log1pf(expf(-R.lam)), carry = R.carry;
    const bf16x8 bwa[2] = {R.bwa[0], R.bwa[1]}, bwx[2] = {R.bwx[0], R.bwx[1]};
    f32x4 ar[8], ai[8];
#pragma unroll
    for (int m = 0; m < 8; ++m) { ar[m] = zero4(); ai[m] = zero4(); }
#pragma unroll
    for (int m = 0; m < 8; ++m)
#pragma unroll
        for (int ks = 0; ks < 2; ++ks) { ar[m] = __builtin_amdgcn_mfma_f32_16x16x32_bf16(af[m][ks], bwa[ks], ar[m], 0, 0, 0); ai[m] = __builtin_amdgcn_mfma_f32_16x16x32_bf16(af[m][ks], bwx[ks], ai[m], 0, 0, 0); }
    const unsigned uo = (unsigned)(32 * fq * UCP + (16 * n + fr) * 2);
#pragma unroll
    for (int m = 0; m < 8; ++m)
#pragma unroll
        for (int jj = 0; jj < 4; ++jj) {
            const float r = __builtin_amdgcn_rcpf(1.0f + __builtin_amdgcn_exp2f(__builtin_fmaf(ar[m][jj], -1.4426950408889634f, ba2)));
            const float ig = __builtin_amdgcn_rcpf(1.0f + __builtin_amdgcn_exp2f(__builtin_fmaf(ai[m][jj], -1.4426950408889634f, bx2)));
            const float a = __builtin_amdgcn_exp2f(cl2 * r);
            const float u = bf2f(*(const LAS bf16_t*)(ucw + uo + (4 * m + jj) * UCP));
            ar[m][jj] = a; ai[m][jj] = __builtin_amdgcn_sqrtf(__builtin_fmaf(-a, a, 1.0f)) * ig * u; }
    float gA = 1.f, gH = 0.f;
#pragma unroll
    for (int mm = 0; mm < 8; ++mm) { const int m = DIR ? 7 - mm : mm;
#pragma unroll
        for (int j4 = 0; j4 < 4; ++j4) { const int jj = DIR ? 3 - j4 : j4; gH = __builtin_fmaf(ar[m][jj], gH, ai[m][jj]); gA *= ar[m][jj]; } }
    const float A0 = lane_bcast(gA, fr), H0 = lane_bcast(gH, fr), A1 = lane_bcast(gA, fr + 16), H1 = lane_bcast(gH, fr + 16), A2 = lane_bcast(gA, fr + 32), H2 = lane_bcast(gH, fr + 32), A3 = lane_bcast(gA, fr + 48), H3 = lane_bcast(gH, fr + 48);
    if (FINAL) { float h = carry;
        if (!DIR) { if (fq > 0) h = A0 * h + H0; if (fq > 1) h = A1 * h + H1; if (fq > 2) h = A2 * h + H2; }
        else { if (fq < 3) h = A3 * h + H3; if (fq < 2) h = A2 * h + H2; if (fq < 1) h = A1 * h + H1; }
#pragma unroll
        for (int mm = 0; mm < 8; ++mm) { const int m = DIR ? 7 - mm : mm;
#pragma unroll
            for (int j4 = 0; j4 < 4; ++j4) { const int jj = DIR ? 3 - j4 : j4; h = __builtin_fmaf(ar[m][jj], h, ai[m][jj]); hsum[m][jj] += h; } } }
    if (!DIR) Htot = A3 * (A2 * (A1 * H0 + H1) + H2) + H3; else Htot = A0 * (A1 * (A2 * H3 + H2) + H1) + H0;
    Atot = (A0 * A1) * (A2 * A3);
}
template <bool FINAL>
__device__ __forceinline__ void rg_part(Frame& F, int l, int item, const Item& it, const int blk, const int n0, const int n1) {
    const bf16_t* P = (const bf16_t*)(F.ws + WS_PA);
    int lane = F.lane;
    ldsp_t ucw = F.lds + F.wave * (128 * UCP);
    { const int grp = lane & 7, ch0 = blk * 64 + grp * 8; float cw[4][8], cb[8];
#pragma unroll
      for (int k = 0; k < 4; ++k)
#pragma unroll
          for (int i = 0; i < 8; ++i) cw[k][i] = F.pa->in[I_CONVW][((size_t)l * 4 + k) * 512 + ch0 + i];
#pragma unroll
      for (int i = 0; i < 8; ++i) cb[i] = F.pa->in[I_CONVB][l * 512 + ch0 + i];
      const bf16_t* Pu = P + (size_t)it.seqbase * INW + ch0;
#pragma unroll 8
      for (int q = 0; q < 16; ++q) { const int token = (lane >> 3) + 8 * q; float o[8];
#pragma unroll
          for (int i = 0; i < 8; ++i) o[i] = cb[i];
#pragma unroll
          for (int k = 0; k < 4; ++k) { const int tt = it.t0 + token + k - 2; const int tc = tt < 0 ? 0 : (tt >= it.seqlen ? it.seqlen - 1 : tt);
              u32x4 v = ldg<u32x4>(Pu, (unsigned)tc * (unsigned)(INW * 2)); if (tt != tc) v = (u32x4){0u, 0u, 0u, 0u};
              o[0] += cw[k][0] * bf2f(v.x & 0xffffu); o[1] += cw[k][1] * __uint_as_float(v.x & 0xffff0000u); o[2] += cw[k][2] * bf2f(v.y & 0xffffu); o[3] += cw[k][3] * __uint_as_float(v.y & 0xffff0000u);
              o[4] += cw[k][4] * bf2f(v.z & 0xffffu); o[5] += cw[k][5] * __uint_as_float(v.z & 0xffff0000u); o[6] += cw[k][6] * bf2f(v.w & 0xffffu); o[7] += cw[k][7] * __uint_as_float(v.w & 0xffff0000u); }
          u32x4 w; w.x = pk2(o[0], o[1]); w.y = pk2(o[2], o[3]); w.z = pk2(o[4], o[5]); w.w = pk2(o[6], o[7]);
          *(LAS u32x4*)(ucw + token * UCP + grp * 16) = w; }
      LDS_WAIT(); asm volatile("" ::: "memory"); }
    asm volatile("" : "+v"(lane));
    bf16x8 af[8][2];
    { const int fr = lane & 15, fq = lane >> 4;
#pragma unroll
      for (int m = 0; m < 8; ++m)
#pragma unroll
          for (int ks = 0; ks < 2; ++ks) af[m][ks] = *(const LAS bf16x8*)(ucw + (32 * (fr >> 2) + 4 * m + (fr & 3)) * UCP + (8 * fq + 32 * ks) * 2); }
    const bf16_t* wg0 = (const bf16_t*)(F.ws + WS_RGW) + (size_t)(l * 2 + 0) * 2 * 8 * 4096;
    const bf16_t* wg1 = (const bf16_t*)(F.ws + WS_RGW) + (size_t)(l * 2 + 1) * 2 * 8 * 4096;
    float* TOT = (float*)(F.ws + WS_TOT);
    RgStep R0, R1;
    rg_load_step<FINAL>(R0, F, wg0, l, 0, item, blk, n0, lane);
#pragma unroll 1
    for (int n = n0; n < n1; ++n) { asm volatile("" : "+v"(lane));
        const int fr = lane & 15, fq = lane >> 4; const int ch = blk * 64 + 16 * n + fr;
        f32x4 hsum[8];
#pragma unroll
        for (int m = 0; m < 8; ++m) hsum[m] = zero4();
        rg_load_step<FINAL>(R1, F, wg1, l, 1, item, blk, n, lane);
        { float At, Ht;
          rg_dir<FINAL, 0>(ucw, af, R0, n, lane, hsum, At, Ht);
          if (!FINAL && fq == 0) { *(f32x2*)(TOT + (((size_t)item * 2 + 0) * 512 + ch) * 2) = (f32x2){At, Ht}; } }
        __builtin_amdgcn_sched_barrier(0);
        if (n + 1 < n1) rg_load_step<FINAL>(R0, F, wg0, l, 0, item, blk, n + 1, lane);
        { float At, Ht;
          rg_dir<FINAL, 1>(ucw, af, R1, n, lane, hsum, At, Ht);
          if (!FINAL && fq == 0) { *(f32x2*)(TOT + (((size_t)item * 2 + 1) * 512 + ch) * 2) = (f32x2){At, Ht}; } }
        if (FINAL) {
            const unsigned uo = (unsigned)(32 * fq * UCP + (16 * n + fr) * 2);
#pragma unroll
            for (int m = 0; m < 8; ++m)
#pragma unroll
                for (int jj = 0; jj < 4; ++jj) *(LAS bf16_t*)(ucw + uo + (4 * m + jj) * UCP) = (bf16_t)f2bf(hsum[m][jj]); }
    }
    if (FINAL) {
        LDS_WAIT(); asm volatile("" : "+v"(lane) :: "memory");
        const int ng = 2 * (n1 - n0);
        const int grp = 2 * n0 + ((ng == 8) ? (lane & 7) : (lane & 1)); const int tk0 = (ng == 8) ? (lane >> 3) : (lane >> 1), tstep = (ng == 8) ? 8 : 32, nq = (ng == 8) ? 16 : 4;
        const bf16_t* Pg = P + (size_t)it.row0 * INW + 512 + blk * 64 + grp * 8; bf16_t* Yo = (bf16_t*)(F.ws + WS_Y) + (size_t)it.row0 * D + blk * 64 + grp * 8;
#pragma unroll 8
        for (int q = 0; q < nq; ++q) { const int token = tk0 + tstep * q;
            const u32x4 hv = *(const LAS u32x4*)(ucw + token * UCP + grp * 16); const u32x4 gv = ldg<u32x4>(Pg, (unsigned)token * (unsigned)(INW * 2));
            u32x4 w;
            w.x = pk2(gelu_tanh(bf2f(gv.x & 0xffffu)) * bf2f(hv.x & 0xffffu), gelu_tanh(__uint_as_float(gv.x & 0xffff0000u)) * __uint_as_float(hv.x & 0xffff0000u));
            w.y = pk2(gelu_tanh(bf2f(gv.y & 0xffffu)) * bf2f(hv.y & 0xffffu), gelu_tanh(__uint_as_float(gv.y & 0xffff0000u)) * __uint_as_float(hv.y & 0xffff0000u));
            w.z = pk2(gelu_tanh(bf2f(gv.z & 0xffffu)) * bf2f(hv.z & 0xffffu), gelu_tanh(__uint_as_float(gv.z & 0xffff0000u)) * __uint_as_float(hv.z & 0xffff0000u));
            w.w = pk2(gelu_tanh(bf2f(gv.w & 0xffffu)) * bf2f(hv.w & 0xffffu), gelu_tanh(__uint_as_float(gv.w & 0xffff0000u)) * __uint_as_float(hv.w & 0xffff0000u));
            stg<u32x4>(Yo, (unsigned)token * (unsigned)(D * 2), w); }
        LDS_WAIT();
    }
}

__device__ __forceinline__ void stage_rows(Frame& F, ldsp_t dst, const Item& it, int col0, bool rope) {
    const bf16_t* P = (const bf16_t*)(F.ws + WS_PA); const float* ct = (const float*)(F.ws + WS_ROPE); const float* st = ct + 4096 * 64;
    for (int task = F.tid; task < 1024; task += NTHREADS) { const int token = task >> 3, d0 = (task & 7) * 8;
        const bf16_t* src = P + (size_t)(it.row0 + token) * INW + col0;
        const u32x4 lo = *(const u32x4*)(src + d0), hi = *(const u32x4*)(src + d0 + 64);
        u32x4 olo = lo, ohi = hi;
        if (rope) { const int pos = it.t0 + token; const f32x4 c0 = *(const f32x4*)(ct + pos * 64 + d0), c1 = *(const f32x4*)(ct + pos * 64 + d0 + 4), s0 = *(const f32x4*)(st + pos * 64 + d0), s1 = *(const f32x4*)(st + pos * 64 + d0 + 4);
            const float a[8] = {bf2f(lo.x & 0xffffu), __uint_as_float(lo.x & 0xffff0000u), bf2f(lo.y & 0xffffu), __uint_as_float(lo.y & 0xffff0000u), bf2f(lo.z & 0xffffu), __uint_as_float(lo.z & 0xffff0000u), bf2f(lo.w & 0xffffu), __uint_as_float(lo.w & 0xffff0000u)};
            const float b[8] = {bf2f(hi.x & 0xffffu), __uint_as_float(hi.x & 0xffff0000u), bf2f(hi.y & 0xffffu), __uint_as_float(hi.y & 0xffff0000u), bf2f(hi.z & 0xffffu), __uint_as_float(hi.z & 0xffff0000u), bf2f(hi.w & 0xffffu), __uint_as_float(hi.w & 0xffff0000u)};
            const float c[8] = {c0.x, c0.y, c0.z, c0.w, c1.x, c1.y, c1.z, c1.w}, s[8] = {s0.x, s0.y, s0.z, s0.w, s1.x, s1.y, s1.z, s1.w};
            float ra[8], rb[8];
#pragma unroll
            for (int i = 0; i < 8; ++i) { ra[i] = a[i] * c[i] - b[i] * s[i]; rb[i] = a[i] * s[i] + b[i] * c[i]; }
            olo.x = pk2(ra[0], ra[1]); olo.y = pk2(ra[2], ra[3]); olo.z = pk2(ra[4], ra[5]); olo.w = pk2(ra[6], ra[7]);
            ohi.x = pk2(rb[0], rb[1]); ohi.y = pk2(rb[2], rb[3]); ohi.z = pk2(rb[4], rb[5]); ohi.w = pk2(rb[6], rb[7]); }
        *(LAS u32x4*)(dst + token * TP + d0 * 2) = olo; *(LAS u32x4*)(dst + token * TP + (d0 + 64) * 2) = ohi; }
}
__device__ __forceinline__ void stage_cols(Frame& F, ldsp_t dst, const Item& it, int col0) {
    const bf16_t* P = (const bf16_t*)(F.ws + WS_PA);
    for (int task = F.tid; task < 2048; task += NTHREADS) { const int token = task >> 4, d0 = (task & 15) * 8;
        const u32x4 v = *(const u32x4*)(P + (size_t)(it.row0 + token) * INW + col0 + d0);
        const unsigned w[4] = {v.x, v.y, v.z, v.w};
#pragma unroll
        for (int i = 0; i < 4; ++i) { *(LAS bf16_t*)(dst + (d0 + 2 * i) * TP + token * 2) = (bf16_t)(w[i] & 0xffffu); *(LAS bf16_t*)(dst + (d0 + 2 * i + 1) * TP + token * 2) = (bf16_t)(w[i] >> 16); } }
}
__device__ __forceinline__ void rope8(u32x4& lo, u32x4& hi, const float* ct, const float* st, int pos, int d0) {
    const f32x4 c0 = *(const f32x4*)(ct + pos * 64 + d0), c1 = *(const f32x4*)(ct + pos * 64 + d0 + 4), s0 = *(const f32x4*)(st + pos * 64 + d0), s1 = *(const f32x4*)(st + pos * 64 + d0 + 4);
    const float a[8] = {bf2f(lo.x & 0xffffu), __uint_as_float(lo.x & 0xffff0000u), bf2f(lo.y & 0xffffu), __uint_as_float(lo.y & 0xffff0000u), bf2f(lo.z & 0xffffu), __uint_as_float(lo.z & 0xffff0000u), bf2f(lo.w & 0xffffu), __uint_as_float(lo.w & 0xffff0000u)};
    const float b[8] = {bf2f(hi.x & 0xffffu), __uint_as_float(hi.x & 0xffff0000u), bf2f(hi.y & 0xffffu), __uint_as_float(hi.y & 0xffff0000u), bf2f(hi.z & 0xffffu), __uint_as_float(hi.z & 0xffff0000u), bf2f(hi.w & 0xffffu), __uint_as_float(hi.w & 0xffff0000u)};
    const float c[8] = {c0.x, c0.y, c0.z, c0.w, c1.x, c1.y, c1.z, c1.w}, sn[8] = {s0.x, s0.y, s0.z, s0.w, s1.x, s1.y, s1.z, s1.w};
    float ra[8], rb[8];
#pragma unroll
    for (int i = 0; i < 8; ++i) { ra[i] = a[i] * c[i] - b[i] * sn[i]; rb[i] = a[i] * sn[i] + b[i] * c[i]; }
    lo = (u32x4){pk2(ra[0], ra[1]), pk2(ra[2], ra[3]), pk2(ra[4], ra[5]), pk2(ra[6], ra[7])};
    hi = (u32x4){pk2(rb[0], rb[1]), pk2(rb[2], rb[3]), pk2(rb[4], rb[5]), pk2(rb[6], rb[7])};
}
struct KvRegs { u32x4 klo[2], khi[2], v[4]; };
__device__ __forceinline__ void kv_issue(Frame& F, KvRegs& R, const Item& it, int h) {
    const bf16_t* P = (const bf16_t*)(F.ws + WS_PA);
    const bf16_t* Pk = P + (size_t)it.row0 * INW + 1536 + h * HD; const bf16_t* Pv = P + (size_t)it.row0 * INW + 2048 + h * HD;
#pragma unroll
    for (int t2 = 0; t2 < 2; ++t2) { const int task = F.tid + t2 * NTHREADS, token = task >> 3, d0 = (task & 7) * 8;
        R.klo[t2] = ldg<u32x4>(Pk, (unsigned)(token * INW + d0) * 2u); R.khi[t2] = ldg<u32x4>(Pk, (unsigned)(token * INW + d0 + 64) * 2u); }
#pragma unroll
    for (int t4 = 0; t4 < 4; ++t4) { const int task = F.tid + t4 * NTHREADS, token = task >> 4, d0 = (task & 15) * 8; R.v[t4] = ldg<u32x4>(Pv, (unsigned)(token * INW + d0) * 2u); }
}
template <int KS> __device__ __forceinline__ void kv_step(unsigned aK, unsigned aVf, unsigned aVb, f32x4 (&accf)[8], f32x4 (&accb)[8]) {
    const bf16x8 af = tr1<KS * 32 * VP>(aVf), ab = tr1<KS * 32 * VP>(aVb);
    bf16x8 b[8];
    tr4<KS * 32 * VP>(aK, b[0], b[1], b[2], b[3]); tr4<KS * 32 * VP + 128>(aK, b[4], b[5], b[6], b[7]);
#pragma unroll
    for (int n = 0; n < 8; ++n) { accf[n] = __builtin_amdgcn_mfma_f32_16x16x32_bf16(af, b[n], accf[n], 0, 0, 0); accb[n] = __builtin_amdgcn_mfma_f32_16x16x32_bf16(ab, b[n], accb[n], 0, 0, 0); }
}
__device__ __forceinline__ void stage_state_t(Frame& F, ldsp_t dst, const bf16_t* St) {
#pragma unroll
    for (int t4 = 0; t4 < 4; ++t4) { const int task = F.tid + t4 * NTHREADS, e = task >> 4, c8 = task & 15;
        *(LAS u32x4*)(dst + e * TP + c8 * 16) = ldg<u32x4>(St, (unsigned)(e * 128 + c8 * 8) * 2u); }
}
__device__ __forceinline__ void mm16x128(ldsp_t At, int ra0, ldsp_t Bt, int lane, f32x4 (&acc)[8]) {
    const int fr = lane & 15, fq = lane >> 4;
#pragma unroll
    for (int ks = 0; ks < 4; ++ks) { const bf16x8 a = *(const LAS bf16x8*)(At + (ra0 + fr) * TP + (32 * ks + 8 * fq) * 2);
#pragma unroll
        for (int n = 0; n < 8; ++n) { const bf16x8 b = *(const LAS bf16x8*)(Bt + (16 * n + fr) * TP + (32 * ks + 8 * fq) * 2); acc[n] = __builtin_amdgcn_mfma_f32_16x16x32_bf16(a, b, acc[n], 0, 0, 0); } }
}

__device__ __forceinline__ void kv_head(Frame& F, KvRegs& R, KvRegs& Rn, bool pre, int item, const Item& it, int h) {
    bf16_t* KV = (bf16_t*)(F.ws + WS_KV);
    const float* ct = (const float*)(F.ws + WS_ROPE); const float* st = ct + 4096 * 64;
    const LAS float* dec = (const LAS float*)(F.lds + LDS_DEC); const bool rope = !it.is_ctx;
    ldsp_t tK = F.lds, tVf = F.lds + TILEV, tVb = F.lds + 2 * TILEV;
#pragma unroll
    for (int t2 = 0; t2 < 2; ++t2) { const int task = F.tid + t2 * NTHREADS, token = task >> 3, d0 = (task & 7) * 8;
        if (rope) rope8(R.klo[t2], R.khi[t2], ct, st, it.t0 + token, d0);
        *(LAS u32x4*)(tK + token * VP + d0 * 2) = R.klo[t2]; *(LAS u32x4*)(tK + token * VP + (d0 + 64) * 2) = R.khi[t2]; }
#pragma unroll
    for (int t4 = 0; t4 < 4; ++t4) { const int task = F.tid + t4 * NTHREADS, token = task >> 4, d0 = (task & 15) * 8; const u32x4 v = R.v[t4];
        const float df = dec[(0 * 4 + h) * 132 + 127 - token], db = dec[(1 * 4 + h) * 132 + token];
        const float x[8] = {bf2f(v.x & 0xffffu), __uint_as_float(v.x & 0xffff0000u), bf2f(v.y & 0xffffu), __uint_as_float(v.y & 0xffff0000u), bf2f(v.z & 0xffffu), __uint_as_float(v.z & 0xffff0000u), bf2f(v.w & 0xffffu), __uint_as_float(v.w & 0xffff0000u)};
        u32x4 wf, wb; wf.x = pk2(x[0] * df, x[1] * df); wf.y = pk2(x[2] * df, x[3] * df); wf.z = pk2(x[4] * df, x[5] * df); wf.w = pk2(x[6] * df, x[7] * df);
        wb.x = pk2(x[0] * db, x[1] * db); wb.y = pk2(x[2] * db, x[3] * db); wb.z = pk2(x[4] * db, x[5] * db); wb.w = pk2(x[6] * db, x[7] * db);
        *(LAS u32x4*)(tVf + token * VP + d0 * 2) = wf; *(LAS u32x4*)(tVb + token * VP + d0 * 2) = wb; }
    WG_BAR_LDS();
    if (pre) kv_issue(F, Rn, it, h + 1);
    f32x4 af[8], ab[8];
#pragma unroll
    for (int n = 0; n < 8; ++n) { af[n] = zero4(); ab[n] = zero4(); }
    { const unsigned aK = tr_lane_addr(tK, F.lane), aVf = tr_lane_addr(tVf, F.lane) + 32u * (unsigned)F.wave, aVb = tr_lane_addr(tVb, F.lane) + 32u * (unsigned)F.wave;
      kv_step<0>(aK, aVf, aVb, af, ab); kv_step<1>(aK, aVf, aVb, af, ab); kv_step<2>(aK, aVf, aVb, af, ab); kv_step<3>(aK, aVf, aVb, af, ab); }
    const int fr = F.lane & 15, fq = F.lane >> 4;
    bf16_t* of = KV + (((size_t)item * 4 + h) * 2 + 0) * 16384 + (size_t)(16 * F.wave) * 128;
    unsigned so = (unsigned)((4 * fq) * 128 + fr) * 2u; asm volatile("" : "+v"(so));
#pragma unroll
    for (int n = 0; n < 8; ++n)
#pragma unroll
        for (int jj = 0; jj < 4; ++jj) { stg<bf16_t>(of, so + (unsigned)((jj * 128 + 16 * n) * 2), (bf16_t)f2bf(af[n][jj])); stg<bf16_t>(of, so + (unsigned)((16384 + jj * 128 + 16 * n) * 2), (bf16_t)f2bf(ab[n][jj])); }
    WG_BAR_LDS();
}
__device__ __forceinline__ int latent_item(int c) { return (c >> 5) * SPB + 2 + (c & 31); }
__device__ __forceinline__ int ctx_item(int ci) { return (ci >> 1) * SPB + (ci & 1); }
__device__ __forceinline__ void phase_m1(Frame& F, int l) {
    build_decay(F, l); __syncthreads();
    for (int c = F.bid; c < 256; c += F.G) {
        fresh(F);
        { const int item = latent_item(c); const Item it = item_info(item);
          rg_part<false>(F, l, item, it, F.wave, 0, 4);
          __syncthreads();
          KvRegs A, B;
          fresh(F); kv_issue(F, A, it, 0);
          kv_head(F, A, B, true, item, it, 0);
          fresh(F); kv_head(F, B, A, true, item, it, 1);
          fresh(F); kv_head(F, A, B, true, item, it, 2);
          fresh(F); kv_head(F, B, A, false, item, it, 3); }
        fresh(F);
        if (F.wave < 2) { const int u = c + 256 * F.wave; const int item = ctx_item(u >> 5); const Item it = item_info(item); rg_part<false>(F, l, item, it, (u >> 2) & 7, u & 3, (u & 3) + 1); }
        __syncthreads();
        if (c < 64) { const int item = ctx_item(c >> 2); const Item it = item_info(item); KvRegs A, B; fresh(F); kv_issue(F, A, it, c & 3); kv_head(F, A, B, false, item, it, c & 3); }
    }
}
__device__ __forceinline__ int seq_order(int dir, int step) { return dir ? (step == 0 ? 1 : (step == 1 ? 0 : 35 - step)) : step; }
__device__ __forceinline__ void phase_m2(Frame& F, int l) {
    bf16_t* KV = (bf16_t*)(F.ws + WS_KV);
    const int gt = F.bid * NTHREADS + F.tid, NGT = F.G * NTHREADS;
    for (int c = gt; c < NB * NH * 2 * 128 * 16; c += NGT) {
        const int dc = c & 15, e = (c >> 4) & 127, dir = (c >> 11) & 1, h = (c >> 12) & 3, b = c >> 14;
        const float x = F.pa->in[I_RETDEC][l * 8 + dir * 4 + h]; const float decay = expf(128.0f * (-log1pf(expf(-x))));
        float S[8];
#pragma unroll
        for (int i = 0; i < 8; ++i) S[i] = 0.f;
        const unsigned lo = (unsigned)((((h * 2 + dir) * 128 + e) * 128 + dc * 8) * 2);
        for (int g0 = 0; g0 < SPB; g0 += 17) {
            u32x4 v[17];
#pragma unroll
            for (int i = 0; i < 17; ++i) { const int item = b * SPB + seq_order(dir, g0 + i); v[i] = ldg<u32x4>(KV + (size_t)item * 4 * 2 * 16384, lo); }
#pragma unroll
            for (int i = 0; i < 17; ++i) { const int item = b * SPB + seq_order(dir, g0 + i);
                u32x4 w; w.x = pk2(S[0], S[1]); w.y = pk2(S[2], S[3]); w.z = pk2(S[4], S[5]); w.w = pk2(S[6], S[7]);
                stg<u32x4>(KV + (size_t)item * 4 * 2 * 16384, lo, w);
                S[0] = S[0] * decay + bf2f(v[i].x & 0xffffu); S[1] = S[1] * decay + __uint_as_float(v[i].x & 0xffff0000u); S[2] = S[2] * decay + bf2f(v[i].y & 0xffffu); S[3] = S[3] * decay + __uint_as_float(v[i].y & 0xffff0000u);
                S[4] = S[4] * decay + bf2f(v[i].z & 0xffffu); S[5] = S[5] * decay + __uint_as_float(v[i].z & 0xffff0000u); S[6] = S[6] * decay + bf2f(v[i].w & 0xffffu); S[7] = S[7] * decay + __uint_as_float(v[i].w & 0xffff0000u); }
        }
    }
    const float* TOT = (const float*)(F.ws + WS_TOT); float* CARRY = (float*)(F.ws + WS_CARRY);
    for (int c = gt; c < NB * 2 * 512; c += NGT) { const int ch = c & 511, dir = (c >> 9) & 1, b = c >> 10; float cr = 0.f;
        for (int step = 0; step < SPB; ++step) { const int item = b * SPB + seq_order(dir, step); const f32x2 ah = *(const f32x2*)(TOT + (((size_t)item * 2 + dir) * 512 + ch) * 2);
            CARRY[((size_t)item * 2 + dir) * 512 + ch] = cr; cr = ah.x * cr + ah.y; } }
}
struct RetRegs { u32x4 v[4], sf[4], sb[4], klo[2], khi[2], g[4]; };
__device__ __forceinline__ void ret_issue(Frame& F, RetRegs& R, int item, const Item& it, int h) {
    const bf16_t* KV = (const bf16_t*)(F.ws + WS_KV); const bf16_t* P = (const bf16_t*)(F.ws + WS_PA);
    const bf16_t* Pk = P + (size_t)it.row0 * INW + 1536 + h * HD; const bf16_t* Pv = P + (size_t)it.row0 * INW + 2048 + h * HD;
    const bf16_t* Sf = KV + (((size_t)item * 4 + h) * 2 + 0) * 16384; const bf16_t* Sb = Sf + 16384;
    const int lane = F.lane, i0 = 16 * F.wave;
#pragma unroll
    for (int t2 = 0; t2 < 2; ++t2) { const int task = F.tid + t2 * NTHREADS, token = task >> 3, d0 = (task & 7) * 8;
        R.klo[t2] = ldg<u32x4>(Pk, (unsigned)(token * INW + d0) * 2u); R.khi[t2] = ldg<u32x4>(Pk, (unsigned)(token * INW + d0 + 64) * 2u); }
#pragma unroll
    for (int t4 = 0; t4 < 4; ++t4) { const int task = F.tid + t4 * NTHREADS, r = task >> 4, c8 = task & 15;
        R.v[t4] = ldg<u32x4>(Pv, (unsigned)(r * INW + c8 * 8) * 2u); R.sf[t4] = ldg<u32x4>(Sf, (unsigned)(r * 128 + c8 * 8) * 2u); R.sb[t4] = ldg<u32x4>(Sb, (unsigned)(r * 128 + c8 * 8) * 2u); }
    { const bf16_t* Pg = P + (size_t)(it.row0 + i0) * INW + 2560 + h * HD;
#pragma unroll
      for (int k = 0; k < 4; ++k) R.g[k] = ldg<u32x4>(Pg, (unsigned)((lane >> 2) * INW + 32 * (lane & 3) + 8 * k) * 2u); }
}
__device__ __forceinline__ void ret_head(Frame& F, RetRegs& R, RetRegs& Rn, bool pre, int item, const Item& it, int h) {
    bf16_t* Y = (bf16_t*)(F.ws + WS_Y);
    const float* ct = (const float*)(F.ws + WS_ROPE); const float* st = ct + 4096 * 64;
    const LAS float* dec = (const LAS float*)(F.lds + LDS_DEC);
    ldsp_t tK = F.lds, tV = F.lds + TILEB, tSf = tV + TILEV, tSb = tSf + TILEB;
    const bool rope = !it.is_ctx;
    const int lane = F.lane, fr = lane & 15, fq = lane >> 4, i0 = 16 * F.wave;
    u32x4 q4[4];
    { const bf16_t* Pq = (const bf16_t*)(F.ws + WS_PA) + (size_t)(it.row0 + i0) * INW + 1024 + h * HD;
#pragma unroll
      for (int ks = 0; ks < 4; ++ks) q4[ks] = ldg<u32x4>(Pq, (unsigned)(fr * INW + 32 * ks + 8 * fq) * 2u); }
#pragma unroll
    for (int t2 = 0; t2 < 2; ++t2) { const int task = F.tid + t2 * NTHREADS, token = task >> 3, d0 = (task & 7) * 8;
        if (rope) rope8(R.klo[t2], R.khi[t2], ct, st, it.t0 + token, d0);
        *(LAS u32x4*)(tK + token * TP + d0 * 2) = R.klo[t2]; *(LAS u32x4*)(tK + token * TP + (d0 + 64) * 2) = R.khi[t2]; }
#pragma unroll
    for (int t4 = 0; t4 < 4; ++t4) { const int task = F.tid + t4 * NTHREADS, r = task >> 4, c8 = task & 15;
        *(LAS u32x4*)(tV + r * VP + c8 * 16) = R.v[t4]; *(LAS u32x4*)(tSf + r * TP + c8 * 16) = R.sf[t4]; *(LAS u32x4*)(tSb + r * TP + c8 * 16) = R.sb[t4]; }
    bf16x8 qf[4];
    { if (rope) { rope8(q4[0], q4[2], ct, st, it.t0 + i0 + fr, 8 * fq); rope8(q4[1], q4[3], ct, st, it.t0 + i0 + fr, 32 + 8 * fq); }
#pragma unroll
      for (int ks = 0; ks < 4; ++ks) qf[ks] = __builtin_bit_cast(bf16x8, q4[ks]); }
    u32x4 gk[4];
#pragma unroll
    for (int k = 0; k < 4; ++k) gk[k] = R.g[k];
    WG_BAR_LDS();
    if (pre) ret_issue(F, Rn, item, it, h + 1);
    bf16x8 pa[4];
    { f32x4 C[8];
#pragma unroll
      for (int jt = 0; jt < 8; ++jt) { C[jt] = zero4();
#pragma unroll
          for (int ks = 0; ks < 4; ++ks) { const bf16x8 a = *(const LAS bf16x8*)(tK + (16 * jt + fr) * TP + (32 * ks + 8 * fq) * 2); C[jt] = __builtin_amdgcn_mfma_f32_16x16x32_bf16(a, qf[ks], C[jt], 0, 0, 0); } }
      const int i = i0 + fr;
#pragma unroll
      for (int jt = 0; jt < 8; ++jt)
#pragma unroll
          for (int jj = 0; jj < 4; ++jj) { const int j = 16 * jt + 4 * fq + jj; const float dcy = (i >= j) ? dec[(0 * 4 + h) * 132 + (i - j)] : dec[(1 * 4 + h) * 132 + (j - i)]; C[jt][jj] *= dcy; }
#pragma unroll
      for (int u = 0; u < 4; ++u) { const u32x4 w = {pg8::cvt_pk_bf16(C[2 * u][0], C[2 * u][1]), pg8::cvt_pk_bf16(C[2 * u][2], C[2 * u][3]), pg8::cvt_pk_bf16(C[2 * u + 1][0], C[2 * u + 1][1]), pg8::cvt_pk_bf16(C[2 * u + 1][2], C[2 * u + 1][3])};
          pa[u] = __builtin_bit_cast(bf16x8, w); } }
    WG_BAR_LDS();
    { ldsp_t gt = tK + (i0 + (lane >> 2)) * TP + (lane & 3) * 64;
#pragma unroll
      for (int k = 0; k < 4; ++k) *(LAS u32x4*)(gt + 16 * k) = gk[k]; }
    f32x4 o[8];
#pragma unroll
    for (int n = 0; n < 8; ++n) o[n] = zero4();
    { const unsigned aV = tr_lane_addr(tV, lane); bf16x8 b[8];
#define RET_PV(U) do { tr4<(U) * 32 * VP>(aV, b[0], b[1], b[2], b[3]); tr4<(U) * 32 * VP + 128>(aV, b[4], b[5], b[6], b[7]); \
        _Pragma("unroll") for (int n = 0; n < 8; ++n) o[n] = __builtin_amdgcn_mfma_f32_16x16x32_bf16(pa[U], b[n], o[n], 0, 0, 0); } while (0)
      RET_PV(0); RET_PV(1); RET_PV(2); RET_PV(3);
#undef RET_PV
    }
    { f32x4 cf[8];
#pragma unroll
      for (int n = 0; n < 8; ++n) { cf[n] = zero4();
#pragma unroll
          for (int ks = 0; ks < 4; ++ks) { const bf16x8 b = *(const LAS bf16x8*)(tSf + (16 * n + fr) * TP + (32 * ks + 8 * fq) * 2); cf[n] = __builtin_amdgcn_mfma_f32_16x16x32_bf16(qf[ks], b, cf[n], 0, 0, 0); } }
#pragma unroll
      for (int jj = 0; jj < 4; ++jj) { const float sf = dec[(0 * 4 + h) * 132 + (i0 + 4 * fq + jj + 1)];
#pragma unroll
          for (int n = 0; n < 8; ++n) o[n][jj] += sf * cf[n][jj]; } }
    { f32x4 cb[8];
#pragma unroll
      for (int n = 0; n < 8; ++n) { cb[n] = zero4();
#pragma unroll
          for (int ks = 0; ks < 4; ++ks) { const bf16x8 b = *(const LAS bf16x8*)(tSb + (16 * n + fr) * TP + (32 * ks + 8 * fq) * 2); cb[n] = __builtin_amdgcn_mfma_f32_16x16x32_bf16(qf[ks], b, cb[n], 0, 0, 0); } }
#pragma unroll
      for (int jj = 0; jj < 4; ++jj) { const float sb = dec[(1 * 4 + h) * 132 + (128 - (i0 + 4 * fq + jj))];
#pragma unroll
          for (int n = 0; n < 8; ++n) o[n][jj] += sb * cb[n][jj]; } }
    { ldsp_t gc = tK + (i0 + 4 * fq) * TP + fr * 2;
#pragma unroll
      for (int jj = 0; jj < 4; ++jj) { float s1 = 0.f;
#pragma unroll
          for (int n = 0; n < 8; ++n) s1 += o[n][jj];
          s1 += swz_xor<1>(s1); s1 += swz_xor<2>(s1); s1 += swz_xor<4>(s1); s1 += swz_xor<8>(s1);
          const float mu = s1 * (1.0f / 128.0f); float q = 0.f;
#pragma unroll
          for (int n = 0; n < 8; ++n) { const float dd = o[n][jj] - mu; q += dd * dd; }
          q += swz_xor<1>(q); q += swz_xor<2>(q); q += swz_xor<4>(q); q += swz_xor<8>(q);
          const float rstd = 1.0f / sqrtf(q * (1.0f / 128.0f) + EPS);
#pragma unroll
          for (int n = 0; n < 8; ++n) { LAS bf16_t* p = (LAS bf16_t*)(gc + jj * TP + 32 * n); const float gv = bf2f(*p); *p = (bf16_t)f2bf(siluf_(gv) * (o[n][jj] - mu) * rstd); } } }
    LDS_WAIT(); asm volatile("" ::: "memory");
    { ldsp_t gt = tK + (i0 + (lane >> 2)) * TP + (lane & 3) * 64; bf16_t* Yo = Y + (size_t)(it.row0 + i0) * D + 512 + h * HD;
#pragma unroll
      for (int k = 0; k < 4; ++k) stg<u32x4>(Yo, (unsigned)((lane >> 2) * D + 32 * (lane & 3) + 8 * k) * 2u, *(const LAS u32x4*)(gt + 16 * k)); }
    WG_BAR_LDS();
}
__device__ __forceinline__ void phase_m3(Frame& F, int l) {
    build_decay(F, l); __syncthreads();
    for (int c = F.bid; c < 256; c += F.G) {
        fresh(F);
        { const int item = latent_item(c); const Item it = item_info(item);
#ifndef PROBE_M3
#define PROBE_M3 0
#endif
          for (int r_ = 0; r_ < ((PROBE_M3 & 1) ? 2 : 1); ++r_) { fresh(F); rg_part<true>(F, l, item, it, F.wave, 0, 4); }
          __syncthreads();
          for (int r_ = 0; r_ < ((PROBE_M3 & 2) ? 2 : 1); ++r_) {
          RetRegs R, Rn;
          fresh(F); ret_issue(F, R, item, it, 0);
          ret_head(F, R, Rn, true, item, it, 0);
          fresh(F); ret_head(F, Rn, R, true, item, it, 1);
          fresh(F); ret_head(F, R, Rn, true, item, it, 2);
          fresh(F); ret_head(F, Rn, R, false, item, it, 3); } }
        if (l == 0) {
            fresh(F);
            if (F.wave < 2) { const int u = c + 256 * F.wave; const int item = ctx_item(u >> 5); const Item it = item_info(item); rg_part<true>(F, l, item, it, (u >> 2) & 7, u & 3, (u & 3) + 1); }
            __syncthreads();
            if (c < 64) { const int item = ctx_item(c >> 2); const Item it = item_info(item); RetRegs R, Rn; fresh(F); ret_issue(F, R, item, it, c & 3); ret_head(F, R, Rn, false, item, it, c & 3); }
        }
    }
}

constexpr int N_PHASES = 24;
__global__ void __launch_bounds__(NTHREADS, 2) fwd_kernel(Args args) {
    extern __shared__ __attribute__((aligned(16))) unsigned char lds_raw[];
    Frame F; F.lds = (ldsp_t)lds_raw; F.wave0 = __builtin_amdgcn_readfirstlane((int)threadIdx.x >> 6); F.G = gridDim.x; F.pa0 = &args; F.out0 = args.out; F.ws0 = args.ws; fresh(F);
    volatile LAS unsigned* MISC = (volatile LAS unsigned*)(F.lds + LDS_MISC);
    if (F.tid < 64) MISC[F.tid] = 0u;
    __syncthreads();
    const int lo = args.ph_lo, hi = args.ph_hi;
    XcdBarrier bar; bar.bar = (unsigned*)(F.ws + WS_CTL); bar.x = 0; bar.st = nullptr;
    if (hi - lo > 1) bar = xcd_barrier_post((unsigned*)(F.ws + WS_CTL), MISC);
#ifndef DIAG_MASK
#define DIAG_MASK 0xffffffffu
#endif
#ifndef REPEAT_MASK
#define REPEAT_MASK 0u
#endif
#define REPS(kind) ((((REPEAT_MASK) >> (kind)) & 1u) ? 2 : 1)
#define INK(k, kind) (((DIAG_MASK >> (kind)) & 1u) && lo <= (k) && (k) < hi && fresh(F))
#define IN(k) (lo <= (k) && (k) < hi)
#define SEAM(k) do { if (IN(k) && IN((k) + 1)) xcd_barrier(bar); } while (0)
    float* ctxx = (float*)(F.ws + WS_CTXX); bf16_t* xb = (bf16_t*)((char*)F.out + XB_OFF);
    const float* modlat = (const float*)(F.ws + WS_MODLAT); const float* modctx = (const float*)(F.ws + WS_MODCTX);

    if (INK(0, 0)) { for (int r_ = 0; r_ < REPS(0); ++r_) { phase_convert_small(F); __syncthreads(); phase_mod(F); __syncthreads(); } } SEAM(0);
    if (INK(1, 1)) { for (int r_ = 0; r_ < REPS(1); ++r_) phase_norm(F, 0, 0, F.pa->in[I_X], nullptr, F.pa->in[I_CTX], MROWS, SlabRed{nullptr, 0, nullptr, nullptr, nullptr}); } SEAM(1);
#pragma unroll 1
    for (int l = 0; l < 2; ++l) {
        const int pb = (l == 0) ? 2 : 11;
        if (INK(pb + 0, 2)) { pg8::Gemm g{(const bf16_t*)(F.ws + WS_HX), (const bf16_t*)(F.ws + WS_WIN) + (size_t)l * INW * D, INW, D, 0, nullptr}; pg8::Order S; S.init(MROWS / 256, INW / 256, F.G, F.bid, nullptr, nullptr, D / 64, false, 0);
            pg8::EpiBf16 E{(bf16_t*)(F.ws + WS_PA), INW}; for (int r_ = 0; r_ < REPS(2); ++r_) pg8::gemm_phase<pg8::EpiBf16>(F.lds, g, S, E, F.tid); }
        SEAM(pb + 0);
        if (INK(pb + 1, 3)) { for (int r_ = 0; r_ < REPS(3); ++r_) phase_m1(F, l); }
        SEAM(pb + 1);
        if (INK(pb + 2, 4)) { for (int r_ = 0; r_ < REPS(4); ++r_) { if (r_) phase_m1(F, l); phase_m2(F, l); } }
        SEAM(pb + 2);
        if (INK(pb + 3, 5)) { for (int r_ = 0; r_ < REPS(5); ++r_) phase_m3(F, l); }
        SEAM(pb + 3);
        if (INK(pb + 4, 6)) { pg8::Gemm g{(const bf16_t*)(F.ws + WS_Y), (const bf16_t*)(F.ws + WS_WOUT) + (size_t)l * D * D, D, D, 0, (float*)(F.ws + WS_SLABA)}; pg8::Order S; S.init((l == 0 ? MROWS : NLAT) / 256, D / 256, F.G, F.bid, nullptr, nullptr, D / 64, true, MAXSLAB_A);
            pg8::EpiResid E{l == 0 ? F.pa->in[I_X] : nullptr, xb, F.pa->in[I_CTX], ctxx, modlat + (size_t)l * 8 * 6144 + 2048, modctx + (size_t)l * 6144 + 2048};
            pg8::gemm_phase<pg8::EpiResid>(F.lds, g, S, E, F.tid); }
        SEAM(pb + 4);
        if (l == 0) {
            if (INK(7, 1)) { for (int r_ = 0; r_ < REPS(1); ++r_) phase_norm(F, 0, 1, nullptr, xb, ctxx, MROWS, SlabRed{(const float*)(F.ws + WS_SLABA), pg8::split_factor((MROWS / 256) * 4, F.G, D / 64, MAXSLAB_A), modctx + 2048, F.pa->in[I_CTX], ctxx}); } SEAM(7);
            if (INK(8, 7)) { pg8::Gemm g{(const bf16_t*)(F.ws + WS_HX), (const bf16_t*)(F.ws + WS_WUP), 2 * DFF, D, 0, nullptr}; pg8::Order S; S.init(MROWS / 256, 2 * DFF / 256, F.G, F.bid, nullptr, nullptr, D / 64, false, 0);
                pg8::EpiSwiGLU E{(bf16_t*)(F.ws + WS_PA), DFF}; for (int r_ = 0; r_ < REPS(7); ++r_) pg8::gemm_phase<pg8::EpiSwiGLU>(F.lds, g, S, E, F.tid); }
            SEAM(8);
            if (INK(9, 8)) { pg8::Gemm g{(const bf16_t*)(F.ws + WS_PA), (const bf16_t*)(F.ws + WS_WDN), D, DFF, 0, (float*)(F.ws + WS_SLABA)}; pg8::Order S; S.init(MROWS / 256, D / 256, F.G, F.bid, nullptr, nullptr, DFF / 64, true, MAXSLAB_A);
                pg8::EpiResid E{nullptr, xb, (const float*)ctxx, ctxx, modlat + 5120, modctx + 5120}; pg8::gemm_phase<pg8::EpiResid>(F.lds, g, S, E, F.tid); }
            SEAM(9);
            if (INK(10, 1)) { for (int r_ = 0; r_ < REPS(1); ++r_) phase_norm(F, 1, 0, nullptr, xb, ctxx, MROWS, SlabRed{(const float*)(F.ws + WS_SLABA), pg8::split_factor((MROWS / 256) * 4, F.G, DFF / 64, MAXSLAB_A), modctx + 5120, ctxx, ctxx}); } SEAM(10);
        }
    }
    if (INK(16, 9)) { for (int r_ = 0; r_ < REPS(9); ++r_) { phase_norm_router(F, xb); __syncthreads(); phase_convert_moe(F); __syncthreads(); } } SEAM(16);
    if (INK(17, 10)) { phase_moe_sort(F); } SEAM(17);
#pragma unroll 1
    for (int k = 0; k < 2; ++k) {
        const int* meta = (const int*)(F.ws + MOE_META) + 9 * k;
        if (INK(18 + 2 * k, 11)) { if (k == 1) { moe_reduce(F, 0); __syncthreads(); } pg8::Gemm g{(const bf16_t*)(F.ws + WS_HX), (const bf16_t*)(F.ws + WS_MOEUP), 2 * DEXP, D, (size_t)2 * DEXP * D * 2, nullptr}; pg8::Order S; S.init(meta[8], 2 * DEXP / 256, F.G, F.bid, meta, (const int*)(F.ws + MOE_PTOK) + k * MROWS, D / 64, false, 0);
            pg8::EpiSwiGLU E{(bf16_t*)(F.ws + WS_PA), DEXP}; for (int r_ = 0; r_ < REPS(11); ++r_) pg8::gemm_phase<pg8::EpiSwiGLU>(F.lds, g, S, E, F.tid); }
        SEAM(18 + 2 * k);
        if (INK(19 + 2 * k, 12)) { pg8::Gemm g{(const bf16_t*)(F.ws + WS_PA), (const bf16_t*)(F.ws + WS_MOEDN), D, DEXP, (size_t)D * DEXP * 2, (float*)(F.ws + WS_SLABM)}; pg8::Order S; S.init(meta[8], D / 256, F.G, F.bid, meta, nullptr, DEXP / 64, true, MAXSLAB_M);
            pg8::EpiMoeDown E{xb, (const int*)(F.ws + MOE_PTOK) + k * MROWS, (const float*)(F.ws + MOE_PW) + k * MROWS, modlat + (size_t)8 * 6144 + 5120}; pg8::gemm_phase<pg8::EpiMoeDown>(F.lds, g, S, E, F.tid); }
        SEAM(19 + 2 * k);
    }
    if (INK(22, 13)) phase_final_a(F);
    SEAM(22);
    if (INK(23, 13)) phase_final_b(F);
#undef IN
#undef INK
#undef SEAM
}

extern "C" void kernel_launch(void* const* d_in, const int* in_sizes, int n_in, void* d_out, int out_size, void* d_ws, size_t ws_size, hipStream_t stream) {
    static int grid = 0;
    if (grid == 0) {
        if (n_in != 27 || in_sizes[0] != NLAT * D || out_size != NLAT * D || ws_size < WS_END) { fprintf(stderr, "kernel_launch: unexpected problem (n_in %d, in0 %d, out %d, ws %zu, need %zu); nothing launched\n", n_in, n_in > 0 ? in_sizes[0] : -1, out_size, ws_size, (size_t)WS_END); grid = -1; return; }
        int dev = 0, cus = 0, per_cu = 0;
        if (hipGetDevice(&dev) != hipSuccess || hipDeviceGetAttribute(&cus, hipDeviceAttributeMultiprocessorCount, dev) != hipSuccess) { grid = -1; return; }
        if (hipFuncSetAttribute((const void*)fwd_kernel, hipFuncAttributeMaxDynamicSharedMemorySize, LDS_BYTES) != hipSuccess) { fprintf(stderr, "kernel_launch: hipFuncSetAttribute failed\n"); grid = -1; return; }
        if (hipOccupancyMaxActiveBlocksPerMultiprocessor(&per_cu, (const void*)fwd_kernel, NTHREADS, LDS_BYTES) != hipSuccess || per_cu < 1) { fprintf(stderr, "kernel_launch: occupancy query says %d\n", per_cu); }
        (void)hipGetLastError();
        grid = cus;
    }
    if (grid < 0) return;
    (void)hipMemsetAsync((char*)d_ws + WS_CTL, 0, CTL_ZERO_BYTES, stream);
    Args a; memset(&a, 0, sizeof(a));
    for (int i = 0; i < 27; ++i) a.in[i] = (const float*)d_in[i];
    a.out = (float*)d_out; a.ws = (unsigned char*)d_ws;
#if MK_ONE_LAUNCH
    a.ph_lo = 0; a.ph_hi = N_PHASES;
    hipLaunchKernelGGL(fwd_kernel, dim3(grid), dim3(NTHREADS), LDS_BYTES, stream, a);
#else
    for (int p = 0; p < N_PHASES; ++p) { a.ph_lo = p; a.ph_hi = p + 1; hipLaunchKernelGGL(fwd_kernel, dim3(grid), dim3(NTHREADS), LDS_BYTES, stream, a); }
#endif
}
```

```cpp
#include <hip/hip_runtime.h>
#include <cstdio>
#include <cstdint>
#include <cstring>

#ifndef MK_ONE_LAUNCH
#define MK_ONE_LAUNCH 1
#endif

#define GAS __attribute__((address_space(1)))
#define LAS __attribute__((address_space(3)))
typedef unsigned short bf16_t;
typedef short bf16x8 __attribute__((ext_vector_type(8)));
typedef float f32x4 __attribute__((ext_vector_type(4)));
typedef float f32x2 __attribute__((ext_vector_type(2)));
typedef unsigned u32x4 __attribute__((ext_vector_type(4)));
typedef unsigned u32x2 __attribute__((ext_vector_type(2)));
typedef LAS unsigned char* ldsp_t;

constexpr int D = 1024, NB = 8, SEQ = 4096, NLAT = NB * SEQ, CTXL = 256, NCTX = NB * CTXL, MROWS = NLAT + NCTX;
constexpr int INW = 3072, NH = 4, HD = 128, CHK = 128;
constexpr int DFF = 2816, NE = 8, DEXP = 3584;
constexpr int SPB = 34;
constexpr int NITEM = NB * SPB;
constexpr float EPS = 1e-6f;
constexpr int NWAVES = 8, NTHREADS = 512;

constexpr size_t MiB = 1u << 20;
constexpr size_t WS_CTL = 0, CTL_ZERO_BYTES = 64 * 1024;
constexpr size_t WS_MODLAT = 1 * MiB;
constexpr size_t WS_MODCTX = 1 * MiB + 2 * 8 * 6144 * 4;
constexpr size_t WS_ROPE = 2 * MiB;
constexpr size_t WS_RGW = 4 * MiB;
constexpr size_t WS_TOT = 5 * MiB;
constexpr size_t WS_CARRY = 8 * MiB;
constexpr size_t WS_MOE = 10 * MiB;
constexpr size_t MOE_CNT = WS_MOE, MOE_META = WS_MOE + 16384, MOE_TOKE = WS_MOE + 65536, MOE_TOKW = WS_MOE + 262144,
                 MOE_PTOK = WS_MOE + 524288, MOE_PW = WS_MOE + 1048576, MOE_PPOS = WS_MOE + 1572864;
constexpr size_t WS_CTXX = 12 * MiB;
constexpr size_t WS_WIN = 20 * MiB;
constexpr size_t WS_WOUT = 32 * MiB;
constexpr size_t WS_WUP = 36 * MiB;
constexpr size_t WS_WDN = 47 * MiB;
constexpr size_t WS_HX = 54 * MiB;
constexpr size_t WS_PA = 122 * MiB;
constexpr size_t WS_KV = 360 * MiB;
constexpr size_t WS_Y = 496 * MiB;
constexpr size_t WS_MOEUP = 360 * MiB;
constexpr size_t WS_MOEDN = 472 * MiB;
constexpr size_t WS_SLABA = WS_KV;
constexpr size_t WS_SLABM = 528 * MiB;
constexpr int MAXSLAB_A = 256, MAXSLAB_M = 216;
constexpr size_t XB_OFF = (size_t)NLAT * D * 2;
constexpr size_t WS_XCOPY = WS_PA;
constexpr size_t WS_END = 582 * MiB;
static_assert(WS_MOEDN + (size_t)NE * D * DEXP * 2 <= WS_END, "ws map");
static_assert(WS_PA + (size_t)MROWS * DEXP * 2 <= WS_KV, "ws map");

constexpr int LDS_SCRATCH = 147456;
constexpr int LDS_MISC = LDS_SCRATCH;
constexpr int LDS_DEC = LDS_MISC + 256;
constexpr int LDS_BYTES = LDS_SCRATCH + 8192;

__device__ __forceinline__ float bf2f(unsigned v) { return __uint_as_float(v << 16); }
typedef __bf16 bf16x2_t __attribute__((ext_vector_type(2)));
__device__ __forceinline__ unsigned pk2(float lo, float hi) { const f32x2 v = {lo, hi}; return __builtin_bit_cast(unsigned, __builtin_convertvector(v, bf16x2_t)); }
__device__ __forceinline__ unsigned f2bf(float f) { return pk2(f, f) & 0xffffu; }
__device__ __forceinline__ void unpack8(const u32x4 v, f32x4& a, f32x4& b) {
    a = (f32x4){bf2f(v.x & 0xffffu), __uint_as_float(v.x & 0xffff0000u), bf2f(v.y & 0xffffu), __uint_as_float(v.y & 0xffff0000u)};
    b = (f32x4){bf2f(v.z & 0xffffu), __uint_as_float(v.z & 0xffff0000u), bf2f(v.w & 0xffffu), __uint_as_float(v.w & 0xffff0000u)}; }
__device__ __forceinline__ u32x4 pack8(const f32x4 a, const f32x4 b) { return (u32x4){pk2(a.x, a.y), pk2(a.z, a.w), pk2(b.x, b.y), pk2(b.z, b.w)}; }
template <int M> __device__ __forceinline__ float swz_xor(float v) { return __int_as_float(__builtin_amdgcn_ds_swizzle(__float_as_int(v), (M << 10) | 0x1f)); }
__device__ __forceinline__ float wave_sum(float v) {
    v += swz_xor<1>(v); v += swz_xor<2>(v); v += swz_xor<4>(v); v += swz_xor<8>(v); v += swz_xor<16>(v);
    const auto r = __builtin_amdgcn_permlane32_swap(__float_as_uint(v), __float_as_uint(v), false, false);
    return __uint_as_float(r[0]) + __uint_as_float(r[1]);
}
__device__ __forceinline__ float lane_bcast(float v, int src_lane) { return __int_as_float(__builtin_amdgcn_ds_bpermute(src_lane << 2, __float_as_int(v))); }
__device__ __forceinline__ float sigmoidf_(float x) { return __builtin_amdgcn_rcpf(1.0f + __expf(-x)); }
__device__ __forceinline__ float siluf_(float x) { return x * __builtin_amdgcn_rcpf(1.0f + __expf(-x)); }
__device__ __forceinline__ float gelu_tanh(float x) { const float z = 0.7978845608028654f * (x + 0.044715f * x * x * x); return x * (1.0f - __builtin_amdgcn_rcpf(1.0f + __expf(2.0f * z))); }
#define LDS_WAIT() asm volatile("s_waitcnt lgkmcnt(0)" ::: "memory")
#define WG_BAR_LDS() do { asm volatile("s_waitcnt lgkmcnt(0)" ::: "memory"); __builtin_amdgcn_s_barrier(); asm volatile("" ::: "memory"); } while (0)
__device__ __forceinline__ f32x4 zero4() { float z; asm volatile("v_mov_b32 %0, 0" : "=v"(z)); return (f32x4){z, z, z, z}; }

template <typename T> __device__ __forceinline__ T ldg(const void* base, unsigned off) { return *(const GAS T*)((const GAS char*)base + off); }
template <typename T> __device__ __forceinline__ void stg(void* base, unsigned off, T v) { *(GAS T*)((GAS char*)base + off) = v; }
#define XB_TMO      128
#define XB_XCNT(j)  (256  + 64 * (j))
#define XB_XSUB(j)  (1280 + 64 * (j))
#define XB_XGEN(j)  (2304 + 64 * (j))
#define XB_TOP      3328
#define XB_TOPGEN   3392
#define XCD_BAR_WORDS 3456
#define XB_SPIN_CAP (1u << 18)
__device__ __forceinline__ unsigned xb_ld(unsigned* p)              { return __hip_atomic_load(p, __ATOMIC_RELAXED, __HIP_MEMORY_SCOPE_AGENT); }
__device__ __forceinline__ unsigned xb_add(unsigned* p, unsigned v) { return __hip_atomic_fetch_add(p, v, __ATOMIC_RELAXED, __HIP_MEMORY_SCOPE_AGENT); }
__device__ __forceinline__ unsigned xb_xcc_id() { return (unsigned)__builtin_amdgcn_s_getreg((3 << 11) | 20) & 0xFu; }
#define XB_SPIN(cond, bar) do { unsigned _sp = 0; while (cond) { __builtin_amdgcn_s_sleep(1); \
    if ((++_sp & 255u) == 0u) { if (xb_ld(&(bar)[XB_TMO])) break; if (_sp > XB_SPIN_CAP) { atomicAdd(&(bar)[XB_TMO], 1u); break; } } } } while (0)
struct XcdBarrier { unsigned* bar; unsigned x; volatile LAS unsigned* st; };
__device__ __forceinline__ XcdBarrier xcd_barrier_post(unsigned* bar, volatile LAS unsigned* st) {
    XcdBarrier b; b.bar = bar; b.x = xb_xcc_id(); b.st = st;
    if (threadIdx.x == 0) (void)xb_add(&bar[XB_XCNT(b.x)], 1u);
    return b;
}
__device__ __forceinline__ void xcd_barrier_complete(unsigned* bar, unsigned x, unsigned& nloc, unsigned& nx) {
    const unsigned G = gridDim.x * gridDim.y * gridDim.z;
    unsigned sum, cnt, mine, sp = 0u;
    for (;;) {
        sum = 0u; cnt = 0u; mine = 0u;
#pragma unroll
        for (unsigned j = 0; j < 16; ++j) { const unsigned c = xb_ld(&bar[XB_XCNT(j)]); sum += c; cnt += (c > 0u) ? 1u : 0u; mine = (j == x) ? c : mine; }
        if (sum == G) break;
        __builtin_amdgcn_s_sleep(1);
        if ((++sp & 255u) == 0u) { if (xb_ld(&bar[XB_TMO])) break; if (sp > XB_SPIN_CAP) { atomicAdd(&bar[XB_TMO], 1u); break; } }
    }
    nloc = mine > 0u ? mine : 1u; nx = cnt > 0u ? cnt : 1u;
}
__device__ __forceinline__ void xcd_barrier(const XcdBarrier& b) {
    asm volatile("s_waitcnt vmcnt(0)" ::: "memory");
    __syncthreads();
    if (threadIdx.x == 0) {
        unsigned* bar = b.bar;
        __builtin_amdgcn_s_waitcnt(0);
        unsigned nloc = b.st[0], nx = b.st[1];
        if (nloc == 0u) { xcd_barrier_complete(bar, b.x, nloc, nx); b.st[0] = nloc; b.st[1] = nx; }
        const unsigned old = xb_add(&bar[XB_XSUB(b.x)], 1u);
        const unsigned gen = old / nloc;
        if (old + 1u == (gen + 1u) * nloc) {
            __builtin_amdgcn_fence(__ATOMIC_RELEASE, "agent");
            asm volatile("s_waitcnt vmcnt(0)" ::: "memory");
            const unsigned og = xb_add(&bar[XB_TOP], 1u);
            const unsigned tg = og / nx;
            if (og + 1u == (tg + 1u) * nx) xb_add(&bar[XB_TOPGEN], 1u);
            else XB_SPIN(xb_ld(&bar[XB_TOPGEN]) == tg, bar);
            __builtin_amdgcn_fence(__ATOMIC_ACQUIRE, "agent");
            xb_add(&bar[XB_XGEN(b.x)], 1u);
            asm volatile("s_waitcnt vmcnt(0)" ::: "memory");
        } else {
            XB_SPIN(xb_ld(&bar[XB_XGEN(b.x)]) == gen, bar);
            __builtin_amdgcn_fence(__ATOMIC_ACQUIRE, "agent");
            asm volatile("s_waitcnt vmcnt(0)" ::: "memory");
        }
    }
    __syncthreads();
}

namespace pg8 {
constexpr int BM = 256, BK = 64, HALF = 128, HTB = HALF * BK * 2, STAGE_BYTES = 8 * HTB, NXCD = 8, WGM = 8;
__host__ __device__ __forceinline__ int lds_byte(int r, int c) { const int st = (r >> 4) * 2 + (c >> 5), rr = r & 15, cc = c & 31, ob = rr * 64 + cc * 2; return st * 1024 + (ob ^ (((ob >> 9) & 1) << 5)); }
__host__ __device__ __forceinline__ void stage_rc(int b, int& R, int& C) { const int st = b / 1024, sb = b % 1024, swz = sb ^ (((sb >> 9) & 1) << 5); R = (st >> 1) * 16 + swz / 64; C = (st & 1) * 32 + (swz % 64) / 2; }
__host__ __device__ __forceinline__ int perm32(int rho) { const int n = rho >> 4, i = rho & 15; return 8 * (i >> 2) + 4 * n + (i & 3); }

struct Unit { int pm, pn, e, kt0, nt, slab; };
struct Gemm { const bf16_t* A; const bf16_t* Bt; int N, K; size_t estride; float* slabs; };

__device__ __forceinline__ int split_factor(int U, int G, int ntiles, int maxslabs) {
    const int R = U % G; if (R == 0) return 1;
    int S = G / R; if (S > 8) S = 8; if (S > ntiles / 2) S = ntiles / 2; if (R * S > maxslabs) S = maxslabs / R;
    return S < 2 ? 1 : S;
}
struct Order {
    int nM, nN, G, c, ntiles, mainu, S, total; const int* segs; const int* rowmap;
    int sg1, sg2, sg3, sg4, sg5, sg6, sg7;
    __device__ __forceinline__ void init(int nM_, int nN_, int G_, int c_, const int* segs_, const int* rowmap_, int ntiles_, bool split, int maxslabs) {
        nM = nM_; nN = nN_; G = G_; c = c_; segs = segs_; rowmap = rowmap_; ntiles = ntiles_;
        sg1 = sg2 = sg3 = sg4 = sg5 = sg6 = sg7 = 0; if (segs_) { sg1 = segs_[1]; sg2 = segs_[2]; sg3 = segs_[3]; sg4 = segs_[4]; sg5 = segs_[5]; sg6 = segs_[6]; sg7 = segs_[7]; }
        const int U = nM * nN; S = split ? split_factor(U, G, ntiles, maxslabs) : 1; const int R = (S > 1) ? U % G : 0; mainu = U - R; total = mainu + R * S; }
    __device__ __forceinline__ bool next(int i, Unit& u) const {
        const long L = (long)i * G + c; if (L >= total) return false;
        int wgid; u.kt0 = 0; u.nt = ntiles; u.slab = -1;
        if (L < mainu) { wgid = (int)L; const int q = mainu / NXCD, r = mainu % NXCD, xcd = wgid % NXCD, off = wgid / NXCD; wgid = (xcd < r ? xcd * (q + 1) : r * (q + 1) + (xcd - r) * q) + off; }
        else { const int sub = (int)L - mainu, lu = sub / S, sl = sub - lu * S, pairs = ntiles / 2, p0 = (sl * pairs) / S, p1 = ((sl + 1) * pairs) / S;
            wgid = mainu + lu; u.kt0 = 2 * p0; u.nt = 2 * (p1 - p0); u.slab = sub; }
        const int nig = WGM * nN, gid = wgid / nig, fm = gid * WGM, gsz = (nM - fm) < WGM ? (nM - fm) : WGM;
        u.pm = fm + ((wgid % nig) % gsz); u.pn = (wgid % nig) / gsz; u.e = 0;
        if (segs) u.e = (u.pm >= sg1) + (u.pm >= sg2) + (u.pm >= sg3) + (u.pm >= sg4) + (u.pm >= sg5) + (u.pm >= sg6) + (u.pm >= sg7);
        return true;
    }
    __device__ __forceinline__ int arow(const Unit& u, int r) const {
        if (rowmap) { const int t = rowmap[u.pm * BM + r]; return t < 0 ? 0 : t; }
        return u.pm * BM + r;
    }
};

__device__ __forceinline__ unsigned cvt_pk_bf16(float lo, float hi) { return pk2(lo, hi); }

struct EpiBf16 {
    static constexpr bool PERM = true, SPLIT = false;
    bf16_t* O; int ldc;
    __device__ __forceinline__ void operator()(const f32x4 (&acc)[2][2][4][2], const Unit& u, int wr, int wc, int fr, int fq) const {
        asm volatile("" : "+v"(fr), "+v"(fq));
        const int row0 = u.pm * BM + wr * 64 + fr, col0 = u.pn * BM + wc * 32 + 8 * fq;
#pragma unroll
        for (int ai = 0; ai < 2; ++ai)
#pragma unroll
            for (int m = 0; m < 4; ++m) { bf16_t* rowp = O + (size_t)(row0 + ai * HALF + m * 16) * ldc + col0;
#pragma unroll
                for (int bj = 0; bj < 2; ++bj) { const f32x4 v0 = acc[ai][bj][m][0], v1 = acc[ai][bj][m][1];
                    u32x4 w; w.x = cvt_pk_bf16(v0[0], v0[1]); w.y = cvt_pk_bf16(v0[2], v0[3]); w.z = cvt_pk_bf16(v1[0], v1[1]); w.w = cvt_pk_bf16(v1[2], v1[3]);
                    *(u32x4*)(rowp + bj * HALF) = w; } }
    }
};
struct EpiSwiGLU {
    static constexpr bool PERM = true, SPLIT = false;
    bf16_t* O; int ldc;
    __device__ __forceinline__ void operator()(const f32x4 (&acc)[2][2][4][2], const Unit& u, int wr, int wc, int fr, int fq) const {
        asm volatile("" : "+v"(fr), "+v"(fq));
        const int row0 = u.pm * BM + wr * 64 + fr, col0 = u.pn * HALF + wc * 32 + 8 * fq;
#pragma unroll
        for (int ai = 0; ai < 2; ++ai)
#pragma unroll
            for (int m = 0; m < 4; ++m) { bf16_t* rowp = O + (size_t)(row0 + ai * HALF + m * 16) * ldc + col0;
                float o[8];
#pragma unroll
                for (int n = 0; n < 2; ++n)
#pragma unroll
                    for (int j = 0; j < 4; ++j) { const float a = acc[ai][0][m][n][j], b = acc[ai][1][m][n][j]; o[n * 4 + j] = (a * __builtin_amdgcn_rcpf(1.0f + __expf(-a))) * b; }
                u32x4 w; w.x = cvt_pk_bf16(o[0], o[1]); w.y = cvt_pk_bf16(o[2], o[3]); w.z = cvt_pk_bf16(o[4], o[5]); w.w = cvt_pk_bf16(o[6], o[7]);
                *(u32x4*)rowp = w; }
    }
};
struct EpiResid {
    static constexpr bool PERM = true, SPLIT = true;
    const float* src_f32; bf16_t* xb; const float* src_ctx; float* dst_ctx; const float* gate_lat; const float* gate_ctx;
    __device__ __forceinline__ void operator()(const f32x4 (&acc)[2][2][4][2], const Unit& u, int wr, int wc, int fr, int fq) const {
        asm volatile("" : "+v"(fr), "+v"(fq));
        const int prow = u.pm * BM; const bool lat = prow < NLAT;
        const float* gate = lat ? gate_lat + (size_t)(prow / SEQ) * 6144 : gate_ctx;
        const int r0 = wr * 64 + fr, col0 = u.pn * BM + wc * 32 + 8 * fq;
        f32x4 gv[2][2];
#pragma unroll
        for (int bj = 0; bj < 2; ++bj)
#pragma unroll
            for (int n = 0; n < 2; ++n) gv[bj][n] = *(const f32x4*)(gate + col0 + bj * HALF + 4 * n);
        if (lat) {
#pragma unroll
            for (int ai = 0; ai < 2; ++ai)
#pragma unroll
                for (int m = 0; m < 4; ++m) { const size_t off = (size_t)(prow + r0 + ai * HALF + m * 16) * D + col0;
#pragma unroll
                    for (int bj = 0; bj < 2; ++bj) { f32x4 s0, s1;
                        if (src_f32) { s0 = *(const f32x4*)(src_f32 + off + bj * HALF); s1 = *(const f32x4*)(src_f32 + off + bj * HALF + 4); }
                        else unpack8(*(const u32x4*)(xb + off + bj * HALF), s0, s1);
                        *(u32x4*)(xb + off + bj * HALF) = pack8(s0 + gv[bj][0] * acc[ai][bj][m][0], s1 + gv[bj][1] * acc[ai][bj][m][1]); }
                    asm volatile("" ::: "memory"); }
        } else {
            const float* src = src_ctx + (size_t)(prow - NLAT) * D; float* dst = dst_ctx + (size_t)(prow - NLAT) * D;
#pragma unroll
            for (int ai = 0; ai < 2; ++ai)
#pragma unroll
                for (int m = 0; m < 4; ++m) { const size_t off = (size_t)(r0 + ai * HALF + m * 16) * D + col0;
#pragma unroll
                    for (int bj = 0; bj < 2; ++bj)
#pragma unroll
                        for (int n = 0; n < 2; ++n) { const f32x4 sv = *(const f32x4*)(src + off + bj * HALF + 4 * n); *(f32x4*)(dst + off + bj * HALF + 4 * n) = sv + gv[bj][n] * acc[ai][bj][m][n]; }
                    asm volatile("" ::: "memory"); }
        }
    }
};
struct EpiMoeDown {
    static constexpr bool PERM = true, SPLIT = true;
    bf16_t* xb; const int* ptok; const float* pw; const float* gate_lat;
    __device__ __forceinline__ void operator()(const f32x4 (&acc)[2][2][4][2], const Unit& u, int wr, int wc, int fr, int fq) const {
        asm volatile("" : "+v"(fr), "+v"(fq));
        const int r0 = u.pm * BM + wr * 64 + fr, col0 = u.pn * BM + wc * 32 + 8 * fq;
#pragma unroll
        for (int ai = 0; ai < 2; ++ai)
#pragma unroll
            for (int m = 0; m < 4; ++m) { const int r = r0 + ai * HALF + m * 16; const int tok = ptok[r]; const float w = pw[r];
                if (tok >= 0) { bf16_t* xr = xb + (size_t)tok * D + col0; const float* gate = gate_lat + (size_t)(tok / SEQ) * 6144 + col0;
#pragma unroll
                    for (int bj = 0; bj < 2; ++bj) { const f32x4 g0 = *(const f32x4*)(gate + bj * HALF), g1 = *(const f32x4*)(gate + bj * HALF + 4); f32x4 s0, s1; unpack8(*(const u32x4*)(xr + bj * HALF), s0, s1);
                        *(u32x4*)(xr + bj * HALF) = pack8(s0 + (g0 * w) * acc[ai][bj][m][0], s1 + (g1 * w) * acc[ai][bj][m][1]); } }
                asm volatile("" ::: "memory"); }
    }
};

template <class Epi>
__device__ __forceinline__ void gemm_phase(ldsp_t lds, const Gemm g, const Order& S, const Epi& E, const int tid) {
    const int wid = __builtin_amdgcn_readfirstlane(tid >> 6), lane = tid & 63, wr = wid >> 2, wc = wid & 3, fr = lane & 15, fq = lane >> 4;
    const int K = g.K;
    unsigned voffB[2];
#pragma unroll
    for (int i = 0; i < 2; ++i) { int R, C; stage_rc(tid * 16 + i * 8192, R, C); const int Rb = Epi::PERM ? ((R & ~31) + perm32(R & 31)) : R;
        voffB[i] = (unsigned)(Rb * K + C) * 2u; }
    const size_t kstep = (size_t)(BK * 2);
    const size_t hstep = (size_t)HALF * K * 2;
    const size_t tstep = 2 * hstep;
    const unsigned ldsw = (unsigned)wid * 1024u;
    const int aoff = lds_byte(wr * 64 + fr, fq * 8), boff = lds_byte(wc * 32 + fr, fq * 8);
#define PG8_SA(b, h) (((b) * 2 + (h)) * HTB)
#define PG8_SB(b, h) ((4 + (b) * 2 + (h)) * HTB)
#define PG8_STAGE_B(bufoff, gbase) do { _Pragma("unroll") for (int _i = 0; _i < 2; ++_i) \
        __builtin_amdgcn_global_load_lds((const unsigned*)((const char*)(gbase) + voffB[_i]), (LAS unsigned*)(lds + (bufoff) + ldsw + _i * 8192), 16, 0, 0); } while (0)
#define PG8_STAGE_A(bufoff, gbase, o0, o1) do { \
        __builtin_amdgcn_global_load_lds((const unsigned*)((const char*)(gbase) + (o0)), (LAS unsigned*)(lds + (bufoff) + ldsw), 16, 0, 0); \
        __builtin_amdgcn_global_load_lds((const unsigned*)((const char*)(gbase) + (o1)), (LAS unsigned*)(lds + (bufoff) + ldsw + 8192), 16, 0, 0); } while (0)
#define PG8_LDA(dst, b, h) do { _Pragma("unroll") for (int m = 0; m < 4; ++m) _Pragma("unroll") for (int k = 0; k < 2; ++k) dst[m][k] = *(const LAS bf16x8*)(lds + PG8_SA(b, h) + aoff + m * 2048 + k * 1024); } while (0)
#define PG8_LDB(dst, b, h) do { _Pragma("unroll") for (int n = 0; n < 2; ++n) _Pragma("unroll") for (int k = 0; k < 2; ++k) dst[n][k] = *(const LAS bf16x8*)(lds + PG8_SB(b, h) + boff + n * 2048 + k * 1024); } while (0)
#define PG8_MMA(ai, bj, At, Bt) do { __builtin_amdgcn_s_setprio(1); _Pragma("unroll") for (int m = 0; m < 4; ++m) _Pragma("unroll") for (int n = 0; n < 2; ++n) _Pragma("unroll") for (int k = 0; k < 2; ++k) \
        acc[ai][bj][m][n] = __builtin_amdgcn_mfma_f32_16x16x32_bf16(Bt[n][k], At[m][k], acc[ai][bj][m][n], 0, 0, 0); __builtin_amdgcn_s_setprio(0); } while (0)
#define PG8_WAIT_V(n) asm volatile("s_waitcnt vmcnt(" #n ")" ::: "memory")
#define PG8_WAIT_L(n) asm volatile("s_waitcnt lgkmcnt(" #n ")" ::: "memory")
#define PG8_BAR __builtin_amdgcn_s_barrier()
#define PG8_SCHED __builtin_amdgcn_sched_barrier(0)
#define PG8_AOFFS(u, o00, o01, o10, o11) do { int R0_, C0_, R1_, C1_; stage_rc(tid * 16, R0_, C0_); stage_rc(tid * 16 + 8192, R1_, C1_); \
        o00 = (unsigned)(S.arow(u, R0_) * K + C0_ + (u).kt0 * BK) * 2u; o01 = (unsigned)(S.arow(u, R1_) * K + C1_ + (u).kt0 * BK) * 2u; \
        o10 = (unsigned)(S.arow(u, HALF + R0_) * K + C0_ + (u).kt0 * BK) * 2u; o11 = (unsigned)(S.arow(u, HALF + R1_) * K + C1_ + (u).kt0 * BK) * 2u; } while (0)
    Unit cur, nxt; int ui = 0;
    if (!S.next(0, cur)) return;
    f32x4 acc[2][2][4][2];
    { float z_; asm volatile("v_mov_b32 %0, 0" : "=v"(z_));
#pragma unroll
    for (int a = 0; a < 2; ++a)
#pragma unroll
        for (int b = 0; b < 2; ++b)
#pragma unroll
            for (int m = 0; m < 4; ++m)
#pragma unroll
                for (int n = 0; n < 2; ++n) acc[a][b][m][n] = (f32x4){z_, z_, z_, z_}; }
    bf16x8 At[4][2], B0[2][2], B1[2][2];
    const char* const Abase = (const char*)g.A;
    const char* cB = (const char*)g.Bt + (size_t)cur.e * g.estride + (size_t)cur.pn * tstep + (size_t)cur.kt0 * kstep;
    unsigned c00, c01, c10, c11;
    PG8_AOFFS(cur, c00, c01, c10, c11);
    PG8_STAGE_B(PG8_SB(0, 0), cB); PG8_STAGE_B(PG8_SB(0, 1), cB + hstep); PG8_STAGE_A(PG8_SA(0, 0), Abase, c00, c01); PG8_STAGE_A(PG8_SA(0, 1), Abase, c10, c11);
    if (wr == 1) PG8_BAR;
    PG8_WAIT_V(2); PG8_BAR;
    PG8_STAGE_B(PG8_SB(1, 0), cB + kstep); PG8_STAGE_A(PG8_SA(1, 0), Abase + kstep, c00, c01); PG8_STAGE_B(PG8_SB(1, 1), cB + hstep + kstep);
    PG8_WAIT_V(6); PG8_BAR;
    for (;;) {
        const bool has_next = S.next(ui + 1, nxt);
        const char* nB = has_next ? (const char*)g.Bt + (size_t)nxt.e * g.estride + (size_t)nxt.pn * tstep + (size_t)nxt.kt0 * kstep : cB;
        const int nt = cur.nt;
        int rn0 = 0, rn1 = 0, rn2 = 0, rn3 = 0;
        if (S.rowmap && has_next) { int R0_, C0_, R1_, C1_; stage_rc(tid * 16, R0_, C0_); stage_rc(tid * 16 + 8192, R1_, C1_);
            rn0 = S.arow(nxt, R0_); rn1 = S.arow(nxt, R1_); rn2 = S.arow(nxt, HALF + R0_); rn3 = S.arow(nxt, HALF + R1_); }
        for (int t = 0; t < nt; t += 2) {
            const bool last = (t == nt - 2);
            const char* a1 = Abase + (size_t)(t + 1) * kstep;
            const char* a2 = last ? Abase : Abase + (size_t)(t + 2) * kstep; const char* b2 = last ? nB : cB + (size_t)(t + 2) * kstep;
            const char* a3 = a2 + kstep; const char* b3 = b2 + kstep;
            PG8_LDB(B0, 0, 0); PG8_LDB(B1, 0, 1); PG8_SCHED; PG8_LDA(At, 0, 0); PG8_STAGE_A(PG8_SA(1, 1), a1, c10, c11);
            PG8_WAIT_V(8); PG8_WAIT_L(0); PG8_BAR; PG8_MMA(0, 0, At, B0); PG8_MMA(0, 1, At, B1); PG8_BAR; PG8_SCHED;
            if (last && has_next) {
                if (S.rowmap) { int R0_, C0_, R1_, C1_; stage_rc(tid * 16, R0_, C0_); stage_rc(tid * 16 + 8192, R1_, C1_);
                    c00 = (unsigned)(rn0 * K + C0_ + nxt.kt0 * BK) * 2u; c01 = (unsigned)(rn1 * K + C1_ + nxt.kt0 * BK) * 2u; c10 = (unsigned)(rn2 * K + C0_ + nxt.kt0 * BK) * 2u; c11 = (unsigned)(rn3 * K + C1_ + nxt.kt0 * BK) * 2u; }
                else { PG8_AOFFS(nxt, c00, c01, c10, c11); } }
            PG8_LDA(At, 0, 1); PG8_STAGE_B(PG8_SB(0, 0), b2); PG8_STAGE_B(PG8_SB(0, 1), b2 + hstep); PG8_STAGE_A(PG8_SA(0, 0), a2, c00, c01);
            PG8_WAIT_V(8); PG8_WAIT_L(0); PG8_BAR; PG8_MMA(1, 0, At, B0); PG8_MMA(1, 1, At, B1); PG8_BAR; PG8_SCHED;
            PG8_LDB(B0, 1, 0); PG8_LDB(B1, 1, 1); PG8_SCHED; PG8_LDA(At, 1, 0); PG8_STAGE_A(PG8_SA(0, 1), a2, c10, c11);
            PG8_WAIT_V(8); PG8_WAIT_L(0); PG8_BAR; PG8_MMA(0, 0, At, B0); PG8_MMA(0, 1, At, B1); PG8_BAR; PG8_SCHED;
            PG8_LDA(At, 1, 1); PG8_STAGE_B(PG8_SB(1, 0), b3); PG8_STAGE_B(PG8_SB(1, 1), b3 + hstep); PG8_STAGE_A(PG8_SA(1, 0), a3, c00, c01);
            PG8_WAIT_V(8); PG8_WAIT_L(0); PG8_BAR; PG8_MMA(1, 0, At, B0); PG8_MMA(1, 1, At, B1); PG8_BAR; PG8_SCHED;
        }
        if (wr == 0) PG8_BAR;
        if (Epi::SPLIT && cur.slab >= 0) {
            int fr_ = fr, fq_ = fq; asm volatile("" : "+v"(fr_), "+v"(fq_));
            float* sp = g.slabs + (size_t)cur.slab * 65536 + (size_t)(wr * 64 + fr_) * 256 + wc * 32 + (Epi::PERM ? 8 : 4) * fq_;
#pragma unroll
            for (int ai = 0; ai < 2; ++ai)
#pragma unroll
                for (int m = 0; m < 4; ++m)
#pragma unroll
                    for (int bj = 0; bj < 2; ++bj)
#pragma unroll
                        for (int n = 0; n < 2; ++n) *(f32x4*)(sp + (ai * HALF + m * 16) * 256 + bj * HALF + n * (Epi::PERM ? 4 : 16)) = acc[ai][bj][m][n];
        } else E(acc, cur, wr, wc, fr, fq);
        if (!has_next) break;
        { float z_; asm volatile("v_mov_b32 %0, 0" : "=v"(z_));
#pragma unroll
        for (int a = 0; a < 2; ++a)
#pragma unroll
            for (int b = 0; b < 2; ++b)
#pragma unroll
                for (int m = 0; m < 4; ++m)
#pragma unroll
                    for (int n = 0; n < 2; ++n) acc[a][b][m][n] = (f32x4){z_, z_, z_, z_}; }
        cur = nxt; cB = nB; ++ui;
        if (wr == 1) PG8_BAR;
    }
    PG8_WAIT_V(0);
    PG8_BAR;
#undef PG8_SA
#undef PG8_SB
#undef PG8_STAGE_A
#undef PG8_STAGE_B
#undef PG8_LDA
#undef PG8_LDB
#undef PG8_MMA
#undef PG8_WAIT_V
#undef PG8_WAIT_L
#undef PG8_BAR
#undef PG8_SCHED
#undef PG8_AOFFS
}
}

struct Args { const float* in[27]; float* out; unsigned char* ws; int ph_lo, ph_hi; };
struct Frame {
    ldsp_t lds; int tid, lane, wave, wave0, G, bid;
    const Args* pa; float* out; unsigned char* ws;
    const Args* pa0; float* out0; unsigned char* ws0;
};
enum { I_X = 0, I_C, I_CTX, I_CCTX, I_WMOD, I_BMOD, I_GMIX, I_GFFN, I_GFINAL, I_WIN, I_WOUT, I_CONVW, I_CONVB, I_RGWA, I_RGBA, I_RGWX, I_RGBX, I_RGLAM, I_RETDEC,
       I_FW1, I_FW3, I_FW2, I_MROUTER, I_MROUTERB, I_MW1, I_MW3, I_MW2 };

constexpr int TRS = 64 * 65 * 4;
struct TrItem { const float* W; bf16_t* WT; int ldw, k0, n0, ldt, drow0; float scale; };
__device__ __forceinline__ void tr_load(const TrItem& t, f32x4 (&v)[16], int lane) {
    const int r4 = lane >> 4, c4 = (lane & 15) * 4;
#pragma unroll
    for (int i = 0; i < 16; ++i) v[i] = *(const f32x4*)(t.W + (size_t)(t.k0 + 4 * i + r4) * t.ldw + t.n0 + c4);
}
__device__ __forceinline__ void tr_store(const TrItem& t, const f32x4 (&v)[16], LAS float* scr, int lane) {
    { const int r4 = lane >> 4, c4 = (lane & 15) * 4;
#pragma unroll
      for (int i = 0; i < 16; ++i) { LAS float* d = scr + (4 * i + r4) * 65 + c4; d[0] = v[i].x; d[1] = v[i].y; d[2] = v[i].z; d[3] = v[i].w; } }
    LDS_WAIT(); asm volatile("" ::: "memory");
    const int c = lane & 7; const float scale = t.scale;
#pragma unroll
    for (int j = 0; j < 8; ++j) { const int n = (lane >> 3) + 8 * j; const LAS float* sp = scr + (8 * c) * 65 + n;
        u32x4 o; o.x = pk2(sp[0 * 65] * scale, sp[1 * 65] * scale); o.y = pk2(sp[2 * 65] * scale, sp[3 * 65] * scale); o.z = pk2(sp[4 * 65] * scale, sp[5 * 65] * scale); o.w = pk2(sp[6 * 65] * scale, sp[7 * 65] * scale);
        *(u32x4*)(t.WT + (size_t)(t.drow0 + n) * t.ldt + t.k0 + 8 * c) = o; }
    LDS_WAIT(); asm volatile("" ::: "memory");
}
__device__ __forceinline__ TrItem up_item(const float* w1, const float* w3, int F, bf16_t* WT, int r) {
    const int per = 16 * (F / 64); const int which = r / per; r -= which * per;
    const int nblk = F / 64, kb = r / nblk, nb = r % nblk, n0 = nb * 64;
    return TrItem{which ? w3 : w1, WT, F, kb * 64, n0, D, (n0 / 128) * 256 + (n0 % 128) + which * 128, 1.0f};
}
__device__ __forceinline__ TrItem small_item(Frame& F, int r) {
    constexpr int I_IN = 16 * (INW / 64), I_OUT = 16 * (D / 64), I_UP = 2 * 16 * (DFF / 64);
    if (r < 2 * I_IN) { const int l = r / I_IN; r -= l * I_IN; const int nblk = INW / 64, kb = r / nblk, nb = r % nblk, n0 = nb * 64;
        const float sc = (n0 >= 1536 && n0 < 2048) ? 0.08838834764831845f : 1.0f;
        return TrItem{F.pa->in[I_WIN] + (size_t)l * D * INW, (bf16_t*)(F.ws + WS_WIN) + (size_t)l * INW * D, INW, kb * 64, n0, D, n0, sc}; }
    r -= 2 * I_IN;
    if (r < 2 * I_OUT) { const int l = r / I_OUT; r -= l * I_OUT; const int nblk = D / 64, kb = r / nblk, nb = r % nblk;
        return TrItem{F.pa->in[I_WOUT] + (size_t)l * D * D, (bf16_t*)(F.ws + WS_WOUT) + (size_t)l * D * D, D, kb * 64, nb * 64, D, nb * 64, 1.0f}; }
    r -= 2 * I_OUT;
    if (r < I_UP) return up_item(F.pa->in[I_FW1], F.pa->in[I_FW3], DFF, (bf16_t*)(F.ws + WS_WUP), r);
    r -= I_UP;
    { const int nblk = D / 64, kb = r / nblk, nb = r % nblk; return TrItem{F.pa->in[I_FW2], (bf16_t*)(F.ws + WS_WDN), D, kb * 64, nb * 64, DFF, nb * 64, 1.0f}; }
}
__device__ __forceinline__ TrItem moe_item(Frame& F, int it) {
    constexpr int I_UP = 2 * 16 * (DEXP / 64), I_DN = (DEXP / 64) * (D / 64), PER_E = I_UP + I_DN;
    const int e = it / PER_E; int r = it - e * PER_E;
    if (r < I_UP) return up_item(F.pa->in[I_MW1] + (size_t)e * D * DEXP, F.pa->in[I_MW3] + (size_t)e * D * DEXP, DEXP, (bf16_t*)(F.ws + WS_MOEUP) + (size_t)e * 2 * DEXP * D, r);
    r -= I_UP;
    { const int nblk = D / 64, kb = r / nblk, nb = r % nblk; return TrItem{F.pa->in[I_MW2] + (size_t)e * DEXP * D, (bf16_t*)(F.ws + WS_MOEDN) + (size_t)e * D * DEXP, D, kb * 64, nb * 64, DEXP, nb * 64, 1.0f}; }
}
__device__ __forceinline__ void phase_convert_small(Frame& F) {
    LAS float* scr = (LAS float*)(F.lds + F.wave * TRS);
    const int gw = F.bid * NWAVES + F.wave, NGW = F.G * NWAVES;
    constexpr int NITEMS = 2 * 16 * (INW / 64) + 2 * 16 * (D / 64) + 2 * 16 * (DFF / 64) + (DFF / 64) * (D / 64);
    if (gw < NITEMS) { TrItem cur = small_item(F, gw); f32x4 va[16], vb[16]; tr_load(cur, va, F.lane);
        for (int it = gw; it < NITEMS; it += 2 * NGW) {
            const bool h1 = it + NGW < NITEMS; TrItem n1 = cur; if (h1) { n1 = small_item(F, it + NGW); tr_load(n1, vb, F.lane); }
            tr_store(cur, va, scr, F.lane);
            if (!h1) break;
            const bool h2 = it + 2 * NGW < NITEMS; if (h2) { cur = small_item(F, it + 2 * NGW); tr_load(cur, va, F.lane); }
            tr_store(n1, vb, scr, F.lane);
            if (!h2) break; } }
    { const int gt = F.bid * NTHREADS + F.tid, NGT = F.G * NTHREADS; bf16_t* o = (bf16_t*)(F.ws + WS_RGW);
      for (int i = gt; i < 2 * 2 * 2 * 8 * 64 * 64; i += NGT) { const int c = i & 63, dp = (i >> 6) & 63, blk = (i >> 12) & 7, gate = (i >> 15) & 1, dir = (i >> 16) & 1, l = i >> 17;
          const float* src = gate ? F.pa->in[I_RGWX] : F.pa->in[I_RGWA]; o[i] = (bf16_t)f2bf(src[((((size_t)l * 2 + dir) * 8 + blk) * 64 + c) * 64 + dp]); } }
    { const int gt = F.bid * NTHREADS + F.tid, NGT = F.G * NTHREADS; float* ct = (float*)(F.ws + WS_ROPE); float* st = ct + 4096 * 64;
      for (int i = gt; i < 4096 * 64; i += NGT) { const int pos = i >> 6, fi = i & 63; const float p = (float)((fi < 32) ? (pos >> 6) : (pos & 63));
          const float inv = powf(10000.0f, -(float)(fi & 31) / 32.0f); const float ang = p * inv;
          const double a = (double)ang; const double kq = __builtin_rint(a * 0.63661977236758134308); const double rr = a - kq * 1.57079632679489661923; const int q = ((int)kq) & 3;
          const double r2 = rr * rr;
          const double sn = rr * (1.0 + r2 * (-1.0 / 6 + r2 * (1.0 / 120 + r2 * (-1.0 / 5040 + r2 * (1.0 / 362880 + r2 * (-1.0 / 39916800))))));
          const double cs = 1.0 + r2 * (-0.5 + r2 * (1.0 / 24 + r2 * (-1.0 / 720 + r2 * (1.0 / 40320 + r2 * (-1.0 / 3628800 + r2 * (1.0 / 479001600))))));
          const double c_ = (q == 0) ? cs : (q == 1) ? -sn : (q == 2) ? -cs : sn; const double s_ = (q == 0) ? sn : (q == 1) ? cs : (q == 2) ? -sn : -cs;
          ct[i] = (float)c_; st[i] = (float)s_; } }
}
__device__ __forceinline__ void phase_convert_moe(Frame& F) {
    LAS float* scr = (LAS float*)(F.lds + F.wave * TRS);
    const int gw = F.bid * NWAVES + F.wave, NGW = F.G * NWAVES;
    constexpr int NITEMS = NE * (2 * 16 * (DEXP / 64) + (DEXP / 64) * (D / 64));
    if (gw < NITEMS) { TrItem cur = moe_item(F, gw); f32x4 va[16], vb[16]; tr_load(cur, va, F.lane);
        for (int it = gw; it < NITEMS; it += 2 * NGW) {
            const bool h1 = it + NGW < NITEMS; TrItem n1 = cur; if (h1) { n1 = moe_item(F, it + NGW); tr_load(n1, vb, F.lane); }
            tr_store(cur, va, scr, F.lane);
            if (!h1) break;
            const bool h2 = it + 2 * NGW < NITEMS; if (h2) { cur = moe_item(F, it + 2 * NGW); tr_load(cur, va, F.lane); }
            tr_store(n1, vb, scr, F.lane);
            if (!h2) break; } }
}
__device__ __forceinline__ void phase_mod(Frame& F) {
    LAS float* sc = (LAS float*)F.lds;
    LAS float* red = (LAS float*)(F.lds + 9 * 1024 * 4);
    for (int i = F.tid; i < 9 * 1024; i += NTHREADS) { const int r = i >> 10, k = i & 1023; const float v = (r < 8) ? F.pa->in[I_C][r * 1024 + k] : F.pa->in[I_CCTX][k]; sc[i] = v / (1.0f + __expf(-v)); }
    __syncthreads();
    for (int strip = F.bid; strip < 2 * 6144 / 64; strip += F.G) {
        const int l = strip / 96, j = (strip % 96) * 64 + F.lane;
        const float* w = F.pa->in[I_WMOD] + (size_t)l * 1024 * 6144 + j;
        float a[9];
#pragma unroll
        for (int r = 0; r < 9; ++r) a[r] = 0.f;
        const int k0 = F.wave * 128;
#pragma unroll 1
        for (int kk = k0; kk < k0 + 128; kk += 16) { float wv[16];
#pragma unroll
            for (int i = 0; i < 16; ++i) wv[i] = w[(size_t)(kk + i) * 6144];
#pragma unroll
            for (int i = 0; i < 16; ++i) {
#pragma unroll
                for (int r = 0; r < 9; ++r) a[r] += sc[r * 1024 + kk + i] * wv[i];
                if ((i & 3) == 3) __builtin_amdgcn_sched_barrier(0); } }
#pragma unroll
        for (int r = 0; r < 9; ++r) red[(F.wave * 9 + r) * 64 + F.lane] = a[r];
        __syncthreads();
        for (int i = F.tid; i < 9 * 64; i += NTHREADS) { const int r = i >> 6, jj = i & 63; float s = 0.f;
#pragma unroll
            for (int w8 = 0; w8 < 8; ++w8) s += red[(w8 * 9 + r) * 64 + jj];
            const int col = (strip % 96) * 64 + jj; s += F.pa->in[I_BMOD][l * 6144 + col];
            if (r < 8) ((float*)(F.ws + WS_MODLAT))[((size_t)l * 8 + r) * 6144 + col] = s; else ((float*)(F.ws + WS_MODCTX))[(size_t)l * 6144 + col] = s; }
        __syncthreads();
    }
}

__device__ __forceinline__ void norm_row(const u32x2 (&xw)[4], const f32x4 (&Am)[4], const f32x4 (&Sh)[4], bf16_t* orow, int lane, f32x4 (&y)[4]) {
    f32x4 v[4]; float ss = 0.f;
#pragma unroll
    for (int j = 0; j < 4; ++j) { const u32x2 w = xw[j]; v[j] = (f32x4){bf2f(w.x & 0xffffu), __uint_as_float(w.x & 0xffff0000u), bf2f(w.y & 0xffffu), __uint_as_float(w.y & 0xffff0000u)};
        ss += (v[j].x * v[j].x + v[j].y * v[j].y) + (v[j].z * v[j].z + v[j].w * v[j].w); }
    const float rstd = 1.0f / sqrtf(wave_sum(ss) * (1.0f / D) + EPS);
    u32x2* o8 = (u32x2*)orow + lane;
#pragma unroll
    for (int j = 0; j < 4; ++j) { y[j] = (v[j] * rstd) * Am[j] + Sh[j]; o8[64 * j] = (u32x2){pk2(y[j].x, y[j].y), pk2(y[j].z, y[j].w)}; }
}
struct SlabRed { const float* slab; int S; const float* gate; const float* xold; float* xnew; };
__device__ __forceinline__ void norm_row_v(f32x4 (&v)[4], const float* g, const float* shift, const float* scale, bf16_t* orow, int lane) {
    float ss = 0.f;
#pragma unroll
    for (int j = 0; j < 4; ++j) ss += (v[j].x * v[j].x + v[j].y * v[j].y) + (v[j].z * v[j].z + v[j].w * v[j].w);
    const float rstd = 1.0f / sqrtf(wave_sum(ss) * (1.0f / D) + EPS);
    u32x2* o8 = (u32x2*)orow + lane;
#pragma unroll
    for (int j = 0; j < 4; ++j) { const f32x4 gg = ((const f32x4*)g)[lane + 64 * j], sh = ((const f32x4*)shift)[lane + 64 * j], sl = ((const f32x4*)scale)[lane + 64 * j];
        const f32x4 y = (v[j] * rstd) * gg * (sl + 1.0f) + sh;
        u32x2 w; w.x = pk2(y.x, y.y); w.y = pk2(y.z, y.w); o8[64 * j] = w; }
}
__device__ __forceinline__ void phase_norm(Frame& F, int l, int sel, const float* xlat, const bf16_t* xb, const float* xctx, int nrows, const SlabRed sr) {
    const int gw = F.bid * NWAVES + F.wave, NGW = F.G * NWAVES;
    const float* g = (sel ? F.pa->in[I_GFFN] : F.pa->in[I_GMIX]) + l * D; const int so = sel ? 3072 : 0;
    bf16_t* HX = (bf16_t*)(F.ws + WS_HX);
    const int nlat = nrows < NLAT ? nrows : NLAT; const int per = (nlat + NGW - 1) / NGW, r_lo = gw * per, r_hi = (r_lo + per < nlat) ? r_lo + per : nlat;
    int curb = -1; f32x4 Am[4], Sh[4];
    for (int row0 = r_lo; row0 < r_hi; row0 += 4) {
        f32x4 v[4][4];
#pragma unroll
        for (int u = 0; u < 4; ++u) { const int row = (row0 + u < r_hi) ? row0 + u : row0;
            if (xb) { const u32x2* xr = (const u32x2*)(xb + (size_t)row * D) + F.lane;
#pragma unroll
                for (int j = 0; j < 4; ++j) { const u32x2 w = xr[64 * j]; v[u][j] = (f32x4){bf2f(w.x & 0xffffu), __uint_as_float(w.x & 0xffff0000u), bf2f(w.y & 0xffffu), __uint_as_float(w.y & 0xffff0000u)}; } }
            else { const f32x4* xr = (const f32x4*)(xlat + (size_t)row * D) + F.lane;
#pragma unroll
                for (int j = 0; j < 4; ++j) v[u][j] = xr[64 * j]; } }
#pragma unroll
        for (int u = 0; u < 4; ++u) { const int row = row0 + u; if (row >= r_hi) continue;
            const int b = row / SEQ;
            if (b != curb) { curb = b; const float* mod = (const float*)(F.ws + WS_MODLAT) + ((size_t)l * 8 + b) * 6144 + so;
#pragma unroll
                for (int j = 0; j < 4; ++j) { Am[j] = ((const f32x4*)g)[F.lane + 64 * j] * (((const f32x4*)(mod + 1024))[F.lane + 64 * j] + 1.0f); Sh[j] = ((const f32x4*)mod)[F.lane + 64 * j]; } }
            float ss = 0.f;
#pragma unroll
            for (int j = 0; j < 4; ++j) ss += (v[u][j].x * v[u][j].x + v[u][j].y * v[u][j].y) + (v[u][j].z * v[u][j].z + v[u][j].w * v[u][j].w);
            const float rstd = 1.0f / sqrtf(wave_sum(ss) * (1.0f / D) + EPS);
            u32x2* o8 = (u32x2*)(HX + (size_t)row * D) + F.lane;
#pragma unroll
            for (int j = 0; j < 4; ++j) { const f32x4 y = (v[u][j] * rstd) * Am[j] + Sh[j]; o8[64 * j] = (u32x2){pk2(y.x, y.y), pk2(y.z, y.w)}; } }
    }
    for (int row = NLAT + gw; row < nrows; row += NGW) {
        const float* mod = (const float*)(F.ws + WS_MODCTX) + (size_t)l * 6144;
        f32x4 v[4];
        if (sr.slab == nullptr) { const f32x4* xr = (const f32x4*)(xctx + (size_t)(row - NLAT) * D) + F.lane;
#pragma unroll
            for (int j = 0; j < 4; ++j) v[j] = xr[64 * j]; }
        else { const int rc = row - NLAT, pmr = rc >> 8, r = rc & 255;
#pragma unroll
            for (int j = 0; j < 4; ++j) { f32x4 a = zero4(); const float* sp = sr.slab + (size_t)((pmr + 8 * j) * sr.S) * 65536 + (size_t)r * 256 + 4 * F.lane;
                f32x4 t8[8];
#pragma unroll
                for (int q = 0; q < 8; ++q) t8[q] = (q < sr.S) ? *(const f32x4*)(sp + (size_t)q * 65536) : zero4();
#pragma unroll
                for (int q = 0; q < 8; ++q) a += t8[q];
                v[j] = ((const f32x4*)(sr.xold + (size_t)rc * D))[F.lane + 64 * j] + ((const f32x4*)sr.gate)[F.lane + 64 * j] * a;
                ((f32x4*)(sr.xnew + (size_t)rc * D))[F.lane + 64 * j] = v[j]; } }
        norm_row_v(v, g, mod + so, mod + so + 1024, HX + (size_t)row * D, F.lane);
    }
}
__device__ __forceinline__ void moe_reduce(Frame& F, int k) {
    const int* meta = (const int*)(F.ws + MOE_META) + 9 * k; const int npan = meta[8], gsz = npan - 128;
    if (gsz <= 0) return;
    const int S = pg8::split_factor(npan * 4, F.G, DEXP / 64, MAXSLAB_M); if (S < 2) return;
    const int gw = F.bid * NWAVES + F.wave, NGW = F.G * NWAVES;
    const int* ptok = (const int*)(F.ws + MOE_PTOK) + k * MROWS; const float* pw = (const float*)(F.ws + MOE_PW) + k * MROWS;
    const float* slab = (const float*)(F.ws + WS_SLABM); const float* gate_lat = (const float*)(F.ws + WS_MODLAT) + (size_t)8 * 6144 + 5120;
    for (int rr = NLAT + gw; rr < npan * 256; rr += NGW) { const int tok = ptok[rr]; if (tok < 0) continue; const float w = pw[rr];
        const int pmr = (rr - NLAT) >> 8, r = rr & 255; u32x2* xr = (u32x2*)((bf16_t*)((char*)F.out + XB_OFF) + (size_t)tok * D); const f32x4* gt = (const f32x4*)(gate_lat + (size_t)(tok / SEQ) * 6144);
#pragma unroll
        for (int j = 0; j < 4; ++j) { f32x4 a = zero4(); const float* sp = slab + (size_t)((pmr + gsz * j) * S) * 65536 + (size_t)r * 256 + 4 * F.lane;
            for (int q = 0; q < S; ++q) a += *(const f32x4*)(sp + (size_t)q * 65536);
            const u32x2 xo = xr[F.lane + 64 * j]; const f32x4 xv = {bf2f(xo.x & 0xffffu), __uint_as_float(xo.x & 0xffff0000u), bf2f(xo.y & 0xffffu), __uint_as_float(xo.y & 0xffff0000u)};
            const f32x4 y = xv + (gt[F.lane + 64 * j] * w) * a; xr[F.lane + 64 * j] = (u32x2){pk2(y.x, y.y), pk2(y.z, y.w)}; } }
}
__device__ __forceinline__ void phase_norm_router(Frame& F, const bf16_t* xb) {
    constexpr int l = 1;
    LAS float* wr = (LAS float*)F.lds;
    LAS int* le = (LAS int*)(F.lds + 32768);
    for (int i = F.tid; i < 1024 * 8 / 4; i += NTHREADS) ((LAS f32x4*)wr)[i] = ((const f32x4*)F.pa->in[I_MROUTER])[i];
    __syncthreads();
    const float* g = F.pa->in[I_GFFN] + l * D; bf16_t* HX = (bf16_t*)(F.ws + WS_HX);
    int* toke = (int*)(F.ws + MOE_TOKE); float* tokw = (float*)(F.ws + MOE_TOKW);
    for (int wg = F.bid; wg < NLAT / 128; wg += F.G) {
        u32x2 nx[4]; f32x4 Am[4], Sh[4];
        { const float* mod = (const float*)(F.ws + WS_MODLAT) + ((size_t)l * 8 + (wg * 128) / SEQ) * 6144 + 3072;
#pragma unroll
          for (int j = 0; j < 4; ++j) { Am[j] = ((const f32x4*)g)[F.lane + 64 * j] * (((const f32x4*)(mod + 1024))[F.lane + 64 * j] + 1.0f); Sh[j] = ((const f32x4*)mod)[F.lane + 64 * j]; } }
        { const u32x2* xr = (const u32x2*)(xb + (size_t)(wg * 128 + F.wave * 16) * D) + F.lane;
#pragma unroll
          for (int j = 0; j < 4; ++j) nx[j] = xr[64 * j]; }
        for (int i = 0; i < 16; ++i) { const int tl = F.wave * 16 + i, row = wg * 128 + tl;
            u32x2 cx[4];
#pragma unroll
            for (int j = 0; j < 4; ++j) cx[j] = nx[j];
            { const int rn = (i < 15) ? row + 1 : row; const u32x2* xr = (const u32x2*)(xb + (size_t)rn * D) + F.lane;
#pragma unroll
              for (int j = 0; j < 4; ++j) nx[j] = xr[64 * j]; }
            f32x4 y[4]; norm_row(cx, Am, Sh, HX + (size_t)row * D, F.lane, y);
            float lg[8];
#pragma unroll
            for (int e = 0; e < 8; ++e) lg[e] = 0.f;
#pragma unroll
            for (int j = 0; j < 4; ++j)
#pragma unroll
                for (int q = 0; q < 4; ++q) { const int k = 4 * F.lane + 256 * j + q; const f32x4 w0 = *(const LAS f32x4*)(wr + k * 8), w1 = *(const LAS f32x4*)(wr + k * 8 + 4); const float yv = y[j][q];
                    lg[0] += yv * w0.x; lg[1] += yv * w0.y; lg[2] += yv * w0.z; lg[3] += yv * w0.w; lg[4] += yv * w1.x; lg[5] += yv * w1.y; lg[6] += yv * w1.z; lg[7] += yv * w1.w; }
#pragma unroll
            for (int e = 0; e < 8; ++e) lg[e] = wave_sum(lg[e]) + F.pa->in[I_MROUTERB][e];
            int e0 = 0; float v0 = lg[0];
#pragma unroll
            for (int e = 1; e < 8; ++e) if (lg[e] > v0) { v0 = lg[e]; e0 = e; }
            int e1 = -1; float v1 = -3.0e38f;
#pragma unroll
            for (int e = 0; e < 8; ++e) if (e != e0 && lg[e] > v1) { v1 = lg[e]; e1 = e; }
            const float w0 = 1.0f / (1.0f + __expf(v1 - v0));
            if (F.lane == 0) { toke[row] = e0 | (e1 << 8); tokw[2 * row] = w0; tokw[2 * row + 1] = 1.0f - w0; le[tl] = e0 | (e1 << 8); }
        }
        __syncthreads();
        if (F.tid < 16) { const int k = F.tid >> 3, e = F.tid & 7; int c = 0; for (int t = 0; t < 128; ++t) c += (((le[t] >> (8 * k)) & 0xff) == e) ? 1 : 0; ((int*)(F.ws + MOE_CNT))[wg * 16 + F.tid] = c; }
        __syncthreads();
    }
}
__device__ __forceinline__ void phase_moe_sort(Frame& F) {
    LAS int* tot = (LAS int*)F.lds;
    LAS int* pre = tot + 16;
    LAS int* seg = tot + 32;
    LAS int* le = tot + 64;
    const int* cnt = (const int*)(F.ws + MOE_CNT); const int* toke = (const int*)(F.ws + MOE_TOKE); const float* tokw = (const float*)(F.ws + MOE_TOKW);
    int* ptok = (int*)(F.ws + MOE_PTOK); float* pw = (float*)(F.ws + MOE_PW); int* meta = (int*)(F.ws + MOE_META);
    for (int wg = F.bid; wg < NLAT / 128; wg += F.G) {
        { LAS int* part = tot + 256;
          if (F.tid < 256) { const int col = F.tid & 15, pt = F.tid >> 4; int t = 0, p = 0;
#pragma unroll
              for (int i = 0; i < 16; ++i) { const int w = pt * 16 + i; const int c = cnt[w * 16 + col]; t += c; p += (w < wg) ? c : 0; }
              part[pt * 16 + col] = t; part[256 + pt * 16 + col] = p; }
          if (F.tid >= 256 && F.tid < 384) le[F.tid - 256] = toke[wg * 128 + F.tid - 256];
          __syncthreads();
          if (F.tid < 16) { int t = 0, p = 0;
#pragma unroll
              for (int pt = 0; pt < 16; ++pt) { t += part[pt * 16 + F.tid]; p += part[256 + pt * 16 + F.tid]; }
              tot[F.tid] = t; pre[F.tid] = p; } }
        __syncthreads();
        if (F.tid < 2) { int s = 0; for (int e = 0; e < 8; ++e) { seg[F.tid * 9 + e] = s; s += (tot[F.tid * 8 + e] + 255) & ~255; } seg[F.tid * 9 + 8] = s; }
        __syncthreads();
        if (F.tid < 256) { const int k = F.tid >> 7, t = F.tid & 127; const int e = (le[t] >> (8 * k)) & 0xff; int rank = 0; for (int u = 0; u < t; ++u) rank += (((le[u] >> (8 * k)) & 0xff) == e) ? 1 : 0;
            const int pos = seg[k * 9 + e] + pre[k * 8 + e] + rank; const int tok = wg * 128 + t; ptok[k * MROWS + pos] = tok; pw[k * MROWS + pos] = tokw[2 * tok + k]; ((int*)(F.ws + MOE_PPOS))[k * NLAT + tok] = pos; }
        if (wg < 16) { const int k = wg >> 3, e = wg & 7; const int a = seg[k * 9 + e] + tot[k * 8 + e], b = seg[k * 9 + e + 1]; for (int p = a + F.tid; p < b; p += NTHREADS) { ptok[k * MROWS + p] = -1; pw[k * MROWS + p] = 0.f; } }
        if (wg == 0 && F.tid < 18) meta[F.tid] = seg[F.tid] >> 8;
        __syncthreads();
    }
}
__device__ __forceinline__ void phase_final_a(Frame& F) {
    const int gw = F.bid * NWAVES + F.wave, NGW = F.G * NWAVES; const float* g = F.pa->in[I_GFINAL];
    const bf16_t* xb = (const bf16_t*)((const char*)F.out + XB_OFF); bf16_t* xc = (bf16_t*)(F.ws + WS_XCOPY);
    const int* meta = (const int*)(F.ws + MOE_META) + 9; const int npan = meta[8], gsz = npan - 128;
    const int S = (gsz > 0) ? pg8::split_factor(npan * 4, F.G, DEXP / 64, MAXSLAB_M) : 1;
    const int* ppos = (const int*)(F.ws + MOE_PPOS) + NLAT; const float* pw = (const float*)(F.ws + MOE_PW) + MROWS;
    const float* slab = (const float*)(F.ws + WS_SLABM); const float* gate_lat = (const float*)(F.ws + WS_MODLAT) + (size_t)8 * 6144 + 5120;
    for (int row0 = gw; row0 < NLAT; row0 += 4 * NGW) {
        u32x2 w[4][4]; int rr[4];
#pragma unroll
        for (int u = 0; u < 4; ++u) { const int row = (row0 + u * NGW < NLAT) ? row0 + u * NGW : row0; const u32x2* xr = (const u32x2*)(xb + (size_t)row * D) + F.lane; rr[u] = ppos[row];
#pragma unroll
            for (int j = 0; j < 4; ++j) w[u][j] = xr[64 * j]; }
#pragma unroll
        for (int u = 0; u < 4; ++u) { const int row = row0 + u * NGW; if (row >= NLAT) continue;
            f32x4 v[4];
#pragma unroll
            for (int j = 0; j < 4; ++j) v[j] = (f32x4){bf2f(w[u][j].x & 0xffffu), __uint_as_float(w[u][j].x & 0xffff0000u), bf2f(w[u][j].y & 0xffffu), __uint_as_float(w[u][j].y & 0xffff0000u)};
            if (S >= 2 && rr[u] >= NLAT) { const float wt = pw[rr[u]]; const int pmr = (rr[u] - NLAT) >> 8, r = rr[u] & 255; const f32x4* gt = (const f32x4*)(gate_lat + (size_t)(row / SEQ) * 6144);
#pragma unroll
                for (int j = 0; j < 4; ++j) { f32x4 a = zero4(); const float* sp = slab + (size_t)((pmr + gsz * j) * S) * 65536 + (size_t)r * 256 + 4 * F.lane;
                    for (int q = 0; q < S; ++q) a += *(const f32x4*)(sp + (size_t)q * 65536);
                    v[j] += (gt[F.lane + 64 * j] * wt) * a; } }
            if (row < NLAT / 2) { float ss = 0.f;
#pragma unroll
                for (int j = 0; j < 4; ++j) ss += (v[j].x * v[j].x + v[j].y * v[j].y) + (v[j].z * v[j].z + v[j].w * v[j].w);
                const float rstd = 1.0f / sqrtf(wave_sum(ss) * (1.0f / D) + EPS); f32x4* o = (f32x4*)(F.out + (size_t)row * D) + F.lane;
#pragma unroll
                for (int j = 0; j < 4; ++j) o[64 * j] = (v[j] * rstd) * ((const f32x4*)g)[F.lane + 64 * j]; }
            else { u32x2* o = (u32x2*)(xc + (size_t)(row - NLAT / 2) * D) + F.lane;
#pragma unroll
                for (int j = 0; j < 4; ++j) o[64 * j] = (u32x2){pk2(v[j].x, v[j].y), pk2(v[j].z, v[j].w)}; } }
    }
}
__device__ __forceinline__ void phase_final_b(Frame& F) {
    const int gw = F.bid * NWAVES + F.wave, NGW = F.G * NWAVES; const float* g = F.pa->in[I_GFINAL]; const bf16_t* xc = (const bf16_t*)(F.ws + WS_XCOPY);
    for (int row0 = NLAT / 2 + gw; row0 < NLAT; row0 += 4 * NGW) {
        u32x2 w[4][4];
#pragma unroll
        for (int u = 0; u < 4; ++u) { const int row = (row0 + u * NGW < NLAT) ? row0 + u * NGW : row0; const u32x2* xr = (const u32x2*)(xc + (size_t)(row - NLAT / 2) * D) + F.lane;
#pragma unroll
            for (int j = 0; j < 4; ++j) w[u][j] = xr[64 * j]; }
#pragma unroll
        for (int u = 0; u < 4; ++u) { const int row = row0 + u * NGW; if (row >= NLAT) continue;
            f32x4 v[4]; float ss = 0.f;
#pragma unroll
            for (int j = 0; j < 4; ++j) { v[j] = (f32x4){bf2f(w[u][j].x & 0xffffu), __uint_as_float(w[u][j].x & 0xffff0000u), bf2f(w[u][j].y & 0xffffu), __uint_as_float(w[u][j].y & 0xffff0000u)};
                ss += (v[j].x * v[j].x + v[j].y * v[j].y) + (v[j].z * v[j].z + v[j].w * v[j].w); }
            const float rstd = 1.0f / sqrtf(wave_sum(ss) * (1.0f / D) + EPS); f32x4* o = (f32x4*)(F.out + (size_t)row * D) + F.lane;
#pragma unroll
            for (int j = 0; j < 4; ++j) o[64 * j] = (v[j] * rstd) * ((const f32x4*)g)[F.lane + 64 * j]; }
    }
}

__device__ __forceinline__ bool fresh(Frame& F) {
    int l_ = (int)__builtin_amdgcn_mbcnt_hi(~0u, __builtin_amdgcn_mbcnt_lo(~0u, 0u)); asm volatile("" : "+v"(l_));
    int w_ = F.wave0; asm volatile("" : "+s"(w_));
    F.lane = l_; F.wave = w_; F.tid = w_ * 64 + l_;
    int b_ = blockIdx.x; asm volatile("" : "+s"(b_)); F.bid = b_;
    GAS unsigned char* w2_ = (GAS unsigned char*)F.ws0; asm volatile("" : "+s"(w2_)); F.ws = (unsigned char*)w2_;
    F.out = F.out0; F.pa = F.pa0;
    return true;
}
struct Item { int b, s, row0, seqbase, t0, seqlen; bool is_ctx; };
__device__ __forceinline__ Item item_info(int item) {
    Item it; it.b = item / SPB; it.s = item % SPB;
    if (it.s < 2) { it.is_ctx = true; it.seqbase = NLAT + it.b * CTXL; it.t0 = it.s * CHK; it.seqlen = CTXL; }
    else { it.is_ctx = false; it.seqbase = it.b * SEQ; it.t0 = (it.s - 2) * CHK; it.seqlen = SEQ; }
    it.row0 = it.seqbase + it.t0; return it;
}
constexpr int UCP = 144;
constexpr int TP = 272;
constexpr int TILEB = 128 * TP;
constexpr int VP = 288;
constexpr int TILEV = 128 * VP;

__device__ __forceinline__ unsigned tr_lane_addr(ldsp_t tile, int lane) { return (unsigned)(__SIZE_TYPE__)tile + (unsigned)((4 * (lane >> 4) + ((lane & 15) >> 2)) * VP + 8 * (lane & 3)); }
__device__ __forceinline__ bf16x8 mk_frag(u32x2 lo, u32x2 hi) { const u32x4 v = {lo.x, lo.y, hi.x, hi.y}; return __builtin_bit_cast(bf16x8, v); }
template <int OFF> __device__ __forceinline__ bf16x8 tr1(unsigned addr) {
    u32x2 a0, a1;
    asm volatile("ds_read_b64_tr_b16 %0, %2 offset:%3\n\tds_read_b64_tr_b16 %1, %2 offset:%4\n\ts_waitcnt lgkmcnt(0)" : "=&v"(a0), "=&v"(a1) : "v"(addr), "i"(OFF), "i"(OFF + 16 * VP) : "memory");
    return mk_frag(a0, a1);
}
template <int OFF> __device__ __forceinline__ void tr4(unsigned addr, bf16x8& f0, bf16x8& f1, bf16x8& f2, bf16x8& f3) {
    u32x2 a0, a1, b0, b1, c0, c1, d0, d1;
    asm volatile("ds_read_b64_tr_b16 %0, %8 offset:%9\n\tds_read_b64_tr_b16 %1, %8 offset:%10\n\tds_read_b64_tr_b16 %2, %8 offset:%11\n\tds_read_b64_tr_b16 %3, %8 offset:%12\n\t"
                 "ds_read_b64_tr_b16 %4, %8 offset:%13\n\tds_read_b64_tr_b16 %5, %8 offset:%14\n\tds_read_b64_tr_b16 %6, %8 offset:%15\n\tds_read_b64_tr_b16 %7, %8 offset:%16\n\ts_waitcnt lgkmcnt(0)"
                 : "=&v"(a0), "=&v"(a1), "=&v"(b0), "=&v"(b1), "=&v"(c0), "=&v"(c1), "=&v"(d0), "=&v"(d1)
                 : "v"(addr), "i"(OFF), "i"(OFF + 16 * VP), "i"(OFF + 32), "i"(OFF + 32 + 16 * VP), "i"(OFF + 64), "i"(OFF + 64 + 16 * VP), "i"(OFF + 96), "i"(OFF + 96 + 16 * VP) : "memory");
    f0 = mk_frag(a0, a1); f1 = mk_frag(b0, b1); f2 = mk_frag(c0, c1); f3 = mk_frag(d0, d1);
}

__device__ __forceinline__ void build_decay(Frame& F, int l) {
    LAS float* dec = (LAS float*)(F.lds + LDS_DEC);
    for (int i = F.tid; i < 2 * 4 * 132; i += NTHREADS) { const int n = i % 132, dh = i / 132; const float x = F.pa->in[I_RETDEC][l * 8 + dh]; const float lg = -log1pf(expf(-x)); dec[i] = expf((float)n * lg); }
}

struct RgStep { bf16x8 bwa[2], bwx[2]; float lam, ba, bx, carry; };
template <bool FINAL>
__device__ __forceinline__ void rg_load_step(RgStep& R, Frame& F, const bf16_t* wgt, int l, int dir, int item, int blk, int n, int lane) {
    const int fr = lane & 15, fq = lane >> 4;
    const bf16_t* wa = wgt + ((size_t)(0 * 8 + blk) * 64 + 16 * n + fr) * 64 + 8 * fq;
    const bf16_t* wx = wgt + ((size_t)(1 * 8 + blk) * 64 + 16 * n + fr) * 64 + 8 * fq;
    R.bwa[0] = *(const bf16x8*)wa; R.bwa[1] = *(const bf16x8*)(wa + 32); R.bwx[0] = *(const bf16x8*)wx; R.bwx[1] = *(const bf16x8*)(wx + 32);
    const int ch = blk * 64 + 16 * n + fr, pi = (l * 2 + dir) * 512 + ch;
    R.lam = F.pa->in[I_RGLAM][pi]; R.ba = F.pa->in[I_RGBA][pi]; R.bx = F.pa->in[I_RGBX][pi];
    R.carry = FINAL ? ((const float*)(F.ws + WS_CARRY))[((size_t)item * 2 + dir) * 512 + ch] : 0.f;
}
template <bool FINAL, int DIR>
__device__ __forceinline__ void rg_dir(ldsp_t ucw, const bf16x8 (&af)[8][2], const RgStep& R, int n, int lane, f32x4 (&hsum)[8], float& Atot, float& Htot) {
    const int fr = lane & 15, fq = lane >> 4;
    constexpr float L2E_ = 1.4426950408889634f;
    const float ba2 = -L2E_ * R.ba, bx2 = -L2E_ * R.bx, cl2 = -8.0f * L2E_ * log1pf(expf(-R.lam)), carry = R.carry;
    const bf16x8 bwa[2] = {R.bwa[0], R.bwa[1]}, bwx[2] = {R.bwx[0], R.bwx[1]};
    f32x4 ar[8], ai[8];
#pragma unroll
    for (int m = 0; m < 8; ++m) { ar[m] = zero4(); ai[m] = zero4(); }
#pragma unroll
    for (int m = 0; m < 8; ++m)
#pragma unroll
        for (int ks = 0; ks < 2; ++ks) { ar[m] = __builtin_amdgcn_mfma_f32_16x16x32_bf16(af[m][ks], bwa[ks], ar[m], 0, 0, 0); ai[m] = __builtin_amdgcn_mfma_f32_16x16x32_bf16(af[m][ks], bwx[ks], ai[m], 0, 0, 0); }
    const unsigned uo = (unsigned)(32 * fq * UCP + (16 * n + fr) * 2);
#pragma unroll
    for (int m = 0; m < 8; ++m)
#pragma unroll
        for (int jj = 0; jj < 4; ++jj) {
            const float r = __builtin_amdgcn_rcpf(1.0f + __builtin_amdgcn_exp2f(__builtin_fmaf(ar[m][jj], -1.4426950408889634f, ba2)));
            const float ig = __builtin_amdgcn_rcpf(1.0f + __builtin_amdgcn_exp2f(__builtin_fmaf(ai[m][jj], -1.4426950408889634f, bx2)));
            const float a = __builtin_amdgcn_exp2f(cl2 * r);
            const float u = bf2f(*(const LAS bf16_t*)(ucw + uo + (4 * m + jj) * UCP));
            ar[m][jj] = a; ai[m][jj] = __builtin_amdgcn_sqrtf(__builtin_fmaf(-a, a, 1.0f)) * ig * u; }
    float gA = 1.f, gH = 0.f;
#pragma unroll
    for (int mm = 0; mm < 8; ++mm) { const int m = DIR ? 7 - mm : mm;
#pragma unroll
        for (int j4 = 0; j4 < 4; ++j4) { const int jj = DIR ? 3 - j4 : j4; gH = __builtin_fmaf(ar[m][jj], gH, ai[m][jj]); gA *= ar[m][jj]; } }
    const float A0 = lane_bcast(gA, fr), H0 = lane_bcast(gH, fr), A1 = lane_bcast(gA, fr + 16), H1 = lane_bcast(gH, fr + 16), A2 = lane_bcast(gA, fr + 32), H2 = lane_bcast(gH, fr + 32), A3 = lane_bcast(gA, fr + 48), H3 = lane_bcast(gH, fr + 48);
    if (FINAL) { float h = carry;
        if (!DIR) { if (fq > 0) h = A0 * h + H0; if (fq > 1) h = A1 * h + H1; if (fq > 2) h = A2 * h + H2; }
        else { if (fq < 3) h = A3 * h + H3; if (fq < 2) h = A2 * h + H2; if (fq < 1) h = A1 * h + H1; }
#pragma unroll
        for (int mm = 0; mm < 8; ++mm) { const int m = DIR ? 7 - mm : mm;
#pragma unroll
            for (int j4 = 0; j4 < 4; ++j4) { const int jj = DIR ? 3 - j4 : j4; h = __builtin_fmaf(ar[m][jj], h, ai[m][jj]); hsum[m][jj] += h; } } }
    if (!DIR) Htot = A3 * (A2 * (A1 * H0 + H1) + H2) + H3; else Htot = A0 * (A1 * (A2 * H3 + H2) + H1) + H0;
    Atot = (A0 * A1) * (A2 * A3);
}
template <bool FINAL>
__device__ __forceinline__ void rg_part(Frame& F, int l, int item, const Item& it, const int blk, const int n0, const int n1) {
    const bf16_t* P = (const bf16_t*)(F.ws + WS_PA);
    int lane = F.lane;
    ldsp_t ucw = F.lds + F.wave * (128 * UCP);
    { const int grp = lane & 7, ch0 = blk * 64 + grp * 8; float cw[4][8], cb[8];
#pragma unroll
      for (int k = 0; k < 4; ++k)
#pragma unroll
          for (int i = 0; i < 8; ++i) cw[k][i] = F.pa->in[I_CONVW][((size_t)l * 4 + k) * 512 + ch0 + i];
#pragma unroll
      for (int i = 0; i < 8; ++i) cb[i] = F.pa->in[I_CONVB][l * 512 + ch0 + i];
      const bf16_t* Pu = P + (size_t)it.seqbase * INW + ch0;
#pragma unroll 8
      for (int q = 0; q < 16; ++q) { const int token = (lane >> 3) + 8 * q; float o[8];
#pragma unroll
          for (int i = 0; i < 8; ++i) o[i] = cb[i];
#pragma unroll
          for (int k = 0; k < 4; ++k) { const int tt = it.t0 + token + k - 2; const int tc = tt < 0 ? 0 : (tt >= it.seqlen ? it.seqlen - 1 : tt);
              u32x4 v = ldg<u32x4>(Pu, (unsigned)tc * (unsigned)(INW * 2)); if (tt != tc) v = (u32x4){0u, 0u, 0u, 0u};
              o[0] += cw[k][0] * bf2f(v.x & 0xffffu); o[1] += cw[k][1] * __uint_as_float(v.x & 0xffff0000u); o[2] += cw[k][2] * bf2f(v.y & 0xffffu); o[3] += cw[k][3] * __uint_as_float(v.y & 0xffff0000u);
              o[4] += cw[k][4] * bf2f(v.z & 0xffffu); o[5] += cw[k][5] * __uint_as_float(v.z & 0xffff0000u); o[6] += cw[k][6] * bf2f(v.w & 0xffffu); o[7] += cw[k][7] * __uint_as_float(v.w & 0xffff0000u); }
          u32x4 w; w.x = pk2(o[0], o[1]); w.y = pk2(o[2], o[3]); w.z = pk2(o[4], o[5]); w.w = pk2(o[6], o[7]);
          *(LAS u32x4*)(ucw + token * UCP + grp * 16) = w; }
      LDS_WAIT(); asm volatile("" ::: "memory"); }
    asm volatile("" : "+v"(lane));
    bf16x8 af[8][2];
    { const int fr = lane & 15, fq = lane >> 4;
#pragma unroll
      for (int m = 0; m < 8; ++m)
#pragma unroll
          for (int ks = 0; ks < 2; ++ks) af[m][ks] = *(const LAS bf16x8*)(ucw + (32 * (fr >> 2) + 4 * m + (fr & 3)) * UCP + (8 * fq + 32 * ks) * 2); }
    const bf16_t* wg0 = (const bf16_t*)(F.ws + WS_RGW) + (size_t)(l * 2 + 0) * 2 * 8 * 4096;
    const bf16_t* wg1 = (const bf16_t*)(F.ws + WS_RGW) + (size_t)(l * 2 + 1) * 2 * 8 * 4096;
    float* TOT = (float*)(F.ws + WS_TOT);
    RgStep R0, R1;
    rg_load_step<FINAL>(R0, F, wg0, l, 0, item, blk, n0, lane);
#pragma unroll 1
    for (int n = n0; n < n1; ++n) { asm volatile("" : "+v"(lane));
        const int fr = lane & 15, fq = lane >> 4; const int ch = blk * 64 + 16 * n + fr;
        f32x4 hsum[8];
#pragma unroll
        for (int m = 0; m < 8; ++m) hsum[m] = zero4();
        rg_load_step<FINAL>(R1, F, wg1, l, 1, item, blk, n, lane);
        { float At, Ht;
          rg_dir<FINAL, 0>(ucw, af, R0, n, lane, hsum, At, Ht);
          if (!FINAL && fq == 0) { *(f32x2*)(TOT + (((size_t)item * 2 + 0) * 512 + ch) * 2) = (f32x2){At, Ht}; } }
        __builtin_amdgcn_sched_barrier(0);
        if (n + 1 < n1) rg_load_step<FINAL>(R0, F, wg0, l, 0, item, blk, n + 1, lane);
        { float At, Ht;
          rg_dir<FINAL, 1>(ucw, af, R1, n, lane, hsum, At, Ht);
          if (!FINAL && fq == 0) { *(f32x2*)(TOT + (((size_t)item * 2 + 1) * 512 + ch) * 2) = (f32x2){At, Ht}; } }
        if (FINAL) {
            const unsigned uo = (unsigned)(32 * fq * UCP + (16 * n + fr) * 2);
#pragma unroll
            for (int m = 0; m < 8; ++m)
#pragma unroll
                for (int jj = 0; jj < 4; ++jj) *(LAS bf16_t*)(ucw + uo + (4 * m + jj) * UCP) = (bf16_t)f2bf(hsum[m][jj]); }
    }
    if (FINAL) {
        LDS_WAIT(); asm volatile("" : "+v"(lane) :: "memory");
        const int ng = 2 * (n1 - n0);
        const int grp = 2 * n0 + ((ng == 8) ? (lane & 7) : (lane & 1)); const int tk0 = (ng == 8) ? (lane >> 3) : (lane >> 1), tstep = (ng == 8) ? 8 : 32, nq = (ng == 8) ? 16 : 4;
        const bf16_t* Pg = P + (size_t)it.row0 * INW + 512 + blk * 64 + grp * 8; bf16_t* Yo = (bf16_t*)(F.ws + WS_Y) + (size_t)it.row0 * D + blk * 64 + grp * 8;
#pragma unroll 8
        for (int q = 0; q < nq; ++q) { const int token = tk0 + tstep * q;
            const u32x4 hv = *(const LAS u32x4*)(ucw + token * UCP + grp * 16); const u32x4 gv = ldg<u32x4>(Pg, (unsigned)token * (unsigned)(INW * 2));
            u32x4 w;
            w.x = pk2(gelu_tanh(bf2f(gv.x & 0xffffu)) * bf2f(hv.x & 0xffffu), gelu_tanh(__uint_as_float(gv.x & 0xffff0000u)) * __uint_as_float(hv.x & 0xffff0000u));
            w.y = pk2(gelu_tanh(bf2f(gv.y & 0xffffu)) * bf2f(hv.y & 0xffffu), gelu_tanh(__uint_as_float(gv.y & 0xffff0000u)) * __uint_as_float(hv.y & 0xffff0000u));
            w.z = pk2(gelu_tanh(bf2f(gv.z & 0xffffu)) * bf2f(hv.z & 0xffffu), gelu_tanh(__uint_as_float(gv.z & 0xffff0000u)) * __uint_as_float(hv.z & 0xffff0000u));
            w.w = pk2(gelu_tanh(bf2f(gv.w & 0xffffu)) * bf2f(hv.w & 0xffffu), gelu_tanh(__uint_as_float(gv.w & 0xffff0000u)) * __uint_as_float(hv.w & 0xffff0000u));
            stg<u32x4>(Yo, (unsigned)token * (unsigned)(D * 2), w); }
        LDS_WAIT();
    }
}

__device__ __forceinline__ void stage_rows(Frame& F, ldsp_t dst, const Item& it, int col0, bool rope) {
    const bf16_t* P = (const bf16_t*)(F.ws + WS_PA); const float* ct = (const float*)(F.ws + WS_ROPE); const float* st = ct + 4096 * 64;
    for (int task = F.tid; task < 1024; task += NTHREADS) { const int token = task >> 3, d0 = (task & 7) * 8;
        const bf16_t* src = P + (size_t)(it.row0 + token) * INW + col0;
        const u32x4 lo = *(const u32x4*)(src + d0), hi = *(const u32x4*)(src + d0 + 64);
        u32x4 olo = lo, ohi = hi;
        if (rope) { const int pos = it.t0 + token; const f32x4 c0 = *(const f32x4*)(ct + pos * 64 + d0), c1 = *(const f32x4*)(ct + pos * 64 + d0 + 4), s0 = *(const f32x4*)(st + pos * 64 + d0), s1 = *(const f32x4*)(st + pos * 64 + d0 + 4);
            const float a[8] = {bf2f(lo.x & 0xffffu), __uint_as_float(lo.x & 0xffff0000u), bf2f(lo.y & 0xffffu), __uint_as_float(lo.y & 0xffff0000u), bf2f(lo.z & 0xffffu), __uint_as_float(lo.z & 0xffff0000u), bf2f(lo.w & 0xffffu), __uint_as_float(lo.w & 0xffff0000u)};
            const float b[8] = {bf2f(hi.x & 0xffffu), __uint_as_float(hi.x & 0xffff0000u), bf2f(hi.y & 0xffffu), __uint_as_float(hi.y & 0xffff0000u), bf2f(hi.z & 0xffffu), __uint_as_float(hi.z & 0xffff0000u), bf2f(hi.w & 0xffffu), __uint_as_float(hi.w & 0xffff0000u)};
            const float c[8] = {c0.x, c0.y, c0.z, c0.w, c1.x, c1.y, c1.z, c1.w}, s[8] = {s0.x, s0.y, s0.z, s0.w, s1.x, s1.y, s1.z, s1.w};
            float ra[8], rb[8];
#pragma unroll
            for (int i = 0; i < 8; ++i) { ra[i] = a[i] * c[i] - b[i] * s[i]; rb[i] = a[i] * s[i] + b[i] * c[i]; }
            olo.x = pk2(ra[0], ra[1]); olo.y = pk2(ra[2], ra[3]); olo.z = pk2(ra[4], ra[5]); olo.w = pk2(ra[6], ra[7]);
            ohi.x = pk2(rb[0], rb[1]); ohi.y = pk2(rb[2], rb[3]); ohi.z = pk2(rb[4], rb[5]); ohi.w = pk2(rb[6], rb[7]); }
        *(LAS u32x4*)(dst + token * TP + d0 * 2) = olo; *(LAS u32x4*)(dst + token * TP + (d0 + 64) * 2) = ohi; }
}
__device__ __forceinline__ void stage_cols(Frame& F, ldsp_t dst, const Item& it, int col0) {
    const bf16_t* P = (const bf16_t*)(F.ws + WS_PA);
    for (int task = F.tid; task < 2048; task += NTHREADS) { const int token = task >> 4, d0 = (task & 15) * 8;
        const u32x4 v = *(const u32x4*)(P + (size_t)(it.row0 + token) * INW + col0 + d0);
        const unsigned w[4] = {v.x, v.y, v.z, v.w};
#pragma unroll
        for (int i = 0; i < 4; ++i) { *(LAS bf16_t*)(dst + (d0 + 2 * i) * TP + token * 2) = (bf16_t)(w[i] & 0xffffu); *(LAS bf16_t*)(dst + (d0 + 2 * i + 1) * TP + token * 2) = (bf16_t)(w[i] >> 16); } }
}
__device__ __forceinline__ void rope8(u32x4& lo, u32x4& hi, const float* ct, const float* st, int pos, int d0) {
    const f32x4 c0 = *(const f32x4*)(ct + pos * 64 + d0), c1 = *(const f32x4*)(ct + pos * 64 + d0 + 4), s0 = *(const f32x4*)(st + pos * 64 + d0), s1 = *(const f32x4*)(st + pos * 64 + d0 + 4);
    const float a[8] = {bf2f(lo.x & 0xffffu), __uint_as_float(lo.x & 0xffff0000u), bf2f(lo.y & 0xffffu), __uint_as_float(lo.y & 0xffff0000u), bf2f(lo.z & 0xffffu), __uint_as_float(lo.z & 0xffff0000u), bf2f(lo.w & 0xffffu), __uint_as_float(lo.w & 0xffff0000u)};
    const float b[8] = {bf2f(hi.x & 0xffffu), __uint_as_float(hi.x & 0xffff0000u), bf2f(hi.y & 0xffffu), __uint_as_float(hi.y & 0xffff0000u), bf2f(hi.z & 0xffffu), __uint_as_float(hi.z & 0xffff0000u), bf2f(hi.w & 0xffffu), __uint_as_float(hi.w & 0xffff0000u)};
    const float c[8] = {c0.x, c0.y, c0.z, c0.w, c1.x, c1.y, c1.z, c1.w}, sn[8] = {s0.x, s0.y, s0.z, s0.w, s1.x, s1.y, s1.z, s1.w};
    float ra[8], rb[8];
#pragma unroll
    for (int i = 0; i < 8; ++i) { ra[i] = a[i] * c[i] - b[i] * sn[i]; rb[i] = a[i] * sn[i] + b[i] * c[i]; }
    lo = (u32x4){pk2(ra[0], ra[1]), pk2(ra[2], ra[3]), pk2(ra[4], ra[5]), pk2(ra[6], ra[7])};
    hi = (u32x4){pk2(rb[0], rb[1]), pk2(rb[2], rb[3]), pk2(rb[4], rb[5]), pk2(rb[6], rb[7])};
}
struct KvRegs { u32x4 klo[2], khi[2], v[4]; };
__device__ __forceinline__ void kv_issue(Frame& F, KvRegs& R, const Item& it, int h) {
    const bf16_t* P = (const bf16_t*)(F.ws + WS_PA);
    const bf16_t* Pk = P + (size_t)it.row0 * INW + 1536 + h * HD; const bf16_t* Pv = P + (size_t)it.row0 * INW + 2048 + h * HD;
#pragma unroll
    for (int t2 = 0; t2 < 2; ++t2) { const int task = F.tid + t2 * NTHREADS, token = task >> 3, d0 = (task & 7) * 8;
        R.klo[t2] = ldg<u32x4>(Pk, (unsigned)(token * INW + d0) * 2u); R.khi[t2] = ldg<u32x4>(Pk, (unsigned)(token * INW + d0 + 64) * 2u); }
#pragma unroll
    for (int t4 = 0; t4 < 4; ++t4) { const int task = F.tid + t4 * NTHREADS, token = task >> 4, d0 = (task & 15) * 8; R.v[t4] = ldg<u32x4>(Pv, (unsigned)(token * INW + d0) * 2u); }
}
template <int KS> __device__ __forceinline__ void kv_step(unsigned aK, unsigned aVf, unsigned aVb, f32x4 (&accf)[8], f32x4 (&accb)[8]) {
    const bf16x8 af = tr1<KS * 32 * VP>(aVf), ab = tr1<KS * 32 * VP>(aVb);
    bf16x8 b[8];
    tr4<KS * 32 * VP>(aK, b[0], b[1], b[2], b[3]); tr4<KS * 32 * VP + 128>(aK, b[4], b[5], b[6], b[7]);
#pragma unroll
    for (int n = 0; n < 8; ++n) { accf[n] = __builtin_amdgcn_mfma_f32_16x16x32_bf16(af, b[n], accf[n], 0, 0, 0); accb[n] = __builtin_amdgcn_mfma_f32_16x16x32_bf16(ab, b[n], accb[n], 0, 0, 0); }
}
__device__ __forceinline__ void stage_state_t(Frame& F, ldsp_t dst, const bf16_t* St) {
#pragma unroll
    for (int t4 = 0; t4 < 4; ++t4) { const int task = F.tid + t4 * NTHREADS, e = task >> 4, c8 = task & 15;
        *(LAS u32x4*)(dst + e * TP + c8 * 16) = ldg<u32x4>(St, (unsigned)(e * 128 + c8 * 8) * 2u); }
}
__device__ __forceinline__ void mm16x128(ldsp_t At, int ra0, ldsp_t Bt, int lane, f32x4 (&acc)[8]) {
    const int fr = lane & 15, fq = lane >> 4;
#pragma unroll
    for (int ks = 0; ks < 4; ++ks) { const bf16x8 a = *(const LAS bf16x8*)(At + (ra0 + fr) * TP + (32 * ks + 8 * fq) * 2);
#pragma unroll
        for (int n = 0; n < 8; ++n) { const bf16x8 b = *(const LAS bf16x8*)(Bt + (16 * n + fr) * TP + (32 * ks + 8 * fq) * 2); acc[n] = __builtin_amdgcn_mfma_f32_16x16x32_bf16(a, b, acc[n], 0, 0, 0); } }
}

__device__ __forceinline__ void kv_head(Frame& F, KvRegs& R, KvRegs& Rn, bool pre, int item, const Item& it, int h) {
    bf16_t* KV = (bf16_t*)(F.ws + WS_KV);
    const float* ct = (const float*)(F.ws + WS_ROPE); const float* st = ct + 4096 * 64;
    const LAS float* dec = (const LAS float*)(F.lds + LDS_DEC); const bool rope = !it.is_ctx;
    ldsp_t tK = F.lds, tVf = F.lds + TILEV, tVb = F.lds + 2 * TILEV;
#pragma unroll
    for (int t2 = 0; t2 < 2; ++t2) { const int task = F.tid + t2 * NTHREADS, token = task >> 3, d0 = (task & 7) * 8;
        if (rope) rope8(R.klo[t2], R.khi[t2], ct, st, it.t0 + token, d0);
        *(LAS u32x4*)(tK + token * VP + d0 * 2) = R.klo[t2]; *(LAS u32x4*)(tK + token * VP + (d0 + 64) * 2) = R.khi[t2]; }
#pragma unroll
    for (int t4 = 0; t4 < 4; ++t4) { const int task = F.tid + t4 * NTHREADS, token = task >> 4, d0 = (task & 15) * 8; const u32x4 v = R.v[t4];
        const float df = dec[(0 * 4 + h) * 132 + 127 - token], db = dec[(1 * 4 + h) * 132 + token];
        const float x[8] = {bf2f(v.x & 0xffffu), __uint_as_float(v.x & 0xffff0000u), bf2f(v.y & 0xffffu), __uint_as_float(v.y & 0xffff0000u), bf2f(v.z & 0xffffu), __uint_as_float(v.z & 0xffff0000u), bf2f(v.w & 0xffffu), __uint_as_float(v.w & 0xffff0000u)};
        u32x4 wf, wb; wf.x = pk2(x[0] * df, x[1] * df); wf.y = pk2(x[2] * df, x[3] * df); wf.z = pk2(x[4] * df, x[5] * df); wf.w = pk2(x[6] * df, x[7] * df);
        wb.x = pk2(x[0] * db, x[1] * db); wb.y = pk2(x[2] * db, x[3] * db); wb.z = pk2(x[4] * db, x[5] * db); wb.w = pk2(x[6] * db, x[7] * db);
        *(LAS u32x4*)(tVf + token * VP + d0 * 2) = wf; *(LAS u32x4*)(tVb + token * VP + d0 * 2) = wb; }
    WG_BAR_LDS();
    if (pre) kv_issue(F, Rn, it, h + 1);
    f32x4 af[8], ab[8];
#pragma unroll
    for (int n = 0; n < 8; ++n) { af[n] = zero4(); ab[n] = zero4(); }
    { const unsigned aK = tr_lane_addr(tK, F.lane), aVf = tr_lane_addr(tVf, F.lane) + 32u * (unsigned)F.wave, aVb = tr_lane_addr(tVb, F.lane) + 32u * (unsigned)F.wave;
      kv_step<0>(aK, aVf, aVb, af, ab); kv_step<1>(aK, aVf, aVb, af, ab); kv_step<2>(aK, aVf, aVb, af, ab); kv_step<3>(aK, aVf, aVb, af, ab); }
    const int fr = F.lane & 15, fq = F.lane >> 4;
    bf16_t* of = KV + (((size_t)item * 4 + h) * 2 + 0) * 16384 + (size_t)(16 * F.wave) * 128;
    unsigned so = (unsigned)((4 * fq) * 128 + fr) * 2u; asm volatile("" : "+v"(so));
#pragma unroll
    for (int n = 0; n < 8; ++n)
#pragma unroll
        for (int jj = 0; jj < 4; ++jj) { stg<bf16_t>(of, so + (unsigned)((jj * 128 + 16 * n) * 2), (bf16_t)f2bf(af[n][jj])); stg<bf16_t>(of, so + (unsigned)((16384 + jj * 128 + 16 * n) * 2), (bf16_t)f2bf(ab[n][jj])); }
    WG_BAR_LDS();
}
__device__ __forceinline__ int latent_item(int c) { return (c >> 5) * SPB + 2 + (c & 31); }
__device__ __forceinline__ int ctx_item(int ci) { return (ci >> 1) * SPB + (ci & 1); }
__device__ __forceinline__ void phase_m1(Frame& F, int l) {
    build_decay(F, l); __syncthreads();
    for (int c = F.bid; c < 256; c += F.G) {
        fresh(F);
        { const int item = latent_item(c); const Item it = item_info(item);
          rg_part<false>(F, l, item, it, F.wave, 0, 4);
          __syncthreads();
          KvRegs A, B;
          fresh(F); kv_issue(F, A, it, 0);
          kv_head(F, A, B, true, item, it, 0);
          fresh(F); kv_head(F, B, A, true, item, it, 1);
          fresh(F); kv_head(F, A, B, true, item, it, 2);
          fresh(F); kv_head(F, B, A, false, item, it, 3); }
        fresh(F);
        if (F.wave < 2) { const int u = c + 256 * F.wave; const int item = ctx_item(u >> 5); const Item it = item_info(item); rg_part<false>(F, l, item, it, (u >> 2) & 7, u & 3, (u & 3) + 1); }
        __syncthreads();
        if (c < 64) { const int item = ctx_item(c >> 2); const Item it = item_info(item); KvRegs A, B; fresh(F); kv_issue(F, A, it, c & 3); kv_head(F, A, B, false, item, it, c & 3); }
    }
}
__device__ __forceinline__ int seq_order(int dir, int step) { return dir ? (step == 0 ? 1 : (step == 1 ? 0 : 35 - step)) : step; }
__device__ __forceinline__ void phase_m2(Frame& F, int l) {
    bf16_t* KV = (bf16_t*)(F.ws + WS_KV);
    const int gt = F.bid * NTHREADS + F.tid, NGT = F.G * NTHREADS;
    for (int c = gt; c < NB * NH * 2 * 128 * 16; c += NGT) {
        const int dc = c & 15, e = (c >> 4) & 127, dir = (c >> 11) & 1, h = (c >> 12) & 3, b = c >> 14;
        const float x = F.pa->in[I_RETDEC][l * 8 + dir * 4 + h]; const float decay = expf(128.0f * (-log1pf(expf(-x))));
        float S[8];
#pragma unroll
        for (int i = 0; i < 8; ++i) S[i] = 0.f;
        const unsigned lo = (unsigned)((((h * 2 + dir) * 128 + e) * 128 + dc * 8) * 2);
        for (int g0 = 0; g0 < SPB; g0 += 17) {
            u32x4 v[17];
#pragma unroll
            for (int i = 0; i < 17; ++i) { const int item = b * SPB + seq_order(dir, g0 + i); v[i] = ldg<u32x4>(KV + (size_t)item * 4 * 2 * 16384, lo); }
#pragma unroll
            for (int i = 0; i < 17; ++i) { const int item = b * SPB + seq_order(dir, g0 + i);
                u32x4 w; w.x = pk2(S[0], S[1]); w.y = pk2(S[2], S[3]); w.z = pk2(S[4], S[5]); w.w = pk2(S[6], S[7]);
                stg<u32x4>(KV + (size_t)item * 4 * 2 * 16384, lo, w);
                S[0] = S[0] * decay + bf2f(v[i].x & 0xffffu); S[1] = S[1] * decay + __uint_as_float(v[i].x & 0xffff0000u); S[2] = S[2] * decay + bf2f(v[i].y & 0xffffu); S[3] = S[3] * decay + __uint_as_float(v[i].y & 0xffff0000u);
                S[4] = S[4] * decay + bf2f(v[i].z & 0xffffu); S[5] = S[5] * decay + __uint_as_float(v[i].z & 0xffff0000u); S[6] = S[6] * decay + bf2f(v[i].w & 0xffffu); S[7] = S[7] * decay + __uint_as_float(v[i].w & 0xffff0000u); }
        }
    }
    const float* TOT = (const float*)(F.ws + WS_TOT); float* CARRY = (float*)(F.ws + WS_CARRY);
    for (int c = gt; c < NB * 2 * 512; c += NGT) { const int ch = c & 511, dir = (c >> 9) & 1, b = c >> 10; float cr = 0.f;
        for (int step = 0; step < SPB; ++step) { const int item = b * SPB + seq_order(dir, step); const f32x2 ah = *(const f32x2*)(TOT + (((size_t)item * 2 + dir) * 512 + ch) * 2);
            CARRY[((size_t)item * 2 + dir) * 512 + ch] = cr; cr = ah.x * cr + ah.y; } }
}
struct RetRegs { u32x4 v[4], sf[4], sb[4], klo[2], khi[2], g[4]; };
__device__ __forceinline__ void ret_issue(Frame& F, RetRegs& R, int item, const Item& it, int h) {
    const bf16_t* KV = (const bf16_t*)(F.ws + WS_KV); const bf16_t* P = (const bf16_t*)(F.ws + WS_PA);
    const bf16_t* Pk = P + (size_t)it.row0 * INW + 1536 + h * HD; const bf16_t* Pv = P + (size_t)it.row0 * INW + 2048 + h * HD;
    const bf16_t* Sf = KV + (((size_t)item * 4 + h) * 2 + 0) * 16384; const bf16_t* Sb = Sf + 16384;
    const int lane = F.lane, i0 = 16 * F.wave;
#pragma unroll
    for (int t2 = 0; t2 < 2; ++t2) { const int task = F.tid + t2 * NTHREADS, token = task >> 3, d0 = (task & 7) * 8;
        R.klo[t2] = ldg<u32x4>(Pk, (unsigned)(token * INW + d0) * 2u); R.khi[t2] = ldg<u32x4>(Pk, (unsigned)(token * INW + d0 + 64) * 2u); }
#pragma unroll
    for (int t4 = 0; t4 < 4; ++t4) { const int task = F.tid + t4 * NTHREADS, r = task >> 4, c8 = task & 15;
        R.v[t4] = ldg<u32x4>(Pv, (unsigned)(r * INW + c8 * 8) * 2u); R.sf[t4] = ldg<u32x4>(Sf, (unsigned)(r * 128 + c8 * 8) * 2u); R.sb[t4] = ldg<u32x4>(Sb, (unsigned)(r * 128 + c8 * 8) * 2u); }
    { const bf16_t* Pg = P + (size_t)(it.row0 + i0) * INW + 2560 + h * HD;
#pragma unroll
      for (int k = 0; k < 4; ++k) R.g[k] = ldg<u32x4>(Pg, (unsigned)((lane >> 2) * INW + 32 * (lane & 3) + 8 * k) * 2u); }
}
__device__ __forceinline__ void ret_head(Frame& F, RetRegs& R, RetRegs& Rn, bool pre, int item, const Item& it, int h) {
    bf16_t* Y = (bf16_t*)(F.ws + WS_Y);
    const float* ct = (const float*)(F.ws + WS_ROPE); const float* st = ct + 4096 * 64;
    const LAS float* dec = (const LAS float*)(F.lds + LDS_DEC);
    ldsp_t tK = F.lds, tV = F.lds + TILEB, tSf = tV + TILEV, tSb = tSf + TILEB;
    const bool rope = !it.is_ctx;
    const int lane = F.lane, fr = lane & 15, fq = lane >> 4, i0 = 16 * F.wave;
    u32x4 q4[4];
    { const bf16_t* Pq = (const bf16_t*)(F.ws + WS_PA) + (size_t)(it.row0 + i0) * INW + 1024 + h * HD;
#pragma unroll
      for (int ks = 0; ks < 4; ++ks) q4[ks] = ldg<u32x4>(Pq, (unsigned)(fr * INW + 32 * ks + 8 * fq) * 2u); }
#pragma unroll
    for (int t2 = 0; t2 < 2; ++t2) { const int task = F.tid + t2 * NTHREADS, token = task >> 3, d0 = (task & 7) * 8;
        if (rope) rope8(R.klo[t2], R.khi[t2], ct, st, it.t0 + token, d0);
        *(LAS u32x4*)(tK + token * TP + d0 * 2) = R.klo[t2]; *(LAS u32x4*)(tK + token * TP + (d0 + 64) * 2) = R.khi[t2]; }
#pragma unroll
    for (int t4 = 0; t4 < 4; ++t4) { const int task = F.tid + t4 * NTHREADS, r = task >> 4, c8 = task & 15;
        *(LAS u32x4*)(tV + r * VP + c8 * 16) = R.v[t4]; *(LAS u32x4*)(tSf + r * TP + c8 * 16) = R.sf[t4]; *(LAS u32x4*)(tSb + r * TP + c8 * 16) = R.sb[t4]; }
    bf16x8 qf[4];
    { if (rope) { rope8(q4[0], q4[2], ct, st, it.t0 + i0 + fr, 8 * fq); rope8(q4[1], q4[3], ct, st, it.t0 + i0 + fr, 32 + 8 * fq); }
#pragma unroll
      for (int ks = 0; ks < 4; ++ks) qf[ks] = __builtin_bit_cast(bf16x8, q4[ks]); }
    u32x4 gk[4];
#pragma unroll
    for (int k = 0; k < 4; ++k) gk[k] = R.g[k];
    WG_BAR_LDS();
    if (pre) ret_issue(F, Rn, item, it, h + 1);
    bf16x8 pa[4];
    { f32x4 C[8];
#pragma unroll
      for (int jt = 0; jt < 8; ++jt) { C[jt] = zero4();
#pragma unroll
          for (int ks = 0; ks < 4; ++ks) { const bf16x8 a = *(const LAS bf16x8*)(tK + (16 * jt + fr) * TP + (32 * ks + 8 * fq) * 2); C[jt] = __builtin_amdgcn_mfma_f32_16x16x32_bf16(a, qf[ks], C[jt], 0, 0, 0); } }
      const int i = i0 + fr;
#pragma unroll
      for (int jt = 0; jt < 8; ++jt)
#pragma unroll
          for (int jj = 0; jj < 4; ++jj) { const int j = 16 * jt + 4 * fq + jj; const float dcy = (i >= j) ? dec[(0 * 4 + h) * 132 + (i - j)] : dec[(1 * 4 + h) * 132 + (j - i)]; C[jt][jj] *= dcy; }
#pragma unroll
      for (int u = 0; u < 4; ++u) { const u32x4 w = {pg8::cvt_pk_bf16(C[2 * u][0], C[2 * u][1]), pg8::cvt_pk_bf16(C[2 * u][2], C[2 * u][3]), pg8::cvt_pk_bf16(C[2 * u + 1][0], C[2 * u + 1][1]), pg8::cvt_pk_bf16(C[2 * u + 1][2], C[2 * u + 1][3])};
          pa[u] = __builtin_bit_cast(bf16x8, w); } }
    WG_BAR_LDS();
    { ldsp_t gt = tK + (i0 + (lane >> 2)) * TP + (lane & 3) * 64;
#pragma unroll
      for (int k = 0; k < 4; ++k) *(LAS u32x4*)(gt + 16 * k) = gk[k]; }
    f32x4 o[8];
#pragma unroll
    for (int n = 0; n < 8; ++n) o[n] = zero4();
    { const unsigned aV = tr_lane_addr(tV, lane); bf16x8 b[8];
#define RET_PV(U) do { tr4<(U) * 32 * VP>(aV, b[0], b[1], b[2], b[3]); tr4<(U) * 32 * VP + 128>(aV, b[4], b[5], b[6], b[7]); \
        _Pragma("unroll") for (int n = 0; n < 8; ++n) o[n] = __builtin_amdgcn_mfma_f32_16x16x32_bf16(pa[U], b[n], o[n], 0, 0, 0); } while (0)
      RET_PV(0); RET_PV(1); RET_PV(2); RET_PV(3);
#undef RET_PV
    }
    { f32x4 cf[8];
#pragma unroll
      for (int n = 0; n < 8; ++n) { cf[n] = zero4();
#pragma unroll
          for (int ks = 0; ks < 4; ++ks) { const bf16x8 b = *(const LAS bf16x8*)(tSf + (16 * n + fr) * TP + (32 * ks + 8 * fq) * 2); cf[n] = __builtin_amdgcn_mfma_f32_16x16x32_bf16(qf[ks], b, cf[n], 0, 0, 0); } }
#pragma unroll
      for (int jj = 0; jj < 4; ++jj) { const float sf = dec[(0 * 4 + h) * 132 + (i0 + 4 * fq + jj + 1)];
#pragma unroll
          for (int n = 0; n < 8; ++n) o[n][jj] += sf * cf[n][jj]; } }
    { f32x4 cb[8];
#pragma unroll
      for (int n = 0; n < 8; ++n) { cb[n] = zero4();
#pragma unroll
          for (int ks = 0; ks < 4; ++ks) { const bf16x8 b = *(const LAS bf16x8*)(tSb + (16 * n + fr) * TP + (32 * ks + 8 * fq) * 2); cb[n] = __builtin_amdgcn_mfma_f32_16x16x32_bf16(qf[ks], b, cb[n], 0, 0, 0); } }
#pragma unroll
      for (int jj = 0; jj < 4; ++jj) { const float sb = dec[(1 * 4 + h) * 132 + (128 - (i0 + 4 * fq + jj))];
#pragma unroll
          for (int n = 0; n < 8; ++n) o[n][jj] += sb * cb[n][jj]; } }
    { ldsp_t gc = tK + (i0 + 4 * fq) * TP + fr * 2;
#pragma unroll
      for (int jj = 0; jj < 4; ++jj) { float s1 = 0.f;
#pragma unroll
          for (int n = 0; n < 8; ++n) s1 += o[n][jj];
          s1 += swz_xor<1>(s1); s1 += swz_xor<2>(s1); s1 += swz_xor<4>(s1); s1 += swz_xor<8>(s1);
          const float mu = s1 * (1.0f / 128.0f); float q = 0.f;
#pragma unroll
          for (int n = 0; n < 8; ++n) { const float dd = o[n][jj] - mu; q += dd * dd; }
          q += swz_xor<1>(q); q += swz_xor<2>(q); q += swz_xor<4>(q); q += swz_xor<8>(q);
          const float rstd = 1.0f / sqrtf(q * (1.0f / 128.0f) + EPS);
#pragma unroll
          for (int n = 0; n < 8; ++n) { LAS bf16_t* p = (LAS bf16_t*)(gc + jj * TP + 32 * n); const float gv = bf2f(*p); *p = (bf16_t)f2bf(siluf_(gv) * (o[n][jj] - mu) * rstd); } } }
    LDS_WAIT(); asm volatile("" ::: "memory");
    { ldsp_t gt = tK + (i0 + (lane >> 2)) * TP + (lane & 3) * 64; bf16_t* Yo = Y + (size_t)(it.row0 + i0) * D + 512 + h * HD;
#pragma unroll
      for (int k = 0; k < 4; ++k) stg<u32x4>(Yo, (unsigned)((lane >> 2) * D + 32 * (lane & 3) + 8 * k) * 2u, *(const LAS u32x4*)(gt + 16 * k)); }
    WG_BAR_LDS();
}
__device__ __forceinline__ void phase_m3(Frame& F, int l) {
    build_decay(F, l); __syncthreads();
    for (int c = F.bid; c < 256; c += F.G) {
        fresh(F);
        { const int item = latent_item(c); const Item it = item_info(item);
#ifndef PROBE_M3
#define PROBE_M3 0
#endif
          for (int r_ = 0; r_ < ((PROBE_M3 & 1) ? 2 : 1); ++r_) { fresh(F); rg_part<true>(F, l, item, it, F.wave, 0, 4); }
          __syncthreads();
          for (int r_ = 0; r_ < ((PROBE_M3 & 2) ? 2 : 1); ++r_) {
          RetRegs R, Rn;
          fresh(F); ret_issue(F, R, item, it, 0);
          ret_head(F, R, Rn, true, item, it, 0);
          fresh(F); ret_head(F, Rn, R, true, item, it, 1);
          fresh(F); ret_head(F, R, Rn, true, item, it, 2);
          fresh(F); ret_head(F, Rn, R, false, item, it, 3); } }
        if (l == 0) {
            fresh(F);
            if (F.wave < 2) { const int u = c + 256 * F.wave; const int item = ctx_item(u >> 5); const Item it = item_info(item); rg_part<true>(F, l, item, it, (u >> 2) & 7, u & 3, (u & 3) + 1); }
            __syncthreads();
            if (c < 64) { const int item = ctx_item(c >> 2); const Item it = item_info(item); RetRegs R, Rn; fresh(F); ret_issue(F, R, item, it, c & 3); ret_head(F, R, Rn, false, item, it, c & 3); }
        }
    }
}

constexpr int N_PHASES = 24;
__global__ void __launch_bounds__(NTHREADS, 2) fwd_kernel(Args args) {
    extern __shared__ __attribute__((aligned(16))) unsigned char lds_raw[];
    Frame F; F.lds = (ldsp_t)lds_raw; F.wave0 = __builtin_amdgcn_readfirstlane((int)threadIdx.x >> 6); F.G = gridDim.x; F.pa0 = &args; F.out0 = args.out; F.ws0 = args.ws; fresh(F);
    volatile LAS unsigned* MISC = (volatile LAS unsigned*)(F.lds + LDS_MISC);
    if (F.tid < 64) MISC[F.tid] = 0u;
    __syncthreads();
    const int lo = args.ph_lo, hi = args.ph_hi;
    XcdBarrier bar; bar.bar = (unsigned*)(F.ws + WS_CTL); bar.x = 0; bar.st = nullptr;
    if (hi - lo > 1) bar = xcd_barrier_post((unsigned*)(F.ws + WS_CTL), MISC);
#ifndef DIAG_MASK
#define DIAG_MASK 0xffffffffu
#endif
#ifndef REPEAT_MASK
#define REPEAT_MASK 0u
#endif
#define REPS(kind) ((((REPEAT_MASK) >> (kind)) & 1u) ? 2 : 1)
#define INK(k, kind) (((DIAG_MASK >> (kind)) & 1u) && lo <= (k) && (k) < hi && fresh(F))
#define IN(k) (lo <= (k) && (k) < hi)
#define SEAM(k) do { if (IN(k) && IN((k) + 1)) xcd_barrier(bar); } while (0)
    float* ctxx = (float*)(F.ws + WS_CTXX); bf16_t* xb = (bf16_t*)((char*)F.out + XB_OFF);
    const float* modlat = (const float*)(F.ws + WS_MODLAT); const float* modctx = (const float*)(F.ws + WS_MODCTX);

    if (INK(0, 0)) { for (int r_ = 0; r_ < REPS(0); ++r_) { phase_convert_small(F); __syncthreads(); phase_mod(F); __syncthreads(); } } SEAM(0);
    if (INK(1, 1)) { for (int r_ = 0; r_ < REPS(1); ++r_) phase_norm(F, 0, 0, F.pa->in[I_X], nullptr, F.pa->in[I_CTX], MROWS, SlabRed{nullptr, 0, nullptr, nullptr, nullptr}); } SEAM(1);
#pragma unroll 1
    for (int l = 0; l < 2; ++l) {
        const int pb = (l == 0) ? 2 : 11;
        if (INK(pb + 0, 2)) { pg8::Gemm g{(const bf16_t*)(F.ws + WS_HX), (const bf16_t*)(F.ws + WS_WIN) + (size_t)l * INW * D, INW, D, 0, nullptr}; pg8::Order S; S.init(MROWS / 256, INW / 256, F.G, F.bid, nullptr, nullptr, D / 64, false, 0);
            pg8::EpiBf16 E{(bf16_t*)(F.ws + WS_PA), INW}; for (int r_ = 0; r_ < REPS(2); ++r_) pg8::gemm_phase<pg8::EpiBf16>(F.lds, g, S, E, F.tid); }
        SEAM(pb + 0);
        if (INK(pb + 1, 3)) { for (int r_ = 0; r_ < REPS(3); ++r_) phase_m1(F, l); }
        SEAM(pb + 1);
        if (INK(pb + 2, 4)) { for (int r_ = 0; r_ < REPS(4); ++r_) { if (r_) phase_m1(F, l); phase_m2(F, l); } }
        SEAM(pb + 2);
        if (INK(pb + 3, 5)) { for (int r_ = 0; r_ < REPS(5); ++r_) phase_m3(F, l); }
        SEAM(pb + 3);
        if (INK(pb + 4, 6)) { pg8::Gemm g{(const bf16_t*)(F.ws + WS_Y), (const bf16_t*)(F.ws + WS_WOUT) + (size_t)l * D * D, D, D, 0, (float*)(F.ws + WS_SLABA)}; pg8::Order S; S.init((l == 0 ? MROWS : NLAT) / 256, D / 256, F.G, F.bid, nullptr, nullptr, D / 64, true, MAXSLAB_A);
            pg8::EpiResid E{l == 0 ? F.pa->in[I_X] : nullptr, xb, F.pa->in[I_CTX], ctxx, modlat + (size_t)l * 8 * 6144 + 2048, modctx + (size_t)l * 6144 + 2048};
            pg8::gemm_phase<pg8::EpiResid>(F.lds, g, S, E, F.tid); }
        SEAM(pb + 4);
        if (l == 0) {
            if (INK(7, 1)) { for (int r_ = 0; r_ < REPS(1); ++r_) phase_norm(F, 0, 1, nullptr, xb, ctxx, MROWS, SlabRed{(const float*)(F.ws + WS_SLABA), pg8::split_factor((MROWS / 256) * 4, F.G, D / 64, MAXSLAB_A), modctx + 2048, F.pa->in[I_CTX], ctxx}); } SEAM(7);
            if (INK(8, 7)) { pg8::Gemm g{(const bf16_t*)(F.ws + WS_HX), (const bf16_t*)(F.ws + WS_WUP), 2 * DFF, D, 0, nullptr}; pg8::Order S; S.init(MROWS / 256, 2 * DFF / 256, F.G, F.bid, nullptr, nullptr, D / 64, false, 0);
                pg8::EpiSwiGLU E{(bf16_t*)(F.ws + WS_PA), DFF}; for (int r_ = 0; r_ < REPS(7); ++r_) pg8::gemm_phase<pg8::EpiSwiGLU>(F.lds, g, S, E, F.tid); }
            SEAM(8);
            if (INK(9, 8)) { pg8::Gemm g{(const bf16_t*)(F.ws + WS_PA), (const bf16_t*)(F.ws + WS_WDN), D, DFF, 0, (float*)(F.ws + WS_SLABA)}; pg8::Order S; S.init(MROWS / 256, D / 256, F.G, F.bid, nullptr, nullptr, DFF / 64, true, MAXSLAB_A);
                pg8::EpiResid E{nullptr, xb, (const float*)ctxx, ctxx, modlat + 5120, modctx + 5120}; pg8::gemm_phase<pg8::EpiResid>(F.lds, g, S, E, F.tid); }
            SEAM(9);
            if (INK(10, 1)) { for (int r_ = 0; r_ < REPS(1); ++r_) phase_norm(F, 1, 0, nullptr, xb, ctxx, MROWS, SlabRed{(const float*)(F.ws + WS_SLABA), pg8::split_factor((MROWS / 256) * 4, F.G, DFF / 64, MAXSLAB_A), modctx + 5120, ctxx, ctxx}); } SEAM(10);
        }
    }
    if (INK(16, 9)) { for (int r_ = 0; r_ < REPS(9); ++r_) { phase_norm_router(F, xb); __syncthreads(); phase_convert_moe(F); __syncthreads(); } } SEAM(16);
    if (INK(17, 10)) { phase_moe_sort(F); } SEAM(17);
#pragma unroll 1
    for (int k = 0; k < 2; ++k) {
        const int* meta = (const int*)(F.ws + MOE_META) + 9 * k;
        if (INK(18 + 2 * k, 11)) { if (k == 1) { moe_reduce(F, 0); __syncthreads(); } pg8::Gemm g{(const bf16_t*)(F.ws + WS_HX), (const bf16_t*)(F.ws + WS_MOEUP), 2 * DEXP, D, (size_t)2 * DEXP * D * 2, nullptr}; pg8::Order S; S.init(meta[8], 2 * DEXP / 256, F.G, F.bid, meta, (const int*)(F.ws + MOE_PTOK) + k * MROWS, D / 64, false, 0);
            pg8::EpiSwiGLU E{(bf16_t*)(F.ws + WS_PA), DEXP}; for (int r_ = 0; r_ < REPS(11); ++r_) pg8::gemm_phase<pg8::EpiSwiGLU>(F.lds, g, S, E, F.tid); }
        SEAM(18 + 2 * k);
        if (INK(19 + 2 * k, 12)) { pg8::Gemm g{(const bf16_t*)(F.ws + WS_PA), (const bf16_t*)(F.ws + WS_MOEDN), D, DEXP, (size_t)D * DEXP * 2, (float*)(F.ws + WS_SLABM)}; pg8::Order S; S.init(meta[8], D / 256, F.G, F.bid, meta, nullptr, DEXP / 64, true, MAXSLAB_M);
            pg8::EpiMoeDown E{xb, (const int*)(F.ws + MOE_PTOK) + k * MROWS, (const float*)(F.ws + MOE_PW) + k * MROWS, modlat + (size_t)8 * 6144 + 5120}; pg8::gemm_phase<pg8::EpiMoeDown>(F.lds, g, S, E, F.tid); }
        SEAM(19 + 2 * k);
    }
    if (INK(22, 13)) phase_final_a(F);
    SEAM(22);
    if (INK(23, 13)) phase_final_b(F);
#undef IN
#undef INK
#undef SEAM
}

extern "C" void kernel_launch(void* const* d_in, const int* in_sizes, int n_in, void* d_out, int out_size, void* d_ws, size_t ws_size, hipStream_t stream) {
    static int grid = 0;
    if (grid == 0) {
        if (n_in != 27 || in_sizes[0] != NLAT * D || out_size != NLAT * D || ws_size < WS_END) { fprintf(stderr, "kernel_launch: unexpected problem (n_in %d, in0 %d, out %d, ws %zu, need %zu); nothing launched\n", n_in, n_in > 0 ? in_sizes[0] : -1, out_size, ws_size, (size_t)WS_END); grid = -1; return; }
        int dev = 0, cus = 0, per_cu = 0;
        if (hipGetDevice(&dev) != hipSuccess || hipDeviceGetAttribute(&cus, hipDeviceAttributeMultiprocessorCount, dev) != hipSuccess) { grid = -1; return; }
        if (hipFuncSetAttribute((const void*)fwd_kernel, hipFuncAttributeMaxDynamicSharedMemorySize, LDS_BYTES) != hipSuccess) { fprintf(stderr, "kernel_launch: hipFuncSetAttribute failed\n"); grid = -1; return; }
        if (hipOccupancyMaxActiveBlocksPerMultiprocessor(&per_cu, (const void*)fwd_kernel, NTHREADS, LDS_BYTES) != hipSuccess || per_cu < 1) { fprintf(stderr, "kernel_launch: occupancy query says %d\n", per_cu); }
        (void)hipGetLastError();
        grid = cus;
    }
    if (grid < 0) return;
    (void)hipMemsetAsync((char*)d_ws + WS_CTL, 0, CTL_ZERO_BYTES, stream);
    Args a; memset(&a, 0, sizeof(a));
    for (int i = 0; i < 27; ++i) a.in[i] = (const float*)d_in[i];
    a.out = (float*)d_out; a.ws = (unsigned char*)d_ws;
#if MK_ONE_LAUNCH
    a.ph_lo = 0; a.ph_hi = N_PHASES;
    hipLaunchKernelGGL(fwd_kernel, dim3(grid), dim3(NTHREADS), LDS_BYTES, stream, a);
#else
    for (int p = 0; p < N_PHASES; ++p) { a.ph_lo = p; a.ph_hi = p + 1; hipLaunchKernelGGL(fwd_kernel, dim3(grid), dim3(NTHREADS), LDS_BYTES, stream, a); }
#endif
}
```

```cpp
#include <hip/hip_runtime.h>
#include <cstdio>
#include <cstdint>
#include <cstring>

#ifndef MK_ONE_LAUNCH
#define MK_ONE_LAUNCH 1
#endif

#define GAS __attribute__((address_space(1)))
#define LAS __attribute__((address_space(3)))
typedef unsigned short bf16_t;
typedef short bf16x8 __attribute__((ext_vector_type(8)));
typedef float f32x4 __attribute__((ext_vector_type(4)));
typedef float f32x2 __attribute__((ext_vector_type(2)));
typedef unsigned u32x4 __attribute__((ext_vector_type(4)));
typedef unsigned u32x2 __attribute__((ext_vector_type(2)));
typedef LAS unsigned char* ldsp_t;

constexpr int D = 1024, NB = 8, SEQ = 4096, NLAT = NB * SEQ, CTXL = 256, NCTX = NB * CTXL, MROWS = NLAT + NCTX;
constexpr int INW = 3072, NH = 4, HD = 128, CHK = 128;
constexpr int DFF = 2816, NE = 8, DEXP = 3584;
constexpr int SPB = 34;
constexpr int NITEM = NB * SPB;
constexpr float EPS = 1e-6f;
constexpr int NWAVES = 8, NTHREADS = 512;

constexpr size_t MiB = 1u << 20;
constexpr size_t WS_CTL = 0, CTL_ZERO_BYTES = 64 * 1024;
constexpr size_t WS_MODLAT = 1 * MiB;
constexpr size_t WS_MODCTX = 1 * MiB + 2 * 8 * 6144 * 4;
constexpr size_t WS_ROPE = 2 * MiB;
constexpr size_t WS_RGW = 4 * MiB;
constexpr size_t WS_TOT = 5 * MiB;
constexpr size_t WS_CARRY = 8 * MiB;
constexpr size_t WS_MOE = 10 * MiB;
constexpr size_t MOE_CNT = WS_MOE, MOE_META = WS_MOE + 16384, MOE_TOKE = WS_MOE + 65536, MOE_TOKW = WS_MOE + 262144,
                 MOE_PTOK = WS_MOE + 524288, MOE_PW = WS_MOE + 1048576, MOE_PPOS = WS_MOE + 1572864;
constexpr size_t WS_CTXX = 12 * MiB;
constexpr size_t WS_WIN = 20 * MiB;
constexpr size_t WS_WOUT = 32 * MiB;
constexpr size_t WS_WUP = 36 * MiB;
constexpr size_t WS_WDN = 47 * MiB;
constexpr size_t WS_HX = 54 * MiB;
constexpr size_t WS_PA = 122 * MiB;
constexpr size_t WS_KV = 360 * MiB;
constexpr size_t WS_Y = 496 * MiB;
constexpr size_t WS_MOEUP = 360 * MiB;
constexpr size_t WS_MOEDN = 472 * MiB;
constexpr size_t WS_SLABA = WS_KV;
constexpr size_t WS_SLABM = 528 * MiB;
constexpr int MAXSLAB_A = 256, MAXSLAB_M = 216;
constexpr size_t XB_OFF = (size_t)NLAT * D * 2;
constexpr size_t WS_XCOPY = WS_PA;
constexpr size_t WS_END = 582 * MiB;
static_assert(WS_MOEDN + (size_t)NE * D * DEXP * 2 <= WS_END, "ws map");
static_assert(WS_PA + (size_t)MROWS * DEXP * 2 <= WS_KV, "ws map");

constexpr int LDS_SCRATCH = 147456;
constexpr int LDS_MISC = LDS_SCRATCH;
constexpr int LDS_DEC = LDS_MISC + 256;
constexpr int LDS_BYTES = LDS_SCRATCH + 8192;

__device__ __forceinline__ float bf2f(unsigned v) { return __uint_as_float(v << 16); }
typedef __bf16 bf16x2_t __attribute__((ext_vector_type(2)));
__device__ __forceinline__ unsigned pk2(float lo, float hi) { const f32x2 v = {lo, hi}; return __builtin_bit_cast(unsigned, __builtin_convertvector(v, bf16x2_t)); }
__device__ __forceinline__ unsigned f2bf(float f) { return pk2(f, f) & 0xffffu; }
__device__ __forceinline__ void unpack8(const u32x4 v, f32x4& a, f32x4& b) {
    a = (f32x4){bf2f(v.x & 0xffffu), __uint_as_float(v.x & 0xffff0000u), bf2f(v.y & 0xffffu), __uint_as_float(v.y & 0xffff0000u)};
    b = (f32x4){bf2f(v.z & 0xffffu), __uint_as_float(v.z & 0xffff0000u), bf2f(v.w & 0xffffu), __uint_as_float(v.w & 0xffff0000u)}; }
__device__ __forceinline__ u32x4 pack8(const f32x4 a, const f32x4 b) { return (u32x4){pk2(a.x, a.y), pk2(a.z, a.w), pk2(b.x, b.y), pk2(b.z, b.w)}; }
template <int M> __device__ __forceinline__ float swz_xor(float v) { return __int_as_float(__builtin_amdgcn_ds_swizzle(__float_as_int(v), (M << 10) | 0x1f)); }
__device__ __forceinline__ float wave_sum(float v) {
    v += swz_xor<1>(v); v += swz_xor<2>(v); v += swz_xor<4>(v); v += swz_xor<8>(v); v += swz_xor<16>(v);
    const auto r = __builtin_amdgcn_permlane32_swap(__float_as_uint(v), __float_as_uint(v), false, false);
    return __uint_as_float(r[0]) + __uint_as_float(r[1]);
}
__device__ __forceinline__ float lane_bcast(float v, int src_lane) { return __int_as_float(__builtin_amdgcn_ds_bpermute(src_lane << 2, __float_as_int(v))); }
__device__ __forceinline__ float sigmoidf_(float x) { return __builtin_amdgcn_rcpf(1.0f + __expf(-x)); }
__device__ __forceinline__ float siluf_(float x) { return x * __builtin_amdgcn_rcpf(1.0f + __expf(-x)); }
__device__ __forceinline__ float gelu_tanh(float x) { const float z = 0.7978845608028654f * (x + 0.044715f * x * x * x); return x * (1.0f - __builtin_amdgcn_rcpf(1.0f + __expf(2.0f * z))); }
#define LDS_WAIT() asm volatile("s_waitcnt lgkmcnt(0)" ::: "memory")
#define WG_BAR_LDS() do { asm volatile("s_waitcnt lgkmcnt(0)" ::: "memory"); __builtin_amdgcn_s_barrier(); asm volatile("" ::: "memory"); } while (0)
__device__ __forceinline__ f32x4 zero4() { float z; asm volatile("v_mov_b32 %0, 0" : "=v"(z)); return (f32x4){z, z, z, z}; }

template <typename T> __device__ __forceinline__ T ldg(const void* base, unsigned off) { return *(const GAS T*)((const GAS char*)base + off); }
template <typename T> __device__ __forceinline__ void stg(void* base, unsigned off, T v) { *(GAS T*)((GAS char*)base + off) = v; }
#define XB_TMO      128
#define XB_XCNT(j)  (256  + 64 * (j))
#define XB_XSUB(j)  (1280 + 64 * (j))
#define XB_XGEN(j)  (2304 + 64 * (j))
#define XB_TOP      3328
#define XB_TOPGEN   3392
#define XCD_BAR_WORDS 3456
#define XB_SPIN_CAP (1u << 18)
__device__ __forceinline__ unsigned xb_ld(unsigned* p)              { return __hip_atomic_load(p, __ATOMIC_RELAXED, __HIP_MEMORY_SCOPE_AGENT); }
__device__ __forceinline__ unsigned xb_add(unsigned* p, unsigned v) { return __hip_atomic_fetch_add(p, v, __ATOMIC_RELAXED, __HIP_MEMORY_SCOPE_AGENT); }
__device__ __forceinline__ unsigned xb_xcc_id() { return (unsigned)__builtin_amdgcn_s_getreg((3 << 11) | 20) & 0xFu; }
#define XB_SPIN(cond, bar) do { unsigned _sp = 0; while (cond) { __builtin_amdgcn_s_sleep(1); \
    if ((++_sp & 255u) == 0u) { if (xb_ld(&(bar)[XB_TMO])) break; if (_sp > XB_SPIN_CAP) { atomicAdd(&(bar)[XB_TMO], 1u); break; } } } } while (0)
struct XcdBarrier { unsigned* bar; unsigned x; volatile LAS unsigned* st; };
__device__ __forceinline__ XcdBarrier xcd_barrier_post(unsigned* bar, volatile LAS unsigned* st) {
    XcdBarrier b; b.bar = bar; b.x = xb_xcc_id(); b.st = st;
    if (threadIdx.x == 0) (void)xb_add(&bar[XB_XCNT(b.x)], 1u);
    return b;
}
__device__ __forceinline__ void xcd_barrier_complete(unsigned* bar, unsigned x, unsigned& nloc, unsigned& nx) {
    const unsigned G = gridDim.x * gridDim.y * gridDim.z;
    unsigned sum, cnt, mine, sp = 0u;
    for (;;) {
        sum = 0u; cnt = 0u; mine = 0u;
#pragma unroll
        for (unsigned j = 0; j < 16; ++j) { const unsigned c = xb_ld(&bar[XB_XCNT(j)]); sum += c; cnt += (c > 0u) ? 1u : 0u; mine = (j == x) ? c : mine; }
        if (sum == G) break;
        __builtin_amdgcn_s_sleep(1);
        if ((++sp & 255u) == 0u) { if (xb_ld(&bar[XB_TMO])) break; if (sp > XB_SPIN_CAP) { atomicAdd(&bar[XB_TMO], 1u); break; } }
    }
    nloc = mine > 0u ? mine : 1u; nx = cnt > 0u ? cnt : 1u;
}
__device__ __forceinline__ void xcd_barrier(const XcdBarrier& b) {
    asm volatile("s_waitcnt vmcnt(0)" ::: "memory");
    __syncthreads();
    if (threadIdx.x == 0) {
        unsigned* bar = b.bar;
        __builtin_amdgcn_s_waitcnt(0);
        unsigned nloc = b.st[0], nx = b.st[1];
        if (nloc == 0u) { xcd_barrier_complete(bar, b.x, nloc, nx); b.st[0] = nloc; b.st[1] = nx; }
        const unsigned old = xb_add(&bar[XB_XSUB(b.x)], 1u);
        const unsigned gen = old / nloc;
        if (old + 1u == (gen + 1u) * nloc) {
            __builtin_amdgcn_fence(__ATOMIC_RELEASE, "agent");
            asm volatile("s_waitcnt vmcnt(0)" ::: "memory");
            const unsigned og = xb_add(&bar[XB_TOP], 1u);
            const unsigned tg = og / nx;
            if (og + 1u == (tg + 1u) * nx) xb_add(&bar[XB_TOPGEN], 1u);
            else XB_SPIN(xb_ld(&bar[XB_TOPGEN]) == tg, bar);
            __builtin_amdgcn_fence(__ATOMIC_ACQUIRE, "agent");
            xb_add(&bar[XB_XGEN(b.x)], 1u);
            asm volatile("s_waitcnt vmcnt(0)" ::: "memory");
        } else {
            XB_SPIN(xb_ld(&bar[XB_XGEN(b.x)]) == gen, bar);
            __builtin_amdgcn_fence(__ATOMIC_ACQUIRE, "agent");
            asm volatile("s_waitcnt vmcnt(0)" ::: "memory");
        }
    }
    __syncthreads();
}

namespace pg8 {
constexpr int BM = 256, BK = 64, HALF = 128, HTB = HALF * BK * 2, STAGE_BYTES = 8 * HTB, NXCD = 8, WGM = 8;
__host__ __device__ __forceinline__ int lds_byte(int r, int c) { const int st = (r >> 4) * 2 + (c >> 5), rr = r & 15, cc = c & 31, ob = rr * 64 + cc * 2; return st * 1024 + (ob ^ (((ob >> 9) & 1) << 5)); }
__host__ __device__ __forceinline__ void stage_rc(int b, int& R, int& C) { const int st = b / 1024, sb = b % 1024, swz = sb ^ (((sb >> 9) & 1) << 5); R = (st >> 1) * 16 + swz / 64; C = (st & 1) * 32 + (swz % 64) / 2; }
__host__ __device__ __forceinline__ int perm32(int rho) { const int n = rho >> 4, i = rho & 15; return 8 * (i >> 2) + 4 * n + (i & 3); }

struct Unit { int pm, pn, e, kt0, nt, slab; };
struct Gemm { const bf16_t* A; const bf16_t* Bt; int N, K; size_t estride; float* slabs; };

__device__ __forceinline__ int split_factor(int U, int G, int ntiles, int maxslabs) {
    const int R = U % G; if (R == 0) return 1;
    int S = G / R; if (S > 8) S = 8; if (S > ntiles / 2) S = ntiles / 2; if (R * S > maxslabs) S = maxslabs / R;
    return S < 2 ? 1 : S;
}
struct Order {
    int nM, nN, G, c, ntiles, mainu, S, total; const int* segs; const int* rowmap;
    int sg1, sg2, sg3, sg4, sg5, sg6, sg7;
    __device__ __forceinline__ void init(int nM_, int nN_, int G_, int c_, const int* segs_, const int* rowmap_, int ntiles_, bool split, int maxslabs) {
        nM = nM_; nN = nN_; G = G_; c = c_; segs = segs_; rowmap = rowmap_; ntiles = ntiles_;
        sg1 = sg2 = sg3 = sg4 = sg5 = sg6 = sg7 = 0; if (segs_) { sg1 = segs_[1]; sg2 = segs_[2]; sg3 = segs_[3]; sg4 = segs_[4]; sg5 = segs_[5]; sg6 = segs_[6]; sg7 = segs_[7]; }
        const int U = nM * nN; S = split ? split_factor(U, G, ntiles, maxslabs) : 1; const int R = (S > 1) ? U % G : 0; mainu = U - R; total = mainu + R * S; }
    __device__ __forceinline__ bool next(int i, Unit& u) const {
        const long L = (long)i * G + c; if (L >= total) return false;
        int wgid; u.kt0 = 0; u.nt = ntiles; u.slab = -1;
        if (L < mainu) { wgid = (int)L; const int q = mainu / NXCD, r = mainu % NXCD, xcd = wgid % NXCD, off = wgid / NXCD; wgid = (xcd < r ? xcd * (q + 1) : r * (q + 1) + (xcd - r) * q) + off; }
        else { const int sub = (int)L - mainu, lu = sub / S, sl = sub - lu * S, pairs = ntiles / 2, p0 = (sl * pairs) / S, p1 = ((sl + 1) * pairs) / S;
            wgid = mainu + lu; u.kt0 = 2 * p0; u.nt = 2 * (p1 - p0); u.slab = sub; }
        const int nig = WGM * nN, gid = wgid / nig, fm = gid * WGM, gsz = (nM - fm) < WGM ? (nM - fm) : WGM;
        u.pm = fm + ((wgid % nig) % gsz); u.pn = (wgid % nig) / gsz; u.e = 0;
        if (segs) u.e = (u.pm >= sg1) + (u.pm >= sg2) + (u.pm >= sg3) + (u.pm >= sg4) + (u.pm >= sg5) + (u.pm >= sg6) + (u.pm >= sg7);
        return true;
    }
    __device__ __forceinline__ int arow(const Unit& u, int r) const {
        if (rowmap) { const int t = rowmap[u.pm * BM + r]; return t < 0 ? 0 : t; }
        return u.pm * BM + r;
    }
};

__device__ __forceinline__ unsigned cvt_pk_bf16(float lo, float hi) { return pk2(lo, hi); }

struct EpiBf16 {
    static constexpr bool PERM = true, SPLIT = false;
    bf16_t* O; int ldc;
    __device__ __forceinline__ void operator()(const f32x4 (&acc)[2][2][4][2], const Unit& u, int wr, int wc, int fr, int fq) const {
        asm volatile("" : "+v"(fr), "+v"(fq));
        const int row0 = u.pm * BM + wr * 64 + fr, col0 = u.pn * BM + wc * 32 + 8 * fq;
#pragma unroll
        for (int ai = 0; ai < 2; ++ai)
#pragma unroll
            for (int m = 0; m < 4; ++m) { bf16_t* rowp = O + (size_t)(row0 + ai * HALF + m * 16) * ldc + col0;
#pragma unroll
                for (int bj = 0; bj < 2; ++bj) { const f32x4 v0 = acc[ai][bj][m][0], v1 = acc[ai][bj][m][1];
                    u32x4 w; w.x = cvt_pk_bf16(v0[0], v0[1]); w.y = cvt_pk_bf16(v0[2], v0[3]); w.z = cvt_pk_bf16(v1[0], v1[1]); w.w = cvt_pk_bf16(v1[2], v1[3]);
                    *(u32x4*)(rowp + bj * HALF) = w; } }
    }
};
struct EpiSwiGLU {
    static constexpr bool PERM = true, SPLIT = false;
    bf16_t* O; int ldc;
    __device__ __forceinline__ void operator()(const f32x4 (&acc)[2][2][4][2], const Unit& u, int wr, int wc, int fr, int fq) const {
        asm volatile("" : "+v"(fr), "+v"(fq));
        const int row0 = u.pm * BM + wr * 64 + fr, col0 = u.pn * HALF + wc * 32 + 8 * fq;
#pragma unroll
        for (int ai = 0; ai < 2; ++ai)
#pragma unroll
            for (int m = 0; m < 4; ++m) { bf16_t* rowp = O + (size_t)(row0 + ai * HALF + m * 16) * ldc + col0;
                float o[8];
#pragma unroll
                for (int n = 0; n < 2; ++n)
#pragma unroll
                    for (int j = 0; j < 4; ++j) { const float a = acc[ai][0][m][n][j], b = acc[ai][1][m][n][j]; o[n * 4 + j] = (a * __builtin_amdgcn_rcpf(1.0f + __expf(-a))) * b; }
                u32x4 w; w.x = cvt_pk_bf16(o[0], o[1]); w.y = cvt_pk_bf16(o[2], o[3]); w.z = cvt_pk_bf16(o[4], o[5]); w.w = cvt_pk_bf16(o[6], o[7]);
                *(u32x4*)rowp = w; }
    }
};
struct EpiResid {
    static constexpr bool PERM = true, SPLIT = true;
    const float* src_f32; bf16_t* xb; const float* src_ctx; float* dst_ctx; const float* gate_lat; const float* gate_ctx;
    __device__ __forceinline__ void operator()(const f32x4 (&acc)[2][2][4][2], const Unit& u, int wr, int wc, int fr, int fq) const {
        asm volatile("" : "+v"(fr), "+v"(fq));
        const int prow = u.pm * BM; const bool lat = prow < NLAT;
        const float* gate = lat ? gate_lat + (size_t)(prow / SEQ) * 6144 : gate_ctx;
        const int r0 = wr * 64 + fr, col0 = u.pn * BM + wc * 32 + 8 * fq;
        f32x4 gv[2][2];
#pragma unroll
        for (int bj = 0; bj < 2; ++bj)
#pragma unroll
            for (int n = 0; n < 2; ++n) gv[bj][n] = *(const f32x4*)(gate + col0 + bj * HALF + 4 * n);
        if (lat) {
#pragma unroll
            for (int ai = 0; ai < 2; ++ai)
#pragma unroll
                for (int m = 0; m < 4; ++m) { const size_t off = (size_t)(prow + r0 + ai * HALF + m * 16) * D + col0;
#pragma unroll
                    for (int bj = 0; bj < 2; ++bj) { f32x4 s0, s1;
                        if (src_f32) { s0 = *(const f32x4*)(src_f32 + off + bj * HALF); s1 = *(const f32x4*)(src_f32 + off + bj * HALF + 4); }
                        else unpack8(*(const u32x4*)(xb + off + bj * HALF), s0, s1);
                        *(u32x4*)(xb + off + bj * HALF) = pack8(s0 + gv[bj][0] * acc[ai][bj][m][0], s1 + gv[bj][1] * acc[ai][bj][m][1]); }
                    asm volatile("" ::: "memory"); }
        } else {
            const float* src = src_ctx + (size_t)(prow - NLAT) * D; float* dst = dst_ctx + (size_t)(prow - NLAT) * D;
#pragma unroll
            for (int ai = 0; ai < 2; ++ai)
#pragma unroll
                for (int m = 0; m < 4; ++m) { const size_t off = (size_t)(r0 + ai * HALF + m * 16) * D + col0;
#pragma unroll
                    for (int bj = 0; bj < 2; ++bj)
#pragma unroll
                        for (int n = 0; n < 2; ++n) { const f32x4 sv = *(const f32x4*)(src + off + bj * HALF + 4 * n); *(f32x4*)(dst + off + bj * HALF + 4 * n) = sv + gv[bj][n] * acc[ai][bj][m][n]; }
                    asm volatile("" ::: "memory"); }
        }
    }
};
struct EpiMoeDown {
    static constexpr bool PERM = true, SPLIT = true;
    bf16_t* xb; const int* ptok; const float* pw; const float* gate_lat;
    __device__ __forceinline__ void operator()(const f32x4 (&acc)[2][2][4][2], const Unit& u, int wr, int wc, int fr, int fq) const {
        asm volatile("" : "+v"(fr), "+v"(fq));
        const int r0 = u.pm * BM + wr * 64 + fr, col0 = u.pn * BM + wc * 32 + 8 * fq;
#pragma unroll
        for (int ai = 0; ai < 2; ++ai)
#pragma unroll
            for (int m = 0; m < 4; ++m) { const int r = r0 + ai * HALF + m * 16; const int tok = ptok[r]; const float w = pw[r];
                if (tok >= 0) { bf16_t* xr = xb + (size_t)tok * D + col0; const float* gate = gate_lat + (size_t)(tok / SEQ) * 6144 + col0;
#pragma unroll
                    for (int bj = 0; bj < 2; ++bj) { const f32x4 g0 = *(const f32x4*)(gate + bj * HALF), g1 = *(const f32x4*)(gate + bj * HALF + 4); f32x4 s0, s1; unpack8(*(const u32x4*)(xr + bj * HALF), s0, s1);
                        *(u32x4*)(xr + bj * HALF) = pack8(s0 + (g0 * w) * acc[ai][bj][m][0], s1 + (g1 * w) * acc[ai][bj][m][1]); } }
                asm volatile("" ::: "memory"); }
    }
};

template <class Epi>
__device__ __forceinline__ void gemm_phase(ldsp_t lds, const Gemm g, const Order& S, const Epi& E, const int tid) {
    const int wid = __builtin_amdgcn_readfirstlane(tid >> 6), lane = tid & 63, wr = wid >> 2, wc = wid & 3, fr = lane & 15, fq = lane >> 4;
    const int K = g.K;
    unsigned voffB[2];
#pragma unroll
    for (int i = 0; i < 2; ++i) { int R, C; stage_rc(tid * 16 + i * 8192, R, C); const int Rb = Epi::PERM ? ((R & ~31) + perm32(R & 31)) : R;
        voffB[i] = (unsigned)(Rb * K + C) * 2u; }
    const size_t kstep = (size_t)(BK * 2);
    const size_t hstep = (size_t)HALF * K * 2;
    const size_t tstep = 2 * hstep;
    const unsigned ldsw = (unsigned)wid * 1024u;
    const int aoff = lds_byte(wr * 64 + fr, fq * 8), boff = lds_byte(wc * 32 + fr, fq * 8);
#define PG8_SA(b, h) (((b) * 2 + (h)) * HTB)
#define PG8_SB(b, h) ((4 + (b) * 2 + (h)) * HTB)
#define PG8_STAGE_B(bufoff, gbase) do { _Pragma("unroll") for (int _i = 0; _i < 2; ++_i) \
        __builtin_amdgcn_global_load_lds((const unsigned*)((const char*)(gbase) + voffB[_i]), (LAS unsigned*)(lds + (bufoff) + ldsw + _i * 8192), 16, 0, 0); } while (0)
#define PG8_STAGE_A(bufoff, gbase, o0, o1) do { \
        __builtin_amdgcn_global_load_lds((const unsigned*)((const char*)(gbase) + (o0)), (LAS unsigned*)(lds + (bufoff) + ldsw), 16, 0, 0); \
        __builtin_amdgcn_global_load_lds((const unsigned*)((const char*)(gbase) + (o1)), (LAS unsigned*)(lds + (bufoff) + ldsw + 8192), 16, 0, 0); } while (0)
#define PG8_LDA(dst, b, h) do { _Pragma("unroll") for (int m = 0; m < 4; ++m) _Pragma("unroll") for (int k = 0; k < 2; ++k) dst[m][k] = *(const LAS bf16x8*)(lds + PG8_SA(b, h) + aoff + m * 2048 + k * 1024); } while (0)
#define PG8_LDB(dst, b, h) do { _Pragma("unroll") for (int n = 0; n < 2; ++n) _Pragma("unroll") for (int k = 0; k < 2; ++k) dst[n][k] = *(const LAS bf16x8*)(lds + PG8_SB(b, h) + boff + n * 2048 + k * 1024); } while (0)
#define PG8_MMA(ai, bj, At, Bt) do { __builtin_amdgcn_s_setprio(1); _Pragma("unroll") for (int m = 0; m < 4; ++m) _Pragma("unroll") for (int n = 0; n < 2; ++n) _Pragma("unroll") for (int k = 0; k < 2; ++k) \
        acc[ai][bj][m][n] = __builtin_amdgcn_mfma_f32_16x16x32_bf16(Bt[n][k], At[m][k], acc[ai][bj][m][n], 0, 0, 0); __builtin_amdgcn_s_setprio(0); } while (0)
#define PG8_WAIT_V(n) asm volatile("s_waitcnt vmcnt(" #n ")" ::: "memory")
#define PG8_WAIT_L(n) asm volatile("s_waitcnt lgkmcnt(" #n ")" ::: "memory")
#define PG8_BAR __builtin_amdgcn_s_barrier()
#define PG8_SCHED __builtin_amdgcn_sched_barrier(0)
#define PG8_AOFFS(u, o00, o01, o10, o11) do { int R0_, C0_, R1_, C1_; stage_rc(tid * 16, R0_, C0_); stage_rc(tid * 16 + 8192, R1_, C1_); \
        o00 = (unsigned)(S.arow(u, R0_) * K + C0_ + (u).kt0 * BK) * 2u; o01 = (unsigned)(S.arow(u, R1_) * K + C1_ + (u).kt0 * BK) * 2u; \
        o10 = (unsigned)(S.arow(u, HALF + R0_) * K + C0_ + (u).kt0 * BK) * 2u; o11 = (unsigned)(S.arow(u, HALF + R1_) * K + C1_ + (u).kt0 * BK) * 2u; } while (0)
    Unit cur, nxt; int ui = 0;
    if (!S.next(0, cur)) return;
    f32x4 acc[2][2][4][2];
    { float z_; asm volatile("v_mov_b32 %0, 0" : "=v"(z_));
#pragma unroll
    for (int a = 0; a < 2; ++a)
#pragma unroll
        for (int b = 0; b < 2; ++b)
#pragma unroll
            for (int m = 0; m < 4; ++m)
#pragma unroll
                for (int n = 0; n < 2; ++n) acc[a][b][m][n] = (f32x4){z_, z_, z_, z_}; }
    bf16x8 At[4][2], B0[2][2], B1[2][2];
    const char* const Abase = (const char*)g.A;
    const char* cB = (const char*)g.Bt + (size_t)cur.e * g.estride + (size_t)cur.pn * tstep + (size_t)cur.kt0 * kstep;
    unsigned c00, c01, c10, c11;
    PG8_AOFFS(cur, c00, c01, c10, c11);
    PG8_STAGE_B(PG8_SB(0, 0), cB); PG8_STAGE_B(PG8_SB(0, 1), cB + hstep); PG8_STAGE_A(PG8_SA(0, 0), Abase, c00, c01); PG8_STAGE_A(PG8_SA(0, 1), Abase, c10, c11);
    if (wr == 1) PG8_BAR;
    PG8_WAIT_V(2); PG8_BAR;
    PG8_STAGE_B(PG8_SB(1, 0), cB + kstep); PG8_STAGE_A(PG8_SA(1, 0), Abase + kstep, c00, c01); PG8_STAGE_B(PG8_SB(1, 1), cB + hstep + kstep);
    PG8_WAIT_V(6); PG8_BAR;
    for (;;) {
        const bool has_next = S.next(ui + 1, nxt);
        const char* nB = has_next ? (const char*)g.Bt + (size_t)nxt.e * g.estride + (size_t)nxt.pn * tstep + (size_t)nxt.kt0 * kstep : cB;
        const int nt = cur.nt;
        int rn0 = 0, rn1 = 0, rn2 = 0, rn3 = 0;
        if (S.rowmap && has_next) { int R0_, C0_, R1_, C1_; stage_rc(tid * 16, R0_, C0_); stage_rc(tid * 16 + 8192, R1_, C1_);
            rn0 = S.arow(nxt, R0_); rn1 = S.arow(nxt, R1_); rn2 = S.arow(nxt, HALF + R0_); rn3 = S.arow(nxt, HALF + R1_); }
        for (int t = 0; t < nt; t += 2) {
            const bool last = (t == nt - 2);
            const char* a1 = Abase + (size_t)(t + 1) * kstep;
            const char* a2 = last ? Abase : Abase + (size_t)(t + 2) * kstep; const char* b2 = last ? nB : cB + (size_t)(t + 2) * kstep;
            const char* a3 = a2 + kstep; const char* b3 = b2 + kstep;
            PG8_LDB(B0, 0, 0); PG8_LDB(B1, 0, 1); PG8_SCHED; PG8_LDA(At, 0, 0); PG8_STAGE_A(PG8_SA(1, 1), a1, c10, c11);
            PG8_WAIT_V(8); PG8_WAIT_L(0); PG8_BAR; PG8_MMA(0, 0, At, B0); PG8_MMA(0, 1, At, B1); PG8_BAR; PG8_SCHED;
            if (last && has_next) {
                if (S.rowmap) { int R0_, C0_, R1_, C1_; stage_rc(tid * 16, R0_, C0_); stage_rc(tid * 16 + 8192, R1_, C1_);
                    c00 = (unsigned)(rn0 * K + C0_ + nxt.kt0 * BK) * 2u; c01 = (unsigned)(rn1 * K + C1_ + nxt.kt0 * BK) * 2u; c10 = (unsigned)(rn2 * K + C0_ + nxt.kt0 * BK) * 2u; c11 = (unsigned)(rn3 * K + C1_ + nxt.kt0 * BK) * 2u; }
                else { PG8_AOFFS(nxt, c00, c01, c10, c11); } }
            PG8_LDA(At, 0, 1); PG8_STAGE_B(PG8_SB(0, 0), b2); PG8_STAGE_B(PG8_SB(0, 1), b2 + hstep); PG8_STAGE_A(PG8_SA(0, 0), a2, c00, c01);
            PG8_WAIT_V(8); PG8_WAIT_L(0); PG8_BAR; PG8_MMA(1, 0, At, B0); PG8_MMA(1, 1, At, B1); PG8_BAR; PG8_SCHED;
            PG8_LDB(B0, 1, 0); PG8_LDB(B1, 1, 1); PG8_SCHED; PG8_LDA(At, 1, 0); PG8_STAGE_A(PG8_SA(0, 1), a2, c10, c11);
            PG8_WAIT_V(8); PG8_WAIT_L(0); PG8_BAR; PG8_MMA(0, 0, At, B0); PG8_MMA(0, 1, At, B1); PG8_BAR; PG8_SCHED;
            PG8_LDA(At, 1, 1); PG8_STAGE_B(PG8_SB(1, 0), b3); PG8_STAGE_B(PG8_SB(1, 1), b3 + hstep); PG8_STAGE_A(PG8_SA(1, 0), a3, c00, c01);
            PG8_WAIT_V(8); PG8_WAIT_L(0); PG8_BAR; PG8_MMA(1, 0, At, B0); PG8_MMA(1, 1, At, B1); PG8_BAR; PG8_SCHED;
        }
        if (wr == 0) PG8_BAR;
        if (Epi::SPLIT && cur.slab >= 0) {
            int fr_ = fr, fq_ = fq; asm volatile("" : "+v"(fr_), "+v"(fq_));
            float* sp = g.slabs + (size_t)cur.slab * 65536 + (size_t)(wr * 64 + fr_) * 256 + wc * 32 + (Epi::PERM ? 8 : 4) * fq_;
#pragma unroll
            for (int ai = 0; ai < 2; ++ai)
#pragma unroll
                for (int m = 0; m < 4; ++m)
#pragma unroll
                    for (int bj = 0; bj < 2; ++bj)
#pragma unroll
                        for (int n = 0; n < 2; ++n) *(f32x4*)(sp + (ai * HALF + m * 16) * 256 + bj * HALF + n * (Epi::PERM ? 4 : 16)) = acc[ai][bj][m][n];
        } else E(acc, cur, wr, wc, fr, fq);
        if (!has_next) break;
        { float z_; asm volatile("v_mov_b32 %0, 0" : "=v"(z_));
#pragma unroll
        for (int a = 0; a < 2; ++a)
#pragma unroll
            for (int b = 0; b < 2; ++b)
#pragma unroll
                for (int m = 0; m < 4; ++m)
#pragma unroll
                    for (int n = 0; n < 2; ++n) acc[a][b][m][n] = (f32x4){z_, z_, z_, z_}; }
        cur = nxt; cB = nB; ++ui;
        if (wr == 1) PG8_BAR;
    }
    PG8_WAIT_V(0);
    PG8_BAR;
#undef PG8_SA
#undef PG8_SB
#undef PG8_STAGE_A
#undef PG8_STAGE_B
#undef PG8_LDA
#undef PG8_LDB
#undef PG8_MMA
#undef PG8_WAIT_V
#undef PG8_WAIT_L
#undef PG8_BAR
#undef PG8_SCHED
#undef PG8_AOFFS
}
}

struct Args { const float* in[27]; float* out; unsigned char* ws; int ph_lo, ph_hi; };
struct Frame {
    ldsp_t lds; int tid, lane, wave, wave0, G, bid;
    const Args* pa; float* out; unsigned char* ws;
    const Args* pa0; float* out0; unsigned char* ws0;
};
enum { I_X = 0, I_C, I_CTX, I_CCTX, I_WMOD, I_BMOD, I_GMIX, I_GFFN, I_GFINAL, I_WIN, I_WOUT, I_CONVW, I_CONVB, I_RGWA, I_RGBA, I_RGWX, I_RGBX, I_RGLAM, I_RETDEC,
       I_FW1, I_FW3, I_FW2, I_MROUTER, I_MROUTERB, I_MW1, I_MW3, I_MW2 };

constexpr int TRS = 64 * 65 * 4;
struct TrItem { const float* W; bf16_t* WT; int ldw, k0, n0, ldt, drow0; float scale; };
__device__ __forceinline__ void tr_load(const TrItem& t, f32x4 (&v)[16], int lane) {
    const int r4 = lane >> 4, c4 = (lane & 15) * 4;
#pragma unroll
    for (int i = 0; i < 16; ++i) v[i] = *(const f32x4*)(t.W + (size_t)(t.k0 + 4 * i + r4) * t.ldw + t.n0 + c4);
}
__device__ __forceinline__ void tr_store(const TrItem& t, const f32x4 (&v)[16], LAS float* scr, int lane) {
    { const int r4 = lane >> 4, c4 = (lane & 15) * 4;
#pragma unroll
      for (int i = 0; i < 16; ++i) { LAS float* d = scr + (4 * i + r4) * 65 + c4; d[0] = v[i].x; d[1] = v[i].y; d[2] = v[i].z; d[3] = v[i].w; } }
    LDS_WAIT(); asm volatile("" ::: "memory");
    const int c = lane & 7; const float scale = t.scale;
#pragma unroll
    for (int j = 0; j < 8; ++j) { const int n = (lane >> 3) + 8 * j; const LAS float* sp = scr + (8 * c) * 65 + n;
        u32x4 o; o.x = pk2(sp[0 * 65] * scale, sp[1 * 65] * scale); o.y = pk2(sp[2 * 65] * scale, sp[3 * 65] * scale); o.z = pk2(sp[4 * 65] * scale, sp[5 * 65] * scale); o.w = pk2(sp[6 * 65] * scale, sp[7 * 65] * scale);
        *(u32x4*)(t.WT + (size_t)(t.drow0 + n) * t.ldt + t.k0 + 8 * c) = o; }
    LDS_WAIT(); asm volatile("" ::: "memory");
}
__device__ __forceinline__ TrItem up_item(const float* w1, const float* w3, int F, bf16_t* WT, int r) {
    const int per = 16 * (F / 64); const int which = r / per; r -= which * per;
    const int nblk = F / 64, kb = r / nblk, nb = r % nblk, n0 = nb * 64;
    return TrItem{which ? w3 : w1, WT, F, kb * 64, n0, D, (n0 / 128) * 256 + (n0 % 128) + which * 128, 1.0f};
}
__device__ __forceinline__ TrItem small_item(Frame& F, int r) {
    constexpr int I_IN = 16 * (INW / 64), I_OUT = 16 * (D / 64), I_UP = 2 * 16 * (DFF / 64);
    if (r < 2 * I_IN) { const int l = r / I_IN; r -= l * I_IN; const int nblk = INW / 64, kb = r / nblk, nb = r % nblk, n0 = nb * 64;
        const float sc = (n0 >= 1536 && n0 < 2048) ? 0.08838834764831845f : 1.0f;
        return TrItem{F.pa->in[I_WIN] + (size_t)l * D * INW, (bf16_t*)(F.ws + WS_WIN) + (size_t)l * INW * D, INW, kb * 64, n0, D, n0, sc}; }
    r -= 2 * I_IN;
    if (r < 2 * I_OUT) { const int l = r / I_OUT; r -= l * I_OUT; const int nblk = D / 64, kb = r / nblk, nb = r % nblk;
        return TrItem{F.pa->in[I_WOUT] + (size_t)l * D * D, (bf16_t*)(F.ws + WS_WOUT) + (size_t)l * D * D, D, kb * 64, nb * 64, D, nb * 64, 1.0f}; }
    r -= 2 * I_OUT;
    if (r < I_UP) return up_item(F.pa->in[I_FW1], F.pa->in[I_FW3], DFF, (bf16_t*)(F.ws + WS_WUP), r);
    r -= I_UP;
    { const int nblk = D / 64, kb = r / nblk, nb = r % nblk; return TrItem{F.pa->in[I_FW2], (bf16_t*)(F.ws + WS_WDN), D, kb * 64, nb * 64, DFF, nb * 64, 1.0f}; }
}
__device__ __forceinline__ TrItem moe_item(Frame& F, int it) {
    constexpr int I_UP = 2 * 16 * (DEXP / 64), I_DN = (DEXP / 64) * (D / 64), PER_E = I_UP + I_DN;
    const int e = it / PER_E; int r = it - e * PER_E;
    if (r < I_UP) return up_item(F.pa->in[I_MW1] + (size_t)e * D * DEXP, F.pa->in[I_MW3] + (size_t)e * D * DEXP, DEXP, (bf16_t*)(F.ws + WS_MOEUP) + (size_t)e * 2 * DEXP * D, r);
    r -= I_UP;
    { const int nblk = D / 64, kb = r / nblk, nb = r % nblk; return TrItem{F.pa->in[I_MW2] + (size_t)e * DEXP * D, (bf16_t*)(F.ws + WS_MOEDN) + (size_t)e * D * DEXP, D, kb * 64, nb * 64, DEXP, nb * 64, 1.0f}; }
}
__device__ __forceinline__ void phase_convert_small(Frame& F) {
    LAS float* scr = (LAS float*)(F.lds + F.wave * TRS);
    const int gw = F.bid * NWAVES + F.wave, NGW = F.G * NWAVES;
    constexpr int NITEMS = 2 * 16 * (INW / 64) + 2 * 16 * (D / 64) + 2 * 16 * (DFF / 64) + (DFF / 64) * (D / 64);
    if (gw < NITEMS) { TrItem cur = small_item(F, gw); f32x4 va[16], vb[16]; tr_load(cur, va, F.lane);
        for (int it = gw; it < NITEMS; it += 2 * NGW) {
            const bool h1 = it + NGW < NITEMS; TrItem n1 = cur; if (h1) { n1 = small_item(F, it + NGW); tr_load(n1, vb, F.lane); }
            tr_store(cur, va, scr, F.lane);
            if (!h1) break;
            const bool h2 = it + 2 * NGW < NITEMS; if (h2) { cur = small_item(F, it + 2 * NGW); tr_load(cur, va, F.lane); }
            tr_store(n1, vb, scr, F.lane);
            if (!h2) break; } }
    { const int gt = F.bid * NTHREADS + F.tid, NGT = F.G * NTHREADS; bf16_t* o = (bf16_t*)(F.ws + WS_RGW);
      for (int i = gt; i < 2 * 2 * 2 * 8 * 64 * 64; i += NGT) { const int c = i & 63, dp = (i >> 6) & 63, blk = (i >> 12) & 7, gate = (i >> 15) & 1, dir = (i >> 16) & 1, l = i >> 17;
          const float* src = gate ? F.pa->in[I_RGWX] : F.pa->in[I_RGWA]; o[i] = (bf16_t)f2bf(src[((((size_t)l * 2 + dir) * 8 + blk) * 64 + c) * 64 + dp]); } }
    { const int gt = F.bid * NTHREADS + F.tid, NGT = F.G * NTHREADS; float* ct = (float*)(F.ws + WS_ROPE); float* st = ct + 4096 * 64;
      for (int i = gt; i < 4096 * 64; i += NGT) { const int pos = i >> 6, fi = i & 63; const float p = (float)((fi < 32) ? (pos >> 6) : (pos & 63));
          const float inv = powf(10000.0f, -(float)(fi & 31) / 32.0f); const float ang = p * inv;
          const double a = (double)ang; const double kq = __builtin_rint(a * 0.63661977236758134308); const double rr = a - kq * 1.57079632679489661923; const int q = ((int)kq) & 3;
          const double r2 = rr * rr;
          const double sn = rr * (1.0 + r2 * (-1.0 / 6 + r2 * (1.0 / 120 + r2 * (-1.0 / 5040 + r2 * (1.0 / 362880 + r2 * (-1.0 / 39916800))))));
          const double cs = 1.0 + r2 * (-0.5 + r2 * (1.0 / 24 + r2 * (-1.0 / 720 + r2 * (1.0 / 40320 + r2 * (-1.0 / 3628800 + r2 * (1.0 / 479001600))))));
          const double c_ = (q == 0) ? cs : (q == 1) ? -sn : (q == 2) ? -cs : sn; const double s_ = (q == 0) ? sn : (q == 1) ? cs : (q == 2) ? -sn : -cs;
          ct[i] = (float)c_; st[i] = (float)s_; } }
}
struct MoeTile { const float* W; bf16_t* WT; int ldw, k0, n0, ldt, up; };
__device__ __forceinline__ MoeTile moe_tile(Frame& F, int t) {
    constexpr int T_UP1 = (D / 128) * (DEXP / 256), T_DN = (DEXP / 128) * (D / 256), PER_E = 2 * T_UP1 + T_DN;
    const int e = t / PER_E; int r = t - e * PER_E;
    if (r < 2 * T_UP1) { const int which = r / T_UP1; r -= which * T_UP1; const int nb = DEXP / 256, kb = r / nb, nn = r % nb;
        return MoeTile{(which ? F.pa->in[I_MW3] : F.pa->in[I_MW1]) + (size_t)e * D * DEXP, (bf16_t*)(F.ws + WS_MOEUP) + (size_t)e * 2 * DEXP * D, DEXP, kb * 128, nn * 256, D, 1 + which}; }
    r -= 2 * T_UP1;
    { const int nb = D / 256, kb = r / nb, nn = r % nb; return MoeTile{F.pa->in[I_MW2] + (size_t)e * DEXP * D, (bf16_t*)(F.ws + WS_MOEDN) + (size_t)e * D * DEXP, D, kb * 128, nn * 256, DEXP, 0}; }
}
__device__ __forceinline__ void moe_tile_load(const MoeTile& t, f32x4 (&v)[16], int wave, int lane) {
#pragma unroll
    for (int i = 0; i < 16; ++i) v[i] = *(const f32x4*)(t.W + (size_t)(t.k0 + 16 * wave + i) * t.ldw + t.n0 + 4 * lane);
}
__device__ __forceinline__ void moe_tile_store(Frame& F, const MoeTile& t, const f32x4 (&v)[16]) {
    LAS float* tile = (LAS float*)F.lds;
#pragma unroll
    for (int i = 0; i < 16; ++i) { const int k = 16 * F.wave + i, p = (4 * F.lane + 2 * (k >> 3)) & 255;
        *(LAS f32x2*)(tile + k * 256 + p) = (f32x2){v[i].x, v[i].y}; *(LAS f32x2*)(tile + k * 256 + ((p + 2) & 255)) = (f32x2){v[i].z, v[i].w}; }
    __syncthreads();
#pragma unroll
    for (int j = 0; j < 8; ++j) { const int task = F.tid + j * NTHREADS, c = task & 15, n = task >> 4; const LAS float* sp = tile + (8 * c) * 256 + ((n + 2 * c) & 255);
        u32x4 o; o.x = pk2(sp[0], sp[256]); o.y = pk2(sp[512], sp[768]); o.z = pk2(sp[1024], sp[1280]); o.w = pk2(sp[1536], sp[1792]);
        const int col = t.n0 + n; const int drow = t.up ? (col >> 7) * 256 + (col & 127) + 128 * (t.up - 1) : col;
        *(u32x4*)(t.WT + (size_t)drow * t.ldt + t.k0 + 8 * c) = o; }
    __syncthreads();
}
__device__ __forceinline__ void phase_convert_moe(Frame& F) {
    constexpr int NT = NE * (2 * (D / 128) * (DEXP / 256) + (DEXP / 128) * (D / 256));
    if (F.bid < NT) { MoeTile cur = moe_tile(F, F.bid); f32x4 va[16], vb[16]; moe_tile_load(cur, va, F.wave, F.lane);
        for (int t = F.bid; t < NT; t += 2 * F.G) {
            const bool h1 = t + F.G < NT; MoeTile n1 = cur; if (h1) { n1 = moe_tile(F, t + F.G); moe_tile_load(n1, vb, F.wave, F.lane); }
            moe_tile_store(F, cur, va);
            if (!h1) break;
            const bool h2 = t + 2 * F.G < NT; if (h2) { cur = moe_tile(F, t + 2 * F.G); moe_tile_load(cur, va, F.wave, F.lane); }
            moe_tile_store(F, n1, vb);
            if (!h2) break; } }
}
__device__ __forceinline__ void phase_mod(Frame& F) {
    LAS float* sc = (LAS float*)F.lds;
    LAS float* red = (LAS float*)(F.lds + 9 * 1024 * 4);
    for (int i = F.tid; i < 9 * 1024; i += NTHREADS) { const int r = i >> 10, k = i & 1023; const float v = (r < 8) ? F.pa->in[I_C][r * 1024 + k] : F.pa->in[I_CCTX][k]; sc[i] = v / (1.0f + __expf(-v)); }
    __syncthreads();
    for (int strip = F.bid; strip < 2 * 6144 / 64; strip += F.G) {
        const int l = strip / 96, j = (strip % 96) * 64 + F.lane;
        const float* w = F.pa->in[I_WMOD] + (size_t)l * 1024 * 6144 + j;
        float a[9];
#pragma unroll
        for (int r = 0; r < 9; ++r) a[r] = 0.f;
        const int k0 = F.wave * 128;
#pragma unroll 1
        for (int kk = k0; kk < k0 + 128; kk += 16) { float wv[16];
#pragma unroll
            for (int i = 0; i < 16; ++i) wv[i] = w[(size_t)(kk + i) * 6144];
#pragma unroll
            for (int i = 0; i < 16; ++i) {
#pragma unroll
                for (int r = 0; r < 9; ++r) a[r] += sc[r * 1024 + kk + i] * wv[i];
                if ((i & 3) == 3) __builtin_amdgcn_sched_barrier(0); } }
#pragma unroll
        for (int r = 0; r < 9; ++r) red[(F.wave * 9 + r) * 64 + F.lane] = a[r];
        __syncthreads();
        for (int i = F.tid; i < 9 * 64; i += NTHREADS) { const int r = i >> 6, jj = i & 63; float s = 0.f;
#pragma unroll
            for (int w8 = 0; w8 < 8; ++w8) s += red[(w8 * 9 + r) * 64 + jj];
            const int col = (strip % 96) * 64 + jj; s += F.pa->in[I_BMOD][l * 6144 + col];
            if (r < 8) ((float*)(F.ws + WS_MODLAT))[((size_t)l * 8 + r) * 6144 + col] = s; else ((float*)(F.ws + WS_MODCTX))[(size_t)l * 6144 + col] = s; }
        __syncthreads();
    }
}

__device__ __forceinline__ void norm_row(const u32x2 (&xw)[4], const f32x4 (&Am)[4], const f32x4 (&Sh)[4], bf16_t* orow, int lane, f32x4 (&y)[4]) {
    f32x4 v[4]; float ss = 0.f;
#pragma unroll
    for (int j = 0; j < 4; ++j) { const u32x2 w = xw[j]; v[j] = (f32x4){bf2f(w.x & 0xffffu), __uint_as_float(w.x & 0xffff0000u), bf2f(w.y & 0xffffu), __uint_as_float(w.y & 0xffff0000u)};
        ss += (v[j].x * v[j].x + v[j].y * v[j].y) + (v[j].z * v[j].z + v[j].w * v[j].w); }
    const float rstd = 1.0f / sqrtf(wave_sum(ss) * (1.0f / D) + EPS);
    u32x2* o8 = (u32x2*)orow + lane;
#pragma unroll
    for (int j = 0; j < 4; ++j) { y[j] = (v[j] * rstd) * Am[j] + Sh[j]; o8[64 * j] = (u32x2){pk2(y[j].x, y[j].y), pk2(y[j].z, y[j].w)}; }
}
struct SlabRed { const float* slab; int S; const float* gate; const float* xold; float* xnew; };
__device__ __forceinline__ void norm_row_v(f32x4 (&v)[4], const float* g, const float* shift, const float* scale, bf16_t* orow, int lane) {
    float ss = 0.f;
#pragma unroll
    for (int j = 0; j < 4; ++j) ss += (v[j].x * v[j].x + v[j].y * v[j].y) + (v[j].z * v[j].z + v[j].w * v[j].w);
    const float rstd = 1.0f / sqrtf(wave_sum(ss) * (1.0f / D) + EPS);
    u32x2* o8 = (u32x2*)orow + lane;
#pragma unroll
    for (int j = 0; j < 4; ++j) { const f32x4 gg = ((const f32x4*)g)[lane + 64 * j], sh = ((const f32x4*)shift)[lane + 64 * j], sl = ((const f32x4*)scale)[lane + 64 * j];
        const f32x4 y = (v[j] * rstd) * gg * (sl + 1.0f) + sh;
        u32x2 w; w.x = pk2(y.x, y.y); w.y = pk2(y.z, y.w); o8[64 * j] = w; }
}
__device__ __forceinline__ void phase_norm(Frame& F, int l, int sel, const float* xlat, const bf16_t* xb, const float* xctx, int nrows, const SlabRed sr) {
    const int gw = F.bid * NWAVES + F.wave, NGW = F.G * NWAVES;
    const float* g = (sel ? F.pa->in[I_GFFN] : F.pa->in[I_GMIX]) + l * D; const int so = sel ? 3072 : 0;
    bf16_t* HX = (bf16_t*)(F.ws + WS_HX);
    const int nlat = nrows < NLAT ? nrows : NLAT; const int per = (nlat + NGW - 1) / NGW, r_lo = gw * per, r_hi = (r_lo + per < nlat) ? r_lo + per : nlat;
    int curb = -1; f32x4 Am[4], Sh[4];
    for (int row0 = r_lo; row0 < r_hi; row0 += 4) {
        f32x4 v[4][4];
#pragma unroll
        for (int u = 0; u < 4; ++u) { const int row = (row0 + u < r_hi) ? row0 + u : row0;
            if (xb) { const u32x2* xr = (const u32x2*)(xb + (size_t)row * D) + F.lane;
#pragma unroll
                for (int j = 0; j < 4; ++j) { const u32x2 w = xr[64 * j]; v[u][j] = (f32x4){bf2f(w.x & 0xffffu), __uint_as_float(w.x & 0xffff0000u), bf2f(w.y & 0xffffu), __uint_as_float(w.y & 0xffff0000u)}; } }
            else { const f32x4* xr = (const f32x4*)(xlat + (size_t)row * D) + F.lane;
#pragma unroll
                for (int j = 0; j < 4; ++j) v[u][j] = xr[64 * j]; } }
#pragma unroll
        for (int u = 0; u < 4; ++u) { const int row = row0 + u; if (row >= r_hi) continue;
            const int b = row / SEQ;
            if (b != curb) { curb = b; const float* mod = (const float*)(F.ws + WS_MODLAT) + ((size_t)l * 8 + b) * 6144 + so;
#pragma unroll
                for (int j = 0; j < 4; ++j) { Am[j] = ((const f32x4*)g)[F.lane + 64 * j] * (((const f32x4*)(mod + 1024))[F.lane + 64 * j] + 1.0f); Sh[j] = ((const f32x4*)mod)[F.lane + 64 * j]; } }
            float ss = 0.f;
#pragma unroll
            for (int j = 0; j < 4; ++j) ss += (v[u][j].x * v[u][j].x + v[u][j].y * v[u][j].y) + (v[u][j].z * v[u][j].z + v[u][j].w * v[u][j].w);
            const float rstd = 1.0f / sqrtf(wave_sum(ss) * (1.0f / D) + EPS);
            u32x2* o8 = (u32x2*)(HX + (size_t)row * D) + F.lane;
#pragma unroll
            for (int j = 0; j < 4; ++j) { const f32x4 y = (v[u][j] * rstd) * Am[j] + Sh[j]; o8[64 * j] = (u32x2){pk2(y.x, y.y), pk2(y.z, y.w)}; } }
    }
    for (int row = NLAT + gw; row < nrows; row += NGW) {
        const float* mod = (const float*)(F.ws + WS_MODCTX) + (size_t)l * 6144;
        f32x4 v[4];
        if (sr.slab == nullptr) { const f32x4* xr = (const f32x4*)(xctx + (size_t)(row - NLAT) * D) + F.lane;
#pragma unroll
            for (int j = 0; j < 4; ++j) v[j] = xr[64 * j]; }
        else { const int rc = row - NLAT, pmr = rc >> 8, r = rc & 255;
#pragma unroll
            for (int j = 0; j < 4; ++j) { f32x4 a = zero4(); const float* sp = sr.slab + (size_t)((pmr + 8 * j) * sr.S) * 65536 + (size_t)r * 256 + 4 * F.lane;
                f32x4 t8[8];
#pragma unroll
                for (int q = 0; q < 8; ++q) t8[q] = (q < sr.S) ? *(const f32x4*)(sp + (size_t)q * 65536) : zero4();
#pragma unroll
                for (int q = 0; q < 8; ++q) a += t8[q];
                v[j] = ((const f32x4*)(sr.xold + (size_t)rc * D))[F.lane + 64 * j] + ((const f32x4*)sr.gate)[F.lane + 64 * j] * a;
                ((f32x4*)(sr.xnew + (size_t)rc * D))[F.lane + 64 * j] = v[j]; } }
        norm_row_v(v, g, mod + so, mod + so + 1024, HX + (size_t)row * D, F.lane);
    }
}
__device__ __forceinline__ void moe_reduce(Frame& F, int k) {
    const int* meta = (const int*)(F.ws + MOE_META) + 9 * k; const int npan = meta[8], gsz = npan - 128;
    if (gsz <= 0) return;
    const int S = pg8::split_factor(npan * 4, F.G, DEXP / 64, MAXSLAB_M); if (S < 2) return;
    const int gw = F.bid * NWAVES + F.wave, NGW = F.G * NWAVES;
    const int* ptok = (const int*)(F.ws + MOE_PTOK) + k * MROWS; const float* pw = (const float*)(F.ws + MOE_PW) + k * MROWS;
    const float* slab = (const float*)(F.ws + WS_SLABM); const float* gate_lat = (const float*)(F.ws + WS_MODLAT) + (size_t)8 * 6144 + 5120;
    for (int rr = NLAT + gw; rr < npan * 256; rr += NGW) { const int tok = ptok[rr]; if (tok < 0) continue; const float w = pw[rr];
        const int pmr = (rr - NLAT) >> 8, r = rr & 255; u32x2* xr = (u32x2*)((bf16_t*)((char*)F.out + XB_OFF) + (size_t)tok * D); const f32x4* gt = (const f32x4*)(gate_lat + (size_t)(tok / SEQ) * 6144);
#pragma unroll
        for (int j = 0; j < 4; ++j) { f32x4 a = zero4(); const float* sp = slab + (size_t)((pmr + gsz * j) * S) * 65536 + (size_t)r * 256 + 4 * F.lane;
            for (int q = 0; q < S; ++q) a += *(const f32x4*)(sp + (size_t)q * 65536);
            const u32x2 xo = xr[F.lane + 64 * j]; const f32x4 xv = {bf2f(xo.x & 0xffffu), __uint_as_float(xo.x & 0xffff0000u), bf2f(xo.y & 0xffffu), __uint_as_float(xo.y & 0xffff0000u)};
            const f32x4 y = xv + (gt[F.lane + 64 * j] * w) * a; xr[F.lane + 64 * j] = (u32x2){pk2(y.x, y.y), pk2(y.z, y.w)}; } }
}
__device__ __forceinline__ void phase_norm_router(Frame& F, const bf16_t* xb) {
    constexpr int l = 1;
    LAS float* wr = (LAS float*)F.lds;
    LAS int* le = (LAS int*)(F.lds + 32768);
    for (int i = F.tid; i < 1024 * 8 / 4; i += NTHREADS) ((LAS f32x4*)wr)[i] = ((const f32x4*)F.pa->in[I_MROUTER])[i];
    __syncthreads();
    const float* g = F.pa->in[I_GFFN] + l * D; bf16_t* HX = (bf16_t*)(F.ws + WS_HX);
    int* toke = (int*)(F.ws + MOE_TOKE); float* tokw = (float*)(F.ws + MOE_TOKW);
    for (int wg = F.bid; wg < NLAT / 128; wg += F.G) {
        u32x2 nx[4]; f32x4 Am[4], Sh[4];
        { const float* mod = (const float*)(F.ws + WS_MODLAT) + ((size_t)l * 8 + (wg * 128) / SEQ) * 6144 + 3072;
#pragma unroll
          for (int j = 0; j < 4; ++j) { Am[j] = ((const f32x4*)g)[F.lane + 64 * j] * (((const f32x4*)(mod + 1024))[F.lane + 64 * j] + 1.0f); Sh[j] = ((const f32x4*)mod)[F.lane + 64 * j]; } }
        { const u32x2* xr = (const u32x2*)(xb + (size_t)(wg * 128 + F.wave * 16) * D) + F.lane;
#pragma unroll
          for (int j = 0; j < 4; ++j) nx[j] = xr[64 * j]; }
        for (int i = 0; i < 16; ++i) { const int tl = F.wave * 16 + i, row = wg * 128 + tl;
            u32x2 cx[4];
#pragma unroll
            for (int j = 0; j < 4; ++j) cx[j] = nx[j];
            { const int rn = (i < 15) ? row + 1 : row; const u32x2* xr = (const u32x2*)(xb + (size_t)rn * D) + F.lane;
#pragma unroll
              for (int j = 0; j < 4; ++j) nx[j] = xr[64 * j]; }
            f32x4 y[4]; norm_row(cx, Am, Sh, HX + (size_t)row * D, F.lane, y);
            float lg[8];
#pragma unroll
            for (int e = 0; e < 8; ++e) lg[e] = 0.f;
#pragma unroll
            for (int j = 0; j < 4; ++j)
#pragma unroll
                for (int q = 0; q < 4; ++q) { const int k = 4 * F.lane + 256 * j + q; const f32x4 w0 = *(const LAS f32x4*)(wr + k * 8), w1 = *(const LAS f32x4*)(wr + k * 8 + 4); const float yv = y[j][q];
                    lg[0] += yv * w0.x; lg[1] += yv * w0.y; lg[2] += yv * w0.z; lg[3] += yv * w0.w; lg[4] += yv * w1.x; lg[5] += yv * w1.y; lg[6] += yv * w1.z; lg[7] += yv * w1.w; }
#pragma unroll
            for (int e = 0; e < 8; ++e) lg[e] = wave_sum(lg[e]) + F.pa->in[I_MROUTERB][e];
            int e0 = 0; float v0 = lg[0];
#pragma unroll
            for (int e = 1; e < 8; ++e) if (lg[e] > v0) { v0 = lg[e]; e0 = e; }
            int e1 = -1; float v1 = -3.0e38f;
#pragma unroll
            for (int e = 0; e < 8; ++e) if (e != e0 && lg[e] > v1) { v1 = lg[e]; e1 = e; }
            const float w0 = 1.0f / (1.0f + __expf(v1 - v0));
            if (F.lane == 0) { toke[row] = e0 | (e1 << 8); tokw[2 * row] = w0; tokw[2 * row + 1] = 1.0f - w0; le[tl] = e0 | (e1 << 8); }
        }
        __syncthreads();
        if (F.tid < 16) { const int k = F.tid >> 3, e = F.tid & 7; int c = 0; for (int t = 0; t < 128; ++t) c += (((le[t] >> (8 * k)) & 0xff) == e) ? 1 : 0; ((int*)(F.ws + MOE_CNT))[wg * 16 + F.tid] = c; }
        __syncthreads();
    }
}
__device__ __forceinline__ void phase_moe_sort(Frame& F) {
    LAS int* tot = (LAS int*)F.lds;
    LAS int* pre = tot + 16;
    LAS int* seg = tot + 32;
    LAS int* le = tot + 64;
    const int* cnt = (const int*)(F.ws + MOE_CNT); const int* toke = (const int*)(F.ws + MOE_TOKE); const float* tokw = (const float*)(F.ws + MOE_TOKW);
    int* ptok = (int*)(F.ws + MOE_PTOK); float* pw = (float*)(F.ws + MOE_PW); int* meta = (int*)(F.ws + MOE_META);
    for (int wg = F.bid; wg < NLAT / 128; wg += F.G) {
        { LAS int* part = tot + 256;
          if (F.tid < 256) { const int col = F.tid & 15, pt = F.tid >> 4; int t = 0, p = 0;
#pragma unroll
              for (int i = 0; i < 16; ++i) { const int w = pt * 16 + i; const int c = cnt[w * 16 + col]; t += c; p += (w < wg) ? c : 0; }
              part[pt * 16 + col] = t; part[256 + pt * 16 + col] = p; }
          if (F.tid >= 256 && F.tid < 384) le[F.tid - 256] = toke[wg * 128 + F.tid - 256];
          __syncthreads();
          if (F.tid < 16) { int t = 0, p = 0;
#pragma unroll
              for (int pt = 0; pt < 16; ++pt) { t += part[pt * 16 + F.tid]; p += part[256 + pt * 16 + F.tid]; }
              tot[F.tid] = t; pre[F.tid] = p; } }
        __syncthreads();
        if (F.tid < 2) { int s = 0; for (int e = 0; e < 8; ++e) { seg[F.tid * 9 + e] = s; s += (tot[F.tid * 8 + e] + 255) & ~255; } seg[F.tid * 9 + 8] = s; }
        __syncthreads();
        if (F.tid < 256) { const int k = F.tid >> 7, t = F.tid & 127; const int e = (le[t] >> (8 * k)) & 0xff; int rank = 0; for (int u = 0; u < t; ++u) rank += (((le[u] >> (8 * k)) & 0xff) == e) ? 1 : 0;
            const int pos = seg[k * 9 + e] + pre[k * 8 + e] + rank; const int tok = wg * 128 + t; ptok[k * MROWS + pos] = tok; pw[k * MROWS + pos] = tokw[2 * tok + k]; ((int*)(F.ws + MOE_PPOS))[k * NLAT + tok] = pos; }
        if (wg < 16) { const int k = wg >> 3, e = wg & 7; const int a = seg[k * 9 + e] + tot[k * 8 + e], b = seg[k * 9 + e + 1]; for (int p = a + F.tid; p < b; p += NTHREADS) { ptok[k * MROWS + p] = -1; pw[k * MROWS + p] = 0.f; } }
        if (wg == 0 && F.tid < 18) meta[F.tid] = seg[F.tid] >> 8;
        __syncthreads();
    }
}
__device__ __forceinline__ void phase_final_a(Frame& F) {
    const int gw = F.bid * NWAVES + F.wave, NGW = F.G * NWAVES; const float* g = F.pa->in[I_GFINAL];
    const bf16_t* xb = (const bf16_t*)((const char*)F.out + XB_OFF); bf16_t* xc = (bf16_t*)(F.ws + WS_XCOPY);
    const int* meta = (const int*)(F.ws + MOE_META) + 9; const int npan = meta[8], gsz = npan - 128;
    const int S = (gsz > 0) ? pg8::split_factor(npan * 4, F.G, DEXP / 64, MAXSLAB_M) : 1;
    const int* ppos = (const int*)(F.ws + MOE_PPOS) + NLAT; const float* pw = (const float*)(F.ws + MOE_PW) + MROWS;
    const float* slab = (const float*)(F.ws + WS_SLABM); const float* gate_lat = (const float*)(F.ws + WS_MODLAT) + (size_t)8 * 6144 + 5120;
    for (int row0 = gw; row0 < NLAT; row0 += 4 * NGW) {
        u32x2 w[4][4]; int rr[4];
#pragma unroll
        for (int u = 0; u < 4; ++u) { const int row = (row0 + u * NGW < NLAT) ? row0 + u * NGW : row0; const u32x2* xr = (const u32x2*)(xb + (size_t)row * D) + F.lane; rr[u] = ppos[row];
#pragma unroll
            for (int j = 0; j < 4; ++j) w[u][j] = xr[64 * j]; }
#pragma unroll
        for (int u = 0; u < 4; ++u) { const int row = row0 + u * NGW; if (row >= NLAT) continue;
            f32x4 v[4];
#pragma unroll
            for (int j = 0; j < 4; ++j) v[j] = (f32x4){bf2f(w[u][j].x & 0xffffu), __uint_as_float(w[u][j].x & 0xffff0000u), bf2f(w[u][j].y & 0xffffu), __uint_as_float(w[u][j].y & 0xffff0000u)};
            if (S >= 2 && rr[u] >= NLAT) { const float wt = pw[rr[u]]; const int pmr = (rr[u] - NLAT) >> 8, r = rr[u] & 255; const f32x4* gt = (const f32x4*)(gate_lat + (size_t)(row / SEQ) * 6144);
#pragma unroll
                for (int j = 0; j < 4; ++j) { f32x4 a = zero4(); const float* sp = slab + (size_t)((pmr + gsz * j) * S) * 65536 + (size_t)r * 256 + 4 * F.lane;
                    for (int q = 0; q < S; ++q) a += *(const f32x4*)(sp + (size_t)q * 65536);
                    v[j] += (gt[F.lane + 64 * j] * wt) * a; } }
            if (row < NLAT / 2) { float ss = 0.f;
#pragma unroll
                for (int j = 0; j < 4; ++j) ss += (v[j].x * v[j].x + v[j].y * v[j].y) + (v[j].z * v[j].z + v[j].w * v[j].w);
                const float rstd = 1.0f / sqrtf(wave_sum(ss) * (1.0f / D) + EPS); f32x4* o = (f32x4*)(F.out + (size_t)row * D) + F.lane;
#pragma unroll
                for (int j = 0; j < 4; ++j) o[64 * j] = (v[j] * rstd) * ((const f32x4*)g)[F.lane + 64 * j]; }
            else { u32x2* o = (u32x2*)(xc + (size_t)(row - NLAT / 2) * D) + F.lane;
#pragma unroll
                for (int j = 0; j < 4; ++j) o[64 * j] = (u32x2){pk2(v[j].x, v[j].y), pk2(v[j].z, v[j].w)}; } }
    }
}
__device__ __forceinline__ void phase_final_b(Frame& F) {
    const int gw = F.bid * NWAVES + F.wave, NGW = F.G * NWAVES; const float* g = F.pa->in[I_GFINAL]; const bf16_t* xc = (const bf16_t*)(F.ws + WS_XCOPY);
    for (int row0 = NLAT / 2 + gw; row0 < NLAT; row0 += 4 * NGW) {
        u32x2 w[4][4];
#pragma unroll
        for (int u = 0; u < 4; ++u) { const int row = (row0 + u * NGW < NLAT) ? row0 + u * NGW : row0; const u32x2* xr = (const u32x2*)(xc + (size_t)(row - NLAT / 2) * D) + F.lane;
#pragma unroll
            for (int j = 0; j < 4; ++j) w[u][j] = xr[64 * j]; }
#pragma unroll
        for (int u = 0; u < 4; ++u) { const int row = row0 + u * NGW; if (row >= NLAT) continue;
            f32x4 v[4]; float ss = 0.f;
#pragma unroll
            for (int j = 0; j < 4; ++j) { v[j] = (f32x4){bf2f(w[u][j].x & 0xffffu), __uint_as_float(w[u][j].x & 0xffff0000u), bf2f(w[u][j].y & 0xffffu), __uint_as_float(w[u][j].y & 0xffff0000u)};
                ss += (v[j].x * v[j].x + v[j].y * v[j].y) + (v[j].z * v[j].z + v[j].w * v[j].w); }
            const float rstd = 1.0f / sqrtf(wave_sum(ss) * (1.0f / D) + EPS); f32x4* o = (f32x4*)(F.out + (size_t)row * D) + F.lane;
#pragma unroll
            for (int j = 0; j < 4; ++j) o[64 * j] = (v[j] * rstd) * ((const f32x4*)g)[F.lane + 64 * j]; }
    }
}

__device__ __forceinline__ bool fresh(Frame& F) {
    int l_ = (int)__builtin_amdgcn_mbcnt_hi(~0u, __builtin_amdgcn_mbcnt_lo(~0u, 0u)); asm volatile("" : "+v"(l_));
    int w_ = F.wave0; asm volatile("" : "+s"(w_));
    F.lane = l_; F.wave = w_; F.tid = w_ * 64 + l_;
    int b_ = blockIdx.x; asm volatile("" : "+s"(b_)); F.bid = b_;
    GAS unsigned char* w2_ = (GAS unsigned char*)F.ws0; asm volatile("" : "+s"(w2_)); F.ws = (unsigned char*)w2_;
    F.out = F.out0; F.pa = F.pa0;
    return true;
}
struct Item { int b, s, row0, seqbase, t0, seqlen; bool is_ctx; };
__device__ __forceinline__ Item item_info(int item) {
    Item it; it.b = item / SPB; it.s = item % SPB;
    if (it.s < 2) { it.is_ctx = true; it.seqbase = NLAT + it.b * CTXL; it.t0 = it.s * CHK; it.seqlen = CTXL; }
    else { it.is_ctx = false; it.seqbase = it.b * SEQ; it.t0 = (it.s - 2) * CHK; it.seqlen = SEQ; }
    it.row0 = it.seqbase + it.t0; return it;
}
constexpr int UCP = 144;
constexpr int TP = 272;
constexpr int TILEB = 128 * TP;
constexpr int VP = 288;
constexpr int TILEV = 128 * VP;

__device__ __forceinline__ unsigned tr_lane_addr(ldsp_t tile, int lane) { return (unsigned)(__SIZE_TYPE__)tile + (unsigned)((4 * (lane >> 4) + ((lane & 15) >> 2)) * VP + 8 * (lane & 3)); }
__device__ __forceinline__ bf16x8 mk_frag(u32x2 lo, u32x2 hi) { const u32x4 v = {lo.x, lo.y, hi.x, hi.y}; return __builtin_bit_cast(bf16x8, v); }
template <int OFF> __device__ __forceinline__ bf16x8 tr1(unsigned addr) {
    u32x2 a0, a1;
    asm volatile("ds_read_b64_tr_b16 %0, %2 offset:%3\n\tds_read_b64_tr_b16 %1, %2 offset:%4\n\ts_waitcnt lgkmcnt(0)" : "=&v"(a0), "=&v"(a1) : "v"(addr), "i"(OFF), "i"(OFF + 16 * VP) : "memory");
    return mk_frag(a0, a1);
}
template <int OFF> __device__ __forceinline__ void tr4(unsigned addr, bf16x8& f0, bf16x8& f1, bf16x8& f2, bf16x8& f3) {
    u32x2 a0, a1, b0, b1, c0, c1, d0, d1;
    asm volatile("ds_read_b64_tr_b16 %0, %8 offset:%9\n\tds_read_b64_tr_b16 %1, %8 offset:%10\n\tds_read_b64_tr_b16 %2, %8 offset:%11\n\tds_read_b64_tr_b16 %3, %8 offset:%12\n\t"
                 "ds_read_b64_tr_b16 %4, %8 offset:%13\n\tds_read_b64_tr_b16 %5, %8 offset:%14\n\tds_read_b64_tr_b16 %6, %8 offset:%15\n\tds_read_b64_tr_b16 %7, %8 offset:%16\n\ts_waitcnt lgkmcnt(0)"
                 : "=&v"(a0), "=&v"(a1), "=&v"(b0), "=&v"(b1), "=&v"(c0), "=&v"(c1), "=&v"(d0), "=&v"(d1)
                 : "v"(addr), "i"(OFF), "i"(OFF + 16 * VP), "i"(OFF + 32), "i"(OFF + 32 + 16 * VP), "i"(OFF + 64), "i"(OFF + 64 + 16 * VP), "i"(OFF + 96), "i"(OFF + 96 + 16 * VP) : "memory");
    f0 = mk_frag(a0, a1); f1 = mk_frag(b0, b1); f2 = mk_frag(c0, c1); f3 = mk_frag(d0, d1);
}

__device__ __forceinline__ void build_decay(Frame& F, int l) {
    LAS float* dec = (LAS float*)(F.lds + LDS_DEC);
    for (int i = F.tid; i < 2 * 4 * 132; i += NTHREADS) { const int n = i % 132, dh = i / 132; const float x = F.pa->in[I_RETDEC][l * 8 + dh]; const float lg = -log1pf(expf(-x)); dec[i] = expf((float)n * lg); }
}

struct RgStep { bf16x8 bwa[2], bwx[2]; float lam, ba, bx, carry; };
template <bool FINAL>
__device__ __forceinline__ void rg_load_step(RgStep& R, Frame& F, const bf16_t* wgt, int l, int dir, int item, int blk, int n, int lane) {
    const int fr = lane & 15, fq = lane >> 4;
    const bf16_t* wa = wgt + ((size_t)(0 * 8 + blk) * 64 + 16 * n + fr) * 64 + 8 * fq;
    const bf16_t* wx = wgt + ((size_t)(1 * 8 + blk) * 64 + 16 * n + fr) * 64 + 8 * fq;
    R.bwa[0] = *(const bf16x8*)wa; R.bwa[1] = *(const bf16x8*)(wa + 32); R.bwx[0] = *(const bf16x8*)wx; R.bwx[1] = *(const bf16x8*)(wx + 32);
    const int ch = blk * 64 + 16 * n + fr, pi = (l * 2 + dir) * 512 + ch;
    R.lam = F.pa->in[I_RGLAM][pi]; R.ba = F.pa->in[I_RGBA][pi]; R.bx = F.pa->in[I_RGBX][pi];
    R.carry = FINAL ? ((const float*)(F.ws + WS_CARRY))[((size_t)item * 2 + dir) * 512 + ch] : 0.f;
}
template <bool FINAL, int DIR>
__device__ __forceinline__ void rg_dir(ldsp_t ucw, const bf16x8 (&af)[8][2], const RgStep& R, int n, int lane, f32x4 (&hsum)[8], float& Atot, float& Htot) {
    const int fr = lane & 15, fq = lane >> 4;
    constexpr float L2E_ = 1.4426950408889634f;
    const float ba2 = -L2E_ * R.ba, bx2 = -L2E_ * R.bx, cl2 = -8.0f * L2E_ * log1pf(expf(-R.lam)), carry = R.carry;
    const bf16x8 bwa[2] = {R.bwa[0], R.bwa[1]}, bwx[2] = {R.bwx[0], R.bwx[1]};
    f32x4 ar[8], ai[8];
#pragma unroll
    for (int m = 0; m < 8; ++m) { ar[m] = zero4(); ai[m] = zero4(); }
#pragma unroll
    for (int m = 0; m < 8; ++m)
#pragma unroll
        for (int ks = 0; ks < 2; ++ks) { ar[m] = __builtin_amdgcn_mfma_f32_16x16x32_bf16(af[m][ks], bwa[ks], ar[m], 0, 0, 0); ai[m] = __builtin_amdgcn_mfma_f32_16x16x32_bf16(af[m][ks], bwx[ks], ai[m], 0, 0, 0); }
    const unsigned uo = (unsigned)(32 * fq * UCP + (16 * n + fr) * 2);
#pragma unroll
    for (int m = 0; m < 8; ++m)
#pragma unroll
        for (int jj = 0; jj < 4; ++jj) {
            const float r = __builtin_amdgcn_rcpf(1.0f + __builtin_amdgcn_exp2f(__builtin_fmaf(ar[m][jj], -1.4426950408889634f, ba2)));
            const float ig = __builtin_amdgcn_rcpf(1.0f + __builtin_amdgcn_exp2f(__builtin_fmaf(ai[m][jj], -1.4426950408889634f, bx2)));
            const float a = __builtin_amdgcn_exp2f(cl2 * r);
            const float u = bf2f(*(const LAS bf16_t*)(ucw + uo + (4 * m + jj) * UCP));
            ar[m][jj] = a; ai[m][jj] = __builtin_amdgcn_sqrtf(__builtin_fmaf(-a, a, 1.0f)) * ig * u; }
    float gA = 1.f, gH = 0.f;
#pragma unroll
    for (int mm = 0; mm < 8; ++mm) { const int m = DIR ? 7 - mm : mm;
#pragma unroll
        for (int j4 = 0; j4 < 4; ++j4) { const int jj = DIR ? 3 - j4 : j4; gH = __builtin_fmaf(ar[m][jj], gH, ai[m][jj]); gA *= ar[m][jj]; } }
    const float A0 = lane_bcast(gA, fr), H0 = lane_bcast(gH, fr), A1 = lane_bcast(gA, fr + 16), H1 = lane_bcast(gH, fr + 16), A2 = lane_bcast(gA, fr + 32), H2 = lane_bcast(gH, fr + 32), A3 = lane_bcast(gA, fr + 48), H3 = lane_bcast(gH, fr + 48);
    if (FINAL) { float h = carry;
        if (!DIR) { if (fq > 0) h = A0 * h + H0; if (fq > 1) h = A1 * h + H1; if (fq > 2) h = A2 * h + H2; }
        else { if (fq < 3) h = A3 * h + H3; if (fq < 2) h = A2 * h + H2; if (fq < 1) h = A1 * h + H1; }
#pragma unroll
        for (int mm = 0; mm < 8; ++mm) { const int m = DIR ? 7 - mm : mm;
#pragma unroll
            for (int j4 = 0; j4 < 4; ++j4) { const int jj = DIR ? 3 - j4 : j4; h = __builtin_fmaf(ar[m][jj], h, ai[m][jj]); hsum[m][jj] += h; } } }
    if (!DIR) Htot = A3 * (A2 * (A1 * H0 + H1) + H2) + H3; else Htot = A0 * (A1 * (A2 * H3 + H2) + H1) + H0;
    Atot = (A0 * A1) * (A2 * A3);
}
template <bool FINAL>
__device__ __forceinline__ void rg_part(Frame& F, int l, int item, const Item& it, const int blk, const int n0, const int n1) {
    const bf16_t* P = (const bf16_t*)(F.ws + WS_PA);
    int lane = F.lane;
    ldsp_t ucw = F.lds + F.wave * (128 * UCP);
    { const int grp = lane & 7, ch0 = blk * 64 + grp * 8; float cw[4][8], cb[8];
#pragma unroll
      for (int k = 0; k < 4; ++k)
#pragma unroll
          for (int i = 0; i < 8; ++i) cw[k][i] = F.pa->in[I_CONVW][((size_t)l * 4 + k) * 512 + ch0 + i];
#pragma unroll
      for (int i = 0; i < 8; ++i) cb[i] = F.pa->in[I_CONVB][l * 512 + ch0 + i];
      const bf16_t* Pu = P + (size_t)it.seqbase * INW + ch0;
#pragma unroll 8
      for (int q = 0; q < 16; ++q) { const int token = (lane >> 3) + 8 * q; float o[8];
#pragma unroll
          for (int i = 0; i < 8; ++i) o[i] = cb[i];
#pragma unroll
          for (int k = 0; k < 4; ++k) { const int tt = it.t0 + token + k - 2; const int tc = tt < 0 ? 0 : (tt >= it.seqlen ? it.seqlen - 1 : tt);
              u32x4 v = ldg<u32x4>(Pu, (unsigned)tc * (unsigned)(INW * 2)); if (tt != tc) v = (u32x4){0u, 0u, 0u, 0u};
              o[0] += cw[k][0] * bf2f(v.x & 0xffffu); o[1] += cw[k][1] * __uint_as_float(v.x & 0xffff0000u); o[2] += cw[k][2] * bf2f(v.y & 0xffffu); o[3] += cw[k][3] * __uint_as_float(v.y & 0xffff0000u);
              o[4] += cw[k][4] * bf2f(v.z & 0xffffu); o[5] += cw[k][5] * __uint_as_float(v.z & 0xffff0000u); o[6] += cw[k][6] * bf2f(v.w & 0xffffu); o[7] += cw[k][7] * __uint_as_float(v.w & 0xffff0000u); }
          u32x4 w; w.x = pk2(o[0], o[1]); w.y = pk2(o[2], o[3]); w.z = pk2(o[4], o[5]); w.w = pk2(o[6], o[7]);
          *(LAS u32x4*)(ucw + token * UCP + grp * 16) = w; }
      LDS_WAIT(); asm volatile("" ::: "memory"); }
    asm volatile("" : "+v"(lane));
    bf16x8 af[8][2];
    { const int fr = lane & 15, fq = lane >> 4;
#pragma unroll
      for (int m = 0; m < 8; ++m)
#pragma unroll
          for (int ks = 0; ks < 2; ++ks) af[m][ks] = *(const LAS bf16x8*)(ucw + (32 * (fr >> 2) + 4 * m + (fr & 3)) * UCP + (8 * fq + 32 * ks) * 2); }
    const bf16_t* wg0 = (const bf16_t*)(F.ws + WS_RGW) + (size_t)(l * 2 + 0) * 2 * 8 * 4096;
    const bf16_t* wg1 = (const bf16_t*)(F.ws + WS_RGW) + (size_t)(l * 2 + 1) * 2 * 8 * 4096;
    float* TOT = (float*)(F.ws + WS_TOT);
    RgStep R0, R1;
    rg_load_step<FINAL>(R0, F, wg0, l, 0, item, blk, n0, lane);
#pragma unroll 1
    for (int n = n0; n < n1; ++n) { asm volatile("" : "+v"(lane));
        const int fr = lane & 15, fq = lane >> 4; const int ch = blk * 64 + 16 * n + fr;
        f32x4 hsum[8];
#pragma unroll
        for (int m = 0; m < 8; ++m) hsum[m] = zero4();
        rg_load_step<FINAL>(R1, F, wg1, l, 1, item, blk, n, lane);
        { float At, Ht;
          rg_dir<FINAL, 0>(ucw, af, R0, n, lane, hsum, At, Ht);
          if (!FINAL && fq == 0) { *(f32x2*)(TOT + (((size_t)item * 2 + 0) * 512 + ch) * 2) = (f32x2){At, Ht}; } }
        __builtin_amdgcn_sched_barrier(0);
        if (n + 1 < n1) rg_load_step<FINAL>(R0, F, wg0, l, 0, item, blk, n + 1, lane);
        { float At, Ht;
          rg_dir<FINAL, 1>(ucw, af, R1, n, lane, hsum, At, Ht);
          if (!FINAL && fq == 0) { *(f32x2*)(TOT + (((size_t)item * 2 + 1) * 512 + ch) * 2) = (f32x2){At, Ht}; } }
        if (FINAL) {
            const unsigned uo = (unsigned)(32 * fq * UCP + (16 * n + fr) * 2);
#pragma unroll
            for (int m = 0; m < 8; ++m)
#pragma unroll
                for (int jj = 0; jj < 4; ++jj) *(LAS bf16_t*)(ucw + uo + (4 * m + jj) * UCP) = (bf16_t)f2bf(hsum[m][jj]); }
    }
    if (FINAL) {
        LDS_WAIT(); asm volatile("" : "+v"(lane) :: "memory");
        const int ng = 2 * (n1 - n0);
        const int grp = 2 * n0 + ((ng == 8) ? (lane & 7) : (lane & 1)); const int tk0 = (ng == 8) ? (lane >> 3) : (lane >> 1), tstep = (ng == 8) ? 8 : 32, nq = (ng == 8) ? 16 : 4;
        const bf16_t* Pg = P + (size_t)it.row0 * INW + 512 + blk * 64 + grp * 8; bf16_t* Yo = (bf16_t*)(F.ws + WS_Y) + (size_t)it.row0 * D + blk * 64 + grp * 8;
#pragma unroll 8
        for (int q = 0; q < nq; ++q) { const int token = tk0 + tstep * q;
            const u32x4 hv = *(const LAS u32x4*)(ucw + token * UCP + grp * 16); const u32x4 gv = ldg<u32x4>(Pg, (unsigned)token * (unsigned)(INW * 2));
            u32x4 w;
            w.x = pk2(gelu_tanh(bf2f(gv.x & 0xffffu)) * bf2f(hv.x & 0xffffu), gelu_tanh(__uint_as_float(gv.x & 0xffff0000u)) * __uint_as_float(hv.x & 0xffff0000u));
            w.y = pk2(gelu_tanh(bf2f(gv.y & 0xffffu)) * bf2f(hv.y & 0xffffu), gelu_tanh(__uint_as_float(gv.y & 0xffff0000u)) * __uint_as_float(hv.y & 0xffff0000u));
            w.z = pk2(gelu_tanh(bf2f(gv.z & 0xffffu)) * bf2f(hv.z & 0xffffu), gelu_tanh(__uint_as_float(gv.z & 0xffff0000u)) * __uint_as_float(hv.z & 0xffff0000u));
            w.w = pk2(gelu_tanh(bf2f(gv.w & 0xffffu)) * bf2f(hv.w & 0xffffu), gelu_tanh(__uint_as_float(gv.w & 0xffff0000u)) * __uint_as_float(hv.w & 0xffff0000u));
            stg<u32x4>(Yo, (unsigned)token * (unsigned)(D * 2), w); }
        LDS_WAIT();
    }
}

__device__ __forceinline__ void stage_rows(Frame& F, ldsp_t dst, const Item& it, int col0, bool rope) {
    const bf16_t* P = (const bf16_t*)(F.ws + WS_PA); const float* ct = (const float*)(F.ws + WS_ROPE); const float* st = ct + 4096 * 64;
    for (int task = F.tid; task < 1024; task += NTHREADS) { const int token = task >> 3, d0 = (task & 7) * 8;
        const bf16_t* src = P + (size_t)(it.row0 + token) * INW + col0;
        const u32x4 lo = *(const u32x4*)(src + d0), hi = *(const u32x4*)(src + d0 + 64);
        u32x4 olo = lo, ohi = hi;
        if (rope) { const int pos = it.t0 + token; const f32x4 c0 = *(const f32x4*)(ct + pos * 64 + d0), c1 = *(const f32x4*)(ct + pos * 64 + d0 + 4), s0 = *(const f32x4*)(st + pos * 64 + d0), s1 = *(const f32x4*)(st + pos * 64 + d0 + 4);
            const float a[8] = {bf2f(lo.x & 0xffffu), __uint_as_float(lo.x & 0xffff0000u), bf2f(lo.y & 0xffffu), __uint_as_float(lo.y & 0xffff0000u), bf2f(lo.z & 0xffffu), __uint_as_float(lo.z & 0xffff0000u), bf2f(lo.w & 0xffffu), __uint_as_float(lo.w & 0xffff0000u)};
            const float b[8] = {bf2f(hi.x & 0xffffu), __uint_as_float(hi.x & 0xffff0000u), bf2f(hi.y & 0xffffu), __uint_as_float(hi.y & 0xffff0000u), bf2f(hi.z & 0xffffu), __uint_as_float(hi.z & 0xffff0000u), bf2f(hi.w & 0xffffu), __uint_as_float(hi.w & 0xffff0000u)};
            const float c[8] = {c0.x, c0.y, c0.z, c0.w, c1.x, c1.y, c1.z, c1.w}, s[8] = {s0.x, s0.y, s0.z, s0.w, s1.x, s1.y, s1.z, s1.w};
            float ra[8], rb[8];
#pragma unroll
            for (int i = 0; i < 8; ++i) { ra[i] = a[i] * c[i] - b[i] * s[i]; rb[i] = a[i] * s[i] + b[i] * c[i]; }
            olo.x = pk2(ra[0], ra[1]); olo.y = pk2(ra[2], ra[3]); olo.z = pk2(ra[4], ra[5]); olo.w = pk2(ra[6], ra[7]);
            ohi.x = pk2(rb[0], rb[1]); ohi.y = pk2(rb[2], rb[3]); ohi.z = pk2(rb[4], rb[5]); ohi.w = pk2(rb[6], rb[7]); }
        *(LAS u32x4*)(dst + token * TP + d0 * 2) = olo; *(LAS u32x4*)(dst + token * TP + (d0 + 64) * 2) = ohi; }
}
__device__ __forceinline__ void stage_cols(Frame& F, ldsp_t dst, const Item& it, int col0) {
    const bf16_t* P = (const bf16_t*)(F.ws + WS_PA);
    for (int task = F.tid; task < 2048; task += NTHREADS) { const int token = task >> 4, d0 = (task & 15) * 8;
        const u32x4 v = *(const u32x4*)(P + (size_t)(it.row0 + token) * INW + col0 + d0);
        const unsigned w[4] = {v.x, v.y, v.z, v.w};
#pragma unroll
        for (int i = 0; i < 4; ++i) { *(LAS bf16_t*)(dst + (d0 + 2 * i) * TP + token * 2) = (bf16_t)(w[i] & 0xffffu); *(LAS bf16_t*)(dst + (d0 + 2 * i + 1) * TP + token * 2) = (bf16_t)(w[i] >> 16); } }
}
__device__ __forceinline__ void rope8(u32x4& lo, u32x4& hi, const float* ct, const float* st, int pos, int d0) {
    const f32x4 c0 = *(const f32x4*)(ct + pos * 64 + d0), c1 = *(const f32x4*)(ct + pos * 64 + d0 + 4), s0 = *(const f32x4*)(st + pos * 64 + d0), s1 = *(const f32x4*)(st + pos * 64 + d0 + 4);
    const float a[8] = {bf2f(lo.x & 0xffffu), __uint_as_float(lo.x & 0xffff0000u), bf2f(lo.y & 0xffffu), __uint_as_float(lo.y & 0xffff0000u), bf2f(lo.z & 0xffffu), __uint_as_float(lo.z & 0xffff0000u), bf2f(lo.w & 0xffffu), __uint_as_float(lo.w & 0xffff0000u)};
    const float b[8] = {bf2f(hi.x & 0xffffu), __uint_as_float(hi.x & 0xffff0000u), bf2f(hi.y & 0xffffu), __uint_as_float(hi.y & 0xffff0000u), bf2f(hi.z & 0xffffu), __uint_as_float(hi.z & 0xffff0000u), bf2f(hi.w & 0xffffu), __uint_as_float(hi.w & 0xffff0000u)};
    const float c[8] = {c0.x, c0.y, c0.z, c0.w, c1.x, c1.y, c1.z, c1.w}, sn[8] = {s0.x, s0.y, s0.z, s0.w, s1.x, s1.y, s1.z, s1.w};
    float ra[8], rb[8];
#pragma unroll
    for (int i = 0; i < 8; ++i) { ra[i] = a[i] * c[i] - b[i] * sn[i]; rb[i] = a[i] * sn[i] + b[i] * c[i]; }
    lo = (u32x4){pk2(ra[0], ra[1]), pk2(ra[2], ra[3]), pk2(ra[4], ra[5]), pk2(ra[6], ra[7])};
    hi = (u32x4){pk2(rb[0], rb[1]), pk2(rb[2], rb[3]), pk2(rb[4], rb[5]), pk2(rb[6], rb[7])};
}
struct KvRegs { u32x4 klo[2], khi[2], v[4]; };
__device__ __forceinline__ void kv_issue(Frame& F, KvRegs& R, const Item& it, int h) {
    const bf16_t* P = (const bf16_t*)(F.ws + WS_PA);
    const bf16_t* Pk = P + (size_t)it.row0 * INW + 1536 + h * HD; const bf16_t* Pv = P + (size_t)it.row0 * INW + 2048 + h * HD;
#pragma unroll
    for (int t2 = 0; t2 < 2; ++t2) { const int task = F.tid + t2 * NTHREADS, token = task >> 3, d0 = (task & 7) * 8;
        R.klo[t2] = ldg<u32x4>(Pk, (unsigned)(token * INW + d0) * 2u); R.khi[t2] = ldg<u32x4>(Pk, (unsigned)(token * INW + d0 + 64) * 2u); }
#pragma unroll
    for (int t4 = 0; t4 < 4; ++t4) { const int task = F.tid + t4 * NTHREADS, token = task >> 4, d0 = (task & 15) * 8; R.v[t4] = ldg<u32x4>(Pv, (unsigned)(token * INW + d0) * 2u); }
}
template <int KS> __device__ __forceinline__ void kv_step(unsigned aK, unsigned aVf, unsigned aVb, f32x4 (&accf)[8], f32x4 (&accb)[8]) {
    const bf16x8 af = tr1<KS * 32 * VP>(aVf), ab = tr1<KS * 32 * VP>(aVb);
    bf16x8 b[8];
    tr4<KS * 32 * VP>(aK, b[0], b[1], b[2], b[3]); tr4<KS * 32 * VP + 128>(aK, b[4], b[5], b[6], b[7]);
#pragma unroll
    for (int n = 0; n < 8; ++n) { accf[n] = __builtin_amdgcn_mfma_f32_16x16x32_bf16(af, b[n], accf[n], 0, 0, 0); accb[n] = __builtin_amdgcn_mfma_f32_16x16x32_bf16(ab, b[n], accb[n], 0, 0, 0); }
}
__device__ __forceinline__ void stage_state_t(Frame& F, ldsp_t dst, const bf16_t* St) {
#pragma unroll
    for (int t4 = 0; t4 < 4; ++t4) { const int task = F.tid + t4 * NTHREADS, e = task >> 4, c8 = task & 15;
        *(LAS u32x4*)(dst + e * TP + c8 * 16) = ldg<u32x4>(St, (unsigned)(e * 128 + c8 * 8) * 2u); }
}
__device__ __forceinline__ void mm16x128(ldsp_t At, int ra0, ldsp_t Bt, int lane, f32x4 (&acc)[8]) {
    const int fr = lane & 15, fq = lane >> 4;
#pragma unroll
    for (int ks = 0; ks < 4; ++ks) { const bf16x8 a = *(const LAS bf16x8*)(At + (ra0 + fr) * TP + (32 * ks + 8 * fq) * 2);
#pragma unroll
        for (int n = 0; n < 8; ++n) { const bf16x8 b = *(const LAS bf16x8*)(Bt + (16 * n + fr) * TP + (32 * ks + 8 * fq) * 2); acc[n] = __builtin_amdgcn_mfma_f32_16x16x32_bf16(a, b, acc[n], 0, 0, 0); } }
}

__device__ __forceinline__ void kv_head(Frame& F, KvRegs& R, KvRegs& Rn, bool pre, int item, const Item& it, int h) {
    bf16_t* KV = (bf16_t*)(F.ws + WS_KV);
    const float* ct = (const float*)(F.ws + WS_ROPE); const float* st = ct + 4096 * 64;
    const LAS float* dec = (const LAS float*)(F.lds + LDS_DEC); const bool rope = !it.is_ctx;
    ldsp_t tK = F.lds, tVf = F.lds + TILEV, tVb = F.lds + 2 * TILEV;
#pragma unroll
    for (int t2 = 0; t2 < 2; ++t2) { const int task = F.tid + t2 * NTHREADS, token = task >> 3, d0 = (task & 7) * 8;
        if (rope) rope8(R.klo[t2], R.khi[t2], ct, st, it.t0 + token, d0);
        *(LAS u32x4*)(tK + token * VP + d0 * 2) = R.klo[t2]; *(LAS u32x4*)(tK + token * VP + (d0 + 64) * 2) = R.khi[t2]; }
#pragma unroll
    for (int t4 = 0; t4 < 4; ++t4) { const int task = F.tid + t4 * NTHREADS, token = task >> 4, d0 = (task & 15) * 8; const u32x4 v = R.v[t4];
        const float df = dec[(0 * 4 + h) * 132 + 127 - token], db = dec[(1 * 4 + h) * 132 + token];
        const float x[8] = {bf2f(v.x & 0xffffu), __uint_as_float(v.x & 0xffff0000u), bf2f(v.y & 0xffffu), __uint_as_float(v.y & 0xffff0000u), bf2f(v.z & 0xffffu), __uint_as_float(v.z & 0xffff0000u), bf2f(v.w & 0xffffu), __uint_as_float(v.w & 0xffff0000u)};
        u32x4 wf, wb; wf.x = pk2(x[0] * df, x[1] * df); wf.y = pk2(x[2] * df, x[3] * df); wf.z = pk2(x[4] * df, x[5] * df); wf.w = pk2(x[6] * df, x[7] * df);
        wb.x = pk2(x[0] * db, x[1] * db); wb.y = pk2(x[2] * db, x[3] * db); wb.z = pk2(x[4] * db, x[5] * db); wb.w = pk2(x[6] * db, x[7] * db);
        *(LAS u32x4*)(tVf + token * VP + d0 * 2) = wf; *(LAS u32x4*)(tVb + token * VP + d0 * 2) = wb; }
    WG_BAR_LDS();
    if (pre) kv_issue(F, Rn, it, h + 1);
    f32x4 af[8], ab[8];
#pragma unroll
    for (int n = 0; n < 8; ++n) { af[n] = zero4(); ab[n] = zero4(); }
    { const unsigned aK = tr_lane_addr(tK, F.lane), aVf = tr_lane_addr(tVf, F.lane) + 32u * (unsigned)F.wave, aVb = tr_lane_addr(tVb, F.lane) + 32u * (unsigned)F.wave;
      kv_step<0>(aK, aVf, aVb, af, ab); kv_step<1>(aK, aVf, aVb, af, ab); kv_step<2>(aK, aVf, aVb, af, ab); kv_step<3>(aK, aVf, aVb, af, ab); }
    const int fr = F.lane & 15, fq = F.lane >> 4;
    bf16_t* of = KV + (((size_t)item * 4 + h) * 2 + 0) * 16384 + (size_t)(16 * F.wave) * 128;
    unsigned so = (unsigned)((4 * fq) * 128 + fr) * 2u; asm volatile("" : "+v"(so));
#pragma unroll
    for (int n = 0; n < 8; ++n)
#pragma unroll
        for (int jj = 0; jj < 4; ++jj) { stg<bf16_t>(of, so + (unsigned)((jj * 128 + 16 * n) * 2), (bf16_t)f2bf(af[n][jj])); stg<bf16_t>(of, so + (unsigned)((16384 + jj * 128 + 16 * n) * 2), (bf16_t)f2bf(ab[n][jj])); }
    WG_BAR_LDS();
}
__device__ __forceinline__ int latent_item(int c) { return (c >> 5) * SPB + 2 + (c & 31); }
__device__ __forceinline__ int ctx_item(int ci) { return (ci >> 1) * SPB + (ci & 1); }
__device__ __forceinline__ void phase_m1(Frame& F, int l) {
    build_decay(F, l); __syncthreads();
    for (int c = F.bid; c < 256; c += F.G) {
        fresh(F);
        { const int item = latent_item(c); const Item it = item_info(item);
          rg_part<false>(F, l, item, it, F.wave, 0, 4);
          __syncthreads();
          KvRegs A, B;
          fresh(F); kv_issue(F, A, it, 0);
          kv_head(F, A, B, true, item, it, 0);
          fresh(F); kv_head(F, B, A, true, item, it, 1);
          fresh(F); kv_head(F, A, B, true, item, it, 2);
          fresh(F); kv_head(F, B, A, false, item, it, 3); }
        fresh(F);
        { const int u = (c - 64) * 3 + F.wave;
          if (c >= 64 && F.wave < 3 && u < 512) { const int item = ctx_item(u >> 5); const Item it = item_info(item); rg_part<false>(F, l, item, it, (u >> 2) & 7, u & 3, (u & 3) + 1); } }
        __syncthreads();
        if (c < 64) { const int item = ctx_item(c >> 2); const Item it = item_info(item); KvRegs A, B; fresh(F); kv_issue(F, A, it, c & 3); kv_head(F, A, B, false, item, it, c & 3); }
    }
}
__device__ __forceinline__ int seq_order(int dir, int step) { return dir ? (step == 0 ? 1 : (step == 1 ? 0 : 35 - step)) : step; }
__device__ __forceinline__ void phase_m2(Frame& F, int l) {
    bf16_t* KV = (bf16_t*)(F.ws + WS_KV);
    const int gt = F.bid * NTHREADS + F.tid, NGT = F.G * NTHREADS;
    for (int c = gt; c < NB * NH * 2 * 128 * 16; c += NGT) {
        const int dc = c & 15, e = (c >> 4) & 127, dir = (c >> 11) & 1, h = (c >> 12) & 3, b = c >> 14;
        const float x = F.pa->in[I_RETDEC][l * 8 + dir * 4 + h]; const float decay = expf(128.0f * (-log1pf(expf(-x))));
        float S[8];
#pragma unroll
        for (int i = 0; i < 8; ++i) S[i] = 0.f;
        const unsigned lo = (unsigned)((((h * 2 + dir) * 128 + e) * 128 + dc * 8) * 2);
        for (int g0 = 0; g0 < SPB; g0 += 17) {
            u32x4 v[17];
#pragma unroll
            for (int i = 0; i < 17; ++i) { const int item = b * SPB + seq_order(dir, g0 + i); v[i] = ldg<u32x4>(KV + (size_t)item * 4 * 2 * 16384, lo); }
#pragma unroll
            for (int i = 0; i < 17; ++i) { const int item = b * SPB + seq_order(dir, g0 + i);
                u32x4 w; w.x = pk2(S[0], S[1]); w.y = pk2(S[2], S[3]); w.z = pk2(S[4], S[5]); w.w = pk2(S[6], S[7]);
                stg<u32x4>(KV + (size_t)item * 4 * 2 * 16384, lo, w);
                S[0] = S[0] * decay + bf2f(v[i].x & 0xffffu); S[1] = S[1] * decay + __uint_as_float(v[i].x & 0xffff0000u); S[2] = S[2] * decay + bf2f(v[i].y & 0xffffu); S[3] = S[3] * decay + __uint_as_float(v[i].y & 0xffff0000u);
                S[4] = S[4] * decay + bf2f(v[i].z & 0xffffu); S[5] = S[5] * decay + __uint_as_float(v[i].z & 0xffff0000u); S[6] = S[6] * decay + bf2f(v[i].w & 0xffffu); S[7] = S[7] * decay + __uint_as_float(v[i].w & 0xffff0000u); }
        }
    }
    const float* TOT = (const float*)(F.ws + WS_TOT); float* CARRY = (float*)(F.ws + WS_CARRY);
    for (int c = gt; c < NB * 2 * 512; c += NGT) { const int ch = c & 511, dir = (c >> 9) & 1, b = c >> 10; float cr = 0.f;
        for (int step = 0; step < SPB; ++step) { const int item = b * SPB + seq_order(dir, step); const f32x2 ah = *(const f32x2*)(TOT + (((size_t)item * 2 + dir) * 512 + ch) * 2);
            CARRY[((size_t)item * 2 + dir) * 512 + ch] = cr; cr = ah.x * cr + ah.y; } }
}
struct RetRegs { u32x4 v[4], sf[4], sb[4], klo[2], khi[2], g[4]; };
__device__ __forceinline__ void ret_issue(Frame& F, RetRegs& R, int item, const Item& it, int h) {
    const bf16_t* KV = (const bf16_t*)(F.ws + WS_KV); const bf16_t* P = (const bf16_t*)(F.ws + WS_PA);
    const bf16_t* Pk = P + (size_t)it.row0 * INW + 1536 + h * HD; const bf16_t* Pv = P + (size_t)it.row0 * INW + 2048 + h * HD;
    const bf16_t* Sf = KV + (((size_t)item * 4 + h) * 2 + 0) * 16384; const bf16_t* Sb = Sf + 16384;
    const int lane = F.lane, i0 = 16 * F.wave;
#pragma unroll
    for (int t2 = 0; t2 < 2; ++t2) { const int task = F.tid + t2 * NTHREADS, token = task >> 3, d0 = (task & 7) * 8;
        R.klo[t2] = ldg<u32x4>(Pk, (unsigned)(token * INW + d0) * 2u); R.khi[t2] = ldg<u32x4>(Pk, (unsigned)(token * INW + d0 + 64) * 2u); }
#pragma unroll
    for (int t4 = 0; t4 < 4; ++t4) { const int task = F.tid + t4 * NTHREADS, r = task >> 4, c8 = task & 15;
        R.v[t4] = ldg<u32x4>(Pv, (unsigned)(r * INW + c8 * 8) * 2u); R.sf[t4] = ldg<u32x4>(Sf, (unsigned)(r * 128 + c8 * 8) * 2u); R.sb[t4] = ldg<u32x4>(Sb, (unsigned)(r * 128 + c8 * 8) * 2u); }
    { const bf16_t* Pg = P + (size_t)(it.row0 + i0) * INW + 2560 + h * HD;
#pragma unroll
      for (int k = 0; k < 4; ++k) R.g[k] = ldg<u32x4>(Pg, (unsigned)((lane >> 2) * INW + 32 * (lane & 3) + 8 * k) * 2u); }
}
__device__ __forceinline__ void ret_head(Frame& F, RetRegs& R, RetRegs& Rn, bool pre, int item, const Item& it, int h) {
    bf16_t* Y = (bf16_t*)(F.ws + WS_Y);
    const float* ct = (const float*)(F.ws + WS_ROPE); const float* st = ct + 4096 * 64;
    const LAS float* dec = (const LAS float*)(F.lds + LDS_DEC);
    ldsp_t tK = F.lds, tV = F.lds + TILEB, tSf = tV + TILEV, tSb = tSf + TILEB;
    const bool rope = !it.is_ctx;
    const int lane = F.lane, fr = lane & 15, fq = lane >> 4, i0 = 16 * F.wave;
    u32x4 q4[4];
    { const bf16_t* Pq = (const bf16_t*)(F.ws + WS_PA) + (size_t)(it.row0 + i0) * INW + 1024 + h * HD;
#pragma unroll
      for (int ks = 0; ks < 4; ++ks) q4[ks] = ldg<u32x4>(Pq, (unsigned)(fr * INW + 32 * ks + 8 * fq) * 2u); }
#pragma unroll
    for (int t2 = 0; t2 < 2; ++t2) { const int task = F.tid + t2 * NTHREADS, token = task >> 3, d0 = (task & 7) * 8;
        if (rope) rope8(R.klo[t2], R.khi[t2], ct, st, it.t0 + token, d0);
        *(LAS u32x4*)(tK + token * TP + d0 * 2) = R.klo[t2]; *(LAS u32x4*)(tK + token * TP + (d0 + 64) * 2) = R.khi[t2]; }
#pragma unroll
    for (int t4 = 0; t4 < 4; ++t4) { const int task = F.tid + t4 * NTHREADS, r = task >> 4, c8 = task & 15;
        *(LAS u32x4*)(tV + r * VP + c8 * 16) = R.v[t4]; *(LAS u32x4*)(tSf + r * TP + c8 * 16) = R.sf[t4]; *(LAS u32x4*)(tSb + r * TP + c8 * 16) = R.sb[t4]; }
    bf16x8 qf[4];
    { if (rope) { rope8(q4[0], q4[2], ct, st, it.t0 + i0 + fr, 8 * fq); rope8(q4[1], q4[3], ct, st, it.t0 + i0 + fr, 32 + 8 * fq); }
#pragma unroll
      for (int ks = 0; ks < 4; ++ks) qf[ks] = __builtin_bit_cast(bf16x8, q4[ks]); }
    u32x4 gk[4];
#pragma unroll
    for (int k = 0; k < 4; ++k) gk[k] = R.g[k];
    WG_BAR_LDS();
    if (pre) ret_issue(F, Rn, item, it, h + 1);
    bf16x8 pa[4];
    { f32x4 C[8];
#pragma unroll
      for (int jt = 0; jt < 8; ++jt) { C[jt] = zero4();
#pragma unroll
          for (int ks = 0; ks < 4; ++ks) { const bf16x8 a = *(const LAS bf16x8*)(tK + (16 * jt + fr) * TP + (32 * ks + 8 * fq) * 2); C[jt] = __builtin_amdgcn_mfma_f32_16x16x32_bf16(a, qf[ks], C[jt], 0, 0, 0); } }
      const int i = i0 + fr;
#pragma unroll
      for (int jt = 0; jt < 8; ++jt)
#pragma unroll
          for (int jj = 0; jj < 4; ++jj) { const int j = 16 * jt + 4 * fq + jj; const float dcy = (i >= j) ? dec[(0 * 4 + h) * 132 + (i - j)] : dec[(1 * 4 + h) * 132 + (j - i)]; C[jt][jj] *= dcy; }
#pragma unroll
      for (int u = 0; u < 4; ++u) { const u32x4 w = {pg8::cvt_pk_bf16(C[2 * u][0], C[2 * u][1]), pg8::cvt_pk_bf16(C[2 * u][2], C[2 * u][3]), pg8::cvt_pk_bf16(C[2 * u + 1][0], C[2 * u + 1][1]), pg8::cvt_pk_bf16(C[2 * u + 1][2], C[2 * u + 1][3])};
          pa[u] = __builtin_bit_cast(bf16x8, w); } }
    WG_BAR_LDS();
    { ldsp_t gt = tK + (i0 + (lane >> 2)) * TP + (lane & 3) * 64;
#pragma unroll
      for (int k = 0; k < 4; ++k) *(LAS u32x4*)(gt + 16 * k) = gk[k]; }
    f32x4 o[8];
#pragma unroll
    for (int n = 0; n < 8; ++n) o[n] = zero4();
    { const unsigned aV = tr_lane_addr(tV, lane); bf16x8 b[8];
#define RET_PV(U) do { tr4<(U) * 32 * VP>(aV, b[0], b[1], b[2], b[3]); tr4<(U) * 32 * VP + 128>(aV, b[4], b[5], b[6], b[7]); \
        _Pragma("unroll") for (int n = 0; n < 8; ++n) o[n] = __builtin_amdgcn_mfma_f32_16x16x32_bf16(pa[U], b[n], o[n], 0, 0, 0); } while (0)
      RET_PV(0); RET_PV(1); RET_PV(2); RET_PV(3);
#undef RET_PV
    }
    { f32x4 cf[8];
#pragma unroll
      for (int n = 0; n < 8; ++n) { cf[n] = zero4();
#pragma unroll
          for (int ks = 0; ks < 4; ++ks) { const bf16x8 b = *(const LAS bf16x8*)(tSf + (16 * n + fr) * TP + (32 * ks + 8 * fq) * 2); cf[n] = __builtin_amdgcn_mfma_f32_16x16x32_bf16(qf[ks], b, cf[n], 0, 0, 0); } }
#pragma unroll
      for (int jj = 0; jj < 4; ++jj) { const float sf = dec[(0 * 4 + h) * 132 + (i0 + 4 * fq + jj + 1)];
#pragma unroll
          for (int n = 0; n < 8; ++n) o[n][jj] += sf * cf[n][jj]; } }
    { f32x4 cb[8];
#pragma unroll
      for (int n = 0; n < 8; ++n) { cb[n] = zero4();
#pragma unroll
          for (int ks = 0; ks < 4; ++ks) { const bf16x8 b = *(const LAS bf16x8*)(tSb + (16 * n + fr) * TP + (32 * ks + 8 * fq) * 2); cb[n] = __builtin_amdgcn_mfma_f32_16x16x32_bf16(qf[ks], b, cb[n], 0, 0, 0); } }
#pragma unroll
      for (int jj = 0; jj < 4; ++jj) { const float sb = dec[(1 * 4 + h) * 132 + (128 - (i0 + 4 * fq + jj))];
#pragma unroll
          for (int n = 0; n < 8; ++n) o[n][jj] += sb * cb[n][jj]; } }
    { ldsp_t gc = tK + (i0 + 4 * fq) * TP + fr * 2;
#pragma unroll
      for (int jj = 0; jj < 4; ++jj) { float s1 = 0.f;
#pragma unroll
          for (int n = 0; n < 8; ++n) s1 += o[n][jj];
          s1 += swz_xor<1>(s1); s1 += swz_xor<2>(s1); s1 += swz_xor<4>(s1); s1 += swz_xor<8>(s1);
          const float mu = s1 * (1.0f / 128.0f); float q = 0.f;
#pragma unroll
          for (int n = 0; n < 8; ++n) { const float dd = o[n][jj] - mu; q += dd * dd; }
          q += swz_xor<1>(q); q += swz_xor<2>(q); q += swz_xor<4>(q); q += swz_xor<8>(q);
          const float rstd = 1.0f / sqrtf(q * (1.0f / 128.0f) + EPS);
#pragma unroll
          for (int n = 0; n < 8; ++n) { LAS bf16_t* p = (LAS bf16_t*)(gc + jj * TP + 32 * n); const float gv = bf2f(*p); *p = (bf16_t)f2bf(siluf_(gv) * (o[n][jj] - mu) * rstd); } } }
    LDS_WAIT(); asm volatile("" ::: "memory");
    { ldsp_t gt = tK + (i0 + (lane >> 2)) * TP + (lane & 3) * 64; bf16_t* Yo = Y + (size_t)(it.row0 + i0) * D + 512 + h * HD;
#pragma unroll
      for (int k = 0; k < 4; ++k) stg<u32x4>(Yo, (unsigned)((lane >> 2) * D + 32 * (lane & 3) + 8 * k) * 2u, *(const LAS u32x4*)(gt + 16 * k)); }
    WG_BAR_LDS();
}
__device__ __forceinline__ void phase_m3(Frame& F, int l) {
    build_decay(F, l); __syncthreads();
    for (int c = F.bid; c < 256; c += F.G) {
        fresh(F);
        { const int item = latent_item(c); const Item it = item_info(item);
#ifndef PROBE_M3
#define PROBE_M3 0
#endif
          for (int r_ = 0; r_ < ((PROBE_M3 & 1) ? 2 : 1); ++r_) { fresh(F); rg_part<true>(F, l, item, it, F.wave, 0, 4); }
          __syncthreads();
          for (int r_ = 0; r_ < ((PROBE_M3 & 2) ? 2 : 1); ++r_) {
          RetRegs R, Rn;
          fresh(F); ret_issue(F, R, item, it, 0);
          ret_head(F, R, Rn, true, item, it, 0);
          fresh(F); ret_head(F, Rn, R, true, item, it, 1);
          fresh(F); ret_head(F, R, Rn, true, item, it, 2);
          fresh(F); ret_head(F, Rn, R, false, item, it, 3); } }
        if (l == 0) {
            fresh(F);
            { const int u = (c - 64) * 3 + F.wave;
              if (c >= 64 && F.wave < 3 && u < 512) { const int item = ctx_item(u >> 5); const Item it = item_info(item); rg_part<true>(F, l, item, it, (u >> 2) & 7, u & 3, (u & 3) + 1); } }
            __syncthreads();
            if (c < 64) { const int item = ctx_item(c >> 2); const Item it = item_info(item); RetRegs R, Rn; fresh(F); ret_issue(F, R, item, it, c & 3); ret_head(F, R, Rn, false, item, it, c & 3); }
        }
    }
}

constexpr int N_PHASES = 24;
__global__ void __launch_bounds__(NTHREADS, 2) fwd_kernel(Args args) {
    extern __shared__ __attribute__((aligned(16))) unsigned char lds_raw[];
    Frame F; F.lds = (ldsp_t)lds_raw; F.wave0 = __builtin_amdgcn_readfirstlane((int)threadIdx.x >> 6); F.G = gridDim.x; F.pa0 = &args; F.out0 = args.out; F.ws0 = args.ws; fresh(F);
    volatile LAS unsigned* MISC = (volatile LAS unsigned*)(F.lds + LDS_MISC);
    if (F.tid < 64) MISC[F.tid] = 0u;
    __syncthreads();
    const int lo = args.ph_lo, hi = args.ph_hi;
    XcdBarrier bar; bar.bar = (unsigned*)(F.ws + WS_CTL); bar.x = 0; bar.st = nullptr;
    if (hi - lo > 1) bar = xcd_barrier_post((unsigned*)(F.ws + WS_CTL), MISC);
#ifndef DIAG_MASK
#define DIAG_MASK 0xffffffffu
#endif
#ifndef REPEAT_MASK
#define REPEAT_MASK 0u
#endif
#define REPS(kind) ((((REPEAT_MASK) >> (kind)) & 1u) ? 2 : 1)
#define INK(k, kind) (((DIAG_MASK >> (kind)) & 1u) && lo <= (k) && (k) < hi && fresh(F))
#define IN(k) (lo <= (k) && (k) < hi)
#define SEAM(k) do { if (IN(k) && IN((k) + 1)) xcd_barrier(bar); } while (0)
    float* ctxx = (float*)(F.ws + WS_CTXX); bf16_t* xb = (bf16_t*)((char*)F.out + XB_OFF);
    const float* modlat = (const float*)(F.ws + WS_MODLAT); const float* modctx = (const float*)(F.ws + WS_MODCTX);

    if (INK(0, 0)) { for (int r_ = 0; r_ < REPS(0); ++r_) { phase_convert_small(F); __syncthreads(); phase_mod(F); __syncthreads(); } } SEAM(0);
    if (INK(1, 1)) { for (int r_ = 0; r_ < REPS(1); ++r_) phase_norm(F, 0, 0, F.pa->in[I_X], nullptr, F.pa->in[I_CTX], MROWS, SlabRed{nullptr, 0, nullptr, nullptr, nullptr}); } SEAM(1);
#pragma unroll 1
    for (int l = 0; l < 2; ++l) {
        const int pb = (l == 0) ? 2 : 11;
        if (INK(pb + 0, 2)) { pg8::Gemm g{(const bf16_t*)(F.ws + WS_HX), (const bf16_t*)(F.ws + WS_WIN) + (size_t)l * INW * D, INW, D, 0, nullptr}; pg8::Order S; S.init(MROWS / 256, INW / 256, F.G, F.bid, nullptr, nullptr, D / 64, false, 0);
            pg8::EpiBf16 E{(bf16_t*)(F.ws + WS_PA), INW}; for (int r_ = 0; r_ < REPS(2); ++r_) pg8::gemm_phase<pg8::EpiBf16>(F.lds, g, S, E, F.tid); }
        SEAM(pb + 0);
        if (INK(pb + 1, 3)) { for (int r_ = 0; r_ < REPS(3); ++r_) phase_m1(F, l); }
        SEAM(pb + 1);
        if (INK(pb + 2, 4)) { for (int r_ = 0; r_ < REPS(4); ++r_) { if (r_) phase_m1(F, l); phase_m2(F, l); } }
        SEAM(pb + 2);
        if (INK(pb + 3, 5)) { for (int r_ = 0; r_ < REPS(5); ++r_) phase_m3(F, l); }
        SEAM(pb + 3);
        if (INK(pb + 4, 6)) { pg8::Gemm g{(const bf16_t*)(F.ws + WS_Y), (const bf16_t*)(F.ws + WS_WOUT) + (size_t)l * D * D, D, D, 0, (float*)(F.ws + WS_SLABA)}; pg8::Order S; S.init((l == 0 ? MROWS : NLAT) / 256, D / 256, F.G, F.bid, nullptr, nullptr, D / 64, true, MAXSLAB_A);
            pg8::EpiResid E{l == 0 ? F.pa->in[I_X] : nullptr, xb, F.pa->in[I_CTX], ctxx, modlat + (size_t)l * 8 * 6144 + 2048, modctx + (size_t)l * 6144 + 2048};
            pg8::gemm_phase<pg8::EpiResid>(F.lds, g, S, E, F.tid); }
        SEAM(pb + 4);
        if (l == 0) {
            if (INK(7, 1)) { for (int r_ = 0; r_ < REPS(1); ++r_) phase_norm(F, 0, 1, nullptr, xb, ctxx, MROWS, SlabRed{(const float*)(F.ws + WS_SLABA), pg8::split_factor((MROWS / 256) * 4, F.G, D / 64, MAXSLAB_A), modctx + 2048, F.pa->in[I_CTX], ctxx}); } SEAM(7);
            if (INK(8, 7)) { pg8::Gemm g{(const bf16_t*)(F.ws + WS_HX), (const bf16_t*)(F.ws + WS_WUP), 2 * DFF, D, 0, nullptr}; pg8::Order S; S.init(MROWS / 256, 2 * DFF / 256, F.G, F.bid, nullptr, nullptr, D / 64, false, 0);
                pg8::EpiSwiGLU E{(bf16_t*)(F.ws + WS_PA), DFF}; for (int r_ = 0; r_ < REPS(7); ++r_) pg8::gemm_phase<pg8::EpiSwiGLU>(F.lds, g, S, E, F.tid); }
            SEAM(8);
            if (INK(9, 8)) { pg8::Gemm g{(const bf16_t*)(F.ws + WS_PA), (const bf16_t*)(F.ws + WS_WDN), D, DFF, 0, (float*)(F.ws + WS_SLABA)}; pg8::Order S; S.init(MROWS / 256, D / 256, F.G, F.bid, nullptr, nullptr, DFF / 64, true, MAXSLAB_A);
                pg8::EpiResid E{nullptr, xb, (const float*)ctxx, ctxx, modlat + 5120, modctx + 5120}; pg8::gemm_phase<pg8::EpiResid>(F.lds, g, S, E, F.tid); }
            SEAM(9);
            if (INK(10, 1)) { for (int r_ = 0; r_ < REPS(1); ++r_) phase_norm(F, 1, 0, nullptr, xb, ctxx, MROWS, SlabRed{(const float*)(F.ws + WS_SLABA), pg8::split_factor((MROWS / 256) * 4, F.G, DFF / 64, MAXSLAB_A), modctx + 5120, ctxx, ctxx}); } SEAM(10);
        }
    }
    if (INK(16, 9)) { for (int r_ = 0; r_ < REPS(9); ++r_) { phase_norm_router(F, xb); __syncthreads(); phase_convert_moe(F); __syncthreads(); } } SEAM(16);
    if (INK(17, 10)) { phase_moe_sort(F); } SEAM(17);
#pragma unroll 1
    for (int k = 0; k < 2; ++k) {
        const int* meta = (const int*)(F.ws + MOE_META) + 9 * k;
        if (INK(18 + 2 * k, 11)) { if (k == 1) { moe_reduce(F, 0); __syncthreads(); } pg8::Gemm g{(const bf16_t*)(F.ws + WS_HX), (const bf16_t*)(F.ws + WS_MOEUP), 2 * DEXP, D, (size_t)2 * DEXP * D * 2, nullptr}; pg8::Order S; S.init(meta[8], 2 * DEXP / 256, F.G, F.bid, meta, (const int*)(F.ws + MOE_PTOK) + k * MROWS, D / 64, false, 0);
            pg8::EpiSwiGLU E{(bf16_t*)(F.ws + WS_PA), DEXP}; for (int r_ = 0; r_ < REPS(11); ++r_) pg8::gemm_phase<pg8::EpiSwiGLU>(F.lds, g, S, E, F.tid); }
        SEAM(18 + 2 * k);
        if (INK(19 + 2 * k, 12)) { pg8::Gemm g{(const bf16_t*)(F.ws + WS_PA), (const bf16_t*)(F.ws + WS_MOEDN), D, DEXP, (size_t)D * DEXP * 2, (float*)(F.ws + WS_SLABM)}; pg8::Order S; S.init(meta[8], D / 256, F.G, F.bid, meta, nullptr, DEXP / 64, true, MAXSLAB_M);
            pg8::EpiMoeDown E{xb, (const int*)(F.ws + MOE_PTOK) + k * MROWS, (const float*)(F.ws + MOE_PW) + k * MROWS, modlat + (size_t)8 * 6144 + 5120}; pg8::gemm_phase<pg8::EpiMoeDown>(F.lds, g, S, E, F.tid); }
        SEAM(19 + 2 * k);
    }
    if (INK(22, 13)) phase_final_a(F);
    SEAM(22);
    if (INK(23, 13)) phase_final_b(F);
#undef IN
#undef INK
#undef SEAM
}

extern "C" void kernel_launch(void* const* d_in, const int* in_sizes, int n_in, void* d_out, int out_size, void* d_ws, size_t ws_size, hipStream_t stream) {
    static int grid = 0;
    if (grid == 0) {
        if (n_in != 27 || in_sizes[0] != NLAT * D || out_size != NLAT * D || ws_size < WS_END) { fprintf(stderr, "kernel_launch: unexpected problem (n_in %d, in0 %d, out %d, ws %zu, need %zu); nothing launched\n", n_in, n_in > 0 ? in_sizes[0] : -1, out_size, ws_size, (size_t)WS_END); grid = -1; return; }
        int dev = 0, cus = 0, per_cu = 0;
        if (hipGetDevice(&dev) != hipSuccess || hipDeviceGetAttribute(&cus, hipDeviceAttributeMultiprocessorCount, dev) != hipSuccess) { grid = -1; return; }
        if (hipFuncSetAttribute((const void*)fwd_kernel, hipFuncAttributeMaxDynamicSharedMemorySize, LDS_BYTES) != hipSuccess) { fprintf(stderr, "kernel_launch: hipFuncSetAttribute failed\n"); grid = -1; return; }
        if (hipOccupancyMaxActiveBlocksPerMultiprocessor(&per_cu, (const void*)fwd_kernel, NTHREADS, LDS_BYTES) != hipSuccess || per_cu < 1) { fprintf(stderr, "kernel_launch: occupancy query says %d\n", per_cu); }
        (void)hipGetLastError();
        grid = cus;
    }
    if (grid < 0) return;
    (void)hipMemsetAsync((char*)d_ws + WS_CTL, 0, CTL_ZERO_BYTES, stream);
    Args a; memset(&a, 0, sizeof(a));
    for (int i = 0; i < 27; ++i) a.in[i] = (const float*)d_in[i];
    a.out = (float*)d_out; a.ws = (unsigned char*)d_ws;
#if MK_ONE_LAUNCH
    a.ph_lo = 0; a.ph_hi = N_PHASES;
    hipLaunchKernelGGL(fwd_kernel, dim3(grid), dim3(NTHREADS), LDS_BYTES, stream, a);
#else
    for (int p = 0; p < N_PHASES; ++p) { a.ph_lo = p; a.ph_hi = p + 1; hipLaunchKernelGGL(fwd_kernel, dim3(grid), dim3(NTHREADS), LDS_BYTES, stream, a); }
#endif
}
```

```cpp
#include <hip/hip_runtime.h>
#include <cstdio>
#include <cstdint>
#include <cstring>

#ifndef MK_ONE_LAUNCH
#define MK_ONE_LAUNCH 1
#endif

#define GAS __attribute__((address_space(1)))
#define LAS __attribute__((address_space(3)))
typedef unsigned short bf16_t;
typedef short bf16x8 __attribute__((ext_vector_type(8)));
typedef float f32x4 __attribute__((ext_vector_type(4)));
typedef float f32x2 __attribute__((ext_vector_type(2)));
typedef unsigned u32x4 __attribute__((ext_vector_type(4)));
typedef unsigned u32x2 __attribute__((ext_vector_type(2)));
typedef LAS unsigned char* ldsp_t;

constexpr int D = 1024, NB = 8, SEQ = 4096, NLAT = NB * SEQ, CTXL = 256, NCTX = NB * CTXL, MROWS = NLAT + NCTX;
constexpr int INW = 3072, NH = 4, HD = 128, CHK = 128;
constexpr int DFF = 2816, NE = 8, DEXP = 3584;
constexpr int SPB = 34;
constexpr int NITEM = NB * SPB;
constexpr float EPS = 1e-6f;
constexpr int NWAVES = 8, NTHREADS = 512;

constexpr size_t MiB = 1u << 20;
constexpr size_t WS_CTL = 0, CTL_ZERO_BYTES = 64 * 1024;
constexpr size_t WS_MODLAT = 1 * MiB;
constexpr size_t WS_MODCTX = 1 * MiB + 2 * 8 * 6144 * 4;
constexpr size_t WS_ROPE = 2 * MiB;
constexpr size_t WS_RGW = 4 * MiB;
constexpr size_t WS_TOT = 5 * MiB;
constexpr size_t WS_CARRY = 8 * MiB;
constexpr size_t WS_MOE = 10 * MiB;
constexpr size_t MOE_CNT = WS_MOE, MOE_META = WS_MOE + 16384, MOE_TOKE = WS_MOE + 65536, MOE_TOKW = WS_MOE + 262144,
                 MOE_PTOK = WS_MOE + 524288, MOE_PW = WS_MOE + 1048576, MOE_PPOS = WS_MOE + 1572864;
constexpr size_t WS_CTXX = 12 * MiB;
constexpr size_t WS_WIN = 20 * MiB;
constexpr size_t WS_WOUT = 32 * MiB;
constexpr size_t WS_WUP = 36 * MiB;
constexpr size_t WS_WDN = 47 * MiB;
constexpr size_t WS_HX = 54 * MiB;
constexpr size_t WS_PA = 122 * MiB;
constexpr size_t WS_KV = 360 * MiB;
constexpr size_t WS_Y = 496 * MiB;
constexpr size_t WS_MOEUP = 360 * MiB;
constexpr size_t WS_MOEDN = 472 * MiB;
constexpr size_t WS_SLABA = WS_KV;
constexpr size_t WS_SLABM = 528 * MiB;
constexpr int MAXSLAB_A = 256, MAXSLAB_M = 216;
constexpr size_t XB_OFF = (size_t)NLAT * D * 2;
constexpr size_t WS_XCOPY = WS_PA;
constexpr size_t WS_END = 582 * MiB;
static_assert(WS_MOEDN + (size_t)NE * D * DEXP * 2 <= WS_END, "ws map");
static_assert(WS_PA + (size_t)MROWS * DEXP * 2 <= WS_KV, "ws map");

constexpr int LDS_SCRATCH = 147456;
constexpr int LDS_MISC = LDS_SCRATCH;
constexpr int LDS_DEC = LDS_MISC + 256;
constexpr int LDS_BYTES = LDS_SCRATCH + 8192;

__device__ __forceinline__ float bf2f(unsigned v) { return __uint_as_float(v << 16); }
typedef __bf16 bf16x2_t __attribute__((ext_vector_type(2)));
__device__ __forceinline__ unsigned pk2(float lo, float hi) { const f32x2 v = {lo, hi}; return __builtin_bit_cast(unsigned, __builtin_convertvector(v, bf16x2_t)); }
__device__ __forceinline__ unsigned f2bf(float f) { return pk2(f, f) & 0xffffu; }
__device__ __forceinline__ void unpack8(const u32x4 v, f32x4& a, f32x4& b) {
    a = (f32x4){bf2f(v.x & 0xffffu), __uint_as_float(v.x & 0xffff0000u), bf2f(v.y & 0xffffu), __uint_as_float(v.y & 0xffff0000u)};
    b = (f32x4){bf2f(v.z & 0xffffu), __uint_as_float(v.z & 0xffff0000u), bf2f(v.w & 0xffffu), __uint_as_float(v.w & 0xffff0000u)}; }
__device__ __forceinline__ u32x4 pack8(const f32x4 a, const f32x4 b) { return (u32x4){pk2(a.x, a.y), pk2(a.z, a.w), pk2(b.x, b.y), pk2(b.z, b.w)}; }
template <int M> __device__ __forceinline__ float swz_xor(float v) { return __int_as_float(__builtin_amdgcn_ds_swizzle(__float_as_int(v), (M << 10) | 0x1f)); }
__device__ __forceinline__ float wave_sum(float v) {
    v += swz_xor<1>(v); v += swz_xor<2>(v); v += swz_xor<4>(v); v += swz_xor<8>(v); v += swz_xor<16>(v);
    const auto r = __builtin_amdgcn_permlane32_swap(__float_as_uint(v), __float_as_uint(v), false, false);
    return __uint_as_float(r[0]) + __uint_as_float(r[1]);
}
__device__ __forceinline__ float lane_bcast(float v, int src_lane) { return __int_as_float(__builtin_amdgcn_ds_bpermute(src_lane << 2, __float_as_int(v))); }
__device__ __forceinline__ float sigmoidf_(float x) { return __builtin_amdgcn_rcpf(1.0f + __expf(-x)); }
__device__ __forceinline__ float siluf_(float x) { return x * __builtin_amdgcn_rcpf(1.0f + __expf(-x)); }
__device__ __forceinline__ float gelu_tanh(float x) { const float z = 0.7978845608028654f * (x + 0.044715f * x * x * x); return x * (1.0f - __builtin_amdgcn_rcpf(1.0f + __expf(2.0f * z))); }
#define LDS_WAIT() asm volatile("s_waitcnt lgkmcnt(0)" ::: "memory")
#define WG_BAR_LDS() do { asm volatile("s_waitcnt lgkmcnt(0)" ::: "memory"); __builtin_amdgcn_s_barrier(); asm volatile("" ::: "memory"); } while (0)
__device__ __forceinline__ f32x4 zero4() { float z; asm volatile("v_mov_b32 %0, 0" : "=v"(z)); return (f32x4){z, z, z, z}; }

template <typename T> __device__ __forceinline__ T ldg(const void* base, unsigned off) { return *(const GAS T*)((const GAS char*)base + off); }
template <typename T> __device__ __forceinline__ void stg(void* base, unsigned off, T v) { *(GAS T*)((GAS char*)base + off) = v; }
#define XB_TMO      128
#define XB_XCNT(j)  (256  + 64 * (j))
#define XB_XSUB(j)  (1280 + 64 * (j))
#define XB_XGEN(j)  (2304 + 64 * (j))
#define XB_TOP      3328
#define XB_TOPGEN   3392
#define XCD_BAR_WORDS 3456
#define XB_SPIN_CAP (1u << 18)
__device__ __forceinline__ unsigned xb_ld(unsigned* p)              { return __hip_atomic_load(p, __ATOMIC_RELAXED, __HIP_MEMORY_SCOPE_AGENT); }
__device__ __forceinline__ unsigned xb_add(unsigned* p, unsigned v) { return __hip_atomic_fetch_add(p, v, __ATOMIC_RELAXED, __HIP_MEMORY_SCOPE_AGENT); }
__device__ __forceinline__ unsigned xb_xcc_id() { return (unsigned)__builtin_amdgcn_s_getreg((3 << 11) | 20) & 0xFu; }
#define XB_SPIN(cond, bar) do { unsigned _sp = 0; while (cond) { __builtin_amdgcn_s_sleep(1); \
    if ((++_sp & 255u) == 0u) { if (xb_ld(&(bar)[XB_TMO])) break; if (_sp > XB_SPIN_CAP) { atomicAdd(&(bar)[XB_TMO], 1u); break; } } } } while (0)
struct XcdBarrier { unsigned* bar; unsigned x; volatile LAS unsigned* st; };
__device__ __forceinline__ XcdBarrier xcd_barrier_post(unsigned* bar, volatile LAS unsigned* st) {
    XcdBarrier b; b.bar = bar; b.x = xb_xcc_id(); b.st = st;
    if (threadIdx.x == 0) (void)xb_add(&bar[XB_XCNT(b.x)], 1u);
    return b;
}
__device__ __forceinline__ void xcd_barrier_complete(unsigned* bar, unsigned x, unsigned& nloc, unsigned& nx) {
    const unsigned G = gridDim.x * gridDim.y * gridDim.z;
    unsigned sum, cnt, mine, sp = 0u;
    for (;;) {
        sum = 0u; cnt = 0u; mine = 0u;
#pragma unroll
        for (unsigned j = 0; j < 16; ++j) { const unsigned c = xb_ld(&bar[XB_XCNT(j)]); sum += c; cnt += (c > 0u) ? 1u : 0u; mine = (j == x) ? c : mine; }
        if (sum == G) break;
        __builtin_amdgcn_s_sleep(1);
        if ((++sp & 255u) == 0u) { if (xb_ld(&bar[XB_TMO])) break; if (sp > XB_SPIN_CAP) { atomicAdd(&bar[XB_TMO], 1u); break; } }
    }
    nloc = mine > 0u ? mine : 1u; nx = cnt > 0u ? cnt : 1u;
}
__device__ __forceinline__ void xcd_barrier(const XcdBarrier& b) {
    asm volatile("s_waitcnt vmcnt(0)" ::: "memory");
    __syncthreads();
    if (threadIdx.x == 0) {
        unsigned* bar = b.bar;
        __builtin_amdgcn_s_waitcnt(0);
        unsigned nloc = b.st[0], nx = b.st[1];
        if (nloc == 0u) { xcd_barrier_complete(bar, b.x, nloc, nx); b.st[0] = nloc; b.st[1] = nx; }
        const unsigned old = xb_add(&bar[XB_XSUB(b.x)], 1u);
        const unsigned gen = old / nloc;
        if (old + 1u == (gen + 1u) * nloc) {
            __builtin_amdgcn_fence(__ATOMIC_RELEASE, "agent");
            asm volatile("s_waitcnt vmcnt(0)" ::: "memory");
            const unsigned og = xb_add(&bar[XB_TOP], 1u);
            const unsigned tg = og / nx;
            if (og + 1u == (tg + 1u) * nx) xb_add(&bar[XB_TOPGEN], 1u);
            else XB_SPIN(xb_ld(&bar[XB_TOPGEN]) == tg, bar);
            __builtin_amdgcn_fence(__ATOMIC_ACQUIRE, "agent");
            xb_add(&bar[XB_XGEN(b.x)], 1u);
            asm volatile("s_waitcnt vmcnt(0)" ::: "memory");
        } else {
            XB_SPIN(xb_ld(&bar[XB_XGEN(b.x)]) == gen, bar);
            __builtin_amdgcn_fence(__ATOMIC_ACQUIRE, "agent");
            asm volatile("s_waitcnt vmcnt(0)" ::: "memory");
        }
    }
    __syncthreads();
}

namespace pg8 {
constexpr int BM = 256, BK = 64, HALF = 128, HTB = HALF * BK * 2, STAGE_BYTES = 8 * HTB, NXCD = 8, WGM = 8;
__host__ __device__ __forceinline__ int lds_byte(int r, int c) { const int st = (r >> 4) * 2 + (c >> 5), rr = r & 15, cc = c & 31, ob = rr * 64 + cc * 2; return st * 1024 + (ob ^ (((ob >> 9) & 1) << 5)); }
__host__ __device__ __forceinline__ void stage_rc(int b, int& R, int& C) { const int st = b / 1024, sb = b % 1024, swz = sb ^ (((sb >> 9) & 1) << 5); R = (st >> 1) * 16 + swz / 64; C = (st & 1) * 32 + (swz % 64) / 2; }
__host__ __device__ __forceinline__ int perm32(int rho) { const int n = rho >> 4, i = rho & 15; return 8 * (i >> 2) + 4 * n + (i & 3); }

struct Unit { int pm, pn, e, kt0, nt, slab; };
struct Gemm { const bf16_t* A; const bf16_t* Bt; int N, K; size_t estride; float* slabs; };

__device__ __forceinline__ int split_factor(int U, int G, int ntiles, int maxslabs) {
    const int R = U % G; if (R == 0) return 1;
    int S = G / R; if (S > 8) S = 8; if (S > ntiles / 2) S = ntiles / 2; if (R * S > maxslabs) S = maxslabs / R;
    return S < 2 ? 1 : S;
}
struct Order {
    int nM, nN, G, c, ntiles, mainu, S, total; const int* segs; const int* rowmap;
    int sg1, sg2, sg3, sg4, sg5, sg6, sg7;
    __device__ __forceinline__ void init(int nM_, int nN_, int G_, int c_, const int* segs_, const int* rowmap_, int ntiles_, bool split, int maxslabs) {
        nM = nM_; nN = nN_; G = G_; c = c_; segs = segs_; rowmap = rowmap_; ntiles = ntiles_;
        sg1 = sg2 = sg3 = sg4 = sg5 = sg6 = sg7 = 0; if (segs_) { sg1 = segs_[1]; sg2 = segs_[2]; sg3 = segs_[3]; sg4 = segs_[4]; sg5 = segs_[5]; sg6 = segs_[6]; sg7 = segs_[7]; }
        const int U = nM * nN; S = split ? split_factor(U, G, ntiles, maxslabs) : 1; const int R = (S > 1) ? U % G : 0; mainu = U - R; total = mainu + R * S; }
    __device__ __forceinline__ bool next(int i, Unit& u) const {
        const long L = (long)i * G + c; if (L >= total) return false;
        int wgid; u.kt0 = 0; u.nt = ntiles; u.slab = -1;
        if (L < mainu) { wgid = (int)L; const int q = mainu / NXCD, r = mainu % NXCD, xcd = wgid % NXCD, off = wgid / NXCD; wgid = (xcd < r ? xcd * (q + 1) : r * (q + 1) + (xcd - r) * q) + off; }
        else { const int sub = (int)L - mainu, lu = sub / S, sl = sub - lu * S, pairs = ntiles / 2, p0 = (sl * pairs) / S, p1 = ((sl + 1) * pairs) / S;
            wgid = mainu + lu; u.kt0 = 2 * p0; u.nt = 2 * (p1 - p0); u.slab = sub; }
        const int nig = WGM * nN, gid = wgid / nig, fm = gid * WGM, gsz = (nM - fm) < WGM ? (nM - fm) : WGM;
        u.pm = fm + ((wgid % nig) % gsz); u.pn = (wgid % nig) / gsz; u.e = 0;
        if (segs) u.e = (u.pm >= sg1) + (u.pm >= sg2) + (u.pm >= sg3) + (u.pm >= sg4) + (u.pm >= sg5) + (u.pm >= sg6) + (u.pm >= sg7);
        return true;
    }
    __device__ __forceinline__ int arow(const Unit& u, int r) const {
        if (rowmap) { const int t = rowmap[u.pm * BM + r]; return t < 0 ? 0 : t; }
        return u.pm * BM + r;
    }
};

__device__ __forceinline__ unsigned cvt_pk_bf16(float lo, float hi) { return pk2(lo, hi); }

struct EpiBf16 {
    static constexpr bool PERM = true, SPLIT = false;
    bf16_t* O; int ldc;
    __device__ __forceinline__ void operator()(const f32x4 (&acc)[2][2][4][2], const Unit& u, int wr, int wc, int fr, int fq) const {
        asm volatile("" : "+v"(fr), "+v"(fq));
        const int row0 = u.pm * BM + wr * 64 + fr, col0 = u.pn * BM + wc * 32 + 8 * fq;
#pragma unroll
        for (int ai = 0; ai < 2; ++ai)
#pragma unroll
            for (int m = 0; m < 4; ++m) { bf16_t* rowp = O + (size_t)(row0 + ai * HALF + m * 16) * ldc + col0;
#pragma unroll
                for (int bj = 0; bj < 2; ++bj) { const f32x4 v0 = acc[ai][bj][m][0], v1 = acc[ai][bj][m][1];
                    u32x4 w; w.x = cvt_pk_bf16(v0[0], v0[1]); w.y = cvt_pk_bf16(v0[2], v0[3]); w.z = cvt_pk_bf16(v1[0], v1[1]); w.w = cvt_pk_bf16(v1[2], v1[3]);
                    *(u32x4*)(rowp + bj * HALF) = w; } }
    }
};
struct EpiSwiGLU {
    static constexpr bool PERM = true, SPLIT = false;
    bf16_t* O; int ldc;
    __device__ __forceinline__ void operator()(const f32x4 (&acc)[2][2][4][2], const Unit& u, int wr, int wc, int fr, int fq) const {
        asm volatile("" : "+v"(fr), "+v"(fq));
        const int row0 = u.pm * BM + wr * 64 + fr, col0 = u.pn * HALF + wc * 32 + 8 * fq;
#pragma unroll
        for (int ai = 0; ai < 2; ++ai)
#pragma unroll
            for (int m = 0; m < 4; ++m) { bf16_t* rowp = O + (size_t)(row0 + ai * HALF + m * 16) * ldc + col0;
                float o[8];
#pragma unroll
                for (int n = 0; n < 2; ++n)
#pragma unroll
                    for (int j = 0; j < 4; ++j) { const float a = acc[ai][0][m][n][j], b = acc[ai][1][m][n][j]; o[n * 4 + j] = (a * __builtin_amdgcn_rcpf(1.0f + __expf(-a))) * b; }
                u32x4 w; w.x = cvt_pk_bf16(o[0], o[1]); w.y = cvt_pk_bf16(o[2], o[3]); w.z = cvt_pk_bf16(o[4], o[5]); w.w = cvt_pk_bf16(o[6], o[7]);
                *(u32x4*)rowp = w; }
    }
};
struct EpiResid {
    static constexpr bool PERM = true, SPLIT = true;
    const float* src_f32; bf16_t* xb; const float* src_ctx; float* dst_ctx; const float* gate_lat; const float* gate_ctx;
    __device__ __forceinline__ void operator()(const f32x4 (&acc)[2][2][4][2], const Unit& u, int wr, int wc, int fr, int fq) const {
        asm volatile("" : "+v"(fr), "+v"(fq));
        const int prow = u.pm * BM; const bool lat = prow < NLAT;
        const float* gate = lat ? gate_lat + (size_t)(prow / SEQ) * 6144 : gate_ctx;
        const int r0 = wr * 64 + fr, col0 = u.pn * BM + wc * 32 + 8 * fq;
        f32x4 gv[2][2];
#pragma unroll
        for (int bj = 0; bj < 2; ++bj)
#pragma unroll
            for (int n = 0; n < 2; ++n) gv[bj][n] = *(const f32x4*)(gate + col0 + bj * HALF + 4 * n);
        if (lat) {
#pragma unroll
            for (int ai = 0; ai < 2; ++ai)
#pragma unroll
                for (int m = 0; m < 4; ++m) { const size_t off = (size_t)(prow + r0 + ai * HALF + m * 16) * D + col0;
#pragma unroll
                    for (int bj = 0; bj < 2; ++bj) { f32x4 s0, s1;
                        if (src_f32) { s0 = *(const f32x4*)(src_f32 + off + bj * HALF); s1 = *(const f32x4*)(src_f32 + off + bj * HALF + 4); }
                        else unpack8(*(const u32x4*)(xb + off + bj * HALF), s0, s1);
                        *(u32x4*)(xb + off + bj * HALF) = pack8(s0 + gv[bj][0] * acc[ai][bj][m][0], s1 + gv[bj][1] * acc[ai][bj][m][1]); }
                    asm volatile("" ::: "memory"); }
        } else {
            const float* src = src_ctx + (size_t)(prow - NLAT) * D; float* dst = dst_ctx + (size_t)(prow - NLAT) * D;
#pragma unroll
            for (int ai = 0; ai < 2; ++ai)
#pragma unroll
                for (int m = 0; m < 4; ++m) { const size_t off = (size_t)(r0 + ai * HALF + m * 16) * D + col0;
#pragma unroll
                    for (int bj = 0; bj < 2; ++bj)
#pragma unroll
                        for (int n = 0; n < 2; ++n) { const f32x4 sv = *(const f32x4*)(src + off + bj * HALF + 4 * n); *(f32x4*)(dst + off + bj * HALF + 4 * n) = sv + gv[bj][n] * acc[ai][bj][m][n]; }
                    asm volatile("" ::: "memory"); }
        }
    }
};
struct EpiMoeDown {
    static constexpr bool PERM = true, SPLIT = true;
    bf16_t* xb; const int* ptok; const float* pw; const float* gate_lat;
    __device__ __forceinline__ void operator()(const f32x4 (&acc)[2][2][4][2], const Unit& u, int wr, int wc, int fr, int fq) const {
        asm volatile("" : "+v"(fr), "+v"(fq));
        const int r0 = u.pm * BM + wr * 64 + fr, col0 = u.pn * BM + wc * 32 + 8 * fq;
#pragma unroll
        for (int ai = 0; ai < 2; ++ai)
#pragma unroll
            for (int m = 0; m < 4; ++m) { const int r = r0 + ai * HALF + m * 16; const int tok = ptok[r]; const float w = pw[r];
                if (tok >= 0) { bf16_t* xr = xb + (size_t)tok * D + col0; const float* gate = gate_lat + (size_t)(tok / SEQ) * 6144 + col0;
#pragma unroll
                    for (int bj = 0; bj < 2; ++bj) { const f32x4 g0 = *(const f32x4*)(gate + bj * HALF), g1 = *(const f32x4*)(gate + bj * HALF + 4); f32x4 s0, s1; unpack8(*(const u32x4*)(xr + bj * HALF), s0, s1);
                        *(u32x4*)(xr + bj * HALF) = pack8(s0 + (g0 * w) * acc[ai][bj][m][0], s1 + (g1 * w) * acc[ai][bj][m][1]); } }
                asm volatile("" ::: "memory"); }
    }
};

template <class Epi>
__device__ __forceinline__ void gemm_phase(ldsp_t lds, const Gemm g, const Order& S, const Epi& E, const int tid) {
    const int wid = __builtin_amdgcn_readfirstlane(tid >> 6), lane = tid & 63, wr = wid >> 2, wc = wid & 3, fr = lane & 15, fq = lane >> 4;
    const int K = g.K;
    unsigned voffB[2];
#pragma unroll
    for (int i = 0; i < 2; ++i) { int R, C; stage_rc(tid * 16 + i * 8192, R, C); const int Rb = Epi::PERM ? ((R & ~31) + perm32(R & 31)) : R;
        voffB[i] = (unsigned)(Rb * K + C) * 2u; }
    const size_t kstep = (size_t)(BK * 2);
    const size_t hstep = (size_t)HALF * K * 2;
    const size_t tstep = 2 * hstep;
    const unsigned ldsw = (unsigned)wid * 1024u;
    const int aoff = lds_byte(wr * 64 + fr, fq * 8), boff = lds_byte(wc * 32 + fr, fq * 8);
#define PG8_SA(b, h) (((b) * 2 + (h)) * HTB)
#define PG8_SB(b, h) ((4 + (b) * 2 + (h)) * HTB)
#define PG8_STAGE_B(bufoff, gbase) do { _Pragma("unroll") for (int _i = 0; _i < 2; ++_i) \
        __builtin_amdgcn_global_load_lds((const unsigned*)((const char*)(gbase) + voffB[_i]), (LAS unsigned*)(lds + (bufoff) + ldsw + _i * 8192), 16, 0, 0); } while (0)
#define PG8_STAGE_A(bufoff, gbase, o0, o1) do { \
        __builtin_amdgcn_global_load_lds((const unsigned*)((const char*)(gbase) + (o0)), (LAS unsigned*)(lds + (bufoff) + ldsw), 16, 0, 0); \
        __builtin_amdgcn_global_load_lds((const unsigned*)((const char*)(gbase) + (o1)), (LAS unsigned*)(lds + (bufoff) + ldsw + 8192), 16, 0, 0); } while (0)
#define PG8_LDA(dst, b, h) do { _Pragma("unroll") for (int m = 0; m < 4; ++m) _Pragma("unroll") for (int k = 0; k < 2; ++k) dst[m][k] = *(const LAS bf16x8*)(lds + PG8_SA(b, h) + aoff + m * 2048 + k * 1024); } while (0)
#define PG8_LDB(dst, b, h) do { _Pragma("unroll") for (int n = 0; n < 2; ++n) _Pragma("unroll") for (int k = 0; k < 2; ++k) dst[n][k] = *(const LAS bf16x8*)(lds + PG8_SB(b, h) + boff + n * 2048 + k * 1024); } while (0)
#define PG8_MMA(ai, bj, At, Bt) do { __builtin_amdgcn_s_setprio(1); _Pragma("unroll") for (int m = 0; m < 4; ++m) _Pragma("unroll") for (int n = 0; n < 2; ++n) _Pragma("unroll") for (int k = 0; k < 2; ++k) \
        acc[ai][bj][m][n] = __builtin_amdgcn_mfma_f32_16x16x32_bf16(Bt[n][k], At[m][k], acc[ai][bj][m][n], 0, 0, 0); __builtin_amdgcn_s_setprio(0); } while (0)
#define PG8_WAIT_V(n) asm volatile("s_waitcnt vmcnt(" #n ")" ::: "memory")
#define PG8_WAIT_L(n) asm volatile("s_waitcnt lgkmcnt(" #n ")" ::: "memory")
#define PG8_BAR __builtin_amdgcn_s_barrier()
#define PG8_SCHED __builtin_amdgcn_sched_barrier(0)
#define PG8_AOFFS(u, o00, o01, o10, o11) do { int R0_, C0_, R1_, C1_; stage_rc(tid * 16, R0_, C0_); stage_rc(tid * 16 + 8192, R1_, C1_); \
        o00 = (unsigned)(S.arow(u, R0_) * K + C0_ + (u).kt0 * BK) * 2u; o01 = (unsigned)(S.arow(u, R1_) * K + C1_ + (u).kt0 * BK) * 2u; \
        o10 = (unsigned)(S.arow(u, HALF + R0_) * K + C0_ + (u).kt0 * BK) * 2u; o11 = (unsigned)(S.arow(u, HALF + R1_) * K + C1_ + (u).kt0 * BK) * 2u; } while (0)
    Unit cur, nxt; int ui = 0;
    if (!S.next(0, cur)) return;
    f32x4 acc[2][2][4][2];
    { float z_; asm volatile("v_mov_b32 %0, 0" : "=v"(z_));
#pragma unroll
    for (int a = 0; a < 2; ++a)
#pragma unroll
        for (int b = 0; b < 2; ++b)
#pragma unroll
            for (int m = 0; m < 4; ++m)
#pragma unroll
                for (int n = 0; n < 2; ++n) acc[a][b][m][n] = (f32x4){z_, z_, z_, z_}; }
    bf16x8 At[4][2], B0[2][2], B1[2][2];
    const char* const Abase = (const char*)g.A;
    const char* cB = (const char*)g.Bt + (size_t)cur.e * g.estride + (size_t)cur.pn * tstep + (size_t)cur.kt0 * kstep;
    unsigned c00, c01, c10, c11;
    PG8_AOFFS(cur, c00, c01, c10, c11);
    PG8_STAGE_B(PG8_SB(0, 0), cB); PG8_STAGE_B(PG8_SB(0, 1), cB + hstep); PG8_STAGE_A(PG8_SA(0, 0), Abase, c00, c01); PG8_STAGE_A(PG8_SA(0, 1), Abase, c10, c11);
    if (wr == 1) PG8_BAR;
    PG8_WAIT_V(2); PG8_BAR;
    PG8_STAGE_B(PG8_SB(1, 0), cB + kstep); PG8_STAGE_A(PG8_SA(1, 0), Abase + kstep, c00, c01); PG8_STAGE_B(PG8_SB(1, 1), cB + hstep + kstep);
    PG8_WAIT_V(6); PG8_BAR;
    for (;;) {
        const bool has_next = S.next(ui + 1, nxt);
        const char* nB = has_next ? (const char*)g.Bt + (size_t)nxt.e * g.estride + (size_t)nxt.pn * tstep + (size_t)nxt.kt0 * kstep : cB;
        const int nt = cur.nt;
        int rn0 = 0, rn1 = 0, rn2 = 0, rn3 = 0;
        if (S.rowmap && has_next) { int R0_, C0_, R1_, C1_; stage_rc(tid * 16, R0_, C0_); stage_rc(tid * 16 + 8192, R1_, C1_);
            rn0 = S.arow(nxt, R0_); rn1 = S.arow(nxt, R1_); rn2 = S.arow(nxt, HALF + R0_); rn3 = S.arow(nxt, HALF + R1_); }
        for (int t = 0; t < nt; t += 2) {
            const bool last = (t == nt - 2);
            const char* a1 = Abase + (size_t)(t + 1) * kstep;
            const char* a2 = last ? Abase : Abase + (size_t)(t + 2) * kstep; const char* b2 = last ? nB : cB + (size_t)(t + 2) * kstep;
            const char* a3 = a2 + kstep; const char* b3 = b2 + kstep;
            PG8_LDB(B0, 0, 0); PG8_LDB(B1, 0, 1); PG8_SCHED; PG8_LDA(At, 0, 0); PG8_STAGE_A(PG8_SA(1, 1), a1, c10, c11);
            PG8_WAIT_V(8); PG8_WAIT_L(0); PG8_BAR; PG8_MMA(0, 0, At, B0); PG8_MMA(0, 1, At, B1); PG8_BAR; PG8_SCHED;
            if (last && has_next) {
                if (S.rowmap) { int R0_, C0_, R1_, C1_; stage_rc(tid * 16, R0_, C0_); stage_rc(tid * 16 + 8192, R1_, C1_);
                    c00 = (unsigned)(rn0 * K + C0_ + nxt.kt0 * BK) * 2u; c01 = (unsigned)(rn1 * K + C1_ + nxt.kt0 * BK) * 2u; c10 = (unsigned)(rn2 * K + C0_ + nxt.kt0 * BK) * 2u; c11 = (unsigned)(rn3 * K + C1_ + nxt.kt0 * BK) * 2u; }
                else { PG8_AOFFS(nxt, c00, c01, c10, c11); } }
            PG8_LDA(At, 0, 1); PG8_STAGE_B(PG8_SB(0, 0), b2); PG8_STAGE_B(PG8_SB(0, 1), b2 + hstep); PG8_STAGE_A(PG8_SA(0, 0), a2, c00, c01);
            PG8_WAIT_V(8); PG8_WAIT_L(0); PG8_BAR; PG8_MMA(1, 0, At, B0); PG8_MMA(1, 1, At, B1); PG8_BAR; PG8_SCHED;
            PG8_LDB(B0, 1, 0); PG8_LDB(B1, 1, 1); PG8_SCHED; PG8_LDA(At, 1, 0); PG8_STAGE_A(PG8_SA(0, 1), a2, c10, c11);
            PG8_WAIT_V(8); PG8_WAIT_L(0); PG8_BAR; PG8_MMA(0, 0, At, B0); PG8_MMA(0, 1, At, B1); PG8_BAR; PG8_SCHED;
            PG8_LDA(At, 1, 1); PG8_STAGE_B(PG8_SB(1, 0), b3); PG8_STAGE_B(PG8_SB(1, 1), b3 + hstep); PG8_STAGE_A(PG8_SA(1, 0), a3, c00, c01);
            PG8_WAIT_V(8); PG8_WAIT_L(0); PG8_BAR; PG8_MMA(1, 0, At, B0); PG8_MMA(1, 1, At, B1); PG8_BAR; PG8_SCHED;
        }
        if (wr == 0) PG8_BAR;
        if (Epi::SPLIT && cur.slab >= 0) {
            int fr_ = fr, fq_ = fq; asm volatile("" : "+v"(fr_), "+v"(fq_));
            float* sp = g.slabs + (size_t)cur.slab * 65536 + (size_t)(wr * 64 + fr_) * 256 + wc * 32 + (Epi::PERM ? 8 : 4) * fq_;
#pragma unroll
            for (int ai = 0; ai < 2; ++ai)
#pragma unroll
                for (int m = 0; m < 4; ++m)
#pragma unroll
                    for (int bj = 0; bj < 2; ++bj)
#pragma unroll
                        for (int n = 0; n < 2; ++n) *(f32x4*)(sp + (ai * HALF + m * 16) * 256 + bj * HALF + n * (Epi::PERM ? 4 : 16)) = acc[ai][bj][m][n];
        } else E(acc, cur, wr, wc, fr, fq);
        if (!has_next) break;
        { float z_; asm volatile("v_mov_b32 %0, 0" : "=v"(z_));
#pragma unroll
        for (int a = 0; a < 2; ++a)
#pragma unroll
            for (int b = 0; b < 2; ++b)
#pragma unroll
                for (int m = 0; m < 4; ++m)
#pragma unroll
                    for (int n = 0; n < 2; ++n) acc[a][b][m][n] = (f32x4){z_, z_, z_, z_}; }
        cur = nxt; cB = nB; ++ui;
        if (wr == 1) PG8_BAR;
    }
    PG8_WAIT_V(0);
    PG8_BAR;
#undef PG8_SA
#undef PG8_SB
#undef PG8_STAGE_A
#undef PG8_STAGE_B
#undef PG8_LDA
#undef PG8_LDB
#undef PG8_MMA
#undef PG8_WAIT_V
#undef PG8_WAIT_L
#undef PG8_BAR
#undef PG8_SCHED
#undef PG8_AOFFS
}
}

struct Args { const float* in[27]; float* out; unsigned char* ws; int ph_lo, ph_hi; };
struct Frame {
    ldsp_t lds; int tid, lane, wave, wave0, G, bid;
    const Args* pa; float* out; unsigned char* ws;
    const Args* pa0; float* out0; unsigned char* ws0;
};
enum { I_X = 0, I_C, I_CTX, I_CCTX, I_WMOD, I_BMOD, I_GMIX, I_GFFN, I_GFINAL, I_WIN, I_WOUT, I_CONVW, I_CONVB, I_RGWA, I_RGBA, I_RGWX, I_RGBX, I_RGLAM, I_RETDEC,
       I_FW1, I_FW3, I_FW2, I_MROUTER, I_MROUTERB, I_MW1, I_MW3, I_MW2 };

constexpr int TRS = 64 * 65 * 4;
struct TrItem { const float* W; bf16_t* WT; int ldw, k0, n0, ldt, drow0; float scale; };
__device__ __forceinline__ void tr_load(const TrItem& t, f32x4 (&v)[16], int lane) {
    const int r4 = lane >> 4, c4 = (lane & 15) * 4;
#pragma unroll
    for (int i = 0; i < 16; ++i) v[i] = *(const f32x4*)(t.W + (size_t)(t.k0 + 4 * i + r4) * t.ldw + t.n0 + c4);
}
__device__ __forceinline__ void tr_store(const TrItem& t, const f32x4 (&v)[16], LAS float* scr, int lane) {
    { const int r4 = lane >> 4, c4 = (lane & 15) * 4;
#pragma unroll
      for (int i = 0; i < 16; ++i) { LAS float* d = scr + (4 * i + r4) * 65 + c4; d[0] = v[i].x; d[1] = v[i].y; d[2] = v[i].z; d[3] = v[i].w; } }
    LDS_WAIT(); asm volatile("" ::: "memory");
    const int c = lane & 7; const float scale = t.scale;
#pragma unroll
    for (int j = 0; j < 8; ++j) { const int n = (lane >> 3) + 8 * j; const LAS float* sp = scr + (8 * c) * 65 + n;
        u32x4 o; o.x = pk2(sp[0 * 65] * scale, sp[1 * 65] * scale); o.y = pk2(sp[2 * 65] * scale, sp[3 * 65] * scale); o.z = pk2(sp[4 * 65] * scale, sp[5 * 65] * scale); o.w = pk2(sp[6 * 65] * scale, sp[7 * 65] * scale);
        *(u32x4*)(t.WT + (size_t)(t.drow0 + n) * t.ldt + t.k0 + 8 * c) = o; }
    LDS_WAIT(); asm volatile("" ::: "memory");
}
__device__ __forceinline__ TrItem up_item(const float* w1, const float* w3, int F, bf16_t* WT, int r) {
    const int per = 16 * (F / 64); const int which = r / per; r -= which * per;
    const int nblk = F / 64, kb = r / nblk, nb = r % nblk, n0 = nb * 64;
    return TrItem{which ? w3 : w1, WT, F, kb * 64, n0, D, (n0 / 128) * 256 + (n0 % 128) + which * 128, 1.0f};
}
__device__ __forceinline__ TrItem small_item(Frame& F, int r) {
    constexpr int I_IN = 16 * (INW / 64), I_OUT = 16 * (D / 64), I_UP = 2 * 16 * (DFF / 64);
    if (r < 2 * I_IN) { const int l = r / I_IN; r -= l * I_IN; const int nblk = INW / 64, kb = r / nblk, nb = r % nblk, n0 = nb * 64;
        const float sc = (n0 >= 1536 && n0 < 2048) ? 0.08838834764831845f : 1.0f;
        return TrItem{F.pa->in[I_WIN] + (size_t)l * D * INW, (bf16_t*)(F.ws + WS_WIN) + (size_t)l * INW * D, INW, kb * 64, n0, D, n0, sc}; }
    r -= 2 * I_IN;
    if (r < 2 * I_OUT) { const int l = r / I_OUT; r -= l * I_OUT; const int nblk = D / 64, kb = r / nblk, nb = r % nblk;
        return TrItem{F.pa->in[I_WOUT] + (size_t)l * D * D, (bf16_t*)(F.ws + WS_WOUT) + (size_t)l * D * D, D, kb * 64, nb * 64, D, nb * 64, 1.0f}; }
    r -= 2 * I_OUT;
    if (r < I_UP) return up_item(F.pa->in[I_FW1], F.pa->in[I_FW3], DFF, (bf16_t*)(F.ws + WS_WUP), r);
    r -= I_UP;
    { const int nblk = D / 64, kb = r / nblk, nb = r % nblk; return TrItem{F.pa->in[I_FW2], (bf16_t*)(F.ws + WS_WDN), D, kb * 64, nb * 64, DFF, nb * 64, 1.0f}; }
}
__device__ __forceinline__ TrItem moe_item(Frame& F, int it) {
    constexpr int I_UP = 2 * 16 * (DEXP / 64), I_DN = (DEXP / 64) * (D / 64), PER_E = I_UP + I_DN;
    const int e = it / PER_E; int r = it - e * PER_E;
    if (r < I_UP) return up_item(F.pa->in[I_MW1] + (size_t)e * D * DEXP, F.pa->in[I_MW3] + (size_t)e * D * DEXP, DEXP, (bf16_t*)(F.ws + WS_MOEUP) + (size_t)e * 2 * DEXP * D, r);
    r -= I_UP;
    { const int nblk = D / 64, kb = r / nblk, nb = r % nblk; return TrItem{F.pa->in[I_MW2] + (size_t)e * DEXP * D, (bf16_t*)(F.ws + WS_MOEDN) + (size_t)e * D * DEXP, D, kb * 64, nb * 64, DEXP, nb * 64, 1.0f}; }
}
__device__ __forceinline__ void phase_convert_small(Frame& F) {
    LAS float* scr = (LAS float*)(F.lds + F.wave * TRS);
    const int gw = F.bid * NWAVES + F.wave, NGW = F.G * NWAVES;
    constexpr int NITEMS = 2 * 16 * (INW / 64) + 2 * 16 * (D / 64) + 2 * 16 * (DFF / 64) + (DFF / 64) * (D / 64);
    if (gw < NITEMS) { TrItem cur = small_item(F, gw); f32x4 va[16], vb[16]; tr_load(cur, va, F.lane);
        for (int it = gw; it < NITEMS; it += 2 * NGW) {
            const bool h1 = it + NGW < NITEMS; TrItem n1 = cur; if (h1) { n1 = small_item(F, it + NGW); tr_load(n1, vb, F.lane); }
            tr_store(cur, va, scr, F.lane);
            if (!h1) break;
            const bool h2 = it + 2 * NGW < NITEMS; if (h2) { cur = small_item(F, it + 2 * NGW); tr_load(cur, va, F.lane); }
            tr_store(n1, vb, scr, F.lane);
            if (!h2) break; } }
    { const int gt = F.bid * NTHREADS + F.tid, NGT = F.G * NTHREADS; bf16_t* o = (bf16_t*)(F.ws + WS_RGW);
      for (int i = gt; i < 2 * 2 * 2 * 8 * 64 * 64; i += NGT) { const int c = i & 63, dp = (i >> 6) & 63, blk = (i >> 12) & 7, gate = (i >> 15) & 1, dir = (i >> 16) & 1, l = i >> 17;
          const float* src = gate ? F.pa->in[I_RGWX] : F.pa->in[I_RGWA]; o[i] = (bf16_t)f2bf(src[((((size_t)l * 2 + dir) * 8 + blk) * 64 + c) * 64 + dp]); } }
    { const int gt = F.bid * NTHREADS + F.tid, NGT = F.G * NTHREADS; float* ct = (float*)(F.ws + WS_ROPE); float* st = ct + 4096 * 64;
      for (int i = gt; i < 4096 * 64; i += NGT) { const int pos = i >> 6, fi = i & 63; const float p = (float)((fi < 32) ? (pos >> 6) : (pos & 63));
          const float inv = powf(10000.0f, -(float)(fi & 31) / 32.0f); const float ang = p * inv;
          const double a = (double)ang; const double kq = __builtin_rint(a * 0.63661977236758134308); const double rr = a - kq * 1.57079632679489661923; const int q = ((int)kq) & 3;
          const double r2 = rr * rr;
          const double sn = rr * (1.0 + r2 * (-1.0 / 6 + r2 * (1.0 / 120 + r2 * (-1.0 / 5040 + r2 * (1.0 / 362880 + r2 * (-1.0 / 39916800))))));
          const double cs = 1.0 + r2 * (-0.5 + r2 * (1.0 / 24 + r2 * (-1.0 / 720 + r2 * (1.0 / 40320 + r2 * (-1.0 / 3628800 + r2 * (1.0 / 479001600))))));
          const double c_ = (q == 0) ? cs : (q == 1) ? -sn : (q == 2) ? -cs : sn; const double s_ = (q == 0) ? sn : (q == 1) ? cs : (q == 2) ? -sn : -cs;
          ct[i] = (float)c_; st[i] = (float)s_; } }
}
struct MoeTile { const float* W; bf16_t* WT; int ldw, k0, n0, ldt, up; };
__device__ __forceinline__ MoeTile moe_tile(Frame& F, int t) {
    constexpr int T_UP1 = (D / 128) * (DEXP / 256), T_DN = (DEXP / 128) * (D / 256), PER_E = 2 * T_UP1 + T_DN;
    const int e = t / PER_E; int r = t - e * PER_E;
    if (r < 2 * T_UP1) { const int which = r / T_UP1; r -= which * T_UP1; const int nb = DEXP / 256, kb = r / nb, nn = r % nb;
        return MoeTile{(which ? F.pa->in[I_MW3] : F.pa->in[I_MW1]) + (size_t)e * D * DEXP, (bf16_t*)(F.ws + WS_MOEUP) + (size_t)e * 2 * DEXP * D, DEXP, kb * 128, nn * 256, D, 1 + which}; }
    r -= 2 * T_UP1;
    { const int nb = D / 256, kb = r / nb, nn = r % nb; return MoeTile{F.pa->in[I_MW2] + (size_t)e * DEXP * D, (bf16_t*)(F.ws + WS_MOEDN) + (size_t)e * D * DEXP, D, kb * 128, nn * 256, DEXP, 0}; }
}
__device__ __forceinline__ void moe_tile_load(const MoeTile& t, f32x4 (&v)[16], int wave, int lane) {
#pragma unroll
    for (int i = 0; i < 16; ++i) v[i] = *(const f32x4*)(t.W + (size_t)(t.k0 + 16 * wave + i) * t.ldw + t.n0 + 4 * lane);
}
__device__ __forceinline__ void moe_tile_store(Frame& F, const MoeTile& t, const f32x4 (&v)[16]) {
    LAS float* tile = (LAS float*)F.lds;
#pragma unroll
    for (int i = 0; i < 16; ++i) { const int k = 16 * F.wave + i, p = (4 * F.lane + 2 * (k >> 3)) & 255;
        *(LAS f32x2*)(tile + k * 256 + p) = (f32x2){v[i].x, v[i].y}; *(LAS f32x2*)(tile + k * 256 + ((p + 2) & 255)) = (f32x2){v[i].z, v[i].w}; }
    __syncthreads();
#pragma unroll
    for (int j = 0; j < 8; ++j) { const int task = F.tid + j * NTHREADS, c = task & 15, n = task >> 4; const LAS float* sp = tile + (8 * c) * 256 + ((n + 2 * c) & 255);
        u32x4 o; o.x = pk2(sp[0], sp[256]); o.y = pk2(sp[512], sp[768]); o.z = pk2(sp[1024], sp[1280]); o.w = pk2(sp[1536], sp[1792]);
        const int col = t.n0 + n; const int drow = t.up ? (col >> 7) * 256 + (col & 127) + 128 * (t.up - 1) : col;
        *(u32x4*)(t.WT + (size_t)drow * t.ldt + t.k0 + 8 * c) = o; }
    __syncthreads();
}
__device__ __forceinline__ void phase_convert_moe(Frame& F) {
    constexpr int NT = NE * (2 * (D / 128) * (DEXP / 256) + (DEXP / 128) * (D / 256));
    if (F.bid < NT) { MoeTile cur = moe_tile(F, F.bid); f32x4 va[16], vb[16]; moe_tile_load(cur, va, F.wave, F.lane);
        for (int t = F.bid; t < NT; t += 2 * F.G) {
            const bool h1 = t + F.G < NT; MoeTile n1 = cur; if (h1) { n1 = moe_tile(F, t + F.G); moe_tile_load(n1, vb, F.wave, F.lane); }
            moe_tile_store(F, cur, va);
            if (!h1) break;
            const bool h2 = t + 2 * F.G < NT; if (h2) { cur = moe_tile(F, t + 2 * F.G); moe_tile_load(cur, va, F.wave, F.lane); }
            moe_tile_store(F, n1, vb);
            if (!h2) break; } }
}
__device__ __forceinline__ void phase_mod(Frame& F) {
    LAS float* sc = (LAS float*)F.lds;
    LAS float* red = (LAS float*)(F.lds + 9 * 1024 * 4);
    for (int i = F.tid; i < 9 * 1024; i += NTHREADS) { const int r = i >> 10, k = i & 1023; const float v = (r < 8) ? F.pa->in[I_C][r * 1024 + k] : F.pa->in[I_CCTX][k]; sc[i] = v / (1.0f + __expf(-v)); }
    __syncthreads();
    for (int strip = F.bid; strip < 2 * 6144 / 64; strip += F.G) {
        const int l = strip / 96, j = (strip % 96) * 64 + F.lane;
        const float* w = F.pa->in[I_WMOD] + (size_t)l * 1024 * 6144 + j;
        float a[9];
#pragma unroll
        for (int r = 0; r < 9; ++r) a[r] = 0.f;
        const int k0 = F.wave * 128;
#pragma unroll 1
        for (int kk = k0; kk < k0 + 128; kk += 16) { float wv[16];
#pragma unroll
            for (int i = 0; i < 16; ++i) wv[i] = w[(size_t)(kk + i) * 6144];
#pragma unroll
            for (int i = 0; i < 16; ++i) {
#pragma unroll
                for (int r = 0; r < 9; ++r) a[r] += sc[r * 1024 + kk + i] * wv[i];
                if ((i & 3) == 3) __builtin_amdgcn_sched_barrier(0); } }
#pragma unroll
        for (int r = 0; r < 9; ++r) red[(F.wave * 9 + r) * 64 + F.lane] = a[r];
        __syncthreads();
        for (int i = F.tid; i < 9 * 64; i += NTHREADS) { const int r = i >> 6, jj = i & 63; float s = 0.f;
#pragma unroll
            for (int w8 = 0; w8 < 8; ++w8) s += red[(w8 * 9 + r) * 64 + jj];
            const int col = (strip % 96) * 64 + jj; s += F.pa->in[I_BMOD][l * 6144 + col];
            if (r < 8) ((float*)(F.ws + WS_MODLAT))[((size_t)l * 8 + r) * 6144 + col] = s; else ((float*)(F.ws + WS_MODCTX))[(size_t)l * 6144 + col] = s; }
        __syncthreads();
    }
}

__device__ __forceinline__ void norm_row(const u32x2 (&xw)[4], const f32x4 (&Am)[4], const f32x4 (&Sh)[4], bf16_t* orow, int lane, f32x4 (&y)[4]) {
    f32x4 v[4]; float ss = 0.f;
#pragma unroll
    for (int j = 0; j < 4; ++j) { const u32x2 w = xw[j]; v[j] = (f32x4){bf2f(w.x & 0xffffu), __uint_as_float(w.x & 0xffff0000u), bf2f(w.y & 0xffffu), __uint_as_float(w.y & 0xffff0000u)};
        ss += (v[j].x * v[j].x + v[j].y * v[j].y) + (v[j].z * v[j].z + v[j].w * v[j].w); }
    const float rstd = 1.0f / sqrtf(wave_sum(ss) * (1.0f / D) + EPS);
    u32x2* o8 = (u32x2*)orow + lane;
#pragma unroll
    for (int j = 0; j < 4; ++j) { y[j] = (v[j] * rstd) * Am[j] + Sh[j]; o8[64 * j] = (u32x2){pk2(y[j].x, y[j].y), pk2(y[j].z, y[j].w)}; }
}
struct SlabRed { const float* slab; int S; const float* gate; const float* xold; float* xnew; };
__device__ __forceinline__ void norm_row_v(f32x4 (&v)[4], const float* g, const float* shift, const float* scale, bf16_t* orow, int lane) {
    float ss = 0.f;
#pragma unroll
    for (int j = 0; j < 4; ++j) ss += (v[j].x * v[j].x + v[j].y * v[j].y) + (v[j].z * v[j].z + v[j].w * v[j].w);
    const float rstd = 1.0f / sqrtf(wave_sum(ss) * (1.0f / D) + EPS);
    u32x2* o8 = (u32x2*)orow + lane;
#pragma unroll
    for (int j = 0; j < 4; ++j) { const f32x4 gg = ((const f32x4*)g)[lane + 64 * j], sh = ((const f32x4*)shift)[lane + 64 * j], sl = ((const f32x4*)scale)[lane + 64 * j];
        const f32x4 y = (v[j] * rstd) * gg * (sl + 1.0f) + sh;
        u32x2 w; w.x = pk2(y.x, y.y); w.y = pk2(y.z, y.w); o8[64 * j] = w; }
}
__device__ __forceinline__ void phase_norm(Frame& F, int l, int sel, const float* xlat, const bf16_t* xb, const float* xctx, int nrows, const SlabRed sr) {
    const int gw = F.bid * NWAVES + F.wave, NGW = F.G * NWAVES;
    const float* g = (sel ? F.pa->in[I_GFFN] : F.pa->in[I_GMIX]) + l * D; const int so = sel ? 3072 : 0;
    bf16_t* HX = (bf16_t*)(F.ws + WS_HX);
    const int nlat = nrows < NLAT ? nrows : NLAT; const int per = (nlat + NGW - 1) / NGW, r_lo = gw * per, r_hi = (r_lo + per < nlat) ? r_lo + per : nlat;
    int curb = -1; f32x4 Am[4], Sh[4];
    for (int row0 = r_lo; row0 < r_hi; row0 += 4) {
        f32x4 v[4][4];
#pragma unroll
        for (int u = 0; u < 4; ++u) { const int row = (row0 + u < r_hi) ? row0 + u : row0;
            if (xb) { const u32x2* xr = (const u32x2*)(xb + (size_t)row * D) + F.lane;
#pragma unroll
                for (int j = 0; j < 4; ++j) { const u32x2 w = xr[64 * j]; v[u][j] = (f32x4){bf2f(w.x & 0xffffu), __uint_as_float(w.x & 0xffff0000u), bf2f(w.y & 0xffffu), __uint_as_float(w.y & 0xffff0000u)}; } }
            else { const f32x4* xr = (const f32x4*)(xlat + (size_t)row * D) + F.lane;
#pragma unroll
                for (int j = 0; j < 4; ++j) v[u][j] = xr[64 * j]; } }
#pragma unroll
        for (int u = 0; u < 4; ++u) { const int row = row0 + u; if (row >= r_hi) continue;
            const int b = row / SEQ;
            if (b != curb) { curb = b; const float* mod = (const float*)(F.ws + WS_MODLAT) + ((size_t)l * 8 + b) * 6144 + so;
#pragma unroll
                for (int j = 0; j < 4; ++j) { Am[j] = ((const f32x4*)g)[F.lane + 64 * j] * (((const f32x4*)(mod + 1024))[F.lane + 64 * j] + 1.0f); Sh[j] = ((const f32x4*)mod)[F.lane + 64 * j]; } }
            float ss = 0.f;
#pragma unroll
            for (int j = 0; j < 4; ++j) ss += (v[u][j].x * v[u][j].x + v[u][j].y * v[u][j].y) + (v[u][j].z * v[u][j].z + v[u][j].w * v[u][j].w);
            const float rstd = 1.0f / sqrtf(wave_sum(ss) * (1.0f / D) + EPS);
            u32x2* o8 = (u32x2*)(HX + (size_t)row * D) + F.lane;
#pragma unroll
            for (int j = 0; j < 4; ++j) { const f32x4 y = (v[u][j] * rstd) * Am[j] + Sh[j]; o8[64 * j] = (u32x2){pk2(y.x, y.y), pk2(y.z, y.w)}; } }
    }
    for (int row = NLAT + gw; row < nrows; row += NGW) {
        const float* mod = (const float*)(F.ws + WS_MODCTX) + (size_t)l * 6144;
        f32x4 v[4];
        if (sr.slab == nullptr) { const f32x4* xr = (const f32x4*)(xctx + (size_t)(row - NLAT) * D) + F.lane;
#pragma unroll
            for (int j = 0; j < 4; ++j) v[j] = xr[64 * j]; }
        else { const int rc = row - NLAT, pmr = rc >> 8, r = rc & 255;
#pragma unroll
            for (int j = 0; j < 4; ++j) { f32x4 a = zero4(); const float* sp = sr.slab + (size_t)((pmr + 8 * j) * sr.S) * 65536 + (size_t)r * 256 + 4 * F.lane;
                f32x4 t8[8];
#pragma unroll
                for (int q = 0; q < 8; ++q) t8[q] = (q < sr.S) ? *(const f32x4*)(sp + (size_t)q * 65536) : zero4();
#pragma unroll
                for (int q = 0; q < 8; ++q) a += t8[q];
                v[j] = ((const f32x4*)(sr.xold + (size_t)rc * D))[F.lane + 64 * j] + ((const f32x4*)sr.gate)[F.lane + 64 * j] * a;
                ((f32x4*)(sr.xnew + (size_t)rc * D))[F.lane + 64 * j] = v[j]; } }
        norm_row_v(v, g, mod + so, mod + so + 1024, HX + (size_t)row * D, F.lane);
    }
}
__device__ __forceinline__ void moe_reduce(Frame& F, int k) {
    const int* meta = (const int*)(F.ws + MOE_META) + 9 * k; const int npan = meta[8], gsz = npan - 128;
    if (gsz <= 0) return;
    const int S = pg8::split_factor(npan * 4, F.G, DEXP / 64, MAXSLAB_M); if (S < 2) return;
    const int gw = F.bid * NWAVES + F.wave, NGW = F.G * NWAVES;
    const int* ptok = (const int*)(F.ws + MOE_PTOK) + k * MROWS; const float* pw = (const float*)(F.ws + MOE_PW) + k * MROWS;
    const float* slab = (const float*)(F.ws + WS_SLABM); const float* gate_lat = (const float*)(F.ws + WS_MODLAT) + (size_t)8 * 6144 + 5120;
    for (int rr = NLAT + gw; rr < npan * 256; rr += NGW) { const int tok = ptok[rr]; if (tok < 0) continue; const float w = pw[rr];
        const int pmr = (rr - NLAT) >> 8, r = rr & 255; u32x2* xr = (u32x2*)((bf16_t*)((char*)F.out + XB_OFF) + (size_t)tok * D); const f32x4* gt = (const f32x4*)(gate_lat + (size_t)(tok / SEQ) * 6144);
#pragma unroll
        for (int j = 0; j < 4; ++j) { f32x4 a = zero4(); const float* sp = slab + (size_t)((pmr + gsz * j) * S) * 65536 + (size_t)r * 256 + 4 * F.lane;
            for (int q = 0; q < S; ++q) a += *(const f32x4*)(sp + (size_t)q * 65536);
            const u32x2 xo = xr[F.lane + 64 * j]; const f32x4 xv = {bf2f(xo.x & 0xffffu), __uint_as_float(xo.x & 0xffff0000u), bf2f(xo.y & 0xffffu), __uint_as_float(xo.y & 0xffff0000u)};
            const f32x4 y = xv + (gt[F.lane + 64 * j] * w) * a; xr[F.lane + 64 * j] = (u32x2){pk2(y.x, y.y), pk2(y.z, y.w)}; } }
}
__device__ __forceinline__ void phase_norm_router(Frame& F, const bf16_t* xb) {
    constexpr int l = 1;
    LAS float* wr = (LAS float*)F.lds;
    LAS int* le = (LAS int*)(F.lds + 32768);
    for (int i = F.tid; i < 1024 * 8 / 4; i += NTHREADS) ((LAS f32x4*)wr)[i] = ((const f32x4*)F.pa->in[I_MROUTER])[i];
    __syncthreads();
    const float* g = F.pa->in[I_GFFN] + l * D; bf16_t* HX = (bf16_t*)(F.ws + WS_HX);
    int* toke = (int*)(F.ws + MOE_TOKE); float* tokw = (float*)(F.ws + MOE_TOKW);
    for (int wg = F.bid; wg < NLAT / 128; wg += F.G) {
        u32x2 nx[4]; f32x4 Am[4], Sh[4];
        { const float* mod = (const float*)(F.ws + WS_MODLAT) + ((size_t)l * 8 + (wg * 128) / SEQ) * 6144 + 3072;
#pragma unroll
          for (int j = 0; j < 4; ++j) { Am[j] = ((const f32x4*)g)[F.lane + 64 * j] * (((const f32x4*)(mod + 1024))[F.lane + 64 * j] + 1.0f); Sh[j] = ((const f32x4*)mod)[F.lane + 64 * j]; } }
        { const u32x2* xr = (const u32x2*)(xb + (size_t)(wg * 128 + F.wave * 16) * D) + F.lane;
#pragma unroll
          for (int j = 0; j < 4; ++j) nx[j] = xr[64 * j]; }
        for (int i = 0; i < 16; ++i) { const int tl = F.wave * 16 + i, row = wg * 128 + tl;
            u32x2 cx[4];
#pragma unroll
            for (int j = 0; j < 4; ++j) cx[j] = nx[j];
            { const int rn = (i < 15) ? row + 1 : row; const u32x2* xr = (const u32x2*)(xb + (size_t)rn * D) + F.lane;
#pragma unroll
              for (int j = 0; j < 4; ++j) nx[j] = xr[64 * j]; }
            f32x4 y[4]; norm_row(cx, Am, Sh, HX + (size_t)row * D, F.lane, y);
            float lg[8];
#pragma unroll
            for (int e = 0; e < 8; ++e) lg[e] = 0.f;
#pragma unroll
            for (int j = 0; j < 4; ++j)
#pragma unroll
                for (int q = 0; q < 4; ++q) { const int k = 4 * F.lane + 256 * j + q; const f32x4 w0 = *(const LAS f32x4*)(wr + k * 8), w1 = *(const LAS f32x4*)(wr + k * 8 + 4); const float yv = y[j][q];
                    lg[0] += yv * w0.x; lg[1] += yv * w0.y; lg[2] += yv * w0.z; lg[3] += yv * w0.w; lg[4] += yv * w1.x; lg[5] += yv * w1.y; lg[6] += yv * w1.z; lg[7] += yv * w1.w; }
#pragma unroll
            for (int e = 0; e < 8; ++e) lg[e] = wave_sum(lg[e]) + F.pa->in[I_MROUTERB][e];
            int e0 = 0; float v0 = lg[0];
#pragma unroll
            for (int e = 1; e < 8; ++e) if (lg[e] > v0) { v0 = lg[e]; e0 = e; }
            int e1 = -1; float v1 = -3.0e38f;
#pragma unroll
            for (int e = 0; e < 8; ++e) if (e != e0 && lg[e] > v1) { v1 = lg[e]; e1 = e; }
            const float w0 = 1.0f / (1.0f + __expf(v1 - v0));
            if (F.lane == 0) { toke[row] = e0 | (e1 << 8); tokw[2 * row] = w0; tokw[2 * row + 1] = 1.0f - w0; le[tl] = e0 | (e1 << 8); }
        }
        __syncthreads();
        if (F.tid < 16) { const int k = F.tid >> 3, e = F.tid & 7; int c = 0; for (int t = 0; t < 128; ++t) c += (((le[t] >> (8 * k)) & 0xff) == e) ? 1 : 0; ((int*)(F.ws + MOE_CNT))[wg * 16 + F.tid] = c; }
        __syncthreads();
    }
}
__device__ __forceinline__ void phase_moe_sort(Frame& F) {
    LAS int* tot = (LAS int*)F.lds;
    LAS int* pre = tot + 16;
    LAS int* seg = tot + 32;
    LAS int* le = tot + 64;
    const int* cnt = (const int*)(F.ws + MOE_CNT); const int* toke = (const int*)(F.ws + MOE_TOKE); const float* tokw = (const float*)(F.ws + MOE_TOKW);
    int* ptok = (int*)(F.ws + MOE_PTOK); float* pw = (float*)(F.ws + MOE_PW); int* meta = (int*)(F.ws + MOE_META);
    for (int wg = F.bid; wg < NLAT / 128; wg += F.G) {
        { LAS int* part = tot + 256;
          if (F.tid < 256) { const int col = F.tid & 15, pt = F.tid >> 4; int t = 0, p = 0;
#pragma unroll
              for (int i = 0; i < 16; ++i) { const int w = pt * 16 + i; const int c = cnt[w * 16 + col]; t += c; p += (w < wg) ? c : 0; }
              part[pt * 16 + col] = t; part[256 + pt * 16 + col] = p; }
          if (F.tid >= 256 && F.tid < 384) le[F.tid - 256] = toke[wg * 128 + F.tid - 256];
          __syncthreads();
          if (F.tid < 16) { int t = 0, p = 0;
#pragma unroll
              for (int pt = 0; pt < 16; ++pt) { t += part[pt * 16 + F.tid]; p += part[256 + pt * 16 + F.tid]; }
              tot[F.tid] = t; pre[F.tid] = p; } }
        __syncthreads();
        if (F.tid < 2) { int s = 0; for (int e = 0; e < 8; ++e) { seg[F.tid * 9 + e] = s; s += (tot[F.tid * 8 + e] + 255) & ~255; } seg[F.tid * 9 + 8] = s; }
        __syncthreads();
        if (F.tid < 256) { const int k = F.tid >> 7, t = F.tid & 127; const int e = (le[t] >> (8 * k)) & 0xff; int rank = 0; for (int u = 0; u < t; ++u) rank += (((le[u] >> (8 * k)) & 0xff) == e) ? 1 : 0;
            const int pos = seg[k * 9 + e] + pre[k * 8 + e] + rank; const int tok = wg * 128 + t; ptok[k * MROWS + pos] = tok; pw[k * MROWS + pos] = tokw[2 * tok + k]; ((int*)(F.ws + MOE_PPOS))[k * NLAT + tok] = pos; }
        if (wg < 16) { const int k = wg >> 3, e = wg & 7; const int a = seg[k * 9 + e] + tot[k * 8 + e], b = seg[k * 9 + e + 1]; for (int p = a + F.tid; p < b; p += NTHREADS) { ptok[k * MROWS + p] = -1; pw[k * MROWS + p] = 0.f; } }
        if (wg == 0 && F.tid < 18) meta[F.tid] = seg[F.tid] >> 8;
        __syncthreads();
    }
}
__device__ __forceinline__ void phase_final_a(Frame& F) {
    const int gw = F.bid * NWAVES + F.wave, NGW = F.G * NWAVES; const float* g = F.pa->in[I_GFINAL];
    const bf16_t* xb = (const bf16_t*)((const char*)F.out + XB_OFF); bf16_t* xc = (bf16_t*)(F.ws + WS_XCOPY);
    const int* meta = (const int*)(F.ws + MOE_META) + 9; const int npan = meta[8], gsz = npan - 128;
    const int S = (gsz > 0) ? pg8::split_factor(npan * 4, F.G, DEXP / 64, MAXSLAB_M) : 1;
    const int* ppos = (const int*)(F.ws + MOE_PPOS) + NLAT; const float* pw = (const float*)(F.ws + MOE_PW) + MROWS;
    const float* slab = (const float*)(F.ws + WS_SLABM); const float* gate_lat = (const float*)(F.ws + WS_MODLAT) + (size_t)8 * 6144 + 5120;
    for (int row0 = gw; row0 < NLAT; row0 += 4 * NGW) {
        u32x2 w[4][4]; int rr[4];
#pragma unroll
        for (int u = 0; u < 4; ++u) { const int row = (row0 + u * NGW < NLAT) ? row0 + u * NGW : row0; const u32x2* xr = (const u32x2*)(xb + (size_t)row * D) + F.lane; rr[u] = ppos[row];
#pragma unroll
            for (int j = 0; j < 4; ++j) w[u][j] = xr[64 * j]; }
#pragma unroll
        for (int u = 0; u < 4; ++u) { const int row = row0 + u * NGW; if (row >= NLAT) continue;
            f32x4 v[4];
#pragma unroll
            for (int j = 0; j < 4; ++j) v[j] = (f32x4){bf2f(w[u][j].x & 0xffffu), __uint_as_float(w[u][j].x & 0xffff0000u), bf2f(w[u][j].y & 0xffffu), __uint_as_float(w[u][j].y & 0xffff0000u)};
            if (S >= 2 && rr[u] >= NLAT) { const float wt = pw[rr[u]]; const int pmr = (rr[u] - NLAT) >> 8, r = rr[u] & 255; const f32x4* gt = (const f32x4*)(gate_lat + (size_t)(row / SEQ) * 6144);
#pragma unroll
                for (int j = 0; j < 4; ++j) { f32x4 a = zero4(); const float* sp = slab + (size_t)((pmr + gsz * j) * S) * 65536 + (size_t)r * 256 + 4 * F.lane;
                    for (int q = 0; q < S; ++q) a += *(const f32x4*)(sp + (size_t)q * 65536);
                    v[j] += (gt[F.lane + 64 * j] * wt) * a; } }
            if (row < NLAT / 2) { float ss = 0.f;
#pragma unroll
                for (int j = 0; j < 4; ++j) ss += (v[j].x * v[j].x + v[j].y * v[j].y) + (v[j].z * v[j].z + v[j].w * v[j].w);
                const float rstd = 1.0f / sqrtf(wave_sum(ss) * (1.0f / D) + EPS); f32x4* o = (f32x4*)(F.out + (size_t)row * D) + F.lane;
#pragma unroll
                for (int j = 0; j < 4; ++j) o[64 * j] = (v[j] * rstd) * ((const f32x4*)g)[F.lane + 64 * j]; }
            else { u32x2* o = (u32x2*)(xc + (size_t)(row - NLAT / 2) * D) + F.lane;
#pragma unroll
                for (int j = 0; j < 4; ++j) o[64 * j] = (u32x2){pk2(v[j].x, v[j].y), pk2(v[j].z, v[j].w)}; } }
    }
}
__device__ __forceinline__ void phase_final_b(Frame& F) {
    const int gw = F.bid * NWAVES + F.wave, NGW = F.G * NWAVES; const float* g = F.pa->in[I_GFINAL]; const bf16_t* xc = (const bf16_t*)(F.ws + WS_XCOPY);
    for (int row0 = NLAT / 2 + gw; row0 < NLAT; row0 += 4 * NGW) {
        u32x2 w[4][4];
#pragma unroll
        for (int u = 0; u < 4; ++u) { const int row = (row0 + u * NGW < NLAT) ? row0 + u * NGW : row0; const u32x2* xr = (const u32x2*)(xc + (size_t)(row - NLAT / 2) * D) + F.lane;
#pragma unroll
            for (int j = 0; j < 4; ++j) w[u][j] = xr[64 * j]; }
#pragma unroll
        for (int u = 0; u < 4; ++u) { const int row = row0 + u * NGW; if (row >= NLAT) continue;
            f32x4 v[4]; float ss = 0.f;
#pragma unroll
            for (int j = 0; j < 4; ++j) { v[j] = (f32x4){bf2f(w[u][j].x & 0xffffu), __uint_as_float(w[u][j].x & 0xffff0000u), bf2f(w[u][j].y & 0xffffu), __uint_as_float(w[u][j].y & 0xffff0000u)};
                ss += (v[j].x * v[j].x + v[j].y * v[j].y) + (v[j].z * v[j].z + v[j].w * v[j].w); }
            const float rstd = 1.0f / sqrtf(wave_sum(ss) * (1.0f / D) + EPS); f32x4* o = (f32x4*)(F.out + (size_t)row * D) + F.lane;
#pragma unroll
            for (int j = 0; j < 4; ++j) o[64 * j] = (v[j] * rstd) * ((const f32x4*)g)[F.lane + 64 * j]; }
    }
}

__device__ __forceinline__ bool fresh(Frame& F) {
    int l_ = (int)__builtin_amdgcn_mbcnt_hi(~0u, __builtin_amdgcn_mbcnt_lo(~0u, 0u)); asm volatile("" : "+v"(l_));
    int w_ = F.wave0; asm volatile("" : "+s"(w_));
    F.lane = l_; F.wave = w_; F.tid = w_ * 64 + l_;
    int b_ = blockIdx.x; asm volatile("" : "+s"(b_)); F.bid = b_;
    GAS unsigned char* w2_ = (GAS unsigned char*)F.ws0; asm volatile("" : "+s"(w2_)); F.ws = (unsigned char*)w2_;
    F.out = F.out0; F.pa = F.pa0;
    return true;
}
struct Item { int b, s, row0, seqbase, t0, seqlen; bool is_ctx; };
__device__ __forceinline__ Item item_info(int item) {
    Item it; it.b = item / SPB; it.s = item % SPB;
    if (it.s < 2) { it.is_ctx = true; it.seqbase = NLAT + it.b * CTXL; it.t0 = it.s * CHK; it.seqlen = CTXL; }
    else { it.is_ctx = false; it.seqbase = it.b * SEQ; it.t0 = (it.s - 2) * CHK; it.seqlen = SEQ; }
    it.row0 = it.seqbase + it.t0; return it;
}
constexpr int UCP = 144;
constexpr int TP = 272;
constexpr int TILEB = 128 * TP;
constexpr int VP = 288;
constexpr int TILEV = 128 * VP;

__device__ __forceinline__ unsigned tr_lane_addr(ldsp_t tile, int lane) { return (unsigned)(__SIZE_TYPE__)tile + (unsigned)((4 * (lane >> 4) + ((lane & 15) >> 2)) * VP + 8 * (lane & 3)); }
__device__ __forceinline__ bf16x8 mk_frag(u32x2 lo, u32x2 hi) { const u32x4 v = {lo.x, lo.y, hi.x, hi.y}; return __builtin_bit_cast(bf16x8, v); }
template <int OFF> __device__ __forceinline__ bf16x8 tr1(unsigned addr) {
    u32x2 a0, a1;
    asm volatile("ds_read_b64_tr_b16 %0, %2 offset:%3\n\tds_read_b64_tr_b16 %1, %2 offset:%4\n\ts_waitcnt lgkmcnt(0)" : "=&v"(a0), "=&v"(a1) : "v"(addr), "i"(OFF), "i"(OFF + 16 * VP) : "memory");
    return mk_frag(a0, a1);
}
template <int OFF> __device__ __forceinline__ void tr4(unsigned addr, bf16x8& f0, bf16x8& f1, bf16x8& f2, bf16x8& f3) {
    u32x2 a0, a1, b0, b1, c0, c1, d0, d1;
    asm volatile("ds_read_b64_tr_b16 %0, %8 offset:%9\n\tds_read_b64_tr_b16 %1, %8 offset:%10\n\tds_read_b64_tr_b16 %2, %8 offset:%11\n\tds_read_b64_tr_b16 %3, %8 offset:%12\n\t"
                 "ds_read_b64_tr_b16 %4, %8 offset:%13\n\tds_read_b64_tr_b16 %5, %8 offset:%14\n\tds_read_b64_tr_b16 %6, %8 offset:%15\n\tds_read_b64_tr_b16 %7, %8 offset:%16\n\ts_waitcnt lgkmcnt(0)"
                 : "=&v"(a0), "=&v"(a1), "=&v"(b0), "=&v"(b1), "=&v"(c0), "=&v"(c1), "=&v"(d0), "=&v"(d1)
                 : "v"(addr), "i"(OFF), "i"(OFF + 16 * VP), "i"(OFF + 32), "i"(OFF + 32 + 16 * VP), "i"(OFF + 64), "i"(OFF + 64 + 16 * VP), "i"(OFF + 96), "i"(OFF + 96 + 16 * VP) : "memory");
    f0 = mk_frag(a0, a1); f1 = mk_frag(b0, b1); f2 = mk_frag(c0, c1); f3 = mk_frag(d0, d1);
}

__device__ __forceinline__ void build_decay(Frame& F, int l) {
    LAS float* dec = (LAS float*)(F.lds + LDS_DEC);
    for (int i = F.tid; i < 2 * 4 * 132; i += NTHREADS) { const int n = i % 132, dh = i / 132; const float x = F.pa->in[I_RETDEC][l * 8 + dh]; const float lg = -log1pf(expf(-x)); dec[i] = expf((float)n * lg); }
}

struct RgStep { bf16x8 bwa[2], bwx[2]; float lam, ba, bx, carry; };
template <bool FINAL>
__device__ __forceinline__ void rg_load_step(RgStep& R, Frame& F, const bf16_t* wgt, int l, int dir, int item, int blk, int n, int lane) {
    const int fr = lane & 15, fq = lane >> 4;
    const bf16_t* wa = wgt + ((size_t)(0 * 8 + blk) * 64 + 16 * n + fr) * 64 + 8 * fq;
    const bf16_t* wx = wgt + ((size_t)(1 * 8 + blk) * 64 + 16 * n + fr) * 64 + 8 * fq;
    R.bwa[0] = *(const bf16x8*)wa; R.bwa[1] = *(const bf16x8*)(wa + 32); R.bwx[0] = *(const bf16x8*)wx; R.bwx[1] = *(const bf16x8*)(wx + 32);
    const int ch = blk * 64 + 16 * n + fr, pi = (l * 2 + dir) * 512 + ch;
    R.lam = F.pa->in[I_RGLAM][pi]; R.ba = F.pa->in[I_RGBA][pi]; R.bx = F.pa->in[I_RGBX][pi];
    R.carry = FINAL ? ((const float*)(F.ws + WS_CARRY))[((size_t)item * 2 + dir) * 512 + ch] : 0.f;
}
template <bool FINAL, int DIR>
__device__ __forceinline__ void rg_dir(ldsp_t ucw, const bf16x8 (&af)[8][2], const RgStep& R, int n, int lane, f32x4 (&hsum)[8], float& Atot, float& Htot) {
    const int fr = lane & 15, fq = lane >> 4;
    constexpr float L2E_ = 1.4426950408889634f;
    const float ba2 = -L2E_ * R.ba, bx2 = -L2E_ * R.bx, cl2 = -8.0f * L2E_ * log1pf(expf(-R.lam)), carry = R.carry;
    const bf16x8 bwa[2] = {R.bwa[0], R.bwa[1]}, bwx[2] = {R.bwx[0], R.bwx[1]};
    f32x4 ar[8], ai[8];
#pragma unroll
    for (int m = 0; m < 8; ++m) { ar[m] = zero4(); ai[m] = zero4(); }
#pragma unroll
    for (int m = 0; m < 8; ++m)
#pragma unroll
        for (int ks = 0; ks < 2; ++ks) { ar[m] = __builtin_amdgcn_mfma_f32_16x16x32_bf16(af[m][ks], bwa[ks], ar[m], 0, 0, 0); ai[m] = __builtin_amdgcn_mfma_f32_16x16x32_bf16(af[m][ks], bwx[ks], ai[m], 0, 0, 0); }
    const unsigned uo = (unsigned)(32 * fq * UCP + (16 * n + fr) * 2);
#pragma unroll
    for (int m = 0; m < 8; ++m)
#pragma unroll
        for (int jj = 0; jj < 4; ++jj) {
            const float r = __builtin_amdgcn_rcpf(1.0f + __builtin_amdgcn_exp2f(__builtin_fmaf(ar[m][jj], -1.4426950408889634f, ba2)));
            const float ig = __builtin_amdgcn_rcpf(1.0f + __builtin_amdgcn_exp2f(__builtin_fmaf(ai[m][jj], -1.4426950408889634f, bx2)));
            const float a = __builtin_amdgcn_exp2f(cl2 * r);
            const float u = bf2f(*(const LAS bf16_t*)(ucw + uo + (4 * m + jj) * UCP));
            ar[m][jj] = a; ai[m][jj] = __builtin_amdgcn_sqrtf(__builtin_fmaf(-a, a, 1.0f)) * ig * u; }
    float gA = 1.f, gH = 0.f;
#pragma unroll
    for (int mm = 0; mm < 8; ++mm) { const int m = DIR ? 7 - mm : mm;
#pragma unroll
        for (int j4 = 0; j4 < 4; ++j4) { const int jj = DIR ? 3 - j4 : j4; gH = __builtin_fmaf(ar[m][jj], gH, ai[m][jj]); gA *= ar[m][jj]; } }
    const float A0 = lane_bcast(gA, fr), H0 = lane_bcast(gH, fr), A1 = lane_bcast(gA, fr + 16), H1 = lane_bcast(gH, fr + 16), A2 = lane_bcast(gA, fr + 32), H2 = lane_bcast(gH, fr + 32), A3 = lane_bcast(gA, fr + 48), H3 = lane_bcast(gH, fr + 48);
    if (FINAL) { float h = carry;
        if (!DIR) { if (fq > 0) h = A0 * h + H0; if (fq > 1) h = A1 * h + H1; if (fq > 2) h = A2 * h + H2; }
        else { if (fq < 3) h = A3 * h + H3; if (fq < 2) h = A2 * h + H2; if (fq < 1) h = A1 * h + H1; }
#pragma unroll
        for (int mm = 0; mm < 8; ++mm) { const int m = DIR ? 7 - mm : mm;
#pragma unroll
            for (int j4 = 0; j4 < 4; ++j4) { const int jj = DIR ? 3 - j4 : j4; h = __builtin_fmaf(ar[m][jj], h, ai[m][jj]); hsum[m][jj] += h; } } }
    if (!DIR) Htot = A3 * (A2 * (A1 * H0 + H1) + H2) + H3; else Htot = A0 * (A1 * (A2 * H3 + H2) + H1) + H0;
    Atot = (A0 * A1) * (A2 * A3);
}
template <bool FINAL, bool SHARED = false>
__device__ __forceinline__ void rg_part(Frame& F, int l, int item, const Item& it, const int blk, const int n0, const int n1) {
    const bf16_t* P = (const bf16_t*)(F.ws + WS_PA);
    int lane = F.lane; const bool act = !SHARED || F.wave < 4;
    ldsp_t ucw = SHARED ? F.lds : F.lds + F.wave * (128 * UCP);
    if (act) { const int grp = lane & 7, ch0 = blk * 64 + grp * 8; float cw[4][8], cb[8];
#pragma unroll
      for (int k = 0; k < 4; ++k)
#pragma unroll
          for (int i = 0; i < 8; ++i) cw[k][i] = F.pa->in[I_CONVW][((size_t)l * 4 + k) * 512 + ch0 + i];
#pragma unroll
      for (int i = 0; i < 8; ++i) cb[i] = F.pa->in[I_CONVB][l * 512 + ch0 + i];
      const bf16_t* Pu = P + (size_t)it.seqbase * INW + ch0;
#pragma unroll 8
      for (int q = 0; q < (SHARED ? 4 : 16); ++q) { const int token = (SHARED ? 32 * F.wave : 0) + (lane >> 3) + 8 * q; float o[8];
#pragma unroll
          for (int i = 0; i < 8; ++i) o[i] = cb[i];
#pragma unroll
          for (int k = 0; k < 4; ++k) { const int tt = it.t0 + token + k - 2; const int tc = tt < 0 ? 0 : (tt >= it.seqlen ? it.seqlen - 1 : tt);
              u32x4 v = ldg<u32x4>(Pu, (unsigned)tc * (unsigned)(INW * 2)); if (tt != tc) v = (u32x4){0u, 0u, 0u, 0u};
              o[0] += cw[k][0] * bf2f(v.x & 0xffffu); o[1] += cw[k][1] * __uint_as_float(v.x & 0xffff0000u); o[2] += cw[k][2] * bf2f(v.y & 0xffffu); o[3] += cw[k][3] * __uint_as_float(v.y & 0xffff0000u);
              o[4] += cw[k][4] * bf2f(v.z & 0xffffu); o[5] += cw[k][5] * __uint_as_float(v.z & 0xffff0000u); o[6] += cw[k][6] * bf2f(v.w & 0xffffu); o[7] += cw[k][7] * __uint_as_float(v.w & 0xffff0000u); }
          u32x4 w; w.x = pk2(o[0], o[1]); w.y = pk2(o[2], o[3]); w.z = pk2(o[4], o[5]); w.w = pk2(o[6], o[7]);
          *(LAS u32x4*)(ucw + token * UCP + grp * 16) = w; }
      LDS_WAIT(); asm volatile("" ::: "memory"); }
    if (SHARED) __syncthreads();
    asm volatile("" : "+v"(lane));
    bf16x8 af[8][2];
    if (act) { const int fr = lane & 15, fq = lane >> 4;
#pragma unroll
      for (int m = 0; m < 8; ++m)
#pragma unroll
          for (int ks = 0; ks < 2; ++ks) af[m][ks] = *(const LAS bf16x8*)(ucw + (32 * (fr >> 2) + 4 * m + (fr & 3)) * UCP + (8 * fq + 32 * ks) * 2); }
    if (SHARED) { __syncthreads(); if (!act) return; }
    const bf16_t* wg0 = (const bf16_t*)(F.ws + WS_RGW) + (size_t)(l * 2 + 0) * 2 * 8 * 4096;
    const bf16_t* wg1 = (const bf16_t*)(F.ws + WS_RGW) + (size_t)(l * 2 + 1) * 2 * 8 * 4096;
    float* TOT = (float*)(F.ws + WS_TOT);
    RgStep R0, R1;
    rg_load_step<FINAL>(R0, F, wg0, l, 0, item, blk, n0, lane);
#pragma unroll 1
    for (int n = n0; n < n1; ++n) { asm volatile("" : "+v"(lane));
        const int fr = lane & 15, fq = lane >> 4; const int ch = blk * 64 + 16 * n + fr;
        f32x4 hsum[8];
#pragma unroll
        for (int m = 0; m < 8; ++m) hsum[m] = zero4();
        rg_load_step<FINAL>(R1, F, wg1, l, 1, item, blk, n, lane);
        { float At, Ht;
          rg_dir<FINAL, 0>(ucw, af, R0, n, lane, hsum, At, Ht);
          if (!FINAL && fq == 0) { *(f32x2*)(TOT + (((size_t)item * 2 + 0) * 512 + ch) * 2) = (f32x2){At, Ht}; } }
        __builtin_amdgcn_sched_barrier(0);
        if (n + 1 < n1) rg_load_step<FINAL>(R0, F, wg0, l, 0, item, blk, n + 1, lane);
        { float At, Ht;
          rg_dir<FINAL, 1>(ucw, af, R1, n, lane, hsum, At, Ht);
          if (!FINAL && fq == 0) { *(f32x2*)(TOT + (((size_t)item * 2 + 1) * 512 + ch) * 2) = (f32x2){At, Ht}; } }
        if (FINAL) {
            const unsigned uo = (unsigned)(32 * fq * UCP + (16 * n + fr) * 2);
#pragma unroll
            for (int m = 0; m < 8; ++m)
#pragma unroll
                for (int jj = 0; jj < 4; ++jj) *(LAS bf16_t*)(ucw + uo + (4 * m + jj) * UCP) = (bf16_t)f2bf(hsum[m][jj]); }
    }
    if (FINAL) {
        LDS_WAIT(); asm volatile("" : "+v"(lane) :: "memory");
        const int ng = 2 * (n1 - n0);
        const int grp = 2 * n0 + ((ng == 8) ? (lane & 7) : (lane & 1)); const int tk0 = (ng == 8) ? (lane >> 3) : (lane >> 1), tstep = (ng == 8) ? 8 : 32, nq = (ng == 8) ? 16 : 4;
        const bf16_t* Pg = P + (size_t)it.row0 * INW + 512 + blk * 64 + grp * 8; bf16_t* Yo = (bf16_t*)(F.ws + WS_Y) + (size_t)it.row0 * D + blk * 64 + grp * 8;
#pragma unroll 8
        for (int q = 0; q < nq; ++q) { const int token = tk0 + tstep * q;
            const u32x4 hv = *(const LAS u32x4*)(ucw + token * UCP + grp * 16); const u32x4 gv = ldg<u32x4>(Pg, (unsigned)token * (unsigned)(INW * 2));
            u32x4 w;
            w.x = pk2(gelu_tanh(bf2f(gv.x & 0xffffu)) * bf2f(hv.x & 0xffffu), gelu_tanh(__uint_as_float(gv.x & 0xffff0000u)) * __uint_as_float(hv.x & 0xffff0000u));
            w.y = pk2(gelu_tanh(bf2f(gv.y & 0xffffu)) * bf2f(hv.y & 0xffffu), gelu_tanh(__uint_as_float(gv.y & 0xffff0000u)) * __uint_as_float(hv.y & 0xffff0000u));
            w.z = pk2(gelu_tanh(bf2f(gv.z & 0xffffu)) * bf2f(hv.z & 0xffffu), gelu_tanh(__uint_as_float(gv.z & 0xffff0000u)) * __uint_as_float(hv.z & 0xffff0000u));
            w.w = pk2(gelu_tanh(bf2f(gv.w & 0xffffu)) * bf2f(hv.w & 0xffffu), gelu_tanh(__uint_as_float(gv.w & 0xffff0000u)) * __uint_as_float(hv.w & 0xffff0000u));
            stg<u32x4>(Yo, (unsigned)token * (unsigned)(D * 2), w); }
        LDS_WAIT();
    }
}

__device__ __forceinline__ void stage_rows(Frame& F, ldsp_t dst, const Item& it, int col0, bool rope) {
    const bf16_t* P = (const bf16_t*)(F.ws + WS_PA); const float* ct = (const float*)(F.ws + WS_ROPE); const float* st = ct + 4096 * 64;
    for (int task = F.tid; task < 1024; task += NTHREADS) { const int token = task >> 3, d0 = (task & 7) * 8;
        const bf16_t* src = P + (size_t)(it.row0 + token) * INW + col0;
        const u32x4 lo = *(const u32x4*)(src + d0), hi = *(const u32x4*)(src + d0 + 64);
        u32x4 olo = lo, ohi = hi;
        if (rope) { const int pos = it.t0 + token; const f32x4 c0 = *(const f32x4*)(ct + pos * 64 + d0), c1 = *(const f32x4*)(ct + pos * 64 + d0 + 4), s0 = *(const f32x4*)(st + pos * 64 + d0), s1 = *(const f32x4*)(st + pos * 64 + d0 + 4);
            const float a[8] = {bf2f(lo.x & 0xffffu), __uint_as_float(lo.x & 0xffff0000u), bf2f(lo.y & 0xffffu), __uint_as_float(lo.y & 0xffff0000u), bf2f(lo.z & 0xffffu), __uint_as_float(lo.z & 0xffff0000u), bf2f(lo.w & 0xffffu), __uint_as_float(lo.w & 0xffff0000u)};
            const float b[8] = {bf2f(hi.x & 0xffffu), __uint_as_float(hi.x & 0xffff0000u), bf2f(hi.y & 0xffffu), __uint_as_float(hi.y & 0xffff0000u), bf2f(hi.z & 0xffffu), __uint_as_float(hi.z & 0xffff0000u), bf2f(hi.w & 0xffffu), __uint_as_float(hi.w & 0xffff0000u)};
            const float c[8] = {c0.x, c0.y, c0.z, c0.w, c1.x, c1.y, c1.z, c1.w}, s[8] = {s0.x, s0.y, s0.z, s0.w, s1.x, s1.y, s1.z, s1.w};
            float ra[8], rb[8];
#pragma unroll
            for (int i = 0; i < 8; ++i) { ra[i] = a[i] * c[i] - b[i] * s[i]; rb[i] = a[i] * s[i] + b[i] * c[i]; }
            olo.x = pk2(ra[0], ra[1]); olo.y = pk2(ra[2], ra[3]); olo.z = pk2(ra[4], ra[5]); olo.w = pk2(ra[6], ra[7]);
            ohi.x = pk2(rb[0], rb[1]); ohi.y = pk2(rb[2], rb[3]); ohi.z = pk2(rb[4], rb[5]); ohi.w = pk2(rb[6], rb[7]); }
        *(LAS u32x4*)(dst + token * TP + d0 * 2) = olo; *(LAS u32x4*)(dst + token * TP + (d0 + 64) * 2) = ohi; }
}
__device__ __forceinline__ void stage_cols(Frame& F, ldsp_t dst, const Item& it, int col0) {
    const bf16_t* P = (const bf16_t*)(F.ws + WS_PA);
    for (int task = F.tid; task < 2048; task += NTHREADS) { const int token = task >> 4, d0 = (task & 15) * 8;
        const u32x4 v = *(const u32x4*)(P + (size_t)(it.row0 + token) * INW + col0 + d0);
        const unsigned w[4] = {v.x, v.y, v.z, v.w};
#pragma unroll
        for (int i = 0; i < 4; ++i) { *(LAS bf16_t*)(dst + (d0 + 2 * i) * TP + token * 2) = (bf16_t)(w[i] & 0xffffu); *(LAS bf16_t*)(dst + (d0 + 2 * i + 1) * TP + token * 2) = (bf16_t)(w[i] >> 16); } }
}
__device__ __forceinline__ void rope8(u32x4& lo, u32x4& hi, const float* ct, const float* st, int pos, int d0) {
    const f32x4 c0 = *(const f32x4*)(ct + pos * 64 + d0), c1 = *(const f32x4*)(ct + pos * 64 + d0 + 4), s0 = *(const f32x4*)(st + pos * 64 + d0), s1 = *(const f32x4*)(st + pos * 64 + d0 + 4);
    const float a[8] = {bf2f(lo.x & 0xffffu), __uint_as_float(lo.x & 0xffff0000u), bf2f(lo.y & 0xffffu), __uint_as_float(lo.y & 0xffff0000u), bf2f(lo.z & 0xffffu), __uint_as_float(lo.z & 0xffff0000u), bf2f(lo.w & 0xffffu), __uint_as_float(lo.w & 0xffff0000u)};
    const float b[8] = {bf2f(hi.x & 0xffffu), __uint_as_float(hi.x & 0xffff0000u), bf2f(hi.y & 0xffffu), __uint_as_float(hi.y & 0xffff0000u), bf2f(hi.z & 0xffffu), __uint_as_float(hi.z & 0xffff0000u), bf2f(hi.w & 0xffffu), __uint_as_float(hi.w & 0xffff0000u)};
    const float c[8] = {c0.x, c0.y, c0.z, c0.w, c1.x, c1.y, c1.z, c1.w}, sn[8] = {s0.x, s0.y, s0.z, s0.w, s1.x, s1.y, s1.z, s1.w};
    float ra[8], rb[8];
#pragma unroll
    for (int i = 0; i < 8; ++i) { ra[i] = a[i] * c[i] - b[i] * sn[i]; rb[i] = a[i] * sn[i] + b[i] * c[i]; }
    lo = (u32x4){pk2(ra[0], ra[1]), pk2(ra[2], ra[3]), pk2(ra[4], ra[5]), pk2(ra[6], ra[7])};
    hi = (u32x4){pk2(rb[0], rb[1]), pk2(rb[2], rb[3]), pk2(rb[4], rb[5]), pk2(rb[6], rb[7])};
}
struct KvRegs { u32x4 klo[2], khi[2], v[4]; };
__device__ __forceinline__ void kv_issue(Frame& F, KvRegs& R, const Item& it, int h) {
    const bf16_t* P = (const bf16_t*)(F.ws + WS_PA);
    const bf16_t* Pk = P + (size_t)it.row0 * INW + 1536 + h * HD; const bf16_t* Pv = P + (size_t)it.row0 * INW + 2048 + h * HD;
#pragma unroll
    for (int t2 = 0; t2 < 2; ++t2) { const int task = F.tid + t2 * NTHREADS, token = task >> 3, d0 = (task & 7) * 8;
        R.klo[t2] = ldg<u32x4>(Pk, (unsigned)(token * INW + d0) * 2u); R.khi[t2] = ldg<u32x4>(Pk, (unsigned)(token * INW + d0 + 64) * 2u); }
#pragma unroll
    for (int t4 = 0; t4 < 4; ++t4) { const int task = F.tid + t4 * NTHREADS, token = task >> 4, d0 = (task & 15) * 8; R.v[t4] = ldg<u32x4>(Pv, (unsigned)(token * INW + d0) * 2u); }
}
template <int KS> __device__ __forceinline__ void kv_step(unsigned aK, unsigned aVf, unsigned aVb, f32x4 (&accf)[8], f32x4 (&accb)[8]) {
    const bf16x8 af = tr1<KS * 32 * VP>(aVf), ab = tr1<KS * 32 * VP>(aVb);
    bf16x8 b[8];
    tr4<KS * 32 * VP>(aK, b[0], b[1], b[2], b[3]); tr4<KS * 32 * VP + 128>(aK, b[4], b[5], b[6], b[7]);
#pragma unroll
    for (int n = 0; n < 8; ++n) { accf[n] = __builtin_amdgcn_mfma_f32_16x16x32_bf16(af, b[n], accf[n], 0, 0, 0); accb[n] = __builtin_amdgcn_mfma_f32_16x16x32_bf16(ab, b[n], accb[n], 0, 0, 0); }
}
__device__ __forceinline__ void stage_state_t(Frame& F, ldsp_t dst, const bf16_t* St) {
#pragma unroll
    for (int t4 = 0; t4 < 4; ++t4) { const int task = F.tid + t4 * NTHREADS, e = task >> 4, c8 = task & 15;
        *(LAS u32x4*)(dst + e * TP + c8 * 16) = ldg<u32x4>(St, (unsigned)(e * 128 + c8 * 8) * 2u); }
}
__device__ __forceinline__ void mm16x128(ldsp_t At, int ra0, ldsp_t Bt, int lane, f32x4 (&acc)[8]) {
    const int fr = lane & 15, fq = lane >> 4;
#pragma unroll
    for (int ks = 0; ks < 4; ++ks) { const bf16x8 a = *(const LAS bf16x8*)(At + (ra0 + fr) * TP + (32 * ks + 8 * fq) * 2);
#pragma unroll
        for (int n = 0; n < 8; ++n) { const bf16x8 b = *(const LAS bf16x8*)(Bt + (16 * n + fr) * TP + (32 * ks + 8 * fq) * 2); acc[n] = __builtin_amdgcn_mfma_f32_16x16x32_bf16(a, b, acc[n], 0, 0, 0); } }
}

__device__ __forceinline__ void kv_head(Frame& F, KvRegs& R, KvRegs& Rn, bool pre, int item, const Item& it, int h) {
    bf16_t* KV = (bf16_t*)(F.ws + WS_KV);
    const float* ct = (const float*)(F.ws + WS_ROPE); const float* st = ct + 4096 * 64;
    const LAS float* dec = (const LAS float*)(F.lds + LDS_DEC); const bool rope = !it.is_ctx;
    ldsp_t tK = F.lds, tVf = F.lds + TILEV, tVb = F.lds + 2 * TILEV;
#pragma unroll
    for (int t2 = 0; t2 < 2; ++t2) { const int task = F.tid + t2 * NTHREADS, token = task >> 3, d0 = (task & 7) * 8;
        if (rope) rope8(R.klo[t2], R.khi[t2], ct, st, it.t0 + token, d0);
        *(LAS u32x4*)(tK + token * VP + d0 * 2) = R.klo[t2]; *(LAS u32x4*)(tK + token * VP + (d0 + 64) * 2) = R.khi[t2]; }
#pragma unroll
    for (int t4 = 0; t4 < 4; ++t4) { const int task = F.tid + t4 * NTHREADS, token = task >> 4, d0 = (task & 15) * 8; const u32x4 v = R.v[t4];
        const float df = dec[(0 * 4 + h) * 132 + 127 - token], db = dec[(1 * 4 + h) * 132 + token];
        const float x[8] = {bf2f(v.x & 0xffffu), __uint_as_float(v.x & 0xffff0000u), bf2f(v.y & 0xffffu), __uint_as_float(v.y & 0xffff0000u), bf2f(v.z & 0xffffu), __uint_as_float(v.z & 0xffff0000u), bf2f(v.w & 0xffffu), __uint_as_float(v.w & 0xffff0000u)};
        u32x4 wf, wb; wf.x = pk2(x[0] * df, x[1] * df); wf.y = pk2(x[2] * df, x[3] * df); wf.z = pk2(x[4] * df, x[5] * df); wf.w = pk2(x[6] * df, x[7] * df);
        wb.x = pk2(x[0] * db, x[1] * db); wb.y = pk2(x[2] * db, x[3] * db); wb.z = pk2(x[4] * db, x[5] * db); wb.w = pk2(x[6] * db, x[7] * db);
        *(LAS u32x4*)(tVf + token * VP + d0 * 2) = wf; *(LAS u32x4*)(tVb + token * VP + d0 * 2) = wb; }
    WG_BAR_LDS();
    if (pre) kv_issue(F, Rn, it, h + 1);
    f32x4 af[8], ab[8];
#pragma unroll
    for (int n = 0; n < 8; ++n) { af[n] = zero4(); ab[n] = zero4(); }
    { const unsigned aK = tr_lane_addr(tK, F.lane), aVf = tr_lane_addr(tVf, F.lane) + 32u * (unsigned)F.wave, aVb = tr_lane_addr(tVb, F.lane) + 32u * (unsigned)F.wave;
      kv_step<0>(aK, aVf, aVb, af, ab); kv_step<1>(aK, aVf, aVb, af, ab); kv_step<2>(aK, aVf, aVb, af, ab); kv_step<3>(aK, aVf, aVb, af, ab); }
    const int fr = F.lane & 15, fq = F.lane >> 4;
    bf16_t* of = KV + (((size_t)item * 4 + h) * 2 + 0) * 16384 + (size_t)(16 * F.wave) * 128;
    unsigned so = (unsigned)((4 * fq) * 128 + fr) * 2u; asm volatile("" : "+v"(so));
#pragma unroll
    for (int n = 0; n < 8; ++n)
#pragma unroll
        for (int jj = 0; jj < 4; ++jj) { stg<bf16_t>(of, so + (unsigned)((jj * 128 + 16 * n) * 2), (bf16_t)f2bf(af[n][jj])); stg<bf16_t>(of, so + (unsigned)((16384 + jj * 128 + 16 * n) * 2), (bf16_t)f2bf(ab[n][jj])); }
    WG_BAR_LDS();
}
__device__ __forceinline__ int latent_item(int c) { return (c >> 5) * SPB + 2 + (c & 31); }
__device__ __forceinline__ int ctx_item(int ci) { return (ci >> 1) * SPB + (ci & 1); }
__device__ __forceinline__ void phase_m1(Frame& F, int l) {
    build_decay(F, l); __syncthreads();
    for (int c = F.bid; c < 256; c += F.G) {
        fresh(F);
        { const int item = latent_item(c); const Item it = item_info(item);
          rg_part<false>(F, l, item, it, F.wave, 0, 4);
          __syncthreads();
          KvRegs A, B;
          fresh(F); kv_issue(F, A, it, 0);
          kv_head(F, A, B, true, item, it, 0);
          fresh(F); kv_head(F, B, A, true, item, it, 1);
          fresh(F); kv_head(F, A, B, true, item, it, 2);
          fresh(F); kv_head(F, B, A, false, item, it, 3); }
        fresh(F);
        if (c >= 64 && c < 192) { const int cu = c - 64; const int item = ctx_item(cu >> 3); const Item it = item_info(item);
            const int w4 = F.wave & 3; rg_part<false, true>(F, l, item, it, cu & 7, w4, w4 + 1); }
        __syncthreads();
        if (c < 64) { const int item = ctx_item(c >> 2); const Item it = item_info(item); KvRegs A, B; fresh(F); kv_issue(F, A, it, c & 3); kv_head(F, A, B, false, item, it, c & 3); }
    }
}
__device__ __forceinline__ int seq_order(int dir, int step) { return dir ? (step == 0 ? 1 : (step == 1 ? 0 : 35 - step)) : step; }
__device__ __forceinline__ void phase_m2(Frame& F, int l) {
    bf16_t* KV = (bf16_t*)(F.ws + WS_KV);
    const int gt = F.bid * NTHREADS + F.tid, NGT = F.G * NTHREADS;
    for (int c = gt; c < NB * NH * 2 * 128 * 16; c += NGT) {
        const int dc = c & 15, e = (c >> 4) & 127, dir = (c >> 11) & 1, h = (c >> 12) & 3, b = c >> 14;
        const float x = F.pa->in[I_RETDEC][l * 8 + dir * 4 + h]; const float decay = expf(128.0f * (-log1pf(expf(-x))));
        float S[8];
#pragma unroll
        for (int i = 0; i < 8; ++i) S[i] = 0.f;
        const unsigned lo = (unsigned)((((h * 2 + dir) * 128 + e) * 128 + dc * 8) * 2);
        for (int g0 = 0; g0 < SPB; g0 += 17) {
            u32x4 v[17];
#pragma unroll
            for (int i = 0; i < 17; ++i) { const int item = b * SPB + seq_order(dir, g0 + i); v[i] = ldg<u32x4>(KV + (size_t)item * 4 * 2 * 16384, lo); }
#pragma unroll
            for (int i = 0; i < 17; ++i) { const int item = b * SPB + seq_order(dir, g0 + i);
                u32x4 w; w.x = pk2(S[0], S[1]); w.y = pk2(S[2], S[3]); w.z = pk2(S[4], S[5]); w.w = pk2(S[6], S[7]);
                stg<u32x4>(KV + (size_t)item * 4 * 2 * 16384, lo, w);
                S[0] = S[0] * decay + bf2f(v[i].x & 0xffffu); S[1] = S[1] * decay + __uint_as_float(v[i].x & 0xffff0000u); S[2] = S[2] * decay + bf2f(v[i].y & 0xffffu); S[3] = S[3] * decay + __uint_as_float(v[i].y & 0xffff0000u);
                S[4] = S[4] * decay + bf2f(v[i].z & 0xffffu); S[5] = S[5] * decay + __uint_as_float(v[i].z & 0xffff0000u); S[6] = S[6] * decay + bf2f(v[i].w & 0xffffu); S[7] = S[7] * decay + __uint_as_float(v[i].w & 0xffff0000u); }
        }
    }
    const float* TOT = (const float*)(F.ws + WS_TOT); float* CARRY = (float*)(F.ws + WS_CARRY);
    for (int c = gt; c < NB * 2 * 512; c += NGT) { const int ch = c & 511, dir = (c >> 9) & 1, b = c >> 10; float cr = 0.f;
        for (int step = 0; step < SPB; ++step) { const int item = b * SPB + seq_order(dir, step); const f32x2 ah = *(const f32x2*)(TOT + (((size_t)item * 2 + dir) * 512 + ch) * 2);
            CARRY[((size_t)item * 2 + dir) * 512 + ch] = cr; cr = ah.x * cr + ah.y; } }
}
struct RetRegs { u32x4 v[4], sf[4], sb[4], klo[2], khi[2], g[4]; };
__device__ __forceinline__ void ret_issue(Frame& F, RetRegs& R, int item, const Item& it, int h) {
    const bf16_t* KV = (const bf16_t*)(F.ws + WS_KV); const bf16_t* P = (const bf16_t*)(F.ws + WS_PA);
    const bf16_t* Pk = P + (size_t)it.row0 * INW + 1536 + h * HD; const bf16_t* Pv = P + (size_t)it.row0 * INW + 2048 + h * HD;
    const bf16_t* Sf = KV + (((size_t)item * 4 + h) * 2 + 0) * 16384; const bf16_t* Sb = Sf + 16384;
    const int lane = F.lane, i0 = 16 * F.wave;
#pragma unroll
    for (int t2 = 0; t2 < 2; ++t2) { const int task = F.tid + t2 * NTHREADS, token = task >> 3, d0 = (task & 7) * 8;
        R.klo[t2] = ldg<u32x4>(Pk, (unsigned)(token * INW + d0) * 2u); R.khi[t2] = ldg<u32x4>(Pk, (unsigned)(token * INW + d0 + 64) * 2u); }
#pragma unroll
    for (int t4 = 0; t4 < 4; ++t4) { const int task = F.tid + t4 * NTHREADS, r = task >> 4, c8 = task & 15;
        R.v[t4] = ldg<u32x4>(Pv, (unsigned)(r * INW + c8 * 8) * 2u); R.sf[t4] = ldg<u32x4>(Sf, (unsigned)(r * 128 + c8 * 8) * 2u); R.sb[t4] = ldg<u32x4>(Sb, (unsigned)(r * 128 + c8 * 8) * 2u); }
    { const bf16_t* Pg = P + (size_t)(it.row0 + i0) * INW + 2560 + h * HD;
#pragma unroll
      for (int k = 0; k < 4; ++k) R.g[k] = ldg<u32x4>(Pg, (unsigned)((lane >> 2) * INW + 32 * (lane & 3) + 8 * k) * 2u); }
}
__device__ __forceinline__ void ret_head(Frame& F, RetRegs& R, RetRegs& Rn, bool pre, int item, const Item& it, int h) {
    bf16_t* Y = (bf16_t*)(F.ws + WS_Y);
    const float* ct = (const float*)(F.ws + WS_ROPE); const float* st = ct + 4096 * 64;
    const LAS float* dec = (const LAS float*)(F.lds + LDS_DEC);
    ldsp_t tK = F.lds, tV = F.lds + TILEB, tSf = tV + TILEV, tSb = tSf + TILEB;
    const bool rope = !it.is_ctx;
    const int lane = F.lane, fr = lane & 15, fq = lane >> 4, i0 = 16 * F.wave;
    u32x4 q4[4];
    { const bf16_t* Pq = (const bf16_t*)(F.ws + WS_PA) + (size_t)(it.row0 + i0) * INW + 1024 + h * HD;
#pragma unroll
      for (int ks = 0; ks < 4; ++ks) q4[ks] = ldg<u32x4>(Pq, (unsigned)(fr * INW + 32 * ks + 8 * fq) * 2u); }
#pragma unroll
    for (int t2 = 0; t2 < 2; ++t2) { const int task = F.tid + t2 * NTHREADS, token = task >> 3, d0 = (task & 7) * 8;
        if (rope) rope8(R.klo[t2], R.khi[t2], ct, st, it.t0 + token, d0);
        *(LAS u32x4*)(tK + token * TP + d0 * 2) = R.klo[t2]; *(LAS u32x4*)(tK + token * TP + (d0 + 64) * 2) = R.khi[t2]; }
#pragma unroll
    for (int t4 = 0; t4 < 4; ++t4) { const int task = F.tid + t4 * NTHREADS, r = task >> 4, c8 = task & 15;
        *(LAS u32x4*)(tV + r * VP + c8 * 16) = R.v[t4]; *(LAS u32x4*)(tSf + r * TP + c8 * 16) = R.sf[t4]; *(LAS u32x4*)(tSb + r * TP + c8 * 16) = R.sb[t4]; }
    bf16x8 qf[4];
    { if (rope) { rope8(q4[0], q4[2], ct, st, it.t0 + i0 + fr, 8 * fq); rope8(q4[1], q4[3], ct, st, it.t0 + i0 + fr, 32 + 8 * fq); }
#pragma unroll
      for (int ks = 0; ks < 4; ++ks) qf[ks] = __builtin_bit_cast(bf16x8, q4[ks]); }
    u32x4 gk[4];
#pragma unroll
    for (int k = 0; k < 4; ++k) gk[k] = R.g[k];
    WG_BAR_LDS();
    if (pre) ret_issue(F, Rn, item, it, h + 1);
    bf16x8 pa[4];
    { f32x4 C[8];
#pragma unroll
      for (int jt = 0; jt < 8; ++jt) { C[jt] = zero4();
#pragma unroll
          for (int ks = 0; ks < 4; ++ks) { const bf16x8 a = *(const LAS bf16x8*)(tK + (16 * jt + fr) * TP + (32 * ks + 8 * fq) * 2); C[jt] = __builtin_amdgcn_mfma_f32_16x16x32_bf16(a, qf[ks], C[jt], 0, 0, 0); } }
      const int i = i0 + fr;
#pragma unroll
      for (int jt = 0; jt < 8; ++jt)
#pragma unroll
          for (int jj = 0; jj < 4; ++jj) { const int j = 16 * jt + 4 * fq + jj; const float dcy = (i >= j) ? dec[(0 * 4 + h) * 132 + (i - j)] : dec[(1 * 4 + h) * 132 + (j - i)]; C[jt][jj] *= dcy; }
#pragma unroll
      for (int u = 0; u < 4; ++u) { const u32x4 w = {pg8::cvt_pk_bf16(C[2 * u][0], C[2 * u][1]), pg8::cvt_pk_bf16(C[2 * u][2], C[2 * u][3]), pg8::cvt_pk_bf16(C[2 * u + 1][0], C[2 * u + 1][1]), pg8::cvt_pk_bf16(C[2 * u + 1][2], C[2 * u + 1][3])};
          pa[u] = __builtin_bit_cast(bf16x8, w); } }
    WG_BAR_LDS();
    { ldsp_t gt = tK + (i0 + (lane >> 2)) * TP + (lane & 3) * 64;
#pragma unroll
      for (int k = 0; k < 4; ++k) *(LAS u32x4*)(gt + 16 * k) = gk[k]; }
    f32x4 o[8];
#pragma unroll
    for (int n = 0; n < 8; ++n) o[n] = zero4();
    { const unsigned aV = tr_lane_addr(tV, lane); bf16x8 b[8];
#define RET_PV(U) do { tr4<(U) * 32 * VP>(aV, b[0], b[1], b[2], b[3]); tr4<(U) * 32 * VP + 128>(aV, b[4], b[5], b[6], b[7]); \
        _Pragma("unroll") for (int n = 0; n < 8; ++n) o[n] = __builtin_amdgcn_mfma_f32_16x16x32_bf16(pa[U], b[n], o[n], 0, 0, 0); } while (0)
      RET_PV(0); RET_PV(1); RET_PV(2); RET_PV(3);
#undef RET_PV
    }
    { f32x4 cf[8];
#pragma unroll
      for (int n = 0; n < 8; ++n) { cf[n] = zero4();
#pragma unroll
          for (int ks = 0; ks < 4; ++ks) { const bf16x8 b = *(const LAS bf16x8*)(tSf + (16 * n + fr) * TP + (32 * ks + 8 * fq) * 2); cf[n] = __builtin_amdgcn_mfma_f32_16x16x32_bf16(qf[ks], b, cf[n], 0, 0, 0); } }
#pragma unroll
      for (int jj = 0; jj < 4; ++jj) { const float sf = dec[(0 * 4 + h) * 132 + (i0 + 4 * fq + jj + 1)];
#pragma unroll
          for (int n = 0; n < 8; ++n) o[n][jj] += sf * cf[n][jj]; } }
    { f32x4 cb[8];
#pragma unroll
      for (int n = 0; n < 8; ++n) { cb[n] = zero4();
#pragma unroll
          for (int ks = 0; ks < 4; ++ks) { const bf16x8 b = *(const LAS bf16x8*)(tSb + (16 * n + fr) * TP + (32 * ks + 8 * fq) * 2); cb[n] = __builtin_amdgcn_mfma_f32_16x16x32_bf16(qf[ks], b, cb[n], 0, 0, 0); } }
#pragma unroll
      for (int jj = 0; jj < 4; ++jj) { const float sb = dec[(1 * 4 + h) * 132 + (128 - (i0 + 4 * fq + jj))];
#pragma unroll
          for (int n = 0; n < 8; ++n) o[n][jj] += sb * cb[n][jj]; } }
    { ldsp_t gc = tK + (i0 + 4 * fq) * TP + fr * 2;
#pragma unroll
      for (int jj = 0; jj < 4; ++jj) { float s1 = 0.f;
#pragma unroll
          for (int n = 0; n < 8; ++n) s1 += o[n][jj];
          s1 += swz_xor<1>(s1); s1 += swz_xor<2>(s1); s1 += swz_xor<4>(s1); s1 += swz_xor<8>(s1);
          const float mu = s1 * (1.0f / 128.0f); float q = 0.f;
#pragma unroll
          for (int n = 0; n < 8; ++n) { const float dd = o[n][jj] - mu; q += dd * dd; }
          q += swz_xor<1>(q); q += swz_xor<2>(q); q += swz_xor<4>(q); q += swz_xor<8>(q);
          const float rstd = 1.0f / sqrtf(q * (1.0f / 128.0f) + EPS);
#pragma unroll
          for (int n = 0; n < 8; ++n) { LAS bf16_t* p = (LAS bf16_t*)(gc + jj * TP + 32 * n); const float gv = bf2f(*p); *p = (bf16_t)f2bf(siluf_(gv) * (o[n][jj] - mu) * rstd); } } }
    LDS_WAIT(); asm volatile("" ::: "memory");
    { ldsp_t gt = tK + (i0 + (lane >> 2)) * TP + (lane & 3) * 64; bf16_t* Yo = Y + (size_t)(it.row0 + i0) * D + 512 + h * HD;
#pragma unroll
      for (int k = 0; k < 4; ++k) stg<u32x4>(Yo, (unsigned)((lane >> 2) * D + 32 * (lane & 3) + 8 * k) * 2u, *(const LAS u32x4*)(gt + 16 * k)); }
    WG_BAR_LDS();
}
__device__ __forceinline__ void phase_m3(Frame& F, int l) {
    build_decay(F, l); __syncthreads();
    for (int c = F.bid; c < 256; c += F.G) {
        fresh(F);
        { const int item = latent_item(c); const Item it = item_info(item);
#ifndef PROBE_M3
#define PROBE_M3 0
#endif
          for (int r_ = 0; r_ < ((PROBE_M3 & 1) ? 2 : 1); ++r_) { fresh(F); rg_part<true>(F, l, item, it, F.wave, 0, 4); }
          __syncthreads();
          for (int r_ = 0; r_ < ((PROBE_M3 & 2) ? 2 : 1); ++r_) {
          RetRegs R, Rn;
          fresh(F); ret_issue(F, R, item, it, 0);
          ret_head(F, R, Rn, true, item, it, 0);
          fresh(F); ret_head(F, Rn, R, true, item, it, 1);
          fresh(F); ret_head(F, R, Rn, true, item, it, 2);
          fresh(F); ret_head(F, Rn, R, false, item, it, 3); } }
        if (l == 0) {
            fresh(F);
            if (c >= 64 && c < 192) { const int cu = c - 64; const int item = ctx_item(cu >> 3); const Item it = item_info(item);
                const int w4 = F.wave & 3; rg_part<true, true>(F, l, item, it, cu & 7, w4, w4 + 1); }
            __syncthreads();
            if (c < 64) { const int item = ctx_item(c >> 2); const Item it = item_info(item); RetRegs R, Rn; fresh(F); ret_issue(F, R, item, it, c & 3); ret_head(F, R, Rn, false, item, it, c & 3); }
        }
    }
}

constexpr int N_PHASES = 24;
__global__ void __launch_bounds__(NTHREADS, 2) fwd_kernel(Args args) {
    extern __shared__ __attribute__((aligned(16))) unsigned char lds_raw[];
    Frame F; F.lds = (ldsp_t)lds_raw; F.wave0 = __builtin_amdgcn_readfirstlane((int)threadIdx.x >> 6); F.G = gridDim.x; F.pa0 = &args; F.out0 = args.out; F.ws0 = args.ws; fresh(F);
    volatile LAS unsigned* MISC = (volatile LAS unsigned*)(F.lds + LDS_MISC);
    if (F.tid < 64) MISC[F.tid] = 0u;
    __syncthreads();
    const int lo = args.ph_lo, hi = args.ph_hi;
    XcdBarrier bar; bar.bar = (unsigned*)(F.ws + WS_CTL); bar.x = 0; bar.st = nullptr;
    if (hi - lo > 1) bar = xcd_barrier_post((unsigned*)(F.ws + WS_CTL), MISC);
#ifndef DIAG_MASK
#define DIAG_MASK 0xffffffffu
#endif
#ifndef REPEAT_MASK
#define REPEAT_MASK 0u
#endif
#define REPS(kind) ((((REPEAT_MASK) >> (kind)) & 1u) ? 2 : 1)
#define INK(k, kind) (((DIAG_MASK >> (kind)) & 1u) && lo <= (k) && (k) < hi && fresh(F))
#define IN(k) (lo <= (k) && (k) < hi)
#define SEAM(k) do { if (IN(k) && IN((k) + 1)) xcd_barrier(bar); } while (0)
    float* ctxx = (float*)(F.ws + WS_CTXX); bf16_t* xb = (bf16_t*)((char*)F.out + XB_OFF);
    const float* modlat = (const float*)(F.ws + WS_MODLAT); const float* modctx = (const float*)(F.ws + WS_MODCTX);

    if (INK(0, 0)) { for (int r_ = 0; r_ < REPS(0); ++r_) { phase_convert_small(F); __syncthreads(); phase_mod(F); __syncthreads(); } } SEAM(0);
    if (INK(1, 1)) { for (int r_ = 0; r_ < REPS(1); ++r_) phase_norm(F, 0, 0, F.pa->in[I_X], nullptr, F.pa->in[I_CTX], MROWS, SlabRed{nullptr, 0, nullptr, nullptr, nullptr}); } SEAM(1);
#pragma unroll 1
    for (int l = 0; l < 2; ++l) {
        const int pb = (l == 0) ? 2 : 11;
        if (INK(pb + 0, 2)) { pg8::Gemm g{(const bf16_t*)(F.ws + WS_HX), (const bf16_t*)(F.ws + WS_WIN) + (size_t)l * INW * D, INW, D, 0, nullptr}; pg8::Order S; S.init(MROWS / 256, INW / 256, F.G, F.bid, nullptr, nullptr, D / 64, false, 0);
            pg8::EpiBf16 E{(bf16_t*)(F.ws + WS_PA), INW}; for (int r_ = 0; r_ < REPS(2); ++r_) pg8::gemm_phase<pg8::EpiBf16>(F.lds, g, S, E, F.tid); }
        SEAM(pb + 0);
        if (INK(pb + 1, 3)) { for (int r_ = 0; r_ < REPS(3); ++r_) phase_m1(F, l); }
        SEAM(pb + 1);
        if (INK(pb + 2, 4)) { for (int r_ = 0; r_ < REPS(4); ++r_) { if (r_) phase_m1(F, l); phase_m2(F, l); } }
        SEAM(pb + 2);
        if (INK(pb + 3, 5)) { for (int r_ = 0; r_ < REPS(5); ++r_) phase_m3(F, l); }
        SEAM(pb + 3);
        if (INK(pb + 4, 6)) { pg8::Gemm g{(const bf16_t*)(F.ws + WS_Y), (const bf16_t*)(F.ws + WS_WOUT) + (size_t)l * D * D, D, D, 0, (float*)(F.ws + WS_SLABA)}; pg8::Order S; S.init((l == 0 ? MROWS : NLAT) / 256, D / 256, F.G, F.bid, nullptr, nullptr, D / 64, true, MAXSLAB_A);
            pg8::EpiResid E{l == 0 ? F.pa->in[I_X] : nullptr, xb, F.pa->in[I_CTX], ctxx, modlat + (size_t)l * 8 * 6144 + 2048, modctx + (size_t)l * 6144 + 2048};
            pg8::gemm_phase<pg8::EpiResid>(F.lds, g, S, E, F.tid); }
        SEAM(pb + 4);
        if (l == 0) {
            if (INK(7, 1)) { for (int r_ = 0; r_ < REPS(1); ++r_) phase_norm(F, 0, 1, nullptr, xb, ctxx, MROWS, SlabRed{(const float*)(F.ws + WS_SLABA), pg8::split_factor((MROWS / 256) * 4, F.G, D / 64, MAXSLAB_A), modctx + 2048, F.pa->in[I_CTX], ctxx}); } SEAM(7);
            if (INK(8, 7)) { pg8::Gemm g{(const bf16_t*)(F.ws + WS_HX), (const bf16_t*)(F.ws + WS_WUP), 2 * DFF, D, 0, nullptr}; pg8::Order S; S.init(MROWS / 256, 2 * DFF / 256, F.G, F.bid, nullptr, nullptr, D / 64, false, 0);
                pg8::EpiSwiGLU E{(bf16_t*)(F.ws + WS_PA), DFF}; for (int r_ = 0; r_ < REPS(7); ++r_) pg8::gemm_phase<pg8::EpiSwiGLU>(F.lds, g, S, E, F.tid); }
            SEAM(8);
            if (INK(9, 8)) { pg8::Gemm g{(const bf16_t*)(F.ws + WS_PA), (const bf16_t*)(F.ws + WS_WDN), D, DFF, 0, (float*)(F.ws + WS_SLABA)}; pg8::Order S; S.init(MROWS / 256, D / 256, F.G, F.bid, nullptr, nullptr, DFF / 64, true, MAXSLAB_A);
                pg8::EpiResid E{nullptr, xb, (const float*)ctxx, ctxx, modlat + 5120, modctx + 5120}; pg8::gemm_phase<pg8::EpiResid>(F.lds, g, S, E, F.tid); }
            SEAM(9);
            if (INK(10, 1)) { for (int r_ = 0; r_ < REPS(1); ++r_) phase_norm(F, 1, 0, nullptr, xb, ctxx, MROWS, SlabRed{(const float*)(F.ws + WS_SLABA), pg8::split_factor((MROWS / 256) * 4, F.G, DFF / 64, MAXSLAB_A), modctx + 5120, ctxx, ctxx}); } SEAM(10);
        }
    }
    if (INK(16, 9)) { for (int r_ = 0; r_ < REPS(9); ++r_) { phase_norm_router(F, xb); __syncthreads(); phase_convert_moe(F); __syncthreads(); } } SEAM(16);
    if (INK(17, 10)) { phase_moe_sort(F); } SEAM(17);
#pragma unroll 1
    for (int k = 0; k < 2; ++k) {
        const int* meta = (const int*)(F.ws + MOE_META) + 9 * k;
        if (INK(18 + 2 * k, 11)) { if (k == 1) { moe_reduce(F, 0); __syncthreads(); } pg8::Gemm g{(const bf16_t*)(F.ws + WS_HX), (const bf16_t*)(F.ws + WS_MOEUP), 2 * DEXP, D, (size_t)2 * DEXP * D * 2, nullptr}; pg8::Order S; S.init(meta[8], 2 * DEXP / 256, F.G, F.bid, meta, (const int*)(F.ws + MOE_PTOK) + k * MROWS, D / 64, false, 0);
            pg8::EpiSwiGLU E{(bf16_t*)(F.ws + WS_PA), DEXP}; for (int r_ = 0; r_ < REPS(11); ++r_) pg8::gemm_phase<pg8::EpiSwiGLU>(F.lds, g, S, E, F.tid); }
        SEAM(18 + 2 * k);
        if (INK(19 + 2 * k, 12)) { pg8::Gemm g{(const bf16_t*)(F.ws + WS_PA), (const bf16_t*)(F.ws + WS_MOEDN), D, DEXP, (size_t)D * DEXP * 2, (float*)(F.ws + WS_SLABM)}; pg8::Order S; S.init(meta[8], D / 256, F.G, F.bid, meta, nullptr, DEXP / 64, true, MAXSLAB_M);
            pg8::EpiMoeDown E{xb, (const int*)(F.ws + MOE_PTOK) + k * MROWS, (const float*)(F.ws + MOE_PW) + k * MROWS, modlat + (size_t)8 * 6144 + 5120}; pg8::gemm_phase<pg8::EpiMoeDown>(F.lds, g, S, E, F.tid); }
        SEAM(19 + 2 * k);
    }
    if (INK(22, 13)) phase_final_a(F);
    SEAM(22);
    if (INK(23, 13)) phase_final_b(F);
#undef IN
#undef INK
#undef SEAM
}

extern "C" void kernel_launch(void* const* d_in, const int* in_sizes, int n_in, void* d_out, int out_size, void* d_ws, size_t ws_size, hipStream_t stream) {
    static int grid = 0;
    if (grid == 0) {
        if (n_in != 27 || in_sizes[0] != NLAT * D || out_size != NLAT * D || ws_size < WS_END) { fprintf(stderr, "kernel_launch: unexpected problem (n_in %d, in0 %d, out %d, ws %zu, need %zu); nothing launched\n", n_in, n_in > 0 ? in_sizes[0] : -1, out_size, ws_size, (size_t)WS_END); grid = -1; return; }
        int dev = 0, cus = 0, per_cu = 0;
        if (hipGetDevice(&dev) != hipSuccess || hipDeviceGetAttribute(&cus, hipDeviceAttributeMultiprocessorCount, dev) != hipSuccess) { grid = -1; return; }
        if (hipFuncSetAttribute((const void*)fwd_kernel, hipFuncAttributeMaxDynamicSharedMemorySize, LDS_BYTES) != hipSuccess) { fprintf(stderr, "kernel_launch: hipFuncSetAttribute failed\n"); grid = -1; return; }
        if (hipOccupancyMaxActiveBlocksPerMultiprocessor(&per_cu, (const void*)fwd_kernel, NTHREADS, LDS_BYTES) != hipSuccess || per_cu < 1) { fprintf(stderr, "kernel_launch: occupancy query says %d\n", per_cu); }
        (void)hipGetLastError();
        grid = cus;
    }
    if (grid < 0) return;
    (void)hipMemsetAsync((char*)d_ws + WS_CTL, 0, CTL_ZERO_BYTES, stream);
    Args a; memset(&a, 0, sizeof(a));
    for (int i = 0; i < 27; ++i) a.in[i] = (const float*)d_in[i];
    a.out = (float*)d_out; a.ws = (unsigned char*)d_ws;
#if MK_ONE_LAUNCH
    a.ph_lo = 0; a.ph_hi = N_PHASES;
    hipLaunchKernelGGL(fwd_kernel, dim3(grid), dim3(NTHREADS), LDS_BYTES, stream, a);
#else
    for (int p = 0; p < N_PHASES; ++p) { a.ph_lo = p; a.ph_hi = p + 1; hipLaunchKernelGGL(fwd_kernel, dim3(grid), dim3(NTHREADS), LDS_BYTES, stream, a); }
#endif
}
```

```cpp
#include <hip/hip_runtime.h>
#include <cstdio>
#include <cstdint>
#include <cstring>

#ifndef MK_ONE_LAUNCH
#define MK_ONE_LAUNCH 1
#endif

#define GAS __attribute__((address_space(1)))
#define LAS __attribute__((address_space(3)))
typedef unsigned short bf16_t;
typedef short bf16x8 __attribute__((ext_vector_type(8)));
typedef float f32x4 __attribute__((ext_vector_type(4)));
typedef float f32x2 __attribute__((ext_vector_type(2)));
typedef unsigned u32x4 __attribute__((ext_vector_type(4)));
typedef unsigned u32x2 __attribute__((ext_vector_type(2)));
typedef LAS unsigned char* ldsp_t;

constexpr int D = 1024, NB = 8, SEQ = 4096, NLAT = NB * SEQ, CTXL = 256, NCTX = NB * CTXL, MROWS = NLAT + NCTX;
constexpr int INW = 3072, NH = 4, HD = 128, CHK = 128;
constexpr int DFF = 2816, NE = 8, DEXP = 3584;
constexpr int SPB = 34;
constexpr int NITEM = NB * SPB;
constexpr float EPS = 1e-6f;
constexpr int NWAVES = 8, NTHREADS = 512;

constexpr size_t MiB = 1u << 20;
constexpr size_t WS_CTL = 0, CTL_ZERO_BYTES = 64 * 1024;
constexpr size_t WS_MODLAT = 1 * MiB;
constexpr size_t WS_MODCTX = 1 * MiB + 2 * 8 * 6144 * 4;
constexpr size_t WS_ROPE = 2 * MiB;
constexpr size_t WS_RGW = 4 * MiB;
constexpr size_t WS_TOT = 5 * MiB;
constexpr size_t WS_CARRY = 8 * MiB;
constexpr size_t WS_MOE = 10 * MiB;
constexpr size_t MOE_CNT = WS_MOE, MOE_META = WS_MOE + 16384, MOE_TOKE = WS_MOE + 65536, MOE_TOKW = WS_MOE + 262144,
                 MOE_PTOK = WS_MOE + 524288, MOE_PW = WS_MOE + 1048576, MOE_PPOS = WS_MOE + 1572864;
constexpr size_t WS_CTXX = 12 * MiB;
constexpr size_t WS_WIN = 20 * MiB;
constexpr size_t WS_WOUT = 32 * MiB;
constexpr size_t WS_WUP = 36 * MiB;
constexpr size_t WS_WDN = 47 * MiB;
constexpr size_t WS_HX = 54 * MiB;
constexpr size_t WS_PA = 122 * MiB;
constexpr size_t WS_KV = 360 * MiB;
constexpr size_t WS_Y = 496 * MiB;
constexpr size_t WS_MOEUP = 360 * MiB;
constexpr size_t WS_MOEDN = 472 * MiB;
constexpr size_t WS_SLABA = WS_KV;
constexpr size_t WS_SLABM = 528 * MiB;
constexpr int MAXSLAB_A = 256, MAXSLAB_M = 216;
constexpr size_t XB_OFF = (size_t)NLAT * D * 2;
constexpr size_t WS_XCOPY = WS_PA;
constexpr size_t WS_END = 582 * MiB;
static_assert(WS_MOEDN + (size_t)NE * D * DEXP * 2 <= WS_END, "ws map");
static_assert(WS_PA + (size_t)MROWS * DEXP * 2 <= WS_KV, "ws map");

constexpr int LDS_SCRATCH = 147456;
constexpr int LDS_MISC = LDS_SCRATCH;
constexpr int LDS_DEC = LDS_MISC + 256;
constexpr int LDS_BYTES = LDS_SCRATCH + 8192;

__device__ __forceinline__ float bf2f(unsigned v) { return __uint_as_float(v << 16); }
typedef __bf16 bf16x2_t __attribute__((ext_vector_type(2)));
__device__ __forceinline__ unsigned pk2(float lo, float hi) { const f32x2 v = {lo, hi}; return __builtin_bit_cast(unsigned, __builtin_convertvector(v, bf16x2_t)); }
__device__ __forceinline__ unsigned f2bf(float f) { return pk2(f, f) & 0xffffu; }
__device__ __forceinline__ void unpack8(const u32x4 v, f32x4& a, f32x4& b) {
    a = (f32x4){bf2f(v.x & 0xffffu), __uint_as_float(v.x & 0xffff0000u), bf2f(v.y & 0xffffu), __uint_as_float(v.y & 0xffff0000u)};
    b = (f32x4){bf2f(v.z & 0xffffu), __uint_as_float(v.z & 0xffff0000u), bf2f(v.w & 0xffffu), __uint_as_float(v.w & 0xffff0000u)}; }
__device__ __forceinline__ u32x4 pack8(const f32x4 a, const f32x4 b) { return (u32x4){pk2(a.x, a.y), pk2(a.z, a.w), pk2(b.x, b.y), pk2(b.z, b.w)}; }
template <int M> __device__ __forceinline__ float swz_xor(float v) { return __int_as_float(__builtin_amdgcn_ds_swizzle(__float_as_int(v), (M << 10) | 0x1f)); }
__device__ __forceinline__ float wave_sum(float v) {
    v += swz_xor<1>(v); v += swz_xor<2>(v); v += swz_xor<4>(v); v += swz_xor<8>(v); v += swz_xor<16>(v);
    const auto r = __builtin_amdgcn_permlane32_swap(__float_as_uint(v), __float_as_uint(v), false, false);
    return __uint_as_float(r[0]) + __uint_as_float(r[1]);
}
__device__ __forceinline__ float lane_bcast(float v, int src_lane) { return __int_as_float(__builtin_amdgcn_ds_bpermute(src_lane << 2, __float_as_int(v))); }
__device__ __forceinline__ float sigmoidf_(float x) { return __builtin_amdgcn_rcpf(1.0f + __expf(-x)); }
__device__ __forceinline__ float siluf_(float x) { return x * __builtin_amdgcn_rcpf(1.0f + __expf(-x)); }
__device__ __forceinline__ float gelu_tanh(float x) { const float z = 0.7978845608028654f * (x + 0.044715f * x * x * x); return x * (1.0f - __builtin_amdgcn_rcpf(1.0f + __expf(2.0f * z))); }
#define LDS_WAIT() asm volatile("s_waitcnt lgkmcnt(0)" ::: "memory")
#define WG_BAR_LDS() do { asm volatile("s_waitcnt lgkmcnt(0)" ::: "memory"); __builtin_amdgcn_s_barrier(); asm volatile("" ::: "memory"); } while (0)
__device__ __forceinline__ f32x4 zero4() { float z; asm volatile("v_mov_b32 %0, 0" : "=v"(z)); return (f32x4){z, z, z, z}; }

template <typename T> __device__ __forceinline__ T ldg(const void* base, unsigned off) { return *(const GAS T*)((const GAS char*)base + off); }
template <typename T> __device__ __forceinline__ void stg(void* base, unsigned off, T v) { *(GAS T*)((GAS char*)base + off) = v; }
#define XB_TMO      128
#define XB_XCNT(j)  (256  + 64 * (j))
#define XB_XSUB(j)  (1280 + 64 * (j))
#define XB_XGEN(j)  (2304 + 64 * (j))
#define XB_TOP      3328
#define XB_TOPGEN   3392
#define XCD_BAR_WORDS 3456
#define XB_SPIN_CAP (1u << 18)
__device__ __forceinline__ unsigned xb_ld(unsigned* p)              { return __hip_atomic_load(p, __ATOMIC_RELAXED, __HIP_MEMORY_SCOPE_AGENT); }
__device__ __forceinline__ unsigned xb_add(unsigned* p, unsigned v) { return __hip_atomic_fetch_add(p, v, __ATOMIC_RELAXED, __HIP_MEMORY_SCOPE_AGENT); }
__device__ __forceinline__ unsigned xb_xcc_id() { return (unsigned)__builtin_amdgcn_s_getreg((3 << 11) | 20) & 0xFu; }
#define XB_SPIN(cond, bar) do { unsigned _sp = 0; while (cond) { __builtin_amdgcn_s_sleep(1); \
    if ((++_sp & 255u) == 0u) { if (xb_ld(&(bar)[XB_TMO])) break; if (_sp > XB_SPIN_CAP) { atomicAdd(&(bar)[XB_TMO], 1u); break; } } } } while (0)
struct XcdBarrier { unsigned* bar; unsigned x; volatile LAS unsigned* st; };
__device__ __forceinline__ XcdBarrier xcd_barrier_post(unsigned* bar, volatile LAS unsigned* st) {
    XcdBarrier b; b.bar = bar; b.x = xb_xcc_id(); b.st = st;
    if (threadIdx.x == 0) (void)xb_add(&bar[XB_XCNT(b.x)], 1u);
    return b;
}
__device__ __forceinline__ void xcd_barrier_complete(unsigned* bar, unsigned x, unsigned& nloc, unsigned& nx) {
    const unsigned G = gridDim.x * gridDim.y * gridDim.z;
    unsigned sum, cnt, mine, sp = 0u;
    for (;;) {
        sum = 0u; cnt = 0u; mine = 0u;
#pragma unroll
        for (unsigned j = 0; j < 16; ++j) { const unsigned c = xb_ld(&bar[XB_XCNT(j)]); sum += c; cnt += (c > 0u) ? 1u : 0u; mine = (j == x) ? c : mine; }
        if (sum == G) break;
        __builtin_amdgcn_s_sleep(1);
        if ((++sp & 255u) == 0u) { if (xb_ld(&bar[XB_TMO])) break; if (sp > XB_SPIN_CAP) { atomicAdd(&bar[XB_TMO], 1u); break; } }
    }
    nloc = mine > 0u ? mine : 1u; nx = cnt > 0u ? cnt : 1u;
}
__device__ __forceinline__ void xcd_barrier(const XcdBarrier& b) {
    asm volatile("s_waitcnt vmcnt(0)" ::: "memory");
    __syncthreads();
    if (threadIdx.x == 0) {
        unsigned* bar = b.bar;
        __builtin_amdgcn_s_waitcnt(0);
        unsigned nloc = b.st[0], nx = b.st[1];
        if (nloc == 0u) { xcd_barrier_complete(bar, b.x, nloc, nx); b.st[0] = nloc; b.st[1] = nx; }
        const unsigned old = xb_add(&bar[XB_XSUB(b.x)], 1u);
        const unsigned gen = old / nloc;
        if (old + 1u == (gen + 1u) * nloc) {
            __builtin_amdgcn_fence(__ATOMIC_RELEASE, "agent");
            asm volatile("s_waitcnt vmcnt(0)" ::: "memory");
            const unsigned og = xb_add(&bar[XB_TOP], 1u);
            const unsigned tg = og / nx;
            if (og + 1u == (tg + 1u) * nx) xb_add(&bar[XB_TOPGEN], 1u);
            else XB_SPIN(xb_ld(&bar[XB_TOPGEN]) == tg, bar);
            __builtin_amdgcn_fence(__ATOMIC_ACQUIRE, "agent");
            xb_add(&bar[XB_XGEN(b.x)], 1u);
            asm volatile("s_waitcnt vmcnt(0)" ::: "memory");
        } else {
            XB_SPIN(xb_ld(&bar[XB_XGEN(b.x)]) == gen, bar);
            __builtin_amdgcn_fence(__ATOMIC_ACQUIRE, "agent");
            asm volatile("s_waitcnt vmcnt(0)" ::: "memory");
        }
    }
    __syncthreads();
}

namespace pg8 {
constexpr int BM = 256, BK = 64, HALF = 128, HTB = HALF * BK * 2, STAGE_BYTES = 8 * HTB, NXCD = 8, WGM = 8;
__host__ __device__ __forceinline__ int lds_byte(int r, int c) { const int st = (r >> 4) * 2 + (c >> 5), rr = r & 15, cc = c & 31, ob = rr * 64 + cc * 2; return st * 1024 + (ob ^ (((ob >> 9) & 1) << 5)); }
__host__ __device__ __forceinline__ void stage_rc(int b, int& R, int& C) { const int st = b / 1024, sb = b % 1024, swz = sb ^ (((sb >> 9) & 1) << 5); R = (st >> 1) * 16 + swz / 64; C = (st & 1) * 32 + (swz % 64) / 2; }
__host__ __device__ __forceinline__ int perm32(int rho) { const int n = rho >> 4, i = rho & 15; return 8 * (i >> 2) + 4 * n + (i & 3); }

struct Unit { int pm, pn, e, kt0, nt, slab; };
struct Gemm { const bf16_t* A; const bf16_t* Bt; int N, K; size_t estride; float* slabs; };

__device__ __forceinline__ int split_factor(int U, int G, int ntiles, int maxslabs) {
    const int R = U % G; if (R == 0) return 1;
    int S = G / R; if (S > 8) S = 8; if (S > ntiles / 2) S = ntiles / 2; if (R * S > maxslabs) S = maxslabs / R;
    return S < 2 ? 1 : S;
}
struct Order {
    int nM, nN, G, c, ntiles, mainu, S, total; const int* segs; const int* rowmap;
    int sg1, sg2, sg3, sg4, sg5, sg6, sg7;
    __device__ __forceinline__ void init(int nM_, int nN_, int G_, int c_, const int* segs_, const int* rowmap_, int ntiles_, bool split, int maxslabs) {
        nM = nM_; nN = nN_; G = G_; c = c_; segs = segs_; rowmap = rowmap_; ntiles = ntiles_;
        sg1 = sg2 = sg3 = sg4 = sg5 = sg6 = sg7 = 0; if (segs_) { sg1 = segs_[1]; sg2 = segs_[2]; sg3 = segs_[3]; sg4 = segs_[4]; sg5 = segs_[5]; sg6 = segs_[6]; sg7 = segs_[7]; }
        const int U = nM * nN; S = split ? split_factor(U, G, ntiles, maxslabs) : 1; const int R = (S > 1) ? U % G : 0; mainu = U - R; total = mainu + R * S; }
    __device__ __forceinline__ bool next(int i, Unit& u) const {
        const long L = (long)i * G + c; if (L >= total) return false;
        int wgid; u.kt0 = 0; u.nt = ntiles; u.slab = -1;
        if (L < mainu) { wgid = (int)L; const int q = mainu / NXCD, r = mainu % NXCD, xcd = wgid % NXCD, off = wgid / NXCD; wgid = (xcd < r ? xcd * (q + 1) : r * (q + 1) + (xcd - r) * q) + off; }
        else { const int sub = (int)L - mainu, lu = sub / S, sl = sub - lu * S, pairs = ntiles / 2, p0 = (sl * pairs) / S, p1 = ((sl + 1) * pairs) / S;
            wgid = mainu + lu; u.kt0 = 2 * p0; u.nt = 2 * (p1 - p0); u.slab = sub; }
        const int nig = WGM * nN, gid = wgid / nig, fm = gid * WGM, gsz = (nM - fm) < WGM ? (nM - fm) : WGM;
        u.pm = fm + ((wgid % nig) % gsz); u.pn = (wgid % nig) / gsz; u.e = 0;
        if (segs) u.e = (u.pm >= sg1) + (u.pm >= sg2) + (u.pm >= sg3) + (u.pm >= sg4) + (u.pm >= sg5) + (u.pm >= sg6) + (u.pm >= sg7);
        return true;
    }
    __device__ __forceinline__ int arow(const Unit& u, int r) const {
        if (rowmap) { const int t = rowmap[u.pm * BM + r]; return t < 0 ? 0 : t; }
        return u.pm * BM + r;
    }
};

__device__ __forceinline__ unsigned cvt_pk_bf16(float lo, float hi) { return pk2(lo, hi); }

struct EpiBf16 {
    static constexpr bool PERM = true, SPLIT = false;
    bf16_t* O; int ldc;
    __device__ __forceinline__ void operator()(const f32x4 (&acc)[2][2][4][2], const Unit& u, int wr, int wc, int fr, int fq) const {
        asm volatile("" : "+v"(fr), "+v"(fq));
        const int row0 = u.pm * BM + wr * 64 + fr, col0 = u.pn * BM + wc * 32 + 8 * fq;
#pragma unroll
        for (int ai = 0; ai < 2; ++ai)
#pragma unroll
            for (int m = 0; m < 4; ++m) { bf16_t* rowp = O + (size_t)(row0 + ai * HALF + m * 16) * ldc + col0;
#pragma unroll
                for (int bj = 0; bj < 2; ++bj) { const f32x4 v0 = acc[ai][bj][m][0], v1 = acc[ai][bj][m][1];
                    u32x4 w; w.x = cvt_pk_bf16(v0[0], v0[1]); w.y = cvt_pk_bf16(v0[2], v0[3]); w.z = cvt_pk_bf16(v1[0], v1[1]); w.w = cvt_pk_bf16(v1[2], v1[3]);
                    *(u32x4*)(rowp + bj * HALF) = w; } }
    }
};
struct EpiSwiGLU {
    static constexpr bool PERM = true, SPLIT = false;
    bf16_t* O; int ldc;
    __device__ __forceinline__ void operator()(const f32x4 (&acc)[2][2][4][2], const Unit& u, int wr, int wc, int fr, int fq) const {
        asm volatile("" : "+v"(fr), "+v"(fq));
        const int row0 = u.pm * BM + wr * 64 + fr, col0 = u.pn * HALF + wc * 32 + 8 * fq;
#pragma unroll
        for (int ai = 0; ai < 2; ++ai)
#pragma unroll
            for (int m = 0; m < 4; ++m) { bf16_t* rowp = O + (size_t)(row0 + ai * HALF + m * 16) * ldc + col0;
                float o[8];
#pragma unroll
                for (int n = 0; n < 2; ++n)
#pragma unroll
                    for (int j = 0; j < 4; ++j) { const float a = acc[ai][0][m][n][j], b = acc[ai][1][m][n][j]; o[n * 4 + j] = (a * __builtin_amdgcn_rcpf(1.0f + __expf(-a))) * b; }
                u32x4 w; w.x = cvt_pk_bf16(o[0], o[1]); w.y = cvt_pk_bf16(o[2], o[3]); w.z = cvt_pk_bf16(o[4], o[5]); w.w = cvt_pk_bf16(o[6], o[7]);
                *(u32x4*)rowp = w; }
    }
};
struct EpiResid {
    static constexpr bool PERM = true, SPLIT = true;
    const float* src_f32; bf16_t* xb; const float* src_ctx; float* dst_ctx; const float* gate_lat; const float* gate_ctx;
    __device__ __forceinline__ void operator()(const f32x4 (&acc)[2][2][4][2], const Unit& u, int wr, int wc, int fr, int fq) const {
        asm volatile("" : "+v"(fr), "+v"(fq));
        const int prow = u.pm * BM; const bool lat = prow < NLAT;
        const float* gate = lat ? gate_lat + (size_t)(prow / SEQ) * 6144 : gate_ctx;
        const int r0 = wr * 64 + fr, col0 = u.pn * BM + wc * 32 + 8 * fq;
        f32x4 gv[2][2];
#pragma unroll
        for (int bj = 0; bj < 2; ++bj)
#pragma unroll
            for (int n = 0; n < 2; ++n) gv[bj][n] = *(const f32x4*)(gate + col0 + bj * HALF + 4 * n);
        if (lat) {
#pragma unroll
            for (int ai = 0; ai < 2; ++ai)
#pragma unroll
                for (int m = 0; m < 4; ++m) { const size_t off = (size_t)(prow + r0 + ai * HALF + m * 16) * D + col0;
#pragma unroll
                    for (int bj = 0; bj < 2; ++bj) { f32x4 s0, s1;
                        if (src_f32) { s0 = *(const f32x4*)(src_f32 + off + bj * HALF); s1 = *(const f32x4*)(src_f32 + off + bj * HALF + 4); }
                        else unpack8(*(const u32x4*)(xb + off + bj * HALF), s0, s1);
                        *(u32x4*)(xb + off + bj * HALF) = pack8(s0 + gv[bj][0] * acc[ai][bj][m][0], s1 + gv[bj][1] * acc[ai][bj][m][1]); }
                    asm volatile("" ::: "memory"); }
        } else {
            const float* src = src_ctx + (size_t)(prow - NLAT) * D; float* dst = dst_ctx + (size_t)(prow - NLAT) * D;
#pragma unroll
            for (int ai = 0; ai < 2; ++ai)
#pragma unroll
                for (int m = 0; m < 4; ++m) { const size_t off = (size_t)(r0 + ai * HALF + m * 16) * D + col0;
#pragma unroll
                    for (int bj = 0; bj < 2; ++bj)
#pragma unroll
                        for (int n = 0; n < 2; ++n) { const f32x4 sv = *(const f32x4*)(src + off + bj * HALF + 4 * n); *(f32x4*)(dst + off + bj * HALF + 4 * n) = sv + gv[bj][n] * acc[ai][bj][m][n]; }
                    asm volatile("" ::: "memory"); }
        }
    }
};
struct EpiMoeDown {
    static constexpr bool PERM = true, SPLIT = true;
    bf16_t* xb; const int* ptok; const float* pw; const float* gate_lat;
    __device__ __forceinline__ void operator()(const f32x4 (&acc)[2][2][4][2], const Unit& u, int wr, int wc, int fr, int fq) const {
        asm volatile("" : "+v"(fr), "+v"(fq));
        const int r0 = u.pm * BM + wr * 64 + fr, col0 = u.pn * BM + wc * 32 + 8 * fq;
#pragma unroll
        for (int ai = 0; ai < 2; ++ai)
#pragma unroll
            for (int m = 0; m < 4; ++m) { const int r = r0 + ai * HALF + m * 16; const int tok = ptok[r]; const float w = pw[r];
                if (tok >= 0) { bf16_t* xr = xb + (size_t)tok * D + col0; const float* gate = gate_lat + (size_t)(tok / SEQ) * 6144 + col0;
#pragma unroll
                    for (int bj = 0; bj < 2; ++bj) { const f32x4 g0 = *(const f32x4*)(gate + bj * HALF), g1 = *(const f32x4*)(gate + bj * HALF + 4); f32x4 s0, s1; unpack8(*(const u32x4*)(xr + bj * HALF), s0, s1);
                        *(u32x4*)(xr + bj * HALF) = pack8(s0 + (g0 * w) * acc[ai][bj][m][0], s1 + (g1 * w) * acc[ai][bj][m][1]); } }
                asm volatile("" ::: "memory"); }
    }
};

template <class Epi>
__device__ __forceinline__ void gemm_phase(ldsp_t lds, const Gemm g, const Order& S, const Epi& E, const int tid) {
    const int wid = __builtin_amdgcn_readfirstlane(tid >> 6), lane = tid & 63, wr = wid >> 2, wc = wid & 3, fr = lane & 15, fq = lane >> 4;
    const int K = g.K;
    unsigned voffB[2];
#pragma unroll
    for (int i = 0; i < 2; ++i) { int R, C; stage_rc(tid * 16 + i * 8192, R, C); const int Rb = Epi::PERM ? ((R & ~31) + perm32(R & 31)) : R;
        voffB[i] = (unsigned)(Rb * K + C) * 2u; }
    const size_t kstep = (size_t)(BK * 2);
    const size_t hstep = (size_t)HALF * K * 2;
    const size_t tstep = 2 * hstep;
    const unsigned ldsw = (unsigned)wid * 1024u;
    const int aoff = lds_byte(wr * 64 + fr, fq * 8), boff = lds_byte(wc * 32 + fr, fq * 8);
#define PG8_SA(b, h) (((b) * 2 + (h)) * HTB)
#define PG8_SB(b, h) ((4 + (b) * 2 + (h)) * HTB)
#define PG8_STAGE_B(bufoff, gbase) do { _Pragma("unroll") for (int _i = 0; _i < 2; ++_i) \
        __builtin_amdgcn_global_load_lds((const unsigned*)((const char*)(gbase) + voffB[_i]), (LAS unsigned*)(lds + (bufoff) + ldsw + _i * 8192), 16, 0, 0); } while (0)
#define PG8_STAGE_A(bufoff, gbase, o0, o1) do { \
        __builtin_amdgcn_global_load_lds((const unsigned*)((const char*)(gbase) + (o0)), (LAS unsigned*)(lds + (bufoff) + ldsw), 16, 0, 0); \
        __builtin_amdgcn_global_load_lds((const unsigned*)((const char*)(gbase) + (o1)), (LAS unsigned*)(lds + (bufoff) + ldsw + 8192), 16, 0, 0); } while (0)
#define PG8_LDA(dst, b, h) do { _Pragma("unroll") for (int m = 0; m < 4; ++m) _Pragma("unroll") for (int k = 0; k < 2; ++k) dst[m][k] = *(const LAS bf16x8*)(lds + PG8_SA(b, h) + aoff + m * 2048 + k * 1024); } while (0)
#define PG8_LDB(dst, b, h) do { _Pragma("unroll") for (int n = 0; n < 2; ++n) _Pragma("unroll") for (int k = 0; k < 2; ++k) dst[n][k] = *(const LAS bf16x8*)(lds + PG8_SB(b, h) + boff + n * 2048 + k * 1024); } while (0)
#define PG8_MMA(ai, bj, At, Bt) do { __builtin_amdgcn_s_setprio(1); _Pragma("unroll") for (int m = 0; m < 4; ++m) _Pragma("unroll") for (int n = 0; n < 2; ++n) _Pragma("unroll") for (int k = 0; k < 2; ++k) \
        acc[ai][bj][m][n] = __builtin_amdgcn_mfma_f32_16x16x32_bf16(Bt[n][k], At[m][k], acc[ai][bj][m][n], 0, 0, 0); __builtin_amdgcn_s_setprio(0); } while (0)
#define PG8_WAIT_V(n) asm volatile("s_waitcnt vmcnt(" #n ")" ::: "memory")
#define PG8_WAIT_L(n) asm volatile("s_waitcnt lgkmcnt(" #n ")" ::: "memory")
#define PG8_BAR __builtin_amdgcn_s_barrier()
#define PG8_SCHED __builtin_amdgcn_sched_barrier(0)
#define PG8_AOFFS(u, o00, o01, o10, o11) do { int R0_, C0_, R1_, C1_; stage_rc(tid * 16, R0_, C0_); stage_rc(tid * 16 + 8192, R1_, C1_); \
        o00 = (unsigned)(S.arow(u, R0_) * K + C0_ + (u).kt0 * BK) * 2u; o01 = (unsigned)(S.arow(u, R1_) * K + C1_ + (u).kt0 * BK) * 2u; \
        o10 = (unsigned)(S.arow(u, HALF + R0_) * K + C0_ + (u).kt0 * BK) * 2u; o11 = (unsigned)(S.arow(u, HALF + R1_) * K + C1_ + (u).kt0 * BK) * 2u; } while (0)
    Unit cur, nxt; int ui = 0;
    if (!S.next(0, cur)) return;
    f32x4 acc[2][2][4][2];
    { float z_; asm volatile("v_mov_b32 %0, 0" : "=v"(z_));
#pragma unroll
    for (int a = 0; a < 2; ++a)
#pragma unroll
        for (int b = 0; b < 2; ++b)
#pragma unroll
            for (int m = 0; m < 4; ++m)
#pragma unroll
                for (int n = 0; n < 2; ++n) acc[a][b][m][n] = (f32x4){z_, z_, z_, z_}; }
    bf16x8 At[4][2], B0[2][2], B1[2][2];
    const char* const Abase = (const char*)g.A;
    const char* cB = (const char*)g.Bt + (size_t)cur.e * g.estride + (size_t)cur.pn * tstep + (size_t)cur.kt0 * kstep;
    unsigned c00, c01, c10, c11;
    PG8_AOFFS(cur, c00, c01, c10, c11);
    PG8_STAGE_B(PG8_SB(0, 0), cB); PG8_STAGE_B(PG8_SB(0, 1), cB + hstep); PG8_STAGE_A(PG8_SA(0, 0), Abase, c00, c01); PG8_STAGE_A(PG8_SA(0, 1), Abase, c10, c11);
    if (wr == 1) PG8_BAR;
    PG8_WAIT_V(2); PG8_BAR;
    PG8_STAGE_B(PG8_SB(1, 0), cB + kstep); PG8_STAGE_A(PG8_SA(1, 0), Abase + kstep, c00, c01); PG8_STAGE_B(PG8_SB(1, 1), cB + hstep + kstep);
    PG8_WAIT_V(6); PG8_BAR;
    for (;;) {
        const bool has_next = S.next(ui + 1, nxt);
        const char* nB = has_next ? (const char*)g.Bt + (size_t)nxt.e * g.estride + (size_t)nxt.pn * tstep + (size_t)nxt.kt0 * kstep : cB;
        const int nt = cur.nt;
        int rn0 = 0, rn1 = 0, rn2 = 0, rn3 = 0;
        if (S.rowmap && has_next) { int R0_, C0_, R1_, C1_; stage_rc(tid * 16, R0_, C0_); stage_rc(tid * 16 + 8192, R1_, C1_);
            rn0 = S.arow(nxt, R0_); rn1 = S.arow(nxt, R1_); rn2 = S.arow(nxt, HALF + R0_); rn3 = S.arow(nxt, HALF + R1_); }
        for (int t = 0; t < nt; t += 2) {
            const bool last = (t == nt - 2);
            const char* a1 = Abase + (size_t)(t + 1) * kstep;
            const char* a2 = last ? Abase : Abase + (size_t)(t + 2) * kstep; const char* b2 = last ? nB : cB + (size_t)(t + 2) * kstep;
            const char* a3 = a2 + kstep; const char* b3 = b2 + kstep;
            PG8_LDB(B0, 0, 0); PG8_LDB(B1, 0, 1); PG8_SCHED; PG8_LDA(At, 0, 0); PG8_STAGE_A(PG8_SA(1, 1), a1, c10, c11);
            PG8_WAIT_V(8); PG8_WAIT_L(0); PG8_BAR; PG8_MMA(0, 0, At, B0); PG8_MMA(0, 1, At, B1); PG8_BAR; PG8_SCHED;
            if (last && has_next) {
                if (S.rowmap) { int R0_, C0_, R1_, C1_; stage_rc(tid * 16, R0_, C0_); stage_rc(tid * 16 + 8192, R1_, C1_);
                    c00 = (unsigned)(rn0 * K + C0_ + nxt.kt0 * BK) * 2u; c01 = (unsigned)(rn1 * K + C1_ + nxt.kt0 * BK) * 2u; c10 = (unsigned)(rn2 * K + C0_ + nxt.kt0 * BK) * 2u; c11 = (unsigned)(rn3 * K + C1_ + nxt.kt0 * BK) * 2u; }
                else { PG8_AOFFS(nxt, c00, c01, c10, c11); } }
            PG8_LDA(At, 0, 1); PG8_STAGE_B(PG8_SB(0, 0), b2); PG8_STAGE_B(PG8_SB(0, 1), b2 + hstep); PG8_STAGE_A(PG8_SA(0, 0), a2, c00, c01);
            PG8_WAIT_V(8); PG8_WAIT_L(0); PG8_BAR; PG8_MMA(1, 0, At, B0); PG8_MMA(1, 1, At, B1); PG8_BAR; PG8_SCHED;
            PG8_LDB(B0, 1, 0); PG8_LDB(B1, 1, 1); PG8_SCHED; PG8_LDA(At, 1, 0); PG8_STAGE_A(PG8_SA(0, 1), a2, c10, c11);
            PG8_WAIT_V(8); PG8_WAIT_L(0); PG8_BAR; PG8_MMA(0, 0, At, B0); PG8_MMA(0, 1, At, B1); PG8_BAR; PG8_SCHED;
            PG8_LDA(At, 1, 1); PG8_STAGE_B(PG8_SB(1, 0), b3); PG8_STAGE_B(PG8_SB(1, 1), b3 + hstep); PG8_STAGE_A(PG8_SA(1, 0), a3, c00, c01);
            PG8_WAIT_V(8); PG8_WAIT_L(0); PG8_BAR; PG8_MMA(1, 0, At, B0); PG8_MMA(1, 1, At, B1); PG8_BAR; PG8_SCHED;
        }
        if (wr == 0) PG8_BAR;
        if (Epi::SPLIT && cur.slab >= 0) {
            int fr_ = fr, fq_ = fq; asm volatile("" : "+v"(fr_), "+v"(fq_));
            float* sp = g.slabs + (size_t)cur.slab * 65536 + (size_t)(wr * 64 + fr_) * 256 + wc * 32 + (Epi::PERM ? 8 : 4) * fq_;
#pragma unroll
            for (int ai = 0; ai < 2; ++ai)
#pragma unroll
                for (int m = 0; m < 4; ++m)
#pragma unroll
                    for (int bj = 0; bj < 2; ++bj)
#pragma unroll
                        for (int n = 0; n < 2; ++n) *(f32x4*)(sp + (ai * HALF + m * 16) * 256 + bj * HALF + n * (Epi::PERM ? 4 : 16)) = acc[ai][bj][m][n];
        } else E(acc, cur, wr, wc, fr, fq);
        if (!has_next) break;
        { float z_; asm volatile("v_mov_b32 %0, 0" : "=v"(z_));
#pragma unroll
        for (int a = 0; a < 2; ++a)
#pragma unroll
            for (int b = 0; b < 2; ++b)
#pragma unroll
                for (int m = 0; m < 4; ++m)
#pragma unroll
                    for (int n = 0; n < 2; ++n) acc[a][b][m][n] = (f32x4){z_, z_, z_, z_}; }
        cur = nxt; cB = nB; ++ui;
        if (wr == 1) PG8_BAR;
    }
    PG8_WAIT_V(0);
    PG8_BAR;
#undef PG8_SA
#undef PG8_SB
#undef PG8_STAGE_A
#undef PG8_STAGE_B
#undef PG8_LDA
#undef PG8_LDB
#undef PG8_MMA
#undef PG8_WAIT_V
#undef PG8_WAIT_L
#undef PG8_BAR
#undef PG8_SCHED
#undef PG8_AOFFS
}
}

struct Args { const float* in[27]; float* out; unsigned char* ws; int ph_lo, ph_hi; };
struct Frame {
    ldsp_t lds; int tid, lane, wave, wave0, G, bid;
    const Args* pa; float* out; unsigned char* ws;
    const Args* pa0; float* out0; unsigned char* ws0;
};
enum { I_X = 0, I_C, I_CTX, I_CCTX, I_WMOD, I_BMOD, I_GMIX, I_GFFN, I_GFINAL, I_WIN, I_WOUT, I_CONVW, I_CONVB, I_RGWA, I_RGBA, I_RGWX, I_RGBX, I_RGLAM, I_RETDEC,
       I_FW1, I_FW3, I_FW2, I_MROUTER, I_MROUTERB, I_MW1, I_MW3, I_MW2 };

constexpr int TRS = 64 * 65 * 4;
struct TrItem { const float* W; bf16_t* WT; int ldw, k0, n0, ldt, drow0; float scale; };
__device__ __forceinline__ void tr_load(const TrItem& t, f32x4 (&v)[16], int lane) {
    const int r4 = lane >> 4, c4 = (lane & 15) * 4;
#pragma unroll
    for (int i = 0; i < 16; ++i) v[i] = *(const f32x4*)(t.W + (size_t)(t.k0 + 4 * i + r4) * t.ldw + t.n0 + c4);
}
__device__ __forceinline__ void tr_store(const TrItem& t, const f32x4 (&v)[16], LAS float* scr, int lane) {
    { const int r4 = lane >> 4, c4 = (lane & 15) * 4;
#pragma unroll
      for (int i = 0; i < 16; ++i) { LAS float* d = scr + (4 * i + r4) * 65 + c4; d[0] = v[i].x; d[1] = v[i].y; d[2] = v[i].z; d[3] = v[i].w; } }
    LDS_WAIT(); asm volatile("" ::: "memory");
    const int c = lane & 7; const float scale = t.scale;
#pragma unroll
    for (int j = 0; j < 8; ++j) { const int n = (lane >> 3) + 8 * j; const LAS float* sp = scr + (8 * c) * 65 + n;
        u32x4 o; o.x = pk2(sp[0 * 65] * scale, sp[1 * 65] * scale); o.y = pk2(sp[2 * 65] * scale, sp[3 * 65] * scale); o.z = pk2(sp[4 * 65] * scale, sp[5 * 65] * scale); o.w = pk2(sp[6 * 65] * scale, sp[7 * 65] * scale);
        *(u32x4*)(t.WT + (size_t)(t.drow0 + n) * t.ldt + t.k0 + 8 * c) = o; }
    LDS_WAIT(); asm volatile("" ::: "memory");
}
__device__ __forceinline__ TrItem up_item(const float* w1, const float* w3, int F, bf16_t* WT, int r) {
    const int per = 16 * (F / 64); const int which = r / per; r -= which * per;
    const int nblk = F / 64, kb = r / nblk, nb = r % nblk, n0 = nb * 64;
    return TrItem{which ? w3 : w1, WT, F, kb * 64, n0, D, (n0 / 128) * 256 + (n0 % 128) + which * 128, 1.0f};
}
__device__ __forceinline__ TrItem small_item(Frame& F, int r) {
    constexpr int I_IN = 16 * (INW / 64), I_OUT = 16 * (D / 64), I_UP = 2 * 16 * (DFF / 64);
    if (r < 2 * I_IN) { const int l = r / I_IN; r -= l * I_IN; const int nblk = INW / 64, kb = r / nblk, nb = r % nblk, n0 = nb * 64;
        const float sc = (n0 >= 1536 && n0 < 2048) ? 0.08838834764831845f : 1.0f;
        return TrItem{F.pa->in[I_WIN] + (size_t)l * D * INW, (bf16_t*)(F.ws + WS_WIN) + (size_t)l * INW * D, INW, kb * 64, n0, D, n0, sc}; }
    r -= 2 * I_IN;
    if (r < 2 * I_OUT) { const int l = r / I_OUT; r -= l * I_OUT; const int nblk = D / 64, kb = r / nblk, nb = r % nblk;
        return TrItem{F.pa->in[I_WOUT] + (size_t)l * D * D, (bf16_t*)(F.ws + WS_WOUT) + (size_t)l * D * D, D, kb * 64, nb * 64, D, nb * 64, 1.0f}; }
    r -= 2 * I_OUT;
    if (r < I_UP) return up_item(F.pa->in[I_FW1], F.pa->in[I_FW3], DFF, (bf16_t*)(F.ws + WS_WUP), r);
    r -= I_UP;
    { const int nblk = D / 64, kb = r / nblk, nb = r % nblk; return TrItem{F.pa->in[I_FW2], (bf16_t*)(F.ws + WS_WDN), D, kb * 64, nb * 64, DFF, nb * 64, 1.0f}; }
}
__device__ __forceinline__ TrItem moe_item(Frame& F, int it) {
    constexpr int I_UP = 2 * 16 * (DEXP / 64), I_DN = (DEXP / 64) * (D / 64), PER_E = I_UP + I_DN;
    const int e = it / PER_E; int r = it - e * PER_E;
    if (r < I_UP) return up_item(F.pa->in[I_MW1] + (size_t)e * D * DEXP, F.pa->in[I_MW3] + (size_t)e * D * DEXP, DEXP, (bf16_t*)(F.ws + WS_MOEUP) + (size_t)e * 2 * DEXP * D, r);
    r -= I_UP;
    { const int nblk = D / 64, kb = r / nblk, nb = r % nblk; return TrItem{F.pa->in[I_MW2] + (size_t)e * DEXP * D, (bf16_t*)(F.ws + WS_MOEDN) + (size_t)e * D * DEXP, D, kb * 64, nb * 64, DEXP, nb * 64, 1.0f}; }
}
__device__ __forceinline__ void phase_convert_small(Frame& F) {
    LAS float* scr = (LAS float*)(F.lds + F.wave * TRS);
    const int gw = F.bid * NWAVES + F.wave, NGW = F.G * NWAVES;
    constexpr int NITEMS = 2 * 16 * (INW / 64) + 2 * 16 * (D / 64) + 2 * 16 * (DFF / 64) + (DFF / 64) * (D / 64);
    if (gw < NITEMS) { TrItem cur = small_item(F, gw); f32x4 va[16], vb[16]; tr_load(cur, va, F.lane);
        for (int it = gw; it < NITEMS; it += 2 * NGW) {
            const bool h1 = it + NGW < NITEMS; TrItem n1 = cur; if (h1) { n1 = small_item(F, it + NGW); tr_load(n1, vb, F.lane); }
            tr_store(cur, va, scr, F.lane);
            if (!h1) break;
            const bool h2 = it + 2 * NGW < NITEMS; if (h2) { cur = small_item(F, it + 2 * NGW); tr_load(cur, va, F.lane); }
            tr_store(n1, vb, scr, F.lane);
            if (!h2) break; } }
    { const int gt = F.bid * NTHREADS + F.tid, NGT = F.G * NTHREADS; bf16_t* o = (bf16_t*)(F.ws + WS_RGW);
      for (int i = gt; i < 2 * 2 * 2 * 8 * 64 * 64; i += NGT) { const int c = i & 63, dp = (i >> 6) & 63, blk = (i >> 12) & 7, gate = (i >> 15) & 1, dir = (i >> 16) & 1, l = i >> 17;
          const float* src = gate ? F.pa->in[I_RGWX] : F.pa->in[I_RGWA]; o[i] = (bf16_t)f2bf(src[((((size_t)l * 2 + dir) * 8 + blk) * 64 + c) * 64 + dp]); } }
    { const int gt = F.bid * NTHREADS + F.tid, NGT = F.G * NTHREADS; float* ct = (float*)(F.ws + WS_ROPE); float* st = ct + 4096 * 64;
      for (int i = gt; i < 4096 * 64; i += NGT) { const int pos = i >> 6, fi = i & 63; const float p = (float)((fi < 32) ? (pos >> 6) : (pos & 63));
          const float inv = powf(10000.0f, -(float)(fi & 31) / 32.0f); const float ang = p * inv;
          const double a = (double)ang; const double kq = __builtin_rint(a * 0.63661977236758134308); const double rr = a - kq * 1.57079632679489661923; const int q = ((int)kq) & 3;
          const double r2 = rr * rr;
          const double sn = rr * (1.0 + r2 * (-1.0 / 6 + r2 * (1.0 / 120 + r2 * (-1.0 / 5040 + r2 * (1.0 / 362880 + r2 * (-1.0 / 39916800))))));
          const double cs = 1.0 + r2 * (-0.5 + r2 * (1.0 / 24 + r2 * (-1.0 / 720 + r2 * (1.0 / 40320 + r2 * (-1.0 / 3628800 + r2 * (1.0 / 479001600))))));
          const double c_ = (q == 0) ? cs : (q == 1) ? -sn : (q == 2) ? -cs : sn; const double s_ = (q == 0) ? sn : (q == 1) ? cs : (q == 2) ? -sn : -cs;
          ct[i] = (float)c_; st[i] = (float)s_; } }
}
struct MoeTile { const float* W; bf16_t* WT; int ldw, k0, n0, ldt, up; };
__device__ __forceinline__ MoeTile moe_tile(Frame& F, int t) {
    constexpr int T_UP1 = (D / 128) * (DEXP / 256), T_DN = (DEXP / 128) * (D / 256), PER_E = 2 * T_UP1 + T_DN;
    const int e = t / PER_E; int r = t - e * PER_E;
    if (r < 2 * T_UP1) { const int which = r / T_UP1; r -= which * T_UP1; const int nb = DEXP / 256, kb = r / nb, nn = r % nb;
        return MoeTile{(which ? F.pa->in[I_MW3] : F.pa->in[I_MW1]) + (size_t)e * D * DEXP, (bf16_t*)(F.ws + WS_MOEUP) + (size_t)e * 2 * DEXP * D, DEXP, kb * 128, nn * 256, D, 1 + which}; }
    r -= 2 * T_UP1;
    { const int nb = D / 256, kb = r / nb, nn = r % nb; return MoeTile{F.pa->in[I_MW2] + (size_t)e * DEXP * D, (bf16_t*)(F.ws + WS_MOEDN) + (size_t)e * D * DEXP, D, kb * 128, nn * 256, DEXP, 0}; }
}
__device__ __forceinline__ void moe_tile_load(const MoeTile& t, f32x4 (&v)[16], int wave, int lane) {
#pragma unroll
    for (int i = 0; i < 16; ++i) v[i] = *(const f32x4*)(t.W + (size_t)(t.k0 + 16 * wave + i) * t.ldw + t.n0 + 4 * lane);
}
__device__ __forceinline__ void moe_tile_store(Frame& F, const MoeTile& t, const f32x4 (&v)[16]) {
    LAS float* tile = (LAS float*)F.lds;
#pragma unroll
    for (int i = 0; i < 16; ++i) { const int k = 16 * F.wave + i, p = (4 * F.lane + 2 * (k >> 3)) & 255;
        *(LAS f32x2*)(tile + k * 256 + p) = (f32x2){v[i].x, v[i].y}; *(LAS f32x2*)(tile + k * 256 + ((p + 2) & 255)) = (f32x2){v[i].z, v[i].w}; }
    __syncthreads();
#pragma unroll
    for (int j = 0; j < 8; ++j) { const int task = F.tid + j * NTHREADS, c = task & 15, n = task >> 4; const LAS float* sp = tile + (8 * c) * 256 + ((n + 2 * c) & 255);
        u32x4 o; o.x = pk2(sp[0], sp[256]); o.y = pk2(sp[512], sp[768]); o.z = pk2(sp[1024], sp[1280]); o.w = pk2(sp[1536], sp[1792]);
        const int col = t.n0 + n; const int drow = t.up ? (col >> 7) * 256 + (col & 127) + 128 * (t.up - 1) : col;
        *(u32x4*)(t.WT + (size_t)drow * t.ldt + t.k0 + 8 * c) = o; }
    __syncthreads();
}
__device__ __forceinline__ void phase_convert_moe(Frame& F) {
    constexpr int NT = NE * (2 * (D / 128) * (DEXP / 256) + (DEXP / 128) * (D / 256));
    if (F.bid < NT) { MoeTile cur = moe_tile(F, F.bid); f32x4 va[16], vb[16]; moe_tile_load(cur, va, F.wave, F.lane);
        for (int t = F.bid; t < NT; t += 2 * F.G) {
            const bool h1 = t + F.G < NT; MoeTile n1 = cur; if (h1) { n1 = moe_tile(F, t + F.G); moe_tile_load(n1, vb, F.wave, F.lane); }
            moe_tile_store(F, cur, va);
            if (!h1) break;
            const bool h2 = t + 2 * F.G < NT; if (h2) { cur = moe_tile(F, t + 2 * F.G); moe_tile_load(cur, va, F.wave, F.lane); }
            moe_tile_store(F, n1, vb);
            if (!h2) break; } }
}
__device__ __forceinline__ void phase_mod(Frame& F) {
    LAS float* sc = (LAS float*)F.lds;
    LAS float* red = (LAS float*)(F.lds + 9 * 1024 * 4);
    for (int i = F.tid; i < 9 * 1024; i += NTHREADS) { const int r = i >> 10, k = i & 1023; const float v = (r < 8) ? F.pa->in[I_C][r * 1024 + k] : F.pa->in[I_CCTX][k]; sc[i] = v / (1.0f + __expf(-v)); }
    __syncthreads();
    for (int strip = F.bid; strip < 2 * 6144 / 64; strip += F.G) {
        const int l = strip / 96, j = (strip % 96) * 64 + F.lane;
        const float* w = F.pa->in[I_WMOD] + (size_t)l * 1024 * 6144 + j;
        float a[9];
#pragma unroll
        for (int r = 0; r < 9; ++r) a[r] = 0.f;
        const int k0 = F.wave * 128;
#pragma unroll 1
        for (int kk = k0; kk < k0 + 128; kk += 16) { float wv[16];
#pragma unroll
            for (int i = 0; i < 16; ++i) wv[i] = w[(size_t)(kk + i) * 6144];
#pragma unroll
            for (int i = 0; i < 16; ++i) {
#pragma unroll
                for (int r = 0; r < 9; ++r) a[r] += sc[r * 1024 + kk + i] * wv[i];
                if ((i & 3) == 3) __builtin_amdgcn_sched_barrier(0); } }
#pragma unroll
        for (int r = 0; r < 9; ++r) red[(F.wave * 9 + r) * 64 + F.lane] = a[r];
        __syncthreads();
        for (int i = F.tid; i < 9 * 64; i += NTHREADS) { const int r = i >> 6, jj = i & 63; float s = 0.f;
#pragma unroll
            for (int w8 = 0; w8 < 8; ++w8) s += red[(w8 * 9 + r) * 64 + jj];
            const int col = (strip % 96) * 64 + jj; s += F.pa->in[I_BMOD][l * 6144 + col];
            if (r < 8) ((float*)(F.ws + WS_MODLAT))[((size_t)l * 8 + r) * 6144 + col] = s; else ((float*)(F.ws + WS_MODCTX))[(size_t)l * 6144 + col] = s; }
        __syncthreads();
    }
}

__device__ __forceinline__ void norm_row(const u32x2 (&xw)[4], const f32x4 (&Am)[4], const f32x4 (&Sh)[4], bf16_t* orow, int lane, f32x4 (&y)[4]) {
    f32x4 v[4]; float ss = 0.f;
#pragma unroll
    for (int j = 0; j < 4; ++j) { const u32x2 w = xw[j]; v[j] = (f32x4){bf2f(w.x & 0xffffu), __uint_as_float(w.x & 0xffff0000u), bf2f(w.y & 0xffffu), __uint_as_float(w.y & 0xffff0000u)};
        ss += (v[j].x * v[j].x + v[j].y * v[j].y) + (v[j].z * v[j].z + v[j].w * v[j].w); }
    const float rstd = 1.0f / sqrtf(wave_sum(ss) * (1.0f / D) + EPS);
    u32x2* o8 = (u32x2*)orow + lane;
#pragma unroll
    for (int j = 0; j < 4; ++j) { y[j] = (v[j] * rstd) * Am[j] + Sh[j]; o8[64 * j] = (u32x2){pk2(y[j].x, y[j].y), pk2(y[j].z, y[j].w)}; }
}
struct SlabRed { const float* slab; int S; const float* gate; const float* xold; float* xnew; };
__device__ __forceinline__ void norm_row_v(f32x4 (&v)[4], const float* g, const float* shift, const float* scale, bf16_t* orow, int lane) {
    float ss = 0.f;
#pragma unroll
    for (int j = 0; j < 4; ++j) ss += (v[j].x * v[j].x + v[j].y * v[j].y) + (v[j].z * v[j].z + v[j].w * v[j].w);
    const float rstd = 1.0f / sqrtf(wave_sum(ss) * (1.0f / D) + EPS);
    u32x2* o8 = (u32x2*)orow + lane;
#pragma unroll
    for (int j = 0; j < 4; ++j) { const f32x4 gg = ((const f32x4*)g)[lane + 64 * j], sh = ((const f32x4*)shift)[lane + 64 * j], sl = ((const f32x4*)scale)[lane + 64 * j];
        const f32x4 y = (v[j] * rstd) * gg * (sl + 1.0f) + sh;
        u32x2 w; w.x = pk2(y.x, y.y); w.y = pk2(y.z, y.w); o8[64 * j] = w; }
}
__device__ __forceinline__ void phase_norm(Frame& F, int l, int sel, const float* xlat, const bf16_t* xb, const float* xctx, int nrows, const SlabRed sr) {
    const int gw = F.bid * NWAVES + F.wave, NGW = F.G * NWAVES;
    const float* g = (sel ? F.pa->in[I_GFFN] : F.pa->in[I_GMIX]) + l * D; const int so = sel ? 3072 : 0;
    bf16_t* HX = (bf16_t*)(F.ws + WS_HX);
    const int nlat = nrows < NLAT ? nrows : NLAT; const int per = (nlat + NGW - 1) / NGW, r_lo = gw * per, r_hi = (r_lo + per < nlat) ? r_lo + per : nlat;
    int curb = -1; f32x4 Am[4], Sh[4];
    for (int row0 = r_lo; row0 < r_hi; row0 += 4) {
        f32x4 v[4][4];
#pragma unroll
        for (int u = 0; u < 4; ++u) { const int row = (row0 + u < r_hi) ? row0 + u : row0;
            if (xb) { const u32x2* xr = (const u32x2*)(xb + (size_t)row * D) + F.lane;
#pragma unroll
                for (int j = 0; j < 4; ++j) { const u32x2 w = xr[64 * j]; v[u][j] = (f32x4){bf2f(w.x & 0xffffu), __uint_as_float(w.x & 0xffff0000u), bf2f(w.y & 0xffffu), __uint_as_float(w.y & 0xffff0000u)}; } }
            else { const f32x4* xr = (const f32x4*)(xlat + (size_t)row * D) + F.lane;
#pragma unroll
                for (int j = 0; j < 4; ++j) v[u][j] = xr[64 * j]; } }
#pragma unroll
        for (int u = 0; u < 4; ++u) { const int row = row0 + u; if (row >= r_hi) continue;
            const int b = row / SEQ;
            if (b != curb) { curb = b; const float* mod = (const float*)(F.ws + WS_MODLAT) + ((size_t)l * 8 + b) * 6144 + so;
#pragma unroll
                for (int j = 0; j < 4; ++j) { Am[j] = ((const f32x4*)g)[F.lane + 64 * j] * (((const f32x4*)(mod + 1024))[F.lane + 64 * j] + 1.0f); Sh[j] = ((const f32x4*)mod)[F.lane + 64 * j]; } }
            float ss = 0.f;
#pragma unroll
            for (int j = 0; j < 4; ++j) ss += (v[u][j].x * v[u][j].x + v[u][j].y * v[u][j].y) + (v[u][j].z * v[u][j].z + v[u][j].w * v[u][j].w);
            const float rstd = 1.0f / sqrtf(wave_sum(ss) * (1.0f / D) + EPS);
            u32x2* o8 = (u32x2*)(HX + (size_t)row * D) + F.lane;
#pragma unroll
            for (int j = 0; j < 4; ++j) { const f32x4 y = (v[u][j] * rstd) * Am[j] + Sh[j]; o8[64 * j] = (u32x2){pk2(y.x, y.y), pk2(y.z, y.w)}; } }
    }
    for (int row = NLAT + gw; row < nrows; row += NGW) {
        const float* mod = (const float*)(F.ws + WS_MODCTX) + (size_t)l * 6144;
        f32x4 v[4];
        if (sr.slab == nullptr) { const f32x4* xr = (const f32x4*)(xctx + (size_t)(row - NLAT) * D) + F.lane;
#pragma unroll
            for (int j = 0; j < 4; ++j) v[j] = xr[64 * j]; }
        else { const int rc = row - NLAT, pmr = rc >> 8, r = rc & 255;
#pragma unroll
            for (int j = 0; j < 4; ++j) { f32x4 a = zero4(); const float* sp = sr.slab + (size_t)((pmr + 8 * j) * sr.S) * 65536 + (size_t)r * 256 + 4 * F.lane;
                f32x4 t8[8];
#pragma unroll
                for (int q = 0; q < 8; ++q) t8[q] = (q < sr.S) ? *(const f32x4*)(sp + (size_t)q * 65536) : zero4();
#pragma unroll
                for (int q = 0; q < 8; ++q) a += t8[q];
                v[j] = ((const f32x4*)(sr.xold + (size_t)rc * D))[F.lane + 64 * j] + ((const f32x4*)sr.gate)[F.lane + 64 * j] * a;
                ((f32x4*)(sr.xnew + (size_t)rc * D))[F.lane + 64 * j] = v[j]; } }
        norm_row_v(v, g, mod + so, mod + so + 1024, HX + (size_t)row * D, F.lane);
    }
}
__device__ __forceinline__ void moe_reduce(Frame& F, int k) {
    const int* meta = (const int*)(F.ws + MOE_META) + 9 * k; const int npan = meta[8], gsz = npan - 128;
    if (gsz <= 0) return;
    const int S = pg8::split_factor(npan * 4, F.G, DEXP / 64, MAXSLAB_M); if (S < 2) return;
    const int gw = F.bid * NWAVES + F.wave, NGW = F.G * NWAVES;
    const int* ptok = (const int*)(F.ws + MOE_PTOK) + k * MROWS; const float* pw = (const float*)(F.ws + MOE_PW) + k * MROWS;
    const float* slab = (const float*)(F.ws + WS_SLABM); const float* gate_lat = (const float*)(F.ws + WS_MODLAT) + (size_t)8 * 6144 + 5120;
    for (int rr = NLAT + gw; rr < npan * 256; rr += NGW) { const int tok = ptok[rr]; if (tok < 0) continue; const float w = pw[rr];
        const int pmr = (rr - NLAT) >> 8, r = rr & 255; u32x2* xr = (u32x2*)((bf16_t*)((char*)F.out + XB_OFF) + (size_t)tok * D); const f32x4* gt = (const f32x4*)(gate_lat + (size_t)(tok / SEQ) * 6144);
#pragma unroll
        for (int j = 0; j < 4; ++j) { f32x4 a = zero4(); const float* sp = slab + (size_t)((pmr + gsz * j) * S) * 65536 + (size_t)r * 256 + 4 * F.lane;
            for (int q = 0; q < S; ++q) a += *(const f32x4*)(sp + (size_t)q * 65536);
            const u32x2 xo = xr[F.lane + 64 * j]; const f32x4 xv = {bf2f(xo.x & 0xffffu), __uint_as_float(xo.x & 0xffff0000u), bf2f(xo.y & 0xffffu), __uint_as_float(xo.y & 0xffff0000u)};
            const f32x4 y = xv + (gt[F.lane + 64 * j] * w) * a; xr[F.lane + 64 * j] = (u32x2){pk2(y.x, y.y), pk2(y.z, y.w)}; } }
}
__device__ __forceinline__ void phase_norm_router(Frame& F, const bf16_t* xb) {
    constexpr int l = 1;
    LAS float* wr = (LAS float*)F.lds;
    LAS int* le = (LAS int*)(F.lds + 32768);
    for (int i = F.tid; i < 1024 * 8 / 4; i += NTHREADS) ((LAS f32x4*)wr)[i] = ((const f32x4*)F.pa->in[I_MROUTER])[i];
    __syncthreads();
    const float* g = F.pa->in[I_GFFN] + l * D; bf16_t* HX = (bf16_t*)(F.ws + WS_HX);
    int* toke = (int*)(F.ws + MOE_TOKE); float* tokw = (float*)(F.ws + MOE_TOKW);
    for (int wg = F.bid; wg < NLAT / 128; wg += F.G) {
        u32x2 nx[4]; f32x4 Am[4], Sh[4];
        { const float* mod = (const float*)(F.ws + WS_MODLAT) + ((size_t)l * 8 + (wg * 128) / SEQ) * 6144 + 3072;
#pragma unroll
          for (int j = 0; j < 4; ++j) { Am[j] = ((const f32x4*)g)[F.lane + 64 * j] * (((const f32x4*)(mod + 1024))[F.lane + 64 * j] + 1.0f); Sh[j] = ((const f32x4*)mod)[F.lane + 64 * j]; } }
        { const u32x2* xr = (const u32x2*)(xb + (size_t)(wg * 128 + F.wave * 16) * D) + F.lane;
#pragma unroll
          for (int j = 0; j < 4; ++j) nx[j] = xr[64 * j]; }
        for (int i = 0; i < 16; ++i) { const int tl = F.wave * 16 + i, row = wg * 128 + tl;
            u32x2 cx[4];
#pragma unroll
            for (int j = 0; j < 4; ++j) cx[j] = nx[j];
            { const int rn = (i < 15) ? row + 1 : row; const u32x2* xr = (const u32x2*)(xb + (size_t)rn * D) + F.lane;
#pragma unroll
              for (int j = 0; j < 4; ++j) nx[j] = xr[64 * j]; }
            f32x4 y[4]; norm_row(cx, Am, Sh, HX + (size_t)row * D, F.lane, y);
            float lg[8];
#pragma unroll
            for (int e = 0; e < 8; ++e) lg[e] = 0.f;
#pragma unroll
            for (int j = 0; j < 4; ++j)
#pragma unroll
                for (int q = 0; q < 4; ++q) { const int k = 4 * F.lane + 256 * j + q; const f32x4 w0 = *(const LAS f32x4*)(wr + k * 8), w1 = *(const LAS f32x4*)(wr + k * 8 + 4); const float yv = y[j][q];
                    lg[0] += yv * w0.x; lg[1] += yv * w0.y; lg[2] += yv * w0.z; lg[3] += yv * w0.w; lg[4] += yv * w1.x; lg[5] += yv * w1.y; lg[6] += yv * w1.z; lg[7] += yv * w1.w; }
#pragma unroll
            for (int e = 0; e < 8; ++e) lg[e] = wave_sum(lg[e]) + F.pa->in[I_MROUTERB][e];
            int e0 = 0; float v0 = lg[0];
#pragma unroll
            for (int e = 1; e < 8; ++e) if (lg[e] > v0) { v0 = lg[e]; e0 = e; }
            int e1 = -1; float v1 = -3.0e38f;
#pragma unroll
            for (int e = 0; e < 8; ++e) if (e != e0 && lg[e] > v1) { v1 = lg[e]; e1 = e; }
            const float w0 = 1.0f / (1.0f + __expf(v1 - v0));
            if (F.lane == 0) { toke[row] = e0 | (e1 << 8); tokw[2 * row] = w0; tokw[2 * row + 1] = 1.0f - w0; le[tl] = e0 | (e1 << 8); }
        }
        __syncthreads();
        if (F.tid < 16) { const int k = F.tid >> 3, e = F.tid & 7; int c = 0; for (int t = 0; t < 128; ++t) c += (((le[t] >> (8 * k)) & 0xff) == e) ? 1 : 0; ((int*)(F.ws + MOE_CNT))[wg * 16 + F.tid] = c; }
        __syncthreads();
    }
}
__device__ __forceinline__ void phase_moe_sort(Frame& F) {
    LAS int* tot = (LAS int*)F.lds;
    LAS int* pre = tot + 16;
    LAS int* seg = tot + 32;
    LAS int* le = tot + 64;
    const int* cnt = (const int*)(F.ws + MOE_CNT); const int* toke = (const int*)(F.ws + MOE_TOKE); const float* tokw = (const float*)(F.ws + MOE_TOKW);
    int* ptok = (int*)(F.ws + MOE_PTOK); float* pw = (float*)(F.ws + MOE_PW); int* meta = (int*)(F.ws + MOE_META);
    for (int wg = F.bid; wg < NLAT / 128; wg += F.G) {
        { LAS int* part = tot + 256;
          if (F.tid < 256) { const int col = F.tid & 15, pt = F.tid >> 4; int t = 0, p = 0;
#pragma unroll
              for (int i = 0; i < 16; ++i) { const int w = pt * 16 + i; const int c = cnt[w * 16 + col]; t += c; p += (w < wg) ? c : 0; }
              part[pt * 16 + col] = t; part[256 + pt * 16 + col] = p; }
          if (F.tid >= 256 && F.tid < 384) le[F.tid - 256] = toke[wg * 128 + F.tid - 256];
          __syncthreads();
          if (F.tid < 16) { int t = 0, p = 0;
#pragma unroll
              for (int pt = 0; pt < 16; ++pt) { t += part[pt * 16 + F.tid]; p += part[256 + pt * 16 + F.tid]; }
              tot[F.tid] = t; pre[F.tid] = p; } }
        __syncthreads();
        if (F.tid < 2) { int s = 0; for (int e = 0; e < 8; ++e) { seg[F.tid * 9 + e] = s; s += (tot[F.tid * 8 + e] + 255) & ~255; } seg[F.tid * 9 + 8] = s; }
        __syncthreads();
        if (F.tid < 256) { const int k = F.tid >> 7, t = F.tid & 127; const int e = (le[t] >> (8 * k)) & 0xff; int rank = 0; for (int u = 0; u < t; ++u) rank += (((le[u] >> (8 * k)) & 0xff) == e) ? 1 : 0;
            const int pos = seg[k * 9 + e] + pre[k * 8 + e] + rank; const int tok = wg * 128 + t; ptok[k * MROWS + pos] = tok; pw[k * MROWS + pos] = tokw[2 * tok + k]; ((int*)(F.ws + MOE_PPOS))[k * NLAT + tok] = pos; }
        if (wg < 16) { const int k = wg >> 3, e = wg & 7; const int a = seg[k * 9 + e] + tot[k * 8 + e], b = seg[k * 9 + e + 1]; for (int p = a + F.tid; p < b; p += NTHREADS) { ptok[k * MROWS + p] = -1; pw[k * MROWS + p] = 0.f; } }
        if (wg == 0 && F.tid < 18) meta[F.tid] = seg[F.tid] >> 8;
        __syncthreads();
    }
}
__device__ __forceinline__ void phase_final_a(Frame& F) {
    const int gw = F.bid * NWAVES + F.wave, NGW = F.G * NWAVES; const float* g = F.pa->in[I_GFINAL];
    const bf16_t* xb = (const bf16_t*)((const char*)F.out + XB_OFF); bf16_t* xc = (bf16_t*)(F.ws + WS_XCOPY);
    const int* meta = (const int*)(F.ws + MOE_META) + 9; const int npan = meta[8], gsz = npan - 128;
    const int S = (gsz > 0) ? pg8::split_factor(npan * 4, F.G, DEXP / 64, MAXSLAB_M) : 1;
    const int* ppos = (const int*)(F.ws + MOE_PPOS) + NLAT; const float* pw = (const float*)(F.ws + MOE_PW) + MROWS;
    const float* slab = (const float*)(F.ws + WS_SLABM); const float* gate_lat = (const float*)(F.ws + WS_MODLAT) + (size_t)8 * 6144 + 5120;
    for (int row0 = gw; row0 < NLAT; row0 += 4 * NGW) {
        u32x2 w[4][4]; int rr[4];
#pragma unroll
        for (int u = 0; u < 4; ++u) { const int row = (row0 + u * NGW < NLAT) ? row0 + u * NGW : row0; const u32x2* xr = (const u32x2*)(xb + (size_t)row * D) + F.lane; rr[u] = ppos[row];
#pragma unroll
            for (int j = 0; j < 4; ++j) w[u][j] = xr[64 * j]; }
#pragma unroll
        for (int u = 0; u < 4; ++u) { const int row = row0 + u * NGW; if (row >= NLAT) continue;
            f32x4 v[4];
#pragma unroll
            for (int j = 0; j < 4; ++j) v[j] = (f32x4){bf2f(w[u][j].x & 0xffffu), __uint_as_float(w[u][j].x & 0xffff0000u), bf2f(w[u][j].y & 0xffffu), __uint_as_float(w[u][j].y & 0xffff0000u)};
            if (S >= 2 && rr[u] >= NLAT) { const float wt = pw[rr[u]]; const int pmr = (rr[u] - NLAT) >> 8, r = rr[u] & 255; const f32x4* gt = (const f32x4*)(gate_lat + (size_t)(row / SEQ) * 6144);
#pragma unroll
                for (int j = 0; j < 4; ++j) { f32x4 a = zero4(); const float* sp = slab + (size_t)((pmr + gsz * j) * S) * 65536 + (size_t)r * 256 + 4 * F.lane;
                    for (int q = 0; q < S; ++q) a += *(const f32x4*)(sp + (size_t)q * 65536);
                    v[j] += (gt[F.lane + 64 * j] * wt) * a; } }
            if (row < NLAT / 2) { float ss = 0.f;
#pragma unroll
                for (int j = 0; j < 4; ++j) ss += (v[j].x * v[j].x + v[j].y * v[j].y) + (v[j].z * v[j].z + v[j].w * v[j].w);
                const float rstd = 1.0f / sqrtf(wave_sum(ss) * (1.0f / D) + EPS); f32x4* o = (f32x4*)(F.out + (size_t)row * D) + F.lane;
#pragma unroll
                for (int j = 0; j < 4; ++j) o[64 * j] = (v[j] * rstd) * ((const f32x4*)g)[F.lane + 64 * j]; }
            else { u32x2* o = (u32x2*)(xc + (size_t)(row - NLAT / 2) * D) + F.lane;
#pragma unroll
                for (int j = 0; j < 4; ++j) o[64 * j] = (u32x2){pk2(v[j].x, v[j].y), pk2(v[j].z, v[j].w)}; } }
    }
}
__device__ __forceinline__ void phase_final_b(Frame& F) {
    const int gw = F.bid * NWAVES + F.wave, NGW = F.G * NWAVES; const float* g = F.pa->in[I_GFINAL]; const bf16_t* xc = (const bf16_t*)(F.ws + WS_XCOPY);
    for (int row0 = NLAT / 2 + gw; row0 < NLAT; row0 += 4 * NGW) {
        u32x2 w[4][4];
#pragma unroll
        for (int u = 0; u < 4; ++u) { const int row = (row0 + u * NGW < NLAT) ? row0 + u * NGW : row0; const u32x2* xr = (const u32x2*)(xc + (size_t)(row - NLAT / 2) * D) + F.lane;
#pragma unroll
            for (int j = 0; j < 4; ++j) w[u][j] = xr[64 * j]; }
#pragma unroll
        for (int u = 0; u < 4; ++u) { const int row = row0 + u * NGW; if (row >= NLAT) continue;
            f32x4 v[4]; float ss = 0.f;
#pragma unroll
            for (int j = 0; j < 4; ++j) { v[j] = (f32x4){bf2f(w[u][j].x & 0xffffu), __uint_as_float(w[u][j].x & 0xffff0000u), bf2f(w[u][j].y & 0xffffu), __uint_as_float(w[u][j].y & 0xffff0000u)};
                ss += (v[j].x * v[j].x + v[j].y * v[j].y) + (v[j].z * v[j].z + v[j].w * v[j].w); }
            const float rstd = 1.0f / sqrtf(wave_sum(ss) * (1.0f / D) + EPS); f32x4* o = (f32x4*)(F.out + (size_t)row * D) + F.lane;
#pragma unroll
            for (int j = 0; j < 4; ++j) o[64 * j] = (v[j] * rstd) * ((const f32x4*)g)[F.lane + 64 * j]; }
    }
}

__device__ __forceinline__ bool fresh(Frame& F) {
    int l_ = (int)__builtin_amdgcn_mbcnt_hi(~0u, __builtin_amdgcn_mbcnt_lo(~0u, 0u)); asm volatile("" : "+v"(l_));
    int w_ = F.wave0; asm volatile("" : "+s"(w_));
    F.lane = l_; F.wave = w_; F.tid = w_ * 64 + l_;
    int b_ = blockIdx.x; asm volatile("" : "+s"(b_)); F.bid = b_;
    GAS unsigned char* w2_ = (GAS unsigned char*)F.ws0; asm volatile("" : "+s"(w2_)); F.ws = (unsigned char*)w2_;
    F.out = F.out0; F.pa = F.pa0;
    return true;
}
struct Item { int b, s, row0, seqbase, t0, seqlen; bool is_ctx; };
__device__ __forceinline__ Item item_info(int item) {
    Item it; it.b = item / SPB; it.s = item % SPB;
    if (it.s < 2) { it.is_ctx = true; it.seqbase = NLAT + it.b * CTXL; it.t0 = it.s * CHK; it.seqlen = CTXL; }
    else { it.is_ctx = false; it.seqbase = it.b * SEQ; it.t0 = (it.s - 2) * CHK; it.seqlen = SEQ; }
    it.row0 = it.seqbase + it.t0; return it;
}
constexpr int UCP = 144;
constexpr int TP = 272;
constexpr int TILEB = 128 * TP;
constexpr int VP = 288;
constexpr int TILEV = 128 * VP;

__device__ __forceinline__ unsigned tr_lane_addr(ldsp_t tile, int lane) { return (unsigned)(__SIZE_TYPE__)tile + (unsigned)((4 * (lane >> 4) + ((lane & 15) >> 2)) * VP + 8 * (lane & 3)); }
__device__ __forceinline__ bf16x8 mk_frag(u32x2 lo, u32x2 hi) { const u32x4 v = {lo.x, lo.y, hi.x, hi.y}; return __builtin_bit_cast(bf16x8, v); }
template <int OFF> __device__ __forceinline__ bf16x8 tr1(unsigned addr) {
    u32x2 a0, a1;
    asm volatile("ds_read_b64_tr_b16 %0, %2 offset:%3\n\tds_read_b64_tr_b16 %1, %2 offset:%4\n\ts_waitcnt lgkmcnt(0)" : "=&v"(a0), "=&v"(a1) : "v"(addr), "i"(OFF), "i"(OFF + 16 * VP) : "memory");
    return mk_frag(a0, a1);
}
template <int OFF> __device__ __forceinline__ void tr4(unsigned addr, bf16x8& f0, bf16x8& f1, bf16x8& f2, bf16x8& f3) {
    u32x2 a0, a1, b0, b1, c0, c1, d0, d1;
    asm volatile("ds_read_b64_tr_b16 %0, %8 offset:%9\n\tds_read_b64_tr_b16 %1, %8 offset:%10\n\tds_read_b64_tr_b16 %2, %8 offset:%11\n\tds_read_b64_tr_b16 %3, %8 offset:%12\n\t"
                 "ds_read_b64_tr_b16 %4, %8 offset:%13\n\tds_read_b64_tr_b16 %5, %8 offset:%14\n\tds_read_b64_tr_b16 %6, %8 offset:%15\n\tds_read_b64_tr_b16 %7, %8 offset:%16\n\ts_waitcnt lgkmcnt(0)"
                 : "=&v"(a0), "=&v"(a1), "=&v"(b0), "=&v"(b1), "=&v"(c0), "=&v"(c1), "=&v"(d0), "=&v"(d1)
                 : "v"(addr), "i"(OFF), "i"(OFF + 16 * VP), "i"(OFF + 32), "i"(OFF + 32 + 16 * VP), "i"(OFF + 64), "i"(OFF + 64 + 16 * VP), "i"(OFF + 96), "i"(OFF + 96 + 16 * VP) : "memory");
    f0 = mk_frag(a0, a1); f1 = mk_frag(b0, b1); f2 = mk_frag(c0, c1); f3 = mk_frag(d0, d1);
}

__device__ __forceinline__ void build_decay(Frame& F, int l) {
    LAS float* dec = (LAS float*)(F.lds + LDS_DEC);
    for (int i = F.tid; i < 2 * 4 * 132; i += NTHREADS) { const int n = i % 132, dh = i / 132; const float x = F.pa->in[I_RETDEC][l * 8 + dh]; const float lg = -log1pf(expf(-x)); dec[i] = expf((float)n * lg); }
}

struct RgStep { bf16x8 bwa[2], bwx[2]; float lam, ba, bx, carry; };
template <bool FINAL>
__device__ __forceinline__ void rg_load_step(RgStep& R, Frame& F, const bf16_t* wgt, int l, int dir, int item, int blk, int n, int lane) {
    const int fr = lane & 15, fq = lane >> 4;
    const bf16_t* wa = wgt + ((size_t)(0 * 8 + blk) * 64 + 16 * n + fr) * 64 + 8 * fq;
    const bf16_t* wx = wgt + ((size_t)(1 * 8 + blk) * 64 + 16 * n + fr) * 64 + 8 * fq;
    R.bwa[0] = *(const bf16x8*)wa; R.bwa[1] = *(const bf16x8*)(wa + 32); R.bwx[0] = *(const bf16x8*)wx; R.bwx[1] = *(const bf16x8*)(wx + 32);
    const int ch = blk * 64 + 16 * n + fr, pi = (l * 2 + dir) * 512 + ch;
    R.lam = F.pa->in[I_RGLAM][pi]; R.ba = F.pa->in[I_RGBA][pi]; R.bx = F.pa->in[I_RGBX][pi];
    R.carry = FINAL ? ((const float*)(F.ws + WS_CARRY))[((size_t)item * 2 + dir) * 512 + ch] : 0.f;
}
template <bool FINAL, int DIR>
__device__ __forceinline__ void rg_dir(ldsp_t ucw, const bf16x8 (&af)[8][2], const RgStep& R, int n, int lane, f32x4 (&hsum)[8], float& Atot, float& Htot) {
    const int fr = lane & 15, fq = lane >> 4;
    constexpr float L2E_ = 1.4426950408889634f;
    const float ba2 = -L2E_ * R.ba, bx2 = -L2E_ * R.bx, cl2 = -8.0f * L2E_ * log1pf(expf(-R.lam)), carry = R.carry;
    const bf16x8 bwa[2] = {R.bwa[0], R.bwa[1]}, bwx[2] = {R.bwx[0], R.bwx[1]};
    f32x4 ar[8], ai[8];
#pragma unroll
    for (int m = 0; m < 8; ++m) { ar[m] = zero4(); ai[m] = zero4(); }
#pragma unroll
    for (int m = 0; m < 8; ++m)
#pragma unroll
        for (int ks = 0; ks < 2; ++ks) { ar[m] = __builtin_amdgcn_mfma_f32_16x16x32_bf16(af[m][ks], bwa[ks], ar[m], 0, 0, 0); ai[m] = __builtin_amdgcn_mfma_f32_16x16x32_bf16(af[m][ks], bwx[ks], ai[m], 0, 0, 0); }
    const unsigned uo = (unsigned)(32 * fq * UCP + (16 * n + fr) * 2);
#pragma unroll
    for (int m = 0; m < 8; ++m)
#pragma unroll
        for (int jj = 0; jj < 4; ++jj) {
            const float r = __builtin_amdgcn_rcpf(1.0f + __builtin_amdgcn_exp2f(__builtin_fmaf(ar[m][jj], -1.4426950408889634f, ba2)));
            const float ig = __builtin_amdgcn_rcpf(1.0f + __builtin_amdgcn_exp2f(__builtin_fmaf(ai[m][jj], -1.4426950408889634f, bx2)));
            const float a = __builtin_amdgcn_exp2f(cl2 * r);
            const float u = bf2f(*(const LAS bf16_t*)(ucw + uo + (4 * m + jj) * UCP));
            ar[m][jj] = a; ai[m][jj] = __builtin_amdgcn_sqrtf(__builtin_fmaf(-a, a, 1.0f)) * ig * u; }
    float gA = 1.f, gH = 0.f;
#pragma unroll
    for (int mm = 0; mm < 8; ++mm) { const int m = DIR ? 7 - mm : mm;
#pragma unroll
        for (int j4 = 0; j4 < 4; ++j4) { const int jj = DIR ? 3 - j4 : j4; gH = __builtin_fmaf(ar[m][jj], gH, ai[m][jj]); gA *= ar[m][jj]; } }
    const float A0 = lane_bcast(gA, fr), H0 = lane_bcast(gH, fr), A1 = lane_bcast(gA, fr + 16), H1 = lane_bcast(gH, fr + 16), A2 = lane_bcast(gA, fr + 32), H2 = lane_bcast(gH, fr + 32), A3 = lane_bcast(gA, fr + 48), H3 = lane_bcast(gH, fr + 48);
    if (FINAL) { float h = carry;
        if (!DIR) { if (fq > 0) h = A0 * h + H0; if (fq > 1) h = A1 * h + H1; if (fq > 2) h = A2 * h + H2; }
        else { if (fq < 3) h = A3 * h + H3; if (fq < 2) h = A2 * h + H2; if (fq < 1) h = A1 * h + H1; }
#pragma unroll
        for (int mm = 0; mm < 8; ++mm) { const int m = DIR ? 7 - mm : mm;
#pragma unroll
            for (int j4 = 0; j4 < 4; ++j4) { const int jj = DIR ? 3 - j4 : j4; h = __builtin_fmaf(ar[m][jj], h, ai[m][jj]); hsum[m][jj] += h; } } }
    if (!DIR) Htot = A3 * (A2 * (A1 * H0 + H1) + H2) + H3; else Htot = A0 * (A1 * (A2 * H3 + H2) + H1) + H0;
    Atot = (A0 * A1) * (A2 * A3);
}
template <bool FINAL, bool SHARED = false>
__device__ __forceinline__ void rg_part(Frame& F, int l, int item, const Item& it, const int blk, const int n0, const int n1) {
    const bf16_t* P = (const bf16_t*)(F.ws + WS_PA);
    int lane = F.lane; const bool act = !SHARED || F.wave < 4;
    ldsp_t ucw = SHARED ? F.lds : F.lds + F.wave * (128 * UCP);
    if (act) { const int grp = lane & 7, ch0 = blk * 64 + grp * 8; float cw[4][8], cb[8];
#pragma unroll
      for (int k = 0; k < 4; ++k)
#pragma unroll
          for (int i = 0; i < 8; ++i) cw[k][i] = F.pa->in[I_CONVW][((size_t)l * 4 + k) * 512 + ch0 + i];
#pragma unroll
      for (int i = 0; i < 8; ++i) cb[i] = F.pa->in[I_CONVB][l * 512 + ch0 + i];
      const bf16_t* Pu = P + (size_t)it.seqbase * INW + ch0;
#pragma unroll 8
      for (int q = 0; q < (SHARED ? 4 : 16); ++q) { const int token = (SHARED ? 32 * F.wave : 0) + (lane >> 3) + 8 * q; float o[8];
#pragma unroll
          for (int i = 0; i < 8; ++i) o[i] = cb[i];
#pragma unroll
          for (int k = 0; k < 4; ++k) { const int tt = it.t0 + token + k - 2; const int tc = tt < 0 ? 0 : (tt >= it.seqlen ? it.seqlen - 1 : tt);
              u32x4 v = ldg<u32x4>(Pu, (unsigned)tc * (unsigned)(INW * 2)); if (tt != tc) v = (u32x4){0u, 0u, 0u, 0u};
              o[0] += cw[k][0] * bf2f(v.x & 0xffffu); o[1] += cw[k][1] * __uint_as_float(v.x & 0xffff0000u); o[2] += cw[k][2] * bf2f(v.y & 0xffffu); o[3] += cw[k][3] * __uint_as_float(v.y & 0xffff0000u);
              o[4] += cw[k][4] * bf2f(v.z & 0xffffu); o[5] += cw[k][5] * __uint_as_float(v.z & 0xffff0000u); o[6] += cw[k][6] * bf2f(v.w & 0xffffu); o[7] += cw[k][7] * __uint_as_float(v.w & 0xffff0000u); }
          u32x4 w; w.x = pk2(o[0], o[1]); w.y = pk2(o[2], o[3]); w.z = pk2(o[4], o[5]); w.w = pk2(o[6], o[7]);
          *(LAS u32x4*)(ucw + token * UCP + grp * 16) = w; }
      LDS_WAIT(); asm volatile("" ::: "memory"); }
    if (SHARED) __syncthreads();
    asm volatile("" : "+v"(lane));
    bf16x8 af[8][2];
    if (act) { const int fr = lane & 15, fq = lane >> 4;
#pragma unroll
      for (int m = 0; m < 8; ++m)
#pragma unroll
          for (int ks = 0; ks < 2; ++ks) af[m][ks] = *(const LAS bf16x8*)(ucw + (32 * (fr >> 2) + 4 * m + (fr & 3)) * UCP + (8 * fq + 32 * ks) * 2); }
    if (SHARED) { __syncthreads(); if (!act) return; }
    const bf16_t* wg0 = (const bf16_t*)(F.ws + WS_RGW) + (size_t)(l * 2 + 0) * 2 * 8 * 4096;
    const bf16_t* wg1 = (const bf16_t*)(F.ws + WS_RGW) + (size_t)(l * 2 + 1) * 2 * 8 * 4096;
    float* TOT = (float*)(F.ws + WS_TOT);
    RgStep R0, R1;
    rg_load_step<FINAL>(R0, F, wg0, l, 0, item, blk, n0, lane);
#pragma unroll 1
    for (int n = n0; n < n1; ++n) { asm volatile("" : "+v"(lane));
        const int fr = lane & 15, fq = lane >> 4; const int ch = blk * 64 + 16 * n + fr;
        f32x4 hsum[8];
#pragma unroll
        for (int m = 0; m < 8; ++m) hsum[m] = zero4();
        rg_load_step<FINAL>(R1, F, wg1, l, 1, item, blk, n, lane);
        { float At, Ht;
          rg_dir<FINAL, 0>(ucw, af, R0, n, lane, hsum, At, Ht);
          if (!FINAL && fq == 0) { *(f32x2*)(TOT + (((size_t)item * 2 + 0) * 512 + ch) * 2) = (f32x2){At, Ht}; } }
        __builtin_amdgcn_sched_barrier(0);
        if (n + 1 < n1) rg_load_step<FINAL>(R0, F, wg0, l, 0, item, blk, n + 1, lane);
        { float At, Ht;
          rg_dir<FINAL, 1>(ucw, af, R1, n, lane, hsum, At, Ht);
          if (!FINAL && fq == 0) { *(f32x2*)(TOT + (((size_t)item * 2 + 1) * 512 + ch) * 2) = (f32x2){At, Ht}; } }
        if (FINAL) {
            const unsigned uo = (unsigned)(32 * fq * UCP + (16 * n + fr) * 2);
#pragma unroll
            for (int m = 0; m < 8; ++m)
#pragma unroll
                for (int jj = 0; jj < 4; ++jj) *(LAS bf16_t*)(ucw + uo + (4 * m + jj) * UCP) = (bf16_t)f2bf(hsum[m][jj]); }
    }
    if (FINAL) {
        LDS_WAIT(); asm volatile("" : "+v"(lane) :: "memory");
        const int ng = 2 * (n1 - n0);
        const int grp = 2 * n0 + ((ng == 8) ? (lane & 7) : (lane & 1)); const int tk0 = (ng == 8) ? (lane >> 3) : (lane >> 1), tstep = (ng == 8) ? 8 : 32, nq = (ng == 8) ? 16 : 4;
        const bf16_t* Pg = P + (size_t)it.row0 * INW + 512 + blk * 64 + grp * 8; bf16_t* Yo = (bf16_t*)(F.ws + WS_Y) + (size_t)it.row0 * D + blk * 64 + grp * 8;
#pragma unroll 8
        for (int q = 0; q < nq; ++q) { const int token = tk0 + tstep * q;
            const u32x4 hv = *(const LAS u32x4*)(ucw + token * UCP + grp * 16); const u32x4 gv = ldg<u32x4>(Pg, (unsigned)token * (unsigned)(INW * 2));
            u32x4 w;
            w.x = pk2(gelu_tanh(bf2f(gv.x & 0xffffu)) * bf2f(hv.x & 0xffffu), gelu_tanh(__uint_as_float(gv.x & 0xffff0000u)) * __uint_as_float(hv.x & 0xffff0000u));
            w.y = pk2(gelu_tanh(bf2f(gv.y & 0xffffu)) * bf2f(hv.y & 0xffffu), gelu_tanh(__uint_as_float(gv.y & 0xffff0000u)) * __uint_as_float(hv.y & 0xffff0000u));
            w.z = pk2(gelu_tanh(bf2f(gv.z & 0xffffu)) * bf2f(hv.z & 0xffffu), gelu_tanh(__uint_as_float(gv.z & 0xffff0000u)) * __uint_as_float(hv.z & 0xffff0000u));
            w.w = pk2(gelu_tanh(bf2f(gv.w & 0xffffu)) * bf2f(hv.w & 0xffffu), gelu_tanh(__uint_as_float(gv.w & 0xffff0000u)) * __uint_as_float(hv.w & 0xffff0000u));
            stg<u32x4>(Yo, (unsigned)token * (unsigned)(D * 2), w); }
        LDS_WAIT();
    }
}

__device__ __forceinline__ void stage_rows(Frame& F, ldsp_t dst, const Item& it, int col0, bool rope) {
    const bf16_t* P = (const bf16_t*)(F.ws + WS_PA); const float* ct = (const float*)(F.ws + WS_ROPE); const float* st = ct + 4096 * 64;
    for (int task = F.tid; task < 1024; task += NTHREADS) { const int token = task >> 3, d0 = (task & 7) * 8;
        const bf16_t* src = P + (size_t)(it.row0 + token) * INW + col0;
        const u32x4 lo = *(const u32x4*)(src + d0), hi = *(const u32x4*)(src + d0 + 64);
        u32x4 olo = lo, ohi = hi;
        if (rope) { const int pos = it.t0 + token; const f32x4 c0 = *(const f32x4*)(ct + pos * 64 + d0), c1 = *(const f32x4*)(ct + pos * 64 + d0 + 4), s0 = *(const f32x4*)(st + pos * 64 + d0), s1 = *(const f32x4*)(st + pos * 64 + d0 + 4);
            const float a[8] = {bf2f(lo.x & 0xffffu), __uint_as_float(lo.x & 0xffff0000u), bf2f(lo.y & 0xffffu), __uint_as_float(lo.y & 0xffff0000u), bf2f(lo.z & 0xffffu), __uint_as_float(lo.z & 0xffff0000u), bf2f(lo.w & 0xffffu), __uint_as_float(lo.w & 0xffff0000u)};
            const float b[8] = {bf2f(hi.x & 0xffffu), __uint_as_float(hi.x & 0xffff0000u), bf2f(hi.y & 0xffffu), __uint_as_float(hi.y & 0xffff0000u), bf2f(hi.z & 0xffffu), __uint_as_float(hi.z & 0xffff0000u), bf2f(hi.w & 0xffffu), __uint_as_float(hi.w & 0xffff0000u)};
            const float c[8] = {c0.x, c0.y, c0.z, c0.w, c1.x, c1.y, c1.z, c1.w}, s[8] = {s0.x, s0.y, s0.z, s0.w, s1.x, s1.y, s1.z, s1.w};
            float ra[8], rb[8];
#pragma unroll
            for (int i = 0; i < 8; ++i) { ra[i] = a[i] * c[i] - b[i] * s[i]; rb[i] = a[i] * s[i] + b[i] * c[i]; }
            olo.x = pk2(ra[0], ra[1]); olo.y = pk2(ra[2], ra[3]); olo.z = pk2(ra[4], ra[5]); olo.w = pk2(ra[6], ra[7]);
            ohi.x = pk2(rb[0], rb[1]); ohi.y = pk2(rb[2], rb[3]); ohi.z = pk2(rb[4], rb[5]); ohi.w = pk2(rb[6], rb[7]); }
        *(LAS u32x4*)(dst + token * TP + d0 * 2) = olo; *(LAS u32x4*)(dst + token * TP + (d0 + 64) * 2) = ohi; }
}
__device__ __forceinline__ void stage_cols(Frame& F, ldsp_t dst, const Item& it, int col0) {
    const bf16_t* P = (const bf16_t*)(F.ws + WS_PA);
    for (int task = F.tid; task < 2048; task += NTHREADS) { const int token = task >> 4, d0 = (task & 15) * 8;
        const u32x4 v = *(const u32x4*)(P + (size_t)(it.row0 + token) * INW + col0 + d0);
        const unsigned w[4] = {v.x, v.y, v.z, v.w};
#pragma unroll
        for (int i = 0; i < 4; ++i) { *(LAS bf16_t*)(dst + (d0 + 2 * i) * TP + token * 2) = (bf16_t)(w[i] & 0xffffu); *(LAS bf16_t*)(dst + (d0 + 2 * i + 1) * TP + token * 2) = (bf16_t)(w[i] >> 16); } }
}
__device__ __forceinline__ void rope8(u32x4& lo, u32x4& hi, const float* ct, const float* st, int pos, int d0) {
    const f32x4 c0 = *(const f32x4*)(ct + pos * 64 + d0), c1 = *(const f32x4*)(ct + pos * 64 + d0 + 4), s0 = *(const f32x4*)(st + pos * 64 + d0), s1 = *(const f32x4*)(st + pos * 64 + d0 + 4);
    const float a[8] = {bf2f(lo.x & 0xffffu), __uint_as_float(lo.x & 0xffff0000u), bf2f(lo.y & 0xffffu), __uint_as_float(lo.y & 0xffff0000u), bf2f(lo.z & 0xffffu), __uint_as_float(lo.z & 0xffff0000u), bf2f(lo.w & 0xffffu), __uint_as_float(lo.w & 0xffff0000u)};
    const float b[8] = {bf2f(hi.x & 0xffffu), __uint_as_float(hi.x & 0xffff0000u), bf2f(hi.y & 0xffffu), __uint_as_float(hi.y & 0xffff0000u), bf2f(hi.z & 0xffffu), __uint_as_float(hi.z & 0xffff0000u), bf2f(hi.w & 0xffffu), __uint_as_float(hi.w & 0xffff0000u)};
    const float c[8] = {c0.x, c0.y, c0.z, c0.w, c1.x, c1.y, c1.z, c1.w}, sn[8] = {s0.x, s0.y, s0.z, s0.w, s1.x, s1.y, s1.z, s1.w};
    float ra[8], rb[8];
#pragma unroll
    for (int i = 0; i < 8; ++i) { ra[i] = a[i] * c[i] - b[i] * sn[i]; rb[i] = a[i] * sn[i] + b[i] * c[i]; }
    lo = (u32x4){pk2(ra[0], ra[1]), pk2(ra[2], ra[3]), pk2(ra[4], ra[5]), pk2(ra[6], ra[7])};
    hi = (u32x4){pk2(rb[0], rb[1]), pk2(rb[2], rb[3]), pk2(rb[4], rb[5]), pk2(rb[6], rb[7])};
}
struct KvRegs { u32x4 klo[2], khi[2], v[4]; };
__device__ __forceinline__ void kv_issue(Frame& F, KvRegs& R, const Item& it, int h) {
    const bf16_t* P = (const bf16_t*)(F.ws + WS_PA);
    const bf16_t* Pk = P + (size_t)it.row0 * INW + 1536 + h * HD; const bf16_t* Pv = P + (size_t)it.row0 * INW + 2048 + h * HD;
#pragma unroll
    for (int t2 = 0; t2 < 2; ++t2) { const int task = F.tid + t2 * NTHREADS, token = task >> 3, d0 = (task & 7) * 8;
        R.klo[t2] = ldg<u32x4>(Pk, (unsigned)(token * INW + d0) * 2u); R.khi[t2] = ldg<u32x4>(Pk, (unsigned)(token * INW + d0 + 64) * 2u); }
#pragma unroll
    for (int t4 = 0; t4 < 4; ++t4) { const int task = F.tid + t4 * NTHREADS, token = task >> 4, d0 = (task & 15) * 8; R.v[t4] = ldg<u32x4>(Pv, (unsigned)(token * INW + d0) * 2u); }
}
template <int KS> __device__ __forceinline__ void kv_step(unsigned aK, unsigned aVf, unsigned aVb, f32x4 (&accf)[8], f32x4 (&accb)[8]) {
    const bf16x8 af = tr1<KS * 32 * VP>(aVf), ab = tr1<KS * 32 * VP>(aVb);
    bf16x8 b[8];
    tr4<KS * 32 * VP>(aK, b[0], b[1], b[2], b[3]); tr4<KS * 32 * VP + 128>(aK, b[4], b[5], b[6], b[7]);
#pragma unroll
    for (int n = 0; n < 8; ++n) { accf[n] = __builtin_amdgcn_mfma_f32_16x16x32_bf16(af, b[n], accf[n], 0, 0, 0); accb[n] = __builtin_amdgcn_mfma_f32_16x16x32_bf16(ab, b[n], accb[n], 0, 0, 0); }
}
__device__ __forceinline__ void stage_state_t(Frame& F, ldsp_t dst, const bf16_t* St) {
#pragma unroll
    for (int t4 = 0; t4 < 4; ++t4) { const int task = F.tid + t4 * NTHREADS, e = task >> 4, c8 = task & 15;
        *(LAS u32x4*)(dst + e * TP + c8 * 16) = ldg<u32x4>(St, (unsigned)(e * 128 + c8 * 8) * 2u); }
}
__device__ __forceinline__ void mm16x128(ldsp_t At, int ra0, ldsp_t Bt, int lane, f32x4 (&acc)[8]) {
    const int fr = lane & 15, fq = lane >> 4;
#pragma unroll
    for (int ks = 0; ks < 4; ++ks) { const bf16x8 a = *(const LAS bf16x8*)(At + (ra0 + fr) * TP + (32 * ks + 8 * fq) * 2);
#pragma unroll
        for (int n = 0; n < 8; ++n) { const bf16x8 b = *(const LAS bf16x8*)(Bt + (16 * n + fr) * TP + (32 * ks + 8 * fq) * 2); acc[n] = __builtin_amdgcn_mfma_f32_16x16x32_bf16(a, b, acc[n], 0, 0, 0); } }
}

__device__ __forceinline__ void kv_head(Frame& F, KvRegs& R, KvRegs& Rn, bool pre, int item, const Item& it, int h) {
    bf16_t* KV = (bf16_t*)(F.ws + WS_KV);
    const float* ct = (const float*)(F.ws + WS_ROPE); const float* st = ct + 4096 * 64;
    const LAS float* dec = (const LAS float*)(F.lds + LDS_DEC); const bool rope = !it.is_ctx;
    ldsp_t tK = F.lds, tVf = F.lds + TILEV, tVb = F.lds + 2 * TILEV;
#pragma unroll
    for (int t2 = 0; t2 < 2; ++t2) { const int task = F.tid + t2 * NTHREADS, token = task >> 3, d0 = (task & 7) * 8;
        if (rope) rope8(R.klo[t2], R.khi[t2], ct, st, it.t0 + token, d0);
        *(LAS u32x4*)(tK + token * VP + d0 * 2) = R.klo[t2]; *(LAS u32x4*)(tK + token * VP + (d0 + 64) * 2) = R.khi[t2]; }
#pragma unroll
    for (int t4 = 0; t4 < 4; ++t4) { const int task = F.tid + t4 * NTHREADS, token = task >> 4, d0 = (task & 15) * 8; const u32x4 v = R.v[t4];
        const float df = dec[(0 * 4 + h) * 132 + 127 - token], db = dec[(1 * 4 + h) * 132 + token];
        const float x[8] = {bf2f(v.x & 0xffffu), __uint_as_float(v.x & 0xffff0000u), bf2f(v.y & 0xffffu), __uint_as_float(v.y & 0xffff0000u), bf2f(v.z & 0xffffu), __uint_as_float(v.z & 0xffff0000u), bf2f(v.w & 0xffffu), __uint_as_float(v.w & 0xffff0000u)};
        u32x4 wf, wb; wf.x = pk2(x[0] * df, x[1] * df); wf.y = pk2(x[2] * df, x[3] * df); wf.z = pk2(x[4] * df, x[5] * df); wf.w = pk2(x[6] * df, x[7] * df);
        wb.x = pk2(x[0] * db, x[1] * db); wb.y = pk2(x[2] * db, x[3] * db); wb.z = pk2(x[4] * db, x[5] * db); wb.w = pk2(x[6] * db, x[7] * db);
        *(LAS u32x4*)(tVf + token * VP + d0 * 2) = wf; *(LAS u32x4*)(tVb + token * VP + d0 * 2) = wb; }
    WG_BAR_LDS();
    if (pre) kv_issue(F, Rn, it, h + 1);
    f32x4 af[8], ab[8];
#pragma unroll
    for (int n = 0; n < 8; ++n) { af[n] = zero4(); ab[n] = zero4(); }
    { const unsigned aK = tr_lane_addr(tK, F.lane), aVf = tr_lane_addr(tVf, F.lane) + 32u * (unsigned)F.wave, aVb = tr_lane_addr(tVb, F.lane) + 32u * (unsigned)F.wave;
      kv_step<0>(aK, aVf, aVb, af, ab); kv_step<1>(aK, aVf, aVb, af, ab); kv_step<2>(aK, aVf, aVb, af, ab); kv_step<3>(aK, aVf, aVb, af, ab); }
    const int fr = F.lane & 15, fq = F.lane >> 4;
    bf16_t* of = KV + (((size_t)item * 4 + h) * 2 + 0) * 16384 + (size_t)(16 * F.wave) * 128;
    unsigned so = (unsigned)((4 * fq) * 128 + fr) * 2u; asm volatile("" : "+v"(so));
#pragma unroll
    for (int n = 0; n < 8; ++n)
#pragma unroll
        for (int jj = 0; jj < 4; ++jj) { stg<bf16_t>(of, so + (unsigned)((jj * 128 + 16 * n) * 2), (bf16_t)f2bf(af[n][jj])); stg<bf16_t>(of, so + (unsigned)((16384 + jj * 128 + 16 * n) * 2), (bf16_t)f2bf(ab[n][jj])); }
    WG_BAR_LDS();
}
__device__ __forceinline__ int latent_item(int c) { return (c >> 5) * SPB + 2 + (c & 31); }
__device__ __forceinline__ int ctx_item(int ci) { return (ci >> 1) * SPB + (ci & 1); }
__device__ __forceinline__ void phase_m1(Frame& F, int l) {
    build_decay(F, l); __syncthreads();
    for (int c = F.bid; c < 256; c += F.G) {
        fresh(F);
        { const int item = latent_item(c); const Item it = item_info(item);
          rg_part<false>(F, l, item, it, F.wave, 0, 4);
          __syncthreads();
          KvRegs A, B;
          fresh(F); kv_issue(F, A, it, 0);
          kv_head(F, A, B, true, item, it, 0);
          fresh(F); kv_head(F, B, A, true, item, it, 1);
          fresh(F); kv_head(F, A, B, true, item, it, 2);
          fresh(F); kv_head(F, B, A, false, item, it, 3); }
        fresh(F);
        if (c >= 64 && c < 192) { const int cu = c - 64; const int item = ctx_item(cu >> 3); const Item it = item_info(item);
            const int w4 = F.wave & 3; rg_part<false, true>(F, l, item, it, cu & 7, w4, w4 + 1); }
        __syncthreads();
        if (c < 64) { const int item = ctx_item(c >> 2); const Item it = item_info(item); KvRegs A, B; fresh(F); kv_issue(F, A, it, c & 3); kv_head(F, A, B, false, item, it, c & 3); }
    }
}
__device__ __forceinline__ int seq_order(int dir, int step) { return dir ? (step == 0 ? 1 : (step == 1 ? 0 : 35 - step)) : step; }
__device__ __forceinline__ void phase_m2(Frame& F, int l) {
    bf16_t* KV = (bf16_t*)(F.ws + WS_KV);
    const int gt = F.bid * NTHREADS + F.tid, NGT = F.G * NTHREADS;
    for (int c = gt; c < NB * NH * 2 * 128 * 16; c += NGT) {
        const int dc = c & 15, e = (c >> 4) & 127, dir = (c >> 11) & 1, h = (c >> 12) & 3, b = c >> 14;
        const float x = F.pa->in[I_RETDEC][l * 8 + dir * 4 + h]; const float decay = expf(128.0f * (-log1pf(expf(-x))));
        float S[8];
#pragma unroll
        for (int i = 0; i < 8; ++i) S[i] = 0.f;
        const unsigned lo = (unsigned)((((h * 2 + dir) * 128 + e) * 128 + dc * 8) * 2);
        for (int g0 = 0; g0 < SPB; g0 += 17) {
            u32x4 v[17];
#pragma unroll
            for (int i = 0; i < 17; ++i) { const int item = b * SPB + seq_order(dir, g0 + i); v[i] = ldg<u32x4>(KV + (size_t)item * 4 * 2 * 16384, lo); }
#pragma unroll
            for (int i = 0; i < 17; ++i) { const int item = b * SPB + seq_order(dir, g0 + i);
                u32x4 w; w.x = pk2(S[0], S[1]); w.y = pk2(S[2], S[3]); w.z = pk2(S[4], S[5]); w.w = pk2(S[6], S[7]);
                stg<u32x4>(KV + (size_t)item * 4 * 2 * 16384, lo, w);
                S[0] = S[0] * decay + bf2f(v[i].x & 0xffffu); S[1] = S[1] * decay + __uint_as_float(v[i].x & 0xffff0000u); S[2] = S[2] * decay + bf2f(v[i].y & 0xffffu); S[3] = S[3] * decay + __uint_as_float(v[i].y & 0xffff0000u);
                S[4] = S[4] * decay + bf2f(v[i].z & 0xffffu); S[5] = S[5] * decay + __uint_as_float(v[i].z & 0xffff0000u); S[6] = S[6] * decay + bf2f(v[i].w & 0xffffu); S[7] = S[7] * decay + __uint_as_float(v[i].w & 0xffff0000u); }
        }
    }
    const float* TOT = (const float*)(F.ws + WS_TOT); float* CARRY = (float*)(F.ws + WS_CARRY);
    if (F.tid < 32) for (int cidx = F.bid * 32 + F.tid; cidx < NB * 2 * 512; cidx += F.G * 32) {
      { const int ch = cidx & 511, dir = (cidx >> 9) & 1, b = cidx >> 10; float cr = 0.f;
          for (int g0 = 0; g0 < SPB; g0 += 17) { f32x2 ah[17];
#pragma unroll
              for (int i = 0; i < 17; ++i) { const int item = b * SPB + seq_order(dir, g0 + i); ah[i] = *(const f32x2*)(TOT + (((size_t)item * 2 + dir) * 512 + ch) * 2); }
#pragma unroll
              for (int i = 0; i < 17; ++i) { const int item = b * SPB + seq_order(dir, g0 + i); CARRY[((size_t)item * 2 + dir) * 512 + ch] = cr; cr = ah[i].x * cr + ah[i].y; } } } }
}
struct RetRegs { u32x4 v[4], sf[4], sb[4], klo[2], khi[2], g[4]; };
__device__ __forceinline__ void ret_issue(Frame& F, RetRegs& R, int item, const Item& it, int h) {
    const bf16_t* KV = (const bf16_t*)(F.ws + WS_KV); const bf16_t* P = (const bf16_t*)(F.ws + WS_PA);
    const bf16_t* Pk = P + (size_t)it.row0 * INW + 1536 + h * HD; const bf16_t* Pv = P + (size_t)it.row0 * INW + 2048 + h * HD;
    const bf16_t* Sf = KV + (((size_t)item * 4 + h) * 2 + 0) * 16384; const bf16_t* Sb = Sf + 16384;
    const int lane = F.lane, i0 = 16 * F.wave;
#pragma unroll
    for (int t2 = 0; t2 < 2; ++t2) { const int task = F.tid + t2 * NTHREADS, token = task >> 3, d0 = (task & 7) * 8;
        R.klo[t2] = ldg<u32x4>(Pk, (unsigned)(token * INW + d0) * 2u); R.khi[t2] = ldg<u32x4>(Pk, (unsigned)(token * INW + d0 + 64) * 2u); }
#pragma unroll
    for (int t4 = 0; t4 < 4; ++t4) { const int task = F.tid + t4 * NTHREADS, r = task >> 4, c8 = task & 15;
        R.v[t4] = ldg<u32x4>(Pv, (unsigned)(r * INW + c8 * 8) * 2u); R.sf[t4] = ldg<u32x4>(Sf, (unsigned)(r * 128 + c8 * 8) * 2u); R.sb[t4] = ldg<u32x4>(Sb, (unsigned)(r * 128 + c8 * 8) * 2u); }
    { const bf16_t* Pg = P + (size_t)(it.row0 + i0) * INW + 2560 + h * HD;
#pragma unroll
      for (int k = 0; k < 4; ++k) R.g[k] = ldg<u32x4>(Pg, (unsigned)((lane >> 2) * INW + 32 * (lane & 3) + 8 * k) * 2u); }
}
__device__ __forceinline__ void ret_head(Frame& F, RetRegs& R, RetRegs& Rn, bool pre, int item, const Item& it, int h) {
    bf16_t* Y = (bf16_t*)(F.ws + WS_Y);
    const float* ct = (const float*)(F.ws + WS_ROPE); const float* st = ct + 4096 * 64;
    const LAS float* dec = (const LAS float*)(F.lds + LDS_DEC);
    ldsp_t tK = F.lds, tV = F.lds + TILEB, tSf = tV + TILEV, tSb = tSf + TILEB;
    const bool rope = !it.is_ctx;
    const int lane = F.lane, fr = lane & 15, fq = lane >> 4, i0 = 16 * F.wave;
    u32x4 q4[4];
    { const bf16_t* Pq = (const bf16_t*)(F.ws + WS_PA) + (size_t)(it.row0 + i0) * INW + 1024 + h * HD;
#pragma unroll
      for (int ks = 0; ks < 4; ++ks) q4[ks] = ldg<u32x4>(Pq, (unsigned)(fr * INW + 32 * ks + 8 * fq) * 2u); }
#pragma unroll
    for (int t2 = 0; t2 < 2; ++t2) { const int task = F.tid + t2 * NTHREADS, token = task >> 3, d0 = (task & 7) * 8;
        if (rope) rope8(R.klo[t2], R.khi[t2], ct, st, it.t0 + token, d0);
        *(LAS u32x4*)(tK + token * TP + d0 * 2) = R.klo[t2]; *(LAS u32x4*)(tK + token * TP + (d0 + 64) * 2) = R.khi[t2]; }
#pragma unroll
    for (int t4 = 0; t4 < 4; ++t4) { const int task = F.tid + t4 * NTHREADS, r = task >> 4, c8 = task & 15;
        *(LAS u32x4*)(tV + r * VP + c8 * 16) = R.v[t4]; *(LAS u32x4*)(tSf + r * TP + c8 * 16) = R.sf[t4]; *(LAS u32x4*)(tSb + r * TP + c8 * 16) = R.sb[t4]; }
    bf16x8 qf[4];
    { if (rope) { rope8(q4[0], q4[2], ct, st, it.t0 + i0 + fr, 8 * fq); rope8(q4[1], q4[3], ct, st, it.t0 + i0 + fr, 32 + 8 * fq); }
#pragma unroll
      for (int ks = 0; ks < 4; ++ks) qf[ks] = __builtin_bit_cast(bf16x8, q4[ks]); }
    u32x4 gk[4];
#pragma unroll
    for (int k = 0; k < 4; ++k) gk[k] = R.g[k];
    WG_BAR_LDS();
    if (pre) ret_issue(F, Rn, item, it, h + 1);
    bf16x8 pa[4];
    { f32x4 C[8];
#pragma unroll
      for (int jt = 0; jt < 8; ++jt) { C[jt] = zero4();
#pragma unroll
          for (int ks = 0; ks < 4; ++ks) { const bf16x8 a = *(const LAS bf16x8*)(tK + (16 * jt + fr) * TP + (32 * ks + 8 * fq) * 2); C[jt] = __builtin_amdgcn_mfma_f32_16x16x32_bf16(a, qf[ks], C[jt], 0, 0, 0); } }
      const int i = i0 + fr;
#pragma unroll
      for (int jt = 0; jt < 8; ++jt)
#pragma unroll
          for (int jj = 0; jj < 4; ++jj) { const int j = 16 * jt + 4 * fq + jj; const float dcy = (i >= j) ? dec[(0 * 4 + h) * 132 + (i - j)] : dec[(1 * 4 + h) * 132 + (j - i)]; C[jt][jj] *= dcy; }
#pragma unroll
      for (int u = 0; u < 4; ++u) { const u32x4 w = {pg8::cvt_pk_bf16(C[2 * u][0], C[2 * u][1]), pg8::cvt_pk_bf16(C[2 * u][2], C[2 * u][3]), pg8::cvt_pk_bf16(C[2 * u + 1][0], C[2 * u + 1][1]), pg8::cvt_pk_bf16(C[2 * u + 1][2], C[2 * u + 1][3])};
          pa[u] = __builtin_bit_cast(bf16x8, w); } }
    WG_BAR_LDS();
    { ldsp_t gt = tK + (i0 + (lane >> 2)) * TP + (lane & 3) * 64;
#pragma unroll
      for (int k = 0; k < 4; ++k) *(LAS u32x4*)(gt + 16 * k) = gk[k]; }
    f32x4 o[8];
#pragma unroll
    for (int n = 0; n < 8; ++n) o[n] = zero4();
    { const unsigned aV = tr_lane_addr(tV, lane); bf16x8 b[8];
#define RET_PV(U) do { tr4<(U) * 32 * VP>(aV, b[0], b[1], b[2], b[3]); tr4<(U) * 32 * VP + 128>(aV, b[4], b[5], b[6], b[7]); \
        _Pragma("unroll") for (int n = 0; n < 8; ++n) o[n] = __builtin_amdgcn_mfma_f32_16x16x32_bf16(pa[U], b[n], o[n], 0, 0, 0); } while (0)
      RET_PV(0); RET_PV(1); RET_PV(2); RET_PV(3);
#undef RET_PV
    }
    { f32x4 cf[8];
#pragma unroll
      for (int n = 0; n < 8; ++n) { cf[n] = zero4();
#pragma unroll
          for (int ks = 0; ks < 4; ++ks) { const bf16x8 b = *(const LAS bf16x8*)(tSf + (16 * n + fr) * TP + (32 * ks + 8 * fq) * 2); cf[n] = __builtin_amdgcn_mfma_f32_16x16x32_bf16(qf[ks], b, cf[n], 0, 0, 0); } }
#pragma unroll
      for (int jj = 0; jj < 4; ++jj) { const float sf = dec[(0 * 4 + h) * 132 + (i0 + 4 * fq + jj + 1)];
#pragma unroll
          for (int n = 0; n < 8; ++n) o[n][jj] += sf * cf[n][jj]; } }
    { f32x4 cb[8];
#pragma unroll
      for (int n = 0; n < 8; ++n) { cb[n] = zero4();
#pragma unroll
          for (int ks = 0; ks < 4; ++ks) { const bf16x8 b = *(const LAS bf16x8*)(tSb + (16 * n + fr) * TP + (32 * ks + 8 * fq) * 2); cb[n] = __builtin_amdgcn_mfma_f32_16x16x32_bf16(qf[ks], b, cb[n], 0, 0, 0); } }
#pragma unroll
      for (int jj = 0; jj < 4; ++jj) { const float sb = dec[(1 * 4 + h) * 132 + (128 - (i0 + 4 * fq + jj))];
#pragma unroll
          for (int n = 0; n < 8; ++n) o[n][jj] += sb * cb[n][jj]; } }
    { ldsp_t gc = tK + (i0 + 4 * fq) * TP + fr * 2;
#pragma unroll
      for (int jj = 0; jj < 4; ++jj) { float s1 = 0.f;
#pragma unroll
          for (int n = 0; n < 8; ++n) s1 += o[n][jj];
          s1 += swz_xor<1>(s1); s1 += swz_xor<2>(s1); s1 += swz_xor<4>(s1); s1 += swz_xor<8>(s1);
          const float mu = s1 * (1.0f / 128.0f); float q = 0.f;
#pragma unroll
          for (int n = 0; n < 8; ++n) { const float dd = o[n][jj] - mu; q += dd * dd; }
          q += swz_xor<1>(q); q += swz_xor<2>(q); q += swz_xor<4>(q); q += swz_xor<8>(q);
          const float rstd = 1.0f / sqrtf(q * (1.0f / 128.0f) + EPS);
#pragma unroll
          for (int n = 0; n < 8; ++n) { LAS bf16_t* p = (LAS bf16_t*)(gc + jj * TP + 32 * n); const float gv = bf2f(*p); *p = (bf16_t)f2bf(siluf_(gv) * (o[n][jj] - mu) * rstd); } } }
    LDS_WAIT(); asm volatile("" ::: "memory");
    { ldsp_t gt = tK + (i0 + (lane >> 2)) * TP + (lane & 3) * 64; bf16_t* Yo = Y + (size_t)(it.row0 + i0) * D + 512 + h * HD;
#pragma unroll
      for (int k = 0; k < 4; ++k) stg<u32x4>(Yo, (unsigned)((lane >> 2) * D + 32 * (lane & 3) + 8 * k) * 2u, *(const LAS u32x4*)(gt + 16 * k)); }
    WG_BAR_LDS();
}
__device__ __forceinline__ void phase_m3(Frame& F, int l) {
    build_decay(F, l); __syncthreads();
    for (int c = F.bid; c < 256; c += F.G) {
        fresh(F);
        { const int item = latent_item(c); const Item it = item_info(item);
#ifndef PROBE_M3
#define PROBE_M3 0
#endif
          for (int r_ = 0; r_ < ((PROBE_M3 & 1) ? 2 : 1); ++r_) { fresh(F); rg_part<true>(F, l, item, it, F.wave, 0, 4); }
          __syncthreads();
          for (int r_ = 0; r_ < ((PROBE_M3 & 2) ? 2 : 1); ++r_) {
          RetRegs R, Rn;
          fresh(F); ret_issue(F, R, item, it, 0);
          ret_head(F, R, Rn, true, item, it, 0);
          fresh(F); ret_head(F, Rn, R, true, item, it, 1);
          fresh(F); ret_head(F, R, Rn, true, item, it, 2);
          fresh(F); ret_head(F, Rn, R, false, item, it, 3); } }
        if (l == 0) {
            fresh(F);
            if (c >= 64 && c < 192) { const int cu = c - 64; const int item = ctx_item(cu >> 3); const Item it = item_info(item);
                const int w4 = F.wave & 3; rg_part<true, true>(F, l, item, it, cu & 7, w4, w4 + 1); }
            __syncthreads();
            if (c < 64) { const int item = ctx_item(c >> 2); const Item it = item_info(item); RetRegs R, Rn; fresh(F); ret_issue(F, R, item, it, c & 3); ret_head(F, R, Rn, false, item, it, c & 3); }
        }
    }
}

constexpr int N_PHASES = 24;
__global__ void __launch_bounds__(NTHREADS, 2) fwd_kernel(Args args) {
    extern __shared__ __attribute__((aligned(16))) unsigned char lds_raw[];
    Frame F; F.lds = (ldsp_t)lds_raw; F.wave0 = __builtin_amdgcn_readfirstlane((int)threadIdx.x >> 6); F.G = gridDim.x; F.pa0 = &args; F.out0 = args.out; F.ws0 = args.ws; fresh(F);
    volatile LAS unsigned* MISC = (volatile LAS unsigned*)(F.lds + LDS_MISC);
    if (F.tid < 64) MISC[F.tid] = 0u;
    __syncthreads();
    const int lo = args.ph_lo, hi = args.ph_hi;
    XcdBarrier bar; bar.bar = (unsigned*)(F.ws + WS_CTL); bar.x = 0; bar.st = nullptr;
    if (hi - lo > 1) bar = xcd_barrier_post((unsigned*)(F.ws + WS_CTL), MISC);
#ifndef DIAG_MASK
#define DIAG_MASK 0xffffffffu
#endif
#ifndef REPEAT_MASK
#define REPEAT_MASK 0u
#endif
#define REPS(kind) ((((REPEAT_MASK) >> (kind)) & 1u) ? 2 : 1)
#define INK(k, kind) (((DIAG_MASK >> (kind)) & 1u) && lo <= (k) && (k) < hi && fresh(F))
#define IN(k) (lo <= (k) && (k) < hi)
#define SEAM(k) do { if (IN(k) && IN((k) + 1)) xcd_barrier(bar); } while (0)
    float* ctxx = (float*)(F.ws + WS_CTXX); bf16_t* xb = (bf16_t*)((char*)F.out + XB_OFF);
    const float* modlat = (const float*)(F.ws + WS_MODLAT); const float* modctx = (const float*)(F.ws + WS_MODCTX);

    if (INK(0, 0)) { for (int r_ = 0; r_ < REPS(0); ++r_) { phase_convert_small(F); __syncthreads(); phase_mod(F); __syncthreads(); } } SEAM(0);
    if (INK(1, 1)) { for (int r_ = 0; r_ < REPS(1); ++r_) phase_norm(F, 0, 0, F.pa->in[I_X], nullptr, F.pa->in[I_CTX], MROWS, SlabRed{nullptr, 0, nullptr, nullptr, nullptr}); } SEAM(1);
#pragma unroll 1
    for (int l = 0; l < 2; ++l) {
        const int pb = (l == 0) ? 2 : 11;
        if (INK(pb + 0, 2)) { pg8::Gemm g{(const bf16_t*)(F.ws + WS_HX), (const bf16_t*)(F.ws + WS_WIN) + (size_t)l * INW * D, INW, D, 0, nullptr}; pg8::Order S; S.init(MROWS / 256, INW / 256, F.G, F.bid, nullptr, nullptr, D / 64, false, 0);
            pg8::EpiBf16 E{(bf16_t*)(F.ws + WS_PA), INW}; for (int r_ = 0; r_ < REPS(2); ++r_) pg8::gemm_phase<pg8::EpiBf16>(F.lds, g, S, E, F.tid); }
        SEAM(pb + 0);
        if (INK(pb + 1, 3)) { for (int r_ = 0; r_ < REPS(3); ++r_) phase_m1(F, l); }
        SEAM(pb + 1);
        if (INK(pb + 2, 4)) { for (int r_ = 0; r_ < REPS(4); ++r_) { if (r_) phase_m1(F, l); phase_m2(F, l); } }
        SEAM(pb + 2);
        if (INK(pb + 3, 5)) { for (int r_ = 0; r_ < REPS(5); ++r_) phase_m3(F, l); }
        SEAM(pb + 3);
        if (INK(pb + 4, 6)) { pg8::Gemm g{(const bf16_t*)(F.ws + WS_Y), (const bf16_t*)(F.ws + WS_WOUT) + (size_t)l * D * D, D, D, 0, (float*)(F.ws + WS_SLABA)}; pg8::Order S; S.init((l == 0 ? MROWS : NLAT) / 256, D / 256, F.G, F.bid, nullptr, nullptr, D / 64, true, MAXSLAB_A);
            pg8::EpiResid E{l == 0 ? F.pa->in[I_X] : nullptr, xb, F.pa->in[I_CTX], ctxx, modlat + (size_t)l * 8 * 6144 + 2048, modctx + (size_t)l * 6144 + 2048};
            pg8::gemm_phase<pg8::EpiResid>(F.lds, g, S, E, F.tid); }
        SEAM(pb + 4);
        if (l == 0) {
            if (INK(7, 1)) { for (int r_ = 0; r_ < REPS(1); ++r_) phase_norm(F, 0, 1, nullptr, xb, ctxx, MROWS, SlabRed{(const float*)(F.ws + WS_SLABA), pg8::split_factor((MROWS / 256) * 4, F.G, D / 64, MAXSLAB_A), modctx + 2048, F.pa->in[I_CTX], ctxx}); } SEAM(7);
            if (INK(8, 7)) { pg8::Gemm g{(const bf16_t*)(F.ws + WS_HX), (const bf16_t*)(F.ws + WS_WUP), 2 * DFF, D, 0, nullptr}; pg8::Order S; S.init(MROWS / 256, 2 * DFF / 256, F.G, F.bid, nullptr, nullptr, D / 64, false, 0);
                pg8::EpiSwiGLU E{(bf16_t*)(F.ws + WS_PA), DFF}; for (int r_ = 0; r_ < REPS(7); ++r_) pg8::gemm_phase<pg8::EpiSwiGLU>(F.lds, g, S, E, F.tid); }
            SEAM(8);
            if (INK(9, 8)) { pg8::Gemm g{(const bf16_t*)(F.ws + WS_PA), (const bf16_t*)(F.ws + WS_WDN), D, DFF, 0, (float*)(F.ws + WS_SLABA)}; pg8::Order S; S.init(MROWS / 256, D / 256, F.G, F.bid, nullptr, nullptr, DFF / 64, true, MAXSLAB_A);
                pg8::EpiResid E{nullptr, xb, (const float*)ctxx, ctxx, modlat + 5120, modctx + 5120}; pg8::gemm_phase<pg8::EpiResid>(F.lds, g, S, E, F.tid); }
            SEAM(9);
            if (INK(10, 1)) { for (int r_ = 0; r_ < REPS(1); ++r_) phase_norm(F, 1, 0, nullptr, xb, ctxx, MROWS, SlabRed{(const float*)(F.ws + WS_SLABA), pg8::split_factor((MROWS / 256) * 4, F.G, DFF / 64, MAXSLAB_A), modctx + 5120, ctxx, ctxx}); } SEAM(10);
        }
    }
    if (INK(16, 9)) { for (int r_ = 0; r_ < REPS(9); ++r_) { phase_norm_router(F, xb); __syncthreads(); phase_convert_moe(F); __syncthreads(); } } SEAM(16);
    if (INK(17, 10)) { phase_moe_sort(F); } SEAM(17);
#pragma unroll 1
    for (int k = 0; k < 2; ++k) {
        const int* meta = (const int*)(F.ws + MOE_META) + 9 * k;
        if (INK(18 + 2 * k, 11)) { if (k == 1) { moe_reduce(F, 0); __syncthreads(); } pg8::Gemm g{(const bf16_t*)(F.ws + WS_HX), (const bf16_t*)(F.ws + WS_MOEUP), 2 * DEXP, D, (size_t)2 * DEXP * D * 2, nullptr}; pg8::Order S; S.init(meta[8], 2 * DEXP / 256, F.G, F.bid, meta, (const int*)(F.ws + MOE_PTOK) + k * MROWS, D / 64, false, 0);
            pg8::EpiSwiGLU E{(bf16_t*)(F.ws + WS_PA), DEXP}; for (int r_ = 0; r_ < REPS(11); ++r_) pg8::gemm_phase<pg8::EpiSwiGLU>(F.lds, g, S, E, F.tid); }
        SEAM(18 + 2 * k);
        if (INK(19 + 2 * k, 12)) { pg8::Gemm g{(const bf16_t*)(F.ws + WS_PA), (const bf16_t*)(F.ws + WS_MOEDN), D, DEXP, (size_t)D * DEXP * 2, (float*)(F.ws + WS_SLABM)}; pg8::Order S; S.init(meta[8], D / 256, F.G, F.bid, meta, nullptr, DEXP / 64, true, MAXSLAB_M);
            pg8::EpiMoeDown E{xb, (const int*)(F.ws + MOE_PTOK) + k * MROWS, (const float*)(F.ws + MOE_PW) + k * MROWS, modlat + (size_t)8 * 6144 + 5120}; pg8::gemm_phase<pg8::EpiMoeDown>(F.lds, g, S, E, F.tid); }
        SEAM(19 + 2 * k);
    }
    if (INK(22, 13)) phase_final_a(F);
    SEAM(22);
    if (INK(23, 13)) phase_final_b(F);
#undef IN
#undef INK
#undef SEAM
}

extern "C" void kernel_launch(void* const* d_in, const int* in_sizes, int n_in, void* d_out, int out_size, void* d_ws, size_t ws_size, hipStream_t stream) {
    static int grid = 0;
    if (grid == 0) {
        if (n_in != 27 || in_sizes[0] != NLAT * D || out_size != NLAT * D || ws_size < WS_END) { fprintf(stderr, "kernel_launch: unexpected problem (n_in %d, in0 %d, out %d, ws %zu, need %zu); nothing launched\n", n_in, n_in > 0 ? in_sizes[0] : -1, out_size, ws_size, (size_t)WS_END); grid = -1; return; }
        int dev = 0, cus = 0, per_cu = 0;
        if (hipGetDevice(&dev) != hipSuccess || hipDeviceGetAttribute(&cus, hipDeviceAttributeMultiprocessorCount, dev) != hipSuccess) { grid = -1; return; }
        if (hipFuncSetAttribute((const void*)fwd_kernel, hipFuncAttributeMaxDynamicSharedMemorySize, LDS_BYTES) != hipSuccess) { fprintf(stderr, "kernel_launch: hipFuncSetAttribute failed\n"); grid = -1; return; }
        if (hipOccupancyMaxActiveBlocksPerMultiprocessor(&per_cu, (const void*)fwd_kernel, NTHREADS, LDS_BYTES) != hipSuccess || per_cu < 1) { fprintf(stderr, "kernel_launch: occupancy query says %d\n", per_cu); }
        (void)hipGetLastError();
        grid = cus;
    }
    if (grid < 0) return;
    (void)hipMemsetAsync((char*)d_ws + WS_CTL, 0, CTL_ZERO_BYTES, stream);
    Args a; memset(&a, 0, sizeof(a));
    for (int i = 0; i < 27; ++i) a.in[i] = (const float*)d_in[i];
    a.out = (float*)d_out; a.ws = (unsigned char*)d_ws;
#if MK_ONE_LAUNCH
    a.ph_lo = 0; a.ph_hi = N_PHASES;
    hipLaunchKernelGGL(fwd_kernel, dim3(grid), dim3(NTHREADS), LDS_BYTES, stream, a);
#else
    for (int p = 0; p < N_PHASES; ++p) { a.ph_lo = p; a.ph_hi = p + 1; hipLaunchKernelGGL(fwd_kernel, dim3(grid), dim3(NTHREADS), LDS_BYTES, stream, a); }
#endif
}
```

```cpp
#include <hip/hip_runtime.h>
#include <cstdio>
#include <cstdint>
#include <cstring>

#ifndef MK_ONE_LAUNCH
#define MK_ONE_LAUNCH 1
#endif

#define GAS __attribute__((address_space(1)))
#define LAS __attribute__((address_space(3)))
typedef unsigned short bf16_t;
typedef short bf16x8 __attribute__((ext_vector_type(8)));
typedef float f32x4 __attribute__((ext_vector_type(4)));
typedef float f32x2 __attribute__((ext_vector_type(2)));
typedef unsigned u32x4 __attribute__((ext_vector_type(4)));
typedef unsigned u32x2 __attribute__((ext_vector_type(2)));
typedef LAS unsigned char* ldsp_t;

constexpr int D = 1024, NB = 8, SEQ = 4096, NLAT = NB * SEQ, CTXL = 256, NCTX = NB * CTXL, MROWS = NLAT + NCTX;
constexpr int INW = 3072, NH = 4, HD = 128, CHK = 128;
constexpr int DFF = 2816, NE = 8, DEXP = 3584;
constexpr int SPB = 34;
constexpr int NITEM = NB * SPB;
constexpr float EPS = 1e-6f;
constexpr int NWAVES = 8, NTHREADS = 512;

constexpr size_t MiB = 1u << 20;
constexpr size_t WS_CTL = 0, CTL_ZERO_BYTES = 64 * 1024;
constexpr size_t WS_MODLAT = 1 * MiB;
constexpr size_t WS_MODCTX = 1 * MiB + 2 * 8 * 6144 * 4;
constexpr size_t WS_ROPE = 2 * MiB;
constexpr size_t WS_RGW = 4 * MiB;
constexpr size_t WS_TOT = 5 * MiB;
constexpr size_t WS_CARRY = 8 * MiB;
constexpr size_t WS_MOE = 10 * MiB;
constexpr size_t MOE_CNT = WS_MOE, MOE_META = WS_MOE + 16384, MOE_TOKE = WS_MOE + 65536, MOE_TOKW = WS_MOE + 262144,
                 MOE_PTOK = WS_MOE + 524288, MOE_PW = WS_MOE + 1048576, MOE_PPOS = WS_MOE + 1572864;
constexpr size_t WS_CTXX = 12 * MiB;
constexpr size_t WS_WIN = 20 * MiB;
constexpr size_t WS_WOUT = 32 * MiB;
constexpr size_t WS_WUP = 36 * MiB;
constexpr size_t WS_WDN = 47 * MiB;
constexpr size_t WS_HX = 54 * MiB;
constexpr size_t WS_PA = 122 * MiB;
constexpr size_t WS_KV = 360 * MiB;
constexpr size_t WS_Y = 496 * MiB;
constexpr size_t WS_MOEUP = 360 * MiB;
constexpr size_t WS_MOEDN = 472 * MiB;
constexpr size_t WS_SLABA = WS_KV;
constexpr size_t WS_SLABM = 528 * MiB;
constexpr int MAXSLAB_A = 256, MAXSLAB_M = 216;
constexpr size_t XB_OFF = (size_t)NLAT * D * 2;
constexpr size_t WS_XCOPY = WS_PA;
constexpr size_t WS_END = 582 * MiB;
static_assert(WS_MOEDN + (size_t)NE * D * DEXP * 2 <= WS_END, "ws map");
static_assert(WS_PA + (size_t)MROWS * DEXP * 2 <= WS_KV, "ws map");

constexpr int LDS_SCRATCH = 147456;
constexpr int LDS_MISC = LDS_SCRATCH;
constexpr int LDS_DEC = LDS_MISC + 256;
constexpr int LDS_BYTES = LDS_SCRATCH + 8192;

__device__ __forceinline__ float bf2f(unsigned v) { return __uint_as_float(v << 16); }
typedef __bf16 bf16x2_t __attribute__((ext_vector_type(2)));
__device__ __forceinline__ unsigned pk2(float lo, float hi) { const f32x2 v = {lo, hi}; return __builtin_bit_cast(unsigned, __builtin_convertvector(v, bf16x2_t)); }
__device__ __forceinline__ unsigned f2bf(float f) { return pk2(f, f) & 0xffffu; }
__device__ __forceinline__ void unpack8(const u32x4 v, f32x4& a, f32x4& b) {
    a = (f32x4){bf2f(v.x & 0xffffu), __uint_as_float(v.x & 0xffff0000u), bf2f(v.y & 0xffffu), __uint_as_float(v.y & 0xffff0000u)};
    b = (f32x4){bf2f(v.z & 0xffffu), __uint_as_float(v.z & 0xffff0000u), bf2f(v.w & 0xffffu), __uint_as_float(v.w & 0xffff0000u)}; }
__device__ __forceinline__ u32x4 pack8(const f32x4 a, const f32x4 b) { return (u32x4){pk2(a.x, a.y), pk2(a.z, a.w), pk2(b.x, b.y), pk2(b.z, b.w)}; }
template <int M> __device__ __forceinline__ float swz_xor(float v) { return __int_as_float(__builtin_amdgcn_ds_swizzle(__float_as_int(v), (M << 10) | 0x1f)); }
__device__ __forceinline__ float wave_sum(float v) {
    v += swz_xor<1>(v); v += swz_xor<2>(v); v += swz_xor<4>(v); v += swz_xor<8>(v); v += swz_xor<16>(v);
    const auto r = __builtin_amdgcn_permlane32_swap(__float_as_uint(v), __float_as_uint(v), false, false);
    return __uint_as_float(r[0]) + __uint_as_float(r[1]);
}
__device__ __forceinline__ float lane_bcast(float v, int src_lane) { return __int_as_float(__builtin_amdgcn_ds_bpermute(src_lane << 2, __float_as_int(v))); }
__device__ __forceinline__ float sigmoidf_(float x) { return __builtin_amdgcn_rcpf(1.0f + __expf(-x)); }
__device__ __forceinline__ float siluf_(float x) { return x * __builtin_amdgcn_rcpf(1.0f + __expf(-x)); }
__device__ __forceinline__ float gelu_tanh(float x) { const float z = 0.7978845608028654f * (x + 0.044715f * x * x * x); return x * (1.0f - __builtin_amdgcn_rcpf(1.0f + __expf(2.0f * z))); }
#define LDS_WAIT() asm volatile("s_waitcnt lgkmcnt(0)" ::: "memory")
#define WG_BAR_LDS() do { asm volatile("s_waitcnt lgkmcnt(0)" ::: "memory"); __builtin_amdgcn_s_barrier(); asm volatile("" ::: "memory"); } while (0)
__device__ __forceinline__ f32x4 zero4() { float z; asm volatile("v_mov_b32 %0, 0" : "=v"(z)); return (f32x4){z, z, z, z}; }

template <typename T> __device__ __forceinline__ T ldg(const void* base, unsigned off) { return *(const GAS T*)((const GAS char*)base + off); }
template <typename T> __device__ __forceinline__ void stg(void* base, unsigned off, T v) { *(GAS T*)((GAS char*)base + off) = v; }
#define XB_TMO      128
#define XB_XCNT(j)  (256  + 64 * (j))
#define XB_XSUB(j)  (1280 + 64 * (j))
#define XB_XGEN(j)  (2304 + 64 * (j))
#define XB_TOP      3328
#define XB_TOPGEN   3392
#define XCD_BAR_WORDS 3456
#define XB_SPIN_CAP (1u << 18)
__device__ __forceinline__ unsigned xb_ld(unsigned* p)              { return __hip_atomic_load(p, __ATOMIC_RELAXED, __HIP_MEMORY_SCOPE_AGENT); }
__device__ __forceinline__ unsigned xb_add(unsigned* p, unsigned v) { return __hip_atomic_fetch_add(p, v, __ATOMIC_RELAXED, __HIP_MEMORY_SCOPE_AGENT); }
__device__ __forceinline__ unsigned xb_xcc_id() { return (unsigned)__builtin_amdgcn_s_getreg((3 << 11) | 20) & 0xFu; }
#define XB_SPIN(cond, bar) do { unsigned _sp = 0; while (cond) { __builtin_amdgcn_s_sleep(1); \
    if ((++_sp & 255u) == 0u) { if (xb_ld(&(bar)[XB_TMO])) break; if (_sp > XB_SPIN_CAP) { atomicAdd(&(bar)[XB_TMO], 1u); break; } } } } while (0)
struct XcdBarrier { unsigned* bar; unsigned x; volatile LAS unsigned* st; };
__device__ __forceinline__ XcdBarrier xcd_barrier_post(unsigned* bar, volatile LAS unsigned* st) {
    XcdBarrier b; b.bar = bar; b.x = xb_xcc_id(); b.st = st;
    if (threadIdx.x == 0) (void)xb_add(&bar[XB_XCNT(b.x)], 1u);
    return b;
}
__device__ __forceinline__ void xcd_barrier_complete(unsigned* bar, unsigned x, unsigned& nloc, unsigned& nx) {
    const unsigned G = gridDim.x * gridDim.y * gridDim.z;
    unsigned sum, cnt, mine, sp = 0u;
    for (;;) {
        sum = 0u; cnt = 0u; mine = 0u;
#pragma unroll
        for (unsigned j = 0; j < 16; ++j) { const unsigned c = xb_ld(&bar[XB_XCNT(j)]); sum += c; cnt += (c > 0u) ? 1u : 0u; mine = (j == x) ? c : mine; }
        if (sum == G) break;
        __builtin_amdgcn_s_sleep(1);
        if ((++sp & 255u) == 0u) { if (xb_ld(&bar[XB_TMO])) break; if (sp > XB_SPIN_CAP) { atomicAdd(&bar[XB_TMO], 1u); break; } }
    }
    nloc = mine > 0u ? mine : 1u; nx = cnt > 0u ? cnt : 1u;
}
__device__ __forceinline__ void xcd_barrier(const XcdBarrier& b) {
    asm volatile("s_waitcnt vmcnt(0)" ::: "memory");
    __syncthreads();
    if (threadIdx.x == 0) {
        unsigned* bar = b.bar;
        __builtin_amdgcn_s_waitcnt(0);
        unsigned nloc = b.st[0], nx = b.st[1];
        if (nloc == 0u) { xcd_barrier_complete(bar, b.x, nloc, nx); b.st[0] = nloc; b.st[1] = nx; }
        const unsigned old = xb_add(&bar[XB_XSUB(b.x)], 1u);
        const unsigned gen = old / nloc;
        if (old + 1u == (gen + 1u) * nloc) {
            __builtin_amdgcn_fence(__ATOMIC_RELEASE, "agent");
            asm volatile("s_waitcnt vmcnt(0)" ::: "memory");
            const unsigned og = xb_add(&bar[XB_TOP], 1u);
            const unsigned tg = og / nx;
            if (og + 1u == (tg + 1u) * nx) xb_add(&bar[XB_TOPGEN], 1u);
            else XB_SPIN(xb_ld(&bar[XB_TOPGEN]) == tg, bar);
            __builtin_amdgcn_fence(__ATOMIC_ACQUIRE, "agent");
            xb_add(&bar[XB_XGEN(b.x)], 1u);
            asm volatile("s_waitcnt vmcnt(0)" ::: "memory");
        } else {
            XB_SPIN(xb_ld(&bar[XB_XGEN(b.x)]) == gen, bar);
            __builtin_amdgcn_fence(__ATOMIC_ACQUIRE, "agent");
            asm volatile("s_waitcnt vmcnt(0)" ::: "memory");
        }
    }
    __syncthreads();
}

namespace pg8 {
constexpr int BM = 256, BK = 64, HALF = 128, HTB = HALF * BK * 2, STAGE_BYTES = 8 * HTB, NXCD = 8, WGM = 8;
__host__ __device__ __forceinline__ int lds_byte(int r, int c) { const int st = (r >> 4) * 2 + (c >> 5), rr = r & 15, cc = c & 31, ob = rr * 64 + cc * 2; return st * 1024 + (ob ^ (((ob >> 9) & 1) << 5)); }
__host__ __device__ __forceinline__ void stage_rc(int b, int& R, int& C) { const int st = b / 1024, sb = b % 1024, swz = sb ^ (((sb >> 9) & 1) << 5); R = (st >> 1) * 16 + swz / 64; C = (st & 1) * 32 + (swz % 64) / 2; }
__host__ __device__ __forceinline__ int perm32(int rho) { const int n = rho >> 4, i = rho & 15; return 8 * (i >> 2) + 4 * n + (i & 3); }

struct Unit { int pm, pn, e, kt0, nt, slab; };
struct Gemm { const bf16_t* A; const bf16_t* Bt; int N, K; size_t estride; float* slabs; };

__device__ __forceinline__ int split_factor(int U, int G, int ntiles, int maxslabs) {
    const int R = U % G; if (R == 0) return 1;
    int S = G / R; if (S > 8) S = 8; if (S > ntiles / 2) S = ntiles / 2; if (R * S > maxslabs) S = maxslabs / R;
    return S < 2 ? 1 : S;
}
struct Order {
    int nM, nN, G, c, ntiles, mainu, S, total; const int* segs; const int* rowmap;
    int sg1, sg2, sg3, sg4, sg5, sg6, sg7;
    __device__ __forceinline__ void init(int nM_, int nN_, int G_, int c_, const int* segs_, const int* rowmap_, int ntiles_, bool split, int maxslabs) {
        nM = nM_; nN = nN_; G = G_; c = c_; segs = segs_; rowmap = rowmap_; ntiles = ntiles_;
        sg1 = sg2 = sg3 = sg4 = sg5 = sg6 = sg7 = 0; if (segs_) { sg1 = segs_[1]; sg2 = segs_[2]; sg3 = segs_[3]; sg4 = segs_[4]; sg5 = segs_[5]; sg6 = segs_[6]; sg7 = segs_[7]; }
        const int U = nM * nN; S = split ? split_factor(U, G, ntiles, maxslabs) : 1; const int R = (S > 1) ? U % G : 0; mainu = U - R; total = mainu + R * S; }
    __device__ __forceinline__ bool next(int i, Unit& u) const {
        const long L = (long)i * G + c; if (L >= total) return false;
        int wgid; u.kt0 = 0; u.nt = ntiles; u.slab = -1;
        if (L < mainu) { wgid = (int)L; const int q = mainu / NXCD, r = mainu % NXCD, xcd = wgid % NXCD, off = wgid / NXCD; wgid = (xcd < r ? xcd * (q + 1) : r * (q + 1) + (xcd - r) * q) + off; }
        else { const int sub = (int)L - mainu, lu = sub / S, sl = sub - lu * S, pairs = ntiles / 2, p0 = (sl * pairs) / S, p1 = ((sl + 1) * pairs) / S;
            wgid = mainu + lu; u.kt0 = 2 * p0; u.nt = 2 * (p1 - p0); u.slab = sub; }
        const int nig = WGM * nN, gid = wgid / nig, fm = gid * WGM, gsz = (nM - fm) < WGM ? (nM - fm) : WGM;
        u.pm = fm + ((wgid % nig) % gsz); u.pn = (wgid % nig) / gsz; u.e = 0;
        if (segs) u.e = (u.pm >= sg1) + (u.pm >= sg2) + (u.pm >= sg3) + (u.pm >= sg4) + (u.pm >= sg5) + (u.pm >= sg6) + (u.pm >= sg7);
        return true;
    }
    __device__ __forceinline__ int arow(const Unit& u, int r) const {
        if (rowmap) { const int t = rowmap[u.pm * BM + r]; return t < 0 ? 0 : t; }
        return u.pm * BM + r;
    }
};

__device__ __forceinline__ unsigned cvt_pk_bf16(float lo, float hi) { return pk2(lo, hi); }

struct EpiBf16 {
    static constexpr bool PERM = true, SPLIT = false;
    bf16_t* O; int ldc;
    __device__ __forceinline__ void operator()(const f32x4 (&acc)[2][2][4][2], const Unit& u, int wr, int wc, int fr, int fq) const {
        asm volatile("" : "+v"(fr), "+v"(fq));
        const int row0 = u.pm * BM + wr * 64 + fr, col0 = u.pn * BM + wc * 32 + 8 * fq;
#pragma unroll
        for (int ai = 0; ai < 2; ++ai)
#pragma unroll
            for (int m = 0; m < 4; ++m) { bf16_t* rowp = O + (size_t)(row0 + ai * HALF + m * 16) * ldc + col0;
#pragma unroll
                for (int bj = 0; bj < 2; ++bj) { const f32x4 v0 = acc[ai][bj][m][0], v1 = acc[ai][bj][m][1];
                    u32x4 w; w.x = cvt_pk_bf16(v0[0], v0[1]); w.y = cvt_pk_bf16(v0[2], v0[3]); w.z = cvt_pk_bf16(v1[0], v1[1]); w.w = cvt_pk_bf16(v1[2], v1[3]);
                    *(u32x4*)(rowp + bj * HALF) = w; } }
    }
};
struct EpiSwiGLU {
    static constexpr bool PERM = true, SPLIT = false;
    bf16_t* O; int ldc;
    __device__ __forceinline__ void operator()(const f32x4 (&acc)[2][2][4][2], const Unit& u, int wr, int wc, int fr, int fq) const {
        asm volatile("" : "+v"(fr), "+v"(fq));
        const int row0 = u.pm * BM + wr * 64 + fr, col0 = u.pn * HALF + wc * 32 + 8 * fq;
#pragma unroll
        for (int ai = 0; ai < 2; ++ai)
#pragma unroll
            for (int m = 0; m < 4; ++m) { bf16_t* rowp = O + (size_t)(row0 + ai * HALF + m * 16) * ldc + col0;
                float o[8];
#pragma unroll
                for (int n = 0; n < 2; ++n)
#pragma unroll
                    for (int j = 0; j < 4; ++j) { const float a = acc[ai][0][m][n][j], b = acc[ai][1][m][n][j]; o[n * 4 + j] = (a * __builtin_amdgcn_rcpf(1.0f + __expf(-a))) * b; }
                u32x4 w; w.x = cvt_pk_bf16(o[0], o[1]); w.y = cvt_pk_bf16(o[2], o[3]); w.z = cvt_pk_bf16(o[4], o[5]); w.w = cvt_pk_bf16(o[6], o[7]);
                *(u32x4*)rowp = w; }
    }
};
struct EpiResid {
    static constexpr bool PERM = true, SPLIT = true;
    const float* src_f32; bf16_t* xb; const float* src_ctx; float* dst_ctx; const float* gate_lat; const float* gate_ctx;
    __device__ __forceinline__ void operator()(const f32x4 (&acc)[2][2][4][2], const Unit& u, int wr, int wc, int fr, int fq) const {
        asm volatile("" : "+v"(fr), "+v"(fq));
        const int prow = u.pm * BM; const bool lat = prow < NLAT;
        const float* gate = lat ? gate_lat + (size_t)(prow / SEQ) * 6144 : gate_ctx;
        const int r0 = wr * 64 + fr, col0 = u.pn * BM + wc * 32 + 8 * fq;
        f32x4 gv[2][2];
#pragma unroll
        for (int bj = 0; bj < 2; ++bj)
#pragma unroll
            for (int n = 0; n < 2; ++n) gv[bj][n] = *(const f32x4*)(gate + col0 + bj * HALF + 4 * n);
        if (lat) {
#pragma unroll
            for (int ai = 0; ai < 2; ++ai)
#pragma unroll
                for (int m = 0; m < 4; ++m) { const size_t off = (size_t)(prow + r0 + ai * HALF + m * 16) * D + col0;
#pragma unroll
                    for (int bj = 0; bj < 2; ++bj) { f32x4 s0, s1;
                        if (src_f32) { s0 = *(const f32x4*)(src_f32 + off + bj * HALF); s1 = *(const f32x4*)(src_f32 + off + bj * HALF + 4); }
                        else unpack8(*(const u32x4*)(xb + off + bj * HALF), s0, s1);
                        *(u32x4*)(xb + off + bj * HALF) = pack8(s0 + gv[bj][0] * acc[ai][bj][m][0], s1 + gv[bj][1] * acc[ai][bj][m][1]); }
                    if (m == 3) asm volatile("" ::: "memory"); }
        } else {
            const float* src = src_ctx + (size_t)(prow - NLAT) * D; float* dst = dst_ctx + (size_t)(prow - NLAT) * D;
#pragma unroll
            for (int ai = 0; ai < 2; ++ai)
#pragma unroll
                for (int m = 0; m < 4; ++m) { const size_t off = (size_t)(r0 + ai * HALF + m * 16) * D + col0;
#pragma unroll
                    for (int bj = 0; bj < 2; ++bj)
#pragma unroll
                        for (int n = 0; n < 2; ++n) { const f32x4 sv = *(const f32x4*)(src + off + bj * HALF + 4 * n); *(f32x4*)(dst + off + bj * HALF + 4 * n) = sv + gv[bj][n] * acc[ai][bj][m][n]; }
                    asm volatile("" ::: "memory"); }
        }
    }
};
struct EpiMoeDown {
    static constexpr bool PERM = true, SPLIT = true;
    bf16_t* xb; const int* ptok; const float* pw; const float* gate_lat;
    __device__ __forceinline__ void operator()(const f32x4 (&acc)[2][2][4][2], const Unit& u, int wr, int wc, int fr, int fq) const {
        asm volatile("" : "+v"(fr), "+v"(fq));
        const int r0 = u.pm * BM + wr * 64 + fr, col0 = u.pn * BM + wc * 32 + 8 * fq;
        int tk[8]; float wk[8];
#pragma unroll
        for (int i = 0; i < 8; ++i) { const int r = r0 + (i >> 2) * HALF + (i & 3) * 16; tk[i] = ptok[r]; wk[i] = pw[r]; }
#pragma unroll
        for (int ai = 0; ai < 2; ++ai)
#pragma unroll
            for (int m = 0; m < 4; ++m) { const int tok = tk[ai * 4 + m]; const float w = wk[ai * 4 + m];
                if (tok >= 0) { bf16_t* xr = xb + (size_t)tok * D + col0; const float* gate = gate_lat + (size_t)(tok / SEQ) * 6144 + col0;
#pragma unroll
                    for (int bj = 0; bj < 2; ++bj) { const f32x4 g0 = *(const f32x4*)(gate + bj * HALF), g1 = *(const f32x4*)(gate + bj * HALF + 4); f32x4 s0, s1; unpack8(*(const u32x4*)(xr + bj * HALF), s0, s1);
                        *(u32x4*)(xr + bj * HALF) = pack8(s0 + (g0 * w) * acc[ai][bj][m][0], s1 + (g1 * w) * acc[ai][bj][m][1]); } }
                if (m & 1) asm volatile("" ::: "memory"); }
    }
};

template <class Epi>
__device__ __forceinline__ void gemm_phase(ldsp_t lds, const Gemm g, const Order& S, const Epi& E, const int tid) {
    const int wid = __builtin_amdgcn_readfirstlane(tid >> 6), lane = tid & 63, wr = wid >> 2, wc = wid & 3, fr = lane & 15, fq = lane >> 4;
    const int K = g.K;
    unsigned voffB[2];
#pragma unroll
    for (int i = 0; i < 2; ++i) { int R, C; stage_rc(tid * 16 + i * 8192, R, C); const int Rb = Epi::PERM ? ((R & ~31) + perm32(R & 31)) : R;
        voffB[i] = (unsigned)(Rb * K + C) * 2u; }
    const size_t kstep = (size_t)(BK * 2);
    const size_t hstep = (size_t)HALF * K * 2;
    const size_t tstep = 2 * hstep;
    const unsigned ldsw = (unsigned)wid * 1024u;
    const int aoff = lds_byte(wr * 64 + fr, fq * 8), boff = lds_byte(wc * 32 + fr, fq * 8);
#define PG8_SA(b, h) (((b) * 2 + (h)) * HTB)
#define PG8_SB(b, h) ((4 + (b) * 2 + (h)) * HTB)
#define PG8_STAGE_B(bufoff, gbase) do { _Pragma("unroll") for (int _i = 0; _i < 2; ++_i) \
        __builtin_amdgcn_global_load_lds((const unsigned*)((const char*)(gbase) + voffB[_i]), (LAS unsigned*)(lds + (bufoff) + ldsw + _i * 8192), 16, 0, 0); } while (0)
#define PG8_STAGE_A(bufoff, gbase, o0, o1) do { \
        __builtin_amdgcn_global_load_lds((const unsigned*)((const char*)(gbase) + (o0)), (LAS unsigned*)(lds + (bufoff) + ldsw), 16, 0, 0); \
        __builtin_amdgcn_global_load_lds((const unsigned*)((const char*)(gbase) + (o1)), (LAS unsigned*)(lds + (bufoff) + ldsw + 8192), 16, 0, 0); } while (0)
#define PG8_LDA(dst, b, h) do { _Pragma("unroll") for (int m = 0; m < 4; ++m) _Pragma("unroll") for (int k = 0; k < 2; ++k) dst[m][k] = *(const LAS bf16x8*)(lds + PG8_SA(b, h) + aoff + m * 2048 + k * 1024); } while (0)
#define PG8_LDB(dst, b, h) do { _Pragma("unroll") for (int n = 0; n < 2; ++n) _Pragma("unroll") for (int k = 0; k < 2; ++k) dst[n][k] = *(const LAS bf16x8*)(lds + PG8_SB(b, h) + boff + n * 2048 + k * 1024); } while (0)
#define PG8_MMA(ai, bj, At, Bt) do { __builtin_amdgcn_s_setprio(1); _Pragma("unroll") for (int m = 0; m < 4; ++m) _Pragma("unroll") for (int n = 0; n < 2; ++n) _Pragma("unroll") for (int k = 0; k < 2; ++k) \
        acc[ai][bj][m][n] = __builtin_amdgcn_mfma_f32_16x16x32_bf16(Bt[n][k], At[m][k], acc[ai][bj][m][n], 0, 0, 0); __builtin_amdgcn_s_setprio(0); } while (0)
#define PG8_WAIT_V(n) asm volatile("s_waitcnt vmcnt(" #n ")" ::: "memory")
#define PG8_WAIT_L(n) asm volatile("s_waitcnt lgkmcnt(" #n ")" ::: "memory")
#define PG8_BAR __builtin_amdgcn_s_barrier()
#define PG8_SCHED __builtin_amdgcn_sched_barrier(0)
#define PG8_AOFFS(u, o00, o01, o10, o11) do { int R0_, C0_, R1_, C1_; stage_rc(tid * 16, R0_, C0_); stage_rc(tid * 16 + 8192, R1_, C1_); \
        o00 = (unsigned)(S.arow(u, R0_) * K + C0_ + (u).kt0 * BK) * 2u; o01 = (unsigned)(S.arow(u, R1_) * K + C1_ + (u).kt0 * BK) * 2u; \
        o10 = (unsigned)(S.arow(u, HALF + R0_) * K + C0_ + (u).kt0 * BK) * 2u; o11 = (unsigned)(S.arow(u, HALF + R1_) * K + C1_ + (u).kt0 * BK) * 2u; } while (0)
    Unit cur, nxt; int ui = 0;
    if (!S.next(0, cur)) return;
    f32x4 acc[2][2][4][2];
    { float z_; asm volatile("v_mov_b32 %0, 0" : "=v"(z_));
#pragma unroll
    for (int a = 0; a < 2; ++a)
#pragma unroll
        for (int b = 0; b < 2; ++b)
#pragma unroll
            for (int m = 0; m < 4; ++m)
#pragma unroll
                for (int n = 0; n < 2; ++n) acc[a][b][m][n] = (f32x4){z_, z_, z_, z_}; }
    bf16x8 At[4][2], B0[2][2], B1[2][2];
    const char* const Abase = (const char*)g.A;
    const char* cB = (const char*)g.Bt + (size_t)cur.e * g.estride + (size_t)cur.pn * tstep + (size_t)cur.kt0 * kstep;
    unsigned c00, c01, c10, c11;
    PG8_AOFFS(cur, c00, c01, c10, c11);
    PG8_STAGE_B(PG8_SB(0, 0), cB); PG8_STAGE_B(PG8_SB(0, 1), cB + hstep); PG8_STAGE_A(PG8_SA(0, 0), Abase, c00, c01); PG8_STAGE_A(PG8_SA(0, 1), Abase, c10, c11);
    if (wr == 1) PG8_BAR;
    PG8_WAIT_V(2); PG8_BAR;
    PG8_STAGE_B(PG8_SB(1, 0), cB + kstep); PG8_STAGE_A(PG8_SA(1, 0), Abase + kstep, c00, c01); PG8_STAGE_B(PG8_SB(1, 1), cB + hstep + kstep);
    PG8_WAIT_V(6); PG8_BAR;
    for (;;) {
        const bool has_next = S.next(ui + 1, nxt);
        const char* nB = has_next ? (const char*)g.Bt + (size_t)nxt.e * g.estride + (size_t)nxt.pn * tstep + (size_t)nxt.kt0 * kstep : cB;
        const int nt = cur.nt;
        int rn0 = 0, rn1 = 0, rn2 = 0, rn3 = 0;
        if (S.rowmap && has_next) { int R0_, C0_, R1_, C1_; stage_rc(tid * 16, R0_, C0_); stage_rc(tid * 16 + 8192, R1_, C1_);
            rn0 = S.arow(nxt, R0_); rn1 = S.arow(nxt, R1_); rn2 = S.arow(nxt, HALF + R0_); rn3 = S.arow(nxt, HALF + R1_); }
        for (int t = 0; t < nt; t += 2) {
            const bool last = (t == nt - 2);
            const char* a1 = Abase + (size_t)(t + 1) * kstep;
            const char* a2 = last ? Abase : Abase + (size_t)(t + 2) * kstep; const char* b2 = last ? nB : cB + (size_t)(t + 2) * kstep;
            const char* a3 = a2 + kstep; const char* b3 = b2 + kstep;
            PG8_LDB(B0, 0, 0); PG8_LDB(B1, 0, 1); PG8_SCHED; PG8_LDA(At, 0, 0); PG8_STAGE_A(PG8_SA(1, 1), a1, c10, c11);
            PG8_WAIT_V(8); PG8_WAIT_L(0); PG8_BAR; PG8_MMA(0, 0, At, B0); PG8_MMA(0, 1, At, B1); PG8_BAR; PG8_SCHED;
            if (last && has_next) {
                if (S.rowmap) { int R0_, C0_, R1_, C1_; stage_rc(tid * 16, R0_, C0_); stage_rc(tid * 16 + 8192, R1_, C1_);
                    c00 = (unsigned)(rn0 * K + C0_ + nxt.kt0 * BK) * 2u; c01 = (unsigned)(rn1 * K + C1_ + nxt.kt0 * BK) * 2u; c10 = (unsigned)(rn2 * K + C0_ + nxt.kt0 * BK) * 2u; c11 = (unsigned)(rn3 * K + C1_ + nxt.kt0 * BK) * 2u; }
                else { PG8_AOFFS(nxt, c00, c01, c10, c11); } }
            PG8_LDA(At, 0, 1); PG8_STAGE_B(PG8_SB(0, 0), b2); PG8_STAGE_B(PG8_SB(0, 1), b2 + hstep); PG8_STAGE_A(PG8_SA(0, 0), a2, c00, c01);
            PG8_WAIT_V(8); PG8_WAIT_L(0); PG8_BAR; PG8_MMA(1, 0, At, B0); PG8_MMA(1, 1, At, B1); PG8_BAR; PG8_SCHED;
            PG8_LDB(B0, 1, 0); PG8_LDB(B1, 1, 1); PG8_SCHED; PG8_LDA(At, 1, 0); PG8_STAGE_A(PG8_SA(0, 1), a2, c10, c11);
            PG8_WAIT_V(8); PG8_WAIT_L(0); PG8_BAR; PG8_MMA(0, 0, At, B0); PG8_MMA(0, 1, At, B1); PG8_BAR; PG8_SCHED;
            PG8_LDA(At, 1, 1); PG8_STAGE_B(PG8_SB(1, 0), b3); PG8_STAGE_B(PG8_SB(1, 1), b3 + hstep); PG8_STAGE_A(PG8_SA(1, 0), a3, c00, c01);
            PG8_WAIT_V(8); PG8_WAIT_L(0); PG8_BAR; PG8_MMA(1, 0, At, B0); PG8_MMA(1, 1, At, B1); PG8_BAR; PG8_SCHED;
        }
        if (wr == 0) PG8_BAR;
        if (Epi::SPLIT && cur.slab >= 0) {
            int fr_ = fr, fq_ = fq; asm volatile("" : "+v"(fr_), "+v"(fq_));
            float* sp = g.slabs + (size_t)cur.slab * 65536 + (size_t)(wr * 64 + fr_) * 256 + wc * 32 + (Epi::PERM ? 8 : 4) * fq_;
#pragma unroll
            for (int ai = 0; ai < 2; ++ai)
#pragma unroll
                for (int m = 0; m < 4; ++m)
#pragma unroll
                    for (int bj = 0; bj < 2; ++bj)
#pragma unroll
                        for (int n = 0; n < 2; ++n) *(f32x4*)(sp + (ai * HALF + m * 16) * 256 + bj * HALF + n * (Epi::PERM ? 4 : 16)) = acc[ai][bj][m][n];
        } else E(acc, cur, wr, wc, fr, fq);
        if (!has_next) break;
        { float z_; asm volatile("v_mov_b32 %0, 0" : "=v"(z_));
#pragma unroll
        for (int a = 0; a < 2; ++a)
#pragma unroll
            for (int b = 0; b < 2; ++b)
#pragma unroll
                for (int m = 0; m < 4; ++m)
#pragma unroll
                    for (int n = 0; n < 2; ++n) acc[a][b][m][n] = (f32x4){z_, z_, z_, z_}; }
        cur = nxt; cB = nB; ++ui;
        if (wr == 1) PG8_BAR;
    }
    PG8_WAIT_V(0);
    PG8_BAR;
#undef PG8_SA
#undef PG8_SB
#undef PG8_STAGE_A
#undef PG8_STAGE_B
#undef PG8_LDA
#undef PG8_LDB
#undef PG8_MMA
#undef PG8_WAIT_V
#undef PG8_WAIT_L
#undef PG8_BAR
#undef PG8_SCHED
#undef PG8_AOFFS
}
}

struct Args { const float* in[27]; float* out; unsigned char* ws; int ph_lo, ph_hi; };
struct Frame {
    ldsp_t lds; int tid, lane, wave, wave0, G, bid;
    const Args* pa; float* out; unsigned char* ws;
    const Args* pa0; float* out0; unsigned char* ws0;
};
enum { I_X = 0, I_C, I_CTX, I_CCTX, I_WMOD, I_BMOD, I_GMIX, I_GFFN, I_GFINAL, I_WIN, I_WOUT, I_CONVW, I_CONVB, I_RGWA, I_RGBA, I_RGWX, I_RGBX, I_RGLAM, I_RETDEC,
       I_FW1, I_FW3, I_FW2, I_MROUTER, I_MROUTERB, I_MW1, I_MW3, I_MW2 };

constexpr int TRS = 64 * 65 * 4;
struct TrItem { const float* W; bf16_t* WT; int ldw, k0, n0, ldt, drow0; float scale; };
__device__ __forceinline__ void tr_load(const TrItem& t, f32x4 (&v)[16], int lane) {
    const int r4 = lane >> 4, c4 = (lane & 15) * 4;
#pragma unroll
    for (int i = 0; i < 16; ++i) v[i] = *(const f32x4*)(t.W + (size_t)(t.k0 + 4 * i + r4) * t.ldw + t.n0 + c4);
}
__device__ __forceinline__ void tr_store(const TrItem& t, const f32x4 (&v)[16], LAS float* scr, int lane) {
    { const int r4 = lane >> 4, c4 = (lane & 15) * 4;
#pragma unroll
      for (int i = 0; i < 16; ++i) { LAS float* d = scr + (4 * i + r4) * 65 + c4; d[0] = v[i].x; d[1] = v[i].y; d[2] = v[i].z; d[3] = v[i].w; } }
    LDS_WAIT(); asm volatile("" ::: "memory");
    const int c = lane & 7; const float scale = t.scale;
#pragma unroll
    for (int j = 0; j < 8; ++j) { const int n = (lane >> 3) + 8 * j; const LAS float* sp = scr + (8 * c) * 65 + n;
        u32x4 o; o.x = pk2(sp[0 * 65] * scale, sp[1 * 65] * scale); o.y = pk2(sp[2 * 65] * scale, sp[3 * 65] * scale); o.z = pk2(sp[4 * 65] * scale, sp[5 * 65] * scale); o.w = pk2(sp[6 * 65] * scale, sp[7 * 65] * scale);
        *(u32x4*)(t.WT + (size_t)(t.drow0 + n) * t.ldt + t.k0 + 8 * c) = o; }
    LDS_WAIT(); asm volatile("" ::: "memory");
}
__device__ __forceinline__ TrItem up_item(const float* w1, const float* w3, int F, bf16_t* WT, int r) {
    const int per = 16 * (F / 64); const int which = r / per; r -= which * per;
    const int nblk = F / 64, kb = r / nblk, nb = r % nblk, n0 = nb * 64;
    return TrItem{which ? w3 : w1, WT, F, kb * 64, n0, D, (n0 / 128) * 256 + (n0 % 128) + which * 128, 1.0f};
}
__device__ __forceinline__ TrItem small_item(Frame& F, int r) {
    constexpr int I_IN = 16 * (INW / 64), I_OUT = 16 * (D / 64), I_UP = 2 * 16 * (DFF / 64);
    if (r < 2 * I_IN) { const int l = r / I_IN; r -= l * I_IN; const int nblk = INW / 64, kb = r / nblk, nb = r % nblk, n0 = nb * 64;
        const float sc = (n0 >= 1536 && n0 < 2048) ? 0.08838834764831845f : 1.0f;
        return TrItem{F.pa->in[I_WIN] + (size_t)l * D * INW, (bf16_t*)(F.ws + WS_WIN) + (size_t)l * INW * D, INW, kb * 64, n0, D, n0, sc}; }
    r -= 2 * I_IN;
    if (r < 2 * I_OUT) { const int l = r / I_OUT; r -= l * I_OUT; const int nblk = D / 64, kb = r / nblk, nb = r % nblk;
        return TrItem{F.pa->in[I_WOUT] + (size_t)l * D * D, (bf16_t*)(F.ws + WS_WOUT) + (size_t)l * D * D, D, kb * 64, nb * 64, D, nb * 64, 1.0f}; }
    r -= 2 * I_OUT;
    if (r < I_UP) return up_item(F.pa->in[I_FW1], F.pa->in[I_FW3], DFF, (bf16_t*)(F.ws + WS_WUP), r);
    r -= I_UP;
    { const int nblk = D / 64, kb = r / nblk, nb = r % nblk; return TrItem{F.pa->in[I_FW2], (bf16_t*)(F.ws + WS_WDN), D, kb * 64, nb * 64, DFF, nb * 64, 1.0f}; }
}
__device__ __forceinline__ TrItem moe_item(Frame& F, int it) {
    constexpr int I_UP = 2 * 16 * (DEXP / 64), I_DN = (DEXP / 64) * (D / 64), PER_E = I_UP + I_DN;
    const int e = it / PER_E; int r = it - e * PER_E;
    if (r < I_UP) return up_item(F.pa->in[I_MW1] + (size_t)e * D * DEXP, F.pa->in[I_MW3] + (size_t)e * D * DEXP, DEXP, (bf16_t*)(F.ws + WS_MOEUP) + (size_t)e * 2 * DEXP * D, r);
    r -= I_UP;
    { const int nblk = D / 64, kb = r / nblk, nb = r % nblk; return TrItem{F.pa->in[I_MW2] + (size_t)e * DEXP * D, (bf16_t*)(F.ws + WS_MOEDN) + (size_t)e * D * DEXP, D, kb * 64, nb * 64, DEXP, nb * 64, 1.0f}; }
}
__device__ __forceinline__ void phase_convert_small(Frame& F) {
    LAS float* scr = (LAS float*)(F.lds + F.wave * TRS);
    const int gw = F.bid * NWAVES + F.wave, NGW = F.G * NWAVES;
    constexpr int NITEMS = 2 * 16 * (INW / 64) + 2 * 16 * (D / 64) + 2 * 16 * (DFF / 64) + (DFF / 64) * (D / 64);
    if (gw < NITEMS) { TrItem cur = small_item(F, gw); f32x4 va[16], vb[16]; tr_load(cur, va, F.lane);
        for (int it = gw; it < NITEMS; it += 2 * NGW) {
            const bool h1 = it + NGW < NITEMS; TrItem n1 = cur; if (h1) { n1 = small_item(F, it + NGW); tr_load(n1, vb, F.lane); }
            tr_store(cur, va, scr, F.lane);
            if (!h1) break;
            const bool h2 = it + 2 * NGW < NITEMS; if (h2) { cur = small_item(F, it + 2 * NGW); tr_load(cur, va, F.lane); }
            tr_store(n1, vb, scr, F.lane);
            if (!h2) break; } }
    { const int gt = F.bid * NTHREADS + F.tid, NGT = F.G * NTHREADS; bf16_t* o = (bf16_t*)(F.ws + WS_RGW);
      for (int i = gt; i < 2 * 2 * 2 * 8 * 64 * 64; i += NGT) { const int c = i & 63, dp = (i >> 6) & 63, blk = (i >> 12) & 7, gate = (i >> 15) & 1, dir = (i >> 16) & 1, l = i >> 17;
          const float* src = gate ? F.pa->in[I_RGWX] : F.pa->in[I_RGWA]; o[i] = (bf16_t)f2bf(src[((((size_t)l * 2 + dir) * 8 + blk) * 64 + c) * 64 + dp]); } }
    { const int gt = F.bid * NTHREADS + F.tid, NGT = F.G * NTHREADS; float* ct = (float*)(F.ws + WS_ROPE); float* st = ct + 4096 * 64;
      for (int i = gt; i < 4096 * 64; i += NGT) { const int pos = i >> 6, fi = i & 63; const float p = (float)((fi < 32) ? (pos >> 6) : (pos & 63));
          const float inv = powf(10000.0f, -(float)(fi & 31) / 32.0f); const float ang = p * inv;
          const double a = (double)ang; const double kq = __builtin_rint(a * 0.63661977236758134308); const double rr = a - kq * 1.57079632679489661923; const int q = ((int)kq) & 3;
          const double r2 = rr * rr;
          const double sn = rr * (1.0 + r2 * (-1.0 / 6 + r2 * (1.0 / 120 + r2 * (-1.0 / 5040 + r2 * (1.0 / 362880 + r2 * (-1.0 / 39916800))))));
          const double cs = 1.0 + r2 * (-0.5 + r2 * (1.0 / 24 + r2 * (-1.0 / 720 + r2 * (1.0 / 40320 + r2 * (-1.0 / 3628800 + r2 * (1.0 / 479001600))))));
          const double c_ = (q == 0) ? cs : (q == 1) ? -sn : (q == 2) ? -cs : sn; const double s_ = (q == 0) ? sn : (q == 1) ? cs : (q == 2) ? -sn : -cs;
          ct[i] = (float)c_; st[i] = (float)s_; } }
}
struct MoeTile { const float* W; bf16_t* WT; int ldw, k0, n0, ldt, up; };
__device__ __forceinline__ MoeTile moe_tile(Frame& F, int t) {
    constexpr int T_UP1 = (D / 128) * (DEXP / 256), T_DN = (DEXP / 128) * (D / 256), PER_E = 2 * T_UP1 + T_DN;
    const int e = t / PER_E; int r = t - e * PER_E;
    if (r < 2 * T_UP1) { const int which = r / T_UP1; r -= which * T_UP1; const int nb = DEXP / 256, kb = r / nb, nn = r % nb;
        return MoeTile{(which ? F.pa->in[I_MW3] : F.pa->in[I_MW1]) + (size_t)e * D * DEXP, (bf16_t*)(F.ws + WS_MOEUP) + (size_t)e * 2 * DEXP * D, DEXP, kb * 128, nn * 256, D, 1 + which}; }
    r -= 2 * T_UP1;
    { const int nb = D / 256, kb = r / nb, nn = r % nb; return MoeTile{F.pa->in[I_MW2] + (size_t)e * DEXP * D, (bf16_t*)(F.ws + WS_MOEDN) + (size_t)e * D * DEXP, D, kb * 128, nn * 256, DEXP, 0}; }
}
__device__ __forceinline__ void moe_tile_load(const MoeTile& t, f32x4 (&v)[16], int wave, int lane) {
#pragma unroll
    for (int i = 0; i < 16; ++i) v[i] = *(const f32x4*)(t.W + (size_t)(t.k0 + 16 * wave + i) * t.ldw + t.n0 + 4 * lane);
}
__device__ __forceinline__ void moe_tile_store(Frame& F, const MoeTile& t, const f32x4 (&v)[16]) {
    LAS float* tile = (LAS float*)F.lds;
#pragma unroll
    for (int i = 0; i < 16; ++i) { const int k = 16 * F.wave + i, p = (4 * F.lane + 2 * (k >> 3)) & 255;
        *(LAS f32x2*)(tile + k * 256 + p) = (f32x2){v[i].x, v[i].y}; *(LAS f32x2*)(tile + k * 256 + ((p + 2) & 255)) = (f32x2){v[i].z, v[i].w}; }
    __syncthreads();
#pragma unroll
    for (int j = 0; j < 8; ++j) { const int task = F.tid + j * NTHREADS, c = task & 15, n = task >> 4; const LAS float* sp = tile + (8 * c) * 256 + ((n + 2 * c) & 255);
        u32x4 o; o.x = pk2(sp[0], sp[256]); o.y = pk2(sp[512], sp[768]); o.z = pk2(sp[1024], sp[1280]); o.w = pk2(sp[1536], sp[1792]);
        const int col = t.n0 + n; const int drow = t.up ? (col >> 7) * 256 + (col & 127) + 128 * (t.up - 1) : col;
        *(u32x4*)(t.WT + (size_t)drow * t.ldt + t.k0 + 8 * c) = o; }
    __syncthreads();
}
__device__ __forceinline__ void phase_convert_moe(Frame& F) {
    constexpr int NT = NE * (2 * (D / 128) * (DEXP / 256) + (DEXP / 128) * (D / 256));
    if (F.bid < NT) { MoeTile cur = moe_tile(F, F.bid); f32x4 va[16], vb[16]; moe_tile_load(cur, va, F.wave, F.lane);
        for (int t = F.bid; t < NT; t += 2 * F.G) {
            const bool h1 = t + F.G < NT; MoeTile n1 = cur; if (h1) { n1 = moe_tile(F, t + F.G); moe_tile_load(n1, vb, F.wave, F.lane); }
            moe_tile_store(F, cur, va);
            if (!h1) break;
            const bool h2 = t + 2 * F.G < NT; if (h2) { cur = moe_tile(F, t + 2 * F.G); moe_tile_load(cur, va, F.wave, F.lane); }
            moe_tile_store(F, n1, vb);
            if (!h2) break; } }
}
__device__ __forceinline__ void phase_mod(Frame& F) {
    LAS float* sc = (LAS float*)F.lds;
    LAS float* red = (LAS float*)(F.lds + 9 * 1024 * 4);
    for (int i = F.tid; i < 9 * 1024; i += NTHREADS) { const int r = i >> 10, k = i & 1023; const float v = (r < 8) ? F.pa->in[I_C][r * 1024 + k] : F.pa->in[I_CCTX][k]; sc[i] = v / (1.0f + __expf(-v)); }
    __syncthreads();
    for (int strip = F.bid; strip < 2 * 6144 / 64; strip += F.G) {
        const int l = strip / 96, j = (strip % 96) * 64 + F.lane;
        const float* w = F.pa->in[I_WMOD] + (size_t)l * 1024 * 6144 + j;
        float a[9];
#pragma unroll
        for (int r = 0; r < 9; ++r) a[r] = 0.f;
        const int k0 = F.wave * 128;
#pragma unroll 1
        for (int kk = k0; kk < k0 + 128; kk += 16) { float wv[16];
#pragma unroll
            for (int i = 0; i < 16; ++i) wv[i] = w[(size_t)(kk + i) * 6144];
#pragma unroll
            for (int i = 0; i < 16; ++i) {
#pragma unroll
                for (int r = 0; r < 9; ++r) a[r] += sc[r * 1024 + kk + i] * wv[i];
                if ((i & 3) == 3) __builtin_amdgcn_sched_barrier(0); } }
#pragma unroll
        for (int r = 0; r < 9; ++r) red[(F.wave * 9 + r) * 64 + F.lane] = a[r];
        __syncthreads();
        for (int i = F.tid; i < 9 * 64; i += NTHREADS) { const int r = i >> 6, jj = i & 63; float s = 0.f;
#pragma unroll
            for (int w8 = 0; w8 < 8; ++w8) s += red[(w8 * 9 + r) * 64 + jj];
            const int col = (strip % 96) * 64 + jj; s += F.pa->in[I_BMOD][l * 6144 + col];
            if (r < 8) ((float*)(F.ws + WS_MODLAT))[((size_t)l * 8 + r) * 6144 + col] = s; else ((float*)(F.ws + WS_MODCTX))[(size_t)l * 6144 + col] = s; }
        __syncthreads();
    }
}

__device__ __forceinline__ void norm_row(const u32x2 (&xw)[4], const f32x4 (&Am)[4], const f32x4 (&Sh)[4], bf16_t* orow, int lane, f32x4 (&y)[4]) {
    f32x4 v[4]; float ss = 0.f;
#pragma unroll
    for (int j = 0; j < 4; ++j) { const u32x2 w = xw[j]; v[j] = (f32x4){bf2f(w.x & 0xffffu), __uint_as_float(w.x & 0xffff0000u), bf2f(w.y & 0xffffu), __uint_as_float(w.y & 0xffff0000u)};
        ss += (v[j].x * v[j].x + v[j].y * v[j].y) + (v[j].z * v[j].z + v[j].w * v[j].w); }
    const float rstd = 1.0f / sqrtf(wave_sum(ss) * (1.0f / D) + EPS);
    u32x2* o8 = (u32x2*)orow + lane;
#pragma unroll
    for (int j = 0; j < 4; ++j) { y[j] = (v[j] * rstd) * Am[j] + Sh[j]; o8[64 * j] = (u32x2){pk2(y[j].x, y[j].y), pk2(y[j].z, y[j].w)}; }
}
struct SlabRed { const float* slab; int S; const float* gate; const float* xold; float* xnew; };
__device__ __forceinline__ void norm_row_v(f32x4 (&v)[4], const float* g, const float* shift, const float* scale, bf16_t* orow, int lane) {
    float ss = 0.f;
#pragma unroll
    for (int j = 0; j < 4; ++j) ss += (v[j].x * v[j].x + v[j].y * v[j].y) + (v[j].z * v[j].z + v[j].w * v[j].w);
    const float rstd = 1.0f / sqrtf(wave_sum(ss) * (1.0f / D) + EPS);
    u32x2* o8 = (u32x2*)orow + lane;
#pragma unroll
    for (int j = 0; j < 4; ++j) { const f32x4 gg = ((const f32x4*)g)[lane + 64 * j], sh = ((const f32x4*)shift)[lane + 64 * j], sl = ((const f32x4*)scale)[lane + 64 * j];
        const f32x4 y = (v[j] * rstd) * gg * (sl + 1.0f) + sh;
        u32x2 w; w.x = pk2(y.x, y.y); w.y = pk2(y.z, y.w); o8[64 * j] = w; }
}
__device__ __forceinline__ void phase_norm(Frame& F, int l, int sel, const float* xlat, const bf16_t* xb, const float* xctx, int nrows, const SlabRed sr) {
    const int gw = F.bid * NWAVES + F.wave, NGW = F.G * NWAVES;
    const float* g = (sel ? F.pa->in[I_GFFN] : F.pa->in[I_GMIX]) + l * D; const int so = sel ? 3072 : 0;
    bf16_t* HX = (bf16_t*)(F.ws + WS_HX);
    const int nlat = nrows < NLAT ? nrows : NLAT; const int per = (nlat + NGW - 1) / NGW, r_lo = gw * per, r_hi = (r_lo + per < nlat) ? r_lo + per : nlat;
    int curb = -1; f32x4 Am[4], Sh[4];
    for (int row0 = r_lo; row0 < r_hi; row0 += 4) {
        f32x4 v[4][4];
#pragma unroll
        for (int u = 0; u < 4; ++u) { const int row = (row0 + u < r_hi) ? row0 + u : row0;
            if (xb) { const u32x2* xr = (const u32x2*)(xb + (size_t)row * D) + F.lane;
#pragma unroll
                for (int j = 0; j < 4; ++j) { const u32x2 w = xr[64 * j]; v[u][j] = (f32x4){bf2f(w.x & 0xffffu), __uint_as_float(w.x & 0xffff0000u), bf2f(w.y & 0xffffu), __uint_as_float(w.y & 0xffff0000u)}; } }
            else { const f32x4* xr = (const f32x4*)(xlat + (size_t)row * D) + F.lane;
#pragma unroll
                for (int j = 0; j < 4; ++j) v[u][j] = xr[64 * j]; } }
#pragma unroll
        for (int u = 0; u < 4; ++u) { const int row = row0 + u; if (row >= r_hi) continue;
            const int b = row / SEQ;
            if (b != curb) { curb = b; const float* mod = (const float*)(F.ws + WS_MODLAT) + ((size_t)l * 8 + b) * 6144 + so;
#pragma unroll
                for (int j = 0; j < 4; ++j) { Am[j] = ((const f32x4*)g)[F.lane + 64 * j] * (((const f32x4*)(mod + 1024))[F.lane + 64 * j] + 1.0f); Sh[j] = ((const f32x4*)mod)[F.lane + 64 * j]; } }
            float ss = 0.f;
#pragma unroll
            for (int j = 0; j < 4; ++j) ss += (v[u][j].x * v[u][j].x + v[u][j].y * v[u][j].y) + (v[u][j].z * v[u][j].z + v[u][j].w * v[u][j].w);
            const float rstd = 1.0f / sqrtf(wave_sum(ss) * (1.0f / D) + EPS);
            u32x2* o8 = (u32x2*)(HX + (size_t)row * D) + F.lane;
#pragma unroll
            for (int j = 0; j < 4; ++j) { const f32x4 y = (v[u][j] * rstd) * Am[j] + Sh[j]; o8[64 * j] = (u32x2){pk2(y.x, y.y), pk2(y.z, y.w)}; } }
    }
    for (int row = NLAT + gw; row < nrows; row += NGW) {
        const float* mod = (const float*)(F.ws + WS_MODCTX) + (size_t)l * 6144;
        f32x4 v[4];
        if (sr.slab == nullptr) { const f32x4* xr = (const f32x4*)(xctx + (size_t)(row - NLAT) * D) + F.lane;
#pragma unroll
            for (int j = 0; j < 4; ++j) v[j] = xr[64 * j]; }
        else { const int rc = row - NLAT, pmr = rc >> 8, r = rc & 255;
#pragma unroll
            for (int j = 0; j < 4; ++j) { f32x4 a = zero4(); const float* sp = sr.slab + (size_t)((pmr + 8 * j) * sr.S) * 65536 + (size_t)r * 256 + 4 * F.lane;
                f32x4 t8[8];
#pragma unroll
                for (int q = 0; q < 8; ++q) t8[q] = *(const f32x4*)(sp + (size_t)(q < sr.S ? q : sr.S - 1) * 65536);
#pragma unroll
                for (int q = 0; q < 8; ++q) a += t8[q] * (q < sr.S ? 1.0f : 0.0f);
                v[j] = ((const f32x4*)(sr.xold + (size_t)rc * D))[F.lane + 64 * j] + ((const f32x4*)sr.gate)[F.lane + 64 * j] * a;
                ((f32x4*)(sr.xnew + (size_t)rc * D))[F.lane + 64 * j] = v[j]; } }
        norm_row_v(v, g, mod + so, mod + so + 1024, HX + (size_t)row * D, F.lane);
    }
}
__device__ __forceinline__ void moe_reduce(Frame& F, int k) {
    const int* meta = (const int*)(F.ws + MOE_META) + 9 * k; const int npan = meta[8], gsz = npan - 128;
    if (gsz <= 0) return;
    const int S = pg8::split_factor(npan * 4, F.G, DEXP / 64, MAXSLAB_M); if (S < 2) return;
    const int gw = F.bid * NWAVES + F.wave, NGW = F.G * NWAVES;
    const int* ptok = (const int*)(F.ws + MOE_PTOK) + k * MROWS; const float* pw = (const float*)(F.ws + MOE_PW) + k * MROWS;
    const float* slab = (const float*)(F.ws + WS_SLABM); const float* gate_lat = (const float*)(F.ws + WS_MODLAT) + (size_t)8 * 6144 + 5120;
    for (int rr = NLAT + gw; rr < npan * 256; rr += NGW) { const int tok = ptok[rr]; if (tok < 0) continue; const float w = pw[rr];
        const int pmr = (rr - NLAT) >> 8, r = rr & 255; u32x2* xr = (u32x2*)((bf16_t*)((char*)F.out + XB_OFF) + (size_t)tok * D); const f32x4* gt = (const f32x4*)(gate_lat + (size_t)(tok / SEQ) * 6144);
#pragma unroll
        for (int j = 0; j < 4; ++j) { f32x4 a = zero4(); const float* sp = slab + (size_t)((pmr + gsz * j) * S) * 65536 + (size_t)r * 256 + 4 * F.lane;
            { f32x4 t8[8];
#pragma unroll
              for (int q = 0; q < 8; ++q) t8[q] = *(const f32x4*)(sp + (size_t)(q < S ? q : S - 1) * 65536);
#pragma unroll
              for (int q = 0; q < 8; ++q) a += t8[q] * (q < S ? 1.0f : 0.0f); }
            const u32x2 xo = xr[F.lane + 64 * j]; const f32x4 xv = {bf2f(xo.x & 0xffffu), __uint_as_float(xo.x & 0xffff0000u), bf2f(xo.y & 0xffffu), __uint_as_float(xo.y & 0xffff0000u)};
            const f32x4 y = xv + (gt[F.lane + 64 * j] * w) * a; xr[F.lane + 64 * j] = (u32x2){pk2(y.x, y.y), pk2(y.z, y.w)}; } }
}
__device__ __forceinline__ void phase_norm_router(Frame& F, const bf16_t* xb) {
    constexpr int l = 1;
    LAS float* wr = (LAS float*)F.lds;
    LAS int* le = (LAS int*)(F.lds + 32768);
    for (int i = F.tid; i < 1024 * 8 / 4; i += NTHREADS) ((LAS f32x4*)wr)[i] = ((const f32x4*)F.pa->in[I_MROUTER])[i];
    __syncthreads();
    const float* g = F.pa->in[I_GFFN] + l * D; bf16_t* HX = (bf16_t*)(F.ws + WS_HX);
    int* toke = (int*)(F.ws + MOE_TOKE); float* tokw = (float*)(F.ws + MOE_TOKW);
    for (int wg = F.bid; wg < NLAT / 128; wg += F.G) {
        u32x2 nx[4]; f32x4 Am[4], Sh[4];
        { const float* mod = (const float*)(F.ws + WS_MODLAT) + ((size_t)l * 8 + (wg * 128) / SEQ) * 6144 + 3072;
#pragma unroll
          for (int j = 0; j < 4; ++j) { Am[j] = ((const f32x4*)g)[F.lane + 64 * j] * (((const f32x4*)(mod + 1024))[F.lane + 64 * j] + 1.0f); Sh[j] = ((const f32x4*)mod)[F.lane + 64 * j]; } }
        { const u32x2* xr = (const u32x2*)(xb + (size_t)(wg * 128 + F.wave * 16) * D) + F.lane;
#pragma unroll
          for (int j = 0; j < 4; ++j) nx[j] = xr[64 * j]; }
        for (int i = 0; i < 16; ++i) { const int tl = F.wave * 16 + i, row = wg * 128 + tl;
            u32x2 cx[4];
#pragma unroll
            for (int j = 0; j < 4; ++j) cx[j] = nx[j];
            { const int rn = (i < 15) ? row + 1 : row; const u32x2* xr = (const u32x2*)(xb + (size_t)rn * D) + F.lane;
#pragma unroll
              for (int j = 0; j < 4; ++j) nx[j] = xr[64 * j]; }
            f32x4 y[4]; norm_row(cx, Am, Sh, HX + (size_t)row * D, F.lane, y);
            float lg[8];
#pragma unroll
            for (int e = 0; e < 8; ++e) lg[e] = 0.f;
#pragma unroll
            for (int j = 0; j < 4; ++j)
#pragma unroll
                for (int q = 0; q < 4; ++q) { const int k = 4 * F.lane + 256 * j + q; const f32x4 w0 = *(const LAS f32x4*)(wr + k * 8), w1 = *(const LAS f32x4*)(wr + k * 8 + 4); const float yv = y[j][q];
                    lg[0] += yv * w0.x; lg[1] += yv * w0.y; lg[2] += yv * w0.z; lg[3] += yv * w0.w; lg[4] += yv * w1.x; lg[5] += yv * w1.y; lg[6] += yv * w1.z; lg[7] += yv * w1.w; }
#pragma unroll
            for (int e = 0; e < 8; ++e) lg[e] = wave_sum(lg[e]) + F.pa->in[I_MROUTERB][e];
            int e0 = 0; float v0 = lg[0];
#pragma unroll
            for (int e = 1; e < 8; ++e) if (lg[e] > v0) { v0 = lg[e]; e0 = e; }
            int e1 = -1; float v1 = -3.0e38f;
#pragma unroll
            for (int e = 0; e < 8; ++e) if (e != e0 && lg[e] > v1) { v1 = lg[e]; e1 = e; }
            const float w0 = 1.0f / (1.0f + __expf(v1 - v0));
            if (F.lane == 0) { toke[row] = e0 | (e1 << 8); tokw[2 * row] = w0; tokw[2 * row + 1] = 1.0f - w0; le[tl] = e0 | (e1 << 8); }
        }
        __syncthreads();
        if (F.tid < 16) { const int k = F.tid >> 3, e = F.tid & 7; int c = 0; for (int t = 0; t < 128; ++t) c += (((le[t] >> (8 * k)) & 0xff) == e) ? 1 : 0; ((int*)(F.ws + MOE_CNT))[wg * 16 + F.tid] = c; }
        __syncthreads();
    }
}
__device__ __forceinline__ void phase_moe_sort(Frame& F) {
    LAS int* tot = (LAS int*)F.lds;
    LAS int* pre = tot + 16;
    LAS int* seg = tot + 32;
    LAS int* le = tot + 64;
    const int* cnt = (const int*)(F.ws + MOE_CNT); const int* toke = (const int*)(F.ws + MOE_TOKE); const float* tokw = (const float*)(F.ws + MOE_TOKW);
    int* ptok = (int*)(F.ws + MOE_PTOK); float* pw = (float*)(F.ws + MOE_PW); int* meta = (int*)(F.ws + MOE_META);
    for (int wg = F.bid; wg < NLAT / 128; wg += F.G) {
        { LAS int* part = tot + 256;
          if (F.tid < 256) { const int col = F.tid & 15, pt = F.tid >> 4; int t = 0, p = 0;
#pragma unroll
              for (int i = 0; i < 16; ++i) { const int w = pt * 16 + i; const int c = cnt[w * 16 + col]; t += c; p += (w < wg) ? c : 0; }
              part[pt * 16 + col] = t; part[256 + pt * 16 + col] = p; }
          if (F.tid >= 256 && F.tid < 384) le[F.tid - 256] = toke[wg * 128 + F.tid - 256];
          __syncthreads();
          if (F.tid < 16) { int t = 0, p = 0;
#pragma unroll
              for (int pt = 0; pt < 16; ++pt) { t += part[pt * 16 + F.tid]; p += part[256 + pt * 16 + F.tid]; }
              tot[F.tid] = t; pre[F.tid] = p; } }
        __syncthreads();
        if (F.tid < 2) { int s = 0; for (int e = 0; e < 8; ++e) { seg[F.tid * 9 + e] = s; s += (tot[F.tid * 8 + e] + 255) & ~255; } seg[F.tid * 9 + 8] = s; }
        __syncthreads();
        if (F.tid < 256) { const int k = F.tid >> 7, t = F.tid & 127; const int e = (le[t] >> (8 * k)) & 0xff; int rank = 0; for (int u = 0; u < t; ++u) rank += (((le[u] >> (8 * k)) & 0xff) == e) ? 1 : 0;
            const int pos = seg[k * 9 + e] + pre[k * 8 + e] + rank; const int tok = wg * 128 + t; ptok[k * MROWS + pos] = tok; pw[k * MROWS + pos] = tokw[2 * tok + k]; ((int*)(F.ws + MOE_PPOS))[k * NLAT + tok] = pos; }
        if (wg < 16) { const int k = wg >> 3, e = wg & 7; const int a = seg[k * 9 + e] + tot[k * 8 + e], b = seg[k * 9 + e + 1]; for (int p = a + F.tid; p < b; p += NTHREADS) { ptok[k * MROWS + p] = -1; pw[k * MROWS + p] = 0.f; } }
        if (wg == 0 && F.tid < 18) meta[F.tid] = seg[F.tid] >> 8;
        __syncthreads();
    }
}
__device__ __forceinline__ void phase_final_a(Frame& F) {
    const int gw = F.bid * NWAVES + F.wave, NGW = F.G * NWAVES; const float* g = F.pa->in[I_GFINAL];
    const bf16_t* xb = (const bf16_t*)((const char*)F.out + XB_OFF); bf16_t* xc = (bf16_t*)(F.ws + WS_XCOPY);
    const int* meta = (const int*)(F.ws + MOE_META) + 9; const int npan = meta[8], gsz = npan - 128;
    const int S = (gsz > 0) ? pg8::split_factor(npan * 4, F.G, DEXP / 64, MAXSLAB_M) : 1;
    const int* ppos = (const int*)(F.ws + MOE_PPOS) + NLAT; const float* pw = (const float*)(F.ws + MOE_PW) + MROWS;
    const float* slab = (const float*)(F.ws + WS_SLABM); const float* gate_lat = (const float*)(F.ws + WS_MODLAT) + (size_t)8 * 6144 + 5120;
    for (int row0 = gw; row0 < NLAT; row0 += 4 * NGW) {
        u32x2 w[4][4]; int rr[4];
#pragma unroll
        for (int u = 0; u < 4; ++u) { const int row = (row0 + u * NGW < NLAT) ? row0 + u * NGW : row0; const u32x2* xr = (const u32x2*)(xb + (size_t)row * D) + F.lane; rr[u] = ppos[row];
#pragma unroll
            for (int j = 0; j < 4; ++j) w[u][j] = xr[64 * j]; }
#pragma unroll
        for (int u = 0; u < 4; ++u) { const int row = row0 + u * NGW; if (row >= NLAT) continue;
            f32x4 v[4];
#pragma unroll
            for (int j = 0; j < 4; ++j) v[j] = (f32x4){bf2f(w[u][j].x & 0xffffu), __uint_as_float(w[u][j].x & 0xffff0000u), bf2f(w[u][j].y & 0xffffu), __uint_as_float(w[u][j].y & 0xffff0000u)};
            if (S >= 2 && rr[u] >= NLAT) { const float wt = pw[rr[u]]; const int pmr = (rr[u] - NLAT) >> 8, r = rr[u] & 255; const f32x4* gt = (const f32x4*)(gate_lat + (size_t)(row / SEQ) * 6144);
#pragma unroll
                for (int j = 0; j < 4; ++j) { f32x4 a = zero4(); const float* sp = slab + (size_t)((pmr + gsz * j) * S) * 65536 + (size_t)r * 256 + 4 * F.lane;
                    { f32x4 t8[8];
#pragma unroll
                      for (int q = 0; q < 8; ++q) t8[q] = *(const f32x4*)(sp + (size_t)(q < S ? q : S - 1) * 65536);
#pragma unroll
                      for (int q = 0; q < 8; ++q) a += t8[q] * (q < S ? 1.0f : 0.0f); }
                    v[j] += (gt[F.lane + 64 * j] * wt) * a; } }
            if (row < NLAT / 2) { float ss = 0.f;
#pragma unroll
                for (int j = 0; j < 4; ++j) ss += (v[j].x * v[j].x + v[j].y * v[j].y) + (v[j].z * v[j].z + v[j].w * v[j].w);
                const float rstd = 1.0f / sqrtf(wave_sum(ss) * (1.0f / D) + EPS); f32x4* o = (f32x4*)(F.out + (size_t)row * D) + F.lane;
#pragma unroll
                for (int j = 0; j < 4; ++j) o[64 * j] = (v[j] * rstd) * ((const f32x4*)g)[F.lane + 64 * j]; }
            else { u32x2* o = (u32x2*)(xc + (size_t)(row - NLAT / 2) * D) + F.lane;
#pragma unroll
                for (int j = 0; j < 4; ++j) o[64 * j] = (u32x2){pk2(v[j].x, v[j].y), pk2(v[j].z, v[j].w)}; } }
    }
}
__device__ __forceinline__ void phase_final_b(Frame& F) {
    const int gw = F.bid * NWAVES + F.wave, NGW = F.G * NWAVES; const float* g = F.pa->in[I_GFINAL]; const bf16_t* xc = (const bf16_t*)(F.ws + WS_XCOPY);
    for (int row0 = NLAT / 2 + gw; row0 < NLAT; row0 += 4 * NGW) {
        u32x2 w[4][4];
#pragma unroll
        for (int u = 0; u < 4; ++u) { const int row = (row0 + u * NGW < NLAT) ? row0 + u * NGW : row0; const u32x2* xr = (const u32x2*)(xc + (size_t)(row - NLAT / 2) * D) + F.lane;
#pragma unroll
            for (int j = 0; j < 4; ++j) w[u][j] = xr[64 * j]; }
#pragma unroll
        for (int u = 0; u < 4; ++u) { const int row = row0 + u * NGW; if (row >= NLAT) continue;
            f32x4 v[4]; float ss = 0.f;
#pragma unroll
            for (int j = 0; j < 4; ++j) { v[j] = (f32x4){bf2f(w[u][j].x & 0xffffu), __uint_as_float(w[u][j].x & 0xffff0000u), bf2f(w[u][j].y & 0xffffu), __uint_as_float(w[u][j].y & 0xffff0000u)};
                ss += (v[j].x * v[j].x + v[j].y * v[j].y) + (v[j].z * v[j].z + v[j].w * v[j].w); }
            const float rstd = 1.0f / sqrtf(wave_sum(ss) * (1.0f / D) + EPS); f32x4* o = (f32x4*)(F.out + (size_t)row * D) + F.lane;
#pragma unroll
            for (int j = 0; j < 4; ++j) o[64 * j] = (v[j] * rstd) * ((const f32x4*)g)[F.lane + 64 * j]; }
    }
}

__device__ __forceinline__ bool fresh(Frame& F) {
    int l_ = (int)__builtin_amdgcn_mbcnt_hi(~0u, __builtin_amdgcn_mbcnt_lo(~0u, 0u)); asm volatile("" : "+v"(l_));
    int w_ = F.wave0; asm volatile("" : "+s"(w_));
    F.lane = l_; F.wave = w_; F.tid = w_ * 64 + l_;
    int b_ = blockIdx.x; asm volatile("" : "+s"(b_)); F.bid = b_;
    GAS unsigned char* w2_ = (GAS unsigned char*)F.ws0; asm volatile("" : "+s"(w2_)); F.ws = (unsigned char*)w2_;
    F.out = F.out0; F.pa = F.pa0;
    return true;
}
struct Item { int b, s, row0, seqbase, t0, seqlen; bool is_ctx; };
__device__ __forceinline__ Item item_info(int item) {
    Item it; it.b = item / SPB; it.s = item % SPB;
    if (it.s < 2) { it.is_ctx = true; it.seqbase = NLAT + it.b * CTXL; it.t0 = it.s * CHK; it.seqlen = CTXL; }
    else { it.is_ctx = false; it.seqbase = it.b * SEQ; it.t0 = (it.s - 2) * CHK; it.seqlen = SEQ; }
    it.row0 = it.seqbase + it.t0; return it;
}
constexpr int UCP = 144;
constexpr int TP = 272;
constexpr int TILEB = 128 * TP;
constexpr int VP = 288;
constexpr int TILEV = 128 * VP;

__device__ __forceinline__ unsigned tr_lane_addr(ldsp_t tile, int lane) { return (unsigned)(__SIZE_TYPE__)tile + (unsigned)((4 * (lane >> 4) + ((lane & 15) >> 2)) * VP + 8 * (lane & 3)); }
__device__ __forceinline__ bf16x8 mk_frag(u32x2 lo, u32x2 hi) { const u32x4 v = {lo.x, lo.y, hi.x, hi.y}; return __builtin_bit_cast(bf16x8, v); }
template <int OFF> __device__ __forceinline__ bf16x8 tr1(unsigned addr) {
    u32x2 a0, a1;
    asm volatile("ds_read_b64_tr_b16 %0, %2 offset:%3\n\tds_read_b64_tr_b16 %1, %2 offset:%4\n\ts_waitcnt lgkmcnt(0)" : "=&v"(a0), "=&v"(a1) : "v"(addr), "i"(OFF), "i"(OFF + 16 * VP) : "memory");
    return mk_frag(a0, a1);
}
template <int OFF> __device__ __forceinline__ void tr4(unsigned addr, bf16x8& f0, bf16x8& f1, bf16x8& f2, bf16x8& f3) {
    u32x2 a0, a1, b0, b1, c0, c1, d0, d1;
    asm volatile("ds_read_b64_tr_b16 %0, %8 offset:%9\n\tds_read_b64_tr_b16 %1, %8 offset:%10\n\tds_read_b64_tr_b16 %2, %8 offset:%11\n\tds_read_b64_tr_b16 %3, %8 offset:%12\n\t"
                 "ds_read_b64_tr_b16 %4, %8 offset:%13\n\tds_read_b64_tr_b16 %5, %8 offset:%14\n\tds_read_b64_tr_b16 %6, %8 offset:%15\n\tds_read_b64_tr_b16 %7, %8 offset:%16\n\ts_waitcnt lgkmcnt(0)"
                 : "=&v"(a0), "=&v"(a1), "=&v"(b0), "=&v"(b1), "=&v"(c0), "=&v"(c1), "=&v"(d0), "=&v"(d1)
                 : "v"(addr), "i"(OFF), "i"(OFF + 16 * VP), "i"(OFF + 32), "i"(OFF + 32 + 16 * VP), "i"(OFF + 64), "i"(OFF + 64 + 16 * VP), "i"(OFF + 96), "i"(OFF + 96 + 16 * VP) : "memory");
    f0 = mk_frag(a0, a1); f1 = mk_frag(b0, b1); f2 = mk_frag(c0, c1); f3 = mk_frag(d0, d1);
}

__device__ __forceinline__ void build_decay(Frame& F, int l) {
    LAS float* dec = (LAS float*)(F.lds + LDS_DEC);
    for (int i = F.tid; i < 2 * 4 * 132; i += NTHREADS) { const int n = i % 132, dh = i / 132; const float x = F.pa->in[I_RETDEC][l * 8 + dh]; const float lg = -log1pf(expf(-x)); dec[i] = expf((float)n * lg); }
}

struct RgStep { bf16x8 bwa[2], bwx[2]; float lam, ba, bx, carry; };
template <bool FINAL>
__device__ __forceinline__ void rg_load_step(RgStep& R, Frame& F, const bf16_t* wgt, int l, int dir, int item, int blk, int n, int lane) {
    const int fr = lane & 15, fq = lane >> 4;
    const bf16_t* wa = wgt + ((size_t)(0 * 8 + blk) * 64 + 16 * n + fr) * 64 + 8 * fq;
    const bf16_t* wx = wgt + ((size_t)(1 * 8 + blk) * 64 + 16 * n + fr) * 64 + 8 * fq;
    R.bwa[0] = *(const bf16x8*)wa; R.bwa[1] = *(const bf16x8*)(wa + 32); R.bwx[0] = *(const bf16x8*)wx; R.bwx[1] = *(const bf16x8*)(wx + 32);
    const int ch = blk * 64 + 16 * n + fr, pi = (l * 2 + dir) * 512 + ch;
    R.lam = F.pa->in[I_RGLAM][pi]; R.ba = F.pa->in[I_RGBA][pi]; R.bx = F.pa->in[I_RGBX][pi];
    R.carry = FINAL ? ((const float*)(F.ws + WS_CARRY))[((size_t)item * 2 + dir) * 512 + ch] : 0.f;
}
template <bool FINAL, int DIR>
__device__ __forceinline__ void rg_dir(ldsp_t ucw, const bf16x8 (&af)[8][2], const RgStep& R, int n, int lane, f32x4 (&hsum)[8], float& Atot, float& Htot) {
    const int fr = lane & 15, fq = lane >> 4;
    constexpr float L2E_ = 1.4426950408889634f;
    const float ba2 = -L2E_ * R.ba, bx2 = -L2E_ * R.bx, cl2 = -8.0f * L2E_ * log1pf(expf(-R.lam)), carry = R.carry;
    const bf16x8 bwa[2] = {R.bwa[0], R.bwa[1]}, bwx[2] = {R.bwx[0], R.bwx[1]};
    f32x4 ar[8], ai[8];
#pragma unroll
    for (int m = 0; m < 8; ++m) { ar[m] = zero4(); ai[m] = zero4(); }
#pragma unroll
    for (int m = 0; m < 8; ++m)
#pragma unroll
        for (int ks = 0; ks < 2; ++ks) { ar[m] = __builtin_amdgcn_mfma_f32_16x16x32_bf16(af[m][ks], bwa[ks], ar[m], 0, 0, 0); ai[m] = __builtin_amdgcn_mfma_f32_16x16x32_bf16(af[m][ks], bwx[ks], ai[m], 0, 0, 0); }
    const unsigned uo = (unsigned)(32 * fq * UCP + (16 * n + fr) * 2);
#pragma unroll
    for (int m = 0; m < 8; ++m)
#pragma unroll
        for (int jj = 0; jj < 4; ++jj) {
            const float r = __builtin_amdgcn_rcpf(1.0f + __builtin_amdgcn_exp2f(__builtin_fmaf(ar[m][jj], -1.4426950408889634f, ba2)));
            const float ig = __builtin_amdgcn_rcpf(1.0f + __builtin_amdgcn_exp2f(__builtin_fmaf(ai[m][jj], -1.4426950408889634f, bx2)));
            const float a = __builtin_amdgcn_exp2f(cl2 * r);
            const float u = bf2f(*(const LAS bf16_t*)(ucw + uo + (4 * m + jj) * UCP));
            ar[m][jj] = a; ai[m][jj] = __builtin_amdgcn_sqrtf(__builtin_fmaf(-a, a, 1.0f)) * ig * u; }
    float gA = 1.f, gH = 0.f;
#pragma unroll
    for (int mm = 0; mm < 8; ++mm) { const int m = DIR ? 7 - mm : mm;
#pragma unroll
        for (int j4 = 0; j4 < 4; ++j4) { const int jj = DIR ? 3 - j4 : j4; gH = __builtin_fmaf(ar[m][jj], gH, ai[m][jj]); gA *= ar[m][jj]; } }
    const float A0 = lane_bcast(gA, fr), H0 = lane_bcast(gH, fr), A1 = lane_bcast(gA, fr + 16), H1 = lane_bcast(gH, fr + 16), A2 = lane_bcast(gA, fr + 32), H2 = lane_bcast(gH, fr + 32), A3 = lane_bcast(gA, fr + 48), H3 = lane_bcast(gH, fr + 48);
    if (FINAL) { float h = carry;
        if (!DIR) { if (fq > 0) h = A0 * h + H0; if (fq > 1) h = A1 * h + H1; if (fq > 2) h = A2 * h + H2; }
        else { if (fq < 3) h = A3 * h + H3; if (fq < 2) h = A2 * h + H2; if (fq < 1) h = A1 * h + H1; }
#pragma unroll
        for (int mm = 0; mm < 8; ++mm) { const int m = DIR ? 7 - mm : mm;
#pragma unroll
            for (int j4 = 0; j4 < 4; ++j4) { const int jj = DIR ? 3 - j4 : j4; h = __builtin_fmaf(ar[m][jj], h, ai[m][jj]); hsum[m][jj] += h; } } }
    if (!DIR) Htot = A3 * (A2 * (A1 * H0 + H1) + H2) + H3; else Htot = A0 * (A1 * (A2 * H3 + H2) + H1) + H0;
    Atot = (A0 * A1) * (A2 * A3);
}
template <bool FINAL, bool SHARED = false>
__device__ __forceinline__ void rg_part(Frame& F, int l, int item, const Item& it, const int blk, const int n0, const int n1) {
    const bf16_t* P = (const bf16_t*)(F.ws + WS_PA);
    int lane = F.lane; const bool act = !SHARED || F.wave < 4;
    ldsp_t ucw = SHARED ? F.lds : F.lds + F.wave * (128 * UCP);
    if (act) { const int grp = lane & 7, ch0 = blk * 64 + grp * 8; float cw[4][8], cb[8];
#pragma unroll
      for (int k = 0; k < 4; ++k)
#pragma unroll
          for (int i = 0; i < 8; ++i) cw[k][i] = F.pa->in[I_CONVW][((size_t)l * 4 + k) * 512 + ch0 + i];
#pragma unroll
      for (int i = 0; i < 8; ++i) cb[i] = F.pa->in[I_CONVB][l * 512 + ch0 + i];
      const bf16_t* Pu = P + (size_t)it.seqbase * INW + ch0;
#pragma unroll 8
      for (int q = 0; q < (SHARED ? 4 : 16); ++q) { const int token = (SHARED ? 32 * F.wave : 0) + (lane >> 3) + 8 * q; float o[8];
#pragma unroll
          for (int i = 0; i < 8; ++i) o[i] = cb[i];
#pragma unroll
          for (int k = 0; k < 4; ++k) { const int tt = it.t0 + token + k - 2; const int tc = tt < 0 ? 0 : (tt >= it.seqlen ? it.seqlen - 1 : tt);
              u32x4 v = ldg<u32x4>(Pu, (unsigned)tc * (unsigned)(INW * 2)); if (tt != tc) v = (u32x4){0u, 0u, 0u, 0u};
              o[0] += cw[k][0] * bf2f(v.x & 0xffffu); o[1] += cw[k][1] * __uint_as_float(v.x & 0xffff0000u); o[2] += cw[k][2] * bf2f(v.y & 0xffffu); o[3] += cw[k][3] * __uint_as_float(v.y & 0xffff0000u);
              o[4] += cw[k][4] * bf2f(v.z & 0xffffu); o[5] += cw[k][5] * __uint_as_float(v.z & 0xffff0000u); o[6] += cw[k][6] * bf2f(v.w & 0xffffu); o[7] += cw[k][7] * __uint_as_float(v.w & 0xffff0000u); }
          u32x4 w; w.x = pk2(o[0], o[1]); w.y = pk2(o[2], o[3]); w.z = pk2(o[4], o[5]); w.w = pk2(o[6], o[7]);
          *(LAS u32x4*)(ucw + token * UCP + grp * 16) = w; }
      LDS_WAIT(); asm volatile("" ::: "memory"); }
    if (SHARED) __syncthreads();
    asm volatile("" : "+v"(lane));
    bf16x8 af[8][2];
    if (act) { const int fr = lane & 15, fq = lane >> 4;
#pragma unroll
      for (int m = 0; m < 8; ++m)
#pragma unroll
          for (int ks = 0; ks < 2; ++ks) af[m][ks] = *(const LAS bf16x8*)(ucw + (32 * (fr >> 2) + 4 * m + (fr & 3)) * UCP + (8 * fq + 32 * ks) * 2); }
    if (SHARED) { __syncthreads(); if (!act) return; }
    const bf16_t* wg0 = (const bf16_t*)(F.ws + WS_RGW) + (size_t)(l * 2 + 0) * 2 * 8 * 4096;
    const bf16_t* wg1 = (const bf16_t*)(F.ws + WS_RGW) + (size_t)(l * 2 + 1) * 2 * 8 * 4096;
    float* TOT = (float*)(F.ws + WS_TOT);
    RgStep R0, R1;
    rg_load_step<FINAL>(R0, F, wg0, l, 0, item, blk, n0, lane);
#pragma unroll 1
    for (int n = n0; n < n1; ++n) { asm volatile("" : "+v"(lane));
        const int fr = lane & 15, fq = lane >> 4; const int ch = blk * 64 + 16 * n + fr;
        f32x4 hsum[8];
#pragma unroll
        for (int m = 0; m < 8; ++m) hsum[m] = zero4();
        rg_load_step<FINAL>(R1, F, wg1, l, 1, item, blk, n, lane);
        { float At, Ht;
          rg_dir<FINAL, 0>(ucw, af, R0, n, lane, hsum, At, Ht);
          if (!FINAL && fq == 0) { *(f32x2*)(TOT + (((size_t)item * 2 + 0) * 512 + ch) * 2) = (f32x2){At, Ht}; } }
        __builtin_amdgcn_sched_barrier(0);
        if (n + 1 < n1) rg_load_step<FINAL>(R0, F, wg0, l, 0, item, blk, n + 1, lane);
        { float At, Ht;
          rg_dir<FINAL, 1>(ucw, af, R1, n, lane, hsum, At, Ht);
          if (!FINAL && fq == 0) { *(f32x2*)(TOT + (((size_t)item * 2 + 1) * 512 + ch) * 2) = (f32x2){At, Ht}; } }
        if (FINAL) {
            const unsigned uo = (unsigned)(32 * fq * UCP + (16 * n + fr) * 2);
#pragma unroll
            for (int m = 0; m < 8; ++m)
#pragma unroll
                for (int jj = 0; jj < 4; ++jj) *(LAS bf16_t*)(ucw + uo + (4 * m + jj) * UCP) = (bf16_t)f2bf(hsum[m][jj]); }
    }
    if (FINAL) {
        LDS_WAIT(); asm volatile("" : "+v"(lane) :: "memory");
        const int ng = 2 * (n1 - n0);
        const int grp = 2 * n0 + ((ng == 8) ? (lane & 7) : (lane & 1)); const int tk0 = (ng == 8) ? (lane >> 3) : (lane >> 1), tstep = (ng == 8) ? 8 : 32, nq = (ng == 8) ? 16 : 4;
        const bf16_t* Pg = P + (size_t)it.row0 * INW + 512 + blk * 64 + grp * 8; bf16_t* Yo = (bf16_t*)(F.ws + WS_Y) + (size_t)it.row0 * D + blk * 64 + grp * 8;
#pragma unroll 8
        for (int q = 0; q < nq; ++q) { const int token = tk0 + tstep * q;
            const u32x4 hv = *(const LAS u32x4*)(ucw + token * UCP + grp * 16); const u32x4 gv = ldg<u32x4>(Pg, (unsigned)token * (unsigned)(INW * 2));
            u32x4 w;
            w.x = pk2(gelu_tanh(bf2f(gv.x & 0xffffu)) * bf2f(hv.x & 0xffffu), gelu_tanh(__uint_as_float(gv.x & 0xffff0000u)) * __uint_as_float(hv.x & 0xffff0000u));
            w.y = pk2(gelu_tanh(bf2f(gv.y & 0xffffu)) * bf2f(hv.y & 0xffffu), gelu_tanh(__uint_as_float(gv.y & 0xffff0000u)) * __uint_as_float(hv.y & 0xffff0000u));
            w.z = pk2(gelu_tanh(bf2f(gv.z & 0xffffu)) * bf2f(hv.z & 0xffffu), gelu_tanh(__uint_as_float(gv.z & 0xffff0000u)) * __uint_as_float(hv.z & 0xffff0000u));
            w.w = pk2(gelu_tanh(bf2f(gv.w & 0xffffu)) * bf2f(hv.w & 0xffffu), gelu_tanh(__uint_as_float(gv.w & 0xffff0000u)) * __uint_as_float(hv.w & 0xffff0000u));
            stg<u32x4>(Yo, (unsigned)token * (unsigned)(D * 2), w); }
        LDS_WAIT();
    }
}

__device__ __forceinline__ void stage_rows(Frame& F, ldsp_t dst, const Item& it, int col0, bool rope) {
    const bf16_t* P = (const bf16_t*)(F.ws + WS_PA); const float* ct = (const float*)(F.ws + WS_ROPE); const float* st = ct + 4096 * 64;
    for (int task = F.tid; task < 1024; task += NTHREADS) { const int token = task >> 3, d0 = (task & 7) * 8;
        const bf16_t* src = P + (size_t)(it.row0 + token) * INW + col0;
        const u32x4 lo = *(const u32x4*)(src + d0), hi = *(const u32x4*)(src + d0 + 64);
        u32x4 olo = lo, ohi = hi;
        if (rope) { const int pos = it.t0 + token; const f32x4 c0 = *(const f32x4*)(ct + pos * 64 + d0), c1 = *(const f32x4*)(ct + pos * 64 + d0 + 4), s0 = *(const f32x4*)(st + pos * 64 + d0), s1 = *(const f32x4*)(st + pos * 64 + d0 + 4);
            const float a[8] = {bf2f(lo.x & 0xffffu), __uint_as_float(lo.x & 0xffff0000u), bf2f(lo.y & 0xffffu), __uint_as_float(lo.y & 0xffff0000u), bf2f(lo.z & 0xffffu), __uint_as_float(lo.z & 0xffff0000u), bf2f(lo.w & 0xffffu), __uint_as_float(lo.w & 0xffff0000u)};
            const float b[8] = {bf2f(hi.x & 0xffffu), __uint_as_float(hi.x & 0xffff0000u), bf2f(hi.y & 0xffffu), __uint_as_float(hi.y & 0xffff0000u), bf2f(hi.z & 0xffffu), __uint_as_float(hi.z & 0xffff0000u), bf2f(hi.w & 0xffffu), __uint_as_float(hi.w & 0xffff0000u)};
            const float c[8] = {c0.x, c0.y, c0.z, c0.w, c1.x, c1.y, c1.z, c1.w}, s[8] = {s0.x, s0.y, s0.z, s0.w, s1.x, s1.y, s1.z, s1.w};
            float ra[8], rb[8];
#pragma unroll
            for (int i = 0; i < 8; ++i) { ra[i] = a[i] * c[i] - b[i] * s[i]; rb[i] = a[i] * s[i] + b[i] * c[i]; }
            olo.x = pk2(ra[0], ra[1]); olo.y = pk2(ra[2], ra[3]); olo.z = pk2(ra[4], ra[5]); olo.w = pk2(ra[6], ra[7]);
            ohi.x = pk2(rb[0], rb[1]); ohi.y = pk2(rb[2], rb[3]); ohi.z = pk2(rb[4], rb[5]); ohi.w = pk2(rb[6], rb[7]); }
        *(LAS u32x4*)(dst + token * TP + d0 * 2) = olo; *(LAS u32x4*)(dst + token * TP + (d0 + 64) * 2) = ohi; }
}
__device__ __forceinline__ void stage_cols(Frame& F, ldsp_t dst, const Item& it, int col0) {
    const bf16_t* P = (const bf16_t*)(F.ws + WS_PA);
    for (int task = F.tid; task < 2048; task += NTHREADS) { const int token = task >> 4, d0 = (task & 15) * 8;
        const u32x4 v = *(const u32x4*)(P + (size_t)(it.row0 + token) * INW + col0 + d0);
        const unsigned w[4] = {v.x, v.y, v.z, v.w};
#pragma unroll
        for (int i = 0; i < 4; ++i) { *(LAS bf16_t*)(dst + (d0 + 2 * i) * TP + token * 2) = (bf16_t)(w[i] & 0xffffu); *(LAS bf16_t*)(dst + (d0 + 2 * i + 1) * TP + token * 2) = (bf16_t)(w[i] >> 16); } }
}
__device__ __forceinline__ void rope8(u32x4& lo, u32x4& hi, const float* ct, const float* st, int pos, int d0) {
    const f32x4 c0 = *(const f32x4*)(ct + pos * 64 + d0), c1 = *(const f32x4*)(ct + pos * 64 + d0 + 4), s0 = *(const f32x4*)(st + pos * 64 + d0), s1 = *(const f32x4*)(st + pos * 64 + d0 + 4);
    const float a[8] = {bf2f(lo.x & 0xffffu), __uint_as_float(lo.x & 0xffff0000u), bf2f(lo.y & 0xffffu), __uint_as_float(lo.y & 0xffff0000u), bf2f(lo.z & 0xffffu), __uint_as_float(lo.z & 0xffff0000u), bf2f(lo.w & 0xffffu), __uint_as_float(lo.w & 0xffff0000u)};
    const float b[8] = {bf2f(hi.x & 0xffffu), __uint_as_float(hi.x & 0xffff0000u), bf2f(hi.y & 0xffffu), __uint_as_float(hi.y & 0xffff0000u), bf2f(hi.z & 0xffffu), __uint_as_float(hi.z & 0xffff0000u), bf2f(hi.w & 0xffffu), __uint_as_float(hi.w & 0xffff0000u)};
    const float c[8] = {c0.x, c0.y, c0.z, c0.w, c1.x, c1.y, c1.z, c1.w}, sn[8] = {s0.x, s0.y, s0.z, s0.w, s1.x, s1.y, s1.z, s1.w};
    float ra[8], rb[8];
#pragma unroll
    for (int i = 0; i < 8; ++i) { ra[i] = a[i] * c[i] - b[i] * sn[i]; rb[i] = a[i] * sn[i] + b[i] * c[i]; }
    lo = (u32x4){pk2(ra[0], ra[1]), pk2(ra[2], ra[3]), pk2(ra[4], ra[5]), pk2(ra[6], ra[7])};
    hi = (u32x4){pk2(rb[0], rb[1]), pk2(rb[2], rb[3]), pk2(rb[4], rb[5]), pk2(rb[6], rb[7])};
}
struct KvRegs { u32x4 klo[2], khi[2], v[4]; };
__device__ __forceinline__ void kv_issue(Frame& F, KvRegs& R, const Item& it, int h) {
    const bf16_t* P = (const bf16_t*)(F.ws + WS_PA);
    const bf16_t* Pk = P + (size_t)it.row0 * INW + 1536 + h * HD; const bf16_t* Pv = P + (size_t)it.row0 * INW + 2048 + h * HD;
#pragma unroll
    for (int t2 = 0; t2 < 2; ++t2) { const int task = F.tid + t2 * NTHREADS, token = task >> 3, d0 = (task & 7) * 8;
        R.klo[t2] = ldg<u32x4>(Pk, (unsigned)(token * INW + d0) * 2u); R.khi[t2] = ldg<u32x4>(Pk, (unsigned)(token * INW + d0 + 64) * 2u); }
#pragma unroll
    for (int t4 = 0; t4 < 4; ++t4) { const int task = F.tid + t4 * NTHREADS, token = task >> 4, d0 = (task & 15) * 8; R.v[t4] = ldg<u32x4>(Pv, (unsigned)(token * INW + d0) * 2u); }
}
template <int KS> __device__ __forceinline__ void kv_step(unsigned aK, unsigned aVf, unsigned aVb, f32x4 (&accf)[8], f32x4 (&accb)[8]) {
    const bf16x8 af = tr1<KS * 32 * VP>(aVf), ab = tr1<KS * 32 * VP>(aVb);
    bf16x8 b[8];
    tr4<KS * 32 * VP>(aK, b[0], b[1], b[2], b[3]); tr4<KS * 32 * VP + 128>(aK, b[4], b[5], b[6], b[7]);
#pragma unroll
    for (int n = 0; n < 8; ++n) { accf[n] = __builtin_amdgcn_mfma_f32_16x16x32_bf16(af, b[n], accf[n], 0, 0, 0); accb[n] = __builtin_amdgcn_mfma_f32_16x16x32_bf16(ab, b[n], accb[n], 0, 0, 0); }
}
__device__ __forceinline__ void stage_state_t(Frame& F, ldsp_t dst, const bf16_t* St) {
#pragma unroll
    for (int t4 = 0; t4 < 4; ++t4) { const int task = F.tid + t4 * NTHREADS, e = task >> 4, c8 = task & 15;
        *(LAS u32x4*)(dst + e * TP + c8 * 16) = ldg<u32x4>(St, (unsigned)(e * 128 + c8 * 8) * 2u); }
}
__device__ __forceinline__ void mm16x128(ldsp_t At, int ra0, ldsp_t Bt, int lane, f32x4 (&acc)[8]) {
    const int fr = lane & 15, fq = lane >> 4;
#pragma unroll
    for (int ks = 0; ks < 4; ++ks) { const bf16x8 a = *(const LAS bf16x8*)(At + (ra0 + fr) * TP + (32 * ks + 8 * fq) * 2);
#pragma unroll
        for (int n = 0; n < 8; ++n) { const bf16x8 b = *(const LAS bf16x8*)(Bt + (16 * n + fr) * TP + (32 * ks + 8 * fq) * 2); acc[n] = __builtin_amdgcn_mfma_f32_16x16x32_bf16(a, b, acc[n], 0, 0, 0); } }
}

__device__ __forceinline__ void kv_head(Frame& F, KvRegs& R, KvRegs& Rn, bool pre, int item, const Item& it, int h) {
    bf16_t* KV = (bf16_t*)(F.ws + WS_KV);
    const float* ct = (const float*)(F.ws + WS_ROPE); const float* st = ct + 4096 * 64;
    const LAS float* dec = (const LAS float*)(F.lds + LDS_DEC); const bool rope = !it.is_ctx;
    ldsp_t tK = F.lds, tVf = F.lds + TILEV, tVb = F.lds + 2 * TILEV;
#pragma unroll
    for (int t2 = 0; t2 < 2; ++t2) { const int task = F.tid + t2 * NTHREADS, token = task >> 3, d0 = (task & 7) * 8;
        if (rope) rope8(R.klo[t2], R.khi[t2], ct, st, it.t0 + token, d0);
        *(LAS u32x4*)(tK + token * VP + d0 * 2) = R.klo[t2]; *(LAS u32x4*)(tK + token * VP + (d0 + 64) * 2) = R.khi[t2]; }
#pragma unroll
    for (int t4 = 0; t4 < 4; ++t4) { const int task = F.tid + t4 * NTHREADS, token = task >> 4, d0 = (task & 15) * 8; const u32x4 v = R.v[t4];
        const float df = dec[(0 * 4 + h) * 132 + 127 - token], db = dec[(1 * 4 + h) * 132 + token];
        const float x[8] = {bf2f(v.x & 0xffffu), __uint_as_float(v.x & 0xffff0000u), bf2f(v.y & 0xffffu), __uint_as_float(v.y & 0xffff0000u), bf2f(v.z & 0xffffu), __uint_as_float(v.z & 0xffff0000u), bf2f(v.w & 0xffffu), __uint_as_float(v.w & 0xffff0000u)};
        u32x4 wf, wb; wf.x = pk2(x[0] * df, x[1] * df); wf.y = pk2(x[2] * df, x[3] * df); wf.z = pk2(x[4] * df, x[5] * df); wf.w = pk2(x[6] * df, x[7] * df);
        wb.x = pk2(x[0] * db, x[1] * db); wb.y = pk2(x[2] * db, x[3] * db); wb.z = pk2(x[4] * db, x[5] * db); wb.w = pk2(x[6] * db, x[7] * db);
        *(LAS u32x4*)(tVf + token * VP + d0 * 2) = wf; *(LAS u32x4*)(tVb + token * VP + d0 * 2) = wb; }
    WG_BAR_LDS();
    if (pre) kv_issue(F, Rn, it, h + 1);
    f32x4 af[8], ab[8];
#pragma unroll
    for (int n = 0; n < 8; ++n) { af[n] = zero4(); ab[n] = zero4(); }
    { const unsigned aK = tr_lane_addr(tK, F.lane), aVf = tr_lane_addr(tVf, F.lane) + 32u * (unsigned)F.wave, aVb = tr_lane_addr(tVb, F.lane) + 32u * (unsigned)F.wave;
      kv_step<0>(aK, aVf, aVb, af, ab); kv_step<1>(aK, aVf, aVb, af, ab); kv_step<2>(aK, aVf, aVb, af, ab); kv_step<3>(aK, aVf, aVb, af, ab); }
    const int fr = F.lane & 15, fq = F.lane >> 4;
    bf16_t* of = KV + (((size_t)item * 4 + h) * 2 + 0) * 16384 + (size_t)(16 * F.wave) * 128;
    unsigned so = (unsigned)((4 * fq) * 128 + fr) * 2u; asm volatile("" : "+v"(so));
#pragma unroll
    for (int n = 0; n < 8; ++n)
#pragma unroll
        for (int jj = 0; jj < 4; ++jj) { stg<bf16_t>(of, so + (unsigned)((jj * 128 + 16 * n) * 2), (bf16_t)f2bf(af[n][jj])); stg<bf16_t>(of, so + (unsigned)((16384 + jj * 128 + 16 * n) * 2), (bf16_t)f2bf(ab[n][jj])); }
    WG_BAR_LDS();
}
__device__ __forceinline__ int latent_item(int c) { return (c >> 5) * SPB + 2 + (c & 31); }
__device__ __forceinline__ int ctx_item(int ci) { return (ci >> 1) * SPB + (ci & 1); }
__device__ __forceinline__ void phase_m1(Frame& F, int l) {
    build_decay(F, l); __syncthreads();
    for (int c = F.bid; c < 256; c += F.G) {
        fresh(F);
        { const int item = latent_item(c); const Item it = item_info(item);
          rg_part<false>(F, l, item, it, F.wave, 0, 4);
          __syncthreads();
          KvRegs A, B;
          fresh(F); kv_issue(F, A, it, 0);
          kv_head(F, A, B, true, item, it, 0);
          fresh(F); kv_head(F, B, A, true, item, it, 1);
          fresh(F); kv_head(F, A, B, true, item, it, 2);
          fresh(F); kv_head(F, B, A, false, item, it, 3); }
        fresh(F);
        if (c >= 64 && c < 192) { const int cu = c - 64; const int item = ctx_item(cu >> 3); const Item it = item_info(item);
            const int w4 = F.wave & 3; rg_part<false, true>(F, l, item, it, cu & 7, w4, w4 + 1); }
        __syncthreads();
        if (c < 64) { const int item = ctx_item(c >> 2); const Item it = item_info(item); KvRegs A, B; fresh(F); kv_issue(F, A, it, c & 3); kv_head(F, A, B, false, item, it, c & 3); }
    }
}
__device__ __forceinline__ int seq_order(int dir, int step) { return dir ? (step == 0 ? 1 : (step == 1 ? 0 : 35 - step)) : step; }
__device__ __forceinline__ void phase_m2(Frame& F, int l) {
    bf16_t* KV = (bf16_t*)(F.ws + WS_KV);
    const int gt = F.bid * NTHREADS + F.tid, NGT = F.G * NTHREADS;
    for (int c = gt; c < NB * NH * 2 * 128 * 16; c += NGT) {
        const int dc = c & 15, e = (c >> 4) & 127, dir = (c >> 11) & 1, h = (c >> 12) & 3, b = c >> 14;
        const float x = F.pa->in[I_RETDEC][l * 8 + dir * 4 + h]; const float decay = expf(128.0f * (-log1pf(expf(-x))));
        float S[8];
#pragma unroll
        for (int i = 0; i < 8; ++i) S[i] = 0.f;
        const unsigned lo = (unsigned)((((h * 2 + dir) * 128 + e) * 128 + dc * 8) * 2);
        for (int g0 = 0; g0 < SPB; g0 += 17) {
            u32x4 v[17];
#pragma unroll
            for (int i = 0; i < 17; ++i) { const int item = b * SPB + seq_order(dir, g0 + i); v[i] = ldg<u32x4>(KV + (size_t)item * 4 * 2 * 16384, lo); }
#pragma unroll
            for (int i = 0; i < 17; ++i) { const int item = b * SPB + seq_order(dir, g0 + i);
                u32x4 w; w.x = pk2(S[0], S[1]); w.y = pk2(S[2], S[3]); w.z = pk2(S[4], S[5]); w.w = pk2(S[6], S[7]);
                stg<u32x4>(KV + (size_t)item * 4 * 2 * 16384, lo, w);
                S[0] = S[0] * decay + bf2f(v[i].x & 0xffffu); S[1] = S[1] * decay + __uint_as_float(v[i].x & 0xffff0000u); S[2] = S[2] * decay + bf2f(v[i].y & 0xffffu); S[3] = S[3] * decay + __uint_as_float(v[i].y & 0xffff0000u);
                S[4] = S[4] * decay + bf2f(v[i].z & 0xffffu); S[5] = S[5] * decay + __uint_as_float(v[i].z & 0xffff0000u); S[6] = S[6] * decay + bf2f(v[i].w & 0xffffu); S[7] = S[7] * decay + __uint_as_float(v[i].w & 0xffff0000u); }
        }
    }
    const float* TOT = (const float*)(F.ws + WS_TOT); float* CARRY = (float*)(F.ws + WS_CARRY);
    if (F.tid < 32) for (int cidx = F.bid * 32 + F.tid; cidx < NB * 2 * 512; cidx += F.G * 32) {
      { const int ch = cidx & 511, dir = (cidx >> 9) & 1, b = cidx >> 10; float cr = 0.f;
          for (int g0 = 0; g0 < SPB; g0 += 17) { f32x2 ah[17];
#pragma unroll
              for (int i = 0; i < 17; ++i) { const int item = b * SPB + seq_order(dir, g0 + i); ah[i] = *(const f32x2*)(TOT + (((size_t)item * 2 + dir) * 512 + ch) * 2); }
#pragma unroll
              for (int i = 0; i < 17; ++i) { const int item = b * SPB + seq_order(dir, g0 + i); CARRY[((size_t)item * 2 + dir) * 512 + ch] = cr; cr = ah[i].x * cr + ah[i].y; } } } }
}
struct RetRegs { u32x4 v[4], sf[4], sb[4], klo[2], khi[2], g[4]; };
__device__ __forceinline__ void ret_issue(Frame& F, RetRegs& R, int item, const Item& it, int h) {
    const bf16_t* KV = (const bf16_t*)(F.ws + WS_KV); const bf16_t* P = (const bf16_t*)(F.ws + WS_PA);
    const bf16_t* Pk = P + (size_t)it.row0 * INW + 1536 + h * HD; const bf16_t* Pv = P + (size_t)it.row0 * INW + 2048 + h * HD;
    const bf16_t* Sf = KV + (((size_t)item * 4 + h) * 2 + 0) * 16384; const bf16_t* Sb = Sf + 16384;
    const int lane = F.lane, i0 = 16 * F.wave;
#pragma unroll
    for (int t2 = 0; t2 < 2; ++t2) { const int task = F.tid + t2 * NTHREADS, token = task >> 3, d0 = (task & 7) * 8;
        R.klo[t2] = ldg<u32x4>(Pk, (unsigned)(token * INW + d0) * 2u); R.khi[t2] = ldg<u32x4>(Pk, (unsigned)(token * INW + d0 + 64) * 2u); }
#pragma unroll
    for (int t4 = 0; t4 < 4; ++t4) { const int task = F.tid + t4 * NTHREADS, r = task >> 4, c8 = task & 15;
        R.v[t4] = ldg<u32x4>(Pv, (unsigned)(r * INW + c8 * 8) * 2u); R.sf[t4] = ldg<u32x4>(Sf, (unsigned)(r * 128 + c8 * 8) * 2u); R.sb[t4] = ldg<u32x4>(Sb, (unsigned)(r * 128 + c8 * 8) * 2u); }
    { const bf16_t* Pg = P + (size_t)(it.row0 + i0) * INW + 2560 + h * HD;
#pragma unroll
      for (int k = 0; k < 4; ++k) R.g[k] = ldg<u32x4>(Pg, (unsigned)((lane >> 2) * INW + 32 * (lane & 3) + 8 * k) * 2u); }
}
__device__ __forceinline__ void ret_head(Frame& F, RetRegs& R, RetRegs& Rn, bool pre, int item, const Item& it, int h) {
    bf16_t* Y = (bf16_t*)(F.ws + WS_Y);
    const float* ct = (const float*)(F.ws + WS_ROPE); const float* st = ct + 4096 * 64;
    const LAS float* dec = (const LAS float*)(F.lds + LDS_DEC);
    ldsp_t tK = F.lds, tV = F.lds + TILEB, tSf = tV + TILEV, tSb = tSf + TILEB;
    const bool rope = !it.is_ctx;
    const int lane = F.lane, fr = lane & 15, fq = lane >> 4, i0 = 16 * F.wave;
    u32x4 q4[4];
    { const bf16_t* Pq = (const bf16_t*)(F.ws + WS_PA) + (size_t)(it.row0 + i0) * INW + 1024 + h * HD;
#pragma unroll
      for (int ks = 0; ks < 4; ++ks) q4[ks] = ldg<u32x4>(Pq, (unsigned)(fr * INW + 32 * ks + 8 * fq) * 2u); }
#pragma unroll
    for (int t2 = 0; t2 < 2; ++t2) { const int task = F.tid + t2 * NTHREADS, token = task >> 3, d0 = (task & 7) * 8;
        if (rope) rope8(R.klo[t2], R.khi[t2], ct, st, it.t0 + token, d0);
        *(LAS u32x4*)(tK + token * TP + d0 * 2) = R.klo[t2]; *(LAS u32x4*)(tK + token * TP + (d0 + 64) * 2) = R.khi[t2]; }
#pragma unroll
    for (int t4 = 0; t4 < 4; ++t4) { const int task = F.tid + t4 * NTHREADS, r = task >> 4, c8 = task & 15;
        *(LAS u32x4*)(tV + r * VP + c8 * 16) = R.v[t4]; *(LAS u32x4*)(tSf + r * TP + c8 * 16) = R.sf[t4]; *(LAS u32x4*)(tSb + r * TP + c8 * 16) = R.sb[t4]; }
    bf16x8 qf[4];
    { if (rope) { rope8(q4[0], q4[2], ct, st, it.t0 + i0 + fr, 8 * fq); rope8(q4[1], q4[3], ct, st, it.t0 + i0 + fr, 32 + 8 * fq); }
#pragma unroll
      for (int ks = 0; ks < 4; ++ks) qf[ks] = __builtin_bit_cast(bf16x8, q4[ks]); }
    u32x4 gk[4];
#pragma unroll
    for (int k = 0; k < 4; ++k) gk[k] = R.g[k];
    WG_BAR_LDS();
    if (pre) ret_issue(F, Rn, item, it, h + 1);
    bf16x8 pa[4];
    { f32x4 C[8];
#pragma unroll
      for (int jt = 0; jt < 8; ++jt) { C[jt] = zero4();
#pragma unroll
          for (int ks = 0; ks < 4; ++ks) { const bf16x8 a = *(const LAS bf16x8*)(tK + (16 * jt + fr) * TP + (32 * ks + 8 * fq) * 2); C[jt] = __builtin_amdgcn_mfma_f32_16x16x32_bf16(a, qf[ks], C[jt], 0, 0, 0); } }
      const int i = i0 + fr;
#pragma unroll
      for (int jt = 0; jt < 8; ++jt)
#pragma unroll
          for (int jj = 0; jj < 4; ++jj) { const int j = 16 * jt + 4 * fq + jj; const float dcy = (i >= j) ? dec[(0 * 4 + h) * 132 + (i - j)] : dec[(1 * 4 + h) * 132 + (j - i)]; C[jt][jj] *= dcy; }
#pragma unroll
      for (int u = 0; u < 4; ++u) { const u32x4 w = {pg8::cvt_pk_bf16(C[2 * u][0], C[2 * u][1]), pg8::cvt_pk_bf16(C[2 * u][2], C[2 * u][3]), pg8::cvt_pk_bf16(C[2 * u + 1][0], C[2 * u + 1][1]), pg8::cvt_pk_bf16(C[2 * u + 1][2], C[2 * u + 1][3])};
          pa[u] = __builtin_bit_cast(bf16x8, w); } }
    WG_BAR_LDS();
    { ldsp_t gt = tK + (i0 + (lane >> 2)) * TP + (lane & 3) * 64;
#pragma unroll
      for (int k = 0; k < 4; ++k) *(LAS u32x4*)(gt + 16 * k) = gk[k]; }
    f32x4 o[8];
#pragma unroll
    for (int n = 0; n < 8; ++n) o[n] = zero4();
    { const unsigned aV = tr_lane_addr(tV, lane); bf16x8 b[8];
#define RET_PV(U) do { tr4<(U) * 32 * VP>(aV, b[0], b[1], b[2], b[3]); tr4<(U) * 32 * VP + 128>(aV, b[4], b[5], b[6], b[7]); \
        _Pragma("unroll") for (int n = 0; n < 8; ++n) o[n] = __builtin_amdgcn_mfma_f32_16x16x32_bf16(pa[U], b[n], o[n], 0, 0, 0); } while (0)
      RET_PV(0); RET_PV(1); RET_PV(2); RET_PV(3);
#undef RET_PV
    }
    { f32x4 cf[8];
#pragma unroll
      for (int n = 0; n < 8; ++n) { cf[n] = zero4();
#pragma unroll
          for (int ks = 0; ks < 4; ++ks) { const bf16x8 b = *(const LAS bf16x8*)(tSf + (16 * n + fr) * TP + (32 * ks + 8 * fq) * 2); cf[n] = __builtin_amdgcn_mfma_f32_16x16x32_bf16(qf[ks], b, cf[n], 0, 0, 0); } }
#pragma unroll
      for (int jj = 0; jj < 4; ++jj) { const float sf = dec[(0 * 4 + h) * 132 + (i0 + 4 * fq + jj + 1)];
#pragma unroll
          for (int n = 0; n < 8; ++n) o[n][jj] += sf * cf[n][jj]; } }
    { f32x4 cb[8];
#pragma unroll
      for (int n = 0; n < 8; ++n) { cb[n] = zero4();
#pragma unroll
          for (int ks = 0; ks < 4; ++ks) { const bf16x8 b = *(const LAS bf16x8*)(tSb + (16 * n + fr) * TP + (32 * ks + 8 * fq) * 2); cb[n] = __builtin_amdgcn_mfma_f32_16x16x32_bf16(qf[ks], b, cb[n], 0, 0, 0); } }
#pragma unroll
      for (int jj = 0; jj < 4; ++jj) { const float sb = dec[(1 * 4 + h) * 132 + (128 - (i0 + 4 * fq + jj))];
#pragma unroll
          for (int n = 0; n < 8; ++n) o[n][jj] += sb * cb[n][jj]; } }
    { ldsp_t gc = tK + (i0 + 4 * fq) * TP + fr * 2;
#pragma unroll
      for (int jj = 0; jj < 4; ++jj) { float s1 = 0.f;
#pragma unroll
          for (int n = 0; n < 8; ++n) s1 += o[n][jj];
          s1 += swz_xor<1>(s1); s1 += swz_xor<2>(s1); s1 += swz_xor<4>(s1); s1 += swz_xor<8>(s1);
          const float mu = s1 * (1.0f / 128.0f); float q = 0.f;
#pragma unroll
          for (int n = 0; n < 8; ++n) { const float dd = o[n][jj] - mu; q += dd * dd; }
          q += swz_xor<1>(q); q += swz_xor<2>(q); q += swz_xor<4>(q); q += swz_xor<8>(q);
          const float rstd = 1.0f / sqrtf(q * (1.0f / 128.0f) + EPS);
#pragma unroll
          for (int n = 0; n < 8; ++n) { LAS bf16_t* p = (LAS bf16_t*)(gc + jj * TP + 32 * n); const float gv = bf2f(*p); *p = (bf16_t)f2bf(siluf_(gv) * (o[n][jj] - mu) * rstd); } } }
    LDS_WAIT(); asm volatile("" ::: "memory");
    { ldsp_t gt = tK + (i0 + (lane >> 2)) * TP + (lane & 3) * 64; bf16_t* Yo = Y + (size_t)(it.row0 + i0) * D + 512 + h * HD;
#pragma unroll
      for (int k = 0; k < 4; ++k) stg<u32x4>(Yo, (unsigned)((lane >> 2) * D + 32 * (lane & 3) + 8 * k) * 2u, *(const LAS u32x4*)(gt + 16 * k)); }
    WG_BAR_LDS();
}
__device__ __forceinline__ void phase_m3(Frame& F, int l) {
    build_decay(F, l); __syncthreads();
    for (int c = F.bid; c < 256; c += F.G) {
        fresh(F);
        { const int item = latent_item(c); const Item it = item_info(item);
#ifndef PROBE_M3
#define PROBE_M3 0
#endif
          for (int r_ = 0; r_ < ((PROBE_M3 & 1) ? 2 : 1); ++r_) { fresh(F); rg_part<true>(F, l, item, it, F.wave, 0, 4); }
          __syncthreads();
          for (int r_ = 0; r_ < ((PROBE_M3 & 2) ? 2 : 1); ++r_) {
          RetRegs R, Rn;
          fresh(F); ret_issue(F, R, item, it, 0);
          ret_head(F, R, Rn, true, item, it, 0);
          fresh(F); ret_head(F, Rn, R, true, item, it, 1);
          fresh(F); ret_head(F, R, Rn, true, item, it, 2);
          fresh(F); ret_head(F, Rn, R, false, item, it, 3); } }
        if (l == 0) {
            fresh(F);
            if (c >= 64 && c < 192) { const int cu = c - 64; const int item = ctx_item(cu >> 3); const Item it = item_info(item);
                const int w4 = F.wave & 3; rg_part<true, true>(F, l, item, it, cu & 7, w4, w4 + 1); }
            __syncthreads();
            if (c < 64) { const int item = ctx_item(c >> 2); const Item it = item_info(item); RetRegs R, Rn; fresh(F); ret_issue(F, R, item, it, c & 3); ret_head(F, R, Rn, false, item, it, c & 3); }
        }
    }
}

constexpr int N_PHASES = 24;
__global__ void __launch_bounds__(NTHREADS, 2) fwd_kernel(Args args) {
    extern __shared__ __attribute__((aligned(16))) unsigned char lds_raw[];
    Frame F; F.lds = (ldsp_t)lds_raw; F.wave0 = __builtin_amdgcn_readfirstlane((int)threadIdx.x >> 6); F.G = gridDim.x; F.pa0 = &args; F.out0 = args.out; F.ws0 = args.ws; fresh(F);
    volatile LAS unsigned* MISC = (volatile LAS unsigned*)(F.lds + LDS_MISC);
    if (F.tid < 64) MISC[F.tid] = 0u;
    __syncthreads();
    const int lo = args.ph_lo, hi = args.ph_hi;
    XcdBarrier bar; bar.bar = (unsigned*)(F.ws + WS_CTL); bar.x = 0; bar.st = nullptr;
    if (hi - lo > 1) bar = xcd_barrier_post((unsigned*)(F.ws + WS_CTL), MISC);
#ifndef DIAG_MASK
#define DIAG_MASK 0xffffffffu
#endif
#ifndef REPEAT_MASK
#define REPEAT_MASK 0u
#endif
#define REPS(kind) ((((REPEAT_MASK) >> (kind)) & 1u) ? 2 : 1)
#define INK(k, kind) (((DIAG_MASK >> (kind)) & 1u) && lo <= (k) && (k) < hi && fresh(F))
#define IN(k) (lo <= (k) && (k) < hi)
#define SEAM(k) do { if (IN(k) && IN((k) + 1)) xcd_barrier(bar); } while (0)
    float* ctxx = (float*)(F.ws + WS_CTXX); bf16_t* xb = (bf16_t*)((char*)F.out + XB_OFF);
    const float* modlat = (const float*)(F.ws + WS_MODLAT); const float* modctx = (const float*)(F.ws + WS_MODCTX);

    if (INK(0, 0)) { for (int r_ = 0; r_ < REPS(0); ++r_) { phase_convert_small(F); __syncthreads(); phase_mod(F); __syncthreads(); } } SEAM(0);
    if (INK(1, 1)) { for (int r_ = 0; r_ < REPS(1); ++r_) phase_norm(F, 0, 0, F.pa->in[I_X], nullptr, F.pa->in[I_CTX], MROWS, SlabRed{nullptr, 0, nullptr, nullptr, nullptr}); } SEAM(1);
#pragma unroll 1
    for (int l = 0; l < 2; ++l) {
        const int pb = (l == 0) ? 2 : 11;
        if (INK(pb + 0, 2)) { pg8::Gemm g{(const bf16_t*)(F.ws + WS_HX), (const bf16_t*)(F.ws + WS_WIN) + (size_t)l * INW * D, INW, D, 0, nullptr}; pg8::Order S; S.init(MROWS / 256, INW / 256, F.G, F.bid, nullptr, nullptr, D / 64, false, 0);
            pg8::EpiBf16 E{(bf16_t*)(F.ws + WS_PA), INW}; for (int r_ = 0; r_ < REPS(2); ++r_) pg8::gemm_phase<pg8::EpiBf16>(F.lds, g, S, E, F.tid); }
        SEAM(pb + 0);
        if (INK(pb + 1, 3)) { for (int r_ = 0; r_ < REPS(3); ++r_) phase_m1(F, l); }
        SEAM(pb + 1);
        if (INK(pb + 2, 4)) { for (int r_ = 0; r_ < REPS(4); ++r_) { if (r_) phase_m1(F, l); phase_m2(F, l); } }
        SEAM(pb + 2);
        if (INK(pb + 3, 5)) { for (int r_ = 0; r_ < REPS(5); ++r_) phase_m3(F, l); }
        SEAM(pb + 3);
        if (INK(pb + 4, 6)) { pg8::Gemm g{(const bf16_t*)(F.ws + WS_Y), (const bf16_t*)(F.ws + WS_WOUT) + (size_t)l * D * D, D, D, 0, (float*)(F.ws + WS_SLABA)}; pg8::Order S; S.init((l == 0 ? MROWS : NLAT) / 256, D / 256, F.G, F.bid, nullptr, nullptr, D / 64, true, MAXSLAB_A);
            pg8::EpiResid E{l == 0 ? F.pa->in[I_X] : nullptr, xb, F.pa->in[I_CTX], ctxx, modlat + (size_t)l * 8 * 6144 + 2048, modctx + (size_t)l * 6144 + 2048};
            pg8::gemm_phase<pg8::EpiResid>(F.lds, g, S, E, F.tid); }
        SEAM(pb + 4);
        if (l == 0) {
            if (INK(7, 1)) { for (int r_ = 0; r_ < REPS(1); ++r_) phase_norm(F, 0, 1, nullptr, xb, ctxx, MROWS, SlabRed{(const float*)(F.ws + WS_SLABA), pg8::split_factor((MROWS / 256) * 4, F.G, D / 64, MAXSLAB_A), modctx + 2048, F.pa->in[I_CTX], ctxx}); } SEAM(7);
            if (INK(8, 7)) { pg8::Gemm g{(const bf16_t*)(F.ws + WS_HX), (const bf16_t*)(F.ws + WS_WUP), 2 * DFF, D, 0, nullptr}; pg8::Order S; S.init(MROWS / 256, 2 * DFF / 256, F.G, F.bid, nullptr, nullptr, D / 64, false, 0);
                pg8::EpiSwiGLU E{(bf16_t*)(F.ws + WS_PA), DFF}; for (int r_ = 0; r_ < REPS(7); ++r_) pg8::gemm_phase<pg8::EpiSwiGLU>(F.lds, g, S, E, F.tid); }
            SEAM(8);
            if (INK(9, 8)) { pg8::Gemm g{(const bf16_t*)(F.ws + WS_PA), (const bf16_t*)(F.ws + WS_WDN), D, DFF, 0, (float*)(F.ws + WS_SLABA)}; pg8::Order S; S.init(MROWS / 256, D / 256, F.G, F.bid, nullptr, nullptr, DFF / 64, true, MAXSLAB_A);
                pg8::EpiResid E{nullptr, xb, (const float*)ctxx, ctxx, modlat + 5120, modctx + 5120}; pg8::gemm_phase<pg8::EpiResid>(F.lds, g, S, E, F.tid); }
            SEAM(9);
            if (INK(10, 1)) { for (int r_ = 0; r_ < REPS(1); ++r_) phase_norm(F, 1, 0, nullptr, xb, ctxx, MROWS, SlabRed{(const float*)(F.ws + WS_SLABA), pg8::split_factor((MROWS / 256) * 4, F.G, DFF / 64, MAXSLAB_A), modctx + 5120, ctxx, ctxx}); } SEAM(10);
        }
    }
    if (INK(16, 9)) { for (int r_ = 0; r_ < REPS(9); ++r_) { phase_norm_router(F, xb); __syncthreads(); phase_convert_moe(F); __syncthreads(); } } SEAM(16);
    if (INK(17, 10)) { phase_moe_sort(F); } SEAM(17);
#pragma unroll 1
    for (int k = 0; k < 2; ++k) {
        const int* meta = (const int*)(F.ws + MOE_META) + 9 * k;
        if (INK(18 + 2 * k, 11)) { if (k == 1) { moe_reduce(F, 0); __syncthreads(); } pg8::Gemm g{(const bf16_t*)(F.ws + WS_HX), (const bf16_t*)(F.ws + WS_MOEUP), 2 * DEXP, D, (size_t)2 * DEXP * D * 2, nullptr}; pg8::Order S; S.init(meta[8], 2 * DEXP / 256, F.G, F.bid, meta, (const int*)(F.ws + MOE_PTOK) + k * MROWS, D / 64, false, 0);
            pg8::EpiSwiGLU E{(bf16_t*)(F.ws + WS_PA), DEXP}; for (int r_ = 0; r_ < REPS(11); ++r_) pg8::gemm_phase<pg8::EpiSwiGLU>(F.lds, g, S, E, F.tid); }
        SEAM(18 + 2 * k);
        if (INK(19 + 2 * k, 12)) { pg8::Gemm g{(const bf16_t*)(F.ws + WS_PA), (const bf16_t*)(F.ws + WS_MOEDN), D, DEXP, (size_t)D * DEXP * 2, (float*)(F.ws + WS_SLABM)}; pg8::Order S; S.init(meta[8], D / 256, F.G, F.bid, meta, nullptr, DEXP / 64, true, MAXSLAB_M);
            pg8::EpiMoeDown E{xb, (const int*)(F.ws + MOE_PTOK) + k * MROWS, (const float*)(F.ws + MOE_PW) + k * MROWS, modlat + (size_t)8 * 6144 + 5120}; pg8::gemm_phase<pg8::EpiMoeDown>(F.lds, g, S, E, F.tid); }
        SEAM(19 + 2 * k);
    }
    if (INK(22, 13)) phase_final_a(F);
    SEAM(22);
    if (INK(23, 13)) phase_final_b(F);
#undef IN
#undef INK
#undef SEAM
}

extern "C" void kernel_launch(void* const* d_in, const int* in_sizes, int n_in, void* d_out, int out_size, void* d_ws, size_t ws_size, hipStream_t stream) {
    static int grid = 0;
    if (grid == 0) {
        if (n_in != 27 || in_sizes[0] != NLAT * D || out_size != NLAT * D || ws_size < WS_END) { fprintf(stderr, "kernel_launch: unexpected problem (n_in %d, in0 %d, out %d, ws %zu, need %zu); nothing launched\n", n_in, n_in > 0 ? in_sizes[0] : -1, out_size, ws_size, (size_t)WS_END); grid = -1; return; }
        int dev = 0, cus = 0, per_cu = 0;
        if (hipGetDevice(&dev) != hipSuccess || hipDeviceGetAttribute(&cus, hipDeviceAttributeMultiprocessorCount, dev) != hipSuccess) { grid = -1; return; }
        if (hipFuncSetAttribute((const void*)fwd_kernel, hipFuncAttributeMaxDynamicSharedMemorySize, LDS_BYTES) != hipSuccess) { fprintf(stderr, "kernel_launch: hipFuncSetAttribute failed\n"); grid = -1; return; }
        if (hipOccupancyMaxActiveBlocksPerMultiprocessor(&per_cu, (const void*)fwd_kernel, NTHREADS, LDS_BYTES) != hipSuccess || per_cu < 1) { fprintf(stderr, "kernel_launch: occupancy query says %d\n", per_cu); }
        (void)hipGetLastError();
        grid = cus;
    }
    if (grid < 0) return;
    (void)hipMemsetAsync((char*)d_ws + WS_CTL, 0, CTL_ZERO_BYTES, stream);
    Args a; memset(&a, 0, sizeof(a));
    for (int i = 0; i < 27; ++i) a.in[i] = (const float*)d_in[i];
    a.out = (float*)d_out; a.ws = (unsigned char*)d_ws;
#if MK_ONE_LAUNCH
    a.ph_lo = 0; a.ph_hi = N_PHASES;
    hipLaunchKernelGGL(fwd_kernel, dim3(grid), dim3(NTHREADS), LDS_BYTES, stream, a);
#else
    for (int p = 0; p < N_PHASES; ++p) { a.ph_lo = p; a.ph_hi = p + 1; hipLaunchKernelGGL(fwd_kernel, dim3(grid), dim3(NTHREADS), LDS_BYTES, stream, a); }
#endif
}
```

```cpp
#include <hip/hip_runtime.h>
#include <cstdio>
#include <cstdint>
#include <cstring>

#ifndef MK_ONE_LAUNCH
#define MK_ONE_LAUNCH 1
#endif

#define GAS __attribute__((address_space(1)))
#define LAS __attribute__((address_space(3)))
typedef unsigned short bf16_t;
typedef short bf16x8 __attribute__((ext_vector_type(8)));
typedef float f32x4 __attribute__((ext_vector_type(4)));
typedef float f32x2 __attribute__((ext_vector_type(2)));
typedef unsigned u32x4 __attribute__((ext_vector_type(4)));
typedef unsigned u32x2 __attribute__((ext_vector_type(2)));
typedef LAS unsigned char* ldsp_t;

constexpr int D = 1024, NB = 8, SEQ = 4096, NLAT = NB * SEQ, CTXL = 256, NCTX = NB * CTXL, MROWS = NLAT + NCTX;
constexpr int INW = 3072, NH = 4, HD = 128, CHK = 128;
constexpr int DFF = 2816, NE = 8, DEXP = 3584;
constexpr int SPB = 34;
constexpr int NITEM = NB * SPB;
constexpr float EPS = 1e-6f;
constexpr int NWAVES = 8, NTHREADS = 512;

constexpr size_t MiB = 1u << 20;
constexpr size_t WS_CTL = 0, CTL_ZERO_BYTES = 64 * 1024;
constexpr size_t WS_MODLAT = 1 * MiB;
constexpr size_t WS_MODCTX = 1 * MiB + 2 * 8 * 6144 * 4;
constexpr size_t WS_ROPE = 2 * MiB;
constexpr size_t WS_RGW = 4 * MiB;
constexpr size_t WS_TOT = 5 * MiB;
constexpr size_t WS_CARRY = 8 * MiB;
constexpr size_t WS_MOE = 10 * MiB;
constexpr size_t MOE_CNT = WS_MOE, MOE_META = WS_MOE + 16384, MOE_TOKE = WS_MOE + 65536, MOE_TOKW = WS_MOE + 262144,
                 MOE_PTOK = WS_MOE + 524288, MOE_PW = WS_MOE + 1048576, MOE_PPOS = WS_MOE + 1572864;
constexpr size_t WS_CTXX = 12 * MiB;
constexpr size_t WS_WIN = 20 * MiB;
constexpr size_t WS_WOUT = 32 * MiB;
constexpr size_t WS_WUP = 36 * MiB;
constexpr size_t WS_WDN = 47 * MiB;
constexpr size_t WS_HX = 54 * MiB;
constexpr size_t WS_PA = 122 * MiB;
constexpr size_t WS_KV = 360 * MiB;
constexpr size_t WS_Y = 496 * MiB;
constexpr size_t WS_MOEUP = 360 * MiB;
constexpr size_t WS_MOEDN = 472 * MiB;
constexpr size_t WS_SLABA = WS_KV;
constexpr size_t WS_SLABM = 528 * MiB;
constexpr int MAXSLAB_A = 256, MAXSLAB_M = 216;
constexpr size_t XB_OFF = (size_t)NLAT * D * 2;
constexpr size_t WS_XCOPY = WS_PA;
constexpr size_t WS_END = 582 * MiB;
static_assert(WS_MOEDN + (size_t)NE * D * DEXP * 2 <= WS_END, "ws map");
static_assert(WS_PA + (size_t)MROWS * DEXP * 2 <= WS_KV, "ws map");

constexpr int LDS_SCRATCH = 147456;
constexpr int LDS_MISC = LDS_SCRATCH;
constexpr int LDS_DEC = LDS_MISC + 256;
constexpr int LDS_BYTES = LDS_SCRATCH + 8192;

__device__ __forceinline__ float bf2f(unsigned v) { return __uint_as_float(v << 16); }
typedef __bf16 bf16x2_t __attribute__((ext_vector_type(2)));
__device__ __forceinline__ unsigned pk2(float lo, float hi) { const f32x2 v = {lo, hi}; return __builtin_bit_cast(unsigned, __builtin_convertvector(v, bf16x2_t)); }
__device__ __forceinline__ unsigned f2bf(float f) { return pk2(f, f) & 0xffffu; }
__device__ __forceinline__ void unpack8(const u32x4 v, f32x4& a, f32x4& b) {
    a = (f32x4){bf2f(v.x & 0xffffu), __uint_as_float(v.x & 0xffff0000u), bf2f(v.y & 0xffffu), __uint_as_float(v.y & 0xffff0000u)};
    b = (f32x4){bf2f(v.z & 0xffffu), __uint_as_float(v.z & 0xffff0000u), bf2f(v.w & 0xffffu), __uint_as_float(v.w & 0xffff0000u)}; }
__device__ __forceinline__ u32x4 pack8(const f32x4 a, const f32x4 b) { return (u32x4){pk2(a.x, a.y), pk2(a.z, a.w), pk2(b.x, b.y), pk2(b.z, b.w)}; }
template <int M> __device__ __forceinline__ float swz_xor(float v) { return __int_as_float(__builtin_amdgcn_ds_swizzle(__float_as_int(v), (M << 10) | 0x1f)); }
__device__ __forceinline__ float wave_sum(float v) {
    v += swz_xor<1>(v); v += swz_xor<2>(v); v += swz_xor<4>(v); v += swz_xor<8>(v); v += swz_xor<16>(v);
    const auto r = __builtin_amdgcn_permlane32_swap(__float_as_uint(v), __float_as_uint(v), false, false);
    return __uint_as_float(r[0]) + __uint_as_float(r[1]);
}
__device__ __forceinline__ float lane_bcast(float v, int src_lane) { return __int_as_float(__builtin_amdgcn_ds_bpermute(src_lane << 2, __float_as_int(v))); }
__device__ __forceinline__ float sigmoidf_(float x) { return __builtin_amdgcn_rcpf(1.0f + __expf(-x)); }
__device__ __forceinline__ float siluf_(float x) { return x * __builtin_amdgcn_rcpf(1.0f + __expf(-x)); }
__device__ __forceinline__ float gelu_tanh(float x) { const float z = 0.7978845608028654f * (x + 0.044715f * x * x * x); return x * (1.0f - __builtin_amdgcn_rcpf(1.0f + __expf(2.0f * z))); }
#define LDS_WAIT() asm volatile("s_waitcnt lgkmcnt(0)" ::: "memory")
#define WG_BAR_LDS() do { asm volatile("s_waitcnt lgkmcnt(0)" ::: "memory"); __builtin_amdgcn_s_barrier(); asm volatile("" ::: "memory"); } while (0)
__device__ __forceinline__ f32x4 zero4() { float z; asm volatile("v_mov_b32 %0, 0" : "=v"(z)); return (f32x4){z, z, z, z}; }

template <typename T> __device__ __forceinline__ T ldg(const void* base, unsigned off) { return *(const GAS T*)((const GAS char*)base + off); }
template <typename T> __device__ __forceinline__ void stg(void* base, unsigned off, T v) { *(GAS T*)((GAS char*)base + off) = v; }
#define XB_TMO      128
#define XB_XCNT(j)  (256  + 64 * (j))
#define XB_XSUB(j)  (1280 + 64 * (j))
#define XB_XGEN(j)  (2304 + 64 * (j))
#define XB_TOP      3328
#define XB_TOPGEN   3392
#define XCD_BAR_WORDS 3456
#define XB_SPIN_CAP (1u << 18)
__device__ __forceinline__ unsigned xb_ld(unsigned* p)              { return __hip_atomic_load(p, __ATOMIC_RELAXED, __HIP_MEMORY_SCOPE_AGENT); }
__device__ __forceinline__ unsigned xb_add(unsigned* p, unsigned v) { return __hip_atomic_fetch_add(p, v, __ATOMIC_RELAXED, __HIP_MEMORY_SCOPE_AGENT); }
__device__ __forceinline__ unsigned xb_xcc_id() { return (unsigned)__builtin_amdgcn_s_getreg((3 << 11) | 20) & 0xFu; }
#define XB_SPIN(cond, bar) do { unsigned _sp = 0; while (cond) { __builtin_amdgcn_s_sleep(1); \
    if ((++_sp & 255u) == 0u) { if (xb_ld(&(bar)[XB_TMO])) break; if (_sp > XB_SPIN_CAP) { atomicAdd(&(bar)[XB_TMO], 1u); break; } } } } while (0)
struct XcdBarrier { unsigned* bar; unsigned x; volatile LAS unsigned* st; };
__device__ __forceinline__ XcdBarrier xcd_barrier_post(unsigned* bar, volatile LAS unsigned* st) {
    XcdBarrier b; b.bar = bar; b.x = xb_xcc_id(); b.st = st;
    if (threadIdx.x == 0) (void)xb_add(&bar[XB_XCNT(b.x)], 1u);
    return b;
}
__device__ __forceinline__ void xcd_barrier_complete(unsigned* bar, unsigned x, unsigned& nloc, unsigned& nx) {
    const unsigned G = gridDim.x * gridDim.y * gridDim.z;
    unsigned sum, cnt, mine, sp = 0u;
    for (;;) {
        sum = 0u; cnt = 0u; mine = 0u;
#pragma unroll
        for (unsigned j = 0; j < 16; ++j) { const unsigned c = xb_ld(&bar[XB_XCNT(j)]); sum += c; cnt += (c > 0u) ? 1u : 0u; mine = (j == x) ? c : mine; }
        if (sum == G) break;
        __builtin_amdgcn_s_sleep(1);
        if ((++sp & 255u) == 0u) { if (xb_ld(&bar[XB_TMO])) break; if (sp > XB_SPIN_CAP) { atomicAdd(&bar[XB_TMO], 1u); break; } }
    }
    nloc = mine > 0u ? mine : 1u; nx = cnt > 0u ? cnt : 1u;
}
__device__ __forceinline__ void xcd_barrier(const XcdBarrier& b) {
    asm volatile("s_waitcnt vmcnt(0)" ::: "memory");
    __syncthreads();
    if (threadIdx.x == 0) {
        unsigned* bar = b.bar;
        __builtin_amdgcn_s_waitcnt(0);
        unsigned nloc = b.st[0], nx = b.st[1];
        if (nloc == 0u) { xcd_barrier_complete(bar, b.x, nloc, nx); b.st[0] = nloc; b.st[1] = nx; }
        const unsigned old = xb_add(&bar[XB_XSUB(b.x)], 1u);
        const unsigned gen = old / nloc;
        if (old + 1u == (gen + 1u) * nloc) {
            __builtin_amdgcn_fence(__ATOMIC_RELEASE, "agent");
            asm volatile("s_waitcnt vmcnt(0)" ::: "memory");
            const unsigned og = xb_add(&bar[XB_TOP], 1u);
            const unsigned tg = og / nx;
            if (og + 1u == (tg + 1u) * nx) xb_add(&bar[XB_TOPGEN], 1u);
            else XB_SPIN(xb_ld(&bar[XB_TOPGEN]) == tg, bar);
            __builtin_amdgcn_fence(__ATOMIC_ACQUIRE, "agent");
            xb_add(&bar[XB_XGEN(b.x)], 1u);
            asm volatile("s_waitcnt vmcnt(0)" ::: "memory");
        } else {
            XB_SPIN(xb_ld(&bar[XB_XGEN(b.x)]) == gen, bar);
            __builtin_amdgcn_fence(__ATOMIC_ACQUIRE, "agent");
            asm volatile("s_waitcnt vmcnt(0)" ::: "memory");
        }
    }
    __syncthreads();
}

namespace pg8 {
constexpr int BM = 256, BK = 64, HALF = 128, HTB = HALF * BK * 2, STAGE_BYTES = 8 * HTB, NXCD = 8, WGM = 8;
__host__ __device__ __forceinline__ int lds_byte(int r, int c) { const int st = (r >> 4) * 2 + (c >> 5), rr = r & 15, cc = c & 31, ob = rr * 64 + cc * 2; return st * 1024 + (ob ^ (((ob >> 9) & 1) << 5)); }
__host__ __device__ __forceinline__ void stage_rc(int b, int& R, int& C) { const int st = b / 1024, sb = b % 1024, swz = sb ^ (((sb >> 9) & 1) << 5); R = (st >> 1) * 16 + swz / 64; C = (st & 1) * 32 + (swz % 64) / 2; }
__host__ __device__ __forceinline__ int perm32(int rho) { const int n = rho >> 4, i = rho & 15; return 8 * (i >> 2) + 4 * n + (i & 3); }

struct Unit { int pm, pn, e, kt0, nt, slab; };
struct Gemm { const bf16_t* A; const bf16_t* Bt; int N, K; size_t estride; float* slabs; };

__device__ __forceinline__ int split_factor(int U, int G, int ntiles, int maxslabs) {
    const int R = U % G; if (R == 0) return 1;
    int S = G / R; if (S > 8) S = 8; if (S > ntiles / 4) S = ntiles / 4; if (R * S > maxslabs) S = maxslabs / R;
    return S < 2 ? 1 : S;
}
struct Order {
    int nM, nN, G, c, ntiles, mainu, S, total; const int* segs; const int* rowmap;
    int sg1, sg2, sg3, sg4, sg5, sg6, sg7;
    __device__ __forceinline__ void init(int nM_, int nN_, int G_, int c_, const int* segs_, const int* rowmap_, int ntiles_, bool split, int maxslabs) {
        nM = nM_; nN = nN_; G = G_; c = c_; segs = segs_; rowmap = rowmap_; ntiles = ntiles_;
        sg1 = sg2 = sg3 = sg4 = sg5 = sg6 = sg7 = 0; if (segs_) { sg1 = segs_[1]; sg2 = segs_[2]; sg3 = segs_[3]; sg4 = segs_[4]; sg5 = segs_[5]; sg6 = segs_[6]; sg7 = segs_[7]; }
        const int U = nM * nN; S = split ? split_factor(U, G, ntiles, maxslabs) : 1; const int R = (S > 1) ? U % G : 0; mainu = U - R; total = mainu + R * S; }
    __device__ __forceinline__ bool next(int i, Unit& u) const {
        const long L = (long)i * G + c; if (L >= total) return false;
        int wgid; u.kt0 = 0; u.nt = ntiles; u.slab = -1;
        if (L < mainu) { wgid = (int)L; const int q = mainu / NXCD, r = mainu % NXCD, xcd = wgid % NXCD, off = wgid / NXCD; wgid = (xcd < r ? xcd * (q + 1) : r * (q + 1) + (xcd - r) * q) + off; }
        else { const int sub = (int)L - mainu, lu = sub / S, sl = sub - lu * S, pairs = ntiles / 2, p0 = (sl * pairs) / S, p1 = ((sl + 1) * pairs) / S;
            wgid = mainu + lu; u.kt0 = 2 * p0; u.nt = 2 * (p1 - p0); u.slab = sub; }
        const int nig = WGM * nN, gid = wgid / nig, fm = gid * WGM, gsz = (nM - fm) < WGM ? (nM - fm) : WGM;
        u.pm = fm + ((wgid % nig) % gsz); u.pn = (wgid % nig) / gsz; u.e = 0;
        if (segs) u.e = (u.pm >= sg1) + (u.pm >= sg2) + (u.pm >= sg3) + (u.pm >= sg4) + (u.pm >= sg5) + (u.pm >= sg6) + (u.pm >= sg7);
        return true;
    }
    __device__ __forceinline__ int arow(const Unit& u, int r) const {
        if (rowmap) { const int t = rowmap[u.pm * BM + r]; return t < 0 ? 0 : t; }
        return u.pm * BM + r;
    }
};

__device__ __forceinline__ unsigned cvt_pk_bf16(float lo, float hi) { return pk2(lo, hi); }

struct EpiBf16 {
    static constexpr bool PERM = true, SPLIT = false;
    bf16_t* O; int ldc;
    __device__ __forceinline__ void operator()(const f32x4 (&acc)[2][2][4][2], const Unit& u, int wr, int wc, int fr, int fq) const {
        asm volatile("" : "+v"(fr), "+v"(fq));
        const int row0 = u.pm * BM + wr * 64 + fr, col0 = u.pn * BM + wc * 32 + 8 * fq;
#pragma unroll
        for (int ai = 0; ai < 2; ++ai)
#pragma unroll
            for (int m = 0; m < 4; ++m) { bf16_t* rowp = O + (size_t)(row0 + ai * HALF + m * 16) * ldc + col0;
#pragma unroll
                for (int bj = 0; bj < 2; ++bj) { const f32x4 v0 = acc[ai][bj][m][0], v1 = acc[ai][bj][m][1];
                    u32x4 w; w.x = cvt_pk_bf16(v0[0], v0[1]); w.y = cvt_pk_bf16(v0[2], v0[3]); w.z = cvt_pk_bf16(v1[0], v1[1]); w.w = cvt_pk_bf16(v1[2], v1[3]);
                    *(u32x4*)(rowp + bj * HALF) = w; } }
    }
};
struct EpiSwiGLU {
    static constexpr bool PERM = true, SPLIT = false;
    bf16_t* O; int ldc;
    __device__ __forceinline__ void operator()(const f32x4 (&acc)[2][2][4][2], const Unit& u, int wr, int wc, int fr, int fq) const {
        asm volatile("" : "+v"(fr), "+v"(fq));
        const int row0 = u.pm * BM + wr * 64 + fr, col0 = u.pn * HALF + wc * 32 + 8 * fq;
#pragma unroll
        for (int ai = 0; ai < 2; ++ai)
#pragma unroll
            for (int m = 0; m < 4; ++m) { bf16_t* rowp = O + (size_t)(row0 + ai * HALF + m * 16) * ldc + col0;
                float o[8];
#pragma unroll
                for (int n = 0; n < 2; ++n)
#pragma unroll
                    for (int j = 0; j < 4; ++j) { const float a = acc[ai][0][m][n][j], b = acc[ai][1][m][n][j]; o[n * 4 + j] = (a * __builtin_amdgcn_rcpf(1.0f + __expf(-a))) * b; }
                u32x4 w; w.x = cvt_pk_bf16(o[0], o[1]); w.y = cvt_pk_bf16(o[2], o[3]); w.z = cvt_pk_bf16(o[4], o[5]); w.w = cvt_pk_bf16(o[6], o[7]);
                *(u32x4*)rowp = w; }
    }
};
struct EpiResid {
    static constexpr bool PERM = true, SPLIT = true;
    const float* src_f32; bf16_t* xb; const float* src_ctx; float* dst_ctx; const float* gate_lat; const float* gate_ctx;
    __device__ __forceinline__ void operator()(const f32x4 (&acc)[2][2][4][2], const Unit& u, int wr, int wc, int fr, int fq) const {
        asm volatile("" : "+v"(fr), "+v"(fq));
        const int prow = u.pm * BM; const bool lat = prow < NLAT;
        const float* gate = lat ? gate_lat + (size_t)(prow / SEQ) * 6144 : gate_ctx;
        const int r0 = wr * 64 + fr, col0 = u.pn * BM + wc * 32 + 8 * fq;
        f32x4 gv[2][2];
#pragma unroll
        for (int bj = 0; bj < 2; ++bj)
#pragma unroll
            for (int n = 0; n < 2; ++n) gv[bj][n] = *(const f32x4*)(gate + col0 + bj * HALF + 4 * n);
        if (lat) {
#pragma unroll
            for (int ai = 0; ai < 2; ++ai)
#pragma unroll
                for (int m = 0; m < 4; ++m) { const size_t off = (size_t)(prow + r0 + ai * HALF + m * 16) * D + col0;
#pragma unroll
                    for (int bj = 0; bj < 2; ++bj) { f32x4 s0, s1;
                        if (src_f32) { s0 = *(const f32x4*)(src_f32 + off + bj * HALF); s1 = *(const f32x4*)(src_f32 + off + bj * HALF + 4); }
                        else unpack8(*(const u32x4*)(xb + off + bj * HALF), s0, s1);
                        *(u32x4*)(xb + off + bj * HALF) = pack8(s0 + gv[bj][0] * acc[ai][bj][m][0], s1 + gv[bj][1] * acc[ai][bj][m][1]); }
                    if (m == 3) asm volatile("" ::: "memory"); }
        } else {
            const float* src = src_ctx + (size_t)(prow - NLAT) * D; float* dst = dst_ctx + (size_t)(prow - NLAT) * D;
#pragma unroll
            for (int ai = 0; ai < 2; ++ai)
#pragma unroll
                for (int m = 0; m < 4; ++m) { const size_t off = (size_t)(r0 + ai * HALF + m * 16) * D + col0;
#pragma unroll
                    for (int bj = 0; bj < 2; ++bj)
#pragma unroll
                        for (int n = 0; n < 2; ++n) { const f32x4 sv = *(const f32x4*)(src + off + bj * HALF + 4 * n); *(f32x4*)(dst + off + bj * HALF + 4 * n) = sv + gv[bj][n] * acc[ai][bj][m][n]; }
                    asm volatile("" ::: "memory"); }
        }
    }
};
struct EpiMoeDown {
    static constexpr bool PERM = true, SPLIT = true;
    bf16_t* xb; const int* ptok; const float* pw; const float* gate_lat;
    __device__ __forceinline__ void operator()(const f32x4 (&acc)[2][2][4][2], const Unit& u, int wr, int wc, int fr, int fq) const {
        asm volatile("" : "+v"(fr), "+v"(fq));
        const int r0 = u.pm * BM + wr * 64 + fr, col0 = u.pn * BM + wc * 32 + 8 * fq;
        int tk[8]; float wk[8];
#pragma unroll
        for (int i = 0; i < 8; ++i) { const int r = r0 + (i >> 2) * HALF + (i & 3) * 16; tk[i] = ptok[r]; wk[i] = pw[r]; }
#pragma unroll
        for (int ai = 0; ai < 2; ++ai)
#pragma unroll
            for (int m = 0; m < 4; ++m) { const int tok = tk[ai * 4 + m]; const float w = wk[ai * 4 + m];
                if (tok >= 0) { bf16_t* xr = xb + (size_t)tok * D + col0; const float* gate = gate_lat + (size_t)(tok / SEQ) * 6144 + col0;
#pragma unroll
                    for (int bj = 0; bj < 2; ++bj) { const f32x4 g0 = *(const f32x4*)(gate + bj * HALF), g1 = *(const f32x4*)(gate + bj * HALF + 4); f32x4 s0, s1; unpack8(*(const u32x4*)(xr + bj * HALF), s0, s1);
                        *(u32x4*)(xr + bj * HALF) = pack8(s0 + (g0 * w) * acc[ai][bj][m][0], s1 + (g1 * w) * acc[ai][bj][m][1]); } }
                if (m & 1) asm volatile("" ::: "memory"); }
    }
};

template <class Epi>
__device__ __forceinline__ void gemm_phase(ldsp_t lds, const Gemm g, const Order& S, const Epi& E, const int tid) {
    const int wid = __builtin_amdgcn_readfirstlane(tid >> 6), lane = tid & 63, wr = wid >> 2, wc = wid & 3, fr = lane & 15, fq = lane >> 4;
    const int K = g.K;
    unsigned voffB[2];
#pragma unroll
    for (int i = 0; i < 2; ++i) { int R, C; stage_rc(tid * 16 + i * 8192, R, C); const int Rb = Epi::PERM ? ((R & ~31) + perm32(R & 31)) : R;
        voffB[i] = (unsigned)(Rb * K + C) * 2u; }
    const size_t kstep = (size_t)(BK * 2);
    const size_t hstep = (size_t)HALF * K * 2;
    const size_t tstep = 2 * hstep;
    const unsigned ldsw = (unsigned)wid * 1024u;
    const int aoff = lds_byte(wr * 64 + fr, fq * 8), boff = lds_byte(wc * 32 + fr, fq * 8);
#define PG8_SA(b, h) (((b) * 2 + (h)) * HTB)
#define PG8_SB(b, h) ((4 + (b) * 2 + (h)) * HTB)
#define PG8_STAGE_B(bufoff, gbase) do { _Pragma("unroll") for (int _i = 0; _i < 2; ++_i) \
        __builtin_amdgcn_global_load_lds((const unsigned*)((const char*)(gbase) + voffB[_i]), (LAS unsigned*)(lds + (bufoff) + ldsw + _i * 8192), 16, 0, 0); } while (0)
#define PG8_STAGE_A(bufoff, gbase, o0, o1) do { \
        __builtin_amdgcn_global_load_lds((const unsigned*)((const char*)(gbase) + (o0)), (LAS unsigned*)(lds + (bufoff) + ldsw), 16, 0, 0); \
        __builtin_amdgcn_global_load_lds((const unsigned*)((const char*)(gbase) + (o1)), (LAS unsigned*)(lds + (bufoff) + ldsw + 8192), 16, 0, 0); } while (0)
#define PG8_LDA(dst, b, h) do { _Pragma("unroll") for (int m = 0; m < 4; ++m) _Pragma("unroll") for (int k = 0; k < 2; ++k) dst[m][k] = *(const LAS bf16x8*)(lds + PG8_SA(b, h) + aoff + m * 2048 + k * 1024); } while (0)
#define PG8_LDB(dst, b, h) do { _Pragma("unroll") for (int n = 0; n < 2; ++n) _Pragma("unroll") for (int k = 0; k < 2; ++k) dst[n][k] = *(const LAS bf16x8*)(lds + PG8_SB(b, h) + boff + n * 2048 + k * 1024); } while (0)
#define PG8_MMA(ai, bj, At, Bt) do { __builtin_amdgcn_s_setprio(1); _Pragma("unroll") for (int m = 0; m < 4; ++m) _Pragma("unroll") for (int n = 0; n < 2; ++n) _Pragma("unroll") for (int k = 0; k < 2; ++k) \
        acc[ai][bj][m][n] = __builtin_amdgcn_mfma_f32_16x16x32_bf16(Bt[n][k], At[m][k], acc[ai][bj][m][n], 0, 0, 0); __builtin_amdgcn_s_setprio(0); } while (0)
#define PG8_WAIT_V(n) asm volatile("s_waitcnt vmcnt(" #n ")" ::: "memory")
#define PG8_WAIT_L(n) asm volatile("s_waitcnt lgkmcnt(" #n ")" ::: "memory")
#define PG8_BAR __builtin_amdgcn_s_barrier()
#define PG8_SCHED __builtin_amdgcn_sched_barrier(0)
#define PG8_AOFFS(u, o00, o01, o10, o11) do { int R0_, C0_, R1_, C1_; stage_rc(tid * 16, R0_, C0_); stage_rc(tid * 16 + 8192, R1_, C1_); \
        o00 = (unsigned)(S.arow(u, R0_) * K + C0_ + (u).kt0 * BK) * 2u; o01 = (unsigned)(S.arow(u, R1_) * K + C1_ + (u).kt0 * BK) * 2u; \
        o10 = (unsigned)(S.arow(u, HALF + R0_) * K + C0_ + (u).kt0 * BK) * 2u; o11 = (unsigned)(S.arow(u, HALF + R1_) * K + C1_ + (u).kt0 * BK) * 2u; } while (0)
    Unit cur, nxt; int ui = 0;
    if (!S.next(0, cur)) return;
    f32x4 acc[2][2][4][2];
    { float z_; asm volatile("v_mov_b32 %0, 0" : "=v"(z_));
#pragma unroll
    for (int a = 0; a < 2; ++a)
#pragma unroll
        for (int b = 0; b < 2; ++b)
#pragma unroll
            for (int m = 0; m < 4; ++m)
#pragma unroll
                for (int n = 0; n < 2; ++n) acc[a][b][m][n] = (f32x4){z_, z_, z_, z_}; }
    bf16x8 At[4][2], B0[2][2], B1[2][2];
    const char* const Abase = (const char*)g.A;
    const char* cB = (const char*)g.Bt + (size_t)cur.e * g.estride + (size_t)cur.pn * tstep + (size_t)cur.kt0 * kstep;
    unsigned c00, c01, c10, c11;
    PG8_AOFFS(cur, c00, c01, c10, c11);
    PG8_STAGE_B(PG8_SB(0, 0), cB); PG8_STAGE_B(PG8_SB(0, 1), cB + hstep); PG8_STAGE_A(PG8_SA(0, 0), Abase, c00, c01); PG8_STAGE_A(PG8_SA(0, 1), Abase, c10, c11);
    if (wr == 1) PG8_BAR;
    PG8_WAIT_V(2); PG8_BAR;
    PG8_STAGE_B(PG8_SB(1, 0), cB + kstep); PG8_STAGE_A(PG8_SA(1, 0), Abase + kstep, c00, c01); PG8_STAGE_B(PG8_SB(1, 1), cB + hstep + kstep);
    PG8_WAIT_V(6); PG8_BAR;
    for (;;) {
        const bool has_next = S.next(ui + 1, nxt);
        const char* nB = has_next ? (const char*)g.Bt + (size_t)nxt.e * g.estride + (size_t)nxt.pn * tstep + (size_t)nxt.kt0 * kstep : cB;
        const int nt = cur.nt;
        int rn0 = 0, rn1 = 0, rn2 = 0, rn3 = 0;
        if (S.rowmap && has_next) { int R0_, C0_, R1_, C1_; stage_rc(tid * 16, R0_, C0_); stage_rc(tid * 16 + 8192, R1_, C1_);
            rn0 = S.arow(nxt, R0_); rn1 = S.arow(nxt, R1_); rn2 = S.arow(nxt, HALF + R0_); rn3 = S.arow(nxt, HALF + R1_); }
        for (int t = 0; t < nt; t += 2) {
            const bool last = (t == nt - 2);
            const char* a1 = Abase + (size_t)(t + 1) * kstep;
            const char* a2 = last ? Abase : Abase + (size_t)(t + 2) * kstep; const char* b2 = last ? nB : cB + (size_t)(t + 2) * kstep;
            const char* a3 = a2 + kstep; const char* b3 = b2 + kstep;
            PG8_LDB(B0, 0, 0); PG8_LDB(B1, 0, 1); PG8_SCHED; PG8_LDA(At, 0, 0); PG8_STAGE_A(PG8_SA(1, 1), a1, c10, c11);
            PG8_WAIT_V(8); PG8_WAIT_L(0); PG8_BAR; PG8_MMA(0, 0, At, B0); PG8_MMA(0, 1, At, B1); PG8_BAR; PG8_SCHED;
            if (last && has_next) {
                if (S.rowmap) { int R0_, C0_, R1_, C1_; stage_rc(tid * 16, R0_, C0_); stage_rc(tid * 16 + 8192, R1_, C1_);
                    c00 = (unsigned)(rn0 * K + C0_ + nxt.kt0 * BK) * 2u; c01 = (unsigned)(rn1 * K + C1_ + nxt.kt0 * BK) * 2u; c10 = (unsigned)(rn2 * K + C0_ + nxt.kt0 * BK) * 2u; c11 = (unsigned)(rn3 * K + C1_ + nxt.kt0 * BK) * 2u; }
                else { PG8_AOFFS(nxt, c00, c01, c10, c11); } }
            PG8_LDA(At, 0, 1); PG8_STAGE_B(PG8_SB(0, 0), b2); PG8_STAGE_B(PG8_SB(0, 1), b2 + hstep); PG8_STAGE_A(PG8_SA(0, 0), a2, c00, c01);
            PG8_WAIT_V(8); PG8_WAIT_L(0); PG8_BAR; PG8_MMA(1, 0, At, B0); PG8_MMA(1, 1, At, B1); PG8_BAR; PG8_SCHED;
            PG8_LDB(B0, 1, 0); PG8_LDB(B1, 1, 1); PG8_SCHED; PG8_LDA(At, 1, 0); PG8_STAGE_A(PG8_SA(0, 1), a2, c10, c11);
            PG8_WAIT_V(8); PG8_WAIT_L(0); PG8_BAR; PG8_MMA(0, 0, At, B0); PG8_MMA(0, 1, At, B1); PG8_BAR; PG8_SCHED;
            PG8_LDA(At, 1, 1); PG8_STAGE_B(PG8_SB(1, 0), b3); PG8_STAGE_B(PG8_SB(1, 1), b3 + hstep); PG8_STAGE_A(PG8_SA(1, 0), a3, c00, c01);
            PG8_WAIT_V(8); PG8_WAIT_L(0); PG8_BAR; PG8_MMA(1, 0, At, B0); PG8_MMA(1, 1, At, B1); PG8_BAR; PG8_SCHED;
        }
        if (wr == 0) PG8_BAR;
        if (Epi::SPLIT && cur.slab >= 0) {
            int fr_ = fr, fq_ = fq; asm volatile("" : "+v"(fr_), "+v"(fq_));
            float* sp = g.slabs + (size_t)cur.slab * 65536 + (size_t)(wr * 64 + fr_) * 256 + wc * 32 + (Epi::PERM ? 8 : 4) * fq_;
#pragma unroll
            for (int ai = 0; ai < 2; ++ai)
#pragma unroll
                for (int m = 0; m < 4; ++m)
#pragma unroll
                    for (int bj = 0; bj < 2; ++bj)
#pragma unroll
                        for (int n = 0; n < 2; ++n) *(f32x4*)(sp + (ai * HALF + m * 16) * 256 + bj * HALF + n * (Epi::PERM ? 4 : 16)) = acc[ai][bj][m][n];
        } else E(acc, cur, wr, wc, fr, fq);
        if (!has_next) break;
        { float z_; asm volatile("v_mov_b32 %0, 0" : "=v"(z_));
#pragma unroll
        for (int a = 0; a < 2; ++a)
#pragma unroll
            for (int b = 0; b < 2; ++b)
#pragma unroll
                for (int m = 0; m < 4; ++m)
#pragma unroll
                    for (int n = 0; n < 2; ++n) acc[a][b][m][n] = (f32x4){z_, z_, z_, z_}; }
        cur = nxt; cB = nB; ++ui;
        if (wr == 1) PG8_BAR;
    }
    PG8_WAIT_V(0);
    PG8_BAR;
#undef PG8_SA
#undef PG8_SB
#undef PG8_STAGE_A
#undef PG8_STAGE_B
#undef PG8_LDA
#undef PG8_LDB
#undef PG8_MMA
#undef PG8_WAIT_V
#undef PG8_WAIT_L
#undef PG8_BAR
#undef PG8_SCHED
#undef PG8_AOFFS
}
}

struct Args { const float* in[27]; float* out; unsigned char* ws; int ph_lo, ph_hi; };
struct Frame {
    ldsp_t lds; int tid, lane, wave, wave0, G, bid;
    const Args* pa; float* out; unsigned char* ws;
    const Args* pa0; float* out0; unsigned char* ws0;
};
enum { I_X = 0, I_C, I_CTX, I_CCTX, I_WMOD, I_BMOD, I_GMIX, I_GFFN, I_GFINAL, I_WIN, I_WOUT, I_CONVW, I_CONVB, I_RGWA, I_RGBA, I_RGWX, I_RGBX, I_RGLAM, I_RETDEC,
       I_FW1, I_FW3, I_FW2, I_MROUTER, I_MROUTERB, I_MW1, I_MW3, I_MW2 };

constexpr int TRS = 64 * 65 * 4;
struct TrItem { const float* W; bf16_t* WT; int ldw, k0, n0, ldt, drow0; float scale; };
__device__ __forceinline__ void tr_load(const TrItem& t, f32x4 (&v)[16], int lane) {
    const int r4 = lane >> 4, c4 = (lane & 15) * 4;
#pragma unroll
    for (int i = 0; i < 16; ++i) v[i] = *(const f32x4*)(t.W + (size_t)(t.k0 + 4 * i + r4) * t.ldw + t.n0 + c4);
}
__device__ __forceinline__ void tr_store(const TrItem& t, const f32x4 (&v)[16], LAS float* scr, int lane) {
    { const int r4 = lane >> 4, c4 = (lane & 15) * 4;
#pragma unroll
      for (int i = 0; i < 16; ++i) { LAS float* d = scr + (4 * i + r4) * 65 + c4; d[0] = v[i].x; d[1] = v[i].y; d[2] = v[i].z; d[3] = v[i].w; } }
    LDS_WAIT(); asm volatile("" ::: "memory");
    const int c = lane & 7; const float scale = t.scale;
#pragma unroll
    for (int j = 0; j < 8; ++j) { const int n = (lane >> 3) + 8 * j; const LAS float* sp = scr + (8 * c) * 65 + n;
        u32x4 o; o.x = pk2(sp[0 * 65] * scale, sp[1 * 65] * scale); o.y = pk2(sp[2 * 65] * scale, sp[3 * 65] * scale); o.z = pk2(sp[4 * 65] * scale, sp[5 * 65] * scale); o.w = pk2(sp[6 * 65] * scale, sp[7 * 65] * scale);
        *(u32x4*)(t.WT + (size_t)(t.drow0 + n) * t.ldt + t.k0 + 8 * c) = o; }
    LDS_WAIT(); asm volatile("" ::: "memory");
}
__device__ __forceinline__ TrItem up_item(const float* w1, const float* w3, int F, bf16_t* WT, int r) {
    const int per = 16 * (F / 64); const int which = r / per; r -= which * per;
    const int nblk = F / 64, kb = r / nblk, nb = r % nblk, n0 = nb * 64;
    return TrItem{which ? w3 : w1, WT, F, kb * 64, n0, D, (n0 / 128) * 256 + (n0 % 128) + which * 128, 1.0f};
}
__device__ __forceinline__ TrItem small_item(Frame& F, int r) {
    constexpr int I_IN = 16 * (INW / 64), I_OUT = 16 * (D / 64), I_UP = 2 * 16 * (DFF / 64);
    if (r < 2 * I_IN) { const int l = r / I_IN; r -= l * I_IN; const int nblk = INW / 64, kb = r / nblk, nb = r % nblk, n0 = nb * 64;
        const float sc = (n0 >= 1536 && n0 < 2048) ? 0.08838834764831845f : 1.0f;
        return TrItem{F.pa->in[I_WIN] + (size_t)l * D * INW, (bf16_t*)(F.ws + WS_WIN) + (size_t)l * INW * D, INW, kb * 64, n0, D, n0, sc}; }
    r -= 2 * I_IN;
    if (r < 2 * I_OUT) { const int l = r / I_OUT; r -= l * I_OUT; const int nblk = D / 64, kb = r / nblk, nb = r % nblk;
        return TrItem{F.pa->in[I_WOUT] + (size_t)l * D * D, (bf16_t*)(F.ws + WS_WOUT) + (size_t)l * D * D, D, kb * 64, nb * 64, D, nb * 64, 1.0f}; }
    r -= 2 * I_OUT;
    if (r < I_UP) return up_item(F.pa->in[I_FW1], F.pa->in[I_FW3], DFF, (bf16_t*)(F.ws + WS_WUP), r);
    r -= I_UP;
    { const int nblk = D / 64, kb = r / nblk, nb = r % nblk; return TrItem{F.pa->in[I_FW2], (bf16_t*)(F.ws + WS_WDN), D, kb * 64, nb * 64, DFF, nb * 64, 1.0f}; }
}
__device__ __forceinline__ TrItem moe_item(Frame& F, int it) {
    constexpr int I_UP = 2 * 16 * (DEXP / 64), I_DN = (DEXP / 64) * (D / 64), PER_E = I_UP + I_DN;
    const int e = it / PER_E; int r = it - e * PER_E;
    if (r < I_UP) return up_item(F.pa->in[I_MW1] + (size_t)e * D * DEXP, F.pa->in[I_MW3] + (size_t)e * D * DEXP, DEXP, (bf16_t*)(F.ws + WS_MOEUP) + (size_t)e * 2 * DEXP * D, r);
    r -= I_UP;
    { const int nblk = D / 64, kb = r / nblk, nb = r % nblk; return TrItem{F.pa->in[I_MW2] + (size_t)e * DEXP * D, (bf16_t*)(F.ws + WS_MOEDN) + (size_t)e * D * DEXP, D, kb * 64, nb * 64, DEXP, nb * 64, 1.0f}; }
}
__device__ __forceinline__ void phase_convert_small(Frame& F) {
    LAS float* scr = (LAS float*)(F.lds + F.wave * TRS);
    const int gw = F.bid * NWAVES + F.wave, NGW = F.G * NWAVES;
    constexpr int NITEMS = 2 * 16 * (INW / 64) + 2 * 16 * (D / 64) + 2 * 16 * (DFF / 64) + (DFF / 64) * (D / 64);
    if (gw < NITEMS) { TrItem cur = small_item(F, gw); f32x4 va[16], vb[16]; tr_load(cur, va, F.lane);
        for (int it = gw; it < NITEMS; it += 2 * NGW) {
            const bool h1 = it + NGW < NITEMS; TrItem n1 = cur; if (h1) { n1 = small_item(F, it + NGW); tr_load(n1, vb, F.lane); }
            tr_store(cur, va, scr, F.lane);
            if (!h1) break;
            const bool h2 = it + 2 * NGW < NITEMS; if (h2) { cur = small_item(F, it + 2 * NGW); tr_load(cur, va, F.lane); }
            tr_store(n1, vb, scr, F.lane);
            if (!h2) break; } }
    { const int gt = F.bid * NTHREADS + F.tid, NGT = F.G * NTHREADS; bf16_t* o = (bf16_t*)(F.ws + WS_RGW);
      for (int i = gt; i < 2 * 2 * 2 * 8 * 64 * 64; i += NGT) { const int c = i & 63, dp = (i >> 6) & 63, blk = (i >> 12) & 7, gate = (i >> 15) & 1, dir = (i >> 16) & 1, l = i >> 17;
          const float* src = gate ? F.pa->in[I_RGWX] : F.pa->in[I_RGWA]; o[i] = (bf16_t)f2bf(src[((((size_t)l * 2 + dir) * 8 + blk) * 64 + c) * 64 + dp]); } }
    { const int gt = F.bid * NTHREADS + F.tid, NGT = F.G * NTHREADS; float* ct = (float*)(F.ws + WS_ROPE); float* st = ct + 4096 * 64;
      for (int i = gt; i < 4096 * 64; i += NGT) { const int pos = i >> 6, fi = i & 63; const float p = (float)((fi < 32) ? (pos >> 6) : (pos & 63));
          const float inv = powf(10000.0f, -(float)(fi & 31) / 32.0f); const float ang = p * inv;
          const double a = (double)ang; const double kq = __builtin_rint(a * 0.63661977236758134308); const double rr = a - kq * 1.57079632679489661923; const int q = ((int)kq) & 3;
          const double r2 = rr * rr;
          const double sn = rr * (1.0 + r2 * (-1.0 / 6 + r2 * (1.0 / 120 + r2 * (-1.0 / 5040 + r2 * (1.0 / 362880 + r2 * (-1.0 / 39916800))))));
          const double cs = 1.0 + r2 * (-0.5 + r2 * (1.0 / 24 + r2 * (-1.0 / 720 + r2 * (1.0 / 40320 + r2 * (-1.0 / 3628800 + r2 * (1.0 / 479001600))))));
          const double c_ = (q == 0) ? cs : (q == 1) ? -sn : (q == 2) ? -cs : sn; const double s_ = (q == 0) ? sn : (q == 1) ? cs : (q == 2) ? -sn : -cs;
          ct[i] = (float)c_; st[i] = (float)s_; } }
}
struct MoeTile { const float* W; bf16_t* WT; int ldw, k0, n0, ldt, up; };
__device__ __forceinline__ MoeTile moe_tile(Frame& F, int t) {
    constexpr int T_UP1 = (D / 128) * (DEXP / 256), T_DN = (DEXP / 128) * (D / 256), PER_E = 2 * T_UP1 + T_DN;
    const int e = t / PER_E; int r = t - e * PER_E;
    if (r < 2 * T_UP1) { const int which = r / T_UP1; r -= which * T_UP1; const int nb = DEXP / 256, kb = r / nb, nn = r % nb;
        return MoeTile{(which ? F.pa->in[I_MW3] : F.pa->in[I_MW1]) + (size_t)e * D * DEXP, (bf16_t*)(F.ws + WS_MOEUP) + (size_t)e * 2 * DEXP * D, DEXP, kb * 128, nn * 256, D, 1 + which}; }
    r -= 2 * T_UP1;
    { const int nb = D / 256, kb = r / nb, nn = r % nb; return MoeTile{F.pa->in[I_MW2] + (size_t)e * DEXP * D, (bf16_t*)(F.ws + WS_MOEDN) + (size_t)e * D * DEXP, D, kb * 128, nn * 256, DEXP, 0}; }
}
__device__ __forceinline__ void moe_tile_load(const MoeTile& t, f32x4 (&v)[16], int wave, int lane) {
#pragma unroll
    for (int i = 0; i < 16; ++i) v[i] = *(const f32x4*)(t.W + (size_t)(t.k0 + 16 * wave + i) * t.ldw + t.n0 + 4 * lane);
}
__device__ __forceinline__ void moe_tile_store(Frame& F, const MoeTile& t, const f32x4 (&v)[16]) {
    LAS float* tile = (LAS float*)F.lds;
#pragma unroll
    for (int i = 0; i < 16; ++i) { const int k = 16 * F.wave + i, p = (4 * F.lane + 2 * (k >> 3)) & 255;
        *(LAS f32x2*)(tile + k * 256 + p) = (f32x2){v[i].x, v[i].y}; *(LAS f32x2*)(tile + k * 256 + ((p + 2) & 255)) = (f32x2){v[i].z, v[i].w}; }
    __syncthreads();
#pragma unroll
    for (int j = 0; j < 8; ++j) { const int task = F.tid + j * NTHREADS, c = task & 15, n = task >> 4; const LAS float* sp = tile + (8 * c) * 256 + ((n + 2 * c) & 255);
        u32x4 o; o.x = pk2(sp[0], sp[256]); o.y = pk2(sp[512], sp[768]); o.z = pk2(sp[1024], sp[1280]); o.w = pk2(sp[1536], sp[1792]);
        const int col = t.n0 + n; const int drow = t.up ? (col >> 7) * 256 + (col & 127) + 128 * (t.up - 1) : col;
        *(u32x4*)(t.WT + (size_t)drow * t.ldt + t.k0 + 8 * c) = o; }
    __syncthreads();
}
__device__ __forceinline__ void phase_convert_moe(Frame& F) {
    constexpr int NT = NE * (2 * (D / 128) * (DEXP / 256) + (DEXP / 128) * (D / 256));
    if (F.bid < NT) { MoeTile cur = moe_tile(F, F.bid); f32x4 va[16], vb[16]; moe_tile_load(cur, va, F.wave, F.lane);
        for (int t = F.bid; t < NT; t += 2 * F.G) {
            const bool h1 = t + F.G < NT; MoeTile n1 = cur; if (h1) { n1 = moe_tile(F, t + F.G); moe_tile_load(n1, vb, F.wave, F.lane); }
            moe_tile_store(F, cur, va);
            if (!h1) break;
            const bool h2 = t + 2 * F.G < NT; if (h2) { cur = moe_tile(F, t + 2 * F.G); moe_tile_load(cur, va, F.wave, F.lane); }
            moe_tile_store(F, n1, vb);
            if (!h2) break; } }
}
__device__ __forceinline__ void phase_mod(Frame& F) {
    LAS float* sc = (LAS float*)F.lds;
    LAS float* red = (LAS float*)(F.lds + 9 * 1024 * 4);
    for (int i = F.tid; i < 9 * 1024; i += NTHREADS) { const int r = i >> 10, k = i & 1023; const float v = (r < 8) ? F.pa->in[I_C][r * 1024 + k] : F.pa->in[I_CCTX][k]; sc[i] = v / (1.0f + __expf(-v)); }
    __syncthreads();
    for (int strip = F.bid; strip < 2 * 6144 / 64; strip += F.G) {
        const int l = strip / 96, j = (strip % 96) * 64 + F.lane;
        const float* w = F.pa->in[I_WMOD] + (size_t)l * 1024 * 6144 + j;
        float a[9];
#pragma unroll
        for (int r = 0; r < 9; ++r) a[r] = 0.f;
        const int k0 = F.wave * 128;
#pragma unroll 1
        for (int kk = k0; kk < k0 + 128; kk += 16) { float wv[16];
#pragma unroll
            for (int i = 0; i < 16; ++i) wv[i] = w[(size_t)(kk + i) * 6144];
#pragma unroll
            for (int i = 0; i < 16; ++i) {
#pragma unroll
                for (int r = 0; r < 9; ++r) a[r] += sc[r * 1024 + kk + i] * wv[i];
                if ((i & 3) == 3) __builtin_amdgcn_sched_barrier(0); } }
#pragma unroll
        for (int r = 0; r < 9; ++r) red[(F.wave * 9 + r) * 64 + F.lane] = a[r];
        __syncthreads();
        for (int i = F.tid; i < 9 * 64; i += NTHREADS) { const int r = i >> 6, jj = i & 63; float s = 0.f;
#pragma unroll
            for (int w8 = 0; w8 < 8; ++w8) s += red[(w8 * 9 + r) * 64 + jj];
            const int col = (strip % 96) * 64 + jj; s += F.pa->in[I_BMOD][l * 6144 + col];
            if (r < 8) ((float*)(F.ws + WS_MODLAT))[((size_t)l * 8 + r) * 6144 + col] = s; else ((float*)(F.ws + WS_MODCTX))[(size_t)l * 6144 + col] = s; }
        __syncthreads();
    }
}

__device__ __forceinline__ void norm_row(const u32x2 (&xw)[4], const f32x4 (&Am)[4], const f32x4 (&Sh)[4], bf16_t* orow, int lane, f32x4 (&y)[4]) {
    f32x4 v[4]; float ss = 0.f;
#pragma unroll
    for (int j = 0; j < 4; ++j) { const u32x2 w = xw[j]; v[j] = (f32x4){bf2f(w.x & 0xffffu), __uint_as_float(w.x & 0xffff0000u), bf2f(w.y & 0xffffu), __uint_as_float(w.y & 0xffff0000u)};
        ss += (v[j].x * v[j].x + v[j].y * v[j].y) + (v[j].z * v[j].z + v[j].w * v[j].w); }
    const float rstd = 1.0f / sqrtf(wave_sum(ss) * (1.0f / D) + EPS);
    u32x2* o8 = (u32x2*)orow + lane;
#pragma unroll
    for (int j = 0; j < 4; ++j) { y[j] = (v[j] * rstd) * Am[j] + Sh[j]; o8[64 * j] = (u32x2){pk2(y[j].x, y[j].y), pk2(y[j].z, y[j].w)}; }
}
struct SlabRed { const float* slab; int S; const float* gate; const float* xold; float* xnew; };
__device__ __forceinline__ void norm_row_v(f32x4 (&v)[4], const float* g, const float* shift, const float* scale, bf16_t* orow, int lane) {
    float ss = 0.f;
#pragma unroll
    for (int j = 0; j < 4; ++j) ss += (v[j].x * v[j].x + v[j].y * v[j].y) + (v[j].z * v[j].z + v[j].w * v[j].w);
    const float rstd = 1.0f / sqrtf(wave_sum(ss) * (1.0f / D) + EPS);
    u32x2* o8 = (u32x2*)orow + lane;
#pragma unroll
    for (int j = 0; j < 4; ++j) { const f32x4 gg = ((const f32x4*)g)[lane + 64 * j], sh = ((const f32x4*)shift)[lane + 64 * j], sl = ((const f32x4*)scale)[lane + 64 * j];
        const f32x4 y = (v[j] * rstd) * gg * (sl + 1.0f) + sh;
        u32x2 w; w.x = pk2(y.x, y.y); w.y = pk2(y.z, y.w); o8[64 * j] = w; }
}
__device__ __forceinline__ void phase_norm(Frame& F, int l, int sel, const float* xlat, const bf16_t* xb, const float* xctx, int nrows, const SlabRed sr) {
    const int gw = F.bid * NWAVES + F.wave, NGW = F.G * NWAVES;
    const float* g = (sel ? F.pa->in[I_GFFN] : F.pa->in[I_GMIX]) + l * D; const int so = sel ? 3072 : 0;
    bf16_t* HX = (bf16_t*)(F.ws + WS_HX);
    const int nlat = nrows < NLAT ? nrows : NLAT; const int per = (nlat + NGW - 1) / NGW, r_lo = gw * per, r_hi = (r_lo + per < nlat) ? r_lo + per : nlat;
    int curb = -1; f32x4 Am[4], Sh[4];
    for (int row0 = r_lo; row0 < r_hi; row0 += 4) {
        f32x4 v[4][4];
#pragma unroll
        for (int u = 0; u < 4; ++u) { const int row = (row0 + u < r_hi) ? row0 + u : row0;
            if (xb) { const u32x2* xr = (const u32x2*)(xb + (size_t)row * D) + F.lane;
#pragma unroll
                for (int j = 0; j < 4; ++j) { const u32x2 w = xr[64 * j]; v[u][j] = (f32x4){bf2f(w.x & 0xffffu), __uint_as_float(w.x & 0xffff0000u), bf2f(w.y & 0xffffu), __uint_as_float(w.y & 0xffff0000u)}; } }
            else { const f32x4* xr = (const f32x4*)(xlat + (size_t)row * D) + F.lane;
#pragma unroll
                for (int j = 0; j < 4; ++j) v[u][j] = xr[64 * j]; } }
#pragma unroll
        for (int u = 0; u < 4; ++u) { const int row = row0 + u; if (row >= r_hi) continue;
            const int b = row / SEQ;
            if (b != curb) { curb = b; const float* mod = (const float*)(F.ws + WS_MODLAT) + ((size_t)l * 8 + b) * 6144 + so;
#pragma unroll
                for (int j = 0; j < 4; ++j) { Am[j] = ((const f32x4*)g)[F.lane + 64 * j] * (((const f32x4*)(mod + 1024))[F.lane + 64 * j] + 1.0f); Sh[j] = ((const f32x4*)mod)[F.lane + 64 * j]; } }
            float ss = 0.f;
#pragma unroll
            for (int j = 0; j < 4; ++j) ss += (v[u][j].x * v[u][j].x + v[u][j].y * v[u][j].y) + (v[u][j].z * v[u][j].z + v[u][j].w * v[u][j].w);
            const float rstd = 1.0f / sqrtf(wave_sum(ss) * (1.0f / D) + EPS);
            u32x2* o8 = (u32x2*)(HX + (size_t)row * D) + F.lane;
#pragma unroll
            for (int j = 0; j < 4; ++j) { const f32x4 y = (v[u][j] * rstd) * Am[j] + Sh[j]; o8[64 * j] = (u32x2){pk2(y.x, y.y), pk2(y.z, y.w)}; } }
    }
    for (int row = NLAT + gw; row < nrows; row += NGW) {
        const float* mod = (const float*)(F.ws + WS_MODCTX) + (size_t)l * 6144;
        f32x4 v[4];
        if (sr.slab == nullptr) { const f32x4* xr = (const f32x4*)(xctx + (size_t)(row - NLAT) * D) + F.lane;
#pragma unroll
            for (int j = 0; j < 4; ++j) v[j] = xr[64 * j]; }
        else { const int rc = row - NLAT, pmr = rc >> 8, r = rc & 255;
#pragma unroll
            for (int j = 0; j < 4; ++j) { f32x4 a = zero4(); const float* sp = sr.slab + (size_t)((pmr + 8 * j) * sr.S) * 65536 + (size_t)r * 256 + 4 * F.lane;
                f32x4 t8[8];
#pragma unroll
                for (int q = 0; q < 8; ++q) t8[q] = *(const f32x4*)(sp + (size_t)(q < sr.S ? q : sr.S - 1) * 65536);
#pragma unroll
                for (int q = 0; q < 8; ++q) a += t8[q] * (q < sr.S ? 1.0f : 0.0f);
                v[j] = ((const f32x4*)(sr.xold + (size_t)rc * D))[F.lane + 64 * j] + ((const f32x4*)sr.gate)[F.lane + 64 * j] * a;
                ((f32x4*)(sr.xnew + (size_t)rc * D))[F.lane + 64 * j] = v[j]; } }
        norm_row_v(v, g, mod + so, mod + so + 1024, HX + (size_t)row * D, F.lane);
    }
}
__device__ __forceinline__ void moe_reduce(Frame& F, int k) {
    const int* meta = (const int*)(F.ws + MOE_META) + 9 * k; const int npan = meta[8], gsz = npan - 128;
    if (gsz <= 0) return;
    const int S = pg8::split_factor(npan * 4, F.G, DEXP / 64, MAXSLAB_M); if (S < 2) return;
    const int gw = F.bid * NWAVES + F.wave, NGW = F.G * NWAVES;
    const int* ptok = (const int*)(F.ws + MOE_PTOK) + k * MROWS; const float* pw = (const float*)(F.ws + MOE_PW) + k * MROWS;
    const float* slab = (const float*)(F.ws + WS_SLABM); const float* gate_lat = (const float*)(F.ws + WS_MODLAT) + (size_t)8 * 6144 + 5120;
    for (int rr = NLAT + gw; rr < npan * 256; rr += NGW) { const int tok = ptok[rr]; if (tok < 0) continue; const float w = pw[rr];
        const int pmr = (rr - NLAT) >> 8, r = rr & 255; u32x2* xr = (u32x2*)((bf16_t*)((char*)F.out + XB_OFF) + (size_t)tok * D); const f32x4* gt = (const f32x4*)(gate_lat + (size_t)(tok / SEQ) * 6144);
#pragma unroll
        for (int j = 0; j < 4; ++j) { f32x4 a = zero4(); const float* sp = slab + (size_t)((pmr + gsz * j) * S) * 65536 + (size_t)r * 256 + 4 * F.lane;
            { f32x4 t8[8];
#pragma unroll
              for (int q = 0; q < 8; ++q) t8[q] = *(const f32x4*)(sp + (size_t)(q < S ? q : S - 1) * 65536);
#pragma unroll
              for (int q = 0; q < 8; ++q) a += t8[q] * (q < S ? 1.0f : 0.0f); }
            const u32x2 xo = xr[F.lane + 64 * j]; const f32x4 xv = {bf2f(xo.x & 0xffffu), __uint_as_float(xo.x & 0xffff0000u), bf2f(xo.y & 0xffffu), __uint_as_float(xo.y & 0xffff0000u)};
            const f32x4 y = xv + (gt[F.lane + 64 * j] * w) * a; xr[F.lane + 64 * j] = (u32x2){pk2(y.x, y.y), pk2(y.z, y.w)}; } }
}
__device__ __forceinline__ void phase_norm_router(Frame& F, const bf16_t* xb) {
    constexpr int l = 1;
    LAS float* wr = (LAS float*)F.lds;
    LAS int* le = (LAS int*)(F.lds + 32768);
    for (int i = F.tid; i < 1024 * 8 / 4; i += NTHREADS) ((LAS f32x4*)wr)[i] = ((const f32x4*)F.pa->in[I_MROUTER])[i];
    __syncthreads();
    const float* g = F.pa->in[I_GFFN] + l * D; bf16_t* HX = (bf16_t*)(F.ws + WS_HX);
    int* toke = (int*)(F.ws + MOE_TOKE); float* tokw = (float*)(F.ws + MOE_TOKW);
    for (int wg = F.bid; wg < NLAT / 128; wg += F.G) {
        u32x2 nx[4]; f32x4 Am[4], Sh[4];
        { const float* mod = (const float*)(F.ws + WS_MODLAT) + ((size_t)l * 8 + (wg * 128) / SEQ) * 6144 + 3072;
#pragma unroll
          for (int j = 0; j < 4; ++j) { Am[j] = ((const f32x4*)g)[F.lane + 64 * j] * (((const f32x4*)(mod + 1024))[F.lane + 64 * j] + 1.0f); Sh[j] = ((const f32x4*)mod)[F.lane + 64 * j]; } }
        { const u32x2* xr = (const u32x2*)(xb + (size_t)(wg * 128 + F.wave * 16) * D) + F.lane;
#pragma unroll
          for (int j = 0; j < 4; ++j) nx[j] = xr[64 * j]; }
        for (int i = 0; i < 16; ++i) { const int tl = F.wave * 16 + i, row = wg * 128 + tl;
            u32x2 cx[4];
#pragma unroll
            for (int j = 0; j < 4; ++j) cx[j] = nx[j];
            { const int rn = (i < 15) ? row + 1 : row; const u32x2* xr = (const u32x2*)(xb + (size_t)rn * D) + F.lane;
#pragma unroll
              for (int j = 0; j < 4; ++j) nx[j] = xr[64 * j]; }
            f32x4 y[4]; norm_row(cx, Am, Sh, HX + (size_t)row * D, F.lane, y);
            float lg[8];
#pragma unroll
            for (int e = 0; e < 8; ++e) lg[e] = 0.f;
#pragma unroll
            for (int j = 0; j < 4; ++j)
#pragma unroll
                for (int q = 0; q < 4; ++q) { const int k = 4 * F.lane + 256 * j + q; const f32x4 w0 = *(const LAS f32x4*)(wr + k * 8), w1 = *(const LAS f32x4*)(wr + k * 8 + 4); const float yv = y[j][q];
                    lg[0] += yv * w0.x; lg[1] += yv * w0.y; lg[2] += yv * w0.z; lg[3] += yv * w0.w; lg[4] += yv * w1.x; lg[5] += yv * w1.y; lg[6] += yv * w1.z; lg[7] += yv * w1.w; }
#pragma unroll
            for (int e = 0; e < 8; ++e) lg[e] = wave_sum(lg[e]) + F.pa->in[I_MROUTERB][e];
            int e0 = 0; float v0 = lg[0];
#pragma unroll
            for (int e = 1; e < 8; ++e) if (lg[e] > v0) { v0 = lg[e]; e0 = e; }
            int e1 = -1; float v1 = -3.0e38f;
#pragma unroll
            for (int e = 0; e < 8; ++e) if (e != e0 && lg[e] > v1) { v1 = lg[e]; e1 = e; }
            const float w0 = 1.0f / (1.0f + __expf(v1 - v0));
            if (F.lane == 0) { toke[row] = e0 | (e1 << 8); tokw[2 * row] = w0; tokw[2 * row + 1] = 1.0f - w0; le[tl] = e0 | (e1 << 8); }
        }
        __syncthreads();
        if (F.tid < 16) { const int k = F.tid >> 3, e = F.tid & 7; int c = 0; for (int t = 0; t < 128; ++t) c += (((le[t] >> (8 * k)) & 0xff) == e) ? 1 : 0; ((int*)(F.ws + MOE_CNT))[wg * 16 + F.tid] = c; }
        __syncthreads();
    }
}
__device__ __forceinline__ void phase_moe_sort(Frame& F) {
    LAS int* tot = (LAS int*)F.lds;
    LAS int* pre = tot + 16;
    LAS int* seg = tot + 32;
    LAS int* le = tot + 64;
    const int* cnt = (const int*)(F.ws + MOE_CNT); const int* toke = (const int*)(F.ws + MOE_TOKE); const float* tokw = (const float*)(F.ws + MOE_TOKW);
    int* ptok = (int*)(F.ws + MOE_PTOK); float* pw = (float*)(F.ws + MOE_PW); int* meta = (int*)(F.ws + MOE_META);
    for (int wg = F.bid; wg < NLAT / 128; wg += F.G) {
        { LAS int* part = tot + 256;
          if (F.tid < 256) { const int col = F.tid & 15, pt = F.tid >> 4; int t = 0, p = 0;
#pragma unroll
              for (int i = 0; i < 16; ++i) { const int w = pt * 16 + i; const int c = cnt[w * 16 + col]; t += c; p += (w < wg) ? c : 0; }
              part[pt * 16 + col] = t; part[256 + pt * 16 + col] = p; }
          if (F.tid >= 256 && F.tid < 384) le[F.tid - 256] = toke[wg * 128 + F.tid - 256];
          __syncthreads();
          if (F.tid < 16) { int t = 0, p = 0;
#pragma unroll
              for (int pt = 0; pt < 16; ++pt) { t += part[pt * 16 + F.tid]; p += part[256 + pt * 16 + F.tid]; }
              tot[F.tid] = t; pre[F.tid] = p; } }
        __syncthreads();
        if (F.tid < 2) { int s = 0; for (int e = 0; e < 8; ++e) { seg[F.tid * 9 + e] = s; s += (tot[F.tid * 8 + e] + 255) & ~255; } seg[F.tid * 9 + 8] = s; }
        __syncthreads();
        if (F.tid < 256) { const int k = F.tid >> 7, t = F.tid & 127; const int e = (le[t] >> (8 * k)) & 0xff; int rank = 0; for (int u = 0; u < t; ++u) rank += (((le[u] >> (8 * k)) & 0xff) == e) ? 1 : 0;
            const int pos = seg[k * 9 + e] + pre[k * 8 + e] + rank; const int tok = wg * 128 + t; ptok[k * MROWS + pos] = tok; pw[k * MROWS + pos] = tokw[2 * tok + k]; ((int*)(F.ws + MOE_PPOS))[k * NLAT + tok] = pos; }
        if (wg < 16) { const int k = wg >> 3, e = wg & 7; const int a = seg[k * 9 + e] + tot[k * 8 + e], b = seg[k * 9 + e + 1]; for (int p = a + F.tid; p < b; p += NTHREADS) { ptok[k * MROWS + p] = -1; pw[k * MROWS + p] = 0.f; } }
        if (wg == 0 && F.tid < 18) meta[F.tid] = seg[F.tid] >> 8;
        __syncthreads();
    }
}
__device__ __forceinline__ void phase_final_a(Frame& F) {
    const int gw = F.bid * NWAVES + F.wave, NGW = F.G * NWAVES; const float* g = F.pa->in[I_GFINAL];
    const bf16_t* xb = (const bf16_t*)((const char*)F.out + XB_OFF); bf16_t* xc = (bf16_t*)(F.ws + WS_XCOPY);
    const int* meta = (const int*)(F.ws + MOE_META) + 9; const int npan = meta[8], gsz = npan - 128;
    const int S = (gsz > 0) ? pg8::split_factor(npan * 4, F.G, DEXP / 64, MAXSLAB_M) : 1;
    const int* ppos = (const int*)(F.ws + MOE_PPOS) + NLAT; const float* pw = (const float*)(F.ws + MOE_PW) + MROWS;
    const float* slab = (const float*)(F.ws + WS_SLABM); const float* gate_lat = (const float*)(F.ws + WS_MODLAT) + (size_t)8 * 6144 + 5120;
    for (int row0 = gw; row0 < NLAT; row0 += 4 * NGW) {
        u32x2 w[4][4]; int rr[4];
#pragma unroll
        for (int u = 0; u < 4; ++u) { const int row = (row0 + u * NGW < NLAT) ? row0 + u * NGW : row0; const u32x2* xr = (const u32x2*)(xb + (size_t)row * D) + F.lane; rr[u] = ppos[row];
#pragma unroll
            for (int j = 0; j < 4; ++j) w[u][j] = xr[64 * j]; }
#pragma unroll
        for (int u = 0; u < 4; ++u) { const int row = row0 + u * NGW; if (row >= NLAT) continue;
            f32x4 v[4];
#pragma unroll
            for (int j = 0; j < 4; ++j) v[j] = (f32x4){bf2f(w[u][j].x & 0xffffu), __uint_as_float(w[u][j].x & 0xffff0000u), bf2f(w[u][j].y & 0xffffu), __uint_as_float(w[u][j].y & 0xffff0000u)};
            if (S >= 2 && rr[u] >= NLAT) { const float wt = pw[rr[u]]; const int pmr = (rr[u] - NLAT) >> 8, r = rr[u] & 255; const f32x4* gt = (const f32x4*)(gate_lat + (size_t)(row / SEQ) * 6144);
#pragma unroll
                for (int j = 0; j < 4; ++j) { f32x4 a = zero4(); const float* sp = slab + (size_t)((pmr + gsz * j) * S) * 65536 + (size_t)r * 256 + 4 * F.lane;
                    { f32x4 t8[8];
#pragma unroll
                      for (int q = 0; q < 8; ++q) t8[q] = *(const f32x4*)(sp + (size_t)(q < S ? q : S - 1) * 65536);
#pragma unroll
                      for (int q = 0; q < 8; ++q) a += t8[q] * (q < S ? 1.0f : 0.0f); }
                    v[j] += (gt[F.lane + 64 * j] * wt) * a; } }
            if (row < NLAT / 2) { float ss = 0.f;
#pragma unroll
                for (int j = 0; j < 4; ++j) ss += (v[j].x * v[j].x + v[j].y * v[j].y) + (v[j].z * v[j].z + v[j].w * v[j].w);
                const float rstd = 1.0f / sqrtf(wave_sum(ss) * (1.0f / D) + EPS); f32x4* o = (f32x4*)(F.out + (size_t)row * D) + F.lane;
#pragma unroll
                for (int j = 0; j < 4; ++j) o[64 * j] = (v[j] * rstd) * ((const f32x4*)g)[F.lane + 64 * j]; }
            else { u32x2* o = (u32x2*)(xc + (size_t)(row - NLAT / 2) * D) + F.lane;
#pragma unroll
                for (int j = 0; j < 4; ++j) o[64 * j] = (u32x2){pk2(v[j].x, v[j].y), pk2(v[j].z, v[j].w)}; } }
    }
}
__device__ __forceinline__ void phase_final_b(Frame& F) {
    const int gw = F.bid * NWAVES + F.wave, NGW = F.G * NWAVES; const float* g = F.pa->in[I_GFINAL]; const bf16_t* xc = (const bf16_t*)(F.ws + WS_XCOPY);
    for (int row0 = NLAT / 2 + gw; row0 < NLAT; row0 += 4 * NGW) {
        u32x2 w[4][4];
#pragma unroll
        for (int u = 0; u < 4; ++u) { const int row = (row0 + u * NGW < NLAT) ? row0 + u * NGW : row0; const u32x2* xr = (const u32x2*)(xc + (size_t)(row - NLAT / 2) * D) + F.lane;
#pragma unroll
            for (int j = 0; j < 4; ++j) w[u][j] = xr[64 * j]; }
#pragma unroll
        for (int u = 0; u < 4; ++u) { const int row = row0 + u * NGW; if (row >= NLAT) continue;
            f32x4 v[4]; float ss = 0.f;
#pragma unroll
            for (int j = 0; j < 4; ++j) { v[j] = (f32x4){bf2f(w[u][j].x & 0xffffu), __uint_as_float(w[u][j].x & 0xffff0000u), bf2f(w[u][j].y & 0xffffu), __uint_as_float(w[u][j].y & 0xffff0000u)};
                ss += (v[j].x * v[j].x + v[j].y * v[j].y) + (v[j].z * v[j].z + v[j].w * v[j].w); }
            const float rstd = 1.0f / sqrtf(wave_sum(ss) * (1.0f / D) + EPS); f32x4* o = (f32x4*)(F.out + (size_t)row * D) + F.lane;
#pragma unroll
            for (int j = 0; j < 4; ++j) o[64 * j] = (v[j] * rstd) * ((const f32x4*)g)[F.lane + 64 * j]; }
    }
}

__device__ __forceinline__ bool fresh(Frame& F) {
    int l_ = (int)__builtin_amdgcn_mbcnt_hi(~0u, __builtin_amdgcn_mbcnt_lo(~0u, 0u)); asm volatile("" : "+v"(l_));
    int w_ = F.wave0; asm volatile("" : "+s"(w_));
    F.lane = l_; F.wave = w_; F.tid = w_ * 64 + l_;
    int b_ = blockIdx.x; asm volatile("" : "+s"(b_)); F.bid = b_;
    GAS unsigned char* w2_ = (GAS unsigned char*)F.ws0; asm volatile("" : "+s"(w2_)); F.ws = (unsigned char*)w2_;
    F.out = F.out0; F.pa = F.pa0;
    return true;
}
struct Item { int b, s, row0, seqbase, t0, seqlen; bool is_ctx; };
__device__ __forceinline__ Item item_info(int item) {
    Item it; it.b = item / SPB; it.s = item % SPB;
    if (it.s < 2) { it.is_ctx = true; it.seqbase = NLAT + it.b * CTXL; it.t0 = it.s * CHK; it.seqlen = CTXL; }
    else { it.is_ctx = false; it.seqbase = it.b * SEQ; it.t0 = (it.s - 2) * CHK; it.seqlen = SEQ; }
    it.row0 = it.seqbase + it.t0; return it;
}
constexpr int UCP = 144;
constexpr int TP = 272;
constexpr int TILEB = 128 * TP;
constexpr int VP = 288;
constexpr int TILEV = 128 * VP;

__device__ __forceinline__ unsigned tr_lane_addr(ldsp_t tile, int lane) { return (unsigned)(__SIZE_TYPE__)tile + (unsigned)((4 * (lane >> 4) + ((lane & 15) >> 2)) * VP + 8 * (lane & 3)); }
__device__ __forceinline__ bf16x8 mk_frag(u32x2 lo, u32x2 hi) { const u32x4 v = {lo.x, lo.y, hi.x, hi.y}; return __builtin_bit_cast(bf16x8, v); }
template <int OFF> __device__ __forceinline__ bf16x8 tr1(unsigned addr) {
    u32x2 a0, a1;
    asm volatile("ds_read_b64_tr_b16 %0, %2 offset:%3\n\tds_read_b64_tr_b16 %1, %2 offset:%4\n\ts_waitcnt lgkmcnt(0)" : "=&v"(a0), "=&v"(a1) : "v"(addr), "i"(OFF), "i"(OFF + 16 * VP) : "memory");
    return mk_frag(a0, a1);
}
template <int OFF> __device__ __forceinline__ void tr4(unsigned addr, bf16x8& f0, bf16x8& f1, bf16x8& f2, bf16x8& f3) {
    u32x2 a0, a1, b0, b1, c0, c1, d0, d1;
    asm volatile("ds_read_b64_tr_b16 %0, %8 offset:%9\n\tds_read_b64_tr_b16 %1, %8 offset:%10\n\tds_read_b64_tr_b16 %2, %8 offset:%11\n\tds_read_b64_tr_b16 %3, %8 offset:%12\n\t"
                 "ds_read_b64_tr_b16 %4, %8 offset:%13\n\tds_read_b64_tr_b16 %5, %8 offset:%14\n\tds_read_b64_tr_b16 %6, %8 offset:%15\n\tds_read_b64_tr_b16 %7, %8 offset:%16\n\ts_waitcnt lgkmcnt(0)"
                 : "=&v"(a0), "=&v"(a1), "=&v"(b0), "=&v"(b1), "=&v"(c0), "=&v"(c1), "=&v"(d0), "=&v"(d1)
                 : "v"(addr), "i"(OFF), "i"(OFF + 16 * VP), "i"(OFF + 32), "i"(OFF + 32 + 16 * VP), "i"(OFF + 64), "i"(OFF + 64 + 16 * VP), "i"(OFF + 96), "i"(OFF + 96 + 16 * VP) : "memory");
    f0 = mk_frag(a0, a1); f1 = mk_frag(b0, b1); f2 = mk_frag(c0, c1); f3 = mk_frag(d0, d1);
}

__device__ __forceinline__ void build_decay(Frame& F, int l) {
    LAS float* dec = (LAS float*)(F.lds + LDS_DEC);
    for (int i = F.tid; i < 2 * 4 * 132; i += NTHREADS) { const int n = i % 132, dh = i / 132; const float x = F.pa->in[I_RETDEC][l * 8 + dh]; const float lg = -log1pf(expf(-x)); dec[i] = expf((float)n * lg); }
}

struct RgStep { bf16x8 bwa[2], bwx[2]; float lam, ba, bx, carry; };
template <bool FINAL>
__device__ __forceinline__ void rg_load_step(RgStep& R, Frame& F, const bf16_t* wgt, int l, int dir, int item, int blk, int n, int lane) {
    const int fr = lane & 15, fq = lane >> 4;
    const bf16_t* wa = wgt + ((size_t)(0 * 8 + blk) * 64 + 16 * n + fr) * 64 + 8 * fq;
    const bf16_t* wx = wgt + ((size_t)(1 * 8 + blk) * 64 + 16 * n + fr) * 64 + 8 * fq;
    R.bwa[0] = *(const bf16x8*)wa; R.bwa[1] = *(const bf16x8*)(wa + 32); R.bwx[0] = *(const bf16x8*)wx; R.bwx[1] = *(const bf16x8*)(wx + 32);
    const int ch = blk * 64 + 16 * n + fr, pi = (l * 2 + dir) * 512 + ch;
    R.lam = F.pa->in[I_RGLAM][pi]; R.ba = F.pa->in[I_RGBA][pi]; R.bx = F.pa->in[I_RGBX][pi];
    R.carry = FINAL ? ((const float*)(F.ws + WS_CARRY))[((size_t)item * 2 + dir) * 512 + ch] : 0.f;
}
template <bool FINAL, int DIR>
__device__ __forceinline__ void rg_dir(ldsp_t ucw, const bf16x8 (&af)[8][2], const RgStep& R, int n, int lane, f32x4 (&hsum)[8], float& Atot, float& Htot) {
    const int fr = lane & 15, fq = lane >> 4;
    constexpr float L2E_ = 1.4426950408889634f;
    const float ba2 = -L2E_ * R.ba, bx2 = -L2E_ * R.bx, cl2 = -8.0f * L2E_ * log1pf(expf(-R.lam)), carry = R.carry;
    const bf16x8 bwa[2] = {R.bwa[0], R.bwa[1]}, bwx[2] = {R.bwx[0], R.bwx[1]};
    f32x4 ar[8], ai[8];
#pragma unroll
    for (int m = 0; m < 8; ++m) { ar[m] = zero4(); ai[m] = zero4(); }
#pragma unroll
    for (int m = 0; m < 8; ++m)
#pragma unroll
        for (int ks = 0; ks < 2; ++ks) { ar[m] = __builtin_amdgcn_mfma_f32_16x16x32_bf16(af[m][ks], bwa[ks], ar[m], 0, 0, 0); ai[m] = __builtin_amdgcn_mfma_f32_16x16x32_bf16(af[m][ks], bwx[ks], ai[m], 0, 0, 0); }
    const unsigned uo = (unsigned)(32 * fq * UCP + (16 * n + fr) * 2);
#pragma unroll
    for (int m = 0; m < 8; ++m)
#pragma unroll
        for (int jj = 0; jj < 4; ++jj) {
            const float r = __builtin_amdgcn_rcpf(1.0f + __builtin_amdgcn_exp2f(__builtin_fmaf(ar[m][jj], -1.4426950408889634f, ba2)));
            const float ig = __builtin_amdgcn_rcpf(1.0f + __builtin_amdgcn_exp2f(__builtin_fmaf(ai[m][jj], -1.4426950408889634f, bx2)));
            const float a = __builtin_amdgcn_exp2f(cl2 * r);
            const float u = bf2f(*(const LAS bf16_t*)(ucw + uo + (4 * m + jj) * UCP));
            ar[m][jj] = a; ai[m][jj] = __builtin_amdgcn_sqrtf(__builtin_fmaf(-a, a, 1.0f)) * ig * u; }
    float gA = 1.f, gH = 0.f;
#pragma unroll
    for (int mm = 0; mm < 8; ++mm) { const int m = DIR ? 7 - mm : mm;
#pragma unroll
        for (int j4 = 0; j4 < 4; ++j4) { const int jj = DIR ? 3 - j4 : j4; gH = __builtin_fmaf(ar[m][jj], gH, ai[m][jj]); gA *= ar[m][jj]; } }
    const float A0 = lane_bcast(gA, fr), H0 = lane_bcast(gH, fr), A1 = lane_bcast(gA, fr + 16), H1 = lane_bcast(gH, fr + 16), A2 = lane_bcast(gA, fr + 32), H2 = lane_bcast(gH, fr + 32), A3 = lane_bcast(gA, fr + 48), H3 = lane_bcast(gH, fr + 48);
    if (FINAL) { float h = carry;
        if (!DIR) { if (fq > 0) h = A0 * h + H0; if (fq > 1) h = A1 * h + H1; if (fq > 2) h = A2 * h + H2; }
        else { if (fq < 3) h = A3 * h + H3; if (fq < 2) h = A2 * h + H2; if (fq < 1) h = A1 * h + H1; }
#pragma unroll
        for (int mm = 0; mm < 8; ++mm) { const int m = DIR ? 7 - mm : mm;
#pragma unroll
            for (int j4 = 0; j4 < 4; ++j4) { const int jj = DIR ? 3 - j4 : j4; h = __builtin_fmaf(ar[m][jj], h, ai[m][jj]); hsum[m][jj] += h; } } }
    if (!DIR) Htot = A3 * (A2 * (A1 * H0 + H1) + H2) + H3; else Htot = A0 * (A1 * (A2 * H3 + H2) + H1) + H0;
    Atot = (A0 * A1) * (A2 * A3);
}
template <bool FINAL, bool SHARED = false>
__device__ __forceinline__ void rg_part(Frame& F, int l, int item, const Item& it, const int blk, const int n0, const int n1) {
    const bf16_t* P = (const bf16_t*)(F.ws + WS_PA);
    int lane = F.lane; const bool act = !SHARED || F.wave < 4;
    ldsp_t ucw = SHARED ? F.lds : F.lds + F.wave * (128 * UCP);
    if (act) { const int grp = lane & 7, ch0 = blk * 64 + grp * 8; float cw[4][8], cb[8];
#pragma unroll
      for (int k = 0; k < 4; ++k)
#pragma unroll
          for (int i = 0; i < 8; ++i) cw[k][i] = F.pa->in[I_CONVW][((size_t)l * 4 + k) * 512 + ch0 + i];
#pragma unroll
      for (int i = 0; i < 8; ++i) cb[i] = F.pa->in[I_CONVB][l * 512 + ch0 + i];
      const bf16_t* Pu = P + (size_t)it.seqbase * INW + ch0;
#pragma unroll 8
      for (int q = 0; q < (SHARED ? 4 : 16); ++q) { const int token = (SHARED ? 32 * F.wave : 0) + (lane >> 3) + 8 * q; float o[8];
#pragma unroll
          for (int i = 0; i < 8; ++i) o[i] = cb[i];
#pragma unroll
          for (int k = 0; k < 4; ++k) { const int tt = it.t0 + token + k - 2; const int tc = tt < 0 ? 0 : (tt >= it.seqlen ? it.seqlen - 1 : tt);
              u32x4 v = ldg<u32x4>(Pu, (unsigned)tc * (unsigned)(INW * 2)); if (tt != tc) v = (u32x4){0u, 0u, 0u, 0u};
              o[0] += cw[k][0] * bf2f(v.x & 0xffffu); o[1] += cw[k][1] * __uint_as_float(v.x & 0xffff0000u); o[2] += cw[k][2] * bf2f(v.y & 0xffffu); o[3] += cw[k][3] * __uint_as_float(v.y & 0xffff0000u);
              o[4] += cw[k][4] * bf2f(v.z & 0xffffu); o[5] += cw[k][5] * __uint_as_float(v.z & 0xffff0000u); o[6] += cw[k][6] * bf2f(v.w & 0xffffu); o[7] += cw[k][7] * __uint_as_float(v.w & 0xffff0000u); }
          u32x4 w; w.x = pk2(o[0], o[1]); w.y = pk2(o[2], o[3]); w.z = pk2(o[4], o[5]); w.w = pk2(o[6], o[7]);
          *(LAS u32x4*)(ucw + token * UCP + grp * 16) = w; }
      LDS_WAIT(); asm volatile("" ::: "memory"); }
    if (SHARED) __syncthreads();
    asm volatile("" : "+v"(lane));
    bf16x8 af[8][2];
    if (act) { const int fr = lane & 15, fq = lane >> 4;
#pragma unroll
      for (int m = 0; m < 8; ++m)
#pragma unroll
          for (int ks = 0; ks < 2; ++ks) af[m][ks] = *(const LAS bf16x8*)(ucw + (32 * (fr >> 2) + 4 * m + (fr & 3)) * UCP + (8 * fq + 32 * ks) * 2); }
    if (SHARED) { __syncthreads(); if (!act) return; }
    const bf16_t* wg0 = (const bf16_t*)(F.ws + WS_RGW) + (size_t)(l * 2 + 0) * 2 * 8 * 4096;
    const bf16_t* wg1 = (const bf16_t*)(F.ws + WS_RGW) + (size_t)(l * 2 + 1) * 2 * 8 * 4096;
    float* TOT = (float*)(F.ws + WS_TOT);
    RgStep R0, R1;
    rg_load_step<FINAL>(R0, F, wg0, l, 0, item, blk, n0, lane);
#pragma unroll 1
    for (int n = n0; n < n1; ++n) { asm volatile("" : "+v"(lane));
        const int fr = lane & 15, fq = lane >> 4; const int ch = blk * 64 + 16 * n + fr;
        f32x4 hsum[8];
#pragma unroll
        for (int m = 0; m < 8; ++m) hsum[m] = zero4();
        rg_load_step<FINAL>(R1, F, wg1, l, 1, item, blk, n, lane);
        { float At, Ht;
          rg_dir<FINAL, 0>(ucw, af, R0, n, lane, hsum, At, Ht);
          if (!FINAL && fq == 0) { *(f32x2*)(TOT + (((size_t)item * 2 + 0) * 512 + ch) * 2) = (f32x2){At, Ht}; } }
        __builtin_amdgcn_sched_barrier(0);
        if (n + 1 < n1) rg_load_step<FINAL>(R0, F, wg0, l, 0, item, blk, n + 1, lane);
        { float At, Ht;
          rg_dir<FINAL, 1>(ucw, af, R1, n, lane, hsum, At, Ht);
          if (!FINAL && fq == 0) { *(f32x2*)(TOT + (((size_t)item * 2 + 1) * 512 + ch) * 2) = (f32x2){At, Ht}; } }
        if (FINAL) {
            const unsigned uo = (unsigned)(32 * fq * UCP + (16 * n + fr) * 2);
#pragma unroll
            for (int m = 0; m < 8; ++m)
#pragma unroll
                for (int jj = 0; jj < 4; ++jj) *(LAS bf16_t*)(ucw + uo + (4 * m + jj) * UCP) = (bf16_t)f2bf(hsum[m][jj]); }
    }
    if (FINAL) {
        LDS_WAIT(); asm volatile("" : "+v"(lane) :: "memory");
        const int ng = 2 * (n1 - n0);
        const int grp = 2 * n0 + ((ng == 8) ? (lane & 7) : (lane & 1)); const int tk0 = (ng == 8) ? (lane >> 3) : (lane >> 1), tstep = (ng == 8) ? 8 : 32, nq = (ng == 8) ? 16 : 4;
        const bf16_t* Pg = P + (size_t)it.row0 * INW + 512 + blk * 64 + grp * 8; bf16_t* Yo = (bf16_t*)(F.ws + WS_Y) + (size_t)it.row0 * D + blk * 64 + grp * 8;
#pragma unroll 8
        for (int q = 0; q < nq; ++q) { const int token = tk0 + tstep * q;
            const u32x4 hv = *(const LAS u32x4*)(ucw + token * UCP + grp * 16); const u32x4 gv = ldg<u32x4>(Pg, (unsigned)token * (unsigned)(INW * 2));
            u32x4 w;
            w.x = pk2(gelu_tanh(bf2f(gv.x & 0xffffu)) * bf2f(hv.x & 0xffffu), gelu_tanh(__uint_as_float(gv.x & 0xffff0000u)) * __uint_as_float(hv.x & 0xffff0000u));
            w.y = pk2(gelu_tanh(bf2f(gv.y & 0xffffu)) * bf2f(hv.y & 0xffffu), gelu_tanh(__uint_as_float(gv.y & 0xffff0000u)) * __uint_as_float(hv.y & 0xffff0000u));
            w.z = pk2(gelu_tanh(bf2f(gv.z & 0xffffu)) * bf2f(hv.z & 0xffffu), gelu_tanh(__uint_as_float(gv.z & 0xffff0000u)) * __uint_as_float(hv.z & 0xffff0000u));
            w.w = pk2(gelu_tanh(bf2f(gv.w & 0xffffu)) * bf2f(hv.w & 0xffffu), gelu_tanh(__uint_as_float(gv.w & 0xffff0000u)) * __uint_as_float(hv.w & 0xffff0000u));
            stg<u32x4>(Yo, (unsigned)token * (unsigned)(D * 2), w); }
        LDS_WAIT();
    }
}

__device__ __forceinline__ void stage_rows(Frame& F, ldsp_t dst, const Item& it, int col0, bool rope) {
    const bf16_t* P = (const bf16_t*)(F.ws + WS_PA); const float* ct = (const float*)(F.ws + WS_ROPE); const float* st = ct + 4096 * 64;
    for (int task = F.tid; task < 1024; task += NTHREADS) { const int token = task >> 3, d0 = (task & 7) * 8;
        const bf16_t* src = P + (size_t)(it.row0 + token) * INW + col0;
        const u32x4 lo = *(const u32x4*)(src + d0), hi = *(const u32x4*)(src + d0 + 64);
        u32x4 olo = lo, ohi = hi;
        if (rope) { const int pos = it.t0 + token; const f32x4 c0 = *(const f32x4*)(ct + pos * 64 + d0), c1 = *(const f32x4*)(ct + pos * 64 + d0 + 4), s0 = *(const f32x4*)(st + pos * 64 + d0), s1 = *(const f32x4*)(st + pos * 64 + d0 + 4);
            const float a[8] = {bf2f(lo.x & 0xffffu), __uint_as_float(lo.x & 0xffff0000u), bf2f(lo.y & 0xffffu), __uint_as_float(lo.y & 0xffff0000u), bf2f(lo.z & 0xffffu), __uint_as_float(lo.z & 0xffff0000u), bf2f(lo.w & 0xffffu), __uint_as_float(lo.w & 0xffff0000u)};
            const float b[8] = {bf2f(hi.x & 0xffffu), __uint_as_float(hi.x & 0xffff0000u), bf2f(hi.y & 0xffffu), __uint_as_float(hi.y & 0xffff0000u), bf2f(hi.z & 0xffffu), __uint_as_float(hi.z & 0xffff0000u), bf2f(hi.w & 0xffffu), __uint_as_float(hi.w & 0xffff0000u)};
            const float c[8] = {c0.x, c0.y, c0.z, c0.w, c1.x, c1.y, c1.z, c1.w}, s[8] = {s0.x, s0.y, s0.z, s0.w, s1.x, s1.y, s1.z, s1.w};
            float ra[8], rb[8];
#pragma unroll
            for (int i = 0; i < 8; ++i) { ra[i] = a[i] * c[i] - b[i] * s[i]; rb[i] = a[i] * s[i] + b[i] * c[i]; }
            olo.x = pk2(ra[0], ra[1]); olo.y = pk2(ra[2], ra[3]); olo.z = pk2(ra[4], ra[5]); olo.w = pk2(ra[6], ra[7]);
            ohi.x = pk2(rb[0], rb[1]); ohi.y = pk2(rb[2], rb[3]); ohi.z = pk2(rb[4], rb[5]); ohi.w = pk2(rb[6], rb[7]); }
        *(LAS u32x4*)(dst + token * TP + d0 * 2) = olo; *(LAS u32x4*)(dst + token * TP + (d0 + 64) * 2) = ohi; }
}
__device__ __forceinline__ void stage_cols(Frame& F, ldsp_t dst, const Item& it, int col0) {
    const bf16_t* P = (const bf16_t*)(F.ws + WS_PA);
    for (int task = F.tid; task < 2048; task += NTHREADS) { const int token = task >> 4, d0 = (task & 15) * 8;
        const u32x4 v = *(const u32x4*)(P + (size_t)(it.row0 + token) * INW + col0 + d0);
        const unsigned w[4] = {v.x, v.y, v.z, v.w};
#pragma unroll
        for (int i = 0; i < 4; ++i) { *(LAS bf16_t*)(dst + (d0 + 2 * i) * TP + token * 2) = (bf16_t)(w[i] & 0xffffu); *(LAS bf16_t*)(dst + (d0 + 2 * i + 1) * TP + token * 2) = (bf16_t)(w[i] >> 16); } }
}
__device__ __forceinline__ void rope8(u32x4& lo, u32x4& hi, const float* ct, const float* st, int pos, int d0) {
    const f32x4 c0 = *(const f32x4*)(ct + pos * 64 + d0), c1 = *(const f32x4*)(ct + pos * 64 + d0 + 4), s0 = *(const f32x4*)(st + pos * 64 + d0), s1 = *(const f32x4*)(st + pos * 64 + d0 + 4);
    const float a[8] = {bf2f(lo.x & 0xffffu), __uint_as_float(lo.x & 0xffff0000u), bf2f(lo.y & 0xffffu), __uint_as_float(lo.y & 0xffff0000u), bf2f(lo.z & 0xffffu), __uint_as_float(lo.z & 0xffff0000u), bf2f(lo.w & 0xffffu), __uint_as_float(lo.w & 0xffff0000u)};
    const float b[8] = {bf2f(hi.x & 0xffffu), __uint_as_float(hi.x & 0xffff0000u), bf2f(hi.y & 0xffffu), __uint_as_float(hi.y & 0xffff0000u), bf2f(hi.z & 0xffffu), __uint_as_float(hi.z & 0xffff0000u), bf2f(hi.w & 0xffffu), __uint_as_float(hi.w & 0xffff0000u)};
    const float c[8] = {c0.x, c0.y, c0.z, c0.w, c1.x, c1.y, c1.z, c1.w}, sn[8] = {s0.x, s0.y, s0.z, s0.w, s1.x, s1.y, s1.z, s1.w};
    float ra[8], rb[8];
#pragma unroll
    for (int i = 0; i < 8; ++i) { ra[i] = a[i] * c[i] - b[i] * sn[i]; rb[i] = a[i] * sn[i] + b[i] * c[i]; }
    lo = (u32x4){pk2(ra[0], ra[1]), pk2(ra[2], ra[3]), pk2(ra[4], ra[5]), pk2(ra[6], ra[7])};
    hi = (u32x4){pk2(rb[0], rb[1]), pk2(rb[2], rb[3]), pk2(rb[4], rb[5]), pk2(rb[6], rb[7])};
}
struct KvRegs { u32x4 klo[2], khi[2], v[4]; };
__device__ __forceinline__ void kv_issue(Frame& F, KvRegs& R, const Item& it, int h) {
    const bf16_t* P = (const bf16_t*)(F.ws + WS_PA);
    const bf16_t* Pk = P + (size_t)it.row0 * INW + 1536 + h * HD; const bf16_t* Pv = P + (size_t)it.row0 * INW + 2048 + h * HD;
#pragma unroll
    for (int t2 = 0; t2 < 2; ++t2) { const int task = F.tid + t2 * NTHREADS, token = task >> 3, d0 = (task & 7) * 8;
        R.klo[t2] = ldg<u32x4>(Pk, (unsigned)(token * INW + d0) * 2u); R.khi[t2] = ldg<u32x4>(Pk, (unsigned)(token * INW + d0 + 64) * 2u); }
#pragma unroll
    for (int t4 = 0; t4 < 4; ++t4) { const int task = F.tid + t4 * NTHREADS, token = task >> 4, d0 = (task & 15) * 8; R.v[t4] = ldg<u32x4>(Pv, (unsigned)(token * INW + d0) * 2u); }
}
template <int KS> __device__ __forceinline__ void kv_step(unsigned aK, unsigned aVf, unsigned aVb, f32x4 (&accf)[8], f32x4 (&accb)[8]) {
    const bf16x8 af = tr1<KS * 32 * VP>(aVf), ab = tr1<KS * 32 * VP>(aVb);
    bf16x8 b[8];
    tr4<KS * 32 * VP>(aK, b[0], b[1], b[2], b[3]); tr4<KS * 32 * VP + 128>(aK, b[4], b[5], b[6], b[7]);
#pragma unroll
    for (int n = 0; n < 8; ++n) { accf[n] = __builtin_amdgcn_mfma_f32_16x16x32_bf16(af, b[n], accf[n], 0, 0, 0); accb[n] = __builtin_amdgcn_mfma_f32_16x16x32_bf16(ab, b[n], accb[n], 0, 0, 0); }
}
__device__ __forceinline__ void stage_state_t(Frame& F, ldsp_t dst, const bf16_t* St) {
#pragma unroll
    for (int t4 = 0; t4 < 4; ++t4) { const int task = F.tid + t4 * NTHREADS, e = task >> 4, c8 = task & 15;
        *(LAS u32x4*)(dst + e * TP + c8 * 16) = ldg<u32x4>(St, (unsigned)(e * 128 + c8 * 8) * 2u); }
}
__device__ __forceinline__ void mm16x128(ldsp_t At, int ra0, ldsp_t Bt, int lane, f32x4 (&acc)[8]) {
    const int fr = lane & 15, fq = lane >> 4;
#pragma unroll
    for (int ks = 0; ks < 4; ++ks) { const bf16x8 a = *(const LAS bf16x8*)(At + (ra0 + fr) * TP + (32 * ks + 8 * fq) * 2);
#pragma unroll
        for (int n = 0; n < 8; ++n) { const bf16x8 b = *(const LAS bf16x8*)(Bt + (16 * n + fr) * TP + (32 * ks + 8 * fq) * 2); acc[n] = __builtin_amdgcn_mfma_f32_16x16x32_bf16(a, b, acc[n], 0, 0, 0); } }
}

__device__ __forceinline__ void kv_head(Frame& F, KvRegs& R, KvRegs& Rn, bool pre, int item, const Item& it, int h) {
    bf16_t* KV = (bf16_t*)(F.ws + WS_KV);
    const float* ct = (const float*)(F.ws + WS_ROPE); const float* st = ct + 4096 * 64;
    const LAS float* dec = (const LAS float*)(F.lds + LDS_DEC); const bool rope = !it.is_ctx;
    ldsp_t tK = F.lds, tVf = F.lds + TILEV, tVb = F.lds + 2 * TILEV;
#pragma unroll
    for (int t2 = 0; t2 < 2; ++t2) { const int task = F.tid + t2 * NTHREADS, token = task >> 3, d0 = (task & 7) * 8;
        if (rope) rope8(R.klo[t2], R.khi[t2], ct, st, it.t0 + token, d0);
        *(LAS u32x4*)(tK + token * VP + d0 * 2) = R.klo[t2]; *(LAS u32x4*)(tK + token * VP + (d0 + 64) * 2) = R.khi[t2]; }
#pragma unroll
    for (int t4 = 0; t4 < 4; ++t4) { const int task = F.tid + t4 * NTHREADS, token = task >> 4, d0 = (task & 15) * 8; const u32x4 v = R.v[t4];
        const float df = dec[(0 * 4 + h) * 132 + 127 - token], db = dec[(1 * 4 + h) * 132 + token];
        const float x[8] = {bf2f(v.x & 0xffffu), __uint_as_float(v.x & 0xffff0000u), bf2f(v.y & 0xffffu), __uint_as_float(v.y & 0xffff0000u), bf2f(v.z & 0xffffu), __uint_as_float(v.z & 0xffff0000u), bf2f(v.w & 0xffffu), __uint_as_float(v.w & 0xffff0000u)};
        u32x4 wf, wb; wf.x = pk2(x[0] * df, x[1] * df); wf.y = pk2(x[2] * df, x[3] * df); wf.z = pk2(x[4] * df, x[5] * df); wf.w = pk2(x[6] * df, x[7] * df);
        wb.x = pk2(x[0] * db, x[1] * db); wb.y = pk2(x[2] * db, x[3] * db); wb.z = pk2(x[4] * db, x[5] * db); wb.w = pk2(x[6] * db, x[7] * db);
        *(LAS u32x4*)(tVf + token * VP + d0 * 2) = wf; *(LAS u32x4*)(tVb + token * VP + d0 * 2) = wb; }
    WG_BAR_LDS();
    if (pre) kv_issue(F, Rn, it, h + 1);
    f32x4 af[8], ab[8];
#pragma unroll
    for (int n = 0; n < 8; ++n) { af[n] = zero4(); ab[n] = zero4(); }
    { const unsigned aK = tr_lane_addr(tK, F.lane), aVf = tr_lane_addr(tVf, F.lane) + 32u * (unsigned)F.wave, aVb = tr_lane_addr(tVb, F.lane) + 32u * (unsigned)F.wave;
      kv_step<0>(aK, aVf, aVb, af, ab); kv_step<1>(aK, aVf, aVb, af, ab); kv_step<2>(aK, aVf, aVb, af, ab); kv_step<3>(aK, aVf, aVb, af, ab); }
    const int fr = F.lane & 15, fq = F.lane >> 4;
    bf16_t* of = KV + (((size_t)item * 4 + h) * 2 + 0) * 16384 + (size_t)(16 * F.wave) * 128;
    unsigned so = (unsigned)((4 * fq) * 128 + fr) * 2u; asm volatile("" : "+v"(so));
#pragma unroll
    for (int n = 0; n < 8; ++n)
#pragma unroll
        for (int jj = 0; jj < 4; ++jj) { stg<bf16_t>(of, so + (unsigned)((jj * 128 + 16 * n) * 2), (bf16_t)f2bf(af[n][jj])); stg<bf16_t>(of, so + (unsigned)((16384 + jj * 128 + 16 * n) * 2), (bf16_t)f2bf(ab[n][jj])); }
    WG_BAR_LDS();
}
__device__ __forceinline__ int latent_item(int c) { return (c >> 5) * SPB + 2 + (c & 31); }
__device__ __forceinline__ int ctx_item(int ci) { return (ci >> 1) * SPB + (ci & 1); }
__device__ __forceinline__ void phase_m1(Frame& F, int l) {
    build_decay(F, l); __syncthreads();
    for (int c = F.bid; c < 256; c += F.G) {
        fresh(F);
        { const int item = latent_item(c); const Item it = item_info(item);
          rg_part<false>(F, l, item, it, F.wave, 0, 4);
          __syncthreads();
          KvRegs A, B;
          fresh(F); kv_issue(F, A, it, 0);
          kv_head(F, A, B, true, item, it, 0);
          fresh(F); kv_head(F, B, A, true, item, it, 1);
          fresh(F); kv_head(F, A, B, true, item, it, 2);
          fresh(F); kv_head(F, B, A, false, item, it, 3); }
        fresh(F);
        if (c >= 64 && c < 192) { const int cu = c - 64; const int item = ctx_item(cu >> 3); const Item it = item_info(item);
            const int w4 = F.wave & 3; rg_part<false, true>(F, l, item, it, cu & 7, w4, w4 + 1); }
        __syncthreads();
        if (c < 64) { const int item = ctx_item(c >> 2); const Item it = item_info(item); KvRegs A, B; fresh(F); kv_issue(F, A, it, c & 3); kv_head(F, A, B, false, item, it, c & 3); }
    }
}
__device__ __forceinline__ int seq_order(int dir, int step) { return dir ? (step == 0 ? 1 : (step == 1 ? 0 : 35 - step)) : step; }
__device__ __forceinline__ void phase_m2(Frame& F, int l) {
    bf16_t* KV = (bf16_t*)(F.ws + WS_KV);
    const int gt = F.bid * NTHREADS + F.tid, NGT = F.G * NTHREADS;
    for (int c = gt; c < NB * NH * 2 * 128 * 16; c += NGT) {
        const int dc = c & 15, e = (c >> 4) & 127, dir = (c >> 11) & 1, h = (c >> 12) & 3, b = c >> 14;
        const float x = F.pa->in[I_RETDEC][l * 8 + dir * 4 + h]; const float decay = expf(128.0f * (-log1pf(expf(-x))));
        float S[8];
#pragma unroll
        for (int i = 0; i < 8; ++i) S[i] = 0.f;
        const unsigned lo = (unsigned)((((h * 2 + dir) * 128 + e) * 128 + dc * 8) * 2);
        for (int g0 = 0; g0 < SPB; g0 += 17) {
            u32x4 v[17];
#pragma unroll
            for (int i = 0; i < 17; ++i) { const int item = b * SPB + seq_order(dir, g0 + i); v[i] = ldg<u32x4>(KV + (size_t)item * 4 * 2 * 16384, lo); }
#pragma unroll
            for (int i = 0; i < 17; ++i) { const int item = b * SPB + seq_order(dir, g0 + i);
                u32x4 w; w.x = pk2(S[0], S[1]); w.y = pk2(S[2], S[3]); w.z = pk2(S[4], S[5]); w.w = pk2(S[6], S[7]);
                stg<u32x4>(KV + (size_t)item * 4 * 2 * 16384, lo, w);
                S[0] = S[0] * decay + bf2f(v[i].x & 0xffffu); S[1] = S[1] * decay + __uint_as_float(v[i].x & 0xffff0000u); S[2] = S[2] * decay + bf2f(v[i].y & 0xffffu); S[3] = S[3] * decay + __uint_as_float(v[i].y & 0xffff0000u);
                S[4] = S[4] * decay + bf2f(v[i].z & 0xffffu); S[5] = S[5] * decay + __uint_as_float(v[i].z & 0xffff0000u); S[6] = S[6] * decay + bf2f(v[i].w & 0xffffu); S[7] = S[7] * decay + __uint_as_float(v[i].w & 0xffff0000u); }
        }
    }
    const float* TOT = (const float*)(F.ws + WS_TOT); float* CARRY = (float*)(F.ws + WS_CARRY);
    if (F.tid < 32) for (int cidx = F.bid * 32 + F.tid; cidx < NB * 2 * 512; cidx += F.G * 32) {
      { const int ch = cidx & 511, dir = (cidx >> 9) & 1, b = cidx >> 10; float cr = 0.f;
          for (int g0 = 0; g0 < SPB; g0 += 17) { f32x2 ah[17];
#pragma unroll
              for (int i = 0; i < 17; ++i) { const int item = b * SPB + seq_order(dir, g0 + i); ah[i] = *(const f32x2*)(TOT + (((size_t)item * 2 + dir) * 512 + ch) * 2); }
#pragma unroll
              for (int i = 0; i < 17; ++i) { const int item = b * SPB + seq_order(dir, g0 + i); CARRY[((size_t)item * 2 + dir) * 512 + ch] = cr; cr = ah[i].x * cr + ah[i].y; } } } }
}
struct RetRegs { u32x4 v[4], sf[4], sb[4], klo[2], khi[2], g[4]; };
__device__ __forceinline__ void ret_issue(Frame& F, RetRegs& R, int item, const Item& it, int h) {
    const bf16_t* KV = (const bf16_t*)(F.ws + WS_KV); const bf16_t* P = (const bf16_t*)(F.ws + WS_PA);
    const bf16_t* Pk = P + (size_t)it.row0 * INW + 1536 + h * HD; const bf16_t* Pv = P + (size_t)it.row0 * INW + 2048 + h * HD;
    const bf16_t* Sf = KV + (((size_t)item * 4 + h) * 2 + 0) * 16384; const bf16_t* Sb = Sf + 16384;
    const int lane = F.lane, i0 = 16 * F.wave;
#pragma unroll
    for (int t2 = 0; t2 < 2; ++t2) { const int task = F.tid + t2 * NTHREADS, token = task >> 3, d0 = (task & 7) * 8;
        R.klo[t2] = ldg<u32x4>(Pk, (unsigned)(token * INW + d0) * 2u); R.khi[t2] = ldg<u32x4>(Pk, (unsigned)(token * INW + d0 + 64) * 2u); }
#pragma unroll
    for (int t4 = 0; t4 < 4; ++t4) { const int task = F.tid + t4 * NTHREADS, r = task >> 4, c8 = task & 15;
        R.v[t4] = ldg<u32x4>(Pv, (unsigned)(r * INW + c8 * 8) * 2u); R.sf[t4] = ldg<u32x4>(Sf, (unsigned)(r * 128 + c8 * 8) * 2u); R.sb[t4] = ldg<u32x4>(Sb, (unsigned)(r * 128 + c8 * 8) * 2u); }
    { const bf16_t* Pg = P + (size_t)(it.row0 + i0) * INW + 2560 + h * HD;
#pragma unroll
      for (int k = 0; k < 4; ++k) R.g[k] = ldg<u32x4>(Pg, (unsigned)((lane >> 2) * INW + 32 * (lane & 3) + 8 * k) * 2u); }
}
__device__ __forceinline__ void ret_head(Frame& F, RetRegs& R, RetRegs& Rn, bool pre, int item, const Item& it, int h) {
    bf16_t* Y = (bf16_t*)(F.ws + WS_Y);
    const float* ct = (const float*)(F.ws + WS_ROPE); const float* st = ct + 4096 * 64;
    const LAS float* dec = (const LAS float*)(F.lds + LDS_DEC);
    ldsp_t tK = F.lds, tV = F.lds + TILEB, tSf = tV + TILEV, tSb = tSf + TILEB;
    const bool rope = !it.is_ctx;
    const int lane = F.lane, fr = lane & 15, fq = lane >> 4, i0 = 16 * F.wave;
    u32x4 q4[4];
    { const bf16_t* Pq = (const bf16_t*)(F.ws + WS_PA) + (size_t)(it.row0 + i0) * INW + 1024 + h * HD;
#pragma unroll
      for (int ks = 0; ks < 4; ++ks) q4[ks] = ldg<u32x4>(Pq, (unsigned)(fr * INW + 32 * ks + 8 * fq) * 2u); }
#pragma unroll
    for (int t2 = 0; t2 < 2; ++t2) { const int task = F.tid + t2 * NTHREADS, token = task >> 3, d0 = (task & 7) * 8;
        if (rope) rope8(R.klo[t2], R.khi[t2], ct, st, it.t0 + token, d0);
        *(LAS u32x4*)(tK + token * TP + d0 * 2) = R.klo[t2]; *(LAS u32x4*)(tK + token * TP + (d0 + 64) * 2) = R.khi[t2]; }
#pragma unroll
    for (int t4 = 0; t4 < 4; ++t4) { const int task = F.tid + t4 * NTHREADS, r = task >> 4, c8 = task & 15;
        *(LAS u32x4*)(tV + r * VP + c8 * 16) = R.v[t4]; *(LAS u32x4*)(tSf + r * TP + c8 * 16) = R.sf[t4]; *(LAS u32x4*)(tSb + r * TP + c8 * 16) = R.sb[t4]; }
    bf16x8 qf[4];
    { if (rope) { rope8(q4[0], q4[2], ct, st, it.t0 + i0 + fr, 8 * fq); rope8(q4[1], q4[3], ct, st, it.t0 + i0 + fr, 32 + 8 * fq); }
#pragma unroll
      for (int ks = 0; ks < 4; ++ks) qf[ks] = __builtin_bit_cast(bf16x8, q4[ks]); }
    u32x4 gk[4];
#pragma unroll
    for (int k = 0; k < 4; ++k) gk[k] = R.g[k];
    WG_BAR_LDS();
    if (pre) ret_issue(F, Rn, item, it, h + 1);
    bf16x8 pa[4];
    { f32x4 C[8];
#pragma unroll
      for (int jt = 0; jt < 8; ++jt) { C[jt] = zero4();
#pragma unroll
          for (int ks = 0; ks < 4; ++ks) { const bf16x8 a = *(const LAS bf16x8*)(tK + (16 * jt + fr) * TP + (32 * ks + 8 * fq) * 2); C[jt] = __builtin_amdgcn_mfma_f32_16x16x32_bf16(a, qf[ks], C[jt], 0, 0, 0); } }
      const int i = i0 + fr;
#pragma unroll
      for (int jt = 0; jt < 8; ++jt)
#pragma unroll
          for (int jj = 0; jj < 4; ++jj) { const int j = 16 * jt + 4 * fq + jj; const float dcy = (i >= j) ? dec[(0 * 4 + h) * 132 + (i - j)] : dec[(1 * 4 + h) * 132 + (j - i)]; C[jt][jj] *= dcy; }
#pragma unroll
      for (int u = 0; u < 4; ++u) { const u32x4 w = {pg8::cvt_pk_bf16(C[2 * u][0], C[2 * u][1]), pg8::cvt_pk_bf16(C[2 * u][2], C[2 * u][3]), pg8::cvt_pk_bf16(C[2 * u + 1][0], C[2 * u + 1][1]), pg8::cvt_pk_bf16(C[2 * u + 1][2], C[2 * u + 1][3])};
          pa[u] = __builtin_bit_cast(bf16x8, w); } }
    WG_BAR_LDS();
    { ldsp_t gt = tK + (i0 + (lane >> 2)) * TP + (lane & 3) * 64;
#pragma unroll
      for (int k = 0; k < 4; ++k) *(LAS u32x4*)(gt + 16 * k) = gk[k]; }
    f32x4 o[8];
#pragma unroll
    for (int n = 0; n < 8; ++n) o[n] = zero4();
    { const unsigned aV = tr_lane_addr(tV, lane); bf16x8 b[8];
#define RET_PV(U) do { tr4<(U) * 32 * VP>(aV, b[0], b[1], b[2], b[3]); tr4<(U) * 32 * VP + 128>(aV, b[4], b[5], b[6], b[7]); \
        _Pragma("unroll") for (int n = 0; n < 8; ++n) o[n] = __builtin_amdgcn_mfma_f32_16x16x32_bf16(pa[U], b[n], o[n], 0, 0, 0); } while (0)
      RET_PV(0); RET_PV(1); RET_PV(2); RET_PV(3);
#undef RET_PV
    }
    { f32x4 cf[8];
#pragma unroll
      for (int n = 0; n < 8; ++n) { cf[n] = zero4();
#pragma unroll
          for (int ks = 0; ks < 4; ++ks) { const bf16x8 b = *(const LAS bf16x8*)(tSf + (16 * n + fr) * TP + (32 * ks + 8 * fq) * 2); cf[n] = __builtin_amdgcn_mfma_f32_16x16x32_bf16(qf[ks], b, cf[n], 0, 0, 0); } }
#pragma unroll
      for (int jj = 0; jj < 4; ++jj) { const float sf = dec[(0 * 4 + h) * 132 + (i0 + 4 * fq + jj + 1)];
#pragma unroll
          for (int n = 0; n < 8; ++n) o[n][jj] += sf * cf[n][jj]; } }
    { f32x4 cb[8];
#pragma unroll
      for (int n = 0; n < 8; ++n) { cb[n] = zero4();
#pragma unroll
          for (int ks = 0; ks < 4; ++ks) { const bf16x8 b = *(const LAS bf16x8*)(tSb + (16 * n + fr) * TP + (32 * ks + 8 * fq) * 2); cb[n] = __builtin_amdgcn_mfma_f32_16x16x32_bf16(qf[ks], b, cb[n], 0, 0, 0); } }
#pragma unroll
      for (int jj = 0; jj < 4; ++jj) { const float sb = dec[(1 * 4 + h) * 132 + (128 - (i0 + 4 * fq + jj))];
#pragma unroll
          for (int n = 0; n < 8; ++n) o[n][jj] += sb * cb[n][jj]; } }
    { ldsp_t gc = tK + (i0 + 4 * fq) * TP + fr * 2;
#pragma unroll
      for (int jj = 0; jj < 4; ++jj) { float s1 = 0.f;
#pragma unroll
          for (int n = 0; n < 8; ++n) s1 += o[n][jj];
          s1 += swz_xor<1>(s1); s1 += swz_xor<2>(s1); s1 += swz_xor<4>(s1); s1 += swz_xor<8>(s1);
          const float mu = s1 * (1.0f / 128.0f); float q = 0.f;
#pragma unroll
          for (int n = 0; n < 8; ++n) { const float dd = o[n][jj] - mu; q += dd * dd; }
          q += swz_xor<1>(q); q += swz_xor<2>(q); q += swz_xor<4>(q); q += swz_xor<8>(q);
          const float rstd = 1.0f / sqrtf(q * (1.0f / 128.0f) + EPS);
#pragma unroll
          for (int n = 0; n < 8; ++n) { LAS bf16_t* p = (LAS bf16_t*)(gc + jj * TP + 32 * n); const float gv = bf2f(*p); *p = (bf16_t)f2bf(siluf_(gv) * (o[n][jj] - mu) * rstd); } } }
    LDS_WAIT(); asm volatile("" ::: "memory");
    { ldsp_t gt = tK + (i0 + (lane >> 2)) * TP + (lane & 3) * 64; bf16_t* Yo = Y + (size_t)(it.row0 + i0) * D + 512 + h * HD;
#pragma unroll
      for (int k = 0; k < 4; ++k) stg<u32x4>(Yo, (unsigned)((lane >> 2) * D + 32 * (lane & 3) + 8 * k) * 2u, *(const LAS u32x4*)(gt + 16 * k)); }
    WG_BAR_LDS();
}
__device__ __forceinline__ void phase_m3(Frame& F, int l) {
    build_decay(F, l); __syncthreads();
    for (int c = F.bid; c < 256; c += F.G) {
        fresh(F);
        { const int item = latent_item(c); const Item it = item_info(item);
#ifndef PROBE_M3
#define PROBE_M3 0
#endif
          for (int r_ = 0; r_ < ((PROBE_M3 & 1) ? 2 : 1); ++r_) { fresh(F); rg_part<true>(F, l, item, it, F.wave, 0, 4); }
          __syncthreads();
          for (int r_ = 0; r_ < ((PROBE_M3 & 2) ? 2 : 1); ++r_) {
          RetRegs R, Rn;
          fresh(F); ret_issue(F, R, item, it, 0);
          ret_head(F, R, Rn, true, item, it, 0);
          fresh(F); ret_head(F, Rn, R, true, item, it, 1);
          fresh(F); ret_head(F, R, Rn, true, item, it, 2);
          fresh(F); ret_head(F, Rn, R, false, item, it, 3); } }
        if (l == 0) {
            fresh(F);
            if (c >= 64 && c < 192) { const int cu = c - 64; const int item = ctx_item(cu >> 3); const Item it = item_info(item);
                const int w4 = F.wave & 3; rg_part<true, true>(F, l, item, it, cu & 7, w4, w4 + 1); }
            __syncthreads();
            if (c < 64) { const int item = ctx_item(c >> 2); const Item it = item_info(item); RetRegs R, Rn; fresh(F); ret_issue(F, R, item, it, c & 3); ret_head(F, R, Rn, false, item, it, c & 3); }
        }
    }
}

constexpr int N_PHASES = 24;
__global__ void __launch_bounds__(NTHREADS, 2) fwd_kernel(Args args) {
    extern __shared__ __attribute__((aligned(16))) unsigned char lds_raw[];
    Frame F; F.lds = (ldsp_t)lds_raw; F.wave0 = __builtin_amdgcn_readfirstlane((int)threadIdx.x >> 6); F.G = gridDim.x; F.pa0 = &args; F.out0 = args.out; F.ws0 = args.ws; fresh(F);
    volatile LAS unsigned* MISC = (volatile LAS unsigned*)(F.lds + LDS_MISC);
    if (F.tid < 64) MISC[F.tid] = 0u;
    __syncthreads();
    const int lo = args.ph_lo, hi = args.ph_hi;
    XcdBarrier bar; bar.bar = (unsigned*)(F.ws + WS_CTL); bar.x = 0; bar.st = nullptr;
    if (hi - lo > 1) bar = xcd_barrier_post((unsigned*)(F.ws + WS_CTL), MISC);
#ifndef DIAG_MASK
#define DIAG_MASK 0xffffffffu
#endif
#ifndef REPEAT_MASK
#define REPEAT_MASK 0u
#endif
#define REPS(kind) ((((REPEAT_MASK) >> (kind)) & 1u) ? 2 : 1)
#define INK(k, kind) (((DIAG_MASK >> (kind)) & 1u) && lo <= (k) && (k) < hi && fresh(F))
#define IN(k) (lo <= (k) && (k) < hi)
#define SEAM(k) do { if (IN(k) && IN((k) + 1)) xcd_barrier(bar); } while (0)
    float* ctxx = (float*)(F.ws + WS_CTXX); bf16_t* xb = (bf16_t*)((char*)F.out + XB_OFF);
    const float* modlat = (const float*)(F.ws + WS_MODLAT); const float* modctx = (const float*)(F.ws + WS_MODCTX);

    if (INK(0, 0)) { for (int r_ = 0; r_ < REPS(0); ++r_) { phase_convert_small(F); __syncthreads(); phase_mod(F); __syncthreads(); } } SEAM(0);
    if (INK(1, 1)) { for (int r_ = 0; r_ < REPS(1); ++r_) phase_norm(F, 0, 0, F.pa->in[I_X], nullptr, F.pa->in[I_CTX], MROWS, SlabRed{nullptr, 0, nullptr, nullptr, nullptr}); } SEAM(1);
#pragma unroll 1
    for (int l = 0; l < 2; ++l) {
        const int pb = (l == 0) ? 2 : 11;
        if (INK(pb + 0, 2)) { pg8::Gemm g{(const bf16_t*)(F.ws + WS_HX), (const bf16_t*)(F.ws + WS_WIN) + (size_t)l * INW * D, INW, D, 0, nullptr}; pg8::Order S; S.init(MROWS / 256, INW / 256, F.G, F.bid, nullptr, nullptr, D / 64, false, 0);
            pg8::EpiBf16 E{(bf16_t*)(F.ws + WS_PA), INW}; for (int r_ = 0; r_ < REPS(2); ++r_) pg8::gemm_phase<pg8::EpiBf16>(F.lds, g, S, E, F.tid); }
        SEAM(pb + 0);
        if (INK(pb + 1, 3)) { for (int r_ = 0; r_ < REPS(3); ++r_) phase_m1(F, l); }
        SEAM(pb + 1);
        if (INK(pb + 2, 4)) { for (int r_ = 0; r_ < REPS(4); ++r_) { if (r_) phase_m1(F, l); phase_m2(F, l); } }
        SEAM(pb + 2);
        if (INK(pb + 3, 5)) { for (int r_ = 0; r_ < REPS(5); ++r_) phase_m3(F, l); }
        SEAM(pb + 3);
        if (INK(pb + 4, 6)) { pg8::Gemm g{(const bf16_t*)(F.ws + WS_Y), (const bf16_t*)(F.ws + WS_WOUT) + (size_t)l * D * D, D, D, 0, (float*)(F.ws + WS_SLABA)}; pg8::Order S; S.init((l == 0 ? MROWS : NLAT) / 256, D / 256, F.G, F.bid, nullptr, nullptr, D / 64, true, MAXSLAB_A);
            pg8::EpiResid E{l == 0 ? F.pa->in[I_X] : nullptr, xb, F.pa->in[I_CTX], ctxx, modlat + (size_t)l * 8 * 6144 + 2048, modctx + (size_t)l * 6144 + 2048};
            pg8::gemm_phase<pg8::EpiResid>(F.lds, g, S, E, F.tid); }
        SEAM(pb + 4);
        if (l == 0) {
            if (INK(7, 1)) { for (int r_ = 0; r_ < REPS(1); ++r_) phase_norm(F, 0, 1, nullptr, xb, ctxx, MROWS, SlabRed{(const float*)(F.ws + WS_SLABA), pg8::split_factor((MROWS / 256) * 4, F.G, D / 64, MAXSLAB_A), modctx + 2048, F.pa->in[I_CTX], ctxx}); } SEAM(7);
            if (INK(8, 7)) { pg8::Gemm g{(const bf16_t*)(F.ws + WS_HX), (const bf16_t*)(F.ws + WS_WUP), 2 * DFF, D, 0, nullptr}; pg8::Order S; S.init(MROWS / 256, 2 * DFF / 256, F.G, F.bid, nullptr, nullptr, D / 64, false, 0);
                pg8::EpiSwiGLU E{(bf16_t*)(F.ws + WS_PA), DFF}; for (int r_ = 0; r_ < REPS(7); ++r_) pg8::gemm_phase<pg8::EpiSwiGLU>(F.lds, g, S, E, F.tid); }
            SEAM(8);
            if (INK(9, 8)) { pg8::Gemm g{(const bf16_t*)(F.ws + WS_PA), (const bf16_t*)(F.ws + WS_WDN), D, DFF, 0, (float*)(F.ws + WS_SLABA)}; pg8::Order S; S.init(MROWS / 256, D / 256, F.G, F.bid, nullptr, nullptr, DFF / 64, true, MAXSLAB_A);
                pg8::EpiResid E{nullptr, xb, (const float*)ctxx, ctxx, modlat + 5120, modctx + 5120}; pg8::gemm_phase<pg8::EpiResid>(F.lds, g, S, E, F.tid); }
            SEAM(9);
            if (INK(10, 1)) { for (int r_ = 0; r_ < REPS(1); ++r_) phase_norm(F, 1, 0, nullptr, xb, ctxx, MROWS, SlabRed{(const float*)(F.ws + WS_SLABA), pg8::split_factor((MROWS / 256) * 4, F.G, DFF / 64, MAXSLAB_A), modctx + 5120, ctxx, ctxx}); } SEAM(10);
        }
    }
    if (INK(16, 9)) { for (int r_ = 0; r_ < REPS(9); ++r_) { phase_norm_router(F, xb); __syncthreads(); phase_convert_moe(F); __syncthreads(); } } SEAM(16);
    if (INK(17, 10)) { phase_moe_sort(F); } SEAM(17);
#pragma unroll 1
    for (int k = 0; k < 2; ++k) {
        const int* meta = (const int*)(F.ws + MOE_META) + 9 * k;
        if (INK(18 + 2 * k, 11)) { if (k == 1) { moe_reduce(F, 0); __syncthreads(); } pg8::Gemm g{(const bf16_t*)(F.ws + WS_HX), (const bf16_t*)(F.ws + WS_MOEUP), 2 * DEXP, D, (size_t)2 * DEXP * D * 2, nullptr}; pg8::Order S; S.init(meta[8], 2 * DEXP / 256, F.G, F.bid, meta, (const int*)(F.ws + MOE_PTOK) + k * MROWS, D / 64, false, 0);
            pg8::EpiSwiGLU E{(bf16_t*)(F.ws + WS_PA), DEXP}; for (int r_ = 0; r_ < REPS(11); ++r_) pg8::gemm_phase<pg8::EpiSwiGLU>(F.lds, g, S, E, F.tid); }
        SEAM(18 + 2 * k);
        if (INK(19 + 2 * k, 12)) { pg8::Gemm g{(const bf16_t*)(F.ws + WS_PA), (const bf16_t*)(F.ws + WS_MOEDN), D, DEXP, (size_t)D * DEXP * 2, (float*)(F.ws + WS_SLABM)}; pg8::Order S; S.init(meta[8], D / 256, F.G, F.bid, meta, nullptr, DEXP / 64, true, MAXSLAB_M);
            pg8::EpiMoeDown E{xb, (const int*)(F.ws + MOE_PTOK) + k * MROWS, (const float*)(F.ws + MOE_PW) + k * MROWS, modlat + (size_t)8 * 6144 + 5120}; pg8::gemm_phase<pg8::EpiMoeDown>(F.lds, g, S, E, F.tid); }
        SEAM(19 + 2 * k);
    }
    if (INK(22, 13)) phase_final_a(F);
    SEAM(22);
    if (INK(23, 13)) phase_final_b(F);
#undef IN
#undef INK
#undef SEAM
}

extern "C" void kernel_launch(void* const* d_in, const int* in_sizes, int n_in, void* d_out, int out_size, void* d_ws, size_t ws_size, hipStream_t stream) {
    static int grid = 0;
    if (grid == 0) {
        if (n_in != 27 || in_sizes[0] != NLAT * D || out_size != NLAT * D || ws_size < WS_END) { fprintf(stderr, "kernel_launch: unexpected problem (n_in %d, in0 %d, out %d, ws %zu, need %zu); nothing launched\n", n_in, n_in > 0 ? in_sizes[0] : -1, out_size, ws_size, (size_t)WS_END); grid = -1; return; }
        int dev = 0, cus = 0, per_cu = 0;
        if (hipGetDevice(&dev) != hipSuccess || hipDeviceGetAttribute(&cus, hipDeviceAttributeMultiprocessorCount, dev) != hipSuccess) { grid = -1; return; }
        if (hipFuncSetAttribute((const void*)fwd_kernel, hipFuncAttributeMaxDynamicSharedMemorySize, LDS_BYTES) != hipSuccess) { fprintf(stderr, "kernel_launch: hipFuncSetAttribute failed\n"); grid = -1; return; }
        if (hipOccupancyMaxActiveBlocksPerMultiprocessor(&per_cu, (const void*)fwd_kernel, NTHREADS, LDS_BYTES) != hipSuccess || per_cu < 1) { fprintf(stderr, "kernel_launch: occupancy query says %d\n", per_cu); }
        (void)hipGetLastError();
        grid = cus;
    }
    if (grid < 0) return;
    (void)hipMemsetAsync((char*)d_ws + WS_CTL, 0, CTL_ZERO_BYTES, stream);
    Args a; memset(&a, 0, sizeof(a));
    for (int i = 0; i < 27; ++i) a.in[i] = (const float*)d_in[i];
    a.out = (float*)d_out; a.ws = (unsigned char*)d_ws;
#if MK_ONE_LAUNCH
    a.ph_lo = 0; a.ph_hi = N_PHASES;
    hipLaunchKernelGGL(fwd_kernel, dim3(grid), dim3(NTHREADS), LDS_BYTES, stream, a);
#else
    for (int p = 0; p < N_PHASES; ++p) { a.ph_lo = p; a.ph_hi = p + 1; hipLaunchKernelGGL(fwd_kernel, dim3(grid), dim3(NTHREADS), LDS_BYTES, stream, a); }
#endif
}
```

```cpp
#include <hip/hip_runtime.h>
#include <cstdio>
#include <cstdint>
#include <cstring>

#ifndef MK_ONE_LAUNCH
#define MK_ONE_LAUNCH 1
#endif

#define GAS __attribute__((address_space(1)))
#define LAS __attribute__((address_space(3)))
typedef unsigned short bf16_t;
typedef short bf16x8 __attribute__((ext_vector_type(8)));
typedef float f32x4 __attribute__((ext_vector_type(4)));
typedef float f32x2 __attribute__((ext_vector_type(2)));
typedef unsigned u32x4 __attribute__((ext_vector_type(4)));
typedef unsigned u32x2 __attribute__((ext_vector_type(2)));
typedef LAS unsigned char* ldsp_t;

constexpr int D = 1024, NB = 8, SEQ = 4096, NLAT = NB * SEQ, CTXL = 256, NCTX = NB * CTXL, MROWS = NLAT + NCTX;
constexpr int INW = 3072, NH = 4, HD = 128, CHK = 128;
constexpr int DFF = 2816, NE = 8, DEXP = 3584;
constexpr int SPB = 34;
constexpr int NITEM = NB * SPB;
constexpr float EPS = 1e-6f;
constexpr int NWAVES = 8, NTHREADS = 512;

constexpr size_t MiB = 1u << 20;
constexpr size_t WS_CTL = 0, CTL_ZERO_BYTES = 64 * 1024;
constexpr size_t WS_MODLAT = 1 * MiB;
constexpr size_t WS_MODCTX = 1 * MiB + 2 * 8 * 6144 * 4;
constexpr size_t WS_ROPE = 2 * MiB;
constexpr size_t WS_RGW = 4 * MiB;
constexpr size_t WS_TOT = 5 * MiB;
constexpr size_t WS_CARRY = 8 * MiB;
constexpr size_t WS_MOE = 10 * MiB;
constexpr size_t MOE_CNT = WS_MOE, MOE_META = WS_MOE + 16384, MOE_TOKE = WS_MOE + 65536, MOE_TOKW = WS_MOE + 262144,
                 MOE_PTOK = WS_MOE + 524288, MOE_PW = WS_MOE + 1048576, MOE_PPOS = WS_MOE + 1572864;
constexpr size_t WS_CTXX = 12 * MiB;
constexpr size_t WS_WIN = 20 * MiB;
constexpr size_t WS_WOUT = 32 * MiB;
constexpr size_t WS_WUP = 36 * MiB;
constexpr size_t WS_WDN = 47 * MiB;
constexpr size_t WS_HX = 54 * MiB;
constexpr size_t WS_PA = 122 * MiB;
constexpr size_t WS_KV = 360 * MiB;
constexpr size_t WS_Y = 496 * MiB;
constexpr size_t WS_MOEUP = 360 * MiB;
constexpr size_t WS_MOEDN = 472 * MiB;
constexpr size_t WS_SLABA = WS_KV;
constexpr size_t WS_SLABM = 528 * MiB;
constexpr int MAXSLAB_A = 256, MAXSLAB_M = 216;
constexpr size_t XB_OFF = (size_t)NLAT * D * 2;
constexpr size_t WS_XCOPY = WS_PA;
constexpr size_t WS_END = 582 * MiB;
static_assert(WS_MOEDN + (size_t)NE * D * DEXP * 2 <= WS_END, "ws map");
static_assert(WS_PA + (size_t)MROWS * DEXP * 2 <= WS_KV, "ws map");

constexpr int LDS_SCRATCH = 147456;
constexpr int LDS_MISC = LDS_SCRATCH;
constexpr int LDS_DEC = LDS_MISC + 256;
constexpr int LDS_BYTES = LDS_SCRATCH + 8192;

__device__ __forceinline__ float bf2f(unsigned v) { return __uint_as_float(v << 16); }
typedef __bf16 bf16x2_t __attribute__((ext_vector_type(2)));
__device__ __forceinline__ unsigned pk2(float lo, float hi) { const f32x2 v = {lo, hi}; return __builtin_bit_cast(unsigned, __builtin_convertvector(v, bf16x2_t)); }
__device__ __forceinline__ unsigned f2bf(float f) { return pk2(f, f) & 0xffffu; }
__device__ __forceinline__ void unpack8(const u32x4 v, f32x4& a, f32x4& b) {
    a = (f32x4){bf2f(v.x & 0xffffu), __uint_as_float(v.x & 0xffff0000u), bf2f(v.y & 0xffffu), __uint_as_float(v.y & 0xffff0000u)};
    b = (f32x4){bf2f(v.z & 0xffffu), __uint_as_float(v.z & 0xffff0000u), bf2f(v.w & 0xffffu), __uint_as_float(v.w & 0xffff0000u)}; }
__device__ __forceinline__ u32x4 pack8(const f32x4 a, const f32x4 b) { return (u32x4){pk2(a.x, a.y), pk2(a.z, a.w), pk2(b.x, b.y), pk2(b.z, b.w)}; }
template <int M> __device__ __forceinline__ float swz_xor(float v) { return __int_as_float(__builtin_amdgcn_ds_swizzle(__float_as_int(v), (M << 10) | 0x1f)); }
__device__ __forceinline__ float wave_sum(float v) {
    v += swz_xor<1>(v); v += swz_xor<2>(v); v += swz_xor<4>(v); v += swz_xor<8>(v); v += swz_xor<16>(v);
    const auto r = __builtin_amdgcn_permlane32_swap(__float_as_uint(v), __float_as_uint(v), false, false);
    return __uint_as_float(r[0]) + __uint_as_float(r[1]);
}
__device__ __forceinline__ float lane_bcast(float v, int src_lane) { return __int_as_float(__builtin_amdgcn_ds_bpermute(src_lane << 2, __float_as_int(v))); }
__device__ __forceinline__ float sigmoidf_(float x) { return __builtin_amdgcn_rcpf(1.0f + __expf(-x)); }
__device__ __forceinline__ float siluf_(float x) { return x * __builtin_amdgcn_rcpf(1.0f + __expf(-x)); }
__device__ __forceinline__ float gelu_tanh(float x) { const float z = 0.7978845608028654f * (x + 0.044715f * x * x * x); return x * (1.0f - __builtin_amdgcn_rcpf(1.0f + __expf(2.0f * z))); }
#define LDS_WAIT() asm volatile("s_waitcnt lgkmcnt(0)" ::: "memory")
#define WG_BAR_LDS() do { asm volatile("s_waitcnt lgkmcnt(0)" ::: "memory"); __builtin_amdgcn_s_barrier(); asm volatile("" ::: "memory"); } while (0)
__device__ __forceinline__ f32x4 zero4() { float z; asm volatile("v_mov_b32 %0, 0" : "=v"(z)); return (f32x4){z, z, z, z}; }

template <typename T> __device__ __forceinline__ T ldg(const void* base, unsigned off) { return *(const GAS T*)((const GAS char*)base + off); }
template <typename T> __device__ __forceinline__ void stg(void* base, unsigned off, T v) { *(GAS T*)((GAS char*)base + off) = v; }
#define XB_TMO      128
#define XB_XCNT(j)  (256  + 64 * (j))
#define XB_XSUB(j)  (1280 + 64 * (j))
#define XB_XGEN(j)  (2304 + 64 * (j))
#define XB_TOP      3328
#define XB_TOPGEN   3392
#define XCD_BAR_WORDS 3456
#define XB_SPIN_CAP (1u << 18)
__device__ __forceinline__ unsigned xb_ld(unsigned* p)              { return __hip_atomic_load(p, __ATOMIC_RELAXED, __HIP_MEMORY_SCOPE_AGENT); }
__device__ __forceinline__ unsigned xb_add(unsigned* p, unsigned v) { return __hip_atomic_fetch_add(p, v, __ATOMIC_RELAXED, __HIP_MEMORY_SCOPE_AGENT); }
__device__ __forceinline__ unsigned xb_xcc_id() { return (unsigned)__builtin_amdgcn_s_getreg((3 << 11) | 20) & 0xFu; }
#define XB_SPIN(cond, bar) do { unsigned _sp = 0; while (cond) { __builtin_amdgcn_s_sleep(1); \
    if ((++_sp & 255u) == 0u) { if (xb_ld(&(bar)[XB_TMO])) break; if (_sp > XB_SPIN_CAP) { atomicAdd(&(bar)[XB_TMO], 1u); break; } } } } while (0)
struct XcdBarrier { unsigned* bar; unsigned x; volatile LAS unsigned* st; };
__device__ __forceinline__ XcdBarrier xcd_barrier_post(unsigned* bar, volatile LAS unsigned* st) {
    XcdBarrier b; b.bar = bar; b.x = xb_xcc_id(); b.st = st;
    if (threadIdx.x == 0) (void)xb_add(&bar[XB_XCNT(b.x)], 1u);
    return b;
}
__device__ __forceinline__ void xcd_barrier_complete(unsigned* bar, unsigned x, unsigned& nloc, unsigned& nx) {
    const unsigned G = gridDim.x * gridDim.y * gridDim.z;
    unsigned sum, cnt, mine, sp = 0u;
    for (;;) {
        sum = 0u; cnt = 0u; mine = 0u;
#pragma unroll
        for (unsigned j = 0; j < 16; ++j) { const unsigned c = xb_ld(&bar[XB_XCNT(j)]); sum += c; cnt += (c > 0u) ? 1u : 0u; mine = (j == x) ? c : mine; }
        if (sum == G) break;
        __builtin_amdgcn_s_sleep(1);
        if ((++sp & 255u) == 0u) { if (xb_ld(&bar[XB_TMO])) break; if (sp > XB_SPIN_CAP) { atomicAdd(&bar[XB_TMO], 1u); break; } }
    }
    nloc = mine > 0u ? mine : 1u; nx = cnt > 0u ? cnt : 1u;
}
__device__ __forceinline__ void xcd_barrier(const XcdBarrier& b) {
    asm volatile("s_waitcnt vmcnt(0)" ::: "memory");
    __syncthreads();
    if (threadIdx.x == 0) {
        unsigned* bar = b.bar;
        __builtin_amdgcn_s_waitcnt(0);
        unsigned nloc = b.st[0], nx = b.st[1];
        if (nloc == 0u) { xcd_barrier_complete(bar, b.x, nloc, nx); b.st[0] = nloc; b.st[1] = nx; }
        const unsigned old = xb_add(&bar[XB_XSUB(b.x)], 1u);
        const unsigned gen = old / nloc;
        if (old + 1u == (gen + 1u) * nloc) {
            __builtin_amdgcn_fence(__ATOMIC_RELEASE, "agent");
            asm volatile("s_waitcnt vmcnt(0)" ::: "memory");
            const unsigned og = xb_add(&bar[XB_TOP], 1u);
            const unsigned tg = og / nx;
            if (og + 1u == (tg + 1u) * nx) xb_add(&bar[XB_TOPGEN], 1u);
            else XB_SPIN(xb_ld(&bar[XB_TOPGEN]) == tg, bar);
            __builtin_amdgcn_fence(__ATOMIC_ACQUIRE, "agent");
            xb_add(&bar[XB_XGEN(b.x)], 1u);
            asm volatile("s_waitcnt vmcnt(0)" ::: "memory");
        } else {
            XB_SPIN(xb_ld(&bar[XB_XGEN(b.x)]) == gen, bar);
            __builtin_amdgcn_fence(__ATOMIC_ACQUIRE, "agent");
            asm volatile("s_waitcnt vmcnt(0)" ::: "memory");
        }
    }
    __syncthreads();
}

namespace pg8 {
constexpr int BM = 256, BK = 64, HALF = 128, HTB = HALF * BK * 2, STAGE_BYTES = 8 * HTB, NXCD = 8, WGM = 8;
__host__ __device__ __forceinline__ int lds_byte(int r, int c) { const int st = (r >> 4) * 2 + (c >> 5), rr = r & 15, cc = c & 31, ob = rr * 64 + cc * 2; return st * 1024 + (ob ^ (((ob >> 9) & 1) << 5)); }
__host__ __device__ __forceinline__ void stage_rc(int b, int& R, int& C) { const int st = b / 1024, sb = b % 1024, swz = sb ^ (((sb >> 9) & 1) << 5); R = (st >> 1) * 16 + swz / 64; C = (st & 1) * 32 + (swz % 64) / 2; }
__host__ __device__ __forceinline__ int perm32(int rho) { const int n = rho >> 4, i = rho & 15; return 8 * (i >> 2) + 4 * n + (i & 3); }

struct Unit { int pm, pn, e, kt0, nt, slab; };
struct Gemm { const bf16_t* A; const bf16_t* Bt; int N, K; size_t estride; float* slabs; };

__device__ __forceinline__ int split_factor(int U, int G, int ntiles, int maxslabs) {
    const int R = U % G; if (R == 0) return 1;
    int S = G / R; if (S > 8) S = 8; if (S > ntiles / 4) S = ntiles / 4; if (R * S > maxslabs) S = maxslabs / R;
    return S < 2 ? 1 : S;
}
struct Order {
    int nM, nN, G, c, ntiles, mainu, S, total; const int* segs; const int* rowmap;
    int sg1, sg2, sg3, sg4, sg5, sg6, sg7;
    __device__ __forceinline__ void init(int nM_, int nN_, int G_, int c_, const int* segs_, const int* rowmap_, int ntiles_, bool split, int maxslabs) {
        nM = nM_; nN = nN_; G = G_; c = c_; segs = segs_; rowmap = rowmap_; ntiles = ntiles_;
        sg1 = sg2 = sg3 = sg4 = sg5 = sg6 = sg7 = 0; if (segs_) { sg1 = segs_[1]; sg2 = segs_[2]; sg3 = segs_[3]; sg4 = segs_[4]; sg5 = segs_[5]; sg6 = segs_[6]; sg7 = segs_[7]; }
        const int U = nM * nN; S = split ? split_factor(U, G, ntiles, maxslabs) : 1; const int R = (S > 1) ? U % G : 0; mainu = U - R; total = mainu + R * S; }
    __device__ __forceinline__ bool next(int i, Unit& u) const {
        const long L = (long)i * G + c; if (L >= total) return false;
        int wgid; u.kt0 = 0; u.nt = ntiles; u.slab = -1;
        if (L < mainu) { wgid = (int)L; const int q = mainu / NXCD, r = mainu % NXCD, xcd = wgid % NXCD, off = wgid / NXCD; wgid = (xcd < r ? xcd * (q + 1) : r * (q + 1) + (xcd - r) * q) + off; }
        else { const int sub = (int)L - mainu, lu = sub / S, sl = sub - lu * S, pairs = ntiles / 2, p0 = (sl * pairs) / S, p1 = ((sl + 1) * pairs) / S;
            wgid = mainu + lu; u.kt0 = 2 * p0; u.nt = 2 * (p1 - p0); u.slab = sub; }
        const int nig = WGM * nN, gid = wgid / nig, fm = gid * WGM, gsz = (nM - fm) < WGM ? (nM - fm) : WGM;
        u.pm = fm + ((wgid % nig) % gsz); u.pn = (wgid % nig) / gsz; u.e = 0;
        if (segs) u.e = (u.pm >= sg1) + (u.pm >= sg2) + (u.pm >= sg3) + (u.pm >= sg4) + (u.pm >= sg5) + (u.pm >= sg6) + (u.pm >= sg7);
        return true;
    }
    __device__ __forceinline__ int arow(const Unit& u, int r) const {
        if (rowmap) { const int t = rowmap[u.pm * BM + r]; return t < 0 ? 0 : t; }
        return u.pm * BM + r;
    }
};

__device__ __forceinline__ unsigned cvt_pk_bf16(float lo, float hi) { return pk2(lo, hi); }

struct EpiBf16 {
    static constexpr bool PERM = true, SPLIT = false;
    bf16_t* O; int ldc;
    __device__ __forceinline__ void operator()(const f32x4 (&acc)[2][2][4][2], const Unit& u, int wr, int wc, int fr, int fq) const {
        asm volatile("" : "+v"(fr), "+v"(fq));
        const int row0 = u.pm * BM + wr * 64 + fr, col0 = u.pn * BM + wc * 32 + 8 * fq;
#pragma unroll
        for (int ai = 0; ai < 2; ++ai)
#pragma unroll
            for (int m = 0; m < 4; ++m) { bf16_t* rowp = O + (size_t)(row0 + ai * HALF + m * 16) * ldc + col0;
#pragma unroll
                for (int bj = 0; bj < 2; ++bj) { const f32x4 v0 = acc[ai][bj][m][0], v1 = acc[ai][bj][m][1];
                    u32x4 w; w.x = cvt_pk_bf16(v0[0], v0[1]); w.y = cvt_pk_bf16(v0[2], v0[3]); w.z = cvt_pk_bf16(v1[0], v1[1]); w.w = cvt_pk_bf16(v1[2], v1[3]);
                    *(u32x4*)(rowp + bj * HALF) = w; } }
    }
};
struct EpiSwiGLU {
    static constexpr bool PERM = true, SPLIT = false;
    bf16_t* O; int ldc;
    __device__ __forceinline__ void operator()(const f32x4 (&acc)[2][2][4][2], const Unit& u, int wr, int wc, int fr, int fq) const {
        asm volatile("" : "+v"(fr), "+v"(fq));
        const int row0 = u.pm * BM + wr * 64 + fr, col0 = u.pn * HALF + wc * 32 + 8 * fq;
#pragma unroll
        for (int ai = 0; ai < 2; ++ai)
#pragma unroll
            for (int m = 0; m < 4; ++m) { bf16_t* rowp = O + (size_t)(row0 + ai * HALF + m * 16) * ldc + col0;
                float o[8];
#pragma unroll
                for (int n = 0; n < 2; ++n)
#pragma unroll
                    for (int j = 0; j < 4; ++j) { const float a = acc[ai][0][m][n][j], b = acc[ai][1][m][n][j]; o[n * 4 + j] = (a * __builtin_amdgcn_rcpf(1.0f + __expf(-a))) * b; }
                u32x4 w; w.x = cvt_pk_bf16(o[0], o[1]); w.y = cvt_pk_bf16(o[2], o[3]); w.z = cvt_pk_bf16(o[4], o[5]); w.w = cvt_pk_bf16(o[6], o[7]);
                *(u32x4*)rowp = w; }
    }
};
struct EpiResid {
    static constexpr bool PERM = true, SPLIT = true;
    const float* src_f32; bf16_t* xb; const float* src_ctx; float* dst_ctx; const float* gate_lat; const float* gate_ctx;
    __device__ __forceinline__ void operator()(const f32x4 (&acc)[2][2][4][2], const Unit& u, int wr, int wc, int fr, int fq) const {
        asm volatile("" : "+v"(fr), "+v"(fq));
        const int prow = u.pm * BM; const bool lat = prow < NLAT;
        const float* gate = lat ? gate_lat + (size_t)(prow / SEQ) * 6144 : gate_ctx;
        const int r0 = wr * 64 + fr, col0 = u.pn * BM + wc * 32 + 8 * fq;
        f32x4 gv[2][2];
#pragma unroll
        for (int bj = 0; bj < 2; ++bj)
#pragma unroll
            for (int n = 0; n < 2; ++n) gv[bj][n] = *(const f32x4*)(gate + col0 + bj * HALF + 4 * n);
        if (lat) {
#pragma unroll
            for (int ai = 0; ai < 2; ++ai)
#pragma unroll
                for (int m = 0; m < 4; ++m) { const size_t off = (size_t)(prow + r0 + ai * HALF + m * 16) * D + col0;
#pragma unroll
                    for (int bj = 0; bj < 2; ++bj) { f32x4 s0, s1;
                        if (src_f32) { s0 = *(const f32x4*)(src_f32 + off + bj * HALF); s1 = *(const f32x4*)(src_f32 + off + bj * HALF + 4); }
                        else unpack8(*(const u32x4*)(xb + off + bj * HALF), s0, s1);
                        *(u32x4*)(xb + off + bj * HALF) = pack8(s0 + gv[bj][0] * acc[ai][bj][m][0], s1 + gv[bj][1] * acc[ai][bj][m][1]); }
                    if (m == 3) asm volatile("" ::: "memory"); }
        } else {
            const float* src = src_ctx + (size_t)(prow - NLAT) * D; float* dst = dst_ctx + (size_t)(prow - NLAT) * D;
#pragma unroll
            for (int ai = 0; ai < 2; ++ai)
#pragma unroll
                for (int m = 0; m < 4; ++m) { const size_t off = (size_t)(r0 + ai * HALF + m * 16) * D + col0;
#pragma unroll
                    for (int bj = 0; bj < 2; ++bj)
#pragma unroll
                        for (int n = 0; n < 2; ++n) { const f32x4 sv = *(const f32x4*)(src + off + bj * HALF + 4 * n); *(f32x4*)(dst + off + bj * HALF + 4 * n) = sv + gv[bj][n] * acc[ai][bj][m][n]; }
                    asm volatile("" ::: "memory"); }
        }
    }
};
struct EpiMoeDown {
    static constexpr bool PERM = true, SPLIT = true;
    bf16_t* xb; const int* ptok; const float* pw; const float* gate_lat;
    __device__ __forceinline__ void operator()(const f32x4 (&acc)[2][2][4][2], const Unit& u, int wr, int wc, int fr, int fq) const {
        asm volatile("" : "+v"(fr), "+v"(fq));
        const int r0 = u.pm * BM + wr * 64 + fr, col0 = u.pn * BM + wc * 32 + 8 * fq;
        int tk[8]; float wk[8];
#pragma unroll
        for (int i = 0; i < 8; ++i) { const int r = r0 + (i >> 2) * HALF + (i & 3) * 16; tk[i] = ptok[r]; wk[i] = pw[r]; }
#pragma unroll
        for (int ai = 0; ai < 2; ++ai)
#pragma unroll
            for (int m = 0; m < 4; ++m) { const int tok = tk[ai * 4 + m]; const float w = wk[ai * 4 + m];
                if (tok >= 0) { bf16_t* xr = xb + (size_t)tok * D + col0; const float* gate = gate_lat + (size_t)(tok / SEQ) * 6144 + col0;
#pragma unroll
                    for (int bj = 0; bj < 2; ++bj) { const f32x4 g0 = *(const f32x4*)(gate + bj * HALF), g1 = *(const f32x4*)(gate + bj * HALF + 4); f32x4 s0, s1; unpack8(*(const u32x4*)(xr + bj * HALF), s0, s1);
                        *(u32x4*)(xr + bj * HALF) = pack8(s0 + (g0 * w) * acc[ai][bj][m][0], s1 + (g1 * w) * acc[ai][bj][m][1]); } }
                if (m & 1) asm volatile("" ::: "memory"); }
    }
};

template <class Epi>
__device__ __forceinline__ void gemm_phase(ldsp_t lds, const Gemm g, const Order& S, const Epi& E, const int tid) {
    const int wid = __builtin_amdgcn_readfirstlane(tid >> 6), lane = tid & 63, wr = wid >> 2, wc = wid & 3, fr = lane & 15, fq = lane >> 4;
    const int K = g.K;
    unsigned voffB[2];
#pragma unroll
    for (int i = 0; i < 2; ++i) { int R, C; stage_rc(tid * 16 + i * 8192, R, C); const int Rb = Epi::PERM ? ((R & ~31) + perm32(R & 31)) : R;
        voffB[i] = (unsigned)(Rb * K + C) * 2u; }
    const size_t kstep = (size_t)(BK * 2);
    const size_t hstep = (size_t)HALF * K * 2;
    const size_t tstep = 2 * hstep;
    const unsigned ldsw = (unsigned)wid * 1024u;
    const int aoff = lds_byte(wr * 64 + fr, fq * 8), boff = lds_byte(wc * 32 + fr, fq * 8);
#define PG8_SA(b, h) (((b) * 2 + (h)) * HTB)
#define PG8_SB(b, h) ((4 + (b) * 2 + (h)) * HTB)
#define PG8_STAGE_B(bufoff, gbase) do { _Pragma("unroll") for (int _i = 0; _i < 2; ++_i) \
        __builtin_amdgcn_global_load_lds((const unsigned*)((const char*)(gbase) + voffB[_i]), (LAS unsigned*)(lds + (bufoff) + ldsw + _i * 8192), 16, 0, 0); } while (0)
#define PG8_STAGE_A(bufoff, gbase, o0, o1) do { \
        __builtin_amdgcn_global_load_lds((const unsigned*)((const char*)(gbase) + (o0)), (LAS unsigned*)(lds + (bufoff) + ldsw), 16, 0, 0); \
        __builtin_amdgcn_global_load_lds((const unsigned*)((const char*)(gbase) + (o1)), (LAS unsigned*)(lds + (bufoff) + ldsw + 8192), 16, 0, 0); } while (0)
#define PG8_LDA(dst, b, h) do { _Pragma("unroll") for (int m = 0; m < 4; ++m) _Pragma("unroll") for (int k = 0; k < 2; ++k) dst[m][k] = *(const LAS bf16x8*)(lds + PG8_SA(b, h) + aoff + m * 2048 + k * 1024); } while (0)
#define PG8_LDB(dst, b, h) do { _Pragma("unroll") for (int n = 0; n < 2; ++n) _Pragma("unroll") for (int k = 0; k < 2; ++k) dst[n][k] = *(const LAS bf16x8*)(lds + PG8_SB(b, h) + boff + n * 2048 + k * 1024); } while (0)
#define PG8_MMA(ai, bj, At, Bt) do { __builtin_amdgcn_s_setprio(1); _Pragma("unroll") for (int m = 0; m < 4; ++m) _Pragma("unroll") for (int n = 0; n < 2; ++n) _Pragma("unroll") for (int k = 0; k < 2; ++k) \
        acc[ai][bj][m][n] = __builtin_amdgcn_mfma_f32_16x16x32_bf16(Bt[n][k], At[m][k], acc[ai][bj][m][n], 0, 0, 0); __builtin_amdgcn_s_setprio(0); } while (0)
#define PG8_WAIT_V(n) asm volatile("s_waitcnt vmcnt(" #n ")" ::: "memory")
#define PG8_WAIT_L(n) asm volatile("s_waitcnt lgkmcnt(" #n ")" ::: "memory")
#define PG8_BAR __builtin_amdgcn_s_barrier()
#define PG8_SCHED __builtin_amdgcn_sched_barrier(0)
#define PG8_AOFFS(u, o00, o01, o10, o11) do { int R0_, C0_, R1_, C1_; stage_rc(tid * 16, R0_, C0_); stage_rc(tid * 16 + 8192, R1_, C1_); \
        o00 = (unsigned)(S.arow(u, R0_) * K + C0_ + (u).kt0 * BK) * 2u; o01 = (unsigned)(S.arow(u, R1_) * K + C1_ + (u).kt0 * BK) * 2u; \
        o10 = (unsigned)(S.arow(u, HALF + R0_) * K + C0_ + (u).kt0 * BK) * 2u; o11 = (unsigned)(S.arow(u, HALF + R1_) * K + C1_ + (u).kt0 * BK) * 2u; } while (0)
    Unit cur, nxt; int ui = 0;
    if (!S.next(0, cur)) return;
    f32x4 acc[2][2][4][2];
    { float z_; asm volatile("v_mov_b32 %0, 0" : "=v"(z_));
#pragma unroll
    for (int a = 0; a < 2; ++a)
#pragma unroll
        for (int b = 0; b < 2; ++b)
#pragma unroll
            for (int m = 0; m < 4; ++m)
#pragma unroll
                for (int n = 0; n < 2; ++n) acc[a][b][m][n] = (f32x4){z_, z_, z_, z_}; }
    bf16x8 At[4][2], B0[2][2], B1[2][2];
    const char* const Abase = (const char*)g.A;
    const char* cB = (const char*)g.Bt + (size_t)cur.e * g.estride + (size_t)cur.pn * tstep + (size_t)cur.kt0 * kstep;
    unsigned c00, c01, c10, c11;
    PG8_AOFFS(cur, c00, c01, c10, c11);
    PG8_STAGE_B(PG8_SB(0, 0), cB); PG8_STAGE_B(PG8_SB(0, 1), cB + hstep); PG8_STAGE_A(PG8_SA(0, 0), Abase, c00, c01); PG8_STAGE_A(PG8_SA(0, 1), Abase, c10, c11);
    if (wr == 1) PG8_BAR;
    PG8_WAIT_V(2); PG8_BAR;
    PG8_STAGE_B(PG8_SB(1, 0), cB + kstep); PG8_STAGE_A(PG8_SA(1, 0), Abase + kstep, c00, c01); PG8_STAGE_B(PG8_SB(1, 1), cB + hstep + kstep);
    PG8_WAIT_V(6); PG8_BAR;
    for (;;) {
        const bool has_next = S.next(ui + 1, nxt);
        const char* nB = has_next ? (const char*)g.Bt + (size_t)nxt.e * g.estride + (size_t)nxt.pn * tstep + (size_t)nxt.kt0 * kstep : cB;
        const int nt = cur.nt;
        int rn0 = 0, rn1 = 0, rn2 = 0, rn3 = 0;
        if (S.rowmap && has_next) { int R0_, C0_, R1_, C1_; stage_rc(tid * 16, R0_, C0_); stage_rc(tid * 16 + 8192, R1_, C1_);
            rn0 = S.arow(nxt, R0_); rn1 = S.arow(nxt, R1_); rn2 = S.arow(nxt, HALF + R0_); rn3 = S.arow(nxt, HALF + R1_); }
        for (int t = 0; t < nt; t += 2) {
            const bool last = (t == nt - 2);
            const char* a1 = Abase + (size_t)(t + 1) * kstep;
            const char* a2 = last ? Abase : Abase + (size_t)(t + 2) * kstep; const char* b2 = last ? nB : cB + (size_t)(t + 2) * kstep;
            const char* a3 = a2 + kstep; const char* b3 = b2 + kstep;
            PG8_LDB(B0, 0, 0); PG8_LDB(B1, 0, 1); PG8_SCHED; PG8_LDA(At, 0, 0); PG8_STAGE_A(PG8_SA(1, 1), a1, c10, c11);
            PG8_WAIT_V(8); PG8_WAIT_L(0); PG8_BAR; PG8_MMA(0, 0, At, B0); PG8_MMA(0, 1, At, B1); PG8_BAR; PG8_SCHED;
            if (last && has_next) {
                if (S.rowmap) { int R0_, C0_, R1_, C1_; stage_rc(tid * 16, R0_, C0_); stage_rc(tid * 16 + 8192, R1_, C1_);
                    c00 = (unsigned)(rn0 * K + C0_ + nxt.kt0 * BK) * 2u; c01 = (unsigned)(rn1 * K + C1_ + nxt.kt0 * BK) * 2u; c10 = (unsigned)(rn2 * K + C0_ + nxt.kt0 * BK) * 2u; c11 = (unsigned)(rn3 * K + C1_ + nxt.kt0 * BK) * 2u; }
                else { PG8_AOFFS(nxt, c00, c01, c10, c11); } }
            PG8_LDA(At, 0, 1); PG8_STAGE_B(PG8_SB(0, 0), b2); PG8_STAGE_B(PG8_SB(0, 1), b2 + hstep); PG8_STAGE_A(PG8_SA(0, 0), a2, c00, c01);
            PG8_WAIT_V(8); PG8_WAIT_L(0); PG8_BAR; PG8_MMA(1, 0, At, B0); PG8_MMA(1, 1, At, B1); PG8_BAR; PG8_SCHED;
            PG8_LDB(B0, 1, 0); PG8_LDB(B1, 1, 1); PG8_SCHED; PG8_LDA(At, 1, 0); PG8_STAGE_A(PG8_SA(0, 1), a2, c10, c11);
            PG8_WAIT_V(8); PG8_WAIT_L(0); PG8_BAR; PG8_MMA(0, 0, At, B0); PG8_MMA(0, 1, At, B1); PG8_BAR; PG8_SCHED;
            PG8_LDA(At, 1, 1); PG8_STAGE_B(PG8_SB(1, 0), b3); PG8_STAGE_B(PG8_SB(1, 1), b3 + hstep); PG8_STAGE_A(PG8_SA(1, 0), a3, c00, c01);
            PG8_WAIT_V(8); PG8_WAIT_L(0); PG8_BAR; PG8_MMA(1, 0, At, B0); PG8_MMA(1, 1, At, B1); PG8_BAR; PG8_SCHED;
        }
        if (wr == 0) PG8_BAR;
        if (Epi::SPLIT && cur.slab >= 0) {
            int fr_ = fr, fq_ = fq; asm volatile("" : "+v"(fr_), "+v"(fq_));
            float* sp = g.slabs + (size_t)cur.slab * 65536 + (size_t)(wr * 64 + fr_) * 256 + wc * 32 + (Epi::PERM ? 8 : 4) * fq_;
#pragma unroll
            for (int ai = 0; ai < 2; ++ai)
#pragma unroll
                for (int m = 0; m < 4; ++m)
#pragma unroll
                    for (int bj = 0; bj < 2; ++bj)
#pragma unroll
                        for (int n = 0; n < 2; ++n) *(f32x4*)(sp + (ai * HALF + m * 16) * 256 + bj * HALF + n * (Epi::PERM ? 4 : 16)) = acc[ai][bj][m][n];
        } else E(acc, cur, wr, wc, fr, fq);
        if (!has_next) break;
        { float z_; asm volatile("v_mov_b32 %0, 0" : "=v"(z_));
#pragma unroll
        for (int a = 0; a < 2; ++a)
#pragma unroll
            for (int b = 0; b < 2; ++b)
#pragma unroll
                for (int m = 0; m < 4; ++m)
#pragma unroll
                    for (int n = 0; n < 2; ++n) acc[a][b][m][n] = (f32x4){z_, z_, z_, z_}; }
        cur = nxt; cB = nB; ++ui;
        if (wr == 1) PG8_BAR;
    }
    PG8_WAIT_V(0);
    PG8_BAR;
#undef PG8_SA
#undef PG8_SB
#undef PG8_STAGE_A
#undef PG8_STAGE_B
#undef PG8_LDA
#undef PG8_LDB
#undef PG8_MMA
#undef PG8_WAIT_V
#undef PG8_WAIT_L
#undef PG8_BAR
#undef PG8_SCHED
#undef PG8_AOFFS
}
}

struct Args { const float* in[27]; float* out; unsigned char* ws; int ph_lo, ph_hi; };
struct Frame {
    ldsp_t lds; int tid, lane, wave, wave0, G, bid;
    const Args* pa; float* out; unsigned char* ws;
    const Args* pa0; float* out0; unsigned char* ws0;
};
enum { I_X = 0, I_C, I_CTX, I_CCTX, I_WMOD, I_BMOD, I_GMIX, I_GFFN, I_GFINAL, I_WIN, I_WOUT, I_CONVW, I_CONVB, I_RGWA, I_RGBA, I_RGWX, I_RGBX, I_RGLAM, I_RETDEC,
       I_FW1, I_FW3, I_FW2, I_MROUTER, I_MROUTERB, I_MW1, I_MW3, I_MW2 };

constexpr int TRS = 64 * 65 * 4;
struct TrItem { const float* W; bf16_t* WT; int ldw, k0, n0, ldt, drow0; float scale; };
__device__ __forceinline__ void tr_load(const TrItem& t, f32x4 (&v)[16], int lane) {
    const int r4 = lane >> 4, c4 = (lane & 15) * 4;
#pragma unroll
    for (int i = 0; i < 16; ++i) v[i] = *(const f32x4*)(t.W + (size_t)(t.k0 + 4 * i + r4) * t.ldw + t.n0 + c4);
}
__device__ __forceinline__ void tr_store(const TrItem& t, const f32x4 (&v)[16], LAS float* scr, int lane) {
    { const int r4 = lane >> 4, c4 = (lane & 15) * 4;
#pragma unroll
      for (int i = 0; i < 16; ++i) { LAS float* d = scr + (4 * i + r4) * 65 + c4; d[0] = v[i].x; d[1] = v[i].y; d[2] = v[i].z; d[3] = v[i].w; } }
    LDS_WAIT(); asm volatile("" ::: "memory");
    const int c = lane & 7; const float scale = t.scale;
#pragma unroll
    for (int j = 0; j < 8; ++j) { const int n = (lane >> 3) + 8 * j; const LAS float* sp = scr + (8 * c) * 65 + n;
        u32x4 o; o.x = pk2(sp[0 * 65] * scale, sp[1 * 65] * scale); o.y = pk2(sp[2 * 65] * scale, sp[3 * 65] * scale); o.z = pk2(sp[4 * 65] * scale, sp[5 * 65] * scale); o.w = pk2(sp[6 * 65] * scale, sp[7 * 65] * scale);
        *(u32x4*)(t.WT + (size_t)(t.drow0 + n) * t.ldt + t.k0 + 8 * c) = o; }
    LDS_WAIT(); asm volatile("" ::: "memory");
}
__device__ __forceinline__ TrItem up_item(const float* w1, const float* w3, int F, bf16_t* WT, int r) {
    const int per = 16 * (F / 64); const int which = r / per; r -= which * per;
    const int nblk = F / 64, kb = r / nblk, nb = r % nblk, n0 = nb * 64;
    return TrItem{which ? w3 : w1, WT, F, kb * 64, n0, D, (n0 / 128) * 256 + (n0 % 128) + which * 128, 1.0f};
}
__device__ __forceinline__ TrItem small_item(Frame& F, int r) {
    constexpr int I_IN = 16 * (INW / 64), I_OUT = 16 * (D / 64), I_UP = 2 * 16 * (DFF / 64);
    if (r < 2 * I_IN) { const int l = r / I_IN; r -= l * I_IN; const int nblk = INW / 64, kb = r / nblk, nb = r % nblk, n0 = nb * 64;
        const float sc = (n0 >= 1536 && n0 < 2048) ? 0.08838834764831845f : 1.0f;
        return TrItem{F.pa->in[I_WIN] + (size_t)l * D * INW, (bf16_t*)(F.ws + WS_WIN) + (size_t)l * INW * D, INW, kb * 64, n0, D, n0, sc}; }
    r -= 2 * I_IN;
    if (r < 2 * I_OUT) { const int l = r / I_OUT; r -= l * I_OUT; const int nblk = D / 64, kb = r / nblk, nb = r % nblk;
        return TrItem{F.pa->in[I_WOUT] + (size_t)l * D * D, (bf16_t*)(F.ws + WS_WOUT) + (size_t)l * D * D, D, kb * 64, nb * 64, D, nb * 64, 1.0f}; }
    r -= 2 * I_OUT;
    if (r < I_UP) return up_item(F.pa->in[I_FW1], F.pa->in[I_FW3], DFF, (bf16_t*)(F.ws + WS_WUP), r);
    r -= I_UP;
    { const int nblk = D / 64, kb = r / nblk, nb = r % nblk; return TrItem{F.pa->in[I_FW2], (bf16_t*)(F.ws + WS_WDN), D, kb * 64, nb * 64, DFF, nb * 64, 1.0f}; }
}
__device__ __forceinline__ TrItem moe_item(Frame& F, int it) {
    constexpr int I_UP = 2 * 16 * (DEXP / 64), I_DN = (DEXP / 64) * (D / 64), PER_E = I_UP + I_DN;
    const int e = it / PER_E; int r = it - e * PER_E;
    if (r < I_UP) return up_item(F.pa->in[I_MW1] + (size_t)e * D * DEXP, F.pa->in[I_MW3] + (size_t)e * D * DEXP, DEXP, (bf16_t*)(F.ws + WS_MOEUP) + (size_t)e * 2 * DEXP * D, r);
    r -= I_UP;
    { const int nblk = D / 64, kb = r / nblk, nb = r % nblk; return TrItem{F.pa->in[I_MW2] + (size_t)e * DEXP * D, (bf16_t*)(F.ws + WS_MOEDN) + (size_t)e * D * DEXP, D, kb * 64, nb * 64, DEXP, nb * 64, 1.0f}; }
}
__device__ __forceinline__ void phase_convert_small(Frame& F) {
    LAS float* scr = (LAS float*)(F.lds + F.wave * TRS);
    const int gw = F.bid * NWAVES + F.wave, NGW = F.G * NWAVES;
    constexpr int NITEMS = 2 * 16 * (INW / 64) + 2 * 16 * (D / 64) + 2 * 16 * (DFF / 64) + (DFF / 64) * (D / 64);
    if (gw < NITEMS) { TrItem cur = small_item(F, gw); f32x4 va[16], vb[16]; tr_load(cur, va, F.lane);
        for (int it = gw; it < NITEMS; it += 2 * NGW) {
            const bool h1 = it + NGW < NITEMS; TrItem n1 = cur; if (h1) { n1 = small_item(F, it + NGW); tr_load(n1, vb, F.lane); }
            tr_store(cur, va, scr, F.lane);
            if (!h1) break;
            const bool h2 = it + 2 * NGW < NITEMS; if (h2) { cur = small_item(F, it + 2 * NGW); tr_load(cur, va, F.lane); }
            tr_store(n1, vb, scr, F.lane);
            if (!h2) break; } }
    { const int gt = F.bid * NTHREADS + F.tid, NGT = F.G * NTHREADS; bf16_t* o = (bf16_t*)(F.ws + WS_RGW);
      for (int i = gt; i < 2 * 2 * 2 * 8 * 64 * 64; i += NGT) { const int c = i & 63, dp = (i >> 6) & 63, blk = (i >> 12) & 7, gate = (i >> 15) & 1, dir = (i >> 16) & 1, l = i >> 17;
          const float* src = gate ? F.pa->in[I_RGWX] : F.pa->in[I_RGWA]; o[i] = (bf16_t)f2bf(src[((((size_t)l * 2 + dir) * 8 + blk) * 64 + c) * 64 + dp]); } }
    { const int gt = F.bid * NTHREADS + F.tid, NGT = F.G * NTHREADS; float* ct = (float*)(F.ws + WS_ROPE); float* st = ct + 4096 * 64;
      for (int i = gt; i < 4096 * 64; i += NGT) { const int pos = i >> 6, fi = i & 63; const float p = (float)((fi < 32) ? (pos >> 6) : (pos & 63));
          const float inv = powf(10000.0f, -(float)(fi & 31) / 32.0f); const float ang = p * inv;
          const double a = (double)ang; const double kq = __builtin_rint(a * 0.63661977236758134308); const double rr = a - kq * 1.57079632679489661923; const int q = ((int)kq) & 3;
          const double r2 = rr * rr;
          const double sn = rr * (1.0 + r2 * (-1.0 / 6 + r2 * (1.0 / 120 + r2 * (-1.0 / 5040 + r2 * (1.0 / 362880 + r2 * (-1.0 / 39916800))))));
          const double cs = 1.0 + r2 * (-0.5 + r2 * (1.0 / 24 + r2 * (-1.0 / 720 + r2 * (1.0 / 40320 + r2 * (-1.0 / 3628800 + r2 * (1.0 / 479001600))))));
          const double c_ = (q == 0) ? cs : (q == 1) ? -sn : (q == 2) ? -cs : sn; const double s_ = (q == 0) ? sn : (q == 1) ? cs : (q == 2) ? -sn : -cs;
          ct[i] = (float)c_; st[i] = (float)s_; } }
}
struct MoeTile { const float* W; bf16_t* WT; int ldw, k0, n0, ldt, up; };
__device__ __forceinline__ MoeTile moe_tile(Frame& F, int t) {
    constexpr int T_UP1 = (D / 128) * (DEXP / 256), T_DN = (DEXP / 128) * (D / 256), PER_E = 2 * T_UP1 + T_DN;
    const int e = t / PER_E; int r = t - e * PER_E;
    if (r < 2 * T_UP1) { const int which = r / T_UP1; r -= which * T_UP1; const int nb = DEXP / 256, kb = r / nb, nn = r % nb;
        return MoeTile{(which ? F.pa->in[I_MW3] : F.pa->in[I_MW1]) + (size_t)e * D * DEXP, (bf16_t*)(F.ws + WS_MOEUP) + (size_t)e * 2 * DEXP * D, DEXP, kb * 128, nn * 256, D, 1 + which}; }
    r -= 2 * T_UP1;
    { const int nb = D / 256, kb = r / nb, nn = r % nb; return MoeTile{F.pa->in[I_MW2] + (size_t)e * DEXP * D, (bf16_t*)(F.ws + WS_MOEDN) + (size_t)e * D * DEXP, D, kb * 128, nn * 256, DEXP, 0}; }
}
__device__ __forceinline__ void moe_tile_load(const MoeTile& t, f32x4 (&v)[16], int wave, int lane) {
#pragma unroll
    for (int i = 0; i < 16; ++i) v[i] = *(const f32x4*)(t.W + (size_t)(t.k0 + 16 * wave + i) * t.ldw + t.n0 + 4 * lane);
}
__device__ __forceinline__ void moe_tile_store(Frame& F, const MoeTile& t, const f32x4 (&v)[16]) {
    LAS float* tile = (LAS float*)F.lds;
#pragma unroll
    for (int i = 0; i < 16; ++i) { const int k = 16 * F.wave + i, p = (4 * F.lane + 2 * (k >> 3)) & 255;
        *(LAS f32x2*)(tile + k * 256 + p) = (f32x2){v[i].x, v[i].y}; *(LAS f32x2*)(tile + k * 256 + ((p + 2) & 255)) = (f32x2){v[i].z, v[i].w}; }
    __syncthreads();
#pragma unroll
    for (int j = 0; j < 8; ++j) { const int task = F.tid + j * NTHREADS, c = task & 15, n = task >> 4; const LAS float* sp = tile + (8 * c) * 256 + ((n + 2 * c) & 255);
        u32x4 o; o.x = pk2(sp[0], sp[256]); o.y = pk2(sp[512], sp[768]); o.z = pk2(sp[1024], sp[1280]); o.w = pk2(sp[1536], sp[1792]);
        const int col = t.n0 + n; const int drow = t.up ? (col >> 7) * 256 + (col & 127) + 128 * (t.up - 1) : col;
        *(u32x4*)(t.WT + (size_t)drow * t.ldt + t.k0 + 8 * c) = o; }
    __syncthreads();
}
__device__ __forceinline__ void phase_convert_moe(Frame& F) {
    constexpr int NT = NE * (2 * (D / 128) * (DEXP / 256) + (DEXP / 128) * (D / 256));
    if (F.bid < NT) { MoeTile cur = moe_tile(F, F.bid); f32x4 va[16], vb[16]; moe_tile_load(cur, va, F.wave, F.lane);
        for (int t = F.bid; t < NT; t += 2 * F.G) {
            const bool h1 = t + F.G < NT; MoeTile n1 = cur; if (h1) { n1 = moe_tile(F, t + F.G); moe_tile_load(n1, vb, F.wave, F.lane); }
            moe_tile_store(F, cur, va);
            if (!h1) break;
            const bool h2 = t + 2 * F.G < NT; if (h2) { cur = moe_tile(F, t + 2 * F.G); moe_tile_load(cur, va, F.wave, F.lane); }
            moe_tile_store(F, n1, vb);
            if (!h2) break; } }
}
__device__ __forceinline__ void phase_mod(Frame& F) {
    LAS float* sc = (LAS float*)F.lds;
    LAS float* red = (LAS float*)(F.lds + 9 * 1024 * 4);
    for (int i = F.tid; i < 9 * 1024; i += NTHREADS) { const int r = i >> 10, k = i & 1023; const float v = (r < 8) ? F.pa->in[I_C][r * 1024 + k] : F.pa->in[I_CCTX][k]; sc[i] = v / (1.0f + __expf(-v)); }
    __syncthreads();
    for (int strip = F.bid; strip < 2 * 6144 / 64; strip += F.G) {
        const int l = strip / 96, j = (strip % 96) * 64 + F.lane;
        const float* w = F.pa->in[I_WMOD] + (size_t)l * 1024 * 6144 + j;
        float a[9];
#pragma unroll
        for (int r = 0; r < 9; ++r) a[r] = 0.f;
        const int k0 = F.wave * 128;
#pragma unroll 1
        for (int kk = k0; kk < k0 + 128; kk += 16) { float wv[16];
#pragma unroll
            for (int i = 0; i < 16; ++i) wv[i] = w[(size_t)(kk + i) * 6144];
#pragma unroll
            for (int i = 0; i < 16; ++i) {
#pragma unroll
                for (int r = 0; r < 9; ++r) a[r] += sc[r * 1024 + kk + i] * wv[i];
                if ((i & 3) == 3) __builtin_amdgcn_sched_barrier(0); } }
#pragma unroll
        for (int r = 0; r < 9; ++r) red[(F.wave * 9 + r) * 64 + F.lane] = a[r];
        __syncthreads();
        for (int i = F.tid; i < 9 * 64; i += NTHREADS) { const int r = i >> 6, jj = i & 63; float s = 0.f;
#pragma unroll
            for (int w8 = 0; w8 < 8; ++w8) s += red[(w8 * 9 + r) * 64 + jj];
            const int col = (strip % 96) * 64 + jj; s += F.pa->in[I_BMOD][l * 6144 + col];
            if (r < 8) ((float*)(F.ws + WS_MODLAT))[((size_t)l * 8 + r) * 6144 + col] = s; else ((float*)(F.ws + WS_MODCTX))[(size_t)l * 6144 + col] = s; }
        __syncthreads();
    }
}

__device__ __forceinline__ void norm_row(const u32x2 (&xw)[4], const f32x4 (&Am)[4], const f32x4 (&Sh)[4], bf16_t* orow, int lane, f32x4 (&y)[4]) {
    f32x4 v[4]; float ss = 0.f;
#pragma unroll
    for (int j = 0; j < 4; ++j) { const u32x2 w = xw[j]; v[j] = (f32x4){bf2f(w.x & 0xffffu), __uint_as_float(w.x & 0xffff0000u), bf2f(w.y & 0xffffu), __uint_as_float(w.y & 0xffff0000u)};
        ss += (v[j].x * v[j].x + v[j].y * v[j].y) + (v[j].z * v[j].z + v[j].w * v[j].w); }
    const float rstd = 1.0f / sqrtf(wave_sum(ss) * (1.0f / D) + EPS);
    u32x2* o8 = (u32x2*)orow + lane;
#pragma unroll
    for (int j = 0; j < 4; ++j) { y[j] = (v[j] * rstd) * Am[j] + Sh[j]; o8[64 * j] = (u32x2){pk2(y[j].x, y[j].y), pk2(y[j].z, y[j].w)}; }
}
struct SlabRed { const float* slab; int S; const float* gate; const float* xold; float* xnew; };
__device__ __forceinline__ void norm_row_v(f32x4 (&v)[4], const float* g, const float* shift, const float* scale, bf16_t* orow, int lane) {
    float ss = 0.f;
#pragma unroll
    for (int j = 0; j < 4; ++j) ss += (v[j].x * v[j].x + v[j].y * v[j].y) + (v[j].z * v[j].z + v[j].w * v[j].w);
    const float rstd = 1.0f / sqrtf(wave_sum(ss) * (1.0f / D) + EPS);
    u32x2* o8 = (u32x2*)orow + lane;
#pragma unroll
    for (int j = 0; j < 4; ++j) { const f32x4 gg = ((const f32x4*)g)[lane + 64 * j], sh = ((const f32x4*)shift)[lane + 64 * j], sl = ((const f32x4*)scale)[lane + 64 * j];
        const f32x4 y = (v[j] * rstd) * gg * (sl + 1.0f) + sh;
        u32x2 w; w.x = pk2(y.x, y.y); w.y = pk2(y.z, y.w); o8[64 * j] = w; }
}
__device__ __forceinline__ void phase_norm(Frame& F, int l, int sel, const float* xlat, const bf16_t* xb, const float* xctx, int nrows, const SlabRed sr) {
    const int gw = F.bid * NWAVES + F.wave, NGW = F.G * NWAVES;
    const float* g = (sel ? F.pa->in[I_GFFN] : F.pa->in[I_GMIX]) + l * D; const int so = sel ? 3072 : 0;
    bf16_t* HX = (bf16_t*)(F.ws + WS_HX);
    const int nlat = nrows < NLAT ? nrows : NLAT; const int per = (nlat + NGW - 1) / NGW, r_lo = gw * per, r_hi = (r_lo + per < nlat) ? r_lo + per : nlat;
    int curb = -1; f32x4 Am[4], Sh[4];
    for (int row0 = r_lo; row0 < r_hi; row0 += 4) {
        f32x4 v[4][4];
#pragma unroll
        for (int u = 0; u < 4; ++u) { const int row = (row0 + u < r_hi) ? row0 + u : row0;
            if (xb) { const u32x2* xr = (const u32x2*)(xb + (size_t)row * D) + F.lane;
#pragma unroll
                for (int j = 0; j < 4; ++j) { const u32x2 w = xr[64 * j]; v[u][j] = (f32x4){bf2f(w.x & 0xffffu), __uint_as_float(w.x & 0xffff0000u), bf2f(w.y & 0xffffu), __uint_as_float(w.y & 0xffff0000u)}; } }
            else { const f32x4* xr = (const f32x4*)(xlat + (size_t)row * D) + F.lane;
#pragma unroll
                for (int j = 0; j < 4; ++j) v[u][j] = xr[64 * j]; } }
#pragma unroll
        for (int u = 0; u < 4; ++u) { const int row = row0 + u; if (row >= r_hi) continue;
            const int b = row / SEQ;
            if (b != curb) { curb = b; const float* mod = (const float*)(F.ws + WS_MODLAT) + ((size_t)l * 8 + b) * 6144 + so;
#pragma unroll
                for (int j = 0; j < 4; ++j) { Am[j] = ((const f32x4*)g)[F.lane + 64 * j] * (((const f32x4*)(mod + 1024))[F.lane + 64 * j] + 1.0f); Sh[j] = ((const f32x4*)mod)[F.lane + 64 * j]; } }
            float ss = 0.f;
#pragma unroll
            for (int j = 0; j < 4; ++j) ss += (v[u][j].x * v[u][j].x + v[u][j].y * v[u][j].y) + (v[u][j].z * v[u][j].z + v[u][j].w * v[u][j].w);
            const float rstd = 1.0f / sqrtf(wave_sum(ss) * (1.0f / D) + EPS);
            u32x2* o8 = (u32x2*)(HX + (size_t)row * D) + F.lane;
#pragma unroll
            for (int j = 0; j < 4; ++j) { const f32x4 y = (v[u][j] * rstd) * Am[j] + Sh[j]; o8[64 * j] = (u32x2){pk2(y.x, y.y), pk2(y.z, y.w)}; } }
    }
    for (int row = NLAT + gw; row < nrows; row += NGW) {
        const float* mod = (const float*)(F.ws + WS_MODCTX) + (size_t)l * 6144;
        f32x4 v[4];
        if (sr.slab == nullptr) { const f32x4* xr = (const f32x4*)(xctx + (size_t)(row - NLAT) * D) + F.lane;
#pragma unroll
            for (int j = 0; j < 4; ++j) v[j] = xr[64 * j]; }
        else { const int rc = row - NLAT, pmr = rc >> 8, r = rc & 255;
#pragma unroll
            for (int j = 0; j < 4; ++j) { f32x4 a = zero4(); const float* sp = sr.slab + (size_t)((pmr + 8 * j) * sr.S) * 65536 + (size_t)r * 256 + 4 * F.lane;
                f32x4 t8[8];
#pragma unroll
                for (int q = 0; q < 8; ++q) t8[q] = *(const f32x4*)(sp + (size_t)(q < sr.S ? q : sr.S - 1) * 65536);
#pragma unroll
                for (int q = 0; q < 8; ++q) a += t8[q] * (q < sr.S ? 1.0f : 0.0f);
                v[j] = ((const f32x4*)(sr.xold + (size_t)rc * D))[F.lane + 64 * j] + ((const f32x4*)sr.gate)[F.lane + 64 * j] * a;
                ((f32x4*)(sr.xnew + (size_t)rc * D))[F.lane + 64 * j] = v[j]; } }
        norm_row_v(v, g, mod + so, mod + so + 1024, HX + (size_t)row * D, F.lane);
    }
}
__device__ __forceinline__ void moe_reduce(Frame& F, int k) {
    const int* meta = (const int*)(F.ws + MOE_META) + 9 * k; const int npan = meta[8], gsz = npan - 128;
    if (gsz <= 0) return;
    const int S = pg8::split_factor(npan * 4, F.G, DEXP / 64, MAXSLAB_M); if (S < 2) return;
    const int gw = F.bid * NWAVES + F.wave, NGW = F.G * NWAVES;
    const int* ptok = (const int*)(F.ws + MOE_PTOK) + k * MROWS; const float* pw = (const float*)(F.ws + MOE_PW) + k * MROWS;
    const float* slab = (const float*)(F.ws + WS_SLABM); const float* gate_lat = (const float*)(F.ws + WS_MODLAT) + (size_t)8 * 6144 + 5120;
    for (int rr = NLAT + gw; rr < npan * 256; rr += NGW) { const int tok = ptok[rr]; if (tok < 0) continue; const float w = pw[rr];
        const int pmr = (rr - NLAT) >> 8, r = rr & 255; u32x2* xr = (u32x2*)((bf16_t*)((char*)F.out + XB_OFF) + (size_t)tok * D); const f32x4* gt = (const f32x4*)(gate_lat + (size_t)(tok / SEQ) * 6144);
#pragma unroll
        for (int j = 0; j < 4; ++j) { f32x4 a = zero4(); const float* sp = slab + (size_t)((pmr + gsz * j) * S) * 65536 + (size_t)r * 256 + 4 * F.lane;
            { f32x4 t8[8];
#pragma unroll
              for (int q = 0; q < 8; ++q) t8[q] = *(const f32x4*)(sp + (size_t)(q < S ? q : S - 1) * 65536);
#pragma unroll
              for (int q = 0; q < 8; ++q) a += t8[q] * (q < S ? 1.0f : 0.0f); }
            const u32x2 xo = xr[F.lane + 64 * j]; const f32x4 xv = {bf2f(xo.x & 0xffffu), __uint_as_float(xo.x & 0xffff0000u), bf2f(xo.y & 0xffffu), __uint_as_float(xo.y & 0xffff0000u)};
            const f32x4 y = xv + (gt[F.lane + 64 * j] * w) * a; xr[F.lane + 64 * j] = (u32x2){pk2(y.x, y.y), pk2(y.z, y.w)}; } }
}
__device__ __forceinline__ void phase_norm_router(Frame& F, const bf16_t* xb) {
    constexpr int l = 1;
    LAS float* wr = (LAS float*)F.lds;
    LAS int* le = (LAS int*)(F.lds + 32768);
    for (int i = F.tid; i < 1024 * 8 / 4; i += NTHREADS) ((LAS f32x4*)wr)[i] = ((const f32x4*)F.pa->in[I_MROUTER])[i];
    __syncthreads();
    const float* g = F.pa->in[I_GFFN] + l * D; bf16_t* HX = (bf16_t*)(F.ws + WS_HX);
    int* toke = (int*)(F.ws + MOE_TOKE); float* tokw = (float*)(F.ws + MOE_TOKW);
    for (int wg = F.bid; wg < NLAT / 128; wg += F.G) {
        u32x2 nx[4]; f32x4 Am[4], Sh[4];
        { const float* mod = (const float*)(F.ws + WS_MODLAT) + ((size_t)l * 8 + (wg * 128) / SEQ) * 6144 + 3072;
#pragma unroll
          for (int j = 0; j < 4; ++j) { Am[j] = ((const f32x4*)g)[F.lane + 64 * j] * (((const f32x4*)(mod + 1024))[F.lane + 64 * j] + 1.0f); Sh[j] = ((const f32x4*)mod)[F.lane + 64 * j]; } }
        { const u32x2* xr = (const u32x2*)(xb + (size_t)(wg * 128 + F.wave * 16) * D) + F.lane;
#pragma unroll
          for (int j = 0; j < 4; ++j) nx[j] = xr[64 * j]; }
        for (int i = 0; i < 16; ++i) { const int tl = F.wave * 16 + i, row = wg * 128 + tl;
            u32x2 cx[4];
#pragma unroll
            for (int j = 0; j < 4; ++j) cx[j] = nx[j];
            { const int rn = (i < 15) ? row + 1 : row; const u32x2* xr = (const u32x2*)(xb + (size_t)rn * D) + F.lane;
#pragma unroll
              for (int j = 0; j < 4; ++j) nx[j] = xr[64 * j]; }
            f32x4 y[4]; norm_row(cx, Am, Sh, HX + (size_t)row * D, F.lane, y);
            float lg[8];
#pragma unroll
            for (int e = 0; e < 8; ++e) lg[e] = 0.f;
#pragma unroll
            for (int j = 0; j < 4; ++j)
#pragma unroll
                for (int q = 0; q < 4; ++q) { const int k = 4 * F.lane + 256 * j + q; const f32x4 w0 = *(const LAS f32x4*)(wr + k * 8), w1 = *(const LAS f32x4*)(wr + k * 8 + 4); const float yv = y[j][q];
                    lg[0] += yv * w0.x; lg[1] += yv * w0.y; lg[2] += yv * w0.z; lg[3] += yv * w0.w; lg[4] += yv * w1.x; lg[5] += yv * w1.y; lg[6] += yv * w1.z; lg[7] += yv * w1.w; }
#pragma unroll
            for (int e = 0; e < 8; ++e) lg[e] = wave_sum(lg[e]) + F.pa->in[I_MROUTERB][e];
            int e0 = 0; float v0 = lg[0];
#pragma unroll
            for (int e = 1; e < 8; ++e) if (lg[e] > v0) { v0 = lg[e]; e0 = e; }
            int e1 = -1; float v1 = -3.0e38f;
#pragma unroll
            for (int e = 0; e < 8; ++e) if (e != e0 && lg[e] > v1) { v1 = lg[e]; e1 = e; }
            const float w0 = 1.0f / (1.0f + __expf(v1 - v0));
            if (F.lane == 0) { toke[row] = e0 | (e1 << 8); tokw[2 * row] = w0; tokw[2 * row + 1] = 1.0f - w0; le[tl] = e0 | (e1 << 8); }
        }
        __syncthreads();
        if (F.tid < 16) { const int k = F.tid >> 3, e = F.tid & 7; int c = 0; for (int t = 0; t < 128; ++t) c += (((le[t] >> (8 * k)) & 0xff) == e) ? 1 : 0; ((int*)(F.ws + MOE_CNT))[wg * 16 + F.tid] = c; }
        __syncthreads();
    }
}
__device__ __forceinline__ void phase_moe_sort(Frame& F) {
    LAS int* tot = (LAS int*)F.lds;
    LAS int* pre = tot + 16;
    LAS int* seg = tot + 32;
    LAS int* le = tot + 64;
    const int* cnt = (const int*)(F.ws + MOE_CNT); const int* toke = (const int*)(F.ws + MOE_TOKE); const float* tokw = (const float*)(F.ws + MOE_TOKW);
    int* ptok = (int*)(F.ws + MOE_PTOK); float* pw = (float*)(F.ws + MOE_PW); int* meta = (int*)(F.ws + MOE_META);
    for (int wg = F.bid; wg < NLAT / 128; wg += F.G) {
        { LAS int* part = tot + 256;
          if (F.tid < 256) { const int col = F.tid & 15, pt = F.tid >> 4; int t = 0, p = 0;
#pragma unroll
              for (int i = 0; i < 16; ++i) { const int w = pt * 16 + i; const int c = cnt[w * 16 + col]; t += c; p += (w < wg) ? c : 0; }
              part[pt * 16 + col] = t; part[256 + pt * 16 + col] = p; }
          if (F.tid >= 256 && F.tid < 384) le[F.tid - 256] = toke[wg * 128 + F.tid - 256];
          __syncthreads();
          if (F.tid < 16) { int t = 0, p = 0;
#pragma unroll
              for (int pt = 0; pt < 16; ++pt) { t += part[pt * 16 + F.tid]; p += part[256 + pt * 16 + F.tid]; }
              tot[F.tid] = t; pre[F.tid] = p; } }
        __syncthreads();
        if (F.tid < 2) { int s = 0; for (int e = 0; e < 8; ++e) { seg[F.tid * 9 + e] = s; s += (tot[F.tid * 8 + e] + 255) & ~255; } seg[F.tid * 9 + 8] = s; }
        __syncthreads();
        if (F.tid < 256) { const int k = F.tid >> 7, t = F.tid & 127; const int e = (le[t] >> (8 * k)) & 0xff; int rank = 0; for (int u = 0; u < t; ++u) rank += (((le[u] >> (8 * k)) & 0xff) == e) ? 1 : 0;
            const int pos = seg[k * 9 + e] + pre[k * 8 + e] + rank; const int tok = wg * 128 + t; ptok[k * MROWS + pos] = tok; pw[k * MROWS + pos] = tokw[2 * tok + k]; ((int*)(F.ws + MOE_PPOS))[k * NLAT + tok] = pos; }
        if (wg < 16) { const int k = wg >> 3, e = wg & 7; const int a = seg[k * 9 + e] + tot[k * 8 + e], b = seg[k * 9 + e + 1]; for (int p = a + F.tid; p < b; p += NTHREADS) { ptok[k * MROWS + p] = -1; pw[k * MROWS + p] = 0.f; } }
        if (wg == 0 && F.tid < 18) meta[F.tid] = seg[F.tid] >> 8;
        __syncthreads();
    }
}
__device__ __forceinline__ void phase_final_a(Frame& F) {
    const int gw = F.bid * NWAVES + F.wave, NGW = F.G * NWAVES; const float* g = F.pa->in[I_GFINAL];
    const bf16_t* xb = (const bf16_t*)((const char*)F.out + XB_OFF); bf16_t* xc = (bf16_t*)(F.ws + WS_XCOPY);
    const int* meta = (const int*)(F.ws + MOE_META) + 9; const int npan = meta[8], gsz = npan - 128;
    const int S = (gsz > 0) ? pg8::split_factor(npan * 4, F.G, DEXP / 64, MAXSLAB_M) : 1;
    const int* ppos = (const int*)(F.ws + MOE_PPOS) + NLAT; const float* pw = (const float*)(F.ws + MOE_PW) + MROWS;
    const float* slab = (const float*)(F.ws + WS_SLABM); const float* gate_lat = (const float*)(F.ws + WS_MODLAT) + (size_t)8 * 6144 + 5120;
    for (int row0 = gw; row0 < NLAT; row0 += 4 * NGW) {
        u32x2 w[4][4]; int rr[4];
#pragma unroll
        for (int u = 0; u < 4; ++u) { const int row = (row0 + u * NGW < NLAT) ? row0 + u * NGW : row0; const u32x2* xr = (const u32x2*)(xb + (size_t)row * D) + F.lane; rr[u] = ppos[row];
#pragma unroll
            for (int j = 0; j < 4; ++j) w[u][j] = xr[64 * j]; }
#pragma unroll
        for (int u = 0; u < 4; ++u) { const int row = row0 + u * NGW; if (row >= NLAT) continue;
            f32x4 v[4];
#pragma unroll
            for (int j = 0; j < 4; ++j) v[j] = (f32x4){bf2f(w[u][j].x & 0xffffu), __uint_as_float(w[u][j].x & 0xffff0000u), bf2f(w[u][j].y & 0xffffu), __uint_as_float(w[u][j].y & 0xffff0000u)};
            if (S >= 2 && rr[u] >= NLAT) { const float wt = pw[rr[u]]; const int pmr = (rr[u] - NLAT) >> 8, r = rr[u] & 255; const f32x4* gt = (const f32x4*)(gate_lat + (size_t)(row / SEQ) * 6144);
#pragma unroll
                for (int j = 0; j < 4; ++j) { f32x4 a = zero4(); const float* sp = slab + (size_t)((pmr + gsz * j) * S) * 65536 + (size_t)r * 256 + 4 * F.lane;
                    { f32x4 t8[8];
#pragma unroll
                      for (int q = 0; q < 8; ++q) t8[q] = *(const f32x4*)(sp + (size_t)(q < S ? q : S - 1) * 65536);
#pragma unroll
                      for (int q = 0; q < 8; ++q) a += t8[q] * (q < S ? 1.0f : 0.0f); }
                    v[j] += (gt[F.lane + 64 * j] * wt) * a; } }
            if (row < NLAT / 2) { float ss = 0.f;
#pragma unroll
                for (int j = 0; j < 4; ++j) ss += (v[j].x * v[j].x + v[j].y * v[j].y) + (v[j].z * v[j].z + v[j].w * v[j].w);
                const float rstd = 1.0f / sqrtf(wave_sum(ss) * (1.0f / D) + EPS); f32x4* o = (f32x4*)(F.out + (size_t)row * D) + F.lane;
#pragma unroll
                for (int j = 0; j < 4; ++j) o[64 * j] = (v[j] * rstd) * ((const f32x4*)g)[F.lane + 64 * j]; }
            else { u32x2* o = (u32x2*)(xc + (size_t)(row - NLAT / 2) * D) + F.lane;
#pragma unroll
                for (int j = 0; j < 4; ++j) o[64 * j] = (u32x2){pk2(v[j].x, v[j].y), pk2(v[j].z, v[j].w)}; } }
    }
}
__device__ __forceinline__ void phase_final_b(Frame& F) {
    const int gw = F.bid * NWAVES + F.wave, NGW = F.G * NWAVES; const float* g = F.pa->in[I_GFINAL]; const bf16_t* xc = (const bf16_t*)(F.ws + WS_XCOPY);
    for (int row0 = NLAT / 2 + gw; row0 < NLAT; row0 += 4 * NGW) {
        u32x2 w[4][4];
#pragma unroll
        for (int u = 0; u < 4; ++u) { const int row = (row0 + u * NGW < NLAT) ? row0 + u * NGW : row0; const u32x2* xr = (const u32x2*)(xc + (size_t)(row - NLAT / 2) * D) + F.lane;
#pragma unroll
            for (int j = 0; j < 4; ++j) w[u][j] = xr[64 * j]; }
#pragma unroll
        for (int u = 0; u < 4; ++u) { const int row = row0 + u * NGW; if (row >= NLAT) continue;
            f32x4 v[4]; float ss = 0.f;
#pragma unroll
            for (int j = 0; j < 4; ++j) { v[j] = (f32x4){bf2f(w[u][j].x & 0xffffu), __uint_as_float(w[u][j].x & 0xffff0000u), bf2f(w[u][j].y & 0xffffu), __uint_as_float(w[u][j].y & 0xffff0000u)};
                ss += (v[j].x * v[j].x + v[j].y * v[j].y) + (v[j].z * v[j].z + v[j].w * v[j].w); }
            const float rstd = 1.0f / sqrtf(wave_sum(ss) * (1.0f / D) + EPS); f32x4* o = (f32x4*)(F.out + (size_t)row * D) + F.lane;
#pragma unroll
            for (int j = 0; j < 4; ++j) o[64 * j] = (v[j] * rstd) * ((const f32x4*)g)[F.lane + 64 * j]; }
    }
}

__device__ __forceinline__ bool fresh(Frame& F) {
    int l_ = (int)__builtin_amdgcn_mbcnt_hi(~0u, __builtin_amdgcn_mbcnt_lo(~0u, 0u)); asm volatile("" : "+v"(l_));
    int w_ = F.wave0; asm volatile("" : "+s"(w_));
    F.lane = l_; F.wave = w_; F.tid = w_ * 64 + l_;
    int b_ = blockIdx.x; asm volatile("" : "+s"(b_)); F.bid = b_;
    GAS unsigned char* w2_ = (GAS unsigned char*)F.ws0; asm volatile("" : "+s"(w2_)); F.ws = (unsigned char*)w2_;
    F.out = F.out0; F.pa = F.pa0;
    return true;
}
struct Item { int b, s, row0, seqbase, t0, seqlen; bool is_ctx; };
__device__ __forceinline__ Item item_info(int item) {
    Item it; it.b = item / SPB; it.s = item % SPB;
    if (it.s < 2) { it.is_ctx = true; it.seqbase = NLAT + it.b * CTXL; it.t0 = it.s * CHK; it.seqlen = CTXL; }
    else { it.is_ctx = false; it.seqbase = it.b * SEQ; it.t0 = (it.s - 2) * CHK; it.seqlen = SEQ; }
    it.row0 = it.seqbase + it.t0; return it;
}
constexpr int UCP = 144;
constexpr int TP = 272;
constexpr int TILEB = 128 * TP;
constexpr int VP = 288;
constexpr int TILEV = 128 * VP;

__device__ __forceinline__ unsigned tr_lane_addr(ldsp_t tile, int lane) { return (unsigned)(__SIZE_TYPE__)tile + (unsigned)((4 * (lane >> 4) + ((lane & 15) >> 2)) * VP + 8 * (lane & 3)); }
__device__ __forceinline__ bf16x8 mk_frag(u32x2 lo, u32x2 hi) { const u32x4 v = {lo.x, lo.y, hi.x, hi.y}; return __builtin_bit_cast(bf16x8, v); }
template <int OFF> __device__ __forceinline__ bf16x8 tr1(unsigned addr) {
    u32x2 a0, a1;
    asm volatile("ds_read_b64_tr_b16 %0, %2 offset:%3\n\tds_read_b64_tr_b16 %1, %2 offset:%4\n\ts_waitcnt lgkmcnt(0)" : "=&v"(a0), "=&v"(a1) : "v"(addr), "i"(OFF), "i"(OFF + 16 * VP) : "memory");
    return mk_frag(a0, a1);
}
template <int OFF> __device__ __forceinline__ void tr4(unsigned addr, bf16x8& f0, bf16x8& f1, bf16x8& f2, bf16x8& f3) {
    u32x2 a0, a1, b0, b1, c0, c1, d0, d1;
    asm volatile("ds_read_b64_tr_b16 %0, %8 offset:%9\n\tds_read_b64_tr_b16 %1, %8 offset:%10\n\tds_read_b64_tr_b16 %2, %8 offset:%11\n\tds_read_b64_tr_b16 %3, %8 offset:%12\n\t"
                 "ds_read_b64_tr_b16 %4, %8 offset:%13\n\tds_read_b64_tr_b16 %5, %8 offset:%14\n\tds_read_b64_tr_b16 %6, %8 offset:%15\n\tds_read_b64_tr_b16 %7, %8 offset:%16\n\ts_waitcnt lgkmcnt(0)"
                 : "=&v"(a0), "=&v"(a1), "=&v"(b0), "=&v"(b1), "=&v"(c0), "=&v"(c1), "=&v"(d0), "=&v"(d1)
                 : "v"(addr), "i"(OFF), "i"(OFF + 16 * VP), "i"(OFF + 32), "i"(OFF + 32 + 16 * VP), "i"(OFF + 64), "i"(OFF + 64 + 16 * VP), "i"(OFF + 96), "i"(OFF + 96 + 16 * VP) : "memory");
    f0 = mk_frag(a0, a1); f1 = mk_frag(b0, b1); f2 = mk_frag(c0, c1); f3 = mk_frag(d0, d1);
}

__device__ __forceinline__ void build_decay(Frame& F, int l) {
    LAS float* dec = (LAS float*)(F.lds + LDS_DEC);
    for (int i = F.tid; i < 2 * 4 * 132; i += NTHREADS) { const int n = i % 132, dh = i / 132; const float x = F.pa->in[I_RETDEC][l * 8 + dh]; const float lg = -log1pf(expf(-x)); dec[i] = expf((float)n * lg); }
}

struct RgStep { bf16x8 bwa[2], bwx[2]; float lam, ba, bx, carry; };
template <bool FINAL>
__device__ __forceinline__ void rg_load_step(RgStep& R, Frame& F, const bf16_t* wgt, int l, int dir, int item, int blk, int n, int lane) {
    const int fr = lane & 15, fq = lane >> 4;
    const bf16_t* wa = wgt + ((size_t)(0 * 8 + blk) * 64 + 16 * n + fr) * 64 + 8 * fq;
    const bf16_t* wx = wgt + ((size_t)(1 * 8 + blk) * 64 + 16 * n + fr) * 64 + 8 * fq;
    R.bwa[0] = *(const bf16x8*)wa; R.bwa[1] = *(const bf16x8*)(wa + 32); R.bwx[0] = *(const bf16x8*)wx; R.bwx[1] = *(const bf16x8*)(wx + 32);
    const int ch = blk * 64 + 16 * n + fr, pi = (l * 2 + dir) * 512 + ch;
    R.lam = F.pa->in[I_RGLAM][pi]; R.ba = F.pa->in[I_RGBA][pi]; R.bx = F.pa->in[I_RGBX][pi];
    R.carry = FINAL ? ((const float*)(F.ws + WS_CARRY))[((size_t)item * 2 + dir) * 512 + ch] : 0.f;
}
template <bool FINAL, int DIR>
__device__ __forceinline__ void rg_dir(ldsp_t ucw, const bf16x8 (&af)[8][2], const RgStep& R, int n, int lane, f32x4 (&hsum)[8], float& Atot, float& Htot) {
    const int fr = lane & 15, fq = lane >> 4;
    constexpr float L2E_ = 1.4426950408889634f;
    const float ba2 = -L2E_ * R.ba, bx2 = -L2E_ * R.bx, cl2 = -8.0f * L2E_ * log1pf(expf(-R.lam)), carry = R.carry;
    const bf16x8 bwa[2] = {R.bwa[0], R.bwa[1]}, bwx[2] = {R.bwx[0], R.bwx[1]};
    f32x4 ar[8], ai[8];
#pragma unroll
    for (int m = 0; m < 8; ++m) { ar[m] = zero4(); ai[m] = zero4(); }
#pragma unroll
    for (int m = 0; m < 8; ++m)
#pragma unroll
        for (int ks = 0; ks < 2; ++ks) { ar[m] = __builtin_amdgcn_mfma_f32_16x16x32_bf16(af[m][ks], bwa[ks], ar[m], 0, 0, 0); ai[m] = __builtin_amdgcn_mfma_f32_16x16x32_bf16(af[m][ks], bwx[ks], ai[m], 0, 0, 0); }
    const unsigned uo = (unsigned)(32 * fq * UCP + (16 * n + fr) * 2);
#pragma unroll
    for (int m = 0; m < 8; ++m)
#pragma unroll
        for (int jj = 0; jj < 4; ++jj) {
            const float r = __builtin_amdgcn_rcpf(1.0f + __builtin_amdgcn_exp2f(__builtin_fmaf(ar[m][jj], -1.4426950408889634f, ba2)));
            const float ig = __builtin_amdgcn_rcpf(1.0f + __builtin_amdgcn_exp2f(__builtin_fmaf(ai[m][jj], -1.4426950408889634f, bx2)));
            const float a = __builtin_amdgcn_exp2f(cl2 * r);
            const float u = bf2f(*(const LAS bf16_t*)(ucw + uo + (4 * m + jj) * UCP));
            ar[m][jj] = a; ai[m][jj] = __builtin_amdgcn_sqrtf(__builtin_fmaf(-a, a, 1.0f)) * ig * u; }
    float gA = 1.f, gH = 0.f;
#pragma unroll
    for (int mm = 0; mm < 8; ++mm) { const int m = DIR ? 7 - mm : mm;
#pragma unroll
        for (int j4 = 0; j4 < 4; ++j4) { const int jj = DIR ? 3 - j4 : j4; gH = __builtin_fmaf(ar[m][jj], gH, ai[m][jj]); gA *= ar[m][jj]; } }
    const float A0 = lane_bcast(gA, fr), H0 = lane_bcast(gH, fr), A1 = lane_bcast(gA, fr + 16), H1 = lane_bcast(gH, fr + 16), A2 = lane_bcast(gA, fr + 32), H2 = lane_bcast(gH, fr + 32), A3 = lane_bcast(gA, fr + 48), H3 = lane_bcast(gH, fr + 48);
    if (FINAL) { float h = carry;
        if (!DIR) { if (fq > 0) h = A0 * h + H0; if (fq > 1) h = A1 * h + H1; if (fq > 2) h = A2 * h + H2; }
        else { if (fq < 3) h = A3 * h + H3; if (fq < 2) h = A2 * h + H2; if (fq < 1) h = A1 * h + H1; }
#pragma unroll
        for (int mm = 0; mm < 8; ++mm) { const int m = DIR ? 7 - mm : mm;
#pragma unroll
            for (int j4 = 0; j4 < 4; ++j4) { const int jj = DIR ? 3 - j4 : j4; h = __builtin_fmaf(ar[m][jj], h, ai[m][jj]); hsum[m][jj] += h; } } }
    if (!DIR) Htot = A3 * (A2 * (A1 * H0 + H1) + H2) + H3; else Htot = A0 * (A1 * (A2 * H3 + H2) + H1) + H0;
    Atot = (A0 * A1) * (A2 * A3);
}
template <bool FINAL, bool SHARED = false>
__device__ __forceinline__ void rg_part(Frame& F, int l, int item, const Item& it, const int blk, const int n0, const int n1) {
    const bf16_t* P = (const bf16_t*)(F.ws + WS_PA);
    int lane = F.lane; const bool act = !SHARED || F.wave < 4;
    ldsp_t ucw = SHARED ? F.lds : F.lds + F.wave * (128 * UCP);
    if (act) { constexpr int NT = SHARED ? 4 : 16;
      const int grp = lane & 7, ch0 = blk * 64 + grp * 8, tok0 = (SHARED ? 32 * F.wave : 0) + (lane >> 3) * NT; float cw[4][8], cb[8];
#pragma unroll
      for (int k = 0; k < 4; ++k)
#pragma unroll
          for (int i = 0; i < 8; ++i) cw[k][i] = F.pa->in[I_CONVW][((size_t)l * 4 + k) * 512 + ch0 + i];
#pragma unroll
      for (int i = 0; i < 8; ++i) cb[i] = F.pa->in[I_CONVB][l * 512 + ch0 + i];
      const bf16_t* Pu = P + (size_t)it.seqbase * INW + ch0;
      u32x4 rv[NT + 3];
#pragma unroll
      for (int r = 0; r < NT + 3; ++r) { const int tt = it.t0 + tok0 + r - 2; const int tc = tt < 0 ? 0 : (tt >= it.seqlen ? it.seqlen - 1 : tt);
          rv[r] = ldg<u32x4>(Pu, (unsigned)tc * (unsigned)(INW * 2)); if (tt != tc) rv[r] = (u32x4){0u, 0u, 0u, 0u}; }
      float win[4][8];
#pragma unroll
      for (int r = 0; r < 3; ++r) { win[r][0] = bf2f(rv[r].x & 0xffffu); win[r][1] = __uint_as_float(rv[r].x & 0xffff0000u); win[r][2] = bf2f(rv[r].y & 0xffffu); win[r][3] = __uint_as_float(rv[r].y & 0xffff0000u);
          win[r][4] = bf2f(rv[r].z & 0xffffu); win[r][5] = __uint_as_float(rv[r].z & 0xffff0000u); win[r][6] = bf2f(rv[r].w & 0xffffu); win[r][7] = __uint_as_float(rv[r].w & 0xffff0000u); }
#pragma unroll
      for (int j = 0; j < NT; ++j) { const int r = j + 3, s3 = (j + 3) & 3;
          win[s3][0] = bf2f(rv[r].x & 0xffffu); win[s3][1] = __uint_as_float(rv[r].x & 0xffff0000u); win[s3][2] = bf2f(rv[r].y & 0xffffu); win[s3][3] = __uint_as_float(rv[r].y & 0xffff0000u);
          win[s3][4] = bf2f(rv[r].z & 0xffffu); win[s3][5] = __uint_as_float(rv[r].z & 0xffff0000u); win[s3][6] = bf2f(rv[r].w & 0xffffu); win[s3][7] = __uint_as_float(rv[r].w & 0xffff0000u);
          float o[8];
#pragma unroll
          for (int i = 0; i < 8; ++i) o[i] = cb[i] + cw[0][i] * win[j & 3][i] + cw[1][i] * win[(j + 1) & 3][i] + cw[2][i] * win[(j + 2) & 3][i] + cw[3][i] * win[s3][i];
          u32x4 w; w.x = pk2(o[0], o[1]); w.y = pk2(o[2], o[3]); w.z = pk2(o[4], o[5]); w.w = pk2(o[6], o[7]);
          *(LAS u32x4*)(ucw + (tok0 + j) * UCP + grp * 16) = w; }
      LDS_WAIT(); asm volatile("" ::: "memory"); }
    if (SHARED) __syncthreads();
    asm volatile("" : "+v"(lane));
    bf16x8 af[8][2];
    if (act) { const int fr = lane & 15, fq = lane >> 4;
#pragma unroll
      for (int m = 0; m < 8; ++m)
#pragma unroll
          for (int ks = 0; ks < 2; ++ks) af[m][ks] = *(const LAS bf16x8*)(ucw + (32 * (fr >> 2) + 4 * m + (fr & 3)) * UCP + (8 * fq + 32 * ks) * 2); }
    if (SHARED) { __syncthreads(); if (!act) return; }
    const bf16_t* wg0 = (const bf16_t*)(F.ws + WS_RGW) + (size_t)(l * 2 + 0) * 2 * 8 * 4096;
    const bf16_t* wg1 = (const bf16_t*)(F.ws + WS_RGW) + (size_t)(l * 2 + 1) * 2 * 8 * 4096;
    float* TOT = (float*)(F.ws + WS_TOT);
    RgStep R0, R1;
    rg_load_step<FINAL>(R0, F, wg0, l, 0, item, blk, n0, lane);
#pragma unroll 1
    for (int n = n0; n < n1; ++n) { asm volatile("" : "+v"(lane));
        const int fr = lane & 15, fq = lane >> 4; const int ch = blk * 64 + 16 * n + fr;
        f32x4 hsum[8];
#pragma unroll
        for (int m = 0; m < 8; ++m) hsum[m] = zero4();
        rg_load_step<FINAL>(R1, F, wg1, l, 1, item, blk, n, lane);
        { float At, Ht;
          rg_dir<FINAL, 0>(ucw, af, R0, n, lane, hsum, At, Ht);
          if (!FINAL && fq == 0) { *(f32x2*)(TOT + (((size_t)item * 2 + 0) * 512 + ch) * 2) = (f32x2){At, Ht}; } }
        __builtin_amdgcn_sched_barrier(0);
        if (n + 1 < n1) rg_load_step<FINAL>(R0, F, wg0, l, 0, item, blk, n + 1, lane);
        { float At, Ht;
          rg_dir<FINAL, 1>(ucw, af, R1, n, lane, hsum, At, Ht);
          if (!FINAL && fq == 0) { *(f32x2*)(TOT + (((size_t)item * 2 + 1) * 512 + ch) * 2) = (f32x2){At, Ht}; } }
        if (FINAL) {
            const unsigned uo = (unsigned)(32 * fq * UCP + (16 * n + fr) * 2);
#pragma unroll
            for (int m = 0; m < 8; ++m)
#pragma unroll
                for (int jj = 0; jj < 4; ++jj) *(LAS bf16_t*)(ucw + uo + (4 * m + jj) * UCP) = (bf16_t)f2bf(hsum[m][jj]); }
    }
    if (FINAL) {
        LDS_WAIT(); asm volatile("" : "+v"(lane) :: "memory");
        const int ng = 2 * (n1 - n0);
        const int grp = 2 * n0 + ((ng == 8) ? (lane & 7) : (lane & 1)); const int tk0 = (ng == 8) ? (lane >> 3) : (lane >> 1), tstep = (ng == 8) ? 8 : 32, nq = (ng == 8) ? 16 : 4;
        const bf16_t* Pg = P + (size_t)it.row0 * INW + 512 + blk * 64 + grp * 8; bf16_t* Yo = (bf16_t*)(F.ws + WS_Y) + (size_t)it.row0 * D + blk * 64 + grp * 8;
#pragma unroll 8
        for (int q = 0; q < nq; ++q) { const int token = tk0 + tstep * q;
            const u32x4 hv = *(const LAS u32x4*)(ucw + token * UCP + grp * 16); const u32x4 gv = ldg<u32x4>(Pg, (unsigned)token * (unsigned)(INW * 2));
            u32x4 w;
            w.x = pk2(gelu_tanh(bf2f(gv.x & 0xffffu)) * bf2f(hv.x & 0xffffu), gelu_tanh(__uint_as_float(gv.x & 0xffff0000u)) * __uint_as_float(hv.x & 0xffff0000u));
            w.y = pk2(gelu_tanh(bf2f(gv.y & 0xffffu)) * bf2f(hv.y & 0xffffu), gelu_tanh(__uint_as_float(gv.y & 0xffff0000u)) * __uint_as_float(hv.y & 0xffff0000u));
            w.z = pk2(gelu_tanh(bf2f(gv.z & 0xffffu)) * bf2f(hv.z & 0xffffu), gelu_tanh(__uint_as_float(gv.z & 0xffff0000u)) * __uint_as_float(hv.z & 0xffff0000u));
            w.w = pk2(gelu_tanh(bf2f(gv.w & 0xffffu)) * bf2f(hv.w & 0xffffu), gelu_tanh(__uint_as_float(gv.w & 0xffff0000u)) * __uint_as_float(hv.w & 0xffff0000u));
            stg<u32x4>(Yo, (unsigned)token * (unsigned)(D * 2), w); }
        LDS_WAIT();
    }
}

__device__ __forceinline__ void stage_rows(Frame& F, ldsp_t dst, const Item& it, int col0, bool rope) {
    const bf16_t* P = (const bf16_t*)(F.ws + WS_PA); const float* ct = (const float*)(F.ws + WS_ROPE); const float* st = ct + 4096 * 64;
    for (int task = F.tid; task < 1024; task += NTHREADS) { const int token = task >> 3, d0 = (task & 7) * 8;
        const bf16_t* src = P + (size_t)(it.row0 + token) * INW + col0;
        const u32x4 lo = *(const u32x4*)(src + d0), hi = *(const u32x4*)(src + d0 + 64);
        u32x4 olo = lo, ohi = hi;
        if (rope) { const int pos = it.t0 + token; const f32x4 c0 = *(const f32x4*)(ct + pos * 64 + d0), c1 = *(const f32x4*)(ct + pos * 64 + d0 + 4), s0 = *(const f32x4*)(st + pos * 64 + d0), s1 = *(const f32x4*)(st + pos * 64 + d0 + 4);
            const float a[8] = {bf2f(lo.x & 0xffffu), __uint_as_float(lo.x & 0xffff0000u), bf2f(lo.y & 0xffffu), __uint_as_float(lo.y & 0xffff0000u), bf2f(lo.z & 0xffffu), __uint_as_float(lo.z & 0xffff0000u), bf2f(lo.w & 0xffffu), __uint_as_float(lo.w & 0xffff0000u)};
            const float b[8] = {bf2f(hi.x & 0xffffu), __uint_as_float(hi.x & 0xffff0000u), bf2f(hi.y & 0xffffu), __uint_as_float(hi.y & 0xffff0000u), bf2f(hi.z & 0xffffu), __uint_as_float(hi.z & 0xffff0000u), bf2f(hi.w & 0xffffu), __uint_as_float(hi.w & 0xffff0000u)};
            const float c[8] = {c0.x, c0.y, c0.z, c0.w, c1.x, c1.y, c1.z, c1.w}, s[8] = {s0.x, s0.y, s0.z, s0.w, s1.x, s1.y, s1.z, s1.w};
            float ra[8], rb[8];
#pragma unroll
            for (int i = 0; i < 8; ++i) { ra[i] = a[i] * c[i] - b[i] * s[i]; rb[i] = a[i] * s[i] + b[i] * c[i]; }
            olo.x = pk2(ra[0], ra[1]); olo.y = pk2(ra[2], ra[3]); olo.z = pk2(ra[4], ra[5]); olo.w = pk2(ra[6], ra[7]);
            ohi.x = pk2(rb[0], rb[1]); ohi.y = pk2(rb[2], rb[3]); ohi.z = pk2(rb[4], rb[5]); ohi.w = pk2(rb[6], rb[7]); }
        *(LAS u32x4*)(dst + token * TP + d0 * 2) = olo; *(LAS u32x4*)(dst + token * TP + (d0 + 64) * 2) = ohi; }
}
__device__ __forceinline__ void stage_cols(Frame& F, ldsp_t dst, const Item& it, int col0) {
    const bf16_t* P = (const bf16_t*)(F.ws + WS_PA);
    for (int task = F.tid; task < 2048; task += NTHREADS) { const int token = task >> 4, d0 = (task & 15) * 8;
        const u32x4 v = *(const u32x4*)(P + (size_t)(it.row0 + token) * INW + col0 + d0);
        const unsigned w[4] = {v.x, v.y, v.z, v.w};
#pragma unroll
        for (int i = 0; i < 4; ++i) { *(LAS bf16_t*)(dst + (d0 + 2 * i) * TP + token * 2) = (bf16_t)(w[i] & 0xffffu); *(LAS bf16_t*)(dst + (d0 + 2 * i + 1) * TP + token * 2) = (bf16_t)(w[i] >> 16); } }
}
__device__ __forceinline__ void rope8(u32x4& lo, u32x4& hi, const float* ct, const float* st, int pos, int d0) {
    const f32x4 c0 = *(const f32x4*)(ct + pos * 64 + d0), c1 = *(const f32x4*)(ct + pos * 64 + d0 + 4), s0 = *(const f32x4*)(st + pos * 64 + d0), s1 = *(const f32x4*)(st + pos * 64 + d0 + 4);
    const float a[8] = {bf2f(lo.x & 0xffffu), __uint_as_float(lo.x & 0xffff0000u), bf2f(lo.y & 0xffffu), __uint_as_float(lo.y & 0xffff0000u), bf2f(lo.z & 0xffffu), __uint_as_float(lo.z & 0xffff0000u), bf2f(lo.w & 0xffffu), __uint_as_float(lo.w & 0xffff0000u)};
    const float b[8] = {bf2f(hi.x & 0xffffu), __uint_as_float(hi.x & 0xffff0000u), bf2f(hi.y & 0xffffu), __uint_as_float(hi.y & 0xffff0000u), bf2f(hi.z & 0xffffu), __uint_as_float(hi.z & 0xffff0000u), bf2f(hi.w & 0xffffu), __uint_as_float(hi.w & 0xffff0000u)};
    const float c[8] = {c0.x, c0.y, c0.z, c0.w, c1.x, c1.y, c1.z, c1.w}, sn[8] = {s0.x, s0.y, s0.z, s0.w, s1.x, s1.y, s1.z, s1.w};
    float ra[8], rb[8];
#pragma unroll
    for (int i = 0; i < 8; ++i) { ra[i] = a[i] * c[i] - b[i] * sn[i]; rb[i] = a[i] * sn[i] + b[i] * c[i]; }
    lo = (u32x4){pk2(ra[0], ra[1]), pk2(ra[2], ra[3]), pk2(ra[4], ra[5]), pk2(ra[6], ra[7])};
    hi = (u32x4){pk2(rb[0], rb[1]), pk2(rb[2], rb[3]), pk2(rb[4], rb[5]), pk2(rb[6], rb[7])};
}
struct KvRegs { u32x4 klo[2], khi[2], v[4]; };
__device__ __forceinline__ void kv_issue(Frame& F, KvRegs& R, const Item& it, int h) {
    const bf16_t* P = (const bf16_t*)(F.ws + WS_PA);
    const bf16_t* Pk = P + (size_t)it.row0 * INW + 1536 + h * HD; const bf16_t* Pv = P + (size_t)it.row0 * INW + 2048 + h * HD;
#pragma unroll
    for (int t2 = 0; t2 < 2; ++t2) { const int task = F.tid + t2 * NTHREADS, token = task >> 3, d0 = (task & 7) * 8;
        R.klo[t2] = ldg<u32x4>(Pk, (unsigned)(token * INW + d0) * 2u); R.khi[t2] = ldg<u32x4>(Pk, (unsigned)(token * INW + d0 + 64) * 2u); }
#pragma unroll
    for (int t4 = 0; t4 < 4; ++t4) { const int task = F.tid + t4 * NTHREADS, token = task >> 4, d0 = (task & 15) * 8; R.v[t4] = ldg<u32x4>(Pv, (unsigned)(token * INW + d0) * 2u); }
}
template <int KS> __device__ __forceinline__ void kv_step(unsigned aK, unsigned aVf, unsigned aVb, f32x4 (&accf)[8], f32x4 (&accb)[8]) {
    const bf16x8 af = tr1<KS * 32 * VP>(aVf), ab = tr1<KS * 32 * VP>(aVb);
    bf16x8 b[8];
    tr4<KS * 32 * VP>(aK, b[0], b[1], b[2], b[3]); tr4<KS * 32 * VP + 128>(aK, b[4], b[5], b[6], b[7]);
#pragma unroll
    for (int n = 0; n < 8; ++n) { accf[n] = __builtin_amdgcn_mfma_f32_16x16x32_bf16(af, b[n], accf[n], 0, 0, 0); accb[n] = __builtin_amdgcn_mfma_f32_16x16x32_bf16(ab, b[n], accb[n], 0, 0, 0); }
}
__device__ __forceinline__ void stage_state_t(Frame& F, ldsp_t dst, const bf16_t* St) {
#pragma unroll
    for (int t4 = 0; t4 < 4; ++t4) { const int task = F.tid + t4 * NTHREADS, e = task >> 4, c8 = task & 15;
        *(LAS u32x4*)(dst + e * TP + c8 * 16) = ldg<u32x4>(St, (unsigned)(e * 128 + c8 * 8) * 2u); }
}
__device__ __forceinline__ void mm16x128(ldsp_t At, int ra0, ldsp_t Bt, int lane, f32x4 (&acc)[8]) {
    const int fr = lane & 15, fq = lane >> 4;
#pragma unroll
    for (int ks = 0; ks < 4; ++ks) { const bf16x8 a = *(const LAS bf16x8*)(At + (ra0 + fr) * TP + (32 * ks + 8 * fq) * 2);
#pragma unroll
        for (int n = 0; n < 8; ++n) { const bf16x8 b = *(const LAS bf16x8*)(Bt + (16 * n + fr) * TP + (32 * ks + 8 * fq) * 2); acc[n] = __builtin_amdgcn_mfma_f32_16x16x32_bf16(a, b, acc[n], 0, 0, 0); } }
}

__device__ __forceinline__ void kv_head(Frame& F, KvRegs& R, KvRegs& Rn, bool pre, int item, const Item& it, int h) {
    bf16_t* KV = (bf16_t*)(F.ws + WS_KV);
    const float* ct = (const float*)(F.ws + WS_ROPE); const float* st = ct + 4096 * 64;
    const LAS float* dec = (const LAS float*)(F.lds + LDS_DEC); const bool rope = !it.is_ctx;
    ldsp_t tK = F.lds, tVf = F.lds + TILEV, tVb = F.lds + 2 * TILEV;
#pragma unroll
    for (int t2 = 0; t2 < 2; ++t2) { const int task = F.tid + t2 * NTHREADS, token = task >> 3, d0 = (task & 7) * 8;
        if (rope) rope8(R.klo[t2], R.khi[t2], ct, st, it.t0 + token, d0);
        *(LAS u32x4*)(tK + token * VP + d0 * 2) = R.klo[t2]; *(LAS u32x4*)(tK + token * VP + (d0 + 64) * 2) = R.khi[t2]; }
#pragma unroll
    for (int t4 = 0; t4 < 4; ++t4) { const int task = F.tid + t4 * NTHREADS, token = task >> 4, d0 = (task & 15) * 8; const u32x4 v = R.v[t4];
        const float df = dec[(0 * 4 + h) * 132 + 127 - token], db = dec[(1 * 4 + h) * 132 + token];
        const float x[8] = {bf2f(v.x & 0xffffu), __uint_as_float(v.x & 0xffff0000u), bf2f(v.y & 0xffffu), __uint_as_float(v.y & 0xffff0000u), bf2f(v.z & 0xffffu), __uint_as_float(v.z & 0xffff0000u), bf2f(v.w & 0xffffu), __uint_as_float(v.w & 0xffff0000u)};
        u32x4 wf, wb; wf.x = pk2(x[0] * df, x[1] * df); wf.y = pk2(x[2] * df, x[3] * df); wf.z = pk2(x[4] * df, x[5] * df); wf.w = pk2(x[6] * df, x[7] * df);
        wb.x = pk2(x[0] * db, x[1] * db); wb.y = pk2(x[2] * db, x[3] * db); wb.z = pk2(x[4] * db, x[5] * db); wb.w = pk2(x[6] * db, x[7] * db);
        *(LAS u32x4*)(tVf + token * VP + d0 * 2) = wf; *(LAS u32x4*)(tVb + token * VP + d0 * 2) = wb; }
    WG_BAR_LDS();
    if (pre) kv_issue(F, Rn, it, h + 1);
    f32x4 af[8], ab[8];
#pragma unroll
    for (int n = 0; n < 8; ++n) { af[n] = zero4(); ab[n] = zero4(); }
    { const unsigned aK = tr_lane_addr(tK, F.lane), aVf = tr_lane_addr(tVf, F.lane) + 32u * (unsigned)F.wave, aVb = tr_lane_addr(tVb, F.lane) + 32u * (unsigned)F.wave;
      kv_step<0>(aK, aVf, aVb, af, ab); kv_step<1>(aK, aVf, aVb, af, ab); kv_step<2>(aK, aVf, aVb, af, ab); kv_step<3>(aK, aVf, aVb, af, ab); }
    const int fr = F.lane & 15, fq = F.lane >> 4;
    bf16_t* of = KV + (((size_t)item * 4 + h) * 2 + 0) * 16384 + (size_t)(16 * F.wave) * 128;
    unsigned so = (unsigned)((4 * fq) * 128 + fr) * 2u; asm volatile("" : "+v"(so));
#pragma unroll
    for (int n = 0; n < 8; ++n)
#pragma unroll
        for (int jj = 0; jj < 4; ++jj) { stg<bf16_t>(of, so + (unsigned)((jj * 128 + 16 * n) * 2), (bf16_t)f2bf(af[n][jj])); stg<bf16_t>(of, so + (unsigned)((16384 + jj * 128 + 16 * n) * 2), (bf16_t)f2bf(ab[n][jj])); }
    WG_BAR_LDS();
}
__device__ __forceinline__ int latent_item(int c) { return (c >> 5) * SPB + 2 + (c & 31); }
__device__ __forceinline__ int ctx_item(int ci) { return (ci >> 1) * SPB + (ci & 1); }
__device__ __forceinline__ void phase_m1(Frame& F, int l) {
    build_decay(F, l); __syncthreads();
    for (int c = F.bid; c < 256; c += F.G) {
        fresh(F);
        { const int item = latent_item(c); const Item it = item_info(item);
          rg_part<false>(F, l, item, it, F.wave, 0, 4);
          __syncthreads();
          KvRegs A, B;
          fresh(F); kv_issue(F, A, it, 0);
          kv_head(F, A, B, true, item, it, 0);
          fresh(F); kv_head(F, B, A, true, item, it, 1);
          fresh(F); kv_head(F, A, B, true, item, it, 2);
          fresh(F); kv_head(F, B, A, false, item, it, 3); }
        fresh(F);
        if (c >= 64 && c < 192) { const int cu = c - 64; const int item = ctx_item(cu >> 3); const Item it = item_info(item);
            const int w4 = F.wave & 3; rg_part<false, true>(F, l, item, it, cu & 7, w4, w4 + 1); }
        __syncthreads();
        if (c < 64) { const int item = ctx_item(c >> 2); const Item it = item_info(item); KvRegs A, B; fresh(F); kv_issue(F, A, it, c & 3); kv_head(F, A, B, false, item, it, c & 3); }
    }
}
__device__ __forceinline__ int seq_order(int dir, int step) { return dir ? (step == 0 ? 1 : (step == 1 ? 0 : 35 - step)) : step; }
__device__ __forceinline__ void phase_m2(Frame& F, int l) {
    bf16_t* KV = (bf16_t*)(F.ws + WS_KV);
    const int gt = F.bid * NTHREADS + F.tid, NGT = F.G * NTHREADS;
    for (int c = gt; c < NB * NH * 2 * 128 * 16; c += NGT) {
        const int dc = c & 15, e = (c >> 4) & 127, dir = (c >> 11) & 1, h = (c >> 12) & 3, b = c >> 14;
        const float x = F.pa->in[I_RETDEC][l * 8 + dir * 4 + h]; const float decay = expf(128.0f * (-log1pf(expf(-x))));
        float S[8];
#pragma unroll
        for (int i = 0; i < 8; ++i) S[i] = 0.f;
        const unsigned lo = (unsigned)((((h * 2 + dir) * 128 + e) * 128 + dc * 8) * 2);
        for (int g0 = 0; g0 < SPB; g0 += 17) {
            u32x4 v[17];
#pragma unroll
            for (int i = 0; i < 17; ++i) { const int item = b * SPB + seq_order(dir, g0 + i); v[i] = ldg<u32x4>(KV + (size_t)item * 4 * 2 * 16384, lo); }
#pragma unroll
            for (int i = 0; i < 17; ++i) { const int item = b * SPB + seq_order(dir, g0 + i);
                u32x4 w; w.x = pk2(S[0], S[1]); w.y = pk2(S[2], S[3]); w.z = pk2(S[4], S[5]); w.w = pk2(S[6], S[7]);
                stg<u32x4>(KV + (size_t)item * 4 * 2 * 16384, lo, w);
                S[0] = S[0] * decay + bf2f(v[i].x & 0xffffu); S[1] = S[1] * decay + __uint_as_float(v[i].x & 0xffff0000u); S[2] = S[2] * decay + bf2f(v[i].y & 0xffffu); S[3] = S[3] * decay + __uint_as_float(v[i].y & 0xffff0000u);
                S[4] = S[4] * decay + bf2f(v[i].z & 0xffffu); S[5] = S[5] * decay + __uint_as_float(v[i].z & 0xffff0000u); S[6] = S[6] * decay + bf2f(v[i].w & 0xffffu); S[7] = S[7] * decay + __uint_as_float(v[i].w & 0xffff0000u); }
        }
    }
    const float* TOT = (const float*)(F.ws + WS_TOT); float* CARRY = (float*)(F.ws + WS_CARRY);
    if (F.tid < 32) for (int cidx = F.bid * 32 + F.tid; cidx < NB * 2 * 512; cidx += F.G * 32) {
      { const int ch = cidx & 511, dir = (cidx >> 9) & 1, b = cidx >> 10; float cr = 0.f;
          for (int g0 = 0; g0 < SPB; g0 += 17) { f32x2 ah[17];
#pragma unroll
              for (int i = 0; i < 17; ++i) { const int item = b * SPB + seq_order(dir, g0 + i); ah[i] = *(const f32x2*)(TOT + (((size_t)item * 2 + dir) * 512 + ch) * 2); }
#pragma unroll
              for (int i = 0; i < 17; ++i) { const int item = b * SPB + seq_order(dir, g0 + i); CARRY[((size_t)item * 2 + dir) * 512 + ch] = cr; cr = ah[i].x * cr + ah[i].y; } } } }
}
struct RetRegs { u32x4 v[4], sf[4], sb[4], klo[2], khi[2], g[4]; };
__device__ __forceinline__ void ret_issue(Frame& F, RetRegs& R, int item, const Item& it, int h) {
    const bf16_t* KV = (const bf16_t*)(F.ws + WS_KV); const bf16_t* P = (const bf16_t*)(F.ws + WS_PA);
    const bf16_t* Pk = P + (size_t)it.row0 * INW + 1536 + h * HD; const bf16_t* Pv = P + (size_t)it.row0 * INW + 2048 + h * HD;
    const bf16_t* Sf = KV + (((size_t)item * 4 + h) * 2 + 0) * 16384; const bf16_t* Sb = Sf + 16384;
    const int lane = F.lane, i0 = 16 * F.wave;
#pragma unroll
    for (int t2 = 0; t2 < 2; ++t2) { const int task = F.tid + t2 * NTHREADS, token = task >> 3, d0 = (task & 7) * 8;
        R.klo[t2] = ldg<u32x4>(Pk, (unsigned)(token * INW + d0) * 2u); R.khi[t2] = ldg<u32x4>(Pk, (unsigned)(token * INW + d0 + 64) * 2u); }
#pragma unroll
    for (int t4 = 0; t4 < 4; ++t4) { const int task = F.tid + t4 * NTHREADS, r = task >> 4, c8 = task & 15;
        R.v[t4] = ldg<u32x4>(Pv, (unsigned)(r * INW + c8 * 8) * 2u); R.sf[t4] = ldg<u32x4>(Sf, (unsigned)(r * 128 + c8 * 8) * 2u); R.sb[t4] = ldg<u32x4>(Sb, (unsigned)(r * 128 + c8 * 8) * 2u); }
    { const bf16_t* Pg = P + (size_t)(it.row0 + i0) * INW + 2560 + h * HD;
#pragma unroll
      for (int k = 0; k < 4; ++k) R.g[k] = ldg<u32x4>(Pg, (unsigned)((lane >> 2) * INW + 32 * (lane & 3) + 8 * k) * 2u); }
}
__device__ __forceinline__ void ret_head(Frame& F, RetRegs& R, RetRegs& Rn, bool pre, int item, const Item& it, int h) {
    bf16_t* Y = (bf16_t*)(F.ws + WS_Y);
    const float* ct = (const float*)(F.ws + WS_ROPE); const float* st = ct + 4096 * 64;
    const LAS float* dec = (const LAS float*)(F.lds + LDS_DEC);
    ldsp_t tK = F.lds, tV = F.lds + TILEB, tSf = tV + TILEV, tSb = tSf + TILEB;
    const bool rope = !it.is_ctx;
    const int lane = F.lane, fr = lane & 15, fq = lane >> 4, i0 = 16 * F.wave;
    u32x4 q4[4];
    { const bf16_t* Pq = (const bf16_t*)(F.ws + WS_PA) + (size_t)(it.row0 + i0) * INW + 1024 + h * HD;
#pragma unroll
      for (int ks = 0; ks < 4; ++ks) q4[ks] = ldg<u32x4>(Pq, (unsigned)(fr * INW + 32 * ks + 8 * fq) * 2u); }
#pragma unroll
    for (int t2 = 0; t2 < 2; ++t2) { const int task = F.tid + t2 * NTHREADS, token = task >> 3, d0 = (task & 7) * 8;
        if (rope) rope8(R.klo[t2], R.khi[t2], ct, st, it.t0 + token, d0);
        *(LAS u32x4*)(tK + token * TP + d0 * 2) = R.klo[t2]; *(LAS u32x4*)(tK + token * TP + (d0 + 64) * 2) = R.khi[t2]; }
#pragma unroll
    for (int t4 = 0; t4 < 4; ++t4) { const int task = F.tid + t4 * NTHREADS, r = task >> 4, c8 = task & 15;
        *(LAS u32x4*)(tV + r * VP + c8 * 16) = R.v[t4]; *(LAS u32x4*)(tSf + r * TP + c8 * 16) = R.sf[t4]; *(LAS u32x4*)(tSb + r * TP + c8 * 16) = R.sb[t4]; }
    bf16x8 qf[4];
    { if (rope) { rope8(q4[0], q4[2], ct, st, it.t0 + i0 + fr, 8 * fq); rope8(q4[1], q4[3], ct, st, it.t0 + i0 + fr, 32 + 8 * fq); }
#pragma unroll
      for (int ks = 0; ks < 4; ++ks) qf[ks] = __builtin_bit_cast(bf16x8, q4[ks]); }
    u32x4 gk[4];
#pragma unroll
    for (int k = 0; k < 4; ++k) gk[k] = R.g[k];
    WG_BAR_LDS();
    if (pre) ret_issue(F, Rn, item, it, h + 1);
    bf16x8 pa[4];
    { f32x4 C[8];
#pragma unroll
      for (int jt = 0; jt < 8; ++jt) { C[jt] = zero4();
#pragma unroll
          for (int ks = 0; ks < 4; ++ks) { const bf16x8 a = *(const LAS bf16x8*)(tK + (16 * jt + fr) * TP + (32 * ks + 8 * fq) * 2); C[jt] = __builtin_amdgcn_mfma_f32_16x16x32_bf16(a, qf[ks], C[jt], 0, 0, 0); } }
      const int i = i0 + fr;
#pragma unroll
      for (int jt = 0; jt < 8; ++jt)
#pragma unroll
          for (int jj = 0; jj < 4; ++jj) { const int j = 16 * jt + 4 * fq + jj; const float dcy = (i >= j) ? dec[(0 * 4 + h) * 132 + (i - j)] : dec[(1 * 4 + h) * 132 + (j - i)]; C[jt][jj] *= dcy; }
#pragma unroll
      for (int u = 0; u < 4; ++u) { const u32x4 w = {pg8::cvt_pk_bf16(C[2 * u][0], C[2 * u][1]), pg8::cvt_pk_bf16(C[2 * u][2], C[2 * u][3]), pg8::cvt_pk_bf16(C[2 * u + 1][0], C[2 * u + 1][1]), pg8::cvt_pk_bf16(C[2 * u + 1][2], C[2 * u + 1][3])};
          pa[u] = __builtin_bit_cast(bf16x8, w); } }
    WG_BAR_LDS();
    { ldsp_t gt = tK + (i0 + (lane >> 2)) * TP + (lane & 3) * 64;
#pragma unroll
      for (int k = 0; k < 4; ++k) *(LAS u32x4*)(gt + 16 * k) = gk[k]; }
    f32x4 o[8];
#pragma unroll
    for (int n = 0; n < 8; ++n) o[n] = zero4();
    { const unsigned aV = tr_lane_addr(tV, lane); bf16x8 b[8];
#define RET_PV(U) do { tr4<(U) * 32 * VP>(aV, b[0], b[1], b[2], b[3]); tr4<(U) * 32 * VP + 128>(aV, b[4], b[5], b[6], b[7]); \
        _Pragma("unroll") for (int n = 0; n < 8; ++n) o[n] = __builtin_amdgcn_mfma_f32_16x16x32_bf16(pa[U], b[n], o[n], 0, 0, 0); } while (0)
      RET_PV(0); RET_PV(1); RET_PV(2); RET_PV(3);
#undef RET_PV
    }
    { f32x4 cf[8];
#pragma unroll
      for (int n = 0; n < 8; ++n) { cf[n] = zero4();
#pragma unroll
          for (int ks = 0; ks < 4; ++ks) { const bf16x8 b = *(const LAS bf16x8*)(tSf + (16 * n + fr) * TP + (32 * ks + 8 * fq) * 2); cf[n] = __builtin_amdgcn_mfma_f32_16x16x32_bf16(qf[ks], b, cf[n], 0, 0, 0); } }
#pragma unroll
      for (int jj = 0; jj < 4; ++jj) { const float sf = dec[(0 * 4 + h) * 132 + (i0 + 4 * fq + jj + 1)];
#pragma unroll
          for (int n = 0; n < 8; ++n) o[n][jj] += sf * cf[n][jj]; } }
    { f32x4 cb[8];
#pragma unroll
      for (int n = 0; n < 8; ++n) { cb[n] = zero4();
#pragma unroll
          for (int ks = 0; ks < 4; ++ks) { const bf16x8 b = *(const LAS bf16x8*)(tSb + (16 * n + fr) * TP + (32 * ks + 8 * fq) * 2); cb[n] = __builtin_amdgcn_mfma_f32_16x16x32_bf16(qf[ks], b, cb[n], 0, 0, 0); } }
#pragma unroll
      for (int jj = 0; jj < 4; ++jj) { const float sb = dec[(1 * 4 + h) * 132 + (128 - (i0 + 4 * fq + jj))];
#pragma unroll
          for (int n = 0; n < 8; ++n) o[n][jj] += sb * cb[n][jj]; } }
    { ldsp_t gc = tK + (i0 + 4 * fq) * TP + fr * 2;
#pragma unroll
      for (int jj = 0; jj < 4; ++jj) { float s1 = 0.f;
#pragma unroll
          for (int n = 0; n < 8; ++n) s1 += o[n][jj];
          s1 += swz_xor<1>(s1); s1 += swz_xor<2>(s1); s1 += swz_xor<4>(s1); s1 += swz_xor<8>(s1);
          const float mu = s1 * (1.0f / 128.0f); float q = 0.f;
#pragma unroll
          for (int n = 0; n < 8; ++n) { const float dd = o[n][jj] - mu; q += dd * dd; }
          q += swz_xor<1>(q); q += swz_xor<2>(q); q += swz_xor<4>(q); q += swz_xor<8>(q);
          const float rstd = 1.0f / sqrtf(q * (1.0f / 128.0f) + EPS);
#pragma unroll
          for (int n = 0; n < 8; ++n) { LAS bf16_t* p = (LAS bf16_t*)(gc + jj * TP + 32 * n); const float gv = bf2f(*p); *p = (bf16_t)f2bf(siluf_(gv) * (o[n][jj] - mu) * rstd); } } }
    LDS_WAIT(); asm volatile("" ::: "memory");
    { ldsp_t gt = tK + (i0 + (lane >> 2)) * TP + (lane & 3) * 64; bf16_t* Yo = Y + (size_t)(it.row0 + i0) * D + 512 + h * HD;
#pragma unroll
      for (int k = 0; k < 4; ++k) stg<u32x4>(Yo, (unsigned)((lane >> 2) * D + 32 * (lane & 3) + 8 * k) * 2u, *(const LAS u32x4*)(gt + 16 * k)); }
    WG_BAR_LDS();
}
__device__ __forceinline__ void phase_m3(Frame& F, int l) {
    build_decay(F, l); __syncthreads();
    for (int c = F.bid; c < 256; c += F.G) {
        fresh(F);
        { const int item = latent_item(c); const Item it = item_info(item);
#ifndef PROBE_M3
#define PROBE_M3 0
#endif
          for (int r_ = 0; r_ < ((PROBE_M3 & 1) ? 2 : 1); ++r_) { fresh(F); rg_part<true>(F, l, item, it, F.wave, 0, 4); }
          __syncthreads();
          for (int r_ = 0; r_ < ((PROBE_M3 & 2) ? 2 : 1); ++r_) {
          RetRegs R, Rn;
          fresh(F); ret_issue(F, R, item, it, 0);
          ret_head(F, R, Rn, true, item, it, 0);
          fresh(F); ret_head(F, Rn, R, true, item, it, 1);
          fresh(F); ret_head(F, R, Rn, true, item, it, 2);
          fresh(F); ret_head(F, Rn, R, false, item, it, 3); } }
        if (l == 0) {
            fresh(F);
            if (c >= 64 && c < 192) { const int cu = c - 64; const int item = ctx_item(cu >> 3); const Item it = item_info(item);
                const int w4 = F.wave & 3; rg_part<true, true>(F, l, item, it, cu & 7, w4, w4 + 1); }
            __syncthreads();
            if (c < 64) { const int item = ctx_item(c >> 2); const Item it = item_info(item); RetRegs R, Rn; fresh(F); ret_issue(F, R, item, it, c & 3); ret_head(F, R, Rn, false, item, it, c & 3); }
        }
    }
}

constexpr int N_PHASES = 24;
__global__ void __launch_bounds__(NTHREADS, 2) fwd_kernel(Args args) {
    extern __shared__ __attribute__((aligned(16))) unsigned char lds_raw[];
    Frame F; F.lds = (ldsp_t)lds_raw; F.wave0 = __builtin_amdgcn_readfirstlane((int)threadIdx.x >> 6); F.G = gridDim.x; F.pa0 = &args; F.out0 = args.out; F.ws0 = args.ws; fresh(F);
    volatile LAS unsigned* MISC = (volatile LAS unsigned*)(F.lds + LDS_MISC);
    if (F.tid < 64) MISC[F.tid] = 0u;
    __syncthreads();
    const int lo = args.ph_lo, hi = args.ph_hi;
    XcdBarrier bar; bar.bar = (unsigned*)(F.ws + WS_CTL); bar.x = 0; bar.st = nullptr;
    if (hi - lo > 1) bar = xcd_barrier_post((unsigned*)(F.ws + WS_CTL), MISC);
#ifndef DIAG_MASK
#define DIAG_MASK 0xffffffffu
#endif
#ifndef REPEAT_MASK
#define REPEAT_MASK 0u
#endif
#define REPS(kind) ((((REPEAT_MASK) >> (kind)) & 1u) ? 2 : 1)
#define INK(k, kind) (((DIAG_MASK >> (kind)) & 1u) && lo <= (k) && (k) < hi && fresh(F))
#define IN(k) (lo <= (k) && (k) < hi)
#define SEAM(k) do { if (IN(k) && IN((k) + 1)) xcd_barrier(bar); } while (0)
    float* ctxx = (float*)(F.ws + WS_CTXX); bf16_t* xb = (bf16_t*)((char*)F.out + XB_OFF);
    const float* modlat = (const float*)(F.ws + WS_MODLAT); const float* modctx = (const float*)(F.ws + WS_MODCTX);

    if (INK(0, 0)) { for (int r_ = 0; r_ < REPS(0); ++r_) { phase_convert_small(F); __syncthreads(); phase_mod(F); __syncthreads(); } } SEAM(0);
    if (INK(1, 1)) { for (int r_ = 0; r_ < REPS(1); ++r_) phase_norm(F, 0, 0, F.pa->in[I_X], nullptr, F.pa->in[I_CTX], MROWS, SlabRed{nullptr, 0, nullptr, nullptr, nullptr}); } SEAM(1);
#pragma unroll 1
    for (int l = 0; l < 2; ++l) {
        const int pb = (l == 0) ? 2 : 11;
        if (INK(pb + 0, 2)) { pg8::Gemm g{(const bf16_t*)(F.ws + WS_HX), (const bf16_t*)(F.ws + WS_WIN) + (size_t)l * INW * D, INW, D, 0, nullptr}; pg8::Order S; S.init(MROWS / 256, INW / 256, F.G, F.bid, nullptr, nullptr, D / 64, false, 0);
            pg8::EpiBf16 E{(bf16_t*)(F.ws + WS_PA), INW}; for (int r_ = 0; r_ < REPS(2); ++r_) pg8::gemm_phase<pg8::EpiBf16>(F.lds, g, S, E, F.tid); }
        SEAM(pb + 0);
        if (INK(pb + 1, 3)) { for (int r_ = 0; r_ < REPS(3); ++r_) phase_m1(F, l); }
        SEAM(pb + 1);
        if (INK(pb + 2, 4)) { for (int r_ = 0; r_ < REPS(4); ++r_) { if (r_) phase_m1(F, l); phase_m2(F, l); } }
        SEAM(pb + 2);
        if (INK(pb + 3, 5)) { for (int r_ = 0; r_ < REPS(5); ++r_) phase_m3(F, l); }
        SEAM(pb + 3);
        if (INK(pb + 4, 6)) { pg8::Gemm g{(const bf16_t*)(F.ws + WS_Y), (const bf16_t*)(F.ws + WS_WOUT) + (size_t)l * D * D, D, D, 0, (float*)(F.ws + WS_SLABA)}; pg8::Order S; S.init((l == 0 ? MROWS : NLAT) / 256, D / 256, F.G, F.bid, nullptr, nullptr, D / 64, true, MAXSLAB_A);
            pg8::EpiResid E{l == 0 ? F.pa->in[I_X] : nullptr, xb, F.pa->in[I_CTX], ctxx, modlat + (size_t)l * 8 * 6144 + 2048, modctx + (size_t)l * 6144 + 2048};
            pg8::gemm_phase<pg8::EpiResid>(F.lds, g, S, E, F.tid); }
        SEAM(pb + 4);
        if (l == 0) {
            if (INK(7, 1)) { for (int r_ = 0; r_ < REPS(1); ++r_) phase_norm(F, 0, 1, nullptr, xb, ctxx, MROWS, SlabRed{(const float*)(F.ws + WS_SLABA), pg8::split_factor((MROWS / 256) * 4, F.G, D / 64, MAXSLAB_A), modctx + 2048, F.pa->in[I_CTX], ctxx}); } SEAM(7);
            if (INK(8, 7)) { pg8::Gemm g{(const bf16_t*)(F.ws + WS_HX), (const bf16_t*)(F.ws + WS_WUP), 2 * DFF, D, 0, nullptr}; pg8::Order S; S.init(MROWS / 256, 2 * DFF / 256, F.G, F.bid, nullptr, nullptr, D / 64, false, 0);
                pg8::EpiSwiGLU E{(bf16_t*)(F.ws + WS_PA), DFF}; for (int r_ = 0; r_ < REPS(7); ++r_) pg8::gemm_phase<pg8::EpiSwiGLU>(F.lds, g, S, E, F.tid); }
            SEAM(8);
            if (INK(9, 8)) { pg8::Gemm g{(const bf16_t*)(F.ws + WS_PA), (const bf16_t*)(F.ws + WS_WDN), D, DFF, 0, (float*)(F.ws + WS_SLABA)}; pg8::Order S; S.init(MROWS / 256, D / 256, F.G, F.bid, nullptr, nullptr, DFF / 64, true, MAXSLAB_A);
                pg8::EpiResid E{nullptr, xb, (const float*)ctxx, ctxx, modlat + 5120, modctx + 5120}; pg8::gemm_phase<pg8::EpiResid>(F.lds, g, S, E, F.tid); }
            SEAM(9);
            if (INK(10, 1)) { for (int r_ = 0; r_ < REPS(1); ++r_) phase_norm(F, 1, 0, nullptr, xb, ctxx, MROWS, SlabRed{(const float*)(F.ws + WS_SLABA), pg8::split_factor((MROWS / 256) * 4, F.G, DFF / 64, MAXSLAB_A), modctx + 5120, ctxx, ctxx}); } SEAM(10);
        }
    }
    if (INK(16, 9)) { for (int r_ = 0; r_ < REPS(9); ++r_) { phase_norm_router(F, xb); __syncthreads(); phase_convert_moe(F); __syncthreads(); } } SEAM(16);
    if (INK(17, 10)) { phase_moe_sort(F); } SEAM(17);
#pragma unroll 1
    for (int k = 0; k < 2; ++k) {
        const int* meta = (const int*)(F.ws + MOE_META) + 9 * k;
        if (INK(18 + 2 * k, 11)) { if (k == 1) { moe_reduce(F, 0); __syncthreads(); } pg8::Gemm g{(const bf16_t*)(F.ws + WS_HX), (const bf16_t*)(F.ws + WS_MOEUP), 2 * DEXP, D, (size_t)2 * DEXP * D * 2, nullptr}; pg8::Order S; S.init(meta[8], 2 * DEXP / 256, F.G, F.bid, meta, (const int*)(F.ws + MOE_PTOK) + k * MROWS, D / 64, false, 0);
            pg8::EpiSwiGLU E{(bf16_t*)(F.ws + WS_PA), DEXP}; for (int r_ = 0; r_ < REPS(11); ++r_) pg8::gemm_phase<pg8::EpiSwiGLU>(F.lds, g, S, E, F.tid); }
        SEAM(18 + 2 * k);
        if (INK(19 + 2 * k, 12)) { pg8::Gemm g{(const bf16_t*)(F.ws + WS_PA), (const bf16_t*)(F.ws + WS_MOEDN), D, DEXP, (size_t)D * DEXP * 2, (float*)(F.ws + WS_SLABM)}; pg8::Order S; S.init(meta[8], D / 256, F.G, F.bid, meta, nullptr, DEXP / 64, true, MAXSLAB_M);
            pg8::EpiMoeDown E{xb, (const int*)(F.ws + MOE_PTOK) + k * MROWS, (const float*)(F.ws + MOE_PW) + k * MROWS, modlat + (size_t)8 * 6144 + 5120}; pg8::gemm_phase<pg8::EpiMoeDown>(F.lds, g, S, E, F.tid); }
        SEAM(19 + 2 * k);
    }
    if (INK(22, 13)) phase_final_a(F);
    SEAM(22);
    if (INK(23, 13)) phase_final_b(F);
#undef IN
#undef INK
#undef SEAM
}

extern "C" void kernel_launch(void* const* d_in, const int* in_sizes, int n_in, void* d_out, int out_size, void* d_ws, size_t ws_size, hipStream_t stream) {
    static int grid = 0;
    if (grid == 0) {
        if (n_in != 27 || in_sizes[0] != NLAT * D || out_size != NLAT * D || ws_size < WS_END) { fprintf(stderr, "kernel_launch: unexpected problem (n_in %d, in0 %d, out %d, ws %zu, need %zu); nothing launched\n", n_in, n_in > 0 ? in_sizes[0] : -1, out_size, ws_size, (size_t)WS_END); grid = -1; return; }
        int dev = 0, cus = 0, per_cu = 0;
        if (hipGetDevice(&dev) != hipSuccess || hipDeviceGetAttribute(&cus, hipDeviceAttributeMultiprocessorCount, dev) != hipSuccess) { grid = -1; return; }
        if (hipFuncSetAttribute((const void*)fwd_kernel, hipFuncAttributeMaxDynamicSharedMemorySize, LDS_BYTES) != hipSuccess) { fprintf(stderr, "kernel_launch: hipFuncSetAttribute failed\n"); grid = -1; return; }
        if (hipOccupancyMaxActiveBlocksPerMultiprocessor(&per_cu, (const void*)fwd_kernel, NTHREADS, LDS_BYTES) != hipSuccess || per_cu < 1) { fprintf(stderr, "kernel_launch: occupancy query says %d\n", per_cu); }
        (void)hipGetLastError();
        grid = cus;
    }
    if (grid < 0) return;
    (void)hipMemsetAsync((char*)d_ws + WS_CTL, 0, CTL_ZERO_BYTES, stream);
    Args a; memset(&a, 0, sizeof(a));
    for (int i = 0; i < 27; ++i) a.in[i] = (const float*)d_in[i];
    a.out = (float*)d_out; a.ws = (unsigned char*)d_ws;
#if MK_ONE_LAUNCH
    a.ph_lo = 0; a.ph_hi = N_PHASES;
    hipLaunchKernelGGL(fwd_kernel, dim3(grid), dim3(NTHREADS), LDS_BYTES, stream, a);
#else
    for (int p = 0; p < N_PHASES; ++p) { a.ph_lo = p; a.ph_hi = p + 1; hipLaunchKernelGGL(fwd_kernel, dim3(grid), dim3(NTHREADS), LDS_BYTES, stream, a); }
#endif
}
```

```cpp
#include <hip/hip_runtime.h>
#include <cstdio>
#include <cstdint>
#include <cstring>

#ifndef MK_ONE_LAUNCH
#define MK_ONE_LAUNCH 1
#endif

#define GAS __attribute__((address_space(1)))
#define LAS __attribute__((address_space(3)))
typedef unsigned short bf16_t;
typedef short bf16x8 __attribute__((ext_vector_type(8)));
typedef float f32x4 __attribute__((ext_vector_type(4)));
typedef float f32x2 __attribute__((ext_vector_type(2)));
typedef unsigned u32x4 __attribute__((ext_vector_type(4)));
typedef unsigned u32x2 __attribute__((ext_vector_type(2)));
typedef LAS unsigned char* ldsp_t;

constexpr int D = 1024, NB = 8, SEQ = 4096, NLAT = NB * SEQ, CTXL = 256, NCTX = NB * CTXL, MROWS = NLAT + NCTX;
constexpr int INW = 3072, NH = 4, HD = 128, CHK = 128;
constexpr int DFF = 2816, NE = 8, DEXP = 3584;
constexpr int SPB = 34;
constexpr int NITEM = NB * SPB;
constexpr float EPS = 1e-6f;
constexpr int NWAVES = 8, NTHREADS = 512;

constexpr size_t MiB = 1u << 20;
constexpr size_t WS_CTL = 0, CTL_ZERO_BYTES = 64 * 1024;
constexpr size_t WS_MODLAT = 1 * MiB;
constexpr size_t WS_MODCTX = 1 * MiB + 2 * 8 * 6144 * 4;
constexpr size_t WS_ROPE = 2 * MiB;
constexpr size_t WS_RGW = 4 * MiB;
constexpr size_t WS_TOT = 5 * MiB;
constexpr size_t WS_CARRY = 8 * MiB;
constexpr size_t WS_MOE = 10 * MiB;
constexpr size_t MOE_CNT = WS_MOE, MOE_META = WS_MOE + 16384, MOE_TOKE = WS_MOE + 65536, MOE_TOKW = WS_MOE + 262144,
                 MOE_PTOK = WS_MOE + 524288, MOE_PW = WS_MOE + 1048576, MOE_PPOS = WS_MOE + 1572864;
constexpr size_t WS_CTXX = 12 * MiB;
constexpr size_t WS_WIN = 20 * MiB;
constexpr size_t WS_WOUT = 32 * MiB;
constexpr size_t WS_WUP = 36 * MiB;
constexpr size_t WS_WDN = 47 * MiB;
constexpr size_t WS_HX = 54 * MiB;
constexpr size_t WS_PA = 122 * MiB;
constexpr size_t WS_KV = 360 * MiB;
constexpr size_t WS_Y = 496 * MiB;
constexpr size_t WS_MOEUP = 360 * MiB;
constexpr size_t WS_MOEDN = 472 * MiB;
constexpr size_t WS_SLABA = WS_KV;
constexpr size_t WS_SLABM = 528 * MiB;
constexpr int MAXSLAB_A = 256, MAXSLAB_M = 216;
constexpr size_t XB_OFF = (size_t)NLAT * D * 2;
constexpr size_t WS_XCOPY = WS_PA;
constexpr size_t WS_END = 582 * MiB;
static_assert(WS_MOEDN + (size_t)NE * D * DEXP * 2 <= WS_END, "ws map");
static_assert(WS_PA + (size_t)MROWS * DEXP * 2 <= WS_KV, "ws map");

constexpr int LDS_SCRATCH = 147456;
constexpr int LDS_MISC = LDS_SCRATCH;
constexpr int LDS_DEC = LDS_MISC + 256;
constexpr int LDS_BYTES = LDS_SCRATCH + 8192;

__device__ __forceinline__ float bf2f(unsigned v) { return __uint_as_float(v << 16); }
typedef __bf16 bf16x2_t __attribute__((ext_vector_type(2)));
__device__ __forceinline__ unsigned pk2(float lo, float hi) { const f32x2 v = {lo, hi}; return __builtin_bit_cast(unsigned, __builtin_convertvector(v, bf16x2_t)); }
__device__ __forceinline__ unsigned f2bf(float f) { return pk2(f, f) & 0xffffu; }
__device__ __forceinline__ void unpack8(const u32x4 v, f32x4& a, f32x4& b) {
    a = (f32x4){bf2f(v.x & 0xffffu), __uint_as_float(v.x & 0xffff0000u), bf2f(v.y & 0xffffu), __uint_as_float(v.y & 0xffff0000u)};
    b = (f32x4){bf2f(v.z & 0xffffu), __uint_as_float(v.z & 0xffff0000u), bf2f(v.w & 0xffffu), __uint_as_float(v.w & 0xffff0000u)}; }
__device__ __forceinline__ u32x4 pack8(const f32x4 a, const f32x4 b) { return (u32x4){pk2(a.x, a.y), pk2(a.z, a.w), pk2(b.x, b.y), pk2(b.z, b.w)}; }
template <int M> __device__ __forceinline__ float swz_xor(float v) { return __int_as_float(__builtin_amdgcn_ds_swizzle(__float_as_int(v), (M << 10) | 0x1f)); }
__device__ __forceinline__ float wave_sum(float v) {
    v += swz_xor<1>(v); v += swz_xor<2>(v); v += swz_xor<4>(v); v += swz_xor<8>(v); v += swz_xor<16>(v);
    const auto r = __builtin_amdgcn_permlane32_swap(__float_as_uint(v), __float_as_uint(v), false, false);
    return __uint_as_float(r[0]) + __uint_as_float(r[1]);
}
__device__ __forceinline__ float lane_bcast(float v, int src_lane) { return __int_as_float(__builtin_amdgcn_ds_bpermute(src_lane << 2, __float_as_int(v))); }
__device__ __forceinline__ float sigmoidf_(float x) { return __builtin_amdgcn_rcpf(1.0f + __expf(-x)); }
__device__ __forceinline__ float siluf_(float x) { return x * __builtin_amdgcn_rcpf(1.0f + __expf(-x)); }
__device__ __forceinline__ float gelu_tanh(float x) { const float z = 0.7978845608028654f * (x + 0.044715f * x * x * x); return x * (1.0f - __builtin_amdgcn_rcpf(1.0f + __expf(2.0f * z))); }
#define LDS_WAIT() asm volatile("s_waitcnt lgkmcnt(0)" ::: "memory")
#define WG_BAR_LDS() do { asm volatile("s_waitcnt lgkmcnt(0)" ::: "memory"); __builtin_amdgcn_s_barrier(); asm volatile("" ::: "memory"); } while (0)
__device__ __forceinline__ f32x4 zero4() { float z; asm volatile("v_mov_b32 %0, 0" : "=v"(z)); return (f32x4){z, z, z, z}; }

template <typename T> __device__ __forceinline__ T ldg(const void* base, unsigned off) { return *(const GAS T*)((const GAS char*)base + off); }
template <typename T> __device__ __forceinline__ void stg(void* base, unsigned off, T v) { *(GAS T*)((GAS char*)base + off) = v; }
#define XB_TMO      128
#define XB_XCNT(j)  (256  + 64 * (j))
#define XB_XSUB(j)  (1280 + 64 * (j))
#define XB_XGEN(j)  (2304 + 64 * (j))
#define XB_TOP      3328
#define XB_TOPGEN   3392
#define XCD_BAR_WORDS 3456
#define XB_SPIN_CAP (1u << 18)
__device__ __forceinline__ unsigned xb_ld(unsigned* p)              { return __hip_atomic_load(p, __ATOMIC_RELAXED, __HIP_MEMORY_SCOPE_AGENT); }
__device__ __forceinline__ unsigned xb_add(unsigned* p, unsigned v) { return __hip_atomic_fetch_add(p, v, __ATOMIC_RELAXED, __HIP_MEMORY_SCOPE_AGENT); }
__device__ __forceinline__ unsigned xb_xcc_id() { return (unsigned)__builtin_amdgcn_s_getreg((3 << 11) | 20) & 0xFu; }
#define XB_SPIN(cond, bar) do { unsigned _sp = 0; while (cond) { __builtin_amdgcn_s_sleep(1); \
    if ((++_sp & 255u) == 0u) { if (xb_ld(&(bar)[XB_TMO])) break; if (_sp > XB_SPIN_CAP) { atomicAdd(&(bar)[XB_TMO], 1u); break; } } } } while (0)
struct XcdBarrier { unsigned* bar; unsigned x; volatile LAS unsigned* st; };
__device__ __forceinline__ XcdBarrier xcd_barrier_post(unsigned* bar, volatile LAS unsigned* st) {
    XcdBarrier b; b.bar = bar; b.x = xb_xcc_id(); b.st = st;
    if (threadIdx.x == 0) (void)xb_add(&bar[XB_XCNT(b.x)], 1u);
    return b;
}
__device__ __forceinline__ void xcd_barrier_complete(unsigned* bar, unsigned x, unsigned& nloc, unsigned& nx) {
    const unsigned G = gridDim.x * gridDim.y * gridDim.z;
    unsigned sum, cnt, mine, sp = 0u;
    for (;;) {
        sum = 0u; cnt = 0u; mine = 0u;
#pragma unroll
        for (unsigned j = 0; j < 16; ++j) { const unsigned c = xb_ld(&bar[XB_XCNT(j)]); sum += c; cnt += (c > 0u) ? 1u : 0u; mine = (j == x) ? c : mine; }
        if (sum == G) break;
        __builtin_amdgcn_s_sleep(1);
        if ((++sp & 255u) == 0u) { if (xb_ld(&bar[XB_TMO])) break; if (sp > XB_SPIN_CAP) { atomicAdd(&bar[XB_TMO], 1u); break; } }
    }
    nloc = mine > 0u ? mine : 1u; nx = cnt > 0u ? cnt : 1u;
}
__device__ __forceinline__ void xcd_barrier(const XcdBarrier& b) {
    asm volatile("s_waitcnt vmcnt(0)" ::: "memory");
    __syncthreads();
    if (threadIdx.x == 0) {
        unsigned* bar = b.bar;
        __builtin_amdgcn_s_waitcnt(0);
        unsigned nloc = b.st[0], nx = b.st[1];
        if (nloc == 0u) { xcd_barrier_complete(bar, b.x, nloc, nx); b.st[0] = nloc; b.st[1] = nx; }
        const unsigned old = xb_add(&bar[XB_XSUB(b.x)], 1u);
        const unsigned gen = old / nloc;
        if (old + 1u == (gen + 1u) * nloc) {
            __builtin_amdgcn_fence(__ATOMIC_RELEASE, "agent");
            asm volatile("s_waitcnt vmcnt(0)" ::: "memory");
            const unsigned og = xb_add(&bar[XB_TOP], 1u);
            const unsigned tg = og / nx;
            if (og + 1u == (tg + 1u) * nx) xb_add(&bar[XB_TOPGEN], 1u);
            else XB_SPIN(xb_ld(&bar[XB_TOPGEN]) == tg, bar);
            __builtin_amdgcn_fence(__ATOMIC_ACQUIRE, "agent");
            xb_add(&bar[XB_XGEN(b.x)], 1u);
            asm volatile("s_waitcnt vmcnt(0)" ::: "memory");
        } else {
            XB_SPIN(xb_ld(&bar[XB_XGEN(b.x)]) == gen, bar);
            __builtin_amdgcn_fence(__ATOMIC_ACQUIRE, "agent");
            asm volatile("s_waitcnt vmcnt(0)" ::: "memory");
        }
    }
    __syncthreads();
}

namespace pg8 {
constexpr int BM = 256, BK = 64, HALF = 128, HTB = HALF * BK * 2, STAGE_BYTES = 8 * HTB, NXCD = 8, WGM = 8;
__host__ __device__ __forceinline__ int lds_byte(int r, int c) { const int st = (r >> 4) * 2 + (c >> 5), rr = r & 15, cc = c & 31, ob = rr * 64 + cc * 2; return st * 1024 + (ob ^ (((ob >> 9) & 1) << 5)); }
__host__ __device__ __forceinline__ void stage_rc(int b, int& R, int& C) { const int st = b / 1024, sb = b % 1024, swz = sb ^ (((sb >> 9) & 1) << 5); R = (st >> 1) * 16 + swz / 64; C = (st & 1) * 32 + (swz % 64) / 2; }
__host__ __device__ __forceinline__ int perm32(int rho) { const int n = rho >> 4, i = rho & 15; return 8 * (i >> 2) + 4 * n + (i & 3); }

struct Unit { int pm, pn, e, kt0, nt, slab; };
struct Gemm { const bf16_t* A; const bf16_t* Bt; int N, K; size_t estride; float* slabs; };

__device__ __forceinline__ int split_factor(int U, int G, int ntiles, int maxslabs) {
    const int R = U % G; if (R == 0) return 1;
    int S = G / R; if (S > 8) S = 8; if (S > ntiles / 4) S = ntiles / 4; if (R * S > maxslabs) S = maxslabs / R;
    return S < 2 ? 1 : S;
}
struct Order {
    int nM, nN, G, c, ntiles, mainu, S, total; const int* segs; const int* rowmap;
    int sg1, sg2, sg3, sg4, sg5, sg6, sg7;
    __device__ __forceinline__ void init(int nM_, int nN_, int G_, int c_, const int* segs_, const int* rowmap_, int ntiles_, bool split, int maxslabs) {
        nM = nM_; nN = nN_; G = G_; c = c_; segs = segs_; rowmap = rowmap_; ntiles = ntiles_;
        sg1 = sg2 = sg3 = sg4 = sg5 = sg6 = sg7 = 0; if (segs_) { sg1 = segs_[1]; sg2 = segs_[2]; sg3 = segs_[3]; sg4 = segs_[4]; sg5 = segs_[5]; sg6 = segs_[6]; sg7 = segs_[7]; }
        const int U = nM * nN; S = split ? split_factor(U, G, ntiles, maxslabs) : 1; const int R = (S > 1) ? U % G : 0; mainu = U - R; total = mainu + R * S; }
    __device__ __forceinline__ bool next(int i, Unit& u) const {
        const long L = (long)i * G + c; if (L >= total) return false;
        int wgid; u.kt0 = 0; u.nt = ntiles; u.slab = -1;
        if (L < mainu) { wgid = (int)L; const int q = mainu / NXCD, r = mainu % NXCD, xcd = wgid % NXCD, off = wgid / NXCD; wgid = (xcd < r ? xcd * (q + 1) : r * (q + 1) + (xcd - r) * q) + off; }
        else { const int sub = (int)L - mainu, lu = sub / S, sl = sub - lu * S, pairs = ntiles / 2, p0 = (sl * pairs) / S, p1 = ((sl + 1) * pairs) / S;
            wgid = mainu + lu; u.kt0 = 2 * p0; u.nt = 2 * (p1 - p0); u.slab = sub; }
        const int nig = WGM * nN, gid = wgid / nig, fm = gid * WGM, gsz = (nM - fm) < WGM ? (nM - fm) : WGM;
        u.pm = fm + ((wgid % nig) % gsz); u.pn = (wgid % nig) / gsz; u.e = 0;
        if (segs) u.e = (u.pm >= sg1) + (u.pm >= sg2) + (u.pm >= sg3) + (u.pm >= sg4) + (u.pm >= sg5) + (u.pm >= sg6) + (u.pm >= sg7);
        return true;
    }
    __device__ __forceinline__ int arow(const Unit& u, int r) const {
        if (rowmap) { const int t = rowmap[u.pm * BM + r]; return t < 0 ? 0 : t; }
        return u.pm * BM + r;
    }
};

__device__ __forceinline__ unsigned cvt_pk_bf16(float lo, float hi) { return pk2(lo, hi); }

struct EpiBf16 {
    static constexpr bool PERM = true, SPLIT = false;
    bf16_t* O; int ldc;
    __device__ __forceinline__ void operator()(const f32x4 (&acc)[2][2][4][2], const Unit& u, int wr, int wc, int fr, int fq) const {
        asm volatile("" : "+v"(fr), "+v"(fq));
        const int row0 = u.pm * BM + wr * 64 + fr, col0 = u.pn * BM + wc * 32 + 8 * fq;
#pragma unroll
        for (int ai = 0; ai < 2; ++ai)
#pragma unroll
            for (int m = 0; m < 4; ++m) { bf16_t* rowp = O + (size_t)(row0 + ai * HALF + m * 16) * ldc + col0;
#pragma unroll
                for (int bj = 0; bj < 2; ++bj) { const f32x4 v0 = acc[ai][bj][m][0], v1 = acc[ai][bj][m][1];
                    u32x4 w; w.x = cvt_pk_bf16(v0[0], v0[1]); w.y = cvt_pk_bf16(v0[2], v0[3]); w.z = cvt_pk_bf16(v1[0], v1[1]); w.w = cvt_pk_bf16(v1[2], v1[3]);
                    *(u32x4*)(rowp + bj * HALF) = w; } }
    }
};
struct EpiInProj {
    static constexpr bool PERM = true, SPLIT = false;
    bf16_t* O; int ldc; const float* ct; const float* st;
    __device__ __forceinline__ void operator()(const f32x4 (&acc)[2][2][4][2], const Unit& u, int wr, int wc, int fr, int fq) const {
        asm volatile("" : "+v"(fr), "+v"(fq));
        const int row0 = u.pm * BM + wr * 64 + fr, col0 = u.pn * BM + wc * 32 + 8 * fq;
        const bool rot = (u.pn >= 4) && (u.pn < 8) && (u.pm * BM < NLAT);
#pragma unroll
        for (int ai = 0; ai < 2; ++ai)
#pragma unroll
            for (int m = 0; m < 4; ++m) { const int row = row0 + ai * HALF + m * 16; bf16_t* rowp = O + (size_t)row * ldc + col0;
                f32x4 c = {1.f, 1.f, 1.f, 1.f}, s = {0.f, 0.f, 0.f, 0.f};
                if (rot) { const unsigned to = (unsigned)((row & (SEQ - 1)) * 64 + wc * 16 + fq * 4) * 4u; c = ldg<f32x4>(ct, to); s = ldg<f32x4>(st, to); }
#pragma unroll
                for (int bj = 0; bj < 2; ++bj) { const f32x4 v0 = acc[ai][bj][m][0], v1 = acc[ai][bj][m][1];
                    u32x4 w; w.x = cvt_pk_bf16(v0[0] * c[0] - v0[1] * s[0], v0[0] * s[0] + v0[1] * c[0]); w.y = cvt_pk_bf16(v0[2] * c[1] - v0[3] * s[1], v0[2] * s[1] + v0[3] * c[1]);
                    w.z = cvt_pk_bf16(v1[0] * c[2] - v1[1] * s[2], v1[0] * s[2] + v1[1] * c[2]); w.w = cvt_pk_bf16(v1[2] * c[3] - v1[3] * s[3], v1[2] * s[3] + v1[3] * c[3]);
                    *(u32x4*)(rowp + bj * HALF) = w; } }
    }
};
struct EpiSwiGLU {
    static constexpr bool PERM = true, SPLIT = false;
    bf16_t* O; int ldc;
    __device__ __forceinline__ void operator()(const f32x4 (&acc)[2][2][4][2], const Unit& u, int wr, int wc, int fr, int fq) const {
        asm volatile("" : "+v"(fr), "+v"(fq));
        const int row0 = u.pm * BM + wr * 64 + fr, col0 = u.pn * HALF + wc * 32 + 8 * fq;
#pragma unroll
        for (int ai = 0; ai < 2; ++ai)
#pragma unroll
            for (int m = 0; m < 4; ++m) { bf16_t* rowp = O + (size_t)(row0 + ai * HALF + m * 16) * ldc + col0;
                float o[8];
#pragma unroll
                for (int n = 0; n < 2; ++n)
#pragma unroll
                    for (int j = 0; j < 4; ++j) { const float a = acc[ai][0][m][n][j], b = acc[ai][1][m][n][j]; o[n * 4 + j] = (a * __builtin_amdgcn_rcpf(1.0f + __expf(-a))) * b; }
                u32x4 w; w.x = cvt_pk_bf16(o[0], o[1]); w.y = cvt_pk_bf16(o[2], o[3]); w.z = cvt_pk_bf16(o[4], o[5]); w.w = cvt_pk_bf16(o[6], o[7]);
                *(u32x4*)rowp = w; }
    }
};
struct EpiResid {
    static constexpr bool PERM = true, SPLIT = true;
    const float* src_f32; bf16_t* xb; const float* src_ctx; float* dst_ctx; const float* gate_lat; const float* gate_ctx;
    __device__ __forceinline__ void operator()(const f32x4 (&acc)[2][2][4][2], const Unit& u, int wr, int wc, int fr, int fq) const {
        asm volatile("" : "+v"(fr), "+v"(fq));
        const int prow = u.pm * BM; const bool lat = prow < NLAT;
        const float* gate = lat ? gate_lat + (size_t)(prow / SEQ) * 6144 : gate_ctx;
        const int r0 = wr * 64 + fr, col0 = u.pn * BM + wc * 32 + 8 * fq;
        f32x4 gv[2][2];
#pragma unroll
        for (int bj = 0; bj < 2; ++bj)
#pragma unroll
            for (int n = 0; n < 2; ++n) gv[bj][n] = *(const f32x4*)(gate + col0 + bj * HALF + 4 * n);
        if (lat) {
#pragma unroll
            for (int ai = 0; ai < 2; ++ai)
#pragma unroll
                for (int m = 0; m < 4; ++m) { const size_t off = (size_t)(prow + r0 + ai * HALF + m * 16) * D + col0;
#pragma unroll
                    for (int bj = 0; bj < 2; ++bj) { f32x4 s0, s1;
                        if (src_f32) { s0 = *(const f32x4*)(src_f32 + off + bj * HALF); s1 = *(const f32x4*)(src_f32 + off + bj * HALF + 4); }
                        else unpack8(*(const u32x4*)(xb + off + bj * HALF), s0, s1);
                        *(u32x4*)(xb + off + bj * HALF) = pack8(s0 + gv[bj][0] * acc[ai][bj][m][0], s1 + gv[bj][1] * acc[ai][bj][m][1]); }
                    if (m == 3) asm volatile("" ::: "memory"); }
        } else {
            const float* src = src_ctx + (size_t)(prow - NLAT) * D; float* dst = dst_ctx + (size_t)(prow - NLAT) * D;
#pragma unroll
            for (int ai = 0; ai < 2; ++ai)
#pragma unroll
                for (int m = 0; m < 4; ++m) { const size_t off = (size_t)(r0 + ai * HALF + m * 16) * D + col0;
#pragma unroll
                    for (int bj = 0; bj < 2; ++bj)
#pragma unroll
                        for (int n = 0; n < 2; ++n) { const f32x4 sv = *(const f32x4*)(src + off + bj * HALF + 4 * n); *(f32x4*)(dst + off + bj * HALF + 4 * n) = sv + gv[bj][n] * acc[ai][bj][m][n]; }
                    asm volatile("" ::: "memory"); }
        }
    }
};
struct EpiMoeDown {
    static constexpr bool PERM = true, SPLIT = true;
    bf16_t* xb; const int* ptok; const float* pw; const float* gate_lat;
    __device__ __forceinline__ void operator()(const f32x4 (&acc)[2][2][4][2], const Unit& u, int wr, int wc, int fr, int fq) const {
        asm volatile("" : "+v"(fr), "+v"(fq));
        const int r0 = u.pm * BM + wr * 64 + fr, col0 = u.pn * BM + wc * 32 + 8 * fq;
        int tk[8]; float wk[8];
#pragma unroll
        for (int i = 0; i < 8; ++i) { const int r = r0 + (i >> 2) * HALF + (i & 3) * 16; tk[i] = ptok[r]; wk[i] = pw[r]; }
#pragma unroll
        for (int ai = 0; ai < 2; ++ai)
#pragma unroll
            for (int m = 0; m < 4; ++m) { const int tok = tk[ai * 4 + m]; const float w = wk[ai * 4 + m];
                if (tok >= 0) { bf16_t* xr = xb + (size_t)tok * D + col0; const float* gate = gate_lat + (size_t)(tok / SEQ) * 6144 + col0;
#pragma unroll
                    for (int bj = 0; bj < 2; ++bj) { const f32x4 g0 = *(const f32x4*)(gate + bj * HALF), g1 = *(const f32x4*)(gate + bj * HALF + 4); f32x4 s0, s1; unpack8(*(const u32x4*)(xr + bj * HALF), s0, s1);
                        *(u32x4*)(xr + bj * HALF) = pack8(s0 + (g0 * w) * acc[ai][bj][m][0], s1 + (g1 * w) * acc[ai][bj][m][1]); } }
                if (m & 1) asm volatile("" ::: "memory"); }
    }
};

template <class Epi>
__device__ __forceinline__ void gemm_phase(ldsp_t lds, const Gemm g, const Order& S, const Epi& E, const int tid) {
    const int wid = __builtin_amdgcn_readfirstlane(tid >> 6), lane = tid & 63, wr = wid >> 2, wc = wid & 3, fr = lane & 15, fq = lane >> 4;
    const int K = g.K;
    unsigned voffB[2];
#pragma unroll
    for (int i = 0; i < 2; ++i) { int R, C; stage_rc(tid * 16 + i * 8192, R, C); const int Rb = Epi::PERM ? ((R & ~31) + perm32(R & 31)) : R;
        voffB[i] = (unsigned)(Rb * K + C) * 2u; }
    const size_t kstep = (size_t)(BK * 2);
    const size_t hstep = (size_t)HALF * K * 2;
    const size_t tstep = 2 * hstep;
    const unsigned ldsw = (unsigned)wid * 1024u;
    const int aoff = lds_byte(wr * 64 + fr, fq * 8), boff = lds_byte(wc * 32 + fr, fq * 8);
#define PG8_SA(b, h) (((b) * 2 + (h)) * HTB)
#define PG8_SB(b, h) ((4 + (b) * 2 + (h)) * HTB)
#define PG8_STAGE_B(bufoff, gbase) do { _Pragma("unroll") for (int _i = 0; _i < 2; ++_i) \
        __builtin_amdgcn_global_load_lds((const unsigned*)((const char*)(gbase) + voffB[_i]), (LAS unsigned*)(lds + (bufoff) + ldsw + _i * 8192), 16, 0, 0); } while (0)
#define PG8_STAGE_A(bufoff, gbase, o0, o1) do { \
        __builtin_amdgcn_global_load_lds((const unsigned*)((const char*)(gbase) + (o0)), (LAS unsigned*)(lds + (bufoff) + ldsw), 16, 0, 0); \
        __builtin_amdgcn_global_load_lds((const unsigned*)((const char*)(gbase) + (o1)), (LAS unsigned*)(lds + (bufoff) + ldsw + 8192), 16, 0, 0); } while (0)
#define PG8_LDA(dst, b, h) do { _Pragma("unroll") for (int m = 0; m < 4; ++m) _Pragma("unroll") for (int k = 0; k < 2; ++k) dst[m][k] = *(const LAS bf16x8*)(lds + PG8_SA(b, h) + aoff + m * 2048 + k * 1024); } while (0)
#define PG8_LDB(dst, b, h) do { _Pragma("unroll") for (int n = 0; n < 2; ++n) _Pragma("unroll") for (int k = 0; k < 2; ++k) dst[n][k] = *(const LAS bf16x8*)(lds + PG8_SB(b, h) + boff + n * 2048 + k * 1024); } while (0)
#define PG8_MMA(ai, bj, At, Bt) do { __builtin_amdgcn_s_setprio(1); _Pragma("unroll") for (int m = 0; m < 4; ++m) _Pragma("unroll") for (int n = 0; n < 2; ++n) _Pragma("unroll") for (int k = 0; k < 2; ++k) \
        acc[ai][bj][m][n] = __builtin_amdgcn_mfma_f32_16x16x32_bf16(Bt[n][k], At[m][k], acc[ai][bj][m][n], 0, 0, 0); __builtin_amdgcn_s_setprio(0); } while (0)
#define PG8_WAIT_V(n) asm volatile("s_waitcnt vmcnt(" #n ")" ::: "memory")
#define PG8_WAIT_L(n) asm volatile("s_waitcnt lgkmcnt(" #n ")" ::: "memory")
#define PG8_BAR __builtin_amdgcn_s_barrier()
#define PG8_SCHED __builtin_amdgcn_sched_barrier(0)
#define PG8_AOFFS(u, o00, o01, o10, o11) do { int R0_, C0_, R1_, C1_; stage_rc(tid * 16, R0_, C0_); stage_rc(tid * 16 + 8192, R1_, C1_); \
        o00 = (unsigned)(S.arow(u, R0_) * K + C0_ + (u).kt0 * BK) * 2u; o01 = (unsigned)(S.arow(u, R1_) * K + C1_ + (u).kt0 * BK) * 2u; \
        o10 = (unsigned)(S.arow(u, HALF + R0_) * K + C0_ + (u).kt0 * BK) * 2u; o11 = (unsigned)(S.arow(u, HALF + R1_) * K + C1_ + (u).kt0 * BK) * 2u; } while (0)
    Unit cur, nxt; int ui = 0;
    if (!S.next(0, cur)) return;
    f32x4 acc[2][2][4][2];
    { float z_; asm volatile("v_mov_b32 %0, 0" : "=v"(z_));
#pragma unroll
    for (int a = 0; a < 2; ++a)
#pragma unroll
        for (int b = 0; b < 2; ++b)
#pragma unroll
            for (int m = 0; m < 4; ++m)
#pragma unroll
                for (int n = 0; n < 2; ++n) acc[a][b][m][n] = (f32x4){z_, z_, z_, z_}; }
    bf16x8 At[4][2], B0[2][2], B1[2][2];
    const char* const Abase = (const char*)g.A;
    const char* cB = (const char*)g.Bt + (size_t)cur.e * g.estride + (size_t)cur.pn * tstep + (size_t)cur.kt0 * kstep;
    unsigned c00, c01, c10, c11;
    PG8_AOFFS(cur, c00, c01, c10, c11);
    PG8_STAGE_B(PG8_SB(0, 0), cB); PG8_STAGE_B(PG8_SB(0, 1), cB + hstep); PG8_STAGE_A(PG8_SA(0, 0), Abase, c00, c01); PG8_STAGE_A(PG8_SA(0, 1), Abase, c10, c11);
    if (wr == 1) PG8_BAR;
    PG8_WAIT_V(2); PG8_BAR;
    PG8_STAGE_B(PG8_SB(1, 0), cB + kstep); PG8_STAGE_A(PG8_SA(1, 0), Abase + kstep, c00, c01); PG8_STAGE_B(PG8_SB(1, 1), cB + hstep + kstep);
    PG8_WAIT_V(6); PG8_BAR;
    for (;;) {
        const bool has_next = S.next(ui + 1, nxt);
        const char* nB = has_next ? (const char*)g.Bt + (size_t)nxt.e * g.estride + (size_t)nxt.pn * tstep + (size_t)nxt.kt0 * kstep : cB;
        const int nt = cur.nt;
        int rn0 = 0, rn1 = 0, rn2 = 0, rn3 = 0;
        if (S.rowmap && has_next) { int R0_, C0_, R1_, C1_; stage_rc(tid * 16, R0_, C0_); stage_rc(tid * 16 + 8192, R1_, C1_);
            rn0 = S.arow(nxt, R0_); rn1 = S.arow(nxt, R1_); rn2 = S.arow(nxt, HALF + R0_); rn3 = S.arow(nxt, HALF + R1_); }
        for (int t = 0; t < nt; t += 2) {
            const bool last = (t == nt - 2);
            const char* a1 = Abase + (size_t)(t + 1) * kstep;
            const char* a2 = last ? Abase : Abase + (size_t)(t + 2) * kstep; const char* b2 = last ? nB : cB + (size_t)(t + 2) * kstep;
            const char* a3 = a2 + kstep; const char* b3 = b2 + kstep;
            PG8_LDB(B0, 0, 0); PG8_LDB(B1, 0, 1); PG8_SCHED; PG8_LDA(At, 0, 0); PG8_STAGE_A(PG8_SA(1, 1), a1, c10, c11);
            PG8_WAIT_V(8); PG8_WAIT_L(0); PG8_BAR; PG8_MMA(0, 0, At, B0); PG8_MMA(0, 1, At, B1); PG8_BAR; PG8_SCHED;
            if (last && has_next) {
                if (S.rowmap) { int R0_, C0_, R1_, C1_; stage_rc(tid * 16, R0_, C0_); stage_rc(tid * 16 + 8192, R1_, C1_);
                    c00 = (unsigned)(rn0 * K + C0_ + nxt.kt0 * BK) * 2u; c01 = (unsigned)(rn1 * K + C1_ + nxt.kt0 * BK) * 2u; c10 = (unsigned)(rn2 * K + C0_ + nxt.kt0 * BK) * 2u; c11 = (unsigned)(rn3 * K + C1_ + nxt.kt0 * BK) * 2u; }
                else { PG8_AOFFS(nxt, c00, c01, c10, c11); } }
            PG8_LDA(At, 0, 1); PG8_STAGE_B(PG8_SB(0, 0), b2); PG8_STAGE_B(PG8_SB(0, 1), b2 + hstep); PG8_STAGE_A(PG8_SA(0, 0), a2, c00, c01);
            PG8_WAIT_V(8); PG8_WAIT_L(0); PG8_BAR; PG8_MMA(1, 0, At, B0); PG8_MMA(1, 1, At, B1); PG8_BAR; PG8_SCHED;
            PG8_LDB(B0, 1, 0); PG8_LDB(B1, 1, 1); PG8_SCHED; PG8_LDA(At, 1, 0); PG8_STAGE_A(PG8_SA(0, 1), a2, c10, c11);
            PG8_WAIT_V(8); PG8_WAIT_L(0); PG8_BAR; PG8_MMA(0, 0, At, B0); PG8_MMA(0, 1, At, B1); PG8_BAR; PG8_SCHED;
            PG8_LDA(At, 1, 1); PG8_STAGE_B(PG8_SB(1, 0), b3); PG8_STAGE_B(PG8_SB(1, 1), b3 + hstep); PG8_STAGE_A(PG8_SA(1, 0), a3, c00, c01);
            PG8_WAIT_V(8); PG8_WAIT_L(0); PG8_BAR; PG8_MMA(1, 0, At, B0); PG8_MMA(1, 1, At, B1); PG8_BAR; PG8_SCHED;
        }
        if (wr == 0) PG8_BAR;
        if (Epi::SPLIT && cur.slab >= 0) {
            int fr_ = fr, fq_ = fq; asm volatile("" : "+v"(fr_), "+v"(fq_));
            float* sp = g.slabs + (size_t)cur.slab * 65536 + (size_t)(wr * 64 + fr_) * 256 + wc * 32 + (Epi::PERM ? 8 : 4) * fq_;
#pragma unroll
            for (int ai = 0; ai < 2; ++ai)
#pragma unroll
                for (int m = 0; m < 4; ++m)
#pragma unroll
                    for (int bj = 0; bj < 2; ++bj)
#pragma unroll
                        for (int n = 0; n < 2; ++n) *(f32x4*)(sp + (ai * HALF + m * 16) * 256 + bj * HALF + n * (Epi::PERM ? 4 : 16)) = acc[ai][bj][m][n];
        } else E(acc, cur, wr, wc, fr, fq);
        if (!has_next) break;
        { float z_; asm volatile("v_mov_b32 %0, 0" : "=v"(z_));
#pragma unroll
        for (int a = 0; a < 2; ++a)
#pragma unroll
            for (int b = 0; b < 2; ++b)
#pragma unroll
                for (int m = 0; m < 4; ++m)
#pragma unroll
                    for (int n = 0; n < 2; ++n) acc[a][b][m][n] = (f32x4){z_, z_, z_, z_}; }
        cur = nxt; cB = nB; ++ui;
        if (wr == 1) PG8_BAR;
    }
    PG8_WAIT_V(0);
    PG8_BAR;
#undef PG8_SA
#undef PG8_SB
#undef PG8_STAGE_A
#undef PG8_STAGE_B
#undef PG8_LDA
#undef PG8_LDB
#undef PG8_MMA
#undef PG8_WAIT_V
#undef PG8_WAIT_L
#undef PG8_BAR
#undef PG8_SCHED
#undef PG8_AOFFS
}
}

struct Args { const float* in[27]; float* out; unsigned char* ws; int ph_lo, ph_hi; };
struct Frame {
    ldsp_t lds; int tid, lane, wave, wave0, G, bid;
    const Args* pa; float* out; unsigned char* ws;
    const Args* pa0; float* out0; unsigned char* ws0;
};
enum { I_X = 0, I_C, I_CTX, I_CCTX, I_WMOD, I_BMOD, I_GMIX, I_GFFN, I_GFINAL, I_WIN, I_WOUT, I_CONVW, I_CONVB, I_RGWA, I_RGBA, I_RGWX, I_RGBX, I_RGLAM, I_RETDEC,
       I_FW1, I_FW3, I_FW2, I_MROUTER, I_MROUTERB, I_MW1, I_MW3, I_MW2 };

constexpr int TRS = 64 * 65 * 4;
struct TrItem { const float* W; bf16_t* WT; int ldw, k0, n0, ldt, drow0; float scale; int perm; };
__device__ __forceinline__ void tr_load(const TrItem& t, f32x4 (&v)[16], int lane) {
    const int r4 = lane >> 4, c4 = (lane & 15) * 4;
#pragma unroll
    for (int i = 0; i < 16; ++i) v[i] = *(const f32x4*)(t.W + (size_t)(t.k0 + 4 * i + r4) * t.ldw + t.n0 + c4);
}
__device__ __forceinline__ void tr_store(const TrItem& t, const f32x4 (&v)[16], LAS float* scr, int lane) {
    { const int r4 = lane >> 4, c4 = (lane & 15) * 4;
#pragma unroll
      for (int i = 0; i < 16; ++i) { LAS float* d = scr + (4 * i + r4) * 65 + c4; d[0] = v[i].x; d[1] = v[i].y; d[2] = v[i].z; d[3] = v[i].w; } }
    LDS_WAIT(); asm volatile("" ::: "memory");
    const int c = lane & 7; const float scale = t.scale;
#pragma unroll
    for (int j = 0; j < 8; ++j) { const int n = (lane >> 3) + 8 * j; const LAS float* sp = scr + (8 * c) * 65 + n;
        u32x4 o; o.x = pk2(sp[0 * 65] * scale, sp[1 * 65] * scale); o.y = pk2(sp[2 * 65] * scale, sp[3 * 65] * scale); o.z = pk2(sp[4 * 65] * scale, sp[5 * 65] * scale); o.w = pk2(sp[6 * 65] * scale, sp[7 * 65] * scale);
        int drow = t.drow0 + n; if (t.perm) drow = (drow & ~127) + ((drow & 63) << 1) + ((drow >> 6) & 1);
        *(u32x4*)(t.WT + (size_t)drow * t.ldt + t.k0 + 8 * c) = o; }
    LDS_WAIT(); asm volatile("" ::: "memory");
}
__device__ __forceinline__ TrItem up_item(const float* w1, const float* w3, int F, bf16_t* WT, int r) {
    const int per = 16 * (F / 64); const int which = r / per; r -= which * per;
    const int nblk = F / 64, kb = r / nblk, nb = r % nblk, n0 = nb * 64;
    return TrItem{which ? w3 : w1, WT, F, kb * 64, n0, D, (n0 / 128) * 256 + (n0 % 128) + which * 128, 1.0f, 0};
}
__device__ __forceinline__ TrItem small_item(Frame& F, int r) {
    constexpr int I_IN = 16 * (INW / 64), I_OUT = 16 * (D / 64), I_UP = 2 * 16 * (DFF / 64);
    if (r < 2 * I_IN) { const int l = r / I_IN; r -= l * I_IN; const int nblk = INW / 64, kb = r / nblk, nb = r % nblk, n0 = nb * 64;
        const float sc = (n0 >= 1536 && n0 < 2048) ? 0.08838834764831845f : 1.0f;
        return TrItem{F.pa->in[I_WIN] + (size_t)l * D * INW, (bf16_t*)(F.ws + WS_WIN) + (size_t)l * INW * D, INW, kb * 64, n0, D, n0, sc, (n0 >= 1024 && n0 < 2048) ? 1 : 0}; }
    r -= 2 * I_IN;
    if (r < 2 * I_OUT) { const int l = r / I_OUT; r -= l * I_OUT; const int nblk = D / 64, kb = r / nblk, nb = r % nblk;
        return TrItem{F.pa->in[I_WOUT] + (size_t)l * D * D, (bf16_t*)(F.ws + WS_WOUT) + (size_t)l * D * D, D, kb * 64, nb * 64, D, nb * 64, 1.0f, 0}; }
    r -= 2 * I_OUT;
    if (r < I_UP) return up_item(F.pa->in[I_FW1], F.pa->in[I_FW3], DFF, (bf16_t*)(F.ws + WS_WUP), r);
    r -= I_UP;
    { const int nblk = D / 64, kb = r / nblk, nb = r % nblk; return TrItem{F.pa->in[I_FW2], (bf16_t*)(F.ws + WS_WDN), D, kb * 64, nb * 64, DFF, nb * 64, 1.0f, 0}; }
}
__device__ __forceinline__ TrItem moe_item(Frame& F, int it) {
    constexpr int I_UP = 2 * 16 * (DEXP / 64), I_DN = (DEXP / 64) * (D / 64), PER_E = I_UP + I_DN;
    const int e = it / PER_E; int r = it - e * PER_E;
    if (r < I_UP) return up_item(F.pa->in[I_MW1] + (size_t)e * D * DEXP, F.pa->in[I_MW3] + (size_t)e * D * DEXP, DEXP, (bf16_t*)(F.ws + WS_MOEUP) + (size_t)e * 2 * DEXP * D, r);
    r -= I_UP;
    { const int nblk = D / 64, kb = r / nblk, nb = r % nblk; return TrItem{F.pa->in[I_MW2] + (size_t)e * DEXP * D, (bf16_t*)(F.ws + WS_MOEDN) + (size_t)e * D * DEXP, D, kb * 64, nb * 64, DEXP, nb * 64, 1.0f, 0}; }
}
__device__ __forceinline__ void phase_convert_small(Frame& F) {
    LAS float* scr = (LAS float*)(F.lds + F.wave * TRS);
    const int gw = F.bid * NWAVES + F.wave, NGW = F.G * NWAVES;
    constexpr int NITEMS = 2 * 16 * (INW / 64) + 2 * 16 * (D / 64) + 2 * 16 * (DFF / 64) + (DFF / 64) * (D / 64);
    if (gw < NITEMS) { TrItem cur = small_item(F, gw); f32x4 va[16], vb[16]; tr_load(cur, va, F.lane);
        for (int it = gw; it < NITEMS; it += 2 * NGW) {
            const bool h1 = it + NGW < NITEMS; TrItem n1 = cur; if (h1) { n1 = small_item(F, it + NGW); tr_load(n1, vb, F.lane); }
            tr_store(cur, va, scr, F.lane);
            if (!h1) break;
            const bool h2 = it + 2 * NGW < NITEMS; if (h2) { cur = small_item(F, it + 2 * NGW); tr_load(cur, va, F.lane); }
            tr_store(n1, vb, scr, F.lane);
            if (!h2) break; } }
    { const int gt = F.bid * NTHREADS + F.tid, NGT = F.G * NTHREADS; bf16_t* o = (bf16_t*)(F.ws + WS_RGW);
      for (int i = gt; i < 2 * 2 * 2 * 8 * 64 * 64; i += NGT) { const int c = i & 63, dp = (i >> 6) & 63, blk = (i >> 12) & 7, gate = (i >> 15) & 1, dir = (i >> 16) & 1, l = i >> 17;
          const float* src = gate ? F.pa->in[I_RGWX] : F.pa->in[I_RGWA]; o[i] = (bf16_t)f2bf(src[((((size_t)l * 2 + dir) * 8 + blk) * 64 + c) * 64 + dp]); } }
    { const int gt = F.bid * NTHREADS + F.tid, NGT = F.G * NTHREADS; float* ct = (float*)(F.ws + WS_ROPE); float* st = ct + 4096 * 64;
      for (int i = gt; i < 4096 * 64; i += NGT) { const int pos = i >> 6, fi = i & 63; const float p = (float)((fi < 32) ? (pos >> 6) : (pos & 63));
          const float inv = powf(10000.0f, -(float)(fi & 31) / 32.0f); const float ang = p * inv;
          const double a = (double)ang; const double kq = __builtin_rint(a * 0.63661977236758134308); const double rr = a - kq * 1.57079632679489661923; const int q = ((int)kq) & 3;
          const double r2 = rr * rr;
          const double sn = rr * (1.0 + r2 * (-1.0 / 6 + r2 * (1.0 / 120 + r2 * (-1.0 / 5040 + r2 * (1.0 / 362880 + r2 * (-1.0 / 39916800))))));
          const double cs = 1.0 + r2 * (-0.5 + r2 * (1.0 / 24 + r2 * (-1.0 / 720 + r2 * (1.0 / 40320 + r2 * (-1.0 / 3628800 + r2 * (1.0 / 479001600))))));
          const double c_ = (q == 0) ? cs : (q == 1) ? -sn : (q == 2) ? -cs : sn; const double s_ = (q == 0) ? sn : (q == 1) ? cs : (q == 2) ? -sn : -cs;
          ct[i] = (float)c_; st[i] = (float)s_; } }
}
struct MoeTile { const float* W; bf16_t* WT; int ldw, k0, n0, ldt, up; };
__device__ __forceinline__ MoeTile moe_tile(Frame& F, int t) {
    constexpr int T_UP1 = (D / 128) * (DEXP / 256), T_DN = (DEXP / 128) * (D / 256), PER_E = 2 * T_UP1 + T_DN;
    const int e = t / PER_E; int r = t - e * PER_E;
    if (r < 2 * T_UP1) { const int which = r / T_UP1; r -= which * T_UP1; const int nb = DEXP / 256, kb = r / nb, nn = r % nb;
        return MoeTile{(which ? F.pa->in[I_MW3] : F.pa->in[I_MW1]) + (size_t)e * D * DEXP, (bf16_t*)(F.ws + WS_MOEUP) + (size_t)e * 2 * DEXP * D, DEXP, kb * 128, nn * 256, D, 1 + which}; }
    r -= 2 * T_UP1;
    { const int nb = D / 256, kb = r / nb, nn = r % nb; return MoeTile{F.pa->in[I_MW2] + (size_t)e * DEXP * D, (bf16_t*)(F.ws + WS_MOEDN) + (size_t)e * D * DEXP, D, kb * 128, nn * 256, DEXP, 0}; }
}
__device__ __forceinline__ void moe_tile_load(const MoeTile& t, f32x4 (&v)[16], int wave, int lane) {
#pragma unroll
    for (int i = 0; i < 16; ++i) v[i] = *(const f32x4*)(t.W + (size_t)(t.k0 + 16 * wave + i) * t.ldw + t.n0 + 4 * lane);
}
__device__ __forceinline__ void moe_tile_store(Frame& F, const MoeTile& t, const f32x4 (&v)[16]) {
    LAS float* tile = (LAS float*)F.lds;
#pragma unroll
    for (int i = 0; i < 16; ++i) { const int k = 16 * F.wave + i, p = (4 * F.lane + 2 * (k >> 3)) & 255;
        *(LAS f32x2*)(tile + k * 256 + p) = (f32x2){v[i].x, v[i].y}; *(LAS f32x2*)(tile + k * 256 + ((p + 2) & 255)) = (f32x2){v[i].z, v[i].w}; }
    __syncthreads();
#pragma unroll
    for (int j = 0; j < 8; ++j) { const int task = F.tid + j * NTHREADS, c = task & 15, n = task >> 4; const LAS float* sp = tile + (8 * c) * 256 + ((n + 2 * c) & 255);
        u32x4 o; o.x = pk2(sp[0], sp[256]); o.y = pk2(sp[512], sp[768]); o.z = pk2(sp[1024], sp[1280]); o.w = pk2(sp[1536], sp[1792]);
        const int col = t.n0 + n; const int drow = t.up ? (col >> 7) * 256 + (col & 127) + 128 * (t.up - 1) : col;
        *(u32x4*)(t.WT + (size_t)drow * t.ldt + t.k0 + 8 * c) = o; }
    __syncthreads();
}
__device__ __forceinline__ void phase_convert_moe(Frame& F) {
    constexpr int NT = NE * (2 * (D / 128) * (DEXP / 256) + (DEXP / 128) * (D / 256));
    if (F.bid < NT) { MoeTile cur = moe_tile(F, F.bid); f32x4 va[16], vb[16]; moe_tile_load(cur, va, F.wave, F.lane);
        for (int t = F.bid; t < NT; t += 2 * F.G) {
            const bool h1 = t + F.G < NT; MoeTile n1 = cur; if (h1) { n1 = moe_tile(F, t + F.G); moe_tile_load(n1, vb, F.wave, F.lane); }
            moe_tile_store(F, cur, va);
            if (!h1) break;
            const bool h2 = t + 2 * F.G < NT; if (h2) { cur = moe_tile(F, t + 2 * F.G); moe_tile_load(cur, va, F.wave, F.lane); }
            moe_tile_store(F, n1, vb);
            if (!h2) break; } }
}
__device__ __forceinline__ void phase_mod(Frame& F) {
    LAS float* sc = (LAS float*)F.lds;
    LAS float* red = (LAS float*)(F.lds + 9 * 1024 * 4);
    for (int i = F.tid; i < 9 * 1024; i += NTHREADS) { const int r = i >> 10, k = i & 1023; const float v = (r < 8) ? F.pa->in[I_C][r * 1024 + k] : F.pa->in[I_CCTX][k]; sc[i] = v / (1.0f + __expf(-v)); }
    __syncthreads();
    for (int strip = F.bid; strip < 2 * 6144 / 64; strip += F.G) {
        const int l = strip / 96, j = (strip % 96) * 64 + F.lane;
        const float* w = F.pa->in[I_WMOD] + (size_t)l * 1024 * 6144 + j;
        float a[9];
#pragma unroll
        for (int r = 0; r < 9; ++r) a[r] = 0.f;
        const int k0 = F.wave * 128;
#pragma unroll 1
        for (int kk = k0; kk < k0 + 128; kk += 16) { float wv[16];
#pragma unroll
            for (int i = 0; i < 16; ++i) wv[i] = w[(size_t)(kk + i) * 6144];
#pragma unroll
            for (int i = 0; i < 16; ++i) {
#pragma unroll
                for (int r = 0; r < 9; ++r) a[r] += sc[r * 1024 + kk + i] * wv[i];
                if ((i & 3) == 3) __builtin_amdgcn_sched_barrier(0); } }
#pragma unroll
        for (int r = 0; r < 9; ++r) red[(F.wave * 9 + r) * 64 + F.lane] = a[r];
        __syncthreads();
        for (int i = F.tid; i < 9 * 64; i += NTHREADS) { const int r = i >> 6, jj = i & 63; float s = 0.f;
#pragma unroll
            for (int w8 = 0; w8 < 8; ++w8) s += red[(w8 * 9 + r) * 64 + jj];
            const int col = (strip % 96) * 64 + jj; s += F.pa->in[I_BMOD][l * 6144 + col];
            if (r < 8) ((float*)(F.ws + WS_MODLAT))[((size_t)l * 8 + r) * 6144 + col] = s; else ((float*)(F.ws + WS_MODCTX))[(size_t)l * 6144 + col] = s; }
        __syncthreads();
    }
}

__device__ __forceinline__ void norm_row(const u32x2 (&xw)[4], const f32x4 (&Am)[4], const f32x4 (&Sh)[4], bf16_t* orow, int lane, f32x4 (&y)[4]) {
    f32x4 v[4]; float ss = 0.f;
#pragma unroll
    for (int j = 0; j < 4; ++j) { const u32x2 w = xw[j]; v[j] = (f32x4){bf2f(w.x & 0xffffu), __uint_as_float(w.x & 0xffff0000u), bf2f(w.y & 0xffffu), __uint_as_float(w.y & 0xffff0000u)};
        ss += (v[j].x * v[j].x + v[j].y * v[j].y) + (v[j].z * v[j].z + v[j].w * v[j].w); }
    const float rstd = 1.0f / sqrtf(wave_sum(ss) * (1.0f / D) + EPS);
    u32x2* o8 = (u32x2*)orow + lane;
#pragma unroll
    for (int j = 0; j < 4; ++j) { y[j] = (v[j] * rstd) * Am[j] + Sh[j]; o8[64 * j] = (u32x2){pk2(y[j].x, y[j].y), pk2(y[j].z, y[j].w)}; }
}
struct SlabRed { const float* slab; int S; const float* gate; const float* xold; float* xnew; };
__device__ __forceinline__ void norm_row_v(f32x4 (&v)[4], const float* g, const float* shift, const float* scale, bf16_t* orow, int lane) {
    float ss = 0.f;
#pragma unroll
    for (int j = 0; j < 4; ++j) ss += (v[j].x * v[j].x + v[j].y * v[j].y) + (v[j].z * v[j].z + v[j].w * v[j].w);
    const float rstd = 1.0f / sqrtf(wave_sum(ss) * (1.0f / D) + EPS);
    u32x2* o8 = (u32x2*)orow + lane;
#pragma unroll
    for (int j = 0; j < 4; ++j) { const f32x4 gg = ((const f32x4*)g)[lane + 64 * j], sh = ((const f32x4*)shift)[lane + 64 * j], sl = ((const f32x4*)scale)[lane + 64 * j];
        const f32x4 y = (v[j] * rstd) * gg * (sl + 1.0f) + sh;
        u32x2 w; w.x = pk2(y.x, y.y); w.y = pk2(y.z, y.w); o8[64 * j] = w; }
}
__device__ __forceinline__ void phase_norm(Frame& F, int l, int sel, const float* xlat, const bf16_t* xb, const float* xctx, int nrows, const SlabRed sr) {
    const int gw = F.bid * NWAVES + F.wave, NGW = F.G * NWAVES;
    const float* g = (sel ? F.pa->in[I_GFFN] : F.pa->in[I_GMIX]) + l * D; const int so = sel ? 3072 : 0;
    bf16_t* HX = (bf16_t*)(F.ws + WS_HX);
    const int nlat = nrows < NLAT ? nrows : NLAT; const int per = (nlat + NGW - 1) / NGW, r_lo = gw * per, r_hi = (r_lo + per < nlat) ? r_lo + per : nlat;
    int curb = -1; f32x4 Am[4], Sh[4];
    for (int row0 = r_lo; row0 < r_hi; row0 += 4) {
        f32x4 v[4][4];
#pragma unroll
        for (int u = 0; u < 4; ++u) { const int row = (row0 + u < r_hi) ? row0 + u : row0;
            if (xb) { const u32x2* xr = (const u32x2*)(xb + (size_t)row * D) + F.lane;
#pragma unroll
                for (int j = 0; j < 4; ++j) { const u32x2 w = xr[64 * j]; v[u][j] = (f32x4){bf2f(w.x & 0xffffu), __uint_as_float(w.x & 0xffff0000u), bf2f(w.y & 0xffffu), __uint_as_float(w.y & 0xffff0000u)}; } }
            else { const f32x4* xr = (const f32x4*)(xlat + (size_t)row * D) + F.lane;
#pragma unroll
                for (int j = 0; j < 4; ++j) v[u][j] = xr[64 * j]; } }
#pragma unroll
        for (int u = 0; u < 4; ++u) { const int row = row0 + u; if (row >= r_hi) continue;
            const int b = row / SEQ;
            if (b != curb) { curb = b; const float* mod = (const float*)(F.ws + WS_MODLAT) + ((size_t)l * 8 + b) * 6144 + so;
#pragma unroll
                for (int j = 0; j < 4; ++j) { Am[j] = ((const f32x4*)g)[F.lane + 64 * j] * (((const f32x4*)(mod + 1024))[F.lane + 64 * j] + 1.0f); Sh[j] = ((const f32x4*)mod)[F.lane + 64 * j]; } }
            float ss = 0.f;
#pragma unroll
            for (int j = 0; j < 4; ++j) ss += (v[u][j].x * v[u][j].x + v[u][j].y * v[u][j].y) + (v[u][j].z * v[u][j].z + v[u][j].w * v[u][j].w);
            const float rstd = 1.0f / sqrtf(wave_sum(ss) * (1.0f / D) + EPS);
            u32x2* o8 = (u32x2*)(HX + (size_t)row * D) + F.lane;
#pragma unroll
            for (int j = 0; j < 4; ++j) { const f32x4 y = (v[u][j] * rstd) * Am[j] + Sh[j]; o8[64 * j] = (u32x2){pk2(y.x, y.y), pk2(y.z, y.w)}; } }
    }
    for (int row = NLAT + gw; row < nrows; row += NGW) {
        const float* mod = (const float*)(F.ws + WS_MODCTX) + (size_t)l * 6144;
        f32x4 v[4];
        if (sr.slab == nullptr) { const f32x4* xr = (const f32x4*)(xctx + (size_t)(row - NLAT) * D) + F.lane;
#pragma unroll
            for (int j = 0; j < 4; ++j) v[j] = xr[64 * j]; }
        else { const int rc = row - NLAT, pmr = rc >> 8, r = rc & 255;
#pragma unroll
            for (int j = 0; j < 4; ++j) { f32x4 a = zero4(); const float* sp = sr.slab + (size_t)((pmr + 8 * j) * sr.S) * 65536 + (size_t)r * 256 + 4 * F.lane;
                f32x4 t8[8];
#pragma unroll
                for (int q = 0; q < 8; ++q) t8[q] = *(const f32x4*)(sp + (size_t)(q < sr.S ? q : sr.S - 1) * 65536);
#pragma unroll
                for (int q = 0; q < 8; ++q) a += t8[q] * (q < sr.S ? 1.0f : 0.0f);
                v[j] = ((const f32x4*)(sr.xold + (size_t)rc * D))[F.lane + 64 * j] + ((const f32x4*)sr.gate)[F.lane + 64 * j] * a;
                ((f32x4*)(sr.xnew + (size_t)rc * D))[F.lane + 64 * j] = v[j]; } }
        norm_row_v(v, g, mod + so, mod + so + 1024, HX + (size_t)row * D, F.lane);
    }
}
__device__ __forceinline__ void moe_reduce(Frame& F, int k) {
    const int* meta = (const int*)(F.ws + MOE_META) + 9 * k; const int npan = meta[8], gsz = npan - 128;
    if (gsz <= 0) return;
    const int S = pg8::split_factor(npan * 4, F.G, DEXP / 64, MAXSLAB_M); if (S < 2) return;
    const int gw = F.bid * NWAVES + F.wave, NGW = F.G * NWAVES;
    const int* ptok = (const int*)(F.ws + MOE_PTOK) + k * MROWS; const float* pw = (const float*)(F.ws + MOE_PW) + k * MROWS;
    const float* slab = (const float*)(F.ws + WS_SLABM); const float* gate_lat = (const float*)(F.ws + WS_MODLAT) + (size_t)8 * 6144 + 5120;
    for (int rr = NLAT + gw; rr < npan * 256; rr += NGW) { const int tok = ptok[rr]; if (tok < 0) continue; const float w = pw[rr];
        const int pmr = (rr - NLAT) >> 8, r = rr & 255; u32x2* xr = (u32x2*)((bf16_t*)((char*)F.out + XB_OFF) + (size_t)tok * D); const f32x4* gt = (const f32x4*)(gate_lat + (size_t)(tok / SEQ) * 6144);
#pragma unroll
        for (int j = 0; j < 4; ++j) { f32x4 a = zero4(); const float* sp = slab + (size_t)((pmr + gsz * j) * S) * 65536 + (size_t)r * 256 + 4 * F.lane;
            { f32x4 t8[8];
#pragma unroll
              for (int q = 0; q < 8; ++q) t8[q] = *(const f32x4*)(sp + (size_t)(q < S ? q : S - 1) * 65536);
#pragma unroll
              for (int q = 0; q < 8; ++q) a += t8[q] * (q < S ? 1.0f : 0.0f); }
            const u32x2 xo = xr[F.lane + 64 * j]; const f32x4 xv = {bf2f(xo.x & 0xffffu), __uint_as_float(xo.x & 0xffff0000u), bf2f(xo.y & 0xffffu), __uint_as_float(xo.y & 0xffff0000u)};
            const f32x4 y = xv + (gt[F.lane + 64 * j] * w) * a; xr[F.lane + 64 * j] = (u32x2){pk2(y.x, y.y), pk2(y.z, y.w)}; } }
}
__device__ __forceinline__ void phase_norm_router(Frame& F, const bf16_t* xb) {
    constexpr int l = 1;
    LAS float* wr = (LAS float*)F.lds;
    LAS int* le = (LAS int*)(F.lds + 32768);
    for (int i = F.tid; i < 1024 * 8 / 4; i += NTHREADS) ((LAS f32x4*)wr)[i] = ((const f32x4*)F.pa->in[I_MROUTER])[i];
    __syncthreads();
    const float* g = F.pa->in[I_GFFN] + l * D; bf16_t* HX = (bf16_t*)(F.ws + WS_HX);
    int* toke = (int*)(F.ws + MOE_TOKE); float* tokw = (float*)(F.ws + MOE_TOKW);
    for (int wg = F.bid; wg < NLAT / 128; wg += F.G) {
        u32x2 nx[4]; f32x4 Am[4], Sh[4];
        { const float* mod = (const float*)(F.ws + WS_MODLAT) + ((size_t)l * 8 + (wg * 128) / SEQ) * 6144 + 3072;
#pragma unroll
          for (int j = 0; j < 4; ++j) { Am[j] = ((const f32x4*)g)[F.lane + 64 * j] * (((const f32x4*)(mod + 1024))[F.lane + 64 * j] + 1.0f); Sh[j] = ((const f32x4*)mod)[F.lane + 64 * j]; } }
        { const u32x2* xr = (const u32x2*)(xb + (size_t)(wg * 128 + F.wave * 16) * D) + F.lane;
#pragma unroll
          for (int j = 0; j < 4; ++j) nx[j] = xr[64 * j]; }
        for (int i = 0; i < 16; ++i) { const int tl = F.wave * 16 + i, row = wg * 128 + tl;
            u32x2 cx[4];
#pragma unroll
            for (int j = 0; j < 4; ++j) cx[j] = nx[j];
            { const int rn = (i < 15) ? row + 1 : row; const u32x2* xr = (const u32x2*)(xb + (size_t)rn * D) + F.lane;
#pragma unroll
              for (int j = 0; j < 4; ++j) nx[j] = xr[64 * j]; }
            f32x4 y[4]; norm_row(cx, Am, Sh, HX + (size_t)row * D, F.lane, y);
            float lg[8];
#pragma unroll
            for (int e = 0; e < 8; ++e) lg[e] = 0.f;
#pragma unroll
            for (int j = 0; j < 4; ++j)
#pragma unroll
                for (int q = 0; q < 4; ++q) { const int k = 4 * F.lane + 256 * j + q; const f32x4 w0 = *(const LAS f32x4*)(wr + k * 8), w1 = *(const LAS f32x4*)(wr + k * 8 + 4); const float yv = y[j][q];
                    lg[0] += yv * w0.x; lg[1] += yv * w0.y; lg[2] += yv * w0.z; lg[3] += yv * w0.w; lg[4] += yv * w1.x; lg[5] += yv * w1.y; lg[6] += yv * w1.z; lg[7] += yv * w1.w; }
#pragma unroll
            for (int e = 0; e < 8; ++e) lg[e] = wave_sum(lg[e]) + F.pa->in[I_MROUTERB][e];
            int e0 = 0; float v0 = lg[0];
#pragma unroll
            for (int e = 1; e < 8; ++e) if (lg[e] > v0) { v0 = lg[e]; e0 = e; }
            int e1 = -1; float v1 = -3.0e38f;
#pragma unroll
            for (int e = 0; e < 8; ++e) if (e != e0 && lg[e] > v1) { v1 = lg[e]; e1 = e; }
            const float w0 = 1.0f / (1.0f + __expf(v1 - v0));
            if (F.lane == 0) { toke[row] = e0 | (e1 << 8); tokw[2 * row] = w0; tokw[2 * row + 1] = 1.0f - w0; le[tl] = e0 | (e1 << 8); }
        }
        __syncthreads();
        if (F.tid < 16) { const int k = F.tid >> 3, e = F.tid & 7; int c = 0; for (int t = 0; t < 128; ++t) c += (((le[t] >> (8 * k)) & 0xff) == e) ? 1 : 0; ((int*)(F.ws + MOE_CNT))[wg * 16 + F.tid] = c; }
        __syncthreads();
    }
}
__device__ __forceinline__ void phase_moe_sort(Frame& F) {
    LAS int* tot = (LAS int*)F.lds;
    LAS int* pre = tot + 16;
    LAS int* seg = tot + 32;
    LAS int* le = tot + 64;
    const int* cnt = (const int*)(F.ws + MOE_CNT); const int* toke = (const int*)(F.ws + MOE_TOKE); const float* tokw = (const float*)(F.ws + MOE_TOKW);
    int* ptok = (int*)(F.ws + MOE_PTOK); float* pw = (float*)(F.ws + MOE_PW); int* meta = (int*)(F.ws + MOE_META);
    for (int wg = F.bid; wg < NLAT / 128; wg += F.G) {
        { LAS int* part = tot + 256;
          if (F.tid < 256) { const int col = F.tid & 15, pt = F.tid >> 4; int t = 0, p = 0;
#pragma unroll
              for (int i = 0; i < 16; ++i) { const int w = pt * 16 + i; const int c = cnt[w * 16 + col]; t += c; p += (w < wg) ? c : 0; }
              part[pt * 16 + col] = t; part[256 + pt * 16 + col] = p; }
          if (F.tid >= 256 && F.tid < 384) le[F.tid - 256] = toke[wg * 128 + F.tid - 256];
          __syncthreads();
          if (F.tid < 16) { int t = 0, p = 0;
#pragma unroll
              for (int pt = 0; pt < 16; ++pt) { t += part[pt * 16 + F.tid]; p += part[256 + pt * 16 + F.tid]; }
              tot[F.tid] = t; pre[F.tid] = p; } }
        __syncthreads();
        if (F.tid < 2) { int s = 0; for (int e = 0; e < 8; ++e) { seg[F.tid * 9 + e] = s; s += (tot[F.tid * 8 + e] + 255) & ~255; } seg[F.tid * 9 + 8] = s; }
        __syncthreads();
        if (F.tid < 256) { const int k = F.tid >> 7, t = F.tid & 127; const int e = (le[t] >> (8 * k)) & 0xff; int rank = 0; for (int u = 0; u < t; ++u) rank += (((le[u] >> (8 * k)) & 0xff) == e) ? 1 : 0;
            const int pos = seg[k * 9 + e] + pre[k * 8 + e] + rank; const int tok = wg * 128 + t; ptok[k * MROWS + pos] = tok; pw[k * MROWS + pos] = tokw[2 * tok + k]; ((int*)(F.ws + MOE_PPOS))[k * NLAT + tok] = pos; }
        if (wg < 16) { const int k = wg >> 3, e = wg & 7; const int a = seg[k * 9 + e] + tot[k * 8 + e], b = seg[k * 9 + e + 1]; for (int p = a + F.tid; p < b; p += NTHREADS) { ptok[k * MROWS + p] = -1; pw[k * MROWS + p] = 0.f; } }
        if (wg == 0 && F.tid < 18) meta[F.tid] = seg[F.tid] >> 8;
        __syncthreads();
    }
}
__device__ __forceinline__ void phase_final_a(Frame& F) {
    const int gw = F.bid * NWAVES + F.wave, NGW = F.G * NWAVES; const float* g = F.pa->in[I_GFINAL];
    const bf16_t* xb = (const bf16_t*)((const char*)F.out + XB_OFF); bf16_t* xc = (bf16_t*)(F.ws + WS_XCOPY);
    const int* meta = (const int*)(F.ws + MOE_META) + 9; const int npan = meta[8], gsz = npan - 128;
    const int S = (gsz > 0) ? pg8::split_factor(npan * 4, F.G, DEXP / 64, MAXSLAB_M) : 1;
    const int* ppos = (const int*)(F.ws + MOE_PPOS) + NLAT; const float* pw = (const float*)(F.ws + MOE_PW) + MROWS;
    const float* slab = (const float*)(F.ws + WS_SLABM); const float* gate_lat = (const float*)(F.ws + WS_MODLAT) + (size_t)8 * 6144 + 5120;
    for (int row0 = gw; row0 < NLAT; row0 += 4 * NGW) {
        u32x2 w[4][4]; int rr[4];
#pragma unroll
        for (int u = 0; u < 4; ++u) { const int row = (row0 + u * NGW < NLAT) ? row0 + u * NGW : row0; const u32x2* xr = (const u32x2*)(xb + (size_t)row * D) + F.lane; rr[u] = ppos[row];
#pragma unroll
            for (int j = 0; j < 4; ++j) w[u][j] = xr[64 * j]; }
#pragma unroll
        for (int u = 0; u < 4; ++u) { const int row = row0 + u * NGW; if (row >= NLAT) continue;
            f32x4 v[4];
#pragma unroll
            for (int j = 0; j < 4; ++j) v[j] = (f32x4){bf2f(w[u][j].x & 0xffffu), __uint_as_float(w[u][j].x & 0xffff0000u), bf2f(w[u][j].y & 0xffffu), __uint_as_float(w[u][j].y & 0xffff0000u)};
            if (S >= 2 && rr[u] >= NLAT) { const float wt = pw[rr[u]]; const int pmr = (rr[u] - NLAT) >> 8, r = rr[u] & 255; const f32x4* gt = (const f32x4*)(gate_lat + (size_t)(row / SEQ) * 6144);
#pragma unroll
                for (int j = 0; j < 4; ++j) { f32x4 a = zero4(); const float* sp = slab + (size_t)((pmr + gsz * j) * S) * 65536 + (size_t)r * 256 + 4 * F.lane;
                    { f32x4 t8[8];
#pragma unroll
                      for (int q = 0; q < 8; ++q) t8[q] = *(const f32x4*)(sp + (size_t)(q < S ? q : S - 1) * 65536);
#pragma unroll
                      for (int q = 0; q < 8; ++q) a += t8[q] * (q < S ? 1.0f : 0.0f); }
                    v[j] += (gt[F.lane + 64 * j] * wt) * a; } }
            if (row < NLAT / 2) { float ss = 0.f;
#pragma unroll
                for (int j = 0; j < 4; ++j) ss += (v[j].x * v[j].x + v[j].y * v[j].y) + (v[j].z * v[j].z + v[j].w * v[j].w);
                const float rstd = 1.0f / sqrtf(wave_sum(ss) * (1.0f / D) + EPS); f32x4* o = (f32x4*)(F.out + (size_t)row * D) + F.lane;
#pragma unroll
                for (int j = 0; j < 4; ++j) o[64 * j] = (v[j] * rstd) * ((const f32x4*)g)[F.lane + 64 * j]; }
            else { u32x2* o = (u32x2*)(xc + (size_t)(row - NLAT / 2) * D) + F.lane;
#pragma unroll
                for (int j = 0; j < 4; ++j) o[64 * j] = (u32x2){pk2(v[j].x, v[j].y), pk2(v[j].z, v[j].w)}; } }
    }
}
__device__ __forceinline__ void phase_final_b(Frame& F) {
    const int gw = F.bid * NWAVES + F.wave, NGW = F.G * NWAVES; const float* g = F.pa->in[I_GFINAL]; const bf16_t* xc = (const bf16_t*)(F.ws + WS_XCOPY);
    for (int row0 = NLAT / 2 + gw; row0 < NLAT; row0 += 4 * NGW) {
        u32x2 w[4][4];
#pragma unroll
        for (int u = 0; u < 4; ++u) { const int row = (row0 + u * NGW < NLAT) ? row0 + u * NGW : row0; const u32x2* xr = (const u32x2*)(xc + (size_t)(row - NLAT / 2) * D) + F.lane;
#pragma unroll
            for (int j = 0; j < 4; ++j) w[u][j] = xr[64 * j]; }
#pragma unroll
        for (int u = 0; u < 4; ++u) { const int row = row0 + u * NGW; if (row >= NLAT) continue;
            f32x4 v[4]; float ss = 0.f;
#pragma unroll
            for (int j = 0; j < 4; ++j) { v[j] = (f32x4){bf2f(w[u][j].x & 0xffffu), __uint_as_float(w[u][j].x & 0xffff0000u), bf2f(w[u][j].y & 0xffffu), __uint_as_float(w[u][j].y & 0xffff0000u)};
                ss += (v[j].x * v[j].x + v[j].y * v[j].y) + (v[j].z * v[j].z + v[j].w * v[j].w); }
            const float rstd = 1.0f / sqrtf(wave_sum(ss) * (1.0f / D) + EPS); f32x4* o = (f32x4*)(F.out + (size_t)row * D) + F.lane;
#pragma unroll
            for (int j = 0; j < 4; ++j) o[64 * j] = (v[j] * rstd) * ((const f32x4*)g)[F.lane + 64 * j]; }
    }
}

__device__ __forceinline__ bool fresh(Frame& F) {
    int l_ = (int)__builtin_amdgcn_mbcnt_hi(~0u, __builtin_amdgcn_mbcnt_lo(~0u, 0u)); asm volatile("" : "+v"(l_));
    int w_ = F.wave0; asm volatile("" : "+s"(w_));
    F.lane = l_; F.wave = w_; F.tid = w_ * 64 + l_;
    int b_ = blockIdx.x; asm volatile("" : "+s"(b_)); F.bid = b_;
    GAS unsigned char* w2_ = (GAS unsigned char*)F.ws0; asm volatile("" : "+s"(w2_)); F.ws = (unsigned char*)w2_;
    F.out = F.out0; F.pa = F.pa0;
    return true;
}
struct Item { int b, s, row0, seqbase, t0, seqlen; bool is_ctx; };
__device__ __forceinline__ Item item_info(int item) {
    Item it; it.b = item / SPB; it.s = item % SPB;
    if (it.s < 2) { it.is_ctx = true; it.seqbase = NLAT + it.b * CTXL; it.t0 = it.s * CHK; it.seqlen = CTXL; }
    else { it.is_ctx = false; it.seqbase = it.b * SEQ; it.t0 = (it.s - 2) * CHK; it.seqlen = SEQ; }
    it.row0 = it.seqbase + it.t0; return it;
}
constexpr int UCP = 144;
constexpr int TP = 272;
constexpr int TILEB = 128 * TP;
constexpr int VP = 288;
constexpr int TILEV = 128 * VP;

__device__ __forceinline__ unsigned tr_lane_addr(ldsp_t tile, int lane) { return (unsigned)(__SIZE_TYPE__)tile + (unsigned)((4 * (lane >> 4) + ((lane & 15) >> 2)) * VP + 8 * (lane & 3)); }
__device__ __forceinline__ bf16x8 mk_frag(u32x2 lo, u32x2 hi) { const u32x4 v = {lo.x, lo.y, hi.x, hi.y}; return __builtin_bit_cast(bf16x8, v); }
template <int OFF> __device__ __forceinline__ bf16x8 tr1(unsigned addr) {
    u32x2 a0, a1;
    asm volatile("ds_read_b64_tr_b16 %0, %2 offset:%3\n\tds_read_b64_tr_b16 %1, %2 offset:%4\n\ts_waitcnt lgkmcnt(0)" : "=&v"(a0), "=&v"(a1) : "v"(addr), "i"(OFF), "i"(OFF + 16 * VP) : "memory");
    return mk_frag(a0, a1);
}
template <int OFF> __device__ __forceinline__ void tr4(unsigned addr, bf16x8& f0, bf16x8& f1, bf16x8& f2, bf16x8& f3) {
    u32x2 a0, a1, b0, b1, c0, c1, d0, d1;
    asm volatile("ds_read_b64_tr_b16 %0, %8 offset:%9\n\tds_read_b64_tr_b16 %1, %8 offset:%10\n\tds_read_b64_tr_b16 %2, %8 offset:%11\n\tds_read_b64_tr_b16 %3, %8 offset:%12\n\t"
                 "ds_read_b64_tr_b16 %4, %8 offset:%13\n\tds_read_b64_tr_b16 %5, %8 offset:%14\n\tds_read_b64_tr_b16 %6, %8 offset:%15\n\tds_read_b64_tr_b16 %7, %8 offset:%16\n\ts_waitcnt lgkmcnt(0)"
                 : "=&v"(a0), "=&v"(a1), "=&v"(b0), "=&v"(b1), "=&v"(c0), "=&v"(c1), "=&v"(d0), "=&v"(d1)
                 : "v"(addr), "i"(OFF), "i"(OFF + 16 * VP), "i"(OFF + 32), "i"(OFF + 32 + 16 * VP), "i"(OFF + 64), "i"(OFF + 64 + 16 * VP), "i"(OFF + 96), "i"(OFF + 96 + 16 * VP) : "memory");
    f0 = mk_frag(a0, a1); f1 = mk_frag(b0, b1); f2 = mk_frag(c0, c1); f3 = mk_frag(d0, d1);
}

__device__ __forceinline__ void build_decay(Frame& F, int l) {
    LAS float* dec = (LAS float*)(F.lds + LDS_DEC);
    for (int i = F.tid; i < 2 * 4 * 132; i += NTHREADS) { const int n = i % 132, dh = i / 132; const float x = F.pa->in[I_RETDEC][l * 8 + dh]; const float lg = -log1pf(expf(-x)); dec[i] = expf((float)n * lg); }
}

struct RgStep { bf16x8 bwa[2], bwx[2]; float lam, ba, bx, carry; };
template <bool FINAL>
__device__ __forceinline__ void rg_load_step(RgStep& R, Frame& F, const bf16_t* wgt, int l, int dir, int item, int blk, int n, int lane) {
    const int fr = lane & 15, fq = lane >> 4;
    const bf16_t* wa = wgt + ((size_t)(0 * 8 + blk) * 64 + 16 * n + fr) * 64 + 8 * fq;
    const bf16_t* wx = wgt + ((size_t)(1 * 8 + blk) * 64 + 16 * n + fr) * 64 + 8 * fq;
    R.bwa[0] = *(const bf16x8*)wa; R.bwa[1] = *(const bf16x8*)(wa + 32); R.bwx[0] = *(const bf16x8*)wx; R.bwx[1] = *(const bf16x8*)(wx + 32);
    const int ch = blk * 64 + 16 * n + fr, pi = (l * 2 + dir) * 512 + ch;
    R.lam = F.pa->in[I_RGLAM][pi]; R.ba = F.pa->in[I_RGBA][pi]; R.bx = F.pa->in[I_RGBX][pi];
    R.carry = FINAL ? ((const float*)(F.ws + WS_CARRY))[((size_t)item * 2 + dir) * 512 + ch] : 0.f;
}
template <bool FINAL, int DIR>
__device__ __forceinline__ void rg_dir(ldsp_t ucw, const bf16x8 (&af)[8][2], const RgStep& R, int n, int lane, f32x4 (&hsum)[8], float& Atot, float& Htot) {
    const int fr = lane & 15, fq = lane >> 4;
    constexpr float L2E_ = 1.4426950408889634f;
    const float ba2 = -L2E_ * R.ba, bx2 = -L2E_ * R.bx, cl2 = -8.0f * L2E_ * log1pf(expf(-R.lam)), carry = R.carry;
    const bf16x8 bwa[2] = {R.bwa[0], R.bwa[1]}, bwx[2] = {R.bwx[0], R.bwx[1]};
    f32x4 ar[8], ai[8];
#pragma unroll
    for (int m = 0; m < 8; ++m) { ar[m] = zero4(); ai[m] = zero4(); }
#pragma unroll
    for (int m = 0; m < 8; ++m)
#pragma unroll
        for (int ks = 0; ks < 2; ++ks) { ar[m] = __builtin_amdgcn_mfma_f32_16x16x32_bf16(af[m][ks], bwa[ks], ar[m], 0, 0, 0); ai[m] = __builtin_amdgcn_mfma_f32_16x16x32_bf16(af[m][ks], bwx[ks], ai[m], 0, 0, 0); }
    const unsigned uo = (unsigned)(32 * fq * UCP + (16 * n + fr) * 2);
#pragma unroll
    for (int m = 0; m < 8; ++m)
#pragma unroll
        for (int jj = 0; jj < 4; ++jj) {
            const float r = __builtin_amdgcn_rcpf(1.0f + __builtin_amdgcn_exp2f(__builtin_fmaf(ar[m][jj], -1.4426950408889634f, ba2)));
            const float ig = __builtin_amdgcn_rcpf(1.0f + __builtin_amdgcn_exp2f(__builtin_fmaf(ai[m][jj], -1.4426950408889634f, bx2)));
            const float a = __builtin_amdgcn_exp2f(cl2 * r);
            const float u = bf2f(*(const LAS bf16_t*)(ucw + uo + (4 * m + jj) * UCP));
            ar[m][jj] = a; ai[m][jj] = __builtin_amdgcn_sqrtf(__builtin_fmaf(-a, a, 1.0f)) * ig * u; }
    float gA = 1.f, gH = 0.f;
#pragma unroll
    for (int mm = 0; mm < 8; ++mm) { const int m = DIR ? 7 - mm : mm;
#pragma unroll
        for (int j4 = 0; j4 < 4; ++j4) { const int jj = DIR ? 3 - j4 : j4; gH = __builtin_fmaf(ar[m][jj], gH, ai[m][jj]); gA *= ar[m][jj]; } }
    const float A0 = lane_bcast(gA, fr), H0 = lane_bcast(gH, fr), A1 = lane_bcast(gA, fr + 16), H1 = lane_bcast(gH, fr + 16), A2 = lane_bcast(gA, fr + 32), H2 = lane_bcast(gH, fr + 32), A3 = lane_bcast(gA, fr + 48), H3 = lane_bcast(gH, fr + 48);
    if (FINAL) { float h = carry;
        if (!DIR) { if (fq > 0) h = A0 * h + H0; if (fq > 1) h = A1 * h + H1; if (fq > 2) h = A2 * h + H2; }
        else { if (fq < 3) h = A3 * h + H3; if (fq < 2) h = A2 * h + H2; if (fq < 1) h = A1 * h + H1; }
#pragma unroll
        for (int mm = 0; mm < 8; ++mm) { const int m = DIR ? 7 - mm : mm;
#pragma unroll
            for (int j4 = 0; j4 < 4; ++j4) { const int jj = DIR ? 3 - j4 : j4; h = __builtin_fmaf(ar[m][jj], h, ai[m][jj]); hsum[m][jj] += h; } } }
    if (!DIR) Htot = A3 * (A2 * (A1 * H0 + H1) + H2) + H3; else Htot = A0 * (A1 * (A2 * H3 + H2) + H1) + H0;
    Atot = (A0 * A1) * (A2 * A3);
}
template <bool FINAL, bool SHARED = false>
__device__ __forceinline__ void rg_part(Frame& F, int l, int item, const Item& it, const int blk, const int n0, const int n1) {
    const bf16_t* P = (const bf16_t*)(F.ws + WS_PA);
    int lane = F.lane; const bool act = !SHARED || F.wave < 4;
    ldsp_t ucw = SHARED ? F.lds : F.lds + F.wave * (128 * UCP);
    if (act) { constexpr int NT = SHARED ? 4 : 16;
      const int grp = lane & 7, ch0 = blk * 64 + grp * 8, tok0 = (SHARED ? 32 * F.wave : 0) + (lane >> 3) * NT; float cw[4][8], cb[8];
#pragma unroll
      for (int k = 0; k < 4; ++k)
#pragma unroll
          for (int i = 0; i < 8; ++i) cw[k][i] = F.pa->in[I_CONVW][((size_t)l * 4 + k) * 512 + ch0 + i];
#pragma unroll
      for (int i = 0; i < 8; ++i) cb[i] = F.pa->in[I_CONVB][l * 512 + ch0 + i];
      const bf16_t* Pu = P + (size_t)it.seqbase * INW + ch0;
      u32x4 rv[NT + 3];
#pragma unroll
      for (int r = 0; r < NT + 3; ++r) { const int tt = it.t0 + tok0 + r - 2; const int tc = tt < 0 ? 0 : (tt >= it.seqlen ? it.seqlen - 1 : tt);
          rv[r] = ldg<u32x4>(Pu, (unsigned)tc * (unsigned)(INW * 2)); if (tt != tc) rv[r] = (u32x4){0u, 0u, 0u, 0u}; }
      float win[4][8];
#pragma unroll
      for (int r = 0; r < 3; ++r) { win[r][0] = bf2f(rv[r].x & 0xffffu); win[r][1] = __uint_as_float(rv[r].x & 0xffff0000u); win[r][2] = bf2f(rv[r].y & 0xffffu); win[r][3] = __uint_as_float(rv[r].y & 0xffff0000u);
          win[r][4] = bf2f(rv[r].z & 0xffffu); win[r][5] = __uint_as_float(rv[r].z & 0xffff0000u); win[r][6] = bf2f(rv[r].w & 0xffffu); win[r][7] = __uint_as_float(rv[r].w & 0xffff0000u); }
#pragma unroll
      for (int j = 0; j < NT; ++j) { const int r = j + 3, s3 = (j + 3) & 3;
          win[s3][0] = bf2f(rv[r].x & 0xffffu); win[s3][1] = __uint_as_float(rv[r].x & 0xffff0000u); win[s3][2] = bf2f(rv[r].y & 0xffffu); win[s3][3] = __uint_as_float(rv[r].y & 0xffff0000u);
          win[s3][4] = bf2f(rv[r].z & 0xffffu); win[s3][5] = __uint_as_float(rv[r].z & 0xffff0000u); win[s3][6] = bf2f(rv[r].w & 0xffffu); win[s3][7] = __uint_as_float(rv[r].w & 0xffff0000u);
          float o[8];
#pragma unroll
          for (int i = 0; i < 8; ++i) o[i] = cb[i] + cw[0][i] * win[j & 3][i] + cw[1][i] * win[(j + 1) & 3][i] + cw[2][i] * win[(j + 2) & 3][i] + cw[3][i] * win[s3][i];
          u32x4 w; w.x = pk2(o[0], o[1]); w.y = pk2(o[2], o[3]); w.z = pk2(o[4], o[5]); w.w = pk2(o[6], o[7]);
          *(LAS u32x4*)(ucw + (tok0 + j) * UCP + grp * 16) = w; }
      LDS_WAIT(); asm volatile("" ::: "memory"); }
    if (SHARED) __syncthreads();
    asm volatile("" : "+v"(lane));
    bf16x8 af[8][2];
    if (act) { const int fr = lane & 15, fq = lane >> 4;
#pragma unroll
      for (int m = 0; m < 8; ++m)
#pragma unroll
          for (int ks = 0; ks < 2; ++ks) af[m][ks] = *(const LAS bf16x8*)(ucw + (32 * (fr >> 2) + 4 * m + (fr & 3)) * UCP + (8 * fq + 32 * ks) * 2); }
    if (SHARED) { __syncthreads(); if (!act) return; }
    const bf16_t* wg0 = (const bf16_t*)(F.ws + WS_RGW) + (size_t)(l * 2 + 0) * 2 * 8 * 4096;
    const bf16_t* wg1 = (const bf16_t*)(F.ws + WS_RGW) + (size_t)(l * 2 + 1) * 2 * 8 * 4096;
    float* TOT = (float*)(F.ws + WS_TOT);
    RgStep R0, R1;
    rg_load_step<FINAL>(R0, F, wg0, l, 0, item, blk, n0, lane);
#pragma unroll 1
    for (int n = n0; n < n1; ++n) { asm volatile("" : "+v"(lane));
        const int fr = lane & 15, fq = lane >> 4; const int ch = blk * 64 + 16 * n + fr;
        f32x4 hsum[8];
#pragma unroll
        for (int m = 0; m < 8; ++m) hsum[m] = zero4();
        rg_load_step<FINAL>(R1, F, wg1, l, 1, item, blk, n, lane);
        { float At, Ht;
          rg_dir<FINAL, 0>(ucw, af, R0, n, lane, hsum, At, Ht);
          if (!FINAL && fq == 0) { *(f32x2*)(TOT + (((size_t)item * 2 + 0) * 512 + ch) * 2) = (f32x2){At, Ht}; } }
        __builtin_amdgcn_sched_barrier(0);
        if (n + 1 < n1) rg_load_step<FINAL>(R0, F, wg0, l, 0, item, blk, n + 1, lane);
        { float At, Ht;
          rg_dir<FINAL, 1>(ucw, af, R1, n, lane, hsum, At, Ht);
          if (!FINAL && fq == 0) { *(f32x2*)(TOT + (((size_t)item * 2 + 1) * 512 + ch) * 2) = (f32x2){At, Ht}; } }
        if (FINAL) {
            const unsigned uo = (unsigned)(32 * fq * UCP + (16 * n + fr) * 2);
#pragma unroll
            for (int m = 0; m < 8; ++m)
#pragma unroll
                for (int jj = 0; jj < 4; ++jj) *(LAS bf16_t*)(ucw + uo + (4 * m + jj) * UCP) = (bf16_t)f2bf(hsum[m][jj]); }
    }
    if (FINAL) {
        LDS_WAIT(); asm volatile("" : "+v"(lane) :: "memory");
        const int ng = 2 * (n1 - n0);
        const int grp = 2 * n0 + ((ng == 8) ? (lane & 7) : (lane & 1)); const int tk0 = (ng == 8) ? (lane >> 3) : (lane >> 1), tstep = (ng == 8) ? 8 : 32, nq = (ng == 8) ? 16 : 4;
        const bf16_t* Pg = P + (size_t)it.row0 * INW + 512 + blk * 64 + grp * 8; bf16_t* Yo = (bf16_t*)(F.ws + WS_Y) + (size_t)it.row0 * D + blk * 64 + grp * 8;
#pragma unroll 8
        for (int q = 0; q < nq; ++q) { const int token = tk0 + tstep * q;
            const u32x4 hv = *(const LAS u32x4*)(ucw + token * UCP + grp * 16); const u32x4 gv = ldg<u32x4>(Pg, (unsigned)token * (unsigned)(INW * 2));
            u32x4 w;
            w.x = pk2(gelu_tanh(bf2f(gv.x & 0xffffu)) * bf2f(hv.x & 0xffffu), gelu_tanh(__uint_as_float(gv.x & 0xffff0000u)) * __uint_as_float(hv.x & 0xffff0000u));
            w.y = pk2(gelu_tanh(bf2f(gv.y & 0xffffu)) * bf2f(hv.y & 0xffffu), gelu_tanh(__uint_as_float(gv.y & 0xffff0000u)) * __uint_as_float(hv.y & 0xffff0000u));
            w.z = pk2(gelu_tanh(bf2f(gv.z & 0xffffu)) * bf2f(hv.z & 0xffffu), gelu_tanh(__uint_as_float(gv.z & 0xffff0000u)) * __uint_as_float(hv.z & 0xffff0000u));
            w.w = pk2(gelu_tanh(bf2f(gv.w & 0xffffu)) * bf2f(hv.w & 0xffffu), gelu_tanh(__uint_as_float(gv.w & 0xffff0000u)) * __uint_as_float(hv.w & 0xffff0000u));
            stg<u32x4>(Yo, (unsigned)token * (unsigned)(D * 2), w); }
        LDS_WAIT();
    }
}

struct KvRegs { u32x4 klo[2], khi[2], v[4]; };
__device__ __forceinline__ void kv_issue(Frame& F, KvRegs& R, const Item& it, int h) {
    const bf16_t* P = (const bf16_t*)(F.ws + WS_PA);
    const bf16_t* Pk = P + (size_t)it.row0 * INW + 1536 + h * HD; const bf16_t* Pv = P + (size_t)it.row0 * INW + 2048 + h * HD;
#pragma unroll
    for (int t2 = 0; t2 < 2; ++t2) { const int task = F.tid + t2 * NTHREADS, token = task >> 3, d0 = (task & 7) * 8;
        R.klo[t2] = ldg<u32x4>(Pk, (unsigned)(token * INW + d0) * 2u); R.khi[t2] = ldg<u32x4>(Pk, (unsigned)(token * INW + d0 + 64) * 2u); }
#pragma unroll
    for (int t4 = 0; t4 < 4; ++t4) { const int task = F.tid + t4 * NTHREADS, token = task >> 4, d0 = (task & 15) * 8; R.v[t4] = ldg<u32x4>(Pv, (unsigned)(token * INW + d0) * 2u); }
}
template <int KS> __device__ __forceinline__ void kv_step(unsigned aK, unsigned aVf, unsigned aVb, f32x4 (&accf)[8], f32x4 (&accb)[8]) {
    const bf16x8 af = tr1<KS * 32 * VP>(aVf), ab = tr1<KS * 32 * VP>(aVb);
    bf16x8 b[8];
    tr4<KS * 32 * VP>(aK, b[0], b[1], b[2], b[3]); tr4<KS * 32 * VP + 128>(aK, b[4], b[5], b[6], b[7]);
#pragma unroll
    for (int n = 0; n < 8; ++n) { accf[n] = __builtin_amdgcn_mfma_f32_16x16x32_bf16(af, b[n], accf[n], 0, 0, 0); accb[n] = __builtin_amdgcn_mfma_f32_16x16x32_bf16(ab, b[n], accb[n], 0, 0, 0); }
}
__device__ __forceinline__ void stage_state_t(Frame& F, ldsp_t dst, const bf16_t* St) {
#pragma unroll
    for (int t4 = 0; t4 < 4; ++t4) { const int task = F.tid + t4 * NTHREADS, e = task >> 4, c8 = task & 15;
        *(LAS u32x4*)(dst + e * TP + c8 * 16) = ldg<u32x4>(St, (unsigned)(e * 128 + c8 * 8) * 2u); }
}
__device__ __forceinline__ void mm16x128(ldsp_t At, int ra0, ldsp_t Bt, int lane, f32x4 (&acc)[8]) {
    const int fr = lane & 15, fq = lane >> 4;
#pragma unroll
    for (int ks = 0; ks < 4; ++ks) { const bf16x8 a = *(const LAS bf16x8*)(At + (ra0 + fr) * TP + (32 * ks + 8 * fq) * 2);
#pragma unroll
        for (int n = 0; n < 8; ++n) { const bf16x8 b = *(const LAS bf16x8*)(Bt + (16 * n + fr) * TP + (32 * ks + 8 * fq) * 2); acc[n] = __builtin_amdgcn_mfma_f32_16x16x32_bf16(a, b, acc[n], 0, 0, 0); } }
}

__device__ __forceinline__ void kv_head(Frame& F, KvRegs& R, KvRegs& Rn, bool pre, int item, const Item& it, int h) {
    bf16_t* KV = (bf16_t*)(F.ws + WS_KV);
    const LAS float* dec = (const LAS float*)(F.lds + LDS_DEC);
    ldsp_t tK = F.lds, tVf = F.lds + TILEV, tVb = F.lds + 2 * TILEV;
#pragma unroll
    for (int t2 = 0; t2 < 2; ++t2) { const int task = F.tid + t2 * NTHREADS, token = task >> 3, d0 = (task & 7) * 8;
        *(LAS u32x4*)(tK + token * VP + d0 * 2) = R.klo[t2]; *(LAS u32x4*)(tK + token * VP + (d0 + 64) * 2) = R.khi[t2]; }
#pragma unroll
    for (int t4 = 0; t4 < 4; ++t4) { const int task = F.tid + t4 * NTHREADS, token = task >> 4, d0 = (task & 15) * 8; const u32x4 v = R.v[t4];
        const float df = dec[(0 * 4 + h) * 132 + 127 - token], db = dec[(1 * 4 + h) * 132 + token];
        const float x[8] = {bf2f(v.x & 0xffffu), __uint_as_float(v.x & 0xffff0000u), bf2f(v.y & 0xffffu), __uint_as_float(v.y & 0xffff0000u), bf2f(v.z & 0xffffu), __uint_as_float(v.z & 0xffff0000u), bf2f(v.w & 0xffffu), __uint_as_float(v.w & 0xffff0000u)};
        u32x4 wf, wb; wf.x = pk2(x[0] * df, x[1] * df); wf.y = pk2(x[2] * df, x[3] * df); wf.z = pk2(x[4] * df, x[5] * df); wf.w = pk2(x[6] * df, x[7] * df);
        wb.x = pk2(x[0] * db, x[1] * db); wb.y = pk2(x[2] * db, x[3] * db); wb.z = pk2(x[4] * db, x[5] * db); wb.w = pk2(x[6] * db, x[7] * db);
        *(LAS u32x4*)(tVf + token * VP + d0 * 2) = wf; *(LAS u32x4*)(tVb + token * VP + d0 * 2) = wb; }
    WG_BAR_LDS();
    if (pre) kv_issue(F, Rn, it, h + 1);
    f32x4 af[8], ab[8];
#pragma unroll
    for (int n = 0; n < 8; ++n) { af[n] = zero4(); ab[n] = zero4(); }
    { const unsigned aK = tr_lane_addr(tK, F.lane), aVf = tr_lane_addr(tVf, F.lane) + 32u * (unsigned)F.wave, aVb = tr_lane_addr(tVb, F.lane) + 32u * (unsigned)F.wave;
      kv_step<0>(aK, aVf, aVb, af, ab); kv_step<1>(aK, aVf, aVb, af, ab); kv_step<2>(aK, aVf, aVb, af, ab); kv_step<3>(aK, aVf, aVb, af, ab); }
    const int fr = F.lane & 15, fq = F.lane >> 4;
    bf16_t* of = KV + (((size_t)item * 4 + h) * 2 + 0) * 16384 + (size_t)(16 * F.wave) * 128;
    unsigned so = (unsigned)((4 * fq) * 128 + fr) * 2u; asm volatile("" : "+v"(so));
#pragma unroll
    for (int n = 0; n < 8; ++n)
#pragma unroll
        for (int jj = 0; jj < 4; ++jj) { stg<bf16_t>(of, so + (unsigned)((jj * 128 + 16 * n) * 2), (bf16_t)f2bf(af[n][jj])); stg<bf16_t>(of, so + (unsigned)((16384 + jj * 128 + 16 * n) * 2), (bf16_t)f2bf(ab[n][jj])); }
    WG_BAR_LDS();
}
__device__ __forceinline__ int latent_item(int c) { return (c >> 5) * SPB + 2 + (c & 31); }
__device__ __forceinline__ int ctx_item(int ci) { return (ci >> 1) * SPB + (ci & 1); }
__device__ __forceinline__ void phase_m1(Frame& F, int l) {
    build_decay(F, l); __syncthreads();
    for (int c = F.bid; c < 256; c += F.G) {
        fresh(F);
        { const int item = latent_item(c); const Item it = item_info(item);
          rg_part<false>(F, l, item, it, F.wave, 0, 4);
          __syncthreads();
          KvRegs A, B;
          fresh(F); kv_issue(F, A, it, 0);
          kv_head(F, A, B, true, item, it, 0);
          fresh(F); kv_head(F, B, A, true, item, it, 1);
          fresh(F); kv_head(F, A, B, true, item, it, 2);
          fresh(F); kv_head(F, B, A, false, item, it, 3); }
        fresh(F);
        if (c >= 64 && c < 192) { const int cu = c - 64; const int item = ctx_item(cu >> 3); const Item it = item_info(item);
            const int w4 = F.wave & 3; rg_part<false, true>(F, l, item, it, cu & 7, w4, w4 + 1); }
        __syncthreads();
        if (c < 64) { const int item = ctx_item(c >> 2); const Item it = item_info(item); KvRegs A, B; fresh(F); kv_issue(F, A, it, c & 3); kv_head(F, A, B, false, item, it, c & 3); }
    }
}
__device__ __forceinline__ int seq_order(int dir, int step) { return dir ? (step == 0 ? 1 : (step == 1 ? 0 : 35 - step)) : step; }
__device__ __forceinline__ void phase_m2(Frame& F, int l) {
    bf16_t* KV = (bf16_t*)(F.ws + WS_KV);
    const int gt = F.bid * NTHREADS + F.tid, NGT = F.G * NTHREADS;
    for (int c = gt; c < NB * NH * 2 * 128 * 16; c += NGT) {
        const int dc = c & 15, e = (c >> 4) & 127, dir = (c >> 11) & 1, h = (c >> 12) & 3, b = c >> 14;
        const float x = F.pa->in[I_RETDEC][l * 8 + dir * 4 + h]; const float decay = expf(128.0f * (-log1pf(expf(-x))));
        float S[8];
#pragma unroll
        for (int i = 0; i < 8; ++i) S[i] = 0.f;
        const unsigned lo = (unsigned)((((h * 2 + dir) * 128 + e) * 128 + dc * 8) * 2);
        for (int g0 = 0; g0 < SPB; g0 += 17) {
            u32x4 v[17];
#pragma unroll
            for (int i = 0; i < 17; ++i) { const int item = b * SPB + seq_order(dir, g0 + i); v[i] = ldg<u32x4>(KV + (size_t)item * 4 * 2 * 16384, lo); }
#pragma unroll
            for (int i = 0; i < 17; ++i) { const int item = b * SPB + seq_order(dir, g0 + i);
                u32x4 w; w.x = pk2(S[0], S[1]); w.y = pk2(S[2], S[3]); w.z = pk2(S[4], S[5]); w.w = pk2(S[6], S[7]);
                stg<u32x4>(KV + (size_t)item * 4 * 2 * 16384, lo, w);
                S[0] = S[0] * decay + bf2f(v[i].x & 0xffffu); S[1] = S[1] * decay + __uint_as_float(v[i].x & 0xffff0000u); S[2] = S[2] * decay + bf2f(v[i].y & 0xffffu); S[3] = S[3] * decay + __uint_as_float(v[i].y & 0xffff0000u);
                S[4] = S[4] * decay + bf2f(v[i].z & 0xffffu); S[5] = S[5] * decay + __uint_as_float(v[i].z & 0xffff0000u); S[6] = S[6] * decay + bf2f(v[i].w & 0xffffu); S[7] = S[7] * decay + __uint_as_float(v[i].w & 0xffff0000u); }
        }
    }
    const float* TOT = (const float*)(F.ws + WS_TOT); float* CARRY = (float*)(F.ws + WS_CARRY);
    if (F.tid < 32) for (int cidx = F.bid * 32 + F.tid; cidx < NB * 2 * 512; cidx += F.G * 32) {
      { const int ch = cidx & 511, dir = (cidx >> 9) & 1, b = cidx >> 10; float cr = 0.f;
          for (int g0 = 0; g0 < SPB; g0 += 17) { f32x2 ah[17];
#pragma unroll
              for (int i = 0; i < 17; ++i) { const int item = b * SPB + seq_order(dir, g0 + i); ah[i] = *(const f32x2*)(TOT + (((size_t)item * 2 + dir) * 512 + ch) * 2); }
#pragma unroll
              for (int i = 0; i < 17; ++i) { const int item = b * SPB + seq_order(dir, g0 + i); CARRY[((size_t)item * 2 + dir) * 512 + ch] = cr; cr = ah[i].x * cr + ah[i].y; } } } }
}
struct RetRegs { u32x4 v[4], sf[4], sb[4], klo[2], khi[2], g[4], q[4]; };
__device__ __forceinline__ void ret_issue(Frame& F, RetRegs& R, int item, const Item& it, int h) {
    const bf16_t* KV = (const bf16_t*)(F.ws + WS_KV); const bf16_t* P = (const bf16_t*)(F.ws + WS_PA);
    const bf16_t* Pk = P + (size_t)it.row0 * INW + 1536 + h * HD; const bf16_t* Pv = P + (size_t)it.row0 * INW + 2048 + h * HD;
    const bf16_t* Sf = KV + (((size_t)item * 4 + h) * 2 + 0) * 16384; const bf16_t* Sb = Sf + 16384;
    const int lane = F.lane, i0 = 16 * F.wave;
#pragma unroll
    for (int t2 = 0; t2 < 2; ++t2) { const int task = F.tid + t2 * NTHREADS, token = task >> 3, d0 = (task & 7) * 8;
        R.klo[t2] = ldg<u32x4>(Pk, (unsigned)(token * INW + d0) * 2u); R.khi[t2] = ldg<u32x4>(Pk, (unsigned)(token * INW + d0 + 64) * 2u); }
#pragma unroll
    for (int t4 = 0; t4 < 4; ++t4) { const int task = F.tid + t4 * NTHREADS, r = task >> 4, c8 = task & 15;
        R.v[t4] = ldg<u32x4>(Pv, (unsigned)(r * INW + c8 * 8) * 2u); R.sf[t4] = ldg<u32x4>(Sf, (unsigned)(r * 128 + c8 * 8) * 2u); R.sb[t4] = ldg<u32x4>(Sb, (unsigned)(r * 128 + c8 * 8) * 2u); }
    { const bf16_t* Pg = P + (size_t)(it.row0 + i0) * INW + 2560 + h * HD;
#pragma unroll
      for (int k = 0; k < 4; ++k) R.g[k] = ldg<u32x4>(Pg, (unsigned)((lane >> 2) * INW + 32 * (lane & 3) + 8 * k) * 2u); }
    { const bf16_t* Pq = P + (size_t)(it.row0 + i0) * INW + 1024 + h * HD;
#pragma unroll
      for (int ks = 0; ks < 4; ++ks) R.q[ks] = ldg<u32x4>(Pq, (unsigned)((lane & 15) * INW + 32 * ks + 8 * (lane >> 4)) * 2u); }
}
__device__ __forceinline__ void ret_head(Frame& F, RetRegs& R, RetRegs& Rn, bool pre, int item, const Item& it, int h) {
    bf16_t* Y = (bf16_t*)(F.ws + WS_Y);
    const LAS float* dec = (const LAS float*)(F.lds + LDS_DEC);
    ldsp_t tK = F.lds, tV = F.lds + TILEB, tSf = tV + TILEV, tSb = tSf + TILEB;
    const int lane = F.lane, fr = lane & 15, fq = lane >> 4, i0 = 16 * F.wave;
#pragma unroll
    for (int t2 = 0; t2 < 2; ++t2) { const int task = F.tid + t2 * NTHREADS, token = task >> 3, d0 = (task & 7) * 8;
        *(LAS u32x4*)(tK + token * TP + d0 * 2) = R.klo[t2]; *(LAS u32x4*)(tK + token * TP + (d0 + 64) * 2) = R.khi[t2]; }
#pragma unroll
    for (int t4 = 0; t4 < 4; ++t4) { const int task = F.tid + t4 * NTHREADS, r = task >> 4, c8 = task & 15;
        *(LAS u32x4*)(tV + r * VP + c8 * 16) = R.v[t4]; *(LAS u32x4*)(tSf + r * TP + c8 * 16) = R.sf[t4]; *(LAS u32x4*)(tSb + r * TP + c8 * 16) = R.sb[t4]; }
    bf16x8 qf[4];
#pragma unroll
    for (int ks = 0; ks < 4; ++ks) qf[ks] = __builtin_bit_cast(bf16x8, R.q[ks]);
    u32x4 gk[4];
#pragma unroll
    for (int k = 0; k < 4; ++k) gk[k] = R.g[k];
    WG_BAR_LDS();
    if (pre) ret_issue(F, Rn, item, it, h + 1);
    bf16x8 pa[4];
    { f32x4 C[8];
#pragma unroll
      for (int jt = 0; jt < 8; ++jt) { C[jt] = zero4();
#pragma unroll
          for (int ks = 0; ks < 4; ++ks) { const bf16x8 a = *(const LAS bf16x8*)(tK + (16 * jt + fr) * TP + (32 * ks + 8 * fq) * 2); C[jt] = __builtin_amdgcn_mfma_f32_16x16x32_bf16(a, qf[ks], C[jt], 0, 0, 0); } }
      const int i = i0 + fr;
#pragma unroll
      for (int jt = 0; jt < 8; ++jt)
#pragma unroll
          for (int jj = 0; jj < 4; ++jj) { const int j = 16 * jt + 4 * fq + jj; const float dcy = (i >= j) ? dec[(0 * 4 + h) * 132 + (i - j)] : dec[(1 * 4 + h) * 132 + (j - i)]; C[jt][jj] *= dcy; }
#pragma unroll
      for (int u = 0; u < 4; ++u) { const u32x4 w = {pg8::cvt_pk_bf16(C[2 * u][0], C[2 * u][1]), pg8::cvt_pk_bf16(C[2 * u][2], C[2 * u][3]), pg8::cvt_pk_bf16(C[2 * u + 1][0], C[2 * u + 1][1]), pg8::cvt_pk_bf16(C[2 * u + 1][2], C[2 * u + 1][3])};
          pa[u] = __builtin_bit_cast(bf16x8, w); } }
    WG_BAR_LDS();
    { ldsp_t gt = tK + (i0 + (lane >> 2)) * TP + (lane & 3) * 64;
#pragma unroll
      for (int k = 0; k < 4; ++k) *(LAS u32x4*)(gt + 16 * k) = gk[k]; }
    f32x4 o[8];
#pragma unroll
    for (int n = 0; n < 8; ++n) o[n] = zero4();
    { const unsigned aV = tr_lane_addr(tV, lane); bf16x8 b[8];
#define RET_PV(U) do { tr4<(U) * 32 * VP>(aV, b[0], b[1], b[2], b[3]); tr4<(U) * 32 * VP + 128>(aV, b[4], b[5], b[6], b[7]); \
        _Pragma("unroll") for (int n = 0; n < 8; ++n) o[n] = __builtin_amdgcn_mfma_f32_16x16x32_bf16(pa[U], b[n], o[n], 0, 0, 0); } while (0)
      RET_PV(0); RET_PV(1); RET_PV(2); RET_PV(3);
#undef RET_PV
    }
    { f32x4 cf[8];
#pragma unroll
      for (int n = 0; n < 8; ++n) { cf[n] = zero4();
#pragma unroll
          for (int ks = 0; ks < 4; ++ks) { const bf16x8 b = *(const LAS bf16x8*)(tSf + (16 * n + fr) * TP + (32 * ks + 8 * fq) * 2); cf[n] = __builtin_amdgcn_mfma_f32_16x16x32_bf16(qf[ks], b, cf[n], 0, 0, 0); } }
#pragma unroll
      for (int jj = 0; jj < 4; ++jj) { const float sf = dec[(0 * 4 + h) * 132 + (i0 + 4 * fq + jj + 1)];
#pragma unroll
          for (int n = 0; n < 8; ++n) o[n][jj] += sf * cf[n][jj]; } }
    { f32x4 cb[8];
#pragma unroll
      for (int n = 0; n < 8; ++n) { cb[n] = zero4();
#pragma unroll
          for (int ks = 0; ks < 4; ++ks) { const bf16x8 b = *(const LAS bf16x8*)(tSb + (16 * n + fr) * TP + (32 * ks + 8 * fq) * 2); cb[n] = __builtin_amdgcn_mfma_f32_16x16x32_bf16(qf[ks], b, cb[n], 0, 0, 0); } }
#pragma unroll
      for (int jj = 0; jj < 4; ++jj) { const float sb = dec[(1 * 4 + h) * 132 + (128 - (i0 + 4 * fq + jj))];
#pragma unroll
          for (int n = 0; n < 8; ++n) o[n][jj] += sb * cb[n][jj]; } }
    { ldsp_t gc = tK + (i0 + 4 * fq) * TP + fr * 2;
#pragma unroll
      for (int jj = 0; jj < 4; ++jj) { float s1 = 0.f;
#pragma unroll
          for (int n = 0; n < 8; ++n) s1 += o[n][jj];
          s1 += swz_xor<1>(s1); s1 += swz_xor<2>(s1); s1 += swz_xor<4>(s1); s1 += swz_xor<8>(s1);
          const float mu = s1 * (1.0f / 128.0f); float q = 0.f;
#pragma unroll
          for (int n = 0; n < 8; ++n) { const float dd = o[n][jj] - mu; q += dd * dd; }
          q += swz_xor<1>(q); q += swz_xor<2>(q); q += swz_xor<4>(q); q += swz_xor<8>(q);
          const float rstd = 1.0f / sqrtf(q * (1.0f / 128.0f) + EPS);
#pragma unroll
          for (int n = 0; n < 8; ++n) { LAS bf16_t* p = (LAS bf16_t*)(gc + jj * TP + 32 * n); const float gv = bf2f(*p); *p = (bf16_t)f2bf(siluf_(gv) * (o[n][jj] - mu) * rstd); } } }
    LDS_WAIT(); asm volatile("" ::: "memory");
    { ldsp_t gt = tK + (i0 + (lane >> 2)) * TP + (lane & 3) * 64; bf16_t* Yo = Y + (size_t)(it.row0 + i0) * D + 512 + h * HD;
#pragma unroll
      for (int k = 0; k < 4; ++k) stg<u32x4>(Yo, (unsigned)((lane >> 2) * D + 32 * (lane & 3) + 8 * k) * 2u, *(const LAS u32x4*)(gt + 16 * k)); }
    WG_BAR_LDS();
}
__device__ __forceinline__ void phase_m3(Frame& F, int l) {
    build_decay(F, l); __syncthreads();
    for (int c = F.bid; c < 256; c += F.G) {
        fresh(F);
        { const int item = latent_item(c); const Item it = item_info(item);
#ifndef PROBE_M3
#define PROBE_M3 0
#endif
          for (int r_ = 0; r_ < ((PROBE_M3 & 1) ? 2 : 1); ++r_) { fresh(F); rg_part<true>(F, l, item, it, F.wave, 0, 4); }
          __syncthreads();
          for (int r_ = 0; r_ < ((PROBE_M3 & 2) ? 2 : 1); ++r_) {
          RetRegs R, Rn;
          fresh(F); ret_issue(F, R, item, it, 0);
          ret_head(F, R, Rn, true, item, it, 0);
          fresh(F); ret_head(F, Rn, R, true, item, it, 1);
          fresh(F); ret_head(F, R, Rn, true, item, it, 2);
          fresh(F); ret_head(F, Rn, R, false, item, it, 3); } }
        if (l == 0) {
            fresh(F);
            if (c >= 64 && c < 192) { const int cu = c - 64; const int item = ctx_item(cu >> 3); const Item it = item_info(item);
                const int w4 = F.wave & 3; rg_part<true, true>(F, l, item, it, cu & 7, w4, w4 + 1); }
            __syncthreads();
            if (c < 64) { const int item = ctx_item(c >> 2); const Item it = item_info(item); RetRegs R, Rn; fresh(F); ret_issue(F, R, item, it, c & 3); ret_head(F, R, Rn, false, item, it, c & 3); }
        }
    }
}

constexpr int N_PHASES = 24;
__global__ void __launch_bounds__(NTHREADS, 2) fwd_kernel(Args args) {
    extern __shared__ __attribute__((aligned(16))) unsigned char lds_raw[];
    Frame F; F.lds = (ldsp_t)lds_raw; F.wave0 = __builtin_amdgcn_readfirstlane((int)threadIdx.x >> 6); F.G = gridDim.x; F.pa0 = &args; F.out0 = args.out; F.ws0 = args.ws; fresh(F);
    volatile LAS unsigned* MISC = (volatile LAS unsigned*)(F.lds + LDS_MISC);
    if (F.tid < 64) MISC[F.tid] = 0u;
    __syncthreads();
    const int lo = args.ph_lo, hi = args.ph_hi;
    XcdBarrier bar; bar.bar = (unsigned*)(F.ws + WS_CTL); bar.x = 0; bar.st = nullptr;
    if (hi - lo > 1) bar = xcd_barrier_post((unsigned*)(F.ws + WS_CTL), MISC);
#ifndef DIAG_MASK
#define DIAG_MASK 0xffffffffu
#endif
#ifndef REPEAT_MASK
#define REPEAT_MASK 0u
#endif
#define REPS(kind) ((((REPEAT_MASK) >> (kind)) & 1u) ? 2 : 1)
#define INK(k, kind) (((DIAG_MASK >> (kind)) & 1u) && lo <= (k) && (k) < hi && fresh(F))
#define IN(k) (lo <= (k) && (k) < hi)
#define SEAM(k) do { if (IN(k) && IN((k) + 1)) xcd_barrier(bar); } while (0)
    float* ctxx = (float*)(F.ws + WS_CTXX); bf16_t* xb = (bf16_t*)((char*)F.out + XB_OFF);
    const float* modlat = (const float*)(F.ws + WS_MODLAT); const float* modctx = (const float*)(F.ws + WS_MODCTX);

    if (INK(0, 0)) { for (int r_ = 0; r_ < REPS(0); ++r_) { phase_convert_small(F); __syncthreads(); phase_mod(F); __syncthreads(); } } SEAM(0);
    if (INK(1, 1)) { for (int r_ = 0; r_ < REPS(1); ++r_) phase_norm(F, 0, 0, F.pa->in[I_X], nullptr, F.pa->in[I_CTX], MROWS, SlabRed{nullptr, 0, nullptr, nullptr, nullptr}); } SEAM(1);
#pragma unroll 1
    for (int l = 0; l < 2; ++l) {
        const int pb = (l == 0) ? 2 : 11;
        if (INK(pb + 0, 2)) { pg8::Gemm g{(const bf16_t*)(F.ws + WS_HX), (const bf16_t*)(F.ws + WS_WIN) + (size_t)l * INW * D, INW, D, 0, nullptr}; pg8::Order S; S.init(MROWS / 256, INW / 256, F.G, F.bid, nullptr, nullptr, D / 64, false, 0);
            pg8::EpiInProj E{(bf16_t*)(F.ws + WS_PA), INW, (const float*)(F.ws + WS_ROPE), (const float*)(F.ws + WS_ROPE) + 4096 * 64}; for (int r_ = 0; r_ < REPS(2); ++r_) pg8::gemm_phase<pg8::EpiInProj>(F.lds, g, S, E, F.tid); }
        SEAM(pb + 0);
        if (INK(pb + 1, 3)) { for (int r_ = 0; r_ < REPS(3); ++r_) phase_m1(F, l); }
        SEAM(pb + 1);
        if (INK(pb + 2, 4)) { for (int r_ = 0; r_ < REPS(4); ++r_) { if (r_) phase_m1(F, l); phase_m2(F, l); } }
        SEAM(pb + 2);
        if (INK(pb + 3, 5)) { for (int r_ = 0; r_ < REPS(5); ++r_) phase_m3(F, l); }
        SEAM(pb + 3);
        if (INK(pb + 4, 6)) { pg8::Gemm g{(const bf16_t*)(F.ws + WS_Y), (const bf16_t*)(F.ws + WS_WOUT) + (size_t)l * D * D, D, D, 0, (float*)(F.ws + WS_SLABA)}; pg8::Order S; S.init((l == 0 ? MROWS : NLAT) / 256, D / 256, F.G, F.bid, nullptr, nullptr, D / 64, true, MAXSLAB_A);
            pg8::EpiResid E{l == 0 ? F.pa->in[I_X] : nullptr, xb, F.pa->in[I_CTX], ctxx, modlat + (size_t)l * 8 * 6144 + 2048, modctx + (size_t)l * 6144 + 2048};
            pg8::gemm_phase<pg8::EpiResid>(F.lds, g, S, E, F.tid); }
        SEAM(pb + 4);
        if (l == 0) {
            if (INK(7, 1)) { for (int r_ = 0; r_ < REPS(1); ++r_) phase_norm(F, 0, 1, nullptr, xb, ctxx, MROWS, SlabRed{(const float*)(F.ws + WS_SLABA), pg8::split_factor((MROWS / 256) * 4, F.G, D / 64, MAXSLAB_A), modctx + 2048, F.pa->in[I_CTX], ctxx}); } SEAM(7);
            if (INK(8, 7)) { pg8::Gemm g{(const bf16_t*)(F.ws + WS_HX), (const bf16_t*)(F.ws + WS_WUP), 2 * DFF, D, 0, nullptr}; pg8::Order S; S.init(MROWS / 256, 2 * DFF / 256, F.G, F.bid, nullptr, nullptr, D / 64, false, 0);
                pg8::EpiSwiGLU E{(bf16_t*)(F.ws + WS_PA), DFF}; for (int r_ = 0; r_ < REPS(7); ++r_) pg8::gemm_phase<pg8::EpiSwiGLU>(F.lds, g, S, E, F.tid); }
            SEAM(8);
            if (INK(9, 8)) { pg8::Gemm g{(const bf16_t*)(F.ws + WS_PA), (const bf16_t*)(F.ws + WS_WDN), D, DFF, 0, (float*)(F.ws + WS_SLABA)}; pg8::Order S; S.init(MROWS / 256, D / 256, F.G, F.bid, nullptr, nullptr, DFF / 64, true, MAXSLAB_A);
                pg8::EpiResid E{nullptr, xb, (const float*)ctxx, ctxx, modlat + 5120, modctx + 5120}; pg8::gemm_phase<pg8::EpiResid>(F.lds, g, S, E, F.tid); }
            SEAM(9);
            if (INK(10, 1)) { for (int r_ = 0; r_ < REPS(1); ++r_) phase_norm(F, 1, 0, nullptr, xb, ctxx, MROWS, SlabRed{(const float*)(F.ws + WS_SLABA), pg8::split_factor((MROWS / 256) * 4, F.G, DFF / 64, MAXSLAB_A), modctx + 5120, ctxx, ctxx}); } SEAM(10);
        }
    }
    if (INK(16, 9)) { for (int r_ = 0; r_ < REPS(9); ++r_) { phase_norm_router(F, xb); __syncthreads(); phase_convert_moe(F); __syncthreads(); } } SEAM(16);
    if (INK(17, 10)) { phase_moe_sort(F); } SEAM(17);
#pragma unroll 1
    for (int k = 0; k < 2; ++k) {
        const int* meta = (const int*)(F.ws + MOE_META) + 9 * k;
        if (INK(18 + 2 * k, 11)) { if (k == 1) { moe_reduce(F, 0); __syncthreads(); } pg8::Gemm g{(const bf16_t*)(F.ws + WS_HX), (const bf16_t*)(F.ws + WS_MOEUP), 2 * DEXP, D, (size_t)2 * DEXP * D * 2, nullptr}; pg8::Order S; S.init(meta[8], 2 * DEXP / 256, F.G, F.bid, meta, (const int*)(F.ws + MOE_PTOK) + k * MROWS, D / 64, false, 0);
            pg8::EpiSwiGLU E{(bf16_t*)(F.ws + WS_PA), DEXP}; for (int r_ = 0; r_ < REPS(11); ++r_) pg8::gemm_phase<pg8::EpiSwiGLU>(F.lds, g, S, E, F.tid); }
        SEAM(18 + 2 * k);
        if (INK(19 + 2 * k, 12)) { pg8::Gemm g{(const bf16_t*)(F.ws + WS_PA), (const bf16_t*)(F.ws + WS_MOEDN), D, DEXP, (size_t)D * DEXP * 2, (float*)(F.ws + WS_SLABM)}; pg8::Order S; S.init(meta[8], D / 256, F.G, F.bid, meta, nullptr, DEXP / 64, true, MAXSLAB_M);
            pg8::EpiMoeDown E{xb, (const int*)(F.ws + MOE_PTOK) + k * MROWS, (const float*)(F.ws + MOE_PW) + k * MROWS, modlat + (size_t)8 * 6144 + 5120}; pg8::gemm_phase<pg8::EpiMoeDown>(F.lds, g, S, E, F.tid); }
        SEAM(19 + 2 * k);
    }
    if (INK(22, 13)) phase_final_a(F);
    SEAM(22);
    if (INK(23, 13)) phase_final_b(F);
#undef IN
#undef INK
#undef SEAM
}

extern "C" void kernel_launch(void* const* d_in, const int* in_sizes, int n_in, void* d_out, int out_size, void* d_ws, size_t ws_size, hipStream_t stream) {
    static int grid = 0;
    if (grid == 0) {
        if (n_in != 27 || in_sizes[0] != NLAT * D || out_size != NLAT * D || ws_size < WS_END) { fprintf(stderr, "kernel_launch: unexpected problem (n_in %d, in0 %d, out %d, ws %zu, need %zu); nothing launched\n", n_in, n_in > 0 ? in_sizes[0] : -1, out_size, ws_size, (size_t)WS_END); grid = -1; return; }
        int dev = 0, cus = 0, per_cu = 0;
        if (hipGetDevice(&dev) != hipSuccess || hipDeviceGetAttribute(&cus, hipDeviceAttributeMultiprocessorCount, dev) != hipSuccess) { grid = -1; return; }
        if (hipFuncSetAttribute((const void*)fwd_kernel, hipFuncAttributeMaxDynamicSharedMemorySize, LDS_BYTES) != hipSuccess) { fprintf(stderr, "kernel_launch: hipFuncSetAttribute failed\n"); grid = -1; return; }
        if (hipOccupancyMaxActiveBlocksPerMultiprocessor(&per_cu, (const void*)fwd_kernel, NTHREADS, LDS_BYTES) != hipSuccess || per_cu < 1) { fprintf(stderr, "kernel_launch: occupancy query says %d\n", per_cu); }
        (void)hipGetLastError();
        grid = cus;
    }
    if (grid < 0) return;
    (void)hipMemsetAsync((char*)d_ws + WS_CTL, 0, CTL_ZERO_BYTES, stream);
    Args a; memset(&a, 0, sizeof(a));
    for (int i = 0; i < 27; ++i) a.in[i] = (const float*)d_in[i];
    a.out = (float*)d_out; a.ws = (unsigned char*)d_ws;
#if MK_ONE_LAUNCH
    a.ph_lo = 0; a.ph_hi = N_PHASES;
    hipLaunchKernelGGL(fwd_kernel, dim3(grid), dim3(NTHREADS), LDS_BYTES, stream, a);
#else
    for (int p = 0; p < N_PHASES; ++p) { a.ph_lo = p; a.ph_hi = p + 1; hipLaunchKernelGGL(fwd_kernel, dim3(grid), dim3(NTHREADS), LDS_BYTES, stream, a); }
#endif
}
```

```cpp
#include <hip/hip_runtime.h>
#include <cstdio>
#include <cstdint>
#include <cstring>

#ifndef MK_ONE_LAUNCH
#define MK_ONE_LAUNCH 1
#endif

#define GAS __attribute__((address_space(1)))
#define LAS __attribute__((address_space(3)))
typedef unsigned short bf16_t;
typedef short bf16x8 __attribute__((ext_vector_type(8)));
typedef float f32x4 __attribute__((ext_vector_type(4)));
typedef float f32x2 __attribute__((ext_vector_type(2)));
typedef unsigned u32x4 __attribute__((ext_vector_type(4)));
typedef unsigned u32x2 __attribute__((ext_vector_type(2)));
typedef LAS unsigned char* ldsp_t;

constexpr int D = 1024, NB = 8, SEQ = 4096, NLAT = NB * SEQ, CTXL = 256, NCTX = NB * CTXL, MROWS = NLAT + NCTX;
constexpr int INW = 3072, NH = 4, HD = 128, CHK = 128;
constexpr int DFF = 2816, NE = 8, DEXP = 3584;
constexpr int SPB = 34;
constexpr int NITEM = NB * SPB;
constexpr float EPS = 1e-6f;
constexpr int NWAVES = 8, NTHREADS = 512;

constexpr size_t MiB = 1u << 20;
constexpr size_t WS_CTL = 0, CTL_ZERO_BYTES = 64 * 1024;
constexpr size_t WS_MODLAT = 1 * MiB;
constexpr size_t WS_MODCTX = 1 * MiB + 2 * 8 * 6144 * 4;
constexpr size_t WS_ROPE = 2 * MiB;
constexpr size_t WS_RGW = 4 * MiB;
constexpr size_t WS_TOT = 5 * MiB;
constexpr size_t WS_CARRY = 8 * MiB;
constexpr size_t WS_MOE = 10 * MiB;
constexpr size_t MOE_CNT = WS_MOE, MOE_META = WS_MOE + 16384, MOE_TOKE = WS_MOE + 65536, MOE_TOKW = WS_MOE + 262144,
                 MOE_PTOK = WS_MOE + 524288, MOE_PW = WS_MOE + 1048576, MOE_PPOS = WS_MOE + 1572864;
constexpr size_t WS_CTXX = 12 * MiB;
constexpr size_t WS_WIN = 20 * MiB;
constexpr size_t WS_WOUT = 32 * MiB;
constexpr size_t WS_WUP = 36 * MiB;
constexpr size_t WS_WDN = 47 * MiB;
constexpr size_t WS_HX = 54 * MiB;
constexpr size_t WS_PA = 122 * MiB;
constexpr size_t WS_KV = 360 * MiB;
constexpr size_t WS_Y = 496 * MiB;
constexpr size_t WS_MOEUP = 360 * MiB;
constexpr size_t WS_SLABA = WS_KV;
constexpr size_t WS_SLABM = 528 * MiB;
constexpr int MAXSLAB_A = 256, MAXSLAB_M = 216;
constexpr size_t XB_OFF = (size_t)NLAT * D * 2;
constexpr size_t WS_XCOPY = WS_PA;
constexpr size_t WS_END = 582 * MiB;
static_assert((size_t)NE * D * DEXP * 2 <= XB_OFF, "MoE-down weights fit the lower half of d_out");
static_assert(WS_PA + (size_t)MROWS * DEXP * 2 <= WS_KV, "ws map");

constexpr int LDS_SCRATCH = 147456;
constexpr int LDS_MISC = LDS_SCRATCH;
constexpr int LDS_DEC = LDS_MISC + 256;
constexpr int LDS_BYTES = LDS_SCRATCH + 8192;

__device__ __forceinline__ float bf2f(unsigned v) { return __uint_as_float(v << 16); }
typedef __bf16 bf16x2_t __attribute__((ext_vector_type(2)));
__device__ __forceinline__ unsigned pk2(float lo, float hi) { const f32x2 v = {lo, hi}; return __builtin_bit_cast(unsigned, __builtin_convertvector(v, bf16x2_t)); }
__device__ __forceinline__ unsigned f2bf(float f) { return pk2(f, f) & 0xffffu; }
__device__ __forceinline__ void unpack8(const u32x4 v, f32x4& a, f32x4& b) {
    a = (f32x4){bf2f(v.x & 0xffffu), __uint_as_float(v.x & 0xffff0000u), bf2f(v.y & 0xffffu), __uint_as_float(v.y & 0xffff0000u)};
    b = (f32x4){bf2f(v.z & 0xffffu), __uint_as_float(v.z & 0xffff0000u), bf2f(v.w & 0xffffu), __uint_as_float(v.w & 0xffff0000u)}; }
__device__ __forceinline__ u32x4 pack8(const f32x4 a, const f32x4 b) { return (u32x4){pk2(a.x, a.y), pk2(a.z, a.w), pk2(b.x, b.y), pk2(b.z, b.w)}; }
template <int M> __device__ __forceinline__ float swz_xor(float v) { return __int_as_float(__builtin_amdgcn_ds_swizzle(__float_as_int(v), (M << 10) | 0x1f)); }
__device__ __forceinline__ float wave_sum(float v) {
    v += swz_xor<1>(v); v += swz_xor<2>(v); v += swz_xor<4>(v); v += swz_xor<8>(v); v += swz_xor<16>(v);
    const auto r = __builtin_amdgcn_permlane32_swap(__float_as_uint(v), __float_as_uint(v), false, false);
    return __uint_as_float(r[0]) + __uint_as_float(r[1]);
}
__device__ __forceinline__ float lane_bcast(float v, int src_lane) { return __int_as_float(__builtin_amdgcn_ds_bpermute(src_lane << 2, __float_as_int(v))); }
__device__ __forceinline__ float sigmoidf_(float x) { return __builtin_amdgcn_rcpf(1.0f + __expf(-x)); }
__device__ __forceinline__ float siluf_(float x) { return x * __builtin_amdgcn_rcpf(1.0f + __expf(-x)); }
__device__ __forceinline__ float gelu_tanh(float x) { const float z = 0.7978845608028654f * (x + 0.044715f * x * x * x); return x * (1.0f - __builtin_amdgcn_rcpf(1.0f + __expf(2.0f * z))); }
#define LDS_WAIT() asm volatile("s_waitcnt lgkmcnt(0)" ::: "memory")
#define WG_BAR_LDS() do { asm volatile("s_waitcnt lgkmcnt(0)" ::: "memory"); __builtin_amdgcn_s_barrier(); asm volatile("" ::: "memory"); } while (0)
__device__ __forceinline__ f32x4 zero4() { float z; asm volatile("v_mov_b32 %0, 0" : "=v"(z)); return (f32x4){z, z, z, z}; }

template <typename T> __device__ __forceinline__ T ldg(const void* base, unsigned off) { return *(const GAS T*)((const GAS char*)base + off); }
template <typename T> __device__ __forceinline__ void stg(void* base, unsigned off, T v) { *(GAS T*)((GAS char*)base + off) = v; }
#define XB_TMO      128
#define XB_XCNT(j)  (256  + 64 * (j))
#define XB_XSUB(j)  (1280 + 64 * (j))
#define XB_XGEN(j)  (2304 + 64 * (j))
#define XB_TOP      3328
#define XB_TOPGEN   3392
#define XCD_BAR_WORDS 3456
#define XB_SPIN_CAP (1u << 18)
__device__ __forceinline__ unsigned xb_ld(unsigned* p)              { return __hip_atomic_load(p, __ATOMIC_RELAXED, __HIP_MEMORY_SCOPE_AGENT); }
__device__ __forceinline__ unsigned xb_add(unsigned* p, unsigned v) { return __hip_atomic_fetch_add(p, v, __ATOMIC_RELAXED, __HIP_MEMORY_SCOPE_AGENT); }
__device__ __forceinline__ unsigned xb_xcc_id() { return (unsigned)__builtin_amdgcn_s_getreg((3 << 11) | 20) & 0xFu; }
#define XB_SPIN(cond, bar) do { unsigned _sp = 0; while (cond) { __builtin_amdgcn_s_sleep(1); \
    if ((++_sp & 255u) == 0u) { if (xb_ld(&(bar)[XB_TMO])) break; if (_sp > XB_SPIN_CAP) { atomicAdd(&(bar)[XB_TMO], 1u); break; } } } } while (0)
struct XcdBarrier { unsigned* bar; unsigned x; volatile LAS unsigned* st; };
__device__ __forceinline__ XcdBarrier xcd_barrier_post(unsigned* bar, volatile LAS unsigned* st) {
    XcdBarrier b; b.bar = bar; b.x = xb_xcc_id(); b.st = st;
    if (threadIdx.x == 0) (void)xb_add(&bar[XB_XCNT(b.x)], 1u);
    return b;
}
__device__ __forceinline__ void xcd_barrier_complete(unsigned* bar, unsigned x, unsigned& nloc, unsigned& nx) {
    const unsigned G = gridDim.x * gridDim.y * gridDim.z;
    unsigned sum, cnt, mine, sp = 0u;
    for (;;) {
        sum = 0u; cnt = 0u; mine = 0u;
#pragma unroll
        for (unsigned j = 0; j < 16; ++j) { const unsigned c = xb_ld(&bar[XB_XCNT(j)]); sum += c; cnt += (c > 0u) ? 1u : 0u; mine = (j == x) ? c : mine; }
        if (sum == G) break;
        __builtin_amdgcn_s_sleep(1);
        if ((++sp & 255u) == 0u) { if (xb_ld(&bar[XB_TMO])) break; if (sp > XB_SPIN_CAP) { atomicAdd(&bar[XB_TMO], 1u); break; } }
    }
    nloc = mine > 0u ? mine : 1u; nx = cnt > 0u ? cnt : 1u;
}
__device__ __forceinline__ void xcd_barrier(const XcdBarrier& b) {
    asm volatile("s_waitcnt vmcnt(0)" ::: "memory");
    __syncthreads();
    if (threadIdx.x == 0) {
        unsigned* bar = b.bar;
        __builtin_amdgcn_s_waitcnt(0);
        unsigned nloc = b.st[0], nx = b.st[1];
        if (nloc == 0u) { xcd_barrier_complete(bar, b.x, nloc, nx); b.st[0] = nloc; b.st[1] = nx; }
        const unsigned old = xb_add(&bar[XB_XSUB(b.x)], 1u);
        const unsigned gen = old / nloc;
        if (old + 1u == (gen + 1u) * nloc) {
            __builtin_amdgcn_fence(__ATOMIC_RELEASE, "agent");
            asm volatile("s_waitcnt vmcnt(0)" ::: "memory");
            const unsigned og = xb_add(&bar[XB_TOP], 1u);
            const unsigned tg = og / nx;
            if (og + 1u == (tg + 1u) * nx) xb_add(&bar[XB_TOPGEN], 1u);
            else XB_SPIN(xb_ld(&bar[XB_TOPGEN]) == tg, bar);
            __builtin_amdgcn_fence(__ATOMIC_ACQUIRE, "agent");
            xb_add(&bar[XB_XGEN(b.x)], 1u);
            asm volatile("s_waitcnt vmcnt(0)" ::: "memory");
        } else {
            XB_SPIN(xb_ld(&bar[XB_XGEN(b.x)]) == gen, bar);
            __builtin_amdgcn_fence(__ATOMIC_ACQUIRE, "agent");
            asm volatile("s_waitcnt vmcnt(0)" ::: "memory");
        }
    }
    __syncthreads();
}

namespace pg8 {
constexpr int BM = 256, BK = 64, HALF = 128, HTB = HALF * BK * 2, STAGE_BYTES = 8 * HTB, NXCD = 8, WGM = 8;
__host__ __device__ __forceinline__ int lds_byte(int r, int c) { const int st = (r >> 4) * 2 + (c >> 5), rr = r & 15, cc = c & 31, ob = rr * 64 + cc * 2; return st * 1024 + (ob ^ (((ob >> 9) & 1) << 5)); }
__host__ __device__ __forceinline__ void stage_rc(int b, int& R, int& C) { const int st = b / 1024, sb = b % 1024, swz = sb ^ (((sb >> 9) & 1) << 5); R = (st >> 1) * 16 + swz / 64; C = (st & 1) * 32 + (swz % 64) / 2; }
__host__ __device__ __forceinline__ int perm32(int rho) { const int n = rho >> 4, i = rho & 15; return 8 * (i >> 2) + 4 * n + (i & 3); }

struct Unit { int pm, pn, e, kt0, nt, slab; };
struct Gemm { const bf16_t* A; const bf16_t* Bt; int N, K; size_t estride; float* slabs; };

__device__ __forceinline__ int split_factor(int U, int G, int ntiles, int maxslabs) {
    const int R = U % G; if (R == 0) return 1;
    int S = G / R; if (S > 8) S = 8; if (S > ntiles / 4) S = ntiles / 4; if (R * S > maxslabs) S = maxslabs / R;
    return S < 2 ? 1 : S;
}
struct Order {
    int nM, nN, G, c, ntiles, mainu, S, total; const int* segs; const int* rowmap;
    int sg1, sg2, sg3, sg4, sg5, sg6, sg7;
    __device__ __forceinline__ void init(int nM_, int nN_, int G_, int c_, const int* segs_, const int* rowmap_, int ntiles_, bool split, int maxslabs) {
        nM = nM_; nN = nN_; G = G_; c = c_; segs = segs_; rowmap = rowmap_; ntiles = ntiles_;
        sg1 = sg2 = sg3 = sg4 = sg5 = sg6 = sg7 = 0; if (segs_) { sg1 = segs_[1]; sg2 = segs_[2]; sg3 = segs_[3]; sg4 = segs_[4]; sg5 = segs_[5]; sg6 = segs_[6]; sg7 = segs_[7]; }
        const int U = nM * nN; S = split ? split_factor(U, G, ntiles, maxslabs) : 1; const int R = (S > 1) ? U % G : 0; mainu = U - R; total = mainu + R * S; }
    __device__ __forceinline__ bool next(int i, Unit& u) const {
        const long L = (long)i * G + c; if (L >= total) return false;
        int wgid; u.kt0 = 0; u.nt = ntiles; u.slab = -1;
        if (L < mainu) { wgid = (int)L; const int q = mainu / NXCD, r = mainu % NXCD, xcd = wgid % NXCD, off = wgid / NXCD; wgid = (xcd < r ? xcd * (q + 1) : r * (q + 1) + (xcd - r) * q) + off; }
        else { const int sub = (int)L - mainu, lu = sub / S, sl = sub - lu * S, pairs = ntiles / 2, p0 = (sl * pairs) / S, p1 = ((sl + 1) * pairs) / S;
            wgid = mainu + lu; u.kt0 = 2 * p0; u.nt = 2 * (p1 - p0); u.slab = sub; }
        const int nig = WGM * nN, gid = wgid / nig, fm = gid * WGM, gsz = (nM - fm) < WGM ? (nM - fm) : WGM;
        u.pm = fm + ((wgid % nig) % gsz); u.pn = (wgid % nig) / gsz; u.e = 0;
        if (segs) u.e = (u.pm >= sg1) + (u.pm >= sg2) + (u.pm >= sg3) + (u.pm >= sg4) + (u.pm >= sg5) + (u.pm >= sg6) + (u.pm >= sg7);
        return true;
    }
    __device__ __forceinline__ int arow(const Unit& u, int r) const {
        if (rowmap) { const int t = rowmap[u.pm * BM + r]; return t < 0 ? 0 : t; }
        return u.pm * BM + r;
    }
};

__device__ __forceinline__ unsigned cvt_pk_bf16(float lo, float hi) { return pk2(lo, hi); }

struct EpiBf16 {
    static constexpr bool PERM = true, SPLIT = false;
    bf16_t* O; int ldc;
    __device__ __forceinline__ void operator()(const f32x4 (&acc)[2][2][4][2], const Unit& u, int wr, int wc, int fr, int fq) const {
        asm volatile("" : "+v"(fr), "+v"(fq));
        const int row0 = u.pm * BM + wr * 64 + fr, col0 = u.pn * BM + wc * 32 + 8 * fq;
#pragma unroll
        for (int ai = 0; ai < 2; ++ai)
#pragma unroll
            for (int m = 0; m < 4; ++m) { bf16_t* rowp = O + (size_t)(row0 + ai * HALF + m * 16) * ldc + col0;
#pragma unroll
                for (int bj = 0; bj < 2; ++bj) { const f32x4 v0 = acc[ai][bj][m][0], v1 = acc[ai][bj][m][1];
                    u32x4 w; w.x = cvt_pk_bf16(v0[0], v0[1]); w.y = cvt_pk_bf16(v0[2], v0[3]); w.z = cvt_pk_bf16(v1[0], v1[1]); w.w = cvt_pk_bf16(v1[2], v1[3]);
                    *(u32x4*)(rowp + bj * HALF) = w; } }
    }
};
struct EpiInProj {
    static constexpr bool PERM = true, SPLIT = false;
    bf16_t* O; int ldc; const float* ct; const float* st;
    __device__ __forceinline__ void operator()(const f32x4 (&acc)[2][2][4][2], const Unit& u, int wr, int wc, int fr, int fq) const {
        asm volatile("" : "+v"(fr), "+v"(fq));
        const int row0 = u.pm * BM + wr * 64 + fr, col0 = u.pn * BM + wc * 32 + 8 * fq;
        const bool rot = (u.pn >= 4) && (u.pn < 8) && (u.pm * BM < NLAT);
#pragma unroll
        for (int ai = 0; ai < 2; ++ai)
#pragma unroll
            for (int m = 0; m < 4; ++m) { const int row = row0 + ai * HALF + m * 16; bf16_t* rowp = O + (size_t)row * ldc + col0;
                f32x4 c = {1.f, 1.f, 1.f, 1.f}, s = {0.f, 0.f, 0.f, 0.f};
                if (rot) { const unsigned to = (unsigned)((row & (SEQ - 1)) * 64 + wc * 16 + fq * 4) * 4u; c = ldg<f32x4>(ct, to); s = ldg<f32x4>(st, to); }
#pragma unroll
                for (int bj = 0; bj < 2; ++bj) { const f32x4 v0 = acc[ai][bj][m][0], v1 = acc[ai][bj][m][1];
                    u32x4 w; w.x = cvt_pk_bf16(v0[0] * c[0] - v0[1] * s[0], v0[0] * s[0] + v0[1] * c[0]); w.y = cvt_pk_bf16(v0[2] * c[1] - v0[3] * s[1], v0[2] * s[1] + v0[3] * c[1]);
                    w.z = cvt_pk_bf16(v1[0] * c[2] - v1[1] * s[2], v1[0] * s[2] + v1[1] * c[2]); w.w = cvt_pk_bf16(v1[2] * c[3] - v1[3] * s[3], v1[2] * s[3] + v1[3] * c[3]);
                    *(u32x4*)(rowp + bj * HALF) = w; } }
    }
};
struct EpiSwiGLU {
    static constexpr bool PERM = true, SPLIT = false;
    bf16_t* O; int ldc;
    __device__ __forceinline__ void operator()(const f32x4 (&acc)[2][2][4][2], const Unit& u, int wr, int wc, int fr, int fq) const {
        asm volatile("" : "+v"(fr), "+v"(fq));
        const int row0 = u.pm * BM + wr * 64 + fr, col0 = u.pn * HALF + wc * 32 + 8 * fq;
#pragma unroll
        for (int ai = 0; ai < 2; ++ai)
#pragma unroll
            for (int m = 0; m < 4; ++m) { bf16_t* rowp = O + (size_t)(row0 + ai * HALF + m * 16) * ldc + col0;
                float o[8];
#pragma unroll
                for (int n = 0; n < 2; ++n)
#pragma unroll
                    for (int j = 0; j < 4; ++j) { const float a = acc[ai][0][m][n][j], b = acc[ai][1][m][n][j]; o[n * 4 + j] = (a * __builtin_amdgcn_rcpf(1.0f + __expf(-a))) * b; }
                u32x4 w; w.x = cvt_pk_bf16(o[0], o[1]); w.y = cvt_pk_bf16(o[2], o[3]); w.z = cvt_pk_bf16(o[4], o[5]); w.w = cvt_pk_bf16(o[6], o[7]);
                *(u32x4*)rowp = w; }
    }
};
struct EpiResid {
    static constexpr bool PERM = true, SPLIT = true;
    const float* src_f32; bf16_t* xb; const float* src_ctx; float* dst_ctx; const float* gate_lat; const float* gate_ctx;
    __device__ __forceinline__ void operator()(const f32x4 (&acc)[2][2][4][2], const Unit& u, int wr, int wc, int fr, int fq) const {
        asm volatile("" : "+v"(fr), "+v"(fq));
        const int prow = u.pm * BM; const bool lat = prow < NLAT;
        const float* gate = lat ? gate_lat + (size_t)(prow / SEQ) * 6144 : gate_ctx;
        const int r0 = wr * 64 + fr, col0 = u.pn * BM + wc * 32 + 8 * fq;
        f32x4 gv[2][2];
#pragma unroll
        for (int bj = 0; bj < 2; ++bj)
#pragma unroll
            for (int n = 0; n < 2; ++n) gv[bj][n] = *(const f32x4*)(gate + col0 + bj * HALF + 4 * n);
        if (lat) {
#pragma unroll
            for (int ai = 0; ai < 2; ++ai)
#pragma unroll
                for (int m = 0; m < 4; ++m) { const size_t off = (size_t)(prow + r0 + ai * HALF + m * 16) * D + col0;
#pragma unroll
                    for (int bj = 0; bj < 2; ++bj) { f32x4 s0, s1;
                        if (src_f32) { s0 = *(const f32x4*)(src_f32 + off + bj * HALF); s1 = *(const f32x4*)(src_f32 + off + bj * HALF + 4); }
                        else unpack8(*(const u32x4*)(xb + off + bj * HALF), s0, s1);
                        *(u32x4*)(xb + off + bj * HALF) = pack8(s0 + gv[bj][0] * acc[ai][bj][m][0], s1 + gv[bj][1] * acc[ai][bj][m][1]); }
                    if (m == 3) asm volatile("" ::: "memory"); }
        } else {
            const float* src = src_ctx + (size_t)(prow - NLAT) * D; float* dst = dst_ctx + (size_t)(prow - NLAT) * D;
#pragma unroll
            for (int ai = 0; ai < 2; ++ai)
#pragma unroll
                for (int m = 0; m < 4; ++m) { const size_t off = (size_t)(r0 + ai * HALF + m * 16) * D + col0;
#pragma unroll
                    for (int bj = 0; bj < 2; ++bj)
#pragma unroll
                        for (int n = 0; n < 2; ++n) { const f32x4 sv = *(const f32x4*)(src + off + bj * HALF + 4 * n); *(f32x4*)(dst + off + bj * HALF + 4 * n) = sv + gv[bj][n] * acc[ai][bj][m][n]; }
                    asm volatile("" ::: "memory"); }
        }
    }
};
struct EpiMoeDown {
    static constexpr bool PERM = true, SPLIT = true;
    bf16_t* xb; const int* ptok; const float* pw; const float* gate_lat;
    __device__ __forceinline__ void operator()(const f32x4 (&acc)[2][2][4][2], const Unit& u, int wr, int wc, int fr, int fq) const {
        asm volatile("" : "+v"(fr), "+v"(fq));
        const int r0 = u.pm * BM + wr * 64 + fr, col0 = u.pn * BM + wc * 32 + 8 * fq;
        int tk[8]; float wk[8];
#pragma unroll
        for (int i = 0; i < 8; ++i) { const int r = r0 + (i >> 2) * HALF + (i & 3) * 16; tk[i] = ptok[r]; wk[i] = pw[r]; }
#pragma unroll
        for (int ai = 0; ai < 2; ++ai)
#pragma unroll
            for (int m = 0; m < 4; ++m) { const int tok = tk[ai * 4 + m]; const float w = wk[ai * 4 + m];
                if (tok >= 0) { bf16_t* xr = xb + (size_t)tok * D + col0; const float* gate = gate_lat + (size_t)(tok / SEQ) * 6144 + col0;
#pragma unroll
                    for (int bj = 0; bj < 2; ++bj) { const f32x4 g0 = *(const f32x4*)(gate + bj * HALF), g1 = *(const f32x4*)(gate + bj * HALF + 4); f32x4 s0, s1; unpack8(*(const u32x4*)(xr + bj * HALF), s0, s1);
                        *(u32x4*)(xr + bj * HALF) = pack8(s0 + (g0 * w) * acc[ai][bj][m][0], s1 + (g1 * w) * acc[ai][bj][m][1]); } }
                if (m & 1) asm volatile("" ::: "memory"); }
    }
};

template <class Epi>
__device__ __forceinline__ void gemm_phase(ldsp_t lds, const Gemm g, const Order& S, const Epi& E, const int tid) {
    const int wid = __builtin_amdgcn_readfirstlane(tid >> 6), lane = tid & 63, wr = wid >> 2, wc = wid & 3, fr = lane & 15, fq = lane >> 4;
    const int K = g.K;
    unsigned voffB[2];
#pragma unroll
    for (int i = 0; i < 2; ++i) { int R, C; stage_rc(tid * 16 + i * 8192, R, C); const int Rb = Epi::PERM ? ((R & ~31) + perm32(R & 31)) : R;
        voffB[i] = (unsigned)(Rb * K + C) * 2u; }
    const size_t kstep = (size_t)(BK * 2);
    const size_t hstep = (size_t)HALF * K * 2;
    const size_t tstep = 2 * hstep;
    const unsigned ldsw = (unsigned)wid * 1024u;
    const int aoff = lds_byte(wr * 64 + fr, fq * 8), boff = lds_byte(wc * 32 + fr, fq * 8);
#define PG8_SA(b, h) (((b) * 2 + (h)) * HTB)
#define PG8_SB(b, h) ((4 + (b) * 2 + (h)) * HTB)
#define PG8_STAGE_B(bufoff, gbase) do { _Pragma("unroll") for (int _i = 0; _i < 2; ++_i) \
        __builtin_amdgcn_global_load_lds((const unsigned*)((const char*)(gbase) + voffB[_i]), (LAS unsigned*)(lds + (bufoff) + ldsw + _i * 8192), 16, 0, 0); } while (0)
#define PG8_STAGE_A(bufoff, gbase, o0, o1) do { \
        __builtin_amdgcn_global_load_lds((const unsigned*)((const char*)(gbase) + (o0)), (LAS unsigned*)(lds + (bufoff) + ldsw), 16, 0, 0); \
        __builtin_amdgcn_global_load_lds((const unsigned*)((const char*)(gbase) + (o1)), (LAS unsigned*)(lds + (bufoff) + ldsw + 8192), 16, 0, 0); } while (0)
#define PG8_LDA(dst, b, h) do { _Pragma("unroll") for (int m = 0; m < 4; ++m) _Pragma("unroll") for (int k = 0; k < 2; ++k) dst[m][k] = *(const LAS bf16x8*)(lds + PG8_SA(b, h) + aoff + m * 2048 + k * 1024); } while (0)
#define PG8_LDB(dst, b, h) do { _Pragma("unroll") for (int n = 0; n < 2; ++n) _Pragma("unroll") for (int k = 0; k < 2; ++k) dst[n][k] = *(const LAS bf16x8*)(lds + PG8_SB(b, h) + boff + n * 2048 + k * 1024); } while (0)
#define PG8_MMA(ai, bj, At, Bt) do { __builtin_amdgcn_s_setprio(1); _Pragma("unroll") for (int m = 0; m < 4; ++m) _Pragma("unroll") for (int n = 0; n < 2; ++n) _Pragma("unroll") for (int k = 0; k < 2; ++k) \
        acc[ai][bj][m][n] = __builtin_amdgcn_mfma_f32_16x16x32_bf16(Bt[n][k], At[m][k], acc[ai][bj][m][n], 0, 0, 0); __builtin_amdgcn_s_setprio(0); } while (0)
#define PG8_WAIT_V(n) asm volatile("s_waitcnt vmcnt(" #n ")" ::: "memory")
#define PG8_WAIT_L(n) asm volatile("s_waitcnt lgkmcnt(" #n ")" ::: "memory")
#define PG8_BAR __builtin_amdgcn_s_barrier()
#define PG8_SCHED __builtin_amdgcn_sched_barrier(0)
#define PG8_AOFFS(u, o00, o01, o10, o11) do { int R0_, C0_, R1_, C1_; stage_rc(tid * 16, R0_, C0_); stage_rc(tid * 16 + 8192, R1_, C1_); \
        o00 = (unsigned)(S.arow(u, R0_) * K + C0_ + (u).kt0 * BK) * 2u; o01 = (unsigned)(S.arow(u, R1_) * K + C1_ + (u).kt0 * BK) * 2u; \
        o10 = (unsigned)(S.arow(u, HALF + R0_) * K + C0_ + (u).kt0 * BK) * 2u; o11 = (unsigned)(S.arow(u, HALF + R1_) * K + C1_ + (u).kt0 * BK) * 2u; } while (0)
    Unit cur, nxt; int ui = 0;
    if (!S.next(0, cur)) return;
    f32x4 acc[2][2][4][2];
    { float z_; asm volatile("v_mov_b32 %0, 0" : "=v"(z_));
#pragma unroll
    for (int a = 0; a < 2; ++a)
#pragma unroll
        for (int b = 0; b < 2; ++b)
#pragma unroll
            for (int m = 0; m < 4; ++m)
#pragma unroll
                for (int n = 0; n < 2; ++n) acc[a][b][m][n] = (f32x4){z_, z_, z_, z_}; }
    bf16x8 At[4][2], B0[2][2], B1[2][2];
    const char* const Abase = (const char*)g.A;
    const char* cB = (const char*)g.Bt + (size_t)cur.e * g.estride + (size_t)cur.pn * tstep + (size_t)cur.kt0 * kstep;
    unsigned c00, c01, c10, c11;
    PG8_AOFFS(cur, c00, c01, c10, c11);
    PG8_STAGE_B(PG8_SB(0, 0), cB); PG8_STAGE_B(PG8_SB(0, 1), cB + hstep); PG8_STAGE_A(PG8_SA(0, 0), Abase, c00, c01); PG8_STAGE_A(PG8_SA(0, 1), Abase, c10, c11);
    if (wr == 1) PG8_BAR;
    PG8_WAIT_V(2); PG8_BAR;
    PG8_STAGE_B(PG8_SB(1, 0), cB + kstep); PG8_STAGE_A(PG8_SA(1, 0), Abase + kstep, c00, c01); PG8_STAGE_B(PG8_SB(1, 1), cB + hstep + kstep);
    PG8_WAIT_V(6); PG8_BAR;
    for (;;) {
        const bool has_next = S.next(ui + 1, nxt);
        const char* nB = has_next ? (const char*)g.Bt + (size_t)nxt.e * g.estride + (size_t)nxt.pn * tstep + (size_t)nxt.kt0 * kstep : cB;
        const int nt = cur.nt;
        int rn0 = 0, rn1 = 0, rn2 = 0, rn3 = 0;
        if (S.rowmap && has_next) { int R0_, C0_, R1_, C1_; stage_rc(tid * 16, R0_, C0_); stage_rc(tid * 16 + 8192, R1_, C1_);
            rn0 = S.arow(nxt, R0_); rn1 = S.arow(nxt, R1_); rn2 = S.arow(nxt, HALF + R0_); rn3 = S.arow(nxt, HALF + R1_); }
        for (int t = 0; t < nt; t += 2) {
            const bool last = (t == nt - 2);
            const char* a1 = Abase + (size_t)(t + 1) * kstep;
            const char* a2 = last ? Abase : Abase + (size_t)(t + 2) * kstep; const char* b2 = last ? nB : cB + (size_t)(t + 2) * kstep;
            const char* a3 = a2 + kstep; const char* b3 = b2 + kstep;
            PG8_LDB(B0, 0, 0); PG8_LDB(B1, 0, 1); PG8_SCHED; PG8_LDA(At, 0, 0); PG8_STAGE_A(PG8_SA(1, 1), a1, c10, c11);
            PG8_WAIT_V(8); PG8_WAIT_L(0); PG8_BAR; PG8_MMA(0, 0, At, B0); PG8_MMA(0, 1, At, B1); PG8_BAR; PG8_SCHED;
            if (last && has_next) {
                if (S.rowmap) { int R0_, C0_, R1_, C1_; stage_rc(tid * 16, R0_, C0_); stage_rc(tid * 16 + 8192, R1_, C1_);
                    c00 = (unsigned)(rn0 * K + C0_ + nxt.kt0 * BK) * 2u; c01 = (unsigned)(rn1 * K + C1_ + nxt.kt0 * BK) * 2u; c10 = (unsigned)(rn2 * K + C0_ + nxt.kt0 * BK) * 2u; c11 = (unsigned)(rn3 * K + C1_ + nxt.kt0 * BK) * 2u; }
                else { PG8_AOFFS(nxt, c00, c01, c10, c11); } }
            PG8_LDA(At, 0, 1); PG8_STAGE_B(PG8_SB(0, 0), b2); PG8_STAGE_B(PG8_SB(0, 1), b2 + hstep); PG8_STAGE_A(PG8_SA(0, 0), a2, c00, c01);
            PG8_WAIT_V(8); PG8_WAIT_L(0); PG8_BAR; PG8_MMA(1, 0, At, B0); PG8_MMA(1, 1, At, B1); PG8_BAR; PG8_SCHED;
            PG8_LDB(B0, 1, 0); PG8_LDB(B1, 1, 1); PG8_SCHED; PG8_LDA(At, 1, 0); PG8_STAGE_A(PG8_SA(0, 1), a2, c10, c11);
            PG8_WAIT_V(8); PG8_WAIT_L(0); PG8_BAR; PG8_MMA(0, 0, At, B0); PG8_MMA(0, 1, At, B1); PG8_BAR; PG8_SCHED;
            PG8_LDA(At, 1, 1); PG8_STAGE_B(PG8_SB(1, 0), b3); PG8_STAGE_B(PG8_SB(1, 1), b3 + hstep); PG8_STAGE_A(PG8_SA(1, 0), a3, c00, c01);
            PG8_WAIT_V(8); PG8_WAIT_L(0); PG8_BAR; PG8_MMA(1, 0, At, B0); PG8_MMA(1, 1, At, B1); PG8_BAR; PG8_SCHED;
        }
        if (wr == 0) PG8_BAR;
        if (Epi::SPLIT && cur.slab >= 0) {
            int fr_ = fr, fq_ = fq; asm volatile("" : "+v"(fr_), "+v"(fq_));
            float* sp = g.slabs + (size_t)cur.slab * 65536 + (size_t)(wr * 64 + fr_) * 256 + wc * 32 + (Epi::PERM ? 8 : 4) * fq_;
#pragma unroll
            for (int ai = 0; ai < 2; ++ai)
#pragma unroll
                for (int m = 0; m < 4; ++m)
#pragma unroll
                    for (int bj = 0; bj < 2; ++bj)
#pragma unroll
                        for (int n = 0; n < 2; ++n) *(f32x4*)(sp + (ai * HALF + m * 16) * 256 + bj * HALF + n * (Epi::PERM ? 4 : 16)) = acc[ai][bj][m][n];
        } else E(acc, cur, wr, wc, fr, fq);
        if (!has_next) break;
        { float z_; asm volatile("v_mov_b32 %0, 0" : "=v"(z_));
#pragma unroll
        for (int a = 0; a < 2; ++a)
#pragma unroll
            for (int b = 0; b < 2; ++b)
#pragma unroll
                for (int m = 0; m < 4; ++m)
#pragma unroll
                    for (int n = 0; n < 2; ++n) acc[a][b][m][n] = (f32x4){z_, z_, z_, z_}; }
        cur = nxt; cB = nB; ++ui;
        if (wr == 1) PG8_BAR;
    }
    PG8_WAIT_V(0);
    PG8_BAR;
#undef PG8_SA
#undef PG8_SB
#undef PG8_STAGE_A
#undef PG8_STAGE_B
#undef PG8_LDA
#undef PG8_LDB
#undef PG8_MMA
#undef PG8_WAIT_V
#undef PG8_WAIT_L
#undef PG8_BAR
#undef PG8_SCHED
#undef PG8_AOFFS
}
}

struct Args { const float* in[27]; float* out; unsigned char* ws; int ph_lo, ph_hi; };
struct Frame {
    ldsp_t lds; int tid, lane, wave, wave0, G, bid;
    const Args* pa; float* out; unsigned char* ws;
    const Args* pa0; float* out0; unsigned char* ws0;
};
enum { I_X = 0, I_C, I_CTX, I_CCTX, I_WMOD, I_BMOD, I_GMIX, I_GFFN, I_GFINAL, I_WIN, I_WOUT, I_CONVW, I_CONVB, I_RGWA, I_RGBA, I_RGWX, I_RGBX, I_RGLAM, I_RETDEC,
       I_FW1, I_FW3, I_FW2, I_MROUTER, I_MROUTERB, I_MW1, I_MW3, I_MW2 };

constexpr int TRS = 64 * 65 * 4;
struct TrItem { const float* W; bf16_t* WT; int ldw, k0, n0, ldt, drow0; float scale; int perm; };
__device__ __forceinline__ void tr_load(const TrItem& t, f32x4 (&v)[16], int lane) {
    const int r4 = lane >> 4, c4 = (lane & 15) * 4;
#pragma unroll
    for (int i = 0; i < 16; ++i) v[i] = *(const f32x4*)(t.W + (size_t)(t.k0 + 4 * i + r4) * t.ldw + t.n0 + c4);
}
__device__ __forceinline__ void tr_store(const TrItem& t, const f32x4 (&v)[16], LAS float* scr, int lane) {
    { const int r4 = lane >> 4, c4 = (lane & 15) * 4;
#pragma unroll
      for (int i = 0; i < 16; ++i) { LAS float* d = scr + (4 * i + r4) * 65 + c4; d[0] = v[i].x; d[1] = v[i].y; d[2] = v[i].z; d[3] = v[i].w; } }
    LDS_WAIT(); asm volatile("" ::: "memory");
    const int c = lane & 7; const float scale = t.scale;
#pragma unroll
    for (int j = 0; j < 8; ++j) { const int n = (lane >> 3) + 8 * j; const LAS float* sp = scr + (8 * c) * 65 + n;
        u32x4 o; o.x = pk2(sp[0 * 65] * scale, sp[1 * 65] * scale); o.y = pk2(sp[2 * 65] * scale, sp[3 * 65] * scale); o.z = pk2(sp[4 * 65] * scale, sp[5 * 65] * scale); o.w = pk2(sp[6 * 65] * scale, sp[7 * 65] * scale);
        int drow = t.drow0 + n; if (t.perm) drow = (drow & ~127) + ((drow & 63) << 1) + ((drow >> 6) & 1);
        *(u32x4*)(t.WT + (size_t)drow * t.ldt + t.k0 + 8 * c) = o; }
    LDS_WAIT(); asm volatile("" ::: "memory");
}
__device__ __forceinline__ TrItem up_item(const float* w1, const float* w3, int F, bf16_t* WT, int r) {
    const int per = 16 * (F / 64); const int which = r / per; r -= which * per;
    const int nblk = F / 64, kb = r / nblk, nb = r % nblk, n0 = nb * 64;
    return TrItem{which ? w3 : w1, WT, F, kb * 64, n0, D, (n0 / 128) * 256 + (n0 % 128) + which * 128, 1.0f, 0};
}
__device__ __forceinline__ TrItem small_item(Frame& F, int r) {
    constexpr int I_IN = 16 * (INW / 64), I_OUT = 16 * (D / 64), I_UP = 2 * 16 * (DFF / 64);
    if (r < 2 * I_IN) { const int l = r / I_IN; r -= l * I_IN; const int nblk = INW / 64, kb = r / nblk, nb = r % nblk, n0 = nb * 64;
        const float sc = (n0 >= 1536 && n0 < 2048) ? 0.08838834764831845f : 1.0f;
        return TrItem{F.pa->in[I_WIN] + (size_t)l * D * INW, (bf16_t*)(F.ws + WS_WIN) + (size_t)l * INW * D, INW, kb * 64, n0, D, n0, sc, (n0 >= 1024 && n0 < 2048) ? 1 : 0}; }
    r -= 2 * I_IN;
    if (r < 2 * I_OUT) { const int l = r / I_OUT; r -= l * I_OUT; const int nblk = D / 64, kb = r / nblk, nb = r % nblk;
        return TrItem{F.pa->in[I_WOUT] + (size_t)l * D * D, (bf16_t*)(F.ws + WS_WOUT) + (size_t)l * D * D, D, kb * 64, nb * 64, D, nb * 64, 1.0f, 0}; }
    r -= 2 * I_OUT;
    if (r < I_UP) return up_item(F.pa->in[I_FW1], F.pa->in[I_FW3], DFF, (bf16_t*)(F.ws + WS_WUP), r);
    r -= I_UP;
    { const int nblk = D / 64, kb = r / nblk, nb = r % nblk; return TrItem{F.pa->in[I_FW2], (bf16_t*)(F.ws + WS_WDN), D, kb * 64, nb * 64, DFF, nb * 64, 1.0f, 0}; }
}
__device__ __forceinline__ TrItem moe_item(Frame& F, int it) {
    constexpr int I_UP = 2 * 16 * (DEXP / 64), I_DN = (DEXP / 64) * (D / 64), PER_E = I_UP + I_DN;
    const int e = it / PER_E; int r = it - e * PER_E;
    if (r < I_UP) return up_item(F.pa->in[I_MW1] + (size_t)e * D * DEXP, F.pa->in[I_MW3] + (size_t)e * D * DEXP, DEXP, (bf16_t*)(F.ws + WS_MOEUP) + (size_t)e * 2 * DEXP * D, r);
    r -= I_UP;
    { const int nblk = D / 64, kb = r / nblk, nb = r % nblk; return TrItem{F.pa->in[I_MW2] + (size_t)e * DEXP * D, (bf16_t*)F.out + (size_t)e * D * DEXP, D, kb * 64, nb * 64, DEXP, nb * 64, 1.0f, 0}; }
}
__device__ __forceinline__ void phase_convert_small(Frame& F) {
    LAS float* scr = (LAS float*)(F.lds + F.wave * TRS);
    const int gw = F.bid * NWAVES + F.wave, NGW = F.G * NWAVES;
    constexpr int NITEMS = 2 * 16 * (INW / 64) + 2 * 16 * (D / 64) + 2 * 16 * (DFF / 64) + (DFF / 64) * (D / 64);
    if (gw < NITEMS) { TrItem cur = small_item(F, gw); f32x4 va[16], vb[16]; tr_load(cur, va, F.lane);
        for (int it = gw; it < NITEMS; it += 2 * NGW) {
            const bool h1 = it + NGW < NITEMS; TrItem n1 = cur; if (h1) { n1 = small_item(F, it + NGW); tr_load(n1, vb, F.lane); }
            tr_store(cur, va, scr, F.lane);
            if (!h1) break;
            const bool h2 = it + 2 * NGW < NITEMS; if (h2) { cur = small_item(F, it + 2 * NGW); tr_load(cur, va, F.lane); }
            tr_store(n1, vb, scr, F.lane);
            if (!h2) break; } }
    { const int gt = F.bid * NTHREADS + F.tid, NGT = F.G * NTHREADS; bf16_t* o = (bf16_t*)(F.ws + WS_RGW);
      for (int i = gt; i < 2 * 2 * 2 * 8 * 64 * 64; i += NGT) { const int c = i & 63, dp = (i >> 6) & 63, blk = (i >> 12) & 7, gate = (i >> 15) & 1, dir = (i >> 16) & 1, l = i >> 17;
          const float* src = gate ? F.pa->in[I_RGWX] : F.pa->in[I_RGWA]; o[i] = (bf16_t)f2bf(src[((((size_t)l * 2 + dir) * 8 + blk) * 64 + c) * 64 + dp]); } }
    { const int gt = F.bid * NTHREADS + F.tid, NGT = F.G * NTHREADS; float* ct = (float*)(F.ws + WS_ROPE); float* st = ct + 4096 * 64;
      for (int i = gt; i < 4096 * 64; i += NGT) { const int pos = i >> 6, fi = i & 63; const float p = (float)((fi < 32) ? (pos >> 6) : (pos & 63));
          const float inv = powf(10000.0f, -(float)(fi & 31) / 32.0f); const float ang = p * inv;
          const double a = (double)ang; const double kq = __builtin_rint(a * 0.63661977236758134308); const double rr = a - kq * 1.57079632679489661923; const int q = ((int)kq) & 3;
          const double r2 = rr * rr;
          const double sn = rr * (1.0 + r2 * (-1.0 / 6 + r2 * (1.0 / 120 + r2 * (-1.0 / 5040 + r2 * (1.0 / 362880 + r2 * (-1.0 / 39916800))))));
          const double cs = 1.0 + r2 * (-0.5 + r2 * (1.0 / 24 + r2 * (-1.0 / 720 + r2 * (1.0 / 40320 + r2 * (-1.0 / 3628800 + r2 * (1.0 / 479001600))))));
          const double c_ = (q == 0) ? cs : (q == 1) ? -sn : (q == 2) ? -cs : sn; const double s_ = (q == 0) ? sn : (q == 1) ? cs : (q == 2) ? -sn : -cs;
          ct[i] = (float)c_; st[i] = (float)s_; } }
}
struct MoeTile { const float* W; bf16_t* WT; int ldw, k0, n0, ldt, up; };
__device__ __forceinline__ MoeTile moe_tile(Frame& F, int t) {
    constexpr int T_UP1 = (D / 128) * (DEXP / 256), T_DN = (DEXP / 128) * (D / 256), PER_E = 2 * T_UP1 + T_DN;
    const int e = t / PER_E; int r = t - e * PER_E;
    if (r < 2 * T_UP1) { const int which = r / T_UP1; r -= which * T_UP1; const int nb = DEXP / 256, kb = r / nb, nn = r % nb;
        return MoeTile{(which ? F.pa->in[I_MW3] : F.pa->in[I_MW1]) + (size_t)e * D * DEXP, (bf16_t*)(F.ws + WS_MOEUP) + (size_t)e * 2 * DEXP * D, DEXP, kb * 128, nn * 256, D, 1 + which}; }
    r -= 2 * T_UP1;
    { const int nb = D / 256, kb = r / nb, nn = r % nb; return MoeTile{F.pa->in[I_MW2] + (size_t)e * DEXP * D, (bf16_t*)F.out + (size_t)e * D * DEXP, D, kb * 128, nn * 256, DEXP, 0}; }
}
__device__ __forceinline__ void moe_tile_load(const MoeTile& t, f32x4 (&v)[16], int wave, int lane) {
#pragma unroll
    for (int i = 0; i < 16; ++i) v[i] = *(const f32x4*)(t.W + (size_t)(t.k0 + 16 * wave + i) * t.ldw + t.n0 + 4 * lane);
}
__device__ __forceinline__ void moe_tile_store(Frame& F, const MoeTile& t, const f32x4 (&v)[16]) {
    LAS float* tile = (LAS float*)F.lds;
#pragma unroll
    for (int i = 0; i < 16; ++i) { const int k = 16 * F.wave + i, p = (4 * F.lane + 2 * (k >> 3)) & 255;
        *(LAS f32x2*)(tile + k * 256 + p) = (f32x2){v[i].x, v[i].y}; *(LAS f32x2*)(tile + k * 256 + ((p + 2) & 255)) = (f32x2){v[i].z, v[i].w}; }
    __syncthreads();
#pragma unroll
    for (int j = 0; j < 8; ++j) { const int task = F.tid + j * NTHREADS, c = task & 15, n = task >> 4; const LAS float* sp = tile + (8 * c) * 256 + ((n + 2 * c) & 255);
        u32x4 o; o.x = pk2(sp[0], sp[256]); o.y = pk2(sp[512], sp[768]); o.z = pk2(sp[1024], sp[1280]); o.w = pk2(sp[1536], sp[1792]);
        const int col = t.n0 + n; const int drow = t.up ? (col >> 7) * 256 + (col & 127) + 128 * (t.up - 1) : col;
        *(u32x4*)(t.WT + (size_t)drow * t.ldt + t.k0 + 8 * c) = o; }
    __syncthreads();
}
__device__ __forceinline__ int moe_tile_of(int q) {
    constexpr int T_UP2 = 2 * (D / 128) * (DEXP / 256), T_DN = (DEXP / 128) * (D / 256), PER_E = T_UP2 + T_DN;
    if (q < NE * T_DN) { const int e = q / T_DN; return e * PER_E + T_UP2 + (q - e * T_DN); }
    q -= NE * T_DN; { const int e = q / T_UP2; return e * PER_E + (q - e * T_UP2); }
}
constexpr int MOE_DN_TILES = NE * (DEXP / 128) * (D / 256);
__device__ __forceinline__ int fill_count(int U, int G) { return (U % G) ? 2 * (G - U % G) : 0; }
__device__ __forceinline__ int fill_total(int G) { const int n = 2 * fill_count((MROWS / 256) * (INW / 256), G) + fill_count((MROWS / 256) * (2 * DFF / 256), G); return n < MOE_DN_TILES ? n : MOE_DN_TILES; }
__device__ __forceinline__ void moe_fill(Frame& F, int U, int base) {
    const int left = U % F.G; if (left == 0 || F.bid < left) return;
    const int q0 = base + 2 * (F.bid - left); if (q0 + 1 >= fill_total(F.G)) return;
    const MoeTile a = moe_tile(F, moe_tile_of(q0)), b = moe_tile(F, moe_tile_of(q0 + 1)); f32x4 va[16], vb[16];
    moe_tile_load(a, va, F.wave, F.lane); moe_tile_load(b, vb, F.wave, F.lane);
    moe_tile_store(F, a, va); moe_tile_store(F, b, vb);
}
__device__ __forceinline__ void phase_convert_moe(Frame& F) {
    constexpr int NT = NE * (2 * (D / 128) * (DEXP / 256) + (DEXP / 128) * (D / 256));
    const int q0 = fill_total(F.G) + F.bid;
    if (q0 < NT) { MoeTile cur = moe_tile(F, moe_tile_of(q0)); f32x4 va[16], vb[16]; moe_tile_load(cur, va, F.wave, F.lane);
        for (int t = q0; t < NT; t += 2 * F.G) {
            const bool h1 = t + F.G < NT; MoeTile n1 = cur; if (h1) { n1 = moe_tile(F, moe_tile_of(t + F.G)); moe_tile_load(n1, vb, F.wave, F.lane); }
            moe_tile_store(F, cur, va);
            if (!h1) break;
            const bool h2 = t + 2 * F.G < NT; if (h2) { cur = moe_tile(F, moe_tile_of(t + 2 * F.G)); moe_tile_load(cur, va, F.wave, F.lane); }
            moe_tile_store(F, n1, vb);
            if (!h2) break; } }
}
__device__ __forceinline__ void phase_mod(Frame& F) {
    LAS float* sc = (LAS float*)F.lds;
    LAS float* red = (LAS float*)(F.lds + 9 * 1024 * 4);
    for (int i = F.tid; i < 9 * 1024; i += NTHREADS) { const int r = i >> 10, k = i & 1023; const float v = (r < 8) ? F.pa->in[I_C][r * 1024 + k] : F.pa->in[I_CCTX][k]; sc[i] = v / (1.0f + __expf(-v)); }
    __syncthreads();
    for (int strip = F.bid; strip < 2 * 6144 / 64; strip += F.G) {
        const int l = strip / 96, j = (strip % 96) * 64 + F.lane;
        const float* w = F.pa->in[I_WMOD] + (size_t)l * 1024 * 6144 + j;
        float a[9];
#pragma unroll
        for (int r = 0; r < 9; ++r) a[r] = 0.f;
        const int k0 = F.wave * 128;
#pragma unroll 1
        for (int kk = k0; kk < k0 + 128; kk += 16) { float wv[16];
#pragma unroll
            for (int i = 0; i < 16; ++i) wv[i] = w[(size_t)(kk + i) * 6144];
#pragma unroll
            for (int i = 0; i < 16; ++i) {
#pragma unroll
                for (int r = 0; r < 9; ++r) a[r] += sc[r * 1024 + kk + i] * wv[i];
                if ((i & 3) == 3) __builtin_amdgcn_sched_barrier(0); } }
#pragma unroll
        for (int r = 0; r < 9; ++r) red[(F.wave * 9 + r) * 64 + F.lane] = a[r];
        __syncthreads();
        for (int i = F.tid; i < 9 * 64; i += NTHREADS) { const int r = i >> 6, jj = i & 63; float s = 0.f;
#pragma unroll
            for (int w8 = 0; w8 < 8; ++w8) s += red[(w8 * 9 + r) * 64 + jj];
            const int col = (strip % 96) * 64 + jj; s += F.pa->in[I_BMOD][l * 6144 + col];
            if (r < 8) ((float*)(F.ws + WS_MODLAT))[((size_t)l * 8 + r) * 6144 + col] = s; else ((float*)(F.ws + WS_MODCTX))[(size_t)l * 6144 + col] = s; }
        __syncthreads();
    }
}

__device__ __forceinline__ void norm_row(const u32x2 (&xw)[4], const f32x4 (&Am)[4], const f32x4 (&Sh)[4], bf16_t* orow, int lane, f32x4 (&y)[4]) {
    f32x4 v[4]; float ss = 0.f;
#pragma unroll
    for (int j = 0; j < 4; ++j) { const u32x2 w = xw[j]; v[j] = (f32x4){bf2f(w.x & 0xffffu), __uint_as_float(w.x & 0xffff0000u), bf2f(w.y & 0xffffu), __uint_as_float(w.y & 0xffff0000u)};
        ss += (v[j].x * v[j].x + v[j].y * v[j].y) + (v[j].z * v[j].z + v[j].w * v[j].w); }
    const float rstd = 1.0f / sqrtf(wave_sum(ss) * (1.0f / D) + EPS);
    u32x2* o8 = (u32x2*)orow + lane;
#pragma unroll
    for (int j = 0; j < 4; ++j) { y[j] = (v[j] * rstd) * Am[j] + Sh[j]; o8[64 * j] = (u32x2){pk2(y[j].x, y[j].y), pk2(y[j].z, y[j].w)}; }
}
struct SlabRed { const float* slab; int S; const float* gate; const float* xold; float* xnew; };
__device__ __forceinline__ void norm_row_v(f32x4 (&v)[4], const float* g, const float* shift, const float* scale, bf16_t* orow, int lane) {
    float ss = 0.f;
#pragma unroll
    for (int j = 0; j < 4; ++j) ss += (v[j].x * v[j].x + v[j].y * v[j].y) + (v[j].z * v[j].z + v[j].w * v[j].w);
    const float rstd = 1.0f / sqrtf(wave_sum(ss) * (1.0f / D) + EPS);
    u32x2* o8 = (u32x2*)orow + lane;
#pragma unroll
    for (int j = 0; j < 4; ++j) { const f32x4 gg = ((const f32x4*)g)[lane + 64 * j], sh = ((const f32x4*)shift)[lane + 64 * j], sl = ((const f32x4*)scale)[lane + 64 * j];
        const f32x4 y = (v[j] * rstd) * gg * (sl + 1.0f) + sh;
        u32x2 w; w.x = pk2(y.x, y.y); w.y = pk2(y.z, y.w); o8[64 * j] = w; }
}
__device__ __forceinline__ void phase_norm(Frame& F, int l, int sel, const float* xlat, const bf16_t* xb, const float* xctx, int nrows, const SlabRed sr) {
    const int gw = F.bid * NWAVES + F.wave, NGW = F.G * NWAVES;
    const float* g = (sel ? F.pa->in[I_GFFN] : F.pa->in[I_GMIX]) + l * D; const int so = sel ? 3072 : 0;
    bf16_t* HX = (bf16_t*)(F.ws + WS_HX);
    const int nlat = nrows < NLAT ? nrows : NLAT; const int per = (nlat + NGW - 1) / NGW, r_lo = gw * per, r_hi = (r_lo + per < nlat) ? r_lo + per : nlat;
    int curb = -1; f32x4 Am[4], Sh[4];
    for (int row0 = r_lo; row0 < r_hi; row0 += 4) {
        f32x4 v[4][4];
#pragma unroll
        for (int u = 0; u < 4; ++u) { const int row = (row0 + u < r_hi) ? row0 + u : row0;
            if (xb) { const u32x2* xr = (const u32x2*)(xb + (size_t)row * D) + F.lane;
#pragma unroll
                for (int j = 0; j < 4; ++j) { const u32x2 w = xr[64 * j]; v[u][j] = (f32x4){bf2f(w.x & 0xffffu), __uint_as_float(w.x & 0xffff0000u), bf2f(w.y & 0xffffu), __uint_as_float(w.y & 0xffff0000u)}; } }
            else { const f32x4* xr = (const f32x4*)(xlat + (size_t)row * D) + F.lane;
#pragma unroll
                for (int j = 0; j < 4; ++j) v[u][j] = xr[64 * j]; } }
#pragma unroll
        for (int u = 0; u < 4; ++u) { const int row = row0 + u; if (row >= r_hi) continue;
            const int b = row / SEQ;
            if (b != curb) { curb = b; const float* mod = (const float*)(F.ws + WS_MODLAT) + ((size_t)l * 8 + b) * 6144 + so;
#pragma unroll
                for (int j = 0; j < 4; ++j) { Am[j] = ((const f32x4*)g)[F.lane + 64 * j] * (((const f32x4*)(mod + 1024))[F.lane + 64 * j] + 1.0f); Sh[j] = ((const f32x4*)mod)[F.lane + 64 * j]; } }
            float ss = 0.f;
#pragma unroll
            for (int j = 0; j < 4; ++j) ss += (v[u][j].x * v[u][j].x + v[u][j].y * v[u][j].y) + (v[u][j].z * v[u][j].z + v[u][j].w * v[u][j].w);
            const float rstd = 1.0f / sqrtf(wave_sum(ss) * (1.0f / D) + EPS);
            u32x2* o8 = (u32x2*)(HX + (size_t)row * D) + F.lane;
#pragma unroll
            for (int j = 0; j < 4; ++j) { const f32x4 y = (v[u][j] * rstd) * Am[j] + Sh[j]; o8[64 * j] = (u32x2){pk2(y.x, y.y), pk2(y.z, y.w)}; } }
    }
    for (int row = NLAT + gw; row < nrows; row += NGW) {
        const float* mod = (const float*)(F.ws + WS_MODCTX) + (size_t)l * 6144;
        f32x4 v[4];
        if (sr.slab == nullptr) { const f32x4* xr = (const f32x4*)(xctx + (size_t)(row - NLAT) * D) + F.lane;
#pragma unroll
            for (int j = 0; j < 4; ++j) v[j] = xr[64 * j]; }
        else { const int rc = row - NLAT, pmr = rc >> 8, r = rc & 255;
            f32x4 t8[4][8], xo[4];
#pragma unroll
            for (int j = 0; j < 4; ++j) { const float* sp = sr.slab + (size_t)((pmr + 8 * j) * sr.S) * 65536 + (size_t)r * 256 + 4 * F.lane;
#pragma unroll
                for (int q = 0; q < 8; ++q) t8[j][q] = *(const f32x4*)(sp + (size_t)(q < sr.S ? q : sr.S - 1) * 65536);
                xo[j] = ((const f32x4*)(sr.xold + (size_t)rc * D))[F.lane + 64 * j]; }
#pragma unroll
            for (int j = 0; j < 4; ++j) { f32x4 a = zero4();
#pragma unroll
                for (int q = 0; q < 8; ++q) a += t8[j][q] * (q < sr.S ? 1.0f : 0.0f);
                v[j] = xo[j] + ((const f32x4*)sr.gate)[F.lane + 64 * j] * a;
                ((f32x4*)(sr.xnew + (size_t)rc * D))[F.lane + 64 * j] = v[j]; } }
        norm_row_v(v, g, mod + so, mod + so + 1024, HX + (size_t)row * D, F.lane);
    }
}
__device__ __forceinline__ void moe_reduce(Frame& F, int k) {
    const int* meta = (const int*)(F.ws + MOE_META) + 9 * k; const int npan = meta[8], gsz = npan - 128;
    if (gsz <= 0) return;
    const int S = pg8::split_factor(npan * 4, F.G, DEXP / 64, MAXSLAB_M); if (S < 2) return;
    const int gw = F.bid * NWAVES + F.wave, NGW = F.G * NWAVES;
    const int* ptok = (const int*)(F.ws + MOE_PTOK) + k * MROWS; const float* pw = (const float*)(F.ws + MOE_PW) + k * MROWS;
    const float* slab = (const float*)(F.ws + WS_SLABM); const float* gate_lat = (const float*)(F.ws + WS_MODLAT) + (size_t)8 * 6144 + 5120;
    for (int rr = NLAT + gw; rr < npan * 256; rr += NGW) { const int tok = ptok[rr]; if (tok < 0) continue; const float w = pw[rr];
        const int pmr = (rr - NLAT) >> 8, r = rr & 255; u32x2* xr = (u32x2*)((bf16_t*)((char*)F.out + XB_OFF) + (size_t)tok * D); const f32x4* gt = (const f32x4*)(gate_lat + (size_t)(tok / SEQ) * 6144);
        f32x4 t8[4][8];
#pragma unroll
        for (int j = 0; j < 4; ++j) { const float* sp = slab + (size_t)((pmr + gsz * j) * S) * 65536 + (size_t)r * 256 + 4 * F.lane;
#pragma unroll
            for (int q = 0; q < 8; ++q) t8[j][q] = *(const f32x4*)(sp + (size_t)(q < S ? q : S - 1) * 65536); }
#pragma unroll
        for (int j = 0; j < 4; ++j) { f32x4 a = zero4();
#pragma unroll
            for (int q = 0; q < 8; ++q) a += t8[j][q] * (q < S ? 1.0f : 0.0f);
            const u32x2 xo = xr[F.lane + 64 * j]; const f32x4 xv = {bf2f(xo.x & 0xffffu), __uint_as_float(xo.x & 0xffff0000u), bf2f(xo.y & 0xffffu), __uint_as_float(xo.y & 0xffff0000u)};
            const f32x4 y = xv + (gt[F.lane + 64 * j] * w) * a; xr[F.lane + 64 * j] = (u32x2){pk2(y.x, y.y), pk2(y.z, y.w)}; } }
}
__device__ __forceinline__ void phase_norm_router(Frame& F, const bf16_t* xb) {
    constexpr int l = 1;
    LAS float* wr = (LAS float*)F.lds;
    LAS int* le = (LAS int*)(F.lds + 32768);
    for (int i = F.tid; i < 1024 * 8 / 4; i += NTHREADS) ((LAS f32x4*)wr)[i] = ((const f32x4*)F.pa->in[I_MROUTER])[i];
    __syncthreads();
    const float* g = F.pa->in[I_GFFN] + l * D; bf16_t* HX = (bf16_t*)(F.ws + WS_HX);
    int* toke = (int*)(F.ws + MOE_TOKE); float* tokw = (float*)(F.ws + MOE_TOKW);
    for (int wg = F.bid; wg < NLAT / 128; wg += F.G) {
        u32x2 nx[4]; f32x4 Am[4], Sh[4];
        { const float* mod = (const float*)(F.ws + WS_MODLAT) + ((size_t)l * 8 + (wg * 128) / SEQ) * 6144 + 3072;
#pragma unroll
          for (int j = 0; j < 4; ++j) { Am[j] = ((const f32x4*)g)[F.lane + 64 * j] * (((const f32x4*)(mod + 1024))[F.lane + 64 * j] + 1.0f); Sh[j] = ((const f32x4*)mod)[F.lane + 64 * j]; } }
        { const u32x2* xr = (const u32x2*)(xb + (size_t)(wg * 128 + F.wave * 16) * D) + F.lane;
#pragma unroll
          for (int j = 0; j < 4; ++j) nx[j] = xr[64 * j]; }
        for (int i = 0; i < 16; ++i) { const int tl = F.wave * 16 + i, row = wg * 128 + tl;
            u32x2 cx[4];
#pragma unroll
            for (int j = 0; j < 4; ++j) cx[j] = nx[j];
            { const int rn = (i < 15) ? row + 1 : row; const u32x2* xr = (const u32x2*)(xb + (size_t)rn * D) + F.lane;
#pragma unroll
              for (int j = 0; j < 4; ++j) nx[j] = xr[64 * j]; }
            f32x4 y[4]; norm_row(cx, Am, Sh, HX + (size_t)row * D, F.lane, y);
            float lg[8];
#pragma unroll
            for (int e = 0; e < 8; ++e) lg[e] = 0.f;
#pragma unroll
            for (int j = 0; j < 4; ++j)
#pragma unroll
                for (int q = 0; q < 4; ++q) { const int k = 4 * F.lane + 256 * j + q; const f32x4 w0 = *(const LAS f32x4*)(wr + k * 8), w1 = *(const LAS f32x4*)(wr + k * 8 + 4); const float yv = y[j][q];
                    lg[0] += yv * w0.x; lg[1] += yv * w0.y; lg[2] += yv * w0.z; lg[3] += yv * w0.w; lg[4] += yv * w1.x; lg[5] += yv * w1.y; lg[6] += yv * w1.z; lg[7] += yv * w1.w; }
#pragma unroll
            for (int e = 0; e < 8; ++e) lg[e] = wave_sum(lg[e]) + F.pa->in[I_MROUTERB][e];
            int e0 = 0; float v0 = lg[0];
#pragma unroll
            for (int e = 1; e < 8; ++e) if (lg[e] > v0) { v0 = lg[e]; e0 = e; }
            int e1 = -1; float v1 = -3.0e38f;
#pragma unroll
            for (int e = 0; e < 8; ++e) if (e != e0 && lg[e] > v1) { v1 = lg[e]; e1 = e; }
            const float w0 = 1.0f / (1.0f + __expf(v1 - v0));
            if (F.lane == 0) { toke[row] = e0 | (e1 << 8); tokw[2 * row] = w0; tokw[2 * row + 1] = 1.0f - w0; le[tl] = e0 | (e1 << 8); }
        }
        __syncthreads();
        if (F.tid < 16) { const int k = F.tid >> 3, e = F.tid & 7; int c = 0; for (int t = 0; t < 128; ++t) c += (((le[t] >> (8 * k)) & 0xff) == e) ? 1 : 0; ((int*)(F.ws + MOE_CNT))[wg * 16 + F.tid] = c; }
        __syncthreads();
    }
}
__device__ __forceinline__ void phase_moe_sort(Frame& F) {
    LAS int* tot = (LAS int*)F.lds;
    LAS int* pre = tot + 16;
    LAS int* seg = tot + 32;
    LAS int* le = tot + 64;
    const int* cnt = (const int*)(F.ws + MOE_CNT); const int* toke = (const int*)(F.ws + MOE_TOKE); const float* tokw = (const float*)(F.ws + MOE_TOKW);
    int* ptok = (int*)(F.ws + MOE_PTOK); float* pw = (float*)(F.ws + MOE_PW); int* meta = (int*)(F.ws + MOE_META);
    for (int wg = F.bid; wg < NLAT / 128; wg += F.G) {
        { LAS int* part = tot + 256;
          if (F.tid < 256) { const int col = F.tid & 15, pt = F.tid >> 4; int t = 0, p = 0;
#pragma unroll
              for (int i = 0; i < 16; ++i) { const int w = pt * 16 + i; const int c = cnt[w * 16 + col]; t += c; p += (w < wg) ? c : 0; }
              part[pt * 16 + col] = t; part[256 + pt * 16 + col] = p; }
          if (F.tid >= 256 && F.tid < 384) le[F.tid - 256] = toke[wg * 128 + F.tid - 256];
          __syncthreads();
          if (F.tid < 16) { int t = 0, p = 0;
#pragma unroll
              for (int pt = 0; pt < 16; ++pt) { t += part[pt * 16 + F.tid]; p += part[256 + pt * 16 + F.tid]; }
              tot[F.tid] = t; pre[F.tid] = p; } }
        __syncthreads();
        if (F.tid < 2) { int s = 0; for (int e = 0; e < 8; ++e) { seg[F.tid * 9 + e] = s; s += (tot[F.tid * 8 + e] + 255) & ~255; } seg[F.tid * 9 + 8] = s; }
        __syncthreads();
        if (F.tid < 256) { const int k = F.tid >> 7, t = F.tid & 127; const int e = (le[t] >> (8 * k)) & 0xff; int rank = 0; for (int u = 0; u < t; ++u) rank += (((le[u] >> (8 * k)) & 0xff) == e) ? 1 : 0;
            const int pos = seg[k * 9 + e] + pre[k * 8 + e] + rank; const int tok = wg * 128 + t; ptok[k * MROWS + pos] = tok; pw[k * MROWS + pos] = tokw[2 * tok + k]; ((int*)(F.ws + MOE_PPOS))[k * NLAT + tok] = pos; }
        if (wg < 16) { const int k = wg >> 3, e = wg & 7; const int a = seg[k * 9 + e] + tot[k * 8 + e], b = seg[k * 9 + e + 1]; for (int p = a + F.tid; p < b; p += NTHREADS) { ptok[k * MROWS + p] = -1; pw[k * MROWS + p] = 0.f; } }
        if (wg == 0 && F.tid < 18) meta[F.tid] = seg[F.tid] >> 8;
        __syncthreads();
    }
}
__device__ __forceinline__ void phase_final_a(Frame& F) {
    const int gw = F.bid * NWAVES + F.wave, NGW = F.G * NWAVES; const float* g = F.pa->in[I_GFINAL];
    const bf16_t* xb = (const bf16_t*)((const char*)F.out + XB_OFF); bf16_t* xc = (bf16_t*)(F.ws + WS_XCOPY);
    const int* meta = (const int*)(F.ws + MOE_META) + 9; const int npan = meta[8], gsz = npan - 128;
    const int S = (gsz > 0) ? pg8::split_factor(npan * 4, F.G, DEXP / 64, MAXSLAB_M) : 1;
    const int* ppos = (const int*)(F.ws + MOE_PPOS) + NLAT; const float* pw = (const float*)(F.ws + MOE_PW) + MROWS;
    const float* slab = (const float*)(F.ws + WS_SLABM); const float* gate_lat = (const float*)(F.ws + WS_MODLAT) + (size_t)8 * 6144 + 5120;
    for (int row0 = gw; row0 < NLAT; row0 += 4 * NGW) {
        u32x2 w[4][4]; int rr[4];
#pragma unroll
        for (int u = 0; u < 4; ++u) { const int row = (row0 + u * NGW < NLAT) ? row0 + u * NGW : row0; const u32x2* xr = (const u32x2*)(xb + (size_t)row * D) + F.lane; rr[u] = ppos[row];
#pragma unroll
            for (int j = 0; j < 4; ++j) w[u][j] = xr[64 * j]; }
#pragma unroll
        for (int u = 0; u < 4; ++u) { const int row = row0 + u * NGW; if (row >= NLAT) continue;
            f32x4 v[4];
#pragma unroll
            for (int j = 0; j < 4; ++j) v[j] = (f32x4){bf2f(w[u][j].x & 0xffffu), __uint_as_float(w[u][j].x & 0xffff0000u), bf2f(w[u][j].y & 0xffffu), __uint_as_float(w[u][j].y & 0xffff0000u)};
            if (S >= 2 && rr[u] >= NLAT) { const float wt = pw[rr[u]]; const int pmr = (rr[u] - NLAT) >> 8, r = rr[u] & 255; const f32x4* gt = (const f32x4*)(gate_lat + (size_t)(row / SEQ) * 6144);
#pragma unroll
                for (int j = 0; j < 4; ++j) { f32x4 a = zero4(); const float* sp = slab + (size_t)((pmr + gsz * j) * S) * 65536 + (size_t)r * 256 + 4 * F.lane;
                    { f32x4 t8[8];
#pragma unroll
                      for (int q = 0; q < 8; ++q) t8[q] = *(const f32x4*)(sp + (size_t)(q < S ? q : S - 1) * 65536);
#pragma unroll
                      for (int q = 0; q < 8; ++q) a += t8[q] * (q < S ? 1.0f : 0.0f); }
                    v[j] += (gt[F.lane + 64 * j] * wt) * a; } }
            if (row < NLAT / 2) { float ss = 0.f;
#pragma unroll
                for (int j = 0; j < 4; ++j) ss += (v[j].x * v[j].x + v[j].y * v[j].y) + (v[j].z * v[j].z + v[j].w * v[j].w);
                const float rstd = 1.0f / sqrtf(wave_sum(ss) * (1.0f / D) + EPS); f32x4* o = (f32x4*)(F.out + (size_t)row * D) + F.lane;
#pragma unroll
                for (int j = 0; j < 4; ++j) o[64 * j] = (v[j] * rstd) * ((const f32x4*)g)[F.lane + 64 * j]; }
            else { u32x2* o = (u32x2*)(xc + (size_t)(row - NLAT / 2) * D) + F.lane;
#pragma unroll
                for (int j = 0; j < 4; ++j) o[64 * j] = (u32x2){pk2(v[j].x, v[j].y), pk2(v[j].z, v[j].w)}; } }
    }
}
__device__ __forceinline__ void phase_final_b(Frame& F) {
    const int gw = F.bid * NWAVES + F.wave, NGW = F.G * NWAVES; const float* g = F.pa->in[I_GFINAL]; const bf16_t* xc = (const bf16_t*)(F.ws + WS_XCOPY);
    for (int row0 = NLAT / 2 + gw; row0 < NLAT; row0 += 4 * NGW) {
        u32x2 w[4][4];
#pragma unroll
        for (int u = 0; u < 4; ++u) { const int row = (row0 + u * NGW < NLAT) ? row0 + u * NGW : row0; const u32x2* xr = (const u32x2*)(xc + (size_t)(row - NLAT / 2) * D) + F.lane;
#pragma unroll
            for (int j = 0; j < 4; ++j) w[u][j] = xr[64 * j]; }
#pragma unroll
        for (int u = 0; u < 4; ++u) { const int row = row0 + u * NGW; if (row >= NLAT) continue;
            f32x4 v[4]; float ss = 0.f;
#pragma unroll
            for (int j = 0; j < 4; ++j) { v[j] = (f32x4){bf2f(w[u][j].x & 0xffffu), __uint_as_float(w[u][j].x & 0xffff0000u), bf2f(w[u][j].y & 0xffffu), __uint_as_float(w[u][j].y & 0xffff0000u)};
                ss += (v[j].x * v[j].x + v[j].y * v[j].y) + (v[j].z * v[j].z + v[j].w * v[j].w); }
            const float rstd = 1.0f / sqrtf(wave_sum(ss) * (1.0f / D) + EPS); f32x4* o = (f32x4*)(F.out + (size_t)row * D) + F.lane;
#pragma unroll
            for (int j = 0; j < 4; ++j) o[64 * j] = (v[j] * rstd) * ((const f32x4*)g)[F.lane + 64 * j]; }
    }
}

__device__ __forceinline__ bool fresh(Frame& F) {
    int l_ = (int)__builtin_amdgcn_mbcnt_hi(~0u, __builtin_amdgcn_mbcnt_lo(~0u, 0u)); asm volatile("" : "+v"(l_));
    int w_ = F.wave0; asm volatile("" : "+s"(w_));
    F.lane = l_; F.wave = w_; F.tid = w_ * 64 + l_;
    int b_ = blockIdx.x; asm volatile("" : "+s"(b_)); F.bid = b_;
    GAS unsigned char* w2_ = (GAS unsigned char*)F.ws0; asm volatile("" : "+s"(w2_)); F.ws = (unsigned char*)w2_;
    F.out = F.out0; F.pa = F.pa0;
    return true;
}
struct Item { int b, s, row0, seqbase, t0, seqlen; bool is_ctx; };
__device__ __forceinline__ Item item_info(int item) {
    Item it; it.b = item / SPB; it.s = item % SPB;
    if (it.s < 2) { it.is_ctx = true; it.seqbase = NLAT + it.b * CTXL; it.t0 = it.s * CHK; it.seqlen = CTXL; }
    else { it.is_ctx = false; it.seqbase = it.b * SEQ; it.t0 = (it.s - 2) * CHK; it.seqlen = SEQ; }
    it.row0 = it.seqbase + it.t0; return it;
}
constexpr int UCP = 144;
constexpr int TP = 272;
constexpr int TILEB = 128 * TP;
constexpr int VP = 288;
constexpr int TILEV = 128 * VP;

__device__ __forceinline__ unsigned tr_lane_addr(ldsp_t tile, int lane) { return (unsigned)(__SIZE_TYPE__)tile + (unsigned)((4 * (lane >> 4) + ((lane & 15) >> 2)) * VP + 8 * (lane & 3)); }
__device__ __forceinline__ bf16x8 mk_frag(u32x2 lo, u32x2 hi) { const u32x4 v = {lo.x, lo.y, hi.x, hi.y}; return __builtin_bit_cast(bf16x8, v); }
template <int OFF> __device__ __forceinline__ bf16x8 tr1(unsigned addr) {
    u32x2 a0, a1;
    asm volatile("ds_read_b64_tr_b16 %0, %2 offset:%3\n\tds_read_b64_tr_b16 %1, %2 offset:%4\n\ts_waitcnt lgkmcnt(0)" : "=&v"(a0), "=&v"(a1) : "v"(addr), "i"(OFF), "i"(OFF + 16 * VP) : "memory");
    return mk_frag(a0, a1);
}
template <int OFF> __device__ __forceinline__ void tr4(unsigned addr, bf16x8& f0, bf16x8& f1, bf16x8& f2, bf16x8& f3) {
    u32x2 a0, a1, b0, b1, c0, c1, d0, d1;
    asm volatile("ds_read_b64_tr_b16 %0, %8 offset:%9\n\tds_read_b64_tr_b16 %1, %8 offset:%10\n\tds_read_b64_tr_b16 %2, %8 offset:%11\n\tds_read_b64_tr_b16 %3, %8 offset:%12\n\t"
                 "ds_read_b64_tr_b16 %4, %8 offset:%13\n\tds_read_b64_tr_b16 %5, %8 offset:%14\n\tds_read_b64_tr_b16 %6, %8 offset:%15\n\tds_read_b64_tr_b16 %7, %8 offset:%16\n\ts_waitcnt lgkmcnt(0)"
                 : "=&v"(a0), "=&v"(a1), "=&v"(b0), "=&v"(b1), "=&v"(c0), "=&v"(c1), "=&v"(d0), "=&v"(d1)
                 : "v"(addr), "i"(OFF), "i"(OFF + 16 * VP), "i"(OFF + 32), "i"(OFF + 32 + 16 * VP), "i"(OFF + 64), "i"(OFF + 64 + 16 * VP), "i"(OFF + 96), "i"(OFF + 96 + 16 * VP) : "memory");
    f0 = mk_frag(a0, a1); f1 = mk_frag(b0, b1); f2 = mk_frag(c0, c1); f3 = mk_frag(d0, d1);
}

__device__ __forceinline__ void build_decay(Frame& F, int l) {
    LAS float* dec = (LAS float*)(F.lds + LDS_DEC);
    for (int i = F.tid; i < 2 * 4 * 132; i += NTHREADS) { const int n = i % 132, dh = i / 132; const float x = F.pa->in[I_RETDEC][l * 8 + dh]; const float lg = -log1pf(expf(-x)); dec[i] = expf((float)n * lg); }
}

struct RgStep { bf16x8 bwa[2], bwx[2]; float lam, ba, bx, carry; };
template <bool FINAL>
__device__ __forceinline__ void rg_load_step(RgStep& R, Frame& F, const bf16_t* wgt, int l, int dir, int item, int blk, int n, int lane) {
    const int fr = lane & 15, fq = lane >> 4;
    const bf16_t* wa = wgt + ((size_t)(0 * 8 + blk) * 64 + 16 * n + fr) * 64 + 8 * fq;
    const bf16_t* wx = wgt + ((size_t)(1 * 8 + blk) * 64 + 16 * n + fr) * 64 + 8 * fq;
    R.bwa[0] = *(const bf16x8*)wa; R.bwa[1] = *(const bf16x8*)(wa + 32); R.bwx[0] = *(const bf16x8*)wx; R.bwx[1] = *(const bf16x8*)(wx + 32);
    const int ch = blk * 64 + 16 * n + fr, pi = (l * 2 + dir) * 512 + ch;
    R.lam = F.pa->in[I_RGLAM][pi]; R.ba = F.pa->in[I_RGBA][pi]; R.bx = F.pa->in[I_RGBX][pi];
    R.carry = FINAL ? ((const float*)(F.ws + WS_CARRY))[((size_t)item * 2 + dir) * 512 + ch] : 0.f;
}
template <bool FINAL, int DIR>
__device__ __forceinline__ void rg_dir(ldsp_t ucw, const bf16x8 (&af)[8][2], const RgStep& R, int n, int lane, f32x4 (&hsum)[8], float& Atot, float& Htot) {
    const int fr = lane & 15, fq = lane >> 4;
    constexpr float L2E_ = 1.4426950408889634f;
    const float ba2 = -L2E_ * R.ba, bx2 = -L2E_ * R.bx, cl2 = -8.0f * L2E_ * log1pf(expf(-R.lam)), carry = R.carry;
    const bf16x8 bwa[2] = {R.bwa[0], R.bwa[1]}, bwx[2] = {R.bwx[0], R.bwx[1]};
    f32x4 ar[8], ai[8];
#pragma unroll
    for (int m = 0; m < 8; ++m) { ar[m] = zero4(); ai[m] = zero4(); }
#pragma unroll
    for (int m = 0; m < 8; ++m)
#pragma unroll
        for (int ks = 0; ks < 2; ++ks) { ar[m] = __builtin_amdgcn_mfma_f32_16x16x32_bf16(af[m][ks], bwa[ks], ar[m], 0, 0, 0); ai[m] = __builtin_amdgcn_mfma_f32_16x16x32_bf16(af[m][ks], bwx[ks], ai[m], 0, 0, 0); }
    const unsigned uo = (unsigned)(32 * fq * UCP + (16 * n + fr) * 2);
#pragma unroll
    for (int m = 0; m < 8; ++m)
#pragma unroll
        for (int jj = 0; jj < 4; ++jj) {
            const float r = __builtin_amdgcn_rcpf(1.0f + __builtin_amdgcn_exp2f(__builtin_fmaf(ar[m][jj], -1.4426950408889634f, ba2)));
            const float ig = __builtin_amdgcn_rcpf(1.0f + __builtin_amdgcn_exp2f(__builtin_fmaf(ai[m][jj], -1.4426950408889634f, bx2)));
            const float a = __builtin_amdgcn_exp2f(cl2 * r);
            const float u = bf2f(*(const LAS bf16_t*)(ucw + uo + (4 * m + jj) * UCP));
            ar[m][jj] = a; ai[m][jj] = __builtin_amdgcn_sqrtf(__builtin_fmaf(-a, a, 1.0f)) * ig * u; }
    float gA = 1.f, gH = 0.f;
#pragma unroll
    for (int mm = 0; mm < 8; ++mm) { const int m = DIR ? 7 - mm : mm;
#pragma unroll
        for (int j4 = 0; j4 < 4; ++j4) { const int jj = DIR ? 3 - j4 : j4; gH = __builtin_fmaf(ar[m][jj], gH, ai[m][jj]); gA *= ar[m][jj]; } }
    const float A0 = lane_bcast(gA, fr), H0 = lane_bcast(gH, fr), A1 = lane_bcast(gA, fr + 16), H1 = lane_bcast(gH, fr + 16), A2 = lane_bcast(gA, fr + 32), H2 = lane_bcast(gH, fr + 32), A3 = lane_bcast(gA, fr + 48), H3 = lane_bcast(gH, fr + 48);
    if (FINAL) { float h = carry;
        if (!DIR) { if (fq > 0) h = A0 * h + H0; if (fq > 1) h = A1 * h + H1; if (fq > 2) h = A2 * h + H2; }
        else { if (fq < 3) h = A3 * h + H3; if (fq < 2) h = A2 * h + H2; if (fq < 1) h = A1 * h + H1; }
#pragma unroll
        for (int mm = 0; mm < 8; ++mm) { const int m = DIR ? 7 - mm : mm;
#pragma unroll
            for (int j4 = 0; j4 < 4; ++j4) { const int jj = DIR ? 3 - j4 : j4; h = __builtin_fmaf(ar[m][jj], h, ai[m][jj]); hsum[m][jj] += h; } } }
    if (!DIR) Htot = A3 * (A2 * (A1 * H0 + H1) + H2) + H3; else Htot = A0 * (A1 * (A2 * H3 + H2) + H1) + H0;
    Atot = (A0 * A1) * (A2 * A3);
}
template <bool FINAL, bool SHARED = false>
__device__ __forceinline__ void rg_part(Frame& F, int l, int item, const Item& it, const int blk, const int n0, const int n1) {
    const bf16_t* P = (const bf16_t*)(F.ws + WS_PA);
    int lane = F.lane; const bool act = !SHARED || F.wave < 4;
    ldsp_t ucw = SHARED ? F.lds : F.lds + F.wave * (128 * UCP);
    if (act) { constexpr int NT = SHARED ? 4 : 16;
      const int grp = lane & 7, ch0 = blk * 64 + grp * 8, tok0 = (SHARED ? 32 * F.wave : 0) + (lane >> 3) * NT; float cw[4][8], cb[8];
#pragma unroll
      for (int k = 0; k < 4; ++k)
#pragma unroll
          for (int i = 0; i < 8; ++i) cw[k][i] = F.pa->in[I_CONVW][((size_t)l * 4 + k) * 512 + ch0 + i];
#pragma unroll
      for (int i = 0; i < 8; ++i) cb[i] = F.pa->in[I_CONVB][l * 512 + ch0 + i];
      const bf16_t* Pu = P + (size_t)it.seqbase * INW + ch0;
      u32x4 rv[NT + 3];
#pragma unroll
      for (int r = 0; r < NT + 3; ++r) { const int tt = it.t0 + tok0 + r - 2; const int tc = tt < 0 ? 0 : (tt >= it.seqlen ? it.seqlen - 1 : tt);
          rv[r] = ldg<u32x4>(Pu, (unsigned)tc * (unsigned)(INW * 2)); if (tt != tc) rv[r] = (u32x4){0u, 0u, 0u, 0u}; }
      float win[4][8];
#pragma unroll
      for (int r = 0; r < 3; ++r) { win[r][0] = bf2f(rv[r].x & 0xffffu); win[r][1] = __uint_as_float(rv[r].x & 0xffff0000u); win[r][2] = bf2f(rv[r].y & 0xffffu); win[r][3] = __uint_as_float(rv[r].y & 0xffff0000u);
          win[r][4] = bf2f(rv[r].z & 0xffffu); win[r][5] = __uint_as_float(rv[r].z & 0xffff0000u); win[r][6] = bf2f(rv[r].w & 0xffffu); win[r][7] = __uint_as_float(rv[r].w & 0xffff0000u); }
#pragma unroll
      for (int j = 0; j < NT; ++j) { const int r = j + 3, s3 = (j + 3) & 3;
          win[s3][0] = bf2f(rv[r].x & 0xffffu); win[s3][1] = __uint_as_float(rv[r].x & 0xffff0000u); win[s3][2] = bf2f(rv[r].y & 0xffffu); win[s3][3] = __uint_as_float(rv[r].y & 0xffff0000u);
          win[s3][4] = bf2f(rv[r].z & 0xffffu); win[s3][5] = __uint_as_float(rv[r].z & 0xffff0000u); win[s3][6] = bf2f(rv[r].w & 0xffffu); win[s3][7] = __uint_as_float(rv[r].w & 0xffff0000u);
          float o[8];
#pragma unroll
          for (int i = 0; i < 8; ++i) o[i] = cb[i] + cw[0][i] * win[j & 3][i] + cw[1][i] * win[(j + 1) & 3][i] + cw[2][i] * win[(j + 2) & 3][i] + cw[3][i] * win[s3][i];
          u32x4 w; w.x = pk2(o[0], o[1]); w.y = pk2(o[2], o[3]); w.z = pk2(o[4], o[5]); w.w = pk2(o[6], o[7]);
          *(LAS u32x4*)(ucw + (tok0 + j) * UCP + grp * 16) = w; }
      LDS_WAIT(); asm volatile("" ::: "memory"); }
    if (SHARED) __syncthreads();
    asm volatile("" : "+v"(lane));
    bf16x8 af[8][2];
    if (act) { const int fr = lane & 15, fq = lane >> 4;
#pragma unroll
      for (int m = 0; m < 8; ++m)
#pragma unroll
          for (int ks = 0; ks < 2; ++ks) af[m][ks] = *(const LAS bf16x8*)(ucw + (32 * (fr >> 2) + 4 * m + (fr & 3)) * UCP + (8 * fq + 32 * ks) * 2); }
    if (SHARED) { __syncthreads(); if (!act) return; }
    const bf16_t* wg0 = (const bf16_t*)(F.ws + WS_RGW) + (size_t)(l * 2 + 0) * 2 * 8 * 4096;
    const bf16_t* wg1 = (const bf16_t*)(F.ws + WS_RGW) + (size_t)(l * 2 + 1) * 2 * 8 * 4096;
    float* TOT = (float*)(F.ws + WS_TOT);
    RgStep R0, R1;
    rg_load_step<FINAL>(R0, F, wg0, l, 0, item, blk, n0, lane);
#pragma unroll 1
    for (int n = n0; n < n1; ++n) { asm volatile("" : "+v"(lane));
        const int fr = lane & 15, fq = lane >> 4; const int ch = blk * 64 + 16 * n + fr;
        f32x4 hsum[8];
#pragma unroll
        for (int m = 0; m < 8; ++m) hsum[m] = zero4();
        rg_load_step<FINAL>(R1, F, wg1, l, 1, item, blk, n, lane);
        { float At, Ht;
          rg_dir<FINAL, 0>(ucw, af, R0, n, lane, hsum, At, Ht);
          if (!FINAL && fq == 0) { *(f32x2*)(TOT + (((size_t)item * 2 + 0) * 512 + ch) * 2) = (f32x2){At, Ht}; } }
        __builtin_amdgcn_sched_barrier(0);
        if (n + 1 < n1) rg_load_step<FINAL>(R0, F, wg0, l, 0, item, blk, n + 1, lane);
        { float At, Ht;
          rg_dir<FINAL, 1>(ucw, af, R1, n, lane, hsum, At, Ht);
          if (!FINAL && fq == 0) { *(f32x2*)(TOT + (((size_t)item * 2 + 1) * 512 + ch) * 2) = (f32x2){At, Ht}; } }
        if (FINAL) {
            const unsigned uo = (unsigned)(32 * fq * UCP + (16 * n + fr) * 2);
#pragma unroll
            for (int m = 0; m < 8; ++m)
#pragma unroll
                for (int jj = 0; jj < 4; ++jj) *(LAS bf16_t*)(ucw + uo + (4 * m + jj) * UCP) = (bf16_t)f2bf(hsum[m][jj]); }
    }
    if (FINAL) {
        LDS_WAIT(); asm volatile("" : "+v"(lane) :: "memory");
        const int ng = 2 * (n1 - n0);
        const int grp = 2 * n0 + ((ng == 8) ? (lane & 7) : (lane & 1)); const int tk0 = (ng == 8) ? (lane >> 3) : (lane >> 1), tstep = (ng == 8) ? 8 : 32, nq = (ng == 8) ? 16 : 4;
        const bf16_t* Pg = P + (size_t)it.row0 * INW + 512 + blk * 64 + grp * 8; bf16_t* Yo = (bf16_t*)(F.ws + WS_Y) + (size_t)it.row0 * D + blk * 64 + grp * 8;
#pragma unroll 8
        for (int q = 0; q < nq; ++q) { const int token = tk0 + tstep * q;
            const u32x4 hv = *(const LAS u32x4*)(ucw + token * UCP + grp * 16); const u32x4 gv = ldg<u32x4>(Pg, (unsigned)token * (unsigned)(INW * 2));
            u32x4 w;
            w.x = pk2(gelu_tanh(bf2f(gv.x & 0xffffu)) * bf2f(hv.x & 0xffffu), gelu_tanh(__uint_as_float(gv.x & 0xffff0000u)) * __uint_as_float(hv.x & 0xffff0000u));
            w.y = pk2(gelu_tanh(bf2f(gv.y & 0xffffu)) * bf2f(hv.y & 0xffffu), gelu_tanh(__uint_as_float(gv.y & 0xffff0000u)) * __uint_as_float(hv.y & 0xffff0000u));
            w.z = pk2(gelu_tanh(bf2f(gv.z & 0xffffu)) * bf2f(hv.z & 0xffffu), gelu_tanh(__uint_as_float(gv.z & 0xffff0000u)) * __uint_as_float(hv.z & 0xffff0000u));
            w.w = pk2(gelu_tanh(bf2f(gv.w & 0xffffu)) * bf2f(hv.w & 0xffffu), gelu_tanh(__uint_as_float(gv.w & 0xffff0000u)) * __uint_as_float(hv.w & 0xffff0000u));
            stg<u32x4>(Yo, (unsigned)token * (unsigned)(D * 2), w); }
        LDS_WAIT();
    }
}

struct KvRegs { u32x4 klo[2], khi[2], v[4]; };
__device__ __forceinline__ void kv_issue(Frame& F, KvRegs& R, const Item& it, int h) {
    const bf16_t* P = (const bf16_t*)(F.ws + WS_PA);
    const bf16_t* Pk = P + (size_t)it.row0 * INW + 1536 + h * HD; const bf16_t* Pv = P + (size_t)it.row0 * INW + 2048 + h * HD;
#pragma unroll
    for (int t2 = 0; t2 < 2; ++t2) { const int task = F.tid + t2 * NTHREADS, token = task >> 3, d0 = (task & 7) * 8;
        R.klo[t2] = ldg<u32x4>(Pk, (unsigned)(token * INW + d0) * 2u); R.khi[t2] = ldg<u32x4>(Pk, (unsigned)(token * INW + d0 + 64) * 2u); }
#pragma unroll
    for (int t4 = 0; t4 < 4; ++t4) { const int task = F.tid + t4 * NTHREADS, token = task >> 4, d0 = (task & 15) * 8; R.v[t4] = ldg<u32x4>(Pv, (unsigned)(token * INW + d0) * 2u); }
}
template <int KS> __device__ __forceinline__ void kv_step(unsigned aK, unsigned aVf, unsigned aVb, f32x4 (&accf)[8], f32x4 (&accb)[8]) {
    const bf16x8 af = tr1<KS * 32 * VP>(aVf), ab = tr1<KS * 32 * VP>(aVb);
    bf16x8 b[8];
    tr4<KS * 32 * VP>(aK, b[0], b[1], b[2], b[3]); tr4<KS * 32 * VP + 128>(aK, b[4], b[5], b[6], b[7]);
#pragma unroll
    for (int n = 0; n < 8; ++n) { accf[n] = __builtin_amdgcn_mfma_f32_16x16x32_bf16(af, b[n], accf[n], 0, 0, 0); accb[n] = __builtin_amdgcn_mfma_f32_16x16x32_bf16(ab, b[n], accb[n], 0, 0, 0); }
}
__device__ __forceinline__ void stage_state_t(Frame& F, ldsp_t dst, const bf16_t* St) {
#pragma unroll
    for (int t4 = 0; t4 < 4; ++t4) { const int task = F.tid + t4 * NTHREADS, e = task >> 4, c8 = task & 15;
        *(LAS u32x4*)(dst + e * TP + c8 * 16) = ldg<u32x4>(St, (unsigned)(e * 128 + c8 * 8) * 2u); }
}
__device__ __forceinline__ void mm16x128(ldsp_t At, int ra0, ldsp_t Bt, int lane, f32x4 (&acc)[8]) {
    const int fr = lane & 15, fq = lane >> 4;
#pragma unroll
    for (int ks = 0; ks < 4; ++ks) { const bf16x8 a = *(const LAS bf16x8*)(At + (ra0 + fr) * TP + (32 * ks + 8 * fq) * 2);
#pragma unroll
        for (int n = 0; n < 8; ++n) { const bf16x8 b = *(const LAS bf16x8*)(Bt + (16 * n + fr) * TP + (32 * ks + 8 * fq) * 2); acc[n] = __builtin_amdgcn_mfma_f32_16x16x32_bf16(a, b, acc[n], 0, 0, 0); } }
}

__device__ __forceinline__ void kv_head(Frame& F, KvRegs& R, KvRegs& Rn, bool pre, int item, const Item& it, int h) {
    bf16_t* KV = (bf16_t*)(F.ws + WS_KV);
    const LAS float* dec = (const LAS float*)(F.lds + LDS_DEC);
    ldsp_t tK = F.lds, tVf = F.lds + TILEV, tVb = F.lds + 2 * TILEV;
#pragma unroll
    for (int t2 = 0; t2 < 2; ++t2) { const int task = F.tid + t2 * NTHREADS, token = task >> 3, d0 = (task & 7) * 8;
        *(LAS u32x4*)(tK + token * VP + d0 * 2) = R.klo[t2]; *(LAS u32x4*)(tK + token * VP + (d0 + 64) * 2) = R.khi[t2]; }
#pragma unroll
    for (int t4 = 0; t4 < 4; ++t4) { const int task = F.tid + t4 * NTHREADS, token = task >> 4, d0 = (task & 15) * 8; const u32x4 v = R.v[t4];
        const float df = dec[(0 * 4 + h) * 132 + 127 - token], db = dec[(1 * 4 + h) * 132 + token];
        const float x[8] = {bf2f(v.x & 0xffffu), __uint_as_float(v.x & 0xffff0000u), bf2f(v.y & 0xffffu), __uint_as_float(v.y & 0xffff0000u), bf2f(v.z & 0xffffu), __uint_as_float(v.z & 0xffff0000u), bf2f(v.w & 0xffffu), __uint_as_float(v.w & 0xffff0000u)};
        u32x4 wf, wb; wf.x = pk2(x[0] * df, x[1] * df); wf.y = pk2(x[2] * df, x[3] * df); wf.z = pk2(x[4] * df, x[5] * df); wf.w = pk2(x[6] * df, x[7] * df);
        wb.x = pk2(x[0] * db, x[1] * db); wb.y = pk2(x[2] * db, x[3] * db); wb.z = pk2(x[4] * db, x[5] * db); wb.w = pk2(x[6] * db, x[7] * db);
        *(LAS u32x4*)(tVf + token * VP + d0 * 2) = wf; *(LAS u32x4*)(tVb + token * VP + d0 * 2) = wb; }
    WG_BAR_LDS();
    if (pre) kv_issue(F, Rn, it, h + 1);
    f32x4 af[8], ab[8];
#pragma unroll
    for (int n = 0; n < 8; ++n) { af[n] = zero4(); ab[n] = zero4(); }
    { const unsigned aK = tr_lane_addr(tK, F.lane), aVf = tr_lane_addr(tVf, F.lane) + 32u * (unsigned)F.wave, aVb = tr_lane_addr(tVb, F.lane) + 32u * (unsigned)F.wave;
      kv_step<0>(aK, aVf, aVb, af, ab); kv_step<1>(aK, aVf, aVb, af, ab); kv_step<2>(aK, aVf, aVb, af, ab); kv_step<3>(aK, aVf, aVb, af, ab); }
    const int fr = F.lane & 15, fq = F.lane >> 4;
    bf16_t* of = KV + (((size_t)item * 4 + h) * 2 + 0) * 16384 + (size_t)(16 * F.wave) * 128;
    unsigned so = (unsigned)((4 * fq) * 128 + fr) * 2u; asm volatile("" : "+v"(so));
#pragma unroll
    for (int n = 0; n < 8; ++n)
#pragma unroll
        for (int jj = 0; jj < 4; ++jj) { stg<bf16_t>(of, so + (unsigned)((jj * 128 + 16 * n) * 2), (bf16_t)f2bf(af[n][jj])); stg<bf16_t>(of, so + (unsigned)((16384 + jj * 128 + 16 * n) * 2), (bf16_t)f2bf(ab[n][jj])); }
    WG_BAR_LDS();
}
__device__ __forceinline__ int latent_item(int c) { return (c >> 5) * SPB + 2 + (c & 31); }
__device__ __forceinline__ int ctx_item(int ci) { return (ci >> 1) * SPB + (ci & 1); }
__device__ __forceinline__ void phase_m1(Frame& F, int l) {
    build_decay(F, l); __syncthreads();
    for (int c = F.bid; c < 256; c += F.G) {
        fresh(F);
        { const int item = latent_item(c); const Item it = item_info(item);
          rg_part<false>(F, l, item, it, F.wave, 0, 4);
          __syncthreads();
          KvRegs A, B;
          fresh(F); kv_issue(F, A, it, 0);
          kv_head(F, A, B, true, item, it, 0);
          fresh(F); kv_head(F, B, A, true, item, it, 1);
          fresh(F); kv_head(F, A, B, true, item, it, 2);
          fresh(F); kv_head(F, B, A, false, item, it, 3); }
        fresh(F);
        if (c >= 64 && c < 192) { const int cu = c - 64; const int item = ctx_item(cu >> 3); const Item it = item_info(item);
            const int w4 = F.wave & 3; rg_part<false, true>(F, l, item, it, cu & 7, w4, w4 + 1); }
        __syncthreads();
        if (c < 64) { const int item = ctx_item(c >> 2); const Item it = item_info(item); KvRegs A, B; fresh(F); kv_issue(F, A, it, c & 3); kv_head(F, A, B, false, item, it, c & 3); }
    }
}
__device__ __forceinline__ int seq_order(int dir, int step) { return dir ? (step == 0 ? 1 : (step == 1 ? 0 : 35 - step)) : step; }
__device__ __forceinline__ void phase_m2(Frame& F, int l) {
    bf16_t* KV = (bf16_t*)(F.ws + WS_KV);
    const int gt = F.bid * NTHREADS + F.tid, NGT = F.G * NTHREADS;
    for (int c = gt; c < NB * NH * 2 * 128 * 16; c += NGT) {
        const int dc = c & 15, e = (c >> 4) & 127, dir = (c >> 11) & 1, h = (c >> 12) & 3, b = c >> 14;
        const float x = F.pa->in[I_RETDEC][l * 8 + dir * 4 + h]; const float decay = expf(128.0f * (-log1pf(expf(-x))));
        float S[8];
#pragma unroll
        for (int i = 0; i < 8; ++i) S[i] = 0.f;
        const unsigned lo = (unsigned)((((h * 2 + dir) * 128 + e) * 128 + dc * 8) * 2);
        for (int g0 = 0; g0 < SPB; g0 += 17) {
            u32x4 v[17];
#pragma unroll
            for (int i = 0; i < 17; ++i) { const int item = b * SPB + seq_order(dir, g0 + i); v[i] = ldg<u32x4>(KV + (size_t)item * 4 * 2 * 16384, lo); }
#pragma unroll
            for (int i = 0; i < 17; ++i) { const int item = b * SPB + seq_order(dir, g0 + i);
                u32x4 w; w.x = pk2(S[0], S[1]); w.y = pk2(S[2], S[3]); w.z = pk2(S[4], S[5]); w.w = pk2(S[6], S[7]);
                stg<u32x4>(KV + (size_t)item * 4 * 2 * 16384, lo, w);
                S[0] = S[0] * decay + bf2f(v[i].x & 0xffffu); S[1] = S[1] * decay + __uint_as_float(v[i].x & 0xffff0000u); S[2] = S[2] * decay + bf2f(v[i].y & 0xffffu); S[3] = S[3] * decay + __uint_as_float(v[i].y & 0xffff0000u);
                S[4] = S[4] * decay + bf2f(v[i].z & 0xffffu); S[5] = S[5] * decay + __uint_as_float(v[i].z & 0xffff0000u); S[6] = S[6] * decay + bf2f(v[i].w & 0xffffu); S[7] = S[7] * decay + __uint_as_float(v[i].w & 0xffff0000u); }
        }
    }
    const float* TOT = (const float*)(F.ws + WS_TOT); float* CARRY = (float*)(F.ws + WS_CARRY);
    if (F.tid < 32) for (int cidx = F.bid * 32 + F.tid; cidx < NB * 2 * 512; cidx += F.G * 32) {
      { const int ch = cidx & 511, dir = (cidx >> 9) & 1, b = cidx >> 10; float cr = 0.f;
          for (int g0 = 0; g0 < SPB; g0 += 17) { f32x2 ah[17];
#pragma unroll
              for (int i = 0; i < 17; ++i) { const int item = b * SPB + seq_order(dir, g0 + i); ah[i] = *(const f32x2*)(TOT + (((size_t)item * 2 + dir) * 512 + ch) * 2); }
#pragma unroll
              for (int i = 0; i < 17; ++i) { const int item = b * SPB + seq_order(dir, g0 + i); CARRY[((size_t)item * 2 + dir) * 512 + ch] = cr; cr = ah[i].x * cr + ah[i].y; } } } }
}
struct RetRegs { u32x4 v[4], sf[4], sb[4], klo[2], khi[2], g[4], q[4]; };
__device__ __forceinline__ void ret_issue(Frame& F, RetRegs& R, int item, const Item& it, int h) {
    const bf16_t* KV = (const bf16_t*)(F.ws + WS_KV); const bf16_t* P = (const bf16_t*)(F.ws + WS_PA);
    const bf16_t* Pk = P + (size_t)it.row0 * INW + 1536 + h * HD; const bf16_t* Pv = P + (size_t)it.row0 * INW + 2048 + h * HD;
    const bf16_t* Sf = KV + (((size_t)item * 4 + h) * 2 + 0) * 16384; const bf16_t* Sb = Sf + 16384;
    const int lane = F.lane, i0 = 16 * F.wave;
#pragma unroll
    for (int t2 = 0; t2 < 2; ++t2) { const int task = F.tid + t2 * NTHREADS, token = task >> 3, d0 = (task & 7) * 8;
        R.klo[t2] = ldg<u32x4>(Pk, (unsigned)(token * INW + d0) * 2u); R.khi[t2] = ldg<u32x4>(Pk, (unsigned)(token * INW + d0 + 64) * 2u); }
#pragma unroll
    for (int t4 = 0; t4 < 4; ++t4) { const int task = F.tid + t4 * NTHREADS, r = task >> 4, c8 = task & 15;
        R.v[t4] = ldg<u32x4>(Pv, (unsigned)(r * INW + c8 * 8) * 2u); R.sf[t4] = ldg<u32x4>(Sf, (unsigned)(r * 128 + c8 * 8) * 2u); R.sb[t4] = ldg<u32x4>(Sb, (unsigned)(r * 128 + c8 * 8) * 2u); }
    { const bf16_t* Pg = P + (size_t)(it.row0 + i0) * INW + 2560 + h * HD;
#pragma unroll
      for (int k = 0; k < 4; ++k) R.g[k] = ldg<u32x4>(Pg, (unsigned)((lane >> 2) * INW + 32 * (lane & 3) + 8 * k) * 2u); }
    { const bf16_t* Pq = P + (size_t)(it.row0 + i0) * INW + 1024 + h * HD;
#pragma unroll
      for (int ks = 0; ks < 4; ++ks) R.q[ks] = ldg<u32x4>(Pq, (unsigned)((lane & 15) * INW + 32 * ks + 8 * (lane >> 4)) * 2u); }
}
__device__ __forceinline__ void ret_head(Frame& F, RetRegs& R, RetRegs& Rn, bool pre, int item, const Item& it, int h) {
    bf16_t* Y = (bf16_t*)(F.ws + WS_Y);
    const LAS float* dec = (const LAS float*)(F.lds + LDS_DEC);
    ldsp_t tK = F.lds, tV = F.lds + TILEB, tSf = tV + TILEV, tSb = tSf + TILEB;
    const int lane = F.lane, fr = lane & 15, fq = lane >> 4, i0 = 16 * F.wave;
#pragma unroll
    for (int t2 = 0; t2 < 2; ++t2) { const int task = F.tid + t2 * NTHREADS, token = task >> 3, d0 = (task & 7) * 8;
        *(LAS u32x4*)(tK + token * TP + d0 * 2) = R.klo[t2]; *(LAS u32x4*)(tK + token * TP + (d0 + 64) * 2) = R.khi[t2]; }
#pragma unroll
    for (int t4 = 0; t4 < 4; ++t4) { const int task = F.tid + t4 * NTHREADS, r = task >> 4, c8 = task & 15;
        *(LAS u32x4*)(tV + r * VP + c8 * 16) = R.v[t4]; *(LAS u32x4*)(tSf + r * TP + c8 * 16) = R.sf[t4]; *(LAS u32x4*)(tSb + r * TP + c8 * 16) = R.sb[t4]; }
    bf16x8 qf[4];
#pragma unroll
    for (int ks = 0; ks < 4; ++ks) qf[ks] = __builtin_bit_cast(bf16x8, R.q[ks]);
    u32x4 gk[4];
#pragma unroll
    for (int k = 0; k < 4; ++k) gk[k] = R.g[k];
    WG_BAR_LDS();
    if (pre) ret_issue(F, Rn, item, it, h + 1);
    bf16x8 pa[4];
    { f32x4 C[8];
#pragma unroll
      for (int jt = 0; jt < 8; ++jt) { C[jt] = zero4();
#pragma unroll
          for (int ks = 0; ks < 4; ++ks) { const bf16x8 a = *(const LAS bf16x8*)(tK + (16 * jt + fr) * TP + (32 * ks + 8 * fq) * 2); C[jt] = __builtin_amdgcn_mfma_f32_16x16x32_bf16(a, qf[ks], C[jt], 0, 0, 0); } }
      const int i = i0 + fr;
#pragma unroll
      for (int jt = 0; jt < 8; ++jt)
#pragma unroll
          for (int jj = 0; jj < 4; ++jj) { const int j = 16 * jt + 4 * fq + jj; const float dcy = (i >= j) ? dec[(0 * 4 + h) * 132 + (i - j)] : dec[(1 * 4 + h) * 132 + (j - i)]; C[jt][jj] *= dcy; }
#pragma unroll
      for (int u = 0; u < 4; ++u) { const u32x4 w = {pg8::cvt_pk_bf16(C[2 * u][0], C[2 * u][1]), pg8::cvt_pk_bf16(C[2 * u][2], C[2 * u][3]), pg8::cvt_pk_bf16(C[2 * u + 1][0], C[2 * u + 1][1]), pg8::cvt_pk_bf16(C[2 * u + 1][2], C[2 * u + 1][3])};
          pa[u] = __builtin_bit_cast(bf16x8, w); } }
    WG_BAR_LDS();
    { ldsp_t gt = tK + (i0 + (lane >> 2)) * TP + (lane & 3) * 64;
#pragma unroll
      for (int k = 0; k < 4; ++k) *(LAS u32x4*)(gt + 16 * k) = gk[k]; }
    f32x4 o[8];
#pragma unroll
    for (int n = 0; n < 8; ++n) o[n] = zero4();
    { const unsigned aV = tr_lane_addr(tV, lane); bf16x8 b[8];
#define RET_PV(U) do { tr4<(U) * 32 * VP>(aV, b[0], b[1], b[2], b[3]); tr4<(U) * 32 * VP + 128>(aV, b[4], b[5], b[6], b[7]); \
        _Pragma("unroll") for (int n = 0; n < 8; ++n) o[n] = __builtin_amdgcn_mfma_f32_16x16x32_bf16(pa[U], b[n], o[n], 0, 0, 0); } while (0)
      RET_PV(0); RET_PV(1); RET_PV(2); RET_PV(3);
#undef RET_PV
    }
    { f32x4 cf[8];
#pragma unroll
      for (int n = 0; n < 8; ++n) { cf[n] = zero4();
#pragma unroll
          for (int ks = 0; ks < 4; ++ks) { const bf16x8 b = *(const LAS bf16x8*)(tSf + (16 * n + fr) * TP + (32 * ks + 8 * fq) * 2); cf[n] = __builtin_amdgcn_mfma_f32_16x16x32_bf16(qf[ks], b, cf[n], 0, 0, 0); } }
#pragma unroll
      for (int jj = 0; jj < 4; ++jj) { const float sf = dec[(0 * 4 + h) * 132 + (i0 + 4 * fq + jj + 1)];
#pragma unroll
          for (int n = 0; n < 8; ++n) o[n][jj] += sf * cf[n][jj]; } }
    { f32x4 cb[8];
#pragma unroll
      for (int n = 0; n < 8; ++n) { cb[n] = zero4();
#pragma unroll
          for (int ks = 0; ks < 4; ++ks) { const bf16x8 b = *(const LAS bf16x8*)(tSb + (16 * n + fr) * TP + (32 * ks + 8 * fq) * 2); cb[n] = __builtin_amdgcn_mfma_f32_16x16x32_bf16(qf[ks], b, cb[n], 0, 0, 0); } }
#pragma unroll
      for (int jj = 0; jj < 4; ++jj) { const float sb = dec[(1 * 4 + h) * 132 + (128 - (i0 + 4 * fq + jj))];
#pragma unroll
          for (int n = 0; n < 8; ++n) o[n][jj] += sb * cb[n][jj]; } }
    { ldsp_t gc = tK + (i0 + 4 * fq) * TP + fr * 2;
#pragma unroll
      for (int jj = 0; jj < 4; ++jj) { float s1 = 0.f;
#pragma unroll
          for (int n = 0; n < 8; ++n) s1 += o[n][jj];
          s1 += swz_xor<1>(s1); s1 += swz_xor<2>(s1); s1 += swz_xor<4>(s1); s1 += swz_xor<8>(s1);
          const float mu = s1 * (1.0f / 128.0f); float q = 0.f;
#pragma unroll
          for (int n = 0; n < 8; ++n) { const float dd = o[n][jj] - mu; q += dd * dd; }
          q += swz_xor<1>(q); q += swz_xor<2>(q); q += swz_xor<4>(q); q += swz_xor<8>(q);
          const float rstd = 1.0f / sqrtf(q * (1.0f / 128.0f) + EPS);
#pragma unroll
          for (int n = 0; n < 8; ++n) { LAS bf16_t* p = (LAS bf16_t*)(gc + jj * TP + 32 * n); const float gv = bf2f(*p); *p = (bf16_t)f2bf(siluf_(gv) * (o[n][jj] - mu) * rstd); } } }
    LDS_WAIT(); asm volatile("" ::: "memory");
    { ldsp_t gt = tK + (i0 + (lane >> 2)) * TP + (lane & 3) * 64; bf16_t* Yo = Y + (size_t)(it.row0 + i0) * D + 512 + h * HD;
#pragma unroll
      for (int k = 0; k < 4; ++k) stg<u32x4>(Yo, (unsigned)((lane >> 2) * D + 32 * (lane & 3) + 8 * k) * 2u, *(const LAS u32x4*)(gt + 16 * k)); }
    WG_BAR_LDS();
}
__device__ __forceinline__ void phase_m3(Frame& F, int l) {
    build_decay(F, l); __syncthreads();
    for (int c = F.bid; c < 256; c += F.G) {
        fresh(F);
        { const int item = latent_item(c); const Item it = item_info(item);
#ifndef PROBE_M3
#define PROBE_M3 0
#endif
          for (int r_ = 0; r_ < ((PROBE_M3 & 1) ? 2 : 1); ++r_) { fresh(F); rg_part<true>(F, l, item, it, F.wave, 0, 4); }
          __syncthreads();
          for (int r_ = 0; r_ < ((PROBE_M3 & 2) ? 2 : 1); ++r_) {
          RetRegs R, Rn;
          fresh(F); ret_issue(F, R, item, it, 0);
          ret_head(F, R, Rn, true, item, it, 0);
          fresh(F); ret_head(F, Rn, R, true, item, it, 1);
          fresh(F); ret_head(F, R, Rn, true, item, it, 2);
          fresh(F); ret_head(F, Rn, R, false, item, it, 3); } }
        if (l == 0) {
            fresh(F);
            if (c >= 64 && c < 192) { const int cu = c - 64; const int item = ctx_item(cu >> 3); const Item it = item_info(item);
                const int w4 = F.wave & 3; rg_part<true, true>(F, l, item, it, cu & 7, w4, w4 + 1); }
            __syncthreads();
            if (c < 64) { const int item = ctx_item(c >> 2); const Item it = item_info(item); RetRegs R, Rn; fresh(F); ret_issue(F, R, item, it, c & 3); ret_head(F, R, Rn, false, item, it, c & 3); }
        }
    }
}

constexpr int N_PHASES = 24;
__global__ void __launch_bounds__(NTHREADS, 2) fwd_kernel(Args args) {
    extern __shared__ __attribute__((aligned(16))) unsigned char lds_raw[];
    Frame F; F.lds = (ldsp_t)lds_raw; F.wave0 = __builtin_amdgcn_readfirstlane((int)threadIdx.x >> 6); F.G = gridDim.x; F.pa0 = &args; F.out0 = args.out; F.ws0 = args.ws; fresh(F);
    volatile LAS unsigned* MISC = (volatile LAS unsigned*)(F.lds + LDS_MISC);
    if (F.tid < 64) MISC[F.tid] = 0u;
    __syncthreads();
    const int lo = args.ph_lo, hi = args.ph_hi;
    XcdBarrier bar; bar.bar = (unsigned*)(F.ws + WS_CTL); bar.x = 0; bar.st = nullptr;
    if (hi - lo > 1) bar = xcd_barrier_post((unsigned*)(F.ws + WS_CTL), MISC);
#ifndef DIAG_MASK
#define DIAG_MASK 0xffffffffu
#endif
#ifndef REPEAT_MASK
#define REPEAT_MASK 0u
#endif
#define REPS(kind) ((((REPEAT_MASK) >> (kind)) & 1u) ? 2 : 1)
#define INK(k, kind) (((DIAG_MASK >> (kind)) & 1u) && lo <= (k) && (k) < hi && fresh(F))
#define IN(k) (lo <= (k) && (k) < hi)
#define SEAM(k) do { if (IN(k) && IN((k) + 1)) xcd_barrier(bar); } while (0)
    float* ctxx = (float*)(F.ws + WS_CTXX); bf16_t* xb = (bf16_t*)((char*)F.out + XB_OFF);
    const float* modlat = (const float*)(F.ws + WS_MODLAT); const float* modctx = (const float*)(F.ws + WS_MODCTX);

    if (INK(0, 0)) { for (int r_ = 0; r_ < REPS(0); ++r_) { phase_convert_small(F); __syncthreads(); phase_mod(F); __syncthreads(); } } SEAM(0);
    if (INK(1, 1)) { for (int r_ = 0; r_ < REPS(1); ++r_) phase_norm(F, 0, 0, F.pa->in[I_X], nullptr, F.pa->in[I_CTX], MROWS, SlabRed{nullptr, 0, nullptr, nullptr, nullptr}); } SEAM(1);
#pragma unroll 1
    for (int l = 0; l < 2; ++l) {
        const int pb = (l == 0) ? 2 : 11;
        if (INK(pb + 0, 2)) { pg8::Gemm g{(const bf16_t*)(F.ws + WS_HX), (const bf16_t*)(F.ws + WS_WIN) + (size_t)l * INW * D, INW, D, 0, nullptr}; pg8::Order S; S.init(MROWS / 256, INW / 256, F.G, F.bid, nullptr, nullptr, D / 64, false, 0);
            pg8::EpiInProj E{(bf16_t*)(F.ws + WS_PA), INW, (const float*)(F.ws + WS_ROPE), (const float*)(F.ws + WS_ROPE) + 4096 * 64}; for (int r_ = 0; r_ < REPS(2); ++r_) pg8::gemm_phase<pg8::EpiInProj>(F.lds, g, S, E, F.tid);
            fresh(F); moe_fill(F, (MROWS / 256) * (INW / 256), l * fill_count((MROWS / 256) * (INW / 256), F.G)); }
        SEAM(pb + 0);
        if (INK(pb + 1, 3)) { for (int r_ = 0; r_ < REPS(3); ++r_) phase_m1(F, l); }
        SEAM(pb + 1);
        if (INK(pb + 2, 4)) { for (int r_ = 0; r_ < REPS(4); ++r_) { if (r_) phase_m1(F, l); phase_m2(F, l); } }
        SEAM(pb + 2);
        if (INK(pb + 3, 5)) { for (int r_ = 0; r_ < REPS(5); ++r_) phase_m3(F, l); }
        SEAM(pb + 3);
        if (INK(pb + 4, 6)) { pg8::Gemm g{(const bf16_t*)(F.ws + WS_Y), (const bf16_t*)(F.ws + WS_WOUT) + (size_t)l * D * D, D, D, 0, (float*)(F.ws + WS_SLABA)}; pg8::Order S; S.init((l == 0 ? MROWS : NLAT) / 256, D / 256, F.G, F.bid, nullptr, nullptr, D / 64, true, MAXSLAB_A);
            pg8::EpiResid E{l == 0 ? F.pa->in[I_X] : nullptr, xb, F.pa->in[I_CTX], ctxx, modlat + (size_t)l * 8 * 6144 + 2048, modctx + (size_t)l * 6144 + 2048};
            pg8::gemm_phase<pg8::EpiResid>(F.lds, g, S, E, F.tid); }
        SEAM(pb + 4);
        if (l == 0) {
            if (INK(7, 1)) { for (int r_ = 0; r_ < REPS(1); ++r_) phase_norm(F, 0, 1, nullptr, xb, ctxx, MROWS, SlabRed{(const float*)(F.ws + WS_SLABA), pg8::split_factor((MROWS / 256) * 4, F.G, D / 64, MAXSLAB_A), modctx + 2048, F.pa->in[I_CTX], ctxx}); } SEAM(7);
            if (INK(8, 7)) { pg8::Gemm g{(const bf16_t*)(F.ws + WS_HX), (const bf16_t*)(F.ws + WS_WUP), 2 * DFF, D, 0, nullptr}; pg8::Order S; S.init(MROWS / 256, 2 * DFF / 256, F.G, F.bid, nullptr, nullptr, D / 64, false, 0);
                pg8::EpiSwiGLU E{(bf16_t*)(F.ws + WS_PA), DFF}; for (int r_ = 0; r_ < REPS(7); ++r_) pg8::gemm_phase<pg8::EpiSwiGLU>(F.lds, g, S, E, F.tid);
                fresh(F); moe_fill(F, (MROWS / 256) * (2 * DFF / 256), 2 * fill_count((MROWS / 256) * (INW / 256), F.G)); }
            SEAM(8);
            if (INK(9, 8)) { pg8::Gemm g{(const bf16_t*)(F.ws + WS_PA), (const bf16_t*)(F.ws + WS_WDN), D, DFF, 0, (float*)(F.ws + WS_SLABA)}; pg8::Order S; S.init(MROWS / 256, D / 256, F.G, F.bid, nullptr, nullptr, DFF / 64, true, MAXSLAB_A);
                pg8::EpiResid E{nullptr, xb, (const float*)ctxx, ctxx, modlat + 5120, modctx + 5120}; pg8::gemm_phase<pg8::EpiResid>(F.lds, g, S, E, F.tid); }
            SEAM(9);
            if (INK(10, 1)) { for (int r_ = 0; r_ < REPS(1); ++r_) phase_norm(F, 1, 0, nullptr, xb, ctxx, MROWS, SlabRed{(const float*)(F.ws + WS_SLABA), pg8::split_factor((MROWS / 256) * 4, F.G, DFF / 64, MAXSLAB_A), modctx + 5120, ctxx, ctxx}); } SEAM(10);
        }
    }
    if (INK(16, 9)) { for (int r_ = 0; r_ < REPS(9); ++r_) { phase_norm_router(F, xb); __syncthreads(); phase_convert_moe(F); __syncthreads(); } } SEAM(16);
    if (INK(17, 10)) { phase_moe_sort(F); } SEAM(17);
#pragma unroll 1
    for (int k = 0; k < 2; ++k) {
        const int* meta = (const int*)(F.ws + MOE_META) + 9 * k;
        if (INK(18 + 2 * k, 11)) { if (k == 1) { moe_reduce(F, 0); __syncthreads(); } pg8::Gemm g{(const bf16_t*)(F.ws + WS_HX), (const bf16_t*)(F.ws + WS_MOEUP), 2 * DEXP, D, (size_t)2 * DEXP * D * 2, nullptr}; pg8::Order S; S.init(meta[8], 2 * DEXP / 256, F.G, F.bid, meta, (const int*)(F.ws + MOE_PTOK) + k * MROWS, D / 64, false, 0);
            pg8::EpiSwiGLU E{(bf16_t*)(F.ws + WS_PA), DEXP}; for (int r_ = 0; r_ < REPS(11); ++r_) pg8::gemm_phase<pg8::EpiSwiGLU>(F.lds, g, S, E, F.tid); }
        SEAM(18 + 2 * k);
        if (INK(19 + 2 * k, 12)) { pg8::Gemm g{(const bf16_t*)(F.ws + WS_PA), (const bf16_t*)F.out, D, DEXP, (size_t)D * DEXP * 2, (float*)(F.ws + WS_SLABM)}; pg8::Order S; S.init(meta[8], D / 256, F.G, F.bid, meta, nullptr, DEXP / 64, true, MAXSLAB_M);
            pg8::EpiMoeDown E{xb, (const int*)(F.ws + MOE_PTOK) + k * MROWS, (const float*)(F.ws + MOE_PW) + k * MROWS, modlat + (size_t)8 * 6144 + 5120}; pg8::gemm_phase<pg8::EpiMoeDown>(F.lds, g, S, E, F.tid); }
        SEAM(19 + 2 * k);
    }
    if (INK(22, 13)) phase_final_a(F);
    SEAM(22);
    if (INK(23, 13)) phase_final_b(F);
#undef IN
#undef INK
#undef SEAM
}

extern "C" void kernel_launch(void* const* d_in, const int* in_sizes, int n_in, void* d_out, int out_size, void* d_ws, size_t ws_size, hipStream_t stream) {
    static int grid = 0;
    if (grid == 0) {
        if (n_in != 27 || in_sizes[0] != NLAT * D || out_size != NLAT * D || ws_size < WS_END) { fprintf(stderr, "kernel_launch: unexpected problem (n_in %d, in0 %d, out %d, ws %zu, need %zu); nothing launched\n", n_in, n_in > 0 ? in_sizes[0] : -1, out_size, ws_size, (size_t)WS_END); grid = -1; return; }
        int dev = 0, cus = 0, per_cu = 0;
        if (hipGetDevice(&dev) != hipSuccess || hipDeviceGetAttribute(&cus, hipDeviceAttributeMultiprocessorCount, dev) != hipSuccess) { grid = -1; return; }
        if (hipFuncSetAttribute((const void*)fwd_kernel, hipFuncAttributeMaxDynamicSharedMemorySize, LDS_BYTES) != hipSuccess) { fprintf(stderr, "kernel_launch: hipFuncSetAttribute failed\n"); grid = -1; return; }
        if (hipOccupancyMaxActiveBlocksPerMultiprocessor(&per_cu, (const void*)fwd_kernel, NTHREADS, LDS_BYTES) != hipSuccess || per_cu < 1) { fprintf(stderr, "kernel_launch: occupancy query says %d\n", per_cu); }
        (void)hipGetLastError();
        grid = cus;
    }
    if (grid < 0) return;
    (void)hipMemsetAsync((char*)d_ws + WS_CTL, 0, CTL_ZERO_BYTES, stream);
    Args a; memset(&a, 0, sizeof(a));
    for (int i = 0; i < 27; ++i) a.in[i] = (const float*)d_in[i];
    a.out = (float*)d_out; a.ws = (unsigned char*)d_ws;
#if MK_ONE_LAUNCH
    a.ph_lo = 0; a.ph_hi = N_PHASES;
    hipLaunchKernelGGL(fwd_kernel, dim3(grid), dim3(NTHREADS), LDS_BYTES, stream, a);
#else
    for (int p = 0; p < N_PHASES; ++p) { a.ph_lo = p; a.ph_hi = p + 1; hipLaunchKernelGGL(fwd_kernel, dim3(grid), dim3(NTHREADS), LDS_BYTES, stream, a); }
#endif
}
```

```cpp
#include <hip/hip_runtime.h>
#include <cstdio>
#include <cstdint>
#include <cstring>

#ifndef MK_ONE_LAUNCH
#define MK_ONE_LAUNCH 1
#endif

#define GAS __attribute__((address_space(1)))
#define LAS __attribute__((address_space(3)))
typedef unsigned short bf16_t;
typedef short bf16x8 __attribute__((ext_vector_type(8)));
typedef float f32x4 __attribute__((ext_vector_type(4)));
typedef float f32x2 __attribute__((ext_vector_type(2)));
typedef unsigned u32x4 __attribute__((ext_vector_type(4)));
typedef unsigned u32x2 __attribute__((ext_vector_type(2)));
typedef LAS unsigned char* ldsp_t;

constexpr int D = 1024, NB = 8, SEQ = 4096, NLAT = NB * SEQ, CTXL = 256, NCTX = NB * CTXL, MROWS = NLAT + NCTX;
constexpr int INW = 3072, NH = 4, HD = 128, CHK = 128;
constexpr int DFF = 2816, NE = 8, DEXP = 3584;
constexpr int SPB = 34;
constexpr int NITEM = NB * SPB;
constexpr float EPS = 1e-6f;
constexpr int NWAVES = 8, NTHREADS = 512;

constexpr size_t MiB = 1u << 20;
constexpr size_t WS_CTL = 0, CTL_ZERO_BYTES = 64 * 1024;
constexpr size_t WS_MODLAT = 1 * MiB;
constexpr size_t WS_MODCTX = 1 * MiB + 2 * 8 * 6144 * 4;
constexpr size_t WS_ROPE = 2 * MiB;
constexpr size_t WS_RGW = 4 * MiB;
constexpr size_t WS_TOT = 5 * MiB;
constexpr size_t WS_CARRY = 8 * MiB;
constexpr size_t WS_MOE = 10 * MiB;
constexpr size_t MOE_CNT = WS_MOE, MOE_META = WS_MOE + 16384, MOE_TOKE = WS_MOE + 65536, MOE_TOKW = WS_MOE + 262144,
                 MOE_PTOK = WS_MOE + 524288, MOE_PW = WS_MOE + 1048576, MOE_PPOS = WS_MOE + 1572864;
constexpr size_t WS_CTXX = 12 * MiB;
constexpr size_t WS_WIN = 20 * MiB;
constexpr size_t WS_WOUT = 32 * MiB;
constexpr size_t WS_WUP = 36 * MiB;
constexpr size_t WS_WDN = 47 * MiB;
constexpr size_t WS_HX = 54 * MiB;
constexpr size_t WS_PA = 122 * MiB;
constexpr size_t WS_KV = 360 * MiB;
constexpr size_t WS_Y = 496 * MiB;
constexpr size_t WS_MOEUP = 360 * MiB;
constexpr size_t WS_SLABA = WS_KV;
constexpr size_t WS_SLABM = 528 * MiB;
constexpr int MAXSLAB_A = 256, MAXSLAB_M = 216;
constexpr size_t XB_OFF = (size_t)NLAT * D * 2;
constexpr size_t WS_XCOPY = WS_PA;
constexpr size_t WS_END = 582 * MiB;
static_assert((size_t)NE * D * DEXP * 2 <= XB_OFF, "MoE-down weights fit the lower half of d_out");
static_assert(WS_PA + (size_t)MROWS * DEXP * 2 <= WS_KV, "ws map");

constexpr int LDS_SCRATCH = 147456;
constexpr int LDS_MISC = LDS_SCRATCH;
constexpr int LDS_DEC = LDS_MISC + 256;
constexpr int LDS_BYTES = LDS_SCRATCH + 8192;

__device__ __forceinline__ float bf2f(unsigned v) { return __uint_as_float(v << 16); }
typedef __bf16 bf16x2_t __attribute__((ext_vector_type(2)));
__device__ __forceinline__ unsigned pk2(float lo, float hi) { const f32x2 v = {lo, hi}; return __builtin_bit_cast(unsigned, __builtin_convertvector(v, bf16x2_t)); }
__device__ __forceinline__ unsigned f2bf(float f) { return pk2(f, f) & 0xffffu; }
__device__ __forceinline__ void unpack8(const u32x4 v, f32x4& a, f32x4& b) {
    a = (f32x4){bf2f(v.x & 0xffffu), __uint_as_float(v.x & 0xffff0000u), bf2f(v.y & 0xffffu), __uint_as_float(v.y & 0xffff0000u)};
    b = (f32x4){bf2f(v.z & 0xffffu), __uint_as_float(v.z & 0xffff0000u), bf2f(v.w & 0xffffu), __uint_as_float(v.w & 0xffff0000u)}; }
__device__ __forceinline__ u32x4 pack8(const f32x4 a, const f32x4 b) { return (u32x4){pk2(a.x, a.y), pk2(a.z, a.w), pk2(b.x, b.y), pk2(b.z, b.w)}; }
template <int M> __device__ __forceinline__ float swz_xor(float v) { return __int_as_float(__builtin_amdgcn_ds_swizzle(__float_as_int(v), (M << 10) | 0x1f)); }
__device__ __forceinline__ float wave_sum(float v) {
    v += swz_xor<1>(v); v += swz_xor<2>(v); v += swz_xor<4>(v); v += swz_xor<8>(v); v += swz_xor<16>(v);
    const auto r = __builtin_amdgcn_permlane32_swap(__float_as_uint(v), __float_as_uint(v), false, false);
    return __uint_as_float(r[0]) + __uint_as_float(r[1]);
}
__device__ __forceinline__ float lane_bcast(float v, int src_lane) { return __int_as_float(__builtin_amdgcn_ds_bpermute(src_lane << 2, __float_as_int(v))); }
__device__ __forceinline__ float sigmoidf_(float x) { return __builtin_amdgcn_rcpf(1.0f + __expf(-x)); }
__device__ __forceinline__ float siluf_(float x) { return x * __builtin_amdgcn_rcpf(1.0f + __expf(-x)); }
__device__ __forceinline__ float gelu_tanh(float x) { const float z = 0.7978845608028654f * (x + 0.044715f * x * x * x); return x * (1.0f - __builtin_amdgcn_rcpf(1.0f + __expf(2.0f * z))); }
#define LDS_WAIT() asm volatile("s_waitcnt lgkmcnt(0)" ::: "memory")
#define WG_BAR_LDS() do { asm volatile("s_waitcnt lgkmcnt(0)" ::: "memory"); __builtin_amdgcn_s_barrier(); asm volatile("" ::: "memory"); } while (0)
__device__ __forceinline__ f32x4 zero4() { float z; asm volatile("v_mov_b32 %0, 0" : "=v"(z)); return (f32x4){z, z, z, z}; }

template <typename T> __device__ __forceinline__ T ldg(const void* base, unsigned off) { return *(const GAS T*)((const GAS char*)base + off); }
template <typename T> __device__ __forceinline__ void stg(void* base, unsigned off, T v) { *(GAS T*)((GAS char*)base + off) = v; }
#define XB_TMO      128
#define XB_XCNT(j)  (256  + 64 * (j))
#define XB_XSUB(j)  (1280 + 64 * (j))
#define XB_XGEN(j)  (2304 + 64 * (j))
#define XB_TOP      3328
#define XB_TOPGEN   3392
#define XCD_BAR_WORDS 3456
#define XB_SPIN_CAP (1u << 18)
__device__ __forceinline__ unsigned xb_ld(unsigned* p)              { return __hip_atomic_load(p, __ATOMIC_RELAXED, __HIP_MEMORY_SCOPE_AGENT); }
__device__ __forceinline__ unsigned xb_add(unsigned* p, unsigned v) { return __hip_atomic_fetch_add(p, v, __ATOMIC_RELAXED, __HIP_MEMORY_SCOPE_AGENT); }
__device__ __forceinline__ unsigned xb_xcc_id() { return (unsigned)__builtin_amdgcn_s_getreg((3 << 11) | 20) & 0xFu; }
#define XB_SPIN(cond, bar) do { unsigned _sp = 0; while (cond) { __builtin_amdgcn_s_sleep(1); \
    if ((++_sp & 255u) == 0u) { if (xb_ld(&(bar)[XB_TMO])) break; if (_sp > XB_SPIN_CAP) { atomicAdd(&(bar)[XB_TMO], 1u); break; } } } } while (0)
struct XcdBarrier { unsigned* bar; unsigned x; volatile LAS unsigned* st; };
__device__ __forceinline__ XcdBarrier xcd_barrier_post(unsigned* bar, volatile LAS unsigned* st) {
    XcdBarrier b; b.bar = bar; b.x = xb_xcc_id(); b.st = st;
    if (threadIdx.x == 0) (void)xb_add(&bar[XB_XCNT(b.x)], 1u);
    return b;
}
__device__ __forceinline__ void xcd_barrier_complete(unsigned* bar, unsigned x, unsigned& nloc, unsigned& nx) {
    const unsigned G = gridDim.x * gridDim.y * gridDim.z;
    unsigned sum, cnt, mine, sp = 0u;
    for (;;) {
        sum = 0u; cnt = 0u; mine = 0u;
#pragma unroll
        for (unsigned j = 0; j < 16; ++j) { const unsigned c = xb_ld(&bar[XB_XCNT(j)]); sum += c; cnt += (c > 0u) ? 1u : 0u; mine = (j == x) ? c : mine; }
        if (sum == G) break;
        __builtin_amdgcn_s_sleep(1);
        if ((++sp & 255u) == 0u) { if (xb_ld(&bar[XB_TMO])) break; if (sp > XB_SPIN_CAP) { atomicAdd(&bar[XB_TMO], 1u); break; } }
    }
    nloc = mine > 0u ? mine : 1u; nx = cnt > 0u ? cnt : 1u;
}
__device__ __forceinline__ void xcd_barrier(const XcdBarrier& b) {
    asm volatile("s_waitcnt vmcnt(0)" ::: "memory");
    __syncthreads();
    if (threadIdx.x == 0) {
        unsigned* bar = b.bar;
        __builtin_amdgcn_s_waitcnt(0);
        unsigned nloc = b.st[0], nx = b.st[1];
        if (nloc == 0u) { xcd_barrier_complete(bar, b.x, nloc, nx); b.st[0] = nloc; b.st[1] = nx; }
        const unsigned old = xb_add(&bar[XB_XSUB(b.x)], 1u);
        const unsigned gen = old / nloc;
        if (old + 1u == (gen + 1u) * nloc) {
            __builtin_amdgcn_fence(__ATOMIC_RELEASE, "agent");
            asm volatile("s_waitcnt vmcnt(0)" ::: "memory");
            const unsigned og = xb_add(&bar[XB_TOP], 1u);
            const unsigned tg = og / nx;
            if (og + 1u == (tg + 1u) * nx) xb_add(&bar[XB_TOPGEN], 1u);
            else XB_SPIN(xb_ld(&bar[XB_TOPGEN]) == tg, bar);
            __builtin_amdgcn_fence(__ATOMIC_ACQUIRE, "agent");
            xb_add(&bar[XB_XGEN(b.x)], 1u);
            asm volatile("s_waitcnt vmcnt(0)" ::: "memory");
        } else {
            XB_SPIN(xb_ld(&bar[XB_XGEN(b.x)]) == gen, bar);
            __builtin_amdgcn_fence(__ATOMIC_ACQUIRE, "agent");
            asm volatile("s_waitcnt vmcnt(0)" ::: "memory");
        }
    }
    __syncthreads();
}

namespace pg8 {
constexpr int BM = 256, BK = 64, HALF = 128, HTB = HALF * BK * 2, STAGE_BYTES = 8 * HTB, NXCD = 8, WGM = 8;
__host__ __device__ __forceinline__ int lds_byte(int r, int c) { const int st = (r >> 4) * 2 + (c >> 5), rr = r & 15, cc = c & 31, ob = rr * 64 + cc * 2; return st * 1024 + (ob ^ (((ob >> 9) & 1) << 5)); }
__host__ __device__ __forceinline__ void stage_rc(int b, int& R, int& C) { const int st = b / 1024, sb = b % 1024, swz = sb ^ (((sb >> 9) & 1) << 5); R = (st >> 1) * 16 + swz / 64; C = (st & 1) * 32 + (swz % 64) / 2; }
__host__ __device__ __forceinline__ int perm32(int rho) { const int n = rho >> 4, i = rho & 15; return 8 * (i >> 2) + 4 * n + (i & 3); }

struct Unit { int pm, pn, e, kt0, nt, slab; };
struct Gemm { const bf16_t* A; const bf16_t* Bt; int N, K; size_t estride; float* slabs; };

__device__ __forceinline__ int split_factor(int U, int G, int ntiles, int maxslabs) {
    const int R = U % G; if (R == 0) return 1;
    int S = G / R; if (S > 8) S = 8; if (S > ntiles / 4) S = ntiles / 4; if (R * S > maxslabs) S = maxslabs / R;
    return S < 2 ? 1 : S;
}
struct Order {
    int nM, nN, G, c, ntiles, mainu, S, total; const int* segs; const int* rowmap;
    int sg1, sg2, sg3, sg4, sg5, sg6, sg7;
    __device__ __forceinline__ void init(int nM_, int nN_, int G_, int c_, const int* segs_, const int* rowmap_, int ntiles_, bool split, int maxslabs) {
        nM = nM_; nN = nN_; G = G_; c = c_; segs = segs_; rowmap = rowmap_; ntiles = ntiles_;
        sg1 = sg2 = sg3 = sg4 = sg5 = sg6 = sg7 = 0; if (segs_) { sg1 = segs_[1]; sg2 = segs_[2]; sg3 = segs_[3]; sg4 = segs_[4]; sg5 = segs_[5]; sg6 = segs_[6]; sg7 = segs_[7]; }
        const int U = nM * nN; S = split ? split_factor(U, G, ntiles, maxslabs) : 1; const int R = (S > 1) ? U % G : 0; mainu = U - R; total = mainu + R * S; }
    __device__ __forceinline__ bool next(int i, Unit& u) const {
        const long L = (long)i * G + c; if (L >= total) return false;
        int wgid; u.kt0 = 0; u.nt = ntiles; u.slab = -1;
        if (L < mainu) { wgid = (int)L; const int q = mainu / NXCD, r = mainu % NXCD, xcd = wgid % NXCD, off = wgid / NXCD; wgid = (xcd < r ? xcd * (q + 1) : r * (q + 1) + (xcd - r) * q) + off; }
        else { const int sub = (int)L - mainu, lu = sub / S, sl = sub - lu * S, pairs = ntiles / 2, p0 = (sl * pairs) / S, p1 = ((sl + 1) * pairs) / S;
            wgid = mainu + lu; u.kt0 = 2 * p0; u.nt = 2 * (p1 - p0); u.slab = sub; }
        const int nig = WGM * nN, gid = wgid / nig, fm = gid * WGM, gsz = (nM - fm) < WGM ? (nM - fm) : WGM;
        u.pm = fm + ((wgid % nig) % gsz); u.pn = (wgid % nig) / gsz; u.e = 0;
        if (segs) u.e = (u.pm >= sg1) + (u.pm >= sg2) + (u.pm >= sg3) + (u.pm >= sg4) + (u.pm >= sg5) + (u.pm >= sg6) + (u.pm >= sg7);
        return true;
    }
    __device__ __forceinline__ int arow(const Unit& u, int r) const {
        if (rowmap) { const int t = rowmap[u.pm * BM + r]; return t < 0 ? 0 : t; }
        return u.pm * BM + r;
    }
};

__device__ __forceinline__ unsigned cvt_pk_bf16(float lo, float hi) { return pk2(lo, hi); }

struct EpiBf16 {
    static constexpr bool PERM = true, SPLIT = false;
    bf16_t* O; int ldc;
    __device__ __forceinline__ void operator()(const f32x4 (&acc)[2][2][4][2], const Unit& u, int wr, int wc, int fr, int fq) const {
        asm volatile("" : "+v"(fr), "+v"(fq));
        const int row0 = u.pm * BM + wr * 64 + fr, col0 = u.pn * BM + wc * 32 + 8 * fq;
#pragma unroll
        for (int ai = 0; ai < 2; ++ai)
#pragma unroll
            for (int m = 0; m < 4; ++m) { bf16_t* rowp = O + (size_t)(row0 + ai * HALF + m * 16) * ldc + col0;
#pragma unroll
                for (int bj = 0; bj < 2; ++bj) { const f32x4 v0 = acc[ai][bj][m][0], v1 = acc[ai][bj][m][1];
                    u32x4 w; w.x = cvt_pk_bf16(v0[0], v0[1]); w.y = cvt_pk_bf16(v0[2], v0[3]); w.z = cvt_pk_bf16(v1[0], v1[1]); w.w = cvt_pk_bf16(v1[2], v1[3]);
                    *(u32x4*)(rowp + bj * HALF) = w; } }
    }
};
struct EpiInProj {
    static constexpr bool PERM = true, SPLIT = false;
    bf16_t* O; int ldc; const float* ct; const float* st;
    __device__ __forceinline__ void operator()(const f32x4 (&acc)[2][2][4][2], const Unit& u, int wr, int wc, int fr, int fq) const {
        asm volatile("" : "+v"(fr), "+v"(fq));
        const int row0 = u.pm * BM + wr * 64 + fr, col0 = u.pn * BM + wc * 32 + 8 * fq;
        const bool rot = (u.pn >= 4) && (u.pn < 8) && (u.pm * BM < NLAT);
#pragma unroll
        for (int ai = 0; ai < 2; ++ai)
#pragma unroll
            for (int m = 0; m < 4; ++m) { const int row = row0 + ai * HALF + m * 16; bf16_t* rowp = O + (size_t)row * ldc + col0;
                f32x4 c = {1.f, 1.f, 1.f, 1.f}, s = {0.f, 0.f, 0.f, 0.f};
                if (rot) { const unsigned to = (unsigned)((row & (SEQ - 1)) * 64 + wc * 16 + fq * 4) * 4u; c = ldg<f32x4>(ct, to); s = ldg<f32x4>(st, to); }
#pragma unroll
                for (int bj = 0; bj < 2; ++bj) { const f32x4 v0 = acc[ai][bj][m][0], v1 = acc[ai][bj][m][1];
                    u32x4 w; w.x = cvt_pk_bf16(v0[0] * c[0] - v0[1] * s[0], v0[0] * s[0] + v0[1] * c[0]); w.y = cvt_pk_bf16(v0[2] * c[1] - v0[3] * s[1], v0[2] * s[1] + v0[3] * c[1]);
                    w.z = cvt_pk_bf16(v1[0] * c[2] - v1[1] * s[2], v1[0] * s[2] + v1[1] * c[2]); w.w = cvt_pk_bf16(v1[2] * c[3] - v1[3] * s[3], v1[2] * s[3] + v1[3] * c[3]);
                    *(u32x4*)(rowp + bj * HALF) = w; } }
    }
};
struct EpiSwiGLU {
    static constexpr bool PERM = true, SPLIT = false;
    bf16_t* O; int ldc;
    __device__ __forceinline__ void operator()(const f32x4 (&acc)[2][2][4][2], const Unit& u, int wr, int wc, int fr, int fq) const {
        asm volatile("" : "+v"(fr), "+v"(fq));
        const int row0 = u.pm * BM + wr * 64 + fr, col0 = u.pn * HALF + wc * 32 + 8 * fq;
#pragma unroll
        for (int ai = 0; ai < 2; ++ai)
#pragma unroll
            for (int m = 0; m < 4; ++m) { bf16_t* rowp = O + (size_t)(row0 + ai * HALF + m * 16) * ldc + col0;
                float o[8];
#pragma unroll
                for (int n = 0; n < 2; ++n)
#pragma unroll
                    for (int j = 0; j < 4; ++j) { const float a = acc[ai][0][m][n][j], b = acc[ai][1][m][n][j]; o[n * 4 + j] = (a * __builtin_amdgcn_rcpf(1.0f + __expf(-a))) * b; }
                u32x4 w; w.x = cvt_pk_bf16(o[0], o[1]); w.y = cvt_pk_bf16(o[2], o[3]); w.z = cvt_pk_bf16(o[4], o[5]); w.w = cvt_pk_bf16(o[6], o[7]);
                *(u32x4*)rowp = w; }
    }
};
struct EpiResid {
    static constexpr bool PERM = true, SPLIT = true;
    const float* src_f32; bf16_t* xb; const float* src_ctx; float* dst_ctx; const float* gate_lat; const float* gate_ctx;
    __device__ __forceinline__ void operator()(const f32x4 (&acc)[2][2][4][2], const Unit& u, int wr, int wc, int fr, int fq) const {
        asm volatile("" : "+v"(fr), "+v"(fq));
        const int prow = u.pm * BM; const bool lat = prow < NLAT;
        const float* gate = lat ? gate_lat + (size_t)(prow / SEQ) * 6144 : gate_ctx;
        const int r0 = wr * 64 + fr, col0 = u.pn * BM + wc * 32 + 8 * fq;
        f32x4 gv[2][2];
#pragma unroll
        for (int bj = 0; bj < 2; ++bj)
#pragma unroll
            for (int n = 0; n < 2; ++n) gv[bj][n] = *(const f32x4*)(gate + col0 + bj * HALF + 4 * n);
        if (lat) {
#pragma unroll
            for (int ai = 0; ai < 2; ++ai)
#pragma unroll
                for (int m = 0; m < 4; ++m) { const size_t off = (size_t)(prow + r0 + ai * HALF + m * 16) * D + col0;
#pragma unroll
                    for (int bj = 0; bj < 2; ++bj) { f32x4 s0, s1;
                        if (src_f32) { s0 = *(const f32x4*)(src_f32 + off + bj * HALF); s1 = *(const f32x4*)(src_f32 + off + bj * HALF + 4); }
                        else unpack8(*(const u32x4*)(xb + off + bj * HALF), s0, s1);
                        *(u32x4*)(xb + off + bj * HALF) = pack8(s0 + gv[bj][0] * acc[ai][bj][m][0], s1 + gv[bj][1] * acc[ai][bj][m][1]); }
                    if (m == 3) asm volatile("" ::: "memory"); }
        } else {
            const float* src = src_ctx + (size_t)(prow - NLAT) * D; float* dst = dst_ctx + (size_t)(prow - NLAT) * D;
#pragma unroll
            for (int ai = 0; ai < 2; ++ai)
#pragma unroll
                for (int m = 0; m < 4; ++m) { const size_t off = (size_t)(r0 + ai * HALF + m * 16) * D + col0;
#pragma unroll
                    for (int bj = 0; bj < 2; ++bj)
#pragma unroll
                        for (int n = 0; n < 2; ++n) { const f32x4 sv = *(const f32x4*)(src + off + bj * HALF + 4 * n); *(f32x4*)(dst + off + bj * HALF + 4 * n) = sv + gv[bj][n] * acc[ai][bj][m][n]; }
                    asm volatile("" ::: "memory"); }
        }
    }
};
struct EpiMoeDown {
    static constexpr bool PERM = true, SPLIT = true;
    bf16_t* xb; const int* ptok; const float* pw; const float* gate_lat;
    __device__ __forceinline__ void operator()(const f32x4 (&acc)[2][2][4][2], const Unit& u, int wr, int wc, int fr, int fq) const {
        asm volatile("" : "+v"(fr), "+v"(fq));
        const int r0 = u.pm * BM + wr * 64 + fr, col0 = u.pn * BM + wc * 32 + 8 * fq;
        int tk[8]; float wk[8];
#pragma unroll
        for (int i = 0; i < 8; ++i) { const int r = r0 + (i >> 2) * HALF + (i & 3) * 16; tk[i] = ptok[r]; wk[i] = pw[r]; }
#pragma unroll
        for (int ai = 0; ai < 2; ++ai)
#pragma unroll
            for (int m = 0; m < 4; ++m) { const int tok = tk[ai * 4 + m]; const float w = wk[ai * 4 + m];
                if (tok >= 0) { bf16_t* xr = xb + (size_t)tok * D + col0; const float* gate = gate_lat + (size_t)(tok / SEQ) * 6144 + col0;
#pragma unroll
                    for (int bj = 0; bj < 2; ++bj) { const f32x4 g0 = *(const f32x4*)(gate + bj * HALF), g1 = *(const f32x4*)(gate + bj * HALF + 4); f32x4 s0, s1; unpack8(*(const u32x4*)(xr + bj * HALF), s0, s1);
                        *(u32x4*)(xr + bj * HALF) = pack8(s0 + (g0 * w) * acc[ai][bj][m][0], s1 + (g1 * w) * acc[ai][bj][m][1]); } }
                if (m & 1) asm volatile("" ::: "memory"); }
    }
};

template <class Epi>
__device__ __forceinline__ void gemm_phase(ldsp_t lds, const Gemm g, const Order& S, const Epi& E, const int tid) {
    const int wid = __builtin_amdgcn_readfirstlane(tid >> 6), lane = tid & 63, wr = wid >> 2, wc = wid & 3, fr = lane & 15, fq = lane >> 4;
    const int K = g.K;
    unsigned voffB[2];
#pragma unroll
    for (int i = 0; i < 2; ++i) { int R, C; stage_rc(tid * 16 + i * 8192, R, C); const int Rb = Epi::PERM ? ((R & ~31) + perm32(R & 31)) : R;
        voffB[i] = (unsigned)(Rb * K + C) * 2u; }
    const size_t kstep = (size_t)(BK * 2);
    const size_t hstep = (size_t)HALF * K * 2;
    const size_t tstep = 2 * hstep;
    const unsigned ldsw = (unsigned)wid * 1024u;
    const int aoff = lds_byte(wr * 64 + fr, fq * 8), boff = lds_byte(wc * 32 + fr, fq * 8);
#define PG8_SA(b, h) (((b) * 2 + (h)) * HTB)
#define PG8_SB(b, h) ((4 + (b) * 2 + (h)) * HTB)
#define PG8_STAGE_B(bufoff, gbase) do { _Pragma("unroll") for (int _i = 0; _i < 2; ++_i) \
        __builtin_amdgcn_global_load_lds((const unsigned*)((const char*)(gbase) + voffB[_i]), (LAS unsigned*)(lds + (bufoff) + ldsw + _i * 8192), 16, 0, 0); } while (0)
#define PG8_STAGE_A(bufoff, gbase, o0, o1) do { \
        __builtin_amdgcn_global_load_lds((const unsigned*)((const char*)(gbase) + (o0)), (LAS unsigned*)(lds + (bufoff) + ldsw), 16, 0, 0); \
        __builtin_amdgcn_global_load_lds((const unsigned*)((const char*)(gbase) + (o1)), (LAS unsigned*)(lds + (bufoff) + ldsw + 8192), 16, 0, 0); } while (0)
#define PG8_LDA(dst, b, h) do { _Pragma("unroll") for (int m = 0; m < 4; ++m) _Pragma("unroll") for (int k = 0; k < 2; ++k) dst[m][k] = *(const LAS bf16x8*)(lds + PG8_SA(b, h) + aoff + m * 2048 + k * 1024); } while (0)
#define PG8_LDB(dst, b, h) do { _Pragma("unroll") for (int n = 0; n < 2; ++n) _Pragma("unroll") for (int k = 0; k < 2; ++k) dst[n][k] = *(const LAS bf16x8*)(lds + PG8_SB(b, h) + boff + n * 2048 + k * 1024); } while (0)
#define PG8_MMA(ai, bj, At, Bt) do { __builtin_amdgcn_s_setprio(1); _Pragma("unroll") for (int m = 0; m < 4; ++m) _Pragma("unroll") for (int n = 0; n < 2; ++n) _Pragma("unroll") for (int k = 0; k < 2; ++k) \
        acc[ai][bj][m][n] = __builtin_amdgcn_mfma_f32_16x16x32_bf16(Bt[n][k], At[m][k], acc[ai][bj][m][n], 0, 0, 0); __builtin_amdgcn_s_setprio(0); } while (0)
#define PG8_WAIT_V(n) asm volatile("s_waitcnt vmcnt(" #n ")" ::: "memory")
#define PG8_WAIT_L(n) asm volatile("s_waitcnt lgkmcnt(" #n ")" ::: "memory")
#define PG8_BAR __builtin_amdgcn_s_barrier()
#define PG8_SCHED __builtin_amdgcn_sched_barrier(0)
#define PG8_AOFFS(u, o00, o01, o10, o11) do { int R0_, C0_, R1_, C1_; stage_rc(tid * 16, R0_, C0_); stage_rc(tid * 16 + 8192, R1_, C1_); \
        o00 = (unsigned)(S.arow(u, R0_) * K + C0_ + (u).kt0 * BK) * 2u; o01 = (unsigned)(S.arow(u, R1_) * K + C1_ + (u).kt0 * BK) * 2u; \
        o10 = (unsigned)(S.arow(u, HALF + R0_) * K + C0_ + (u).kt0 * BK) * 2u; o11 = (unsigned)(S.arow(u, HALF + R1_) * K + C1_ + (u).kt0 * BK) * 2u; } while (0)
    Unit cur, nxt; int ui = 0;
    if (!S.next(0, cur)) return;
    f32x4 acc[2][2][4][2];
    { float z_; asm volatile("v_mov_b32 %0, 0" : "=v"(z_));
#pragma unroll
    for (int a = 0; a < 2; ++a)
#pragma unroll
        for (int b = 0; b < 2; ++b)
#pragma unroll
            for (int m = 0; m < 4; ++m)
#pragma unroll
                for (int n = 0; n < 2; ++n) acc[a][b][m][n] = (f32x4){z_, z_, z_, z_}; }
    bf16x8 At[4][2], B0[2][2], B1[2][2];
    const char* const Abase = (const char*)g.A;
    const char* cB = (const char*)g.Bt + (size_t)cur.e * g.estride + (size_t)cur.pn * tstep + (size_t)cur.kt0 * kstep;
    unsigned c00, c01, c10, c11;
    PG8_AOFFS(cur, c00, c01, c10, c11);
    PG8_STAGE_B(PG8_SB(0, 0), cB); PG8_STAGE_B(PG8_SB(0, 1), cB + hstep); PG8_STAGE_A(PG8_SA(0, 0), Abase, c00, c01); PG8_STAGE_A(PG8_SA(0, 1), Abase, c10, c11);
    if (wr == 1) PG8_BAR;
    PG8_WAIT_V(2); PG8_BAR;
    PG8_STAGE_B(PG8_SB(1, 0), cB + kstep); PG8_STAGE_A(PG8_SA(1, 0), Abase + kstep, c00, c01); PG8_STAGE_B(PG8_SB(1, 1), cB + hstep + kstep);
    PG8_WAIT_V(6); PG8_BAR;
    for (;;) {
        const bool has_next = S.next(ui + 1, nxt);
        const char* nB = has_next ? (const char*)g.Bt + (size_t)nxt.e * g.estride + (size_t)nxt.pn * tstep + (size_t)nxt.kt0 * kstep : cB;
        const int nt = cur.nt;
        int rn0 = 0, rn1 = 0, rn2 = 0, rn3 = 0;
        if (S.rowmap && has_next) { int R0_, C0_, R1_, C1_; stage_rc(tid * 16, R0_, C0_); stage_rc(tid * 16 + 8192, R1_, C1_);
            rn0 = S.arow(nxt, R0_); rn1 = S.arow(nxt, R1_); rn2 = S.arow(nxt, HALF + R0_); rn3 = S.arow(nxt, HALF + R1_); }
        for (int t = 0; t < nt; t += 2) {
            const bool last = (t == nt - 2);
            const char* a1 = Abase + (size_t)(t + 1) * kstep;
            const char* a2 = last ? Abase : Abase + (size_t)(t + 2) * kstep; const char* b2 = last ? nB : cB + (size_t)(t + 2) * kstep;
            const char* a3 = a2 + kstep; const char* b3 = b2 + kstep;
            PG8_LDB(B0, 0, 0); PG8_LDB(B1, 0, 1); PG8_SCHED; PG8_LDA(At, 0, 0); PG8_STAGE_A(PG8_SA(1, 1), a1, c10, c11);
            PG8_WAIT_V(8); PG8_WAIT_L(0); PG8_BAR; PG8_MMA(0, 0, At, B0); PG8_MMA(0, 1, At, B1); PG8_BAR; PG8_SCHED;
            if (last && has_next) {
                if (S.rowmap) { int R0_, C0_, R1_, C1_; stage_rc(tid * 16, R0_, C0_); stage_rc(tid * 16 + 8192, R1_, C1_);
                    c00 = (unsigned)(rn0 * K + C0_ + nxt.kt0 * BK) * 2u; c01 = (unsigned)(rn1 * K + C1_ + nxt.kt0 * BK) * 2u; c10 = (unsigned)(rn2 * K + C0_ + nxt.kt0 * BK) * 2u; c11 = (unsigned)(rn3 * K + C1_ + nxt.kt0 * BK) * 2u; }
                else { PG8_AOFFS(nxt, c00, c01, c10, c11); } }
            PG8_LDA(At, 0, 1); PG8_STAGE_B(PG8_SB(0, 0), b2); PG8_STAGE_B(PG8_SB(0, 1), b2 + hstep); PG8_STAGE_A(PG8_SA(0, 0), a2, c00, c01);
            PG8_WAIT_V(8); PG8_WAIT_L(0); PG8_BAR; PG8_MMA(1, 0, At, B0); PG8_MMA(1, 1, At, B1); PG8_BAR; PG8_SCHED;
            PG8_LDB(B0, 1, 0); PG8_LDB(B1, 1, 1); PG8_SCHED; PG8_LDA(At, 1, 0); PG8_STAGE_A(PG8_SA(0, 1), a2, c10, c11);
            PG8_WAIT_V(8); PG8_WAIT_L(0); PG8_BAR; PG8_MMA(0, 0, At, B0); PG8_MMA(0, 1, At, B1); PG8_BAR; PG8_SCHED;
            PG8_LDA(At, 1, 1); PG8_STAGE_B(PG8_SB(1, 0), b3); PG8_STAGE_B(PG8_SB(1, 1), b3 + hstep); PG8_STAGE_A(PG8_SA(1, 0), a3, c00, c01);
            PG8_WAIT_V(8); PG8_WAIT_L(0); PG8_BAR; PG8_MMA(1, 0, At, B0); PG8_MMA(1, 1, At, B1); PG8_BAR; PG8_SCHED;
        }
        if (wr == 0) PG8_BAR;
        if (Epi::SPLIT && cur.slab >= 0) {
            int fr_ = fr, fq_ = fq; asm volatile("" : "+v"(fr_), "+v"(fq_));
            float* sp = g.slabs + (size_t)cur.slab * 65536 + (size_t)(wr * 64 + fr_) * 256 + wc * 32 + (Epi::PERM ? 8 : 4) * fq_;
#pragma unroll
            for (int ai = 0; ai < 2; ++ai)
#pragma unroll
                for (int m = 0; m < 4; ++m)
#pragma unroll
                    for (int bj = 0; bj < 2; ++bj)
#pragma unroll
                        for (int n = 0; n < 2; ++n) *(f32x4*)(sp + (ai * HALF + m * 16) * 256 + bj * HALF + n * (Epi::PERM ? 4 : 16)) = acc[ai][bj][m][n];
        } else E(acc, cur, wr, wc, fr, fq);
        if (!has_next) break;
        { float z_; asm volatile("v_mov_b32 %0, 0" : "=v"(z_));
#pragma unroll
        for (int a = 0; a < 2; ++a)
#pragma unroll
            for (int b = 0; b < 2; ++b)
#pragma unroll
                for (int m = 0; m < 4; ++m)
#pragma unroll
                    for (int n = 0; n < 2; ++n) acc[a][b][m][n] = (f32x4){z_, z_, z_, z_}; }
        cur = nxt; cB = nB; ++ui;
        if (wr == 1) PG8_BAR;
    }
    PG8_WAIT_V(0);
    PG8_BAR;
#undef PG8_SA
#undef PG8_SB
#undef PG8_STAGE_A
#undef PG8_STAGE_B
#undef PG8_LDA
#undef PG8_LDB
#undef PG8_MMA
#undef PG8_WAIT_V
#undef PG8_WAIT_L
#undef PG8_BAR
#undef PG8_SCHED
#undef PG8_AOFFS
}
}

struct Args { const float* in[27]; float* out; unsigned char* ws; int ph_lo, ph_hi; };
struct Frame {
    ldsp_t lds; int tid, lane, wave, wave0, G, bid;
    const Args* pa; float* out; unsigned char* ws;
    const Args* pa0; float* out0; unsigned char* ws0;
};
enum { I_X = 0, I_C, I_CTX, I_CCTX, I_WMOD, I_BMOD, I_GMIX, I_GFFN, I_GFINAL, I_WIN, I_WOUT, I_CONVW, I_CONVB, I_RGWA, I_RGBA, I_RGWX, I_RGBX, I_RGLAM, I_RETDEC,
       I_FW1, I_FW3, I_FW2, I_MROUTER, I_MROUTERB, I_MW1, I_MW3, I_MW2 };

constexpr int TRS = 64 * 65 * 4;
struct TrItem { const float* W; bf16_t* WT; int ldw, k0, n0, ldt, drow0; float scale; int perm; };
__device__ __forceinline__ void tr_load(const TrItem& t, f32x4 (&v)[16], int lane) {
    const int r4 = lane >> 4, c4 = (lane & 15) * 4;
#pragma unroll
    for (int i = 0; i < 16; ++i) v[i] = *(const f32x4*)(t.W + (size_t)(t.k0 + 4 * i + r4) * t.ldw + t.n0 + c4);
}
__device__ __forceinline__ void tr_store(const TrItem& t, const f32x4 (&v)[16], LAS float* scr, int lane) {
    { const int r4 = lane >> 4, c4 = (lane & 15) * 4;
#pragma unroll
      for (int i = 0; i < 16; ++i) { LAS float* d = scr + (4 * i + r4) * 65 + c4; d[0] = v[i].x; d[1] = v[i].y; d[2] = v[i].z; d[3] = v[i].w; } }
    LDS_WAIT(); asm volatile("" ::: "memory");
    const int c = lane & 7; const float scale = t.scale;
#pragma unroll
    for (int j = 0; j < 8; ++j) { const int n = (lane >> 3) + 8 * j; const LAS float* sp = scr + (8 * c) * 65 + n;
        u32x4 o; o.x = pk2(sp[0 * 65] * scale, sp[1 * 65] * scale); o.y = pk2(sp[2 * 65] * scale, sp[3 * 65] * scale); o.z = pk2(sp[4 * 65] * scale, sp[5 * 65] * scale); o.w = pk2(sp[6 * 65] * scale, sp[7 * 65] * scale);
        int drow = t.drow0 + n; if (t.perm) drow = (drow & ~127) + ((drow & 63) << 1) + ((drow >> 6) & 1);
        *(u32x4*)(t.WT + (size_t)drow * t.ldt + t.k0 + 8 * c) = o; }
    LDS_WAIT(); asm volatile("" ::: "memory");
}
__device__ __forceinline__ TrItem up_item(const float* w1, const float* w3, int F, bf16_t* WT, int r) {
    const int per = 16 * (F / 64); const int which = r / per; r -= which * per;
    const int nblk = F / 64, kb = r / nblk, nb = r % nblk, n0 = nb * 64;
    return TrItem{which ? w3 : w1, WT, F, kb * 64, n0, D, (n0 / 128) * 256 + (n0 % 128) + which * 128, 1.0f, 0};
}
__device__ __forceinline__ TrItem small_item(Frame& F, int r) {
    constexpr int I_IN = 16 * (INW / 64), I_OUT = 16 * (D / 64), I_UP = 2 * 16 * (DFF / 64);
    if (r < 2 * I_IN) { const int l = r / I_IN; r -= l * I_IN; const int nblk = INW / 64, kb = r / nblk, nb = r % nblk, n0 = nb * 64;
        const float sc = (n0 >= 1536 && n0 < 2048) ? 0.08838834764831845f : 1.0f;
        return TrItem{F.pa->in[I_WIN] + (size_t)l * D * INW, (bf16_t*)(F.ws + WS_WIN) + (size_t)l * INW * D, INW, kb * 64, n0, D, n0, sc, (n0 >= 1024 && n0 < 2048) ? 1 : 0}; }
    r -= 2 * I_IN;
    if (r < 2 * I_OUT) { const int l = r / I_OUT; r -= l * I_OUT; const int nblk = D / 64, kb = r / nblk, nb = r % nblk;
        return TrItem{F.pa->in[I_WOUT] + (size_t)l * D * D, (bf16_t*)(F.ws + WS_WOUT) + (size_t)l * D * D, D, kb * 64, nb * 64, D, nb * 64, 1.0f, 0}; }
    r -= 2 * I_OUT;
    if (r < I_UP) return up_item(F.pa->in[I_FW1], F.pa->in[I_FW3], DFF, (bf16_t*)(F.ws + WS_WUP), r);
    r -= I_UP;
    { const int nblk = D / 64, kb = r / nblk, nb = r % nblk; return TrItem{F.pa->in[I_FW2], (bf16_t*)(F.ws + WS_WDN), D, kb * 64, nb * 64, DFF, nb * 64, 1.0f, 0}; }
}
__device__ __forceinline__ TrItem moe_item(Frame& F, int it) {
    constexpr int I_UP = 2 * 16 * (DEXP / 64), I_DN = (DEXP / 64) * (D / 64), PER_E = I_UP + I_DN;
    const int e = it / PER_E; int r = it - e * PER_E;
    if (r < I_UP) return up_item(F.pa->in[I_MW1] + (size_t)e * D * DEXP, F.pa->in[I_MW3] + (size_t)e * D * DEXP, DEXP, (bf16_t*)(F.ws + WS_MOEUP) + (size_t)e * 2 * DEXP * D, r);
    r -= I_UP;
    { const int nblk = D / 64, kb = r / nblk, nb = r % nblk; return TrItem{F.pa->in[I_MW2] + (size_t)e * DEXP * D, (bf16_t*)F.out + (size_t)e * D * DEXP, D, kb * 64, nb * 64, DEXP, nb * 64, 1.0f, 0}; }
}
__device__ __forceinline__ void phase_convert_small(Frame& F) {
    LAS float* scr = (LAS float*)(F.lds + F.wave * TRS);
    const int gw = F.bid * NWAVES + F.wave, NGW = F.G * NWAVES;
    constexpr int NITEMS = 2 * 16 * (INW / 64) + 2 * 16 * (D / 64) + 2 * 16 * (DFF / 64) + (DFF / 64) * (D / 64);
    if (gw < NITEMS) { TrItem cur = small_item(F, gw); f32x4 va[16], vb[16]; tr_load(cur, va, F.lane);
        for (int it = gw; it < NITEMS; it += 2 * NGW) {
            const bool h1 = it + NGW < NITEMS; TrItem n1 = cur; if (h1) { n1 = small_item(F, it + NGW); tr_load(n1, vb, F.lane); }
            tr_store(cur, va, scr, F.lane);
            if (!h1) break;
            const bool h2 = it + 2 * NGW < NITEMS; if (h2) { cur = small_item(F, it + 2 * NGW); tr_load(cur, va, F.lane); }
            tr_store(n1, vb, scr, F.lane);
            if (!h2) break; } }
    { const int gt = F.bid * NTHREADS + F.tid, NGT = F.G * NTHREADS; bf16_t* o = (bf16_t*)(F.ws + WS_RGW);
      for (int i = gt; i < 2 * 2 * 2 * 8 * 64 * 64; i += NGT) { const int c = i & 63, dp = (i >> 6) & 63, blk = (i >> 12) & 7, gate = (i >> 15) & 1, dir = (i >> 16) & 1, l = i >> 17;
          const float* src = gate ? F.pa->in[I_RGWX] : F.pa->in[I_RGWA]; o[i] = (bf16_t)f2bf(src[((((size_t)l * 2 + dir) * 8 + blk) * 64 + c) * 64 + dp]); } }
    { const int gt = F.bid * NTHREADS + F.tid, NGT = F.G * NTHREADS; float* ct = (float*)(F.ws + WS_ROPE); float* st = ct + 4096 * 64;
      for (int i = gt; i < 4096 * 64; i += NGT) { const int pos = i >> 6, fi = i & 63; const float p = (float)((fi < 32) ? (pos >> 6) : (pos & 63));
          const float inv = powf(10000.0f, -(float)(fi & 31) / 32.0f); const float ang = p * inv;
          const double a = (double)ang; const double kq = __builtin_rint(a * 0.63661977236758134308); const double rr = a - kq * 1.57079632679489661923; const int q = ((int)kq) & 3;
          const double r2 = rr * rr;
          const double sn = rr * (1.0 + r2 * (-1.0 / 6 + r2 * (1.0 / 120 + r2 * (-1.0 / 5040 + r2 * (1.0 / 362880 + r2 * (-1.0 / 39916800))))));
          const double cs = 1.0 + r2 * (-0.5 + r2 * (1.0 / 24 + r2 * (-1.0 / 720 + r2 * (1.0 / 40320 + r2 * (-1.0 / 3628800 + r2 * (1.0 / 479001600))))));
          const double c_ = (q == 0) ? cs : (q == 1) ? -sn : (q == 2) ? -cs : sn; const double s_ = (q == 0) ? sn : (q == 1) ? cs : (q == 2) ? -sn : -cs;
          ct[i] = (float)c_; st[i] = (float)s_; } }
}
struct MoeTile { const float* W; bf16_t* WT; int ldw, k0, n0, ldt, up; };
__device__ __forceinline__ MoeTile moe_tile(Frame& F, int t) {
    constexpr int T_UP1 = (D / 128) * (DEXP / 256), T_DN = (DEXP / 128) * (D / 256), PER_E = 2 * T_UP1 + T_DN;
    const int e = t / PER_E; int r = t - e * PER_E;
    if (r < 2 * T_UP1) { const int which = r / T_UP1; r -= which * T_UP1; const int nb = DEXP / 256, kb = r / nb, nn = r % nb;
        return MoeTile{(which ? F.pa->in[I_MW3] : F.pa->in[I_MW1]) + (size_t)e * D * DEXP, (bf16_t*)(F.ws + WS_MOEUP) + (size_t)e * 2 * DEXP * D, DEXP, kb * 128, nn * 256, D, 1 + which}; }
    r -= 2 * T_UP1;
    { const int nb = D / 256, kb = r / nb, nn = r % nb; return MoeTile{F.pa->in[I_MW2] + (size_t)e * DEXP * D, (bf16_t*)F.out + (size_t)e * D * DEXP, D, kb * 128, nn * 256, DEXP, 0}; }
}
__device__ __forceinline__ void moe_tile_load(const MoeTile& t, f32x4 (&v)[16], int wave, int lane) {
#pragma unroll
    for (int i = 0; i < 16; ++i) v[i] = *(const f32x4*)(t.W + (size_t)(t.k0 + 16 * wave + i) * t.ldw + t.n0 + 4 * lane);
}
__device__ __forceinline__ void moe_tile_store(Frame& F, const MoeTile& t, const f32x4 (&v)[16]) {
    LAS float* tile = (LAS float*)F.lds;
#pragma unroll
    for (int i = 0; i < 16; ++i) { const int k = 16 * F.wave + i, p = (4 * F.lane + 2 * (k >> 3)) & 255;
        *(LAS f32x2*)(tile + k * 256 + p) = (f32x2){v[i].x, v[i].y}; *(LAS f32x2*)(tile + k * 256 + ((p + 2) & 255)) = (f32x2){v[i].z, v[i].w}; }
    __syncthreads();
#pragma unroll
    for (int j = 0; j < 8; ++j) { const int task = F.tid + j * NTHREADS, c = task & 15, n = task >> 4; const LAS float* sp = tile + (8 * c) * 256 + ((n + 2 * c) & 255);
        u32x4 o; o.x = pk2(sp[0], sp[256]); o.y = pk2(sp[512], sp[768]); o.z = pk2(sp[1024], sp[1280]); o.w = pk2(sp[1536], sp[1792]);
        const int col = t.n0 + n; const int drow = t.up ? (col >> 7) * 256 + (col & 127) + 128 * (t.up - 1) : col;
        *(u32x4*)(t.WT + (size_t)drow * t.ldt + t.k0 + 8 * c) = o; }
    __syncthreads();
}
__device__ __forceinline__ int moe_tile_of(int q) {
    constexpr int T_UP2 = 2 * (D / 128) * (DEXP / 256), T_DN = (DEXP / 128) * (D / 256), PER_E = T_UP2 + T_DN;
    if (q < NE * T_DN) { const int e = q / T_DN; return e * PER_E + T_UP2 + (q - e * T_DN); }
    q -= NE * T_DN; { const int e5 = q / T_UP2, e = (e5 + 5) & 7; return e * PER_E + (q - e5 * T_UP2); }
}
constexpr int FILL_EARLY = NE * (DEXP / 128) * (D / 256) + 3 * 2 * (D / 128) * (DEXP / 256);
static_assert(WS_MOEUP + (size_t)5 * 2 * DEXP * D * 2 >= WS_KV + (size_t)272 * 4 * 2 * 16384 * 2 && WS_MOEUP + (size_t)8 * 2 * DEXP * D * 2 <= WS_Y, "experts 5..7 of MOEUP sit in the gap between the state buffer and Y");
__device__ __forceinline__ int gemm_idle(int U, int G) { return (U % G) ? G - U % G : 0; }
constexpr int U_GIN = (MROWS / 256) * (INW / 256), U_GUP = (MROWS / 256) * (2 * DFF / 256);
__device__ __forceinline__ int fill_base(int G, int slot) {
    const int gin = 3 * gemm_idle(U_GIN, G), gup = 2 * gemm_idle(U_GUP, G);
    int b = 0; if (slot > 0) b += gin; if (slot > 1) b += gin; if (slot > 2) b += gup; if (slot > 3) b += 64; if (slot > 4) b += 64; if (slot > 5) b += 128;
    return b < FILL_EARLY ? b : FILL_EARLY;
}
__device__ __forceinline__ void moe_fill(Frame& F, int q0, int n) {
    const int tot = fill_base(F.G, 6); if (q0 + n > tot) n = tot - q0; if (n <= 0) return;
    f32x4 va[16], vb[16];
    const MoeTile a = moe_tile(F, moe_tile_of(q0)); moe_tile_load(a, va, F.wave, F.lane);
    MoeTile b = a; if (n > 1) { b = moe_tile(F, moe_tile_of(q0 + 1)); moe_tile_load(b, vb, F.wave, F.lane); }
    moe_tile_store(F, a, va);
    MoeTile c = a; if (n > 2) { c = moe_tile(F, moe_tile_of(q0 + 2)); moe_tile_load(c, va, F.wave, F.lane); }
    if (n > 1) moe_tile_store(F, b, vb);
    if (n > 2) moe_tile_store(F, c, va);
}
__device__ __forceinline__ void moe_fill_gemm(Frame& F, int U, int slot, int per) { const int left = U % F.G; if (left == 0 || F.bid < left) return; moe_fill(F, fill_base(F.G, slot) + per * (F.bid - left), per); }
__device__ __forceinline__ void phase_convert_moe(Frame& F) {
    constexpr int NT = NE * (2 * (D / 128) * (DEXP / 256) + (DEXP / 128) * (D / 256));
    const int q0 = fill_base(F.G, 6) + F.bid;
    if (q0 < NT) { MoeTile cur = moe_tile(F, moe_tile_of(q0)); f32x4 va[16], vb[16]; moe_tile_load(cur, va, F.wave, F.lane);
        for (int t = q0; t < NT; t += 2 * F.G) {
            const bool h1 = t + F.G < NT; MoeTile n1 = cur; if (h1) { n1 = moe_tile(F, moe_tile_of(t + F.G)); moe_tile_load(n1, vb, F.wave, F.lane); }
            moe_tile_store(F, cur, va);
            if (!h1) break;
            const bool h2 = t + 2 * F.G < NT; if (h2) { cur = moe_tile(F, moe_tile_of(t + 2 * F.G)); moe_tile_load(cur, va, F.wave, F.lane); }
            moe_tile_store(F, n1, vb);
            if (!h2) break; } }
}
__device__ __forceinline__ void phase_mod(Frame& F) {
    LAS float* sc = (LAS float*)F.lds;
    LAS float* red = (LAS float*)(F.lds + 9 * 1024 * 4);
    for (int i = F.tid; i < 9 * 1024; i += NTHREADS) { const int r = i >> 10, k = i & 1023; const float v = (r < 8) ? F.pa->in[I_C][r * 1024 + k] : F.pa->in[I_CCTX][k]; sc[i] = v / (1.0f + __expf(-v)); }
    __syncthreads();
    for (int strip = F.bid; strip < 2 * 6144 / 64; strip += F.G) {
        const int l = strip / 96, j = (strip % 96) * 64 + F.lane;
        const float* w = F.pa->in[I_WMOD] + (size_t)l * 1024 * 6144 + j;
        float a[9];
#pragma unroll
        for (int r = 0; r < 9; ++r) a[r] = 0.f;
        const int k0 = F.wave * 128;
#pragma unroll 1
        for (int kk = k0; kk < k0 + 128; kk += 16) { float wv[16];
#pragma unroll
            for (int i = 0; i < 16; ++i) wv[i] = w[(size_t)(kk + i) * 6144];
#pragma unroll
            for (int i = 0; i < 16; ++i) {
#pragma unroll
                for (int r = 0; r < 9; ++r) a[r] += sc[r * 1024 + kk + i] * wv[i];
                if ((i & 3) == 3) __builtin_amdgcn_sched_barrier(0); } }
#pragma unroll
        for (int r = 0; r < 9; ++r) red[(F.wave * 9 + r) * 64 + F.lane] = a[r];
        __syncthreads();
        for (int i = F.tid; i < 9 * 64; i += NTHREADS) { const int r = i >> 6, jj = i & 63; float s = 0.f;
#pragma unroll
            for (int w8 = 0; w8 < 8; ++w8) s += red[(w8 * 9 + r) * 64 + jj];
            const int col = (strip % 96) * 64 + jj; s += F.pa->in[I_BMOD][l * 6144 + col];
            if (r < 8) ((float*)(F.ws + WS_MODLAT))[((size_t)l * 8 + r) * 6144 + col] = s; else ((float*)(F.ws + WS_MODCTX))[(size_t)l * 6144 + col] = s; }
        __syncthreads();
    }
}

__device__ __forceinline__ void norm_row(const u32x2 (&xw)[4], const f32x4 (&Am)[4], const f32x4 (&Sh)[4], bf16_t* orow, int lane, f32x4 (&y)[4]) {
    f32x4 v[4]; float ss = 0.f;
#pragma unroll
    for (int j = 0; j < 4; ++j) { const u32x2 w = xw[j]; v[j] = (f32x4){bf2f(w.x & 0xffffu), __uint_as_float(w.x & 0xffff0000u), bf2f(w.y & 0xffffu), __uint_as_float(w.y & 0xffff0000u)};
        ss += (v[j].x * v[j].x + v[j].y * v[j].y) + (v[j].z * v[j].z + v[j].w * v[j].w); }
    const float rstd = 1.0f / sqrtf(wave_sum(ss) * (1.0f / D) + EPS);
    u32x2* o8 = (u32x2*)orow + lane;
#pragma unroll
    for (int j = 0; j < 4; ++j) { y[j] = (v[j] * rstd) * Am[j] + Sh[j]; o8[64 * j] = (u32x2){pk2(y[j].x, y[j].y), pk2(y[j].z, y[j].w)}; }
}
struct SlabRed { const float* slab; int S; const float* gate; const float* xold; float* xnew; };
__device__ __forceinline__ void norm_row_v(f32x4 (&v)[4], const float* g, const float* shift, const float* scale, bf16_t* orow, int lane) {
    float ss = 0.f;
#pragma unroll
    for (int j = 0; j < 4; ++j) ss += (v[j].x * v[j].x + v[j].y * v[j].y) + (v[j].z * v[j].z + v[j].w * v[j].w);
    const float rstd = 1.0f / sqrtf(wave_sum(ss) * (1.0f / D) + EPS);
    u32x2* o8 = (u32x2*)orow + lane;
#pragma unroll
    for (int j = 0; j < 4; ++j) { const f32x4 gg = ((const f32x4*)g)[lane + 64 * j], sh = ((const f32x4*)shift)[lane + 64 * j], sl = ((const f32x4*)scale)[lane + 64 * j];
        const f32x4 y = (v[j] * rstd) * gg * (sl + 1.0f) + sh;
        u32x2 w; w.x = pk2(y.x, y.y); w.y = pk2(y.z, y.w); o8[64 * j] = w; }
}
__device__ __forceinline__ void phase_norm(Frame& F, int l, int sel, const float* xlat, const bf16_t* xb, const float* xctx, int nrows, const SlabRed sr) {
    const int gw = F.bid * NWAVES + F.wave, NGW = F.G * NWAVES;
    const float* g = (sel ? F.pa->in[I_GFFN] : F.pa->in[I_GMIX]) + l * D; const int so = sel ? 3072 : 0;
    bf16_t* HX = (bf16_t*)(F.ws + WS_HX);
    const int nlat = nrows < NLAT ? nrows : NLAT; const int per = (nlat + NGW - 1) / NGW, r_lo = gw * per, r_hi = (r_lo + per < nlat) ? r_lo + per : nlat;
    int curb = -1; f32x4 Am[4], Sh[4];
    for (int row0 = r_lo; row0 < r_hi; row0 += 4) {
        f32x4 v[4][4];
#pragma unroll
        for (int u = 0; u < 4; ++u) { const int row = (row0 + u < r_hi) ? row0 + u : row0;
            if (xb) { const u32x2* xr = (const u32x2*)(xb + (size_t)row * D) + F.lane;
#pragma unroll
                for (int j = 0; j < 4; ++j) { const u32x2 w = xr[64 * j]; v[u][j] = (f32x4){bf2f(w.x & 0xffffu), __uint_as_float(w.x & 0xffff0000u), bf2f(w.y & 0xffffu), __uint_as_float(w.y & 0xffff0000u)}; } }
            else { const f32x4* xr = (const f32x4*)(xlat + (size_t)row * D) + F.lane;
#pragma unroll
                for (int j = 0; j < 4; ++j) v[u][j] = xr[64 * j]; } }
#pragma unroll
        for (int u = 0; u < 4; ++u) { const int row = row0 + u; if (row >= r_hi) continue;
            const int b = row / SEQ;
            if (b != curb) { curb = b; const float* mod = (const float*)(F.ws + WS_MODLAT) + ((size_t)l * 8 + b) * 6144 + so;
#pragma unroll
                for (int j = 0; j < 4; ++j) { Am[j] = ((const f32x4*)g)[F.lane + 64 * j] * (((const f32x4*)(mod + 1024))[F.lane + 64 * j] + 1.0f); Sh[j] = ((const f32x4*)mod)[F.lane + 64 * j]; } }
            float ss = 0.f;
#pragma unroll
            for (int j = 0; j < 4; ++j) ss += (v[u][j].x * v[u][j].x + v[u][j].y * v[u][j].y) + (v[u][j].z * v[u][j].z + v[u][j].w * v[u][j].w);
            const float rstd = 1.0f / sqrtf(wave_sum(ss) * (1.0f / D) + EPS);
            u32x2* o8 = (u32x2*)(HX + (size_t)row * D) + F.lane;
#pragma unroll
            for (int j = 0; j < 4; ++j) { const f32x4 y = (v[u][j] * rstd) * Am[j] + Sh[j]; o8[64 * j] = (u32x2){pk2(y.x, y.y), pk2(y.z, y.w)}; } }
    }
    for (int row = NLAT + gw; row < nrows; row += NGW) {
        const float* mod = (const float*)(F.ws + WS_MODCTX) + (size_t)l * 6144;
        f32x4 v[4];
        if (sr.slab == nullptr) { const f32x4* xr = (const f32x4*)(xctx + (size_t)(row - NLAT) * D) + F.lane;
#pragma unroll
            for (int j = 0; j < 4; ++j) v[j] = xr[64 * j]; }
        else { const int rc = row - NLAT, pmr = rc >> 8, r = rc & 255;
            f32x4 t8[4][8], xo[4];
#pragma unroll
            for (int j = 0; j < 4; ++j) { const float* sp = sr.slab + (size_t)((pmr + 8 * j) * sr.S) * 65536 + (size_t)r * 256 + 4 * F.lane;
#pragma unroll
                for (int q = 0; q < 8; ++q) t8[j][q] = *(const f32x4*)(sp + (size_t)(q < sr.S ? q : sr.S - 1) * 65536);
                xo[j] = ((const f32x4*)(sr.xold + (size_t)rc * D))[F.lane + 64 * j]; }
#pragma unroll
            for (int j = 0; j < 4; ++j) { f32x4 a = zero4();
#pragma unroll
                for (int q = 0; q < 8; ++q) a += t8[j][q] * (q < sr.S ? 1.0f : 0.0f);
                v[j] = xo[j] + ((const f32x4*)sr.gate)[F.lane + 64 * j] * a;
                ((f32x4*)(sr.xnew + (size_t)rc * D))[F.lane + 64 * j] = v[j]; } }
        norm_row_v(v, g, mod + so, mod + so + 1024, HX + (size_t)row * D, F.lane);
    }
}
__device__ __forceinline__ void moe_reduce(Frame& F, int k) {
    const int* meta = (const int*)(F.ws + MOE_META) + 9 * k; const int npan = meta[8], gsz = npan - 128;
    if (gsz <= 0) return;
    const int S = pg8::split_factor(npan * 4, F.G, DEXP / 64, MAXSLAB_M); if (S < 2) return;
    const int gw = F.bid * NWAVES + F.wave, NGW = F.G * NWAVES;
    const int* ptok = (const int*)(F.ws + MOE_PTOK) + k * MROWS; const float* pw = (const float*)(F.ws + MOE_PW) + k * MROWS;
    const float* slab = (const float*)(F.ws + WS_SLABM); const float* gate_lat = (const float*)(F.ws + WS_MODLAT) + (size_t)8 * 6144 + 5120;
    for (int rr = NLAT + gw; rr < npan * 256; rr += NGW) { const int tok = ptok[rr]; if (tok < 0) continue; const float w = pw[rr];
        const int pmr = (rr - NLAT) >> 8, r = rr & 255; u32x2* xr = (u32x2*)((bf16_t*)((char*)F.out + XB_OFF) + (size_t)tok * D); const f32x4* gt = (const f32x4*)(gate_lat + (size_t)(tok / SEQ) * 6144);
        f32x4 t8[4][8];
#pragma unroll
        for (int j = 0; j < 4; ++j) { const float* sp = slab + (size_t)((pmr + gsz * j) * S) * 65536 + (size_t)r * 256 + 4 * F.lane;
#pragma unroll
            for (int q = 0; q < 8; ++q) t8[j][q] = *(const f32x4*)(sp + (size_t)(q < S ? q : S - 1) * 65536); }
#pragma unroll
        for (int j = 0; j < 4; ++j) { f32x4 a = zero4();
#pragma unroll
            for (int q = 0; q < 8; ++q) a += t8[j][q] * (q < S ? 1.0f : 0.0f);
            const u32x2 xo = xr[F.lane + 64 * j]; const f32x4 xv = {bf2f(xo.x & 0xffffu), __uint_as_float(xo.x & 0xffff0000u), bf2f(xo.y & 0xffffu), __uint_as_float(xo.y & 0xffff0000u)};
            const f32x4 y = xv + (gt[F.lane + 64 * j] * w) * a; xr[F.lane + 64 * j] = (u32x2){pk2(y.x, y.y), pk2(y.z, y.w)}; } }
}
__device__ __forceinline__ void phase_norm_router(Frame& F, const bf16_t* xb) {
    constexpr int l = 1;
    LAS float* wr = (LAS float*)F.lds;
    LAS int* le = (LAS int*)(F.lds + 32768);
    for (int i = F.tid; i < 1024 * 8 / 4; i += NTHREADS) ((LAS f32x4*)wr)[i] = ((const f32x4*)F.pa->in[I_MROUTER])[i];
    __syncthreads();
    const float* g = F.pa->in[I_GFFN] + l * D; bf16_t* HX = (bf16_t*)(F.ws + WS_HX);
    int* toke = (int*)(F.ws + MOE_TOKE); float* tokw = (float*)(F.ws + MOE_TOKW);
    for (int wg = F.bid; wg < NLAT / 128; wg += F.G) {
        u32x2 nx[4]; f32x4 Am[4], Sh[4];
        { const float* mod = (const float*)(F.ws + WS_MODLAT) + ((size_t)l * 8 + (wg * 128) / SEQ) * 6144 + 3072;
#pragma unroll
          for (int j = 0; j < 4; ++j) { Am[j] = ((const f32x4*)g)[F.lane + 64 * j] * (((const f32x4*)(mod + 1024))[F.lane + 64 * j] + 1.0f); Sh[j] = ((const f32x4*)mod)[F.lane + 64 * j]; } }
        { const u32x2* xr = (const u32x2*)(xb + (size_t)(wg * 128 + F.wave * 16) * D) + F.lane;
#pragma unroll
          for (int j = 0; j < 4; ++j) nx[j] = xr[64 * j]; }
        for (int i = 0; i < 16; ++i) { const int tl = F.wave * 16 + i, row = wg * 128 + tl;
            u32x2 cx[4];
#pragma unroll
            for (int j = 0; j < 4; ++j) cx[j] = nx[j];
            { const int rn = (i < 15) ? row + 1 : row; const u32x2* xr = (const u32x2*)(xb + (size_t)rn * D) + F.lane;
#pragma unroll
              for (int j = 0; j < 4; ++j) nx[j] = xr[64 * j]; }
            f32x4 y[4]; norm_row(cx, Am, Sh, HX + (size_t)row * D, F.lane, y);
            float lg[8];
#pragma unroll
            for (int e = 0; e < 8; ++e) lg[e] = 0.f;
#pragma unroll
            for (int j = 0; j < 4; ++j)
#pragma unroll
                for (int q = 0; q < 4; ++q) { const int k = 4 * F.lane + 256 * j + q; const f32x4 w0 = *(const LAS f32x4*)(wr + k * 8), w1 = *(const LAS f32x4*)(wr + k * 8 + 4); const float yv = y[j][q];
                    lg[0] += yv * w0.x; lg[1] += yv * w0.y; lg[2] += yv * w0.z; lg[3] += yv * w0.w; lg[4] += yv * w1.x; lg[5] += yv * w1.y; lg[6] += yv * w1.z; lg[7] += yv * w1.w; }
#pragma unroll
            for (int e = 0; e < 8; ++e) lg[e] = wave_sum(lg[e]) + F.pa->in[I_MROUTERB][e];
            int e0 = 0; float v0 = lg[0];
#pragma unroll
            for (int e = 1; e < 8; ++e) if (lg[e] > v0) { v0 = lg[e]; e0 = e; }
            int e1 = -1; float v1 = -3.0e38f;
#pragma unroll
            for (int e = 0; e < 8; ++e) if (e != e0 && lg[e] > v1) { v1 = lg[e]; e1 = e; }
            const float w0 = 1.0f / (1.0f + __expf(v1 - v0));
            if (F.lane == 0) { toke[row] = e0 | (e1 << 8); tokw[2 * row] = w0; tokw[2 * row + 1] = 1.0f - w0; le[tl] = e0 | (e1 << 8); }
        }
        __syncthreads();
        if (F.tid < 16) { const int k = F.tid >> 3, e = F.tid & 7; int c = 0; for (int t = 0; t < 128; ++t) c += (((le[t] >> (8 * k)) & 0xff) == e) ? 1 : 0; ((int*)(F.ws + MOE_CNT))[wg * 16 + F.tid] = c; }
        __syncthreads();
    }
}
__device__ __forceinline__ void phase_moe_sort(Frame& F) {
    LAS int* tot = (LAS int*)F.lds;
    LAS int* pre = tot + 16;
    LAS int* seg = tot + 32;
    LAS int* le = tot + 64;
    const int* cnt = (const int*)(F.ws + MOE_CNT); const int* toke = (const int*)(F.ws + MOE_TOKE); const float* tokw = (const float*)(F.ws + MOE_TOKW);
    int* ptok = (int*)(F.ws + MOE_PTOK); float* pw = (float*)(F.ws + MOE_PW); int* meta = (int*)(F.ws + MOE_META);
    for (int wg = F.bid; wg < NLAT / 128; wg += F.G) {
        { LAS int* part = tot + 256;
          if (F.tid < 256) { const int col = F.tid & 15, pt = F.tid >> 4; int t = 0, p = 0;
#pragma unroll
              for (int i = 0; i < 16; ++i) { const int w = pt * 16 + i; const int c = cnt[w * 16 + col]; t += c; p += (w < wg) ? c : 0; }
              part[pt * 16 + col] = t; part[256 + pt * 16 + col] = p; }
          if (F.tid >= 256 && F.tid < 384) le[F.tid - 256] = toke[wg * 128 + F.tid - 256];
          __syncthreads();
          if (F.tid < 16) { int t = 0, p = 0;
#pragma unroll
              for (int pt = 0; pt < 16; ++pt) { t += part[pt * 16 + F.tid]; p += part[256 + pt * 16 + F.tid]; }
              tot[F.tid] = t; pre[F.tid] = p; } }
        __syncthreads();
        if (F.tid < 2) { int s = 0; for (int e = 0; e < 8; ++e) { seg[F.tid * 9 + e] = s; s += (tot[F.tid * 8 + e] + 255) & ~255; } seg[F.tid * 9 + 8] = s; }
        __syncthreads();
        if (F.tid < 256) { const int k = F.tid >> 7, t = F.tid & 127; const int e = (le[t] >> (8 * k)) & 0xff; int rank = 0; for (int u = 0; u < t; ++u) rank += (((le[u] >> (8 * k)) & 0xff) == e) ? 1 : 0;
            const int pos = seg[k * 9 + e] + pre[k * 8 + e] + rank; const int tok = wg * 128 + t; ptok[k * MROWS + pos] = tok; pw[k * MROWS + pos] = tokw[2 * tok + k]; ((int*)(F.ws + MOE_PPOS))[k * NLAT + tok] = pos; }
        if (wg < 16) { const int k = wg >> 3, e = wg & 7; const int a = seg[k * 9 + e] + tot[k * 8 + e], b = seg[k * 9 + e + 1]; for (int p = a + F.tid; p < b; p += NTHREADS) { ptok[k * MROWS + p] = -1; pw[k * MROWS + p] = 0.f; } }
        if (wg == 0 && F.tid < 18) meta[F.tid] = seg[F.tid] >> 8;
        __syncthreads();
    }
}
__device__ __forceinline__ void phase_final_a(Frame& F) {
    const int gw = F.bid * NWAVES + F.wave, NGW = F.G * NWAVES; const float* g = F.pa->in[I_GFINAL];
    const bf16_t* xb = (const bf16_t*)((const char*)F.out + XB_OFF); bf16_t* xc = (bf16_t*)(F.ws + WS_XCOPY);
    const int* meta = (const int*)(F.ws + MOE_META) + 9; const int npan = meta[8], gsz = npan - 128;
    const int S = (gsz > 0) ? pg8::split_factor(npan * 4, F.G, DEXP / 64, MAXSLAB_M) : 1;
    const int* ppos = (const int*)(F.ws + MOE_PPOS) + NLAT; const float* pw = (const float*)(F.ws + MOE_PW) + MROWS;
    const float* slab = (const float*)(F.ws + WS_SLABM); const float* gate_lat = (const float*)(F.ws + WS_MODLAT) + (size_t)8 * 6144 + 5120;
    for (int row0 = gw; row0 < NLAT; row0 += 4 * NGW) {
        u32x2 w[4][4]; int rr[4];
#pragma unroll
        for (int u = 0; u < 4; ++u) { const int row = (row0 + u * NGW < NLAT) ? row0 + u * NGW : row0; const u32x2* xr = (const u32x2*)(xb + (size_t)row * D) + F.lane; rr[u] = ppos[row];
#pragma unroll
            for (int j = 0; j < 4; ++j) w[u][j] = xr[64 * j]; }
#pragma unroll
        for (int u = 0; u < 4; ++u) { const int row = row0 + u * NGW; if (row >= NLAT) continue;
            f32x4 v[4];
#pragma unroll
            for (int j = 0; j < 4; ++j) v[j] = (f32x4){bf2f(w[u][j].x & 0xffffu), __uint_as_float(w[u][j].x & 0xffff0000u), bf2f(w[u][j].y & 0xffffu), __uint_as_float(w[u][j].y & 0xffff0000u)};
            if (S >= 2 && rr[u] >= NLAT) { const float wt = pw[rr[u]]; const int pmr = (rr[u] - NLAT) >> 8, r = rr[u] & 255; const f32x4* gt = (const f32x4*)(gate_lat + (size_t)(row / SEQ) * 6144);
#pragma unroll
                for (int j = 0; j < 4; ++j) { f32x4 a = zero4(); const float* sp = slab + (size_t)((pmr + gsz * j) * S) * 65536 + (size_t)r * 256 + 4 * F.lane;
                    { f32x4 t8[8];
#pragma unroll
                      for (int q = 0; q < 8; ++q) t8[q] = *(const f32x4*)(sp + (size_t)(q < S ? q : S - 1) * 65536);
#pragma unroll
                      for (int q = 0; q < 8; ++q) a += t8[q] * (q < S ? 1.0f : 0.0f); }
                    v[j] += (gt[F.lane + 64 * j] * wt) * a; } }
            if (row < NLAT / 2) { float ss = 0.f;
#pragma unroll
                for (int j = 0; j < 4; ++j) ss += (v[j].x * v[j].x + v[j].y * v[j].y) + (v[j].z * v[j].z + v[j].w * v[j].w);
                const float rstd = 1.0f / sqrtf(wave_sum(ss) * (1.0f / D) + EPS); f32x4* o = (f32x4*)(F.out + (size_t)row * D) + F.lane;
#pragma unroll
                for (int j = 0; j < 4; ++j) o[64 * j] = (v[j] * rstd) * ((const f32x4*)g)[F.lane + 64 * j]; }
            else { u32x2* o = (u32x2*)(xc + (size_t)(row - NLAT / 2) * D) + F.lane;
#pragma unroll
                for (int j = 0; j < 4; ++j) o[64 * j] = (u32x2){pk2(v[j].x, v[j].y), pk2(v[j].z, v[j].w)}; } }
    }
}
__device__ __forceinline__ void phase_final_b(Frame& F) {
    const int gw = F.bid * NWAVES + F.wave, NGW = F.G * NWAVES; const float* g = F.pa->in[I_GFINAL]; const bf16_t* xc = (const bf16_t*)(F.ws + WS_XCOPY);
    for (int row0 = NLAT / 2 + gw; row0 < NLAT; row0 += 4 * NGW) {
        u32x2 w[4][4];
#pragma unroll
        for (int u = 0; u < 4; ++u) { const int row = (row0 + u * NGW < NLAT) ? row0 + u * NGW : row0; const u32x2* xr = (const u32x2*)(xc + (size_t)(row - NLAT / 2) * D) + F.lane;
#pragma unroll
            for (int j = 0; j < 4; ++j) w[u][j] = xr[64 * j]; }
#pragma unroll
        for (int u = 0; u < 4; ++u) { const int row = row0 + u * NGW; if (row >= NLAT) continue;
            f32x4 v[4]; float ss = 0.f;
#pragma unroll
            for (int j = 0; j < 4; ++j) { v[j] = (f32x4){bf2f(w[u][j].x & 0xffffu), __uint_as_float(w[u][j].x & 0xffff0000u), bf2f(w[u][j].y & 0xffffu), __uint_as_float(w[u][j].y & 0xffff0000u)};
                ss += (v[j].x * v[j].x + v[j].y * v[j].y) + (v[j].z * v[j].z + v[j].w * v[j].w); }
            const float rstd = 1.0f / sqrtf(wave_sum(ss) * (1.0f / D) + EPS); f32x4* o = (f32x4*)(F.out + (size_t)row * D) + F.lane;
#pragma unroll
            for (int j = 0; j < 4; ++j) o[64 * j] = (v[j] * rstd) * ((const f32x4*)g)[F.lane + 64 * j]; }
    }
}

__device__ __forceinline__ bool fresh(Frame& F) {
    int l_ = (int)__builtin_amdgcn_mbcnt_hi(~0u, __builtin_amdgcn_mbcnt_lo(~0u, 0u)); asm volatile("" : "+v"(l_));
    int w_ = F.wave0; asm volatile("" : "+s"(w_));
    F.lane = l_; F.wave = w_; F.tid = w_ * 64 + l_;
    int b_ = blockIdx.x; asm volatile("" : "+s"(b_)); F.bid = b_;
    GAS unsigned char* w2_ = (GAS unsigned char*)F.ws0; asm volatile("" : "+s"(w2_)); F.ws = (unsigned char*)w2_;
    F.out = F.out0; F.pa = F.pa0;
    return true;
}
struct Item { int b, s, row0, seqbase, t0, seqlen; bool is_ctx; };
__device__ __forceinline__ Item item_info(int item) {
    Item it; it.b = item / SPB; it.s = item % SPB;
    if (it.s < 2) { it.is_ctx = true; it.seqbase = NLAT + it.b * CTXL; it.t0 = it.s * CHK; it.seqlen = CTXL; }
    else { it.is_ctx = false; it.seqbase = it.b * SEQ; it.t0 = (it.s - 2) * CHK; it.seqlen = SEQ; }
    it.row0 = it.seqbase + it.t0; return it;
}
constexpr int UCP = 144;
constexpr int TP = 272;
constexpr int TILEB = 128 * TP;
constexpr int VP = 288;
constexpr int TILEV = 128 * VP;

__device__ __forceinline__ unsigned tr_lane_addr(ldsp_t tile, int lane) { return (unsigned)(__SIZE_TYPE__)tile + (unsigned)((4 * (lane >> 4) + ((lane & 15) >> 2)) * VP + 8 * (lane & 3)); }
__device__ __forceinline__ bf16x8 mk_frag(u32x2 lo, u32x2 hi) { const u32x4 v = {lo.x, lo.y, hi.x, hi.y}; return __builtin_bit_cast(bf16x8, v); }
template <int OFF> __device__ __forceinline__ bf16x8 tr1(unsigned addr) {
    u32x2 a0, a1;
    asm volatile("ds_read_b64_tr_b16 %0, %2 offset:%3\n\tds_read_b64_tr_b16 %1, %2 offset:%4\n\ts_waitcnt lgkmcnt(0)" : "=&v"(a0), "=&v"(a1) : "v"(addr), "i"(OFF), "i"(OFF + 16 * VP) : "memory");
    return mk_frag(a0, a1);
}
template <int OFF> __device__ __forceinline__ void tr4(unsigned addr, bf16x8& f0, bf16x8& f1, bf16x8& f2, bf16x8& f3) {
    u32x2 a0, a1, b0, b1, c0, c1, d0, d1;
    asm volatile("ds_read_b64_tr_b16 %0, %8 offset:%9\n\tds_read_b64_tr_b16 %1, %8 offset:%10\n\tds_read_b64_tr_b16 %2, %8 offset:%11\n\tds_read_b64_tr_b16 %3, %8 offset:%12\n\t"
                 "ds_read_b64_tr_b16 %4, %8 offset:%13\n\tds_read_b64_tr_b16 %5, %8 offset:%14\n\tds_read_b64_tr_b16 %6, %8 offset:%15\n\tds_read_b64_tr_b16 %7, %8 offset:%16\n\ts_waitcnt lgkmcnt(0)"
                 : "=&v"(a0), "=&v"(a1), "=&v"(b0), "=&v"(b1), "=&v"(c0), "=&v"(c1), "=&v"(d0), "=&v"(d1)
                 : "v"(addr), "i"(OFF), "i"(OFF + 16 * VP), "i"(OFF + 32), "i"(OFF + 32 + 16 * VP), "i"(OFF + 64), "i"(OFF + 64 + 16 * VP), "i"(OFF + 96), "i"(OFF + 96 + 16 * VP) : "memory");
    f0 = mk_frag(a0, a1); f1 = mk_frag(b0, b1); f2 = mk_frag(c0, c1); f3 = mk_frag(d0, d1);
}

__device__ __forceinline__ void build_decay(Frame& F, int l) {
    LAS float* dec = (LAS float*)(F.lds + LDS_DEC);
    for (int i = F.tid; i < 2 * 4 * 132; i += NTHREADS) { const int n = i % 132, dh = i / 132; const float x = F.pa->in[I_RETDEC][l * 8 + dh]; const float lg = -log1pf(expf(-x)); dec[i] = expf((float)n * lg); }
}

struct RgStep { bf16x8 bwa[2], bwx[2]; float lam, ba, bx, carry; };
template <bool FINAL>
__device__ __forceinline__ void rg_load_step(RgStep& R, Frame& F, const bf16_t* wgt, int l, int dir, int item, int blk, int n, int lane) {
    const int fr = lane & 15, fq = lane >> 4;
    const bf16_t* wa = wgt + ((size_t)(0 * 8 + blk) * 64 + 16 * n + fr) * 64 + 8 * fq;
    const bf16_t* wx = wgt + ((size_t)(1 * 8 + blk) * 64 + 16 * n + fr) * 64 + 8 * fq;
    R.bwa[0] = *(const bf16x8*)wa; R.bwa[1] = *(const bf16x8*)(wa + 32); R.bwx[0] = *(const bf16x8*)wx; R.bwx[1] = *(const bf16x8*)(wx + 32);
    const int ch = blk * 64 + 16 * n + fr, pi = (l * 2 + dir) * 512 + ch;
    R.lam = F.pa->in[I_RGLAM][pi]; R.ba = F.pa->in[I_RGBA][pi]; R.bx = F.pa->in[I_RGBX][pi];
    R.carry = FINAL ? ((const float*)(F.ws + WS_CARRY))[((size_t)item * 2 + dir) * 512 + ch] : 0.f;
}
template <bool FINAL, int DIR>
__device__ __forceinline__ void rg_dir(ldsp_t ucw, const bf16x8 (&af)[8][2], const RgStep& R, int n, int lane, f32x4 (&hsum)[8], float& Atot, float& Htot) {
    const int fr = lane & 15, fq = lane >> 4;
    constexpr float L2E_ = 1.4426950408889634f;
    const float ba2 = -L2E_ * R.ba, bx2 = -L2E_ * R.bx, cl2 = -8.0f * L2E_ * log1pf(expf(-R.lam)), carry = R.carry;
    const bf16x8 bwa[2] = {R.bwa[0], R.bwa[1]}, bwx[2] = {R.bwx[0], R.bwx[1]};
    f32x4 ar[8], ai[8];
#pragma unroll
    for (int m = 0; m < 8; ++m) { ar[m] = zero4(); ai[m] = zero4(); }
#pragma unroll
    for (int m = 0; m < 8; ++m)
#pragma unroll
        for (int ks = 0; ks < 2; ++ks) { ar[m] = __builtin_amdgcn_mfma_f32_16x16x32_bf16(af[m][ks], bwa[ks], ar[m], 0, 0, 0); ai[m] = __builtin_amdgcn_mfma_f32_16x16x32_bf16(af[m][ks], bwx[ks], ai[m], 0, 0, 0); }
    const unsigned uo = (unsigned)(32 * fq * UCP + (16 * n + fr) * 2);
#pragma unroll
    for (int m = 0; m < 8; ++m)
#pragma unroll
        for (int jj = 0; jj < 4; ++jj) {
            const float r = __builtin_amdgcn_rcpf(1.0f + __builtin_amdgcn_exp2f(__builtin_fmaf(ar[m][jj], -1.4426950408889634f, ba2)));
            const float ig = __builtin_amdgcn_rcpf(1.0f + __builtin_amdgcn_exp2f(__builtin_fmaf(ai[m][jj], -1.4426950408889634f, bx2)));
            const float a = __builtin_amdgcn_exp2f(cl2 * r);
            const float u = bf2f(*(const LAS bf16_t*)(ucw + uo + (4 * m + jj) * UCP));
            ar[m][jj] = a; ai[m][jj] = __builtin_amdgcn_sqrtf(__builtin_fmaf(-a, a, 1.0f)) * ig * u; }
    float gA = 1.f, gH = 0.f;
#pragma unroll
    for (int mm = 0; mm < 8; ++mm) { const int m = DIR ? 7 - mm : mm;
#pragma unroll
        for (int j4 = 0; j4 < 4; ++j4) { const int jj = DIR ? 3 - j4 : j4; gH = __builtin_fmaf(ar[m][jj], gH, ai[m][jj]); gA *= ar[m][jj]; } }
    const float A0 = lane_bcast(gA, fr), H0 = lane_bcast(gH, fr), A1 = lane_bcast(gA, fr + 16), H1 = lane_bcast(gH, fr + 16), A2 = lane_bcast(gA, fr + 32), H2 = lane_bcast(gH, fr + 32), A3 = lane_bcast(gA, fr + 48), H3 = lane_bcast(gH, fr + 48);
    if (FINAL) { float h = carry;
        if (!DIR) { if (fq > 0) h = A0 * h + H0; if (fq > 1) h = A1 * h + H1; if (fq > 2) h = A2 * h + H2; }
        else { if (fq < 3) h = A3 * h + H3; if (fq < 2) h = A2 * h + H2; if (fq < 1) h = A1 * h + H1; }
#pragma unroll
        for (int mm = 0; mm < 8; ++mm) { const int m = DIR ? 7 - mm : mm;
#pragma unroll
            for (int j4 = 0; j4 < 4; ++j4) { const int jj = DIR ? 3 - j4 : j4; h = __builtin_fmaf(ar[m][jj], h, ai[m][jj]); hsum[m][jj] += h; } } }
    if (!DIR) Htot = A3 * (A2 * (A1 * H0 + H1) + H2) + H3; else Htot = A0 * (A1 * (A2 * H3 + H2) + H1) + H0;
    Atot = (A0 * A1) * (A2 * A3);
}
template <bool FINAL, bool SHARED = false>
__device__ __forceinline__ void rg_part(Frame& F, int l, int item, const Item& it, const int blk, const int n0, const int n1) {
    const bf16_t* P = (const bf16_t*)(F.ws + WS_PA);
    int lane = F.lane; const bool act = !SHARED || F.wave < 4;
    ldsp_t ucw = SHARED ? F.lds : F.lds + F.wave * (128 * UCP);
    if (act) { constexpr int NT = SHARED ? 4 : 16;
      const int grp = lane & 7, ch0 = blk * 64 + grp * 8, tok0 = (SHARED ? 32 * F.wave : 0) + (lane >> 3) * NT; float cw[4][8], cb[8];
#pragma unroll
      for (int k = 0; k < 4; ++k)
#pragma unroll
          for (int i = 0; i < 8; ++i) cw[k][i] = F.pa->in[I_CONVW][((size_t)l * 4 + k) * 512 + ch0 + i];
#pragma unroll
      for (int i = 0; i < 8; ++i) cb[i] = F.pa->in[I_CONVB][l * 512 + ch0 + i];
      const bf16_t* Pu = P + (size_t)it.seqbase * INW + ch0;
      u32x4 rv[NT + 3];
#pragma unroll
      for (int r = 0; r < NT + 3; ++r) { const int tt = it.t0 + tok0 + r - 2; const int tc = tt < 0 ? 0 : (tt >= it.seqlen ? it.seqlen - 1 : tt);
          rv[r] = ldg<u32x4>(Pu, (unsigned)tc * (unsigned)(INW * 2)); if (tt != tc) rv[r] = (u32x4){0u, 0u, 0u, 0u}; }
      float win[4][8];
#pragma unroll
      for (int r = 0; r < 3; ++r) { win[r][0] = bf2f(rv[r].x & 0xffffu); win[r][1] = __uint_as_float(rv[r].x & 0xffff0000u); win[r][2] = bf2f(rv[r].y & 0xffffu); win[r][3] = __uint_as_float(rv[r].y & 0xffff0000u);
          win[r][4] = bf2f(rv[r].z & 0xffffu); win[r][5] = __uint_as_float(rv[r].z & 0xffff0000u); win[r][6] = bf2f(rv[r].w & 0xffffu); win[r][7] = __uint_as_float(rv[r].w & 0xffff0000u); }
#pragma unroll
      for (int j = 0; j < NT; ++j) { const int r = j + 3, s3 = (j + 3) & 3;
          win[s3][0] = bf2f(rv[r].x & 0xffffu); win[s3][1] = __uint_as_float(rv[r].x & 0xffff0000u); win[s3][2] = bf2f(rv[r].y & 0xffffu); win[s3][3] = __uint_as_float(rv[r].y & 0xffff0000u);
          win[s3][4] = bf2f(rv[r].z & 0xffffu); win[s3][5] = __uint_as_float(rv[r].z & 0xffff0000u); win[s3][6] = bf2f(rv[r].w & 0xffffu); win[s3][7] = __uint_as_float(rv[r].w & 0xffff0000u);
          float o[8];
#pragma unroll
          for (int i = 0; i < 8; ++i) o[i] = cb[i] + cw[0][i] * win[j & 3][i] + cw[1][i] * win[(j + 1) & 3][i] + cw[2][i] * win[(j + 2) & 3][i] + cw[3][i] * win[s3][i];
          u32x4 w; w.x = pk2(o[0], o[1]); w.y = pk2(o[2], o[3]); w.z = pk2(o[4], o[5]); w.w = pk2(o[6], o[7]);
          *(LAS u32x4*)(ucw + (tok0 + j) * UCP + grp * 16) = w; }
      LDS_WAIT(); asm volatile("" ::: "memory"); }
    if (SHARED) __syncthreads();
    asm volatile("" : "+v"(lane));
    bf16x8 af[8][2];
    if (act) { const int fr = lane & 15, fq = lane >> 4;
#pragma unroll
      for (int m = 0; m < 8; ++m)
#pragma unroll
          for (int ks = 0; ks < 2; ++ks) af[m][ks] = *(const LAS bf16x8*)(ucw + (32 * (fr >> 2) + 4 * m + (fr & 3)) * UCP + (8 * fq + 32 * ks) * 2); }
    if (SHARED) { __syncthreads(); if (!act) return; }
    const bf16_t* wg0 = (const bf16_t*)(F.ws + WS_RGW) + (size_t)(l * 2 + 0) * 2 * 8 * 4096;
    const bf16_t* wg1 = (const bf16_t*)(F.ws + WS_RGW) + (size_t)(l * 2 + 1) * 2 * 8 * 4096;
    float* TOT = (float*)(F.ws + WS_TOT);
    RgStep R0, R1;
    rg_load_step<FINAL>(R0, F, wg0, l, 0, item, blk, n0, lane);
#pragma unroll 1
    for (int n = n0; n < n1; ++n) { asm volatile("" : "+v"(lane));
        const int fr = lane & 15, fq = lane >> 4; const int ch = blk * 64 + 16 * n + fr;
        f32x4 hsum[8];
#pragma unroll
        for (int m = 0; m < 8; ++m) hsum[m] = zero4();
        rg_load_step<FINAL>(R1, F, wg1, l, 1, item, blk, n, lane);
        { float At, Ht;
          rg_dir<FINAL, 0>(ucw, af, R0, n, lane, hsum, At, Ht);
          if (!FINAL && fq == 0) { *(f32x2*)(TOT + (((size_t)item * 2 + 0) * 512 + ch) * 2) = (f32x2){At, Ht}; } }
        __builtin_amdgcn_sched_barrier(0);
        if (n + 1 < n1) rg_load_step<FINAL>(R0, F, wg0, l, 0, item, blk, n + 1, lane);
        { float At, Ht;
          rg_dir<FINAL, 1>(ucw, af, R1, n, lane, hsum, At, Ht);
          if (!FINAL && fq == 0) { *(f32x2*)(TOT + (((size_t)item * 2 + 1) * 512 + ch) * 2) = (f32x2){At, Ht}; } }
        if (FINAL) {
            const unsigned uo = (unsigned)(32 * fq * UCP + (16 * n + fr) * 2);
#pragma unroll
            for (int m = 0; m < 8; ++m)
#pragma unroll
                for (int jj = 0; jj < 4; ++jj) *(LAS bf16_t*)(ucw + uo + (4 * m + jj) * UCP) = (bf16_t)f2bf(hsum[m][jj]); }
    }
    if (FINAL) {
        LDS_WAIT(); asm volatile("" : "+v"(lane) :: "memory");
        const int ng = 2 * (n1 - n0);
        const int grp = 2 * n0 + ((ng == 8) ? (lane & 7) : (lane & 1)); const int tk0 = (ng == 8) ? (lane >> 3) : (lane >> 1), tstep = (ng == 8) ? 8 : 32, nq = (ng == 8) ? 16 : 4;
        const bf16_t* Pg = P + (size_t)it.row0 * INW + 512 + blk * 64 + grp * 8; bf16_t* Yo = (bf16_t*)(F.ws + WS_Y) + (size_t)it.row0 * D + blk * 64 + grp * 8;
#pragma unroll 8
        for (int q = 0; q < nq; ++q) { const int token = tk0 + tstep * q;
            const u32x4 hv = *(const LAS u32x4*)(ucw + token * UCP + grp * 16); const u32x4 gv = ldg<u32x4>(Pg, (unsigned)token * (unsigned)(INW * 2));
            u32x4 w;
            w.x = pk2(gelu_tanh(bf2f(gv.x & 0xffffu)) * bf2f(hv.x & 0xffffu), gelu_tanh(__uint_as_float(gv.x & 0xffff0000u)) * __uint_as_float(hv.x & 0xffff0000u));
            w.y = pk2(gelu_tanh(bf2f(gv.y & 0xffffu)) * bf2f(hv.y & 0xffffu), gelu_tanh(__uint_as_float(gv.y & 0xffff0000u)) * __uint_as_float(hv.y & 0xffff0000u));
            w.z = pk2(gelu_tanh(bf2f(gv.z & 0xffffu)) * bf2f(hv.z & 0xffffu), gelu_tanh(__uint_as_float(gv.z & 0xffff0000u)) * __uint_as_float(hv.z & 0xffff0000u));
            w.w = pk2(gelu_tanh(bf2f(gv.w & 0xffffu)) * bf2f(hv.w & 0xffffu), gelu_tanh(__uint_as_float(gv.w & 0xffff0000u)) * __uint_as_float(hv.w & 0xffff0000u));
            stg<u32x4>(Yo, (unsigned)token * (unsigned)(D * 2), w); }
        LDS_WAIT();
    }
}

struct KvRegs { u32x4 klo[2], khi[2], v[4]; };
__device__ __forceinline__ void kv_issue(Frame& F, KvRegs& R, const Item& it, int h) {
    const bf16_t* P = (const bf16_t*)(F.ws + WS_PA);
    const bf16_t* Pk = P + (size_t)it.row0 * INW + 1536 + h * HD; const bf16_t* Pv = P + (size_t)it.row0 * INW + 2048 + h * HD;
#pragma unroll
    for (int t2 = 0; t2 < 2; ++t2) { const int task = F.tid + t2 * NTHREADS, token = task >> 3, d0 = (task & 7) * 8;
        R.klo[t2] = ldg<u32x4>(Pk, (unsigned)(token * INW + d0) * 2u); R.khi[t2] = ldg<u32x4>(Pk, (unsigned)(token * INW + d0 + 64) * 2u); }
#pragma unroll
    for (int t4 = 0; t4 < 4; ++t4) { const int task = F.tid + t4 * NTHREADS, token = task >> 4, d0 = (task & 15) * 8; R.v[t4] = ldg<u32x4>(Pv, (unsigned)(token * INW + d0) * 2u); }
}
template <int KS> __device__ __forceinline__ void kv_step(unsigned aK, unsigned aVf, unsigned aVb, f32x4 (&accf)[8], f32x4 (&accb)[8]) {
    const bf16x8 af = tr1<KS * 32 * VP>(aVf), ab = tr1<KS * 32 * VP>(aVb);
    bf16x8 b[8];
    tr4<KS * 32 * VP>(aK, b[0], b[1], b[2], b[3]); tr4<KS * 32 * VP + 128>(aK, b[4], b[5], b[6], b[7]);
#pragma unroll
    for (int n = 0; n < 8; ++n) { accf[n] = __builtin_amdgcn_mfma_f32_16x16x32_bf16(af, b[n], accf[n], 0, 0, 0); accb[n] = __builtin_amdgcn_mfma_f32_16x16x32_bf16(ab, b[n], accb[n], 0, 0, 0); }
}
__device__ __forceinline__ void stage_state_t(Frame& F, ldsp_t dst, const bf16_t* St) {
#pragma unroll
    for (int t4 = 0; t4 < 4; ++t4) { const int task = F.tid + t4 * NTHREADS, e = task >> 4, c8 = task & 15;
        *(LAS u32x4*)(dst + e * TP + c8 * 16) = ldg<u32x4>(St, (unsigned)(e * 128 + c8 * 8) * 2u); }
}
__device__ __forceinline__ void mm16x128(ldsp_t At, int ra0, ldsp_t Bt, int lane, f32x4 (&acc)[8]) {
    const int fr = lane & 15, fq = lane >> 4;
#pragma unroll
    for (int ks = 0; ks < 4; ++ks) { const bf16x8 a = *(const LAS bf16x8*)(At + (ra0 + fr) * TP + (32 * ks + 8 * fq) * 2);
#pragma unroll
        for (int n = 0; n < 8; ++n) { const bf16x8 b = *(const LAS bf16x8*)(Bt + (16 * n + fr) * TP + (32 * ks + 8 * fq) * 2); acc[n] = __builtin_amdgcn_mfma_f32_16x16x32_bf16(a, b, acc[n], 0, 0, 0); } }
}

__device__ __forceinline__ void kv_head(Frame& F, KvRegs& R, KvRegs& Rn, bool pre, int item, const Item& it, int h) {
    bf16_t* KV = (bf16_t*)(F.ws + WS_KV);
    const LAS float* dec = (const LAS float*)(F.lds + LDS_DEC);
    ldsp_t tK = F.lds, tVf = F.lds + TILEV, tVb = F.lds + 2 * TILEV;
#pragma unroll
    for (int t2 = 0; t2 < 2; ++t2) { const int task = F.tid + t2 * NTHREADS, token = task >> 3, d0 = (task & 7) * 8;
        *(LAS u32x4*)(tK + token * VP + d0 * 2) = R.klo[t2]; *(LAS u32x4*)(tK + token * VP + (d0 + 64) * 2) = R.khi[t2]; }
#pragma unroll
    for (int t4 = 0; t4 < 4; ++t4) { const int task = F.tid + t4 * NTHREADS, token = task >> 4, d0 = (task & 15) * 8; const u32x4 v = R.v[t4];
        const float df = dec[(0 * 4 + h) * 132 + 127 - token], db = dec[(1 * 4 + h) * 132 + token];
        const float x[8] = {bf2f(v.x & 0xffffu), __uint_as_float(v.x & 0xffff0000u), bf2f(v.y & 0xffffu), __uint_as_float(v.y & 0xffff0000u), bf2f(v.z & 0xffffu), __uint_as_float(v.z & 0xffff0000u), bf2f(v.w & 0xffffu), __uint_as_float(v.w & 0xffff0000u)};
        u32x4 wf, wb; wf.x = pk2(x[0] * df, x[1] * df); wf.y = pk2(x[2] * df, x[3] * df); wf.z = pk2(x[4] * df, x[5] * df); wf.w = pk2(x[6] * df, x[7] * df);
        wb.x = pk2(x[0] * db, x[1] * db); wb.y = pk2(x[2] * db, x[3] * db); wb.z = pk2(x[4] * db, x[5] * db); wb.w = pk2(x[6] * db, x[7] * db);
        *(LAS u32x4*)(tVf + token * VP + d0 * 2) = wf; *(LAS u32x4*)(tVb + token * VP + d0 * 2) = wb; }
    WG_BAR_LDS();
    if (pre) kv_issue(F, Rn, it, h + 1);
    f32x4 af[8], ab[8];
#pragma unroll
    for (int n = 0; n < 8; ++n) { af[n] = zero4(); ab[n] = zero4(); }
    { const unsigned aK = tr_lane_addr(tK, F.lane), aVf = tr_lane_addr(tVf, F.lane) + 32u * (unsigned)F.wave, aVb = tr_lane_addr(tVb, F.lane) + 32u * (unsigned)F.wave;
      kv_step<0>(aK, aVf, aVb, af, ab); kv_step<1>(aK, aVf, aVb, af, ab); kv_step<2>(aK, aVf, aVb, af, ab); kv_step<3>(aK, aVf, aVb, af, ab); }
    const int fr = F.lane & 15, fq = F.lane >> 4;
    bf16_t* of = KV + (((size_t)item * 4 + h) * 2 + 0) * 16384 + (size_t)(16 * F.wave) * 128;
    unsigned so = (unsigned)((4 * fq) * 128 + fr) * 2u; asm volatile("" : "+v"(so));
#pragma unroll
    for (int n = 0; n < 8; ++n)
#pragma unroll
        for (int jj = 0; jj < 4; ++jj) { stg<bf16_t>(of, so + (unsigned)((jj * 128 + 16 * n) * 2), (bf16_t)f2bf(af[n][jj])); stg<bf16_t>(of, so + (unsigned)((16384 + jj * 128 + 16 * n) * 2), (bf16_t)f2bf(ab[n][jj])); }
    WG_BAR_LDS();
}
__device__ __forceinline__ int latent_item(int c) { return (c >> 5) * SPB + 2 + (c & 31); }
__device__ __forceinline__ int ctx_item(int ci) { return (ci >> 1) * SPB + (ci & 1); }
__device__ __forceinline__ void phase_m1(Frame& F, int l) {
    build_decay(F, l); __syncthreads();
    for (int c = F.bid; c < 256; c += F.G) {
        fresh(F);
        { const int item = latent_item(c); const Item it = item_info(item);
          rg_part<false>(F, l, item, it, F.wave, 0, 4);
          __syncthreads();
          KvRegs A, B;
          fresh(F); kv_issue(F, A, it, 0);
          kv_head(F, A, B, true, item, it, 0);
          fresh(F); kv_head(F, B, A, true, item, it, 1);
          fresh(F); kv_head(F, A, B, true, item, it, 2);
          fresh(F); kv_head(F, B, A, false, item, it, 3); }
        fresh(F);
        if (c >= 64 && c < 192) { const int cu = c - 64; const int item = ctx_item(cu >> 3); const Item it = item_info(item);
            const int w4 = F.wave & 3; rg_part<false, true>(F, l, item, it, cu & 7, w4, w4 + 1); }
        __syncthreads();
        if (c < 64) { const int item = ctx_item(c >> 2); const Item it = item_info(item); KvRegs A, B; fresh(F); kv_issue(F, A, it, c & 3); kv_head(F, A, B, false, item, it, c & 3); }
        if (c >= 192) { __syncthreads(); fresh(F); moe_fill(F, fill_base(F.G, 3 + l) + (c - 192), 1); }
    }
}
__device__ __forceinline__ int seq_order(int dir, int step) { return dir ? (step == 0 ? 1 : (step == 1 ? 0 : 35 - step)) : step; }
__device__ __forceinline__ void phase_m2(Frame& F, int l) {
    bf16_t* KV = (bf16_t*)(F.ws + WS_KV);
    const int gt = F.bid * NTHREADS + F.tid, NGT = F.G * NTHREADS;
    for (int c = gt; c < NB * NH * 2 * 128 * 16; c += NGT) {
        const int dc = c & 15, e = (c >> 4) & 127, dir = (c >> 11) & 1, h = (c >> 12) & 3, b = c >> 14;
        const float x = F.pa->in[I_RETDEC][l * 8 + dir * 4 + h]; const float decay = expf(128.0f * (-log1pf(expf(-x))));
        float S[8];
#pragma unroll
        for (int i = 0; i < 8; ++i) S[i] = 0.f;
        const unsigned lo = (unsigned)((((h * 2 + dir) * 128 + e) * 128 + dc * 8) * 2);
        for (int g0 = 0; g0 < SPB; g0 += 17) {
            u32x4 v[17];
#pragma unroll
            for (int i = 0; i < 17; ++i) { const int item = b * SPB + seq_order(dir, g0 + i); v[i] = ldg<u32x4>(KV + (size_t)item * 4 * 2 * 16384, lo); }
#pragma unroll
            for (int i = 0; i < 17; ++i) { const int item = b * SPB + seq_order(dir, g0 + i);
                u32x4 w; w.x = pk2(S[0], S[1]); w.y = pk2(S[2], S[3]); w.z = pk2(S[4], S[5]); w.w = pk2(S[6], S[7]);
                stg<u32x4>(KV + (size_t)item * 4 * 2 * 16384, lo, w);
                S[0] = S[0] * decay + bf2f(v[i].x & 0xffffu); S[1] = S[1] * decay + __uint_as_float(v[i].x & 0xffff0000u); S[2] = S[2] * decay + bf2f(v[i].y & 0xffffu); S[3] = S[3] * decay + __uint_as_float(v[i].y & 0xffff0000u);
                S[4] = S[4] * decay + bf2f(v[i].z & 0xffffu); S[5] = S[5] * decay + __uint_as_float(v[i].z & 0xffff0000u); S[6] = S[6] * decay + bf2f(v[i].w & 0xffffu); S[7] = S[7] * decay + __uint_as_float(v[i].w & 0xffff0000u); }
        }
    }
    const float* TOT = (const float*)(F.ws + WS_TOT); float* CARRY = (float*)(F.ws + WS_CARRY);
    if (F.tid < 32) for (int cidx = F.bid * 32 + F.tid; cidx < NB * 2 * 512; cidx += F.G * 32) {
      { const int ch = cidx & 511, dir = (cidx >> 9) & 1, b = cidx >> 10; float cr = 0.f;
          for (int g0 = 0; g0 < SPB; g0 += 17) { f32x2 ah[17];
#pragma unroll
              for (int i = 0; i < 17; ++i) { const int item = b * SPB + seq_order(dir, g0 + i); ah[i] = *(const f32x2*)(TOT + (((size_t)item * 2 + dir) * 512 + ch) * 2); }
#pragma unroll
              for (int i = 0; i < 17; ++i) { const int item = b * SPB + seq_order(dir, g0 + i); CARRY[((size_t)item * 2 + dir) * 512 + ch] = cr; cr = ah[i].x * cr + ah[i].y; } } } }
}
struct RetRegs { u32x4 v[4], sf[4], sb[4], klo[2], khi[2], g[4], q[4]; };
__device__ __forceinline__ void ret_issue(Frame& F, RetRegs& R, int item, const Item& it, int h) {
    const bf16_t* KV = (const bf16_t*)(F.ws + WS_KV); const bf16_t* P = (const bf16_t*)(F.ws + WS_PA);
    const bf16_t* Pk = P + (size_t)it.row0 * INW + 1536 + h * HD; const bf16_t* Pv = P + (size_t)it.row0 * INW + 2048 + h * HD;
    const bf16_t* Sf = KV + (((size_t)item * 4 + h) * 2 + 0) * 16384; const bf16_t* Sb = Sf + 16384;
    const int lane = F.lane, i0 = 16 * F.wave;
#pragma unroll
    for (int t2 = 0; t2 < 2; ++t2) { const int task = F.tid + t2 * NTHREADS, token = task >> 3, d0 = (task & 7) * 8;
        R.klo[t2] = ldg<u32x4>(Pk, (unsigned)(token * INW + d0) * 2u); R.khi[t2] = ldg<u32x4>(Pk, (unsigned)(token * INW + d0 + 64) * 2u); }
#pragma unroll
    for (int t4 = 0; t4 < 4; ++t4) { const int task = F.tid + t4 * NTHREADS, r = task >> 4, c8 = task & 15;
        R.v[t4] = ldg<u32x4>(Pv, (unsigned)(r * INW + c8 * 8) * 2u); R.sf[t4] = ldg<u32x4>(Sf, (unsigned)(r * 128 + c8 * 8) * 2u); R.sb[t4] = ldg<u32x4>(Sb, (unsigned)(r * 128 + c8 * 8) * 2u); }
    { const bf16_t* Pg = P + (size_t)(it.row0 + i0) * INW + 2560 + h * HD;
#pragma unroll
      for (int k = 0; k < 4; ++k) R.g[k] = ldg<u32x4>(Pg, (unsigned)((lane >> 2) * INW + 32 * (lane & 3) + 8 * k) * 2u); }
    { const bf16_t* Pq = P + (size_t)(it.row0 + i0) * INW + 1024 + h * HD;
#pragma unroll
      for (int ks = 0; ks < 4; ++ks) R.q[ks] = ldg<u32x4>(Pq, (unsigned)((lane & 15) * INW + 32 * ks + 8 * (lane >> 4)) * 2u); }
}
__device__ __forceinline__ void ret_head(Frame& F, RetRegs& R, RetRegs& Rn, bool pre, int item, const Item& it, int h) {
    bf16_t* Y = (bf16_t*)(F.ws + WS_Y);
    const LAS float* dec = (const LAS float*)(F.lds + LDS_DEC);
    ldsp_t tK = F.lds, tV = F.lds + TILEB, tSf = tV + TILEV, tSb = tSf + TILEB;
    const int lane = F.lane, fr = lane & 15, fq = lane >> 4, i0 = 16 * F.wave;
#pragma unroll
    for (int t2 = 0; t2 < 2; ++t2) { const int task = F.tid + t2 * NTHREADS, token = task >> 3, d0 = (task & 7) * 8;
        *(LAS u32x4*)(tK + token * TP + d0 * 2) = R.klo[t2]; *(LAS u32x4*)(tK + token * TP + (d0 + 64) * 2) = R.khi[t2]; }
#pragma unroll
    for (int t4 = 0; t4 < 4; ++t4) { const int task = F.tid + t4 * NTHREADS, r = task >> 4, c8 = task & 15;
        *(LAS u32x4*)(tV + r * VP + c8 * 16) = R.v[t4]; *(LAS u32x4*)(tSf + r * TP + c8 * 16) = R.sf[t4]; *(LAS u32x4*)(tSb + r * TP + c8 * 16) = R.sb[t4]; }
    bf16x8 qf[4];
#pragma unroll
    for (int ks = 0; ks < 4; ++ks) qf[ks] = __builtin_bit_cast(bf16x8, R.q[ks]);
    u32x4 gk[4];
#pragma unroll
    for (int k = 0; k < 4; ++k) gk[k] = R.g[k];
    WG_BAR_LDS();
    if (pre) ret_issue(F, Rn, item, it, h + 1);
    bf16x8 pa[4];
    { f32x4 C[8];
#pragma unroll
      for (int jt = 0; jt < 8; ++jt) { C[jt] = zero4();
#pragma unroll
          for (int ks = 0; ks < 4; ++ks) { const bf16x8 a = *(const LAS bf16x8*)(tK + (16 * jt + fr) * TP + (32 * ks + 8 * fq) * 2); C[jt] = __builtin_amdgcn_mfma_f32_16x16x32_bf16(a, qf[ks], C[jt], 0, 0, 0); } }
      const int i = i0 + fr;
#pragma unroll
      for (int jt = 0; jt < 8; ++jt)
#pragma unroll
          for (int jj = 0; jj < 4; ++jj) { const int j = 16 * jt + 4 * fq + jj; const float dcy = (i >= j) ? dec[(0 * 4 + h) * 132 + (i - j)] : dec[(1 * 4 + h) * 132 + (j - i)]; C[jt][jj] *= dcy; }
#pragma unroll
      for (int u = 0; u < 4; ++u) { const u32x4 w = {pg8::cvt_pk_bf16(C[2 * u][0], C[2 * u][1]), pg8::cvt_pk_bf16(C[2 * u][2], C[2 * u][3]), pg8::cvt_pk_bf16(C[2 * u + 1][0], C[2 * u + 1][1]), pg8::cvt_pk_bf16(C[2 * u + 1][2], C[2 * u + 1][3])};
          pa[u] = __builtin_bit_cast(bf16x8, w); } }
    WG_BAR_LDS();
    { ldsp_t gt = tK + (i0 + (lane >> 2)) * TP + (lane & 3) * 64;
#pragma unroll
      for (int k = 0; k < 4; ++k) *(LAS u32x4*)(gt + 16 * k) = gk[k]; }
    f32x4 o[8];
#pragma unroll
    for (int n = 0; n < 8; ++n) o[n] = zero4();
    { const unsigned aV = tr_lane_addr(tV, lane); bf16x8 b[8];
#define RET_PV(U) do { tr4<(U) * 32 * VP>(aV, b[0], b[1], b[2], b[3]); tr4<(U) * 32 * VP + 128>(aV, b[4], b[5], b[6], b[7]); \
        _Pragma("unroll") for (int n = 0; n < 8; ++n) o[n] = __builtin_amdgcn_mfma_f32_16x16x32_bf16(pa[U], b[n], o[n], 0, 0, 0); } while (0)
      RET_PV(0); RET_PV(1); RET_PV(2); RET_PV(3);
#undef RET_PV
    }
    { f32x4 cf[8];
#pragma unroll
      for (int n = 0; n < 8; ++n) { cf[n] = zero4();
#pragma unroll
          for (int ks = 0; ks < 4; ++ks) { const bf16x8 b = *(const LAS bf16x8*)(tSf + (16 * n + fr) * TP + (32 * ks + 8 * fq) * 2); cf[n] = __builtin_amdgcn_mfma_f32_16x16x32_bf16(qf[ks], b, cf[n], 0, 0, 0); } }
#pragma unroll
      for (int jj = 0; jj < 4; ++jj) { const float sf = dec[(0 * 4 + h) * 132 + (i0 + 4 * fq + jj + 1)];
#pragma unroll
          for (int n = 0; n < 8; ++n) o[n][jj] += sf * cf[n][jj]; } }
    { f32x4 cb[8];
#pragma unroll
      for (int n = 0; n < 8; ++n) { cb[n] = zero4();
#pragma unroll
          for (int ks = 0; ks < 4; ++ks) { const bf16x8 b = *(const LAS bf16x8*)(tSb + (16 * n + fr) * TP + (32 * ks + 8 * fq) * 2); cb[n] = __builtin_amdgcn_mfma_f32_16x16x32_bf16(qf[ks], b, cb[n], 0, 0, 0); } }
#pragma unroll
      for (int jj = 0; jj < 4; ++jj) { const float sb = dec[(1 * 4 + h) * 132 + (128 - (i0 + 4 * fq + jj))];
#pragma unroll
          for (int n = 0; n < 8; ++n) o[n][jj] += sb * cb[n][jj]; } }
    { ldsp_t gc = tK + (i0 + 4 * fq) * TP + fr * 2;
#pragma unroll
      for (int jj = 0; jj < 4; ++jj) { float s1 = 0.f;
#pragma unroll
          for (int n = 0; n < 8; ++n) s1 += o[n][jj];
          s1 += swz_xor<1>(s1); s1 += swz_xor<2>(s1); s1 += swz_xor<4>(s1); s1 += swz_xor<8>(s1);
          const float mu = s1 * (1.0f / 128.0f); float q = 0.f;
#pragma unroll
          for (int n = 0; n < 8; ++n) { const float dd = o[n][jj] - mu; q += dd * dd; }
          q += swz_xor<1>(q); q += swz_xor<2>(q); q += swz_xor<4>(q); q += swz_xor<8>(q);
          const float rstd = 1.0f / sqrtf(q * (1.0f / 128.0f) + EPS);
#pragma unroll
          for (int n = 0; n < 8; ++n) { LAS bf16_t* p = (LAS bf16_t*)(gc + jj * TP + 32 * n); const float gv = bf2f(*p); *p = (bf16_t)f2bf(siluf_(gv) * (o[n][jj] - mu) * rstd); } } }
    LDS_WAIT(); asm volatile("" ::: "memory");
    { ldsp_t gt = tK + (i0 + (lane >> 2)) * TP + (lane & 3) * 64; bf16_t* Yo = Y + (size_t)(it.row0 + i0) * D + 512 + h * HD;
#pragma unroll
      for (int k = 0; k < 4; ++k) stg<u32x4>(Yo, (unsigned)((lane >> 2) * D + 32 * (lane & 3) + 8 * k) * 2u, *(const LAS u32x4*)(gt + 16 * k)); }
    WG_BAR_LDS();
}
__device__ __forceinline__ void phase_m3(Frame& F, int l) {
    build_decay(F, l); __syncthreads();
    for (int c = F.bid; c < 256; c += F.G) {
        fresh(F);
        { const int item = latent_item(c); const Item it = item_info(item);
#ifndef PROBE_M3
#define PROBE_M3 0
#endif
          for (int r_ = 0; r_ < ((PROBE_M3 & 1) ? 2 : 1); ++r_) { fresh(F); rg_part<true>(F, l, item, it, F.wave, 0, 4); }
          __syncthreads();
          for (int r_ = 0; r_ < ((PROBE_M3 & 2) ? 2 : 1); ++r_) {
          RetRegs R, Rn;
          fresh(F); ret_issue(F, R, item, it, 0);
          ret_head(F, R, Rn, true, item, it, 0);
          fresh(F); ret_head(F, Rn, R, true, item, it, 1);
          fresh(F); ret_head(F, R, Rn, true, item, it, 2);
          fresh(F); ret_head(F, Rn, R, false, item, it, 3); } }
        if (l == 0) {
            fresh(F);
            if (c >= 64 && c < 192) { const int cu = c - 64; const int item = ctx_item(cu >> 3); const Item it = item_info(item);
                const int w4 = F.wave & 3; rg_part<true, true>(F, l, item, it, cu & 7, w4, w4 + 1); }
            __syncthreads();
            if (c < 64) { const int item = ctx_item(c >> 2); const Item it = item_info(item); RetRegs R, Rn; fresh(F); ret_issue(F, R, item, it, c & 3); ret_head(F, R, Rn, false, item, it, c & 3); }
            if (c >= 192) { fresh(F); moe_fill(F, fill_base(F.G, 5) + 2 * (c - 192), 2); }
        }
    }
}

constexpr int N_PHASES = 24;
__global__ void __launch_bounds__(NTHREADS, 2) fwd_kernel(Args args) {
    extern __shared__ __attribute__((aligned(16))) unsigned char lds_raw[];
    Frame F; F.lds = (ldsp_t)lds_raw; F.wave0 = __builtin_amdgcn_readfirstlane((int)threadIdx.x >> 6); F.G = gridDim.x; F.pa0 = &args; F.out0 = args.out; F.ws0 = args.ws; fresh(F);
    volatile LAS unsigned* MISC = (volatile LAS unsigned*)(F.lds + LDS_MISC);
    if (F.tid < 64) MISC[F.tid] = 0u;
    __syncthreads();
    const int lo = args.ph_lo, hi = args.ph_hi;
    XcdBarrier bar; bar.bar = (unsigned*)(F.ws + WS_CTL); bar.x = 0; bar.st = nullptr;
    if (hi - lo > 1) bar = xcd_barrier_post((unsigned*)(F.ws + WS_CTL), MISC);
#ifndef DIAG_MASK
#define DIAG_MASK 0xffffffffu
#endif
#ifndef REPEAT_MASK
#define REPEAT_MASK 0u
#endif
#define REPS(kind) ((((REPEAT_MASK) >> (kind)) & 1u) ? 2 : 1)
#define INK(k, kind) (((DIAG_MASK >> (kind)) & 1u) && lo <= (k) && (k) < hi && fresh(F))
#define IN(k) (lo <= (k) && (k) < hi)
#define SEAM(k) do { if (IN(k) && IN((k) + 1)) xcd_barrier(bar); } while (0)
    float* ctxx = (float*)(F.ws + WS_CTXX); bf16_t* xb = (bf16_t*)((char*)F.out + XB_OFF);
    const float* modlat = (const float*)(F.ws + WS_MODLAT); const float* modctx = (const float*)(F.ws + WS_MODCTX);

    if (INK(0, 0)) { for (int r_ = 0; r_ < REPS(0); ++r_) { phase_convert_small(F); __syncthreads(); phase_mod(F); __syncthreads(); } } SEAM(0);
    if (INK(1, 1)) { for (int r_ = 0; r_ < REPS(1); ++r_) phase_norm(F, 0, 0, F.pa->in[I_X], nullptr, F.pa->in[I_CTX], MROWS, SlabRed{nullptr, 0, nullptr, nullptr, nullptr}); } SEAM(1);
#pragma unroll 1
    for (int l = 0; l < 2; ++l) {
        const int pb = (l == 0) ? 2 : 11;
        if (INK(pb + 0, 2)) { pg8::Gemm g{(const bf16_t*)(F.ws + WS_HX), (const bf16_t*)(F.ws + WS_WIN) + (size_t)l * INW * D, INW, D, 0, nullptr}; pg8::Order S; S.init(MROWS / 256, INW / 256, F.G, F.bid, nullptr, nullptr, D / 64, false, 0);
            pg8::EpiInProj E{(bf16_t*)(F.ws + WS_PA), INW, (const float*)(F.ws + WS_ROPE), (const float*)(F.ws + WS_ROPE) + 4096 * 64}; for (int r_ = 0; r_ < REPS(2); ++r_) pg8::gemm_phase<pg8::EpiInProj>(F.lds, g, S, E, F.tid);
            fresh(F); moe_fill_gemm(F, U_GIN, l, 3); }
        SEAM(pb + 0);
        if (INK(pb + 1, 3)) { for (int r_ = 0; r_ < REPS(3); ++r_) phase_m1(F, l); }
        SEAM(pb + 1);
        if (INK(pb + 2, 4)) { for (int r_ = 0; r_ < REPS(4); ++r_) { if (r_) phase_m1(F, l); phase_m2(F, l); } }
        SEAM(pb + 2);
        if (INK(pb + 3, 5)) { for (int r_ = 0; r_ < REPS(5); ++r_) phase_m3(F, l); }
        SEAM(pb + 3);
        if (INK(pb + 4, 6)) { pg8::Gemm g{(const bf16_t*)(F.ws + WS_Y), (const bf16_t*)(F.ws + WS_WOUT) + (size_t)l * D * D, D, D, 0, (float*)(F.ws + WS_SLABA)}; pg8::Order S; S.init((l == 0 ? MROWS : NLAT) / 256, D / 256, F.G, F.bid, nullptr, nullptr, D / 64, true, MAXSLAB_A);
            pg8::EpiResid E{l == 0 ? F.pa->in[I_X] : nullptr, xb, F.pa->in[I_CTX], ctxx, modlat + (size_t)l * 8 * 6144 + 2048, modctx + (size_t)l * 6144 + 2048};
            pg8::gemm_phase<pg8::EpiResid>(F.lds, g, S, E, F.tid); }
        SEAM(pb + 4);
        if (l == 0) {
            if (INK(7, 1)) { for (int r_ = 0; r_ < REPS(1); ++r_) phase_norm(F, 0, 1, nullptr, xb, ctxx, MROWS, SlabRed{(const float*)(F.ws + WS_SLABA), pg8::split_factor((MROWS / 256) * 4, F.G, D / 64, MAXSLAB_A), modctx + 2048, F.pa->in[I_CTX], ctxx}); } SEAM(7);
            if (INK(8, 7)) { pg8::Gemm g{(const bf16_t*)(F.ws + WS_HX), (const bf16_t*)(F.ws + WS_WUP), 2 * DFF, D, 0, nullptr}; pg8::Order S; S.init(MROWS / 256, 2 * DFF / 256, F.G, F.bid, nullptr, nullptr, D / 64, false, 0);
                pg8::EpiSwiGLU E{(bf16_t*)(F.ws + WS_PA), DFF}; for (int r_ = 0; r_ < REPS(7); ++r_) pg8::gemm_phase<pg8::EpiSwiGLU>(F.lds, g, S, E, F.tid);
                fresh(F); moe_fill_gemm(F, U_GUP, 2, 2); }
            SEAM(8);
            if (INK(9, 8)) { pg8::Gemm g{(const bf16_t*)(F.ws + WS_PA), (const bf16_t*)(F.ws + WS_WDN), D, DFF, 0, (float*)(F.ws + WS_SLABA)}; pg8::Order S; S.init(MROWS / 256, D / 256, F.G, F.bid, nullptr, nullptr, DFF / 64, true, MAXSLAB_A);
                pg8::EpiResid E{nullptr, xb, (const float*)ctxx, ctxx, modlat + 5120, modctx + 5120}; pg8::gemm_phase<pg8::EpiResid>(F.lds, g, S, E, F.tid); }
            SEAM(9);
            if (INK(10, 1)) { for (int r_ = 0; r_ < REPS(1); ++r_) phase_norm(F, 1, 0, nullptr, xb, ctxx, MROWS, SlabRed{(const float*)(F.ws + WS_SLABA), pg8::split_factor((MROWS / 256) * 4, F.G, DFF / 64, MAXSLAB_A), modctx + 5120, ctxx, ctxx}); } SEAM(10);
        }
    }
    if (INK(16, 9)) { for (int r_ = 0; r_ < REPS(9); ++r_) { phase_norm_router(F, xb); __syncthreads(); phase_convert_moe(F); __syncthreads(); } } SEAM(16);
    if (INK(17, 10)) { phase_moe_sort(F); } SEAM(17);
#pragma unroll 1
    for (int k = 0; k < 2; ++k) {
        const int* meta = (const int*)(F.ws + MOE_META) + 9 * k;
        if (INK(18 + 2 * k, 11)) { if (k == 1) { moe_reduce(F, 0); __syncthreads(); } pg8::Gemm g{(const bf16_t*)(F.ws + WS_HX), (const bf16_t*)(F.ws + WS_MOEUP), 2 * DEXP, D, (size_t)2 * DEXP * D * 2, nullptr}; pg8::Order S; S.init(meta[8], 2 * DEXP / 256, F.G, F.bid, meta, (const int*)(F.ws + MOE_PTOK) + k * MROWS, D / 64, false, 0);
            pg8::EpiSwiGLU E{(bf16_t*)(F.ws + WS_PA), DEXP}; for (int r_ = 0; r_ < REPS(11); ++r_) pg8::gemm_phase<pg8::EpiSwiGLU>(F.lds, g, S, E, F.tid); }
        SEAM(18 + 2 * k);
        if (INK(19 + 2 * k, 12)) { pg8::Gemm g{(const bf16_t*)(F.ws + WS_PA), (const bf16_t*)F.out, D, DEXP, (size_t)D * DEXP * 2, (float*)(F.ws + WS_SLABM)}; pg8::Order S; S.init(meta[8], D / 256, F.G, F.bid, meta, nullptr, DEXP / 64, true, MAXSLAB_M);
            pg8::EpiMoeDown E{xb, (const int*)(F.ws + MOE_PTOK) + k * MROWS, (const float*)(F.ws + MOE_PW) + k * MROWS, modlat + (size_t)8 * 6144 + 5120}; pg8::gemm_phase<pg8::EpiMoeDown>(F.lds, g, S, E, F.tid); }
        SEAM(19 + 2 * k);
    }
    if (INK(22, 13)) phase_final_a(F);
    SEAM(22);
    if (INK(23, 13)) phase_final_b(F);
#undef IN
#undef INK
#undef SEAM
}

extern "C" void kernel_launch(void* const* d_in, const int* in_sizes, int n_in, void* d_out, int out_size, void* d_ws, size_t ws_size, hipStream_t stream) {
    static int grid = 0;
    if (grid == 0) {
        if (n_in != 27 || in_sizes[0] != NLAT * D || out_size != NLAT * D || ws_size < WS_END) { fprintf(stderr, "kernel_launch: unexpected problem (n_in %d, in0 %d, out %d, ws %zu, need %zu); nothing launched\n", n_in, n_in > 0 ? in_sizes[0] : -1, out_size, ws_size, (size_t)WS_END); grid = -1; return; }
        int dev = 0, cus = 0, per_cu = 0;
        if (hipGetDevice(&dev) != hipSuccess || hipDeviceGetAttribute(&cus, hipDeviceAttributeMultiprocessorCount, dev) != hipSuccess) { grid = -1; return; }
        if (hipFuncSetAttribute((const void*)fwd_kernel, hipFuncAttributeMaxDynamicSharedMemorySize, LDS_BYTES) != hipSuccess) { fprintf(stderr, "kernel_launch: hipFuncSetAttribute failed\n"); grid = -1; return; }
        if (hipOccupancyMaxActiveBlocksPerMultiprocessor(&per_cu, (const void*)fwd_kernel, NTHREADS, LDS_BYTES) != hipSuccess || per_cu < 1) { fprintf(stderr, "kernel_launch: occupancy query says %d\n", per_cu); }
        (void)hipGetLastError();
        grid = cus;
    }
    if (grid < 0) return;
    (void)hipMemsetAsync((char*)d_ws + WS_CTL, 0, CTL_ZERO_BYTES, stream);
    Args a; memset(&a, 0, sizeof(a));
    for (int i = 0; i < 27; ++i) a.in[i] = (const float*)d_in[i];
    a.out = (float*)d_out; a.ws = (unsigned char*)d_ws;
#if MK_ONE_LAUNCH
    a.ph_lo = 0; a.ph_hi = N_PHASES;
    hipLaunchKernelGGL(fwd_kernel, dim3(grid), dim3(NTHREADS), LDS_BYTES, stream, a);
#else
    for (int p = 0; p < N_PHASES; ++p) { a.ph_lo = p; a.ph_hi = p + 1; hipLaunchKernelGGL(fwd_kernel, dim3(grid), dim3(NTHREADS), LDS_BYTES, stream, a); }
#endif
}
```

```cpp
#include <hip/hip_runtime.h>
#include <cstdio>
#include <cstdint>
#include <cstring>

#ifndef MK_ONE_LAUNCH
#define MK_ONE_LAUNCH 1
#endif

#define GAS __attribute__((address_space(1)))
#define LAS __attribute__((address_space(3)))
typedef unsigned short bf16_t;
typedef short bf16x8 __attribute__((ext_vector_type(8)));
typedef float f32x4 __attribute__((ext_vector_type(4)));
typedef float f32x2 __attribute__((ext_vector_type(2)));
typedef unsigned u32x4 __attribute__((ext_vector_type(4)));
typedef unsigned u32x2 __attribute__((ext_vector_type(2)));
typedef LAS unsigned char* ldsp_t;

constexpr int D = 1024, NB = 8, SEQ = 4096, NLAT = NB * SEQ, CTXL = 256, NCTX = NB * CTXL, MROWS = NLAT + NCTX;
constexpr int INW = 3072, NH = 4, HD = 128, CHK = 128;
constexpr int DFF = 2816, NE = 8, DEXP = 3584;
constexpr int SPB = 34;
constexpr int NITEM = NB * SPB;
constexpr float EPS = 1e-6f;
constexpr int NWAVES = 8, NTHREADS = 512;

constexpr size_t MiB = 1u << 20;
constexpr size_t WS_CTL = 0, CTL_ZERO_BYTES = 64 * 1024;
constexpr size_t WS_MODLAT = 1 * MiB;
constexpr size_t WS_MODCTX = 1 * MiB + 2 * 8 * 6144 * 4;
constexpr size_t WS_ROPE = 2 * MiB;
constexpr size_t WS_RGW = 4 * MiB;
constexpr size_t WS_TOT = 5 * MiB;
constexpr size_t WS_CARRY = 8 * MiB;
constexpr size_t WS_MOE = 10 * MiB;
constexpr size_t MOE_CNT = WS_MOE, MOE_META = WS_MOE + 16384, MOE_TOKE = WS_MOE + 65536, MOE_TOKW = WS_MOE + 262144,
                 MOE_PTOK = WS_MOE + 524288, MOE_PW = WS_MOE + 1048576, MOE_PPOS = WS_MOE + 1572864;
constexpr size_t WS_CTXX = 12 * MiB;
constexpr size_t WS_WIN = 20 * MiB;
constexpr size_t WS_WOUT = 32 * MiB;
constexpr size_t WS_WUP = 36 * MiB;
constexpr size_t WS_WDN = 47 * MiB;
constexpr size_t WS_HX = 54 * MiB;
constexpr size_t WS_PA = 122 * MiB;
constexpr size_t WS_KV = 360 * MiB;
constexpr size_t WS_Y = 496 * MiB;
constexpr size_t WS_MOEUP = 360 * MiB;
constexpr size_t WS_SLABA = WS_KV;
constexpr size_t WS_SLABM = 528 * MiB;
constexpr int MAXSLAB_A = 256, MAXSLAB_M = 216;
constexpr size_t XB_OFF = (size_t)NLAT * D * 2;
constexpr size_t WS_XF = WS_HX;
constexpr size_t WS_END = 582 * MiB;
static_assert((size_t)NE * D * DEXP * 2 <= XB_OFF, "MoE-down weights fit the lower half of d_out");
static_assert(WS_PA + (size_t)MROWS * DEXP * 2 <= WS_KV, "ws map");

constexpr int LDS_SCRATCH = 147456;
constexpr int LDS_MISC = LDS_SCRATCH;
constexpr int LDS_DEC = LDS_MISC + 256;
constexpr int LDS_BYTES = LDS_SCRATCH + 8192;

__device__ __forceinline__ float bf2f(unsigned v) { return __uint_as_float(v << 16); }
typedef __bf16 bf16x2_t __attribute__((ext_vector_type(2)));
__device__ __forceinline__ unsigned pk2(float lo, float hi) { const f32x2 v = {lo, hi}; return __builtin_bit_cast(unsigned, __builtin_convertvector(v, bf16x2_t)); }
__device__ __forceinline__ unsigned f2bf(float f) { return pk2(f, f) & 0xffffu; }
__device__ __forceinline__ void unpack8(const u32x4 v, f32x4& a, f32x4& b) {
    a = (f32x4){bf2f(v.x & 0xffffu), __uint_as_float(v.x & 0xffff0000u), bf2f(v.y & 0xffffu), __uint_as_float(v.y & 0xffff0000u)};
    b = (f32x4){bf2f(v.z & 0xffffu), __uint_as_float(v.z & 0xffff0000u), bf2f(v.w & 0xffffu), __uint_as_float(v.w & 0xffff0000u)}; }
__device__ __forceinline__ u32x4 pack8(const f32x4 a, const f32x4 b) { return (u32x4){pk2(a.x, a.y), pk2(a.z, a.w), pk2(b.x, b.y), pk2(b.z, b.w)}; }
template <int M> __device__ __forceinline__ float swz_xor(float v) { return __int_as_float(__builtin_amdgcn_ds_swizzle(__float_as_int(v), (M << 10) | 0x1f)); }
__device__ __forceinline__ float wave_sum(float v) {
    v += swz_xor<1>(v); v += swz_xor<2>(v); v += swz_xor<4>(v); v += swz_xor<8>(v); v += swz_xor<16>(v);
    const auto r = __builtin_amdgcn_permlane32_swap(__float_as_uint(v), __float_as_uint(v), false, false);
    return __uint_as_float(r[0]) + __uint_as_float(r[1]);
}
__device__ __forceinline__ float lane_bcast(float v, int src_lane) { return __int_as_float(__builtin_amdgcn_ds_bpermute(src_lane << 2, __float_as_int(v))); }
__device__ __forceinline__ float sigmoidf_(float x) { return __builtin_amdgcn_rcpf(1.0f + __expf(-x)); }
__device__ __forceinline__ float siluf_(float x) { return x * __builtin_amdgcn_rcpf(1.0f + __expf(-x)); }
__device__ __forceinline__ float gelu_tanh(float x) { const float z = 0.7978845608028654f * (x + 0.044715f * x * x * x); return x * (1.0f - __builtin_amdgcn_rcpf(1.0f + __expf(2.0f * z))); }
#define LDS_WAIT() asm volatile("s_waitcnt lgkmcnt(0)" ::: "memory")
#define WG_BAR_LDS() do { asm volatile("s_waitcnt lgkmcnt(0)" ::: "memory"); __builtin_amdgcn_s_barrier(); asm volatile("" ::: "memory"); } while (0)
__device__ __forceinline__ f32x4 zero4() { float z; asm volatile("v_mov_b32 %0, 0" : "=v"(z)); return (f32x4){z, z, z, z}; }

template <typename T> __device__ __forceinline__ T ldg(const void* base, unsigned off) { return *(const GAS T*)((const GAS char*)base + off); }
template <typename T> __device__ __forceinline__ void stg(void* base, unsigned off, T v) { *(GAS T*)((GAS char*)base + off) = v; }
#define XB_TMO      128
#define XB_XCNT(j)  (256  + 64 * (j))
#define XB_XSUB(j)  (1280 + 64 * (j))
#define XB_XGEN(j)  (2304 + 64 * (j))
#define XB_TOP      3328
#define XB_TOPGEN   3392
#define XCD_BAR_WORDS 3456
#define XB_SPIN_CAP (1u << 18)
__device__ __forceinline__ unsigned xb_ld(unsigned* p)              { return __hip_atomic_load(p, __ATOMIC_RELAXED, __HIP_MEMORY_SCOPE_AGENT); }
__device__ __forceinline__ unsigned xb_add(unsigned* p, unsigned v) { return __hip_atomic_fetch_add(p, v, __ATOMIC_RELAXED, __HIP_MEMORY_SCOPE_AGENT); }
__device__ __forceinline__ unsigned xb_xcc_id() { return (unsigned)__builtin_amdgcn_s_getreg((3 << 11) | 20) & 0xFu; }
#define XB_SPIN(cond, bar) do { unsigned _sp = 0; while (cond) { __builtin_amdgcn_s_sleep(1); \
    if ((++_sp & 255u) == 0u) { if (xb_ld(&(bar)[XB_TMO])) break; if (_sp > XB_SPIN_CAP) { atomicAdd(&(bar)[XB_TMO], 1u); break; } } } } while (0)
struct XcdBarrier { unsigned* bar; unsigned x; volatile LAS unsigned* st; };
__device__ __forceinline__ XcdBarrier xcd_barrier_post(unsigned* bar, volatile LAS unsigned* st) {
    XcdBarrier b; b.bar = bar; b.x = xb_xcc_id(); b.st = st;
    if (threadIdx.x == 0) (void)xb_add(&bar[XB_XCNT(b.x)], 1u);
    return b;
}
__device__ __forceinline__ void xcd_barrier_complete(unsigned* bar, unsigned x, unsigned& nloc, unsigned& nx) {
    const unsigned G = gridDim.x * gridDim.y * gridDim.z;
    unsigned sum, cnt, mine, sp = 0u;
    for (;;) {
        sum = 0u; cnt = 0u; mine = 0u;
#pragma unroll
        for (unsigned j = 0; j < 16; ++j) { const unsigned c = xb_ld(&bar[XB_XCNT(j)]); sum += c; cnt += (c > 0u) ? 1u : 0u; mine = (j == x) ? c : mine; }
        if (sum == G) break;
        __builtin_amdgcn_s_sleep(1);
        if ((++sp & 255u) == 0u) { if (xb_ld(&bar[XB_TMO])) break; if (sp > XB_SPIN_CAP) { atomicAdd(&bar[XB_TMO], 1u); break; } }
    }
    nloc = mine > 0u ? mine : 1u; nx = cnt > 0u ? cnt : 1u;
}
__device__ __forceinline__ void xcd_barrier(const XcdBarrier& b) {
    asm volatile("s_waitcnt vmcnt(0)" ::: "memory");
    __syncthreads();
    if (threadIdx.x == 0) {
        unsigned* bar = b.bar;
        __builtin_amdgcn_s_waitcnt(0);
        unsigned nloc = b.st[0], nx = b.st[1];
        if (nloc == 0u) { xcd_barrier_complete(bar, b.x, nloc, nx); b.st[0] = nloc; b.st[1] = nx; }
        const unsigned old = xb_add(&bar[XB_XSUB(b.x)], 1u);
        const unsigned gen = old / nloc;
        if (old + 1u == (gen + 1u) * nloc) {
            __builtin_amdgcn_fence(__ATOMIC_RELEASE, "agent");
            asm volatile("s_waitcnt vmcnt(0)" ::: "memory");
            const unsigned og = xb_add(&bar[XB_TOP], 1u);
            const unsigned tg = og / nx;
            if (og + 1u == (tg + 1u) * nx) xb_add(&bar[XB_TOPGEN], 1u);
            else XB_SPIN(xb_ld(&bar[XB_TOPGEN]) == tg, bar);
            __builtin_amdgcn_fence(__ATOMIC_ACQUIRE, "agent");
            xb_add(&bar[XB_XGEN(b.x)], 1u);
            asm volatile("s_waitcnt vmcnt(0)" ::: "memory");
        } else {
            XB_SPIN(xb_ld(&bar[XB_XGEN(b.x)]) == gen, bar);
            __builtin_amdgcn_fence(__ATOMIC_ACQUIRE, "agent");
            asm volatile("s_waitcnt vmcnt(0)" ::: "memory");
        }
    }
    __syncthreads();
}

namespace pg8 {
constexpr int BM = 256, BK = 64, HALF = 128, HTB = HALF * BK * 2, STAGE_BYTES = 8 * HTB, NXCD = 8, WGM = 8;
__host__ __device__ __forceinline__ int lds_byte(int r, int c) { const int st = (r >> 4) * 2 + (c >> 5), rr = r & 15, cc = c & 31, ob = rr * 64 + cc * 2; return st * 1024 + (ob ^ (((ob >> 9) & 1) << 5)); }
__host__ __device__ __forceinline__ void stage_rc(int b, int& R, int& C) { const int st = b / 1024, sb = b % 1024, swz = sb ^ (((sb >> 9) & 1) << 5); R = (st >> 1) * 16 + swz / 64; C = (st & 1) * 32 + (swz % 64) / 2; }
__host__ __device__ __forceinline__ int perm32(int rho) { const int n = rho >> 4, i = rho & 15; return 8 * (i >> 2) + 4 * n + (i & 3); }

struct Unit { int pm, pn, e, kt0, nt, slab; };
struct Gemm { const bf16_t* A; const bf16_t* Bt; int N, K; size_t estride; float* slabs; int tiled; };

__device__ __forceinline__ int split_factor(int U, int G, int ntiles, int maxslabs) {
    const int R = U % G; if (R == 0) return 1;
    int S = G / R; if (S > 8) S = 8; if (S > ntiles / 4) S = ntiles / 4; if (R * S > maxslabs) S = maxslabs / R;
    return S < 2 ? 1 : S;
}
struct Order {
    int nM, nN, G, c, ntiles, mainu, S, total; const int* segs; const int* rowmap;
    int sg1, sg2, sg3, sg4, sg5, sg6, sg7;
    __device__ __forceinline__ void init(int nM_, int nN_, int G_, int c_, const int* segs_, const int* rowmap_, int ntiles_, bool split, int maxslabs) {
        nM = nM_; nN = nN_; G = G_; c = c_; segs = segs_; rowmap = rowmap_; ntiles = ntiles_;
        sg1 = sg2 = sg3 = sg4 = sg5 = sg6 = sg7 = 0; if (segs_) { sg1 = segs_[1]; sg2 = segs_[2]; sg3 = segs_[3]; sg4 = segs_[4]; sg5 = segs_[5]; sg6 = segs_[6]; sg7 = segs_[7]; }
        const int U = nM * nN; S = split ? split_factor(U, G, ntiles, maxslabs) : 1; const int R = (S > 1) ? U % G : 0; mainu = U - R; total = mainu + R * S; }
    __device__ __forceinline__ bool next(int i, Unit& u) const {
        const long L = (long)i * G + c; if (L >= total) return false;
        int wgid; u.kt0 = 0; u.nt = ntiles; u.slab = -1;
        if (L < mainu) { wgid = (int)L; const int q = mainu / NXCD, r = mainu % NXCD, xcd = wgid % NXCD, off = wgid / NXCD; wgid = (xcd < r ? xcd * (q + 1) : r * (q + 1) + (xcd - r) * q) + off; }
        else { const int sub = (int)L - mainu, lu = sub / S, sl = sub - lu * S, pairs = ntiles / 2, p0 = (sl * pairs) / S, p1 = ((sl + 1) * pairs) / S;
            wgid = mainu + lu; u.kt0 = 2 * p0; u.nt = 2 * (p1 - p0); u.slab = sub; }
        const int nig = WGM * nN, gid = wgid / nig, fm = gid * WGM, gsz = (nM - fm) < WGM ? (nM - fm) : WGM;
        u.pm = fm + ((wgid % nig) % gsz); u.pn = (wgid % nig) / gsz; u.e = 0;
        if (segs) u.e = (u.pm >= sg1) + (u.pm >= sg2) + (u.pm >= sg3) + (u.pm >= sg4) + (u.pm >= sg5) + (u.pm >= sg6) + (u.pm >= sg7);
        return true;
    }
    __device__ __forceinline__ int arow(const Unit& u, int r) const {
        if (rowmap) { const int t = rowmap[u.pm * BM + r]; return t < 0 ? 0 : t; }
        return u.pm * BM + r;
    }
};

__device__ __forceinline__ unsigned cvt_pk_bf16(float lo, float hi) { return pk2(lo, hi); }

struct EpiBf16 {
    static constexpr bool PERM = true, SPLIT = false;
    bf16_t* O; int ldc;
    __device__ __forceinline__ void operator()(const f32x4 (&acc)[2][2][4][2], const Unit& u, int wr, int wc, int fr, int fq) const {
        asm volatile("" : "+v"(fr), "+v"(fq));
        const int row0 = u.pm * BM + wr * 64 + fr, col0 = u.pn * BM + wc * 32 + 8 * fq;
#pragma unroll
        for (int ai = 0; ai < 2; ++ai)
#pragma unroll
            for (int m = 0; m < 4; ++m) { bf16_t* rowp = O + (size_t)(row0 + ai * HALF + m * 16) * ldc + col0;
#pragma unroll
                for (int bj = 0; bj < 2; ++bj) { const f32x4 v0 = acc[ai][bj][m][0], v1 = acc[ai][bj][m][1];
                    u32x4 w; w.x = cvt_pk_bf16(v0[0], v0[1]); w.y = cvt_pk_bf16(v0[2], v0[3]); w.z = cvt_pk_bf16(v1[0], v1[1]); w.w = cvt_pk_bf16(v1[2], v1[3]);
                    *(u32x4*)(rowp + bj * HALF) = w; } }
    }
};
struct EpiInProj {
    static constexpr bool PERM = true, SPLIT = false;
    bf16_t* O; int ldc; const float* ct; const float* st;
    __device__ __forceinline__ void operator()(const f32x4 (&acc)[2][2][4][2], const Unit& u, int wr, int wc, int fr, int fq) const {
        asm volatile("" : "+v"(fr), "+v"(fq));
        const int row0 = u.pm * BM + wr * 64 + fr, col0 = u.pn * BM + wc * 32 + 8 * fq;
        const bool rot = (u.pn >= 4) && (u.pn < 8) && (u.pm * BM < NLAT);
#pragma unroll
        for (int ai = 0; ai < 2; ++ai)
#pragma unroll
            for (int m = 0; m < 4; ++m) { const int row = row0 + ai * HALF + m * 16;
                bf16_t* rowp = O + ((size_t)(row >> 7) * (ldc / 128) + u.pn * 2) * 16384 + (row & 127) * 128 + wc * 32 + 8 * fq;
                f32x4 c = {1.f, 1.f, 1.f, 1.f}, s = {0.f, 0.f, 0.f, 0.f};
                if (rot) { const unsigned to = (unsigned)((row & (SEQ - 1)) * 64 + wc * 16 + fq * 4) * 4u; c = ldg<f32x4>(ct, to); s = ldg<f32x4>(st, to); }
#pragma unroll
                for (int bj = 0; bj < 2; ++bj) { const f32x4 v0 = acc[ai][bj][m][0], v1 = acc[ai][bj][m][1];
                    u32x4 w; w.x = cvt_pk_bf16(v0[0] * c[0] - v0[1] * s[0], v0[0] * s[0] + v0[1] * c[0]); w.y = cvt_pk_bf16(v0[2] * c[1] - v0[3] * s[1], v0[2] * s[1] + v0[3] * c[1]);
                    w.z = cvt_pk_bf16(v1[0] * c[2] - v1[1] * s[2], v1[0] * s[2] + v1[1] * c[2]); w.w = cvt_pk_bf16(v1[2] * c[3] - v1[3] * s[3], v1[2] * s[3] + v1[3] * c[3]);
                    *(u32x4*)(rowp + bj * 16384) = w; } }
    }
};
struct EpiSwiGLU {
    static constexpr bool PERM = true, SPLIT = false;
    bf16_t* O; int ldc;
    __device__ __forceinline__ void operator()(const f32x4 (&acc)[2][2][4][2], const Unit& u, int wr, int wc, int fr, int fq) const {
        asm volatile("" : "+v"(fr), "+v"(fq));
        bf16_t* tb = O + ((size_t)(u.pm * (ldc / 64) + u.pn * 2 + (wc >> 1)) * 256 + wr * 64 + fr) * 64 + (wc & 1) * 32 + 8 * fq;
#pragma unroll
        for (int ai = 0; ai < 2; ++ai)
#pragma unroll
            for (int m = 0; m < 4; ++m) { bf16_t* rowp = tb + (ai * HALF + m * 16) * 64;
                float o[8];
#pragma unroll
                for (int n = 0; n < 2; ++n)
#pragma unroll
                    for (int j = 0; j < 4; ++j) { const float a = acc[ai][0][m][n][j], b = acc[ai][1][m][n][j]; o[n * 4 + j] = (a * __builtin_amdgcn_rcpf(1.0f + __expf(-a))) * b; }
                u32x4 w; w.x = cvt_pk_bf16(o[0], o[1]); w.y = cvt_pk_bf16(o[2], o[3]); w.z = cvt_pk_bf16(o[4], o[5]); w.w = cvt_pk_bf16(o[6], o[7]);
                *(u32x4*)rowp = w; }
    }
};
struct EpiResid {
    static constexpr bool PERM = true, SPLIT = true;
    const float* src_f32; bf16_t* xb; const float* src_ctx; float* dst_ctx; const float* gate_lat; const float* gate_ctx;
    __device__ __forceinline__ void slab_first(const Unit&, int, int, int, int) const {}
    __device__ __forceinline__ void operator()(const f32x4 (&acc)[2][2][4][2], const Unit& u, int wr, int wc, int fr, int fq) const {
        asm volatile("" : "+v"(fr), "+v"(fq));
        const int prow = u.pm * BM; const bool lat = prow < NLAT;
        const float* gate = lat ? gate_lat + (size_t)(prow / SEQ) * 6144 : gate_ctx;
        const int r0 = wr * 64 + fr, col0 = u.pn * BM + wc * 32 + 8 * fq;
        f32x4 gv[2][2];
#pragma unroll
        for (int bj = 0; bj < 2; ++bj)
#pragma unroll
            for (int n = 0; n < 2; ++n) gv[bj][n] = *(const f32x4*)(gate + col0 + bj * HALF + 4 * n);
        if (lat) {
#pragma unroll
            for (int ai = 0; ai < 2; ++ai)
#pragma unroll
                for (int m = 0; m < 4; ++m) { const size_t off = (size_t)(prow + r0 + ai * HALF + m * 16) * D + col0;
#pragma unroll
                    for (int bj = 0; bj < 2; ++bj) { f32x4 s0, s1;
                        if (src_f32) { s0 = *(const f32x4*)(src_f32 + off + bj * HALF); s1 = *(const f32x4*)(src_f32 + off + bj * HALF + 4); }
                        else unpack8(*(const u32x4*)(xb + off + bj * HALF), s0, s1);
                        *(u32x4*)(xb + off + bj * HALF) = pack8(s0 + gv[bj][0] * acc[ai][bj][m][0], s1 + gv[bj][1] * acc[ai][bj][m][1]); }
                    if (m == 3) asm volatile("" ::: "memory"); }
        } else {
            const float* src = src_ctx + (size_t)(prow - NLAT) * D; float* dst = dst_ctx + (size_t)(prow - NLAT) * D;
#pragma unroll
            for (int ai = 0; ai < 2; ++ai)
#pragma unroll
                for (int m = 0; m < 4; ++m) { const size_t off = (size_t)(r0 + ai * HALF + m * 16) * D + col0;
#pragma unroll
                    for (int bj = 0; bj < 2; ++bj)
#pragma unroll
                        for (int n = 0; n < 2; ++n) { const f32x4 sv = *(const f32x4*)(src + off + bj * HALF + 4 * n); *(f32x4*)(dst + off + bj * HALF + 4 * n) = sv + gv[bj][n] * acc[ai][bj][m][n]; }
                    asm volatile("" ::: "memory"); }
        }
    }
};
struct EpiMoeDown {
    static constexpr bool PERM = true, SPLIT = true;
    bf16_t* xb; bf16_t* dst; const int* ptok; const float* pw; const float* gate_lat;
    __device__ __forceinline__ void slab_first(const Unit& u, int wr, int wc, int fr, int fq) const {
        if (dst == xb) return;
        asm volatile("" : "+v"(fr), "+v"(fq));
        const int r0 = u.pm * BM + wr * 64 + fr, col0 = u.pn * BM + wc * 32 + 8 * fq;
#pragma unroll
        for (int i = 0; i < 8; ++i) { const int tok = ptok[r0 + (i >> 2) * HALF + (i & 3) * 16];
            if (tok >= 0) { const size_t o = (size_t)tok * D + col0; *(u32x4*)(dst + o) = *(const u32x4*)(xb + o); *(u32x4*)(dst + o + HALF) = *(const u32x4*)(xb + o + HALF); } }
    }
    __device__ __forceinline__ void operator()(const f32x4 (&acc)[2][2][4][2], const Unit& u, int wr, int wc, int fr, int fq) const {
        asm volatile("" : "+v"(fr), "+v"(fq));
        const int r0 = u.pm * BM + wr * 64 + fr, col0 = u.pn * BM + wc * 32 + 8 * fq;
        int tk[8]; float wk[8];
#pragma unroll
        for (int i = 0; i < 8; ++i) { const int r = r0 + (i >> 2) * HALF + (i & 3) * 16; tk[i] = ptok[r]; wk[i] = pw[r]; }
#pragma unroll
        for (int ai = 0; ai < 2; ++ai)
#pragma unroll
            for (int m = 0; m < 4; ++m) { const int tok = tk[ai * 4 + m]; const float w = wk[ai * 4 + m];
                if (tok >= 0) { const bf16_t* xr = xb + (size_t)tok * D + col0; bf16_t* xw = dst + (size_t)tok * D + col0; const float* gate = gate_lat + (size_t)(tok / SEQ) * 6144 + col0;
#pragma unroll
                    for (int bj = 0; bj < 2; ++bj) { const f32x4 g0 = *(const f32x4*)(gate + bj * HALF), g1 = *(const f32x4*)(gate + bj * HALF + 4); f32x4 s0, s1; unpack8(*(const u32x4*)(xr + bj * HALF), s0, s1);
                        *(u32x4*)(xw + bj * HALF) = pack8(s0 + (g0 * w) * acc[ai][bj][m][0], s1 + (g1 * w) * acc[ai][bj][m][1]); } }
                if (m & 1) asm volatile("" ::: "memory"); }
    }
};

template <class Epi>
__device__ __forceinline__ void gemm_phase(ldsp_t lds, const Gemm g, const Order& S, const Epi& E, const int tid) {
    const int wid = __builtin_amdgcn_readfirstlane(tid >> 6), lane = tid & 63, wr = wid >> 2, wc = wid & 3, fr = lane & 15, fq = lane >> 4;
    const int K = g.K;
    unsigned voffB[2];
#pragma unroll
    for (int i = 0; i < 2; ++i) { int R, C; stage_rc(tid * 16 + i * 8192, R, C); const int Rb = Epi::PERM ? ((R & ~31) + perm32(R & 31)) : R;
        voffB[i] = (unsigned)(Rb * (g.tiled ? BK : K) + C) * 2u; }
    const size_t kstep = g.tiled ? (size_t)(256 * BK * 2) : (size_t)(BK * 2);
    const size_t hstep = g.tiled ? (size_t)HALF * BK * 2 : (size_t)HALF * K * 2;
    const size_t tstep = (size_t)2 * HALF * K * 2;
    const unsigned ldsw = (unsigned)wid * 1024u;
    const int aoff = lds_byte(wr * 64 + fr, fq * 8), boff = lds_byte(wc * 32 + fr, fq * 8);
#define PG8_SA(b, h) (((b) * 2 + (h)) * HTB)
#define PG8_SB(b, h) ((4 + (b) * 2 + (h)) * HTB)
#define PG8_STAGE_B(bufoff, gbase) do { _Pragma("unroll") for (int _i = 0; _i < 2; ++_i) \
        __builtin_amdgcn_global_load_lds((const unsigned*)((const char*)(gbase) + voffB[_i]), (LAS unsigned*)(lds + (bufoff) + ldsw + _i * 8192), 16, 0, 0); } while (0)
#define PG8_STAGE_A(bufoff, gbase, o0, o1) do { \
        __builtin_amdgcn_global_load_lds((const unsigned*)((const char*)(gbase) + (o0)), (LAS unsigned*)(lds + (bufoff) + ldsw), 16, 0, 0); \
        __builtin_amdgcn_global_load_lds((const unsigned*)((const char*)(gbase) + (o1)), (LAS unsigned*)(lds + (bufoff) + ldsw + 8192), 16, 0, 0); } while (0)
#define PG8_LDA(dst, b, h) do { _Pragma("unroll") for (int m = 0; m < 4; ++m) _Pragma("unroll") for (int k = 0; k < 2; ++k) dst[m][k] = *(const LAS bf16x8*)(lds + PG8_SA(b, h) + aoff + m * 2048 + k * 1024); } while (0)
#define PG8_LDB(dst, b, h) do { _Pragma("unroll") for (int n = 0; n < 2; ++n) _Pragma("unroll") for (int k = 0; k < 2; ++k) dst[n][k] = *(const LAS bf16x8*)(lds + PG8_SB(b, h) + boff + n * 2048 + k * 1024); } while (0)
#define PG8_MMA(ai, bj, At, Bt) do { __builtin_amdgcn_s_setprio(1); _Pragma("unroll") for (int m = 0; m < 4; ++m) _Pragma("unroll") for (int n = 0; n < 2; ++n) _Pragma("unroll") for (int k = 0; k < 2; ++k) \
        acc[ai][bj][m][n] = __builtin_amdgcn_mfma_f32_16x16x32_bf16(Bt[n][k], At[m][k], acc[ai][bj][m][n], 0, 0, 0); __builtin_amdgcn_s_setprio(0); } while (0)
#define PG8_WAIT_V(n) asm volatile("s_waitcnt vmcnt(" #n ")" ::: "memory")
#define PG8_WAIT_L(n) asm volatile("s_waitcnt lgkmcnt(" #n ")" ::: "memory")
#define PG8_BAR __builtin_amdgcn_s_barrier()
#define PG8_SCHED __builtin_amdgcn_sched_barrier(0)
#define PG8_AOFFS(u, o00, o01, o10, o11) do { int R0_, C0_, R1_, C1_; stage_rc(tid * 16, R0_, C0_); stage_rc(tid * 16 + 8192, R1_, C1_); \
        if (g.tiled) { const int tb_ = ((u).pm * (K / BK) + (u).kt0) * 256; o00 = (unsigned)((tb_ + R0_) * BK + C0_) * 2u; o01 = (unsigned)((tb_ + R1_) * BK + C1_) * 2u; \
            o10 = (unsigned)((tb_ + HALF + R0_) * BK + C0_) * 2u; o11 = (unsigned)((tb_ + HALF + R1_) * BK + C1_) * 2u; break; } \
        o00 = (unsigned)(S.arow(u, R0_) * K + C0_ + (u).kt0 * BK) * 2u; o01 = (unsigned)(S.arow(u, R1_) * K + C1_ + (u).kt0 * BK) * 2u; \
        o10 = (unsigned)(S.arow(u, HALF + R0_) * K + C0_ + (u).kt0 * BK) * 2u; o11 = (unsigned)(S.arow(u, HALF + R1_) * K + C1_ + (u).kt0 * BK) * 2u; } while (0)
    Unit cur, nxt; int ui = 0;
    if (!S.next(0, cur)) return;
    f32x4 acc[2][2][4][2];
    { float z_; asm volatile("v_mov_b32 %0, 0" : "=v"(z_));
#pragma unroll
    for (int a = 0; a < 2; ++a)
#pragma unroll
        for (int b = 0; b < 2; ++b)
#pragma unroll
            for (int m = 0; m < 4; ++m)
#pragma unroll
                for (int n = 0; n < 2; ++n) acc[a][b][m][n] = (f32x4){z_, z_, z_, z_}; }
    bf16x8 At[4][2], B0[2][2], B1[2][2];
    const char* const Abase = (const char*)g.A;
    const char* cB = (const char*)g.Bt + (size_t)cur.e * g.estride + (size_t)cur.pn * tstep + (size_t)cur.kt0 * kstep;
    unsigned c00, c01, c10, c11;
    PG8_AOFFS(cur, c00, c01, c10, c11);
    PG8_STAGE_B(PG8_SB(0, 0), cB); PG8_STAGE_B(PG8_SB(0, 1), cB + hstep); PG8_STAGE_A(PG8_SA(0, 0), Abase, c00, c01); PG8_STAGE_A(PG8_SA(0, 1), Abase, c10, c11);
    if (wr == 1) PG8_BAR;
    PG8_WAIT_V(2); PG8_BAR;
    PG8_STAGE_B(PG8_SB(1, 0), cB + kstep); PG8_STAGE_A(PG8_SA(1, 0), Abase + kstep, c00, c01); PG8_STAGE_B(PG8_SB(1, 1), cB + hstep + kstep);
    PG8_WAIT_V(6); PG8_BAR;
    for (;;) {
        const bool has_next = S.next(ui + 1, nxt);
        const char* nB = has_next ? (const char*)g.Bt + (size_t)nxt.e * g.estride + (size_t)nxt.pn * tstep + (size_t)nxt.kt0 * kstep : cB;
        const int nt = cur.nt;
        int rn0 = 0, rn1 = 0, rn2 = 0, rn3 = 0;
        if (S.rowmap && has_next) { int R0_, C0_, R1_, C1_; stage_rc(tid * 16, R0_, C0_); stage_rc(tid * 16 + 8192, R1_, C1_);
            rn0 = S.arow(nxt, R0_); rn1 = S.arow(nxt, R1_); rn2 = S.arow(nxt, HALF + R0_); rn3 = S.arow(nxt, HALF + R1_); }
        for (int t = 0; t < nt; t += 2) {
            const bool last = (t == nt - 2);
            const char* a1 = Abase + (size_t)(t + 1) * kstep;
            const char* a2 = last ? Abase : Abase + (size_t)(t + 2) * kstep; const char* b2 = last ? nB : cB + (size_t)(t + 2) * kstep;
            const char* a3 = a2 + kstep; const char* b3 = b2 + kstep;
            PG8_LDB(B0, 0, 0); PG8_LDB(B1, 0, 1); PG8_SCHED; PG8_LDA(At, 0, 0); PG8_STAGE_A(PG8_SA(1, 1), a1, c10, c11);
            PG8_WAIT_V(8); PG8_WAIT_L(0); PG8_BAR; PG8_MMA(0, 0, At, B0); PG8_MMA(0, 1, At, B1); PG8_BAR; PG8_SCHED;
            if (last && has_next) {
                if (S.rowmap) { int R0_, C0_, R1_, C1_; stage_rc(tid * 16, R0_, C0_); stage_rc(tid * 16 + 8192, R1_, C1_);
                    c00 = (unsigned)(rn0 * K + C0_ + nxt.kt0 * BK) * 2u; c01 = (unsigned)(rn1 * K + C1_ + nxt.kt0 * BK) * 2u; c10 = (unsigned)(rn2 * K + C0_ + nxt.kt0 * BK) * 2u; c11 = (unsigned)(rn3 * K + C1_ + nxt.kt0 * BK) * 2u; }
                else { PG8_AOFFS(nxt, c00, c01, c10, c11); } }
            PG8_LDA(At, 0, 1); PG8_STAGE_B(PG8_SB(0, 0), b2); PG8_STAGE_B(PG8_SB(0, 1), b2 + hstep); PG8_STAGE_A(PG8_SA(0, 0), a2, c00, c01);
            PG8_WAIT_V(8); PG8_WAIT_L(0); PG8_BAR; PG8_MMA(1, 0, At, B0); PG8_MMA(1, 1, At, B1); PG8_BAR; PG8_SCHED;
            PG8_LDB(B0, 1, 0); PG8_LDB(B1, 1, 1); PG8_SCHED; PG8_LDA(At, 1, 0); PG8_STAGE_A(PG8_SA(0, 1), a2, c10, c11);
            PG8_WAIT_V(8); PG8_WAIT_L(0); PG8_BAR; PG8_MMA(0, 0, At, B0); PG8_MMA(0, 1, At, B1); PG8_BAR; PG8_SCHED;
            PG8_LDA(At, 1, 1); PG8_STAGE_B(PG8_SB(1, 0), b3); PG8_STAGE_B(PG8_SB(1, 1), b3 + hstep); PG8_STAGE_A(PG8_SA(1, 0), a3, c00, c01);
            PG8_WAIT_V(8); PG8_WAIT_L(0); PG8_BAR; PG8_MMA(1, 0, At, B0); PG8_MMA(1, 1, At, B1); PG8_BAR; PG8_SCHED;
        }
        if (wr == 0) PG8_BAR;
        if (Epi::SPLIT && cur.slab >= 0) {
            int fr_ = fr, fq_ = fq; asm volatile("" : "+v"(fr_), "+v"(fq_));
            float* sp = g.slabs + (size_t)cur.slab * 65536 + (size_t)(wr * 64 + fr_) * 256 + wc * 32 + (Epi::PERM ? 8 : 4) * fq_;
#pragma unroll
            for (int ai = 0; ai < 2; ++ai)
#pragma unroll
                for (int m = 0; m < 4; ++m)
#pragma unroll
                    for (int bj = 0; bj < 2; ++bj)
#pragma unroll
                        for (int n = 0; n < 2; ++n) *(f32x4*)(sp + (ai * HALF + m * 16) * 256 + bj * HALF + n * (Epi::PERM ? 4 : 16)) = acc[ai][bj][m][n];
            if constexpr (Epi::SPLIT) { if (cur.kt0 == 0) E.slab_first(cur, wr, wc, fr, fq); }
        } else E(acc, cur, wr, wc, fr, fq);
        if (!has_next) break;
        { float z_; asm volatile("v_mov_b32 %0, 0" : "=v"(z_));
#pragma unroll
        for (int a = 0; a < 2; ++a)
#pragma unroll
            for (int b = 0; b < 2; ++b)
#pragma unroll
                for (int m = 0; m < 4; ++m)
#pragma unroll
                    for (int n = 0; n < 2; ++n) acc[a][b][m][n] = (f32x4){z_, z_, z_, z_}; }
        cur = nxt; cB = nB; ++ui;
        if (wr == 1) PG8_BAR;
    }
    PG8_WAIT_V(0);
    PG8_BAR;
#undef PG8_SA
#undef PG8_SB
#undef PG8_STAGE_A
#undef PG8_STAGE_B
#undef PG8_LDA
#undef PG8_LDB
#undef PG8_MMA
#undef PG8_WAIT_V
#undef PG8_WAIT_L
#undef PG8_BAR
#undef PG8_SCHED
#undef PG8_AOFFS
}
}

struct Args { const float* in[27]; float* out; unsigned char* ws; int ph_lo, ph_hi; };
struct Frame {
    ldsp_t lds; int tid, lane, wave, wave0, G, bid;
    const Args* pa; float* out; unsigned char* ws;
    const Args* pa0; float* out0; unsigned char* ws0;
};
enum { I_X = 0, I_C, I_CTX, I_CCTX, I_WMOD, I_BMOD, I_GMIX, I_GFFN, I_GFINAL, I_WIN, I_WOUT, I_CONVW, I_CONVB, I_RGWA, I_RGBA, I_RGWX, I_RGBX, I_RGLAM, I_RETDEC,
       I_FW1, I_FW3, I_FW2, I_MROUTER, I_MROUTERB, I_MW1, I_MW3, I_MW2 };

constexpr int TRS = 64 * 65 * 4;
struct TrItem { const float* W; bf16_t* WT; int ldw, k0, n0, ldt, drow0; float scale; int perm; };
__device__ __forceinline__ void tr_load(const TrItem& t, f32x4 (&v)[16], int lane) {
    const int r4 = lane >> 4, c4 = (lane & 15) * 4;
#pragma unroll
    for (int i = 0; i < 16; ++i) v[i] = *(const f32x4*)(t.W + (size_t)(t.k0 + 4 * i + r4) * t.ldw + t.n0 + c4);
}
__device__ __forceinline__ void tr_store(const TrItem& t, const f32x4 (&v)[16], LAS float* scr, int lane) {
    { const int r4 = lane >> 4, c4 = (lane & 15) * 4;
#pragma unroll
      for (int i = 0; i < 16; ++i) { LAS float* d = scr + (4 * i + r4) * 65 + c4; d[0] = v[i].x; d[1] = v[i].y; d[2] = v[i].z; d[3] = v[i].w; } }
    LDS_WAIT(); asm volatile("" ::: "memory");
    const int c = lane & 7; const float scale = t.scale;
#pragma unroll
    for (int j = 0; j < 8; ++j) { const int n = (lane >> 3) + 8 * j; const LAS float* sp = scr + (8 * c) * 65 + n;
        u32x4 o; o.x = pk2(sp[0 * 65] * scale, sp[1 * 65] * scale); o.y = pk2(sp[2 * 65] * scale, sp[3 * 65] * scale); o.z = pk2(sp[4 * 65] * scale, sp[5 * 65] * scale); o.w = pk2(sp[6 * 65] * scale, sp[7 * 65] * scale);
        int drow = t.drow0 + n; if (t.perm == 1) drow = (drow & ~127) + ((drow & 63) << 1) + ((drow >> 6) & 1);
        const int kk = t.k0 + 8 * c;
        bf16_t* dp = (t.perm == 2) ? t.WT + ((size_t)((drow >> 8) * (t.ldt / 64) + (kk >> 6)) * 256 + (drow & 255)) * 64 + (kk & 63) : t.WT + (size_t)drow * t.ldt + kk;
        *(u32x4*)dp = o; }
    LDS_WAIT(); asm volatile("" ::: "memory");
}
__device__ __forceinline__ TrItem up_item(const float* w1, const float* w3, int F, bf16_t* WT, int r) {
    const int per = 16 * (F / 64); const int which = r / per; r -= which * per;
    const int nblk = F / 64, kb = r / nblk, nb = r % nblk, n0 = nb * 64;
    return TrItem{which ? w3 : w1, WT, F, kb * 64, n0, D, (n0 / 128) * 256 + (n0 % 128) + which * 128, 1.0f, 0};
}
__device__ __forceinline__ TrItem small_item(Frame& F, int r) {
    constexpr int I_IN = 16 * (INW / 64), I_OUT = 16 * (D / 64), I_UP = 2 * 16 * (DFF / 64);
    if (r < 2 * I_IN) { const int l = r / I_IN; r -= l * I_IN; const int nblk = INW / 64, kb = r / nblk, nb = r % nblk, n0 = nb * 64;
        const float sc = (n0 >= 1536 && n0 < 2048) ? 0.08838834764831845f : 1.0f;
        return TrItem{F.pa->in[I_WIN] + (size_t)l * D * INW, (bf16_t*)(F.ws + WS_WIN) + (size_t)l * INW * D, INW, kb * 64, n0, D, n0, sc, (n0 >= 1024 && n0 < 2048) ? 1 : 0}; }
    r -= 2 * I_IN;
    if (r < 2 * I_OUT) { const int l = r / I_OUT; r -= l * I_OUT; const int nblk = D / 64, kb = r / nblk, nb = r % nblk;
        return TrItem{F.pa->in[I_WOUT] + (size_t)l * D * D, (bf16_t*)(F.ws + WS_WOUT) + (size_t)l * D * D, D, kb * 64, nb * 64, D, nb * 64, 1.0f, 0}; }
    r -= 2 * I_OUT;
    if (r < I_UP) return up_item(F.pa->in[I_FW1], F.pa->in[I_FW3], DFF, (bf16_t*)(F.ws + WS_WUP), r);
    r -= I_UP;
    { const int nblk = D / 64, kb = r / nblk, nb = r % nblk; return TrItem{F.pa->in[I_FW2], (bf16_t*)(F.ws + WS_WDN), D, kb * 64, nb * 64, DFF, nb * 64, 1.0f, 2}; }
}
__device__ __forceinline__ TrItem moe_item(Frame& F, int it) {
    constexpr int I_UP = 2 * 16 * (DEXP / 64), I_DN = (DEXP / 64) * (D / 64), PER_E = I_UP + I_DN;
    const int e = it / PER_E; int r = it - e * PER_E;
    if (r < I_UP) return up_item(F.pa->in[I_MW1] + (size_t)e * D * DEXP, F.pa->in[I_MW3] + (size_t)e * D * DEXP, DEXP, (bf16_t*)(F.ws + WS_MOEUP) + (size_t)e * 2 * DEXP * D, r);
    r -= I_UP;
    { const int nblk = D / 64, kb = r / nblk, nb = r % nblk; return TrItem{F.pa->in[I_MW2] + (size_t)e * DEXP * D, (bf16_t*)F.out + (size_t)e * D * DEXP, D, kb * 64, nb * 64, DEXP, nb * 64, 1.0f, 0}; }
}
__device__ __forceinline__ void phase_convert_small(Frame& F) {
    LAS float* scr = (LAS float*)(F.lds + F.wave * TRS);
    const int gw = F.bid * NWAVES + F.wave, NGW = F.G * NWAVES;
    constexpr int NITEMS = 2 * 16 * (INW / 64) + 2 * 16 * (D / 64) + 2 * 16 * (DFF / 64) + (DFF / 64) * (D / 64);
    if (gw < NITEMS) { TrItem cur = small_item(F, gw); f32x4 va[16], vb[16]; tr_load(cur, va, F.lane);
        for (int it = gw; it < NITEMS; it += 2 * NGW) {
            const bool h1 = it + NGW < NITEMS; TrItem n1 = cur; if (h1) { n1 = small_item(F, it + NGW); tr_load(n1, vb, F.lane); }
            tr_store(cur, va, scr, F.lane);
            if (!h1) break;
            const bool h2 = it + 2 * NGW < NITEMS; if (h2) { cur = small_item(F, it + 2 * NGW); tr_load(cur, va, F.lane); }
            tr_store(n1, vb, scr, F.lane);
            if (!h2) break; } }
    { const int gt = F.bid * NTHREADS + F.tid, NGT = F.G * NTHREADS; bf16_t* o = (bf16_t*)(F.ws + WS_RGW);
      for (int i = gt; i < 2 * 2 * 2 * 8 * 64 * 64; i += NGT) { const int c = i & 63, dp = (i >> 6) & 63, blk = (i >> 12) & 7, gate = (i >> 15) & 1, dir = (i >> 16) & 1, l = i >> 17;
          const float* src = gate ? F.pa->in[I_RGWX] : F.pa->in[I_RGWA]; o[i] = (bf16_t)f2bf(-1.4426950408889634f * src[((((size_t)l * 2 + dir) * 8 + blk) * 64 + c) * 64 + dp]); } }
    { const int gt = F.bid * NTHREADS + F.tid, NGT = F.G * NTHREADS; float* ct = (float*)(F.ws + WS_ROPE); float* st = ct + 4096 * 64;
      for (int i = gt; i < 4096 * 64; i += NGT) { const int pos = i >> 6, fi = i & 63; const float p = (float)((fi < 32) ? (pos >> 6) : (pos & 63));
          const float inv = powf(10000.0f, -(float)(fi & 31) / 32.0f); const float ang = p * inv;
          const double a = (double)ang; const double kq = __builtin_rint(a * 0.63661977236758134308); const double rr = a - kq * 1.57079632679489661923; const int q = ((int)kq) & 3;
          const double r2 = rr * rr;
          const double sn = rr * (1.0 + r2 * (-1.0 / 6 + r2 * (1.0 / 120 + r2 * (-1.0 / 5040 + r2 * (1.0 / 362880 + r2 * (-1.0 / 39916800))))));
          const double cs = 1.0 + r2 * (-0.5 + r2 * (1.0 / 24 + r2 * (-1.0 / 720 + r2 * (1.0 / 40320 + r2 * (-1.0 / 3628800 + r2 * (1.0 / 479001600))))));
          const double c_ = (q == 0) ? cs : (q == 1) ? -sn : (q == 2) ? -cs : sn; const double s_ = (q == 0) ? sn : (q == 1) ? cs : (q == 2) ? -sn : -cs;
          ct[i] = (float)c_; st[i] = (float)s_; } }
}
struct MoeTile { const float* W; bf16_t* WT; int ldw, k0, n0, ldt, up; };
__device__ __forceinline__ MoeTile moe_tile(Frame& F, int t) {
    constexpr int T_UP1 = (D / 128) * (DEXP / 256), T_DN = (DEXP / 128) * (D / 256), PER_E = 2 * T_UP1 + T_DN;
    const int e = t / PER_E; int r = t - e * PER_E;
    if (r < 2 * T_UP1) { const int which = r / T_UP1; r -= which * T_UP1; const int nb = DEXP / 256, kb = r / nb, nn = r % nb;
        return MoeTile{(which ? F.pa->in[I_MW3] : F.pa->in[I_MW1]) + (size_t)e * D * DEXP, (bf16_t*)(F.ws + WS_MOEUP) + (size_t)e * 2 * DEXP * D, DEXP, kb * 128, nn * 256, D, 1 + which}; }
    r -= 2 * T_UP1;
    { const int nb = D / 256, kb = r / nb, nn = r % nb; return MoeTile{F.pa->in[I_MW2] + (size_t)e * DEXP * D, (bf16_t*)F.out + (size_t)e * D * DEXP, D, kb * 128, nn * 256, DEXP, 0}; }
}
__device__ __forceinline__ void moe_tile_load(const MoeTile& t, f32x4 (&v)[16], int wave, int lane) {
#pragma unroll
    for (int i = 0; i < 16; ++i) v[i] = *(const f32x4*)(t.W + (size_t)(t.k0 + 16 * wave + i) * t.ldw + t.n0 + 4 * lane);
}
__device__ __forceinline__ void moe_tile_store(Frame& F, const MoeTile& t, const f32x4 (&v)[16]) {
    LAS float* tile = (LAS float*)F.lds;
#pragma unroll
    for (int i = 0; i < 16; ++i) { const int k = 16 * F.wave + i, p = (4 * F.lane + 2 * (k >> 3)) & 255;
        *(LAS f32x2*)(tile + k * 256 + p) = (f32x2){v[i].x, v[i].y}; *(LAS f32x2*)(tile + k * 256 + ((p + 2) & 255)) = (f32x2){v[i].z, v[i].w}; }
    __syncthreads();
#pragma unroll
    for (int j = 0; j < 8; ++j) { const int task = F.tid + j * NTHREADS, c = task & 15, n = task >> 4; const LAS float* sp = tile + (8 * c) * 256 + ((n + 2 * c) & 255);
        u32x4 o; o.x = pk2(sp[0], sp[256]); o.y = pk2(sp[512], sp[768]); o.z = pk2(sp[1024], sp[1280]); o.w = pk2(sp[1536], sp[1792]);
        const int col = t.n0 + n; const int drow = t.up ? (col >> 7) * 256 + (col & 127) + 128 * (t.up - 1) : col; const int kk = t.k0 + 8 * c;
        bf16_t* dp = t.up ? t.WT + (size_t)drow * t.ldt + kk : t.WT + ((size_t)((drow >> 8) * (t.ldt / 64) + (kk >> 6)) * 256 + (drow & 255)) * 64 + (kk & 63);
        *(u32x4*)dp = o; }
    __syncthreads();
}
__device__ __forceinline__ int moe_tile_of(int q) {
    constexpr int T_UP2 = 2 * (D / 128) * (DEXP / 256), T_DN = (DEXP / 128) * (D / 256), PER_E = T_UP2 + T_DN;
    if (q < NE * T_DN) { const int e = q / T_DN; return e * PER_E + T_UP2 + (q - e * T_DN); }
    q -= NE * T_DN; { const int e5 = q / T_UP2, e = (e5 + 5) & 7; return e * PER_E + (q - e5 * T_UP2); }
}
constexpr int FILL_EARLY = NE * (DEXP / 128) * (D / 256) + 3 * 2 * (D / 128) * (DEXP / 256);
static_assert(WS_MOEUP + (size_t)5 * 2 * DEXP * D * 2 >= WS_KV + (size_t)272 * 4 * 2 * 16384 * 2 && WS_MOEUP + (size_t)8 * 2 * DEXP * D * 2 <= WS_Y, "experts 5..7 of MOEUP sit in the gap between the state buffer and Y");
__device__ __forceinline__ int gemm_idle(int U, int G) { return (U % G) ? G - U % G : 0; }
constexpr int U_GIN = (MROWS / 256) * (INW / 256), U_GUP = (MROWS / 256) * (2 * DFF / 256);
__device__ __forceinline__ int fill_base(int G, int slot) {
    const int gin = 2 * gemm_idle(U_GIN, G), gup = 2 * gemm_idle(U_GUP, G);
    int b = 0; if (slot > 0) b += gin; if (slot > 1) b += gin; if (slot > 2) b += gup; if (slot > 3) b += 64; if (slot > 4) b += 64; if (slot > 5) b += 128; if (slot > 6) b += 2 * (G > 192 ? G - 192 : 0);
    return b < FILL_EARLY ? b : FILL_EARLY;
}
__device__ __forceinline__ void moe_fill(Frame& F, int q0, int n) {
    const int tot = fill_base(F.G, 7); if (q0 + n > tot) n = tot - q0; if (n <= 0) return;
    f32x4 va[16], vb[16];
    const MoeTile a = moe_tile(F, moe_tile_of(q0)); moe_tile_load(a, va, F.wave, F.lane);
    MoeTile b = a; if (n > 1) { b = moe_tile(F, moe_tile_of(q0 + 1)); moe_tile_load(b, vb, F.wave, F.lane); }
    moe_tile_store(F, a, va);
    MoeTile c = a; if (n > 2) { c = moe_tile(F, moe_tile_of(q0 + 2)); moe_tile_load(c, va, F.wave, F.lane); }
    if (n > 1) moe_tile_store(F, b, vb);
    if (n > 2) moe_tile_store(F, c, va);
}
__device__ __forceinline__ void moe_fill_gemm(Frame& F, int U, int slot, int per) { const int left = U % F.G; if (left == 0 || F.bid < left) return; moe_fill(F, fill_base(F.G, slot) + per * (F.bid - left), per); }
__device__ __forceinline__ void phase_convert_moe(Frame& F) {
    constexpr int NT = NE * (2 * (D / 128) * (DEXP / 256) + (DEXP / 128) * (D / 256));
    const int q0 = fill_base(F.G, 7) + F.bid;
    if (q0 < NT) { MoeTile cur = moe_tile(F, moe_tile_of(q0)); f32x4 va[16], vb[16]; moe_tile_load(cur, va, F.wave, F.lane);
        for (int t = q0; t < NT; t += 2 * F.G) {
            const bool h1 = t + F.G < NT; MoeTile n1 = cur; if (h1) { n1 = moe_tile(F, moe_tile_of(t + F.G)); moe_tile_load(n1, vb, F.wave, F.lane); }
            moe_tile_store(F, cur, va);
            if (!h1) break;
            const bool h2 = t + 2 * F.G < NT; if (h2) { cur = moe_tile(F, moe_tile_of(t + 2 * F.G)); moe_tile_load(cur, va, F.wave, F.lane); }
            moe_tile_store(F, n1, vb);
            if (!h2) break; } }
}
__device__ __forceinline__ void phase_mod(Frame& F) {
    LAS float* sc = (LAS float*)F.lds;
    LAS float* red = (LAS float*)(F.lds + 9 * 1024 * 4);
    for (int i = F.tid; i < 9 * 1024; i += NTHREADS) { const int r = i >> 10, k = i & 1023; const float v = (r < 8) ? F.pa->in[I_C][r * 1024 + k] : F.pa->in[I_CCTX][k]; sc[i] = v / (1.0f + __expf(-v)); }
    __syncthreads();
    for (int strip = F.bid; strip < 2 * 6144 / 64; strip += F.G) {
        const int l = strip / 96, j = (strip % 96) * 64 + F.lane;
        const float* w = F.pa->in[I_WMOD] + (size_t)l * 1024 * 6144 + j;
        float a[9];
#pragma unroll
        for (int r = 0; r < 9; ++r) a[r] = 0.f;
        const int k0 = F.wave * 128;
#pragma unroll 1
        for (int kk = k0; kk < k0 + 128; kk += 16) { float wv[16];
#pragma unroll
            for (int i = 0; i < 16; ++i) wv[i] = w[(size_t)(kk + i) * 6144];
#pragma unroll
            for (int i = 0; i < 16; ++i) {
#pragma unroll
                for (int r = 0; r < 9; ++r) a[r] += sc[r * 1024 + kk + i] * wv[i];
                if ((i & 3) == 3) __builtin_amdgcn_sched_barrier(0); } }
#pragma unroll
        for (int r = 0; r < 9; ++r) red[(F.wave * 9 + r) * 64 + F.lane] = a[r];
        __syncthreads();
        for (int i = F.tid; i < 9 * 64; i += NTHREADS) { const int r = i >> 6, jj = i & 63; float s = 0.f;
#pragma unroll
            for (int w8 = 0; w8 < 8; ++w8) s += red[(w8 * 9 + r) * 64 + jj];
            const int col = (strip % 96) * 64 + jj; s += F.pa->in[I_BMOD][l * 6144 + col];
            if (r < 8) ((float*)(F.ws + WS_MODLAT))[((size_t)l * 8 + r) * 6144 + col] = s; else ((float*)(F.ws + WS_MODCTX))[(size_t)l * 6144 + col] = s; }
        __syncthreads();
    }
}

__device__ __forceinline__ void norm_row(const u32x2 (&xw)[4], const f32x4 (&Am)[4], const f32x4 (&Sh)[4], bf16_t* orow, int lane, f32x4 (&y)[4]) {
    f32x4 v[4]; float ss = 0.f;
#pragma unroll
    for (int j = 0; j < 4; ++j) { const u32x2 w = xw[j]; v[j] = (f32x4){bf2f(w.x & 0xffffu), __uint_as_float(w.x & 0xffff0000u), bf2f(w.y & 0xffffu), __uint_as_float(w.y & 0xffff0000u)};
        ss += (v[j].x * v[j].x + v[j].y * v[j].y) + (v[j].z * v[j].z + v[j].w * v[j].w); }
    const float rstd = 1.0f / sqrtf(wave_sum(ss) * (1.0f / D) + EPS);
    u32x2* o8 = (u32x2*)orow + lane;
#pragma unroll
    for (int j = 0; j < 4; ++j) { y[j] = (v[j] * rstd) * Am[j] + Sh[j]; o8[64 * j] = (u32x2){pk2(y[j].x, y[j].y), pk2(y[j].z, y[j].w)}; }
}
struct SlabRed { const float* slab; int S; const float* gate; const float* xold; float* xnew; };
__device__ __forceinline__ void norm_row_v(f32x4 (&v)[4], const float* g, const float* shift, const float* scale, bf16_t* orow, int lane) {
    float ss = 0.f;
#pragma unroll
    for (int j = 0; j < 4; ++j) ss += (v[j].x * v[j].x + v[j].y * v[j].y) + (v[j].z * v[j].z + v[j].w * v[j].w);
    const float rstd = 1.0f / sqrtf(wave_sum(ss) * (1.0f / D) + EPS);
    u32x2* o8 = (u32x2*)orow + lane;
#pragma unroll
    for (int j = 0; j < 4; ++j) { const f32x4 gg = ((const f32x4*)g)[lane + 64 * j], sh = ((const f32x4*)shift)[lane + 64 * j], sl = ((const f32x4*)scale)[lane + 64 * j];
        const f32x4 y = (v[j] * rstd) * gg * (sl + 1.0f) + sh;
        u32x2 w; w.x = pk2(y.x, y.y); w.y = pk2(y.z, y.w); o8[64 * j] = w; }
}
__device__ __forceinline__ void phase_norm(Frame& F, int l, int sel, const float* xlat, const bf16_t* xb, const float* xctx, int nrows, const SlabRed sr) {
    const int gw = F.bid * NWAVES + F.wave, NGW = F.G * NWAVES;
    const float* g = (sel ? F.pa->in[I_GFFN] : F.pa->in[I_GMIX]) + l * D; const int so = sel ? 3072 : 0;
    bf16_t* HX = (bf16_t*)(F.ws + WS_HX);
    const int nlat = nrows < NLAT ? nrows : NLAT; const int per = (nlat + NGW - 1) / NGW, r_lo = gw * per, r_hi = (r_lo + per < nlat) ? r_lo + per : nlat;
    int curb = -1; f32x4 Am[4], Sh[4];
    for (int row0 = r_lo; row0 < r_hi; row0 += 4) {
        f32x4 v[4][4];
#pragma unroll
        for (int u = 0; u < 4; ++u) { const int row = (row0 + u < r_hi) ? row0 + u : row0;
            if (xb) { const u32x2* xr = (const u32x2*)(xb + (size_t)row * D) + F.lane;
#pragma unroll
                for (int j = 0; j < 4; ++j) { const u32x2 w = xr[64 * j]; v[u][j] = (f32x4){bf2f(w.x & 0xffffu), __uint_as_float(w.x & 0xffff0000u), bf2f(w.y & 0xffffu), __uint_as_float(w.y & 0xffff0000u)}; } }
            else { const f32x4* xr = (const f32x4*)(xlat + (size_t)row * D) + F.lane;
#pragma unroll
                for (int j = 0; j < 4; ++j) v[u][j] = xr[64 * j]; } }
#pragma unroll
        for (int u = 0; u < 4; ++u) { const int row = row0 + u; if (row >= r_hi) continue;
            const int b = row / SEQ;
            if (b != curb) { curb = b; const float* mod = (const float*)(F.ws + WS_MODLAT) + ((size_t)l * 8 + b) * 6144 + so;
#pragma unroll
                for (int j = 0; j < 4; ++j) { Am[j] = ((const f32x4*)g)[F.lane + 64 * j] * (((const f32x4*)(mod + 1024))[F.lane + 64 * j] + 1.0f); Sh[j] = ((const f32x4*)mod)[F.lane + 64 * j]; } }
            float ss = 0.f;
#pragma unroll
            for (int j = 0; j < 4; ++j) ss += (v[u][j].x * v[u][j].x + v[u][j].y * v[u][j].y) + (v[u][j].z * v[u][j].z + v[u][j].w * v[u][j].w);
            const float rstd = 1.0f / sqrtf(wave_sum(ss) * (1.0f / D) + EPS);
            u32x2* o8 = (u32x2*)(HX + (size_t)row * D) + F.lane;
#pragma unroll
            for (int j = 0; j < 4; ++j) { const f32x4 y = (v[u][j] * rstd) * Am[j] + Sh[j]; o8[64 * j] = (u32x2){pk2(y.x, y.y), pk2(y.z, y.w)}; } }
    }
    for (int row = NLAT + gw; row < nrows; row += NGW) {
        const float* mod = (const float*)(F.ws + WS_MODCTX) + (size_t)l * 6144;
        f32x4 v[4];
        if (sr.slab == nullptr) { const f32x4* xr = (const f32x4*)(xctx + (size_t)(row - NLAT) * D) + F.lane;
#pragma unroll
            for (int j = 0; j < 4; ++j) v[j] = xr[64 * j]; }
        else { const int rc = row - NLAT, pmr = rc >> 8, r = rc & 255;
            f32x4 t8[4][8], xo[4];
#pragma unroll
            for (int j = 0; j < 4; ++j) { const float* sp = sr.slab + (size_t)((pmr + 8 * j) * sr.S) * 65536 + (size_t)r * 256 + 4 * F.lane;
#pragma unroll
                for (int q = 0; q < 8; ++q) t8[j][q] = *(const f32x4*)(sp + (size_t)(q < sr.S ? q : sr.S - 1) * 65536);
                xo[j] = ((const f32x4*)(sr.xold + (size_t)rc * D))[F.lane + 64 * j]; }
#pragma unroll
            for (int j = 0; j < 4; ++j) { f32x4 a = zero4();
#pragma unroll
                for (int q = 0; q < 8; ++q) a += t8[j][q] * (q < sr.S ? 1.0f : 0.0f);
                v[j] = xo[j] + ((const f32x4*)sr.gate)[F.lane + 64 * j] * a;
                ((f32x4*)(sr.xnew + (size_t)rc * D))[F.lane + 64 * j] = v[j]; } }
        norm_row_v(v, g, mod + so, mod + so + 1024, HX + (size_t)row * D, F.lane);
    }
}
__device__ __forceinline__ void moe_reduce(Frame& F, int k) {
    const int* meta = (const int*)(F.ws + MOE_META) + 9 * k; const int npan = meta[8], gsz = npan - 128;
    if (gsz <= 0) return;
    const int S = pg8::split_factor(npan * 4, F.G, DEXP / 64, MAXSLAB_M); if (S < 2) return;
    const int gw = F.bid * NWAVES + F.wave, NGW = F.G * NWAVES;
    const int* ptok = (const int*)(F.ws + MOE_PTOK) + k * MROWS; const float* pw = (const float*)(F.ws + MOE_PW) + k * MROWS;
    const float* slab = (const float*)(F.ws + WS_SLABM); const float* gate_lat = (const float*)(F.ws + WS_MODLAT) + (size_t)8 * 6144 + 5120;
    for (int rr = NLAT + gw; rr < npan * 256; rr += NGW) { const int tok = ptok[rr]; if (tok < 0) continue; const float w = pw[rr];
        const int pmr = (rr - NLAT) >> 8, r = rr & 255; u32x2* xr = (u32x2*)((bf16_t*)((char*)F.out + XB_OFF) + (size_t)tok * D); const f32x4* gt = (const f32x4*)(gate_lat + (size_t)(tok / SEQ) * 6144);
        f32x4 t8[4][8];
#pragma unroll
        for (int j = 0; j < 4; ++j) { const float* sp = slab + (size_t)((pmr + gsz * j) * S) * 65536 + (size_t)r * 256 + 4 * F.lane;
#pragma unroll
            for (int q = 0; q < 8; ++q) t8[j][q] = *(const f32x4*)(sp + (size_t)(q < S ? q : S - 1) * 65536); }
#pragma unroll
        for (int j = 0; j < 4; ++j) { f32x4 a = zero4();
#pragma unroll
            for (int q = 0; q < 8; ++q) a += t8[j][q] * (q < S ? 1.0f : 0.0f);
            const u32x2 xo = xr[F.lane + 64 * j]; const f32x4 xv = {bf2f(xo.x & 0xffffu), __uint_as_float(xo.x & 0xffff0000u), bf2f(xo.y & 0xffffu), __uint_as_float(xo.y & 0xffff0000u)};
            const f32x4 y = xv + (gt[F.lane + 64 * j] * w) * a; xr[F.lane + 64 * j] = (u32x2){pk2(y.x, y.y), pk2(y.z, y.w)}; } }
}
__device__ __forceinline__ void phase_norm_router(Frame& F, const bf16_t* xb) {
    constexpr int l = 1;
    LAS f32x4* wr0 = (LAS f32x4*)F.lds; LAS f32x4* wr1 = wr0 + 1024;
    LAS int* le = (LAS int*)(F.lds + 32768);
    for (int k = F.tid; k < 1024; k += NTHREADS) { const int slot = ((k >> 8) * 4 + (k & 3)) * 64 + ((k & 255) >> 2);
        wr0[slot] = ((const f32x4*)F.pa->in[I_MROUTER])[2 * k]; wr1[slot] = ((const f32x4*)F.pa->in[I_MROUTER])[2 * k + 1]; }
    __syncthreads();
    const float* g = F.pa->in[I_GFFN] + l * D; bf16_t* HX = (bf16_t*)(F.ws + WS_HX);
    int* toke = (int*)(F.ws + MOE_TOKE); float* tokw = (float*)(F.ws + MOE_TOKW);
    for (int wg = F.bid; wg < NLAT / 128; wg += F.G) {
        u32x2 nx[4][4]; f32x4 Am[4], Sh[4];
        { const float* mod = (const float*)(F.ws + WS_MODLAT) + ((size_t)l * 8 + (wg * 128) / SEQ) * 6144 + 3072;
#pragma unroll
          for (int j = 0; j < 4; ++j) { Am[j] = ((const f32x4*)g)[F.lane + 64 * j] * (((const f32x4*)(mod + 1024))[F.lane + 64 * j] + 1.0f); Sh[j] = ((const f32x4*)mod)[F.lane + 64 * j]; } }
#pragma unroll
        for (int u = 0; u < 4; ++u) { const u32x2* xr = (const u32x2*)(xb + (size_t)(wg * 128 + F.wave * 16 + u) * D) + F.lane;
#pragma unroll
          for (int j = 0; j < 4; ++j) nx[u][j] = xr[64 * j]; }
        for (int i0 = 0; i0 < 16; i0 += 4) {
          u32x2 cb[4][4];
#pragma unroll
          for (int u = 0; u < 4; ++u)
#pragma unroll
              for (int j = 0; j < 4; ++j) cb[u][j] = nx[u][j];
          { const int rb = wg * 128 + F.wave * 16 + ((i0 < 12) ? i0 + 4 : i0);
#pragma unroll
            for (int u = 0; u < 4; ++u) { const u32x2* xr = (const u32x2*)(xb + (size_t)(rb + u) * D) + F.lane;
#pragma unroll
                for (int j = 0; j < 4; ++j) nx[u][j] = xr[64 * j]; } }
#pragma unroll
          for (int u = 0; u < 4; ++u) { const int i = i0 + u, tl = F.wave * 16 + i, row = wg * 128 + tl;
            f32x4 y[4]; norm_row(cb[u], Am, Sh, HX + (size_t)row * D, F.lane, y);
            float lg[8];
#pragma unroll
            for (int e = 0; e < 8; ++e) lg[e] = 0.f;
#pragma unroll
            for (int j = 0; j < 4; ++j)
#pragma unroll
                for (int q = 0; q < 4; ++q) { const f32x4 w0 = wr0[(j * 4 + q) * 64 + F.lane], w1 = wr1[(j * 4 + q) * 64 + F.lane]; const float yv = y[j][q];
                    lg[0] += yv * w0.x; lg[1] += yv * w0.y; lg[2] += yv * w0.z; lg[3] += yv * w0.w; lg[4] += yv * w1.x; lg[5] += yv * w1.y; lg[6] += yv * w1.z; lg[7] += yv * w1.w; }
            { const bool b0 = F.lane & 1, b1 = F.lane & 2, b2 = F.lane & 4; float a4[4], a2[2];
#pragma unroll
              for (int i = 0; i < 4; ++i) { const float mine = b0 ? lg[4 + i] : lg[i], give = b0 ? lg[i] : lg[4 + i]; a4[i] = mine + swz_xor<1>(give); }
#pragma unroll
              for (int i = 0; i < 2; ++i) { const float mine = b1 ? a4[2 + i] : a4[i], give = b1 ? a4[i] : a4[2 + i]; a2[i] = mine + swz_xor<2>(give); }
              float a1 = (b2 ? a2[1] : a2[0]) + swz_xor<4>(b2 ? a2[0] : a2[1]);
              a1 += swz_xor<8>(a1); a1 += swz_xor<16>(a1);
              { const auto r2 = __builtin_amdgcn_permlane32_swap(__float_as_uint(a1), __float_as_uint(a1), false, false); a1 = __uint_as_float(r2[0]) + __uint_as_float(r2[1]); }
#pragma unroll
              for (int e = 0; e < 8; ++e) lg[e] = __int_as_float(__builtin_amdgcn_readlane(__float_as_int(a1), ((e >> 2) & 1) | (e & 2) | ((e & 1) << 2))) + F.pa->in[I_MROUTERB][e]; }
            int e0 = 0; float v0 = lg[0];
#pragma unroll
            for (int e = 1; e < 8; ++e) if (lg[e] > v0) { v0 = lg[e]; e0 = e; }
            int e1 = -1; float v1 = -3.0e38f;
#pragma unroll
            for (int e = 0; e < 8; ++e) if (e != e0 && lg[e] > v1) { v1 = lg[e]; e1 = e; }
            const float w0 = 1.0f / (1.0f + __expf(v1 - v0));
            if (F.lane == 0) { toke[row] = e0 | (e1 << 8); tokw[2 * row] = w0; tokw[2 * row + 1] = 1.0f - w0; le[tl] = e0 | (e1 << 8); }
          } }
        __syncthreads();
        if (F.tid < 16) { const int k = F.tid >> 3, e = F.tid & 7; int c = 0; for (int t = 0; t < 128; ++t) c += (((le[t] >> (8 * k)) & 0xff) == e) ? 1 : 0; ((int*)(F.ws + MOE_CNT))[wg * 16 + F.tid] = c; }
        __syncthreads();
    }
}
__device__ __forceinline__ void phase_moe_sort(Frame& F) {
    LAS int* tot = (LAS int*)F.lds;
    LAS int* pre = tot + 16;
    LAS int* seg = tot + 32;
    LAS int* le = tot + 64;
    const int* cnt = (const int*)(F.ws + MOE_CNT); const int* toke = (const int*)(F.ws + MOE_TOKE); const float* tokw = (const float*)(F.ws + MOE_TOKW);
    int* ptok = (int*)(F.ws + MOE_PTOK); float* pw = (float*)(F.ws + MOE_PW); int* meta = (int*)(F.ws + MOE_META);
    for (int wg = F.bid; wg < NLAT / 128; wg += F.G) {
        { LAS int* part = tot + 256;
          if (F.tid < 256) { const int col = F.tid & 15, pt = F.tid >> 4; int t = 0, p = 0;
#pragma unroll
              for (int i = 0; i < 16; ++i) { const int w = pt * 16 + i; const int c = cnt[w * 16 + col]; t += c; p += (w < wg) ? c : 0; }
              part[pt * 16 + col] = t; part[256 + pt * 16 + col] = p; }
          if (F.tid >= 256 && F.tid < 384) le[F.tid - 256] = toke[wg * 128 + F.tid - 256];
          __syncthreads();
          if (F.tid < 16) { int t = 0, p = 0;
#pragma unroll
              for (int pt = 0; pt < 16; ++pt) { t += part[pt * 16 + F.tid]; p += part[256 + pt * 16 + F.tid]; }
              tot[F.tid] = t; pre[F.tid] = p; } }
        __syncthreads();
        if (F.tid < 2) { int s = 0; for (int e = 0; e < 8; ++e) { seg[F.tid * 9 + e] = s; s += (tot[F.tid * 8 + e] + 255) & ~255; } seg[F.tid * 9 + 8] = s; }
        __syncthreads();
        if (F.tid < 256) { const int k = F.tid >> 7, t = F.tid & 127; const int e = (le[t] >> (8 * k)) & 0xff; int rank = 0; for (int u = 0; u < t; ++u) rank += (((le[u] >> (8 * k)) & 0xff) == e) ? 1 : 0;
            const int pos = seg[k * 9 + e] + pre[k * 8 + e] + rank; const int tok = wg * 128 + t; ptok[k * MROWS + pos] = tok; pw[k * MROWS + pos] = tokw[2 * tok + k]; ((int*)(F.ws + MOE_PPOS))[k * NLAT + tok] = pos; }
        if (wg < 16) { const int k = wg >> 3, e = wg & 7; const int a = seg[k * 9 + e] + tot[k * 8 + e], b = seg[k * 9 + e + 1]; for (int p = a + F.tid; p < b; p += NTHREADS) { ptok[k * MROWS + p] = -1; pw[k * MROWS + p] = 0.f; } }
        if (wg == 0 && F.tid < 18) meta[F.tid] = seg[F.tid] >> 8;
        __syncthreads();
    }
}
__device__ __forceinline__ void phase_final(Frame& F) {
    const int gw = F.bid * NWAVES + F.wave, NGW = F.G * NWAVES; const float* g = F.pa->in[I_GFINAL];
    const bf16_t* xf = (const bf16_t*)(F.ws + WS_XF);
    const int* meta = (const int*)(F.ws + MOE_META) + 9; const int npan = meta[8], gsz = npan - 128;
    const int S = (gsz > 0) ? pg8::split_factor(npan * 4, F.G, DEXP / 64, MAXSLAB_M) : 1;
    const int* ppos = (const int*)(F.ws + MOE_PPOS) + NLAT; const float* pw = (const float*)(F.ws + MOE_PW) + MROWS;
    const float* slab = (const float*)(F.ws + WS_SLABM); const float* gate_lat = (const float*)(F.ws + WS_MODLAT) + (size_t)8 * 6144 + 5120;
    for (int row0 = gw; row0 < NLAT; row0 += 4 * NGW) {
        u32x2 w[4][4]; int rr[4];
#pragma unroll
        for (int u = 0; u < 4; ++u) { const int row = (row0 + u * NGW < NLAT) ? row0 + u * NGW : row0; const u32x2* xr = (const u32x2*)(xf + (size_t)row * D) + F.lane; rr[u] = ppos[row];
#pragma unroll
            for (int j = 0; j < 4; ++j) w[u][j] = xr[64 * j]; }
#pragma unroll
        for (int u = 0; u < 4; ++u) { const int row = row0 + u * NGW; if (row >= NLAT) continue;
            f32x4 v[4];
#pragma unroll
            for (int j = 0; j < 4; ++j) v[j] = (f32x4){bf2f(w[u][j].x & 0xffffu), __uint_as_float(w[u][j].x & 0xffff0000u), bf2f(w[u][j].y & 0xffffu), __uint_as_float(w[u][j].y & 0xffff0000u)};
            if (S >= 2 && rr[u] >= NLAT) { const float wt = pw[rr[u]]; const int pmr = (rr[u] - NLAT) >> 8, r = rr[u] & 255; const f32x4* gt = (const f32x4*)(gate_lat + (size_t)(row / SEQ) * 6144);
#pragma unroll
                for (int j = 0; j < 4; ++j) { f32x4 a = zero4(); const float* sp = slab + (size_t)((pmr + gsz * j) * S) * 65536 + (size_t)r * 256 + 4 * F.lane;
                    { f32x4 t8[8];
#pragma unroll
                      for (int q = 0; q < 8; ++q) t8[q] = *(const f32x4*)(sp + (size_t)(q < S ? q : S - 1) * 65536);
#pragma unroll
                      for (int q = 0; q < 8; ++q) a += t8[q] * (q < S ? 1.0f : 0.0f); }
                    v[j] += (gt[F.lane + 64 * j] * wt) * a; } }
            float ss = 0.f;
#pragma unroll
            for (int j = 0; j < 4; ++j) ss += (v[j].x * v[j].x + v[j].y * v[j].y) + (v[j].z * v[j].z + v[j].w * v[j].w);
            const float rstd = 1.0f / sqrtf(wave_sum(ss) * (1.0f / D) + EPS); f32x4* o = (f32x4*)(F.out + (size_t)row * D) + F.lane;
#pragma unroll
            for (int j = 0; j < 4; ++j) o[64 * j] = (v[j] * rstd) * ((const f32x4*)g)[F.lane + 64 * j]; }
    }
}

__device__ __forceinline__ bool fresh(Frame& F) {
    int l_ = (int)__builtin_amdgcn_mbcnt_hi(~0u, __builtin_amdgcn_mbcnt_lo(~0u, 0u)); asm volatile("" : "+v"(l_));
    int w_ = F.wave0; asm volatile("" : "+s"(w_));
    F.lane = l_; F.wave = w_; F.tid = w_ * 64 + l_;
    int b_ = blockIdx.x; asm volatile("" : "+s"(b_)); F.bid = b_;
    GAS unsigned char* w2_ = (GAS unsigned char*)F.ws0; asm volatile("" : "+s"(w2_)); F.ws = (unsigned char*)w2_;
    F.out = F.out0; F.pa = F.pa0;
    return true;
}
__device__ __forceinline__ size_t ptile(int chunk, int ct) { return ((size_t)chunk * (INW / 128) + ct) * 16384; }
struct Item { int b, s, row0, seqbase, t0, seqlen; bool is_ctx; };
__device__ __forceinline__ Item item_info(int item) {
    Item it; it.b = item / SPB; it.s = item % SPB;
    if (it.s < 2) { it.is_ctx = true; it.seqbase = NLAT + it.b * CTXL; it.t0 = it.s * CHK; it.seqlen = CTXL; }
    else { it.is_ctx = false; it.seqbase = it.b * SEQ; it.t0 = (it.s - 2) * CHK; it.seqlen = SEQ; }
    it.row0 = it.seqbase + it.t0; return it;
}
constexpr int UCP = 144;
constexpr int TP = 272;
constexpr int TILEB = 128 * TP;
constexpr int VP = 288;
constexpr int TILEV = 128 * VP;

__device__ __forceinline__ unsigned tr_lane_addr(ldsp_t tile, int lane) { return (unsigned)(__SIZE_TYPE__)tile + (unsigned)((4 * (lane >> 4) + ((lane & 15) >> 2)) * VP + 8 * (lane & 3)); }
__device__ __forceinline__ bf16x8 mk_frag(u32x2 lo, u32x2 hi) { const u32x4 v = {lo.x, lo.y, hi.x, hi.y}; return __builtin_bit_cast(bf16x8, v); }
template <int OFF> __device__ __forceinline__ bf16x8 tr1(unsigned addr) {
    u32x2 a0, a1;
    asm volatile("ds_read_b64_tr_b16 %0, %2 offset:%3\n\tds_read_b64_tr_b16 %1, %2 offset:%4\n\ts_waitcnt lgkmcnt(0)" : "=&v"(a0), "=&v"(a1) : "v"(addr), "i"(OFF), "i"(OFF + 16 * VP) : "memory");
    return mk_frag(a0, a1);
}
template <int OFF> __device__ __forceinline__ void tr4(unsigned addr, bf16x8& f0, bf16x8& f1, bf16x8& f2, bf16x8& f3) {
    u32x2 a0, a1, b0, b1, c0, c1, d0, d1;
    asm volatile("ds_read_b64_tr_b16 %0, %8 offset:%9\n\tds_read_b64_tr_b16 %1, %8 offset:%10\n\tds_read_b64_tr_b16 %2, %8 offset:%11\n\tds_read_b64_tr_b16 %3, %8 offset:%12\n\t"
                 "ds_read_b64_tr_b16 %4, %8 offset:%13\n\tds_read_b64_tr_b16 %5, %8 offset:%14\n\tds_read_b64_tr_b16 %6, %8 offset:%15\n\tds_read_b64_tr_b16 %7, %8 offset:%16\n\ts_waitcnt lgkmcnt(0)"
                 : "=&v"(a0), "=&v"(a1), "=&v"(b0), "=&v"(b1), "=&v"(c0), "=&v"(c1), "=&v"(d0), "=&v"(d1)
                 : "v"(addr), "i"(OFF), "i"(OFF + 16 * VP), "i"(OFF + 32), "i"(OFF + 32 + 16 * VP), "i"(OFF + 64), "i"(OFF + 64 + 16 * VP), "i"(OFF + 96), "i"(OFF + 96 + 16 * VP) : "memory");
    f0 = mk_frag(a0, a1); f1 = mk_frag(b0, b1); f2 = mk_frag(c0, c1); f3 = mk_frag(d0, d1);
}

__device__ __forceinline__ void build_decay(Frame& F, int l) {
    LAS float* dec = (LAS float*)(F.lds + LDS_DEC);
    for (int i = F.tid; i < 2 * 4 * 132; i += NTHREADS) { const int n = i % 132, dh = i / 132; const float x = F.pa->in[I_RETDEC][l * 8 + dh]; const float lg = -log1pf(expf(-x)); dec[i] = expf((float)n * lg); }
}

struct RgStep { bf16x8 bwa[2], bwx[2]; float lam, ba, bx, carry; };
template <bool FINAL>
__device__ __forceinline__ void rg_load_step(RgStep& R, Frame& F, const bf16_t* wgt, int l, int dir, int item, int blk, int n, int lane) {
    const int fr = lane & 15, fq = lane >> 4;
    const bf16_t* wa = wgt + ((size_t)(0 * 8 + blk) * 64 + 16 * n + fr) * 64 + 8 * fq;
    const bf16_t* wx = wgt + ((size_t)(1 * 8 + blk) * 64 + 16 * n + fr) * 64 + 8 * fq;
    R.bwa[0] = *(const bf16x8*)wa; R.bwa[1] = *(const bf16x8*)(wa + 32); R.bwx[0] = *(const bf16x8*)wx; R.bwx[1] = *(const bf16x8*)(wx + 32);
    const int ch = blk * 64 + 16 * n + fr, pi = (l * 2 + dir) * 512 + ch;
    R.lam = F.pa->in[I_RGLAM][pi]; R.ba = F.pa->in[I_RGBA][pi]; R.bx = F.pa->in[I_RGBX][pi];
    R.carry = FINAL ? ((const float*)(F.ws + WS_CARRY))[((size_t)item * 2 + dir) * 512 + ch] : 0.f;
}
template <bool FINAL, int DIR>
__device__ __forceinline__ void rg_dir(ldsp_t ucw, const bf16x8 (&af)[8][2], const RgStep& R, int n, int lane, f32x4 (&hsum)[8], float& Atot, float& Htot) {
    const int fr = lane & 15, fq = lane >> 4;
    constexpr float L2E_ = 1.4426950408889634f;
    const float ba2 = -L2E_ * R.ba, bx2 = -L2E_ * R.bx, cl2 = -8.0f * L2E_ * log1pf(expf(-R.lam)), carry = R.carry;
    const bf16x8 bwa[2] = {R.bwa[0], R.bwa[1]}, bwx[2] = {R.bwx[0], R.bwx[1]};
    f32x4 ar[8], ai[8];
#pragma unroll
    for (int m = 0; m < 8; ++m) { ar[m] = (f32x4){ba2, ba2, ba2, ba2}; ai[m] = (f32x4){bx2, bx2, bx2, bx2}; }
#pragma unroll
    for (int m = 0; m < 8; ++m)
#pragma unroll
        for (int ks = 0; ks < 2; ++ks) { ar[m] = __builtin_amdgcn_mfma_f32_16x16x32_bf16(af[m][ks], bwa[ks], ar[m], 0, 0, 0); ai[m] = __builtin_amdgcn_mfma_f32_16x16x32_bf16(af[m][ks], bwx[ks], ai[m], 0, 0, 0); }
    const unsigned uo = (unsigned)(32 * fq * UCP + (16 * n + fr) * 2);
#pragma unroll
    for (int m = 0; m < 8; ++m)
#pragma unroll
        for (int jj = 0; jj < 4; ++jj) {
            const float r = __builtin_amdgcn_rcpf(1.0f + __builtin_amdgcn_exp2f(ar[m][jj]));
            const float di = 1.0f + __builtin_amdgcn_exp2f(ai[m][jj]);
            const float a = __builtin_amdgcn_exp2f(cl2 * r);
            const float u = bf2f(*(const LAS bf16_t*)(ucw + uo + (4 * m + jj) * UCP));
            const float w = __builtin_fmaf(-a, a, 1.0f);
            ar[m][jj] = a; ai[m][jj] = (w * __builtin_amdgcn_rsqf((__builtin_fmaxf(w, 1.0e-30f) * di) * di)) * u; }
    float gA = 1.f, gH = 0.f;
#pragma unroll
    for (int mm = 0; mm < 8; ++mm) { const int m = DIR ? 7 - mm : mm;
#pragma unroll
        for (int j4 = 0; j4 < 4; ++j4) { const int jj = DIR ? 3 - j4 : j4; gH = __builtin_fmaf(ar[m][jj], gH, ai[m][jj]); gA *= ar[m][jj]; } }
    const float A0 = lane_bcast(gA, fr), H0 = lane_bcast(gH, fr), A1 = lane_bcast(gA, fr + 16), H1 = lane_bcast(gH, fr + 16), A2 = lane_bcast(gA, fr + 32), H2 = lane_bcast(gH, fr + 32), A3 = lane_bcast(gA, fr + 48), H3 = lane_bcast(gH, fr + 48);
    if (FINAL) { float h = carry;
        if (!DIR) { if (fq > 0) h = A0 * h + H0; if (fq > 1) h = A1 * h + H1; if (fq > 2) h = A2 * h + H2; }
        else { if (fq < 3) h = A3 * h + H3; if (fq < 2) h = A2 * h + H2; if (fq < 1) h = A1 * h + H1; }
#pragma unroll
        for (int mm = 0; mm < 8; ++mm) { const int m = DIR ? 7 - mm : mm;
#pragma unroll
            for (int j4 = 0; j4 < 4; ++j4) { const int jj = DIR ? 3 - j4 : j4; h = __builtin_fmaf(ar[m][jj], h, ai[m][jj]); hsum[m][jj] += h; } } }
    if (!DIR) Htot = A3 * (A2 * (A1 * H0 + H1) + H2) + H3; else Htot = A0 * (A1 * (A2 * H3 + H2) + H1) + H0;
    Atot = (A0 * A1) * (A2 * A3);
}
template <bool FINAL, bool SHARED = false>
__device__ __forceinline__ void rg_part(Frame& F, int l, int item, const Item& it, const int blk, const int n0, const int n1) {
    const bf16_t* P = (const bf16_t*)(F.ws + WS_PA);
    int lane = F.lane; const bool act = !SHARED || F.wave < 4;
    ldsp_t ucw = SHARED ? F.lds : F.lds + F.wave * (128 * UCP);
    if (act) { constexpr int NT = SHARED ? 4 : 16;
      const int grp = lane & 7, ch0 = blk * 64 + grp * 8, tok0 = (SHARED ? 32 * F.wave : 0) + (lane >> 3) * NT; float cw[4][8], cb[8];
#pragma unroll
      for (int k = 0; k < 4; ++k)
#pragma unroll
          for (int i = 0; i < 8; ++i) cw[k][i] = F.pa->in[I_CONVW][((size_t)l * 4 + k) * 512 + ch0 + i];
#pragma unroll
      for (int i = 0; i < 8; ++i) cb[i] = F.pa->in[I_CONVB][l * 512 + ch0 + i];
      const bf16_t* Pu = P + ptile(it.seqbase >> 7, blk >> 1) + (blk & 1) * 64 + grp * 8;
      u32x4 rv[NT + 3];
#pragma unroll
      for (int r = 0; r < NT + 3; ++r) { const int tt = it.t0 + tok0 + r - 2; const int tc = tt < 0 ? 0 : (tt >= it.seqlen ? it.seqlen - 1 : tt);
          rv[r] = ldg<u32x4>(Pu, ((unsigned)(tc >> 7) * (unsigned)((INW / 128) * 16384) + (unsigned)(tc & 127) * 128u) * 2u); if (tt != tc) rv[r] = (u32x4){0u, 0u, 0u, 0u}; }
      float win[4][8];
#pragma unroll
      for (int r = 0; r < 3; ++r) { win[r][0] = bf2f(rv[r].x & 0xffffu); win[r][1] = __uint_as_float(rv[r].x & 0xffff0000u); win[r][2] = bf2f(rv[r].y & 0xffffu); win[r][3] = __uint_as_float(rv[r].y & 0xffff0000u);
          win[r][4] = bf2f(rv[r].z & 0xffffu); win[r][5] = __uint_as_float(rv[r].z & 0xffff0000u); win[r][6] = bf2f(rv[r].w & 0xffffu); win[r][7] = __uint_as_float(rv[r].w & 0xffff0000u); }
#pragma unroll
      for (int j = 0; j < NT; ++j) { const int r = j + 3, s3 = (j + 3) & 3;
          win[s3][0] = bf2f(rv[r].x & 0xffffu); win[s3][1] = __uint_as_float(rv[r].x & 0xffff0000u); win[s3][2] = bf2f(rv[r].y & 0xffffu); win[s3][3] = __uint_as_float(rv[r].y & 0xffff0000u);
          win[s3][4] = bf2f(rv[r].z & 0xffffu); win[s3][5] = __uint_as_float(rv[r].z & 0xffff0000u); win[s3][6] = bf2f(rv[r].w & 0xffffu); win[s3][7] = __uint_as_float(rv[r].w & 0xffff0000u);
          float o[8];
#pragma unroll
          for (int i = 0; i < 8; ++i) o[i] = cb[i] + cw[0][i] * win[j & 3][i] + cw[1][i] * win[(j + 1) & 3][i] + cw[2][i] * win[(j + 2) & 3][i] + cw[3][i] * win[s3][i];
          u32x4 w; w.x = pk2(o[0], o[1]); w.y = pk2(o[2], o[3]); w.z = pk2(o[4], o[5]); w.w = pk2(o[6], o[7]);
          *(LAS u32x4*)(ucw + (tok0 + j) * UCP + grp * 16) = w; }
      LDS_WAIT(); asm volatile("" ::: "memory"); }
    if (SHARED) __syncthreads();
    asm volatile("" : "+v"(lane));
    bf16x8 af[8][2];
    if (act) { const int fr = lane & 15, fq = lane >> 4;
#pragma unroll
      for (int m = 0; m < 8; ++m)
#pragma unroll
          for (int ks = 0; ks < 2; ++ks) af[m][ks] = *(const LAS bf16x8*)(ucw + (32 * (fr >> 2) + 4 * m + (fr & 3)) * UCP + (8 * fq + 32 * ks) * 2); }
    if (SHARED) { __syncthreads(); if (!act) return; }
    const bf16_t* wg0 = (const bf16_t*)(F.ws + WS_RGW) + (size_t)(l * 2 + 0) * 2 * 8 * 4096;
    const bf16_t* wg1 = (const bf16_t*)(F.ws + WS_RGW) + (size_t)(l * 2 + 1) * 2 * 8 * 4096;
    float* TOT = (float*)(F.ws + WS_TOT);
    RgStep R0, R1;
    rg_load_step<FINAL>(R0, F, wg0, l, 0, item, blk, n0, lane);
#pragma unroll 1
    for (int n = n0; n < n1; ++n) { asm volatile("" : "+v"(lane));
        const int fr = lane & 15, fq = lane >> 4; const int ch = blk * 64 + 16 * n + fr;
        f32x4 hsum[8];
#pragma unroll
        for (int m = 0; m < 8; ++m) hsum[m] = zero4();
        rg_load_step<FINAL>(R1, F, wg1, l, 1, item, blk, n, lane);
        { float At, Ht;
          rg_dir<FINAL, 0>(ucw, af, R0, n, lane, hsum, At, Ht);
          if (!FINAL && fq == 0) { *(f32x2*)(TOT + (((size_t)item * 2 + 0) * 512 + ch) * 2) = (f32x2){At, Ht}; } }
        __builtin_amdgcn_sched_barrier(0);
        if (n + 1 < n1) rg_load_step<FINAL>(R0, F, wg0, l, 0, item, blk, n + 1, lane);
        { float At, Ht;
          rg_dir<FINAL, 1>(ucw, af, R1, n, lane, hsum, At, Ht);
          if (!FINAL && fq == 0) { *(f32x2*)(TOT + (((size_t)item * 2 + 1) * 512 + ch) * 2) = (f32x2){At, Ht}; } }
        if (FINAL) {
            const unsigned uo = (unsigned)(32 * fq * UCP + (16 * n + fr) * 2);
#pragma unroll
            for (int m = 0; m < 8; ++m)
#pragma unroll
                for (int jj = 0; jj < 4; ++jj) *(LAS bf16_t*)(ucw + uo + (4 * m + jj) * UCP) = (bf16_t)f2bf(hsum[m][jj]); }
    }
    if (FINAL) {
        LDS_WAIT(); asm volatile("" : "+v"(lane) :: "memory");
        const int ng = 2 * (n1 - n0);
        const int grp = 2 * n0 + ((ng == 8) ? (lane & 7) : (lane & 1)); const int tk0 = (ng == 8) ? (lane >> 3) : (lane >> 1), tstep = (ng == 8) ? 8 : 32, nq = (ng == 8) ? 16 : 4;
        const bf16_t* Pg = P + ptile(it.row0 >> 7, 4 + (blk >> 1)) + (blk & 1) * 64 + grp * 8; bf16_t* Yo = (bf16_t*)(F.ws + WS_Y) + (size_t)it.row0 * D + blk * 64 + grp * 8;
#pragma unroll 8
        for (int q = 0; q < nq; ++q) { const int token = tk0 + tstep * q;
            const u32x4 hv = *(const LAS u32x4*)(ucw + token * UCP + grp * 16); const u32x4 gv = ldg<u32x4>(Pg, (unsigned)token * 256u);
            u32x4 w;
            w.x = pk2(gelu_tanh(bf2f(gv.x & 0xffffu)) * bf2f(hv.x & 0xffffu), gelu_tanh(__uint_as_float(gv.x & 0xffff0000u)) * __uint_as_float(hv.x & 0xffff0000u));
            w.y = pk2(gelu_tanh(bf2f(gv.y & 0xffffu)) * bf2f(hv.y & 0xffffu), gelu_tanh(__uint_as_float(gv.y & 0xffff0000u)) * __uint_as_float(hv.y & 0xffff0000u));
            w.z = pk2(gelu_tanh(bf2f(gv.z & 0xffffu)) * bf2f(hv.z & 0xffffu), gelu_tanh(__uint_as_float(gv.z & 0xffff0000u)) * __uint_as_float(hv.z & 0xffff0000u));
            w.w = pk2(gelu_tanh(bf2f(gv.w & 0xffffu)) * bf2f(hv.w & 0xffffu), gelu_tanh(__uint_as_float(gv.w & 0xffff0000u)) * __uint_as_float(hv.w & 0xffff0000u));
            stg<u32x4>(Yo, (unsigned)token * (unsigned)(D * 2), w); }
        LDS_WAIT();
    }
}

struct KvRegs { u32x4 klo[2], khi[2], v[4]; };
__device__ __forceinline__ void kv_issue(Frame& F, KvRegs& R, const Item& it, int h) {
    const bf16_t* P = (const bf16_t*)(F.ws + WS_PA);
    const bf16_t* Pk = P + ptile(it.row0 >> 7, 12 + h); const bf16_t* Pv = P + ptile(it.row0 >> 7, 16 + h);
#pragma unroll
    for (int t2 = 0; t2 < 2; ++t2) { const int task = F.tid + t2 * NTHREADS, token = task >> 3, d0 = (task & 7) * 8;
        R.klo[t2] = ldg<u32x4>(Pk, (unsigned)(token * 128 + d0) * 2u); R.khi[t2] = ldg<u32x4>(Pk, (unsigned)(token * 128 + d0 + 64) * 2u); }
#pragma unroll
    for (int t4 = 0; t4 < 4; ++t4) { const int task = F.tid + t4 * NTHREADS, token = task >> 4, d0 = (task & 15) * 8; R.v[t4] = ldg<u32x4>(Pv, (unsigned)(token * 128 + d0) * 2u); }
}
template <int KS> __device__ __forceinline__ void kv_step(unsigned aK, unsigned aVf, unsigned aVb, f32x4 (&accf)[8], f32x4 (&accb)[8]) {
    const bf16x8 af = tr1<KS * 32 * VP>(aVf), ab = tr1<KS * 32 * VP>(aVb);
    bf16x8 b[8];
    tr4<KS * 32 * VP>(aK, b[0], b[1], b[2], b[3]); tr4<KS * 32 * VP + 128>(aK, b[4], b[5], b[6], b[7]);
#pragma unroll
    for (int n = 0; n < 8; ++n) { accf[n] = __builtin_amdgcn_mfma_f32_16x16x32_bf16(af, b[n], accf[n], 0, 0, 0); accb[n] = __builtin_amdgcn_mfma_f32_16x16x32_bf16(ab, b[n], accb[n], 0, 0, 0); }
}
__device__ __forceinline__ void stage_state_t(Frame& F, ldsp_t dst, const bf16_t* St) {
#pragma unroll
    for (int t4 = 0; t4 < 4; ++t4) { const int task = F.tid + t4 * NTHREADS, e = task >> 4, c8 = task & 15;
        *(LAS u32x4*)(dst + e * TP + c8 * 16) = ldg<u32x4>(St, (unsigned)(e * 128 + c8 * 8) * 2u); }
}
__device__ __forceinline__ void mm16x128(ldsp_t At, int ra0, ldsp_t Bt, int lane, f32x4 (&acc)[8]) {
    const int fr = lane & 15, fq = lane >> 4;
#pragma unroll
    for (int ks = 0; ks < 4; ++ks) { const bf16x8 a = *(const LAS bf16x8*)(At + (ra0 + fr) * TP + (32 * ks + 8 * fq) * 2);
#pragma unroll
        for (int n = 0; n < 8; ++n) { const bf16x8 b = *(const LAS bf16x8*)(Bt + (16 * n + fr) * TP + (32 * ks + 8 * fq) * 2); acc[n] = __builtin_amdgcn_mfma_f32_16x16x32_bf16(a, b, acc[n], 0, 0, 0); } }
}

__device__ __forceinline__ void kv_head(Frame& F, KvRegs& R, KvRegs& Rn, bool pre, int item, const Item& it, int h) {
    bf16_t* KV = (bf16_t*)(F.ws + WS_KV);
    const LAS float* dec = (const LAS float*)(F.lds + LDS_DEC);
    ldsp_t tK = F.lds, tVf = F.lds + TILEV, tVb = F.lds + 2 * TILEV;
#pragma unroll
    for (int t2 = 0; t2 < 2; ++t2) { const int task = F.tid + t2 * NTHREADS, token = task >> 3, d0 = (task & 7) * 8;
        *(LAS u32x4*)(tK + token * VP + d0 * 2) = R.klo[t2]; *(LAS u32x4*)(tK + token * VP + (d0 + 64) * 2) = R.khi[t2]; }
#pragma unroll
    for (int t4 = 0; t4 < 4; ++t4) { const int task = F.tid + t4 * NTHREADS, token = task >> 4, d0 = (task & 15) * 8; const u32x4 v = R.v[t4];
        const float df = dec[(0 * 4 + h) * 132 + 127 - token], db = dec[(1 * 4 + h) * 132 + token];
        const float x[8] = {bf2f(v.x & 0xffffu), __uint_as_float(v.x & 0xffff0000u), bf2f(v.y & 0xffffu), __uint_as_float(v.y & 0xffff0000u), bf2f(v.z & 0xffffu), __uint_as_float(v.z & 0xffff0000u), bf2f(v.w & 0xffffu), __uint_as_float(v.w & 0xffff0000u)};
        u32x4 wf, wb; wf.x = pk2(x[0] * df, x[1] * df); wf.y = pk2(x[2] * df, x[3] * df); wf.z = pk2(x[4] * df, x[5] * df); wf.w = pk2(x[6] * df, x[7] * df);
        wb.x = pk2(x[0] * db, x[1] * db); wb.y = pk2(x[2] * db, x[3] * db); wb.z = pk2(x[4] * db, x[5] * db); wb.w = pk2(x[6] * db, x[7] * db);
        *(LAS u32x4*)(tVf + token * VP + d0 * 2) = wf; *(LAS u32x4*)(tVb + token * VP + d0 * 2) = wb; }
    WG_BAR_LDS();
    if (pre) kv_issue(F, Rn, it, h + 1);
    f32x4 af[8], ab[8];
#pragma unroll
    for (int n = 0; n < 8; ++n) { af[n] = zero4(); ab[n] = zero4(); }
    { const unsigned aK = tr_lane_addr(tK, F.lane), aVf = tr_lane_addr(tVf, F.lane) + 32u * (unsigned)F.wave, aVb = tr_lane_addr(tVb, F.lane) + 32u * (unsigned)F.wave;
      kv_step<0>(aK, aVf, aVb, af, ab); kv_step<1>(aK, aVf, aVb, af, ab); kv_step<2>(aK, aVf, aVb, af, ab); kv_step<3>(aK, aVf, aVb, af, ab); }
    const int fr = F.lane & 15, fq = F.lane >> 4;
    bf16_t* of = KV + (((size_t)item * 4 + h) * 2 + 0) * 16384 + (size_t)(16 * F.wave) * 128;
    unsigned so = (unsigned)((4 * fq) * 128 + fr) * 2u; asm volatile("" : "+v"(so));
#pragma unroll
    for (int n = 0; n < 8; ++n)
#pragma unroll
        for (int jj = 0; jj < 4; ++jj) { stg<bf16_t>(of, so + (unsigned)((jj * 128 + 16 * n) * 2), (bf16_t)f2bf(af[n][jj])); stg<bf16_t>(of, so + (unsigned)((16384 + jj * 128 + 16 * n) * 2), (bf16_t)f2bf(ab[n][jj])); }
    WG_BAR_LDS();
}
__device__ __forceinline__ int latent_item(int c) { return (c >> 5) * SPB + 2 + (c & 31); }
__device__ __forceinline__ int ctx_item(int ci) { return (ci >> 1) * SPB + (ci & 1); }
__device__ __forceinline__ void phase_m1(Frame& F, int l) {
    build_decay(F, l); __syncthreads();
    for (int c = F.bid; c < 256; c += F.G) {
        fresh(F);
        { const int item = latent_item(c); const Item it = item_info(item); const int swp = (c >> 3) & 1;
#pragma unroll 1
          for (int step = 0; step < 2; ++step) {
              fresh(F);
              if ((step ^ swp) == 0) rg_part<false>(F, l, item, it, F.wave, 0, 4);
              else { KvRegs A, B;
                  kv_issue(F, A, it, 0);
                  kv_head(F, A, B, true, item, it, 0);
                  fresh(F); kv_head(F, B, A, true, item, it, 1);
                  fresh(F); kv_head(F, A, B, true, item, it, 2);
                  fresh(F); kv_head(F, B, A, false, item, it, 3); }
              __syncthreads(); } }
        fresh(F);
        if (c >= 64 && c < 192) { const int cu = c - 64; const int item = ctx_item(cu >> 3); const Item it = item_info(item);
            const int w4 = F.wave & 3; rg_part<false, true>(F, l, item, it, cu & 7, w4, w4 + 1); }
        __syncthreads();
        if (c < 64) { const int item = ctx_item(c >> 2); const Item it = item_info(item); KvRegs A, B; fresh(F); kv_issue(F, A, it, c & 3); kv_head(F, A, B, false, item, it, c & 3); }
        if (c >= 192) { __syncthreads(); fresh(F); moe_fill(F, fill_base(F.G, 3 + l) + (c - 192), 1); }
    }
}
__device__ __forceinline__ int seq_order(int dir, int step) { return dir ? (step == 0 ? 1 : (step == 1 ? 0 : 35 - step)) : step; }
__device__ __forceinline__ void phase_m2(Frame& F, int l) {
    bf16_t* KV = (bf16_t*)(F.ws + WS_KV);
    const int gt = F.bid * NTHREADS + F.tid, NGT = F.G * NTHREADS;
    for (int c = gt; c < NB * NH * 2 * 128 * 16; c += NGT) {
        const int dc = c & 15, e = (c >> 4) & 127, dir = (c >> 11) & 1, h = (c >> 12) & 3, b = c >> 14;
        const float x = F.pa->in[I_RETDEC][l * 8 + dir * 4 + h]; const float decay = expf(128.0f * (-log1pf(expf(-x))));
        float S[8];
#pragma unroll
        for (int i = 0; i < 8; ++i) S[i] = 0.f;
        const unsigned lo = (unsigned)((((h * 2 + dir) * 128 + e) * 128 + dc * 8) * 2);
        for (int g0 = 0; g0 < SPB; g0 += 17) {
            u32x4 v[17];
#pragma unroll
            for (int i = 0; i < 17; ++i) { const int item = b * SPB + seq_order(dir, g0 + i); v[i] = ldg<u32x4>(KV + (size_t)item * 4 * 2 * 16384, lo); }
#pragma unroll
            for (int i = 0; i < 17; ++i) { const int item = b * SPB + seq_order(dir, g0 + i);
                u32x4 w; w.x = pk2(S[0], S[1]); w.y = pk2(S[2], S[3]); w.z = pk2(S[4], S[5]); w.w = pk2(S[6], S[7]);
                stg<u32x4>(KV + (size_t)item * 4 * 2 * 16384, lo, w);
                S[0] = S[0] * decay + bf2f(v[i].x & 0xffffu); S[1] = S[1] * decay + __uint_as_float(v[i].x & 0xffff0000u); S[2] = S[2] * decay + bf2f(v[i].y & 0xffffu); S[3] = S[3] * decay + __uint_as_float(v[i].y & 0xffff0000u);
                S[4] = S[4] * decay + bf2f(v[i].z & 0xffffu); S[5] = S[5] * decay + __uint_as_float(v[i].z & 0xffff0000u); S[6] = S[6] * decay + bf2f(v[i].w & 0xffffu); S[7] = S[7] * decay + __uint_as_float(v[i].w & 0xffff0000u); }
        }
    }
    const float* TOT = (const float*)(F.ws + WS_TOT); float* CARRY = (float*)(F.ws + WS_CARRY);
    if (F.tid < 32) for (int cidx = F.bid * 32 + F.tid; cidx < NB * 2 * 512; cidx += F.G * 32) {
      { const int ch = cidx & 511, dir = (cidx >> 9) & 1, b = cidx >> 10; float cr = 0.f;
          for (int g0 = 0; g0 < SPB; g0 += 17) { f32x2 ah[17];
#pragma unroll
              for (int i = 0; i < 17; ++i) { const int item = b * SPB + seq_order(dir, g0 + i); ah[i] = *(const f32x2*)(TOT + (((size_t)item * 2 + dir) * 512 + ch) * 2); }
#pragma unroll
              for (int i = 0; i < 17; ++i) { const int item = b * SPB + seq_order(dir, g0 + i); CARRY[((size_t)item * 2 + dir) * 512 + ch] = cr; cr = ah[i].x * cr + ah[i].y; } } } }
}
struct RetRegs { u32x4 v[4], sf[4], sb[4], klo[2], khi[2], g[4], q[4]; };
__device__ __forceinline__ void ret_issue(Frame& F, RetRegs& R, int item, const Item& it, int h) {
    const bf16_t* KV = (const bf16_t*)(F.ws + WS_KV); const bf16_t* P = (const bf16_t*)(F.ws + WS_PA);
    const bf16_t* Pk = P + ptile(it.row0 >> 7, 12 + h); const bf16_t* Pv = P + ptile(it.row0 >> 7, 16 + h);
    const bf16_t* Sf = KV + (((size_t)item * 4 + h) * 2 + 0) * 16384; const bf16_t* Sb = Sf + 16384;
    const int lane = F.lane, i0 = 16 * F.wave;
#pragma unroll
    for (int t2 = 0; t2 < 2; ++t2) { const int task = F.tid + t2 * NTHREADS, token = task >> 3, d0 = (task & 7) * 8;
        R.klo[t2] = ldg<u32x4>(Pk, (unsigned)(token * 128 + d0) * 2u); R.khi[t2] = ldg<u32x4>(Pk, (unsigned)(token * 128 + d0 + 64) * 2u); }
#pragma unroll
    for (int t4 = 0; t4 < 4; ++t4) { const int task = F.tid + t4 * NTHREADS, r = task >> 4, c8 = task & 15;
        R.v[t4] = ldg<u32x4>(Pv, (unsigned)(r * 128 + c8 * 8) * 2u); R.sf[t4] = ldg<u32x4>(Sf, (unsigned)(r * 128 + c8 * 8) * 2u); R.sb[t4] = ldg<u32x4>(Sb, (unsigned)(r * 128 + c8 * 8) * 2u); }
    { const bf16_t* Pg = P + ptile(it.row0 >> 7, 20 + h) + i0 * 128;
#pragma unroll
      for (int k = 0; k < 4; ++k) R.g[k] = ldg<u32x4>(Pg, (unsigned)((lane >> 2) * 128 + 32 * (lane & 3) + 8 * k) * 2u); }
    { const bf16_t* Pq = P + ptile(it.row0 >> 7, 8 + h) + i0 * 128;
#pragma unroll
      for (int ks = 0; ks < 4; ++ks) R.q[ks] = ldg<u32x4>(Pq, (unsigned)((lane & 15) * 128 + 32 * ks + 8 * (lane >> 4)) * 2u); }
}
__device__ __forceinline__ void ret_head(Frame& F, RetRegs& R, RetRegs& Rn, bool pre, int item, const Item& it, int h) {
    bf16_t* Y = (bf16_t*)(F.ws + WS_Y);
    const LAS float* dec = (const LAS float*)(F.lds + LDS_DEC);
    ldsp_t tK = F.lds, tV = F.lds + TILEB, tSf = tV + TILEV, tSb = tSf + TILEB;
    const int lane = F.lane, fr = lane & 15, fq = lane >> 4, i0 = 16 * F.wave;
#pragma unroll
    for (int t2 = 0; t2 < 2; ++t2) { const int task = F.tid + t2 * NTHREADS, token = task >> 3, d0 = (task & 7) * 8;
        *(LAS u32x4*)(tK + token * TP + d0 * 2) = R.klo[t2]; *(LAS u32x4*)(tK + token * TP + (d0 + 64) * 2) = R.khi[t2]; }
#pragma unroll
    for (int t4 = 0; t4 < 4; ++t4) { const int task = F.tid + t4 * NTHREADS, r = task >> 4, c8 = task & 15;
        *(LAS u32x4*)(tV + r * VP + c8 * 16) = R.v[t4]; *(LAS u32x4*)(tSf + r * TP + c8 * 16) = R.sf[t4]; *(LAS u32x4*)(tSb + r * TP + c8 * 16) = R.sb[t4]; }
    bf16x8 qf[4];
#pragma unroll
    for (int ks = 0; ks < 4; ++ks) qf[ks] = __builtin_bit_cast(bf16x8, R.q[ks]);
    u32x4 gk[4];
#pragma unroll
    for (int k = 0; k < 4; ++k) gk[k] = R.g[k];
    WG_BAR_LDS();
    if (pre) ret_issue(F, Rn, item, it, h + 1);
    bf16x8 pa[4];
    { f32x4 C[8];
#pragma unroll
      for (int jt = 0; jt < 8; ++jt) { C[jt] = zero4();
#pragma unroll
          for (int ks = 0; ks < 4; ++ks) { const bf16x8 a = *(const LAS bf16x8*)(tK + (16 * jt + fr) * TP + (32 * ks + 8 * fq) * 2); C[jt] = __builtin_amdgcn_mfma_f32_16x16x32_bf16(a, qf[ks], C[jt], 0, 0, 0); } }
      const int i = i0 + fr;
#pragma unroll
      for (int jt = 0; jt < 8; ++jt)
#pragma unroll
          for (int jj = 0; jj < 4; ++jj) { const int j = 16 * jt + 4 * fq + jj; const float dcy = (i >= j) ? dec[(0 * 4 + h) * 132 + (i - j)] : dec[(1 * 4 + h) * 132 + (j - i)]; C[jt][jj] *= dcy; }
#pragma unroll
      for (int u = 0; u < 4; ++u) { const u32x4 w = {pg8::cvt_pk_bf16(C[2 * u][0], C[2 * u][1]), pg8::cvt_pk_bf16(C[2 * u][2], C[2 * u][3]), pg8::cvt_pk_bf16(C[2 * u + 1][0], C[2 * u + 1][1]), pg8::cvt_pk_bf16(C[2 * u + 1][2], C[2 * u + 1][3])};
          pa[u] = __builtin_bit_cast(bf16x8, w); } }
    WG_BAR_LDS();
    { ldsp_t gt = tK + (i0 + (lane >> 2)) * TP + (lane & 3) * 64;
#pragma unroll
      for (int k = 0; k < 4; ++k) *(LAS u32x4*)(gt + 16 * k) = gk[k]; }
    f32x4 o[8];
#pragma unroll
    for (int n = 0; n < 8; ++n) o[n] = zero4();
    { const unsigned aV = tr_lane_addr(tV, lane); bf16x8 b[8];
#define RET_PV(U) do { tr4<(U) * 32 * VP>(aV, b[0], b[1], b[2], b[3]); tr4<(U) * 32 * VP + 128>(aV, b[4], b[5], b[6], b[7]); \
        _Pragma("unroll") for (int n = 0; n < 8; ++n) o[n] = __builtin_amdgcn_mfma_f32_16x16x32_bf16(pa[U], b[n], o[n], 0, 0, 0); } while (0)
      RET_PV(0); RET_PV(1); RET_PV(2); RET_PV(3);
#undef RET_PV
    }
    { f32x4 cf[8];
#pragma unroll
      for (int n = 0; n < 8; ++n) { cf[n] = zero4();
#pragma unroll
          for (int ks = 0; ks < 4; ++ks) { const bf16x8 b = *(const LAS bf16x8*)(tSf + (16 * n + fr) * TP + (32 * ks + 8 * fq) * 2); cf[n] = __builtin_amdgcn_mfma_f32_16x16x32_bf16(qf[ks], b, cf[n], 0, 0, 0); } }
#pragma unroll
      for (int jj = 0; jj < 4; ++jj) { const float sf = dec[(0 * 4 + h) * 132 + (i0 + 4 * fq + jj + 1)];
#pragma unroll
          for (int n = 0; n < 8; ++n) o[n][jj] += sf * cf[n][jj]; } }
    { f32x4 cb[8];
#pragma unroll
      for (int n = 0; n < 8; ++n) { cb[n] = zero4();
#pragma unroll
          for (int ks = 0; ks < 4; ++ks) { const bf16x8 b = *(const LAS bf16x8*)(tSb + (16 * n + fr) * TP + (32 * ks + 8 * fq) * 2); cb[n] = __builtin_amdgcn_mfma_f32_16x16x32_bf16(qf[ks], b, cb[n], 0, 0, 0); } }
#pragma unroll
      for (int jj = 0; jj < 4; ++jj) { const float sb = dec[(1 * 4 + h) * 132 + (128 - (i0 + 4 * fq + jj))];
#pragma unroll
          for (int n = 0; n < 8; ++n) o[n][jj] += sb * cb[n][jj]; } }
    { ldsp_t gc = tK + (i0 + 4 * fq) * TP + fr * 2;
#pragma unroll
      for (int jj = 0; jj < 4; ++jj) { float s1 = 0.f;
#pragma unroll
          for (int n = 0; n < 8; ++n) s1 += o[n][jj];
          s1 += swz_xor<1>(s1); s1 += swz_xor<2>(s1); s1 += swz_xor<4>(s1); s1 += swz_xor<8>(s1);
          const float mu = s1 * (1.0f / 128.0f); float q = 0.f;
#pragma unroll
          for (int n = 0; n < 8; ++n) { const float dd = o[n][jj] - mu; q += dd * dd; }
          q += swz_xor<1>(q); q += swz_xor<2>(q); q += swz_xor<4>(q); q += swz_xor<8>(q);
          const float rstd = 1.0f / sqrtf(q * (1.0f / 128.0f) + EPS);
#pragma unroll
          for (int n = 0; n < 8; ++n) { LAS bf16_t* p = (LAS bf16_t*)(gc + jj * TP + 32 * n); const float gv = bf2f(*p); *p = (bf16_t)f2bf(siluf_(gv) * (o[n][jj] - mu) * rstd); } } }
    LDS_WAIT(); asm volatile("" ::: "memory");
    { ldsp_t gt = tK + (i0 + (lane >> 2)) * TP + (lane & 3) * 64; bf16_t* Yo = Y + (size_t)(it.row0 + i0) * D + 512 + h * HD;
#pragma unroll
      for (int k = 0; k < 4; ++k) stg<u32x4>(Yo, (unsigned)((lane >> 2) * D + 32 * (lane & 3) + 8 * k) * 2u, *(const LAS u32x4*)(gt + 16 * k)); }
    WG_BAR_LDS();
}
__device__ __forceinline__ void phase_m3(Frame& F, int l) {
    build_decay(F, l); __syncthreads();
    for (int c = F.bid; c < 256; c += F.G) {
        fresh(F);
        { const int item = latent_item(c); const Item it = item_info(item); const int swp = (c >> 3) & 1;
#pragma unroll 1
          for (int step = 0; step < 2; ++step) {
              fresh(F);
              if ((step ^ swp) == 0) rg_part<true>(F, l, item, it, F.wave, 0, 4);
              else { RetRegs R, Rn;
                  ret_issue(F, R, item, it, 0);
                  ret_head(F, R, Rn, true, item, it, 0);
                  fresh(F); ret_head(F, Rn, R, true, item, it, 1);
                  fresh(F); ret_head(F, R, Rn, true, item, it, 2);
                  fresh(F); ret_head(F, Rn, R, false, item, it, 3); }
              __syncthreads(); } }
        if (l == 0) {
            fresh(F);
            if (c >= 64 && c < 192) { const int cu = c - 64; const int item = ctx_item(cu >> 3); const Item it = item_info(item);
                const int w4 = F.wave & 3; rg_part<true, true>(F, l, item, it, cu & 7, w4, w4 + 1); }
            __syncthreads();
            if (c < 64) { const int item = ctx_item(c >> 2); const Item it = item_info(item); RetRegs R, Rn; fresh(F); ret_issue(F, R, item, it, c & 3); ret_head(F, R, Rn, false, item, it, c & 3); }
            if (c >= 192) { fresh(F); moe_fill(F, fill_base(F.G, 5) + 2 * (c - 192), 2); }
        }
    }
}

constexpr int N_PHASES = 23;
__global__ void __launch_bounds__(NTHREADS, 2) fwd_kernel(Args args) {
    extern __shared__ __attribute__((aligned(16))) unsigned char lds_raw[];
    Frame F; F.lds = (ldsp_t)lds_raw; F.wave0 = __builtin_amdgcn_readfirstlane((int)threadIdx.x >> 6); F.G = gridDim.x; F.pa0 = &args; F.out0 = args.out; F.ws0 = args.ws; fresh(F);
    volatile LAS unsigned* MISC = (volatile LAS unsigned*)(F.lds + LDS_MISC);
    if (F.tid < 64) MISC[F.tid] = 0u;
    __syncthreads();
    const int lo = args.ph_lo, hi = args.ph_hi;
    XcdBarrier bar; bar.bar = (unsigned*)(F.ws + WS_CTL); bar.x = 0; bar.st = nullptr;
    if (hi - lo > 1) bar = xcd_barrier_post((unsigned*)(F.ws + WS_CTL), MISC);
#ifndef DIAG_MASK
#define DIAG_MASK 0xffffffffu
#endif
#ifndef REPEAT_MASK
#define REPEAT_MASK 0u
#endif
#define REPS(kind) ((((REPEAT_MASK) >> (kind)) & 1u) ? 2 : 1)
#define INK(k, kind) (((DIAG_MASK >> (kind)) & 1u) && lo <= (k) && (k) < hi && fresh(F))
#define IN(k) (lo <= (k) && (k) < hi)
#define SEAM(k) do { if (IN(k) && IN((k) + 1)) xcd_barrier(bar); } while (0)
    float* ctxx = (float*)(F.ws + WS_CTXX); bf16_t* xb = (bf16_t*)((char*)F.out + XB_OFF);
    const float* modlat = (const float*)(F.ws + WS_MODLAT); const float* modctx = (const float*)(F.ws + WS_MODCTX);

    if (INK(0, 0)) { const int swp = (F.bid >> 3) & 1;
#pragma unroll 1
        for (int step = 0; step < 2; ++step) { fresh(F); if ((step ^ swp) == 0) phase_convert_small(F); else phase_mod(F); __syncthreads(); }
        if (F.bid >= 192) { fresh(F); moe_fill(F, fill_base(F.G, 6) + 2 * (F.bid - 192), 2); } } SEAM(0);
    if (INK(1, 1)) { for (int r_ = 0; r_ < REPS(1); ++r_) phase_norm(F, 0, 0, F.pa->in[I_X], nullptr, F.pa->in[I_CTX], MROWS, SlabRed{nullptr, 0, nullptr, nullptr, nullptr}); } SEAM(1);
#pragma unroll 1
    for (int l = 0; l < 2; ++l) {
        const int pb = (l == 0) ? 2 : 11;
        if (INK(pb + 0, 2)) { pg8::Gemm g{(const bf16_t*)(F.ws + WS_HX), (const bf16_t*)(F.ws + WS_WIN) + (size_t)l * INW * D, INW, D, 0, nullptr}; pg8::Order S; S.init(MROWS / 256, INW / 256, F.G, F.bid, nullptr, nullptr, D / 64, false, 0);
            pg8::EpiInProj E{(bf16_t*)(F.ws + WS_PA), INW, (const float*)(F.ws + WS_ROPE), (const float*)(F.ws + WS_ROPE) + 4096 * 64}; for (int r_ = 0; r_ < REPS(2); ++r_) pg8::gemm_phase<pg8::EpiInProj>(F.lds, g, S, E, F.tid);
            fresh(F); moe_fill_gemm(F, U_GIN, l, 2); }
        SEAM(pb + 0);
        if (INK(pb + 1, 3)) { for (int r_ = 0; r_ < REPS(3); ++r_) phase_m1(F, l); }
        SEAM(pb + 1);
        if (INK(pb + 2, 4)) { for (int r_ = 0; r_ < REPS(4); ++r_) { if (r_) phase_m1(F, l); phase_m2(F, l); } }
        SEAM(pb + 2);
        if (INK(pb + 3, 5)) { for (int r_ = 0; r_ < REPS(5); ++r_) phase_m3(F, l); }
        SEAM(pb + 3);
        if (INK(pb + 4, 6)) { pg8::Gemm g{(const bf16_t*)(F.ws + WS_Y), (const bf16_t*)(F.ws + WS_WOUT) + (size_t)l * D * D, D, D, 0, (float*)(F.ws + WS_SLABA)}; pg8::Order S; S.init((l == 0 ? MROWS : NLAT) / 256, D / 256, F.G, F.bid, nullptr, nullptr, D / 64, true, MAXSLAB_A);
            pg8::EpiResid E{l == 0 ? F.pa->in[I_X] : nullptr, xb, F.pa->in[I_CTX], ctxx, modlat + (size_t)l * 8 * 6144 + 2048, modctx + (size_t)l * 6144 + 2048};
            pg8::gemm_phase<pg8::EpiResid>(F.lds, g, S, E, F.tid); }
        SEAM(pb + 4);
        if (l == 0) {
            if (INK(7, 1)) { for (int r_ = 0; r_ < REPS(1); ++r_) phase_norm(F, 0, 1, nullptr, xb, ctxx, MROWS, SlabRed{(const float*)(F.ws + WS_SLABA), pg8::split_factor((MROWS / 256) * 4, F.G, D / 64, MAXSLAB_A), modctx + 2048, F.pa->in[I_CTX], ctxx}); } SEAM(7);
            if (INK(8, 7)) { pg8::Gemm g{(const bf16_t*)(F.ws + WS_HX), (const bf16_t*)(F.ws + WS_WUP), 2 * DFF, D, 0, nullptr}; pg8::Order S; S.init(MROWS / 256, 2 * DFF / 256, F.G, F.bid, nullptr, nullptr, D / 64, false, 0);
                pg8::EpiSwiGLU E{(bf16_t*)(F.ws + WS_PA), DFF}; for (int r_ = 0; r_ < REPS(7); ++r_) pg8::gemm_phase<pg8::EpiSwiGLU>(F.lds, g, S, E, F.tid);
                fresh(F); moe_fill_gemm(F, U_GUP, 2, 2); }
            SEAM(8);
            if (INK(9, 8)) { pg8::Gemm g{(const bf16_t*)(F.ws + WS_PA), (const bf16_t*)(F.ws + WS_WDN), D, DFF, 0, (float*)(F.ws + WS_SLABA), 1}; pg8::Order S; S.init(MROWS / 256, D / 256, F.G, F.bid, nullptr, nullptr, DFF / 64, true, MAXSLAB_A);
                pg8::EpiResid E{nullptr, xb, (const float*)ctxx, ctxx, modlat + 5120, modctx + 5120}; pg8::gemm_phase<pg8::EpiResid>(F.lds, g, S, E, F.tid); }
            SEAM(9);
            if (INK(10, 1)) { for (int r_ = 0; r_ < REPS(1); ++r_) phase_norm(F, 1, 0, nullptr, xb, ctxx, MROWS, SlabRed{(const float*)(F.ws + WS_SLABA), pg8::split_factor((MROWS / 256) * 4, F.G, DFF / 64, MAXSLAB_A), modctx + 5120, ctxx, ctxx}); } SEAM(10);
        }
    }
    if (INK(16, 9)) { const int swp = (F.bid >> 3) & 1;
#pragma unroll 1
        for (int step = 0; step < 2; ++step) { fresh(F); if ((step ^ swp) == 0) phase_norm_router(F, xb); else phase_convert_moe(F); __syncthreads(); } } SEAM(16);
    if (INK(17, 10)) { phase_moe_sort(F); } SEAM(17);
#pragma unroll 1
    for (int k = 0; k < 2; ++k) {
        const int* meta = (const int*)(F.ws + MOE_META) + 9 * k;
        if (INK(18 + 2 * k, 11)) { if (k == 1) { moe_reduce(F, 0); __syncthreads(); } pg8::Gemm g{(const bf16_t*)(F.ws + WS_HX), (const bf16_t*)(F.ws + WS_MOEUP), 2 * DEXP, D, (size_t)2 * DEXP * D * 2, nullptr}; pg8::Order S; S.init(meta[8], 2 * DEXP / 256, F.G, F.bid, meta, (const int*)(F.ws + MOE_PTOK) + k * MROWS, D / 64, false, 0);
            pg8::EpiSwiGLU E{(bf16_t*)(F.ws + WS_PA), DEXP}; for (int r_ = 0; r_ < REPS(11); ++r_) pg8::gemm_phase<pg8::EpiSwiGLU>(F.lds, g, S, E, F.tid); }
        SEAM(18 + 2 * k);
        if (INK(19 + 2 * k, 12)) { pg8::Gemm g{(const bf16_t*)(F.ws + WS_PA), (const bf16_t*)F.out, D, DEXP, (size_t)D * DEXP * 2, (float*)(F.ws + WS_SLABM), 1}; pg8::Order S; S.init(meta[8], D / 256, F.G, F.bid, meta, nullptr, DEXP / 64, true, MAXSLAB_M);
            pg8::EpiMoeDown E{xb, k == 1 ? (bf16_t*)(F.ws + WS_XF) : xb, (const int*)(F.ws + MOE_PTOK) + k * MROWS, (const float*)(F.ws + MOE_PW) + k * MROWS, modlat + (size_t)8 * 6144 + 5120}; pg8::gemm_phase<pg8::EpiMoeDown>(F.lds, g, S, E, F.tid); }
        SEAM(19 + 2 * k);
    }
    if (INK(22, 13)) phase_final(F);
#undef IN
#undef INK
#undef SEAM
}

extern "C" void kernel_launch(void* const* d_in, const int* in_sizes, int n_in, void* d_out, int out_size, void* d_ws, size_t ws_size, hipStream_t stream) {
    static int grid = 0;
    if (grid == 0) {
        if (n_in != 27 || in_sizes[0] != NLAT * D || out_size != NLAT * D || ws_size < WS_END) { fprintf(stderr, "kernel_launch: unexpected problem (n_in %d, in0 %d, out %d, ws %zu, need %zu); nothing launched\n", n_in, n_in > 0 ? in_sizes[0] : -1, out_size, ws_size, (size_t)WS_END); grid = -1; return; }
        int dev = 0, cus = 0, per_cu = 0;
        if (hipGetDevice(&dev) != hipSuccess || hipDeviceGetAttribute(&cus, hipDeviceAttributeMultiprocessorCount, dev) != hipSuccess) { grid = -1; return; }
        if (hipFuncSetAttribute((const void*)fwd_kernel, hipFuncAttributeMaxDynamicSharedMemorySize, LDS_BYTES) != hipSuccess) { fprintf(stderr, "kernel_launch: hipFuncSetAttribute failed\n"); grid = -1; return; }
        if (hipOccupancyMaxActiveBlocksPerMultiprocessor(&per_cu, (const void*)fwd_kernel, NTHREADS, LDS_BYTES) != hipSuccess || per_cu < 1) { fprintf(stderr, "kernel_launch: occupancy query says %d\n", per_cu); }
        (void)hipGetLastError();
        grid = cus;
    }
    if (grid < 0) return;
    (void)hipMemsetAsync((char*)d_ws + WS_CTL, 0, CTL_ZERO_BYTES, stream);
    Args a; memset(&a, 0, sizeof(a));
    for (int i = 0; i < 27; ++i) a.in[i] = (const float*)d_in[i];
    a.out = (float*)d_out; a.ws = (unsigned char*)d_ws;
#if MK_ONE_LAUNCH
    a.ph_lo = 0; a.ph_hi = N_PHASES;
    hipLaunchKernelGGL(fwd_kernel, dim3(grid), dim3(NTHREADS), LDS_BYTES, stream, a);
#else
    for (int p = 0; p < N_PHASES; ++p) { a.ph_lo = p; a.ph_hi = p + 1; hipLaunchKernelGGL(fwd_kernel, dim3(grid), dim3(NTHREADS), LDS_BYTES, stream, a); }
#endif
}
```
